# Optimizing an MI355X kernel written in HIP

```python
import jax
import jax.numpy as jnp
from jax import lax
import numpy as np

D_MODEL = 1024
BATCH = 8
SEQ = 2048
DEPTH = 2

GRID_W = 64
CTX_LEN = 256
QBLK = 128
ROPE_THETA = 10000.0
EPS = 1e-6

POOL_GROUPS = 4
POOL_CH = 64
POOL_DIM = POOL_GROUPS * POOL_CH
POOL_WINDOWS = (2, 4, 8, 16)

HEAD_DIM = 64
GQA_HEADS = 12
GQA_KV_HEADS = 4
GQA_GROUP = GQA_HEADS // GQA_KV_HEADS
GQA_Q_DIM = GQA_HEADS * HEAD_DIM
GQA_KV_DIM = GQA_KV_HEADS * HEAD_DIM
L0_IN = POOL_DIM + GQA_Q_DIM + 2 * GQA_KV_DIM
L0_MIX = POOL_DIM + GQA_Q_DIM

MLA_HEADS = 8
MLA_NOPE = 64
MLA_ROPE = 32
MLA_QK = MLA_NOPE + MLA_ROPE
MLA_V = 64
MLA_Q_LORA = 384
MLA_KV_LORA = 256

NA_HEADS = 8
NA_HEAD_DIM = 64
NA_DIM = NA_HEADS * NA_HEAD_DIM
NA_ROWS = 8
NA_COLS = 16

L1_IN = MLA_Q_LORA + MLA_KV_LORA + MLA_ROPE + 3 * NA_DIM
L1_MIX = MLA_HEADS * MLA_V + NA_DIM

FFN_DIM = -(-8 * D_MODEL // (3 * 256)) * 256

kernel_name = "hybrid_pool_gqa_mla_na_dit_trunk"


def rmsnorm(x, g):
    xf = x.astype(jnp.float32)
    y = xf * lax.rsqrt(jnp.mean(xf * xf, axis=-1, keepdims=True) + EPS)
    return y.astype(x.dtype) * g


def rope_1d(x, pos):
    d = x.shape[-1]
    half = d // 2
    inv = (ROPE_THETA ** (-np.arange(half, dtype=np.float32) * 2.0 / d)).astype(np.float32)
    ang = pos.astype(jnp.float32)[:, None] * inv[None, :]
    shape = (1, x.shape[1]) + (1,) * (x.ndim - 3) + (half,)
    cos = jnp.cos(ang).reshape(shape)
    sin = jnp.sin(ang).reshape(shape)
    xf = x.astype(jnp.float32)
    x1, x2 = xf[..., :half], xf[..., half:]
    return jnp.concatenate([x1 * cos - x2 * sin, x1 * sin + x2 * cos], axis=-1).astype(x.dtype)


def axial_rope(x, row, col):
    half = x.shape[-1] // 2
    return jnp.concatenate([rope_1d(x[..., :half], row), rope_1d(x[..., half:], col)], axis=-1)


def split_cols(p, sizes):
    return jnp.split(p, [int(o) for o in np.cumsum(sizes)[:-1]], axis=-1)


def block_attention(q, k, v, scale):
    B, T = q.shape[:2]
    qb = jnp.moveaxis(q.reshape((B, T // QBLK, QBLK) + q.shape[2:]), 1, 0)

    def one_block(q_blk):
        s = jnp.einsum("bqhgd,bkhd->bhgqk", q_blk, k).astype(jnp.float32) * scale
        p = jax.nn.softmax(s, axis=-1).astype(v.dtype)
        return jnp.einsum("bhgqk,bkhd->bqhgd", p, v)

    o = lax.map(one_block, qb)
    return jnp.moveaxis(o, 0, 1).reshape((B, T) + o.shape[3:])


def multiscale_pool(u, w_grp, ch_scale):
    B, T, _ = u.shape
    ug = u.reshape(B, T, POOL_GROUPS, POOL_CH).astype(jnp.float32)
    csum = jnp.concatenate([jnp.zeros((B, 1, POOL_GROUPS, POOL_CH), jnp.float32),
                            jnp.cumsum(ug, axis=1)], axis=1)
    t = np.arange(T)
    lo = np.stack([np.clip(t - w // 2, 0, T) for w in POOL_WINDOWS], axis=-1).astype(np.int32)
    hi = np.stack([np.clip(t - w // 2 + w, 0, T) for w in POOL_WINDOWS], axis=-1).astype(np.int32)
    grp = np.arange(POOL_GROUPS, dtype=np.int32)[None, :]
    win_sum = csum[:, hi, grp] - csum[:, lo, grp]
    count = jnp.asarray((hi - lo).astype(np.float32))[None, :, :, None]
    d = (win_sum / count - ug).astype(u.dtype)
    y = jnp.einsum("btgc,gcd->btgd", d, w_grp).reshape(B, T, POOL_DIM)
    return y * ch_scale


def neighbourhood_attention(q, k, v, k_ctx, v_ctx, rpb, scale):
    B, S, H, dh = q.shape
    rows = S // GRID_W
    kr = min(NA_ROWS, rows)
    kc = NA_COLS
    cols = np.arange(GRID_W)
    key_col = (np.clip(cols - kc // 2, 0, GRID_W - kc)[:, None] + np.arange(kc)[None, :]).astype(np.int32)
    dc_idx = (key_col - cols[:, None] + (NA_COLS - 1)).astype(np.int32)
    n_win = kr * kc
    q_rows = jnp.moveaxis(q.reshape(B, rows, GRID_W, H, dh), 1, 0)

    def one_row(args):
        r, q_r = args
        r0 = jnp.clip(r - kr // 2, 0, rows - kr)
        key_row = r0 + jnp.arange(kr, dtype=jnp.int32)
        idx = (key_row[None, :, None] * GRID_W + key_col[:, None, :]).reshape(GRID_W, n_win)
        k_w = jnp.take(k, idx, axis=1)
        v_w = jnp.take(v, idx, axis=1)
        bias = rpb[:, key_row - r + (NA_ROWS - 1)][:, :, dc_idx]
        bias = jnp.transpose(bias, (0, 2, 1, 3)).reshape(H, GRID_W, n_win)
        s_win = jnp.einsum("bqhd,bqkhd->bhqk", q_r, k_w).astype(jnp.float32) * scale + bias.astype(jnp.float32)
        s_ctx = jnp.einsum("bqhd,bchd->bhqc", q_r, k_ctx).astype(jnp.float32) * scale
        p = jax.nn.softmax(jnp.concatenate([s_win, s_ctx], axis=-1), axis=-1).astype(v.dtype)
        return (jnp.einsum("bhqk,bqkhd->bqhd", p[..., :n_win], v_w)
                + jnp.einsum("bhqc,bchd->bqhd", p[..., n_win:], v_ctx))

    o = lax.map(one_row, (jnp.arange(rows, dtype=jnp.int32), q_rows))
    return jnp.moveaxis(o, 0, 1).reshape(B, S, H, dh)


def adaln(cond, w, b):
    d = w.shape[0]
    m = jax.nn.silu(cond) @ w + b
    return [m[:, None, i * d:(i + 1) * d] for i in range(6)]


def modulate(x, g, shift, scale):
    return rmsnorm(x, g) * (1.0 + scale) + shift


def swiglu(h, wg, wu, wd):
    return (jax.nn.silu(h @ wg) * (h @ wu)) @ wd


def mixer_pool_gqa(h, hc, row, col, need_ctx, w_in, pool_w, pool_scale, q_gain, k_gain, w_out):
    B, S, _ = h.shape
    Tc = hc.shape[1]
    sizes = (POOL_DIM, GQA_Q_DIM, GQA_KV_DIM, GQA_KV_DIM)
    a, q, k, v = split_cols(h @ w_in, sizes)
    ac, qc, kc, vc = split_cols(hc @ w_in, sizes)
    q = axial_rope(rmsnorm(q.reshape(B, S, GQA_KV_HEADS, GQA_GROUP, HEAD_DIM), q_gain), row, col)
    k = axial_rope(rmsnorm(k.reshape(B, S, GQA_KV_HEADS, HEAD_DIM), k_gain), row, col)
    v = v.reshape(B, S, GQA_KV_HEADS, HEAD_DIM)
    kc = rmsnorm(kc.reshape(B, Tc, GQA_KV_HEADS, HEAD_DIM), k_gain)
    vc = vc.reshape(B, Tc, GQA_KV_HEADS, HEAD_DIM)
    scale = HEAD_DIM ** -0.5
    attn = block_attention(q, jnp.concatenate([kc, k], axis=1), jnp.concatenate([vc, v], axis=1),
                           scale).reshape(B, S, GQA_Q_DIM)
    out = jnp.concatenate([multiscale_pool(a, pool_w, pool_scale), attn], axis=-1) @ w_out
    if not need_ctx:
        return out, None
    qc = rmsnorm(qc.reshape(B, Tc, GQA_KV_HEADS, GQA_GROUP, HEAD_DIM), q_gain)
    attn_c = block_attention(qc, kc, vc, scale).reshape(B, Tc, GQA_Q_DIM)
    out_c = jnp.concatenate([multiscale_pool(ac, pool_w, pool_scale), attn_c], axis=-1) @ w_out
    return out, out_c


def mixer_mla_na(h, hc, row, col, need_ctx, w_in, q_a_gain, kv_a_gain, w_uq, w_ukv,
                 mla_q_gain, mla_k_gain, na_q_gain, na_k_gain, na_rpb, w_out):
    B, S, _ = h.shape
    Tc = hc.shape[1]
    sizes = (MLA_Q_LORA, MLA_KV_LORA, MLA_ROPE, NA_DIM, NA_DIM, NA_DIM)
    cq, ckv, kr, nq, nk, nv = split_cols(h @ w_in, sizes)
    cqc, ckvc, krc, nqc, nkc, nvc = split_cols(hc @ w_in, sizes)

    def mla_q(cq_, T):
        q_ = (rmsnorm(cq_, q_a_gain) @ w_uq).reshape(B, T, MLA_HEADS, MLA_QK)
        return rmsnorm(q_, mla_q_gain)

    def mla_kv(ckv_, kr_, T):
        kv = (rmsnorm(ckv_, kv_a_gain) @ w_ukv).reshape(B, T, MLA_HEADS, MLA_NOPE + MLA_V)
        k_rope = jnp.broadcast_to(kr_[:, :, None, :], (B, T, MLA_HEADS, MLA_ROPE))
        k_ = jnp.concatenate([kv[..., :MLA_NOPE], k_rope], axis=-1)
        return rmsnorm(k_, mla_k_gain), kv[..., MLA_NOPE:]

    def rope_tail(t):
        return jnp.concatenate([t[..., :MLA_NOPE], axial_rope(t[..., MLA_NOPE:], row, col)], axis=-1)

    mq = rope_tail(mla_q(cq, S))
    mk, mv = mla_kv(ckv, kr, S)
    mk = rope_tail(mk)
    mkc, mvc = mla_kv(ckvc, krc, Tc)
    mla_scale = MLA_QK ** -0.5
    o_mla = block_attention(mq[:, :, :, None], jnp.concatenate([mkc, mk], axis=1),
                            jnp.concatenate([mvc, mv], axis=1), mla_scale).reshape(B, S, MLA_HEADS * MLA_V)

    q_na = rmsnorm(nq.reshape(B, S, NA_HEADS, NA_HEAD_DIM), na_q_gain)
    k_na = rmsnorm(nk.reshape(B, S, NA_HEADS, NA_HEAD_DIM), na_k_gain)
    v_na = nv.reshape(B, S, NA_HEADS, NA_HEAD_DIM)
    k_nac = rmsnorm(nkc.reshape(B, Tc, NA_HEADS, NA_HEAD_DIM), na_k_gain)
    v_nac = nvc.reshape(B, Tc, NA_HEADS, NA_HEAD_DIM)
    na_scale = NA_HEAD_DIM ** -0.5
    o_na = neighbourhood_attention(q_na, k_na, v_na, k_nac, v_nac, na_rpb, na_scale).reshape(B, S, NA_DIM)

    out = jnp.concatenate([o_mla, o_na], axis=-1) @ w_out
    if not need_ctx:
        return out, None
    mqc = mla_q(cqc, Tc)
    o_mla_c = block_attention(mqc[:, :, :, None], mkc, mvc, mla_scale).reshape(B, Tc, MLA_HEADS * MLA_V)
    q_nac = rmsnorm(nqc.reshape(B, Tc, NA_HEADS, NA_HEAD_DIM), na_q_gain)
    o_na_c = block_attention(q_nac[:, :, :, None], k_nac, v_nac, na_scale).reshape(B, Tc, NA_DIM)
    out_c = jnp.concatenate([o_mla_c, o_na_c], axis=-1) @ w_out
    return out, out_c


def setup_inputs(seed: int = 0) -> dict:
    key = jax.random.key(seed)
    ks = iter(jax.random.split(key, 48))

    def nrm(shape, s):
        return jax.random.normal(next(ks), shape, jnp.float32) * s

    def gain(n):
        return 1.0 + nrm((n,), 0.1)

    D = D_MODEL
    inp = {}
    inp["x"] = nrm((BATCH, SEQ, D), 1.0)
    inp["c"] = nrm((BATCH, D), 1.0)
    inp["ctx"] = nrm((BATCH, CTX_LEN, D), 1.0)
    inp["c_ctx"] = nrm((D,), 1.0)
    inp["l0_ada_w"] = nrm((D, 6 * D), 0.5 * D ** -0.5)
    inp["l0_ada_b"] = nrm((6 * D,), 0.02)
    inp["l0_norm_mix"] = gain(D)
    inp["l0_norm_ffn"] = gain(D)
    inp["l0_w_in"] = nrm((D, L0_IN), D ** -0.5)
    inp["l0_pool_w"] = nrm((POOL_GROUPS, POOL_CH, POOL_CH), POOL_CH ** -0.5)
    inp["l0_pool_scale"] = gain(POOL_DIM)
    inp["l0_q_gain"] = gain(HEAD_DIM)
    inp["l0_k_gain"] = gain(HEAD_DIM)
    inp["l0_w_out"] = nrm((L0_MIX, D), L0_MIX ** -0.5)
    inp["l0_ffn_w_gate"] = nrm((D, FFN_DIM), D ** -0.5)
    inp["l0_ffn_w_up"] = nrm((D, FFN_DIM), D ** -0.5)
    inp["l0_ffn_w_down"] = nrm((FFN_DIM, D), FFN_DIM ** -0.5)
    inp["l1_ada_w"] = nrm((D, 6 * D), 0.5 * D ** -0.5)
    inp["l1_ada_b"] = nrm((6 * D,), 0.02)
    inp["l1_norm_mix"] = gain(D)
    inp["l1_norm_ffn"] = gain(D)
    inp["l1_w_in"] = nrm((D, L1_IN), D ** -0.5)
    inp["l1_mla_q_a_gain"] = gain(MLA_Q_LORA)
    inp["l1_mla_kv_a_gain"] = gain(MLA_KV_LORA)
    inp["l1_mla_w_uq"] = nrm((MLA_Q_LORA, MLA_HEADS * MLA_QK), MLA_Q_LORA ** -0.5)
    inp["l1_mla_w_ukv"] = nrm((MLA_KV_LORA, MLA_HEADS * (MLA_NOPE + MLA_V)), MLA_KV_LORA ** -0.5)
    inp["l1_mla_q_gain"] = gain(MLA_QK)
    inp["l1_mla_k_gain"] = gain(MLA_QK)
    inp["l1_na_q_gain"] = gain(NA_HEAD_DIM)
    inp["l1_na_k_gain"] = gain(NA_HEAD_DIM)
    inp["l1_na_rpb"] = nrm((NA_HEADS, 2 * NA_ROWS - 1, 2 * NA_COLS - 1), 0.1)
    inp["l1_w_out"] = nrm((L1_MIX, D), L1_MIX ** -0.5)
    inp["l1_ffn_w_gate"] = nrm((D, FFN_DIM), D ** -0.5)
    inp["l1_ffn_w_up"] = nrm((D, FFN_DIM), D ** -0.5)
    inp["l1_ffn_w_down"] = nrm((FFN_DIM, D), FFN_DIM ** -0.5)
    return inp


def reference(x, c, ctx, c_ctx,
              l0_ada_w, l0_ada_b, l0_norm_mix, l0_norm_ffn, l0_w_in, l0_pool_w, l0_pool_scale,
              l0_q_gain, l0_k_gain, l0_w_out, l0_ffn_w_gate, l0_ffn_w_up, l0_ffn_w_down,
              l1_ada_w, l1_ada_b, l1_norm_mix, l1_norm_ffn, l1_w_in, l1_mla_q_a_gain, l1_mla_kv_a_gain,
              l1_mla_w_uq, l1_mla_w_ukv, l1_mla_q_gain, l1_mla_k_gain, l1_na_q_gain, l1_na_k_gain,
              l1_na_rpb, l1_w_out, l1_ffn_w_gate, l1_ffn_w_up, l1_ffn_w_down):
    S = x.shape[1]
    tok = jnp.arange(S, dtype=jnp.int32)
    row = tok // GRID_W
    col = tok % GRID_W
    layers = [
        (l0_ada_w, l0_ada_b, l0_norm_mix, l0_norm_ffn, l0_ffn_w_gate, l0_ffn_w_up, l0_ffn_w_down,
         mixer_pool_gqa, (l0_w_in, l0_pool_w, l0_pool_scale, l0_q_gain, l0_k_gain, l0_w_out)),
        (l1_ada_w, l1_ada_b, l1_norm_mix, l1_norm_ffn, l1_ffn_w_gate, l1_ffn_w_up, l1_ffn_w_down,
         mixer_mla_na, (l1_w_in, l1_mla_q_a_gain, l1_mla_kv_a_gain, l1_mla_w_uq, l1_mla_w_ukv,
                        l1_mla_q_gain, l1_mla_k_gain, l1_na_q_gain, l1_na_k_gain, l1_na_rpb, l1_w_out)),
    ]
    xc = ctx
    for i in range(DEPTH):
        ada_w, ada_b, n_mix, n_ffn, wg, wu, wd, mixer, mparams = layers[i]
        need_ctx = i < DEPTH - 1
        sh1, sc1, g1, sh2, sc2, g2 = adaln(c, ada_w, ada_b)
        csh1, csc1, cg1, csh2, csc2, cg2 = adaln(c_ctx[None, :], ada_w, ada_b)
        h = modulate(x, n_mix, sh1, sc1)
        hc = modulate(xc, n_mix, csh1, csc1)
        o, oc = mixer(h, hc, row, col, need_ctx, *mparams)
        x = x + g1 * o
        x = x + g2 * swiglu(modulate(x, n_ffn, sh2, sc2), wg, wu, wd)
        if need_ctx:
            xc = xc + cg1 * oc
            xc = xc + cg2 * swiglu(modulate(xc, n_ffn, csh2, csc2), wg, wu, wd)
    return x
```

```cpp
#include <hip/hip_runtime.h>
#include <hip/hip_cooperative_groups.h>
#include <cstdio>
#include <cstdint>
namespace cg = cooperative_groups;

typedef unsigned short bf16_t;
constexpr int D = 1024, NB = 8, S = 2048, CTX = 256, SK = S + CTX, ML = NB * S, MC = NB * CTX, MT = ML + MC, FF = 2816;
constexpr int GW = 64;
constexpr int L0_IN = 1536, L1_IN = 2208, L1_INP = 2304;
constexpr float EPS = 1e-6f;
constexpr float LOG2E = 1.4426950408889634f;
constexpr float C2_64 = 0.125f * LOG2E;
constexpr float C2_96 = 0.10206207261596577f * LOG2E;

enum { I_X = 0, I_C, I_CTX, I_CCTX,
       I0_ADAW, I0_ADAB, I0_NMIX, I0_NFFN, I0_WIN, I0_POOLW, I0_POOLS, I0_QG, I0_KG, I0_WOUT, I0_WG, I0_WU, I0_WD,
       I1_ADAW, I1_ADAB, I1_NMIX, I1_NFFN, I1_WIN, I1_QAG, I1_KVAG, I1_WUQ, I1_WUKV, I1_MQG, I1_MKG, I1_NQG, I1_NKG, I1_RPB, I1_WOUT, I1_WG, I1_WU, I1_WD, N_IN };

constexpr size_t MiB = 1u << 20;
constexpr size_t WS_CTL = 0;
constexpr size_t WS_MOD = 64 * 1024;
constexpr size_t WS_SSQ = 512 * 1024;
constexpr size_t WS_SSKV = 600 * 1024;
constexpr size_t WS_ROPE32 = 700 * 1024;
constexpr size_t WS_ROPE16 = 712 * 1024;
constexpr size_t WS_W_IN0 = 1 * MiB;
constexpr size_t WS_W_OUT0 = 4 * MiB;
constexpr size_t WS_W_GU0 = 6 * MiB;
constexpr size_t WS_W_D0 = 17 * MiB;
constexpr size_t WS_W_IN1 = 23 * MiB;
constexpr size_t WS_W_UQ = 28 * MiB;
constexpr size_t WS_W_UKV = 29 * MiB;
constexpr size_t WS_W_OUT1 = 30 * MiB;
constexpr size_t WS_W_GU1 = 32 * MiB;
constexpr size_t WS_W_D1 = 43 * MiB;
constexpr size_t WS_XRC = 49 * MiB;
constexpr size_t WS_XN = 57 * MiB;
constexpr size_t WS_MIX = WS_XN;
constexpr size_t WS_BIG = 96 * MiB;
constexpr size_t WS_H = WS_BIG;
constexpr size_t WS_A0 = WS_BIG;
constexpr size_t WS_Q0 = WS_BIG + 9 * MiB;
constexpr size_t WS_K0 = WS_BIG + 36 * MiB;
constexpr size_t WS_V0 = WS_BIG + 45 * MiB;
constexpr size_t WS_CQ = WS_BIG;
constexpr size_t WS_CKV = WS_BIG + 14 * MiB;
constexpr size_t WS_NQ = WS_BIG + 23 * MiB;
constexpr size_t WS_NK = WS_BIG + 41 * MiB;
constexpr size_t WS_NV = WS_BIG + 59 * MiB;
constexpr size_t WS_MQ = WS_BIG + 77 * MiB;
constexpr size_t WS_MK = WS_BIG + 101 * MiB;
constexpr size_t WS_MV = WS_BIG + 128 * MiB;
constexpr size_t WS_KR = WS_BIG + 146 * MiB;
constexpr size_t WS_SNAP = WS_BIG + 100 * MiB;
constexpr size_t WS_END = 256 * MiB;
static_assert(WS_KR + (size_t)MT * 32 * 4 <= WS_END, "ws map");
static_assert(WS_W_D1 + (size_t)D * FF * 2 <= WS_XRC, "ws map");
static_assert(WS_XN + (size_t)MT * D * 2 <= WS_BIG, "ws map");

__device__ __forceinline__ float bf2f(bf16_t u) { return __uint_as_float((unsigned)u << 16); }
__device__ __forceinline__ bf16_t f2bf(float f) { unsigned u = __float_as_uint(f); return (bf16_t)((u + 0x7fffu + ((u >> 16) & 1u)) >> 16); }
__device__ __forceinline__ int kvrow_of(int m) { return m < ML ? (m / S) * SK + CTX + (m % S) : ((m - ML) / CTX) * SK + ((m - ML) % CTX); }
__device__ __forceinline__ int modidx_of(int m) { return m < ML ? m / S : 8; }
__device__ __forceinline__ float wave_sum(float v) {
#pragma unroll
    for (int o = 1; o < 64; o <<= 1) v += __shfl_xor(v, o);
    return v;
}
__device__ __forceinline__ float wave_max(float v) {
#pragma unroll
    for (int o = 1; o < 64; o <<= 1) v = fmaxf(v, __shfl_xor(v, o));
    return v;
}

struct Params {
    const float* in[N_IN];
    float* out;
    unsigned char* ws;
};
namespace nv {
constexpr int R = 4;

template <bool CHECK> __device__ __forceinline__ void put_bf(bf16_t* p, float v, unsigned* errslot, float sc) {
    if (!CHECK) *p = f2bf(v);
    else { const float o = bf2f(*p); const float e = fabsf(o - v) / (fabsf(v) + sc); atomicMax(errslot, __float_as_uint(e)); }
}
template <bool CHECK> __device__ __forceinline__ void put_f(float* p, float v, unsigned* errslot, float sc) {
    if (!CHECK) *p = v;
    else { const float o = *p; const float e = fabsf(o - v) / (fabsf(v) + sc); atomicMax(errslot, __float_as_uint(e)); }
}

__device__ __forceinline__ float silu_f(float x) { return x / (1.f + expf(-x)); }

__global__ void __launch_bounds__(256) k_adaln(Params p) {
    const int n = blockIdx.x * 256 + threadIdx.x, j = blockIdx.y, l = blockIdx.z;
    const float* w = p.in[l ? I1_ADAW : I0_ADAW]; const float* b = p.in[l ? I1_ADAB : I0_ADAB];
    const float* cond = (j < 8) ? p.in[I_C] + j * D : p.in[I_CCTX];
    __shared__ float sc[D];
    for (int k = threadIdx.x; k < D; k += 256) sc[k] = silu_f(cond[k]);
    __syncthreads();
    float acc = 0.f;
    for (int k = 0; k < D; ++k) acc += sc[k] * w[(size_t)k * 6144 + n];
    float* MOD = (float*)(p.ws + WS_MOD);
    MOD[(size_t)(l * 9 + j) * 6144 + n] = acc + b[n];
}

template <bool CHECK> __global__ void __launch_bounds__(256) k_norm(Params p, const float* xl, const float* xc, int gain_idx, int layer, int sh_chunk, int sc_chunk, int nrows, unsigned* errslot) {
    const int m = blockIdx.x * 4 + (threadIdx.x >> 6), lane = threadIdx.x & 63;
    if (m >= nrows) return;
    const float* xr = m < ML ? xl + (size_t)m * D : xc + (size_t)(m - ML) * D;
    const float* g = p.in[gain_idx];
    const float* MOD = (const float*)(p.ws + WS_MOD) + (size_t)(layer * 9 + modidx_of(m)) * 6144;
    float v[16]; float ss = 0.f;
    for (int i = 0; i < 16; ++i) { v[i] = xr[lane + 64 * i]; ss += v[i] * v[i]; }
    ss = wave_sum(ss);
    const float r = rsqrtf(ss * (1.f / D) + EPS);
    bf16_t* o = (bf16_t*)(p.ws + WS_XN) + (size_t)m * D;
    for (int i = 0; i < 16; ++i) { const int c = lane + 64 * i; const float y = (v[i] * r) * g[c] * (1.f + MOD[sc_chunk * D + c]) + MOD[sh_chunk * D + c]; put_bf<CHECK>(o + c, y, errslot, 1.0f); }
}

__device__ __forceinline__ void rowgemm(const float* As, int K, const float* W, int ldw, int n, float (&acc)[R]) {
#pragma unroll
    for (int r = 0; r < R; ++r) acc[r] = 0.f;
    for (int k = 0; k < K; ++k) { const float w = W[(size_t)k * ldw + n];
#pragma unroll
        for (int r = 0; r < R; ++r) acc[r] += As[r * K + k] * w; }
}

__device__ __forceinline__ float inv_freq(int i, int d) { return powf(10000.0f, -((float)i * 2.0f) / (float)d); }

__device__ __forceinline__ float head64(float val, const float* gain, bool rope, int grow, int gcol, float scale, int lane) {
    const float ss = wave_sum(val * val);
    float y = val * rsqrtf(ss * (1.f / 64.f) + EPS) * gain[lane];
    if (rope) {
        const int part = lane >> 5, dd = lane & 31, i = dd & 15; const float pos = (float)(part ? gcol : grow);
        const float ang = pos * inv_freq(i, 32); const float cs = cosf(ang), sn = sinf(ang);
        const float other = __shfl_xor(y, 16);
        y = (dd < 16) ? (y * cs - other * sn) : (other * sn + y * cs);
    } else { (void)__shfl_xor(y, 16); }
    return y * scale;
}

template <bool CHECK> __global__ void __launch_bounds__(256) k_in0(Params p, unsigned* errslot) {
    extern __shared__ float sm[];
    float* a = sm; float* y = sm + R * D;
    const int m0 = blockIdx.x * R, tid = threadIdx.x, lane = tid & 63, wv = tid >> 6;
    const bf16_t* XN = (const bf16_t*)(p.ws + WS_XN);
    for (int i = tid; i < R * D; i += 256) a[i] = bf2f(XN[(size_t)m0 * D + i]);
    __syncthreads();
    for (int n = tid; n < L0_IN; n += 256) { float acc[R]; rowgemm(a, D, p.in[I0_WIN], L0_IN, n, acc);
        for (int r = 0; r < R; ++r) y[r * L0_IN + n] = acc[r]; }
    __syncthreads();
    bf16_t* A0 = (bf16_t*)(p.ws + WS_A0); bf16_t* Q0 = (bf16_t*)(p.ws + WS_Q0); bf16_t* K0 = (bf16_t*)(p.ws + WS_K0); bf16_t* V0 = (bf16_t*)(p.ws + WS_V0);
    for (int r = 0; r < R; ++r) { const int m = m0 + r; const int kvr = kvrow_of(m);
        put_bf<CHECK>(A0 + (size_t)m * 256 + tid, y[r * L0_IN + tid], errslot, 1.0f);
        put_bf<CHECK>(V0 + (size_t)kvr * 256 + tid, y[r * L0_IN + 1280 + tid], errslot, 1.0f); }
    for (int pr = wv; pr < R * 16; pr += 4) {
        const int r = pr / 16, hh = pr % 16, m = m0 + r; const bool lat = m < ML; const int t = lat ? m % S : 0;
        const float val = y[r * L0_IN + 256 + hh * 64 + lane];
        if (hh < 12) { const float o = head64(val, p.in[I0_QG], lat, t / GW, t % GW, C2_64, lane); put_bf<CHECK>(Q0 + (size_t)m * 768 + hh * 64 + lane, o, errslot, 0.2f); }
        else { const float o = head64(val, p.in[I0_KG], lat, t / GW, t % GW, 1.0f, lane); put_bf<CHECK>(K0 + (size_t)kvrow_of(m) * 256 + (hh - 12) * 64 + lane, o, errslot, 1.0f); }
    }
}

template <bool CHECK> __global__ void __launch_bounds__(256) k_pool0(Params p, unsigned* errslot) {
    const int m = blockIdx.x, ch = threadIdx.x, g = ch >> 6, w = 2 << g;
    const bf16_t* A0 = (const bf16_t*)(p.ws + WS_A0);
    int t, T, base; if (m < ML) { t = m % S; T = S; base = m - t; } else { t = (m - ML) % CTX; T = CTX; base = m - t; }
    int lo = t - w / 2; if (lo < 0) lo = 0; int hi = t - w / 2 + w; if (hi > T) hi = T;
    float s = 0.f; for (int j = lo; j < hi; ++j) s += bf2f(A0[(size_t)(base + j) * 256 + ch]);
    const float d = s / (float)(hi - lo) - bf2f(A0[(size_t)m * 256 + ch]);
    put_bf<CHECK>((bf16_t*)(p.ws + WS_MIX) + (size_t)m * D + ch, d, errslot, 0.5f);
}

template <bool CHECK, int MODE> __global__ void __launch_bounds__(256) k_attn(Params p, unsigned* errslot) {
    extern __shared__ float sm[];
    constexpr int DQ = (MODE == 2) ? 96 : 64;
    constexpr int NH = (MODE <= 1) ? 12 : 8;
    const int wv = threadIdx.x >> 6, lane = threadIdx.x & 63;
    float* sc = sm + wv * (SK + 128);
    float* qv = sc + SK;
    const int qi = blockIdx.x * 4 + wv;
    const int h = blockIdx.y;
    int m, b, t;
    if (MODE == 1) { m = ML + qi; b = qi / CTX; t = qi % CTX; } else { m = qi; b = qi / S; t = qi % S; }
    const int grow = t / GW, gcol = t % GW;
    const bf16_t *Qb, *Kb, *Vb; int qp, kp, vp, kh, nkeys, mixcol;
    if (MODE <= 1) { Qb = (const bf16_t*)(p.ws + WS_Q0); Kb = (const bf16_t*)(p.ws + WS_K0); Vb = (const bf16_t*)(p.ws + WS_V0); qp = 768; kp = 256; vp = 256; kh = h / 3; nkeys = (MODE == 0) ? SK : CTX; mixcol = 256 + h * 64; }
    else if (MODE == 2) { Qb = (const bf16_t*)(p.ws + WS_MQ); Kb = (const bf16_t*)(p.ws + WS_MK); Vb = (const bf16_t*)(p.ws + WS_MV); qp = 768; kp = 768; vp = 512; kh = h; nkeys = SK; mixcol = h * 64; }
    else { Qb = (const bf16_t*)(p.ws + WS_NQ); Kb = (const bf16_t*)(p.ws + WS_NK); Vb = (const bf16_t*)(p.ws + WS_NV); qp = 512; kp = 512; vp = 512; kh = h; nkeys = CTX + 128; mixcol = 512 + h * 64; }
    if (MODE == 2) {
        float v0 = bf2f(Qb[(size_t)m * qp + h * 96 + lane]); float v1 = lane < 32 ? bf2f(Qb[(size_t)m * qp + h * 96 + 64 + lane]) : 0.f;
        const float ss = wave_sum(v0 * v0 + v1 * v1); const float r = rsqrtf(ss * (1.f / 96.f) + EPS);
        v0 = v0 * r * p.in[I1_MQG][lane]; if (lane < 32) v1 = v1 * r * p.in[I1_MQG][64 + lane];
        const int part = (lane >> 4) & 1, dd = lane & 15, i = dd & 7; const float pos = (float)(part ? gcol : grow);
        const float ang = pos * inv_freq(i, 16); const float cs = cosf(ang), sn = sinf(ang);
        const float other = __shfl_xor(v1, 8);
        const float v1r = (dd < 8) ? (v1 * cs - other * sn) : (other * sn + v1 * cs);
        qv[lane] = v0 * C2_96; if (lane < 32) qv[64 + lane] = v1r * C2_96;
    } else { qv[lane] = bf2f(Qb[(size_t)m * qp + h * 64 + lane]); }
    __builtin_amdgcn_s_waitcnt(0); __builtin_amdgcn_wave_barrier();
    const int r0 = min(max(grow - 4, 0), 24), cs0 = min(max(gcol - 8, 0), 48);
    float mx = -INFINITY;
    for (int j = lane; j < nkeys; j += 64) {
        int krow; float bias = 0.f;
        if (MODE == 3) {
            if (j < CTX) krow = b * SK + j;
            else { const int jj = j - CTX, kr = r0 + jj / 16, kc = cs0 + jj % 16; krow = b * SK + CTX + kr * GW + kc;
                   bias = p.in[I1_RPB][(h * 15 + (kr - grow + 7)) * 31 + (kc - gcol + 15)] * LOG2E; }
        } else krow = b * SK + j;
        const uint4* kr_ = (const uint4*)(Kb + (size_t)krow * kp + kh * DQ);
        float s = 0.f;
        for (int d8 = 0; d8 < DQ / 8; ++d8) { const uint4 kk = kr_[d8]; const unsigned w4[4] = {kk.x, kk.y, kk.z, kk.w};
#pragma unroll
            for (int e = 0; e < 4; ++e) { s += qv[d8 * 8 + 2 * e] * __uint_as_float(w4[e] << 16); s += qv[d8 * 8 + 2 * e + 1] * __uint_as_float(w4[e] & 0xffff0000u); } }
        s += bias; sc[j] = s; mx = fmaxf(mx, s);
    }
    mx = wave_max(mx);
    float sum = 0.f;
    for (int j = lane; j < nkeys; j += 64) { const float e = exp2f(sc[j] - mx); sc[j] = e; sum += e; }
    sum = wave_sum(sum);
    __builtin_amdgcn_s_waitcnt(0); __builtin_amdgcn_wave_barrier();
    float o = 0.f;
    for (int j = 0; j < nkeys; ++j) {
        int krow;
        if (MODE == 3 && j >= CTX) { const int jj = j - CTX; krow = b * SK + CTX + (r0 + jj / 16) * GW + cs0 + jj % 16; } else krow = b * SK + j;
        o += sc[j] * bf2f(Vb[(size_t)krow * vp + kh * 64 + lane]);
    }
    put_bf<CHECK>((bf16_t*)(p.ws + WS_MIX) + (size_t)m * D + mixcol + lane, o / sum, errslot, 0.1f);
}

template <bool CHECK, int LAYER> __global__ void __launch_bounds__(256) k_out(Params p, const float* base_l, const float* base_c, float* out_l, float* out_c, int row0, unsigned* errslot) {
    extern __shared__ float sm[];
    float* a = sm; float* yp = sm + R * D;
    const int m0 = row0 + blockIdx.x * R, tid = threadIdx.x;
    const bf16_t* MIX = (const bf16_t*)(p.ws + WS_MIX);
    for (int i = tid; i < R * D; i += 256) a[i] = bf2f(MIX[(size_t)m0 * D + i]);
    __syncthreads();
    if (LAYER == 0) {
        const int g = tid >> 6, dd = tid & 63; const float* pw = p.in[I0_POOLW] + g * 4096; const float s = p.in[I0_POOLS][tid];
        for (int r = 0; r < R; ++r) { float acc = 0.f; for (int c = 0; c < 64; ++c) acc += a[r * D + g * 64 + c] * pw[c * 64 + dd]; yp[r * 256 + tid] = acc * s; }
        __syncthreads();
        for (int r = 0; r < R; ++r) a[r * D + tid] = yp[r * 256 + tid];
        __syncthreads();
    }
    const float* W = p.in[LAYER ? I1_WOUT : I0_WOUT];
    const float* MOD = (const float*)(p.ws + WS_MOD) + (size_t)(LAYER * 9 + modidx_of(m0)) * 6144 + 2 * D;
    for (int n = tid; n < D; n += 256) { float acc[R]; rowgemm(a, D, W, D, n, acc);
        for (int r = 0; r < R; ++r) { const int m = m0 + r; const float* bp = m < ML ? base_l + (size_t)m * D : base_c + (size_t)(m - ML) * D; float* op = m < ML ? out_l + (size_t)m * D : out_c + (size_t)(m - ML) * D;
            put_f<CHECK>(op + n, bp[n] + MOD[n] * acc[r], errslot, 1.0f); } }
}

template <bool CHECK, int LAYER> __global__ void __launch_bounds__(256) k_ffn_gu(Params p, unsigned* errslot) {
    extern __shared__ float sm[];
    float* a = sm;
    const int m0 = blockIdx.x * R, tid = threadIdx.x;
    const bf16_t* XN = (const bf16_t*)(p.ws + WS_XN);
    for (int i = tid; i < R * D; i += 256) a[i] = bf2f(XN[(size_t)m0 * D + i]);
    __syncthreads();
    const float* Wg = p.in[LAYER ? I1_WG : I0_WG]; const float* Wu = p.in[LAYER ? I1_WU : I0_WU];
    bf16_t* H = (bf16_t*)(p.ws + WS_H);
    for (int n = tid; n < FF; n += 256) { float g[R], u[R]; rowgemm(a, D, Wg, FF, n, g); rowgemm(a, D, Wu, FF, n, u);
        for (int r = 0; r < R; ++r) put_bf<CHECK>(H + (size_t)(m0 + r) * FF + n, silu_f(g[r]) * u[r], errslot, 0.3f); }
}

template <bool CHECK, int LAYER> __global__ void __launch_bounds__(256) k_ffn_d(Params p, const float* base_l, const float* base_c, float* out_l, float* out_c, int row0, unsigned* errslot) {
    extern __shared__ float sm[];
    float* a = sm;
    const int m0 = row0 + blockIdx.x * R, tid = threadIdx.x;
    const bf16_t* H = (const bf16_t*)(p.ws + WS_H);
    for (int i = tid; i < R * FF; i += 256) a[i] = bf2f(H[(size_t)m0 * FF + i]);
    __syncthreads();
    const float* W = p.in[LAYER ? I1_WD : I0_WD];
    const float* MOD = (const float*)(p.ws + WS_MOD) + (size_t)(LAYER * 9 + modidx_of(m0)) * 6144 + 5 * D;
    for (int n = tid; n < D; n += 256) { float acc[R]; rowgemm(a, FF, W, D, n, acc);
        for (int r = 0; r < R; ++r) { const int m = m0 + r; const float* bp = m < ML ? base_l + (size_t)m * D : base_c + (size_t)(m - ML) * D; float* op = m < ML ? out_l + (size_t)m * D : out_c + (size_t)(m - ML) * D;
            put_f<CHECK>(op + n, bp[n] + MOD[n] * acc[r], errslot, 1.0f); } }
}

template <bool CHECK> __global__ void __launch_bounds__(256) k_in1(Params p, unsigned* errslot) {
    extern __shared__ float sm[];
    float* a = sm; float* y = sm + R * D;
    const int m0 = blockIdx.x * R, tid = threadIdx.x, lane = tid & 63, wv = tid >> 6;
    const bf16_t* XN = (const bf16_t*)(p.ws + WS_XN);
    for (int i = tid; i < R * D; i += 256) a[i] = bf2f(XN[(size_t)m0 * D + i]);
    __syncthreads();
    for (int n = tid; n < L1_IN; n += 256) { float acc[R]; rowgemm(a, D, p.in[I1_WIN], L1_IN, n, acc);
        for (int r = 0; r < R; ++r) y[r * L1_IN + n] = acc[r]; }
    __syncthreads();
    bf16_t* CQ = (bf16_t*)(p.ws + WS_CQ); bf16_t* CKV = (bf16_t*)(p.ws + WS_CKV); float* KR = (float*)(p.ws + WS_KR);
    bf16_t* NQ = (bf16_t*)(p.ws + WS_NQ); bf16_t* NK = (bf16_t*)(p.ws + WS_NK); bf16_t* NV = (bf16_t*)(p.ws + WS_NV);
    float* SSQ = (float*)(p.ws + WS_SSQ); float* SSKV = (float*)(p.ws + WS_SSKV);
    { const int r = wv, m = m0 + r, kvr = kvrow_of(m); const float* yr = y + r * L1_IN;
        float ss = 0.f; for (int j = lane; j < 384; j += 64) { ss += yr[j] * yr[j]; put_bf<CHECK>(CQ + (size_t)m * 384 + j, yr[j], errslot, 1.0f); }
        ss = wave_sum(ss); if (lane == 0) put_f<CHECK>(SSQ + m, ss, errslot, 1.0f);
        ss = 0.f; for (int j = lane; j < 256; j += 64) { ss += yr[384 + j] * yr[384 + j]; put_bf<CHECK>(CKV + (size_t)m * 256 + j, yr[384 + j], errslot, 1.0f); }
        ss = wave_sum(ss); if (lane == 0) put_f<CHECK>(SSKV + m, ss, errslot, 1.0f);
        if (lane < 32) put_f<CHECK>(KR + (size_t)m * 32 + lane, yr[640 + lane], errslot, 1.0f);
        for (int j = lane; j < 512; j += 64) put_bf<CHECK>(NV + (size_t)kvr * 512 + j, yr[1696 + j], errslot, 1.0f); }
    for (int pr = wv; pr < R * 16; pr += 4) {
        const int r = pr / 16, hh = pr % 16, m = m0 + r;
        if (hh < 8) { const float val = y[r * L1_IN + 672 + hh * 64 + lane]; const float o = head64(val, p.in[I1_NQG], false, 0, 0, C2_64, lane); put_bf<CHECK>(NQ + (size_t)m * 512 + hh * 64 + lane, o, errslot, 0.2f); }
        else { const float val = y[r * L1_IN + 1184 + (hh - 8) * 64 + lane]; const float o = head64(val, p.in[I1_NKG], false, 0, 0, 1.0f, lane); put_bf<CHECK>(NK + (size_t)kvrow_of(m) * 512 + (hh - 8) * 64 + lane, o, errslot, 1.0f); }
    }
}

template <bool CHECK> __global__ void __launch_bounds__(256) k_mlaq(Params p, unsigned* errslot) {
    extern __shared__ float sm[];
    float* a = sm;
    const int m0 = blockIdx.x * R, tid = threadIdx.x;
    const bf16_t* CQ = (const bf16_t*)(p.ws + WS_CQ);
    for (int i = tid; i < R * 384; i += 256) a[i] = bf2f(CQ[(size_t)m0 * 384 + i]) * p.in[I1_QAG][i % 384];
    __syncthreads();
    const float* SSQ = (const float*)(p.ws + WS_SSQ); bf16_t* MQ = (bf16_t*)(p.ws + WS_MQ);
    for (int n = tid; n < 768; n += 256) { float acc[R]; rowgemm(a, 384, p.in[I1_WUQ], 768, n, acc);
        for (int r = 0; r < R; ++r) { const int m = m0 + r; put_bf<CHECK>(MQ + (size_t)m * 768 + n, acc[r] * rsqrtf(SSQ[m] * (1.f / 384.f) + EPS), errslot, 1.0f); } }
}

template <bool CHECK> __global__ void __launch_bounds__(256) k_mlakv(Params p, unsigned* errslot) {
    extern __shared__ float sm[];
    float* a = sm; float* y = sm + R * 256;
    const int m0 = blockIdx.x * R, tid = threadIdx.x, lane = tid & 63, wv = tid >> 6;
    const bf16_t* CKV = (const bf16_t*)(p.ws + WS_CKV);
    for (int i = tid; i < R * 256; i += 256) a[i] = bf2f(CKV[(size_t)m0 * 256 + i]) * p.in[I1_KVAG][i % 256];
    __syncthreads();
    const float* SSKV = (const float*)(p.ws + WS_SSKV);
    for (int n = tid; n < 1024; n += 256) { float acc[R]; rowgemm(a, 256, p.in[I1_WUKV], 1024, n, acc);
        for (int r = 0; r < R; ++r) y[r * 1024 + n] = acc[r] * rsqrtf(SSKV[m0 + r] * (1.f / 256.f) + EPS); }
    __syncthreads();
    const float* KR = (const float*)(p.ws + WS_KR); bf16_t* MK = (bf16_t*)(p.ws + WS_MK); bf16_t* MV = (bf16_t*)(p.ws + WS_MV);
    for (int pr = wv; pr < R * 8; pr += 4) {
        const int r = pr / 8, h = pr % 8, m = m0 + r, kvr = kvrow_of(m); const bool lat = m < ML; const int t = lat ? m % S : 0; const int grow = t / GW, gcol = t % GW;
        const float nope = y[r * 1024 + h * 128 + lane]; const float vv = y[r * 1024 + h * 128 + 64 + lane];
        const float kr = lane < 32 ? KR[(size_t)m * 32 + lane] : 0.f;
        const float ss = wave_sum(nope * nope + kr * kr); const float rr = rsqrtf(ss * (1.f / 96.f) + EPS);
        const float k0 = nope * rr * p.in[I1_MKG][lane]; float k1 = lane < 32 ? kr * rr * p.in[I1_MKG][64 + lane] : 0.f;
        const int part = (lane >> 4) & 1, dd = lane & 15, i = dd & 7; const float pos = (float)(part ? gcol : grow);
        const float ang = pos * inv_freq(i, 16); const float cs = cosf(ang), sn = sinf(ang);
        const float other = __shfl_xor(k1, 8);
        if (lat) k1 = (dd < 8) ? (k1 * cs - other * sn) : (other * sn + k1 * cs);
        put_bf<CHECK>(MK + (size_t)kvr * 768 + h * 96 + lane, k0, errslot, 1.0f);
        if (lane < 32) put_bf<CHECK>(MK + (size_t)kvr * 768 + h * 96 + 64 + lane, k1, errslot, 1.0f);
        put_bf<CHECK>(MV + (size_t)kvr * 512 + h * 64 + lane, vv, errslot, 1.0f);
    }
}

__global__ void k_report(Params p, int nslots, float tol) {
    const unsigned* e = (const unsigned*)(p.ws + WS_CTL) + 64;
    for (int k = 0; k < nslots; ++k) { const float v = __uint_as_float(e[k]); if (!(v <= tol)) { p.out[0] = 1000.f * (k + 1); p.out[1] = v; return; } }
}
}
static void launch_naive(const Params& p, hipStream_t st) {
    using namespace nv;
    unsigned* err = (unsigned*)(p.ws + WS_CTL) + 64;
    float* out = p.out; float* xrc = (float*)(p.ws + WS_XRC);
    const float* x = p.in[I_X]; const float* cx = p.in[I_CTX];
    const size_t att_sm = 4 * (SK + 128) * sizeof(float);
    k_adaln<<<dim3(6144 / 256, 9, 2), 256, 0, st>>>(p);
    k_norm<false><<<MT / 4, 256, 0, st>>>(p, x, cx, I0_NMIX, 0, 0, 1, MT, err);
    k_in0<false><<<MT / R, 256, (R * D + R * L0_IN) * 4, st>>>(p, err);
    k_attn<false, 0><<<dim3(ML / 4, 12), 256, att_sm, st>>>(p, err);
    k_attn<false, 1><<<dim3(MC / 4, 12), 256, att_sm, st>>>(p, err);
    k_pool0<false><<<MT, 256, 0, st>>>(p, err);
    k_out<false, 0><<<MT / R, 256, (R * D + R * 256) * 4, st>>>(p, x, cx, out, xrc, 0, err);
    k_norm<false><<<MT / 4, 256, 0, st>>>(p, out, xrc, I0_NFFN, 0, 3, 4, MT, err);
    k_ffn_gu<false, 0><<<MT / R, 256, R * D * 4, st>>>(p, err);
    k_ffn_d<false, 0><<<MT / R, 256, R * FF * 4, st>>>(p, out, xrc, out, xrc, 0, err);
    k_norm<false><<<MT / 4, 256, 0, st>>>(p, out, xrc, I1_NMIX, 1, 0, 1, MT, err);
    k_in1<false><<<MT / R, 256, (R * D + R * L1_IN) * 4, st>>>(p, err);
    k_mlaq<false><<<ML / R, 256, R * 384 * 4, st>>>(p, err);
    k_mlakv<false><<<MT / R, 256, (R * 256 + R * 1024) * 4, st>>>(p, err);
    k_attn<false, 2><<<dim3(ML / 4, 8), 256, att_sm, st>>>(p, err);
    k_attn<false, 3><<<dim3(ML / 4, 8), 256, att_sm, st>>>(p, err);
    k_out<false, 1><<<ML / R, 256, (R * D + R * 256) * 4, st>>>(p, out, xrc, out, xrc, 0, err);
    k_norm<false><<<ML / 4, 256, 0, st>>>(p, out, xrc, I1_NFFN, 1, 3, 4, ML, err);
    k_ffn_gu<false, 1><<<ML / R, 256, R * D * 4, st>>>(p, err);
    k_ffn_d<false, 1><<<ML / R, 256, R * FF * 4, st>>>(p, out, xrc, out, xrc, 0, err);
}
extern "C" void kernel_launch(void* const* d_in, const int* in_sizes, int n_in, void* d_out, int out_size, void* d_ws, size_t ws_size, hipStream_t stream) {
    if (n_in != N_IN || out_size != ML * D || ws_size < WS_END) { fprintf(stderr, "kernel_launch: unexpected shapes n_in=%d out=%d ws=%zu\n", n_in, out_size, ws_size); return; }
    Params p{};
    for (int i = 0; i < N_IN; ++i) p.in[i] = (const float*)d_in[i];
    p.out = (float*)d_out; p.ws = (unsigned char*)d_ws;
    launch_naive(p, stream);
}
```

```cpp
#include <hip/hip_runtime.h>
#include <hip/hip_cooperative_groups.h>
#include <cstdio>
#include <cstdint>
namespace cg = cooperative_groups;

typedef unsigned short bf16_t;
constexpr int D = 1024, NB = 8, S = 2048, CTX = 256, SK = S + CTX, ML = NB * S, MC = NB * CTX, MT = ML + MC, FF = 2816;
constexpr int GW = 64;
constexpr int L0_IN = 1536, L1_IN = 2208, L1_INP = 2304;
constexpr float EPS = 1e-6f;
constexpr float LOG2E = 1.4426950408889634f;
constexpr float C2_64 = 0.125f * LOG2E;
constexpr float C2_96 = 0.10206207261596577f * LOG2E;

enum { I_X = 0, I_C, I_CTX, I_CCTX,
       I0_ADAW, I0_ADAB, I0_NMIX, I0_NFFN, I0_WIN, I0_POOLW, I0_POOLS, I0_QG, I0_KG, I0_WOUT, I0_WG, I0_WU, I0_WD,
       I1_ADAW, I1_ADAB, I1_NMIX, I1_NFFN, I1_WIN, I1_QAG, I1_KVAG, I1_WUQ, I1_WUKV, I1_MQG, I1_MKG, I1_NQG, I1_NKG, I1_RPB, I1_WOUT, I1_WG, I1_WU, I1_WD, N_IN };

constexpr size_t MiB = 1u << 20;
constexpr size_t WS_CTL = 0;
constexpr size_t WS_MOD = 64 * 1024;
constexpr size_t WS_SSQ = 512 * 1024;
constexpr size_t WS_SSKV = 600 * 1024;
constexpr size_t WS_ROPE32 = 700 * 1024;
constexpr size_t WS_ROPE16 = 712 * 1024;
constexpr size_t WS_W_IN0 = 1 * MiB;
constexpr size_t WS_W_OUT0 = 4 * MiB;
constexpr size_t WS_W_GU0 = 6 * MiB;
constexpr size_t WS_W_D0 = 17 * MiB;
constexpr size_t WS_W_IN1 = 23 * MiB;
constexpr size_t WS_W_UQ = 28 * MiB;
constexpr size_t WS_W_UKV = 29 * MiB;
constexpr size_t WS_W_OUT1 = 30 * MiB;
constexpr size_t WS_W_GU1 = 32 * MiB;
constexpr size_t WS_W_D1 = 43 * MiB;
constexpr size_t WS_XRC = 49 * MiB;
constexpr size_t WS_XN = 57 * MiB;
constexpr size_t WS_MIX = WS_XN;
constexpr size_t WS_BIG = 96 * MiB;
constexpr size_t WS_H = WS_BIG;
constexpr size_t WS_A0 = WS_BIG;
constexpr size_t WS_Q0 = WS_BIG + 9 * MiB;
constexpr size_t WS_K0 = WS_BIG + 36 * MiB;
constexpr size_t WS_V0 = WS_BIG + 45 * MiB;
constexpr size_t WS_CQ = WS_BIG;
constexpr size_t WS_CKV = WS_BIG + 14 * MiB;
constexpr size_t WS_NQ = WS_BIG + 23 * MiB;
constexpr size_t WS_NK = WS_BIG + 41 * MiB;
constexpr size_t WS_NV = WS_BIG + 59 * MiB;
constexpr size_t WS_MQ = WS_BIG + 77 * MiB;
constexpr size_t WS_MK = WS_BIG + 101 * MiB;
constexpr size_t WS_MV = WS_BIG + 128 * MiB;
constexpr size_t WS_KR = WS_BIG + 146 * MiB;
constexpr size_t WS_SNAP = WS_BIG + 100 * MiB;
constexpr size_t WS_END = 256 * MiB;
static_assert(WS_KR + (size_t)MT * 32 * 4 <= WS_END, "ws map");
static_assert(WS_W_D1 + (size_t)D * FF * 2 <= WS_XRC, "ws map");
static_assert(WS_XN + (size_t)MT * D * 2 <= WS_BIG, "ws map");

__device__ __forceinline__ float bf2f(bf16_t u) { return __uint_as_float((unsigned)u << 16); }
__device__ __forceinline__ bf16_t f2bf(float f) { unsigned u = __float_as_uint(f); return (bf16_t)((u + 0x7fffu + ((u >> 16) & 1u)) >> 16); }
__device__ __forceinline__ int kvrow_of(int m) { return m < ML ? (m / S) * SK + CTX + (m % S) : ((m - ML) / CTX) * SK + ((m - ML) % CTX); }
__device__ __forceinline__ int modidx_of(int m) { return m < ML ? m / S : 8; }
__device__ __forceinline__ float wave_sum(float v) {
#pragma unroll
    for (int o = 1; o < 64; o <<= 1) v += __shfl_xor(v, o);
    return v;
}
__device__ __forceinline__ float wave_max(float v) {
#pragma unroll
    for (int o = 1; o < 64; o <<= 1) v = fmaxf(v, __shfl_xor(v, o));
    return v;
}

struct Params {
    const float* in[N_IN];
    float* out;
    unsigned char* ws;
};
namespace pg8 {
#define PG8_LAS __attribute__((address_space(3)))
typedef unsigned short bf16_t;
typedef short bf16x8 __attribute__((ext_vector_type(8)));
typedef float f32x4 __attribute__((ext_vector_type(4)));
typedef unsigned u32x4 __attribute__((ext_vector_type(4)));
constexpr int BM = 256, BK = 64, HALF = 128, HTB = HALF * BK * 2  , STAGE_BYTES = 8 * HTB, NXCD = 8, WGM = 8;

__host__ __device__ __forceinline__ int lds_byte(int r, int c) { const int st = (r >> 4) * 2 + (c >> 5), rr = r & 15, cc = c & 31, ob = rr * 64 + cc * 2; return st * 1024 + (ob ^ (((ob >> 9) & 1) << 5)); }
__host__ __device__ __forceinline__ void stage_rc(int b, int& R, int& C) { const int st = b / 1024, sb = b % 1024, swz = sb ^ (((sb >> 9) & 1) << 5); R = (st >> 1) * 16 + swz / 64; C = (st & 1) * 32 + (swz % 64) / 2; }
__host__ __device__ __forceinline__ int perm32(int rho) { const int n = rho >> 4, i = rho & 15; return 8 * (i >> 2) + 4 * n + (i & 3); }

struct Unit { int pm, pn; };
struct Gemm { const bf16_t* A; const bf16_t* Bt; int M, N, K; };

struct StaticOrder {
    int nM, nN, nwg, G, c;
    __host__ __device__ void init(int M, int N, int G_, int c_) { nM = M / BM; nN = N / BM; nwg = nM * nN; G = G_; c = c_; }
    __host__ __device__ bool next(int i, Unit& u) const {
        const long L = (long)i * G + c; if (L >= nwg) return false;
        int wgid = (int)L; { const int q = nwg / NXCD, r = nwg % NXCD, xcd = wgid % NXCD, off = wgid / NXCD; wgid = (xcd < r ? xcd * (q + 1) : r * (q + 1) + (xcd - r) * q) + off; }
        const int nig = WGM * nN, gid = wgid / nig, fm = gid * WGM, gsz = (nM - fm) < WGM ? (nM - fm) : WGM;
        u.pm = fm + ((wgid % nig) % gsz); u.pn = (wgid % nig) / gsz; return true;
    }
    __device__ __forceinline__ void a_ready(const Unit&) const {}
    __device__ __forceinline__ void done(const Unit&) const {}
};

__device__ __forceinline__ unsigned cvt_pk_bf16(float lo, float hi) { unsigned r; asm volatile("v_cvt_pk_bf16_f32 %0, %1, %2" : "=v"(r) : "v"(lo), "v"(hi)); return r; }
typedef float f32x2 __attribute__((ext_vector_type(2)));
template <class Epi, class Sched, bool ALIGN_EPI = false, bool SP2 = false>
__device__ __forceinline__ void gemm_phase(PG8_LAS unsigned char* lds, const Gemm g, const Sched& S, const Epi& E) {
    int tid_ = threadIdx.x; asm volatile("" : "+v"(tid_));
    const int tid = tid_, wid = __builtin_amdgcn_readfirstlane(tid >> 6), lane = tid & 63, wr = wid >> 2, wc = wid & 3, fr = lane & 15, fq = lane >> 4;
    int K_ = g.K; asm volatile("" : "+s"(K_));
    const int K = K_, nt = K / BK;
    unsigned voffA[2], voffB[2];
#pragma unroll
    for (int i = 0; i < 2; ++i) { int R, C; stage_rc(tid * 16 + i * 8192, R, C); const int Rb = Epi::PERM ? ((R & ~31) + perm32(R & 31)) : R;
        voffA[i] = (unsigned)(R * K + C) * 2u; voffB[i] = (unsigned)(Rb * K + C) * 2u; }
    const size_t kstep = (size_t)(BK * 2);
    const size_t hstep = (size_t)HALF * K * 2;
    const size_t tstep = 2 * hstep;
    const unsigned ldsw = (unsigned)wid * 1024u;
    const int aoff = lds_byte(wr * 64 + fr, fq * 8), boff = lds_byte(wc * 32 + fr, fq * 8);
#define PG8_SA(b, h) (((b) * 2 + (h)) * HTB)
#define PG8_SB(b, h) ((4 + (b) * 2 + (h)) * HTB)
#define PG8_STAGE(bufoff, gbase, voff) do { _Pragma("unroll") for (int _i = 0; _i < 2; ++_i) \
        __builtin_amdgcn_global_load_lds((const unsigned*)((const char*)(gbase) + (voff)[_i]), (PG8_LAS unsigned*)(lds + (bufoff) + ldsw + _i * 8192), 16, 0, 0); } while (0)
#define PG8_LDA(dst, b, h) do { _Pragma("unroll") for (int m = 0; m < 4; ++m) _Pragma("unroll") for (int k = 0; k < 2; ++k) dst[m][k] = *(const PG8_LAS bf16x8*)(lds + PG8_SA(b, h) + aoff + m * 2048 + k * 1024); } while (0)
#define PG8_LDB(dst, b, h) do { _Pragma("unroll") for (int n = 0; n < 2; ++n) _Pragma("unroll") for (int k = 0; k < 2; ++k) dst[n][k] = *(const PG8_LAS bf16x8*)(lds + PG8_SB(b, h) + boff + n * 2048 + k * 1024); } while (0)
#define PG8_MMA(ai, bj, At, Bt) do { __builtin_amdgcn_s_setprio(1); _Pragma("unroll") for (int m = 0; m < 4; ++m) _Pragma("unroll") for (int n = 0; n < 2; ++n) _Pragma("unroll") for (int k = 0; k < 2; ++k) \
        acc[ai][bj][m][n] = __builtin_amdgcn_mfma_f32_16x16x32_bf16(Bt[n][k], At[m][k], acc[ai][bj][m][n], 0, 0, 0); __builtin_amdgcn_s_setprio(0); } while (0)
#define PG8_WAIT_V(n) asm volatile("s_waitcnt vmcnt(" #n ")" ::: "memory")
#define PG8_WAIT_L(n) asm volatile("s_waitcnt lgkmcnt(" #n ")" ::: "memory")
#define PG8_BAR __builtin_amdgcn_s_barrier()
#define PG8_SCHED __builtin_amdgcn_sched_barrier(0)
    Unit cur, nxt; int ui = 0;
    if (!S.next(0, cur)) return;
    f32x4 acc[2][2][4][2];
#pragma unroll
    for (int a = 0; a < 2; ++a)
#pragma unroll
        for (int b = 0; b < 2; ++b)
#pragma unroll
            for (int m = 0; m < 4; ++m)
#pragma unroll
                for (int n = 0; n < 2; ++n) acc[a][b][m][n] = (f32x4){0.f, 0.f, 0.f, 0.f};
    bf16x8 At[4][2], B0[2][2], B1[2][2];
    const char* cA = (const char*)g.A + (size_t)cur.pm * tstep; const char* cB = (const char*)g.Bt + (size_t)cur.pn * tstep;
    S.a_ready(cur);
    if constexpr (SP2) {
        PG8_STAGE(PG8_SB(0, 0), cB, voffB); PG8_STAGE(PG8_SB(0, 1), cB + hstep, voffB); PG8_STAGE(PG8_SA(0, 0), cA, voffA); PG8_STAGE(PG8_SA(0, 1), cA + hstep, voffA);
        if (wr == 1) PG8_BAR;
        PG8_WAIT_V(2); PG8_BAR;
        PG8_STAGE(PG8_SB(1, 0), cB + kstep, voffB); PG8_STAGE(PG8_SA(1, 0), cA + kstep, voffA); PG8_STAGE(PG8_SB(1, 1), cB + hstep + kstep, voffB);
        PG8_WAIT_V(6); PG8_BAR;
    } else {
        PG8_STAGE(PG8_SB(0, 0), cB, voffB); PG8_STAGE(PG8_SA(0, 0), cA, voffA); PG8_STAGE(PG8_SB(0, 1), cB + hstep, voffB); PG8_STAGE(PG8_SA(0, 1), cA + hstep, voffA);
        if (wr == 1) PG8_BAR;
        PG8_WAIT_V(4); PG8_BAR;
        PG8_STAGE(PG8_SB(1, 0), cB + kstep, voffB); PG8_STAGE(PG8_SA(1, 0), cA + kstep, voffA); PG8_STAGE(PG8_SB(1, 1), cB + hstep + kstep, voffB);
        PG8_WAIT_V(6); PG8_BAR;
    }
    for (;;) {
        const bool has_next = S.next(ui + 1, nxt);
        const char* nA = has_next ? (const char*)g.A + (size_t)nxt.pm * tstep : cA; const char* nB = has_next ? (const char*)g.Bt + (size_t)nxt.pn * tstep : cB;
        for (int t = 0; t < nt; t += 2) {
            const bool last = (t == nt - 2);
            const char* a1 = cA + (size_t)(t + 1) * kstep;
            const char* a2 = last ? nA : cA + (size_t)(t + 2) * kstep; const char* b2 = last ? nB : cB + (size_t)(t + 2) * kstep;
            const char* a3 = a2 + kstep; const char* b3 = b2 + kstep;
            if (last && has_next) S.a_ready(nxt);
            if constexpr (SP2) {
            PG8_LDB(B0, 0, 0); PG8_LDB(B1, 0, 1); PG8_SCHED; PG8_LDA(At, 0, 0); PG8_STAGE(PG8_SA(1, 1), a1 + hstep, voffA);
            PG8_WAIT_V(8); PG8_WAIT_L(0); PG8_BAR; PG8_MMA(0, 0, At, B0); PG8_MMA(0, 1, At, B1); PG8_BAR; PG8_SCHED;
            PG8_LDA(At, 0, 1); PG8_STAGE(PG8_SB(0, 0), b2, voffB); PG8_STAGE(PG8_SB(0, 1), b2 + hstep, voffB); PG8_STAGE(PG8_SA(0, 0), a2, voffA);
            PG8_WAIT_V(8); PG8_WAIT_L(0); PG8_BAR; PG8_MMA(1, 0, At, B0); PG8_MMA(1, 1, At, B1); PG8_BAR; PG8_SCHED;
            PG8_LDB(B0, 1, 0); PG8_LDB(B1, 1, 1); PG8_SCHED; PG8_LDA(At, 1, 0); PG8_STAGE(PG8_SA(0, 1), a2 + hstep, voffA);
            PG8_WAIT_V(8); PG8_WAIT_L(0); PG8_BAR; PG8_MMA(0, 0, At, B0); PG8_MMA(0, 1, At, B1); PG8_BAR; PG8_SCHED;
            PG8_LDA(At, 1, 1); PG8_STAGE(PG8_SB(1, 0), b3, voffB); PG8_STAGE(PG8_SB(1, 1), b3 + hstep, voffB); PG8_STAGE(PG8_SA(1, 0), a3, voffA);
            PG8_WAIT_V(8); PG8_WAIT_L(0); PG8_BAR; PG8_MMA(1, 0, At, B0); PG8_MMA(1, 1, At, B1); PG8_BAR; PG8_SCHED;
            } else {
            PG8_LDB(B0, 0, 0); PG8_SCHED; PG8_LDA(At, 0, 0); PG8_STAGE(PG8_SA(1, 1), a1 + hstep, voffA);
            PG8_WAIT_L(8); PG8_BAR; PG8_WAIT_L(0); PG8_MMA(0, 0, At, B0); PG8_BAR; PG8_SCHED;
            PG8_LDB(B1, 0, 1); PG8_STAGE(PG8_SB(0, 0), b2, voffB);
            PG8_BAR; PG8_WAIT_L(0); PG8_MMA(0, 1, At, B1); PG8_BAR;
            PG8_LDA(At, 0, 1); PG8_STAGE(PG8_SA(0, 0), a2, voffA);
            PG8_BAR; PG8_WAIT_L(0); PG8_MMA(1, 0, At, B0); PG8_BAR; PG8_SCHED;
            PG8_STAGE(PG8_SB(0, 1), b2 + hstep, voffB);
            PG8_WAIT_V(6); PG8_BAR; PG8_MMA(1, 1, At, B1); PG8_BAR;
            PG8_LDB(B0, 1, 0); PG8_SCHED; PG8_LDA(At, 1, 0); PG8_STAGE(PG8_SA(0, 1), a2 + hstep, voffA);
            PG8_WAIT_L(8); PG8_BAR; PG8_WAIT_L(0); PG8_MMA(0, 0, At, B0); PG8_BAR; PG8_SCHED;
            PG8_LDB(B1, 1, 1); PG8_STAGE(PG8_SB(1, 0), b3, voffB);
            PG8_BAR; PG8_WAIT_L(0); PG8_MMA(0, 1, At, B1); PG8_BAR;
            PG8_LDA(At, 1, 1); PG8_STAGE(PG8_SA(1, 0), a3, voffA);
            PG8_BAR; PG8_WAIT_L(0); PG8_MMA(1, 0, At, B0); PG8_BAR; PG8_SCHED;
            PG8_STAGE(PG8_SB(1, 1), b3 + hstep, voffB);
            PG8_WAIT_V(6); PG8_BAR; PG8_MMA(1, 1, At, B1); PG8_BAR;
            }
        }
        if constexpr (ALIGN_EPI) { if (wr == 0) PG8_BAR; }
        if constexpr (!Epi::AFTER_DRAIN) { E(acc, cur, wr, wc, fr, fq); S.done(cur); }
        if (!has_next) break;
#pragma unroll
        for (int a = 0; a < 2; ++a)
#pragma unroll
            for (int b = 0; b < 2; ++b)
#pragma unroll
                for (int m = 0; m < 4; ++m)
#pragma unroll
                    for (int n = 0; n < 2; ++n) acc[a][b][m][n] = (f32x4){0.f, 0.f, 0.f, 0.f};
        cur = nxt; cA = nA; cB = nB; ++ui;
        if constexpr (ALIGN_EPI) { if (wr == 1) PG8_BAR; }
    }
    PG8_WAIT_V(0);
    if constexpr (!ALIGN_EPI) { if (wr == 0) PG8_BAR; }
    PG8_BAR;
    if constexpr (Epi::AFTER_DRAIN) { E.fused(acc, cur, wr, wc, fr, fq, lds, wid, lane); S.done(cur); }
#undef PG8_SA
#undef PG8_SB
#undef PG8_STAGE
#undef PG8_LDA
#undef PG8_LDB
#undef PG8_MMA
#undef PG8_WAIT_V
#undef PG8_WAIT_L
#undef PG8_BAR
#undef PG8_SCHED
}
}
namespace epi {
using pg8::f32x4; using pg8::Unit;
typedef unsigned u32x2 __attribute__((ext_vector_type(2)));
typedef unsigned u32x4 __attribute__((ext_vector_type(4)));
typedef float f32x2 __attribute__((ext_vector_type(2)));
typedef __bf16 bf16x2_t __attribute__((ext_vector_type(2)));
__device__ __forceinline__ unsigned pk(float lo, float hi) { f32x2 v = {lo, hi}; bf16x2_t b = __builtin_convertvector(v, bf16x2_t); return __builtin_bit_cast(unsigned, b); }
__device__ __forceinline__ u32x2 pk4(f32x4 v) { u32x2 w; w.x = pk(v[0], v[1]); w.y = pk(v[2], v[3]); return w; }
__device__ __forceinline__ float sum4sq(f32x4 v) { return (v[0] * v[0] + v[1] * v[1]) + (v[2] * v[2] + v[3] * v[3]); }
__device__ __forceinline__ float quad_sum(float s) { s += __shfl_xor(s, 16); s += __shfl_xor(s, 32); return s; }

__device__ __forceinline__ int kvbase_of(int pm) { return pm < 64 ? (pm >> 3) * SK + CTX + (pm & 7) * 256 : (pm - 64) * SK; }
__device__ __forceinline__ int modidx_pm(int pm) { return pm < 64 ? (pm >> 3) : 8; }

__device__ __forceinline__ void head_finish(f32x4 (&v)[2][2], const float* gain, bool rope, const float* T32, int grow, int gcol, float scale, int fq) {
    float ss = (sum4sq(v[0][0]) + sum4sq(v[0][1])) + (sum4sq(v[1][0]) + sum4sq(v[1][1]));
    ss = quad_sum(ss);
    const float rn = rsqrtf(ss * (1.f / 64.f) + EPS);
#pragma unroll
    for (int bj = 0; bj < 2; ++bj)
#pragma unroll
        for (int n = 0; n < 2; ++n) { const f32x4 g = *(const f32x4*)(gain + 32 * bj + 16 * n + 4 * fq); v[bj][n] = (v[bj][n] * rn) * g; }
    if (rope) {
#pragma unroll
        for (int bj = 0; bj < 2; ++bj) { const int pos = bj ? gcol : grow;
            const f32x4 cs = *(const f32x4*)(T32 + pos * 16 + 4 * fq), sn = *(const f32x4*)(T32 + 1024 + pos * 16 + 4 * fq);
            const f32x4 x1 = v[bj][0], x2 = v[bj][1];
            v[bj][0] = x1 * cs - x2 * sn; v[bj][1] = x1 * sn + x2 * cs; }
    }
#pragma unroll
    for (int bj = 0; bj < 2; ++bj)
#pragma unroll
        for (int n = 0; n < 2; ++n) v[bj][n] = v[bj][n] * scale;
}

struct EpiIn0 {
    static constexpr bool PERM = false, AFTER_DRAIN = false;
    bf16_t *A0, *Q0, *K0, *V0; const float *qg, *kg, *T32;
    __device__ __forceinline__ void operator()(const f32x4 (&acc)[2][2][4][2], const Unit& u, int wr, int wc, int fr_in, int fq_in) const {
        int fr = fr_in, fq = fq_in; asm volatile("" : "+v"(fr), "+v"(fq));
        const int pn = u.pn, pm = u.pm; const bool lat = pm < 64; const int kvb = kvbase_of(pm);
#pragma unroll
        for (int ai = 0; ai < 2; ++ai)
#pragma unroll
            for (int m = 0; m < 4; ++m) {
                const int rl = 128 * ai + 64 * wr + 16 * m + fr; const size_t r = (size_t)pm * 256 + rl;
                if (pn == 0 || pn == 5) {
                    bf16_t* dst = pn == 0 ? A0 + r * 256 : V0 + (size_t)(kvb + rl) * 256;
#pragma unroll
                    for (int bj = 0; bj < 2; ++bj)
#pragma unroll
                        for (int n = 0; n < 2; ++n) *(u32x2*)(dst + 64 * wc + 32 * bj + 16 * n + 4 * fq) = pk4(acc[ai][bj][m][n]);
                } else {
                    f32x4 v[2][2] = {{acc[ai][0][m][0], acc[ai][0][m][1]}, {acc[ai][1][m][0], acc[ai][1][m][1]}};
                    const int grow = (pm & 7) * 4 + 2 * ai + wr, gcol = 16 * m + fr;
                    bf16_t* dst;
                    if (pn < 4) { head_finish(v, qg, lat, T32, grow, gcol, C2_64, fq); dst = Q0 + r * 768 + ((pn - 1) * 4 + wc) * 64; }
                    else { head_finish(v, kg, lat, T32, grow, gcol, 1.0f, fq); dst = K0 + (size_t)(kvb + rl) * 256 + wc * 64; }
#pragma unroll
                    for (int bj = 0; bj < 2; ++bj)
#pragma unroll
                        for (int n = 0; n < 2; ++n) *(u32x2*)(dst + 32 * bj + 16 * n + 4 * fq) = pk4(v[bj][n]);
                }
            }
    }
};

struct EpiResid {
    static constexpr bool PERM = false, AFTER_DRAIN = false;
    const float *base_l, *base_c; float *out_l, *out_c; const float* mod;
    __device__ __forceinline__ void operator()(const f32x4 (&acc)[2][2][4][2], const Unit& u, int wr, int wc, int fr_in, int fq_in) const {
        int fr = fr_in, fq = fq_in; asm volatile("" : "+v"(fr), "+v"(fq));
        const int pm = u.pm; const bool lat = pm < 64;
        const float* bp = lat ? base_l + (size_t)pm * 256 * D : base_c + (size_t)(pm - 64) * 256 * D;
        float* op = lat ? out_l + (size_t)pm * 256 * D : out_c + (size_t)(pm - 64) * 256 * D;
        const float* gp = mod + (size_t)modidx_pm(pm) * 6144 + u.pn * 256 + 32 * wc + 4 * fq;
        f32x4 g[2][2];
#pragma unroll
        for (int bj = 0; bj < 2; ++bj)
#pragma unroll
            for (int n = 0; n < 2; ++n) g[bj][n] = *(const f32x4*)(gp + 128 * bj + 16 * n);
#pragma unroll
        for (int ai = 0; ai < 2; ++ai)
#pragma unroll
            for (int m = 0; m < 4; ++m) { const size_t off = (size_t)(128 * ai + 64 * wr + 16 * m + fr) * D + u.pn * 256 + 32 * wc + 4 * fq;
#pragma unroll
                for (int bj = 0; bj < 2; ++bj)
#pragma unroll
                    for (int n = 0; n < 2; ++n) { const f32x4 b = *(const f32x4*)(bp + off + 128 * bj + 16 * n); *(f32x4*)(op + off + 128 * bj + 16 * n) = b + g[bj][n] * acc[ai][bj][m][n]; } }
    }
};

struct EpiSwiGLU {
    static constexpr bool PERM = true, AFTER_DRAIN = false;
    bf16_t* H;
    __device__ __forceinline__ void operator()(const f32x4 (&acc)[2][2][4][2], const Unit& u, int wr, int wc, int fr_in, int fq_in) const {
        int fr = fr_in, fq = fq_in; asm volatile("" : "+v"(fr), "+v"(fq));
#pragma unroll
        for (int ai = 0; ai < 2; ++ai)
#pragma unroll
            for (int m = 0; m < 4; ++m) { const size_t r = (size_t)u.pm * 256 + 128 * ai + 64 * wr + 16 * m + fr;
                f32x4 h[2];
#pragma unroll
                for (int n = 0; n < 2; ++n) { const f32x4 g = acc[ai][0][m][n], up = acc[ai][1][m][n];
#pragma unroll
                    for (int e = 0; e < 4; ++e) h[n][e] = g[e] * __builtin_amdgcn_rcpf(1.f + __builtin_amdgcn_exp2f(-g[e] * LOG2E)) * up[e]; }
                u32x4 w; w.x = pk(h[0][0], h[0][1]); w.y = pk(h[0][2], h[0][3]); w.z = pk(h[1][0], h[1][1]); w.w = pk(h[1][2], h[1][3]);
                *(u32x4*)(H + r * FF + u.pn * 128 + 32 * wc + 8 * fq) = w; }
    }
};

struct EpiIn1 {
    static constexpr bool PERM = false, AFTER_DRAIN = false;
    bf16_t *CQ, *CKV, *NQ, *NK, *NV; float *KR, *SSQ, *SSKV; const float *nqg, *nkg;
    __device__ __forceinline__ void operator()(const f32x4 (&acc)[2][2][4][2], const Unit& u, int wr, int wc, int fr_in, int fq_in) const {
        int fr = fr_in, fq = fq_in; asm volatile("" : "+v"(fr), "+v"(fq));
        const int pn = u.pn, pm = u.pm; const int kvb = kvbase_of(pm);
#pragma unroll
        for (int ai = 0; ai < 2; ++ai)
#pragma unroll
            for (int m = 0; m < 4; ++m) {
                const int rl = 128 * ai + 64 * wr + 16 * m + fr; const size_t r = (size_t)pm * 256 + rl;
                if (pn == 0 || pn == 2) {
                    bf16_t* dst = pn == 0 ? CQ + r * 384 : CKV + r * 256; float ss = 0.f;
#pragma unroll
                    for (int bj = 0; bj < 2; ++bj)
#pragma unroll
                        for (int n = 0; n < 2; ++n) { ss += sum4sq(acc[ai][bj][m][n]); *(u32x2*)(dst + 128 * bj + 32 * wc + 16 * n + 4 * fq) = pk4(acc[ai][bj][m][n]); }
                    ss = quad_sum(ss);
                    if (fq == 0) atomicAdd((pn == 0 ? SSQ : SSKV) + r, ss);
                } else if (pn == 1) {
                    float ss = 0.f;
#pragma unroll
                    for (int n = 0; n < 2; ++n) { ss += sum4sq(acc[ai][0][m][n]); *(u32x2*)(CQ + r * 384 + 256 + 32 * wc + 16 * n + 4 * fq) = pk4(acc[ai][0][m][n]); }
                    ss = quad_sum(ss);
                    if (fq == 0) atomicAdd(SSQ + r, ss);
                    if (wc == 0) {
#pragma unroll
                        for (int n = 0; n < 2; ++n) *(f32x4*)(KR + r * 32 + 16 * n + 4 * fq) = acc[ai][1][m][n]; }
                } else if (pn >= 7) {
                    bf16_t* dst = NV + (size_t)(kvb + rl) * 512 + (pn - 7) * 256 + 64 * wc;
#pragma unroll
                    for (int bj = 0; bj < 2; ++bj)
#pragma unroll
                        for (int n = 0; n < 2; ++n) *(u32x2*)(dst + 32 * bj + 16 * n + 4 * fq) = pk4(acc[ai][bj][m][n]);
                } else {
                    f32x4 v[2][2] = {{acc[ai][0][m][0], acc[ai][0][m][1]}, {acc[ai][1][m][0], acc[ai][1][m][1]}};
                    bf16_t* dst;
                    if (pn < 5) { head_finish(v, nqg, false, nullptr, 0, 0, C2_64, fq); dst = NQ + r * 512 + ((pn - 3) * 4 + wc) * 64; }
                    else { head_finish(v, nkg, false, nullptr, 0, 0, 1.0f, fq); dst = NK + (size_t)(kvb + rl) * 512 + ((pn - 5) * 4 + wc) * 64; }
#pragma unroll
                    for (int bj = 0; bj < 2; ++bj)
#pragma unroll
                        for (int n = 0; n < 2; ++n) *(u32x2*)(dst + 32 * bj + 16 * n + 4 * fq) = pk4(v[bj][n]);
                }
            }
    }
};

struct EpiQUp {
    static constexpr bool PERM = true, AFTER_DRAIN = false;
    bf16_t* MQ; const float* SSQ;
    __device__ __forceinline__ void operator()(const f32x4 (&acc)[2][2][4][2], const Unit& u, int wr, int wc, int fr_in, int fq_in) const {
        int fr = fr_in, fq = fq_in; asm volatile("" : "+v"(fr), "+v"(fq));
#pragma unroll
        for (int ai = 0; ai < 2; ++ai)
#pragma unroll
            for (int m = 0; m < 4; ++m) { const size_t r = (size_t)u.pm * 256 + 128 * ai + 64 * wr + 16 * m + fr;
                const float rs = rsqrtf(SSQ[r] * (1.f / 384.f) + EPS);
#pragma unroll
                for (int bj = 0; bj < 2; ++bj) { const f32x4 a = acc[ai][bj][m][0] * rs, b = acc[ai][bj][m][1] * rs;
                    u32x4 w; w.x = pk(a[0], a[1]); w.y = pk(a[2], a[3]); w.z = pk(b[0], b[1]); w.w = pk(b[2], b[3]);
                    *(u32x4*)(MQ + r * 768 + u.pn * 256 + 128 * bj + 32 * wc + 8 * fq) = w; } }
    }
};

struct EpiKvUp {
    static constexpr bool PERM = false, AFTER_DRAIN = false;
    bf16_t *MK, *MV; const float *SSKV, *KR, *kg, *T16;
    __device__ __forceinline__ void operator()(const f32x4 (&acc)[2][2][4][2], const Unit& u, int wr, int wc, int fr_in, int fq_in) const {
        int fr = fr_in, fq = fq_in; asm volatile("" : "+v"(fr), "+v"(fq));
        const int pm = u.pm; const bool lat = pm < 64; const int kvb = kvbase_of(pm); const int head = 2 * u.pn + (wc >> 1); const bool isv = wc & 1;
#pragma unroll
        for (int ai = 0; ai < 2; ++ai)
#pragma unroll
            for (int m = 0; m < 4; ++m) {
                const int rl = 128 * ai + 64 * wr + 16 * m + fr; const size_t r = (size_t)pm * 256 + rl; const size_t kvr = (size_t)(kvb + rl);
                const float rs = rsqrtf(SSKV[r] * (1.f / 256.f) + EPS);
                f32x4 v[2][2];
#pragma unroll
                for (int bj = 0; bj < 2; ++bj)
#pragma unroll
                    for (int n = 0; n < 2; ++n) v[bj][n] = acc[ai][bj][m][n] * rs;
                if (isv) {
#pragma unroll
                    for (int bj = 0; bj < 2; ++bj)
#pragma unroll
                        for (int n = 0; n < 2; ++n) *(u32x2*)(MV + kvr * 512 + head * 64 + 32 * bj + 16 * n + 4 * fq) = pk4(v[bj][n]);
                } else {
                    f32x2 k[4];
#pragma unroll
                    for (int j = 0; j < 4; ++j) k[j] = *(const f32x2*)(KR + r * 32 + 8 * j + 2 * fq);
                    float ss = (sum4sq(v[0][0]) + sum4sq(v[0][1])) + (sum4sq(v[1][0]) + sum4sq(v[1][1]));
#pragma unroll
                    for (int j = 0; j < 4; ++j) ss += k[j][0] * k[j][0] + k[j][1] * k[j][1];
                    ss = quad_sum(ss);
                    const float rr = rsqrtf(ss * (1.f / 96.f) + EPS);
#pragma unroll
                    for (int bj = 0; bj < 2; ++bj)
#pragma unroll
                        for (int n = 0; n < 2; ++n) { const f32x4 g = *(const f32x4*)(kg + 32 * bj + 16 * n + 4 * fq);
                            *(u32x2*)(MK + kvr * 768 + head * 96 + 32 * bj + 16 * n + 4 * fq) = pk4((v[bj][n] * rr) * g); }
#pragma unroll
                    for (int j = 0; j < 4; ++j) { const f32x2 g = *(const f32x2*)(kg + 64 + 8 * j + 2 * fq); k[j] = (k[j] * rr) * g; }
                    if (lat) {
                        const int grow = (pm & 7) * 4 + 2 * ai + wr, gcol = 16 * m + fr;
#pragma unroll
                        for (int part = 0; part < 2; ++part) { const int pos = part ? gcol : grow;
                            const f32x2 cs = *(const f32x2*)(T16 + pos * 8 + 2 * fq), sn = *(const f32x2*)(T16 + 512 + pos * 8 + 2 * fq);
                            const f32x2 x1 = k[2 * part], x2 = k[2 * part + 1];
                            k[2 * part] = x1 * cs - x2 * sn; k[2 * part + 1] = x1 * sn + x2 * cs; }
                    }
#pragma unroll
                    for (int j = 0; j < 4; ++j) *(unsigned*)(MK + kvr * 768 + head * 96 + 64 + 8 * j + 2 * fq) = pk(k[j][0], k[j][1]);
                }
                asm volatile("" ::: "memory");
            }
    }
};
}
namespace att {
using bf16x8 = __attribute__((ext_vector_type(8))) short;
using s16x4 = __attribute__((ext_vector_type(4))) short;
using f32x16 = __attribute__((ext_vector_type(16))) float;
using u32x4 = __attribute__((ext_vector_type(4))) unsigned;
typedef float f32x2_t __attribute__((ext_vector_type(2))); typedef __bf16 bf16x2_t __attribute__((ext_vector_type(2)));
#define ALAS __attribute__((address_space(3)))
constexpr int KSLOT = 12288, VSLOT = 8192, SLOT = KSLOT + VSLOT, NSLOT = 3;
constexpr int LDS_WS = NSLOT * SLOT;
constexpr int LDS_OST = LDS_WS + 8 * 256;
constexpr int LDS_RPB = LDS_OST + 8 * 4096;
constexpr int LDS_BYTES = LDS_RPB + 2048;
constexpr float THR = 8.0f;

__device__ __forceinline__ int crow(int r, int hi) { return (r & 3) + 8 * (r >> 2) + 4 * hi; }
__device__ __forceinline__ void glds16(const void* gsrc, unsigned lds_dst) { unsigned keep;
    asm volatile("s_mov_b32 %0, m0\n\ts_mov_b32 m0, %2\n\ts_nop 0\n\tglobal_load_lds_dwordx4 %1, off\n\ts_mov_b32 m0, %0" : "=&s"(keep) : "v"(gsrc), "s"(lds_dst) : "memory"); }
__device__ __forceinline__ unsigned cvtpk(float lo, float hi) { f32x2_t v = {lo, hi}; bf16x2_t b = __builtin_convertvector(v, bf16x2_t); return __builtin_bit_cast(unsigned, b); }
#define AWAIT_BAR(N) asm volatile("s_waitcnt vmcnt(" #N ") lgkmcnt(0)\n\ts_barrier" ::: "memory")

template <int ND0> __device__ __forceinline__ void qkt(f32x16& p0, f32x16& p1, const ALAS char* Kslot, const bf16x8* qr, int r32, int hi) {
    const ALAS char* kb = Kslot + hi * 1024 + r32 * 16;
    p0 = f32x16{}; p1 = f32x16{};
#pragma unroll
    for (int d0 = 0; d0 < ND0; ++d0) {
        const bf16x8 b0 = *(const ALAS bf16x8*)(kb + d0 * 2048);
        const bf16x8 b1 = *(const ALAS bf16x8*)(kb + d0 * 2048 + 512);
        p0 = __builtin_amdgcn_mfma_f32_32x32x16_bf16(b0, qr[d0], p0, 0, 0, 0);
        p1 = __builtin_amdgcn_mfma_f32_32x32x16_bf16(b1, qr[d0], p1, 0, 0, 0);
    }
}
__device__ __forceinline__ float rowmax32(const f32x16& p0, const f32x16& p1) {
    float a = fmaxf(p0[0], p1[0]);
#pragma unroll
    for (int r = 1; r < 16; ++r) a = fmaxf(a, fmaxf(p0[r], p1[r]));
    auto rr = __builtin_amdgcn_permlane32_swap(__float_as_uint(a), __float_as_uint(a), false, false);
    return fmaxf(__uint_as_float(rr[0]), __uint_as_float(rr[1]));
}
__device__ __forceinline__ void pv(f32x16* o, int vb, bf16x8 pa0, bf16x8 pa1, bf16x8 pa2, bf16x8 pa3) {
#pragma unroll
    for (int d0 = 0; d0 < 2; ++d0) { s16x4 lo[4], hi[4];
#pragma unroll
        for (int ks = 0; ks < 4; ++ks) {
            asm volatile("ds_read_b64_tr_b16 %0,%1 offset:%c2" : "=&v"(lo[ks]) : "v"(vb), "i"(d0 * 4096 + ks * 1024) : "memory");
            asm volatile("ds_read_b64_tr_b16 %0,%1 offset:%c2" : "=&v"(hi[ks]) : "v"(vb), "i"(d0 * 4096 + ks * 1024 + 512) : "memory"); }
        asm volatile("s_waitcnt lgkmcnt(0)" ::: "memory"); __builtin_amdgcn_sched_barrier(0);
#define APK(k) (bf16x8){lo[k][0], lo[k][1], lo[k][2], lo[k][3], hi[k][0], hi[k][1], hi[k][2], hi[k][3]}
        o[d0] = __builtin_amdgcn_mfma_f32_32x32x16_bf16(pa0, APK(0), o[d0], 0, 0, 0);
        o[d0] = __builtin_amdgcn_mfma_f32_32x32x16_bf16(pa1, APK(1), o[d0], 0, 0, 0);
        o[d0] = __builtin_amdgcn_mfma_f32_32x32x16_bf16(pa2, APK(2), o[d0], 0, 0, 0);
        o[d0] = __builtin_amdgcn_mfma_f32_32x32x16_bf16(pa3, APK(3), o[d0], 0, 0, 0);
#undef APK
    }
}

struct UnitDesc {
    const bf16_t* Q; int qpitch;
    long q0; int qcol;
    const bf16_t* K; int kpitch, kcol;
    const bf16_t* V; int vpitch, vcol;
    bf16_t* O; int opitch, ocol;
    int kv0;
    int nt;
    int rg;
    int rmin;
    int head;
};

template <int DQK, bool NA, bool MLAQ>
__device__ __forceinline__ void attn_unit(const UnitDesc& U, ALAS char* shm, const float* qgain, const float* T16, const float* rpb_g) {
    constexpr int ND0 = DQK / 16, NCH = DQK / 8, NP = NCH + 8;
    int tid_ = threadIdx.x; asm volatile("" : "+v"(tid_));
    const int tid = tid_, lane = tid & 63, r32 = lane & 31, hi = lane >> 5; const int wid = __builtin_amdgcn_readfirstlane(tid >> 6);
    const unsigned lds0 = (unsigned)(uintptr_t)shm;
    ALAS float* wsf = (ALAS float*)(shm + LDS_WS) + wid * 64;
    auto dma_tile = [&](int t, int slot) {
        int key0;
        if (NA && t >= 4) key0 = U.kv0 + CTX + (U.rmin + (t - 4)) * GW; else key0 = U.kv0 + 64 * t;
        const unsigned sbase = lds0 + slot * SLOT;
#pragma unroll
        for (int i = 0; i < 3; ++i) { const int pc = wid + 8 * i;
            if (pc < NP) {
                if (pc < NCH) glds16(U.K + (size_t)(key0 + lane) * U.kpitch + U.kcol + pc * 8, (unsigned)__builtin_amdgcn_readfirstlane(sbase + pc * 1024));
                else { const int v = pc - NCH; glds16(U.V + (size_t)(key0 + 16 * (v & 3) + (lane >> 2)) * U.vpitch + U.vcol + (v >> 2) * 32 + (lane & 3) * 8, (unsigned)__builtin_amdgcn_readfirstlane(sbase + KSLOT + v * 1024)); }
            } }
    };
    asm volatile("s_waitcnt vmcnt(0)" ::: "memory");
    dma_tile(0, 0); if (U.nt > 1) dma_tile(1, 1);
    if (NA) { ALAS float* tb = (ALAS float*)(shm + LDS_RPB); for (int i = tid; i < 15 * 31; i += 512) tb[i] = rpb_g[U.head * 465 + i] * LOG2E; }
    bf16x8 qr[ND0];
    const bf16_t* Qw = U.Q + (size_t)(U.q0 + wid * 32 + r32) * U.qpitch + U.qcol;
#pragma unroll
    for (int d0 = 0; d0 < ND0; ++d0) qr[d0] = *(const bf16x8*)(Qw + d0 * 16 + hi * 8);
    if (MLAQ) {
        float f[ND0][8]; float ss = 0.f;
#pragma unroll
        for (int d0 = 0; d0 < ND0; ++d0)
#pragma unroll
            for (int j = 0; j < 8; ++j) { f[d0][j] = bf2f((bf16_t)qr[d0][j]); ss += f[d0][j] * f[d0][j]; }
        ss += __shfl_xor(ss, 32);
        const float rn = rsqrtf(ss * (1.f / 96.f) + EPS) * C2_96;
#pragma unroll
        for (int d0 = 0; d0 < ND0; ++d0)
#pragma unroll
            for (int j = 0; j < 8; ++j) f[d0][j] = f[d0][j] * rn * qgain[d0 * 16 + hi * 8 + j];
        const int t = (int)((U.q0 + wid * 32 + r32) % S); const int grow = t / GW, gcol = t % GW;
#pragma unroll
        for (int part = 0; part < 2; ++part) { const int pos = part ? gcol : grow;
#pragma unroll
            for (int j = 0; j < 8; ++j) { const float cs = T16[pos * 8 + j], sn = T16[512 + pos * 8 + j];
                const float mine = f[4 + part][j], other = __shfl_xor(mine, 32);
                f[4 + part][j] = hi == 0 ? (mine * cs - other * sn) : (other * sn + mine * cs); } }
#pragma unroll
        for (int d0 = 0; d0 < ND0; ++d0)
#pragma unroll
            for (int j = 0; j < 4; ++j) { const unsigned w = cvtpk(f[d0][2 * j], f[d0][2 * j + 1]); qr[d0][2 * j] = (short)(w & 0xffff); qr[d0][2 * j + 1] = (short)(w >> 16); }
    }
    const int grow_w = NA ? 4 * U.rg + (wid >> 1) : 0, c0w = 32 * (wid & 1);
    const int r0w = NA ? min(max(grow_w - 4, 0), 24) : 0;
    const int qc = c0w + r32;
    const int cs_q = min(max(qc - 8, 0), 48);
    float mhat = -INFINITY, l_reg = 0.f; f32x16 o[2]; o[0] = f32x16{}; o[1] = f32x16{};
    const int vb0 = (int)(lds0 + KSLOT) + ((lane >> 4) & 1) * 32 + (lane & 3) * 8 + (4 * hi + ((lane & 15) >> 2)) * 64;
    int slot = 0;
    for (int t = 0; t < U.nt; ++t) {
        if (t + 1 < U.nt) { if (NP == 20 && wid < 4) AWAIT_BAR(3); else AWAIT_BAR(2); } else AWAIT_BAR(0);
        if (t + 2 < U.nt) { int s2 = slot + 2; if (s2 >= NSLOT) s2 -= NSLOT; dma_tile(t + 2, s2); }
        bool take = true; int krow = 0;
        if (NA && t >= 4) { krow = U.rmin + (t - 4); take = (krow >= r0w) && (krow < r0w + 8); }
        if (take) {
            f32x16 p0, p1;
            qkt<ND0>(p0, p1, shm + slot * SLOT, qr, r32, hi);
            if (NA && t >= 4) {
                const ALAS float* tb = (const ALAS float*)(shm + LDS_RPB) + (krow - grow_w + 7) * 31;
#pragma unroll
                for (int r = 0; r < 16; ++r) {
                    const int kc0 = crow(r, hi), kc1 = kc0 + 32;
                    { const int rel = kc0 - cs_q; const int bi = min(max(kc0 - qc + 15, 0), 30); const float bv = tb[bi]; p0[r] = ((unsigned)rel < 16u) ? p0[r] + bv : -INFINITY; }
                    { const int rel = kc1 - cs_q; const int bi = min(max(kc1 - qc + 15, 0), 30); const float bv = tb[bi]; p1[r] = ((unsigned)rel < 16u) ? p1[r] + bv : -INFINITY; }
                }
            }
            const float rm = rowmax32(p0, p1);
            if (__any(rm > mhat + THR)) {
                const float mnew = fmaxf(mhat, rm); const float f = __builtin_amdgcn_exp2f(mhat - mnew);
                l_reg *= f; mhat = mnew;
                if (hi == 0) wsf[r32] = f;
                asm volatile("s_waitcnt lgkmcnt(0)" ::: "memory");
#pragma unroll
                for (int r = 0; r < 16; ++r) { const float fr_ = wsf[crow(r, hi)]; o[0][r] *= fr_; o[1][r] *= fr_; }
            }
            float sacc = 0.f;
#pragma unroll
            for (int r = 0; r < 16; ++r) { p0[r] = __builtin_amdgcn_exp2f(p0[r] - mhat); p1[r] = __builtin_amdgcn_exp2f(p1[r] - mhat); sacc += p0[r] + p1[r]; }
            l_reg += sacc;
            u32x4 pw0, pw1, pw2, pw3;
#pragma unroll
            for (int j = 0; j < 4; ++j) { pw0[j] = cvtpk(p0[2 * j], p0[2 * j + 1]); pw1[j] = cvtpk(p0[8 + 2 * j], p0[9 + 2 * j]); pw2[j] = cvtpk(p1[2 * j], p1[2 * j + 1]); pw3[j] = cvtpk(p1[8 + 2 * j], p1[9 + 2 * j]); }
            pv(o, vb0 + slot * SLOT, __builtin_bit_cast(bf16x8, pw0), __builtin_bit_cast(bf16x8, pw1), __builtin_bit_cast(bf16x8, pw2), __builtin_bit_cast(bf16x8, pw3));
        }
        ++slot; if (slot >= NSLOT) slot = 0;
    }
    { auto rr = __builtin_amdgcn_permlane32_swap(__float_as_uint(l_reg), __float_as_uint(l_reg), false, false); l_reg = __uint_as_float(rr[0]) + __uint_as_float(rr[1]); }
    if (hi == 0) wsf[32 + r32] = l_reg;
    asm volatile("s_waitcnt lgkmcnt(0)" ::: "memory");
    float rli[16];
#pragma unroll
    for (int r = 0; r < 16; ++r) rli[r] = __builtin_amdgcn_rcpf(wsf[32 + crow(r, hi)]);
    bf16_t* Ow = U.O + (size_t)(U.q0 + wid * 32) * U.opitch + U.ocol;
    { ALAS bf16_t* stg = (ALAS bf16_t*)(shm + LDS_OST) + wid * 2048;
#pragma unroll
        for (int r = 0; r < 16; ++r) { const int orow = crow(r, hi);
#pragma unroll
            for (int d0 = 0; d0 < 2; ++d0) stg[orow * 64 + d0 * 32 + r32] = f2bf(o[d0][r] * rli[r]); }
        asm volatile("s_waitcnt lgkmcnt(0)" ::: "memory");
#pragma unroll
        for (int i = 0; i < 4; ++i) { const int row = i * 8 + (lane >> 3), ch = lane & 7; const u32x4 v = *(const ALAS u32x4*)(stg + row * 64 + ch * 8); *(u32x4*)(Ow + (size_t)row * U.opitch + ch * 8) = v; } }
    asm volatile("s_waitcnt vmcnt(0) lgkmcnt(0)\n\ts_barrier" ::: "memory");
}
}
namespace mk {
#define MLAS __attribute__((address_space(3)))
constexpr int NWAVES = 8, NTHR = 512;
constexpr int RING_BYTES = 131072;
constexpr int LDS_BYTES = 147456;
constexpr int NPHASE = 16;
typedef unsigned v4u __attribute__((ext_vector_type(4)));
typedef float f32x4 __attribute__((ext_vector_type(4)));

struct Ctx {
    Params p; MLAS unsigned char* lds; int tid, lane, wave, G, vcu, bid;
};
__device__ __forceinline__ unsigned pk2(float lo, float hi) { return (unsigned)f2bf(lo) | ((unsigned)f2bf(hi) << 16); }

enum { W_IN0 = 0, W_OUT0, W_GU0, W_D0, W_IN1, W_UQ, W_UKV, W_OUT1, W_GU1, W_D1, NWMAT };
struct SrcBlk { const float* W; int ld; int col; const float* kscale; };
__device__ __forceinline__ SrcBlk src_of(const Params& p, int mat, int nb) {
    SrcBlk s; s.kscale = nullptr; const int pn = nb >> 3, q = nb & 7, bj = q >> 2, wc = q & 3;
    switch (mat) {
    case W_IN0: s.W = p.in[I0_WIN]; s.ld = L0_IN; s.col = 256 * pn + 64 * wc + 32 * bj; break;
    case W_OUT0: s.W = p.in[I0_WOUT]; s.ld = D; s.col = 32 * nb; break;
    case W_GU0: s.W = bj ? p.in[I0_WU] : p.in[I0_WG]; s.ld = FF; s.col = 128 * pn + 32 * wc; break;
    case W_D0: s.W = p.in[I0_WD]; s.ld = D; s.col = 32 * nb; break;
    case W_IN1: s.W = p.in[I1_WIN]; s.ld = L1_IN;
        if (pn == 0) s.col = 128 * bj + 32 * wc;
        else if (pn == 1) { if (bj == 0) s.col = 256 + 32 * wc; else s.col = 640; }
        else if (pn == 2) s.col = 384 + 128 * bj + 32 * wc;
        else if (pn < 5) s.col = 672 + (pn - 3) * 256 + 64 * wc + 32 * bj;
        else if (pn < 7) s.col = 1184 + (pn - 5) * 256 + 64 * wc + 32 * bj;
        else s.col = 1696 + (pn - 7) * 256 + 64 * wc + 32 * bj;
        break;
    case W_UQ: s.W = p.in[I1_WUQ]; s.ld = 768; s.col = 32 * nb; s.kscale = p.in[I1_QAG]; break;
    case W_UKV: s.W = p.in[I1_WUKV]; s.ld = 1024; s.col = (2 * pn + (wc >> 1)) * 128 + (wc & 1) * 64 + 32 * bj; s.kscale = p.in[I1_KVAG]; break;
    case W_OUT1: s.W = p.in[I1_WOUT]; s.ld = D; s.col = 32 * nb; break;
    case W_GU1: s.W = bj ? p.in[I1_WU] : p.in[I1_WG]; s.ld = FF; s.col = 128 * pn + 32 * wc; break;
    default: s.W = p.in[I1_WD]; s.ld = D; s.col = 32 * nb; break;
    }
    return s;
}
struct WMat { size_t ws_off; int K, N; };
__host__ __device__ constexpr WMat wmat(int mat) {
    switch (mat) {
    case W_IN0: return {WS_W_IN0, D, 1536}; case W_OUT0: return {WS_W_OUT0, D, D}; case W_GU0: return {WS_W_GU0, D, 2 * FF}; case W_D0: return {WS_W_D0, FF, D};
    case W_IN1: return {WS_W_IN1, D, L1_INP}; case W_UQ: return {WS_W_UQ, 384, 768}; case W_UKV: return {WS_W_UKV, 256, 1024}; case W_OUT1: return {WS_W_OUT1, D, D};
    case W_GU1: return {WS_W_GU1, D, 2 * FF}; default: return {WS_W_D1, FF, D};
    }
}
template <int mat> __device__ __forceinline__ void transpose_item(const Params& p, int item, MLAS float* scr, int lane) {
    const WMat wm = wmat(mat); const int nblk = wm.N / 32, kb = item / nblk, nb = item % nblk, k0 = 64 * kb;
    const SrcBlk s = src_of(p, mat, nb);
    bf16_t* WT = (bf16_t*)(p.ws + wm.ws_off);
    const int c = lane & 7;
    if (s.W == nullptr) {
#pragma unroll
        for (int j = 0; j < 4; ++j) { const int n = (lane >> 3) + 8 * j; *(v4u*)(WT + (size_t)(32 * nb + n) * wm.K + k0 + 8 * c) = (v4u){0u, 0u, 0u, 0u}; }
        return;
    }
    MLAS float* t0 = scr; MLAS float* t1 = scr + 64 * 33;
    const bool fused_pool = (mat == W_OUT0 && kb < 4);
    const float* wsrc = s.W + (size_t)k0 * s.ld + s.col + (lane & 31);
#pragma unroll 8
    for (int i = 0; i < 32; ++i) { const int kk = 2 * i + (lane >> 5); t0[kk * 33 + (lane & 31)] = wsrc[(size_t)kk * s.ld]; }
    if (s.kscale) {
#pragma unroll 8
        for (int i = 0; i < 32; ++i) { const int kk = 2 * i + (lane >> 5); t0[kk * 33 + (lane & 31)] *= s.kscale[k0 + kk]; }
    }
    if (fused_pool) {
#pragma unroll 8
        for (int i = 0; i < 32; ++i) { const int kk = 2 * i + (lane >> 5); t0[kk * 33 + (lane & 31)] *= p.in[I0_POOLS][k0 + kk]; }
    }
    asm volatile("s_waitcnt lgkmcnt(0)" ::: "memory");
    MLAS float* src = t0;
    if (fused_pool) {
        const float* pw = p.in[I0_POOLW] + kb * 4096; const int nn = lane & 31, ch = lane >> 5;
        for (int cc = ch; cc < 64; cc += 2) { float a = 0.f;
#pragma unroll 8
            for (int d = 0; d < 64; ++d) a += pw[cc * 64 + d] * t0[d * 33 + nn];
            t1[cc * 33 + nn] = a; }
        asm volatile("s_waitcnt lgkmcnt(0)" ::: "memory");
        src = t1;
    }
#pragma unroll
    for (int j = 0; j < 4; ++j) { const int n = (lane >> 3) + 8 * j; const MLAS float* sp = src + (8 * c) * 33 + n;
        v4u o; o.x = pk2(sp[0 * 33], sp[1 * 33]); o.y = pk2(sp[2 * 33], sp[3 * 33]); o.z = pk2(sp[4 * 33], sp[5 * 33]); o.w = pk2(sp[6 * 33], sp[7 * 33]);
        *(v4u*)(WT + (size_t)(32 * nb + n) * wm.K + k0 + 8 * c) = o; }
    asm volatile("s_waitcnt lgkmcnt(0)" ::: "memory");
}

__device__ __forceinline__ void phase_prologue(Ctx& C) {
    const Params& p = C.p;
    MLAS float* sil = (MLAS float*)C.lds;
    MLAS float* red = (MLAS float*)(C.lds + 9 * 1024 * 4);
    for (int i = C.tid; i < 9 * D; i += NTHR) { const int j = i / D, k = i % D; const float c = (j < 8) ? p.in[I_C][j * D + k] : p.in[I_CCTX][k]; sil[i] = c / (1.f + expf(-c)); }
    __syncthreads();
    float* MOD = (float*)(p.ws + WS_MOD);
#ifndef P0MASK
#define P0MASK 15
#endif
    if (P0MASK & 1)
    for (int it = C.vcu; it < 192; it += C.G) {
        const int l = it / 96, n0 = (it % 96) * 64; const float* w = (l ? p.in[I1_ADAW] : p.in[I0_ADAW]) + n0 + C.lane;
        float acc[9];
#pragma unroll
        for (int j = 0; j < 9; ++j) acc[j] = 0.f;
        const int kb = C.wave * 128;
#pragma unroll 4
        for (int k = kb; k < kb + 128; ++k) { const float wv = w[(size_t)k * 6144];
#pragma unroll
            for (int j = 0; j < 9; ++j) acc[j] += sil[j * D + k] * wv; }
#pragma unroll
        for (int j = 0; j < 9; ++j) red[(C.wave * 9 + j) * 64 + C.lane] = acc[j];
        __syncthreads();
        for (int i = C.tid; i < 9 * 64; i += NTHR) { const int j = i / 64, c = i % 64; float s = 0.f;
#pragma unroll
            for (int wv = 0; wv < 8; ++wv) s += red[(wv * 9 + j) * 64 + c];
            MOD[(size_t)(l * 9 + j) * 6144 + n0 + c] = s + (l ? p.in[I1_ADAB] : p.in[I0_ADAB])[n0 + c]; }
        __syncthreads();
    }
    __syncthreads();
    const int gw = C.vcu * NWAVES + C.wave, NGW = C.G * NWAVES;
    MLAS float* scr = (MLAS float*)(C.lds + C.wave * 16896);
    if (P0MASK & 2) {
        int rot = 0;
#define TR_MAT(M) { constexpr int ni = (wmat(M).K / 64) * (wmat(M).N / 32); int first = gw - rot; if (first < 0) first += NGW; \
            for (int it = first; it < ni; it += NGW) transpose_item<M>(p, it, scr, C.lane); rot = (rot + ni) % NGW; }
        TR_MAT(W_IN0) TR_MAT(W_OUT0) TR_MAT(W_GU0) TR_MAT(W_D0) TR_MAT(W_IN1) TR_MAT(W_UQ) TR_MAT(W_UKV) TR_MAT(W_OUT1) TR_MAT(W_GU1) TR_MAT(W_D1)
#undef TR_MAT
    }
    if ((P0MASK & 4) && C.bid == C.G - 1) {
        float* T32 = (float*)(p.ws + WS_ROPE32); float* T16 = (float*)(p.ws + WS_ROPE16);
        for (int i = C.tid; i < 1024; i += NTHR) { const int pos = i >> 4, f = i & 15; const float ang = (float)pos * powf(10000.0f, -((float)f * 2.0f) / 32.0f); T32[i] = cosf(ang); T32[1024 + i] = sinf(ang); }
        for (int i = C.tid; i < 512; i += NTHR) { const int pos = i >> 3, f = i & 7; const float ang = (float)pos * powf(10000.0f, -((float)f * 2.0f) / 16.0f); T16[i] = cosf(ang); T16[512 + i] = sinf(ang); }
    }
    if (P0MASK & 8) { float* SSQ = (float*)(p.ws + WS_SSQ); float* SSKV = (float*)(p.ws + WS_SSKV);
        for (int i = C.bid * NTHR + C.tid; i < MT; i += C.G * NTHR) { SSQ[i] = 0.f; SSKV[i] = 0.f; } }
}

__device__ __forceinline__ void phase_norm(Ctx& C, const float* xl, const float* xc, const float* gain, int layer, int sh_chunk, int sc_chunk, int nrows) {
    const int gw = C.vcu * NWAVES + C.wave, NGW = C.G * NWAVES;
    bf16_t* XN = (bf16_t*)(C.p.ws + WS_XN); const float* MODb = (const float*)(C.p.ws + WS_MOD) + (size_t)layer * 9 * 6144;
    for (int m = gw; m < nrows; m += NGW) {
        const float* xr = m < ML ? xl + (size_t)m * D : xc + (size_t)(m - ML) * D;
        const float* mod = MODb + (size_t)modidx_of(m) * 6144;
        f32x4 v[4]; float ss = 0.f;
#pragma unroll
        for (int j = 0; j < 4; ++j) { v[j] = *(const f32x4*)(xr + 4 * C.lane + 256 * j); ss += (v[j][0] * v[j][0] + v[j][1] * v[j][1]) + (v[j][2] * v[j][2] + v[j][3] * v[j][3]); }
        ss = wave_sum(ss);
        const float r = rsqrtf(ss * (1.f / D) + EPS);
#pragma unroll
        for (int j = 0; j < 4; ++j) { const int c = 4 * C.lane + 256 * j;
            const f32x4 g = *(const f32x4*)(gain + c), sc = *(const f32x4*)(mod + sc_chunk * D + c), sh = *(const f32x4*)(mod + sh_chunk * D + c);
            const f32x4 y = ((v[j] * r) * g) * (sc + 1.f) + sh;
            uint2 o; o.x = pk2(y[0], y[1]); o.y = pk2(y[2], y[3]);
            *(uint2*)(XN + (size_t)m * D + c) = o; }
    }
}

__device__ __forceinline__ void phase_pool(Ctx& C) {
    const bf16_t* A0 = (const bf16_t*)(C.p.ws + WS_A0); bf16_t* MIX = (bf16_t*)(C.p.ws + WS_MIX);
    const int gt = C.vcu * NTHR + C.tid, NGT = C.G * NTHR;
    for (int it = gt; it < MT * 32; it += NGT) {
        const int m = it >> 5, c8 = (it & 31) * 8, g = c8 >> 6, w = 2 << g;
        int t, T; if (m < ML) { t = m % S; T = S; } else { t = (m - ML) % CTX; T = CTX; }
        const int base = m - t; int lo = t - w / 2; if (lo < 0) lo = 0; int hi = t - w / 2 + w; if (hi > T) hi = T;
        float s[8];
#pragma unroll
        for (int e = 0; e < 8; ++e) s[e] = 0.f;
        for (int j = lo; j < hi; ++j) { const v4u q = *(const v4u*)(A0 + (size_t)(base + j) * 256 + c8);
#pragma unroll
            for (int e = 0; e < 4; ++e) { s[2 * e] += __uint_as_float(q[e] << 16); s[2 * e + 1] += __uint_as_float(q[e] & 0xffff0000u); } }
        const v4u q = *(const v4u*)(A0 + (size_t)m * 256 + c8); const float inv = 1.f / (float)(hi - lo);
        v4u o;
#pragma unroll
        for (int e = 0; e < 4; ++e) o[e] = pk2(s[2 * e] * inv - __uint_as_float(q[e] << 16), s[2 * e + 1] * inv - __uint_as_float(q[e] & 0xffff0000u));
        *(v4u*)(MIX + (size_t)m * D + c8) = o;
    }
}

__device__ __forceinline__ void phase_attn0(Ctx& C) {
    const Params& p = C.p;
    MLAS char* shm = (MLAS char*)C.lds;
    att::UnitDesc U; U.Q = (const bf16_t*)(p.ws + WS_Q0); U.qpitch = 768; U.K = (const bf16_t*)(p.ws + WS_K0); U.kpitch = 256; U.V = (const bf16_t*)(p.ws + WS_V0); U.vpitch = 256;
    U.O = (bf16_t*)(p.ws + WS_MIX); U.opitch = D; U.rg = 0; U.rmin = 0; U.head = 0;
    for (int u = C.vcu; u < 768 + 96; u += C.G) {
        if (u < 768) { const int qb = u & 7, bh = u >> 3, h = bh % 12, b = bh / 12;
            U.q0 = (long)b * S + 256 * qb; U.qcol = h * 64; U.kcol = (h / 3) * 64; U.vcol = (h / 3) * 64; U.ocol = 256 + h * 64; U.kv0 = b * SK; U.nt = SK / 64; }
        else { const int bh = u - 768, h = bh % 12, b = bh / 12;
            U.q0 = (long)ML + 256 * b; U.qcol = h * 64; U.kcol = (h / 3) * 64; U.vcol = (h / 3) * 64; U.ocol = 256 + h * 64; U.kv0 = b * SK; U.nt = CTX / 64; }
        att::attn_unit<64, false, false>(U, shm, nullptr, nullptr, nullptr);
    }
    phase_pool(C);
}
__device__ __forceinline__ void phase_attn1(Ctx& C) {
    const Params& p = C.p;
    MLAS char* shm = (MLAS char*)C.lds;
    const float* T16 = (const float*)(p.ws + WS_ROPE16);
    att::UnitDesc U; U.O = (bf16_t*)(p.ws + WS_MIX); U.opitch = D;
    for (int u = C.vcu; u < 1024; u += C.G) {
        const int uu = u & 511, qb = uu & 7, h = (uu >> 3) & 7, b = uu >> 6;
        U.q0 = (long)b * S + 256 * qb; U.kv0 = b * SK; U.head = h;
        if (u < 512) {
            U.Q = (const bf16_t*)(p.ws + WS_MQ); U.qpitch = 768; U.qcol = h * 96; U.K = (const bf16_t*)(p.ws + WS_MK); U.kpitch = 768; U.kcol = h * 96;
            U.V = (const bf16_t*)(p.ws + WS_MV); U.vpitch = 512; U.vcol = h * 64; U.ocol = h * 64; U.nt = SK / 64; U.rg = 0; U.rmin = 0;
            att::attn_unit<96, false, true>(U, shm, p.in[I1_MQG], T16, nullptr);
        } else {
            U.Q = (const bf16_t*)(p.ws + WS_NQ); U.qpitch = 512; U.qcol = h * 64; U.K = (const bf16_t*)(p.ws + WS_NK); U.kpitch = 512; U.kcol = h * 64;
            U.V = (const bf16_t*)(p.ws + WS_NV); U.vpitch = 512; U.vcol = h * 64; U.ocol = 512 + h * 64; U.rg = qb;
            const int rmin = min(max(4 * qb - 4, 0), 24), rmax = min(max(4 * qb + 3 - 4, 0), 24) + 7;
            U.rmin = rmin; U.nt = 4 + (rmax - rmin + 1);
            att::attn_unit<64, true, false>(U, shm, nullptr, nullptr, p.in[I1_RPB]);
        }
    }
}

__global__ void __launch_bounds__(NTHR, 2) mega(Params p, int ph_lo, int ph_hi) {
    extern __shared__ __attribute__((aligned(16))) unsigned char lds_raw[];
    cg::grid_group grid = cg::this_grid();
    Ctx C; C.p = p; C.lds = (MLAS unsigned char*)lds_raw; C.tid = threadIdx.x; C.lane = C.tid & 63; C.wave = __builtin_amdgcn_readfirstlane(C.tid >> 6);
    C.G = gridDim.x; C.bid = blockIdx.x; C.vcu = (C.G % 8 == 0) ? (C.bid % 8) * (C.G / 8) + C.bid / 8 : C.bid;
    float* out = p.out; float* xrc = (float*)(p.ws + WS_XRC);
    const float* MOD = (const float*)(p.ws + WS_MOD);
    bf16_t* XN = (bf16_t*)(p.ws + WS_XN); bf16_t* MIX = (bf16_t*)(p.ws + WS_MIX); bf16_t* H = (bf16_t*)(p.ws + WS_H);
    const float* T32 = (const float*)(p.ws + WS_ROPE32); const float* T16 = (const float*)(p.ws + WS_ROPE16);
#define WSB(off) ((bf16_t*)(p.ws + (off)))
#ifndef PHMASK
#define PHMASK 0xFFFF
#endif
#define PH(k) if (((PHMASK >> (k)) & 1) && ph_lo <= (k) && (k) < ph_hi)
#define SEAM(k) if (ph_lo <= (k) && (k) + 1 < ph_hi) grid.sync()
    PH(0) { phase_prologue(C); } SEAM(0);
    PH(1) { phase_norm(C, p.in[I_X], p.in[I_CTX], p.in[I0_NMIX], 0, 0, 1, MT); } SEAM(1);
    PH(2) { pg8::Gemm g{XN, WSB(WS_W_IN0), MT, 1536, D}; pg8::StaticOrder So; So.init(MT, 1536, C.G, C.bid);
        epi::EpiIn0 E{WSB(WS_A0), WSB(WS_Q0), WSB(WS_K0), WSB(WS_V0), p.in[I0_QG], p.in[I0_KG], T32};
        pg8::gemm_phase<epi::EpiIn0, pg8::StaticOrder, true, true>(C.lds, g, So, E); } SEAM(2);
    PH(3) { phase_attn0(C); } SEAM(3);
    PH(4) { pg8::Gemm g{MIX, WSB(WS_W_OUT0), MT, D, D}; pg8::StaticOrder So; So.init(MT, D, C.G, C.bid);
        epi::EpiResid E{p.in[I_X], p.in[I_CTX], out, xrc, MOD + 2 * D};
        pg8::gemm_phase<epi::EpiResid, pg8::StaticOrder, true, true>(C.lds, g, So, E); } SEAM(4);
    PH(5) { phase_norm(C, out, xrc, p.in[I0_NFFN], 0, 3, 4, MT); } SEAM(5);
    PH(6) { pg8::Gemm g{XN, WSB(WS_W_GU0), MT, 2 * FF, D}; pg8::StaticOrder So; So.init(MT, 2 * FF, C.G, C.bid);
        epi::EpiSwiGLU E{H};
        pg8::gemm_phase<epi::EpiSwiGLU, pg8::StaticOrder, true, true>(C.lds, g, So, E); } SEAM(6);
    PH(7) { pg8::Gemm g{H, WSB(WS_W_D0), MT, D, FF}; pg8::StaticOrder So; So.init(MT, D, C.G, C.bid);
        epi::EpiResid E{out, xrc, out, xrc, MOD + 5 * D};
        pg8::gemm_phase<epi::EpiResid, pg8::StaticOrder, true, true>(C.lds, g, So, E); } SEAM(7);
    PH(8) { phase_norm(C, out, xrc, p.in[I1_NMIX], 1, 0, 1, MT); } SEAM(8);
    PH(9) { pg8::Gemm g{XN, WSB(WS_W_IN1), MT, L1_INP, D}; pg8::StaticOrder So; So.init(MT, L1_INP, C.G, C.bid);
        epi::EpiIn1 E{WSB(WS_CQ), WSB(WS_CKV), WSB(WS_NQ), WSB(WS_NK), WSB(WS_NV), (float*)(p.ws + WS_KR), (float*)(p.ws + WS_SSQ), (float*)(p.ws + WS_SSKV), p.in[I1_NQG], p.in[I1_NKG]};
        pg8::gemm_phase<epi::EpiIn1, pg8::StaticOrder, true, true>(C.lds, g, So, E); } SEAM(9);
    PH(10) {
#ifndef NO_QUP
        { pg8::Gemm g{WSB(WS_CQ), WSB(WS_W_UQ), ML, 768, 384}; pg8::StaticOrder So; So.init(ML, 768, C.G, C.bid);
          epi::EpiQUp E{WSB(WS_MQ), (const float*)(p.ws + WS_SSQ)};
          pg8::gemm_phase<epi::EpiQUp, pg8::StaticOrder, true, true>(C.lds, g, So, E); }
#endif
#ifndef NO_KVUP
        { pg8::Gemm g{WSB(WS_CKV), WSB(WS_W_UKV), MT, 1024, 256}; pg8::StaticOrder So; So.init(MT, 1024, C.G, C.bid);
          epi::EpiKvUp E{WSB(WS_MK), WSB(WS_MV), (const float*)(p.ws + WS_SSKV), (const float*)(p.ws + WS_KR), p.in[I1_MKG], T16};
          pg8::gemm_phase<epi::EpiKvUp, pg8::StaticOrder, true, true>(C.lds, g, So, E); }
#endif
    } SEAM(10);
    PH(11) { phase_attn1(C); } SEAM(11);
    PH(12) { pg8::Gemm g{MIX, WSB(WS_W_OUT1), ML, D, D}; pg8::StaticOrder So; So.init(ML, D, C.G, C.bid);
        epi::EpiResid E{out, xrc, out, xrc, MOD + 9 * 6144 + 2 * D};
        pg8::gemm_phase<epi::EpiResid, pg8::StaticOrder, true, true>(C.lds, g, So, E); } SEAM(12);
    PH(13) { phase_norm(C, out, xrc, p.in[I1_NFFN], 1, 3, 4, ML); } SEAM(13);
    PH(14) { pg8::Gemm g{XN, WSB(WS_W_GU1), ML, 2 * FF, D}; pg8::StaticOrder So; So.init(ML, 2 * FF, C.G, C.bid);
        epi::EpiSwiGLU E{H};
        pg8::gemm_phase<epi::EpiSwiGLU, pg8::StaticOrder, true, true>(C.lds, g, So, E); } SEAM(14);
    PH(15) { pg8::Gemm g{H, WSB(WS_W_D1), ML, D, FF}; pg8::StaticOrder So; So.init(ML, D, C.G, C.bid);
        epi::EpiResid E{out, xrc, out, xrc, MOD + 9 * 6144 + 5 * D};
        pg8::gemm_phase<epi::EpiResid, pg8::StaticOrder, true, true>(C.lds, g, So, E); }
#undef PH
#undef SEAM
#undef WSB
}
}
#ifndef MK_DEBUG
#define MK_DEBUG 0
#endif
static int g_grid = 0;
static bool mega_setup() {
    if (g_grid) return g_grid > 0;
    int dev = 0, cus = 0, per_cu = 0;
    if (hipGetDevice(&dev) != hipSuccess || hipDeviceGetAttribute(&cus, hipDeviceAttributeMultiprocessorCount, dev) != hipSuccess) { g_grid = -1; return false; }
    if (hipFuncSetAttribute((const void*)mk::mega, hipFuncAttributeMaxDynamicSharedMemorySize, mk::LDS_BYTES) != hipSuccess) { fprintf(stderr, "kernel_launch: hipFuncSetAttribute failed\n"); g_grid = -1; return false; }
    if (hipOccupancyMaxActiveBlocksPerMultiprocessor(&per_cu, (const void*)mk::mega, mk::NTHR, mk::LDS_BYTES) != hipSuccess || per_cu < 1) { fprintf(stderr, "kernel_launch: occupancy query says %d\n", per_cu); g_grid = -1; return false; }
    g_grid = cus;
    fprintf(stderr, "kernel_launch: %d CUs, occupancy %d blocks/CU, grid %d\n", cus, per_cu, g_grid);
    return true;
}
static void launch_phases(const Params& p, int lo, int hi, hipStream_t st) {
    Params pp = p; int l = lo, h = hi;
    void* args[] = {&pp, &l, &h};
    hipError_t e;
    if (hi - lo > 1) e = hipLaunchCooperativeKernel((const void*)mk::mega, dim3(g_grid), dim3(mk::NTHR), args, mk::LDS_BYTES, st);
    else e = hipLaunchKernel((const void*)mk::mega, dim3(g_grid), dim3(mk::NTHR), args, mk::LDS_BYTES, st);
    if (e != hipSuccess) fprintf(stderr, "kernel_launch: launch [%d,%d) failed: %s\n", lo, hi, hipGetErrorString(e));
}
#if MK_DEBUG
static void launch_debug(const Params& p, hipStream_t st) {
    using namespace nv;
    unsigned* err = (unsigned*)(p.ws + WS_CTL) + 64;
    float* out = p.out; float* xrc = (float*)(p.ws + WS_XRC);
    const float* x = p.in[I_X]; const float* cx = p.in[I_CTX];
    const size_t att_sm = 4 * (SK + 128) * sizeof(float);
    const int SR = 4096;
    float* snapL = (float*)(p.ws + WS_SNAP); float* snapC = snapL + (size_t)SR * D;
    float* snapB = (float*)(p.ws + WS_BIG);
    hipMemsetAsync(p.ws + WS_CTL, 0, 4096, st);
    launch_phases(p, 0, 1, st);  k_adaln<true><<<dim3(6144 / 256, 9, 2), 256, 0, st>>>(p, err + 0);
    launch_phases(p, 1, 2, st);  k_norm<true><<<MT / 4, 256, 0, st>>>(p, x, cx, I0_NMIX, 0, 0, 1, MT, err + 1);
    launch_phases(p, 2, 3, st);  k_in0<true><<<MT / R, 256, (R * D + R * L0_IN) * 4, st>>>(p, err + 2);
    launch_phases(p, 3, 4, st);  k_attn<true, 0><<<dim3(ML / 4, 12), 256, att_sm, st>>>(p, err + 3);
                                 k_attn<true, 1><<<dim3(MC / 4, 12), 256, att_sm, st>>>(p, err + 16);
                                 k_pool0<true><<<MT, 256, 0, st>>>(p, err + 17);
    launch_phases(p, 4, 5, st);  k_out<true, 0><<<MT / R, 256, (R * D + R * 256) * 4, st>>>(p, x, cx, out, xrc, 0, err + 4);
    launch_phases(p, 5, 6, st);  k_norm<true><<<MT / 4, 256, 0, st>>>(p, out, xrc, I0_NFFN, 0, 3, 4, MT, err + 5);
    launch_phases(p, 6, 7, st);  k_ffn_gu<true, 0><<<MT / R, 256, R * D * 4, st>>>(p, err + 6);
    hipMemcpyAsync(snapL, out, (size_t)SR * D * 4, hipMemcpyDeviceToDevice, st); hipMemcpyAsync(snapC, xrc, (size_t)MC * D * 4, hipMemcpyDeviceToDevice, st);
    launch_phases(p, 7, 8, st);  k_ffn_d<true, 0><<<SR / R, 256, R * FF * 4, st>>>(p, snapL, snapC, out, xrc, 0, err + 7);
                                 k_ffn_d<true, 0><<<MC / R, 256, R * FF * 4, st>>>(p, snapL, snapC, out, xrc, ML, err + 7);
    launch_phases(p, 8, 9, st);  k_norm<true><<<MT / 4, 256, 0, st>>>(p, out, xrc, I1_NMIX, 1, 0, 1, MT, err + 8);
    launch_phases(p, 9, 10, st); k_in1<true><<<MT / R, 256, (R * D + R * L1_IN) * 4, st>>>(p, err + 9);
    launch_phases(p, 10, 11, st); k_mlaq<true><<<ML / R, 256, R * 384 * 4, st>>>(p, err + 10);
                                 k_mlakv<true><<<MT / R, 256, (R * 256 + R * 1024) * 4, st>>>(p, err + 19);
    launch_phases(p, 11, 12, st); k_attn<true, 2><<<dim3(ML / 4, 8), 256, att_sm, st>>>(p, err + 11);
                                 k_attn<true, 3><<<dim3(ML / 4, 8), 256, att_sm, st>>>(p, err + 18);
    hipMemcpyAsync(snapB, out, (size_t)SR * D * 4, hipMemcpyDeviceToDevice, st);
    launch_phases(p, 12, 13, st); k_out<true, 1><<<SR / R, 256, (R * D + R * 256) * 4, st>>>(p, snapB, snapC, out, xrc, 0, err + 12);
    launch_phases(p, 13, 14, st); k_norm<true><<<ML / 4, 256, 0, st>>>(p, out, xrc, I1_NFFN, 1, 3, 4, ML, err + 13);
    launch_phases(p, 14, 15, st); k_ffn_gu<true, 1><<<ML / R, 256, R * D * 4, st>>>(p, err + 14);
    hipMemcpyAsync(snapL, out, (size_t)SR * D * 4, hipMemcpyDeviceToDevice, st);
    launch_phases(p, 15, 16, st); k_ffn_d<true, 1><<<SR / R, 256, R * FF * 4, st>>>(p, snapL, snapC, out, xrc, 0, err + 15);
    k_report<<<1, 1, 0, st>>>(p, 20, 0.15f);
}
#endif
extern "C" void kernel_launch(void* const* d_in, const int* in_sizes, int n_in, void* d_out, int out_size, void* d_ws, size_t ws_size, hipStream_t stream) {
    if (n_in != N_IN || out_size != ML * D || ws_size < WS_END) { fprintf(stderr, "kernel_launch: unexpected shapes n_in=%d out=%d ws=%zu\n", n_in, out_size, ws_size); return; }
    if (!mega_setup()) return;
    Params p{};
    for (int i = 0; i < N_IN; ++i) p.in[i] = (const float*)d_in[i];
    p.out = (float*)d_out; p.ws = (unsigned char*)d_ws;
#if MK_DEBUG
    launch_debug(p, stream);
#else
    launch_phases(p, 0, mk::NPHASE, stream);
#endif
}
```

```cpp
#include <hip/hip_runtime.h>
#include <hip/hip_cooperative_groups.h>
#include <cstdio>
#include <cstdint>
namespace cg = cooperative_groups;

typedef unsigned short bf16_t;
constexpr int D = 1024, NB = 8, S = 2048, CTX = 256, SK = S + CTX, ML = NB * S, MC = NB * CTX, MT = ML + MC, FF = 2816;
constexpr int GW = 64;
constexpr int L0_IN = 1536, L1_IN = 2208, L1_INP = 2304;
constexpr float EPS = 1e-6f;
constexpr float LOG2E = 1.4426950408889634f;
constexpr float C2_64 = 0.125f * LOG2E;
constexpr float C2_96 = 0.10206207261596577f * LOG2E;

enum { I_X = 0, I_C, I_CTX, I_CCTX,
       I0_ADAW, I0_ADAB, I0_NMIX, I0_NFFN, I0_WIN, I0_POOLW, I0_POOLS, I0_QG, I0_KG, I0_WOUT, I0_WG, I0_WU, I0_WD,
       I1_ADAW, I1_ADAB, I1_NMIX, I1_NFFN, I1_WIN, I1_QAG, I1_KVAG, I1_WUQ, I1_WUKV, I1_MQG, I1_MKG, I1_NQG, I1_NKG, I1_RPB, I1_WOUT, I1_WG, I1_WU, I1_WD, N_IN };

constexpr size_t MiB = 1u << 20;
constexpr size_t WS_CTL = 0;
constexpr size_t WS_BARRIER = 16 * 1024;
constexpr size_t WS_MOD = 64 * 1024;
constexpr size_t WS_SSQ = 512 * 1024;
constexpr size_t WS_SSKV = 600 * 1024;
constexpr size_t WS_ROPE32 = 700 * 1024;
constexpr size_t WS_ROPE16 = 712 * 1024;
constexpr size_t WS_W_IN0 = 1 * MiB;
constexpr size_t WS_W_OUT0 = 4 * MiB;
constexpr size_t WS_W_GU0 = 6 * MiB;
constexpr size_t WS_W_D0 = 17 * MiB;
constexpr size_t WS_W_IN1 = 23 * MiB;
constexpr size_t WS_W_UQ = 28 * MiB;
constexpr size_t WS_W_UKV = 29 * MiB;
constexpr size_t WS_W_OUT1 = 30 * MiB;
constexpr size_t WS_W_GU1 = 32 * MiB;
constexpr size_t WS_W_D1 = 43 * MiB;
constexpr size_t WS_XRC = 49 * MiB;
constexpr size_t WS_XN = 57 * MiB;
constexpr size_t WS_MIX = WS_XN;
constexpr size_t WS_BIG = 96 * MiB;
constexpr size_t WS_H = WS_BIG;
constexpr size_t WS_A0 = WS_BIG;
constexpr size_t WS_Q0 = WS_BIG + 9 * MiB;
constexpr size_t WS_K0 = WS_BIG + 36 * MiB;
constexpr size_t WS_V0 = WS_BIG + 45 * MiB;
constexpr size_t WS_CQ = WS_BIG;
constexpr size_t WS_CKV = WS_BIG + 14 * MiB;
constexpr size_t WS_NQ = WS_BIG + 23 * MiB;
constexpr size_t WS_NK = WS_BIG + 41 * MiB;
constexpr size_t WS_NV = WS_BIG + 59 * MiB;
constexpr size_t WS_MQ = WS_BIG + 77 * MiB;
constexpr size_t WS_MK = WS_BIG + 101 * MiB;
constexpr size_t WS_MV = WS_BIG + 128 * MiB;
constexpr size_t WS_KR = WS_BIG + 146 * MiB;
constexpr size_t WS_SNAP = WS_BIG + 100 * MiB;
constexpr size_t WS_END = 256 * MiB;
static_assert(WS_KR + (size_t)MT * 32 * 4 <= WS_END, "ws map");
static_assert(WS_W_D1 + (size_t)D * FF * 2 <= WS_XRC, "ws map");
static_assert(WS_XN + (size_t)MT * D * 2 <= WS_BIG, "ws map");

__device__ __forceinline__ float bf2f(bf16_t u) { return __uint_as_float((unsigned)u << 16); }
__device__ __forceinline__ bf16_t f2bf(float f) { unsigned u = __float_as_uint(f); return (bf16_t)((u + 0x7fffu + ((u >> 16) & 1u)) >> 16); }
__device__ __forceinline__ int kvrow_of(int m) { return m < ML ? (m / S) * SK + CTX + (m % S) : ((m - ML) / CTX) * SK + ((m - ML) % CTX); }
__device__ __forceinline__ int modidx_of(int m) { return m < ML ? m / S : 8; }
__device__ __forceinline__ float wave_sum(float v) {
#pragma unroll
    for (int o = 1; o < 64; o <<= 1) v += __shfl_xor(v, o);
    return v;
}
__device__ __forceinline__ float wave_max(float v) {
#pragma unroll
    for (int o = 1; o < 64; o <<= 1) v = fmaxf(v, __shfl_xor(v, o));
    return v;
}

struct Params {
    const float* in[N_IN];
    float* out;
    unsigned char* ws;
};
namespace pg8 {
#define PG8_LAS __attribute__((address_space(3)))
typedef unsigned short bf16_t;
typedef short bf16x8 __attribute__((ext_vector_type(8)));
typedef float f32x4 __attribute__((ext_vector_type(4)));
typedef unsigned u32x4 __attribute__((ext_vector_type(4)));
constexpr int BM = 256, BK = 64, HALF = 128, HTB = HALF * BK * 2  , STAGE_BYTES = 8 * HTB, NXCD = 8, WGM = 8;

__host__ __device__ __forceinline__ int lds_byte(int r, int c) { const int st = (r >> 4) * 2 + (c >> 5), rr = r & 15, cc = c & 31, ob = rr * 64 + cc * 2; return st * 1024 + (ob ^ (((ob >> 9) & 1) << 5)); }
__host__ __device__ __forceinline__ void stage_rc(int b, int& R, int& C) { const int st = b / 1024, sb = b % 1024, swz = sb ^ (((sb >> 9) & 1) << 5); R = (st >> 1) * 16 + swz / 64; C = (st & 1) * 32 + (swz % 64) / 2; }
__host__ __device__ __forceinline__ int perm32(int rho) { const int n = rho >> 4, i = rho & 15; return 8 * (i >> 2) + 4 * n + (i & 3); }

struct Unit { int pm, pn; };
struct Gemm { const bf16_t* A; const bf16_t* Bt; int M, N, K; };

struct StaticOrder {
    int nM, nN, nwg, G, c;
    __host__ __device__ void init(int M, int N, int G_, int c_) { nM = M / BM; nN = N / BM; nwg = nM * nN; G = G_; c = c_; }
    __host__ __device__ bool next(int i, Unit& u) const {
        const long L = (long)i * G + c; if (L >= nwg) return false;
        int wgid = (int)L; { const int q = nwg / NXCD, r = nwg % NXCD, xcd = wgid % NXCD, off = wgid / NXCD; wgid = (xcd < r ? xcd * (q + 1) : r * (q + 1) + (xcd - r) * q) + off; }
        const int nig = WGM * nN, gid = wgid / nig, fm = gid * WGM, gsz = (nM - fm) < WGM ? (nM - fm) : WGM;
        u.pm = fm + ((wgid % nig) % gsz); u.pn = (wgid % nig) / gsz; return true;
    }
    __device__ __forceinline__ void a_ready(const Unit&) const {}
    __device__ __forceinline__ void done(const Unit&) const {}
};

__device__ __forceinline__ unsigned cvt_pk_bf16(float lo, float hi) { unsigned r; asm volatile("v_cvt_pk_bf16_f32 %0, %1, %2" : "=v"(r) : "v"(lo), "v"(hi)); return r; }
typedef float f32x2 __attribute__((ext_vector_type(2)));
template <class Epi, class Sched, bool ALIGN_EPI = false, bool SP2 = false>
__device__ __forceinline__ void gemm_phase(PG8_LAS unsigned char* lds, const Gemm g, const Sched& S, const Epi& E) {
    int tid_ = threadIdx.x; asm volatile("" : "+v"(tid_));
    const int tid = tid_, wid = __builtin_amdgcn_readfirstlane(tid >> 6), lane = tid & 63, wr = wid >> 2, wc = wid & 3, fr = lane & 15, fq = lane >> 4;
    int K_ = g.K; asm volatile("" : "+s"(K_));
    const int K = K_, nt = K / BK;
    unsigned voffA[2], voffB[2];
#pragma unroll
    for (int i = 0; i < 2; ++i) { int R, C; stage_rc(tid * 16 + i * 8192, R, C); const int Rb = Epi::PERM ? ((R & ~31) + perm32(R & 31)) : R;
        voffA[i] = (unsigned)(R * K + C) * 2u; voffB[i] = (unsigned)(Rb * K + C) * 2u; }
    const size_t kstep = (size_t)(BK * 2);
    const size_t hstep = (size_t)HALF * K * 2;
    const size_t tstep = 2 * hstep;
    const unsigned ldsw = (unsigned)wid * 1024u;
    const int aoff = lds_byte(wr * 64 + fr, fq * 8), boff = lds_byte(wc * 32 + fr, fq * 8);
#define PG8_SA(b, h) (((b) * 2 + (h)) * HTB)
#define PG8_SB(b, h) ((4 + (b) * 2 + (h)) * HTB)
#define PG8_STAGE(bufoff, gbase, voff) do { _Pragma("unroll") for (int _i = 0; _i < 2; ++_i) \
        __builtin_amdgcn_global_load_lds((const unsigned*)((const char*)(gbase) + (voff)[_i]), (PG8_LAS unsigned*)(lds + (bufoff) + ldsw + _i * 8192), 16, 0, 0); } while (0)
#define PG8_LDA(dst, b, h) do { _Pragma("unroll") for (int m = 0; m < 4; ++m) _Pragma("unroll") for (int k = 0; k < 2; ++k) dst[m][k] = *(const PG8_LAS bf16x8*)(lds + PG8_SA(b, h) + aoff + m * 2048 + k * 1024); } while (0)
#define PG8_LDB(dst, b, h) do { _Pragma("unroll") for (int n = 0; n < 2; ++n) _Pragma("unroll") for (int k = 0; k < 2; ++k) dst[n][k] = *(const PG8_LAS bf16x8*)(lds + PG8_SB(b, h) + boff + n * 2048 + k * 1024); } while (0)
#define PG8_MMA(ai, bj, At, Bt) do { __builtin_amdgcn_s_setprio(1); _Pragma("unroll") for (int m = 0; m < 4; ++m) _Pragma("unroll") for (int n = 0; n < 2; ++n) _Pragma("unroll") for (int k = 0; k < 2; ++k) \
        acc[ai][bj][m][n] = __builtin_amdgcn_mfma_f32_16x16x32_bf16(Bt[n][k], At[m][k], acc[ai][bj][m][n], 0, 0, 0); __builtin_amdgcn_s_setprio(0); } while (0)
#define PG8_WAIT_V(n) asm volatile("s_waitcnt vmcnt(" #n ")" ::: "memory")
#define PG8_WAIT_L(n) asm volatile("s_waitcnt lgkmcnt(" #n ")" ::: "memory")
#define PG8_BAR __builtin_amdgcn_s_barrier()
#define PG8_SCHED __builtin_amdgcn_sched_barrier(0)
    Unit cur, nxt; int ui = 0;
    if (!S.next(0, cur)) return;
    f32x4 acc[2][2][4][2];
#pragma unroll
    for (int a = 0; a < 2; ++a)
#pragma unroll
        for (int b = 0; b < 2; ++b)
#pragma unroll
            for (int m = 0; m < 4; ++m)
#pragma unroll
                for (int n = 0; n < 2; ++n) acc[a][b][m][n] = (f32x4){0.f, 0.f, 0.f, 0.f};
    bf16x8 At[4][2], B0[2][2], B1[2][2];
    const char* cA = (const char*)g.A + (size_t)cur.pm * tstep; const char* cB = (const char*)g.Bt + (size_t)cur.pn * tstep;
    S.a_ready(cur);
    if constexpr (SP2) {
        PG8_STAGE(PG8_SB(0, 0), cB, voffB); PG8_STAGE(PG8_SB(0, 1), cB + hstep, voffB); PG8_STAGE(PG8_SA(0, 0), cA, voffA); PG8_STAGE(PG8_SA(0, 1), cA + hstep, voffA);
        if (wr == 1) PG8_BAR;
        PG8_WAIT_V(2); PG8_BAR;
        PG8_STAGE(PG8_SB(1, 0), cB + kstep, voffB); PG8_STAGE(PG8_SA(1, 0), cA + kstep, voffA); PG8_STAGE(PG8_SB(1, 1), cB + hstep + kstep, voffB);
        PG8_WAIT_V(6); PG8_BAR;
    } else {
        PG8_STAGE(PG8_SB(0, 0), cB, voffB); PG8_STAGE(PG8_SA(0, 0), cA, voffA); PG8_STAGE(PG8_SB(0, 1), cB + hstep, voffB); PG8_STAGE(PG8_SA(0, 1), cA + hstep, voffA);
        if (wr == 1) PG8_BAR;
        PG8_WAIT_V(4); PG8_BAR;
        PG8_STAGE(PG8_SB(1, 0), cB + kstep, voffB); PG8_STAGE(PG8_SA(1, 0), cA + kstep, voffA); PG8_STAGE(PG8_SB(1, 1), cB + hstep + kstep, voffB);
        PG8_WAIT_V(6); PG8_BAR;
    }
    for (;;) {
        const bool has_next = S.next(ui + 1, nxt);
        const char* nA = has_next ? (const char*)g.A + (size_t)nxt.pm * tstep : cA; const char* nB = has_next ? (const char*)g.Bt + (size_t)nxt.pn * tstep : cB;
        for (int t = 0; t < nt; t += 2) {
            const bool last = (t == nt - 2);
            const char* a1 = cA + (size_t)(t + 1) * kstep;
            const char* a2 = last ? nA : cA + (size_t)(t + 2) * kstep; const char* b2 = last ? nB : cB + (size_t)(t + 2) * kstep;
            const char* a3 = a2 + kstep; const char* b3 = b2 + kstep;
            if (last && has_next) S.a_ready(nxt);
            if constexpr (SP2) {
            PG8_LDB(B0, 0, 0); PG8_LDB(B1, 0, 1); PG8_SCHED; PG8_LDA(At, 0, 0); PG8_STAGE(PG8_SA(1, 1), a1 + hstep, voffA);
            PG8_WAIT_V(8); PG8_WAIT_L(0); PG8_BAR; PG8_MMA(0, 0, At, B0); PG8_MMA(0, 1, At, B1); PG8_BAR; PG8_SCHED;
            PG8_LDA(At, 0, 1); PG8_STAGE(PG8_SB(0, 0), b2, voffB); PG8_STAGE(PG8_SB(0, 1), b2 + hstep, voffB); PG8_STAGE(PG8_SA(0, 0), a2, voffA);
            PG8_WAIT_V(8); PG8_WAIT_L(0); PG8_BAR; PG8_MMA(1, 0, At, B0); PG8_MMA(1, 1, At, B1); PG8_BAR; PG8_SCHED;
            PG8_LDB(B0, 1, 0); PG8_LDB(B1, 1, 1); PG8_SCHED; PG8_LDA(At, 1, 0); PG8_STAGE(PG8_SA(0, 1), a2 + hstep, voffA);
            PG8_WAIT_V(8); PG8_WAIT_L(0); PG8_BAR; PG8_MMA(0, 0, At, B0); PG8_MMA(0, 1, At, B1); PG8_BAR; PG8_SCHED;
            PG8_LDA(At, 1, 1); PG8_STAGE(PG8_SB(1, 0), b3, voffB); PG8_STAGE(PG8_SB(1, 1), b3 + hstep, voffB); PG8_STAGE(PG8_SA(1, 0), a3, voffA);
            PG8_WAIT_V(8); PG8_WAIT_L(0); PG8_BAR; PG8_MMA(1, 0, At, B0); PG8_MMA(1, 1, At, B1); PG8_BAR; PG8_SCHED;
            } else {
            PG8_LDB(B0, 0, 0); PG8_SCHED; PG8_LDA(At, 0, 0); PG8_STAGE(PG8_SA(1, 1), a1 + hstep, voffA);
            PG8_WAIT_L(8); PG8_BAR; PG8_WAIT_L(0); PG8_MMA(0, 0, At, B0); PG8_BAR; PG8_SCHED;
            PG8_LDB(B1, 0, 1); PG8_STAGE(PG8_SB(0, 0), b2, voffB);
            PG8_BAR; PG8_WAIT_L(0); PG8_MMA(0, 1, At, B1); PG8_BAR;
            PG8_LDA(At, 0, 1); PG8_STAGE(PG8_SA(0, 0), a2, voffA);
            PG8_BAR; PG8_WAIT_L(0); PG8_MMA(1, 0, At, B0); PG8_BAR; PG8_SCHED;
            PG8_STAGE(PG8_SB(0, 1), b2 + hstep, voffB);
            PG8_WAIT_V(6); PG8_BAR; PG8_MMA(1, 1, At, B1); PG8_BAR;
            PG8_LDB(B0, 1, 0); PG8_SCHED; PG8_LDA(At, 1, 0); PG8_STAGE(PG8_SA(0, 1), a2 + hstep, voffA);
            PG8_WAIT_L(8); PG8_BAR; PG8_WAIT_L(0); PG8_MMA(0, 0, At, B0); PG8_BAR; PG8_SCHED;
            PG8_LDB(B1, 1, 1); PG8_STAGE(PG8_SB(1, 0), b3, voffB);
            PG8_BAR; PG8_WAIT_L(0); PG8_MMA(0, 1, At, B1); PG8_BAR;
            PG8_LDA(At, 1, 1); PG8_STAGE(PG8_SA(1, 0), a3, voffA);
            PG8_BAR; PG8_WAIT_L(0); PG8_MMA(1, 0, At, B0); PG8_BAR; PG8_SCHED;
            PG8_STAGE(PG8_SB(1, 1), b3 + hstep, voffB);
            PG8_WAIT_V(6); PG8_BAR; PG8_MMA(1, 1, At, B1); PG8_BAR;
            }
        }
        if constexpr (ALIGN_EPI) { if (wr == 0) PG8_BAR; }
        if constexpr (!Epi::AFTER_DRAIN) { E(acc, cur, wr, wc, fr, fq); S.done(cur); }
        if (!has_next) break;
#pragma unroll
        for (int a = 0; a < 2; ++a)
#pragma unroll
            for (int b = 0; b < 2; ++b)
#pragma unroll
                for (int m = 0; m < 4; ++m)
#pragma unroll
                    for (int n = 0; n < 2; ++n) acc[a][b][m][n] = (f32x4){0.f, 0.f, 0.f, 0.f};
        cur = nxt; cA = nA; cB = nB; ++ui;
        if constexpr (ALIGN_EPI) { if (wr == 1) PG8_BAR; }
    }
    PG8_WAIT_V(0);
    if constexpr (!ALIGN_EPI) { if (wr == 0) PG8_BAR; }
    PG8_BAR;
    if constexpr (Epi::AFTER_DRAIN) { E.fused(acc, cur, wr, wc, fr, fq, lds, wid, lane); S.done(cur); }
#undef PG8_SA
#undef PG8_SB
#undef PG8_STAGE
#undef PG8_LDA
#undef PG8_LDB
#undef PG8_MMA
#undef PG8_WAIT_V
#undef PG8_WAIT_L
#undef PG8_BAR
#undef PG8_SCHED
}
}
namespace epi {
using pg8::f32x4; using pg8::Unit;
typedef unsigned u32x2 __attribute__((ext_vector_type(2)));
typedef unsigned u32x4 __attribute__((ext_vector_type(4)));
typedef float f32x2 __attribute__((ext_vector_type(2)));
typedef __bf16 bf16x2_t __attribute__((ext_vector_type(2)));
__device__ __forceinline__ unsigned pk(float lo, float hi) { f32x2 v = {lo, hi}; bf16x2_t b = __builtin_convertvector(v, bf16x2_t); return __builtin_bit_cast(unsigned, b); }
__device__ __forceinline__ u32x2 pk4(f32x4 v) { u32x2 w; w.x = pk(v[0], v[1]); w.y = pk(v[2], v[3]); return w; }
__device__ __forceinline__ float sum4sq(f32x4 v) { return (v[0] * v[0] + v[1] * v[1]) + (v[2] * v[2] + v[3] * v[3]); }
__device__ __forceinline__ float quad_sum(float s) { s += __shfl_xor(s, 16); s += __shfl_xor(s, 32); return s; }

__device__ __forceinline__ int kvbase_of(int pm) { return pm < 64 ? (pm >> 3) * SK + CTX + (pm & 7) * 256 : (pm - 64) * SK; }
__device__ __forceinline__ int modidx_pm(int pm) { return pm < 64 ? (pm >> 3) : 8; }

__device__ __forceinline__ void head_finish(f32x4 (&v)[2][2], const float* gain, bool rope, const float* T32, int grow, int gcol, float scale, int fq) {
    float ss = (sum4sq(v[0][0]) + sum4sq(v[0][1])) + (sum4sq(v[1][0]) + sum4sq(v[1][1]));
    ss = quad_sum(ss);
    const float rn = rsqrtf(ss * (1.f / 64.f) + EPS);
#pragma unroll
    for (int bj = 0; bj < 2; ++bj)
#pragma unroll
        for (int n = 0; n < 2; ++n) { const f32x4 g = *(const f32x4*)(gain + 32 * bj + 16 * n + 4 * fq); v[bj][n] = (v[bj][n] * rn) * g; }
    if (rope) {
#pragma unroll
        for (int bj = 0; bj < 2; ++bj) { const int pos = bj ? gcol : grow;
            const f32x4 cs = *(const f32x4*)(T32 + pos * 16 + 4 * fq), sn = *(const f32x4*)(T32 + 1024 + pos * 16 + 4 * fq);
            const f32x4 x1 = v[bj][0], x2 = v[bj][1];
            v[bj][0] = x1 * cs - x2 * sn; v[bj][1] = x1 * sn + x2 * cs; }
    }
#pragma unroll
    for (int bj = 0; bj < 2; ++bj)
#pragma unroll
        for (int n = 0; n < 2; ++n) v[bj][n] = v[bj][n] * scale;
}

struct EpiIn0 {
    static constexpr bool PERM = false, AFTER_DRAIN = false;
    bf16_t *A0, *Q0, *K0, *V0; const float *qg, *kg, *T32;
    __device__ __forceinline__ void operator()(const f32x4 (&acc)[2][2][4][2], const Unit& u, int wr, int wc, int fr_in, int fq_in) const {
        int fr = fr_in, fq = fq_in; asm volatile("" : "+v"(fr), "+v"(fq));
        const int pn = u.pn, pm = u.pm; const bool lat = pm < 64; const int kvb = kvbase_of(pm);
#pragma unroll
        for (int ai = 0; ai < 2; ++ai)
#pragma unroll
            for (int m = 0; m < 4; ++m) {
                const int rl = 128 * ai + 64 * wr + 16 * m + fr; const size_t r = (size_t)pm * 256 + rl;
                if (pn == 0 || pn == 5) {
                    bf16_t* dst = pn == 0 ? A0 + r * 256 : V0 + (size_t)(kvb + rl) * 256;
#pragma unroll
                    for (int bj = 0; bj < 2; ++bj)
#pragma unroll
                        for (int n = 0; n < 2; ++n) *(u32x2*)(dst + 64 * wc + 32 * bj + 16 * n + 4 * fq) = pk4(acc[ai][bj][m][n]);
                } else {
                    f32x4 v[2][2] = {{acc[ai][0][m][0], acc[ai][0][m][1]}, {acc[ai][1][m][0], acc[ai][1][m][1]}};
                    const int grow = (pm & 7) * 4 + 2 * ai + wr, gcol = 16 * m + fr;
                    bf16_t* dst;
                    if (pn < 4) { head_finish(v, qg, lat, T32, grow, gcol, C2_64, fq); dst = Q0 + r * 768 + ((pn - 1) * 4 + wc) * 64; }
                    else { head_finish(v, kg, lat, T32, grow, gcol, 1.0f, fq); dst = K0 + (size_t)(kvb + rl) * 256 + wc * 64; }
#pragma unroll
                    for (int bj = 0; bj < 2; ++bj)
#pragma unroll
                        for (int n = 0; n < 2; ++n) *(u32x2*)(dst + 32 * bj + 16 * n + 4 * fq) = pk4(v[bj][n]);
                }
            }
    }
};

struct EpiResid {
    static constexpr bool PERM = false, AFTER_DRAIN = false;
    const float *base_l, *base_c; float *out_l, *out_c; const float* mod;
    __device__ __forceinline__ void operator()(const f32x4 (&acc)[2][2][4][2], const Unit& u, int wr, int wc, int fr_in, int fq_in) const {
        int fr = fr_in, fq = fq_in; asm volatile("" : "+v"(fr), "+v"(fq));
        const int pm = u.pm; const bool lat = pm < 64;
        const float* bp = lat ? base_l + (size_t)pm * 256 * D : base_c + (size_t)(pm - 64) * 256 * D;
        float* op = lat ? out_l + (size_t)pm * 256 * D : out_c + (size_t)(pm - 64) * 256 * D;
        const float* gp = mod + (size_t)modidx_pm(pm) * 6144 + u.pn * 256 + 32 * wc + 4 * fq;
        f32x4 g[2][2];
#pragma unroll
        for (int bj = 0; bj < 2; ++bj)
#pragma unroll
            for (int n = 0; n < 2; ++n) g[bj][n] = *(const f32x4*)(gp + 128 * bj + 16 * n);
#pragma unroll
        for (int ai = 0; ai < 2; ++ai)
#pragma unroll
            for (int m = 0; m < 4; ++m) { const size_t off = (size_t)(128 * ai + 64 * wr + 16 * m + fr) * D + u.pn * 256 + 32 * wc + 4 * fq;
#pragma unroll
                for (int bj = 0; bj < 2; ++bj)
#pragma unroll
                    for (int n = 0; n < 2; ++n) { const f32x4 b = *(const f32x4*)(bp + off + 128 * bj + 16 * n); *(f32x4*)(op + off + 128 * bj + 16 * n) = b + g[bj][n] * acc[ai][bj][m][n]; } }
    }
};

struct EpiSwiGLU {
    static constexpr bool PERM = true, AFTER_DRAIN = false;
    bf16_t* H;
    __device__ __forceinline__ void operator()(const f32x4 (&acc)[2][2][4][2], const Unit& u, int wr, int wc, int fr_in, int fq_in) const {
        int fr = fr_in, fq = fq_in; asm volatile("" : "+v"(fr), "+v"(fq));
#pragma unroll
        for (int ai = 0; ai < 2; ++ai)
#pragma unroll
            for (int m = 0; m < 4; ++m) { const size_t r = (size_t)u.pm * 256 + 128 * ai + 64 * wr + 16 * m + fr;
                f32x4 h[2];
#pragma unroll
                for (int n = 0; n < 2; ++n) { const f32x4 g = acc[ai][0][m][n], up = acc[ai][1][m][n];
#pragma unroll
                    for (int e = 0; e < 4; ++e) h[n][e] = g[e] * __builtin_amdgcn_rcpf(1.f + __builtin_amdgcn_exp2f(-g[e] * LOG2E)) * up[e]; }
                u32x4 w; w.x = pk(h[0][0], h[0][1]); w.y = pk(h[0][2], h[0][3]); w.z = pk(h[1][0], h[1][1]); w.w = pk(h[1][2], h[1][3]);
                *(u32x4*)(H + r * FF + u.pn * 128 + 32 * wc + 8 * fq) = w; }
    }
};

struct EpiIn1 {
    static constexpr bool PERM = false, AFTER_DRAIN = false;
    bf16_t *CQ, *CKV, *NQ, *NK, *NV; float *KR, *SSQ, *SSKV; const float *nqg, *nkg;
    __device__ __forceinline__ void operator()(const f32x4 (&acc)[2][2][4][2], const Unit& u, int wr, int wc, int fr_in, int fq_in) const {
        int fr = fr_in, fq = fq_in; asm volatile("" : "+v"(fr), "+v"(fq));
        const int pn = u.pn, pm = u.pm; const int kvb = kvbase_of(pm);
#pragma unroll
        for (int ai = 0; ai < 2; ++ai)
#pragma unroll
            for (int m = 0; m < 4; ++m) {
                const int rl = 128 * ai + 64 * wr + 16 * m + fr; const size_t r = (size_t)pm * 256 + rl;
                if (pn == 0 || pn == 2) {
                    bf16_t* dst = pn == 0 ? CQ + r * 384 : CKV + r * 256; float ss = 0.f;
#pragma unroll
                    for (int bj = 0; bj < 2; ++bj)
#pragma unroll
                        for (int n = 0; n < 2; ++n) { ss += sum4sq(acc[ai][bj][m][n]); *(u32x2*)(dst + 128 * bj + 32 * wc + 16 * n + 4 * fq) = pk4(acc[ai][bj][m][n]); }
                    ss = quad_sum(ss);
                    if (fq == 0) atomicAdd((pn == 0 ? SSQ : SSKV) + r, ss);
                } else if (pn == 1) {
                    float ss = 0.f;
#pragma unroll
                    for (int n = 0; n < 2; ++n) { ss += sum4sq(acc[ai][0][m][n]); *(u32x2*)(CQ + r * 384 + 256 + 32 * wc + 16 * n + 4 * fq) = pk4(acc[ai][0][m][n]); }
                    ss = quad_sum(ss);
                    if (fq == 0) atomicAdd(SSQ + r, ss);
                    if (wc == 0) {
#pragma unroll
                        for (int n = 0; n < 2; ++n) *(f32x4*)(KR + r * 32 + 16 * n + 4 * fq) = acc[ai][1][m][n]; }
                } else if (pn >= 7) {
                    bf16_t* dst = NV + (size_t)(kvb + rl) * 512 + (pn - 7) * 256 + 64 * wc;
#pragma unroll
                    for (int bj = 0; bj < 2; ++bj)
#pragma unroll
                        for (int n = 0; n < 2; ++n) *(u32x2*)(dst + 32 * bj + 16 * n + 4 * fq) = pk4(acc[ai][bj][m][n]);
                } else {
                    f32x4 v[2][2] = {{acc[ai][0][m][0], acc[ai][0][m][1]}, {acc[ai][1][m][0], acc[ai][1][m][1]}};
                    bf16_t* dst;
                    if (pn < 5) { head_finish(v, nqg, false, nullptr, 0, 0, C2_64, fq); dst = NQ + r * 512 + ((pn - 3) * 4 + wc) * 64; }
                    else { head_finish(v, nkg, false, nullptr, 0, 0, 1.0f, fq); dst = NK + (size_t)(kvb + rl) * 512 + ((pn - 5) * 4 + wc) * 64; }
#pragma unroll
                    for (int bj = 0; bj < 2; ++bj)
#pragma unroll
                        for (int n = 0; n < 2; ++n) *(u32x2*)(dst + 32 * bj + 16 * n + 4 * fq) = pk4(v[bj][n]);
                }
            }
    }
};

struct EpiQUp {
    static constexpr bool PERM = true, AFTER_DRAIN = false;
    bf16_t* MQ; const float* SSQ;
    __device__ __forceinline__ void operator()(const f32x4 (&acc)[2][2][4][2], const Unit& u, int wr, int wc, int fr_in, int fq_in) const {
        int fr = fr_in, fq = fq_in; asm volatile("" : "+v"(fr), "+v"(fq));
#pragma unroll
        for (int ai = 0; ai < 2; ++ai)
#pragma unroll
            for (int m = 0; m < 4; ++m) { const size_t r = (size_t)u.pm * 256 + 128 * ai + 64 * wr + 16 * m + fr;
                const float rs = rsqrtf(SSQ[r] * (1.f / 384.f) + EPS);
#pragma unroll
                for (int bj = 0; bj < 2; ++bj) { const f32x4 a = acc[ai][bj][m][0] * rs, b = acc[ai][bj][m][1] * rs;
                    u32x4 w; w.x = pk(a[0], a[1]); w.y = pk(a[2], a[3]); w.z = pk(b[0], b[1]); w.w = pk(b[2], b[3]);
                    *(u32x4*)(MQ + r * 768 + u.pn * 256 + 128 * bj + 32 * wc + 8 * fq) = w; } }
    }
};

struct EpiKvUp {
    static constexpr bool PERM = false, AFTER_DRAIN = false;
    bf16_t *MK, *MV; const float *SSKV, *KR, *kg, *T16;
    __device__ __forceinline__ void operator()(const f32x4 (&acc)[2][2][4][2], const Unit& u, int wr, int wc, int fr_in, int fq_in) const {
        int fr = fr_in, fq = fq_in; asm volatile("" : "+v"(fr), "+v"(fq));
        const int pm = u.pm; const bool lat = pm < 64; const int kvb = kvbase_of(pm); const int head = 2 * u.pn + (wc >> 1); const bool isv = wc & 1;
#pragma unroll
        for (int ai = 0; ai < 2; ++ai)
#pragma unroll
            for (int m = 0; m < 4; ++m) {
                const int rl = 128 * ai + 64 * wr + 16 * m + fr; const size_t r = (size_t)pm * 256 + rl; const size_t kvr = (size_t)(kvb + rl);
                const float rs = rsqrtf(SSKV[r] * (1.f / 256.f) + EPS);
                f32x4 v[2][2];
#pragma unroll
                for (int bj = 0; bj < 2; ++bj)
#pragma unroll
                    for (int n = 0; n < 2; ++n) v[bj][n] = acc[ai][bj][m][n] * rs;
                if (isv) {
#pragma unroll
                    for (int bj = 0; bj < 2; ++bj)
#pragma unroll
                        for (int n = 0; n < 2; ++n) *(u32x2*)(MV + kvr * 512 + head * 64 + 32 * bj + 16 * n + 4 * fq) = pk4(v[bj][n]);
                } else {
                    f32x2 k[4];
#pragma unroll
                    for (int j = 0; j < 4; ++j) k[j] = *(const f32x2*)(KR + r * 32 + 8 * j + 2 * fq);
                    float ss = (sum4sq(v[0][0]) + sum4sq(v[0][1])) + (sum4sq(v[1][0]) + sum4sq(v[1][1]));
#pragma unroll
                    for (int j = 0; j < 4; ++j) ss += k[j][0] * k[j][0] + k[j][1] * k[j][1];
                    ss = quad_sum(ss);
                    const float rr = rsqrtf(ss * (1.f / 96.f) + EPS);
#pragma unroll
                    for (int bj = 0; bj < 2; ++bj)
#pragma unroll
                        for (int n = 0; n < 2; ++n) { const f32x4 g = *(const f32x4*)(kg + 32 * bj + 16 * n + 4 * fq);
                            *(u32x2*)(MK + kvr * 768 + head * 96 + 32 * bj + 16 * n + 4 * fq) = pk4((v[bj][n] * rr) * g); }
#pragma unroll
                    for (int j = 0; j < 4; ++j) { const f32x2 g = *(const f32x2*)(kg + 64 + 8 * j + 2 * fq); k[j] = (k[j] * rr) * g; }
                    if (lat) {
                        const int grow = (pm & 7) * 4 + 2 * ai + wr, gcol = 16 * m + fr;
#pragma unroll
                        for (int part = 0; part < 2; ++part) { const int pos = part ? gcol : grow;
                            const f32x2 cs = *(const f32x2*)(T16 + pos * 8 + 2 * fq), sn = *(const f32x2*)(T16 + 512 + pos * 8 + 2 * fq);
                            const f32x2 x1 = k[2 * part], x2 = k[2 * part + 1];
                            k[2 * part] = x1 * cs - x2 * sn; k[2 * part + 1] = x1 * sn + x2 * cs; }
                    }
#pragma unroll
                    for (int j = 0; j < 4; ++j) *(unsigned*)(MK + kvr * 768 + head * 96 + 64 + 8 * j + 2 * fq) = pk(k[j][0], k[j][1]);
                }
                asm volatile("" ::: "memory");
            }
    }
};
}
namespace att {
using bf16x8 = __attribute__((ext_vector_type(8))) short;
using s16x4 = __attribute__((ext_vector_type(4))) short;
using f32x16 = __attribute__((ext_vector_type(16))) float;
using u32x4 = __attribute__((ext_vector_type(4))) unsigned;
typedef float f32x2_t __attribute__((ext_vector_type(2))); typedef __bf16 bf16x2_t __attribute__((ext_vector_type(2)));
#define ALAS __attribute__((address_space(3)))
constexpr int KSLOT = 12288, VSLOT = 8192, SLOT = KSLOT + VSLOT, NSLOT = 3;
constexpr int LDS_WS = NSLOT * SLOT;
constexpr int LDS_OST = LDS_WS + 8 * 256;
constexpr int LDS_RPB = LDS_OST + 8 * 4096;
constexpr int LDS_BYTES = LDS_RPB + 2048;
constexpr float THR = 8.0f;

__device__ __forceinline__ int crow(int r, int hi) { return (r & 3) + 8 * (r >> 2) + 4 * hi; }
__device__ __forceinline__ void glds16(const void* gsrc, unsigned lds_dst) { unsigned keep;
    asm volatile("s_mov_b32 %0, m0\n\ts_mov_b32 m0, %2\n\ts_nop 0\n\tglobal_load_lds_dwordx4 %1, off\n\ts_mov_b32 m0, %0" : "=&s"(keep) : "v"(gsrc), "s"(lds_dst) : "memory"); }
__device__ __forceinline__ unsigned cvtpk(float lo, float hi) { f32x2_t v = {lo, hi}; bf16x2_t b = __builtin_convertvector(v, bf16x2_t); return __builtin_bit_cast(unsigned, b); }
#define AWAIT_BAR(N) asm volatile("s_waitcnt vmcnt(" #N ") lgkmcnt(0)\n\ts_barrier" ::: "memory")

template <int ND0> __device__ __forceinline__ void qkt(f32x16& p0, f32x16& p1, const ALAS char* Kslot, const bf16x8* qr, int r32, int hi) {
    const ALAS char* kb = Kslot + hi * 1024 + r32 * 16;
    p0 = f32x16{}; p1 = f32x16{};
#pragma unroll
    for (int d0 = 0; d0 < ND0; ++d0) {
        const bf16x8 b0 = *(const ALAS bf16x8*)(kb + d0 * 2048);
        const bf16x8 b1 = *(const ALAS bf16x8*)(kb + d0 * 2048 + 512);
        p0 = __builtin_amdgcn_mfma_f32_32x32x16_bf16(b0, qr[d0], p0, 0, 0, 0);
        p1 = __builtin_amdgcn_mfma_f32_32x32x16_bf16(b1, qr[d0], p1, 0, 0, 0);
    }
}
__device__ __forceinline__ float rowmax32(const f32x16& p0, const f32x16& p1) {
    float a = fmaxf(p0[0], p1[0]);
#pragma unroll
    for (int r = 1; r < 16; ++r) a = fmaxf(a, fmaxf(p0[r], p1[r]));
    auto rr = __builtin_amdgcn_permlane32_swap(__float_as_uint(a), __float_as_uint(a), false, false);
    return fmaxf(__uint_as_float(rr[0]), __uint_as_float(rr[1]));
}
__device__ __forceinline__ void pv(f32x16* o, int vb, bf16x8 pa0, bf16x8 pa1, bf16x8 pa2, bf16x8 pa3) {
#pragma unroll
    for (int d0 = 0; d0 < 2; ++d0) { s16x4 lo[4], hi[4];
#pragma unroll
        for (int ks = 0; ks < 4; ++ks) {
            asm volatile("ds_read_b64_tr_b16 %0,%1 offset:%c2" : "=&v"(lo[ks]) : "v"(vb), "i"(d0 * 4096 + ks * 1024) : "memory");
            asm volatile("ds_read_b64_tr_b16 %0,%1 offset:%c2" : "=&v"(hi[ks]) : "v"(vb), "i"(d0 * 4096 + ks * 1024 + 512) : "memory"); }
        asm volatile("s_waitcnt lgkmcnt(0)" ::: "memory"); __builtin_amdgcn_sched_barrier(0);
#define APK(k) (bf16x8){lo[k][0], lo[k][1], lo[k][2], lo[k][3], hi[k][0], hi[k][1], hi[k][2], hi[k][3]}
        o[d0] = __builtin_amdgcn_mfma_f32_32x32x16_bf16(pa0, APK(0), o[d0], 0, 0, 0);
        o[d0] = __builtin_amdgcn_mfma_f32_32x32x16_bf16(pa1, APK(1), o[d0], 0, 0, 0);
        o[d0] = __builtin_amdgcn_mfma_f32_32x32x16_bf16(pa2, APK(2), o[d0], 0, 0, 0);
        o[d0] = __builtin_amdgcn_mfma_f32_32x32x16_bf16(pa3, APK(3), o[d0], 0, 0, 0);
#undef APK
    }
}

struct UnitDesc {
    const bf16_t* Q; int qpitch;
    long q0; int qcol;
    const bf16_t* K; int kpitch, kcol;
    const bf16_t* V; int vpitch, vcol;
    bf16_t* O; int opitch, ocol;
    int kv0;
    int nt;
    int rg;
    int rmin;
    int head;
};

template <int DQK, bool NA, bool MLAQ>
__device__ __forceinline__ void attn_unit(const UnitDesc& U, ALAS char* shm, const float* qgain, const float* T16, const float* rpb_g) {
    constexpr int ND0 = DQK / 16, NCH = DQK / 8, NP = NCH + 8;
    int tid_ = threadIdx.x; asm volatile("" : "+v"(tid_));
    const int tid = tid_, lane = tid & 63, r32 = lane & 31, hi = lane >> 5; const int wid = __builtin_amdgcn_readfirstlane(tid >> 6);
    const unsigned lds0 = (unsigned)(uintptr_t)shm;
    ALAS float* wsf = (ALAS float*)(shm + LDS_WS) + wid * 64;
    auto dma_tile = [&](int t, int slot) {
        int key0;
        if (NA && t >= 4) key0 = U.kv0 + CTX + (U.rmin + (t - 4)) * GW; else key0 = U.kv0 + 64 * t;
        const unsigned sbase = lds0 + slot * SLOT;
#pragma unroll
        for (int i = 0; i < 3; ++i) { const int pc = wid + 8 * i;
            if (pc < NP) {
                if (pc < NCH) glds16(U.K + (size_t)(key0 + lane) * U.kpitch + U.kcol + pc * 8, (unsigned)__builtin_amdgcn_readfirstlane(sbase + pc * 1024));
                else { const int v = pc - NCH; glds16(U.V + (size_t)(key0 + 16 * (v & 3) + (lane >> 2)) * U.vpitch + U.vcol + (v >> 2) * 32 + (lane & 3) * 8, (unsigned)__builtin_amdgcn_readfirstlane(sbase + KSLOT + v * 1024)); }
            } }
    };
    asm volatile("s_waitcnt vmcnt(0)" ::: "memory");
    dma_tile(0, 0); if (U.nt > 1) dma_tile(1, 1);
    if (NA) { ALAS float* tb = (ALAS float*)(shm + LDS_RPB); for (int i = tid; i < 15 * 31; i += 512) tb[i] = rpb_g[U.head * 465 + i] * LOG2E; }
    bf16x8 qr[ND0];
    const bf16_t* Qw = U.Q + (size_t)(U.q0 + wid * 32 + r32) * U.qpitch + U.qcol;
#pragma unroll
    for (int d0 = 0; d0 < ND0; ++d0) qr[d0] = *(const bf16x8*)(Qw + d0 * 16 + hi * 8);
    if (MLAQ) {
        float f[ND0][8]; float ss = 0.f;
#pragma unroll
        for (int d0 = 0; d0 < ND0; ++d0)
#pragma unroll
            for (int j = 0; j < 8; ++j) { f[d0][j] = bf2f((bf16_t)qr[d0][j]); ss += f[d0][j] * f[d0][j]; }
        ss += __shfl_xor(ss, 32);
        const float rn = rsqrtf(ss * (1.f / 96.f) + EPS) * C2_96;
#pragma unroll
        for (int d0 = 0; d0 < ND0; ++d0)
#pragma unroll
            for (int j = 0; j < 8; ++j) f[d0][j] = f[d0][j] * rn * qgain[d0 * 16 + hi * 8 + j];
        const int t = (int)((U.q0 + wid * 32 + r32) % S); const int grow = t / GW, gcol = t % GW;
#pragma unroll
        for (int part = 0; part < 2; ++part) { const int pos = part ? gcol : grow;
#pragma unroll
            for (int j = 0; j < 8; ++j) { const float cs = T16[pos * 8 + j], sn = T16[512 + pos * 8 + j];
                const float mine = f[4 + part][j], other = __shfl_xor(mine, 32);
                f[4 + part][j] = hi == 0 ? (mine * cs - other * sn) : (other * sn + mine * cs); } }
#pragma unroll
        for (int d0 = 0; d0 < ND0; ++d0)
#pragma unroll
            for (int j = 0; j < 4; ++j) { const unsigned w = cvtpk(f[d0][2 * j], f[d0][2 * j + 1]); qr[d0][2 * j] = (short)(w & 0xffff); qr[d0][2 * j + 1] = (short)(w >> 16); }
    }
    const int grow_w = NA ? 4 * U.rg + (wid >> 1) : 0, c0w = 32 * (wid & 1);
    const int r0w = NA ? min(max(grow_w - 4, 0), 24) : 0;
    const int qc = c0w + r32;
    const int cs_q = min(max(qc - 8, 0), 48);
    float mhat = -INFINITY, l_reg = 0.f; f32x16 o[2]; o[0] = f32x16{}; o[1] = f32x16{};
    const int vb0 = (int)(lds0 + KSLOT) + ((lane >> 4) & 1) * 32 + (lane & 3) * 8 + (4 * hi + ((lane & 15) >> 2)) * 64;
    int slot = 0;
    for (int t = 0; t < U.nt; ++t) {
        if (t + 1 < U.nt) { if (NP == 20 && wid < 4) AWAIT_BAR(3); else AWAIT_BAR(2); } else AWAIT_BAR(0);
        if (t + 2 < U.nt) { int s2 = slot + 2; if (s2 >= NSLOT) s2 -= NSLOT; dma_tile(t + 2, s2); }
        bool take = true; int krow = 0;
        if (NA && t >= 4) { krow = U.rmin + (t - 4); take = (krow >= r0w) && (krow < r0w + 8); }
        if (take) {
            f32x16 p0, p1;
            qkt<ND0>(p0, p1, shm + slot * SLOT, qr, r32, hi);
            if (NA && t >= 4) {
                const ALAS float* tb = (const ALAS float*)(shm + LDS_RPB) + (krow - grow_w + 7) * 31;
#pragma unroll
                for (int r = 0; r < 16; ++r) {
                    const int kc0 = crow(r, hi), kc1 = kc0 + 32;
                    { const int rel = kc0 - cs_q; const int bi = min(max(kc0 - qc + 15, 0), 30); const float bv = tb[bi]; p0[r] = ((unsigned)rel < 16u) ? p0[r] + bv : -INFINITY; }
                    { const int rel = kc1 - cs_q; const int bi = min(max(kc1 - qc + 15, 0), 30); const float bv = tb[bi]; p1[r] = ((unsigned)rel < 16u) ? p1[r] + bv : -INFINITY; }
                }
            }
            const float rm = rowmax32(p0, p1);
            if (__any(rm > mhat + THR)) {
                const float mnew = fmaxf(mhat, rm); const float f = __builtin_amdgcn_exp2f(mhat - mnew);
                l_reg *= f; mhat = mnew;
                if (hi == 0) wsf[r32] = f;
                asm volatile("s_waitcnt lgkmcnt(0)" ::: "memory");
#pragma unroll
                for (int r = 0; r < 16; ++r) { const float fr_ = wsf[crow(r, hi)]; o[0][r] *= fr_; o[1][r] *= fr_; }
            }
            float sacc = 0.f;
#pragma unroll
            for (int r = 0; r < 16; ++r) { p0[r] = __builtin_amdgcn_exp2f(p0[r] - mhat); p1[r] = __builtin_amdgcn_exp2f(p1[r] - mhat); sacc += p0[r] + p1[r]; }
            l_reg += sacc;
            u32x4 pw0, pw1, pw2, pw3;
#pragma unroll
            for (int j = 0; j < 4; ++j) { pw0[j] = cvtpk(p0[2 * j], p0[2 * j + 1]); pw1[j] = cvtpk(p0[8 + 2 * j], p0[9 + 2 * j]); pw2[j] = cvtpk(p1[2 * j], p1[2 * j + 1]); pw3[j] = cvtpk(p1[8 + 2 * j], p1[9 + 2 * j]); }
            pv(o, vb0 + slot * SLOT, __builtin_bit_cast(bf16x8, pw0), __builtin_bit_cast(bf16x8, pw1), __builtin_bit_cast(bf16x8, pw2), __builtin_bit_cast(bf16x8, pw3));
        }
        ++slot; if (slot >= NSLOT) slot = 0;
    }
    { auto rr = __builtin_amdgcn_permlane32_swap(__float_as_uint(l_reg), __float_as_uint(l_reg), false, false); l_reg = __uint_as_float(rr[0]) + __uint_as_float(rr[1]); }
    if (hi == 0) wsf[32 + r32] = l_reg;
    asm volatile("s_waitcnt lgkmcnt(0)" ::: "memory");
    float rli[16];
#pragma unroll
    for (int r = 0; r < 16; ++r) rli[r] = __builtin_amdgcn_rcpf(wsf[32 + crow(r, hi)]);
    bf16_t* Ow = U.O + (size_t)(U.q0 + wid * 32) * U.opitch + U.ocol;
    { ALAS bf16_t* stg = (ALAS bf16_t*)(shm + LDS_OST) + wid * 2048;
#pragma unroll
        for (int r = 0; r < 16; ++r) { const int orow = crow(r, hi);
#pragma unroll
            for (int d0 = 0; d0 < 2; ++d0) stg[orow * 64 + d0 * 32 + r32] = f2bf(o[d0][r] * rli[r]); }
        asm volatile("s_waitcnt lgkmcnt(0)" ::: "memory");
#pragma unroll
        for (int i = 0; i < 4; ++i) { const int row = i * 8 + (lane >> 3), ch = lane & 7; const u32x4 v = *(const ALAS u32x4*)(stg + row * 64 + ch * 8); *(u32x4*)(Ow + (size_t)row * U.opitch + ch * 8) = v; } }
    asm volatile("s_waitcnt vmcnt(0) lgkmcnt(0)\n\ts_barrier" ::: "memory");
}
}
#define LAS __attribute__((address_space(3)))
#define XB_TMO      128
#define XB_XCNT(j)  (256  + 64 * (j))
#define XB_XSUB(j)  (1280 + 64 * (j))
#define XB_XGEN(j)  (2304 + 64 * (j))
#define XB_TOP      3328
#define XB_TOPGEN   3392
#define XCD_BAR_WORDS 3456
#define XB_SPIN_CAP (1u << 18)

__device__ __forceinline__ unsigned xb_ld(unsigned* p)              { return __hip_atomic_load(p, __ATOMIC_RELAXED, __HIP_MEMORY_SCOPE_AGENT); }
__device__ __forceinline__ unsigned xb_add(unsigned* p, unsigned v) { return __hip_atomic_fetch_add(p, v, __ATOMIC_RELAXED, __HIP_MEMORY_SCOPE_AGENT); }
__device__ __forceinline__ unsigned xb_xcc_id() { return (unsigned)__builtin_amdgcn_s_getreg((3 << 11) | 20) & 0xFu; }
#define XB_SPIN(cond, bar) do { unsigned _sp = 0; while (cond) { __builtin_amdgcn_s_sleep(1); \
    if ((++_sp & 255u) == 0u) { if (xb_ld(&(bar)[XB_TMO])) break; if (_sp > XB_SPIN_CAP) { atomicAdd(&(bar)[XB_TMO], 1u); break; } } } } while (0)

struct XcdBarrier {
    unsigned* bar; unsigned x;
    volatile LAS unsigned* st;
};

__device__ __forceinline__ XcdBarrier xcd_barrier_post(unsigned* bar, volatile LAS unsigned* st) {
    XcdBarrier b; b.bar = bar; b.x = xb_xcc_id(); b.st = st;
    if (threadIdx.x == 0) (void)xb_add(&bar[XB_XCNT(b.x)], 1u);
    return b;
}
__device__ __forceinline__ void xcd_barrier_complete(unsigned* bar, unsigned x, unsigned& nloc, unsigned& nx) {
    const unsigned G = gridDim.x * gridDim.y * gridDim.z;
    unsigned sum, cnt, mine, sp = 0u;
    for (;;) {
        sum = 0u; cnt = 0u; mine = 0u;
#pragma unroll
        for (unsigned j = 0; j < 16; ++j) { const unsigned c = xb_ld(&bar[XB_XCNT(j)]); sum += c; cnt += (c > 0u) ? 1u : 0u; mine = (j == x) ? c : mine; }
        if (sum == G) break;
        __builtin_amdgcn_s_sleep(1);
        if ((++sp & 255u) == 0u) { if (xb_ld(&bar[XB_TMO])) break; if (sp > XB_SPIN_CAP) { atomicAdd(&bar[XB_TMO], 1u); break; } }
    }
    nloc = mine > 0u ? mine : 1u; nx = cnt > 0u ? cnt : 1u;
}

__device__ __forceinline__ void xcd_barrier(const XcdBarrier& b) {
    asm volatile("s_waitcnt vmcnt(0)" ::: "memory");
    __syncthreads();
    if (threadIdx.x == 0) {
        unsigned* bar = b.bar;
        __builtin_amdgcn_s_waitcnt(0);
        unsigned nloc = b.st[0], nx = b.st[1];
        if (nloc == 0u) { xcd_barrier_complete(bar, b.x, nloc, nx); b.st[0] = nloc; b.st[1] = nx; }
        const unsigned old = xb_add(&bar[XB_XSUB(b.x)], 1u);
        const unsigned gen = old / nloc;
        if (old + 1u == (gen + 1u) * nloc) {
            __builtin_amdgcn_fence(__ATOMIC_RELEASE, "agent");
            asm volatile("s_waitcnt vmcnt(0)" ::: "memory");
            const unsigned og = xb_add(&bar[XB_TOP], 1u);
            const unsigned tg = og / nx;
            if (og + 1u == (tg + 1u) * nx) xb_add(&bar[XB_TOPGEN], 1u);
            else XB_SPIN(xb_ld(&bar[XB_TOPGEN]) == tg, bar);
            __builtin_amdgcn_fence(__ATOMIC_ACQUIRE, "agent");
            xb_add(&bar[XB_XGEN(b.x)], 1u);
            asm volatile("s_waitcnt vmcnt(0)" ::: "memory");
        } else {
            XB_SPIN(xb_ld(&bar[XB_XGEN(b.x)]) == gen, bar);
            __builtin_amdgcn_fence(__ATOMIC_ACQUIRE, "agent");
            asm volatile("s_waitcnt vmcnt(0)" ::: "memory");
        }
    }
    __syncthreads();
}
namespace mk {
#define MLAS __attribute__((address_space(3)))
constexpr int NWAVES = 8, NTHR = 512;
constexpr int RING_BYTES = 131072;
constexpr int LDS_BYTES = 147456;
constexpr int NPHASE = 16;
typedef unsigned v4u __attribute__((ext_vector_type(4)));
typedef float f32x4 __attribute__((ext_vector_type(4)));

struct Ctx {
    Params p; MLAS unsigned char* lds; int tid, lane, wave, G, vcu, bid;
};
__device__ __forceinline__ unsigned pk2(float lo, float hi) { return (unsigned)f2bf(lo) | ((unsigned)f2bf(hi) << 16); }

enum { W_IN0 = 0, W_OUT0, W_GU0, W_D0, W_IN1, W_UQ, W_UKV, W_OUT1, W_GU1, W_D1, NWMAT };
struct SrcBlk { const float* W; int ld; int col; const float* kscale; };
__device__ __forceinline__ SrcBlk src_of(const Params& p, int mat, int nb) {
    SrcBlk s; s.kscale = nullptr; const int pn = nb >> 3, q = nb & 7, bj = q >> 2, wc = q & 3;
    switch (mat) {
    case W_IN0: s.W = p.in[I0_WIN]; s.ld = L0_IN; s.col = 256 * pn + 64 * wc + 32 * bj; break;
    case W_OUT0: s.W = p.in[I0_WOUT]; s.ld = D; s.col = 32 * nb; break;
    case W_GU0: s.W = bj ? p.in[I0_WU] : p.in[I0_WG]; s.ld = FF; s.col = 128 * pn + 32 * wc; break;
    case W_D0: s.W = p.in[I0_WD]; s.ld = D; s.col = 32 * nb; break;
    case W_IN1: s.W = p.in[I1_WIN]; s.ld = L1_IN;
        if (pn == 0) s.col = 128 * bj + 32 * wc;
        else if (pn == 1) { if (bj == 0) s.col = 256 + 32 * wc; else s.col = 640; }
        else if (pn == 2) s.col = 384 + 128 * bj + 32 * wc;
        else if (pn < 5) s.col = 672 + (pn - 3) * 256 + 64 * wc + 32 * bj;
        else if (pn < 7) s.col = 1184 + (pn - 5) * 256 + 64 * wc + 32 * bj;
        else s.col = 1696 + (pn - 7) * 256 + 64 * wc + 32 * bj;
        break;
    case W_UQ: s.W = p.in[I1_WUQ]; s.ld = 768; s.col = 32 * nb; s.kscale = p.in[I1_QAG]; break;
    case W_UKV: s.W = p.in[I1_WUKV]; s.ld = 1024; s.col = (2 * pn + (wc >> 1)) * 128 + (wc & 1) * 64 + 32 * bj; s.kscale = p.in[I1_KVAG]; break;
    case W_OUT1: s.W = p.in[I1_WOUT]; s.ld = D; s.col = 32 * nb; break;
    case W_GU1: s.W = bj ? p.in[I1_WU] : p.in[I1_WG]; s.ld = FF; s.col = 128 * pn + 32 * wc; break;
    default: s.W = p.in[I1_WD]; s.ld = D; s.col = 32 * nb; break;
    }
    return s;
}
struct WMat { size_t ws_off; int K, N; };
__host__ __device__ constexpr WMat wmat(int mat) {
    switch (mat) {
    case W_IN0: return {WS_W_IN0, D, 1536}; case W_OUT0: return {WS_W_OUT0, D, D}; case W_GU0: return {WS_W_GU0, D, 2 * FF}; case W_D0: return {WS_W_D0, FF, D};
    case W_IN1: return {WS_W_IN1, D, L1_INP}; case W_UQ: return {WS_W_UQ, 384, 768}; case W_UKV: return {WS_W_UKV, 256, 1024}; case W_OUT1: return {WS_W_OUT1, D, D};
    case W_GU1: return {WS_W_GU1, D, 2 * FF}; default: return {WS_W_D1, FF, D};
    }
}
template <int mat> __device__ __forceinline__ void transpose_item(const Params& p, int item, MLAS float* scr, int lane) {
    const WMat wm = wmat(mat); const int nblk = wm.N / 32, kb = item / nblk, nb = item % nblk, k0 = 64 * kb;
    const SrcBlk s = src_of(p, mat, nb);
    bf16_t* WT = (bf16_t*)(p.ws + wm.ws_off);
    const int c = lane & 7;
    if (s.W == nullptr) {
#pragma unroll
        for (int j = 0; j < 4; ++j) { const int n = (lane >> 3) + 8 * j; *(v4u*)(WT + (size_t)(32 * nb + n) * wm.K + k0 + 8 * c) = (v4u){0u, 0u, 0u, 0u}; }
        return;
    }
    MLAS float* t0 = scr; MLAS float* t1 = scr + 64 * 33;
    const bool fused_pool = (mat == W_OUT0 && kb < 4);
    const float* wsrc = s.W + (size_t)k0 * s.ld + s.col + (lane & 31);
#pragma unroll 8
    for (int i = 0; i < 32; ++i) { const int kk = 2 * i + (lane >> 5); t0[kk * 33 + (lane & 31)] = wsrc[(size_t)kk * s.ld]; }
    if (s.kscale) {
#pragma unroll 8
        for (int i = 0; i < 32; ++i) { const int kk = 2 * i + (lane >> 5); t0[kk * 33 + (lane & 31)] *= s.kscale[k0 + kk]; }
    }
    if (fused_pool) {
#pragma unroll 8
        for (int i = 0; i < 32; ++i) { const int kk = 2 * i + (lane >> 5); t0[kk * 33 + (lane & 31)] *= p.in[I0_POOLS][k0 + kk]; }
    }
    asm volatile("s_waitcnt lgkmcnt(0)" ::: "memory");
    MLAS float* src = t0;
    if (fused_pool) {
        const float* pw = p.in[I0_POOLW] + kb * 4096; const int nn = lane & 31, ch = lane >> 5;
        for (int cc = ch; cc < 64; cc += 2) { float a = 0.f;
#pragma unroll 8
            for (int d = 0; d < 64; ++d) a += pw[cc * 64 + d] * t0[d * 33 + nn];
            t1[cc * 33 + nn] = a; }
        asm volatile("s_waitcnt lgkmcnt(0)" ::: "memory");
        src = t1;
    }
#pragma unroll
    for (int j = 0; j < 4; ++j) { const int n = (lane >> 3) + 8 * j; const MLAS float* sp = src + (8 * c) * 33 + n;
        v4u o; o.x = pk2(sp[0 * 33], sp[1 * 33]); o.y = pk2(sp[2 * 33], sp[3 * 33]); o.z = pk2(sp[4 * 33], sp[5 * 33]); o.w = pk2(sp[6 * 33], sp[7 * 33]);
        *(v4u*)(WT + (size_t)(32 * nb + n) * wm.K + k0 + 8 * c) = o; }
    asm volatile("s_waitcnt lgkmcnt(0)" ::: "memory");
}

__device__ __forceinline__ void phase_prologue(Ctx& C) {
    const Params& p = C.p;
    MLAS float* sil = (MLAS float*)C.lds;
    MLAS float* red = (MLAS float*)(C.lds + 9 * 1024 * 4);
    for (int i = C.tid; i < 9 * D; i += NTHR) { const int j = i / D, k = i % D; const float c = (j < 8) ? p.in[I_C][j * D + k] : p.in[I_CCTX][k]; sil[i] = c / (1.f + expf(-c)); }
    __syncthreads();
    float* MOD = (float*)(p.ws + WS_MOD);
#ifndef P0MASK
#define P0MASK 15
#endif
    if (P0MASK & 1)
    for (int it = C.vcu; it < 192; it += C.G) {
        const int l = it / 96, n0 = (it % 96) * 64; const float* w = (l ? p.in[I1_ADAW] : p.in[I0_ADAW]) + n0 + C.lane;
        float acc[9];
#pragma unroll
        for (int j = 0; j < 9; ++j) acc[j] = 0.f;
        const int kb = C.wave * 128;
#pragma unroll 4
        for (int k = kb; k < kb + 128; ++k) { const float wv = w[(size_t)k * 6144];
#pragma unroll
            for (int j = 0; j < 9; ++j) acc[j] += sil[j * D + k] * wv; }
#pragma unroll
        for (int j = 0; j < 9; ++j) red[(C.wave * 9 + j) * 64 + C.lane] = acc[j];
        __syncthreads();
        for (int i = C.tid; i < 9 * 64; i += NTHR) { const int j = i / 64, c = i % 64; float s = 0.f;
#pragma unroll
            for (int wv = 0; wv < 8; ++wv) s += red[(wv * 9 + j) * 64 + c];
            MOD[(size_t)(l * 9 + j) * 6144 + n0 + c] = s + (l ? p.in[I1_ADAB] : p.in[I0_ADAB])[n0 + c]; }
        __syncthreads();
    }
    __syncthreads();
    const int gw = C.vcu * NWAVES + C.wave, NGW = C.G * NWAVES;
    MLAS float* scr = (MLAS float*)(C.lds + C.wave * 16896);
    if (P0MASK & 2) {
        int rot = 0;
#define TR_MAT(M) { constexpr int ni = (wmat(M).K / 64) * (wmat(M).N / 32); int first = gw - rot; if (first < 0) first += NGW; \
            for (int it = first; it < ni; it += NGW) transpose_item<M>(p, it, scr, C.lane); rot = (rot + ni) % NGW; }
        TR_MAT(W_IN0) TR_MAT(W_OUT0) TR_MAT(W_GU0) TR_MAT(W_D0) TR_MAT(W_IN1) TR_MAT(W_UQ) TR_MAT(W_UKV) TR_MAT(W_OUT1) TR_MAT(W_GU1) TR_MAT(W_D1)
#undef TR_MAT
    }
    if ((P0MASK & 4) && C.bid == C.G - 1) {
        float* T32 = (float*)(p.ws + WS_ROPE32); float* T16 = (float*)(p.ws + WS_ROPE16);
        for (int i = C.tid; i < 1024; i += NTHR) { const int pos = i >> 4, f = i & 15; const float ang = (float)pos * powf(10000.0f, -((float)f * 2.0f) / 32.0f); T32[i] = cosf(ang); T32[1024 + i] = sinf(ang); }
        for (int i = C.tid; i < 512; i += NTHR) { const int pos = i >> 3, f = i & 7; const float ang = (float)pos * powf(10000.0f, -((float)f * 2.0f) / 16.0f); T16[i] = cosf(ang); T16[512 + i] = sinf(ang); }
    }
    if (P0MASK & 8) { float* SSQ = (float*)(p.ws + WS_SSQ); float* SSKV = (float*)(p.ws + WS_SSKV);
        for (int i = C.bid * NTHR + C.tid; i < MT; i += C.G * NTHR) { SSQ[i] = 0.f; SSKV[i] = 0.f; } }
}

__device__ __forceinline__ void phase_norm(Ctx& C, const float* xl, const float* xc, const float* gain, int layer, int sh_chunk, int sc_chunk, int nrows) {
    const int gw = C.vcu * NWAVES + C.wave, NGW = C.G * NWAVES;
    bf16_t* XN = (bf16_t*)(C.p.ws + WS_XN); const float* MODb = (const float*)(C.p.ws + WS_MOD) + (size_t)layer * 9 * 6144;
    for (int m = gw; m < nrows; m += NGW) {
        const float* xr = m < ML ? xl + (size_t)m * D : xc + (size_t)(m - ML) * D;
        const float* mod = MODb + (size_t)modidx_of(m) * 6144;
        f32x4 v[4]; float ss = 0.f;
#pragma unroll
        for (int j = 0; j < 4; ++j) { v[j] = *(const f32x4*)(xr + 4 * C.lane + 256 * j); ss += (v[j][0] * v[j][0] + v[j][1] * v[j][1]) + (v[j][2] * v[j][2] + v[j][3] * v[j][3]); }
        ss = wave_sum(ss);
        const float r = rsqrtf(ss * (1.f / D) + EPS);
#pragma unroll
        for (int j = 0; j < 4; ++j) { const int c = 4 * C.lane + 256 * j;
            const f32x4 g = *(const f32x4*)(gain + c), sc = *(const f32x4*)(mod + sc_chunk * D + c), sh = *(const f32x4*)(mod + sh_chunk * D + c);
            const f32x4 y = ((v[j] * r) * g) * (sc + 1.f) + sh;
            uint2 o; o.x = pk2(y[0], y[1]); o.y = pk2(y[2], y[3]);
            *(uint2*)(XN + (size_t)m * D + c) = o; }
    }
}

__device__ __forceinline__ void phase_pool(Ctx& C) {
    const bf16_t* A0 = (const bf16_t*)(C.p.ws + WS_A0); bf16_t* MIX = (bf16_t*)(C.p.ws + WS_MIX);
    const int gt = C.vcu * NTHR + C.tid, NGT = C.G * NTHR;
    for (int it = gt; it < MT * 32; it += NGT) {
        const int m = it >> 5, c8 = (it & 31) * 8, g = c8 >> 6, w = 2 << g;
        int t, T; if (m < ML) { t = m % S; T = S; } else { t = (m - ML) % CTX; T = CTX; }
        const int base = m - t; int lo = t - w / 2; if (lo < 0) lo = 0; int hi = t - w / 2 + w; if (hi > T) hi = T;
        float s[8];
#pragma unroll
        for (int e = 0; e < 8; ++e) s[e] = 0.f;
        for (int j = lo; j < hi; ++j) { const v4u q = *(const v4u*)(A0 + (size_t)(base + j) * 256 + c8);
#pragma unroll
            for (int e = 0; e < 4; ++e) { s[2 * e] += __uint_as_float(q[e] << 16); s[2 * e + 1] += __uint_as_float(q[e] & 0xffff0000u); } }
        const v4u q = *(const v4u*)(A0 + (size_t)m * 256 + c8); const float inv = 1.f / (float)(hi - lo);
        v4u o;
#pragma unroll
        for (int e = 0; e < 4; ++e) o[e] = pk2(s[2 * e] * inv - __uint_as_float(q[e] << 16), s[2 * e + 1] * inv - __uint_as_float(q[e] & 0xffff0000u));
        *(v4u*)(MIX + (size_t)m * D + c8) = o;
    }
}

__device__ __forceinline__ void phase_attn0(Ctx& C) {
    const Params& p = C.p;
    MLAS char* shm = (MLAS char*)C.lds;
    att::UnitDesc U; U.Q = (const bf16_t*)(p.ws + WS_Q0); U.qpitch = 768; U.K = (const bf16_t*)(p.ws + WS_K0); U.kpitch = 256; U.V = (const bf16_t*)(p.ws + WS_V0); U.vpitch = 256;
    U.O = (bf16_t*)(p.ws + WS_MIX); U.opitch = D; U.rg = 0; U.rmin = 0; U.head = 0;
    for (int u = C.vcu; u < 768 + 96; u += C.G) {
        if (u < 768) { const int qb = u & 7, bh = u >> 3, h = bh % 12, b = bh / 12;
            U.q0 = (long)b * S + 256 * qb; U.qcol = h * 64; U.kcol = (h / 3) * 64; U.vcol = (h / 3) * 64; U.ocol = 256 + h * 64; U.kv0 = b * SK; U.nt = SK / 64; }
        else { const int bh = u - 768, h = bh % 12, b = bh / 12;
            U.q0 = (long)ML + 256 * b; U.qcol = h * 64; U.kcol = (h / 3) * 64; U.vcol = (h / 3) * 64; U.ocol = 256 + h * 64; U.kv0 = b * SK; U.nt = CTX / 64; }
        att::attn_unit<64, false, false>(U, shm, nullptr, nullptr, nullptr);
    }
    phase_pool(C);
}
__device__ __forceinline__ void phase_attn1(Ctx& C) {
    const Params& p = C.p;
    MLAS char* shm = (MLAS char*)C.lds;
    const float* T16 = (const float*)(p.ws + WS_ROPE16);
    att::UnitDesc U; U.O = (bf16_t*)(p.ws + WS_MIX); U.opitch = D;
    for (int u = C.vcu; u < 1024; u += C.G) {
        const int uu = u & 511, qb = uu & 7, h = (uu >> 3) & 7, b = uu >> 6;
        U.q0 = (long)b * S + 256 * qb; U.kv0 = b * SK; U.head = h;
        if (u < 512) {
            U.Q = (const bf16_t*)(p.ws + WS_MQ); U.qpitch = 768; U.qcol = h * 96; U.K = (const bf16_t*)(p.ws + WS_MK); U.kpitch = 768; U.kcol = h * 96;
            U.V = (const bf16_t*)(p.ws + WS_MV); U.vpitch = 512; U.vcol = h * 64; U.ocol = h * 64; U.nt = SK / 64; U.rg = 0; U.rmin = 0;
            att::attn_unit<96, false, true>(U, shm, p.in[I1_MQG], T16, nullptr);
        } else {
            U.Q = (const bf16_t*)(p.ws + WS_NQ); U.qpitch = 512; U.qcol = h * 64; U.K = (const bf16_t*)(p.ws + WS_NK); U.kpitch = 512; U.kcol = h * 64;
            U.V = (const bf16_t*)(p.ws + WS_NV); U.vpitch = 512; U.vcol = h * 64; U.ocol = 512 + h * 64; U.rg = qb;
            const int rmin = min(max(4 * qb - 4, 0), 24), rmax = min(max(4 * qb + 3 - 4, 0), 24) + 7;
            U.rmin = rmin; U.nt = 4 + (rmax - rmin + 1);
            att::attn_unit<64, true, false>(U, shm, nullptr, nullptr, p.in[I1_RPB]);
        }
    }
}

__global__ void __launch_bounds__(NTHR, 2) mega(Params p, int ph_lo, int ph_hi) {
    extern __shared__ __attribute__((aligned(16))) unsigned char lds_raw[];
    cg::grid_group grid = cg::this_grid();
    Ctx C; C.p = p; C.lds = (MLAS unsigned char*)lds_raw; C.tid = threadIdx.x; C.lane = C.tid & 63; C.wave = __builtin_amdgcn_readfirstlane(C.tid >> 6);
    C.G = gridDim.x; C.bid = blockIdx.x; C.vcu = (C.G % 8 == 0) ? (C.bid % 8) * (C.G / 8) + C.bid / 8 : C.bid;
    volatile LAS unsigned* bst = (volatile LAS unsigned*)(C.lds + LDS_BYTES - 64);
    if (C.tid < 2) bst[C.tid] = 0u;
    __syncthreads();
    unsigned* barw = (unsigned*)(p.ws + WS_BARRIER);
    XcdBarrier bar; bar.bar = barw; bar.x = 0; bar.st = nullptr;
    if (ph_hi - ph_lo > 1) bar = xcd_barrier_post(barw, bst);
    float* out = p.out; float* xrc = (float*)(p.ws + WS_XRC);
    const float* MOD = (const float*)(p.ws + WS_MOD);
    bf16_t* XN = (bf16_t*)(p.ws + WS_XN); bf16_t* MIX = (bf16_t*)(p.ws + WS_MIX); bf16_t* H = (bf16_t*)(p.ws + WS_H);
    const float* T32 = (const float*)(p.ws + WS_ROPE32); const float* T16 = (const float*)(p.ws + WS_ROPE16);
#define WSB(off) ((bf16_t*)(p.ws + (off)))
#ifndef PHMASK
#define PHMASK 0xFFFF
#endif
#ifndef REPMASK
#define REPMASK 0
#endif
#ifndef NSYNC
#define NSYNC 1
#endif
#define PH(k) if (((PHMASK >> (k)) & 1) && ph_lo <= (k) && (k) < ph_hi) for (int rep_ = 0; rep_ < (((REPMASK >> (k)) & 1) ? 2 : 1); ++rep_, (((REPMASK >> (k)) & 1) && rep_ == 1 ? xcd_barrier(bar) : (void)0))
#ifndef USE_CG_SYNC
#define USE_CG_SYNC 0
#endif
#define SEAM(k) if (ph_lo <= (k) && (k) + 1 < ph_hi) { for (int s_ = 0; s_ < NSYNC; ++s_) { if (USE_CG_SYNC || ph_hi > 1000) grid.sync(); else xcd_barrier(bar); } }
    PH(0) { phase_prologue(C); } SEAM(0);
    PH(1) { phase_norm(C, p.in[I_X], p.in[I_CTX], p.in[I0_NMIX], 0, 0, 1, MT); } SEAM(1);
    PH(2) { pg8::Gemm g{XN, WSB(WS_W_IN0), MT, 1536, D}; pg8::StaticOrder So; So.init(MT, 1536, C.G, C.bid);
        epi::EpiIn0 E{WSB(WS_A0), WSB(WS_Q0), WSB(WS_K0), WSB(WS_V0), p.in[I0_QG], p.in[I0_KG], T32};
        pg8::gemm_phase<epi::EpiIn0, pg8::StaticOrder, true, true>(C.lds, g, So, E); } SEAM(2);
    PH(3) { phase_attn0(C); } SEAM(3);
    PH(4) { pg8::Gemm g{MIX, WSB(WS_W_OUT0), MT, D, D}; pg8::StaticOrder So; So.init(MT, D, C.G, C.bid);
        epi::EpiResid E{p.in[I_X], p.in[I_CTX], out, xrc, MOD + 2 * D};
        pg8::gemm_phase<epi::EpiResid, pg8::StaticOrder, true, true>(C.lds, g, So, E); } SEAM(4);
    PH(5) { phase_norm(C, out, xrc, p.in[I0_NFFN], 0, 3, 4, MT); } SEAM(5);
    PH(6) { pg8::Gemm g{XN, WSB(WS_W_GU0), MT, 2 * FF, D}; pg8::StaticOrder So; So.init(MT, 2 * FF, C.G, C.bid);
        epi::EpiSwiGLU E{H};
        pg8::gemm_phase<epi::EpiSwiGLU, pg8::StaticOrder, true, true>(C.lds, g, So, E); } SEAM(6);
    PH(7) { pg8::Gemm g{H, WSB(WS_W_D0), MT, D, FF}; pg8::StaticOrder So; So.init(MT, D, C.G, C.bid);
        epi::EpiResid E{out, xrc, out, xrc, MOD + 5 * D};
        pg8::gemm_phase<epi::EpiResid, pg8::StaticOrder, true, true>(C.lds, g, So, E); } SEAM(7);
    PH(8) { phase_norm(C, out, xrc, p.in[I1_NMIX], 1, 0, 1, MT); } SEAM(8);
    PH(9) { pg8::Gemm g{XN, WSB(WS_W_IN1), MT, L1_INP, D}; pg8::StaticOrder So; So.init(MT, L1_INP, C.G, C.bid);
        epi::EpiIn1 E{WSB(WS_CQ), WSB(WS_CKV), WSB(WS_NQ), WSB(WS_NK), WSB(WS_NV), (float*)(p.ws + WS_KR), (float*)(p.ws + WS_SSQ), (float*)(p.ws + WS_SSKV), p.in[I1_NQG], p.in[I1_NKG]};
        pg8::gemm_phase<epi::EpiIn1, pg8::StaticOrder, true, true>(C.lds, g, So, E); } SEAM(9);
    PH(10) {
#ifndef NO_QUP
        { pg8::Gemm g{WSB(WS_CQ), WSB(WS_W_UQ), ML, 768, 384}; pg8::StaticOrder So; So.init(ML, 768, C.G, C.bid);
          epi::EpiQUp E{WSB(WS_MQ), (const float*)(p.ws + WS_SSQ)};
          pg8::gemm_phase<epi::EpiQUp, pg8::StaticOrder, true, true>(C.lds, g, So, E); }
#endif
#ifndef NO_KVUP
        { pg8::Gemm g{WSB(WS_CKV), WSB(WS_W_UKV), MT, 1024, 256}; pg8::StaticOrder So; So.init(MT, 1024, C.G, C.bid);
          epi::EpiKvUp E{WSB(WS_MK), WSB(WS_MV), (const float*)(p.ws + WS_SSKV), (const float*)(p.ws + WS_KR), p.in[I1_MKG], T16};
          pg8::gemm_phase<epi::EpiKvUp, pg8::StaticOrder, true, true>(C.lds, g, So, E); }
#endif
    } SEAM(10);
    PH(11) { phase_attn1(C); } SEAM(11);
    PH(12) { pg8::Gemm g{MIX, WSB(WS_W_OUT1), ML, D, D}; pg8::StaticOrder So; So.init(ML, D, C.G, C.bid);
        epi::EpiResid E{out, xrc, out, xrc, MOD + 9 * 6144 + 2 * D};
        pg8::gemm_phase<epi::EpiResid, pg8::StaticOrder, true, true>(C.lds, g, So, E); } SEAM(12);
    PH(13) { phase_norm(C, out, xrc, p.in[I1_NFFN], 1, 3, 4, ML); } SEAM(13);
    PH(14) { pg8::Gemm g{XN, WSB(WS_W_GU1), ML, 2 * FF, D}; pg8::StaticOrder So; So.init(ML, 2 * FF, C.G, C.bid);
        epi::EpiSwiGLU E{H};
        pg8::gemm_phase<epi::EpiSwiGLU, pg8::StaticOrder, true, true>(C.lds, g, So, E); } SEAM(14);
    PH(15) { pg8::Gemm g{H, WSB(WS_W_D1), ML, D, FF}; pg8::StaticOrder So; So.init(ML, D, C.G, C.bid);
        epi::EpiResid E{out, xrc, out, xrc, MOD + 9 * 6144 + 5 * D};
        pg8::gemm_phase<epi::EpiResid, pg8::StaticOrder, true, true>(C.lds, g, So, E); }
    if (ph_hi - ph_lo > 1 && C.bid == 0 && C.tid == 0) { if (xb_ld(&barw[XB_TMO]) != 0u) out[0] = __builtin_nanf(""); }
#undef PH
#undef SEAM
#undef WSB
}
}
#ifndef MK_DEBUG
#define MK_DEBUG 0
#endif
static int g_grid = 0;
static bool mega_setup() {
    if (g_grid) return g_grid > 0;
    int dev = 0, cus = 0, per_cu = 0;
    if (hipGetDevice(&dev) != hipSuccess || hipDeviceGetAttribute(&cus, hipDeviceAttributeMultiprocessorCount, dev) != hipSuccess) { g_grid = -1; return false; }
    if (hipFuncSetAttribute((const void*)mk::mega, hipFuncAttributeMaxDynamicSharedMemorySize, mk::LDS_BYTES) != hipSuccess) { fprintf(stderr, "kernel_launch: hipFuncSetAttribute failed\n"); g_grid = -1; return false; }
    if (hipOccupancyMaxActiveBlocksPerMultiprocessor(&per_cu, (const void*)mk::mega, mk::NTHR, mk::LDS_BYTES) != hipSuccess || per_cu < 1) { fprintf(stderr, "kernel_launch: occupancy query says %d\n", per_cu); g_grid = -1; return false; }
    g_grid = cus;
    fprintf(stderr, "kernel_launch: %d CUs, occupancy %d blocks/CU, grid %d\n", cus, per_cu, g_grid);
    return true;
}
static void launch_phases(const Params& p, int lo, int hi, hipStream_t st) {
    Params pp = p; int l = lo, h = hi;
    void* args[] = {&pp, &l, &h};
    hipError_t e;
    if (hi - lo > 1) e = hipLaunchCooperativeKernel((const void*)mk::mega, dim3(g_grid), dim3(mk::NTHR), args, mk::LDS_BYTES, st);
    else e = hipLaunchKernel((const void*)mk::mega, dim3(g_grid), dim3(mk::NTHR), args, mk::LDS_BYTES, st);
    if (e != hipSuccess) fprintf(stderr, "kernel_launch: launch [%d,%d) failed: %s\n", lo, hi, hipGetErrorString(e));
}
#if MK_DEBUG
static void launch_debug(const Params& p, hipStream_t st) {
    using namespace nv;
    unsigned* err = (unsigned*)(p.ws + WS_CTL) + 64;
    float* out = p.out; float* xrc = (float*)(p.ws + WS_XRC);
    const float* x = p.in[I_X]; const float* cx = p.in[I_CTX];
    const size_t att_sm = 4 * (SK + 128) * sizeof(float);
    const int SR = 4096;
    float* snapL = (float*)(p.ws + WS_SNAP); float* snapC = snapL + (size_t)SR * D;
    float* snapB = (float*)(p.ws + WS_BIG);
    hipMemsetAsync(p.ws + WS_CTL, 0, 4096, st);
    launch_phases(p, 0, 1, st);  k_adaln<true><<<dim3(6144 / 256, 9, 2), 256, 0, st>>>(p, err + 0);
    launch_phases(p, 1, 2, st);  k_norm<true><<<MT / 4, 256, 0, st>>>(p, x, cx, I0_NMIX, 0, 0, 1, MT, err + 1);
    launch_phases(p, 2, 3, st);  k_in0<true><<<MT / R, 256, (R * D + R * L0_IN) * 4, st>>>(p, err + 2);
    launch_phases(p, 3, 4, st);  k_attn<true, 0><<<dim3(ML / 4, 12), 256, att_sm, st>>>(p, err + 3);
                                 k_attn<true, 1><<<dim3(MC / 4, 12), 256, att_sm, st>>>(p, err + 16);
                                 k_pool0<true><<<MT, 256, 0, st>>>(p, err + 17);
    launch_phases(p, 4, 5, st);  k_out<true, 0><<<MT / R, 256, (R * D + R * 256) * 4, st>>>(p, x, cx, out, xrc, 0, err + 4);
    launch_phases(p, 5, 6, st);  k_norm<true><<<MT / 4, 256, 0, st>>>(p, out, xrc, I0_NFFN, 0, 3, 4, MT, err + 5);
    launch_phases(p, 6, 7, st);  k_ffn_gu<true, 0><<<MT / R, 256, R * D * 4, st>>>(p, err + 6);
    hipMemcpyAsync(snapL, out, (size_t)SR * D * 4, hipMemcpyDeviceToDevice, st); hipMemcpyAsync(snapC, xrc, (size_t)MC * D * 4, hipMemcpyDeviceToDevice, st);
    launch_phases(p, 7, 8, st);  k_ffn_d<true, 0><<<SR / R, 256, R * FF * 4, st>>>(p, snapL, snapC, out, xrc, 0, err + 7);
                                 k_ffn_d<true, 0><<<MC / R, 256, R * FF * 4, st>>>(p, snapL, snapC, out, xrc, ML, err + 7);
    launch_phases(p, 8, 9, st);  k_norm<true><<<MT / 4, 256, 0, st>>>(p, out, xrc, I1_NMIX, 1, 0, 1, MT, err + 8);
    launch_phases(p, 9, 10, st); k_in1<true><<<MT / R, 256, (R * D + R * L1_IN) * 4, st>>>(p, err + 9);
    launch_phases(p, 10, 11, st); k_mlaq<true><<<ML / R, 256, R * 384 * 4, st>>>(p, err + 10);
                                 k_mlakv<true><<<MT / R, 256, (R * 256 + R * 1024) * 4, st>>>(p, err + 19);
    launch_phases(p, 11, 12, st); k_attn<true, 2><<<dim3(ML / 4, 8), 256, att_sm, st>>>(p, err + 11);
                                 k_attn<true, 3><<<dim3(ML / 4, 8), 256, att_sm, st>>>(p, err + 18);
    hipMemcpyAsync(snapB, out, (size_t)SR * D * 4, hipMemcpyDeviceToDevice, st);
    launch_phases(p, 12, 13, st); k_out<true, 1><<<SR / R, 256, (R * D + R * 256) * 4, st>>>(p, snapB, snapC, out, xrc, 0, err + 12);
    launch_phases(p, 13, 14, st); k_norm<true><<<ML / 4, 256, 0, st>>>(p, out, xrc, I1_NFFN, 1, 3, 4, ML, err + 13);
    launch_phases(p, 14, 15, st); k_ffn_gu<true, 1><<<ML / R, 256, R * D * 4, st>>>(p, err + 14);
    hipMemcpyAsync(snapL, out, (size_t)SR * D * 4, hipMemcpyDeviceToDevice, st);
    launch_phases(p, 15, 16, st); k_ffn_d<true, 1><<<SR / R, 256, R * FF * 4, st>>>(p, snapL, snapC, out, xrc, 0, err + 15);
    k_report<<<1, 1, 0, st>>>(p, 20, 0.15f);
}
#endif
extern "C" void kernel_launch(void* const* d_in, const int* in_sizes, int n_in, void* d_out, int out_size, void* d_ws, size_t ws_size, hipStream_t stream) {
    if (n_in != N_IN || out_size != ML * D || ws_size < WS_END) { fprintf(stderr, "kernel_launch: unexpected shapes n_in=%d out=%d ws=%zu\n", n_in, out_size, ws_size); return; }
    if (!mega_setup()) return;
    Params p{};
    for (int i = 0; i < N_IN; ++i) p.in[i] = (const float*)d_in[i];
    p.out = (float*)d_out; p.ws = (unsigned char*)d_ws;
#if MK_DEBUG
    launch_debug(p, stream);
#else
    if (hipMemsetAsync((char*)d_ws + WS_BARRIER, 0, 16 * 1024, stream) != hipSuccess) { fprintf(stderr, "kernel_launch: memset failed\n"); return; }
    launch_phases(p, 0, mk::NPHASE, stream);
#endif
}
```

```cpp
#include <hip/hip_runtime.h>
#include <hip/hip_cooperative_groups.h>
#include <cstdio>
#include <cstdint>
namespace cg = cooperative_groups;

typedef unsigned short bf16_t;
constexpr int D = 1024, NB = 8, S = 2048, CTX = 256, SK = S + CTX, ML = NB * S, MC = NB * CTX, MT = ML + MC, FF = 2816;
constexpr int GW = 64;
constexpr int L0_IN = 1536, L1_IN = 2208, L1_INP = 2304;
constexpr float EPS = 1e-6f;
constexpr float LOG2E = 1.4426950408889634f;
constexpr float C2_64 = 0.125f * LOG2E;
constexpr float C2_96 = 0.10206207261596577f * LOG2E;

enum { I_X = 0, I_C, I_CTX, I_CCTX,
       I0_ADAW, I0_ADAB, I0_NMIX, I0_NFFN, I0_WIN, I0_POOLW, I0_POOLS, I0_QG, I0_KG, I0_WOUT, I0_WG, I0_WU, I0_WD,
       I1_ADAW, I1_ADAB, I1_NMIX, I1_NFFN, I1_WIN, I1_QAG, I1_KVAG, I1_WUQ, I1_WUKV, I1_MQG, I1_MKG, I1_NQG, I1_NKG, I1_RPB, I1_WOUT, I1_WG, I1_WU, I1_WD, N_IN };

constexpr size_t MiB = 1u << 20;
constexpr size_t WS_CTL = 0;
constexpr size_t WS_BARRIER = 16 * 1024;
constexpr size_t WS_MOD = 64 * 1024;
constexpr size_t WS_SSQ = 512 * 1024;
constexpr size_t WS_SSKV = 600 * 1024;
constexpr size_t WS_ROPE32 = 700 * 1024;
constexpr size_t WS_ROPE16 = 712 * 1024;
constexpr size_t WS_W_IN0 = 1 * MiB;
constexpr size_t WS_W_OUT0 = 4 * MiB;
constexpr size_t WS_W_GU0 = 6 * MiB;
constexpr size_t WS_W_D0 = 17 * MiB;
constexpr size_t WS_W_IN1 = 23 * MiB;
constexpr size_t WS_W_UQ = 28 * MiB;
constexpr size_t WS_W_UKV = 29 * MiB;
constexpr size_t WS_W_OUT1 = 30 * MiB;
constexpr size_t WS_W_GU1 = 32 * MiB;
constexpr size_t WS_W_D1 = 43 * MiB;
constexpr size_t WS_XRC = 49 * MiB;
constexpr size_t WS_XN = 57 * MiB;
constexpr size_t WS_MIX = WS_XN;
constexpr size_t WS_BIG = 96 * MiB;
constexpr size_t WS_H = WS_BIG;
constexpr size_t WS_A0 = WS_BIG;
constexpr size_t WS_Q0 = WS_BIG + 9 * MiB;
constexpr size_t WS_K0 = WS_BIG + 36 * MiB;
constexpr size_t WS_V0 = WS_BIG + 45 * MiB;
constexpr size_t WS_CQ = WS_BIG;
constexpr size_t WS_CKV = WS_BIG + 14 * MiB;
constexpr size_t WS_NQ = WS_BIG + 23 * MiB;
constexpr size_t WS_NK = WS_BIG + 41 * MiB;
constexpr size_t WS_NV = WS_BIG + 59 * MiB;
constexpr size_t WS_MQ = WS_BIG + 77 * MiB;
constexpr size_t WS_MK = WS_BIG + 101 * MiB;
constexpr size_t WS_MV = WS_BIG + 128 * MiB;
constexpr size_t WS_KR = WS_BIG + 146 * MiB;
constexpr size_t WS_SNAP = WS_BIG + 100 * MiB;
constexpr size_t WS_END = 256 * MiB;
static_assert(WS_KR + (size_t)MT * 32 * 4 <= WS_END, "ws map");
static_assert(WS_W_D1 + (size_t)D * FF * 2 <= WS_XRC, "ws map");
static_assert(WS_XN + (size_t)MT * D * 2 <= WS_BIG, "ws map");

__device__ __forceinline__ float bf2f(bf16_t u) { return __uint_as_float((unsigned)u << 16); }
__device__ __forceinline__ bf16_t f2bf(float f) { unsigned u = __float_as_uint(f); return (bf16_t)((u + 0x7fffu + ((u >> 16) & 1u)) >> 16); }
__device__ __forceinline__ int kvrow_of(int m) { return m < ML ? (m / S) * SK + CTX + (m % S) : ((m - ML) / CTX) * SK + ((m - ML) % CTX); }
__device__ __forceinline__ int modidx_of(int m) { return m < ML ? m / S : 8; }
__device__ __forceinline__ float wave_sum(float v) {
#pragma unroll
    for (int o = 1; o < 64; o <<= 1) v += __shfl_xor(v, o);
    return v;
}
__device__ __forceinline__ float wave_max(float v) {
#pragma unroll
    for (int o = 1; o < 64; o <<= 1) v = fmaxf(v, __shfl_xor(v, o));
    return v;
}

struct Params {
    const float* in[N_IN];
    float* out;
    unsigned char* ws;
};
namespace pg8 {
#define PG8_LAS __attribute__((address_space(3)))
typedef unsigned short bf16_t;
typedef short bf16x8 __attribute__((ext_vector_type(8)));
typedef float f32x4 __attribute__((ext_vector_type(4)));
typedef unsigned u32x4 __attribute__((ext_vector_type(4)));
constexpr int BM = 256, BK = 64, HALF = 128, HTB = HALF * BK * 2  , STAGE_BYTES = 8 * HTB, NXCD = 8, WGM = 8;

__host__ __device__ __forceinline__ int lds_byte(int r, int c) { const int st = (r >> 4) * 2 + (c >> 5), rr = r & 15, cc = c & 31, ob = rr * 64 + cc * 2; return st * 1024 + (ob ^ (((ob >> 9) & 1) << 5)); }
__host__ __device__ __forceinline__ void stage_rc(int b, int& R, int& C) { const int st = b / 1024, sb = b % 1024, swz = sb ^ (((sb >> 9) & 1) << 5); R = (st >> 1) * 16 + swz / 64; C = (st & 1) * 32 + (swz % 64) / 2; }
__host__ __device__ __forceinline__ int perm32(int rho) { const int n = rho >> 4, i = rho & 15; return 8 * (i >> 2) + 4 * n + (i & 3); }

struct Unit { int pm, pn; };
struct Gemm { const bf16_t* A; const bf16_t* Bt; int M, N, K; };

struct StaticOrder {
    int nM, nN, nwg, G, c;
    __host__ __device__ void init(int M, int N, int G_, int c_) { nM = M / BM; nN = N / BM; nwg = nM * nN; G = G_; c = c_; }
    __host__ __device__ bool next(int i, Unit& u) const {
        const long L = (long)i * G + c; if (L >= nwg) return false;
        int wgid = (int)L; { const int q = nwg / NXCD, r = nwg % NXCD, xcd = wgid % NXCD, off = wgid / NXCD; wgid = (xcd < r ? xcd * (q + 1) : r * (q + 1) + (xcd - r) * q) + off; }
        const int nig = WGM * nN, gid = wgid / nig, fm = gid * WGM, gsz = (nM - fm) < WGM ? (nM - fm) : WGM;
        u.pm = fm + ((wgid % nig) % gsz); u.pn = (wgid % nig) / gsz; return true;
    }
    __device__ __forceinline__ void a_ready(const Unit&) const {}
    __device__ __forceinline__ void done(const Unit&) const {}
};

__device__ __forceinline__ unsigned cvt_pk_bf16(float lo, float hi) { unsigned r; asm volatile("v_cvt_pk_bf16_f32 %0, %1, %2" : "=v"(r) : "v"(lo), "v"(hi)); return r; }
typedef float f32x2 __attribute__((ext_vector_type(2)));
template <class Epi, class Sched, bool ALIGN_EPI = false, bool SP2 = false>
__device__ __forceinline__ void gemm_phase(PG8_LAS unsigned char* lds, const Gemm g, const Sched& S, const Epi& E) {
    int tid_ = threadIdx.x; asm volatile("" : "+v"(tid_));
    const int tid = tid_, wid = __builtin_amdgcn_readfirstlane(tid >> 6), lane = tid & 63, wr = wid >> 2, wc = wid & 3, fr = lane & 15, fq = lane >> 4;
    int K_ = g.K; asm volatile("" : "+s"(K_));
    const int K = K_, nt = K / BK;
    unsigned voffA[2], voffB[2];
#pragma unroll
    for (int i = 0; i < 2; ++i) { int R, C; stage_rc(tid * 16 + i * 8192, R, C); const int Rb = Epi::PERM ? ((R & ~31) + perm32(R & 31)) : R;
        voffA[i] = (unsigned)(R * K + C) * 2u; voffB[i] = (unsigned)(Rb * K + C) * 2u; }
    const size_t kstep = (size_t)(BK * 2);
    const size_t hstep = (size_t)HALF * K * 2;
    const size_t tstep = 2 * hstep;
    const unsigned ldsw = (unsigned)wid * 1024u;
    const int aoff = lds_byte(wr * 64 + fr, fq * 8), boff = lds_byte(wc * 32 + fr, fq * 8);
#define PG8_SA(b, h) (((b) * 2 + (h)) * HTB)
#define PG8_SB(b, h) ((4 + (b) * 2 + (h)) * HTB)
#define PG8_STAGE(bufoff, gbase, voff) do { _Pragma("unroll") for (int _i = 0; _i < 2; ++_i) \
        __builtin_amdgcn_global_load_lds((const unsigned*)((const char*)(gbase) + (voff)[_i]), (PG8_LAS unsigned*)(lds + (bufoff) + ldsw + _i * 8192), 16, 0, 0); } while (0)
#define PG8_LDA(dst, b, h) do { _Pragma("unroll") for (int m = 0; m < 4; ++m) _Pragma("unroll") for (int k = 0; k < 2; ++k) dst[m][k] = *(const PG8_LAS bf16x8*)(lds + PG8_SA(b, h) + aoff + m * 2048 + k * 1024); } while (0)
#define PG8_LDB(dst, b, h) do { _Pragma("unroll") for (int n = 0; n < 2; ++n) _Pragma("unroll") for (int k = 0; k < 2; ++k) dst[n][k] = *(const PG8_LAS bf16x8*)(lds + PG8_SB(b, h) + boff + n * 2048 + k * 1024); } while (0)
#define PG8_MMA(ai, bj, At, Bt) do { __builtin_amdgcn_s_setprio(1); _Pragma("unroll") for (int m = 0; m < 4; ++m) _Pragma("unroll") for (int n = 0; n < 2; ++n) _Pragma("unroll") for (int k = 0; k < 2; ++k) \
        acc[ai][bj][m][n] = __builtin_amdgcn_mfma_f32_16x16x32_bf16(Bt[n][k], At[m][k], acc[ai][bj][m][n], 0, 0, 0); __builtin_amdgcn_s_setprio(0); } while (0)
#define PG8_WAIT_V(n) asm volatile("s_waitcnt vmcnt(" #n ")" ::: "memory")
#define PG8_WAIT_L(n) asm volatile("s_waitcnt lgkmcnt(" #n ")" ::: "memory")
#define PG8_BAR __builtin_amdgcn_s_barrier()
#define PG8_SCHED __builtin_amdgcn_sched_barrier(0)
    Unit cur, nxt; int ui = 0;
    if (!S.next(0, cur)) return;
    f32x4 acc[2][2][4][2];
#pragma unroll
    for (int a = 0; a < 2; ++a)
#pragma unroll
        for (int b = 0; b < 2; ++b)
#pragma unroll
            for (int m = 0; m < 4; ++m)
#pragma unroll
                for (int n = 0; n < 2; ++n) acc[a][b][m][n] = (f32x4){0.f, 0.f, 0.f, 0.f};
    bf16x8 At[4][2], B0[2][2], B1[2][2];
    const char* cA = (const char*)g.A + (size_t)cur.pm * tstep; const char* cB = (const char*)g.Bt + (size_t)cur.pn * tstep;
    S.a_ready(cur);
    if constexpr (SP2) {
        PG8_STAGE(PG8_SB(0, 0), cB, voffB); PG8_STAGE(PG8_SB(0, 1), cB + hstep, voffB); PG8_STAGE(PG8_SA(0, 0), cA, voffA); PG8_STAGE(PG8_SA(0, 1), cA + hstep, voffA);
        if (wr == 1) PG8_BAR;
        PG8_WAIT_V(2); PG8_BAR;
        PG8_STAGE(PG8_SB(1, 0), cB + kstep, voffB); PG8_STAGE(PG8_SA(1, 0), cA + kstep, voffA); PG8_STAGE(PG8_SB(1, 1), cB + hstep + kstep, voffB);
        PG8_WAIT_V(6); PG8_BAR;
    } else {
        PG8_STAGE(PG8_SB(0, 0), cB, voffB); PG8_STAGE(PG8_SA(0, 0), cA, voffA); PG8_STAGE(PG8_SB(0, 1), cB + hstep, voffB); PG8_STAGE(PG8_SA(0, 1), cA + hstep, voffA);
        if (wr == 1) PG8_BAR;
        PG8_WAIT_V(4); PG8_BAR;
        PG8_STAGE(PG8_SB(1, 0), cB + kstep, voffB); PG8_STAGE(PG8_SA(1, 0), cA + kstep, voffA); PG8_STAGE(PG8_SB(1, 1), cB + hstep + kstep, voffB);
        PG8_WAIT_V(6); PG8_BAR;
    }
    for (;;) {
        const bool has_next = S.next(ui + 1, nxt);
        const char* nA = has_next ? (const char*)g.A + (size_t)nxt.pm * tstep : cA; const char* nB = has_next ? (const char*)g.Bt + (size_t)nxt.pn * tstep : cB;
        for (int t = 0; t < nt; t += 2) {
            const bool last = (t == nt - 2);
            const char* a1 = cA + (size_t)(t + 1) * kstep;
            const char* a2 = last ? nA : cA + (size_t)(t + 2) * kstep; const char* b2 = last ? nB : cB + (size_t)(t + 2) * kstep;
            const char* a3 = a2 + kstep; const char* b3 = b2 + kstep;
            if (last && has_next) S.a_ready(nxt);
            if constexpr (SP2) {
            PG8_LDB(B0, 0, 0); PG8_LDB(B1, 0, 1); PG8_SCHED; PG8_LDA(At, 0, 0); PG8_STAGE(PG8_SA(1, 1), a1 + hstep, voffA);
            PG8_WAIT_V(8); PG8_WAIT_L(0); PG8_BAR; PG8_MMA(0, 0, At, B0); PG8_MMA(0, 1, At, B1); PG8_BAR; PG8_SCHED;
            PG8_LDA(At, 0, 1); PG8_STAGE(PG8_SB(0, 0), b2, voffB); PG8_STAGE(PG8_SB(0, 1), b2 + hstep, voffB); PG8_STAGE(PG8_SA(0, 0), a2, voffA);
            PG8_WAIT_V(8); PG8_WAIT_L(0); PG8_BAR; PG8_MMA(1, 0, At, B0); PG8_MMA(1, 1, At, B1); PG8_BAR; PG8_SCHED;
            PG8_LDB(B0, 1, 0); PG8_LDB(B1, 1, 1); PG8_SCHED; PG8_LDA(At, 1, 0); PG8_STAGE(PG8_SA(0, 1), a2 + hstep, voffA);
            PG8_WAIT_V(8); PG8_WAIT_L(0); PG8_BAR; PG8_MMA(0, 0, At, B0); PG8_MMA(0, 1, At, B1); PG8_BAR; PG8_SCHED;
            PG8_LDA(At, 1, 1); PG8_STAGE(PG8_SB(1, 0), b3, voffB); PG8_STAGE(PG8_SB(1, 1), b3 + hstep, voffB); PG8_STAGE(PG8_SA(1, 0), a3, voffA);
            PG8_WAIT_V(8); PG8_WAIT_L(0); PG8_BAR; PG8_MMA(1, 0, At, B0); PG8_MMA(1, 1, At, B1); PG8_BAR; PG8_SCHED;
            } else {
            PG8_LDB(B0, 0, 0); PG8_SCHED; PG8_LDA(At, 0, 0); PG8_STAGE(PG8_SA(1, 1), a1 + hstep, voffA);
            PG8_WAIT_L(8); PG8_BAR; PG8_WAIT_L(0); PG8_MMA(0, 0, At, B0); PG8_BAR; PG8_SCHED;
            PG8_LDB(B1, 0, 1); PG8_STAGE(PG8_SB(0, 0), b2, voffB);
            PG8_BAR; PG8_WAIT_L(0); PG8_MMA(0, 1, At, B1); PG8_BAR;
            PG8_LDA(At, 0, 1); PG8_STAGE(PG8_SA(0, 0), a2, voffA);
            PG8_BAR; PG8_WAIT_L(0); PG8_MMA(1, 0, At, B0); PG8_BAR; PG8_SCHED;
            PG8_STAGE(PG8_SB(0, 1), b2 + hstep, voffB);
            PG8_WAIT_V(6); PG8_BAR; PG8_MMA(1, 1, At, B1); PG8_BAR;
            PG8_LDB(B0, 1, 0); PG8_SCHED; PG8_LDA(At, 1, 0); PG8_STAGE(PG8_SA(0, 1), a2 + hstep, voffA);
            PG8_WAIT_L(8); PG8_BAR; PG8_WAIT_L(0); PG8_MMA(0, 0, At, B0); PG8_BAR; PG8_SCHED;
            PG8_LDB(B1, 1, 1); PG8_STAGE(PG8_SB(1, 0), b3, voffB);
            PG8_BAR; PG8_WAIT_L(0); PG8_MMA(0, 1, At, B1); PG8_BAR;
            PG8_LDA(At, 1, 1); PG8_STAGE(PG8_SA(1, 0), a3, voffA);
            PG8_BAR; PG8_WAIT_L(0); PG8_MMA(1, 0, At, B0); PG8_BAR; PG8_SCHED;
            PG8_STAGE(PG8_SB(1, 1), b3 + hstep, voffB);
            PG8_WAIT_V(6); PG8_BAR; PG8_MMA(1, 1, At, B1); PG8_BAR;
            }
        }
        if constexpr (ALIGN_EPI) { if (wr == 0) PG8_BAR; }
        if constexpr (!Epi::AFTER_DRAIN) { E(acc, cur, wr, wc, fr, fq); S.done(cur); }
        if (!has_next) break;
#pragma unroll
        for (int a = 0; a < 2; ++a)
#pragma unroll
            for (int b = 0; b < 2; ++b)
#pragma unroll
                for (int m = 0; m < 4; ++m)
#pragma unroll
                    for (int n = 0; n < 2; ++n) acc[a][b][m][n] = (f32x4){0.f, 0.f, 0.f, 0.f};
        cur = nxt; cA = nA; cB = nB; ++ui;
        if constexpr (ALIGN_EPI) { if (wr == 1) PG8_BAR; }
    }
    PG8_WAIT_V(0);
    if constexpr (!ALIGN_EPI) { if (wr == 0) PG8_BAR; }
    PG8_BAR;
    if constexpr (Epi::AFTER_DRAIN) { E.fused(acc, cur, wr, wc, fr, fq, lds, wid, lane); S.done(cur); }
#undef PG8_SA
#undef PG8_SB
#undef PG8_STAGE
#undef PG8_LDA
#undef PG8_LDB
#undef PG8_MMA
#undef PG8_WAIT_V
#undef PG8_WAIT_L
#undef PG8_BAR
#undef PG8_SCHED
}
}
namespace epi {
using pg8::f32x4; using pg8::Unit;
typedef unsigned u32x2 __attribute__((ext_vector_type(2)));
typedef unsigned u32x4 __attribute__((ext_vector_type(4)));
typedef float f32x2 __attribute__((ext_vector_type(2)));
typedef __bf16 bf16x2_t __attribute__((ext_vector_type(2)));
__device__ __forceinline__ unsigned pk(float lo, float hi) { f32x2 v = {lo, hi}; bf16x2_t b = __builtin_convertvector(v, bf16x2_t); return __builtin_bit_cast(unsigned, b); }
__device__ __forceinline__ u32x2 pk4(f32x4 v) { u32x2 w; w.x = pk(v[0], v[1]); w.y = pk(v[2], v[3]); return w; }
__device__ __forceinline__ float sum4sq(f32x4 v) { return (v[0] * v[0] + v[1] * v[1]) + (v[2] * v[2] + v[3] * v[3]); }
__device__ __forceinline__ float quad_sum(float s) { s += __shfl_xor(s, 16); s += __shfl_xor(s, 32); return s; }

__device__ __forceinline__ int kvbase_of(int pm) { return pm < 64 ? (pm >> 3) * SK + CTX + (pm & 7) * 256 : (pm - 64) * SK; }
__device__ __forceinline__ int modidx_pm(int pm) { return pm < 64 ? (pm >> 3) : 8; }

__device__ __forceinline__ void head_finish(f32x4 (&v)[2][2], const float* gain, bool rope, const float* T32, int grow, int gcol, float scale, int fq) {
    float ss = (sum4sq(v[0][0]) + sum4sq(v[0][1])) + (sum4sq(v[1][0]) + sum4sq(v[1][1]));
    ss = quad_sum(ss);
    const float rn = rsqrtf(ss * (1.f / 64.f) + EPS);
#pragma unroll
    for (int bj = 0; bj < 2; ++bj)
#pragma unroll
        for (int n = 0; n < 2; ++n) { const f32x4 g = *(const f32x4*)(gain + 32 * bj + 16 * n + 4 * fq); v[bj][n] = (v[bj][n] * rn) * g; }
    if (rope) {
#pragma unroll
        for (int bj = 0; bj < 2; ++bj) { const int pos = bj ? gcol : grow;
            const f32x4 cs = *(const f32x4*)(T32 + pos * 16 + 4 * fq), sn = *(const f32x4*)(T32 + 1024 + pos * 16 + 4 * fq);
            const f32x4 x1 = v[bj][0], x2 = v[bj][1];
            v[bj][0] = x1 * cs - x2 * sn; v[bj][1] = x1 * sn + x2 * cs; }
    }
#pragma unroll
    for (int bj = 0; bj < 2; ++bj)
#pragma unroll
        for (int n = 0; n < 2; ++n) v[bj][n] = v[bj][n] * scale;
}

struct EpiIn0 {
    static constexpr bool PERM = false, AFTER_DRAIN = false;
    bf16_t *A0, *Q0, *K0, *V0; const float *qg, *kg, *T32;
    __device__ __forceinline__ void operator()(const f32x4 (&acc)[2][2][4][2], const Unit& u, int wr, int wc, int fr_in, int fq_in) const {
        int fr = fr_in, fq = fq_in; asm volatile("" : "+v"(fr), "+v"(fq));
        const int pn = u.pn, pm = u.pm; const bool lat = pm < 64; const int kvb = kvbase_of(pm);
#pragma unroll
        for (int ai = 0; ai < 2; ++ai)
#pragma unroll
            for (int m = 0; m < 4; ++m) {
                const int rl = 128 * ai + 64 * wr + 16 * m + fr; const size_t r = (size_t)pm * 256 + rl;
                if (pn == 0 || pn == 5) {
                    bf16_t* dst = pn == 0 ? A0 + r * 256 : V0 + (size_t)(kvb + rl) * 256;
#pragma unroll
                    for (int bj = 0; bj < 2; ++bj)
#pragma unroll
                        for (int n = 0; n < 2; ++n) *(u32x2*)(dst + 64 * wc + 32 * bj + 16 * n + 4 * fq) = pk4(acc[ai][bj][m][n]);
                } else {
                    f32x4 v[2][2] = {{acc[ai][0][m][0], acc[ai][0][m][1]}, {acc[ai][1][m][0], acc[ai][1][m][1]}};
                    const int grow = (pm & 7) * 4 + 2 * ai + wr, gcol = 16 * m + fr;
                    bf16_t* dst;
                    if (pn < 4) { head_finish(v, qg, lat, T32, grow, gcol, C2_64, fq); dst = Q0 + r * 768 + ((pn - 1) * 4 + wc) * 64; }
                    else { head_finish(v, kg, lat, T32, grow, gcol, 1.0f, fq); dst = K0 + (size_t)(kvb + rl) * 256 + wc * 64; }
#pragma unroll
                    for (int bj = 0; bj < 2; ++bj)
#pragma unroll
                        for (int n = 0; n < 2; ++n) *(u32x2*)(dst + 32 * bj + 16 * n + 4 * fq) = pk4(v[bj][n]);
                }
            }
    }
};

struct EpiResid {
    static constexpr bool PERM = false, AFTER_DRAIN = false;
    const float *base_l, *base_c; float *out_l, *out_c; const float* mod;
    __device__ __forceinline__ void operator()(const f32x4 (&acc)[2][2][4][2], const Unit& u, int wr, int wc, int fr_in, int fq_in) const {
        int fr = fr_in, fq = fq_in; asm volatile("" : "+v"(fr), "+v"(fq));
        const int pm = u.pm; const bool lat = pm < 64;
        const float* bp = lat ? base_l + (size_t)pm * 256 * D : base_c + (size_t)(pm - 64) * 256 * D;
        float* op = lat ? out_l + (size_t)pm * 256 * D : out_c + (size_t)(pm - 64) * 256 * D;
        const float* gp = mod + (size_t)modidx_pm(pm) * 6144 + u.pn * 256 + 32 * wc + 4 * fq;
        f32x4 g[2][2];
#pragma unroll
        for (int bj = 0; bj < 2; ++bj)
#pragma unroll
            for (int n = 0; n < 2; ++n) g[bj][n] = *(const f32x4*)(gp + 128 * bj + 16 * n);
#pragma unroll
        for (int ai = 0; ai < 2; ++ai)
#pragma unroll
            for (int m = 0; m < 4; ++m) { const size_t off = (size_t)(128 * ai + 64 * wr + 16 * m + fr) * D + u.pn * 256 + 32 * wc + 4 * fq;
#pragma unroll
                for (int bj = 0; bj < 2; ++bj)
#pragma unroll
                    for (int n = 0; n < 2; ++n) { const f32x4 b = *(const f32x4*)(bp + off + 128 * bj + 16 * n); *(f32x4*)(op + off + 128 * bj + 16 * n) = b + g[bj][n] * acc[ai][bj][m][n]; } }
    }
};

struct EpiSwiGLU {
    static constexpr bool PERM = true, AFTER_DRAIN = false;
    bf16_t* H;
    __device__ __forceinline__ void operator()(const f32x4 (&acc)[2][2][4][2], const Unit& u, int wr, int wc, int fr_in, int fq_in) const {
        int fr = fr_in, fq = fq_in; asm volatile("" : "+v"(fr), "+v"(fq));
#pragma unroll
        for (int ai = 0; ai < 2; ++ai)
#pragma unroll
            for (int m = 0; m < 4; ++m) { const size_t r = (size_t)u.pm * 256 + 128 * ai + 64 * wr + 16 * m + fr;
                f32x4 h[2];
#pragma unroll
                for (int n = 0; n < 2; ++n) { const f32x4 g = acc[ai][0][m][n], up = acc[ai][1][m][n];
#pragma unroll
                    for (int e = 0; e < 4; ++e) h[n][e] = g[e] * __builtin_amdgcn_rcpf(1.f + __builtin_amdgcn_exp2f(-g[e] * LOG2E)) * up[e]; }
                u32x4 w; w.x = pk(h[0][0], h[0][1]); w.y = pk(h[0][2], h[0][3]); w.z = pk(h[1][0], h[1][1]); w.w = pk(h[1][2], h[1][3]);
                *(u32x4*)(H + r * FF + u.pn * 128 + 32 * wc + 8 * fq) = w; }
    }
};

struct EpiIn1 {
    static constexpr bool PERM = false, AFTER_DRAIN = false;
    bf16_t *CQ, *CKV, *NQ, *NK, *NV; float *KR, *SSQ, *SSKV; const float *nqg, *nkg;
    __device__ __forceinline__ void operator()(const f32x4 (&acc)[2][2][4][2], const Unit& u, int wr, int wc, int fr_in, int fq_in) const {
        int fr = fr_in, fq = fq_in; asm volatile("" : "+v"(fr), "+v"(fq));
        const int pn = u.pn, pm = u.pm; const int kvb = kvbase_of(pm);
#pragma unroll
        for (int ai = 0; ai < 2; ++ai)
#pragma unroll
            for (int m = 0; m < 4; ++m) {
                const int rl = 128 * ai + 64 * wr + 16 * m + fr; const size_t r = (size_t)pm * 256 + rl;
                if (pn == 0 || pn == 2) {
                    bf16_t* dst = pn == 0 ? CQ + r * 384 : CKV + r * 256; float ss = 0.f;
#pragma unroll
                    for (int bj = 0; bj < 2; ++bj)
#pragma unroll
                        for (int n = 0; n < 2; ++n) { ss += sum4sq(acc[ai][bj][m][n]); *(u32x2*)(dst + 128 * bj + 32 * wc + 16 * n + 4 * fq) = pk4(acc[ai][bj][m][n]); }
                    ss = quad_sum(ss);
                    if (fq == 0) atomicAdd((pn == 0 ? SSQ : SSKV) + r, ss);
                } else if (pn == 1) {
                    float ss = 0.f;
#pragma unroll
                    for (int n = 0; n < 2; ++n) { ss += sum4sq(acc[ai][0][m][n]); *(u32x2*)(CQ + r * 384 + 256 + 32 * wc + 16 * n + 4 * fq) = pk4(acc[ai][0][m][n]); }
                    ss = quad_sum(ss);
                    if (fq == 0) atomicAdd(SSQ + r, ss);
                    if (wc == 0) {
#pragma unroll
                        for (int n = 0; n < 2; ++n) *(f32x4*)(KR + r * 32 + 16 * n + 4 * fq) = acc[ai][1][m][n]; }
                } else if (pn >= 7) {
                    bf16_t* dst = NV + (size_t)(kvb + rl) * 512 + (pn - 7) * 256 + 64 * wc;
#pragma unroll
                    for (int bj = 0; bj < 2; ++bj)
#pragma unroll
                        for (int n = 0; n < 2; ++n) *(u32x2*)(dst + 32 * bj + 16 * n + 4 * fq) = pk4(acc[ai][bj][m][n]);
                } else {
                    f32x4 v[2][2] = {{acc[ai][0][m][0], acc[ai][0][m][1]}, {acc[ai][1][m][0], acc[ai][1][m][1]}};
                    bf16_t* dst;
                    if (pn < 5) { head_finish(v, nqg, false, nullptr, 0, 0, C2_64, fq); dst = NQ + r * 512 + ((pn - 3) * 4 + wc) * 64; }
                    else { head_finish(v, nkg, false, nullptr, 0, 0, 1.0f, fq); dst = NK + (size_t)(kvb + rl) * 512 + ((pn - 5) * 4 + wc) * 64; }
#pragma unroll
                    for (int bj = 0; bj < 2; ++bj)
#pragma unroll
                        for (int n = 0; n < 2; ++n) *(u32x2*)(dst + 32 * bj + 16 * n + 4 * fq) = pk4(v[bj][n]);
                }
            }
    }
};

struct EpiQUp {
    static constexpr bool PERM = true, AFTER_DRAIN = false;
    bf16_t* MQ; const float* SSQ;
    __device__ __forceinline__ void operator()(const f32x4 (&acc)[2][2][4][2], const Unit& u, int wr, int wc, int fr_in, int fq_in) const {
        int fr = fr_in, fq = fq_in; asm volatile("" : "+v"(fr), "+v"(fq));
#pragma unroll
        for (int ai = 0; ai < 2; ++ai)
#pragma unroll
            for (int m = 0; m < 4; ++m) { const size_t r = (size_t)u.pm * 256 + 128 * ai + 64 * wr + 16 * m + fr;
                const float rs = rsqrtf(SSQ[r] * (1.f / 384.f) + EPS);
#pragma unroll
                for (int bj = 0; bj < 2; ++bj) { const f32x4 a = acc[ai][bj][m][0] * rs, b = acc[ai][bj][m][1] * rs;
                    u32x4 w; w.x = pk(a[0], a[1]); w.y = pk(a[2], a[3]); w.z = pk(b[0], b[1]); w.w = pk(b[2], b[3]);
                    *(u32x4*)(MQ + r * 768 + u.pn * 256 + 128 * bj + 32 * wc + 8 * fq) = w; } }
    }
};

struct EpiKvUp {
    static constexpr bool PERM = false, AFTER_DRAIN = false;
    bf16_t *MK, *MV; const float *SSKV, *KR, *kg, *T16;
    __device__ __forceinline__ void operator()(const f32x4 (&acc)[2][2][4][2], const Unit& u, int wr, int wc, int fr_in, int fq_in) const {
        int fr = fr_in, fq = fq_in; asm volatile("" : "+v"(fr), "+v"(fq));
        const int pm = u.pm; const bool lat = pm < 64; const int kvb = kvbase_of(pm); const int head = 2 * u.pn + (wc >> 1); const bool isv = wc & 1;
#pragma unroll
        for (int ai = 0; ai < 2; ++ai)
#pragma unroll
            for (int m = 0; m < 4; ++m) {
                const int rl = 128 * ai + 64 * wr + 16 * m + fr; const size_t r = (size_t)pm * 256 + rl; const size_t kvr = (size_t)(kvb + rl);
                const float rs = rsqrtf(SSKV[r] * (1.f / 256.f) + EPS);
                f32x4 v[2][2];
#pragma unroll
                for (int bj = 0; bj < 2; ++bj)
#pragma unroll
                    for (int n = 0; n < 2; ++n) v[bj][n] = acc[ai][bj][m][n] * rs;
                if (isv) {
#pragma unroll
                    for (int bj = 0; bj < 2; ++bj)
#pragma unroll
                        for (int n = 0; n < 2; ++n) *(u32x2*)(MV + kvr * 512 + head * 64 + 32 * bj + 16 * n + 4 * fq) = pk4(v[bj][n]);
                } else {
                    f32x2 k[4];
#pragma unroll
                    for (int j = 0; j < 4; ++j) k[j] = *(const f32x2*)(KR + r * 32 + 8 * j + 2 * fq);
                    float ss = (sum4sq(v[0][0]) + sum4sq(v[0][1])) + (sum4sq(v[1][0]) + sum4sq(v[1][1]));
#pragma unroll
                    for (int j = 0; j < 4; ++j) ss += k[j][0] * k[j][0] + k[j][1] * k[j][1];
                    ss = quad_sum(ss);
                    const float rr = rsqrtf(ss * (1.f / 96.f) + EPS);
#pragma unroll
                    for (int bj = 0; bj < 2; ++bj)
#pragma unroll
                        for (int n = 0; n < 2; ++n) { const f32x4 g = *(const f32x4*)(kg + 32 * bj + 16 * n + 4 * fq);
                            *(u32x2*)(MK + kvr * 768 + head * 96 + 32 * bj + 16 * n + 4 * fq) = pk4((v[bj][n] * rr) * g); }
#pragma unroll
                    for (int j = 0; j < 4; ++j) { const f32x2 g = *(const f32x2*)(kg + 64 + 8 * j + 2 * fq); k[j] = (k[j] * rr) * g; }
                    if (lat) {
                        const int grow = (pm & 7) * 4 + 2 * ai + wr, gcol = 16 * m + fr;
#pragma unroll
                        for (int part = 0; part < 2; ++part) { const int pos = part ? gcol : grow;
                            const f32x2 cs = *(const f32x2*)(T16 + pos * 8 + 2 * fq), sn = *(const f32x2*)(T16 + 512 + pos * 8 + 2 * fq);
                            const f32x2 x1 = k[2 * part], x2 = k[2 * part + 1];
                            k[2 * part] = x1 * cs - x2 * sn; k[2 * part + 1] = x1 * sn + x2 * cs; }
                    }
#pragma unroll
                    for (int j = 0; j < 4; ++j) *(unsigned*)(MK + kvr * 768 + head * 96 + 64 + 8 * j + 2 * fq) = pk(k[j][0], k[j][1]);
                }
                asm volatile("" ::: "memory");
            }
    }
};
}
namespace att {
using bf16x8 = __attribute__((ext_vector_type(8))) short;
using s16x4 = __attribute__((ext_vector_type(4))) short;
using f32x16 = __attribute__((ext_vector_type(16))) float;
using u32x4 = __attribute__((ext_vector_type(4))) unsigned;
typedef float f32x2_t __attribute__((ext_vector_type(2))); typedef __bf16 bf16x2_t __attribute__((ext_vector_type(2)));
#define ALAS __attribute__((address_space(3)))
constexpr int KSLOT = 12288, VSLOT = 8192, SLOT = KSLOT + VSLOT, NSLOT = 4;
constexpr int LDS_WS = NSLOT * SLOT;
constexpr int LDS_OST = LDS_WS + 8 * 256;
constexpr int LDS_RPB = LDS_OST + 8 * 4096;
constexpr int LDS_BYTES = LDS_RPB + 2048;
constexpr float THR = 8.0f;

__device__ __forceinline__ int crow(int r, int hi) { return (r & 3) + 8 * (r >> 2) + 4 * hi; }
__device__ __forceinline__ void glds16(const void* gsrc, unsigned lds_dst) { unsigned keep;
    asm volatile("s_mov_b32 %0, m0\n\ts_mov_b32 m0, %2\n\ts_nop 0\n\tglobal_load_lds_dwordx4 %1, off\n\ts_mov_b32 m0, %0" : "=&s"(keep) : "v"(gsrc), "s"(lds_dst) : "memory"); }
__device__ __forceinline__ unsigned cvtpk(float lo, float hi) { f32x2_t v = {lo, hi}; bf16x2_t b = __builtin_convertvector(v, bf16x2_t); return __builtin_bit_cast(unsigned, b); }
__device__ __forceinline__ void glds16s(unsigned voff, const void* sbase, unsigned lds_dst) { unsigned keep;
    asm volatile("s_mov_b32 %0, m0\n\ts_mov_b32 m0, %3\n\ts_nop 0\n\tglobal_load_lds_dwordx4 %1, %2\n\ts_mov_b32 m0, %0" : "=&s"(keep) : "v"(voff), "s"(sbase), "s"(lds_dst) : "memory"); }
__device__ __forceinline__ float max3f(float a, float b, float c) { float r; asm("v_max3_f32 %0, %1, %2, %3" : "=v"(r) : "v"(a), "v"(b), "v"(c)); return r; }
__device__ __forceinline__ float max2f(float a, float b) { float r; asm("v_max_f32_e32 %0, %1, %2" : "=v"(r) : "v"(a), "v"(b)); return r; }
#define AWAIT_BAR(N) asm volatile("s_waitcnt vmcnt(" #N ") lgkmcnt(0)\n\ts_barrier" ::: "memory")

template <int ND0> __device__ __forceinline__ void qkt(f32x16& p0, f32x16& p1, const ALAS char* Kslot, const bf16x8* qr, const f32x16& negm, int r32, int hi) {
    const ALAS char* kb = Kslot + hi * 1024 + r32 * 16;
#pragma unroll
    for (int d0 = 0; d0 < ND0; ++d0) {
        const bf16x8 b0 = *(const ALAS bf16x8*)(kb + d0 * 2048);
        const bf16x8 b1 = *(const ALAS bf16x8*)(kb + d0 * 2048 + 512);
        if (d0 == 0) { p0 = __builtin_amdgcn_mfma_f32_32x32x16_bf16(b0, qr[0], negm, 0, 0, 0); p1 = __builtin_amdgcn_mfma_f32_32x32x16_bf16(b1, qr[0], negm, 0, 0, 0); }
        else { p0 = __builtin_amdgcn_mfma_f32_32x32x16_bf16(b0, qr[d0], p0, 0, 0, 0); p1 = __builtin_amdgcn_mfma_f32_32x32x16_bf16(b1, qr[d0], p1, 0, 0, 0); }
    }
}
__device__ __forceinline__ float rowmax32(const f32x16& p0, const f32x16& p1) {
    float a = max3f(p0[0], p0[1], p1[0]), b = max3f(p0[2], p0[3], p1[1]); a = max3f(a, p1[2], p1[3]);
#pragma unroll
    for (int r = 4; r < 16; r += 4) { a = max3f(a, p0[r], p0[r + 1]); b = max3f(b, p0[r + 2], p0[r + 3]); a = max3f(a, p1[r], p1[r + 1]); b = max3f(b, p1[r + 2], p1[r + 3]); }
    const float m = max2f(a, b);
    auto rr = __builtin_amdgcn_permlane32_swap(__float_as_uint(m), __float_as_uint(m), false, false);
    return max2f(__uint_as_float(rr[0]), __uint_as_float(rr[1]));
}
typedef short v4i16_t __attribute__((ext_vector_type(4)));
__device__ __forceinline__ s16x4 vtr(const ALAS char* p) { return __builtin_bit_cast(s16x4, __builtin_amdgcn_ds_read_tr16_b64_v4i16((ALAS v4i16_t*)p)); }
__device__ __forceinline__ void pv(f32x16* o, const ALAS char* vp, bf16x8 pa0, bf16x8 pa1, bf16x8 pa2, bf16x8 pa3) {
#pragma unroll
    for (int d0 = 0; d0 < 2; ++d0) { s16x4 lo[4], hi[4];
#pragma unroll
        for (int ks = 0; ks < 4; ++ks) { lo[ks] = vtr(vp + d0 * 4096 + ks * 1024); hi[ks] = vtr(vp + d0 * 4096 + ks * 1024 + 512); }
#define APK(k) (bf16x8){lo[k][0], lo[k][1], lo[k][2], lo[k][3], hi[k][0], hi[k][1], hi[k][2], hi[k][3]}
        o[d0] = __builtin_amdgcn_mfma_f32_32x32x16_bf16(pa0, APK(0), o[d0], 0, 0, 0);
        o[d0] = __builtin_amdgcn_mfma_f32_32x32x16_bf16(pa1, APK(1), o[d0], 0, 0, 0);
        o[d0] = __builtin_amdgcn_mfma_f32_32x32x16_bf16(pa2, APK(2), o[d0], 0, 0, 0);
        o[d0] = __builtin_amdgcn_mfma_f32_32x32x16_bf16(pa3, APK(3), o[d0], 0, 0, 0);
#undef APK
    }
}

struct UnitDesc {
    const bf16_t* Q; int qpitch;
    long q0; int qcol;
    const bf16_t* K; int kpitch, kcol;
    const bf16_t* V; int vpitch, vcol;
    bf16_t* O; int opitch, ocol;
    int kv0;
    int nt;
    int rg;
    int rmin;
    int head;
};

template <int DQK, bool NA, bool MLAQ>
__device__ __forceinline__ void attn_unit(const UnitDesc& U, ALAS char* shm, const float* qgain, const float* T16, const float* rpb_g) {
    constexpr int ND0 = DQK / 16, NCH = DQK / 8, NP = NCH + 8;
    int tid_ = threadIdx.x; asm volatile("" : "+v"(tid_));
    const int tid = tid_, lane = tid & 63, r32 = lane & 31, hi = lane >> 5; const int wid = __builtin_amdgcn_readfirstlane(tid >> 6);
    const unsigned lds0 = (unsigned)(uintptr_t)shm;
    ALAS float* wsf = (ALAS float*)(shm + LDS_WS) + wid * 64;
    unsigned doff[3];
#pragma unroll
    for (int i = 0; i < 3; ++i) { const int pc = wid + 8 * i;
        if (pc < NCH) doff[i] = (unsigned)((lane * U.kpitch + U.kcol + pc * 8) * 2);
        else { const int v = pc - NCH; doff[i] = (unsigned)(((16 * (v & 3) + (lane >> 2)) * U.vpitch + U.vcol + (v >> 2) * 32 + (lane & 3) * 8) * 2); } }
    auto dma_tile = [&](int t, int slot) {
        int key0;
        if (NA && t >= 4) key0 = U.kv0 + CTX + (U.rmin + (t - 4)) * GW; else key0 = U.kv0 + 64 * t;
        const unsigned sbase = lds0 + slot * SLOT;
        const bf16_t* kb_ = U.K + (size_t)key0 * U.kpitch; const bf16_t* vb_ = U.V + (size_t)key0 * U.vpitch;
#pragma unroll
        for (int i = 0; i < 3; ++i) { const int pc = wid + 8 * i;
            if (pc < NP) {
                if (pc < NCH) glds16s(doff[i], kb_, (unsigned)__builtin_amdgcn_readfirstlane(sbase + pc * 1024));
                else glds16s(doff[i], vb_, (unsigned)__builtin_amdgcn_readfirstlane(sbase + KSLOT + (pc - NCH) * 1024));
            } }
    };
    asm volatile("s_waitcnt vmcnt(0)" ::: "memory");
    dma_tile(0, 0); if (U.nt > 1) dma_tile(1, 1);
    if (NA) { ALAS float* tb = (ALAS float*)(shm + LDS_RPB); for (int i = tid; i < 15 * 31; i += 512) tb[i] = rpb_g[U.head * 465 + i] * LOG2E; }
    bf16x8 qr[ND0];
    const bf16_t* Qw = U.Q + (size_t)(U.q0 + wid * 32 + r32) * U.qpitch + U.qcol;
#pragma unroll
    for (int d0 = 0; d0 < ND0; ++d0) qr[d0] = *(const bf16x8*)(Qw + d0 * 16 + hi * 8);
    if (MLAQ) {
        float f[ND0][8]; float ss = 0.f;
#pragma unroll
        for (int d0 = 0; d0 < ND0; ++d0)
#pragma unroll
            for (int j = 0; j < 8; ++j) { f[d0][j] = bf2f((bf16_t)qr[d0][j]); ss += f[d0][j] * f[d0][j]; }
        ss += __shfl_xor(ss, 32);
        const float rn = rsqrtf(ss * (1.f / 96.f) + EPS) * C2_96;
#pragma unroll
        for (int d0 = 0; d0 < ND0; ++d0)
#pragma unroll
            for (int j = 0; j < 8; ++j) f[d0][j] = f[d0][j] * rn * qgain[d0 * 16 + hi * 8 + j];
        const int t = (int)((U.q0 + wid * 32 + r32) % S); const int grow = t / GW, gcol = t % GW;
#pragma unroll
        for (int part = 0; part < 2; ++part) { const int pos = part ? gcol : grow;
#pragma unroll
            for (int j = 0; j < 8; ++j) { const float cs = T16[pos * 8 + j], sn = T16[512 + pos * 8 + j];
                const float mine = f[4 + part][j], other = __shfl_xor(mine, 32);
                f[4 + part][j] = hi == 0 ? (mine * cs - other * sn) : (other * sn + mine * cs); } }
#pragma unroll
        for (int d0 = 0; d0 < ND0; ++d0)
#pragma unroll
            for (int j = 0; j < 4; ++j) { const unsigned w = cvtpk(f[d0][2 * j], f[d0][2 * j + 1]); qr[d0][2 * j] = (short)(w & 0xffff); qr[d0][2 * j + 1] = (short)(w >> 16); }
    }
    const int grow_w = NA ? 4 * U.rg + (wid >> 1) : 0, c0w = 32 * (wid & 1);
    const int r0w = NA ? min(max(grow_w - 4, 0), 24) : 0;
    const int qc = c0w + r32;
    const int cs_q = min(max(qc - 8, 0), 48);
    float mhat = 0.f, l_reg = 0.f; f32x16 o[2]; o[0] = f32x16{}; o[1] = f32x16{};
    const ALAS char* vp0 = shm + KSLOT + ((lane >> 4) & 1) * 32 + (lane & 3) * 8 + (4 * hi + ((lane & 15) >> 2)) * 64;
    const int NT = U.nt;
    f32x16 a0, a1, b0, b1;
    u32x4 pw0, pw1, pw2, pw3;
    auto wait_tile = [&](int t) {
        if (t + 1 < NT) { if (NP == 20 && wid < 4) AWAIT_BAR(3); else AWAIT_BAR(2); } else AWAIT_BAR(0);
        if (t + 2 < NT) dma_tile(t + 2, (t + 2) & 3);
    };
    auto maskbias = [&](f32x16& c0, f32x16& c1, int t) {
        if (NA && t >= 4) {
            const int krow = U.rmin + (t - 4); const bool rowok = (krow >= r0w) && (krow < r0w + 8);
            const ALAS float* tb = (const ALAS float*)(shm + LDS_RPB) + min(max(krow - grow_w + 7, 0), 14) * 31;
#pragma unroll
            for (int r = 0; r < 16; ++r) {
                const int kc0 = crow(r, hi), kc1 = kc0 + 32;
                { const int rel = kc0 - cs_q; const int bi = min(max(kc0 - qc + 15, 0), 30); const float bv = tb[bi]; c0[r] = (rowok && (unsigned)rel < 16u) ? c0[r] + bv : -INFINITY; }
                { const int rel = kc1 - cs_q; const int bi = min(max(kc1 - qc + 15, 0), 30); const float bv = tb[bi]; c1[r] = (rowok && (unsigned)rel < 16u) ? c1[r] + bv : -INFINITY; }
            }
        }
    };
    f32x16 negm = f32x16{};
    auto decide = [&](f32x16& c0, f32x16& c1, bool first) {
        const float rm = rowmax32(c0, c1);
        if (first || __any(rm > THR)) {
            const float dl = first ? rm : fmaxf(rm, 0.f);
            mhat += dl;
#pragma unroll
            for (int r = 0; r < 16; ++r) { c0[r] -= dl; c1[r] -= dl; }
#pragma unroll
            for (int r = 0; r < 16; ++r) negm[r] = -mhat;
            if (!first) {
                const float f = __builtin_amdgcn_exp2f(-dl);
                l_reg *= f;
                if (hi == 0) wsf[r32] = f;
                asm volatile("s_waitcnt lgkmcnt(0)" ::: "memory");
#pragma unroll
                for (int r = 0; r < 16; ++r) { const float fr_ = wsf[crow(r, hi)]; o[0][r] *= fr_; o[1][r] *= fr_; }
            }
        }
    };
    auto finish = [&](f32x16& c0, f32x16& c1) {
        float sacc = 0.f;
#pragma unroll
        for (int r = 0; r < 16; ++r) { c0[r] = __builtin_amdgcn_exp2f(c0[r]); c1[r] = __builtin_amdgcn_exp2f(c1[r]); sacc += c0[r] + c1[r]; }
        l_reg += sacc;
#pragma unroll
        for (int j = 0; j < 4; ++j) { pw0[j] = cvtpk(c0[2 * j], c0[2 * j + 1]); pw1[j] = cvtpk(c0[8 + 2 * j], c0[9 + 2 * j]); pw2[j] = cvtpk(c1[2 * j], c1[2 * j + 1]); pw3[j] = cvtpk(c1[8 + 2 * j], c1[9 + 2 * j]); }
    };
    auto step = [&](f32x16& c0, f32x16& c1, f32x16& q0, f32x16& q1, int j) {
        wait_tile(j);
#ifdef ATT_DUP_BAR
        asm volatile("s_waitcnt lgkmcnt(0)\n\ts_barrier" ::: "memory");
#endif
        qkt<ND0>(c0, c1, shm + (j & 3) * SLOT, qr, negm, r32, hi);
#ifdef ATT_DUP_MFMA
        { f32x16 d0_, d1_; qkt<ND0>(d0_, d1_, shm + (j & 3) * SLOT, qr, r32, hi); asm volatile("" :: "v"(d0_), "v"(d1_)); }
#endif
#ifdef ATT_DUP_VALU
        { f32x16 e0_ = q0, e1_ = q1; float sacc_ = 0.f;
#pragma unroll
          for (int r = 0; r < 16; ++r) { e0_[r] = __builtin_amdgcn_exp2f(e0_[r] - mhat * 1.0001f); e1_[r] = __builtin_amdgcn_exp2f(e1_[r] - mhat * 1.0001f); sacc_ += e0_[r] + e1_[r]; }
          unsigned w_ = 0;
#pragma unroll
          for (int jj = 0; jj < 8; ++jj) { w_ ^= cvtpk(e0_[2 * jj], e0_[2 * jj + 1]); w_ ^= cvtpk(e1_[2 * jj], e1_[2 * jj + 1]); }
          asm volatile("" :: "v"(sacc_), "v"(w_)); }
#endif
        finish(q0, q1);
        pv(o, vp0 + ((j - 1) & 3) * SLOT, __builtin_bit_cast(bf16x8, pw0), __builtin_bit_cast(bf16x8, pw1), __builtin_bit_cast(bf16x8, pw2), __builtin_bit_cast(bf16x8, pw3));
        maskbias(c0, c1, j);
        decide(c0, c1, false);
    };
    wait_tile(0);
    qkt<ND0>(a0, a1, shm, qr, negm, r32, hi);
    decide(a0, a1, true);
    int j = 1;
#pragma unroll 1
    for (; j + 1 < NT; j += 2) { step(b0, b1, a0, a1, j); step(a0, a1, b0, b1, j + 1); }
    if (j < NT) { step(b0, b1, a0, a1, j); finish(b0, b1); } else finish(a0, a1);
    pv(o, vp0 + ((NT - 1) & 3) * SLOT, __builtin_bit_cast(bf16x8, pw0), __builtin_bit_cast(bf16x8, pw1), __builtin_bit_cast(bf16x8, pw2), __builtin_bit_cast(bf16x8, pw3));
    { auto rr = __builtin_amdgcn_permlane32_swap(__float_as_uint(l_reg), __float_as_uint(l_reg), false, false); l_reg = __uint_as_float(rr[0]) + __uint_as_float(rr[1]); }
    if (hi == 0) wsf[32 + r32] = l_reg;
    asm volatile("s_waitcnt lgkmcnt(0)" ::: "memory");
    float rli[16];
#pragma unroll
    for (int r = 0; r < 16; ++r) rli[r] = __builtin_amdgcn_rcpf(wsf[32 + crow(r, hi)]);
    bf16_t* Ow = U.O + (size_t)(U.q0 + wid * 32) * U.opitch + U.ocol;
    { ALAS bf16_t* stg = (ALAS bf16_t*)(shm + LDS_OST) + wid * 2048;
#pragma unroll
        for (int r = 0; r < 16; ++r) { const int orow = crow(r, hi);
#pragma unroll
            for (int d0 = 0; d0 < 2; ++d0) stg[orow * 64 + d0 * 32 + r32] = f2bf(o[d0][r] * rli[r]); }
        asm volatile("s_waitcnt lgkmcnt(0)" ::: "memory");
#pragma unroll
        for (int i = 0; i < 4; ++i) { const int row = i * 8 + (lane >> 3), ch = lane & 7; const u32x4 v = *(const ALAS u32x4*)(stg + row * 64 + ch * 8); *(u32x4*)(Ow + (size_t)row * U.opitch + ch * 8) = v; } }
    asm volatile("s_waitcnt vmcnt(0) lgkmcnt(0)\n\ts_barrier" ::: "memory");
}
}
#define LAS __attribute__((address_space(3)))
#define XB_TMO      128
#define XB_XCNT(j)  (256  + 64 * (j))
#define XB_XSUB(j)  (1280 + 64 * (j))
#define XB_XGEN(j)  (2304 + 64 * (j))
#define XB_TOP      3328
#define XB_TOPGEN   3392
#define XCD_BAR_WORDS 3456
#define XB_SPIN_CAP (1u << 18)

__device__ __forceinline__ unsigned xb_ld(unsigned* p)              { return __hip_atomic_load(p, __ATOMIC_RELAXED, __HIP_MEMORY_SCOPE_AGENT); }
__device__ __forceinline__ unsigned xb_add(unsigned* p, unsigned v) { return __hip_atomic_fetch_add(p, v, __ATOMIC_RELAXED, __HIP_MEMORY_SCOPE_AGENT); }
__device__ __forceinline__ unsigned xb_xcc_id() { return (unsigned)__builtin_amdgcn_s_getreg((3 << 11) | 20) & 0xFu; }
#define XB_SPIN(cond, bar) do { unsigned _sp = 0; while (cond) { __builtin_amdgcn_s_sleep(1); \
    if ((++_sp & 255u) == 0u) { if (xb_ld(&(bar)[XB_TMO])) break; if (_sp > XB_SPIN_CAP) { atomicAdd(&(bar)[XB_TMO], 1u); break; } } } } while (0)

struct XcdBarrier {
    unsigned* bar; unsigned x;
    volatile LAS unsigned* st;
};

__device__ __forceinline__ XcdBarrier xcd_barrier_post(unsigned* bar, volatile LAS unsigned* st) {
    XcdBarrier b; b.bar = bar; b.x = xb_xcc_id(); b.st = st;
    if (threadIdx.x == 0) (void)xb_add(&bar[XB_XCNT(b.x)], 1u);
    return b;
}
__device__ __forceinline__ void xcd_barrier_complete(unsigned* bar, unsigned x, unsigned& nloc, unsigned& nx) {
    const unsigned G = gridDim.x * gridDim.y * gridDim.z;
    unsigned sum, cnt, mine, sp = 0u;
    for (;;) {
        sum = 0u; cnt = 0u; mine = 0u;
#pragma unroll
        for (unsigned j = 0; j < 16; ++j) { const unsigned c = xb_ld(&bar[XB_XCNT(j)]); sum += c; cnt += (c > 0u) ? 1u : 0u; mine = (j == x) ? c : mine; }
        if (sum == G) break;
        __builtin_amdgcn_s_sleep(1);
        if ((++sp & 255u) == 0u) { if (xb_ld(&bar[XB_TMO])) break; if (sp > XB_SPIN_CAP) { atomicAdd(&bar[XB_TMO], 1u); break; } }
    }
    nloc = mine > 0u ? mine : 1u; nx = cnt > 0u ? cnt : 1u;
}

__device__ __forceinline__ void xcd_barrier(const XcdBarrier& b) {
    asm volatile("s_waitcnt vmcnt(0)" ::: "memory");
    __syncthreads();
    if (threadIdx.x == 0) {
        unsigned* bar = b.bar;
        __builtin_amdgcn_s_waitcnt(0);
        unsigned nloc = b.st[0], nx = b.st[1];
        if (nloc == 0u) { xcd_barrier_complete(bar, b.x, nloc, nx); b.st[0] = nloc; b.st[1] = nx; }
        const unsigned old = xb_add(&bar[XB_XSUB(b.x)], 1u);
        const unsigned gen = old / nloc;
        if (old + 1u == (gen + 1u) * nloc) {
            __builtin_amdgcn_fence(__ATOMIC_RELEASE, "agent");
            asm volatile("s_waitcnt vmcnt(0)" ::: "memory");
            const unsigned og = xb_add(&bar[XB_TOP], 1u);
            const unsigned tg = og / nx;
            if (og + 1u == (tg + 1u) * nx) xb_add(&bar[XB_TOPGEN], 1u);
            else XB_SPIN(xb_ld(&bar[XB_TOPGEN]) == tg, bar);
            __builtin_amdgcn_fence(__ATOMIC_ACQUIRE, "agent");
            xb_add(&bar[XB_XGEN(b.x)], 1u);
            asm volatile("s_waitcnt vmcnt(0)" ::: "memory");
        } else {
            XB_SPIN(xb_ld(&bar[XB_XGEN(b.x)]) == gen, bar);
            __builtin_amdgcn_fence(__ATOMIC_ACQUIRE, "agent");
            asm volatile("s_waitcnt vmcnt(0)" ::: "memory");
        }
    }
    __syncthreads();
}
namespace mk {
#define MLAS __attribute__((address_space(3)))
constexpr int NWAVES = 8, NTHR = 512;
constexpr int RING_BYTES = 131072;
constexpr int LDS_BYTES = 147456;
constexpr int NPHASE = 16;
typedef unsigned v4u __attribute__((ext_vector_type(4)));
typedef float f32x4 __attribute__((ext_vector_type(4)));

struct Ctx {
    Params p; MLAS unsigned char* lds; int tid, lane, wave, G, vcu, bid;
};
__device__ __forceinline__ unsigned pk2(float lo, float hi) { return (unsigned)f2bf(lo) | ((unsigned)f2bf(hi) << 16); }

enum { W_IN0 = 0, W_OUT0, W_GU0, W_D0, W_IN1, W_UQ, W_UKV, W_OUT1, W_GU1, W_D1, NWMAT };
struct SrcBlk { const float* W; int ld; int col; const float* kscale; };
__device__ __forceinline__ SrcBlk src_of(const Params& p, int mat, int nb) {
    SrcBlk s; s.kscale = nullptr; const int pn = nb >> 3, q = nb & 7, bj = q >> 2, wc = q & 3;
    switch (mat) {
    case W_IN0: s.W = p.in[I0_WIN]; s.ld = L0_IN; s.col = 256 * pn + 64 * wc + 32 * bj; break;
    case W_OUT0: s.W = p.in[I0_WOUT]; s.ld = D; s.col = 32 * nb; break;
    case W_GU0: s.W = bj ? p.in[I0_WU] : p.in[I0_WG]; s.ld = FF; s.col = 128 * pn + 32 * wc; break;
    case W_D0: s.W = p.in[I0_WD]; s.ld = D; s.col = 32 * nb; break;
    case W_IN1: s.W = p.in[I1_WIN]; s.ld = L1_IN;
        if (pn == 0) s.col = 128 * bj + 32 * wc;
        else if (pn == 1) { if (bj == 0) s.col = 256 + 32 * wc; else s.col = 640; }
        else if (pn == 2) s.col = 384 + 128 * bj + 32 * wc;
        else if (pn < 5) s.col = 672 + (pn - 3) * 256 + 64 * wc + 32 * bj;
        else if (pn < 7) s.col = 1184 + (pn - 5) * 256 + 64 * wc + 32 * bj;
        else s.col = 1696 + (pn - 7) * 256 + 64 * wc + 32 * bj;
        break;
    case W_UQ: s.W = p.in[I1_WUQ]; s.ld = 768; s.col = 32 * nb; s.kscale = p.in[I1_QAG]; break;
    case W_UKV: s.W = p.in[I1_WUKV]; s.ld = 1024; s.col = (2 * pn + (wc >> 1)) * 128 + (wc & 1) * 64 + 32 * bj; s.kscale = p.in[I1_KVAG]; break;
    case W_OUT1: s.W = p.in[I1_WOUT]; s.ld = D; s.col = 32 * nb; break;
    case W_GU1: s.W = bj ? p.in[I1_WU] : p.in[I1_WG]; s.ld = FF; s.col = 128 * pn + 32 * wc; break;
    default: s.W = p.in[I1_WD]; s.ld = D; s.col = 32 * nb; break;
    }
    return s;
}
struct WMat { size_t ws_off; int K, N; };
__host__ __device__ constexpr WMat wmat(int mat) {
    switch (mat) {
    case W_IN0: return {WS_W_IN0, D, 1536}; case W_OUT0: return {WS_W_OUT0, D, D}; case W_GU0: return {WS_W_GU0, D, 2 * FF}; case W_D0: return {WS_W_D0, FF, D};
    case W_IN1: return {WS_W_IN1, D, L1_INP}; case W_UQ: return {WS_W_UQ, 384, 768}; case W_UKV: return {WS_W_UKV, 256, 1024}; case W_OUT1: return {WS_W_OUT1, D, D};
    case W_GU1: return {WS_W_GU1, D, 2 * FF}; default: return {WS_W_D1, FF, D};
    }
}
template <int mat> __device__ __forceinline__ void transpose_item(const Params& p, int item, MLAS float* scr, int lane) {
    const WMat wm = wmat(mat); const int nblk = wm.N / 32, kb = item / nblk, nb = item % nblk, k0 = 64 * kb;
    const SrcBlk s = src_of(p, mat, nb);
    bf16_t* WT = (bf16_t*)(p.ws + wm.ws_off);
    const int c = lane & 7;
    if (s.W == nullptr) {
#pragma unroll
        for (int j = 0; j < 4; ++j) { const int n = (lane >> 3) + 8 * j; *(v4u*)(WT + (size_t)(32 * nb + n) * wm.K + k0 + 8 * c) = (v4u){0u, 0u, 0u, 0u}; }
        return;
    }
    MLAS float* t0 = scr; MLAS float* t1 = scr + 64 * 33;
    const bool fused_pool = (mat == W_OUT0 && kb < 4);
    const float* wsrc = s.W + (size_t)k0 * s.ld + s.col + (lane & 31);
#pragma unroll 8
    for (int i = 0; i < 32; ++i) { const int kk = 2 * i + (lane >> 5); t0[kk * 33 + (lane & 31)] = wsrc[(size_t)kk * s.ld]; }
    if (s.kscale) {
#pragma unroll 8
        for (int i = 0; i < 32; ++i) { const int kk = 2 * i + (lane >> 5); t0[kk * 33 + (lane & 31)] *= s.kscale[k0 + kk]; }
    }
    if (fused_pool) {
#pragma unroll 8
        for (int i = 0; i < 32; ++i) { const int kk = 2 * i + (lane >> 5); t0[kk * 33 + (lane & 31)] *= p.in[I0_POOLS][k0 + kk]; }
    }
    asm volatile("s_waitcnt lgkmcnt(0)" ::: "memory");
    MLAS float* src = t0;
    if (fused_pool) {
        const float* pw = p.in[I0_POOLW] + kb * 4096; const int nn = lane & 31, ch = lane >> 5;
        for (int cc = ch; cc < 64; cc += 2) { float a = 0.f;
#pragma unroll 8
            for (int d = 0; d < 64; ++d) a += pw[cc * 64 + d] * t0[d * 33 + nn];
            t1[cc * 33 + nn] = a; }
        asm volatile("s_waitcnt lgkmcnt(0)" ::: "memory");
        src = t1;
    }
#pragma unroll
    for (int j = 0; j < 4; ++j) { const int n = (lane >> 3) + 8 * j; const MLAS float* sp = src + (8 * c) * 33 + n;
        v4u o; o.x = pk2(sp[0 * 33], sp[1 * 33]); o.y = pk2(sp[2 * 33], sp[3 * 33]); o.z = pk2(sp[4 * 33], sp[5 * 33]); o.w = pk2(sp[6 * 33], sp[7 * 33]);
        *(v4u*)(WT + (size_t)(32 * nb + n) * wm.K + k0 + 8 * c) = o; }
    asm volatile("s_waitcnt lgkmcnt(0)" ::: "memory");
}

__device__ __forceinline__ void phase_prologue(Ctx& C) {
    const Params& p = C.p;
    MLAS float* sil = (MLAS float*)C.lds;
    MLAS float* red = (MLAS float*)(C.lds + 9 * 1024 * 4);
    for (int i = C.tid; i < 9 * D; i += NTHR) { const int j = i / D, k = i % D; const float c = (j < 8) ? p.in[I_C][j * D + k] : p.in[I_CCTX][k]; sil[i] = c / (1.f + expf(-c)); }
    __syncthreads();
    float* MOD = (float*)(p.ws + WS_MOD);
#ifndef P0MASK
#define P0MASK 15
#endif
    if (P0MASK & 1)
    for (int it = C.vcu; it < 192; it += C.G) {
        const int l = it / 96, n0 = (it % 96) * 64; const float* w = (l ? p.in[I1_ADAW] : p.in[I0_ADAW]) + n0 + C.lane;
        float acc[9];
#pragma unroll
        for (int j = 0; j < 9; ++j) acc[j] = 0.f;
        const int kb = C.wave * 128;
#pragma unroll 4
        for (int k = kb; k < kb + 128; ++k) { const float wv = w[(size_t)k * 6144];
#pragma unroll
            for (int j = 0; j < 9; ++j) acc[j] += sil[j * D + k] * wv; }
#pragma unroll
        for (int j = 0; j < 9; ++j) red[(C.wave * 9 + j) * 64 + C.lane] = acc[j];
        __syncthreads();
        for (int i = C.tid; i < 9 * 64; i += NTHR) { const int j = i / 64, c = i % 64; float s = 0.f;
#pragma unroll
            for (int wv = 0; wv < 8; ++wv) s += red[(wv * 9 + j) * 64 + c];
            MOD[(size_t)(l * 9 + j) * 6144 + n0 + c] = s + (l ? p.in[I1_ADAB] : p.in[I0_ADAB])[n0 + c]; }
        __syncthreads();
    }
    __syncthreads();
    const int gw = C.vcu * NWAVES + C.wave, NGW = C.G * NWAVES;
    MLAS float* scr = (MLAS float*)(C.lds + C.wave * 16896);
    if (P0MASK & 2) {
        int rot = 0;
#define TR_MAT(M) { constexpr int ni = (wmat(M).K / 64) * (wmat(M).N / 32); int first = gw - rot; if (first < 0) first += NGW; \
            for (int it = first; it < ni; it += NGW) transpose_item<M>(p, it, scr, C.lane); rot = (rot + ni) % NGW; }
        TR_MAT(W_IN0) TR_MAT(W_OUT0) TR_MAT(W_GU0) TR_MAT(W_D0) TR_MAT(W_IN1) TR_MAT(W_UQ) TR_MAT(W_UKV) TR_MAT(W_OUT1) TR_MAT(W_GU1) TR_MAT(W_D1)
#undef TR_MAT
    }
    if ((P0MASK & 4) && C.bid == C.G - 1) {
        float* T32 = (float*)(p.ws + WS_ROPE32); float* T16 = (float*)(p.ws + WS_ROPE16);
        for (int i = C.tid; i < 1024; i += NTHR) { const int pos = i >> 4, f = i & 15; const float ang = (float)pos * powf(10000.0f, -((float)f * 2.0f) / 32.0f); T32[i] = cosf(ang); T32[1024 + i] = sinf(ang); }
        for (int i = C.tid; i < 512; i += NTHR) { const int pos = i >> 3, f = i & 7; const float ang = (float)pos * powf(10000.0f, -((float)f * 2.0f) / 16.0f); T16[i] = cosf(ang); T16[512 + i] = sinf(ang); }
    }
    if (P0MASK & 8) { float* SSQ = (float*)(p.ws + WS_SSQ); float* SSKV = (float*)(p.ws + WS_SSKV);
        for (int i = C.bid * NTHR + C.tid; i < MT; i += C.G * NTHR) { SSQ[i] = 0.f; SSKV[i] = 0.f; } }
}

__device__ __forceinline__ void phase_norm(Ctx& C, const float* xl, const float* xc, const float* gain, int layer, int sh_chunk, int sc_chunk, int nrows) {
    const int gw = C.vcu * NWAVES + C.wave, NGW = C.G * NWAVES;
    bf16_t* XN = (bf16_t*)(C.p.ws + WS_XN); const float* MODb = (const float*)(C.p.ws + WS_MOD) + (size_t)layer * 9 * 6144;
    for (int m = gw; m < nrows; m += NGW) {
        const float* xr = m < ML ? xl + (size_t)m * D : xc + (size_t)(m - ML) * D;
        const float* mod = MODb + (size_t)modidx_of(m) * 6144;
        f32x4 v[4]; float ss = 0.f;
#pragma unroll
        for (int j = 0; j < 4; ++j) { v[j] = *(const f32x4*)(xr + 4 * C.lane + 256 * j); ss += (v[j][0] * v[j][0] + v[j][1] * v[j][1]) + (v[j][2] * v[j][2] + v[j][3] * v[j][3]); }
        ss = wave_sum(ss);
        const float r = rsqrtf(ss * (1.f / D) + EPS);
#pragma unroll
        for (int j = 0; j < 4; ++j) { const int c = 4 * C.lane + 256 * j;
            const f32x4 g = *(const f32x4*)(gain + c), sc = *(const f32x4*)(mod + sc_chunk * D + c), sh = *(const f32x4*)(mod + sh_chunk * D + c);
            const f32x4 y = ((v[j] * r) * g) * (sc + 1.f) + sh;
            uint2 o; o.x = pk2(y[0], y[1]); o.y = pk2(y[2], y[3]);
            *(uint2*)(XN + (size_t)m * D + c) = o; }
    }
}

__device__ __forceinline__ void phase_pool(Ctx& C) {
    const bf16_t* A0 = (const bf16_t*)(C.p.ws + WS_A0); bf16_t* MIX = (bf16_t*)(C.p.ws + WS_MIX);
    const int gt = C.vcu * NTHR + C.tid, NGT = C.G * NTHR;
    for (int it = gt; it < MT * 32; it += NGT) {
        const int m = it >> 5, c8 = (it & 31) * 8, g = c8 >> 6, w = 2 << g;
        int t, T; if (m < ML) { t = m % S; T = S; } else { t = (m - ML) % CTX; T = CTX; }
        const int base = m - t; int lo = t - w / 2; if (lo < 0) lo = 0; int hi = t - w / 2 + w; if (hi > T) hi = T;
        float s[8];
#pragma unroll
        for (int e = 0; e < 8; ++e) s[e] = 0.f;
        for (int j = lo; j < hi; ++j) { const v4u q = *(const v4u*)(A0 + (size_t)(base + j) * 256 + c8);
#pragma unroll
            for (int e = 0; e < 4; ++e) { s[2 * e] += __uint_as_float(q[e] << 16); s[2 * e + 1] += __uint_as_float(q[e] & 0xffff0000u); } }
        const v4u q = *(const v4u*)(A0 + (size_t)m * 256 + c8); const float inv = 1.f / (float)(hi - lo);
        v4u o;
#pragma unroll
        for (int e = 0; e < 4; ++e) o[e] = pk2(s[2 * e] * inv - __uint_as_float(q[e] << 16), s[2 * e + 1] * inv - __uint_as_float(q[e] & 0xffff0000u));
        *(v4u*)(MIX + (size_t)m * D + c8) = o;
    }
}

__device__ __forceinline__ void phase_attn0(Ctx& C) {
    const Params& p = C.p;
    MLAS char* shm = (MLAS char*)C.lds;
    att::UnitDesc U; U.Q = (const bf16_t*)(p.ws + WS_Q0); U.qpitch = 768; U.K = (const bf16_t*)(p.ws + WS_K0); U.kpitch = 256; U.V = (const bf16_t*)(p.ws + WS_V0); U.vpitch = 256;
    U.O = (bf16_t*)(p.ws + WS_MIX); U.opitch = D; U.rg = 0; U.rmin = 0; U.head = 0;
    for (int u = C.vcu; u < 768 + 96; u += C.G) {
        if (u < 768) { const int qb = u & 7, bh = u >> 3, h = bh % 12, b = bh / 12;
            U.q0 = (long)b * S + 256 * qb; U.qcol = h * 64; U.kcol = (h / 3) * 64; U.vcol = (h / 3) * 64; U.ocol = 256 + h * 64; U.kv0 = b * SK; U.nt = SK / 64; }
        else { const int bh = u - 768, h = bh % 12, b = bh / 12;
            U.q0 = (long)ML + 256 * b; U.qcol = h * 64; U.kcol = (h / 3) * 64; U.vcol = (h / 3) * 64; U.ocol = 256 + h * 64; U.kv0 = b * SK; U.nt = CTX / 64; }
        att::attn_unit<64, false, false>(U, shm, nullptr, nullptr, nullptr);
    }
    phase_pool(C);
}
__device__ __forceinline__ void phase_attn1(Ctx& C) {
    const Params& p = C.p;
    MLAS char* shm = (MLAS char*)C.lds;
    const float* T16 = (const float*)(p.ws + WS_ROPE16);
    att::UnitDesc U; U.O = (bf16_t*)(p.ws + WS_MIX); U.opitch = D;
    for (int u = C.vcu; u < 1024; u += C.G) {
        const int uu = u & 511, qb = uu & 7, h = (uu >> 3) & 7, b = uu >> 6;
        U.q0 = (long)b * S + 256 * qb; U.kv0 = b * SK; U.head = h;
        if (u < 512) {
            U.Q = (const bf16_t*)(p.ws + WS_MQ); U.qpitch = 768; U.qcol = h * 96; U.K = (const bf16_t*)(p.ws + WS_MK); U.kpitch = 768; U.kcol = h * 96;
            U.V = (const bf16_t*)(p.ws + WS_MV); U.vpitch = 512; U.vcol = h * 64; U.ocol = h * 64; U.nt = SK / 64; U.rg = 0; U.rmin = 0;
            att::attn_unit<96, false, true>(U, shm, p.in[I1_MQG], T16, nullptr);
        } else {
            U.Q = (const bf16_t*)(p.ws + WS_NQ); U.qpitch = 512; U.qcol = h * 64; U.K = (const bf16_t*)(p.ws + WS_NK); U.kpitch = 512; U.kcol = h * 64;
            U.V = (const bf16_t*)(p.ws + WS_NV); U.vpitch = 512; U.vcol = h * 64; U.ocol = 512 + h * 64; U.rg = qb;
            const int rmin = min(max(4 * qb - 4, 0), 24), rmax = min(max(4 * qb + 3 - 4, 0), 24) + 7;
            U.rmin = rmin; U.nt = 4 + (rmax - rmin + 1);
            att::attn_unit<64, true, false>(U, shm, nullptr, nullptr, p.in[I1_RPB]);
        }
    }
}

__global__ void __launch_bounds__(NTHR, 2) mega(Params p, int ph_lo, int ph_hi) {
    extern __shared__ __attribute__((aligned(16))) unsigned char lds_raw[];
    cg::grid_group grid = cg::this_grid();
    Ctx C; C.p = p; C.lds = (MLAS unsigned char*)lds_raw; C.tid = threadIdx.x; C.lane = C.tid & 63; C.wave = __builtin_amdgcn_readfirstlane(C.tid >> 6);
    C.G = gridDim.x; C.bid = blockIdx.x; C.vcu = (C.G % 8 == 0) ? (C.bid % 8) * (C.G / 8) + C.bid / 8 : C.bid;
    volatile LAS unsigned* bst = (volatile LAS unsigned*)(C.lds + LDS_BYTES - 64);
    if (C.tid < 2) bst[C.tid] = 0u;
    __syncthreads();
    unsigned* barw = (unsigned*)(p.ws + WS_BARRIER);
    XcdBarrier bar; bar.bar = barw; bar.x = 0; bar.st = nullptr;
    if (ph_hi - ph_lo > 1) bar = xcd_barrier_post(barw, bst);
    float* out = p.out; float* xrc = (float*)(p.ws + WS_XRC);
    const float* MOD = (const float*)(p.ws + WS_MOD);
    bf16_t* XN = (bf16_t*)(p.ws + WS_XN); bf16_t* MIX = (bf16_t*)(p.ws + WS_MIX); bf16_t* H = (bf16_t*)(p.ws + WS_H);
    const float* T32 = (const float*)(p.ws + WS_ROPE32); const float* T16 = (const float*)(p.ws + WS_ROPE16);
#define WSB(off) ((bf16_t*)(p.ws + (off)))
#ifndef PHMASK
#define PHMASK 0xFFFF
#endif
#ifndef REPMASK
#define REPMASK 0
#endif
#ifndef NSYNC
#define NSYNC 1
#endif
#define PH(k) if (((PHMASK >> (k)) & 1) && ph_lo <= (k) && (k) < ph_hi) for (int rep_ = 0; rep_ < (((REPMASK >> (k)) & 1) ? 2 : 1); ++rep_, (((REPMASK >> (k)) & 1) && rep_ == 1 ? xcd_barrier(bar) : (void)0))
#ifndef USE_CG_SYNC
#define USE_CG_SYNC 0
#endif
#define SEAM(k) if (ph_lo <= (k) && (k) + 1 < ph_hi) { for (int s_ = 0; s_ < NSYNC; ++s_) { if (USE_CG_SYNC || ph_hi > 1000) grid.sync(); else xcd_barrier(bar); } }
    PH(0) { phase_prologue(C); } SEAM(0);
    PH(1) { phase_norm(C, p.in[I_X], p.in[I_CTX], p.in[I0_NMIX], 0, 0, 1, MT); } SEAM(1);
    PH(2) { pg8::Gemm g{XN, WSB(WS_W_IN0), MT, 1536, D}; pg8::StaticOrder So; So.init(MT, 1536, C.G, C.bid);
        epi::EpiIn0 E{WSB(WS_A0), WSB(WS_Q0), WSB(WS_K0), WSB(WS_V0), p.in[I0_QG], p.in[I0_KG], T32};
        pg8::gemm_phase<epi::EpiIn0, pg8::StaticOrder, true, true>(C.lds, g, So, E); } SEAM(2);
    PH(3) { phase_attn0(C); } SEAM(3);
    PH(4) { pg8::Gemm g{MIX, WSB(WS_W_OUT0), MT, D, D}; pg8::StaticOrder So; So.init(MT, D, C.G, C.bid);
        epi::EpiResid E{p.in[I_X], p.in[I_CTX], out, xrc, MOD + 2 * D};
        pg8::gemm_phase<epi::EpiResid, pg8::StaticOrder, true, true>(C.lds, g, So, E); } SEAM(4);
    PH(5) { phase_norm(C, out, xrc, p.in[I0_NFFN], 0, 3, 4, MT); } SEAM(5);
    PH(6) { pg8::Gemm g{XN, WSB(WS_W_GU0), MT, 2 * FF, D}; pg8::StaticOrder So; So.init(MT, 2 * FF, C.G, C.bid);
        epi::EpiSwiGLU E{H};
        pg8::gemm_phase<epi::EpiSwiGLU, pg8::StaticOrder, true, true>(C.lds, g, So, E); } SEAM(6);
    PH(7) { pg8::Gemm g{H, WSB(WS_W_D0), MT, D, FF}; pg8::StaticOrder So; So.init(MT, D, C.G, C.bid);
        epi::EpiResid E{out, xrc, out, xrc, MOD + 5 * D};
        pg8::gemm_phase<epi::EpiResid, pg8::StaticOrder, true, true>(C.lds, g, So, E); } SEAM(7);
    PH(8) { phase_norm(C, out, xrc, p.in[I1_NMIX], 1, 0, 1, MT); } SEAM(8);
    PH(9) { pg8::Gemm g{XN, WSB(WS_W_IN1), MT, L1_INP, D}; pg8::StaticOrder So; So.init(MT, L1_INP, C.G, C.bid);
        epi::EpiIn1 E{WSB(WS_CQ), WSB(WS_CKV), WSB(WS_NQ), WSB(WS_NK), WSB(WS_NV), (float*)(p.ws + WS_KR), (float*)(p.ws + WS_SSQ), (float*)(p.ws + WS_SSKV), p.in[I1_NQG], p.in[I1_NKG]};
        pg8::gemm_phase<epi::EpiIn1, pg8::StaticOrder, true, true>(C.lds, g, So, E); } SEAM(9);
    PH(10) {
#ifndef NO_QUP
        { pg8::Gemm g{WSB(WS_CQ), WSB(WS_W_UQ), ML, 768, 384}; pg8::StaticOrder So; So.init(ML, 768, C.G, C.bid);
          epi::EpiQUp E{WSB(WS_MQ), (const float*)(p.ws + WS_SSQ)};
          pg8::gemm_phase<epi::EpiQUp, pg8::StaticOrder, true, true>(C.lds, g, So, E); }
#endif
#ifndef NO_KVUP
        { pg8::Gemm g{WSB(WS_CKV), WSB(WS_W_UKV), MT, 1024, 256}; pg8::StaticOrder So; So.init(MT, 1024, C.G, C.bid);
          epi::EpiKvUp E{WSB(WS_MK), WSB(WS_MV), (const float*)(p.ws + WS_SSKV), (const float*)(p.ws + WS_KR), p.in[I1_MKG], T16};
          pg8::gemm_phase<epi::EpiKvUp, pg8::StaticOrder, true, true>(C.lds, g, So, E); }
#endif
    } SEAM(10);
    PH(11) { phase_attn1(C); } SEAM(11);
    PH(12) { pg8::Gemm g{MIX, WSB(WS_W_OUT1), ML, D, D}; pg8::StaticOrder So; So.init(ML, D, C.G, C.bid);
        epi::EpiResid E{out, xrc, out, xrc, MOD + 9 * 6144 + 2 * D};
        pg8::gemm_phase<epi::EpiResid, pg8::StaticOrder, true, true>(C.lds, g, So, E); } SEAM(12);
    PH(13) { phase_norm(C, out, xrc, p.in[I1_NFFN], 1, 3, 4, ML); } SEAM(13);
    PH(14) { pg8::Gemm g{XN, WSB(WS_W_GU1), ML, 2 * FF, D}; pg8::StaticOrder So; So.init(ML, 2 * FF, C.G, C.bid);
        epi::EpiSwiGLU E{H};
        pg8::gemm_phase<epi::EpiSwiGLU, pg8::StaticOrder, true, true>(C.lds, g, So, E); } SEAM(14);
    PH(15) { pg8::Gemm g{H, WSB(WS_W_D1), ML, D, FF}; pg8::StaticOrder So; So.init(ML, D, C.G, C.bid);
        epi::EpiResid E{out, xrc, out, xrc, MOD + 9 * 6144 + 5 * D};
        pg8::gemm_phase<epi::EpiResid, pg8::StaticOrder, true, true>(C.lds, g, So, E); }
    if (ph_hi - ph_lo > 1 && C.bid == 0 && C.tid == 0) { if (xb_ld(&barw[XB_TMO]) != 0u) out[0] = __builtin_nanf(""); }
#undef PH
#undef SEAM
#undef WSB
}
}
#ifndef MK_DEBUG
#define MK_DEBUG 0
#endif
static int g_grid = 0;
static bool mega_setup() {
    if (g_grid) return g_grid > 0;
    int dev = 0, cus = 0, per_cu = 0;
    if (hipGetDevice(&dev) != hipSuccess || hipDeviceGetAttribute(&cus, hipDeviceAttributeMultiprocessorCount, dev) != hipSuccess) { g_grid = -1; return false; }
    if (hipFuncSetAttribute((const void*)mk::mega, hipFuncAttributeMaxDynamicSharedMemorySize, mk::LDS_BYTES) != hipSuccess) { fprintf(stderr, "kernel_launch: hipFuncSetAttribute failed\n"); g_grid = -1; return false; }
    if (hipOccupancyMaxActiveBlocksPerMultiprocessor(&per_cu, (const void*)mk::mega, mk::NTHR, mk::LDS_BYTES) != hipSuccess || per_cu < 1) { fprintf(stderr, "kernel_launch: occupancy query says %d\n", per_cu); g_grid = -1; return false; }
    g_grid = cus;
    fprintf(stderr, "kernel_launch: %d CUs, occupancy %d blocks/CU, grid %d\n", cus, per_cu, g_grid);
    return true;
}
static void launch_phases(const Params& p, int lo, int hi, hipStream_t st) {
    Params pp = p; int l = lo, h = hi;
    void* args[] = {&pp, &l, &h};
    hipError_t e;
    if (hi - lo > 1) e = hipLaunchCooperativeKernel((const void*)mk::mega, dim3(g_grid), dim3(mk::NTHR), args, mk::LDS_BYTES, st);
    else e = hipLaunchKernel((const void*)mk::mega, dim3(g_grid), dim3(mk::NTHR), args, mk::LDS_BYTES, st);
    if (e != hipSuccess) fprintf(stderr, "kernel_launch: launch [%d,%d) failed: %s\n", lo, hi, hipGetErrorString(e));
}
#if MK_DEBUG
static void launch_debug(const Params& p, hipStream_t st) {
    using namespace nv;
    unsigned* err = (unsigned*)(p.ws + WS_CTL) + 64;
    float* out = p.out; float* xrc = (float*)(p.ws + WS_XRC);
    const float* x = p.in[I_X]; const float* cx = p.in[I_CTX];
    const size_t att_sm = 4 * (SK + 128) * sizeof(float);
    const int SR = 4096;
    float* snapL = (float*)(p.ws + WS_SNAP); float* snapC = snapL + (size_t)SR * D;
    float* snapB = (float*)(p.ws + WS_BIG);
    hipMemsetAsync(p.ws + WS_CTL, 0, 4096, st);
    launch_phases(p, 0, 1, st);  k_adaln<true><<<dim3(6144 / 256, 9, 2), 256, 0, st>>>(p, err + 0);
    launch_phases(p, 1, 2, st);  k_norm<true><<<MT / 4, 256, 0, st>>>(p, x, cx, I0_NMIX, 0, 0, 1, MT, err + 1);
    launch_phases(p, 2, 3, st);  k_in0<true><<<MT / R, 256, (R * D + R * L0_IN) * 4, st>>>(p, err + 2);
    launch_phases(p, 3, 4, st);  k_attn<true, 0><<<dim3(ML / 4, 12), 256, att_sm, st>>>(p, err + 3);
                                 k_attn<true, 1><<<dim3(MC / 4, 12), 256, att_sm, st>>>(p, err + 16);
                                 k_pool0<true><<<MT, 256, 0, st>>>(p, err + 17);
    launch_phases(p, 4, 5, st);  k_out<true, 0><<<MT / R, 256, (R * D + R * 256) * 4, st>>>(p, x, cx, out, xrc, 0, err + 4);
    launch_phases(p, 5, 6, st);  k_norm<true><<<MT / 4, 256, 0, st>>>(p, out, xrc, I0_NFFN, 0, 3, 4, MT, err + 5);
    launch_phases(p, 6, 7, st);  k_ffn_gu<true, 0><<<MT / R, 256, R * D * 4, st>>>(p, err + 6);
    hipMemcpyAsync(snapL, out, (size_t)SR * D * 4, hipMemcpyDeviceToDevice, st); hipMemcpyAsync(snapC, xrc, (size_t)MC * D * 4, hipMemcpyDeviceToDevice, st);
    launch_phases(p, 7, 8, st);  k_ffn_d<true, 0><<<SR / R, 256, R * FF * 4, st>>>(p, snapL, snapC, out, xrc, 0, err + 7);
                                 k_ffn_d<true, 0><<<MC / R, 256, R * FF * 4, st>>>(p, snapL, snapC, out, xrc, ML, err + 7);
    launch_phases(p, 8, 9, st);  k_norm<true><<<MT / 4, 256, 0, st>>>(p, out, xrc, I1_NMIX, 1, 0, 1, MT, err + 8);
    launch_phases(p, 9, 10, st); k_in1<true><<<MT / R, 256, (R * D + R * L1_IN) * 4, st>>>(p, err + 9);
    launch_phases(p, 10, 11, st); k_mlaq<true><<<ML / R, 256, R * 384 * 4, st>>>(p, err + 10);
                                 k_mlakv<true><<<MT / R, 256, (R * 256 + R * 1024) * 4, st>>>(p, err + 19);
    launch_phases(p, 11, 12, st); k_attn<true, 2><<<dim3(ML / 4, 8), 256, att_sm, st>>>(p, err + 11);
                                 k_attn<true, 3><<<dim3(ML / 4, 8), 256, att_sm, st>>>(p, err + 18);
    hipMemcpyAsync(snapB, out, (size_t)SR * D * 4, hipMemcpyDeviceToDevice, st);
    launch_phases(p, 12, 13, st); k_out<true, 1><<<SR / R, 256, (R * D + R * 256) * 4, st>>>(p, snapB, snapC, out, xrc, 0, err + 12);
    launch_phases(p, 13, 14, st); k_norm<true><<<ML / 4, 256, 0, st>>>(p, out, xrc, I1_NFFN, 1, 3, 4, ML, err + 13);
    launch_phases(p, 14, 15, st); k_ffn_gu<true, 1><<<ML / R, 256, R * D * 4, st>>>(p, err + 14);
    hipMemcpyAsync(snapL, out, (size_t)SR * D * 4, hipMemcpyDeviceToDevice, st);
    launch_phases(p, 15, 16, st); k_ffn_d<true, 1><<<SR / R, 256, R * FF * 4, st>>>(p, snapL, snapC, out, xrc, 0, err + 15);
    k_report<<<1, 1, 0, st>>>(p, 20, 0.15f);
}
#endif
extern "C" void kernel_launch(void* const* d_in, const int* in_sizes, int n_in, void* d_out, int out_size, void* d_ws, size_t ws_size, hipStream_t stream) {
    if (n_in != N_IN || out_size != ML * D || ws_size < WS_END) { fprintf(stderr, "kernel_launch: unexpected shapes n_in=%d out=%d ws=%zu\n", n_in, out_size, ws_size); return; }
    if (!mega_setup()) return;
    Params p{};
    for (int i = 0; i < N_IN; ++i) p.in[i] = (const float*)d_in[i];
    p.out = (float*)d_out; p.ws = (unsigned char*)d_ws;
#if MK_DEBUG
    launch_debug(p, stream);
#else
    if (hipMemsetAsync((char*)d_ws + WS_BARRIER, 0, 16 * 1024, stream) != hipSuccess) { fprintf(stderr, "kernel_launch: memset failed\n"); return; }
    launch_phases(p, 0, mk::NPHASE, stream);
#endif
}
```

```cpp
#include <hip/hip_runtime.h>
#include <hip/hip_cooperative_groups.h>
#include <cstdio>
#include <cstdint>
namespace cg = cooperative_groups;

typedef unsigned short bf16_t;
constexpr int D = 1024, NB = 8, S = 2048, CTX = 256, SK = S + CTX, ML = NB * S, MC = NB * CTX, MT = ML + MC, FF = 2816;
constexpr int GW = 64;
constexpr int L0_IN = 1536, L1_IN = 2208, L1_INP = 2304;
constexpr float EPS = 1e-6f;
constexpr float LOG2E = 1.4426950408889634f;
constexpr float C2_64 = 0.125f * LOG2E;
constexpr float C2_96 = 0.10206207261596577f * LOG2E;

enum { I_X = 0, I_C, I_CTX, I_CCTX,
       I0_ADAW, I0_ADAB, I0_NMIX, I0_NFFN, I0_WIN, I0_POOLW, I0_POOLS, I0_QG, I0_KG, I0_WOUT, I0_WG, I0_WU, I0_WD,
       I1_ADAW, I1_ADAB, I1_NMIX, I1_NFFN, I1_WIN, I1_QAG, I1_KVAG, I1_WUQ, I1_WUKV, I1_MQG, I1_MKG, I1_NQG, I1_NKG, I1_RPB, I1_WOUT, I1_WG, I1_WU, I1_WD, N_IN };

constexpr size_t MiB = 1u << 20;
constexpr size_t WS_CTL = 0;
constexpr size_t WS_BARRIER = 16 * 1024;
constexpr size_t WS_MOD = 64 * 1024;
constexpr size_t WS_SSQ = 512 * 1024;
constexpr size_t WS_SSKV = 600 * 1024;
constexpr size_t WS_ROPE32 = 700 * 1024;
constexpr size_t WS_ROPE16 = 712 * 1024;
constexpr size_t WS_W_IN0 = 1 * MiB;
constexpr size_t WS_W_OUT0 = 4 * MiB;
constexpr size_t WS_W_GU0 = 6 * MiB;
constexpr size_t WS_W_D0 = 17 * MiB;
constexpr size_t WS_W_IN1 = 23 * MiB;
constexpr size_t WS_W_UQ = 28 * MiB;
constexpr size_t WS_W_UKV = 29 * MiB;
constexpr size_t WS_W_OUT1 = 30 * MiB;
constexpr size_t WS_W_GU1 = 32 * MiB;
constexpr size_t WS_W_D1 = 43 * MiB;
constexpr size_t WS_XRC = 49 * MiB;
constexpr size_t WS_XN = 57 * MiB;
constexpr size_t WS_MIX = WS_XN;
constexpr size_t WS_BIG = 96 * MiB;
constexpr size_t WS_H = WS_BIG;
constexpr size_t WS_A0 = WS_BIG;
constexpr size_t WS_Q0 = WS_BIG + 9 * MiB;
constexpr size_t WS_K0 = WS_BIG + 36 * MiB;
constexpr size_t WS_V0 = WS_BIG + 45 * MiB;
constexpr size_t WS_CQ = WS_BIG;
constexpr size_t WS_CKV = WS_BIG + 14 * MiB;
constexpr size_t WS_NQ = WS_BIG + 23 * MiB;
constexpr size_t WS_NK = WS_BIG + 41 * MiB;
constexpr size_t WS_NV = WS_BIG + 59 * MiB;
constexpr size_t WS_MQ = WS_BIG + 77 * MiB;
constexpr size_t WS_MK = WS_BIG + 101 * MiB;
constexpr size_t WS_MV = WS_BIG + 128 * MiB;
constexpr size_t WS_KR = WS_BIG + 146 * MiB;
constexpr size_t WS_SNAP = WS_BIG + 100 * MiB;
constexpr size_t WS_END = 256 * MiB;
static_assert(WS_KR + (size_t)MT * 32 * 4 <= WS_END, "ws map");
static_assert(WS_W_D1 + (size_t)D * FF * 2 <= WS_XRC, "ws map");
static_assert(WS_XN + (size_t)MT * D * 2 <= WS_BIG, "ws map");

__device__ __forceinline__ float bf2f(bf16_t u) { return __uint_as_float((unsigned)u << 16); }
__device__ __forceinline__ bf16_t f2bf(float f) { unsigned u = __float_as_uint(f); return (bf16_t)((u + 0x7fffu + ((u >> 16) & 1u)) >> 16); }
__device__ __forceinline__ int kvrow_of(int m) { return m < ML ? (m / S) * SK + CTX + (m % S) : ((m - ML) / CTX) * SK + ((m - ML) % CTX); }
__device__ __forceinline__ int modidx_of(int m) { return m < ML ? m / S : 8; }
__device__ __forceinline__ float wave_sum(float v) {
#pragma unroll
    for (int o = 1; o < 64; o <<= 1) v += __shfl_xor(v, o);
    return v;
}
__device__ __forceinline__ float wave_max(float v) {
#pragma unroll
    for (int o = 1; o < 64; o <<= 1) v = fmaxf(v, __shfl_xor(v, o));
    return v;
}

struct Params {
    const float* in[N_IN];
    float* out;
    unsigned char* ws;
};
namespace pg8 {
#define PG8_LAS __attribute__((address_space(3)))
typedef unsigned short bf16_t;
typedef short bf16x8 __attribute__((ext_vector_type(8)));
typedef float f32x4 __attribute__((ext_vector_type(4)));
typedef unsigned u32x4 __attribute__((ext_vector_type(4)));
constexpr int BM = 256, BK = 64, HALF = 128, HTB = HALF * BK * 2  , STAGE_BYTES = 8 * HTB, NXCD = 8, WGM = 8;

__host__ __device__ __forceinline__ int lds_byte(int r, int c) { const int st = (r >> 4) * 2 + (c >> 5), rr = r & 15, cc = c & 31, ob = rr * 64 + cc * 2; return st * 1024 + (ob ^ (((ob >> 9) & 1) << 5)); }
__host__ __device__ __forceinline__ void stage_rc(int b, int& R, int& C) { const int st = b / 1024, sb = b % 1024, swz = sb ^ (((sb >> 9) & 1) << 5); R = (st >> 1) * 16 + swz / 64; C = (st & 1) * 32 + (swz % 64) / 2; }
__host__ __device__ __forceinline__ int perm32(int rho) { const int n = rho >> 4, i = rho & 15; return 8 * (i >> 2) + 4 * n + (i & 3); }

struct Unit { int pm, pn; };
struct Gemm { const bf16_t* A; const bf16_t* Bt; int M, N, K; };

struct StaticOrder {
    int nM, nN, nwg, G, c;
    __host__ __device__ void init(int M, int N, int G_, int c_) { nM = M / BM; nN = N / BM; nwg = nM * nN; G = G_; c = c_; }
    __host__ __device__ bool next(int i, Unit& u) const {
        const long L = (long)i * G + c; if (L >= nwg) return false;
        int wgid = (int)L; { const int q = nwg / NXCD, r = nwg % NXCD, xcd = wgid % NXCD, off = wgid / NXCD; wgid = (xcd < r ? xcd * (q + 1) : r * (q + 1) + (xcd - r) * q) + off; }
        const int nig = WGM * nN, gid = wgid / nig, fm = gid * WGM, gsz = (nM - fm) < WGM ? (nM - fm) : WGM;
        u.pm = fm + ((wgid % nig) % gsz); u.pn = (wgid % nig) / gsz; return true;
    }
    __device__ __forceinline__ void a_ready(const Unit&) const {}
    __device__ __forceinline__ void done(const Unit&) const {}
};

__device__ __forceinline__ unsigned cvt_pk_bf16(float lo, float hi) { unsigned r; asm volatile("v_cvt_pk_bf16_f32 %0, %1, %2" : "=v"(r) : "v"(lo), "v"(hi)); return r; }
typedef float f32x2 __attribute__((ext_vector_type(2)));
template <class Epi, class Sched, bool ALIGN_EPI = false, bool SP2 = false>
__device__ __forceinline__ void gemm_phase(PG8_LAS unsigned char* lds, const Gemm g, const Sched& S, const Epi& E) {
    int tid_ = threadIdx.x; asm volatile("" : "+v"(tid_));
    const int tid = tid_, wid = __builtin_amdgcn_readfirstlane(tid >> 6), lane = tid & 63, wr = wid >> 2, wc = wid & 3, fr = lane & 15, fq = lane >> 4;
    int K_ = g.K; asm volatile("" : "+s"(K_));
    const int K = K_, nt = K / BK;
    unsigned voffA[2], voffB[2];
#pragma unroll
    for (int i = 0; i < 2; ++i) { int R, C; stage_rc(tid * 16 + i * 8192, R, C); const int Rb = Epi::PERM ? ((R & ~31) + perm32(R & 31)) : R;
        voffA[i] = (unsigned)(R * K + C) * 2u; voffB[i] = (unsigned)(Rb * K + C) * 2u; }
    const size_t kstep = (size_t)(BK * 2);
    const size_t hstep = (size_t)HALF * K * 2;
    const size_t tstep = 2 * hstep;
    const unsigned ldsw = (unsigned)wid * 1024u;
    const int aoff = lds_byte(wr * 64 + fr, fq * 8), boff = lds_byte(wc * 32 + fr, fq * 8);
#define PG8_SA(b, h) (((b) * 2 + (h)) * HTB)
#define PG8_SB(b, h) ((4 + (b) * 2 + (h)) * HTB)
#define PG8_STAGE(bufoff, gbase, voff) do { _Pragma("unroll") for (int _i = 0; _i < 2; ++_i) \
        __builtin_amdgcn_global_load_lds((const unsigned*)((const char*)(gbase) + (voff)[_i]), (PG8_LAS unsigned*)(lds + (bufoff) + ldsw + _i * 8192), 16, 0, 0); } while (0)
#define PG8_LDA(dst, b, h) do { _Pragma("unroll") for (int m = 0; m < 4; ++m) _Pragma("unroll") for (int k = 0; k < 2; ++k) dst[m][k] = *(const PG8_LAS bf16x8*)(lds + PG8_SA(b, h) + aoff + m * 2048 + k * 1024); } while (0)
#define PG8_LDB(dst, b, h) do { _Pragma("unroll") for (int n = 0; n < 2; ++n) _Pragma("unroll") for (int k = 0; k < 2; ++k) dst[n][k] = *(const PG8_LAS bf16x8*)(lds + PG8_SB(b, h) + boff + n * 2048 + k * 1024); } while (0)
#define PG8_MMA(ai, bj, At, Bt) do { __builtin_amdgcn_s_setprio(1); _Pragma("unroll") for (int m = 0; m < 4; ++m) _Pragma("unroll") for (int n = 0; n < 2; ++n) _Pragma("unroll") for (int k = 0; k < 2; ++k) \
        acc[ai][bj][m][n] = __builtin_amdgcn_mfma_f32_16x16x32_bf16(Bt[n][k], At[m][k], acc[ai][bj][m][n], 0, 0, 0); __builtin_amdgcn_s_setprio(0); } while (0)
#define PG8_WAIT_V(n) asm volatile("s_waitcnt vmcnt(" #n ")" ::: "memory")
#define PG8_WAIT_L(n) asm volatile("s_waitcnt lgkmcnt(" #n ")" ::: "memory")
#define PG8_BAR __builtin_amdgcn_s_barrier()
#define PG8_SCHED __builtin_amdgcn_sched_barrier(0)
    Unit cur, nxt; int ui = 0;
    if (!S.next(0, cur)) return;
    f32x4 acc[2][2][4][2];
#pragma unroll
    for (int a = 0; a < 2; ++a)
#pragma unroll
        for (int b = 0; b < 2; ++b)
#pragma unroll
            for (int m = 0; m < 4; ++m)
#pragma unroll
                for (int n = 0; n < 2; ++n) acc[a][b][m][n] = (f32x4){0.f, 0.f, 0.f, 0.f};
    bf16x8 At[4][2], B0[2][2], B1[2][2];
    const char* cA = (const char*)g.A + (size_t)cur.pm * tstep; const char* cB = (const char*)g.Bt + (size_t)cur.pn * tstep;
    S.a_ready(cur);
    if constexpr (SP2) {
        PG8_STAGE(PG8_SB(0, 0), cB, voffB); PG8_STAGE(PG8_SB(0, 1), cB + hstep, voffB); PG8_STAGE(PG8_SA(0, 0), cA, voffA); PG8_STAGE(PG8_SA(0, 1), cA + hstep, voffA);
        if (wr == 1) PG8_BAR;
        PG8_WAIT_V(2); PG8_BAR;
        PG8_STAGE(PG8_SB(1, 0), cB + kstep, voffB); PG8_STAGE(PG8_SA(1, 0), cA + kstep, voffA); PG8_STAGE(PG8_SB(1, 1), cB + hstep + kstep, voffB);
        PG8_WAIT_V(6); PG8_BAR;
    } else {
        PG8_STAGE(PG8_SB(0, 0), cB, voffB); PG8_STAGE(PG8_SA(0, 0), cA, voffA); PG8_STAGE(PG8_SB(0, 1), cB + hstep, voffB); PG8_STAGE(PG8_SA(0, 1), cA + hstep, voffA);
        if (wr == 1) PG8_BAR;
        PG8_WAIT_V(4); PG8_BAR;
        PG8_STAGE(PG8_SB(1, 0), cB + kstep, voffB); PG8_STAGE(PG8_SA(1, 0), cA + kstep, voffA); PG8_STAGE(PG8_SB(1, 1), cB + hstep + kstep, voffB);
        PG8_WAIT_V(6); PG8_BAR;
    }
    for (;;) {
        const bool has_next = S.next(ui + 1, nxt);
        const char* nA = has_next ? (const char*)g.A + (size_t)nxt.pm * tstep : cA; const char* nB = has_next ? (const char*)g.Bt + (size_t)nxt.pn * tstep : cB;
        for (int t = 0; t < nt; t += 2) {
            const bool last = (t == nt - 2);
            const char* a1 = cA + (size_t)(t + 1) * kstep;
            const char* a2 = last ? nA : cA + (size_t)(t + 2) * kstep; const char* b2 = last ? nB : cB + (size_t)(t + 2) * kstep;
            const char* a3 = a2 + kstep; const char* b3 = b2 + kstep;
            if (last && has_next) S.a_ready(nxt);
            if constexpr (SP2) {
            PG8_LDB(B0, 0, 0); PG8_LDB(B1, 0, 1); PG8_SCHED; PG8_LDA(At, 0, 0); PG8_STAGE(PG8_SA(1, 1), a1 + hstep, voffA);
            PG8_WAIT_V(8); PG8_WAIT_L(0); PG8_BAR; PG8_MMA(0, 0, At, B0); PG8_MMA(0, 1, At, B1); PG8_BAR; PG8_SCHED;
            PG8_LDA(At, 0, 1); PG8_STAGE(PG8_SB(0, 0), b2, voffB); PG8_STAGE(PG8_SB(0, 1), b2 + hstep, voffB); PG8_STAGE(PG8_SA(0, 0), a2, voffA);
            PG8_WAIT_V(8); PG8_WAIT_L(0); PG8_BAR; PG8_MMA(1, 0, At, B0); PG8_MMA(1, 1, At, B1); PG8_BAR; PG8_SCHED;
            PG8_LDB(B0, 1, 0); PG8_LDB(B1, 1, 1); PG8_SCHED; PG8_LDA(At, 1, 0); PG8_STAGE(PG8_SA(0, 1), a2 + hstep, voffA);
            PG8_WAIT_V(8); PG8_WAIT_L(0); PG8_BAR; PG8_MMA(0, 0, At, B0); PG8_MMA(0, 1, At, B1); PG8_BAR; PG8_SCHED;
            PG8_LDA(At, 1, 1); PG8_STAGE(PG8_SB(1, 0), b3, voffB); PG8_STAGE(PG8_SB(1, 1), b3 + hstep, voffB); PG8_STAGE(PG8_SA(1, 0), a3, voffA);
            PG8_WAIT_V(8); PG8_WAIT_L(0); PG8_BAR; PG8_MMA(1, 0, At, B0); PG8_MMA(1, 1, At, B1); PG8_BAR; PG8_SCHED;
            } else {
            PG8_LDB(B0, 0, 0); PG8_SCHED; PG8_LDA(At, 0, 0); PG8_STAGE(PG8_SA(1, 1), a1 + hstep, voffA);
            PG8_WAIT_L(8); PG8_BAR; PG8_WAIT_L(0); PG8_MMA(0, 0, At, B0); PG8_BAR; PG8_SCHED;
            PG8_LDB(B1, 0, 1); PG8_STAGE(PG8_SB(0, 0), b2, voffB);
            PG8_BAR; PG8_WAIT_L(0); PG8_MMA(0, 1, At, B1); PG8_BAR;
            PG8_LDA(At, 0, 1); PG8_STAGE(PG8_SA(0, 0), a2, voffA);
            PG8_BAR; PG8_WAIT_L(0); PG8_MMA(1, 0, At, B0); PG8_BAR; PG8_SCHED;
            PG8_STAGE(PG8_SB(0, 1), b2 + hstep, voffB);
            PG8_WAIT_V(6); PG8_BAR; PG8_MMA(1, 1, At, B1); PG8_BAR;
            PG8_LDB(B0, 1, 0); PG8_SCHED; PG8_LDA(At, 1, 0); PG8_STAGE(PG8_SA(0, 1), a2 + hstep, voffA);
            PG8_WAIT_L(8); PG8_BAR; PG8_WAIT_L(0); PG8_MMA(0, 0, At, B0); PG8_BAR; PG8_SCHED;
            PG8_LDB(B1, 1, 1); PG8_STAGE(PG8_SB(1, 0), b3, voffB);
            PG8_BAR; PG8_WAIT_L(0); PG8_MMA(0, 1, At, B1); PG8_BAR;
            PG8_LDA(At, 1, 1); PG8_STAGE(PG8_SA(1, 0), a3, voffA);
            PG8_BAR; PG8_WAIT_L(0); PG8_MMA(1, 0, At, B0); PG8_BAR; PG8_SCHED;
            PG8_STAGE(PG8_SB(1, 1), b3 + hstep, voffB);
            PG8_WAIT_V(6); PG8_BAR; PG8_MMA(1, 1, At, B1); PG8_BAR;
            }
        }
        if constexpr (ALIGN_EPI) { if (wr == 0) PG8_BAR; }
        if constexpr (!Epi::AFTER_DRAIN) { E(acc, cur, wr, wc, fr, fq); S.done(cur); }
        if (!has_next) break;
#pragma unroll
        for (int a = 0; a < 2; ++a)
#pragma unroll
            for (int b = 0; b < 2; ++b)
#pragma unroll
                for (int m = 0; m < 4; ++m)
#pragma unroll
                    for (int n = 0; n < 2; ++n) acc[a][b][m][n] = (f32x4){0.f, 0.f, 0.f, 0.f};
        cur = nxt; cA = nA; cB = nB; ++ui;
        if constexpr (ALIGN_EPI) { if (wr == 1) PG8_BAR; }
    }
    PG8_WAIT_V(0);
    if constexpr (!ALIGN_EPI) { if (wr == 0) PG8_BAR; }
    PG8_BAR;
    if constexpr (Epi::AFTER_DRAIN) { E.fused(acc, cur, wr, wc, fr, fq, lds, wid, lane); S.done(cur); }
#undef PG8_SA
#undef PG8_SB
#undef PG8_STAGE
#undef PG8_LDA
#undef PG8_LDB
#undef PG8_MMA
#undef PG8_WAIT_V
#undef PG8_WAIT_L
#undef PG8_BAR
#undef PG8_SCHED
}
}
namespace epi {
using pg8::f32x4; using pg8::Unit;
typedef unsigned u32x2 __attribute__((ext_vector_type(2)));
typedef unsigned u32x4 __attribute__((ext_vector_type(4)));
typedef float f32x2 __attribute__((ext_vector_type(2)));
typedef __bf16 bf16x2_t __attribute__((ext_vector_type(2)));
__device__ __forceinline__ unsigned pk(float lo, float hi) { f32x2 v = {lo, hi}; bf16x2_t b = __builtin_convertvector(v, bf16x2_t); return __builtin_bit_cast(unsigned, b); }
__device__ __forceinline__ u32x2 pk4(f32x4 v) { u32x2 w; w.x = pk(v[0], v[1]); w.y = pk(v[2], v[3]); return w; }
__device__ __forceinline__ float sum4sq(f32x4 v) { return (v[0] * v[0] + v[1] * v[1]) + (v[2] * v[2] + v[3] * v[3]); }
__device__ __forceinline__ float quad_sum(float s) { s += __shfl_xor(s, 16); s += __shfl_xor(s, 32); return s; }

__device__ __forceinline__ int kvbase_of(int pm) { return pm < 64 ? (pm >> 3) * SK + CTX + (pm & 7) * 256 : (pm - 64) * SK; }
__device__ __forceinline__ int modidx_pm(int pm) { return pm < 64 ? (pm >> 3) : 8; }

__device__ __forceinline__ void head_finish(f32x4 (&v)[2][2], const float* gain, bool rope, const float* T32, int grow, int gcol, float scale, int fq) {
    float ss = (sum4sq(v[0][0]) + sum4sq(v[0][1])) + (sum4sq(v[1][0]) + sum4sq(v[1][1]));
    ss = quad_sum(ss);
    const float rn = rsqrtf(ss * (1.f / 64.f) + EPS);
#pragma unroll
    for (int bj = 0; bj < 2; ++bj)
#pragma unroll
        for (int n = 0; n < 2; ++n) { const f32x4 g = *(const f32x4*)(gain + 32 * bj + 16 * n + 4 * fq); v[bj][n] = (v[bj][n] * rn) * g; }
    if (rope) {
#pragma unroll
        for (int bj = 0; bj < 2; ++bj) { const int pos = bj ? gcol : grow;
            const f32x4 cs = *(const f32x4*)(T32 + pos * 16 + 4 * fq), sn = *(const f32x4*)(T32 + 1024 + pos * 16 + 4 * fq);
            const f32x4 x1 = v[bj][0], x2 = v[bj][1];
            v[bj][0] = x1 * cs - x2 * sn; v[bj][1] = x1 * sn + x2 * cs; }
    }
#pragma unroll
    for (int bj = 0; bj < 2; ++bj)
#pragma unroll
        for (int n = 0; n < 2; ++n) v[bj][n] = v[bj][n] * scale;
}

struct EpiIn0 {
    static constexpr bool PERM = false, AFTER_DRAIN = false;
    bf16_t *A0, *Q0, *K0, *V0; const float *qg, *kg, *T32;
    __device__ __forceinline__ void operator()(const f32x4 (&acc)[2][2][4][2], const Unit& u, int wr, int wc, int fr_in, int fq_in) const {
        int fr = fr_in, fq = fq_in; asm volatile("" : "+v"(fr), "+v"(fq));
        const int pn = u.pn, pm = u.pm; const bool lat = pm < 64; const int kvb = kvbase_of(pm);
#pragma unroll
        for (int ai = 0; ai < 2; ++ai)
#pragma unroll
            for (int m = 0; m < 4; ++m) {
                const int rl = 128 * ai + 64 * wr + 16 * m + fr; const size_t r = (size_t)pm * 256 + rl;
                if (pn == 0 || pn == 5) {
                    bf16_t* dst = pn == 0 ? A0 + r * 256 : V0 + (size_t)(kvb + rl) * 256;
#pragma unroll
                    for (int bj = 0; bj < 2; ++bj)
#pragma unroll
                        for (int n = 0; n < 2; ++n) *(u32x2*)(dst + 64 * wc + 32 * bj + 16 * n + 4 * fq) = pk4(acc[ai][bj][m][n]);
                } else {
                    f32x4 v[2][2] = {{acc[ai][0][m][0], acc[ai][0][m][1]}, {acc[ai][1][m][0], acc[ai][1][m][1]}};
                    const int grow = (pm & 7) * 4 + 2 * ai + wr, gcol = 16 * m + fr;
                    bf16_t* dst;
                    if (pn < 4) { head_finish(v, qg, lat, T32, grow, gcol, C2_64, fq); dst = Q0 + r * 768 + ((pn - 1) * 4 + wc) * 64; }
                    else { head_finish(v, kg, lat, T32, grow, gcol, 1.0f, fq); dst = K0 + (size_t)(kvb + rl) * 256 + wc * 64; }
#pragma unroll
                    for (int bj = 0; bj < 2; ++bj)
#pragma unroll
                        for (int n = 0; n < 2; ++n) *(u32x2*)(dst + 32 * bj + 16 * n + 4 * fq) = pk4(v[bj][n]);
                }
            }
    }
};

struct EpiResid {
    static constexpr bool PERM = false, AFTER_DRAIN = false;
    const float *base_l, *base_c; float *out_l, *out_c; const float* mod;
    __device__ __forceinline__ void operator()(const f32x4 (&acc)[2][2][4][2], const Unit& u, int wr, int wc, int fr_in, int fq_in) const {
        int fr = fr_in, fq = fq_in; asm volatile("" : "+v"(fr), "+v"(fq));
        const int pm = u.pm; const bool lat = pm < 64;
        const float* bp = lat ? base_l + (size_t)pm * 256 * D : base_c + (size_t)(pm - 64) * 256 * D;
        float* op = lat ? out_l + (size_t)pm * 256 * D : out_c + (size_t)(pm - 64) * 256 * D;
        const float* gp = mod + (size_t)modidx_pm(pm) * 6144 + u.pn * 256 + 32 * wc + 4 * fq;
        f32x4 g[2][2];
#pragma unroll
        for (int bj = 0; bj < 2; ++bj)
#pragma unroll
            for (int n = 0; n < 2; ++n) g[bj][n] = *(const f32x4*)(gp + 128 * bj + 16 * n);
#pragma unroll
        for (int ai = 0; ai < 2; ++ai)
#pragma unroll
            for (int m = 0; m < 4; ++m) { const size_t off = (size_t)(128 * ai + 64 * wr + 16 * m + fr) * D + u.pn * 256 + 32 * wc + 4 * fq;
#pragma unroll
                for (int bj = 0; bj < 2; ++bj)
#pragma unroll
                    for (int n = 0; n < 2; ++n) { const f32x4 b = *(const f32x4*)(bp + off + 128 * bj + 16 * n); *(f32x4*)(op + off + 128 * bj + 16 * n) = b + g[bj][n] * acc[ai][bj][m][n]; } }
    }
};

struct EpiSwiGLU {
    static constexpr bool PERM = true, AFTER_DRAIN = false;
    bf16_t* H;
    __device__ __forceinline__ void operator()(const f32x4 (&acc)[2][2][4][2], const Unit& u, int wr, int wc, int fr_in, int fq_in) const {
        int fr = fr_in, fq = fq_in; asm volatile("" : "+v"(fr), "+v"(fq));
#pragma unroll
        for (int ai = 0; ai < 2; ++ai)
#pragma unroll
            for (int m = 0; m < 4; ++m) { const size_t r = (size_t)u.pm * 256 + 128 * ai + 64 * wr + 16 * m + fr;
                f32x4 h[2];
#pragma unroll
                for (int n = 0; n < 2; ++n) { const f32x4 g = acc[ai][0][m][n], up = acc[ai][1][m][n];
#pragma unroll
                    for (int e = 0; e < 4; ++e) h[n][e] = g[e] * __builtin_amdgcn_rcpf(1.f + __builtin_amdgcn_exp2f(-g[e] * LOG2E)) * up[e]; }
                u32x4 w; w.x = pk(h[0][0], h[0][1]); w.y = pk(h[0][2], h[0][3]); w.z = pk(h[1][0], h[1][1]); w.w = pk(h[1][2], h[1][3]);
                *(u32x4*)(H + r * FF + u.pn * 128 + 32 * wc + 8 * fq) = w; }
    }
};

struct EpiIn1 {
    static constexpr bool PERM = false, AFTER_DRAIN = false;
    bf16_t *CQ, *CKV, *NQ, *NK, *NV; float *KR, *SSQ, *SSKV; const float *nqg, *nkg;
    __device__ __forceinline__ void operator()(const f32x4 (&acc)[2][2][4][2], const Unit& u, int wr, int wc, int fr_in, int fq_in) const {
        int fr = fr_in, fq = fq_in; asm volatile("" : "+v"(fr), "+v"(fq));
        const int pn = u.pn, pm = u.pm; const int kvb = kvbase_of(pm);
#pragma unroll
        for (int ai = 0; ai < 2; ++ai)
#pragma unroll
            for (int m = 0; m < 4; ++m) {
                const int rl = 128 * ai + 64 * wr + 16 * m + fr; const size_t r = (size_t)pm * 256 + rl;
                if (pn == 0 || pn == 2) {
                    bf16_t* dst = pn == 0 ? CQ + r * 384 : CKV + r * 256; float ss = 0.f;
#pragma unroll
                    for (int bj = 0; bj < 2; ++bj)
#pragma unroll
                        for (int n = 0; n < 2; ++n) { ss += sum4sq(acc[ai][bj][m][n]); *(u32x2*)(dst + 128 * bj + 32 * wc + 16 * n + 4 * fq) = pk4(acc[ai][bj][m][n]); }
                    ss = quad_sum(ss);
                    if (fq == 0) atomicAdd((pn == 0 ? SSQ : SSKV) + r, ss);
                } else if (pn == 1) {
                    float ss = 0.f;
#pragma unroll
                    for (int n = 0; n < 2; ++n) { ss += sum4sq(acc[ai][0][m][n]); *(u32x2*)(CQ + r * 384 + 256 + 32 * wc + 16 * n + 4 * fq) = pk4(acc[ai][0][m][n]); }
                    ss = quad_sum(ss);
                    if (fq == 0) atomicAdd(SSQ + r, ss);
                    if (wc == 0) {
#pragma unroll
                        for (int n = 0; n < 2; ++n) *(f32x4*)(KR + r * 32 + 16 * n + 4 * fq) = acc[ai][1][m][n]; }
                } else if (pn >= 7) {
                    bf16_t* dst = NV + (size_t)(kvb + rl) * 512 + (pn - 7) * 256 + 64 * wc;
#pragma unroll
                    for (int bj = 0; bj < 2; ++bj)
#pragma unroll
                        for (int n = 0; n < 2; ++n) *(u32x2*)(dst + 32 * bj + 16 * n + 4 * fq) = pk4(acc[ai][bj][m][n]);
                } else {
                    f32x4 v[2][2] = {{acc[ai][0][m][0], acc[ai][0][m][1]}, {acc[ai][1][m][0], acc[ai][1][m][1]}};
                    bf16_t* dst;
                    if (pn < 5) { head_finish(v, nqg, false, nullptr, 0, 0, C2_64, fq); dst = NQ + r * 512 + ((pn - 3) * 4 + wc) * 64; }
                    else { head_finish(v, nkg, false, nullptr, 0, 0, 1.0f, fq); dst = NK + (size_t)(kvb + rl) * 512 + ((pn - 5) * 4 + wc) * 64; }
#pragma unroll
                    for (int bj = 0; bj < 2; ++bj)
#pragma unroll
                        for (int n = 0; n < 2; ++n) *(u32x2*)(dst + 32 * bj + 16 * n + 4 * fq) = pk4(v[bj][n]);
                }
            }
    }
};

struct EpiQUp {
    static constexpr bool PERM = true, AFTER_DRAIN = false;
    bf16_t* MQ; const float* SSQ;
    __device__ __forceinline__ void operator()(const f32x4 (&acc)[2][2][4][2], const Unit& u, int wr, int wc, int fr_in, int fq_in) const {
        int fr = fr_in, fq = fq_in; asm volatile("" : "+v"(fr), "+v"(fq));
#pragma unroll
        for (int ai = 0; ai < 2; ++ai)
#pragma unroll
            for (int m = 0; m < 4; ++m) { const size_t r = (size_t)u.pm * 256 + 128 * ai + 64 * wr + 16 * m + fr;
                const float rs = rsqrtf(SSQ[r] * (1.f / 384.f) + EPS);
#pragma unroll
                for (int bj = 0; bj < 2; ++bj) { const f32x4 a = acc[ai][bj][m][0] * rs, b = acc[ai][bj][m][1] * rs;
                    u32x4 w; w.x = pk(a[0], a[1]); w.y = pk(a[2], a[3]); w.z = pk(b[0], b[1]); w.w = pk(b[2], b[3]);
                    *(u32x4*)(MQ + r * 768 + u.pn * 256 + 128 * bj + 32 * wc + 8 * fq) = w; } }
    }
};

struct EpiKvUp {
    static constexpr bool PERM = false, AFTER_DRAIN = false;
    bf16_t *MK, *MV; const float *SSKV, *KR, *kg, *T16;
    __device__ __forceinline__ void operator()(const f32x4 (&acc)[2][2][4][2], const Unit& u, int wr, int wc, int fr_in, int fq_in) const {
        int fr = fr_in, fq = fq_in; asm volatile("" : "+v"(fr), "+v"(fq));
        const int pm = u.pm; const bool lat = pm < 64; const int kvb = kvbase_of(pm); const int head = 2 * u.pn + (wc >> 1); const bool isv = wc & 1;
#pragma unroll
        for (int ai = 0; ai < 2; ++ai)
#pragma unroll
            for (int m = 0; m < 4; ++m) {
                const int rl = 128 * ai + 64 * wr + 16 * m + fr; const size_t r = (size_t)pm * 256 + rl; const size_t kvr = (size_t)(kvb + rl);
                const float rs = rsqrtf(SSKV[r] * (1.f / 256.f) + EPS);
                f32x4 v[2][2];
#pragma unroll
                for (int bj = 0; bj < 2; ++bj)
#pragma unroll
                    for (int n = 0; n < 2; ++n) v[bj][n] = acc[ai][bj][m][n] * rs;
                if (isv) {
#pragma unroll
                    for (int bj = 0; bj < 2; ++bj)
#pragma unroll
                        for (int n = 0; n < 2; ++n) *(u32x2*)(MV + kvr * 512 + head * 64 + 32 * bj + 16 * n + 4 * fq) = pk4(v[bj][n]);
                } else {
                    f32x2 k[4];
#pragma unroll
                    for (int j = 0; j < 4; ++j) k[j] = *(const f32x2*)(KR + r * 32 + 8 * j + 2 * fq);
                    float ss = (sum4sq(v[0][0]) + sum4sq(v[0][1])) + (sum4sq(v[1][0]) + sum4sq(v[1][1]));
#pragma unroll
                    for (int j = 0; j < 4; ++j) ss += k[j][0] * k[j][0] + k[j][1] * k[j][1];
                    ss = quad_sum(ss);
                    const float rr = rsqrtf(ss * (1.f / 96.f) + EPS);
#pragma unroll
                    for (int bj = 0; bj < 2; ++bj)
#pragma unroll
                        for (int n = 0; n < 2; ++n) { const f32x4 g = *(const f32x4*)(kg + 32 * bj + 16 * n + 4 * fq);
                            *(u32x2*)(MK + kvr * 768 + head * 96 + 32 * bj + 16 * n + 4 * fq) = pk4((v[bj][n] * rr) * g); }
#pragma unroll
                    for (int j = 0; j < 4; ++j) { const f32x2 g = *(const f32x2*)(kg + 64 + 8 * j + 2 * fq); k[j] = (k[j] * rr) * g; }
                    if (lat) {
                        const int grow = (pm & 7) * 4 + 2 * ai + wr, gcol = 16 * m + fr;
#pragma unroll
                        for (int part = 0; part < 2; ++part) { const int pos = part ? gcol : grow;
                            const f32x2 cs = *(const f32x2*)(T16 + pos * 8 + 2 * fq), sn = *(const f32x2*)(T16 + 512 + pos * 8 + 2 * fq);
                            const f32x2 x1 = k[2 * part], x2 = k[2 * part + 1];
                            k[2 * part] = x1 * cs - x2 * sn; k[2 * part + 1] = x1 * sn + x2 * cs; }
                    }
#pragma unroll
                    for (int j = 0; j < 4; ++j) *(unsigned*)(MK + kvr * 768 + head * 96 + 64 + 8 * j + 2 * fq) = pk(k[j][0], k[j][1]);
                }
                asm volatile("" ::: "memory");
            }
    }
};
}
namespace att {
using bf16x8 = __attribute__((ext_vector_type(8))) short;
using s16x4 = __attribute__((ext_vector_type(4))) short;
using f32x16 = __attribute__((ext_vector_type(16))) float;
using u32x4 = __attribute__((ext_vector_type(4))) unsigned;
typedef float f32x2_t __attribute__((ext_vector_type(2))); typedef __bf16 bf16x2_t __attribute__((ext_vector_type(2)));
#define ALAS __attribute__((address_space(3)))
constexpr int KSLOT = 12288, VSLOT = 8192, SLOT = KSLOT + VSLOT, NSLOT = 4;
constexpr int LDS_WS = NSLOT * SLOT;
constexpr int LDS_OST = LDS_WS + 8 * 256;
constexpr int LDS_RPB = LDS_OST + 8 * 4096;
constexpr int LDS_BYTES = LDS_RPB + 2048;
constexpr float THR = 8.0f;

__device__ __forceinline__ int crow(int r, int hi) { return (r & 3) + 8 * (r >> 2) + 4 * hi; }
__device__ __forceinline__ void glds16(const void* gsrc, unsigned lds_dst) { unsigned keep;
    asm volatile("s_mov_b32 %0, m0\n\ts_mov_b32 m0, %2\n\ts_nop 0\n\tglobal_load_lds_dwordx4 %1, off\n\ts_mov_b32 m0, %0" : "=&s"(keep) : "v"(gsrc), "s"(lds_dst) : "memory"); }
__device__ __forceinline__ unsigned cvtpk(float lo, float hi) { f32x2_t v = {lo, hi}; bf16x2_t b = __builtin_convertvector(v, bf16x2_t); return __builtin_bit_cast(unsigned, b); }
__device__ __forceinline__ void glds16s(unsigned voff, const void* sbase, unsigned lds_dst) { unsigned keep;
    asm volatile("s_mov_b32 %0, m0\n\ts_mov_b32 m0, %3\n\ts_nop 0\n\tglobal_load_lds_dwordx4 %1, %2\n\ts_mov_b32 m0, %0" : "=&s"(keep) : "v"(voff), "s"(sbase), "s"(lds_dst) : "memory"); }
__device__ __forceinline__ float max3f(float a, float b, float c) { float r; asm("v_max3_f32 %0, %1, %2, %3" : "=v"(r) : "v"(a), "v"(b), "v"(c)); return r; }
__device__ __forceinline__ float max2f(float a, float b) { float r; asm("v_max_f32_e32 %0, %1, %2" : "=v"(r) : "v"(a), "v"(b)); return r; }
#define AWAIT_BAR(N) asm volatile("s_waitcnt vmcnt(" #N ") lgkmcnt(0)\n\ts_barrier" ::: "memory")

template <int ND0> __device__ __forceinline__ void qkt(f32x16& p0, f32x16& p1, const ALAS char* Kslot, const bf16x8* qr, const f32x16& negm, int r32, int hi) {
    const ALAS char* kb = Kslot + hi * 1024 + r32 * 16;
#pragma unroll
    for (int d0 = 0; d0 < ND0; ++d0) {
        const bf16x8 b0 = *(const ALAS bf16x8*)(kb + d0 * 2048);
        const bf16x8 b1 = *(const ALAS bf16x8*)(kb + d0 * 2048 + 512);
        if (d0 == 0) { p0 = __builtin_amdgcn_mfma_f32_32x32x16_bf16(b0, qr[0], negm, 0, 0, 0); p1 = __builtin_amdgcn_mfma_f32_32x32x16_bf16(b1, qr[0], negm, 0, 0, 0); }
        else { p0 = __builtin_amdgcn_mfma_f32_32x32x16_bf16(b0, qr[d0], p0, 0, 0, 0); p1 = __builtin_amdgcn_mfma_f32_32x32x16_bf16(b1, qr[d0], p1, 0, 0, 0); }
    }
}
__device__ __forceinline__ float rowmax32(const f32x16& p0, const f32x16& p1) {
    float a = max3f(p0[0], p0[1], p1[0]), b = max3f(p0[2], p0[3], p1[1]); a = max3f(a, p1[2], p1[3]);
#pragma unroll
    for (int r = 4; r < 16; r += 4) { a = max3f(a, p0[r], p0[r + 1]); b = max3f(b, p0[r + 2], p0[r + 3]); a = max3f(a, p1[r], p1[r + 1]); b = max3f(b, p1[r + 2], p1[r + 3]); }
    const float m = max2f(a, b);
    auto rr = __builtin_amdgcn_permlane32_swap(__float_as_uint(m), __float_as_uint(m), false, false);
    return max2f(__uint_as_float(rr[0]), __uint_as_float(rr[1]));
}
typedef short v4i16_t __attribute__((ext_vector_type(4)));
__device__ __forceinline__ s16x4 vtr(const ALAS char* p) { return __builtin_bit_cast(s16x4, __builtin_amdgcn_ds_read_tr16_b64_v4i16((ALAS v4i16_t*)p)); }
__device__ __forceinline__ void pv(f32x16* o, const ALAS char* vp, bf16x8 pa0, bf16x8 pa1, bf16x8 pa2, bf16x8 pa3) {
#pragma unroll
    for (int d0 = 0; d0 < 2; ++d0) { s16x4 lo[4], hi[4];
#pragma unroll
        for (int ks = 0; ks < 4; ++ks) { lo[ks] = vtr(vp + d0 * 4096 + ks * 1024); hi[ks] = vtr(vp + d0 * 4096 + ks * 1024 + 512); }
#define APK(k) (bf16x8){lo[k][0], lo[k][1], lo[k][2], lo[k][3], hi[k][0], hi[k][1], hi[k][2], hi[k][3]}
        o[d0] = __builtin_amdgcn_mfma_f32_32x32x16_bf16(pa0, APK(0), o[d0], 0, 0, 0);
        o[d0] = __builtin_amdgcn_mfma_f32_32x32x16_bf16(pa1, APK(1), o[d0], 0, 0, 0);
        o[d0] = __builtin_amdgcn_mfma_f32_32x32x16_bf16(pa2, APK(2), o[d0], 0, 0, 0);
        o[d0] = __builtin_amdgcn_mfma_f32_32x32x16_bf16(pa3, APK(3), o[d0], 0, 0, 0);
#undef APK
    }
}

struct UnitDesc {
    const bf16_t* Q; int qpitch;
    long q0; int qcol;
    const bf16_t* K; int kpitch, kcol;
    const bf16_t* V; int vpitch, vcol;
    bf16_t* O; int opitch, ocol;
    int kv0;
    int nt;
    int rg;
    int rmin;
    int head;
};

template <int DQK, bool NA, bool MLAQ>
__device__ __forceinline__ void attn_unit(const UnitDesc& U, ALAS char* shm, const float* qgain, const float* T16, const float* rpb_g) {
    constexpr int ND0 = DQK / 16, NCH = DQK / 8, NP = NCH + 8;
    int tid_ = threadIdx.x; asm volatile("" : "+v"(tid_));
    const int tid = tid_, lane = tid & 63, r32 = lane & 31, hi = lane >> 5; const int wid = __builtin_amdgcn_readfirstlane(tid >> 6);
    const unsigned lds0 = (unsigned)(uintptr_t)shm;
    ALAS float* wsf = (ALAS float*)(shm + LDS_WS) + wid * 64;
    unsigned doff[3];
#pragma unroll
    for (int i = 0; i < 3; ++i) { const int pc = wid + 8 * i;
        if (pc < NCH) doff[i] = (unsigned)((lane * U.kpitch + U.kcol + pc * 8) * 2);
        else { const int v = pc - NCH; doff[i] = (unsigned)(((16 * (v & 3) + (lane >> 2)) * U.vpitch + U.vcol + (v >> 2) * 32 + (lane & 3) * 8) * 2); } }
    auto dma_tile = [&](int t, int slot) {
        int key0;
        if (NA && t >= 4) key0 = U.kv0 + CTX + (U.rmin + (t - 4)) * GW; else key0 = U.kv0 + 64 * t;
        const unsigned sbase = lds0 + slot * SLOT;
        const bf16_t* kb_ = U.K + (size_t)key0 * U.kpitch; const bf16_t* vb_ = U.V + (size_t)key0 * U.vpitch;
#pragma unroll
        for (int i = 0; i < 3; ++i) { const int pc = wid + 8 * i;
            if (pc < NP) {
                if (pc < NCH) glds16s(doff[i], kb_, (unsigned)__builtin_amdgcn_readfirstlane(sbase + pc * 1024));
                else glds16s(doff[i], vb_, (unsigned)__builtin_amdgcn_readfirstlane(sbase + KSLOT + (pc - NCH) * 1024));
            } }
    };
    asm volatile("s_waitcnt vmcnt(0)" ::: "memory");
    dma_tile(0, 0); if (U.nt > 1) dma_tile(1, 1);
    if (NA) { ALAS float* tb = (ALAS float*)(shm + LDS_RPB); for (int i = tid; i < 15 * 31; i += 512) tb[i] = rpb_g[U.head * 465 + i] * LOG2E; }
    bf16x8 qr[ND0];
    const bf16_t* Qw = U.Q + (size_t)(U.q0 + wid * 32 + r32) * U.qpitch + U.qcol;
#pragma unroll
    for (int d0 = 0; d0 < ND0; ++d0) qr[d0] = *(const bf16x8*)(Qw + d0 * 16 + hi * 8);
    if (MLAQ) {
        float f[ND0][8]; float ss = 0.f;
#pragma unroll
        for (int d0 = 0; d0 < ND0; ++d0)
#pragma unroll
            for (int j = 0; j < 8; ++j) { f[d0][j] = bf2f((bf16_t)qr[d0][j]); ss += f[d0][j] * f[d0][j]; }
        ss += __shfl_xor(ss, 32);
        const float rn = rsqrtf(ss * (1.f / 96.f) + EPS) * C2_96;
#pragma unroll
        for (int d0 = 0; d0 < ND0; ++d0)
#pragma unroll
            for (int j = 0; j < 8; ++j) f[d0][j] = f[d0][j] * rn * qgain[d0 * 16 + hi * 8 + j];
        const int t = (int)((U.q0 + wid * 32 + r32) % S); const int grow = t / GW, gcol = t % GW;
#pragma unroll
        for (int part = 0; part < 2; ++part) { const int pos = part ? gcol : grow;
#pragma unroll
            for (int j = 0; j < 8; ++j) { const float cs = T16[pos * 8 + j], sn = T16[512 + pos * 8 + j];
                const float mine = f[4 + part][j], other = __shfl_xor(mine, 32);
                f[4 + part][j] = hi == 0 ? (mine * cs - other * sn) : (other * sn + mine * cs); } }
#pragma unroll
        for (int d0 = 0; d0 < ND0; ++d0)
#pragma unroll
            for (int j = 0; j < 4; ++j) { const unsigned w = cvtpk(f[d0][2 * j], f[d0][2 * j + 1]); qr[d0][2 * j] = (short)(w & 0xffff); qr[d0][2 * j + 1] = (short)(w >> 16); }
    }
    const int grow_w = NA ? 4 * U.rg + (wid >> 1) : 0, c0w = 32 * (wid & 1);
    const int r0w = NA ? min(max(grow_w - 4, 0), 24) : 0;
    const int qc = c0w + r32;
    const int cs_q = min(max(qc - 8, 0), 48);
    float mhat = 0.f, l_reg = 0.f; f32x16 o[2]; o[0] = f32x16{}; o[1] = f32x16{};
    const ALAS char* vp0 = shm + KSLOT + ((lane >> 4) & 1) * 32 + (lane & 3) * 8 + (4 * hi + ((lane & 15) >> 2)) * 64;
    const int NT = U.nt;
    f32x16 a0, a1, b0, b1;
    u32x4 pw0, pw1, pw2, pw3;
    auto wait_tile = [&](int t) {
        if (t + 1 < NT) { if (NP == 20 && wid < 4) AWAIT_BAR(3); else AWAIT_BAR(2); } else AWAIT_BAR(0);
        if (t + 2 < NT) dma_tile(t + 2, (t + 2) & 3);
    };
    auto maskbias = [&](f32x16& c0, f32x16& c1, int t) {
        if (NA && t >= 4) {
            const int krow = U.rmin + (t - 4); const bool rowok = (krow >= r0w) && (krow < r0w + 8);
            const ALAS float* tb = (const ALAS float*)(shm + LDS_RPB) + min(max(krow - grow_w + 7, 0), 14) * 31;
#pragma unroll
            for (int r = 0; r < 16; ++r) {
                const int kc0 = crow(r, hi), kc1 = kc0 + 32;
                { const int rel = kc0 - cs_q; const int bi = min(max(kc0 - qc + 15, 0), 30); const float bv = tb[bi]; c0[r] = (rowok && (unsigned)rel < 16u) ? c0[r] + bv : -INFINITY; }
                { const int rel = kc1 - cs_q; const int bi = min(max(kc1 - qc + 15, 0), 30); const float bv = tb[bi]; c1[r] = (rowok && (unsigned)rel < 16u) ? c1[r] + bv : -INFINITY; }
            }
        }
    };
    f32x16 negm = f32x16{};
    auto decide = [&](f32x16& c0, f32x16& c1, bool first) {
        const float rm = rowmax32(c0, c1);
        if (first || __any(rm > THR)) {
            const float dl = first ? rm : fmaxf(rm, 0.f);
            mhat += dl;
#pragma unroll
            for (int r = 0; r < 16; ++r) { c0[r] -= dl; c1[r] -= dl; }
#pragma unroll
            for (int r = 0; r < 16; ++r) negm[r] = -mhat;
            if (!first) {
                const float f = __builtin_amdgcn_exp2f(-dl);
                l_reg *= f;
                if (hi == 0) wsf[r32] = f;
                asm volatile("s_waitcnt lgkmcnt(0)" ::: "memory");
#pragma unroll
                for (int r = 0; r < 16; ++r) { const float fr_ = wsf[crow(r, hi)]; o[0][r] *= fr_; o[1][r] *= fr_; }
            }
        }
    };
    auto finish = [&](f32x16& c0, f32x16& c1) {
        float sacc = 0.f;
#pragma unroll
        for (int r = 0; r < 16; ++r) { c0[r] = __builtin_amdgcn_exp2f(c0[r]); c1[r] = __builtin_amdgcn_exp2f(c1[r]); sacc += c0[r] + c1[r]; }
        l_reg += sacc;
#pragma unroll
        for (int j = 0; j < 4; ++j) { pw0[j] = cvtpk(c0[2 * j], c0[2 * j + 1]); pw1[j] = cvtpk(c0[8 + 2 * j], c0[9 + 2 * j]); pw2[j] = cvtpk(c1[2 * j], c1[2 * j + 1]); pw3[j] = cvtpk(c1[8 + 2 * j], c1[9 + 2 * j]); }
    };
    auto step = [&](f32x16& c0, f32x16& c1, f32x16& q0, f32x16& q1, int j) {
        wait_tile(j);
#ifdef ATT_DUP_BAR
        asm volatile("s_waitcnt lgkmcnt(0)\n\ts_barrier" ::: "memory");
#endif
        qkt<ND0>(c0, c1, shm + (j & 3) * SLOT, qr, negm, r32, hi);
#ifdef ATT_DUP_MFMA
        { f32x16 d0_, d1_; qkt<ND0>(d0_, d1_, shm + (j & 3) * SLOT, qr, r32, hi); asm volatile("" :: "v"(d0_), "v"(d1_)); }
#endif
#ifdef ATT_DUP_VALU
        { f32x16 e0_ = q0, e1_ = q1; float sacc_ = 0.f;
#pragma unroll
          for (int r = 0; r < 16; ++r) { e0_[r] = __builtin_amdgcn_exp2f(e0_[r] - mhat * 1.0001f); e1_[r] = __builtin_amdgcn_exp2f(e1_[r] - mhat * 1.0001f); sacc_ += e0_[r] + e1_[r]; }
          unsigned w_ = 0;
#pragma unroll
          for (int jj = 0; jj < 8; ++jj) { w_ ^= cvtpk(e0_[2 * jj], e0_[2 * jj + 1]); w_ ^= cvtpk(e1_[2 * jj], e1_[2 * jj + 1]); }
          asm volatile("" :: "v"(sacc_), "v"(w_)); }
#endif
        finish(q0, q1);
        pv(o, vp0 + ((j - 1) & 3) * SLOT, __builtin_bit_cast(bf16x8, pw0), __builtin_bit_cast(bf16x8, pw1), __builtin_bit_cast(bf16x8, pw2), __builtin_bit_cast(bf16x8, pw3));
        maskbias(c0, c1, j);
        decide(c0, c1, false);
    };
    wait_tile(0);
    qkt<ND0>(a0, a1, shm, qr, negm, r32, hi);
    decide(a0, a1, true);
    int j = 1;
#pragma unroll 1
    for (; j + 1 < NT; j += 2) { step(b0, b1, a0, a1, j); step(a0, a1, b0, b1, j + 1); }
    if (j < NT) { step(b0, b1, a0, a1, j); finish(b0, b1); } else finish(a0, a1);
    pv(o, vp0 + ((NT - 1) & 3) * SLOT, __builtin_bit_cast(bf16x8, pw0), __builtin_bit_cast(bf16x8, pw1), __builtin_bit_cast(bf16x8, pw2), __builtin_bit_cast(bf16x8, pw3));
    { auto rr = __builtin_amdgcn_permlane32_swap(__float_as_uint(l_reg), __float_as_uint(l_reg), false, false); l_reg = __uint_as_float(rr[0]) + __uint_as_float(rr[1]); }
    if (hi == 0) wsf[32 + r32] = l_reg;
    asm volatile("s_waitcnt lgkmcnt(0)" ::: "memory");
    float rli[16];
#pragma unroll
    for (int r = 0; r < 16; ++r) rli[r] = __builtin_amdgcn_rcpf(wsf[32 + crow(r, hi)]);
    bf16_t* Ow = U.O + (size_t)(U.q0 + wid * 32) * U.opitch + U.ocol;
    { ALAS bf16_t* stg = (ALAS bf16_t*)(shm + LDS_OST) + wid * 2048;
#pragma unroll
        for (int r = 0; r < 16; ++r) { const int orow = crow(r, hi);
#pragma unroll
            for (int d0 = 0; d0 < 2; ++d0) stg[orow * 64 + d0 * 32 + r32] = f2bf(o[d0][r] * rli[r]); }
        asm volatile("s_waitcnt lgkmcnt(0)" ::: "memory");
#pragma unroll
        for (int i = 0; i < 4; ++i) { const int row = i * 8 + (lane >> 3), ch = lane & 7; const u32x4 v = *(const ALAS u32x4*)(stg + row * 64 + ch * 8); *(u32x4*)(Ow + (size_t)row * U.opitch + ch * 8) = v; } }
    asm volatile("s_waitcnt vmcnt(0) lgkmcnt(0)\n\ts_barrier" ::: "memory");
}
}
#define LAS __attribute__((address_space(3)))
#define XB_TMO      128
#define XB_XCNT(j)  (256  + 64 * (j))
#define XB_XSUB(j)  (1280 + 64 * (j))
#define XB_XGEN(j)  (2304 + 64 * (j))
#define XB_TOP      3328
#define XB_TOPGEN   3392
#define XCD_BAR_WORDS 3456
#define XB_SPIN_CAP (1u << 18)

__device__ __forceinline__ unsigned xb_ld(unsigned* p)              { return __hip_atomic_load(p, __ATOMIC_RELAXED, __HIP_MEMORY_SCOPE_AGENT); }
__device__ __forceinline__ unsigned xb_add(unsigned* p, unsigned v) { return __hip_atomic_fetch_add(p, v, __ATOMIC_RELAXED, __HIP_MEMORY_SCOPE_AGENT); }
__device__ __forceinline__ unsigned xb_xcc_id() { return (unsigned)__builtin_amdgcn_s_getreg((3 << 11) | 20) & 0xFu; }
#define XB_SPIN(cond, bar) do { unsigned _sp = 0; while (cond) { __builtin_amdgcn_s_sleep(1); \
    if ((++_sp & 255u) == 0u) { if (xb_ld(&(bar)[XB_TMO])) break; if (_sp > XB_SPIN_CAP) { atomicAdd(&(bar)[XB_TMO], 1u); break; } } } } while (0)

struct XcdBarrier {
    unsigned* bar; unsigned x;
    volatile LAS unsigned* st;
};

__device__ __forceinline__ XcdBarrier xcd_barrier_post(unsigned* bar, volatile LAS unsigned* st) {
    XcdBarrier b; b.bar = bar; b.x = xb_xcc_id(); b.st = st;
    if (threadIdx.x == 0) (void)xb_add(&bar[XB_XCNT(b.x)], 1u);
    return b;
}
__device__ __forceinline__ void xcd_barrier_complete(unsigned* bar, unsigned x, unsigned& nloc, unsigned& nx) {
    const unsigned G = gridDim.x * gridDim.y * gridDim.z;
    unsigned sum, cnt, mine, sp = 0u;
    for (;;) {
        sum = 0u; cnt = 0u; mine = 0u;
#pragma unroll
        for (unsigned j = 0; j < 16; ++j) { const unsigned c = xb_ld(&bar[XB_XCNT(j)]); sum += c; cnt += (c > 0u) ? 1u : 0u; mine = (j == x) ? c : mine; }
        if (sum == G) break;
        __builtin_amdgcn_s_sleep(1);
        if ((++sp & 255u) == 0u) { if (xb_ld(&bar[XB_TMO])) break; if (sp > XB_SPIN_CAP) { atomicAdd(&bar[XB_TMO], 1u); break; } }
    }
    nloc = mine > 0u ? mine : 1u; nx = cnt > 0u ? cnt : 1u;
}

__device__ __forceinline__ void xcd_barrier(const XcdBarrier& b) {
    asm volatile("s_waitcnt vmcnt(0)" ::: "memory");
    __syncthreads();
    if (threadIdx.x == 0) {
        unsigned* bar = b.bar;
        __builtin_amdgcn_s_waitcnt(0);
        unsigned nloc = b.st[0], nx = b.st[1];
        if (nloc == 0u) { xcd_barrier_complete(bar, b.x, nloc, nx); b.st[0] = nloc; b.st[1] = nx; }
        const unsigned old = xb_add(&bar[XB_XSUB(b.x)], 1u);
        const unsigned gen = old / nloc;
        if (old + 1u == (gen + 1u) * nloc) {
            __builtin_amdgcn_fence(__ATOMIC_RELEASE, "agent");
            asm volatile("s_waitcnt vmcnt(0)" ::: "memory");
            const unsigned og = xb_add(&bar[XB_TOP], 1u);
            const unsigned tg = og / nx;
            if (og + 1u == (tg + 1u) * nx) xb_add(&bar[XB_TOPGEN], 1u);
            else XB_SPIN(xb_ld(&bar[XB_TOPGEN]) == tg, bar);
            __builtin_amdgcn_fence(__ATOMIC_ACQUIRE, "agent");
            xb_add(&bar[XB_XGEN(b.x)], 1u);
            asm volatile("s_waitcnt vmcnt(0)" ::: "memory");
        } else {
            XB_SPIN(xb_ld(&bar[XB_XGEN(b.x)]) == gen, bar);
            __builtin_amdgcn_fence(__ATOMIC_ACQUIRE, "agent");
            asm volatile("s_waitcnt vmcnt(0)" ::: "memory");
        }
    }
    __syncthreads();
}
namespace mk {
#define MLAS __attribute__((address_space(3)))
constexpr int NWAVES = 8, NTHR = 512;
constexpr int RING_BYTES = 131072;
constexpr int LDS_BYTES = 147456;
constexpr int NPHASE = 16;
typedef unsigned v4u __attribute__((ext_vector_type(4)));
typedef float f32x4 __attribute__((ext_vector_type(4)));

struct Ctx {
    Params p; MLAS unsigned char* lds; int tid, lane, wave, G, vcu, bid;
};
__device__ __forceinline__ unsigned pk2(float lo, float hi) { return (unsigned)f2bf(lo) | ((unsigned)f2bf(hi) << 16); }

enum { W_IN0 = 0, W_OUT0, W_GU0, W_D0, W_IN1, W_UQ, W_UKV, W_OUT1, W_GU1, W_D1, NWMAT };
struct SrcBlk { const float* W; int ld; int col; const float* kscale; };
__device__ __forceinline__ SrcBlk src_of(const Params& p, int mat, int nb) {
    SrcBlk s; s.kscale = nullptr; const int pn = nb >> 3, q = nb & 7, bj = q >> 2, wc = q & 3;
    switch (mat) {
    case W_IN0: s.W = p.in[I0_WIN]; s.ld = L0_IN; s.col = 256 * pn + 64 * wc + 32 * bj; break;
    case W_OUT0: s.W = p.in[I0_WOUT]; s.ld = D; s.col = 32 * nb; break;
    case W_GU0: s.W = bj ? p.in[I0_WU] : p.in[I0_WG]; s.ld = FF; s.col = 128 * pn + 32 * wc; break;
    case W_D0: s.W = p.in[I0_WD]; s.ld = D; s.col = 32 * nb; break;
    case W_IN1: s.W = p.in[I1_WIN]; s.ld = L1_IN;
        if (pn == 0) s.col = 128 * bj + 32 * wc;
        else if (pn == 1) { if (bj == 0) s.col = 256 + 32 * wc; else s.col = 640; }
        else if (pn == 2) s.col = 384 + 128 * bj + 32 * wc;
        else if (pn < 5) s.col = 672 + (pn - 3) * 256 + 64 * wc + 32 * bj;
        else if (pn < 7) s.col = 1184 + (pn - 5) * 256 + 64 * wc + 32 * bj;
        else s.col = 1696 + (pn - 7) * 256 + 64 * wc + 32 * bj;
        break;
    case W_UQ: s.W = p.in[I1_WUQ]; s.ld = 768; s.col = 32 * nb; s.kscale = p.in[I1_QAG]; break;
    case W_UKV: s.W = p.in[I1_WUKV]; s.ld = 1024; s.col = (2 * pn + (wc >> 1)) * 128 + (wc & 1) * 64 + 32 * bj; s.kscale = p.in[I1_KVAG]; break;
    case W_OUT1: s.W = p.in[I1_WOUT]; s.ld = D; s.col = 32 * nb; break;
    case W_GU1: s.W = bj ? p.in[I1_WU] : p.in[I1_WG]; s.ld = FF; s.col = 128 * pn + 32 * wc; break;
    default: s.W = p.in[I1_WD]; s.ld = D; s.col = 32 * nb; break;
    }
    return s;
}
struct WMat { size_t ws_off; int K, N; };
__host__ __device__ constexpr WMat wmat(int mat) {
    switch (mat) {
    case W_IN0: return {WS_W_IN0, D, 1536}; case W_OUT0: return {WS_W_OUT0, D, D}; case W_GU0: return {WS_W_GU0, D, 2 * FF}; case W_D0: return {WS_W_D0, FF, D};
    case W_IN1: return {WS_W_IN1, D, L1_INP}; case W_UQ: return {WS_W_UQ, 384, 768}; case W_UKV: return {WS_W_UKV, 256, 1024}; case W_OUT1: return {WS_W_OUT1, D, D};
    case W_GU1: return {WS_W_GU1, D, 2 * FF}; default: return {WS_W_D1, FF, D};
    }
}
template <int mat> __device__ __forceinline__ void transpose_item(const Params& p, int item, MLAS float* scr, int lane) {
    const WMat wm = wmat(mat); const int nblk = wm.N / 32, kb = item / nblk, nb = item % nblk, k0 = 64 * kb;
    const SrcBlk s = src_of(p, mat, nb);
    bf16_t* WT = (bf16_t*)(p.ws + wm.ws_off);
    const int c = lane & 7;
    if (s.W == nullptr) {
#pragma unroll
        for (int j = 0; j < 4; ++j) { const int n = (lane >> 3) + 8 * j; *(v4u*)(WT + (size_t)(32 * nb + n) * wm.K + k0 + 8 * c) = (v4u){0u, 0u, 0u, 0u}; }
        return;
    }
    MLAS float* t0 = scr; MLAS float* t1 = scr + 64 * 33;
    if (mat == W_OUT0 && kb < 4) return;
    constexpr bool fused_pool = false;
    { const int c4 = (lane & 7) * 4, kr = lane >> 3;
        const float* wsrc = s.W + (size_t)(k0 + kr) * s.ld + s.col + c4;
        f32x4 v[8];
#pragma unroll
        for (int i = 0; i < 8; ++i) v[i] = *(const f32x4*)(wsrc + (size_t)(8 * i) * s.ld);
#pragma unroll
        for (int i = 0; i < 8; ++i) { const int kk = kr + 8 * i; float sc = 1.f;
            if (s.kscale) sc = s.kscale[k0 + kk];
            if (fused_pool) sc *= p.in[I0_POOLS][k0 + kk];
            MLAS float* d = t0 + kk * 33 + c4; d[0] = v[i][0] * sc; d[1] = v[i][1] * sc; d[2] = v[i][2] * sc; d[3] = v[i][3] * sc; } }
    asm volatile("s_waitcnt lgkmcnt(0)" ::: "memory");
    MLAS float* src = t0;
    if (fused_pool) {
        const float* pw = p.in[I0_POOLW] + kb * 4096; const int nn = lane & 31, ch = lane >> 5;
        for (int cc = ch; cc < 64; cc += 2) { float a = 0.f;
#pragma unroll 8
            for (int d = 0; d < 64; ++d) a += pw[cc * 64 + d] * t0[d * 33 + nn];
            t1[cc * 33 + nn] = a; }
        asm volatile("s_waitcnt lgkmcnt(0)" ::: "memory");
        src = t1;
    }
#pragma unroll
    for (int j = 0; j < 4; ++j) { const int n = (lane >> 3) + 8 * j; const MLAS float* sp = src + (8 * c) * 33 + n;
        v4u o; o.x = pk2(sp[0 * 33], sp[1 * 33]); o.y = pk2(sp[2 * 33], sp[3 * 33]); o.z = pk2(sp[4 * 33], sp[5 * 33]); o.w = pk2(sp[6 * 33], sp[7 * 33]);
        *(v4u*)(WT + (size_t)(32 * nb + n) * wm.K + k0 + 8 * c) = o; }
    asm volatile("s_waitcnt lgkmcnt(0)" ::: "memory");
}

#ifndef P0MASK
#define P0MASK 15
#endif
__device__ __forceinline__ void phase_prologue(Ctx& C) {
    const Params& p = C.p;
    MLAS float* sil = (MLAS float*)C.lds;
    MLAS float* red = (MLAS float*)(C.lds + 9 * 1024 * 4);
    for (int i = C.tid; i < 9 * D; i += NTHR) { const int j = i / D, k = i % D; const float c = (j < 8) ? p.in[I_C][j * D + k] : p.in[I_CCTX][k]; sil[i] = c / (1.f + expf(-c)); }
    __syncthreads();
    float* MOD = (float*)(p.ws + WS_MOD);
    if (P0MASK & 1)
    for (int it = C.vcu; it < 192; it += C.G) {
        const int l = it / 96, r_ = it % 96, cg_ = r_ >> 2, kq = r_ & 3, n0 = cg_ * 256;
        const float* w = (l ? p.in[I1_ADAW] : p.in[I0_ADAW]) + (size_t)(kq * 256 + C.wave * 32) * 6144 + n0 + 4 * C.lane;
        f32x4 acc[9];
#pragma unroll
        for (int j = 0; j < 9; ++j) acc[j] = (f32x4){0.f, 0.f, 0.f, 0.f};
#pragma unroll 8
        for (int k = 0; k < 32; ++k) { const f32x4 wv = *(const f32x4*)(w + (size_t)k * 6144); const int kk = kq * 256 + C.wave * 32 + k;
#pragma unroll
            for (int j = 0; j < 9; ++j) acc[j] += wv * sil[j * D + kk]; }
#pragma unroll
        for (int j = 0; j < 9; ++j) *(MLAS f32x4*)(red + (C.wave * 9 + j) * 256 + 4 * C.lane) = acc[j];
        __syncthreads();
        for (int i = C.tid; i < 9 * 256; i += NTHR) { const int j = i >> 8, c = i & 255; float sm_ = 0.f;
#pragma unroll
            for (int wv = 0; wv < 8; ++wv) sm_ += red[(wv * 9 + j) * 256 + c];
            if (kq == 0) sm_ += (l ? p.in[I1_ADAB] : p.in[I0_ADAB])[n0 + c];
            atomicAdd(MOD + (size_t)(l * 9 + j) * 6144 + n0 + c, sm_); }
        __syncthreads();
    }
    __syncthreads();
    {
        MLAS float* PA = (MLAS float*)C.lds;
        MLAS float* PB = (MLAS float*)(C.lds + 64 * 65 * 4);
        bf16_t* WT = (bf16_t*)(p.ws + WS_W_OUT0);
        for (int tile = C.vcu; tile < 128; tile += C.G) {
            const int g = tile >> 5, nb = tile & 31;
            for (int i = C.tid; i < 4096; i += NTHR) PA[(i >> 6) * 65 + (i & 63)] = p.in[I0_POOLW][g * 4096 + i];
            for (int i = C.tid; i < 2048; i += NTHR) { const int d = i >> 5, nn = i & 31; PB[d * 33 + nn] = p.in[I0_WOUT][(size_t)(g * 64 + d) * D + 32 * nb + nn] * p.in[I0_POOLS][g * 64 + d]; }
            __syncthreads();
            { const int c = C.tid >> 3, n4 = (C.tid & 7) * 4; float a0 = 0.f, a1 = 0.f, a2 = 0.f, a3 = 0.f;
#pragma unroll 8
                for (int d = 0; d < 64; ++d) { const float pa = PA[c * 65 + d]; const MLAS float* b = PB + d * 33 + n4; a0 += pa * b[0]; a1 += pa * b[1]; a2 += pa * b[2]; a3 += pa * b[3]; }
                bf16_t* o = WT + (size_t)(32 * nb + n4) * D + g * 64 + c;
                o[0] = f2bf(a0); o[D] = f2bf(a1); o[2 * D] = f2bf(a2); o[3 * D] = f2bf(a3); }
            __syncthreads();
        }
    }
    const int gw = C.vcu * NWAVES + C.wave, NGW = C.G * NWAVES;
    MLAS float* scr = (MLAS float*)(C.lds + C.wave * 16896);
    if (P0MASK & 2) {
        int rot = 0;
#define TR_MAT(M) { constexpr int ni = (wmat(M).K / 64) * (wmat(M).N / 32); int first = gw - rot; if (first < 0) first += NGW; \
            for (int it = first; it < ni; it += NGW) transpose_item<M>(p, it, scr, C.lane); rot = (rot + ni) % NGW; }
        TR_MAT(W_IN0) TR_MAT(W_OUT0) TR_MAT(W_GU0) TR_MAT(W_D0) TR_MAT(W_IN1) TR_MAT(W_UQ) TR_MAT(W_UKV) TR_MAT(W_OUT1) TR_MAT(W_GU1) TR_MAT(W_D1)
#undef TR_MAT
    }
    if ((P0MASK & 4) && C.bid == C.G - 1) {
        float* T32 = (float*)(p.ws + WS_ROPE32); float* T16 = (float*)(p.ws + WS_ROPE16);
        for (int i = C.tid; i < 1024; i += NTHR) { const int pos = i >> 4, f = i & 15; const float ang = (float)pos * powf(10000.0f, -((float)f * 2.0f) / 32.0f); T32[i] = cosf(ang); T32[1024 + i] = sinf(ang); }
        for (int i = C.tid; i < 512; i += NTHR) { const int pos = i >> 3, f = i & 7; const float ang = (float)pos * powf(10000.0f, -((float)f * 2.0f) / 16.0f); T16[i] = cosf(ang); T16[512 + i] = sinf(ang); }
    }
    if (P0MASK & 8) { float* SSQ = (float*)(p.ws + WS_SSQ); float* SSKV = (float*)(p.ws + WS_SSKV);
        for (int i = C.bid * NTHR + C.tid; i < MT; i += C.G * NTHR) { SSQ[i] = 0.f; SSKV[i] = 0.f; } }
}

__device__ __forceinline__ void phase_norm(Ctx& C, const float* xl, const float* xc, const float* gain, int layer, int sh_chunk, int sc_chunk, int nrows) {
    const int gw = C.vcu * NWAVES + C.wave, NGW = C.G * NWAVES;
    bf16_t* XN = (bf16_t*)(C.p.ws + WS_XN); const float* MODb = (const float*)(C.p.ws + WS_MOD) + (size_t)layer * 9 * 6144;
    for (int m = gw; m < nrows; m += NGW) {
        const float* xr = m < ML ? xl + (size_t)m * D : xc + (size_t)(m - ML) * D;
        const float* mod = MODb + (size_t)modidx_of(m) * 6144;
        f32x4 v[4]; float ss = 0.f;
#pragma unroll
        for (int j = 0; j < 4; ++j) { v[j] = *(const f32x4*)(xr + 4 * C.lane + 256 * j); ss += (v[j][0] * v[j][0] + v[j][1] * v[j][1]) + (v[j][2] * v[j][2] + v[j][3] * v[j][3]); }
        ss = wave_sum(ss);
        const float r = rsqrtf(ss * (1.f / D) + EPS);
#pragma unroll
        for (int j = 0; j < 4; ++j) { const int c = 4 * C.lane + 256 * j;
            const f32x4 g = *(const f32x4*)(gain + c), sc = *(const f32x4*)(mod + sc_chunk * D + c), sh = *(const f32x4*)(mod + sh_chunk * D + c);
            const f32x4 y = ((v[j] * r) * g) * (sc + 1.f) + sh;
            uint2 o; o.x = pk2(y[0], y[1]); o.y = pk2(y[2], y[3]);
            *(uint2*)(XN + (size_t)m * D + c) = o; }
    }
}

__device__ __forceinline__ void phase_pool(Ctx& C) {
    const bf16_t* A0 = (const bf16_t*)(C.p.ws + WS_A0); bf16_t* MIX = (bf16_t*)(C.p.ws + WS_MIX);
    const int gt = C.vcu * NTHR + C.tid, NGT = C.G * NTHR;
    for (int it = gt; it < MT * 32; it += NGT) {
        const int m = it >> 5, c8 = (it & 31) * 8, g = c8 >> 6, w = 2 << g;
        int t, T; if (m < ML) { t = m % S; T = S; } else { t = (m - ML) % CTX; T = CTX; }
        const int base = m - t; int lo = t - w / 2; if (lo < 0) lo = 0; int hi = t - w / 2 + w; if (hi > T) hi = T;
        float s[8];
#pragma unroll
        for (int e = 0; e < 8; ++e) s[e] = 0.f;
        for (int j = lo; j < hi; ++j) { const v4u q = *(const v4u*)(A0 + (size_t)(base + j) * 256 + c8);
#pragma unroll
            for (int e = 0; e < 4; ++e) { s[2 * e] += __uint_as_float(q[e] << 16); s[2 * e + 1] += __uint_as_float(q[e] & 0xffff0000u); } }
        const v4u q = *(const v4u*)(A0 + (size_t)m * 256 + c8); const float inv = 1.f / (float)(hi - lo);
        v4u o;
#pragma unroll
        for (int e = 0; e < 4; ++e) o[e] = pk2(s[2 * e] * inv - __uint_as_float(q[e] << 16), s[2 * e + 1] * inv - __uint_as_float(q[e] & 0xffff0000u));
        *(v4u*)(MIX + (size_t)m * D + c8) = o;
    }
}

__device__ __forceinline__ void phase_attn0(Ctx& C) {
    const Params& p = C.p;
    MLAS char* shm = (MLAS char*)C.lds;
    att::UnitDesc U; U.Q = (const bf16_t*)(p.ws + WS_Q0); U.qpitch = 768; U.K = (const bf16_t*)(p.ws + WS_K0); U.kpitch = 256; U.V = (const bf16_t*)(p.ws + WS_V0); U.vpitch = 256;
    U.O = (bf16_t*)(p.ws + WS_MIX); U.opitch = D; U.rg = 0; U.rmin = 0; U.head = 0;
    for (int u = C.vcu; u < 768 + 96; u += C.G) {
        if (u < 768) { const int qb = u & 7, bh = u >> 3, h = bh % 12, b = bh / 12;
            U.q0 = (long)b * S + 256 * qb; U.qcol = h * 64; U.kcol = (h / 3) * 64; U.vcol = (h / 3) * 64; U.ocol = 256 + h * 64; U.kv0 = b * SK; U.nt = SK / 64; }
        else { const int bh = u - 768, h = bh % 12, b = bh / 12;
            U.q0 = (long)ML + 256 * b; U.qcol = h * 64; U.kcol = (h / 3) * 64; U.vcol = (h / 3) * 64; U.ocol = 256 + h * 64; U.kv0 = b * SK; U.nt = CTX / 64; }
        att::attn_unit<64, false, false>(U, shm, nullptr, nullptr, nullptr);
    }
    phase_pool(C);
}
__device__ __forceinline__ void phase_attn1(Ctx& C) {
    const Params& p = C.p;
    MLAS char* shm = (MLAS char*)C.lds;
    const float* T16 = (const float*)(p.ws + WS_ROPE16);
    att::UnitDesc U; U.O = (bf16_t*)(p.ws + WS_MIX); U.opitch = D;
    for (int u = C.vcu; u < 1024; u += C.G) {
        const int uu = u & 511, qb = uu & 7, h = (uu >> 3) & 7, b = uu >> 6;
        U.q0 = (long)b * S + 256 * qb; U.kv0 = b * SK; U.head = h;
        if (u < 512) {
            U.Q = (const bf16_t*)(p.ws + WS_MQ); U.qpitch = 768; U.qcol = h * 96; U.K = (const bf16_t*)(p.ws + WS_MK); U.kpitch = 768; U.kcol = h * 96;
            U.V = (const bf16_t*)(p.ws + WS_MV); U.vpitch = 512; U.vcol = h * 64; U.ocol = h * 64; U.nt = SK / 64; U.rg = 0; U.rmin = 0;
            att::attn_unit<96, false, true>(U, shm, p.in[I1_MQG], T16, nullptr);
        } else {
            U.Q = (const bf16_t*)(p.ws + WS_NQ); U.qpitch = 512; U.qcol = h * 64; U.K = (const bf16_t*)(p.ws + WS_NK); U.kpitch = 512; U.kcol = h * 64;
            U.V = (const bf16_t*)(p.ws + WS_NV); U.vpitch = 512; U.vcol = h * 64; U.ocol = 512 + h * 64; U.rg = qb;
            const int rmin = min(max(4 * qb - 4, 0), 24), rmax = min(max(4 * qb + 3 - 4, 0), 24) + 7;
            U.rmin = rmin; U.nt = 4 + (rmax - rmin + 1);
            att::attn_unit<64, true, false>(U, shm, nullptr, nullptr, p.in[I1_RPB]);
        }
    }
}

__global__ void __launch_bounds__(NTHR, 2) mega(Params p, int ph_lo, int ph_hi) {
    extern __shared__ __attribute__((aligned(16))) unsigned char lds_raw[];
    cg::grid_group grid = cg::this_grid();
    Ctx C; C.p = p; C.lds = (MLAS unsigned char*)lds_raw; C.tid = threadIdx.x; C.lane = C.tid & 63; C.wave = __builtin_amdgcn_readfirstlane(C.tid >> 6);
    C.G = gridDim.x; C.bid = blockIdx.x; C.vcu = (C.G % 8 == 0) ? (C.bid % 8) * (C.G / 8) + C.bid / 8 : C.bid;
    volatile LAS unsigned* bst = (volatile LAS unsigned*)(C.lds + LDS_BYTES - 64);
    if (C.tid < 2) bst[C.tid] = 0u;
    __syncthreads();
    unsigned* barw = (unsigned*)(p.ws + WS_BARRIER);
    XcdBarrier bar; bar.bar = barw; bar.x = 0; bar.st = nullptr;
    if (ph_hi - ph_lo > 1) bar = xcd_barrier_post(barw, bst);
    float* out = p.out; float* xrc = (float*)(p.ws + WS_XRC);
    const float* MOD = (const float*)(p.ws + WS_MOD);
    bf16_t* XN = (bf16_t*)(p.ws + WS_XN); bf16_t* MIX = (bf16_t*)(p.ws + WS_MIX); bf16_t* H = (bf16_t*)(p.ws + WS_H);
    const float* T32 = (const float*)(p.ws + WS_ROPE32); const float* T16 = (const float*)(p.ws + WS_ROPE16);
#define WSB(off) ((bf16_t*)(p.ws + (off)))
#ifndef PHMASK
#define PHMASK 0xFFFF
#endif
#ifndef REPMASK
#define REPMASK 0
#endif
#ifndef NSYNC
#define NSYNC 1
#endif
#define PH(k) if (((PHMASK >> (k)) & 1) && ph_lo <= (k) && (k) < ph_hi) for (int rep_ = 0; rep_ < (((REPMASK >> (k)) & 1) ? 2 : 1); ++rep_, (((REPMASK >> (k)) & 1) && rep_ == 1 ? xcd_barrier(bar) : (void)0))
#ifndef USE_CG_SYNC
#define USE_CG_SYNC 0
#endif
#define SEAM(k) if (ph_lo <= (k) && (k) + 1 < ph_hi) { for (int s_ = 0; s_ < NSYNC; ++s_) { if (USE_CG_SYNC || ph_hi > 1000) grid.sync(); else xcd_barrier(bar); } }
    PH(0) { phase_prologue(C); } SEAM(0);
    PH(1) { phase_norm(C, p.in[I_X], p.in[I_CTX], p.in[I0_NMIX], 0, 0, 1, MT); } SEAM(1);
    PH(2) { pg8::Gemm g{XN, WSB(WS_W_IN0), MT, 1536, D}; pg8::StaticOrder So; So.init(MT, 1536, C.G, C.bid);
        epi::EpiIn0 E{WSB(WS_A0), WSB(WS_Q0), WSB(WS_K0), WSB(WS_V0), p.in[I0_QG], p.in[I0_KG], T32};
        pg8::gemm_phase<epi::EpiIn0, pg8::StaticOrder, true, true>(C.lds, g, So, E); } SEAM(2);
    PH(3) { phase_attn0(C); } SEAM(3);
    PH(4) { pg8::Gemm g{MIX, WSB(WS_W_OUT0), MT, D, D}; pg8::StaticOrder So; So.init(MT, D, C.G, C.bid);
        epi::EpiResid E{p.in[I_X], p.in[I_CTX], out, xrc, MOD + 2 * D};
        pg8::gemm_phase<epi::EpiResid, pg8::StaticOrder, true, true>(C.lds, g, So, E); } SEAM(4);
    PH(5) { phase_norm(C, out, xrc, p.in[I0_NFFN], 0, 3, 4, MT); } SEAM(5);
    PH(6) { pg8::Gemm g{XN, WSB(WS_W_GU0), MT, 2 * FF, D}; pg8::StaticOrder So; So.init(MT, 2 * FF, C.G, C.bid);
        epi::EpiSwiGLU E{H};
        pg8::gemm_phase<epi::EpiSwiGLU, pg8::StaticOrder, true, true>(C.lds, g, So, E); } SEAM(6);
    PH(7) { pg8::Gemm g{H, WSB(WS_W_D0), MT, D, FF}; pg8::StaticOrder So; So.init(MT, D, C.G, C.bid);
        epi::EpiResid E{out, xrc, out, xrc, MOD + 5 * D};
        pg8::gemm_phase<epi::EpiResid, pg8::StaticOrder, true, true>(C.lds, g, So, E); } SEAM(7);
    PH(8) { phase_norm(C, out, xrc, p.in[I1_NMIX], 1, 0, 1, MT); } SEAM(8);
    PH(9) { pg8::Gemm g{XN, WSB(WS_W_IN1), MT, L1_INP, D}; pg8::StaticOrder So; So.init(MT, L1_INP, C.G, C.bid);
        epi::EpiIn1 E{WSB(WS_CQ), WSB(WS_CKV), WSB(WS_NQ), WSB(WS_NK), WSB(WS_NV), (float*)(p.ws + WS_KR), (float*)(p.ws + WS_SSQ), (float*)(p.ws + WS_SSKV), p.in[I1_NQG], p.in[I1_NKG]};
        pg8::gemm_phase<epi::EpiIn1, pg8::StaticOrder, true, true>(C.lds, g, So, E); } SEAM(9);
    PH(10) {
#ifndef NO_QUP
        { pg8::Gemm g{WSB(WS_CQ), WSB(WS_W_UQ), ML, 768, 384}; pg8::StaticOrder So; So.init(ML, 768, C.G, C.bid);
          epi::EpiQUp E{WSB(WS_MQ), (const float*)(p.ws + WS_SSQ)};
          pg8::gemm_phase<epi::EpiQUp, pg8::StaticOrder, true, true>(C.lds, g, So, E); }
#endif
#ifndef NO_KVUP
        { pg8::Gemm g{WSB(WS_CKV), WSB(WS_W_UKV), MT, 1024, 256}; pg8::StaticOrder So; So.init(MT, 1024, C.G, C.bid);
          epi::EpiKvUp E{WSB(WS_MK), WSB(WS_MV), (const float*)(p.ws + WS_SSKV), (const float*)(p.ws + WS_KR), p.in[I1_MKG], T16};
          pg8::gemm_phase<epi::EpiKvUp, pg8::StaticOrder, true, true>(C.lds, g, So, E); }
#endif
    } SEAM(10);
    PH(11) { phase_attn1(C); } SEAM(11);
    PH(12) { pg8::Gemm g{MIX, WSB(WS_W_OUT1), ML, D, D}; pg8::StaticOrder So; So.init(ML, D, C.G, C.bid);
        epi::EpiResid E{out, xrc, out, xrc, MOD + 9 * 6144 + 2 * D};
        pg8::gemm_phase<epi::EpiResid, pg8::StaticOrder, true, true>(C.lds, g, So, E); } SEAM(12);
    PH(13) { phase_norm(C, out, xrc, p.in[I1_NFFN], 1, 3, 4, ML); } SEAM(13);
    PH(14) { pg8::Gemm g{XN, WSB(WS_W_GU1), ML, 2 * FF, D}; pg8::StaticOrder So; So.init(ML, 2 * FF, C.G, C.bid);
        epi::EpiSwiGLU E{H};
        pg8::gemm_phase<epi::EpiSwiGLU, pg8::StaticOrder, true, true>(C.lds, g, So, E); } SEAM(14);
    PH(15) { pg8::Gemm g{H, WSB(WS_W_D1), ML, D, FF}; pg8::StaticOrder So; So.init(ML, D, C.G, C.bid);
        epi::EpiResid E{out, xrc, out, xrc, MOD + 9 * 6144 + 5 * D};
        pg8::gemm_phase<epi::EpiResid, pg8::StaticOrder, true, true>(C.lds, g, So, E); }
    if (ph_hi - ph_lo > 1 && C.bid == 0 && C.tid == 0) { if (xb_ld(&barw[XB_TMO]) != 0u) out[0] = __builtin_nanf(""); }
#undef PH
#undef SEAM
#undef WSB
}
}
#ifndef MK_DEBUG
#define MK_DEBUG 0
#endif
static int g_grid = 0;
static bool mega_setup() {
    if (g_grid) return g_grid > 0;
    int dev = 0, cus = 0, per_cu = 0;
    if (hipGetDevice(&dev) != hipSuccess || hipDeviceGetAttribute(&cus, hipDeviceAttributeMultiprocessorCount, dev) != hipSuccess) { g_grid = -1; return false; }
    if (hipFuncSetAttribute((const void*)mk::mega, hipFuncAttributeMaxDynamicSharedMemorySize, mk::LDS_BYTES) != hipSuccess) { fprintf(stderr, "kernel_launch: hipFuncSetAttribute failed\n"); g_grid = -1; return false; }
    if (hipOccupancyMaxActiveBlocksPerMultiprocessor(&per_cu, (const void*)mk::mega, mk::NTHR, mk::LDS_BYTES) != hipSuccess || per_cu < 1) { fprintf(stderr, "kernel_launch: occupancy query says %d\n", per_cu); g_grid = -1; return false; }
    g_grid = cus;
    fprintf(stderr, "kernel_launch: %d CUs, occupancy %d blocks/CU, grid %d\n", cus, per_cu, g_grid);
    return true;
}
static void launch_phases(const Params& p, int lo, int hi, hipStream_t st) {
    Params pp = p; int l = lo, h = hi;
    void* args[] = {&pp, &l, &h};
    hipError_t e;
    if (hi - lo > 1) e = hipLaunchCooperativeKernel((const void*)mk::mega, dim3(g_grid), dim3(mk::NTHR), args, mk::LDS_BYTES, st);
    else e = hipLaunchKernel((const void*)mk::mega, dim3(g_grid), dim3(mk::NTHR), args, mk::LDS_BYTES, st);
    if (e != hipSuccess) fprintf(stderr, "kernel_launch: launch [%d,%d) failed: %s\n", lo, hi, hipGetErrorString(e));
}
#if MK_DEBUG
static void launch_debug(const Params& p, hipStream_t st) {
    using namespace nv;
    unsigned* err = (unsigned*)(p.ws + WS_CTL) + 64;
    float* out = p.out; float* xrc = (float*)(p.ws + WS_XRC);
    const float* x = p.in[I_X]; const float* cx = p.in[I_CTX];
    const size_t att_sm = 4 * (SK + 128) * sizeof(float);
    const int SR = 4096;
    float* snapL = (float*)(p.ws + WS_SNAP); float* snapC = snapL + (size_t)SR * D;
    float* snapB = (float*)(p.ws + WS_BIG);
    hipMemsetAsync(p.ws + WS_CTL, 0, WS_SSQ, st);
    launch_phases(p, 0, 1, st);  k_adaln<true><<<dim3(6144 / 256, 9, 2), 256, 0, st>>>(p, err + 0);
    launch_phases(p, 1, 2, st);  k_norm<true><<<MT / 4, 256, 0, st>>>(p, x, cx, I0_NMIX, 0, 0, 1, MT, err + 1);
    launch_phases(p, 2, 3, st);  k_in0<true><<<MT / R, 256, (R * D + R * L0_IN) * 4, st>>>(p, err + 2);
    launch_phases(p, 3, 4, st);  k_attn<true, 0><<<dim3(ML / 4, 12), 256, att_sm, st>>>(p, err + 3);
                                 k_attn<true, 1><<<dim3(MC / 4, 12), 256, att_sm, st>>>(p, err + 16);
                                 k_pool0<true><<<MT, 256, 0, st>>>(p, err + 17);
    launch_phases(p, 4, 5, st);  k_out<true, 0><<<MT / R, 256, (R * D + R * 256) * 4, st>>>(p, x, cx, out, xrc, 0, err + 4);
    launch_phases(p, 5, 6, st);  k_norm<true><<<MT / 4, 256, 0, st>>>(p, out, xrc, I0_NFFN, 0, 3, 4, MT, err + 5);
    launch_phases(p, 6, 7, st);  k_ffn_gu<true, 0><<<MT / R, 256, R * D * 4, st>>>(p, err + 6);
    hipMemcpyAsync(snapL, out, (size_t)SR * D * 4, hipMemcpyDeviceToDevice, st); hipMemcpyAsync(snapC, xrc, (size_t)MC * D * 4, hipMemcpyDeviceToDevice, st);
    launch_phases(p, 7, 8, st);  k_ffn_d<true, 0><<<SR / R, 256, R * FF * 4, st>>>(p, snapL, snapC, out, xrc, 0, err + 7);
                                 k_ffn_d<true, 0><<<MC / R, 256, R * FF * 4, st>>>(p, snapL, snapC, out, xrc, ML, err + 7);
    launch_phases(p, 8, 9, st);  k_norm<true><<<MT / 4, 256, 0, st>>>(p, out, xrc, I1_NMIX, 1, 0, 1, MT, err + 8);
    launch_phases(p, 9, 10, st); k_in1<true><<<MT / R, 256, (R * D + R * L1_IN) * 4, st>>>(p, err + 9);
    launch_phases(p, 10, 11, st); k_mlaq<true><<<ML / R, 256, R * 384 * 4, st>>>(p, err + 10);
                                 k_mlakv<true><<<MT / R, 256, (R * 256 + R * 1024) * 4, st>>>(p, err + 19);
    launch_phases(p, 11, 12, st); k_attn<true, 2><<<dim3(ML / 4, 8), 256, att_sm, st>>>(p, err + 11);
                                 k_attn<true, 3><<<dim3(ML / 4, 8), 256, att_sm, st>>>(p, err + 18);
    hipMemcpyAsync(snapB, out, (size_t)SR * D * 4, hipMemcpyDeviceToDevice, st);
    launch_phases(p, 12, 13, st); k_out<true, 1><<<SR / R, 256, (R * D + R * 256) * 4, st>>>(p, snapB, snapC, out, xrc, 0, err + 12);
    launch_phases(p, 13, 14, st); k_norm<true><<<ML / 4, 256, 0, st>>>(p, out, xrc, I1_NFFN, 1, 3, 4, ML, err + 13);
    launch_phases(p, 14, 15, st); k_ffn_gu<true, 1><<<ML / R, 256, R * D * 4, st>>>(p, err + 14);
    hipMemcpyAsync(snapL, out, (size_t)SR * D * 4, hipMemcpyDeviceToDevice, st);
    launch_phases(p, 15, 16, st); k_ffn_d<true, 1><<<SR / R, 256, R * FF * 4, st>>>(p, snapL, snapC, out, xrc, 0, err + 15);
    k_report<<<1, 1, 0, st>>>(p, 20, 0.15f);
}
#endif
extern "C" void kernel_launch(void* const* d_in, const int* in_sizes, int n_in, void* d_out, int out_size, void* d_ws, size_t ws_size, hipStream_t stream) {
    if (n_in != N_IN || out_size != ML * D || ws_size < WS_END) { fprintf(stderr, "kernel_launch: unexpected shapes n_in=%d out=%d ws=%zu\n", n_in, out_size, ws_size); return; }
    if (!mega_setup()) return;
    Params p{};
    for (int i = 0; i < N_IN; ++i) p.in[i] = (const float*)d_in[i];
    p.out = (float*)d_out; p.ws = (unsigned char*)d_ws;
#if MK_DEBUG
    launch_debug(p, stream);
#else
    if (hipMemsetAsync((char*)d_ws + WS_BARRIER, 0, WS_SSQ - WS_BARRIER, stream) != hipSuccess) { fprintf(stderr, "kernel_launch: memset failed\n"); return; }
    launch_phases(p, 0, mk::NPHASE, stream);
#endif
}
```

```cpp
#include <hip/hip_runtime.h>
#include <hip/hip_cooperative_groups.h>
#include <cstdio>
#include <cstdint>
namespace cg = cooperative_groups;

typedef unsigned short bf16_t;
constexpr int D = 1024, NB = 8, S = 2048, CTX = 256, SK = S + CTX, ML = NB * S, MC = NB * CTX, MT = ML + MC, FF = 2816;
constexpr int GW = 64;
constexpr int L0_IN = 1536, L1_IN = 2208, L1_INP = 2304;
constexpr float EPS = 1e-6f;
constexpr float LOG2E = 1.4426950408889634f;
constexpr float C2_64 = 0.125f * LOG2E;
constexpr float C2_96 = 0.10206207261596577f * LOG2E;

enum { I_X = 0, I_C, I_CTX, I_CCTX,
       I0_ADAW, I0_ADAB, I0_NMIX, I0_NFFN, I0_WIN, I0_POOLW, I0_POOLS, I0_QG, I0_KG, I0_WOUT, I0_WG, I0_WU, I0_WD,
       I1_ADAW, I1_ADAB, I1_NMIX, I1_NFFN, I1_WIN, I1_QAG, I1_KVAG, I1_WUQ, I1_WUKV, I1_MQG, I1_MKG, I1_NQG, I1_NKG, I1_RPB, I1_WOUT, I1_WG, I1_WU, I1_WD, N_IN };

constexpr size_t MiB = 1u << 20;
constexpr size_t WS_CTL = 0;
constexpr size_t WS_BARRIER = 16 * 1024;
constexpr size_t WS_MOD = 64 * 1024;
constexpr size_t WS_SSQ = 512 * 1024;
constexpr size_t WS_SSKV = 600 * 1024;
constexpr size_t WS_ROPE32 = 700 * 1024;
constexpr size_t WS_ROPE16 = 712 * 1024;
constexpr size_t WS_W_IN0 = 1 * MiB;
constexpr size_t WS_W_OUT0 = 4 * MiB;
constexpr size_t WS_W_GU0 = 6 * MiB;
constexpr size_t WS_W_D0 = 17 * MiB;
constexpr size_t WS_W_IN1 = 23 * MiB;
constexpr size_t WS_W_UQ = 28 * MiB;
constexpr size_t WS_W_UKV = 29 * MiB;
constexpr size_t WS_W_OUT1 = 30 * MiB;
constexpr size_t WS_W_GU1 = 32 * MiB;
constexpr size_t WS_W_D1 = 43 * MiB;
constexpr size_t WS_XRC = 49 * MiB;
constexpr size_t WS_XN = 57 * MiB;
constexpr size_t WS_MIX = WS_XN;
constexpr size_t WS_BIG = 96 * MiB;
constexpr size_t WS_H = WS_BIG;
constexpr size_t WS_A0 = WS_BIG;
constexpr size_t WS_Q0 = WS_BIG + 9 * MiB;
constexpr size_t WS_K0 = WS_BIG + 36 * MiB;
constexpr size_t WS_V0 = WS_BIG + 45 * MiB;
constexpr size_t WS_CQ = WS_BIG;
constexpr size_t WS_CKV = WS_BIG + 14 * MiB;
constexpr size_t WS_NQ = WS_BIG + 23 * MiB;
constexpr size_t WS_NK = WS_BIG + 41 * MiB;
constexpr size_t WS_NV = WS_BIG + 59 * MiB;
constexpr size_t WS_MQ = WS_BIG + 77 * MiB;
constexpr size_t WS_MK = WS_BIG + 101 * MiB;
constexpr size_t WS_MV = WS_BIG + 128 * MiB;
constexpr size_t WS_KR = WS_BIG + 146 * MiB;
constexpr size_t WS_SLAB4 = WS_BIG;
constexpr size_t WS_SLAB7 = WS_BIG + 100 * MiB;
constexpr size_t WS_SNAP = WS_BIG + 100 * MiB;
constexpr size_t WS_END = 256 * MiB;
static_assert(WS_KR + (size_t)MT * 32 * 4 <= WS_END, "ws map");
static_assert(WS_W_D1 + (size_t)D * FF * 2 <= WS_XRC, "ws map");
static_assert(WS_XN + (size_t)MT * D * 2 <= WS_BIG, "ws map");

__device__ __forceinline__ float bf2f(bf16_t u) { return __uint_as_float((unsigned)u << 16); }
__device__ __forceinline__ bf16_t f2bf(float f) { unsigned u = __float_as_uint(f); return (bf16_t)((u + 0x7fffu + ((u >> 16) & 1u)) >> 16); }
__device__ __forceinline__ int kvrow_of(int m) { return m < ML ? (m / S) * SK + CTX + (m % S) : ((m - ML) / CTX) * SK + ((m - ML) % CTX); }
__device__ __forceinline__ int modidx_of(int m) { return m < ML ? m / S : 8; }
__device__ __forceinline__ float wave_sum(float v) {
#pragma unroll
    for (int o = 1; o < 64; o <<= 1) v += __shfl_xor(v, o);
    return v;
}
__device__ __forceinline__ float wave_max(float v) {
#pragma unroll
    for (int o = 1; o < 64; o <<= 1) v = fmaxf(v, __shfl_xor(v, o));
    return v;
}

struct Params {
    const float* in[N_IN];
    float* out;
    unsigned char* ws;
};
namespace pg8 {
#define PG8_LAS __attribute__((address_space(3)))
typedef unsigned short bf16_t;
typedef short bf16x8 __attribute__((ext_vector_type(8)));
typedef float f32x4 __attribute__((ext_vector_type(4)));
typedef unsigned u32x4 __attribute__((ext_vector_type(4)));
constexpr int BM = 256, BK = 64, HALF = 128, HTB = HALF * BK * 2  , STAGE_BYTES = 8 * HTB, NXCD = 8, WGM = 8;

__host__ __device__ __forceinline__ int lds_byte(int r, int c) { const int st = (r >> 4) * 2 + (c >> 5), rr = r & 15, cc = c & 31, ob = rr * 64 + cc * 2; return st * 1024 + (ob ^ (((ob >> 9) & 1) << 5)); }
__host__ __device__ __forceinline__ void stage_rc(int b, int& R, int& C) { const int st = b / 1024, sb = b % 1024, swz = sb ^ (((sb >> 9) & 1) << 5); R = (st >> 1) * 16 + swz / 64; C = (st & 1) * 32 + (swz % 64) / 2; }
__host__ __device__ __forceinline__ int perm32(int rho) { const int n = rho >> 4, i = rho & 15; return 8 * (i >> 2) + 4 * n + (i & 3); }

struct Unit { int pm, pn, ks; };
struct Gemm { const bf16_t* A; const bf16_t* Bt; int M, N, K, ld; };

struct StaticOrder {
    int nM, nN, nwg, G, c;
    __host__ __device__ void init(int M, int N, int G_, int c_) { nM = M / BM; nN = N / BM; nwg = nM * nN; G = G_; c = c_; }
    __host__ __device__ bool next(int i, Unit& u) const {
        const long L = (long)i * G + c; if (L >= nwg) return false;
        int wgid = (int)L; { const int q = nwg / NXCD, r = nwg % NXCD, xcd = wgid % NXCD, off = wgid / NXCD; wgid = (xcd < r ? xcd * (q + 1) : r * (q + 1) + (xcd - r) * q) + off; }
        const int nig = WGM * nN, gid = wgid / nig, fm = gid * WGM, gsz = (nM - fm) < WGM ? (nM - fm) : WGM;
        u.pm = fm + ((wgid % nig) % gsz); u.pn = (wgid % nig) / gsz; u.ks = 0; return true;
    }
    __device__ __forceinline__ void a_ready(const Unit&) const {}
    __device__ __forceinline__ void done(const Unit&) const {}
};

__device__ __forceinline__ unsigned cvt_pk_bf16(float lo, float hi) { unsigned r; asm volatile("v_cvt_pk_bf16_f32 %0, %1, %2" : "=v"(r) : "v"(lo), "v"(hi)); return r; }
typedef float f32x2 __attribute__((ext_vector_type(2)));
struct CtxSplitOrder {
    int G, c, split;
    __host__ __device__ void init(int split_, int G_, int c_) { split = split_; G = G_; c = c_; }
    __host__ __device__ bool next(int i, Unit& u) const {
        const int L = i * G + c; if (L >= 32 * split) return false;
        u.ks = L % split; const int t = L / split; u.pn = t & 3; u.pm = 64 + (t >> 2); return true;
    }
    __device__ __forceinline__ void a_ready(const Unit&) const {}
    __device__ __forceinline__ void done(const Unit&) const {}
};
template <class Epi, class Sched, bool ALIGN_EPI = false, bool SP2 = false>
__device__ __forceinline__ void gemm_phase(PG8_LAS unsigned char* lds, const Gemm g, const Sched& S, const Epi& E) {
    int tid_ = threadIdx.x; asm volatile("" : "+v"(tid_));
    const int tid = tid_, wid = __builtin_amdgcn_readfirstlane(tid >> 6), lane = tid & 63, wr = wid >> 2, wc = wid & 3, fr = lane & 15, fq = lane >> 4;
    int K_ = g.K; asm volatile("" : "+s"(K_));
    const int K = K_, nt = K / BK; int LD_ = g.ld; asm volatile("" : "+s"(LD_)); const int LD = LD_;
    unsigned voffA[2], voffB[2];
#pragma unroll
    for (int i = 0; i < 2; ++i) { int R, C; stage_rc(tid * 16 + i * 8192, R, C); const int Rb = Epi::PERM ? ((R & ~31) + perm32(R & 31)) : R;
        voffA[i] = (unsigned)(R * LD + C) * 2u; voffB[i] = (unsigned)(Rb * LD + C) * 2u; }
    const size_t kstep = (size_t)(BK * 2);
    const size_t hstep = (size_t)HALF * LD * 2;
    const size_t tstep = 2 * hstep;
    const unsigned ldsw = (unsigned)wid * 1024u;
    const int aoff = lds_byte(wr * 64 + fr, fq * 8), boff = lds_byte(wc * 32 + fr, fq * 8);
#define PG8_SA(b, h) (((b) * 2 + (h)) * HTB)
#define PG8_SB(b, h) ((4 + (b) * 2 + (h)) * HTB)
#define PG8_STAGE(bufoff, gbase, voff) do { _Pragma("unroll") for (int _i = 0; _i < 2; ++_i) \
        __builtin_amdgcn_global_load_lds((const unsigned*)((const char*)(gbase) + (voff)[_i]), (PG8_LAS unsigned*)(lds + (bufoff) + ldsw + _i * 8192), 16, 0, 0); } while (0)
#define PG8_LDA(dst, b, h) do { _Pragma("unroll") for (int m = 0; m < 4; ++m) _Pragma("unroll") for (int k = 0; k < 2; ++k) dst[m][k] = *(const PG8_LAS bf16x8*)(lds + PG8_SA(b, h) + aoff + m * 2048 + k * 1024); } while (0)
#define PG8_LDB(dst, b, h) do { _Pragma("unroll") for (int n = 0; n < 2; ++n) _Pragma("unroll") for (int k = 0; k < 2; ++k) dst[n][k] = *(const PG8_LAS bf16x8*)(lds + PG8_SB(b, h) + boff + n * 2048 + k * 1024); } while (0)
#define PG8_MMA(ai, bj, At, Bt) do { __builtin_amdgcn_s_setprio(1); _Pragma("unroll") for (int m = 0; m < 4; ++m) _Pragma("unroll") for (int n = 0; n < 2; ++n) _Pragma("unroll") for (int k = 0; k < 2; ++k) \
        acc[ai][bj][m][n] = __builtin_amdgcn_mfma_f32_16x16x32_bf16(Bt[n][k], At[m][k], acc[ai][bj][m][n], 0, 0, 0); __builtin_amdgcn_s_setprio(0); } while (0)
#define PG8_WAIT_V(n) asm volatile("s_waitcnt vmcnt(" #n ")" ::: "memory")
#define PG8_WAIT_L(n) asm volatile("s_waitcnt lgkmcnt(" #n ")" ::: "memory")
#define PG8_BAR __builtin_amdgcn_s_barrier()
#define PG8_SCHED __builtin_amdgcn_sched_barrier(0)
    Unit cur, nxt; int ui = 0;
    if (!S.next(0, cur)) return;
    f32x4 acc[2][2][4][2];
#pragma unroll
    for (int a = 0; a < 2; ++a)
#pragma unroll
        for (int b = 0; b < 2; ++b)
#pragma unroll
            for (int m = 0; m < 4; ++m)
#pragma unroll
                for (int n = 0; n < 2; ++n) acc[a][b][m][n] = (f32x4){0.f, 0.f, 0.f, 0.f};
    bf16x8 At[4][2], B0[2][2], B1[2][2];
    const char* cA = (const char*)g.A + (size_t)cur.pm * tstep + (size_t)cur.ks * K * 2; const char* cB = (const char*)g.Bt + (size_t)cur.pn * tstep + (size_t)cur.ks * K * 2;
    S.a_ready(cur);
    if constexpr (SP2) {
        PG8_STAGE(PG8_SB(0, 0), cB, voffB); PG8_STAGE(PG8_SB(0, 1), cB + hstep, voffB); PG8_STAGE(PG8_SA(0, 0), cA, voffA); PG8_STAGE(PG8_SA(0, 1), cA + hstep, voffA);
        if (wr == 1) PG8_BAR;
        PG8_WAIT_V(2); PG8_BAR;
        PG8_STAGE(PG8_SB(1, 0), cB + kstep, voffB); PG8_STAGE(PG8_SA(1, 0), cA + kstep, voffA); PG8_STAGE(PG8_SB(1, 1), cB + hstep + kstep, voffB);
        PG8_WAIT_V(6); PG8_BAR;
    } else {
        PG8_STAGE(PG8_SB(0, 0), cB, voffB); PG8_STAGE(PG8_SA(0, 0), cA, voffA); PG8_STAGE(PG8_SB(0, 1), cB + hstep, voffB); PG8_STAGE(PG8_SA(0, 1), cA + hstep, voffA);
        if (wr == 1) PG8_BAR;
        PG8_WAIT_V(4); PG8_BAR;
        PG8_STAGE(PG8_SB(1, 0), cB + kstep, voffB); PG8_STAGE(PG8_SA(1, 0), cA + kstep, voffA); PG8_STAGE(PG8_SB(1, 1), cB + hstep + kstep, voffB);
        PG8_WAIT_V(6); PG8_BAR;
    }
    for (;;) {
        const bool has_next = S.next(ui + 1, nxt);
        const char* nA = has_next ? (const char*)g.A + (size_t)nxt.pm * tstep + (size_t)nxt.ks * K * 2 : cA; const char* nB = has_next ? (const char*)g.Bt + (size_t)nxt.pn * tstep + (size_t)nxt.ks * K * 2 : cB;
        for (int t = 0; t < nt; t += 2) {
            const bool last = (t == nt - 2);
            const char* a1 = cA + (size_t)(t + 1) * kstep;
            const char* a2 = last ? nA : cA + (size_t)(t + 2) * kstep; const char* b2 = last ? nB : cB + (size_t)(t + 2) * kstep;
            const char* a3 = a2 + kstep; const char* b3 = b2 + kstep;
            if (last && has_next) S.a_ready(nxt);
            if constexpr (SP2) {
            PG8_LDB(B0, 0, 0); PG8_LDB(B1, 0, 1); PG8_SCHED; PG8_LDA(At, 0, 0); PG8_STAGE(PG8_SA(1, 1), a1 + hstep, voffA);
            PG8_WAIT_V(8); PG8_WAIT_L(0); PG8_BAR; PG8_MMA(0, 0, At, B0); PG8_MMA(0, 1, At, B1); PG8_BAR; PG8_SCHED;
            PG8_LDA(At, 0, 1); PG8_STAGE(PG8_SB(0, 0), b2, voffB); PG8_STAGE(PG8_SB(0, 1), b2 + hstep, voffB); PG8_STAGE(PG8_SA(0, 0), a2, voffA);
            PG8_WAIT_V(8); PG8_WAIT_L(0); PG8_BAR; PG8_MMA(1, 0, At, B0); PG8_MMA(1, 1, At, B1); PG8_BAR; PG8_SCHED;
            PG8_LDB(B0, 1, 0); PG8_LDB(B1, 1, 1); PG8_SCHED; PG8_LDA(At, 1, 0); PG8_STAGE(PG8_SA(0, 1), a2 + hstep, voffA);
            PG8_WAIT_V(8); PG8_WAIT_L(0); PG8_BAR; PG8_MMA(0, 0, At, B0); PG8_MMA(0, 1, At, B1); PG8_BAR; PG8_SCHED;
            PG8_LDA(At, 1, 1); PG8_STAGE(PG8_SB(1, 0), b3, voffB); PG8_STAGE(PG8_SB(1, 1), b3 + hstep, voffB); PG8_STAGE(PG8_SA(1, 0), a3, voffA);
            PG8_WAIT_V(8); PG8_WAIT_L(0); PG8_BAR; PG8_MMA(1, 0, At, B0); PG8_MMA(1, 1, At, B1); PG8_BAR; PG8_SCHED;
            } else {
            PG8_LDB(B0, 0, 0); PG8_SCHED; PG8_LDA(At, 0, 0); PG8_STAGE(PG8_SA(1, 1), a1 + hstep, voffA);
            PG8_WAIT_L(8); PG8_BAR; PG8_WAIT_L(0); PG8_MMA(0, 0, At, B0); PG8_BAR; PG8_SCHED;
            PG8_LDB(B1, 0, 1); PG8_STAGE(PG8_SB(0, 0), b2, voffB);
            PG8_BAR; PG8_WAIT_L(0); PG8_MMA(0, 1, At, B1); PG8_BAR;
            PG8_LDA(At, 0, 1); PG8_STAGE(PG8_SA(0, 0), a2, voffA);
            PG8_BAR; PG8_WAIT_L(0); PG8_MMA(1, 0, At, B0); PG8_BAR; PG8_SCHED;
            PG8_STAGE(PG8_SB(0, 1), b2 + hstep, voffB);
            PG8_WAIT_V(6); PG8_BAR; PG8_MMA(1, 1, At, B1); PG8_BAR;
            PG8_LDB(B0, 1, 0); PG8_SCHED; PG8_LDA(At, 1, 0); PG8_STAGE(PG8_SA(0, 1), a2 + hstep, voffA);
            PG8_WAIT_L(8); PG8_BAR; PG8_WAIT_L(0); PG8_MMA(0, 0, At, B0); PG8_BAR; PG8_SCHED;
            PG8_LDB(B1, 1, 1); PG8_STAGE(PG8_SB(1, 0), b3, voffB);
            PG8_BAR; PG8_WAIT_L(0); PG8_MMA(0, 1, At, B1); PG8_BAR;
            PG8_LDA(At, 1, 1); PG8_STAGE(PG8_SA(1, 0), a3, voffA);
            PG8_BAR; PG8_WAIT_L(0); PG8_MMA(1, 0, At, B0); PG8_BAR; PG8_SCHED;
            PG8_STAGE(PG8_SB(1, 1), b3 + hstep, voffB);
            PG8_WAIT_V(6); PG8_BAR; PG8_MMA(1, 1, At, B1); PG8_BAR;
            }
        }
        if constexpr (ALIGN_EPI) { if (wr == 0) PG8_BAR; }
        if constexpr (!Epi::AFTER_DRAIN) { E(acc, cur, wr, wc, fr, fq); S.done(cur); }
        if (!has_next) break;
#pragma unroll
        for (int a = 0; a < 2; ++a)
#pragma unroll
            for (int b = 0; b < 2; ++b)
#pragma unroll
                for (int m = 0; m < 4; ++m)
#pragma unroll
                    for (int n = 0; n < 2; ++n) acc[a][b][m][n] = (f32x4){0.f, 0.f, 0.f, 0.f};
        cur = nxt; cA = nA; cB = nB; ++ui;
        if constexpr (ALIGN_EPI) { if (wr == 1) PG8_BAR; }
    }
    PG8_WAIT_V(0);
    if constexpr (!ALIGN_EPI) { if (wr == 0) PG8_BAR; }
    PG8_BAR;
    if constexpr (Epi::AFTER_DRAIN) { E.fused(acc, cur, wr, wc, fr, fq, lds, wid, lane); S.done(cur); }
#undef PG8_SA
#undef PG8_SB
#undef PG8_STAGE
#undef PG8_LDA
#undef PG8_LDB
#undef PG8_MMA
#undef PG8_WAIT_V
#undef PG8_WAIT_L
#undef PG8_BAR
#undef PG8_SCHED
}
}
namespace epi {
using pg8::f32x4; using pg8::Unit;
typedef unsigned u32x2 __attribute__((ext_vector_type(2)));
typedef unsigned u32x4 __attribute__((ext_vector_type(4)));
typedef float f32x2 __attribute__((ext_vector_type(2)));
typedef __bf16 bf16x2_t __attribute__((ext_vector_type(2)));
__device__ __forceinline__ unsigned pk(float lo, float hi) { f32x2 v = {lo, hi}; bf16x2_t b = __builtin_convertvector(v, bf16x2_t); return __builtin_bit_cast(unsigned, b); }
__device__ __forceinline__ u32x2 pk4(f32x4 v) { u32x2 w; w.x = pk(v[0], v[1]); w.y = pk(v[2], v[3]); return w; }
__device__ __forceinline__ float sum4sq(f32x4 v) { return (v[0] * v[0] + v[1] * v[1]) + (v[2] * v[2] + v[3] * v[3]); }
__device__ __forceinline__ float quad_sum(float s) { s += __shfl_xor(s, 16); s += __shfl_xor(s, 32); return s; }

__device__ __forceinline__ int kvbase_of(int pm) { return pm < 64 ? (pm >> 3) * SK + CTX + (pm & 7) * 256 : (pm - 64) * SK; }
__device__ __forceinline__ int modidx_pm(int pm) { return pm < 64 ? (pm >> 3) : 8; }

__device__ __forceinline__ void head_finish(f32x4 (&v)[2][2], const float* gain, bool rope, const float* T32, int grow, int gcol, float scale, int fq) {
    float ss = (sum4sq(v[0][0]) + sum4sq(v[0][1])) + (sum4sq(v[1][0]) + sum4sq(v[1][1]));
    ss = quad_sum(ss);
    const float rn = rsqrtf(ss * (1.f / 64.f) + EPS);
#pragma unroll
    for (int bj = 0; bj < 2; ++bj)
#pragma unroll
        for (int n = 0; n < 2; ++n) { const f32x4 g = *(const f32x4*)(gain + 32 * bj + 16 * n + 4 * fq); v[bj][n] = (v[bj][n] * rn) * g; }
    if (rope) {
#pragma unroll
        for (int bj = 0; bj < 2; ++bj) { const int pos = bj ? gcol : grow;
            const f32x4 cs = *(const f32x4*)(T32 + pos * 16 + 4 * fq), sn = *(const f32x4*)(T32 + 1024 + pos * 16 + 4 * fq);
            const f32x4 x1 = v[bj][0], x2 = v[bj][1];
            v[bj][0] = x1 * cs - x2 * sn; v[bj][1] = x1 * sn + x2 * cs; }
    }
#pragma unroll
    for (int bj = 0; bj < 2; ++bj)
#pragma unroll
        for (int n = 0; n < 2; ++n) v[bj][n] = v[bj][n] * scale;
}

struct EpiIn0 {
    static constexpr bool PERM = false, AFTER_DRAIN = false;
    bf16_t *A0, *Q0, *K0, *V0; const float *qg, *kg, *T32;
    __device__ __forceinline__ void operator()(const f32x4 (&acc)[2][2][4][2], const Unit& u, int wr, int wc, int fr_in, int fq_in) const {
        int fr = fr_in, fq = fq_in; asm volatile("" : "+v"(fr), "+v"(fq));
        const int pn = u.pn, pm = u.pm; const bool lat = pm < 64; const int kvb = kvbase_of(pm);
#pragma unroll
        for (int ai = 0; ai < 2; ++ai)
#pragma unroll
            for (int m = 0; m < 4; ++m) {
                const int rl = 128 * ai + 64 * wr + 16 * m + fr; const size_t r = (size_t)pm * 256 + rl;
                if (pn == 0 || pn == 5) {
                    bf16_t* dst = pn == 0 ? A0 + r * 256 : V0 + (size_t)(kvb + rl) * 256;
#pragma unroll
                    for (int bj = 0; bj < 2; ++bj)
#pragma unroll
                        for (int n = 0; n < 2; ++n) *(u32x2*)(dst + 64 * wc + 32 * bj + 16 * n + 4 * fq) = pk4(acc[ai][bj][m][n]);
                } else {
                    f32x4 v[2][2] = {{acc[ai][0][m][0], acc[ai][0][m][1]}, {acc[ai][1][m][0], acc[ai][1][m][1]}};
                    const int grow = (pm & 7) * 4 + 2 * ai + wr, gcol = 16 * m + fr;
                    bf16_t* dst;
                    if (pn < 4) { head_finish(v, qg, lat, T32, grow, gcol, C2_64, fq); dst = Q0 + r * 768 + ((pn - 1) * 4 + wc) * 64; }
                    else { head_finish(v, kg, lat, T32, grow, gcol, 1.0f, fq); dst = K0 + (size_t)(kvb + rl) * 256 + wc * 64; }
#pragma unroll
                    for (int bj = 0; bj < 2; ++bj)
#pragma unroll
                        for (int n = 0; n < 2; ++n) *(u32x2*)(dst + 32 * bj + 16 * n + 4 * fq) = pk4(v[bj][n]);
                }
            }
    }
};

struct EpiResid {
    static constexpr bool PERM = false, AFTER_DRAIN = false;
    const float *base_l, *base_c; float *out_l, *out_c; const float* mod;
    __device__ __forceinline__ void operator()(const f32x4 (&acc)[2][2][4][2], const Unit& u, int wr, int wc, int fr_in, int fq_in) const {
        int fr = fr_in, fq = fq_in; asm volatile("" : "+v"(fr), "+v"(fq));
        const int pm = u.pm; const bool lat = pm < 64;
        const float* bp = lat ? base_l + (size_t)pm * 256 * D : base_c + (size_t)(pm - 64) * 256 * D;
        float* op = lat ? out_l + (size_t)pm * 256 * D : out_c + (size_t)(pm - 64) * 256 * D;
        const float* gp = mod + (size_t)modidx_pm(pm) * 6144 + u.pn * 256 + 32 * wc + 4 * fq;
        f32x4 g[2][2];
#pragma unroll
        for (int bj = 0; bj < 2; ++bj)
#pragma unroll
            for (int n = 0; n < 2; ++n) g[bj][n] = *(const f32x4*)(gp + 128 * bj + 16 * n);
#pragma unroll
        for (int ai = 0; ai < 2; ++ai)
#pragma unroll
            for (int m = 0; m < 4; ++m) { const size_t off = (size_t)(128 * ai + 64 * wr + 16 * m + fr) * D + u.pn * 256 + 32 * wc + 4 * fq;
#pragma unroll
                for (int bj = 0; bj < 2; ++bj)
#pragma unroll
                    for (int n = 0; n < 2; ++n) { const f32x4 b = *(const f32x4*)(bp + off + 128 * bj + 16 * n); *(f32x4*)(op + off + 128 * bj + 16 * n) = b + g[bj][n] * acc[ai][bj][m][n]; } }
    }
};

struct EpiResidSplit {
    static constexpr bool PERM = false, AFTER_DRAIN = false;
    const float* base_c; float* out_c; float* slab; const float* mod;
    __device__ __forceinline__ void operator()(const f32x4 (&acc)[2][2][4][2], const Unit& u, int wr, int wc, int fr_in, int fq_in) const {
        int fr = fr_in, fq = fq_in; asm volatile("" : "+v"(fr), "+v"(fq));
        const int pm = u.pm - 64;
        const float* bp = base_c + (size_t)pm * 256 * D;
        float* op = u.ks == 0 ? out_c + (size_t)pm * 256 * D : slab + (size_t)(u.ks - 1) * MC * D + (size_t)pm * 256 * D;
        const float* gp = mod + (size_t)8 * 6144 + u.pn * 256 + 32 * wc + 4 * fq;
        f32x4 g[2][2];
#pragma unroll
        for (int bj = 0; bj < 2; ++bj)
#pragma unroll
            for (int n = 0; n < 2; ++n) g[bj][n] = *(const f32x4*)(gp + 128 * bj + 16 * n);
#pragma unroll
        for (int ai = 0; ai < 2; ++ai)
#pragma unroll
            for (int m = 0; m < 4; ++m) { const size_t off = (size_t)(128 * ai + 64 * wr + 16 * m + fr) * D + u.pn * 256 + 32 * wc + 4 * fq;
#pragma unroll
                for (int bj = 0; bj < 2; ++bj)
#pragma unroll
                    for (int n = 0; n < 2; ++n) { f32x4 v = g[bj][n] * acc[ai][bj][m][n]; if (u.ks == 0) v += *(const f32x4*)(bp + off + 128 * bj + 16 * n); *(f32x4*)(op + off + 128 * bj + 16 * n) = v; } }
    }
};

struct EpiSwiGLU {
    static constexpr bool PERM = true, AFTER_DRAIN = false;
    bf16_t* H;
    __device__ __forceinline__ void operator()(const f32x4 (&acc)[2][2][4][2], const Unit& u, int wr, int wc, int fr_in, int fq_in) const {
        int fr = fr_in, fq = fq_in; asm volatile("" : "+v"(fr), "+v"(fq));
#pragma unroll
        for (int ai = 0; ai < 2; ++ai)
#pragma unroll
            for (int m = 0; m < 4; ++m) { const size_t r = (size_t)u.pm * 256 + 128 * ai + 64 * wr + 16 * m + fr;
                f32x4 h[2];
#pragma unroll
                for (int n = 0; n < 2; ++n) { const f32x4 g = acc[ai][0][m][n], up = acc[ai][1][m][n];
#pragma unroll
                    for (int e = 0; e < 4; ++e) h[n][e] = g[e] * __builtin_amdgcn_rcpf(1.f + __builtin_amdgcn_exp2f(-g[e] * LOG2E)) * up[e]; }
                u32x4 w; w.x = pk(h[0][0], h[0][1]); w.y = pk(h[0][2], h[0][3]); w.z = pk(h[1][0], h[1][1]); w.w = pk(h[1][2], h[1][3]);
                *(u32x4*)(H + r * FF + u.pn * 128 + 32 * wc + 8 * fq) = w; }
    }
};

struct EpiIn1 {
    static constexpr bool PERM = false, AFTER_DRAIN = false;
    bf16_t *CQ, *CKV, *NQ, *NK, *NV; float *KR, *SSQ, *SSKV; const float *nqg, *nkg;
    __device__ __forceinline__ void operator()(const f32x4 (&acc)[2][2][4][2], const Unit& u, int wr, int wc, int fr_in, int fq_in) const {
        int fr = fr_in, fq = fq_in; asm volatile("" : "+v"(fr), "+v"(fq));
        const int pn = u.pn, pm = u.pm; const int kvb = kvbase_of(pm);
#pragma unroll
        for (int ai = 0; ai < 2; ++ai)
#pragma unroll
            for (int m = 0; m < 4; ++m) {
                const int rl = 128 * ai + 64 * wr + 16 * m + fr; const size_t r = (size_t)pm * 256 + rl;
                if (pn == 0 || pn == 2) {
                    bf16_t* dst = pn == 0 ? CQ + r * 384 : CKV + r * 256; float ss = 0.f;
#pragma unroll
                    for (int bj = 0; bj < 2; ++bj)
#pragma unroll
                        for (int n = 0; n < 2; ++n) { ss += sum4sq(acc[ai][bj][m][n]); *(u32x2*)(dst + 128 * bj + 32 * wc + 16 * n + 4 * fq) = pk4(acc[ai][bj][m][n]); }
                    ss = quad_sum(ss);
                    if (fq == 0) atomicAdd((pn == 0 ? SSQ : SSKV) + r, ss);
                } else if (pn == 1) {
                    float ss = 0.f;
#pragma unroll
                    for (int n = 0; n < 2; ++n) { ss += sum4sq(acc[ai][0][m][n]); *(u32x2*)(CQ + r * 384 + 256 + 32 * wc + 16 * n + 4 * fq) = pk4(acc[ai][0][m][n]); }
                    ss = quad_sum(ss);
                    if (fq == 0) atomicAdd(SSQ + r, ss);
                    if (wc == 0) {
#pragma unroll
                        for (int n = 0; n < 2; ++n) *(f32x4*)(KR + r * 32 + 16 * n + 4 * fq) = acc[ai][1][m][n]; }
                } else if (pn >= 7) {
                    bf16_t* dst = NV + (size_t)(kvb + rl) * 512 + (pn - 7) * 256 + 64 * wc;
#pragma unroll
                    for (int bj = 0; bj < 2; ++bj)
#pragma unroll
                        for (int n = 0; n < 2; ++n) *(u32x2*)(dst + 32 * bj + 16 * n + 4 * fq) = pk4(acc[ai][bj][m][n]);
                } else {
                    f32x4 v[2][2] = {{acc[ai][0][m][0], acc[ai][0][m][1]}, {acc[ai][1][m][0], acc[ai][1][m][1]}};
                    bf16_t* dst;
                    if (pn < 5) { head_finish(v, nqg, false, nullptr, 0, 0, C2_64, fq); dst = NQ + r * 512 + ((pn - 3) * 4 + wc) * 64; }
                    else { head_finish(v, nkg, false, nullptr, 0, 0, 1.0f, fq); dst = NK + (size_t)(kvb + rl) * 512 + ((pn - 5) * 4 + wc) * 64; }
#pragma unroll
                    for (int bj = 0; bj < 2; ++bj)
#pragma unroll
                        for (int n = 0; n < 2; ++n) *(u32x2*)(dst + 32 * bj + 16 * n + 4 * fq) = pk4(v[bj][n]);
                }
            }
    }
};

struct EpiQUp {
    static constexpr bool PERM = true, AFTER_DRAIN = false;
    bf16_t* MQ; const float* SSQ;
    __device__ __forceinline__ void operator()(const f32x4 (&acc)[2][2][4][2], const Unit& u, int wr, int wc, int fr_in, int fq_in) const {
        int fr = fr_in, fq = fq_in; asm volatile("" : "+v"(fr), "+v"(fq));
#pragma unroll
        for (int ai = 0; ai < 2; ++ai)
#pragma unroll
            for (int m = 0; m < 4; ++m) { const size_t r = (size_t)u.pm * 256 + 128 * ai + 64 * wr + 16 * m + fr;
                const float rs = rsqrtf(SSQ[r] * (1.f / 384.f) + EPS);
#pragma unroll
                for (int bj = 0; bj < 2; ++bj) { const f32x4 a = acc[ai][bj][m][0] * rs, b = acc[ai][bj][m][1] * rs;
                    u32x4 w; w.x = pk(a[0], a[1]); w.y = pk(a[2], a[3]); w.z = pk(b[0], b[1]); w.w = pk(b[2], b[3]);
                    *(u32x4*)(MQ + r * 768 + u.pn * 256 + 128 * bj + 32 * wc + 8 * fq) = w; } }
    }
};

struct EpiKvUp {
    static constexpr bool PERM = false, AFTER_DRAIN = false;
    bf16_t *MK, *MV; const float *SSKV, *KR, *kg, *T16;
    __device__ __forceinline__ void operator()(const f32x4 (&acc)[2][2][4][2], const Unit& u, int wr, int wc, int fr_in, int fq_in) const {
        int fr = fr_in, fq = fq_in; asm volatile("" : "+v"(fr), "+v"(fq));
        const int pm = u.pm; const bool lat = pm < 64; const int kvb = kvbase_of(pm); const int head = 2 * u.pn + (wc >> 1); const bool isv = wc & 1;
        float rs[2][4];
#pragma unroll
        for (int ai = 0; ai < 2; ++ai)
#pragma unroll
            for (int m = 0; m < 4; ++m) rs[ai][m] = SSKV[(size_t)pm * 256 + 128 * ai + 64 * wr + 16 * m + fr];
#pragma unroll
        for (int ai = 0; ai < 2; ++ai)
#pragma unroll
            for (int m = 0; m < 4; ++m) rs[ai][m] = rsqrtf(rs[ai][m] * (1.f / 256.f) + EPS);
        if (isv) {
#pragma unroll
            for (int ai = 0; ai < 2; ++ai)
#pragma unroll
                for (int m = 0; m < 4; ++m) { const size_t kvr = (size_t)(kvb + 128 * ai + 64 * wr + 16 * m + fr);
#pragma unroll
                    for (int bj = 0; bj < 2; ++bj)
#pragma unroll
                        for (int n = 0; n < 2; ++n) *(u32x2*)(MV + kvr * 512 + head * 64 + 32 * bj + 16 * n + 4 * fq) = pk4(acc[ai][bj][m][n] * rs[ai][m]); }
            return;
        }
        f32x4 gn[2][2]; f32x2 gr[4];
#pragma unroll
        for (int bj = 0; bj < 2; ++bj)
#pragma unroll
            for (int n = 0; n < 2; ++n) gn[bj][n] = *(const f32x4*)(kg + 32 * bj + 16 * n + 4 * fq);
#pragma unroll
        for (int j = 0; j < 4; ++j) gr[j] = *(const f32x2*)(kg + 64 + 8 * j + 2 * fq);
#pragma unroll
        for (int ai = 0; ai < 2; ++ai) {
            const int grow = (pm & 7) * 4 + 2 * ai + wr;
            f32x2 csr = {1.f, 1.f}, snr = {0.f, 0.f};
            if (lat) { csr = *(const f32x2*)(T16 + grow * 8 + 2 * fq); snr = *(const f32x2*)(T16 + 512 + grow * 8 + 2 * fq); }
#pragma unroll
            for (int m = 0; m < 4; ++m) {
                const int rl = 128 * ai + 64 * wr + 16 * m + fr; const size_t r = (size_t)pm * 256 + rl; const size_t kvr = (size_t)(kvb + rl);
                f32x2 k[4];
#pragma unroll
                for (int j = 0; j < 4; ++j) k[j] = *(const f32x2*)(KR + r * 32 + 8 * j + 2 * fq);
                f32x2 csc = {1.f, 1.f}, snc = {0.f, 0.f};
                if (lat) { const int gcol = 16 * m + fr; csc = *(const f32x2*)(T16 + gcol * 8 + 2 * fq); snc = *(const f32x2*)(T16 + 512 + gcol * 8 + 2 * fq); }
                f32x4 v[2][2];
#pragma unroll
                for (int bj = 0; bj < 2; ++bj)
#pragma unroll
                    for (int n = 0; n < 2; ++n) v[bj][n] = acc[ai][bj][m][n] * rs[ai][m];
                float ss = (sum4sq(v[0][0]) + sum4sq(v[0][1])) + (sum4sq(v[1][0]) + sum4sq(v[1][1]));
#pragma unroll
                for (int j = 0; j < 4; ++j) ss += k[j][0] * k[j][0] + k[j][1] * k[j][1];
                ss = quad_sum(ss);
                const float rr = rsqrtf(ss * (1.f / 96.f) + EPS);
#pragma unroll
                for (int bj = 0; bj < 2; ++bj)
#pragma unroll
                    for (int n = 0; n < 2; ++n) *(u32x2*)(MK + kvr * 768 + head * 96 + 32 * bj + 16 * n + 4 * fq) = pk4((v[bj][n] * rr) * gn[bj][n]);
#pragma unroll
                for (int j = 0; j < 4; ++j) k[j] = (k[j] * rr) * gr[j];
                { const f32x2 x1 = k[0], x2 = k[1]; k[0] = x1 * csr - x2 * snr; k[1] = x1 * snr + x2 * csr; }
                { const f32x2 x1 = k[2], x2 = k[3]; k[2] = x1 * csc - x2 * snc; k[3] = x1 * snc + x2 * csc; }
#pragma unroll
                for (int j = 0; j < 4; ++j) *(unsigned*)(MK + kvr * 768 + head * 96 + 64 + 8 * j + 2 * fq) = pk(k[j][0], k[j][1]);
                if (m & 1) asm volatile("" ::: "memory");
            }
        }
    }
};
}
namespace att {
using bf16x8 = __attribute__((ext_vector_type(8))) short;
using s16x4 = __attribute__((ext_vector_type(4))) short;
using f32x16 = __attribute__((ext_vector_type(16))) float;
using u32x4 = __attribute__((ext_vector_type(4))) unsigned;
typedef float f32x2_t __attribute__((ext_vector_type(2))); typedef __bf16 bf16x2_t __attribute__((ext_vector_type(2)));
#define ALAS __attribute__((address_space(3)))
constexpr int KSLOT = 12288, VSLOT = 8192, SLOT = KSLOT + VSLOT, NSLOT = 4;
constexpr int LDS_WS = NSLOT * SLOT;
constexpr int LDS_OST = LDS_WS + 8 * 256;
constexpr int LDS_RPB = LDS_OST + 8 * 4096;
constexpr int LDS_BYTES = LDS_RPB + 2048;
constexpr float THR = 8.0f;

__device__ __forceinline__ int crow(int r, int hi) { return (r & 3) + 8 * (r >> 2) + 4 * hi; }
__device__ __forceinline__ void glds16(const void* gsrc, unsigned lds_dst) { unsigned keep;
    asm volatile("s_mov_b32 %0, m0\n\ts_mov_b32 m0, %2\n\ts_nop 0\n\tglobal_load_lds_dwordx4 %1, off\n\ts_mov_b32 m0, %0" : "=&s"(keep) : "v"(gsrc), "s"(lds_dst) : "memory"); }
__device__ __forceinline__ unsigned cvtpk(float lo, float hi) { f32x2_t v = {lo, hi}; bf16x2_t b = __builtin_convertvector(v, bf16x2_t); return __builtin_bit_cast(unsigned, b); }
__device__ __forceinline__ void glds16s(unsigned voff, const void* sbase, unsigned lds_dst) { unsigned keep;
    asm volatile("s_mov_b32 %0, m0\n\ts_mov_b32 m0, %3\n\ts_nop 0\n\tglobal_load_lds_dwordx4 %1, %2\n\ts_mov_b32 m0, %0" : "=&s"(keep) : "v"(voff), "s"(sbase), "s"(lds_dst) : "memory"); }
__device__ __forceinline__ float max3f(float a, float b, float c) { float r; asm("v_max3_f32 %0, %1, %2, %3" : "=v"(r) : "v"(a), "v"(b), "v"(c)); return r; }
__device__ __forceinline__ float max2f(float a, float b) { float r; asm("v_max_f32_e32 %0, %1, %2" : "=v"(r) : "v"(a), "v"(b)); return r; }
#define AWAIT_BAR(N) asm volatile("s_waitcnt vmcnt(" #N ") lgkmcnt(0)\n\ts_barrier" ::: "memory")

template <int ND0> __device__ __forceinline__ void qkt(f32x16& p0, f32x16& p1, const ALAS char* Kslot, const bf16x8* qr, const f32x16& negm, int r32, int hi) {
    const ALAS char* kb = Kslot + hi * 1024 + r32 * 16;
#pragma unroll
    for (int d0 = 0; d0 < ND0; ++d0) {
        const bf16x8 b0 = *(const ALAS bf16x8*)(kb + d0 * 2048);
        const bf16x8 b1 = *(const ALAS bf16x8*)(kb + d0 * 2048 + 512);
        if (d0 == 0) { p0 = __builtin_amdgcn_mfma_f32_32x32x16_bf16(b0, qr[0], negm, 0, 0, 0); p1 = __builtin_amdgcn_mfma_f32_32x32x16_bf16(b1, qr[0], negm, 0, 0, 0); }
        else { p0 = __builtin_amdgcn_mfma_f32_32x32x16_bf16(b0, qr[d0], p0, 0, 0, 0); p1 = __builtin_amdgcn_mfma_f32_32x32x16_bf16(b1, qr[d0], p1, 0, 0, 0); }
    }
}
__device__ __forceinline__ float rowmax32(const f32x16& p0, const f32x16& p1) {
    float a = max3f(p0[0], p0[1], p1[0]), b = max3f(p0[2], p0[3], p1[1]); a = max3f(a, p1[2], p1[3]);
#pragma unroll
    for (int r = 4; r < 16; r += 4) { a = max3f(a, p0[r], p0[r + 1]); b = max3f(b, p0[r + 2], p0[r + 3]); a = max3f(a, p1[r], p1[r + 1]); b = max3f(b, p1[r + 2], p1[r + 3]); }
    const float m = max2f(a, b);
    auto rr = __builtin_amdgcn_permlane32_swap(__float_as_uint(m), __float_as_uint(m), false, false);
    return max2f(__uint_as_float(rr[0]), __uint_as_float(rr[1]));
}
typedef short v4i16_t __attribute__((ext_vector_type(4)));
__device__ __forceinline__ s16x4 vtr(const ALAS char* p) { return __builtin_bit_cast(s16x4, __builtin_amdgcn_ds_read_tr16_b64_v4i16((ALAS v4i16_t*)p)); }
__device__ __forceinline__ void pv(f32x16* o, const ALAS char* vp, bf16x8 pa0, bf16x8 pa1, bf16x8 pa2, bf16x8 pa3) {
#pragma unroll
    for (int d0 = 0; d0 < 2; ++d0) { s16x4 lo[4], hi[4];
#pragma unroll
        for (int ks = 0; ks < 4; ++ks) { lo[ks] = vtr(vp + d0 * 4096 + ks * 1024); hi[ks] = vtr(vp + d0 * 4096 + ks * 1024 + 512); }
#define APK(k) (bf16x8){lo[k][0], lo[k][1], lo[k][2], lo[k][3], hi[k][0], hi[k][1], hi[k][2], hi[k][3]}
        o[d0] = __builtin_amdgcn_mfma_f32_32x32x16_bf16(pa0, APK(0), o[d0], 0, 0, 0);
        o[d0] = __builtin_amdgcn_mfma_f32_32x32x16_bf16(pa1, APK(1), o[d0], 0, 0, 0);
        o[d0] = __builtin_amdgcn_mfma_f32_32x32x16_bf16(pa2, APK(2), o[d0], 0, 0, 0);
        o[d0] = __builtin_amdgcn_mfma_f32_32x32x16_bf16(pa3, APK(3), o[d0], 0, 0, 0);
#undef APK
    }
}

struct UnitDesc {
    const bf16_t* Q; int qpitch;
    long q0; int qcol;
    const bf16_t* K; int kpitch, kcol;
    const bf16_t* V; int vpitch, vcol;
    bf16_t* O; int opitch, ocol;
    int kv0;
    int nt;
    int rg;
    int rmin;
    int head;
};

template <int DQK, bool NA, bool MLAQ>
__device__ __forceinline__ void attn_unit(const UnitDesc& U, ALAS char* shm, const float* qgain, const float* T16, const float* rpb_g) {
    constexpr int ND0 = DQK / 16, NCH = DQK / 8, NP = NCH + 8;
    int tid_ = threadIdx.x; asm volatile("" : "+v"(tid_));
    const int tid = tid_, lane = tid & 63, r32 = lane & 31, hi = lane >> 5; const int wid = __builtin_amdgcn_readfirstlane(tid >> 6);
    const unsigned lds0 = (unsigned)(uintptr_t)shm;
    ALAS float* wsf = (ALAS float*)(shm + LDS_WS) + wid * 64;
    unsigned doff[3];
#pragma unroll
    for (int i = 0; i < 3; ++i) { const int pc = wid + 8 * i;
        if (pc < NCH) doff[i] = (unsigned)((lane * U.kpitch + U.kcol + pc * 8) * 2);
        else { const int v = pc - NCH; doff[i] = (unsigned)(((16 * (v & 3) + (lane >> 2)) * U.vpitch + U.vcol + (v >> 2) * 32 + (lane & 3) * 8) * 2); } }
    auto dma_tile = [&](int t, int slot) {
        int key0;
        if (NA && t >= 4) key0 = U.kv0 + CTX + (U.rmin + (t - 4)) * GW; else key0 = U.kv0 + 64 * t;
        const unsigned sbase = lds0 + slot * SLOT;
        const bf16_t* kb_ = U.K + (size_t)key0 * U.kpitch; const bf16_t* vb_ = U.V + (size_t)key0 * U.vpitch;
#pragma unroll
        for (int i = 0; i < 3; ++i) { const int pc = wid + 8 * i;
            if (pc < NP) {
                if (pc < NCH) glds16s(doff[i], kb_, (unsigned)__builtin_amdgcn_readfirstlane(sbase + pc * 1024));
                else glds16s(doff[i], vb_, (unsigned)__builtin_amdgcn_readfirstlane(sbase + KSLOT + (pc - NCH) * 1024));
            } }
    };
    asm volatile("s_waitcnt vmcnt(0)" ::: "memory");
    dma_tile(0, 0); if (U.nt > 1) dma_tile(1, 1);
    if (NA) { ALAS float* tb = (ALAS float*)(shm + LDS_RPB); for (int i = tid; i < 15 * 31; i += 512) tb[i] = rpb_g[U.head * 465 + i] * LOG2E; }
    bf16x8 qr[ND0];
    const bf16_t* Qw = U.Q + (size_t)(U.q0 + wid * 32 + r32) * U.qpitch + U.qcol;
#pragma unroll
    for (int d0 = 0; d0 < ND0; ++d0) qr[d0] = *(const bf16x8*)(Qw + d0 * 16 + hi * 8);
    if (MLAQ) {
        float f[ND0][8]; float ss = 0.f;
#pragma unroll
        for (int d0 = 0; d0 < ND0; ++d0)
#pragma unroll
            for (int j = 0; j < 8; ++j) { f[d0][j] = bf2f((bf16_t)qr[d0][j]); ss += f[d0][j] * f[d0][j]; }
        ss += __shfl_xor(ss, 32);
        const float rn = rsqrtf(ss * (1.f / 96.f) + EPS) * C2_96;
#pragma unroll
        for (int d0 = 0; d0 < ND0; ++d0)
#pragma unroll
            for (int j = 0; j < 8; ++j) f[d0][j] = f[d0][j] * rn * qgain[d0 * 16 + hi * 8 + j];
        const int t = (int)((U.q0 + wid * 32 + r32) % S); const int grow = t / GW, gcol = t % GW;
#pragma unroll
        for (int part = 0; part < 2; ++part) { const int pos = part ? gcol : grow;
#pragma unroll
            for (int j = 0; j < 8; ++j) { const float cs = T16[pos * 8 + j], sn = T16[512 + pos * 8 + j];
                const float mine = f[4 + part][j], other = __shfl_xor(mine, 32);
                f[4 + part][j] = hi == 0 ? (mine * cs - other * sn) : (other * sn + mine * cs); } }
#pragma unroll
        for (int d0 = 0; d0 < ND0; ++d0)
#pragma unroll
            for (int j = 0; j < 4; ++j) { const unsigned w = cvtpk(f[d0][2 * j], f[d0][2 * j + 1]); qr[d0][2 * j] = (short)(w & 0xffff); qr[d0][2 * j + 1] = (short)(w >> 16); }
    }
    const int grow_w = NA ? 4 * U.rg + (wid >> 1) : 0, c0w = 32 * (wid & 1);
    const int r0w = NA ? min(max(grow_w - 4, 0), 24) : 0;
    const int qc = c0w + r32;
    const int cs_q = min(max(qc - 8, 0), 48);
    float mhat = 0.f, l_reg = 0.f; f32x16 o[2]; o[0] = f32x16{}; o[1] = f32x16{};
    const ALAS char* vp0 = shm + KSLOT + ((lane >> 4) & 1) * 32 + (lane & 3) * 8 + (4 * hi + ((lane & 15) >> 2)) * 64;
    const int NT = U.nt;
    f32x16 a0, a1, b0, b1;
    u32x4 pw0, pw1, pw2, pw3;
    auto wait_tile = [&](int t) {
        if (t + 1 < NT) { if (NP == 20 && wid < 4) AWAIT_BAR(3); else AWAIT_BAR(2); } else AWAIT_BAR(0);
        if (t + 2 < NT) dma_tile(t + 2, (t + 2) & 3);
    };
    auto maskbias = [&](f32x16& c0, f32x16& c1, int t) {
        if (NA && t >= 4) {
            const int krow = U.rmin + (t - 4); const bool rowok = (krow >= r0w) && (krow < r0w + 8);
            const ALAS float* tb = (const ALAS float*)(shm + LDS_RPB) + min(max(krow - grow_w + 7, 0), 14) * 31;
#pragma unroll
            for (int r = 0; r < 16; ++r) {
                const int kc0 = crow(r, hi), kc1 = kc0 + 32;
                { const int rel = kc0 - cs_q; const int bi = min(max(kc0 - qc + 15, 0), 30); const float bv = tb[bi]; c0[r] = (rowok && (unsigned)rel < 16u) ? c0[r] + bv : -INFINITY; }
                { const int rel = kc1 - cs_q; const int bi = min(max(kc1 - qc + 15, 0), 30); const float bv = tb[bi]; c1[r] = (rowok && (unsigned)rel < 16u) ? c1[r] + bv : -INFINITY; }
            }
        }
    };
    f32x16 negm = f32x16{};
    auto decide = [&](f32x16& c0, f32x16& c1, bool first) {
        const float rm = rowmax32(c0, c1);
        if (first || __any(rm > THR)) {
            const float dl = first ? rm : fmaxf(rm, 0.f);
            mhat += dl;
#pragma unroll
            for (int r = 0; r < 16; ++r) { c0[r] -= dl; c1[r] -= dl; }
#pragma unroll
            for (int r = 0; r < 16; ++r) negm[r] = -mhat;
            if (!first) {
                const float f = __builtin_amdgcn_exp2f(-dl);
                l_reg *= f;
                if (hi == 0) wsf[r32] = f;
                asm volatile("s_waitcnt lgkmcnt(0)" ::: "memory");
#pragma unroll
                for (int r = 0; r < 16; ++r) { const float fr_ = wsf[crow(r, hi)]; o[0][r] *= fr_; o[1][r] *= fr_; }
            }
        }
    };
    auto finish = [&](f32x16& c0, f32x16& c1) {
        float sacc = 0.f;
#pragma unroll
        for (int r = 0; r < 16; ++r) { c0[r] = __builtin_amdgcn_exp2f(c0[r]); c1[r] = __builtin_amdgcn_exp2f(c1[r]); sacc += c0[r] + c1[r]; }
        l_reg += sacc;
#pragma unroll
        for (int j = 0; j < 4; ++j) { pw0[j] = cvtpk(c0[2 * j], c0[2 * j + 1]); pw1[j] = cvtpk(c0[8 + 2 * j], c0[9 + 2 * j]); pw2[j] = cvtpk(c1[2 * j], c1[2 * j + 1]); pw3[j] = cvtpk(c1[8 + 2 * j], c1[9 + 2 * j]); }
    };
    auto step = [&](f32x16& c0, f32x16& c1, f32x16& q0, f32x16& q1, int j) {
        wait_tile(j);
#ifdef ATT_DUP_BAR
        asm volatile("s_waitcnt lgkmcnt(0)\n\ts_barrier" ::: "memory");
#endif
        qkt<ND0>(c0, c1, shm + (j & 3) * SLOT, qr, negm, r32, hi);
#ifdef ATT_DUP_MFMA
        { f32x16 d0_, d1_; qkt<ND0>(d0_, d1_, shm + (j & 3) * SLOT, qr, r32, hi); asm volatile("" :: "v"(d0_), "v"(d1_)); }
#endif
#ifdef ATT_DUP_VALU
        { f32x16 e0_ = q0, e1_ = q1; float sacc_ = 0.f;
#pragma unroll
          for (int r = 0; r < 16; ++r) { e0_[r] = __builtin_amdgcn_exp2f(e0_[r] - mhat * 1.0001f); e1_[r] = __builtin_amdgcn_exp2f(e1_[r] - mhat * 1.0001f); sacc_ += e0_[r] + e1_[r]; }
          unsigned w_ = 0;
#pragma unroll
          for (int jj = 0; jj < 8; ++jj) { w_ ^= cvtpk(e0_[2 * jj], e0_[2 * jj + 1]); w_ ^= cvtpk(e1_[2 * jj], e1_[2 * jj + 1]); }
          asm volatile("" :: "v"(sacc_), "v"(w_)); }
#endif
        finish(q0, q1);
        pv(o, vp0 + ((j - 1) & 3) * SLOT, __builtin_bit_cast(bf16x8, pw0), __builtin_bit_cast(bf16x8, pw1), __builtin_bit_cast(bf16x8, pw2), __builtin_bit_cast(bf16x8, pw3));
        maskbias(c0, c1, j);
        decide(c0, c1, false);
    };
    wait_tile(0);
    qkt<ND0>(a0, a1, shm, qr, negm, r32, hi);
    decide(a0, a1, true);
    int j = 1;
#pragma unroll 1
    for (; j + 1 < NT; j += 2) { step(b0, b1, a0, a1, j); step(a0, a1, b0, b1, j + 1); }
    if (j < NT) { step(b0, b1, a0, a1, j); finish(b0, b1); } else finish(a0, a1);
    pv(o, vp0 + ((NT - 1) & 3) * SLOT, __builtin_bit_cast(bf16x8, pw0), __builtin_bit_cast(bf16x8, pw1), __builtin_bit_cast(bf16x8, pw2), __builtin_bit_cast(bf16x8, pw3));
    { auto rr = __builtin_amdgcn_permlane32_swap(__float_as_uint(l_reg), __float_as_uint(l_reg), false, false); l_reg = __uint_as_float(rr[0]) + __uint_as_float(rr[1]); }
    if (hi == 0) wsf[32 + r32] = l_reg;
    asm volatile("s_waitcnt lgkmcnt(0)" ::: "memory");
    float rli[16];
#pragma unroll
    for (int r = 0; r < 16; ++r) rli[r] = __builtin_amdgcn_rcpf(wsf[32 + crow(r, hi)]);
    bf16_t* Ow = U.O + (size_t)(U.q0 + wid * 32) * U.opitch + U.ocol;
    { ALAS bf16_t* stg = (ALAS bf16_t*)(shm + LDS_OST) + wid * 2048;
#pragma unroll
        for (int r = 0; r < 16; ++r) { const int orow = crow(r, hi);
#pragma unroll
            for (int d0 = 0; d0 < 2; ++d0) stg[orow * 64 + d0 * 32 + r32] = f2bf(o[d0][r] * rli[r]); }
        asm volatile("s_waitcnt lgkmcnt(0)" ::: "memory");
#pragma unroll
        for (int i = 0; i < 4; ++i) { const int row = i * 8 + (lane >> 3), ch = lane & 7; const u32x4 v = *(const ALAS u32x4*)(stg + row * 64 + ch * 8); *(u32x4*)(Ow + (size_t)row * U.opitch + ch * 8) = v; } }
    asm volatile("s_waitcnt vmcnt(0) lgkmcnt(0)\n\ts_barrier" ::: "memory");
}
}
#define LAS __attribute__((address_space(3)))
#define XB_TMO      128
#define XB_XCNT(j)  (256  + 64 * (j))
#define XB_XSUB(j)  (1280 + 64 * (j))
#define XB_XGEN(j)  (2304 + 64 * (j))
#define XB_TOP      3328
#define XB_TOPGEN   3392
#define XCD_BAR_WORDS 3456
#define XB_SPIN_CAP (1u << 18)

__device__ __forceinline__ unsigned xb_ld(unsigned* p)              { return __hip_atomic_load(p, __ATOMIC_RELAXED, __HIP_MEMORY_SCOPE_AGENT); }
__device__ __forceinline__ unsigned xb_add(unsigned* p, unsigned v) { return __hip_atomic_fetch_add(p, v, __ATOMIC_RELAXED, __HIP_MEMORY_SCOPE_AGENT); }
__device__ __forceinline__ unsigned xb_xcc_id() { return (unsigned)__builtin_amdgcn_s_getreg((3 << 11) | 20) & 0xFu; }
#define XB_SPIN(cond, bar) do { unsigned _sp = 0; while (cond) { __builtin_amdgcn_s_sleep(1); \
    if ((++_sp & 255u) == 0u) { if (xb_ld(&(bar)[XB_TMO])) break; if (_sp > XB_SPIN_CAP) { atomicAdd(&(bar)[XB_TMO], 1u); break; } } } } while (0)

struct XcdBarrier {
    unsigned* bar; unsigned x;
    volatile LAS unsigned* st;
};

__device__ __forceinline__ XcdBarrier xcd_barrier_post(unsigned* bar, volatile LAS unsigned* st) {
    XcdBarrier b; b.bar = bar; b.x = xb_xcc_id(); b.st = st;
    if (threadIdx.x == 0) (void)xb_add(&bar[XB_XCNT(b.x)], 1u);
    return b;
}
__device__ __forceinline__ void xcd_barrier_complete(unsigned* bar, unsigned x, unsigned& nloc, unsigned& nx) {
    const unsigned G = gridDim.x * gridDim.y * gridDim.z;
    unsigned sum, cnt, mine, sp = 0u;
    for (;;) {
        sum = 0u; cnt = 0u; mine = 0u;
#pragma unroll
        for (unsigned j = 0; j < 16; ++j) { const unsigned c = xb_ld(&bar[XB_XCNT(j)]); sum += c; cnt += (c > 0u) ? 1u : 0u; mine = (j == x) ? c : mine; }
        if (sum == G) break;
        __builtin_amdgcn_s_sleep(1);
        if ((++sp & 255u) == 0u) { if (xb_ld(&bar[XB_TMO])) break; if (sp > XB_SPIN_CAP) { atomicAdd(&bar[XB_TMO], 1u); break; } }
    }
    nloc = mine > 0u ? mine : 1u; nx = cnt > 0u ? cnt : 1u;
}

__device__ __forceinline__ void xcd_barrier(const XcdBarrier& b) {
    asm volatile("s_waitcnt vmcnt(0)" ::: "memory");
    __syncthreads();
    if (threadIdx.x == 0) {
        unsigned* bar = b.bar;
        __builtin_amdgcn_s_waitcnt(0);
        unsigned nloc = b.st[0], nx = b.st[1];
        if (nloc == 0u) { xcd_barrier_complete(bar, b.x, nloc, nx); b.st[0] = nloc; b.st[1] = nx; }
        const unsigned old = xb_add(&bar[XB_XSUB(b.x)], 1u);
        const unsigned gen = old / nloc;
        if (old + 1u == (gen + 1u) * nloc) {
            __builtin_amdgcn_fence(__ATOMIC_RELEASE, "agent");
            asm volatile("s_waitcnt vmcnt(0)" ::: "memory");
            const unsigned og = xb_add(&bar[XB_TOP], 1u);
            const unsigned tg = og / nx;
            if (og + 1u == (tg + 1u) * nx) xb_add(&bar[XB_TOPGEN], 1u);
            else XB_SPIN(xb_ld(&bar[XB_TOPGEN]) == tg, bar);
            __builtin_amdgcn_fence(__ATOMIC_ACQUIRE, "agent");
            xb_add(&bar[XB_XGEN(b.x)], 1u);
            asm volatile("s_waitcnt vmcnt(0)" ::: "memory");
        } else {
            XB_SPIN(xb_ld(&bar[XB_XGEN(b.x)]) == gen, bar);
            __builtin_amdgcn_fence(__ATOMIC_ACQUIRE, "agent");
            asm volatile("s_waitcnt vmcnt(0)" ::: "memory");
        }
    }
    __syncthreads();
}
namespace mk {
#define MLAS __attribute__((address_space(3)))
constexpr int NWAVES = 8, NTHR = 512;
constexpr int RING_BYTES = 131072;
constexpr int LDS_BYTES = 147456;
constexpr int NPHASE = 16;
typedef unsigned v4u __attribute__((ext_vector_type(4)));
typedef float f32x4 __attribute__((ext_vector_type(4)));

struct Ctx {
    Params p; MLAS unsigned char* lds; int tid, lane, wave, G, vcu, bid;
};
__device__ __forceinline__ unsigned pk2(float lo, float hi) { return (unsigned)f2bf(lo) | ((unsigned)f2bf(hi) << 16); }

enum { W_IN0 = 0, W_OUT0, W_GU0, W_D0, W_IN1, W_UQ, W_UKV, W_OUT1, W_GU1, W_D1, NWMAT };
struct SrcBlk { const float* W; int ld; int col; const float* kscale; };
__device__ __forceinline__ SrcBlk src_of(const Params& p, int mat, int nb) {
    SrcBlk s; s.kscale = nullptr; const int pn = nb >> 3, q = nb & 7, bj = q >> 2, wc = q & 3;
    switch (mat) {
    case W_IN0: s.W = p.in[I0_WIN]; s.ld = L0_IN; s.col = 256 * pn + 64 * wc + 32 * bj; break;
    case W_OUT0: s.W = p.in[I0_WOUT]; s.ld = D; s.col = 32 * nb; break;
    case W_GU0: s.W = bj ? p.in[I0_WU] : p.in[I0_WG]; s.ld = FF; s.col = 128 * pn + 32 * wc; break;
    case W_D0: s.W = p.in[I0_WD]; s.ld = D; s.col = 32 * nb; break;
    case W_IN1: s.W = p.in[I1_WIN]; s.ld = L1_IN;
        if (pn == 0) s.col = 128 * bj + 32 * wc;
        else if (pn == 1) { if (bj == 0) s.col = 256 + 32 * wc; else s.col = 640; }
        else if (pn == 2) s.col = 384 + 128 * bj + 32 * wc;
        else if (pn < 5) s.col = 672 + (pn - 3) * 256 + 64 * wc + 32 * bj;
        else if (pn < 7) s.col = 1184 + (pn - 5) * 256 + 64 * wc + 32 * bj;
        else s.col = 1696 + (pn - 7) * 256 + 64 * wc + 32 * bj;
        break;
    case W_UQ: s.W = p.in[I1_WUQ]; s.ld = 768; s.col = 32 * nb; s.kscale = p.in[I1_QAG]; break;
    case W_UKV: s.W = p.in[I1_WUKV]; s.ld = 1024; s.col = (2 * pn + (wc >> 1)) * 128 + (wc & 1) * 64 + 32 * bj; s.kscale = p.in[I1_KVAG]; break;
    case W_OUT1: s.W = p.in[I1_WOUT]; s.ld = D; s.col = 32 * nb; break;
    case W_GU1: s.W = bj ? p.in[I1_WU] : p.in[I1_WG]; s.ld = FF; s.col = 128 * pn + 32 * wc; break;
    default: s.W = p.in[I1_WD]; s.ld = D; s.col = 32 * nb; break;
    }
    return s;
}
struct WMat { size_t ws_off; int K, N; };
__host__ __device__ constexpr WMat wmat(int mat) {
    switch (mat) {
    case W_IN0: return {WS_W_IN0, D, 1536}; case W_OUT0: return {WS_W_OUT0, D, D}; case W_GU0: return {WS_W_GU0, D, 2 * FF}; case W_D0: return {WS_W_D0, FF, D};
    case W_IN1: return {WS_W_IN1, D, L1_INP}; case W_UQ: return {WS_W_UQ, 384, 768}; case W_UKV: return {WS_W_UKV, 256, 1024}; case W_OUT1: return {WS_W_OUT1, D, D};
    case W_GU1: return {WS_W_GU1, D, 2 * FF}; default: return {WS_W_D1, FF, D};
    }
}
template <int mat> __device__ __forceinline__ void transpose_item(const Params& p, int item, MLAS float* scr, int lane) {
    const WMat wm = wmat(mat); const int nblk = wm.N / 32, kb = item / nblk, nb = item % nblk, k0 = 64 * kb;
    const SrcBlk s = src_of(p, mat, nb);
    bf16_t* WT = (bf16_t*)(p.ws + wm.ws_off);
    const int c = lane & 7;
    if (s.W == nullptr) {
#pragma unroll
        for (int j = 0; j < 4; ++j) { const int n = (lane >> 3) + 8 * j; *(v4u*)(WT + (size_t)(32 * nb + n) * wm.K + k0 + 8 * c) = (v4u){0u, 0u, 0u, 0u}; }
        return;
    }
    MLAS float* t0 = scr; MLAS float* t1 = scr + 64 * 33;
    if (mat == W_OUT0 && kb < 4) return;
    constexpr bool fused_pool = false;
    { const int c4 = (lane & 7) * 4, kr = lane >> 3;
        const float* wsrc = s.W + (size_t)(k0 + kr) * s.ld + s.col + c4;
        f32x4 v[8];
#pragma unroll
        for (int i = 0; i < 8; ++i) v[i] = *(const f32x4*)(wsrc + (size_t)(8 * i) * s.ld);
#pragma unroll
        for (int i = 0; i < 8; ++i) { const int kk = kr + 8 * i; float sc = 1.f;
            if (s.kscale) sc = s.kscale[k0 + kk];
            if (fused_pool) sc *= p.in[I0_POOLS][k0 + kk];
            MLAS float* d = t0 + kk * 33 + c4; d[0] = v[i][0] * sc; d[1] = v[i][1] * sc; d[2] = v[i][2] * sc; d[3] = v[i][3] * sc; } }
    asm volatile("s_waitcnt lgkmcnt(0)" ::: "memory");
    MLAS float* src = t0;
    if (fused_pool) {
        const float* pw = p.in[I0_POOLW] + kb * 4096; const int nn = lane & 31, ch = lane >> 5;
        for (int cc = ch; cc < 64; cc += 2) { float a = 0.f;
#pragma unroll 8
            for (int d = 0; d < 64; ++d) a += pw[cc * 64 + d] * t0[d * 33 + nn];
            t1[cc * 33 + nn] = a; }
        asm volatile("s_waitcnt lgkmcnt(0)" ::: "memory");
        src = t1;
    }
#pragma unroll
    for (int j = 0; j < 4; ++j) { const int n = (lane >> 3) + 8 * j; const MLAS float* sp = src + (8 * c) * 33 + n;
        v4u o; o.x = pk2(sp[0 * 33], sp[1 * 33]); o.y = pk2(sp[2 * 33], sp[3 * 33]); o.z = pk2(sp[4 * 33], sp[5 * 33]); o.w = pk2(sp[6 * 33], sp[7 * 33]);
        *(v4u*)(WT + (size_t)(32 * nb + n) * wm.K + k0 + 8 * c) = o; }
    asm volatile("s_waitcnt lgkmcnt(0)" ::: "memory");
}

#ifndef P0MASK
#define P0MASK 15
#endif
__device__ __forceinline__ void phase_prologue(Ctx& C) {
    const Params& p = C.p;
    MLAS float* sil = (MLAS float*)C.lds;
    MLAS float* red = (MLAS float*)(C.lds + 9 * 1024 * 4);
    for (int i = C.tid; i < 9 * D; i += NTHR) { const int j = i / D, k = i % D; const float c = (j < 8) ? p.in[I_C][j * D + k] : p.in[I_CCTX][k]; sil[i] = c / (1.f + expf(-c)); }
    __syncthreads();
    float* MOD = (float*)(p.ws + WS_MOD);
    if (P0MASK & 1)
    for (int it = C.vcu; it < 192; it += C.G) {
        const int l = it / 96, r_ = it % 96, cg_ = r_ >> 2, kq = r_ & 3, n0 = cg_ * 256;
        const float* w = (l ? p.in[I1_ADAW] : p.in[I0_ADAW]) + (size_t)(kq * 256 + C.wave * 32) * 6144 + n0 + 4 * C.lane;
        f32x4 acc[9];
#pragma unroll
        for (int j = 0; j < 9; ++j) acc[j] = (f32x4){0.f, 0.f, 0.f, 0.f};
#pragma unroll 8
        for (int k = 0; k < 32; ++k) { const f32x4 wv = *(const f32x4*)(w + (size_t)k * 6144); const int kk = kq * 256 + C.wave * 32 + k;
#pragma unroll
            for (int j = 0; j < 9; ++j) acc[j] += wv * sil[j * D + kk]; }
#pragma unroll
        for (int j = 0; j < 9; ++j) *(MLAS f32x4*)(red + (C.wave * 9 + j) * 256 + 4 * C.lane) = acc[j];
        __syncthreads();
        for (int i = C.tid; i < 9 * 256; i += NTHR) { const int j = i >> 8, c = i & 255; float sm_ = 0.f;
#pragma unroll
            for (int wv = 0; wv < 8; ++wv) sm_ += red[(wv * 9 + j) * 256 + c];
            if (kq == 0) sm_ += (l ? p.in[I1_ADAB] : p.in[I0_ADAB])[n0 + c];
            atomicAdd(MOD + (size_t)(l * 9 + j) * 6144 + n0 + c, sm_); }
        __syncthreads();
    }
    __syncthreads();
    {
        MLAS float* PA = (MLAS float*)C.lds;
        MLAS float* PB = (MLAS float*)(C.lds + 64 * 65 * 4);
        bf16_t* WT = (bf16_t*)(p.ws + WS_W_OUT0);
        for (int tile = C.vcu; tile < 128; tile += C.G) {
            const int g = tile >> 5, nb = tile & 31;
            for (int i = C.tid; i < 4096; i += NTHR) PA[(i >> 6) * 65 + (i & 63)] = p.in[I0_POOLW][g * 4096 + i];
            for (int i = C.tid; i < 2048; i += NTHR) { const int d = i >> 5, nn = i & 31; PB[d * 33 + nn] = p.in[I0_WOUT][(size_t)(g * 64 + d) * D + 32 * nb + nn] * p.in[I0_POOLS][g * 64 + d]; }
            __syncthreads();
            { const int c = C.tid >> 3, n4 = (C.tid & 7) * 4; float a0 = 0.f, a1 = 0.f, a2 = 0.f, a3 = 0.f;
#pragma unroll 8
                for (int d = 0; d < 64; ++d) { const float pa = PA[c * 65 + d]; const MLAS float* b = PB + d * 33 + n4; a0 += pa * b[0]; a1 += pa * b[1]; a2 += pa * b[2]; a3 += pa * b[3]; }
                bf16_t* o = WT + (size_t)(32 * nb + n4) * D + g * 64 + c;
                o[0] = f2bf(a0); o[D] = f2bf(a1); o[2 * D] = f2bf(a2); o[3 * D] = f2bf(a3); }
            __syncthreads();
        }
    }
    const int gw = C.vcu * NWAVES + C.wave, NGW = C.G * NWAVES;
    MLAS float* scr = (MLAS float*)(C.lds + C.wave * 16896);
    if (P0MASK & 2) {
        int rot = 0;
#define TR_MAT(M) { constexpr int ni = (wmat(M).K / 64) * (wmat(M).N / 32); int first = gw - rot; if (first < 0) first += NGW; \
            for (int it = first; it < ni; it += NGW) transpose_item<M>(p, it, scr, C.lane); rot = (rot + ni) % NGW; }
        TR_MAT(W_IN0) TR_MAT(W_OUT0) TR_MAT(W_GU0) TR_MAT(W_D0) TR_MAT(W_IN1) TR_MAT(W_UQ) TR_MAT(W_UKV) TR_MAT(W_OUT1) TR_MAT(W_GU1) TR_MAT(W_D1)
#undef TR_MAT
    }
    if ((P0MASK & 4) && C.bid == C.G - 1) {
        float* T32 = (float*)(p.ws + WS_ROPE32); float* T16 = (float*)(p.ws + WS_ROPE16);
        for (int i = C.tid; i < 1024; i += NTHR) { const int pos = i >> 4, f = i & 15; const float ang = (float)pos * powf(10000.0f, -((float)f * 2.0f) / 32.0f); T32[i] = cosf(ang); T32[1024 + i] = sinf(ang); }
        for (int i = C.tid; i < 512; i += NTHR) { const int pos = i >> 3, f = i & 7; const float ang = (float)pos * powf(10000.0f, -((float)f * 2.0f) / 16.0f); T16[i] = cosf(ang); T16[512 + i] = sinf(ang); }
    }
    if (P0MASK & 8) { float* SSQ = (float*)(p.ws + WS_SSQ); float* SSKV = (float*)(p.ws + WS_SSKV);
        for (int i = C.bid * NTHR + C.tid; i < MT; i += C.G * NTHR) { SSQ[i] = 0.f; SSKV[i] = 0.f; } }
}

__device__ __forceinline__ void phase_norm(Ctx& C, const float* xl, const float* xc, const float* gain, int layer, int sh_chunk, int sc_chunk, int nrows, const float* slab = nullptr, int nslab = 0, float* xc_wb = nullptr) {
    const int gw = C.vcu * NWAVES + C.wave, NGW = C.G * NWAVES;
    bf16_t* XN = (bf16_t*)(C.p.ws + WS_XN); const float* MODb = (const float*)(C.p.ws + WS_MOD) + (size_t)layer * 9 * 6144;
    for (int m = gw; m < nrows; m += NGW) {
        const float* xr = m < ML ? xl + (size_t)m * D : xc + (size_t)(m - ML) * D;
        const float* mod = MODb + (size_t)modidx_of(m) * 6144;
        f32x4 v[4]; float ss = 0.f;
#pragma unroll
        for (int j = 0; j < 4; ++j) { v[j] = *(const f32x4*)(xr + 4 * C.lane + 256 * j);
            if (m >= ML && nslab > 0) { for (int s_ = 0; s_ < nslab; ++s_) v[j] += *(const f32x4*)(slab + (size_t)s_ * MC * D + (size_t)(m - ML) * D + 4 * C.lane + 256 * j);
                if (xc_wb) *(f32x4*)(xc_wb + (size_t)(m - ML) * D + 4 * C.lane + 256 * j) = v[j]; }
            ss += (v[j][0] * v[j][0] + v[j][1] * v[j][1]) + (v[j][2] * v[j][2] + v[j][3] * v[j][3]); }
        ss = wave_sum(ss);
        const float r = rsqrtf(ss * (1.f / D) + EPS);
#pragma unroll
        for (int j = 0; j < 4; ++j) { const int c = 4 * C.lane + 256 * j;
            const f32x4 g = *(const f32x4*)(gain + c), sc = *(const f32x4*)(mod + sc_chunk * D + c), sh = *(const f32x4*)(mod + sh_chunk * D + c);
            const f32x4 y = ((v[j] * r) * g) * (sc + 1.f) + sh;
            uint2 o; o.x = pk2(y[0], y[1]); o.y = pk2(y[2], y[3]);
            *(uint2*)(XN + (size_t)m * D + c) = o; }
    }
}

__device__ __forceinline__ void phase_pool(Ctx& C) {
    const bf16_t* A0 = (const bf16_t*)(C.p.ws + WS_A0); bf16_t* MIX = (bf16_t*)(C.p.ws + WS_MIX);
    const int gt = C.vcu * NTHR + C.tid, NGT = C.G * NTHR;
    for (int it = gt; it < MT * 32; it += NGT) {
        const int m = it >> 5, c8 = (it & 31) * 8, g = c8 >> 6, w = 2 << g;
        int t, T; if (m < ML) { t = m % S; T = S; } else { t = (m - ML) % CTX; T = CTX; }
        const int base = m - t; int lo = t - w / 2; if (lo < 0) lo = 0; int hi = t - w / 2 + w; if (hi > T) hi = T;
        float s[8];
#pragma unroll
        for (int e = 0; e < 8; ++e) s[e] = 0.f;
        for (int j = lo; j < hi; ++j) { const v4u q = *(const v4u*)(A0 + (size_t)(base + j) * 256 + c8);
#pragma unroll
            for (int e = 0; e < 4; ++e) { s[2 * e] += __uint_as_float(q[e] << 16); s[2 * e + 1] += __uint_as_float(q[e] & 0xffff0000u); } }
        const v4u q = *(const v4u*)(A0 + (size_t)m * 256 + c8); const float inv = 1.f / (float)(hi - lo);
        v4u o;
#pragma unroll
        for (int e = 0; e < 4; ++e) o[e] = pk2(s[2 * e] * inv - __uint_as_float(q[e] << 16), s[2 * e + 1] * inv - __uint_as_float(q[e] & 0xffff0000u));
        *(v4u*)(MIX + (size_t)m * D + c8) = o;
    }
}

__device__ __forceinline__ void phase_attn0(Ctx& C) {
    const Params& p = C.p;
    MLAS char* shm = (MLAS char*)C.lds;
    att::UnitDesc U; U.Q = (const bf16_t*)(p.ws + WS_Q0); U.qpitch = 768; U.K = (const bf16_t*)(p.ws + WS_K0); U.kpitch = 256; U.V = (const bf16_t*)(p.ws + WS_V0); U.vpitch = 256;
    U.O = (bf16_t*)(p.ws + WS_MIX); U.opitch = D; U.rg = 0; U.rmin = 0; U.head = 0;
    for (int u = C.vcu; u < 768 + 96; u += C.G) {
        if (u < 768) { const int qb = u & 7, bh = u >> 3, h = bh % 12, b = bh / 12;
            U.q0 = (long)b * S + 256 * qb; U.qcol = h * 64; U.kcol = (h / 3) * 64; U.vcol = (h / 3) * 64; U.ocol = 256 + h * 64; U.kv0 = b * SK; U.nt = SK / 64; }
        else { const int bh = u - 768, h = bh % 12, b = bh / 12;
            U.q0 = (long)ML + 256 * b; U.qcol = h * 64; U.kcol = (h / 3) * 64; U.vcol = (h / 3) * 64; U.ocol = 256 + h * 64; U.kv0 = b * SK; U.nt = CTX / 64; }
        att::attn_unit<64, false, false>(U, shm, nullptr, nullptr, nullptr);
    }
    phase_pool(C);
}
__device__ __forceinline__ void phase_attn1(Ctx& C) {
    const Params& p = C.p;
    MLAS char* shm = (MLAS char*)C.lds;
    const float* T16 = (const float*)(p.ws + WS_ROPE16);
    att::UnitDesc U; U.O = (bf16_t*)(p.ws + WS_MIX); U.opitch = D;
    for (int u = C.vcu; u < 1024; u += C.G) {
        const int uu = u & 511, qb = uu & 7, h = (uu >> 3) & 7, b = uu >> 6;
        U.q0 = (long)b * S + 256 * qb; U.kv0 = b * SK; U.head = h;
        if (u < 512) {
            U.Q = (const bf16_t*)(p.ws + WS_MQ); U.qpitch = 768; U.qcol = h * 96; U.K = (const bf16_t*)(p.ws + WS_MK); U.kpitch = 768; U.kcol = h * 96;
            U.V = (const bf16_t*)(p.ws + WS_MV); U.vpitch = 512; U.vcol = h * 64; U.ocol = h * 64; U.nt = SK / 64; U.rg = 0; U.rmin = 0;
            att::attn_unit<96, false, true>(U, shm, p.in[I1_MQG], T16, nullptr);
        } else {
            U.Q = (const bf16_t*)(p.ws + WS_NQ); U.qpitch = 512; U.qcol = h * 64; U.K = (const bf16_t*)(p.ws + WS_NK); U.kpitch = 512; U.kcol = h * 64;
            U.V = (const bf16_t*)(p.ws + WS_NV); U.vpitch = 512; U.vcol = h * 64; U.ocol = 512 + h * 64; U.rg = qb;
            const int rmin = min(max(4 * qb - 4, 0), 24), rmax = min(max(4 * qb + 3 - 4, 0), 24) + 7;
            U.rmin = rmin; U.nt = 4 + (rmax - rmin + 1);
            att::attn_unit<64, true, false>(U, shm, nullptr, nullptr, p.in[I1_RPB]);
        }
    }
}

__global__ void __launch_bounds__(NTHR, 2) mega(Params p, int ph_lo, int ph_hi) {
    extern __shared__ __attribute__((aligned(16))) unsigned char lds_raw[];
    cg::grid_group grid = cg::this_grid();
    Ctx C; C.p = p; C.lds = (MLAS unsigned char*)lds_raw; C.tid = threadIdx.x; C.lane = C.tid & 63; C.wave = __builtin_amdgcn_readfirstlane(C.tid >> 6);
    C.G = gridDim.x; C.bid = blockIdx.x; C.vcu = (C.G % 8 == 0) ? (C.bid % 8) * (C.G / 8) + C.bid / 8 : C.bid;
    volatile LAS unsigned* bst = (volatile LAS unsigned*)(C.lds + LDS_BYTES - 64);
    if (C.tid < 2) bst[C.tid] = 0u;
    __syncthreads();
    unsigned* barw = (unsigned*)(p.ws + WS_BARRIER);
    XcdBarrier bar; bar.bar = barw; bar.x = 0; bar.st = nullptr;
    if (ph_hi - ph_lo > 1) bar = xcd_barrier_post(barw, bst);
    float* out = p.out; float* xrc = (float*)(p.ws + WS_XRC);
    const float* MOD = (const float*)(p.ws + WS_MOD);
    bf16_t* XN = (bf16_t*)(p.ws + WS_XN); bf16_t* MIX = (bf16_t*)(p.ws + WS_MIX); bf16_t* H = (bf16_t*)(p.ws + WS_H);
    const float* T32 = (const float*)(p.ws + WS_ROPE32); const float* T16 = (const float*)(p.ws + WS_ROPE16);
#define WSB(off) ((bf16_t*)(p.ws + (off)))
#ifndef PHMASK
#define PHMASK 0xFFFF
#endif
#ifndef REPMASK
#define REPMASK 0
#endif
#ifndef NSYNC
#define NSYNC 1
#endif
#define PH(k) if (((PHMASK >> (k)) & 1) && ph_lo <= (k) && (k) < ph_hi) for (int rep_ = 0; rep_ < (((REPMASK >> (k)) & 1) ? 2 : 1); ++rep_, (((REPMASK >> (k)) & 1) && rep_ == 1 ? xcd_barrier(bar) : (void)0))
#ifndef USE_CG_SYNC
#define USE_CG_SYNC 0
#endif
#define SEAM(k) if (ph_lo <= (k) && (k) + 1 < ph_hi) { for (int s_ = 0; s_ < NSYNC; ++s_) { if (USE_CG_SYNC || ph_hi > 1000) grid.sync(); else xcd_barrier(bar); } }
    PH(0) { phase_prologue(C); } SEAM(0);
    PH(1) { phase_norm(C, p.in[I_X], p.in[I_CTX], p.in[I0_NMIX], 0, 0, 1, MT); } SEAM(1);
    PH(2) { pg8::Gemm g{XN, WSB(WS_W_IN0), MT, 1536, D, D}; pg8::StaticOrder So; So.init(MT, 1536, C.G, C.bid);
        epi::EpiIn0 E{WSB(WS_A0), WSB(WS_Q0), WSB(WS_K0), WSB(WS_V0), p.in[I0_QG], p.in[I0_KG], T32};
        pg8::gemm_phase<epi::EpiIn0, pg8::StaticOrder, true, true>(C.lds, g, So, E); } SEAM(2);
    PH(3) { phase_attn0(C); } SEAM(3);
    PH(4) { { pg8::Gemm g{MIX, WSB(WS_W_OUT0), ML, D, D, D}; pg8::StaticOrder So; So.init(ML, D, C.G, C.bid);
          epi::EpiResid E{p.in[I_X], p.in[I_CTX], out, xrc, MOD + 2 * D};
          pg8::gemm_phase<epi::EpiResid, pg8::StaticOrder, true, true>(C.lds, g, So, E); }
        { pg8::Gemm g{MIX, WSB(WS_W_OUT0), MT, D, D / 4, D}; pg8::CtxSplitOrder So; So.init(4, C.G, C.bid);
          epi::EpiResidSplit E{p.in[I_CTX], xrc, (float*)(p.ws + WS_SLAB4), MOD + 2 * D};
          pg8::gemm_phase<epi::EpiResidSplit, pg8::CtxSplitOrder, true, true>(C.lds, g, So, E); } } SEAM(4);
    PH(5) { phase_norm(C, out, xrc, p.in[I0_NFFN], 0, 3, 4, MT, (const float*)(p.ws + WS_SLAB4), 3, xrc); } SEAM(5);
    PH(6) { pg8::Gemm g{XN, WSB(WS_W_GU0), MT, 2 * FF, D, D}; pg8::StaticOrder So; So.init(MT, 2 * FF, C.G, C.bid);
        epi::EpiSwiGLU E{H};
        pg8::gemm_phase<epi::EpiSwiGLU, pg8::StaticOrder, true, true>(C.lds, g, So, E); } SEAM(6);
    PH(7) { { pg8::Gemm g{H, WSB(WS_W_D0), ML, D, FF, FF}; pg8::StaticOrder So; So.init(ML, D, C.G, C.bid);
          epi::EpiResid E{out, xrc, out, xrc, MOD + 5 * D};
          pg8::gemm_phase<epi::EpiResid, pg8::StaticOrder, true, true>(C.lds, g, So, E); }
        { pg8::Gemm g{H, WSB(WS_W_D0), MT, D, FF / 2, FF}; pg8::CtxSplitOrder So; So.init(2, C.G, C.bid);
          epi::EpiResidSplit E{xrc, xrc, (float*)(p.ws + WS_SLAB7), MOD + 5 * D};
          pg8::gemm_phase<epi::EpiResidSplit, pg8::CtxSplitOrder, true, true>(C.lds, g, So, E); } } SEAM(7);
    PH(8) { phase_norm(C, out, xrc, p.in[I1_NMIX], 1, 0, 1, MT, (const float*)(p.ws + WS_SLAB7), 1, nullptr); } SEAM(8);
    PH(9) { pg8::Gemm g{XN, WSB(WS_W_IN1), MT, L1_INP, D, D}; pg8::StaticOrder So; So.init(MT, L1_INP, C.G, C.bid);
        epi::EpiIn1 E{WSB(WS_CQ), WSB(WS_CKV), WSB(WS_NQ), WSB(WS_NK), WSB(WS_NV), (float*)(p.ws + WS_KR), (float*)(p.ws + WS_SSQ), (float*)(p.ws + WS_SSKV), p.in[I1_NQG], p.in[I1_NKG]};
        pg8::gemm_phase<epi::EpiIn1, pg8::StaticOrder, true, true>(C.lds, g, So, E); } SEAM(9);
    PH(10) {
#ifndef NO_QUP
        { pg8::Gemm g{WSB(WS_CQ), WSB(WS_W_UQ), ML, 768, 384, 384}; pg8::StaticOrder So; So.init(ML, 768, C.G, C.bid);
          epi::EpiQUp E{WSB(WS_MQ), (const float*)(p.ws + WS_SSQ)};
          pg8::gemm_phase<epi::EpiQUp, pg8::StaticOrder, true, true>(C.lds, g, So, E); }
#endif
#ifndef NO_KVUP
        { pg8::Gemm g{WSB(WS_CKV), WSB(WS_W_UKV), MT, 1024, 256, 256}; pg8::StaticOrder So; So.init(MT, 1024, C.G, C.bid);
          epi::EpiKvUp E{WSB(WS_MK), WSB(WS_MV), (const float*)(p.ws + WS_SSKV), (const float*)(p.ws + WS_KR), p.in[I1_MKG], T16};
          pg8::gemm_phase<epi::EpiKvUp, pg8::StaticOrder, true, true>(C.lds, g, So, E); }
#endif
    } SEAM(10);
    PH(11) { phase_attn1(C); } SEAM(11);
    PH(12) { pg8::Gemm g{MIX, WSB(WS_W_OUT1), ML, D, D, D}; pg8::StaticOrder So; So.init(ML, D, C.G, C.bid);
        epi::EpiResid E{out, xrc, out, xrc, MOD + 9 * 6144 + 2 * D};
        pg8::gemm_phase<epi::EpiResid, pg8::StaticOrder, true, true>(C.lds, g, So, E); } SEAM(12);
    PH(13) { phase_norm(C, out, xrc, p.in[I1_NFFN], 1, 3, 4, ML); } SEAM(13);
    PH(14) { pg8::Gemm g{XN, WSB(WS_W_GU1), ML, 2 * FF, D, D}; pg8::StaticOrder So; So.init(ML, 2 * FF, C.G, C.bid);
        epi::EpiSwiGLU E{H};
        pg8::gemm_phase<epi::EpiSwiGLU, pg8::StaticOrder, true, true>(C.lds, g, So, E); } SEAM(14);
    PH(15) { pg8::Gemm g{H, WSB(WS_W_D1), ML, D, FF, FF}; pg8::StaticOrder So; So.init(ML, D, C.G, C.bid);
        epi::EpiResid E{out, xrc, out, xrc, MOD + 9 * 6144 + 5 * D};
        pg8::gemm_phase<epi::EpiResid, pg8::StaticOrder, true, true>(C.lds, g, So, E); }
    if (ph_hi - ph_lo > 1 && C.bid == 0 && C.tid == 0) { if (xb_ld(&barw[XB_TMO]) != 0u) out[0] = __builtin_nanf(""); }
#undef PH
#undef SEAM
#undef WSB
}
}
#ifndef MK_DEBUG
#define MK_DEBUG 0
#endif
static int g_grid = 0;
static bool mega_setup() {
    if (g_grid) return g_grid > 0;
    int dev = 0, cus = 0, per_cu = 0;
    if (hipGetDevice(&dev) != hipSuccess || hipDeviceGetAttribute(&cus, hipDeviceAttributeMultiprocessorCount, dev) != hipSuccess) { g_grid = -1; return false; }
    if (hipFuncSetAttribute((const void*)mk::mega, hipFuncAttributeMaxDynamicSharedMemorySize, mk::LDS_BYTES) != hipSuccess) { fprintf(stderr, "kernel_launch: hipFuncSetAttribute failed\n"); g_grid = -1; return false; }
    if (hipOccupancyMaxActiveBlocksPerMultiprocessor(&per_cu, (const void*)mk::mega, mk::NTHR, mk::LDS_BYTES) != hipSuccess || per_cu < 1) { fprintf(stderr, "kernel_launch: occupancy query says %d\n", per_cu); g_grid = -1; return false; }
    g_grid = cus;
    fprintf(stderr, "kernel_launch: %d CUs, occupancy %d blocks/CU, grid %d\n", cus, per_cu, g_grid);
    return true;
}
static void launch_phases(const Params& p, int lo, int hi, hipStream_t st) {
    Params pp = p; int l = lo, h = hi;
    void* args[] = {&pp, &l, &h};
    hipError_t e;
    if (hi - lo > 1) e = hipLaunchCooperativeKernel((const void*)mk::mega, dim3(g_grid), dim3(mk::NTHR), args, mk::LDS_BYTES, st);
    else e = hipLaunchKernel((const void*)mk::mega, dim3(g_grid), dim3(mk::NTHR), args, mk::LDS_BYTES, st);
    if (e != hipSuccess) fprintf(stderr, "kernel_launch: launch [%d,%d) failed: %s\n", lo, hi, hipGetErrorString(e));
}
#if MK_DEBUG
static void launch_debug(const Params& p, hipStream_t st) {
    using namespace nv;
    unsigned* err = (unsigned*)(p.ws + WS_CTL) + 64;
    float* out = p.out; float* xrc = (float*)(p.ws + WS_XRC);
    const float* x = p.in[I_X]; const float* cx = p.in[I_CTX];
    const size_t att_sm = 4 * (SK + 128) * sizeof(float);
    const int SR = 4096;
    float* snapL = (float*)(p.ws + WS_SNAP); float* snapC = snapL + (size_t)SR * D;
    float* snapB = (float*)(p.ws + WS_BIG);
    hipMemsetAsync(p.ws + WS_CTL, 0, WS_SSQ, st);
    launch_phases(p, 0, 1, st);  k_adaln<true><<<dim3(6144 / 256, 9, 2), 256, 0, st>>>(p, err + 0);
    launch_phases(p, 1, 2, st);  k_norm<true><<<MT / 4, 256, 0, st>>>(p, x, cx, I0_NMIX, 0, 0, 1, MT, err + 1);
    launch_phases(p, 2, 3, st);  k_in0<true><<<MT / R, 256, (R * D + R * L0_IN) * 4, st>>>(p, err + 2);
    launch_phases(p, 3, 4, st);  k_attn<true, 0><<<dim3(ML / 4, 12), 256, att_sm, st>>>(p, err + 3);
                                 k_attn<true, 1><<<dim3(MC / 4, 12), 256, att_sm, st>>>(p, err + 16);
                                 k_pool0<true><<<MT, 256, 0, st>>>(p, err + 17);
    launch_phases(p, 4, 5, st);  k_out<true, 0><<<MT / R, 256, (R * D + R * 256) * 4, st>>>(p, x, cx, out, xrc, 0, err + 4);
    launch_phases(p, 5, 6, st);  k_norm<true><<<MT / 4, 256, 0, st>>>(p, out, xrc, I0_NFFN, 0, 3, 4, MT, err + 5);
    launch_phases(p, 6, 7, st);  k_ffn_gu<true, 0><<<MT / R, 256, R * D * 4, st>>>(p, err + 6);
    hipMemcpyAsync(snapL, out, (size_t)SR * D * 4, hipMemcpyDeviceToDevice, st); hipMemcpyAsync(snapC, xrc, (size_t)MC * D * 4, hipMemcpyDeviceToDevice, st);
    launch_phases(p, 7, 8, st);  k_ffn_d<true, 0><<<SR / R, 256, R * FF * 4, st>>>(p, snapL, snapC, out, xrc, 0, err + 7);
                                 k_ffn_d<true, 0><<<MC / R, 256, R * FF * 4, st>>>(p, snapL, snapC, out, xrc, ML, err + 7);
    launch_phases(p, 8, 9, st);  k_norm<true><<<MT / 4, 256, 0, st>>>(p, out, xrc, I1_NMIX, 1, 0, 1, MT, err + 8);
    launch_phases(p, 9, 10, st); k_in1<true><<<MT / R, 256, (R * D + R * L1_IN) * 4, st>>>(p, err + 9);
    launch_phases(p, 10, 11, st); k_mlaq<true><<<ML / R, 256, R * 384 * 4, st>>>(p, err + 10);
                                 k_mlakv<true><<<MT / R, 256, (R * 256 + R * 1024) * 4, st>>>(p, err + 19);
    launch_phases(p, 11, 12, st); k_attn<true, 2><<<dim3(ML / 4, 8), 256, att_sm, st>>>(p, err + 11);
                                 k_attn<true, 3><<<dim3(ML / 4, 8), 256, att_sm, st>>>(p, err + 18);
    hipMemcpyAsync(snapB, out, (size_t)SR * D * 4, hipMemcpyDeviceToDevice, st);
    launch_phases(p, 12, 13, st); k_out<true, 1><<<SR / R, 256, (R * D + R * 256) * 4, st>>>(p, snapB, snapC, out, xrc, 0, err + 12);
    launch_phases(p, 13, 14, st); k_norm<true><<<ML / 4, 256, 0, st>>>(p, out, xrc, I1_NFFN, 1, 3, 4, ML, err + 13);
    launch_phases(p, 14, 15, st); k_ffn_gu<true, 1><<<ML / R, 256, R * D * 4, st>>>(p, err + 14);
    hipMemcpyAsync(snapL, out, (size_t)SR * D * 4, hipMemcpyDeviceToDevice, st);
    launch_phases(p, 15, 16, st); k_ffn_d<true, 1><<<SR / R, 256, R * FF * 4, st>>>(p, snapL, snapC, out, xrc, 0, err + 15);
    k_report<<<1, 1, 0, st>>>(p, 20, 0.15f);
}
#endif
extern "C" void kernel_launch(void* const* d_in, const int* in_sizes, int n_in, void* d_out, int out_size, void* d_ws, size_t ws_size, hipStream_t stream) {
    if (n_in != N_IN || out_size != ML * D || ws_size < WS_END) { fprintf(stderr, "kernel_launch: unexpected shapes n_in=%d out=%d ws=%zu\n", n_in, out_size, ws_size); return; }
    if (!mega_setup()) return;
    Params p{};
    for (int i = 0; i < N_IN; ++i) p.in[i] = (const float*)d_in[i];
    p.out = (float*)d_out; p.ws = (unsigned char*)d_ws;
#if MK_DEBUG
    launch_debug(p, stream);
#else
    if (hipMemsetAsync((char*)d_ws + WS_BARRIER, 0, WS_SSQ - WS_BARRIER, stream) != hipSuccess) { fprintf(stderr, "kernel_launch: memset failed\n"); return; }
    launch_phases(p, 0, mk::NPHASE, stream);
#endif
}
```

```cpp
#define USE_ATT64 1
#define USE_ATT96 1
#define ATT_STATIC_PRIO 1
#define L1_IN_P7 1
#define L0_SPLIT 1
#define CTXD_IN_P6 1
#include <hip/hip_runtime.h>
#include <hip/hip_cooperative_groups.h>
#include <cstdio>
#include <cstdint>
namespace cg = cooperative_groups;

typedef unsigned short bf16_t;
constexpr int D = 1024, NB = 8, S = 2048, CTX = 256, SK = S + CTX, ML = NB * S, MC = NB * CTX, MT = ML + MC, FF = 2816;
constexpr int GW = 64;
constexpr int L0_IN = 1536, L1_IN = 2208, L1_INP = 2304;
constexpr float EPS = 1e-6f;
constexpr float LOG2E = 1.4426950408889634f;
constexpr float C2_64 = 0.125f * LOG2E;
constexpr float C2_96 = 0.10206207261596577f * LOG2E;

enum { I_X = 0, I_C, I_CTX, I_CCTX,
       I0_ADAW, I0_ADAB, I0_NMIX, I0_NFFN, I0_WIN, I0_POOLW, I0_POOLS, I0_QG, I0_KG, I0_WOUT, I0_WG, I0_WU, I0_WD,
       I1_ADAW, I1_ADAB, I1_NMIX, I1_NFFN, I1_WIN, I1_QAG, I1_KVAG, I1_WUQ, I1_WUKV, I1_MQG, I1_MKG, I1_NQG, I1_NKG, I1_RPB, I1_WOUT, I1_WG, I1_WU, I1_WD, N_IN };

constexpr size_t MiB = 1u << 20;
constexpr size_t WS_CTL = 0;
constexpr size_t WS_BARRIER = 16 * 1024;
constexpr size_t WS_MOD = 64 * 1024;
constexpr size_t WS_SSQ = 512 * 1024;
constexpr size_t WS_SSKV = 600 * 1024;
constexpr size_t WS_ROPE32 = 700 * 1024;
constexpr size_t WS_ROPE16 = 712 * 1024;
constexpr size_t WS_W_IN0 = 1 * MiB;
constexpr size_t WS_W_OUT0 = 4 * MiB;
constexpr size_t WS_W_GU0 = 6 * MiB;
constexpr size_t WS_W_D0 = 17 * MiB;
constexpr size_t WS_W_IN1 = 23 * MiB;
constexpr size_t WS_W_UQ = 28 * MiB;
constexpr size_t WS_W_UKV = 29 * MiB;
constexpr size_t WS_W_OUT1 = 30 * MiB;
constexpr size_t WS_W_GU1 = 32 * MiB;
constexpr size_t WS_W_D1 = 43 * MiB;
constexpr size_t WS_XRC = 49 * MiB;
constexpr size_t WS_XN = 57 * MiB;
constexpr size_t WS_MIX = WS_XN;
constexpr size_t WS_BIG = 96 * MiB;
constexpr size_t WS_H = WS_BIG;
constexpr size_t WS_A0 = WS_BIG;
constexpr size_t WS_Q0 = WS_BIG + 9 * MiB;
constexpr size_t WS_K0 = WS_BIG + 36 * MiB;
constexpr size_t WS_V0 = WS_BIG + 45 * MiB;
constexpr size_t WS_CQ = WS_BIG;
constexpr size_t WS_CKV = WS_BIG + 14 * MiB;
constexpr size_t WS_NQ = WS_BIG + 23 * MiB;
constexpr size_t WS_NK = WS_BIG + 41 * MiB;
constexpr size_t WS_NV = WS_BIG + 59 * MiB;
constexpr size_t WS_MQ = WS_BIG + 77 * MiB;
constexpr size_t WS_MK = WS_BIG + 101 * MiB;
constexpr size_t WS_MV = WS_BIG + 128 * MiB;
constexpr size_t WS_KR = WS_BIG + 146 * MiB;
constexpr size_t WS_SLAB4 = WS_BIG;
constexpr size_t WS_SLAB7 = WS_BIG + 100 * MiB;
constexpr size_t WS_NAG = WS_BIG + 150 * MiB;
constexpr size_t WS_SNAP = WS_BIG + 100 * MiB;
constexpr size_t WS_END = 256 * MiB;
static_assert(WS_KR + (size_t)MT * 32 * 4 <= WS_END, "ws map");
static_assert(WS_W_D1 + (size_t)D * FF * 2 <= WS_XRC, "ws map");
static_assert(WS_XN + (size_t)MT * D * 2 <= WS_BIG, "ws map");

__device__ __forceinline__ float bf2f(bf16_t u) { return __uint_as_float((unsigned)u << 16); }
__device__ __forceinline__ bf16_t f2bf(float f) { unsigned u = __float_as_uint(f); return (bf16_t)((u + 0x7fffu + ((u >> 16) & 1u)) >> 16); }
__device__ __forceinline__ int kvrow_of(int m) { return m < ML ? (m / S) * SK + CTX + (m % S) : ((m - ML) / CTX) * SK + ((m - ML) % CTX); }
__device__ __forceinline__ int modidx_of(int m) { return m < ML ? m / S : 8; }
__device__ __forceinline__ float wave_sum(float v) {
#pragma unroll
    for (int o = 1; o < 64; o <<= 1) v += __shfl_xor(v, o);
    return v;
}
__device__ __forceinline__ float wave_max(float v) {
#pragma unroll
    for (int o = 1; o < 64; o <<= 1) v = fmaxf(v, __shfl_xor(v, o));
    return v;
}

struct Params {
    const float* in[N_IN];
    float* out;
    unsigned char* ws;
};
namespace pg8 {
#define PG8_LAS __attribute__((address_space(3)))
typedef unsigned short bf16_t;
typedef short bf16x8 __attribute__((ext_vector_type(8)));
typedef float f32x4 __attribute__((ext_vector_type(4)));
typedef unsigned u32x4 __attribute__((ext_vector_type(4)));
constexpr int BM = 256, BK = 64, HALF = 128, HTB = HALF * BK * 2  , STAGE_BYTES = 8 * HTB, NXCD = 8, WGM = 8;

__host__ __device__ __forceinline__ int lds_byte(int r, int c) { const int st = (r >> 4) * 2 + (c >> 5), rr = r & 15, cc = c & 31, ob = rr * 64 + cc * 2; return st * 1024 + (ob ^ (((ob >> 9) & 1) << 5)); }
__host__ __device__ __forceinline__ void stage_rc(int b, int& R, int& C) { const int st = b / 1024, sb = b % 1024, swz = sb ^ (((sb >> 9) & 1) << 5); R = (st >> 1) * 16 + swz / 64; C = (st & 1) * 32 + (swz % 64) / 2; }
__host__ __device__ __forceinline__ int perm32(int rho) { const int n = rho >> 4, i = rho & 15; return 8 * (i >> 2) + 4 * n + (i & 3); }

struct Unit { int pm, pn, ks; };
struct Gemm { const bf16_t* A; const bf16_t* Bt; int M, N, K, ld; };

struct StaticOrder {
    int nM, nN, nwg, G, c;
    __host__ __device__ void init(int M, int N, int G_, int c_) { nM = M / BM; nN = N / BM; nwg = nM * nN; G = G_; c = c_; }
    __host__ __device__ bool next(int i, Unit& u) const {
        const long L = (long)i * G + c; if (L >= nwg) return false;
        int wgid = (int)L; { const int q = nwg / NXCD, r = nwg % NXCD, xcd = wgid % NXCD, off = wgid / NXCD; wgid = (xcd < r ? xcd * (q + 1) : r * (q + 1) + (xcd - r) * q) + off; }
        const int nig = WGM * nN, gid = wgid / nig, fm = gid * WGM, gsz = (nM - fm) < WGM ? (nM - fm) : WGM;
        u.pm = fm + ((wgid % nig) % gsz); u.pn = (wgid % nig) / gsz; u.ks = 0; return true;
    }
    __device__ __forceinline__ void a_ready(const Unit&) const {}
    __device__ __forceinline__ void done(const Unit&) const {}
};

__device__ __forceinline__ unsigned cvt_pk_bf16(float lo, float hi) { unsigned r; asm volatile("v_cvt_pk_bf16_f32 %0, %1, %2" : "=v"(r) : "v"(lo), "v"(hi)); return r; }
typedef float f32x2 __attribute__((ext_vector_type(2)));
struct CtxSplitOrder {
    int G, c, split;
    __host__ __device__ void init(int split_, int G_, int c_) { split = split_; G = G_; c = c_; }
    __host__ __device__ bool next(int i, Unit& u) const {
        const int L = i * G + c; if (L >= 32 * split) return false;
        u.ks = L % split; const int t = L / split; u.pn = t & 3; u.pm = 64 + (t >> 2); return true;
    }
    __device__ __forceinline__ void a_ready(const Unit&) const {}
    __device__ __forceinline__ void done(const Unit&) const {}
};
struct CtxFirstOrder {
    int c, mode; StaticOrder lat;
    __host__ __device__ void init(int mode_, int c_) { mode = mode_; c = c_; lat.init(64 * BM, 22 * BM, 1 << 28, 0); }
    __host__ __device__ bool next(int i, Unit& u) const {
        if (mode == 0) { if (i != 0 || c < 80) return false; const int j = c - 80; u.pm = 64 + (j & 7); u.pn = j >> 3; u.ks = 0; return true; }
        const int Lp = c < 80 ? (i == 0 ? c : 80 + (i - 1) * 256 + c) : 80 + i * 256 + c;
        if (Lp >= 1408) return false;
        StaticOrder t = lat; t.c = Lp; return t.next(0, u);
    }
    __device__ __forceinline__ void a_ready(const Unit&) const {}
    __device__ __forceinline__ void done(const Unit&) const {}
};
template <class Epi, class Sched, bool ALIGN_EPI = false, bool SP2 = false>
__device__ __forceinline__ void gemm_phase(PG8_LAS unsigned char* lds, const Gemm g, const Sched& S, const Epi& E) {
    int tid_ = threadIdx.x; asm volatile("" : "+v"(tid_));
    const int tid = tid_, wid = __builtin_amdgcn_readfirstlane(tid >> 6), lane = tid & 63, wr = wid >> 2, wc = wid & 3, fr = lane & 15, fq = lane >> 4;
    int K_ = g.K; asm volatile("" : "+s"(K_));
    const int K = K_, nt = K / BK; int LD_ = g.ld; asm volatile("" : "+s"(LD_)); const int LD = LD_;
    unsigned voffA[2], voffB[2];
#pragma unroll
    for (int i = 0; i < 2; ++i) { int R, C; stage_rc(tid * 16 + i * 8192, R, C); const int Rb = Epi::PERM ? ((R & ~31) + perm32(R & 31)) : R;
        voffA[i] = (unsigned)(R * LD + C) * 2u; voffB[i] = (unsigned)(Rb * LD + C) * 2u; }
    const size_t kstep = (size_t)(BK * 2);
    const size_t hstep = (size_t)HALF * LD * 2;
    const size_t tstep = 2 * hstep;
    const unsigned ldsw = (unsigned)wid * 1024u;
    const int aoff = lds_byte(wr * 64 + fr, fq * 8), boff = lds_byte(wc * 32 + fr, fq * 8);
#define PG8_SA(b, h) (((b) * 2 + (h)) * HTB)
#define PG8_SB(b, h) ((4 + (b) * 2 + (h)) * HTB)
#define PG8_STAGE(bufoff, gbase, voff) do { _Pragma("unroll") for (int _i = 0; _i < 2; ++_i) \
        __builtin_amdgcn_global_load_lds((const unsigned*)((const char*)(gbase) + (voff)[_i]), (PG8_LAS unsigned*)(lds + (bufoff) + ldsw + _i * 8192), 16, 0, 0); } while (0)
#define PG8_LDA(dst, b, h) do { _Pragma("unroll") for (int m = 0; m < 4; ++m) _Pragma("unroll") for (int k = 0; k < 2; ++k) dst[m][k] = *(const PG8_LAS bf16x8*)(lds + PG8_SA(b, h) + aoff + m * 2048 + k * 1024); } while (0)
#define PG8_LDB(dst, b, h) do { _Pragma("unroll") for (int n = 0; n < 2; ++n) _Pragma("unroll") for (int k = 0; k < 2; ++k) dst[n][k] = *(const PG8_LAS bf16x8*)(lds + PG8_SB(b, h) + boff + n * 2048 + k * 1024); } while (0)
#define PG8_MMA(ai, bj, At, Bt) do { __builtin_amdgcn_s_setprio(1); _Pragma("unroll") for (int m = 0; m < 4; ++m) _Pragma("unroll") for (int n = 0; n < 2; ++n) _Pragma("unroll") for (int k = 0; k < 2; ++k) \
        acc[ai][bj][m][n] = __builtin_amdgcn_mfma_f32_16x16x32_bf16(Bt[n][k], At[m][k], acc[ai][bj][m][n], 0, 0, 0); __builtin_amdgcn_s_setprio(0); } while (0)
#define PG8_WAIT_V(n) asm volatile("s_waitcnt vmcnt(" #n ")" ::: "memory")
#define PG8_WAIT_L(n) asm volatile("s_waitcnt lgkmcnt(" #n ")" ::: "memory")
#define PG8_BAR __builtin_amdgcn_s_barrier()
#define PG8_SCHED __builtin_amdgcn_sched_barrier(0)
    Unit cur, nxt; int ui = 0;
    if (!S.next(0, cur)) return;
    f32x4 acc[2][2][4][2];
#pragma unroll
    for (int a = 0; a < 2; ++a)
#pragma unroll
        for (int b = 0; b < 2; ++b)
#pragma unroll
            for (int m = 0; m < 4; ++m)
#pragma unroll
                for (int n = 0; n < 2; ++n) acc[a][b][m][n] = (f32x4){0.f, 0.f, 0.f, 0.f};
    bf16x8 At[4][2], B0[2][2], B1[2][2];
    const char* cA = (const char*)g.A + (size_t)cur.pm * tstep + (size_t)cur.ks * K * 2; const char* cB = (const char*)g.Bt + (size_t)cur.pn * tstep + (size_t)cur.ks * K * 2;
    S.a_ready(cur);
    if constexpr (SP2) {
        PG8_STAGE(PG8_SB(0, 0), cB, voffB); PG8_STAGE(PG8_SB(0, 1), cB + hstep, voffB); PG8_STAGE(PG8_SA(0, 0), cA, voffA); PG8_STAGE(PG8_SA(0, 1), cA + hstep, voffA);
        if (wr == 1) PG8_BAR;
        PG8_WAIT_V(2); PG8_BAR;
        PG8_STAGE(PG8_SB(1, 0), cB + kstep, voffB); PG8_STAGE(PG8_SA(1, 0), cA + kstep, voffA); PG8_STAGE(PG8_SB(1, 1), cB + hstep + kstep, voffB);
        PG8_WAIT_V(6); PG8_BAR;
    } else {
        PG8_STAGE(PG8_SB(0, 0), cB, voffB); PG8_STAGE(PG8_SA(0, 0), cA, voffA); PG8_STAGE(PG8_SB(0, 1), cB + hstep, voffB); PG8_STAGE(PG8_SA(0, 1), cA + hstep, voffA);
        if (wr == 1) PG8_BAR;
        PG8_WAIT_V(4); PG8_BAR;
        PG8_STAGE(PG8_SB(1, 0), cB + kstep, voffB); PG8_STAGE(PG8_SA(1, 0), cA + kstep, voffA); PG8_STAGE(PG8_SB(1, 1), cB + hstep + kstep, voffB);
        PG8_WAIT_V(6); PG8_BAR;
    }
    for (;;) {
        const bool has_next = S.next(ui + 1, nxt);
        const char* nA = has_next ? (const char*)g.A + (size_t)nxt.pm * tstep + (size_t)nxt.ks * K * 2 : cA; const char* nB = has_next ? (const char*)g.Bt + (size_t)nxt.pn * tstep + (size_t)nxt.ks * K * 2 : cB;
        for (int t = 0; t < nt; t += 2) {
            const bool last = (t == nt - 2);
            const char* a1 = cA + (size_t)(t + 1) * kstep;
            const char* a2 = last ? nA : cA + (size_t)(t + 2) * kstep; const char* b2 = last ? nB : cB + (size_t)(t + 2) * kstep;
            const char* a3 = a2 + kstep; const char* b3 = b2 + kstep;
            if (last && has_next) S.a_ready(nxt);
            if constexpr (SP2) {
            PG8_LDB(B0, 0, 0); PG8_LDB(B1, 0, 1); PG8_SCHED; PG8_LDA(At, 0, 0); PG8_STAGE(PG8_SA(1, 1), a1 + hstep, voffA);
            PG8_WAIT_V(8); PG8_WAIT_L(0); PG8_BAR; PG8_MMA(0, 0, At, B0); PG8_MMA(0, 1, At, B1); PG8_BAR; PG8_SCHED;
            PG8_LDA(At, 0, 1); PG8_STAGE(PG8_SB(0, 0), b2, voffB); PG8_STAGE(PG8_SB(0, 1), b2 + hstep, voffB); PG8_STAGE(PG8_SA(0, 0), a2, voffA);
            PG8_WAIT_V(8); PG8_WAIT_L(0); PG8_BAR; PG8_MMA(1, 0, At, B0); PG8_MMA(1, 1, At, B1); PG8_BAR; PG8_SCHED;
            PG8_LDB(B0, 1, 0); PG8_LDB(B1, 1, 1); PG8_SCHED; PG8_LDA(At, 1, 0); PG8_STAGE(PG8_SA(0, 1), a2 + hstep, voffA);
            PG8_WAIT_V(8); PG8_WAIT_L(0); PG8_BAR; PG8_MMA(0, 0, At, B0); PG8_MMA(0, 1, At, B1); PG8_BAR; PG8_SCHED;
            PG8_LDA(At, 1, 1); PG8_STAGE(PG8_SB(1, 0), b3, voffB); PG8_STAGE(PG8_SB(1, 1), b3 + hstep, voffB); PG8_STAGE(PG8_SA(1, 0), a3, voffA);
            PG8_WAIT_V(8); PG8_WAIT_L(0); PG8_BAR; PG8_MMA(1, 0, At, B0); PG8_MMA(1, 1, At, B1); PG8_BAR; PG8_SCHED;
            } else {
            PG8_LDB(B0, 0, 0); PG8_SCHED; PG8_LDA(At, 0, 0); PG8_STAGE(PG8_SA(1, 1), a1 + hstep, voffA);
            PG8_WAIT_L(8); PG8_BAR; PG8_WAIT_L(0); PG8_MMA(0, 0, At, B0); PG8_BAR; PG8_SCHED;
            PG8_LDB(B1, 0, 1); PG8_STAGE(PG8_SB(0, 0), b2, voffB);
            PG8_BAR; PG8_WAIT_L(0); PG8_MMA(0, 1, At, B1); PG8_BAR;
            PG8_LDA(At, 0, 1); PG8_STAGE(PG8_SA(0, 0), a2, voffA);
            PG8_BAR; PG8_WAIT_L(0); PG8_MMA(1, 0, At, B0); PG8_BAR; PG8_SCHED;
            PG8_STAGE(PG8_SB(0, 1), b2 + hstep, voffB);
            PG8_WAIT_V(6); PG8_BAR; PG8_MMA(1, 1, At, B1); PG8_BAR;
            PG8_LDB(B0, 1, 0); PG8_SCHED; PG8_LDA(At, 1, 0); PG8_STAGE(PG8_SA(0, 1), a2 + hstep, voffA);
            PG8_WAIT_L(8); PG8_BAR; PG8_WAIT_L(0); PG8_MMA(0, 0, At, B0); PG8_BAR; PG8_SCHED;
            PG8_LDB(B1, 1, 1); PG8_STAGE(PG8_SB(1, 0), b3, voffB);
            PG8_BAR; PG8_WAIT_L(0); PG8_MMA(0, 1, At, B1); PG8_BAR;
            PG8_LDA(At, 1, 1); PG8_STAGE(PG8_SA(1, 0), a3, voffA);
            PG8_BAR; PG8_WAIT_L(0); PG8_MMA(1, 0, At, B0); PG8_BAR; PG8_SCHED;
            PG8_STAGE(PG8_SB(1, 1), b3 + hstep, voffB);
            PG8_WAIT_V(6); PG8_BAR; PG8_MMA(1, 1, At, B1); PG8_BAR;
            }
        }
        if constexpr (ALIGN_EPI) { if (wr == 0) PG8_BAR; }
        if constexpr (!Epi::AFTER_DRAIN) { E(acc, cur, wr, wc, fr, fq); S.done(cur); }
        if (!has_next) break;
#pragma unroll
        for (int a = 0; a < 2; ++a)
#pragma unroll
            for (int b = 0; b < 2; ++b)
#pragma unroll
                for (int m = 0; m < 4; ++m)
#pragma unroll
                    for (int n = 0; n < 2; ++n) acc[a][b][m][n] = (f32x4){0.f, 0.f, 0.f, 0.f};
        cur = nxt; cA = nA; cB = nB; ++ui;
        if constexpr (ALIGN_EPI) { if (wr == 1) PG8_BAR; }
    }
    PG8_WAIT_V(0);
    if constexpr (!ALIGN_EPI) { if (wr == 0) PG8_BAR; }
    PG8_BAR;
    if constexpr (Epi::AFTER_DRAIN) { E.fused(acc, cur, wr, wc, fr, fq, lds, wid, lane); S.done(cur); }
#undef PG8_SA
#undef PG8_SB
#undef PG8_STAGE
#undef PG8_LDA
#undef PG8_LDB
#undef PG8_MMA
#undef PG8_WAIT_V
#undef PG8_WAIT_L
#undef PG8_BAR
#undef PG8_SCHED
}
}
namespace epi {
using pg8::f32x4; using pg8::Unit;
typedef unsigned u32x2 __attribute__((ext_vector_type(2)));
typedef unsigned u32x4 __attribute__((ext_vector_type(4)));
typedef float f32x2 __attribute__((ext_vector_type(2)));
typedef __bf16 bf16x2_t __attribute__((ext_vector_type(2)));
__device__ __forceinline__ unsigned pk(float lo, float hi) { f32x2 v = {lo, hi}; bf16x2_t b = __builtin_convertvector(v, bf16x2_t); return __builtin_bit_cast(unsigned, b); }
__device__ __forceinline__ u32x2 pk4(f32x4 v) { u32x2 w; w.x = pk(v[0], v[1]); w.y = pk(v[2], v[3]); return w; }
__device__ __forceinline__ float sum4sq(f32x4 v) { return (v[0] * v[0] + v[1] * v[1]) + (v[2] * v[2] + v[3] * v[3]); }
__device__ __forceinline__ float quad_sum(float s) { s += __shfl_xor(s, 16); s += __shfl_xor(s, 32); return s; }

__device__ __forceinline__ void st32(bf16_t* base32, f32x4 v0, f32x4 v1, int fq) {
    u32x2 a = pk4(v0), b = pk4(v1);
    { auto r = __builtin_amdgcn_permlane16_swap(a.x, b.x, false, false); a.x = r[0]; b.x = r[1]; }
    { auto r = __builtin_amdgcn_permlane16_swap(a.y, b.y, false, false); a.y = r[0]; b.y = r[1]; }
    u32x4 w; w.x = a.x; w.y = a.y; w.z = b.x; w.w = b.y;
    *(u32x4*)(base32 + 16 * (fq & 1) + 8 * (fq >> 1)) = w;
}

__device__ __forceinline__ int kvbase_of(int pm) { return pm < 64 ? (pm >> 3) * SK + CTX + (pm & 7) * 256 : (pm - 64) * SK; }
__device__ __forceinline__ int modidx_pm(int pm) { return pm < 64 ? (pm >> 3) : 8; }

__device__ __forceinline__ void head_finish(f32x4 (&v)[2][2], const float* gain, bool rope, const float* T32, int grow, int gcol, float scale, int fq) {
    float ss = (sum4sq(v[0][0]) + sum4sq(v[0][1])) + (sum4sq(v[1][0]) + sum4sq(v[1][1]));
    ss = quad_sum(ss);
    const float rn = rsqrtf(ss * (1.f / 64.f) + EPS);
#pragma unroll
    for (int bj = 0; bj < 2; ++bj)
#pragma unroll
        for (int n = 0; n < 2; ++n) { const f32x4 g = *(const f32x4*)(gain + 32 * bj + 16 * n + 4 * fq); v[bj][n] = (v[bj][n] * rn) * g; }
    if (rope) {
#pragma unroll
        for (int bj = 0; bj < 2; ++bj) { const int pos = bj ? gcol : grow;
            const f32x4 cs = *(const f32x4*)(T32 + pos * 16 + 4 * fq), sn = *(const f32x4*)(T32 + 1024 + pos * 16 + 4 * fq);
            const f32x4 x1 = v[bj][0], x2 = v[bj][1];
            v[bj][0] = x1 * cs - x2 * sn; v[bj][1] = x1 * sn + x2 * cs; }
    }
#pragma unroll
    for (int bj = 0; bj < 2; ++bj)
#pragma unroll
        for (int n = 0; n < 2; ++n) v[bj][n] = v[bj][n] * scale;
}

struct EpiIn0 {
    static constexpr bool PERM = false, AFTER_DRAIN = false;
    bf16_t *A0, *Q0, *K0, *V0; const float *qg, *kg, *T32;
    __device__ __forceinline__ void operator()(const f32x4 (&acc)[2][2][4][2], const Unit& u, int wr, int wc, int fr_in, int fq_in) const {
        int fr = fr_in, fq = fq_in; asm volatile("" : "+v"(fr), "+v"(fq));
        const int pn = u.pn, pm = u.pm; const bool lat = pm < 64; const int kvb = kvbase_of(pm);
#pragma unroll
        for (int ai = 0; ai < 2; ++ai)
#pragma unroll
            for (int m = 0; m < 4; ++m) {
                const int rl = 128 * ai + 64 * wr + 16 * m + fr; const size_t r = (size_t)pm * 256 + rl;
                if (pn == 0 || pn == 5) {
                    bf16_t* dst = pn == 0 ? A0 + r * 256 : V0 + (size_t)(kvb + rl) * 256;
#pragma unroll
                    for (int bj = 0; bj < 2; ++bj)
                        st32(dst + 64 * wc + 32 * bj, acc[ai][bj][m][0], acc[ai][bj][m][1], fq);
                } else {
                    f32x4 v[2][2] = {{acc[ai][0][m][0], acc[ai][0][m][1]}, {acc[ai][1][m][0], acc[ai][1][m][1]}};
                    const int grow = (pm & 7) * 4 + 2 * ai + wr, gcol = 16 * m + fr;
                    bf16_t* dst;
                    if (pn < 4) { head_finish(v, qg, lat, T32, grow, gcol, C2_64, fq); dst = Q0 + r * 768 + ((pn - 1) * 4 + wc) * 64; }
                    else { head_finish(v, kg, lat, T32, grow, gcol, 1.0f, fq); dst = K0 + (size_t)(kvb + rl) * 256 + wc * 64; }
#pragma unroll
                    for (int bj = 0; bj < 2; ++bj)
                        st32(dst + 32 * bj, v[bj][0], v[bj][1], fq);
                }
            }
    }
};

struct EpiResid {
    static constexpr bool PERM = false, AFTER_DRAIN = false;
    const float *base_l, *base_c; float *out_l, *out_c; const float* mod;
    __device__ __forceinline__ void operator()(const f32x4 (&acc)[2][2][4][2], const Unit& u, int wr, int wc, int fr_in, int fq_in) const {
        int fr = fr_in, fq = fq_in; asm volatile("" : "+v"(fr), "+v"(fq));
        const int pm = u.pm; const bool lat = pm < 64;
        const float* bp = lat ? base_l + (size_t)pm * 256 * D : base_c + (size_t)(pm - 64) * 256 * D;
        float* op = lat ? out_l + (size_t)pm * 256 * D : out_c + (size_t)(pm - 64) * 256 * D;
        const float* gp = mod + (size_t)modidx_pm(pm) * 6144 + u.pn * 256 + 32 * wc + 4 * fq;
        f32x4 g[2][2];
#pragma unroll
        for (int bj = 0; bj < 2; ++bj)
#pragma unroll
            for (int n = 0; n < 2; ++n) g[bj][n] = *(const f32x4*)(gp + 128 * bj + 16 * n);
#pragma unroll
        for (int ai = 0; ai < 2; ++ai)
#pragma unroll
            for (int m = 0; m < 4; ++m) { const size_t off = (size_t)(128 * ai + 64 * wr + 16 * m + fr) * D + u.pn * 256 + 32 * wc + 4 * fq;
#pragma unroll
                for (int bj = 0; bj < 2; ++bj)
#pragma unroll
                    for (int n = 0; n < 2; ++n) { const f32x4 b = *(const f32x4*)(bp + off + 128 * bj + 16 * n); *(f32x4*)(op + off + 128 * bj + 16 * n) = b + g[bj][n] * acc[ai][bj][m][n]; } }
    }
};

struct EpiResidSplit {
    static constexpr bool PERM = false, AFTER_DRAIN = false;
    const float* base_c; float* out_c; float* slab; const float* mod; int ks_base = 0;
    __device__ __forceinline__ void operator()(const f32x4 (&acc)[2][2][4][2], const Unit& u_in, int wr, int wc, int fr_in, int fq_in) const {
        int fr = fr_in, fq = fq_in; asm volatile("" : "+v"(fr), "+v"(fq));
        Unit u = u_in; u.ks += ks_base;
        const int pm = u.pm - 64;
        const float* bp = base_c + (size_t)pm * 256 * D;
        float* op = u.ks == 0 ? out_c + (size_t)pm * 256 * D : slab + (size_t)(u.ks - 1) * MC * D + (size_t)pm * 256 * D;
        const float* gp = mod + (size_t)8 * 6144 + u.pn * 256 + 32 * wc + 4 * fq;
        f32x4 g[2][2];
#pragma unroll
        for (int bj = 0; bj < 2; ++bj)
#pragma unroll
            for (int n = 0; n < 2; ++n) g[bj][n] = *(const f32x4*)(gp + 128 * bj + 16 * n);
#pragma unroll
        for (int ai = 0; ai < 2; ++ai)
#pragma unroll
            for (int m = 0; m < 4; ++m) { const size_t off = (size_t)(128 * ai + 64 * wr + 16 * m + fr) * D + u.pn * 256 + 32 * wc + 4 * fq;
#pragma unroll
                for (int bj = 0; bj < 2; ++bj)
#pragma unroll
                    for (int n = 0; n < 2; ++n) { f32x4 v = g[bj][n] * acc[ai][bj][m][n]; if (u.ks == 0) v += *(const f32x4*)(bp + off + 128 * bj + 16 * n); *(f32x4*)(op + off + 128 * bj + 16 * n) = v; } }
    }
};

struct EpiSwiGLU {
    static constexpr bool PERM = true, AFTER_DRAIN = false;
    bf16_t* H;
    __device__ __forceinline__ void operator()(const f32x4 (&acc)[2][2][4][2], const Unit& u, int wr, int wc, int fr_in, int fq_in) const {
        int fr = fr_in, fq = fq_in; asm volatile("" : "+v"(fr), "+v"(fq));
#pragma unroll
        for (int ai = 0; ai < 2; ++ai)
#pragma unroll
            for (int m = 0; m < 4; ++m) { const size_t r = (size_t)u.pm * 256 + 128 * ai + 64 * wr + 16 * m + fr;
                f32x4 h[2];
#pragma unroll
                for (int n = 0; n < 2; ++n) { const f32x4 g = acc[ai][0][m][n], up = acc[ai][1][m][n];
#pragma unroll
                    for (int e = 0; e < 4; ++e) h[n][e] = g[e] * __builtin_amdgcn_rcpf(1.f + __builtin_amdgcn_exp2f(-g[e] * LOG2E)) * up[e]; }
                u32x4 w; w.x = pk(h[0][0], h[0][1]); w.y = pk(h[0][2], h[0][3]); w.z = pk(h[1][0], h[1][1]); w.w = pk(h[1][2], h[1][3]);
                *(u32x4*)(H + r * FF + u.pn * 128 + 32 * wc + 8 * fq) = w; }
    }
};

struct EpiIn1 {
    static constexpr bool PERM = false, AFTER_DRAIN = false;
    bf16_t *CQ, *CKV, *NQ, *NK, *NV; float *KR, *SSQ, *SSKV; const float *nqg, *nkg;
    __device__ __forceinline__ void operator()(const f32x4 (&acc)[2][2][4][2], const Unit& u, int wr, int wc, int fr_in, int fq_in) const {
        int fr = fr_in, fq = fq_in; asm volatile("" : "+v"(fr), "+v"(fq));
        const int pn = u.pn, pm = u.pm; const int kvb = kvbase_of(pm);
#pragma unroll
        for (int ai = 0; ai < 2; ++ai)
#pragma unroll
            for (int m = 0; m < 4; ++m) {
                const int rl = 128 * ai + 64 * wr + 16 * m + fr; const size_t r = (size_t)pm * 256 + rl;
                if (pn == 0 || pn == 2) {
                    bf16_t* dst = pn == 0 ? CQ + r * 384 : CKV + r * 256; float ss = 0.f;
#pragma unroll
                    for (int bj = 0; bj < 2; ++bj)
                        { ss += sum4sq(acc[ai][bj][m][0]) + sum4sq(acc[ai][bj][m][1]); st32(dst + 128 * bj + 32 * wc, acc[ai][bj][m][0], acc[ai][bj][m][1], fq); }
                    ss = quad_sum(ss);
                    if (fq == 0) atomicAdd((pn == 0 ? SSQ : SSKV) + r, ss);
                } else if (pn == 1) {
                    float ss = 0.f;
                    { ss += sum4sq(acc[ai][0][m][0]) + sum4sq(acc[ai][0][m][1]); st32(CQ + r * 384 + 256 + 32 * wc, acc[ai][0][m][0], acc[ai][0][m][1], fq); }
                    ss = quad_sum(ss);
                    if (fq == 0) atomicAdd(SSQ + r, ss);
                    if (wc == 0) {
#pragma unroll
                        for (int n = 0; n < 2; ++n) *(f32x4*)(KR + r * 32 + 16 * n + 4 * fq) = acc[ai][1][m][n]; }
                } else if (pn >= 7) {
                    bf16_t* dst = NV + (size_t)(kvb + rl) * 512 + (pn - 7) * 256 + 64 * wc;
#pragma unroll
                    for (int bj = 0; bj < 2; ++bj)
                        st32(dst + 32 * bj, acc[ai][bj][m][0], acc[ai][bj][m][1], fq);
                } else {
                    f32x4 v[2][2] = {{acc[ai][0][m][0], acc[ai][0][m][1]}, {acc[ai][1][m][0], acc[ai][1][m][1]}};
                    bf16_t* dst;
                    if (pn < 5) { head_finish(v, nqg, false, nullptr, 0, 0, C2_64, fq); dst = NQ + r * 512 + ((pn - 3) * 4 + wc) * 64; }
                    else { head_finish(v, nkg, false, nullptr, 0, 0, 1.0f, fq); dst = NK + (size_t)(kvb + rl) * 512 + ((pn - 5) * 4 + wc) * 64; }
#pragma unroll
                    for (int bj = 0; bj < 2; ++bj)
                        st32(dst + 32 * bj, v[bj][0], v[bj][1], fq);
                }
            }
    }
};

struct EpiQUp {
    static constexpr bool PERM = true, AFTER_DRAIN = false;
    bf16_t* MQ; const float* SSQ;
    __device__ __forceinline__ void operator()(const f32x4 (&acc)[2][2][4][2], const Unit& u, int wr, int wc, int fr_in, int fq_in) const {
        int fr = fr_in, fq = fq_in; asm volatile("" : "+v"(fr), "+v"(fq));
#pragma unroll
        for (int ai = 0; ai < 2; ++ai)
#pragma unroll
            for (int m = 0; m < 4; ++m) { const size_t r = (size_t)u.pm * 256 + 128 * ai + 64 * wr + 16 * m + fr;
                const float rs = rsqrtf(SSQ[r] * (1.f / 384.f) + EPS);
#pragma unroll
                for (int bj = 0; bj < 2; ++bj) { const f32x4 a = acc[ai][bj][m][0] * rs, b = acc[ai][bj][m][1] * rs;
                    u32x4 w; w.x = pk(a[0], a[1]); w.y = pk(a[2], a[3]); w.z = pk(b[0], b[1]); w.w = pk(b[2], b[3]);
                    *(u32x4*)(MQ + r * 768 + u.pn * 256 + 128 * bj + 32 * wc + 8 * fq) = w; } }
    }
};

struct EpiKvUp {
    static constexpr bool PERM = false, AFTER_DRAIN = false;
    bf16_t *MK, *MV; const float *SSKV, *KR, *kg, *T16;
    __device__ __forceinline__ void operator()(const f32x4 (&acc)[2][2][4][2], const Unit& u, int wr, int wc, int fr_in, int fq_in) const {
        int fr = fr_in, fq = fq_in; asm volatile("" : "+v"(fr), "+v"(fq));
        const int pm = u.pm; const bool lat = pm < 64; const int kvb = kvbase_of(pm); const int head = 2 * u.pn + (wc >> 1); const bool isv = wc & 1;
        float rs[2][4];
#pragma unroll
        for (int ai = 0; ai < 2; ++ai)
#pragma unroll
            for (int m = 0; m < 4; ++m) rs[ai][m] = SSKV[(size_t)pm * 256 + 128 * ai + 64 * wr + 16 * m + fr];
#pragma unroll
        for (int ai = 0; ai < 2; ++ai)
#pragma unroll
            for (int m = 0; m < 4; ++m) rs[ai][m] = rsqrtf(rs[ai][m] * (1.f / 256.f) + EPS);
        if (isv) {
#pragma unroll
            for (int ai = 0; ai < 2; ++ai)
#pragma unroll
                for (int m = 0; m < 4; ++m) { const size_t kvr = (size_t)(kvb + 128 * ai + 64 * wr + 16 * m + fr);
#pragma unroll
                    for (int bj = 0; bj < 2; ++bj)
                        st32(MV + kvr * 512 + head * 64 + 32 * bj, acc[ai][bj][m][0] * rs[ai][m], acc[ai][bj][m][1] * rs[ai][m], fq); }
            return;
        }
        f32x4 gn[2][2]; f32x2 gr[4];
#pragma unroll
        for (int bj = 0; bj < 2; ++bj)
#pragma unroll
            for (int n = 0; n < 2; ++n) gn[bj][n] = *(const f32x4*)(kg + 32 * bj + 16 * n + 4 * fq);
#pragma unroll
        for (int j = 0; j < 4; ++j) gr[j] = *(const f32x2*)(kg + 64 + 8 * j + 2 * fq);
#pragma unroll
        for (int ai = 0; ai < 2; ++ai) {
            const int grow = (pm & 7) * 4 + 2 * ai + wr;
            f32x2 csr = {1.f, 1.f}, snr = {0.f, 0.f};
            if (lat) { csr = *(const f32x2*)(T16 + grow * 8 + 2 * fq); snr = *(const f32x2*)(T16 + 512 + grow * 8 + 2 * fq); }
#pragma unroll
            for (int m = 0; m < 4; ++m) {
                const int rl = 128 * ai + 64 * wr + 16 * m + fr; const size_t r = (size_t)pm * 256 + rl; const size_t kvr = (size_t)(kvb + rl);
                f32x2 k[4];
#pragma unroll
                for (int j = 0; j < 4; ++j) k[j] = *(const f32x2*)(KR + r * 32 + 8 * j + 2 * fq);
                f32x2 csc = {1.f, 1.f}, snc = {0.f, 0.f};
                if (lat) { const int gcol = 16 * m + fr; csc = *(const f32x2*)(T16 + gcol * 8 + 2 * fq); snc = *(const f32x2*)(T16 + 512 + gcol * 8 + 2 * fq); }
                f32x4 v[2][2];
#pragma unroll
                for (int bj = 0; bj < 2; ++bj)
#pragma unroll
                    for (int n = 0; n < 2; ++n) v[bj][n] = acc[ai][bj][m][n] * rs[ai][m];
                float ss = (sum4sq(v[0][0]) + sum4sq(v[0][1])) + (sum4sq(v[1][0]) + sum4sq(v[1][1]));
#pragma unroll
                for (int j = 0; j < 4; ++j) ss += k[j][0] * k[j][0] + k[j][1] * k[j][1];
                ss = quad_sum(ss);
                const float rr = rsqrtf(ss * (1.f / 96.f) + EPS);
#pragma unroll
                for (int bj = 0; bj < 2; ++bj)
                    st32(MK + kvr * 768 + head * 96 + 32 * bj, (v[bj][0] * rr) * gn[bj][0], (v[bj][1] * rr) * gn[bj][1], fq);
#pragma unroll
                for (int j = 0; j < 4; ++j) k[j] = (k[j] * rr) * gr[j];
                { const f32x2 x1 = k[0], x2 = k[1]; k[0] = x1 * csr - x2 * snr; k[1] = x1 * snr + x2 * csr; }
                { const f32x2 x1 = k[2], x2 = k[3]; k[2] = x1 * csc - x2 * snc; k[3] = x1 * snc + x2 * csc; }
#pragma unroll
                for (int j = 0; j < 4; ++j) *(unsigned*)(MK + kvr * 768 + head * 96 + 64 + 8 * j + 2 * fq) = pk(k[j][0], k[j][1]);
                if (m & 1) asm volatile("" ::: "memory");
            }
        }
    }
};
}
namespace att {
using bf16x8 = __attribute__((ext_vector_type(8))) short;
using s16x4 = __attribute__((ext_vector_type(4))) short;
using f32x16 = __attribute__((ext_vector_type(16))) float;
using u32x4 = __attribute__((ext_vector_type(4))) unsigned;
typedef float f32x2_t __attribute__((ext_vector_type(2))); typedef __bf16 bf16x2_t __attribute__((ext_vector_type(2)));
#define ALAS __attribute__((address_space(3)))
constexpr int KSLOT = 12288, VSLOT = 8192, SLOT = KSLOT + VSLOT, NSLOT = 4, PD = NSLOT - 2;
constexpr int LDS_WS = NSLOT * SLOT;
constexpr int LDS_OST = LDS_WS + 8 * 256;
constexpr int LDS_RPB = LDS_OST + 8 * 4096;
constexpr int LDS_BYTES = LDS_RPB + 4096;
constexpr float THR = 8.0f;

__device__ __forceinline__ int crow(int r, int hi) { return (r & 3) + 8 * (r >> 2) + 4 * hi; }
__device__ __forceinline__ void glds16(const void* gsrc, unsigned lds_dst) { unsigned keep;
    asm volatile("s_mov_b32 %0, m0\n\ts_mov_b32 m0, %2\n\ts_nop 0\n\tglobal_load_lds_dwordx4 %1, off\n\ts_mov_b32 m0, %0" : "=&s"(keep) : "v"(gsrc), "s"(lds_dst) : "memory"); }
__device__ __forceinline__ unsigned cvtpk(float lo, float hi) { f32x2_t v = {lo, hi}; bf16x2_t b = __builtin_convertvector(v, bf16x2_t); return __builtin_bit_cast(unsigned, b); }
__device__ __forceinline__ void glds16s(unsigned voff, const void* sbase, unsigned lds_dst) { unsigned keep;
    asm volatile("s_mov_b32 %0, m0\n\ts_mov_b32 m0, %3\n\ts_nop 0\n\tglobal_load_lds_dwordx4 %1, %2\n\ts_mov_b32 m0, %0" : "=&s"(keep) : "v"(voff), "s"(sbase), "s"(lds_dst) : "memory"); }
__device__ __forceinline__ float max3f(float a, float b, float c) { float r; asm("v_max3_f32 %0, %1, %2, %3" : "=v"(r) : "v"(a), "v"(b), "v"(c)); return r; }
__device__ __forceinline__ float max2f(float a, float b) { float r; asm("v_max_f32_e32 %0, %1, %2" : "=v"(r) : "v"(a), "v"(b)); return r; }
#define AWAIT_BAR(N) asm volatile("s_waitcnt vmcnt(" #N ") lgkmcnt(0)\n\ts_barrier" ::: "memory")

template <int ND0> __device__ __forceinline__ void qkt(f32x16& p0, f32x16& p1, const ALAS char* Kslot, const bf16x8* qr, const f32x16& negm, int r32, int hi) {
    const ALAS char* kb = Kslot + hi * 1024 + r32 * 16;
#pragma unroll
    for (int d0 = 0; d0 < ND0; ++d0) {
        const bf16x8 b0 = *(const ALAS bf16x8*)(kb + d0 * 2048);
        const bf16x8 b1 = *(const ALAS bf16x8*)(kb + d0 * 2048 + 512);
        if (d0 == 0) { p0 = __builtin_amdgcn_mfma_f32_32x32x16_bf16(b0, qr[0], negm, 0, 0, 0); p1 = __builtin_amdgcn_mfma_f32_32x32x16_bf16(b1, qr[0], negm, 0, 0, 0); }
        else { p0 = __builtin_amdgcn_mfma_f32_32x32x16_bf16(b0, qr[d0], p0, 0, 0, 0); p1 = __builtin_amdgcn_mfma_f32_32x32x16_bf16(b1, qr[d0], p1, 0, 0, 0); }
    }
}
__device__ __forceinline__ float rowmax32(const f32x16& p0, const f32x16& p1) {
    float a[4];
#pragma unroll
    for (int k = 0; k < 4; ++k) { a[k] = max3f(p0[4 * k], p0[4 * k + 1], p0[4 * k + 2]); }
#pragma unroll
    for (int k = 0; k < 4; ++k) { a[k] = max3f(a[k], p0[4 * k + 3], p1[4 * k]); }
#pragma unroll
    for (int k = 0; k < 4; ++k) { a[k] = max3f(a[k], p1[4 * k + 1], p1[4 * k + 2]); }
    const float m = max3f(max3f(a[0], p1[3], p1[7]), max3f(a[1], p1[11], p1[15]), max2f(a[2], a[3]));
    auto rr = __builtin_amdgcn_permlane32_swap(__float_as_uint(m), __float_as_uint(m), false, false);
    return max2f(__uint_as_float(rr[0]), __uint_as_float(rr[1]));
}
typedef short v4i16_t __attribute__((ext_vector_type(4)));
__device__ __forceinline__ s16x4 vtr(const ALAS char* p) { return __builtin_bit_cast(s16x4, __builtin_amdgcn_ds_read_tr16_b64_v4i16((ALAS v4i16_t*)p)); }
__device__ __forceinline__ void pv(f32x16* o, const ALAS char* vp, bf16x8 pa0, bf16x8 pa1, bf16x8 pa2, bf16x8 pa3) {
#pragma unroll
    for (int d0 = 0; d0 < 2; ++d0) { s16x4 lo[4], hi[4];
#pragma unroll
        for (int ks = 0; ks < 4; ++ks) { lo[ks] = vtr(vp + d0 * 4096 + ks * 1024); hi[ks] = vtr(vp + d0 * 4096 + ks * 1024 + 512); }
#define APK(k) (bf16x8){lo[k][0], lo[k][1], lo[k][2], lo[k][3], hi[k][0], hi[k][1], hi[k][2], hi[k][3]}
        o[d0] = __builtin_amdgcn_mfma_f32_32x32x16_bf16(pa0, APK(0), o[d0], 0, 0, 0);
        o[d0] = __builtin_amdgcn_mfma_f32_32x32x16_bf16(pa1, APK(1), o[d0], 0, 0, 0);
        o[d0] = __builtin_amdgcn_mfma_f32_32x32x16_bf16(pa2, APK(2), o[d0], 0, 0, 0);
        o[d0] = __builtin_amdgcn_mfma_f32_32x32x16_bf16(pa3, APK(3), o[d0], 0, 0, 0);
#undef APK
    }
}

struct UnitDesc {
    const bf16_t* Q; int qpitch;
    long q0; int qcol;
    const bf16_t* K; int kpitch, kcol;
    const bf16_t* V; int vpitch, vcol;
    bf16_t* O; int opitch, ocol;
    int kv0;
    int nt;
    int rg;
    int rmin;
    int head;
    const bf16_t* G;
};

template <int DQK, bool NA, bool MLAQ>
__device__ __forceinline__ void attn_unit(const UnitDesc& U, ALAS char* shm, const float* qgain, const float* T16, const float* rpb_g) {
    constexpr int ND0 = DQK / 16, NCH = DQK / 8, NP = NCH + 8;
    int tid_ = threadIdx.x; asm volatile("" : "+v"(tid_));
    const int tid = tid_, lane = tid & 63, r32 = lane & 31, hi = lane >> 5; const int wid = __builtin_amdgcn_readfirstlane(tid >> 6);
#ifdef ATT_STATIC_PRIO_NA
    if (wid >= 4) __builtin_amdgcn_s_setprio(1);
#endif
    const unsigned lds0 = (unsigned)(uintptr_t)shm;
    ALAS float* wsf = (ALAS float*)(shm + LDS_WS) + wid * 64;
    unsigned doff[3];
#pragma unroll
    for (int i = 0; i < 3; ++i) { const int pc = wid + 8 * i;
        if (pc < NCH) doff[i] = (unsigned)((lane * U.kpitch + U.kcol + pc * 8) * 2);
        else { const int v = pc - NCH; doff[i] = (unsigned)(((16 * (v & 3) + (lane >> 2)) * U.vpitch + U.vcol + (v >> 2) * 32 + (lane & 3) * 8) * 2); } }
    auto dma_tile = [&](int t, int slot) {
        int key0;
        if (NA && t >= 4) key0 = U.kv0 + CTX + (U.rmin + (t - 4)) * GW; else key0 = U.kv0 + 64 * t;
        const unsigned sbase = lds0 + slot * SLOT;
        const bf16_t* kb_ = U.K + (size_t)key0 * U.kpitch; const bf16_t* vb_ = U.V + (size_t)key0 * U.vpitch;
#pragma unroll
        for (int i = 0; i < 3; ++i) { const int pc = wid + 8 * i;
            if (pc < NP) {
                if (pc < NCH) glds16s(doff[i], kb_, (unsigned)__builtin_amdgcn_readfirstlane(sbase + pc * 1024));
                else glds16s(doff[i], vb_, (unsigned)__builtin_amdgcn_readfirstlane(sbase + KSLOT + (pc - NCH) * 1024));
#ifdef ATT_DUP_DMA
                if (pc < NCH) glds16s(doff[i], kb_, (unsigned)__builtin_amdgcn_readfirstlane(sbase + pc * 1024));
                else glds16s(doff[i], vb_, (unsigned)__builtin_amdgcn_readfirstlane(sbase + KSLOT + (pc - NCH) * 1024));
#endif
            } }
    };
    asm volatile("s_waitcnt vmcnt(0)" ::: "memory");
#pragma unroll
    for (int t0_ = 0; t0_ < PD; ++t0_) if (t0_ < U.nt) dma_tile(t0_, t0_);
    bf16x8 qr[ND0];
    const bf16_t* Qw = U.Q + (size_t)(U.q0 + wid * 32 + r32) * U.qpitch + U.qcol;
#pragma unroll
    for (int d0 = 0; d0 < ND0; ++d0) qr[d0] = *(const bf16x8*)(Qw + d0 * 16 + hi * 8);
    if (MLAQ) {
        float f[ND0][8]; float ss = 0.f;
#pragma unroll
        for (int d0 = 0; d0 < ND0; ++d0)
#pragma unroll
            for (int j = 0; j < 8; ++j) { f[d0][j] = bf2f((bf16_t)qr[d0][j]); ss += f[d0][j] * f[d0][j]; }
        ss += __shfl_xor(ss, 32);
        const float rn = rsqrtf(ss * (1.f / 96.f) + EPS) * C2_96;
#pragma unroll
        for (int d0 = 0; d0 < ND0; ++d0)
#pragma unroll
            for (int j = 0; j < 8; ++j) f[d0][j] = f[d0][j] * rn * qgain[d0 * 16 + hi * 8 + j];
        const int t = (int)((U.q0 + wid * 32 + r32) % S); const int grow = t / GW, gcol = t % GW;
#pragma unroll
        for (int part = 0; part < 2; ++part) { const int pos = part ? gcol : grow;
#pragma unroll
            for (int j = 0; j < 8; ++j) { const float cs = T16[pos * 8 + j], sn = T16[512 + pos * 8 + j];
                const float mine = f[4 + part][j], other = __shfl_xor(mine, 32);
                f[4 + part][j] = hi == 0 ? (mine * cs - other * sn) : (other * sn + mine * cs); } }
#pragma unroll
        for (int d0 = 0; d0 < ND0; ++d0)
#pragma unroll
            for (int j = 0; j < 4; ++j) { const unsigned w = cvtpk(f[d0][2 * j], f[d0][2 * j + 1]); qr[d0][2 * j] = (short)(w & 0xffff); qr[d0][2 * j + 1] = (short)(w >> 16); }
    }
    const int grow_w = NA ? 4 * U.rg + (wid >> 1) : 0, c0w = 32 * (wid & 1);
    const int r0w = NA ? min(max(grow_w - 4, 0), 24) : 0;
    const int qc = c0w + r32;
    const int cs_q = min(max(qc - 8, 0), 48);
    float mhat = 0.f, l_reg = 0.f; f32x16 o[2]; o[0] = f32x16{}; o[1] = f32x16{};
    const ALAS char* vp0 = shm + KSLOT + ((lane >> 4) & 1) * 32 + (lane & 3) * 8 + (4 * hi + ((lane & 15) >> 2)) * 64;
    const int NT = U.nt;
    f32x16 a0, a1, b0, b1;
    u32x4 pw0, pw1, pw2, pw3;
    auto wait_tile = [&](int t) {
        const int ahead = min(PD - 1, NT - 1 - t);
        const bool big = (NP == 20 && wid < 4);
#ifdef ATT_DUP_DMA
        if (ahead >= 1) { if (big) AWAIT_BAR(6); else AWAIT_BAR(4); }
        else AWAIT_BAR(0);
#else
        if (ahead >= 2) { if (big) AWAIT_BAR(6); else AWAIT_BAR(4); }
        else if (ahead == 1) { if (big) AWAIT_BAR(3); else AWAIT_BAR(2); }
        else AWAIT_BAR(0);
#endif
        if (t + PD < NT) dma_tile(t + PD, (t + PD) % NSLOT);
    };
    bf16x8 eq[2];
    if (NA) {
#pragma unroll
        for (int s_ = 0; s_ < 2; ++s_)
#pragma unroll
            for (int jj = 0; jj < 8; ++jj) eq[s_][jj] = (16 * s_ + 8 * hi + jj == r32) ? (short)0x3f80 : (short)0;
    }
    const bf16_t* gq = NA ? U.G + (size_t)U.head * (16 * 2 * 64 * 32) + (size_t)(wid & 1) * (64 * 32) + r32 * 32 + hi * 8 : nullptr;
    auto gbias_load = [&](bf16x8 (&f)[4], int t) {
        const int krow = U.rmin + (t - 4); int dr = krow - grow_w + 7; if (krow < r0w || krow >= r0w + 8) dr = 15;
        const bf16_t* g = gq + (size_t)dr * (2 * 64 * 32);
#pragma unroll
        for (int half = 0; half < 2; ++half)
#pragma unroll
            for (int s_ = 0; s_ < 2; ++s_) f[2 * s_ + half] = *(const bf16x8*)(g + half * 1024 + s_ * 16);
    };
    auto gbias_mma = [&](f32x16& c0, f32x16& c1, const bf16x8 (&f)[4]) {
        c0 = __builtin_amdgcn_mfma_f32_32x32x16_bf16(f[0], eq[0], c0, 0, 0, 0); c1 = __builtin_amdgcn_mfma_f32_32x32x16_bf16(f[1], eq[0], c1, 0, 0, 0);
        c0 = __builtin_amdgcn_mfma_f32_32x32x16_bf16(f[2], eq[1], c0, 0, 0, 0); c1 = __builtin_amdgcn_mfma_f32_32x32x16_bf16(f[3], eq[1], c1, 0, 0, 0);
    };
    constexpr bool NEGM = true;
    f32x16 negm = f32x16{};
    auto decide = [&](f32x16& c0, f32x16& c1, bool first) -> bool {
        const float rm = rowmax32(c0, c1);
        if (first || __any(rm > THR)) {
            const float dl = first ? rm : fmaxf(rm, 0.f);
            mhat += dl;
#pragma unroll
            for (int r = 0; r < 16; ++r) { c0[r] -= dl; c1[r] -= dl; }
#pragma unroll
            for (int r = 0; r < 16; ++r) negm[r] = -mhat;
            if (!first) { const float f = __builtin_amdgcn_exp2f(-dl); l_reg *= f; if (hi == 0) wsf[r32] = f; return true; }
        }
        return false;
    };
    auto rescale_o = [&]() {
        asm volatile("s_waitcnt lgkmcnt(0)" ::: "memory");
#pragma unroll
        for (int r = 0; r < 16; ++r) { const float fr_ = wsf[crow(r, hi)]; o[0][r] *= fr_; o[1][r] *= fr_; }
    };
    auto expo = [&](f32x16& c0, f32x16& c1) {
#pragma unroll
        for (int r = 0; r < 16; ++r) { c0[r] = __builtin_amdgcn_exp2f(c0[r]); c1[r] = __builtin_amdgcn_exp2f(c1[r]); }
    };
    auto sumpack = [&](const f32x16& c0, const f32x16& c1) {
        float s4[4];
#pragma unroll
        for (int k = 0; k < 4; ++k) s4[k] = c0[k] + c1[k];
#pragma unroll
        for (int r = 4; r < 16; ++r) s4[r & 3] += c0[r] + c1[r];
        l_reg += (s4[0] + s4[1]) + (s4[2] + s4[3]);
#pragma unroll
        for (int j = 0; j < 4; ++j) { pw0[j] = cvtpk(c0[2 * j], c0[2 * j + 1]); pw1[j] = cvtpk(c0[8 + 2 * j], c0[9 + 2 * j]); pw2[j] = cvtpk(c1[2 * j], c1[2 * j + 1]); pw3[j] = cvtpk(c1[8 + 2 * j], c1[9 + 2 * j]); }
    };
    auto step = [&](f32x16& c0, f32x16& c1, f32x16& q0, f32x16& q1, int j) {
        wait_tile(j);
        bf16x8 gf[4];
        if (NA && j >= 4) gbias_load(gf, j);
        qkt<ND0>(c0, c1, shm + (j % NSLOT) * SLOT, qr, negm, r32, hi);
        if (NA && j >= 4) gbias_mma(c0, c1, gf);
        sumpack(q0, q1);
        const bool resc = decide(c0, c1, false);
        pv(o, vp0 + ((j - 1) % NSLOT) * SLOT, __builtin_bit_cast(bf16x8, pw0), __builtin_bit_cast(bf16x8, pw1), __builtin_bit_cast(bf16x8, pw2), __builtin_bit_cast(bf16x8, pw3));
        expo(c0, c1);
        if (resc) rescale_o();
    };
    wait_tile(0);
    qkt<ND0>(a0, a1, shm, qr, negm, r32, hi);
    (void)decide(a0, a1, true);
    expo(a0, a1);
    int j = 1;
#pragma unroll 1
    for (; j + 1 < NT; j += 2) { step(b0, b1, a0, a1, j); step(a0, a1, b0, b1, j + 1); }
    if (j < NT) { step(b0, b1, a0, a1, j); sumpack(b0, b1); } else sumpack(a0, a1);
    pv(o, vp0 + ((NT - 1) % NSLOT) * SLOT, __builtin_bit_cast(bf16x8, pw0), __builtin_bit_cast(bf16x8, pw1), __builtin_bit_cast(bf16x8, pw2), __builtin_bit_cast(bf16x8, pw3));
    { auto rr = __builtin_amdgcn_permlane32_swap(__float_as_uint(l_reg), __float_as_uint(l_reg), false, false); l_reg = __uint_as_float(rr[0]) + __uint_as_float(rr[1]); }
    if (hi == 0) wsf[32 + r32] = l_reg;
    asm volatile("s_waitcnt lgkmcnt(0)" ::: "memory");
    float rli[16];
#pragma unroll
    for (int r = 0; r < 16; ++r) rli[r] = __builtin_amdgcn_rcpf(wsf[32 + crow(r, hi)]);
    bf16_t* Ow = U.O + (size_t)(U.q0 + wid * 32) * U.opitch + U.ocol;
    { ALAS bf16_t* stg = (ALAS bf16_t*)(shm + LDS_OST) + wid * 2048;
#pragma unroll
        for (int r = 0; r < 16; ++r) { const int orow = crow(r, hi);
#pragma unroll
            for (int d0 = 0; d0 < 2; ++d0) stg[orow * 64 + d0 * 32 + r32] = f2bf(o[d0][r] * rli[r]); }
        asm volatile("s_waitcnt lgkmcnt(0)" ::: "memory");
#pragma unroll
        for (int i = 0; i < 4; ++i) { const int row = i * 8 + (lane >> 3), ch = lane & 7; const u32x4 v = *(const ALAS u32x4*)(stg + row * 64 + ch * 8); *(u32x4*)(Ow + (size_t)row * U.opitch + ch * 8) = v; } }
#ifdef ATT_STATIC_PRIO_NA
    __builtin_amdgcn_s_setprio(0);
#endif
    asm volatile("s_waitcnt vmcnt(0) lgkmcnt(0)\n\ts_barrier" ::: "memory");
}
}
#include <hip/hip_bf16.h>
namespace att64 {
using bf16=__hip_bfloat16;
using bf16x8=__attribute__((ext_vector_type(8)))short;
using s16x4=__attribute__((ext_vector_type(4)))short;
using f32x16=__attribute__((ext_vector_type(16)))float;
using u32x4=__attribute__((ext_vector_type(4)))unsigned;
constexpr int D=64;
constexpr int NW=8,QBLK=32,QB=QBLK*NW,KVBLK=64;

__device__ __forceinline__ int crow(int r,int hi){return (r&3)+8*(r>>2)+4*hi;}
#define SBAR() __builtin_amdgcn_sched_barrier(0)
__device__ __forceinline__ void cmask(f32x16&p0,f32x16&p1,int jb,int qrel,int hi){
  const float NEG=-INFINITY; int kb=64*jb+4*hi;
  #pragma unroll
  for(int r=0;r<16;++r){int kv=kb+(r&3)+8*(r>>2); if(kv>qrel)p0[r]=NEG; if(kv+32>qrel)p1[r]=NEG;}
}

constexpr int NSLOT=3, SLOTB=8192;
constexpr int LDS_K=0, LDS_V=NSLOT*SLOTB, LDS_WS=2*NSLOT*SLOTB, LDS_OST=LDS_WS+NW*64*4, LDS_BYTES=LDS_OST+NW*4096;
constexpr float C2=0.125f*1.4426950408889634f;
__device__ __forceinline__ void glds16(const void*gsrc,unsigned lds_dst){unsigned keep;
  asm volatile("s_mov_b32 %0, m0\n\ts_mov_b32 m0, %2\n\ts_nop 0\n\tglobal_load_lds_dwordx4 %1, off\n\ts_mov_b32 m0, %0":"=&s"(keep):"v"(gsrc),"s"(lds_dst):"memory");}
__device__ __forceinline__ float max3f(float a,float b,float c){float r;asm("v_max3_f32 %0, %1, %2, %3":"=v"(r):"v"(a),"v"(b),"v"(c));return r;}
__device__ __forceinline__ float max2f(float a,float b){float r;asm("v_max_f32_e32 %0, %1, %2":"=v"(r):"v"(a),"v"(b));return r;}
__device__ __forceinline__ float fadd_s(float a,float b){float r;asm("v_add_f32_e32 %0, %1, %2":"=v"(r):"v"(a),"v"(b));return r;}
__device__ __forceinline__ float fsub_s(float a,float b){float r;asm("v_sub_f32_e32 %0, %1, %2":"=v"(r):"v"(a),"v"(b));return r;}
typedef float f32x2_t __attribute__((ext_vector_type(2))); typedef __bf16 bf16x2_t __attribute__((ext_vector_type(2)));
__device__ __forceinline__ unsigned cvtpk_s(float lo,float hi){f32x2_t v={lo,hi};bf16x2_t b=__builtin_convertvector(v,bf16x2_t);return __builtin_bit_cast(unsigned,b);}
#define WAIT_BAR(N) asm volatile("s_waitcnt vmcnt(" #N ") lgkmcnt(0)\n\ts_barrier":::"memory")

__device__ __forceinline__ void qkt(f32x16&p0,f32x16&p1,const char*Kslot,const bf16x8*qr,const f32x16&negm,int r32,int hi){
  const char*kb=Kslot+hi*1024+r32*16;
  #pragma unroll
  for(int d0=0;d0<4;++d0){
    const bf16x8 b0=*reinterpret_cast<const bf16x8*>(kb+d0*2048);
    const bf16x8 b1=*reinterpret_cast<const bf16x8*>(kb+d0*2048+512);
    if(d0==0){p0=__builtin_amdgcn_mfma_f32_32x32x16_bf16(b0,qr[0],negm,0,0,0);p1=__builtin_amdgcn_mfma_f32_32x32x16_bf16(b1,qr[0],negm,0,0,0);}
    else{p0=__builtin_amdgcn_mfma_f32_32x32x16_bf16(b0,qr[d0],p0,0,0,0);p1=__builtin_amdgcn_mfma_f32_32x32x16_bf16(b1,qr[d0],p1,0,0,0);}}
}
typedef __attribute__((address_space(3))) const char* lds_cptr;
typedef short v4i16_t __attribute__((ext_vector_type(4)));
__device__ __forceinline__ void kload8(bf16x8*kf,lds_cptr kp){
  kf[0]=*(const __attribute__((address_space(3))) bf16x8*)(kp);      kf[1]=*(const __attribute__((address_space(3))) bf16x8*)(kp+512);
  kf[2]=*(const __attribute__((address_space(3))) bf16x8*)(kp+2048); kf[3]=*(const __attribute__((address_space(3))) bf16x8*)(kp+2560);
  kf[4]=*(const __attribute__((address_space(3))) bf16x8*)(kp+4096); kf[5]=*(const __attribute__((address_space(3))) bf16x8*)(kp+4608);
  kf[6]=*(const __attribute__((address_space(3))) bf16x8*)(kp+6144); kf[7]=*(const __attribute__((address_space(3))) bf16x8*)(kp+6656);
}
__device__ __forceinline__ void kload2(bf16x8*kf,lds_cptr kp,int j){ kf[2*j]=*(const __attribute__((address_space(3))) bf16x8*)(kp+j*2048); kf[2*j+1]=*(const __attribute__((address_space(3))) bf16x8*)(kp+j*2048+512); }
__device__ __forceinline__ s16x4 vtr(lds_cptr p){ return __builtin_bit_cast(s16x4,__builtin_amdgcn_ds_read_tr16_b64_v4i16((__attribute__((address_space(3))) v4i16_t*)p)); }
__device__ __forceinline__ float rowmax(const f32x16&p0,const f32x16&p1){
  float a=max3f(p0[0],p0[1],p1[0]),b=max3f(p0[2],p0[3],p1[1]);a=max3f(a,p1[2],p1[3]);
  #pragma unroll
  for(int r=4;r<16;r+=4){a=max3f(a,p0[r],p0[r+1]);b=max3f(b,p0[r+2],p0[r+3]);a=max3f(a,p1[r],p1[r+1]);b=max3f(b,p1[r+2],p1[r+3]);}
  const float m=max2f(a,b);
  auto rr=__builtin_amdgcn_permlane32_swap(__float_as_uint(m),__float_as_uint(m),false,false);
  return max2f(__uint_as_float(rr[0]),__uint_as_float(rr[1]));
}
__device__ __forceinline__ void pv(f32x16*o,int vb,bf16x8 pa0,bf16x8 pa1,bf16x8 pa2,bf16x8 pa3){
  #pragma unroll
  for(int d0=0;d0<2;++d0){s16x4 lo[4],hi[4];
    #pragma unroll
    for(int ks=0;ks<4;++ks){
      asm volatile("ds_read_b64_tr_b16 %0,%1 offset:%c2":"=&v"(lo[ks]):"v"(vb),"i"(d0*4096+ks*1024):"memory");
      asm volatile("ds_read_b64_tr_b16 %0,%1 offset:%c2":"=&v"(hi[ks]):"v"(vb),"i"(d0*4096+ks*1024+512):"memory");}
    asm volatile("s_waitcnt lgkmcnt(0)":::"memory");SBAR();
    #define PK(k) (bf16x8){lo[k][0],lo[k][1],lo[k][2],lo[k][3],hi[k][0],hi[k][1],hi[k][2],hi[k][3]}
    o[d0]=__builtin_amdgcn_mfma_f32_32x32x16_bf16(pa0,PK(0),o[d0],0,0,0);
    o[d0]=__builtin_amdgcn_mfma_f32_32x32x16_bf16(pa1,PK(1),o[d0],0,0,0);
    o[d0]=__builtin_amdgcn_mfma_f32_32x32x16_bf16(pa2,PK(2),o[d0],0,0,0);
    o[d0]=__builtin_amdgcn_mfma_f32_32x32x16_bf16(pa3,PK(3),o[d0],0,0,0);
    #undef PK
  }
}

#ifndef ATTN_STORE16
#define ATTN_STORE16(p,v) (*(u32x4*)(p)=(v))
#endif
template<int THRL> __device__ __forceinline__ void attn_unit(long q0,const bf16*Q,int qp,int qcol,const bf16*__restrict__ K,int kp,int kcol,const bf16*__restrict__ V,int vp,int vcol,long kv0,int NT,bf16*O,int op,int ocol,char*shm){
  int tid_=threadIdx.x; asm volatile("":"+v"(tid_));
  const int tid=tid_,lane=tid&63,r32=lane&31,hi=lane>>5; const int wid=__builtin_amdgcn_readfirstlane(tid>>6);
#ifdef ATT_STATIC_PRIO
  if(wid>=4)__builtin_amdgcn_s_setprio(1);
#endif
  const bf16*Qw=Q+(q0+wid*QBLK)*qp+qcol;
  const bf16*Kh=K+kv0*kp+kcol,*Vh=V+kv0*vp+vcol;
  const unsigned lds0=(unsigned)(uintptr_t)shm;
  float*wsf=(float*)(shm+LDS_WS)+wid*64;
  const bf16*ksrc=Kh+(long)lane*kp+wid*8;
  const bf16*vsrc=Vh+(long)(16*(wid&3)+(lane>>2))*vp+(wid>>2)*32+(lane&3)*8;
  const unsigned kdst=lds0+LDS_K+wid*1024, vdst=lds0+LDS_V+wid*1024;
  #define DMA_K(t,slot) glds16(ksrc+(long)(t)*KVBLK*kp,(unsigned)__builtin_amdgcn_readfirstlane(kdst+(slot)))
  #define DMA_V(t,slot) glds16(vsrc+(long)(t)*KVBLK*vp,(unsigned)__builtin_amdgcn_readfirstlane(vdst+(slot)))
  const int vb0=(int)(lds0+LDS_V)+((lane>>4)&1)*32+(lane&3)*8+(4*hi+((lane&15)>>2))*64;
  const char*Kbase=shm+LDS_K; bf16x8 kf[8];
  const lds_cptr shm3=(lds_cptr)shm; const lds_cptr kp0=shm3+LDS_K+hi*1024+r32*16; const lds_cptr vp0=shm3+LDS_V+((lane>>4)&1)*32+(lane&3)*8+(4*hi+((lane&15)>>2))*64;
  DMA_K(0,0);DMA_V(0,0);DMA_K(1,SLOTB);
  bf16x8 qr[4];
  #pragma unroll
  for(int d0=0;d0<4;++d0)qr[d0]=*reinterpret_cast<const bf16x8*>(&Qw[(long)r32*qp+d0*16+hi*8]);
  float mhat=0.f,l_reg=0.f;f32x16 o[2];o[0]=f32x16{};o[1]=f32x16{};f32x16 negm=f32x16{};asm volatile("":"+v"(negm));
  #define CMASK(P0,P1,t) do{}while(0)
  bool resc=false;
  #define START(P0,P1) do{ const float rm=rowmax(P0,P1); resc=false; \
    { const float dl=rm; mhat=fadd_s(mhat,dl); \
      _Pragma("unroll") for(int r=0;r<16;++r){P0[r]=fsub_s(P0[r],dl);P1[r]=fsub_s(P1[r],dl);} \
      _Pragma("unroll") for(int r=0;r<16;++r)negm[r]=-mhat; asm volatile("":"+v"(negm)); } \
    _Pragma("unroll") for(int r=0;r<16;++r)P0[r]=__builtin_amdgcn_exp2f(P0[r]); }while(0)
  #define RESC() do{ if(resc){ asm volatile("s_waitcnt lgkmcnt(0)":::"memory"); \
      _Pragma("unroll") for(int d_=0;d_<2;++d_) _Pragma("unroll") for(int r=0;r<16;++r)o[d_][r]*=wsf[crow(r,hi)]; } }while(0)
  f32x16 pA0,pA1,pB0,pB1;
  int sl_prev=0,sl_cur=0,sl_next=SLOTB;
  #define ROT() do{sl_prev=sl_cur;sl_cur=sl_next;sl_next=(sl_next==(NSLOT-1)*SLOTB)?0:sl_next+SLOTB;}while(0)
  DMA_K(2,2*SLOTB);
  WAIT_BAR(3);
  qkt(pA0,pA1,Kbase,qr,negm,r32,hi);asm volatile("s_nop 15\n\ts_nop 7":"+v"(pA0),"+v"(pA1));CMASK(pA0,pA1,0);
  START(pA0,pA1);
  _Pragma("unroll") for(int r=0;r<16;++r)pA1[r]=__builtin_amdgcn_exp2f(pA1[r]);
  WAIT_BAR(0);
  DMA_K(3,0);DMA_V(1,SLOTB);
  ROT();
  kload8(kf,kp0+sl_cur);
  WAIT_BAR(2);
  s16x4 vlo[8],vhi[8]; u32x4 pw0,pw1,pw2,pw3;
  #define PKW(P,B) cvtpk_s(P[B],P[B+1])
  #define PAF(k) __builtin_bit_cast(bf16x8,pw##k)
  #define VFR(i) (bf16x8){vlo[i][0],vlo[i][1],vlo[i][2],vlo[i][3],vhi[i][0],vhi[i][1],vhi[i][2],vhi[i][3]}
  #define PIN(x) asm volatile("":"+v"(x))
  #define MX3(a,b,c) __builtin_fmaxf(__builtin_fmaxf((a),(b)),(c))
  #define GAPA(MF,A0,A1,A2,A3,W0,W1,PW) do{ MF; sacc+=A0; sacc+=A1; sacc+=A2; sacc+=A3; PIN(sacc); W0; W1; PIN(PW); SBAR(); }while(0)
  #define EX(v) __builtin_amdgcn_exp2f(v)
  #define GAPB(MF,X,B) do{ MF; X[B]=EX(X[B]); X[B+1]=EX(X[B+1]); X[B+2]=EX(X[B+2]); X[B+3]=EX(X[B+3]); PIN(X); SBAR(); }while(0)
  #define VRD(i) do{ vlo[i]=vtr(vp_+(((i)>>2)*4096+((i)&3)*1024)); vhi[i]=vtr(vp_+(((i)>>2)*4096+((i)&3)*1024+512)); }while(0)
  #define KRD(G,j) do{ if(G){ kload2(kf,kp0+sl_next,j); SBAR(); } }while(0)
  #define STEP(C0,C1,P0,P1,t,GK,GV,GL) do{ SBAR(); \
    const lds_cptr vp_=vp0+sl_prev; \
    VRD(0); SBAR(); float sacc=(P0[0]+P0[1]); \
    GAPA(C0=__builtin_amdgcn_mfma_f32_32x32x16_bf16(kf[0],qr[0],negm,0,0,0), P0[2],P0[3],P0[4],P0[5],     pw0[0]=PKW(P0,0), pw0[1]=PKW(P0,2), pw0); \
    VRD(4); SBAR(); GAPA(C1=__builtin_amdgcn_mfma_f32_32x32x16_bf16(kf[1],qr[0],negm,0,0,0), P0[6],P0[7],P0[8],P0[9],     pw0[2]=PKW(P0,4), pw0[3]=PKW(P0,6), pw0); \
    VRD(1); SBAR(); GAPA(C0=__builtin_amdgcn_mfma_f32_32x32x16_bf16(kf[2],qr[1],C0,0,0,0),   P0[10],P0[11],P0[12],P0[13], pw1[0]=PKW(P0,8), pw1[1]=PKW(P0,10), pw1); \
    VRD(5); SBAR(); GAPA(C1=__builtin_amdgcn_mfma_f32_32x32x16_bf16(kf[3],qr[1],C1,0,0,0),   P0[14],P0[15],P1[0],P1[1],   pw1[2]=PKW(P0,12),pw1[3]=PKW(P0,14), pw1); \
    VRD(2); SBAR(); GAPA(C0=__builtin_amdgcn_mfma_f32_32x32x16_bf16(kf[4],qr[2],C0,0,0,0),   P1[2],P1[3],P1[4],P1[5],     pw2[0]=PKW(P1,0), pw2[1]=PKW(P1,2), pw2); \
    VRD(6); SBAR(); GAPA(C1=__builtin_amdgcn_mfma_f32_32x32x16_bf16(kf[5],qr[2],C1,0,0,0),   P1[6],P1[7],P1[8],P1[9],     pw2[2]=PKW(P1,4), pw2[3]=PKW(P1,6), pw2); \
    VRD(3); SBAR(); GAPA(C0=__builtin_amdgcn_mfma_f32_32x32x16_bf16(kf[6],qr[3],C0,0,0,0),   P1[10],P1[11],P1[12],P1[13], pw3[0]=PKW(P1,8), pw3[1]=PKW(P1,10), pw3); \
    VRD(7); SBAR(); GAPA(C1=__builtin_amdgcn_mfma_f32_32x32x16_bf16(kf[7],qr[3],C1,0,0,0),   P1[14],P1[15],0.f,0.f,       pw3[2]=PKW(P1,12),pw3[3]=PKW(P1,14), pw3); \
    l_reg+=sacc; \
    if(GK){DMA_K((t)+3,sl_cur);} if(GV){DMA_V((t)+1,sl_next);} \
    CMASK(C0,C1,t); \
    { float a=MX3(C0[0],C0[1],C1[0]),b=MX3(C0[2],C0[3],C1[1]); a=MX3(a,C1[2],C1[3]); \
      _Pragma("unroll") for(int r=4;r<16;r+=4){a=MX3(a,C0[r],C0[r+1]);b=MX3(b,C0[r+2],C0[r+3]);a=MX3(a,C1[r],C1[r+1]);b=MX3(b,C1[r+2],C1[r+3]);} \
      float rm=__builtin_fmaxf(a,b); { auto rr=__builtin_amdgcn_permlane32_swap(__float_as_uint(rm),__float_as_uint(rm),false,false); rm=__builtin_fmaxf(__uint_as_float(rr[0]),__uint_as_float(rr[1])); } \
      resc=false; \
      if(__builtin_expect(__any(rm>(float)THRL),0)){ const float dl=__builtin_fmaxf(rm,0.f); mhat+=dl; \
        _Pragma("unroll") for(int r=0;r<16;++r){C0[r]-=dl;C1[r]-=dl;} \
        _Pragma("unroll") for(int r=0;r<16;++r)negm[r]=-mhat; asm volatile("":"+v"(negm)); \
        const float f=__builtin_amdgcn_exp2f(-dl); l_reg*=f; if(hi==0)wsf[r32]=f; resc=true; } } \
    SBAR(); \
    GAPB(o[0]=__builtin_amdgcn_mfma_f32_32x32x16_bf16(PAF(0),VFR(0),o[0],0,0,0), C0,0); \
    GAPB(o[1]=__builtin_amdgcn_mfma_f32_32x32x16_bf16(PAF(0),VFR(4),o[1],0,0,0), C0,4); \
    KRD(GL,0); GAPB(o[0]=__builtin_amdgcn_mfma_f32_32x32x16_bf16(PAF(1),VFR(1),o[0],0,0,0), C0,8); \
    KRD(GL,1); GAPB(o[1]=__builtin_amdgcn_mfma_f32_32x32x16_bf16(PAF(1),VFR(5),o[1],0,0,0), C0,12); \
    KRD(GL,2); GAPB(o[0]=__builtin_amdgcn_mfma_f32_32x32x16_bf16(PAF(2),VFR(2),o[0],0,0,0), C1,0); \
    KRD(GL,3); GAPB(o[1]=__builtin_amdgcn_mfma_f32_32x32x16_bf16(PAF(2),VFR(6),o[1],0,0,0), C1,4); \
    GAPB(o[0]=__builtin_amdgcn_mfma_f32_32x32x16_bf16(PAF(3),VFR(3),o[0],0,0,0), C1,8); \
    GAPB(o[1]=__builtin_amdgcn_mfma_f32_32x32x16_bf16(PAF(3),VFR(7),o[1],0,0,0), C1,12); \
    }while(0)
  int t=1;
  #undef CMASK
  #define CMASK(P0,P1,t) do{}while(0)
  for(;t+5<NT;t+=2){
    STEP(pB0,pB1,pA0,pA1,t,true,true,true);     WAIT_BAR(2); RESC(); ROT();
    STEP(pA0,pA1,pB0,pB1,t+1,true,true,true);   WAIT_BAR(2); RESC(); ROT();
  }
  #undef CMASK
  #define CMASK(P0,P1,t) do{}while(0)
  #define ENDW(tt) do{ if((tt)+3<NT){WAIT_BAR(2);} else if((tt)+2<NT){WAIT_BAR(1);} else {WAIT_BAR(0);} }while(0)
  for(;t+1<NT;t+=2){
    STEP(pB0,pB1,pA0,pA1,t,(t+3<NT),(t+1<NT),(t+1<NT));       ENDW(t);   RESC(); ROT();
    STEP(pA0,pA1,pB0,pB1,t+1,(t+4<NT),(t+2<NT),(t+2<NT));     ENDW(t+1); RESC(); ROT();
  }
  STEP(pB0,pB1,pA0,pA1,NT-1,false,false,false); RESC();
  { float sacc=pB0[0]+pB0[1]; _Pragma("unroll") for(int r=2;r<16;++r)sacc+=pB0[r]; _Pragma("unroll") for(int r=0;r<16;++r)sacc+=pB1[r]; l_reg+=sacc;
    pw0=(u32x4){PKW(pB0,0),PKW(pB0,2),PKW(pB0,4),PKW(pB0,6)};pw1=(u32x4){PKW(pB0,8),PKW(pB0,10),PKW(pB0,12),PKW(pB0,14)};pw2=(u32x4){PKW(pB1,0),PKW(pB1,2),PKW(pB1,4),PKW(pB1,6)};pw3=(u32x4){PKW(pB1,8),PKW(pB1,10),PKW(pB1,12),PKW(pB1,14)};
    SBAR(); pv(o,vb0+sl_cur,PAF(0),PAF(1),PAF(2),PAF(3)); }
  #undef PKW
  #undef PAF
  #undef VFR
  #undef PIN
  #undef MX3
  #undef GAPA
  #undef GAPB
  #undef EX
  #undef VRD
  #undef KRD
  #undef STEP
  #undef ENDW
  {auto rr=__builtin_amdgcn_permlane32_swap(__float_as_uint(l_reg),__float_as_uint(l_reg),false,false);l_reg=__uint_as_float(rr[0])+__uint_as_float(rr[1]);}
  if(hi==0)wsf[32+r32]=l_reg;asm volatile("s_waitcnt lgkmcnt(0)":::"memory");
  float rli[16];
  #pragma unroll
  for(int r=0;r<16;++r)rli[r]=__builtin_amdgcn_rcpf(wsf[32+crow(r,hi)]);
  bf16*Ow=O+(q0+wid*QBLK)*op+ocol;
  { bf16*stg=(bf16*)(shm+LDS_OST)+wid*2048;
    #pragma unroll
    for(int r=0;r<16;++r){const int orow=crow(r,hi);
      #pragma unroll
      for(int d0=0;d0<2;++d0)stg[orow*64+d0*32+r32]=__float2bfloat16(o[d0][r]*rli[r]);}
    asm volatile("s_waitcnt lgkmcnt(0)":::"memory");
    #pragma unroll
    for(int i=0;i<4;++i){const int row=i*8+(lane>>3),ch=lane&7; const u32x4 v=*(const u32x4*)(stg+row*64+ch*8); ATTN_STORE16(Ow+(long)row*op+ch*8,v);} }
#ifdef ATT_STATIC_PRIO
  __builtin_amdgcn_s_setprio(0);
#endif
  asm volatile("s_waitcnt lgkmcnt(0)\n\ts_barrier":::"memory");
  #undef DMA_K
  #undef DMA_V
  #undef CMASK
  #undef START
  #undef RESC
  #undef ROT
}
constexpr int ATTN_LDS_BYTES=LDS_BYTES;

#undef SBAR
#undef WAIT_BAR
}
namespace att96 {
using bf16=__hip_bfloat16;
using bf16x8=__attribute__((ext_vector_type(8)))short;
using s16x4=__attribute__((ext_vector_type(4)))short;
using f32x16=__attribute__((ext_vector_type(16)))float;
using u32x4=__attribute__((ext_vector_type(4)))unsigned;
constexpr int D=64;
constexpr int NW=8,QBLK=32,QB=QBLK*NW,KVBLK=64;

__device__ __forceinline__ int crow(int r,int hi){return (r&3)+8*(r>>2)+4*hi;}
#define SBAR() __builtin_amdgcn_sched_barrier(0)
__device__ __forceinline__ void cmask(f32x16&p0,f32x16&p1,int jb,int qrel,int hi){
  const float NEG=-INFINITY; int kb=64*jb+4*hi;
  #pragma unroll
  for(int r=0;r<16;++r){int kv=kb+(r&3)+8*(r>>2); if(kv>qrel)p0[r]=NEG; if(kv+32>qrel)p1[r]=NEG;}
}

constexpr int NSLOT=3, SLOTB=8192;
constexpr int KSLOTB=12288;
constexpr int LDS_K=0, LDS_V=NSLOT*KSLOTB, LDS_WS=LDS_V+NSLOT*SLOTB, LDS_OST=LDS_WS+NW*64*4, LDS_BYTES=LDS_OST+NW*4096;
constexpr float C2=0.125f*1.4426950408889634f;
__device__ __forceinline__ void glds16(const void*gsrc,unsigned lds_dst){unsigned keep;
  asm volatile("s_mov_b32 %0, m0\n\ts_mov_b32 m0, %2\n\ts_nop 0\n\tglobal_load_lds_dwordx4 %1, off\n\ts_mov_b32 m0, %0":"=&s"(keep):"v"(gsrc),"s"(lds_dst):"memory");}
__device__ __forceinline__ float max3f(float a,float b,float c){float r;asm("v_max3_f32 %0, %1, %2, %3":"=v"(r):"v"(a),"v"(b),"v"(c));return r;}
__device__ __forceinline__ float max2f(float a,float b){float r;asm("v_max_f32_e32 %0, %1, %2":"=v"(r):"v"(a),"v"(b));return r;}
__device__ __forceinline__ float fadd_s(float a,float b){float r;asm("v_add_f32_e32 %0, %1, %2":"=v"(r):"v"(a),"v"(b));return r;}
__device__ __forceinline__ float fsub_s(float a,float b){float r;asm("v_sub_f32_e32 %0, %1, %2":"=v"(r):"v"(a),"v"(b));return r;}
typedef float f32x2_t __attribute__((ext_vector_type(2))); typedef __bf16 bf16x2_t __attribute__((ext_vector_type(2)));
__device__ __forceinline__ unsigned cvtpk_s(float lo,float hi){f32x2_t v={lo,hi};bf16x2_t b=__builtin_convertvector(v,bf16x2_t);return __builtin_bit_cast(unsigned,b);}
#define KOFF(sl) ((sl)+((sl)>>1))
#define WAIT_BAR(N) asm volatile("s_waitcnt vmcnt(" #N ") lgkmcnt(0)\n\ts_barrier":::"memory")

__device__ __forceinline__ void qkt(f32x16&p0,f32x16&p1,const char*Kslot,const bf16x8*qr,const f32x16&negm,int r32,int hi){
  const char*kb=Kslot+hi*1024+r32*16;
  #pragma unroll
  for(int d0=0;d0<6;++d0){
    const bf16x8 b0=*reinterpret_cast<const bf16x8*>(kb+d0*2048);
    const bf16x8 b1=*reinterpret_cast<const bf16x8*>(kb+d0*2048+512);
    if(d0==0){p0=__builtin_amdgcn_mfma_f32_32x32x16_bf16(b0,qr[0],negm,0,0,0);p1=__builtin_amdgcn_mfma_f32_32x32x16_bf16(b1,qr[0],negm,0,0,0);}
    else{p0=__builtin_amdgcn_mfma_f32_32x32x16_bf16(b0,qr[d0],p0,0,0,0);p1=__builtin_amdgcn_mfma_f32_32x32x16_bf16(b1,qr[d0],p1,0,0,0);}}
}
typedef __attribute__((address_space(3))) const char* lds_cptr;
typedef short v4i16_t __attribute__((ext_vector_type(4)));
__device__ __forceinline__ void kload12(bf16x8*kf,lds_cptr kp){
  kf[0]=*(const __attribute__((address_space(3))) bf16x8*)(kp);      kf[1]=*(const __attribute__((address_space(3))) bf16x8*)(kp+512);
  kf[2]=*(const __attribute__((address_space(3))) bf16x8*)(kp+2048); kf[3]=*(const __attribute__((address_space(3))) bf16x8*)(kp+2560);
  kf[4]=*(const __attribute__((address_space(3))) bf16x8*)(kp+4096); kf[5]=*(const __attribute__((address_space(3))) bf16x8*)(kp+4608);
  kf[6]=*(const __attribute__((address_space(3))) bf16x8*)(kp+6144); kf[7]=*(const __attribute__((address_space(3))) bf16x8*)(kp+6656);
  kf[8]=*(const __attribute__((address_space(3))) bf16x8*)(kp+8192); kf[9]=*(const __attribute__((address_space(3))) bf16x8*)(kp+8704);
  kf[10]=*(const __attribute__((address_space(3))) bf16x8*)(kp+10240); kf[11]=*(const __attribute__((address_space(3))) bf16x8*)(kp+10752);
}
__device__ __forceinline__ void kload2(bf16x8*kf,lds_cptr kp,int j){ kf[2*j]=*(const __attribute__((address_space(3))) bf16x8*)(kp+j*2048); kf[2*j+1]=*(const __attribute__((address_space(3))) bf16x8*)(kp+j*2048+512); }
__device__ __forceinline__ s16x4 vtr(lds_cptr p){ return __builtin_bit_cast(s16x4,__builtin_amdgcn_ds_read_tr16_b64_v4i16((__attribute__((address_space(3))) v4i16_t*)p)); }
__device__ __forceinline__ float rowmax(const f32x16&p0,const f32x16&p1){
  float a=max3f(p0[0],p0[1],p1[0]),b=max3f(p0[2],p0[3],p1[1]);a=max3f(a,p1[2],p1[3]);
  #pragma unroll
  for(int r=4;r<16;r+=4){a=max3f(a,p0[r],p0[r+1]);b=max3f(b,p0[r+2],p0[r+3]);a=max3f(a,p1[r],p1[r+1]);b=max3f(b,p1[r+2],p1[r+3]);}
  const float m=max2f(a,b);
  auto rr=__builtin_amdgcn_permlane32_swap(__float_as_uint(m),__float_as_uint(m),false,false);
  return max2f(__uint_as_float(rr[0]),__uint_as_float(rr[1]));
}
__device__ __forceinline__ void pv(f32x16*o,int vb,bf16x8 pa0,bf16x8 pa1,bf16x8 pa2,bf16x8 pa3){
  #pragma unroll
  for(int d0=0;d0<2;++d0){s16x4 lo[4],hi[4];
    #pragma unroll
    for(int ks=0;ks<4;++ks){
      asm volatile("ds_read_b64_tr_b16 %0,%1 offset:%c2":"=&v"(lo[ks]):"v"(vb),"i"(d0*4096+ks*1024):"memory");
      asm volatile("ds_read_b64_tr_b16 %0,%1 offset:%c2":"=&v"(hi[ks]):"v"(vb),"i"(d0*4096+ks*1024+512):"memory");}
    asm volatile("s_waitcnt lgkmcnt(0)":::"memory");SBAR();
    #define PK(k) (bf16x8){lo[k][0],lo[k][1],lo[k][2],lo[k][3],hi[k][0],hi[k][1],hi[k][2],hi[k][3]}
    o[d0]=__builtin_amdgcn_mfma_f32_32x32x16_bf16(pa0,PK(0),o[d0],0,0,0);
    o[d0]=__builtin_amdgcn_mfma_f32_32x32x16_bf16(pa1,PK(1),o[d0],0,0,0);
    o[d0]=__builtin_amdgcn_mfma_f32_32x32x16_bf16(pa2,PK(2),o[d0],0,0,0);
    o[d0]=__builtin_amdgcn_mfma_f32_32x32x16_bf16(pa3,PK(3),o[d0],0,0,0);
    #undef PK
  }
}

#ifndef ATTN_STORE16
#define ATTN_STORE16(p,v) (*(u32x4*)(p)=(v))
#endif
template<int THRL> __device__ __forceinline__ void attn_unit(long q0,const bf16*Q,int qp,int qcol,const bf16*__restrict__ K,int kp,int kcol,const bf16*__restrict__ V,int vp,int vcol,long kv0,int NT,bf16*O,int op,int ocol,char*shm,const float*qgain,const float*T16){
  int tid_=threadIdx.x; asm volatile("":"+v"(tid_));
  const int tid=tid_,lane=tid&63,r32=lane&31,hi=lane>>5; const int wid=__builtin_amdgcn_readfirstlane(tid>>6);
#ifdef ATT_STATIC_PRIO
  if(wid>=4)__builtin_amdgcn_s_setprio(1);
#endif
  const bf16*Qw=Q+(q0+wid*QBLK)*qp+qcol;
  const bf16*Kh=K+kv0*kp+kcol,*Vh=V+kv0*vp+vcol;
  const unsigned lds0=(unsigned)(uintptr_t)shm;
  float*wsf=(float*)(shm+LDS_WS)+wid*64;
  const bf16*ksrc=Kh+(long)lane*kp+wid*8;
  const bf16*vsrc=Vh+(long)(16*(wid&3)+(lane>>2))*vp+(wid>>2)*32+(lane&3)*8;
  const unsigned kdst=lds0+LDS_K+wid*1024, vdst=lds0+LDS_V+wid*1024, kdst2=lds0+LDS_K+(8+wid)*1024;
  const bf16*ksrc2=Kh+(long)lane*kp+64+wid*8;
  const bool big=wid<4;
  #define DMA_K(t,slot) do{ glds16(ksrc+(long)(t)*KVBLK*kp,(unsigned)__builtin_amdgcn_readfirstlane(kdst+KOFF(slot))); if(big) glds16(ksrc2+(long)(t)*KVBLK*kp,(unsigned)__builtin_amdgcn_readfirstlane(kdst2+KOFF(slot))); }while(0)
  #define WAITKV() do{ if(big){WAIT_BAR(3);} else {WAIT_BAR(2);} }while(0)
  #define DMA_V(t,slot) glds16(vsrc+(long)(t)*KVBLK*vp,(unsigned)__builtin_amdgcn_readfirstlane(vdst+(slot)))
  const int vb0=(int)(lds0+LDS_V)+((lane>>4)&1)*32+(lane&3)*8+(4*hi+((lane&15)>>2))*64;
  const char*Kbase=shm+LDS_K; bf16x8 kf[12];
  const lds_cptr shm3=(lds_cptr)shm; const lds_cptr kp0=shm3+LDS_K+hi*1024+r32*16; const lds_cptr vp0=shm3+LDS_V+((lane>>4)&1)*32+(lane&3)*8+(4*hi+((lane&15)>>2))*64;
  DMA_K(0,0);DMA_V(0,0);DMA_K(1,SLOTB);
  bf16x8 qr[6];
  #pragma unroll
  for(int d0=0;d0<6;++d0)qr[d0]=*reinterpret_cast<const bf16x8*>(&Qw[(long)r32*qp+d0*16+hi*8]);
  {
    float f[6][8]; float ss=0.f;
    #pragma unroll
    for(int d0=0;d0<6;++d0)
      #pragma unroll
      for(int j=0;j<8;++j){ f[d0][j]=__uint_as_float(((unsigned)(unsigned short)qr[d0][j])<<16); ss+=f[d0][j]*f[d0][j]; }
    ss+=__shfl_xor(ss,32);
    const float rn=rsqrtf(ss*(1.f/96.f)+EPS)*C2_96;
    #pragma unroll
    for(int d0=0;d0<6;++d0)
      #pragma unroll
      for(int j=0;j<8;++j) f[d0][j]=f[d0][j]*rn*qgain[d0*16+hi*8+j];
    const int tq=(int)((q0+wid*QBLK+r32)%S); const int grow=tq/GW,gcol=tq%GW;
    #pragma unroll
    for(int part=0;part<2;++part){ const int pos=part?gcol:grow;
      #pragma unroll
      for(int j=0;j<8;++j){ const float cs=T16[pos*8+j],sn=T16[512+pos*8+j];
        const float mine=f[4+part][j],other=__shfl_xor(mine,32);
        f[4+part][j]=hi==0?(mine*cs-other*sn):(other*sn+mine*cs); } }
    #pragma unroll
    for(int d0=0;d0<6;++d0)
      #pragma unroll
      for(int j=0;j<4;++j){ const unsigned w=cvtpk_s(f[d0][2*j],f[d0][2*j+1]); qr[d0][2*j]=(short)(w&0xffff); qr[d0][2*j+1]=(short)(w>>16); }
  }
  float mhat=0.f,l_reg=0.f;f32x16 o[2];o[0]=f32x16{};o[1]=f32x16{};f32x16 negm=f32x16{};asm volatile("":"+v"(negm));
  #define CMASK(P0,P1,t) do{}while(0)
  bool resc=false;
  #define START(P0,P1) do{ const float rm=rowmax(P0,P1); resc=false; \
    { const float dl=rm; mhat=fadd_s(mhat,dl); \
      _Pragma("unroll") for(int r=0;r<16;++r){P0[r]=fsub_s(P0[r],dl);P1[r]=fsub_s(P1[r],dl);} \
      _Pragma("unroll") for(int r=0;r<16;++r)negm[r]=-mhat; asm volatile("":"+v"(negm)); } \
    _Pragma("unroll") for(int r=0;r<16;++r)P0[r]=__builtin_amdgcn_exp2f(P0[r]); }while(0)
  #define RESC() do{ if(resc){ asm volatile("s_waitcnt lgkmcnt(0)":::"memory"); \
      _Pragma("unroll") for(int d_=0;d_<2;++d_) _Pragma("unroll") for(int r=0;r<16;++r)o[d_][r]*=wsf[crow(r,hi)]; } }while(0)
  f32x16 pA0,pA1,pB0,pB1;
  int sl_prev=0,sl_cur=0,sl_next=SLOTB;
  #define ROT() do{sl_prev=sl_cur;sl_cur=sl_next;sl_next=(sl_next==(NSLOT-1)*SLOTB)?0:sl_next+SLOTB;}while(0)
  DMA_K(2,2*SLOTB);
  if(big){WAIT_BAR(5);}else{WAIT_BAR(3);}
  qkt(pA0,pA1,Kbase,qr,negm,r32,hi);asm volatile("s_nop 15\n\ts_nop 7":"+v"(pA0),"+v"(pA1));CMASK(pA0,pA1,0);
  START(pA0,pA1);
  _Pragma("unroll") for(int r=0;r<16;++r)pA1[r]=__builtin_amdgcn_exp2f(pA1[r]);
  WAIT_BAR(0);
  DMA_K(3,0);DMA_V(1,SLOTB);
  ROT();
  kload12(kf,kp0+KOFF(sl_cur));
  WAITKV();
  s16x4 vlo[8],vhi[8]; u32x4 pw0,pw1,pw2,pw3;
  #define PKW(P,B) cvtpk_s(P[B],P[B+1])
  #define PAF(k) __builtin_bit_cast(bf16x8,pw##k)
  #define VFR(i) (bf16x8){vlo[i][0],vlo[i][1],vlo[i][2],vlo[i][3],vhi[i][0],vhi[i][1],vhi[i][2],vhi[i][3]}
  #define PIN(x) asm volatile("":"+v"(x))
  #define MX3(a,b,c) __builtin_fmaxf(__builtin_fmaxf((a),(b)),(c))
  #define GAPA(MF,A0,A1,A2,A3,W0,W1,PW) do{ MF; sacc+=A0; sacc+=A1; sacc+=A2; sacc+=A3; PIN(sacc); W0; W1; PIN(PW); SBAR(); }while(0)
  #define EX(v) __builtin_amdgcn_exp2f(v)
  #define GAPB(MF,X,B) do{ MF; X[B]=EX(X[B]); X[B+1]=EX(X[B+1]); X[B+2]=EX(X[B+2]); X[B+3]=EX(X[B+3]); PIN(X); SBAR(); }while(0)
  #define VRD(i) do{ vlo[i]=vtr(vp_+(((i)>>2)*4096+((i)&3)*1024)); vhi[i]=vtr(vp_+(((i)>>2)*4096+((i)&3)*1024+512)); }while(0)
  #define KRD(G,j) do{ if(G){ kload2(kf,kp0+KOFF(sl_next),j); SBAR(); } }while(0)
  #define STEP(C0,C1,P0,P1,t,GK,GV,GL) do{ SBAR(); \
    const lds_cptr vp_=vp0+sl_prev; \
    VRD(0); SBAR(); float sacc=(P0[0]+P0[1]); \
    GAPA(C0=__builtin_amdgcn_mfma_f32_32x32x16_bf16(kf[0],qr[0],negm,0,0,0), P0[2],P0[3],P0[4],P0[5],     pw0[0]=PKW(P0,0), pw0[1]=PKW(P0,2), pw0); \
    VRD(4); SBAR(); GAPA(C1=__builtin_amdgcn_mfma_f32_32x32x16_bf16(kf[1],qr[0],negm,0,0,0), P0[6],P0[7],P0[8],P0[9],     pw0[2]=PKW(P0,4), pw0[3]=PKW(P0,6), pw0); \
    VRD(1); SBAR(); GAPA(C0=__builtin_amdgcn_mfma_f32_32x32x16_bf16(kf[2],qr[1],C0,0,0,0),   P0[10],P0[11],P0[12],P0[13], pw1[0]=PKW(P0,8), pw1[1]=PKW(P0,10), pw1); \
    VRD(5); SBAR(); GAPA(C1=__builtin_amdgcn_mfma_f32_32x32x16_bf16(kf[3],qr[1],C1,0,0,0),   P0[14],P0[15],P1[0],P1[1],   pw1[2]=PKW(P0,12),pw1[3]=PKW(P0,14), pw1); \
    VRD(2); SBAR(); GAPA(C0=__builtin_amdgcn_mfma_f32_32x32x16_bf16(kf[4],qr[2],C0,0,0,0),   P1[2],P1[3],P1[4],P1[5],     pw2[0]=PKW(P1,0), pw2[1]=PKW(P1,2), pw2); \
    VRD(6); SBAR(); GAPA(C1=__builtin_amdgcn_mfma_f32_32x32x16_bf16(kf[5],qr[2],C1,0,0,0),   P1[6],P1[7],P1[8],P1[9],     pw2[2]=PKW(P1,4), pw2[3]=PKW(P1,6), pw2); \
    VRD(3); SBAR(); GAPA(C0=__builtin_amdgcn_mfma_f32_32x32x16_bf16(kf[6],qr[3],C0,0,0,0),   P1[10],P1[11],P1[12],P1[13], pw3[0]=PKW(P1,8), pw3[1]=PKW(P1,10), pw3); \
    VRD(7); SBAR(); GAPA(C1=__builtin_amdgcn_mfma_f32_32x32x16_bf16(kf[7],qr[3],C1,0,0,0),   P1[14],P1[15],0.f,0.f,       pw3[2]=PKW(P1,12),pw3[3]=PKW(P1,14), pw3); \
    C0=__builtin_amdgcn_mfma_f32_32x32x16_bf16(kf[8],qr[4],C0,0,0,0); SBAR(); C1=__builtin_amdgcn_mfma_f32_32x32x16_bf16(kf[9],qr[4],C1,0,0,0); SBAR(); \
    C0=__builtin_amdgcn_mfma_f32_32x32x16_bf16(kf[10],qr[5],C0,0,0,0); SBAR(); C1=__builtin_amdgcn_mfma_f32_32x32x16_bf16(kf[11],qr[5],C1,0,0,0); SBAR(); \
    l_reg+=sacc; \
    if(GK){DMA_K((t)+3,sl_cur);} if(GV){DMA_V((t)+1,sl_next);} \
    CMASK(C0,C1,t); \
    { float a=MX3(C0[0],C0[1],C1[0]),b=MX3(C0[2],C0[3],C1[1]); a=MX3(a,C1[2],C1[3]); \
      _Pragma("unroll") for(int r=4;r<16;r+=4){a=MX3(a,C0[r],C0[r+1]);b=MX3(b,C0[r+2],C0[r+3]);a=MX3(a,C1[r],C1[r+1]);b=MX3(b,C1[r+2],C1[r+3]);} \
      float rm=__builtin_fmaxf(a,b); { auto rr=__builtin_amdgcn_permlane32_swap(__float_as_uint(rm),__float_as_uint(rm),false,false); rm=__builtin_fmaxf(__uint_as_float(rr[0]),__uint_as_float(rr[1])); } \
      resc=false; \
      if(__builtin_expect(__any(rm>(float)THRL),0)){ const float dl=__builtin_fmaxf(rm,0.f); mhat+=dl; \
        _Pragma("unroll") for(int r=0;r<16;++r){C0[r]-=dl;C1[r]-=dl;} \
        _Pragma("unroll") for(int r=0;r<16;++r)negm[r]=-mhat; asm volatile("":"+v"(negm)); \
        const float f=__builtin_amdgcn_exp2f(-dl); l_reg*=f; if(hi==0)wsf[r32]=f; resc=true; } } \
    SBAR(); \
    GAPB(o[0]=__builtin_amdgcn_mfma_f32_32x32x16_bf16(PAF(0),VFR(0),o[0],0,0,0), C0,0); \
    KRD(GL,0); GAPB(o[1]=__builtin_amdgcn_mfma_f32_32x32x16_bf16(PAF(0),VFR(4),o[1],0,0,0), C0,4); \
    KRD(GL,1); GAPB(o[0]=__builtin_amdgcn_mfma_f32_32x32x16_bf16(PAF(1),VFR(1),o[0],0,0,0), C0,8); \
    KRD(GL,2); GAPB(o[1]=__builtin_amdgcn_mfma_f32_32x32x16_bf16(PAF(1),VFR(5),o[1],0,0,0), C0,12); \
    KRD(GL,3); GAPB(o[0]=__builtin_amdgcn_mfma_f32_32x32x16_bf16(PAF(2),VFR(2),o[0],0,0,0), C1,0); \
    KRD(GL,4); GAPB(o[1]=__builtin_amdgcn_mfma_f32_32x32x16_bf16(PAF(2),VFR(6),o[1],0,0,0), C1,4); \
    KRD(GL,5); GAPB(o[0]=__builtin_amdgcn_mfma_f32_32x32x16_bf16(PAF(3),VFR(3),o[0],0,0,0), C1,8); \
    GAPB(o[1]=__builtin_amdgcn_mfma_f32_32x32x16_bf16(PAF(3),VFR(7),o[1],0,0,0), C1,12); \
    }while(0)
  int t=1;
  #undef CMASK
  #define CMASK(P0,P1,t) do{}while(0)
  for(;t+5<NT;t+=2){
    STEP(pB0,pB1,pA0,pA1,t,true,true,true);     WAITKV(); RESC(); ROT();
    STEP(pA0,pA1,pB0,pB1,t+1,true,true,true);   WAITKV(); RESC(); ROT();
  }
  #undef CMASK
  #define CMASK(P0,P1,t) do{}while(0)
  #define ENDW(tt) do{ if((tt)+3<NT){WAITKV();} else if((tt)+2<NT){WAIT_BAR(1);} else {WAIT_BAR(0);} }while(0)
  for(;t+1<NT;t+=2){
    STEP(pB0,pB1,pA0,pA1,t,(t+3<NT),(t+1<NT),(t+1<NT));       ENDW(t);   RESC(); ROT();
    STEP(pA0,pA1,pB0,pB1,t+1,(t+4<NT),(t+2<NT),(t+2<NT));     ENDW(t+1); RESC(); ROT();
  }
  STEP(pB0,pB1,pA0,pA1,NT-1,false,false,false); RESC();
  { float sacc=pB0[0]+pB0[1]; _Pragma("unroll") for(int r=2;r<16;++r)sacc+=pB0[r]; _Pragma("unroll") for(int r=0;r<16;++r)sacc+=pB1[r]; l_reg+=sacc;
    pw0=(u32x4){PKW(pB0,0),PKW(pB0,2),PKW(pB0,4),PKW(pB0,6)};pw1=(u32x4){PKW(pB0,8),PKW(pB0,10),PKW(pB0,12),PKW(pB0,14)};pw2=(u32x4){PKW(pB1,0),PKW(pB1,2),PKW(pB1,4),PKW(pB1,6)};pw3=(u32x4){PKW(pB1,8),PKW(pB1,10),PKW(pB1,12),PKW(pB1,14)};
    SBAR(); pv(o,vb0+sl_cur,PAF(0),PAF(1),PAF(2),PAF(3)); }
  #undef PKW
  #undef PAF
  #undef VFR
  #undef PIN
  #undef MX3
  #undef GAPA
  #undef GAPB
  #undef EX
  #undef VRD
  #undef KRD
  #undef STEP
  #undef ENDW
  {auto rr=__builtin_amdgcn_permlane32_swap(__float_as_uint(l_reg),__float_as_uint(l_reg),false,false);l_reg=__uint_as_float(rr[0])+__uint_as_float(rr[1]);}
  if(hi==0)wsf[32+r32]=l_reg;asm volatile("s_waitcnt lgkmcnt(0)":::"memory");
  float rli[16];
  #pragma unroll
  for(int r=0;r<16;++r)rli[r]=__builtin_amdgcn_rcpf(wsf[32+crow(r,hi)]);
  bf16*Ow=O+(q0+wid*QBLK)*op+ocol;
  { bf16*stg=(bf16*)(shm+LDS_OST)+wid*2048;
    #pragma unroll
    for(int r=0;r<16;++r){const int orow=crow(r,hi);
      #pragma unroll
      for(int d0=0;d0<2;++d0)stg[orow*64+d0*32+r32]=__float2bfloat16(o[d0][r]*rli[r]);}
    asm volatile("s_waitcnt lgkmcnt(0)":::"memory");
    #pragma unroll
    for(int i=0;i<4;++i){const int row=i*8+(lane>>3),ch=lane&7; const u32x4 v=*(const u32x4*)(stg+row*64+ch*8); ATTN_STORE16(Ow+(long)row*op+ch*8,v);} }
#ifdef ATT_STATIC_PRIO
  __builtin_amdgcn_s_setprio(0);
#endif
  asm volatile("s_waitcnt lgkmcnt(0)\n\ts_barrier":::"memory");
  #undef DMA_K
  #undef WAITKV
  #undef DMA_V
  #undef CMASK
  #undef START
  #undef RESC
  #undef ROT
}
constexpr int ATTN_LDS_BYTES=LDS_BYTES;

#undef SBAR
#undef WAIT_BAR
#undef KOFF
}
#define LAS __attribute__((address_space(3)))
#define XB_TMO      128
#define XB_XCNT(j)  (256  + 64 * (j))
#define XB_XSUB(j)  (1280 + 64 * (j))
#define XB_XGEN(j)  (2304 + 64 * (j))
#define XB_TOP      3328
#define XB_TOPGEN   3392
#define XCD_BAR_WORDS 3456
#define XB_CTXH     3520
#define XB_SPIN_CAP (1u << 18)

__device__ __forceinline__ unsigned xb_ld(unsigned* p)              { return __hip_atomic_load(p, __ATOMIC_RELAXED, __HIP_MEMORY_SCOPE_AGENT); }
__device__ __forceinline__ unsigned xb_add(unsigned* p, unsigned v) { return __hip_atomic_fetch_add(p, v, __ATOMIC_RELAXED, __HIP_MEMORY_SCOPE_AGENT); }
__device__ __forceinline__ unsigned xb_xcc_id() { return (unsigned)__builtin_amdgcn_s_getreg((3 << 11) | 20) & 0xFu; }
#define XB_SPIN(cond, bar) do { unsigned _sp = 0; while (cond) { __builtin_amdgcn_s_sleep(1); \
    if ((++_sp & 255u) == 0u) { if (xb_ld(&(bar)[XB_TMO])) break; if (_sp > XB_SPIN_CAP) { atomicAdd(&(bar)[XB_TMO], 1u); break; } } } } while (0)

struct XcdBarrier {
    unsigned* bar; unsigned x;
    volatile LAS unsigned* st;
};

__device__ __forceinline__ XcdBarrier xcd_barrier_post(unsigned* bar, volatile LAS unsigned* st) {
    XcdBarrier b; b.bar = bar; b.x = xb_xcc_id(); b.st = st;
    if (threadIdx.x == 0) (void)xb_add(&bar[XB_XCNT(b.x)], 1u);
    return b;
}
__device__ __forceinline__ void xcd_barrier_complete(unsigned* bar, unsigned x, unsigned& nloc, unsigned& nx) {
    const unsigned G = gridDim.x * gridDim.y * gridDim.z;
    unsigned sum, cnt, mine, sp = 0u;
    for (;;) {
        sum = 0u; cnt = 0u; mine = 0u;
#pragma unroll
        for (unsigned j = 0; j < 16; ++j) { const unsigned c = xb_ld(&bar[XB_XCNT(j)]); sum += c; cnt += (c > 0u) ? 1u : 0u; mine = (j == x) ? c : mine; }
        if (sum == G) break;
        __builtin_amdgcn_s_sleep(1);
        if ((++sp & 255u) == 0u) { if (xb_ld(&bar[XB_TMO])) break; if (sp > XB_SPIN_CAP) { atomicAdd(&bar[XB_TMO], 1u); break; } }
    }
    nloc = mine > 0u ? mine : 1u; nx = cnt > 0u ? cnt : 1u;
}

__device__ __forceinline__ void xcd_barrier(const XcdBarrier& b) {
    asm volatile("s_waitcnt vmcnt(0)" ::: "memory");
    __syncthreads();
    if (threadIdx.x == 0) {
        unsigned* bar = b.bar;
        __builtin_amdgcn_s_waitcnt(0);
        unsigned nloc = b.st[0], nx = b.st[1];
        if (nloc == 0u) { xcd_barrier_complete(bar, b.x, nloc, nx); b.st[0] = nloc; b.st[1] = nx; }
        const unsigned old = xb_add(&bar[XB_XSUB(b.x)], 1u);
        const unsigned gen = old / nloc;
        if (old + 1u == (gen + 1u) * nloc) {
            __builtin_amdgcn_fence(__ATOMIC_RELEASE, "agent");
            asm volatile("s_waitcnt vmcnt(0)" ::: "memory");
            const unsigned og = xb_add(&bar[XB_TOP], 1u);
            const unsigned tg = og / nx;
            if (og + 1u == (tg + 1u) * nx) xb_add(&bar[XB_TOPGEN], 1u);
            else XB_SPIN(xb_ld(&bar[XB_TOPGEN]) == tg, bar);
            __builtin_amdgcn_fence(__ATOMIC_ACQUIRE, "agent");
            xb_add(&bar[XB_XGEN(b.x)], 1u);
            asm volatile("s_waitcnt vmcnt(0)" ::: "memory");
        } else {
            XB_SPIN(xb_ld(&bar[XB_XGEN(b.x)]) == gen, bar);
            __builtin_amdgcn_fence(__ATOMIC_ACQUIRE, "agent");
            asm volatile("s_waitcnt vmcnt(0)" ::: "memory");
        }
    }
    __syncthreads();
}
namespace mk {
#ifndef KVROT
#define KVROT 0
#endif
#ifndef ALIGN2
#define ALIGN2 true
#endif
#ifndef ALIGN1
#define ALIGN1 true
#endif
#define MLAS __attribute__((address_space(3)))
constexpr int NWAVES = 8, NTHR = 512;
constexpr int RING_BYTES = 131072;
constexpr int LDS_BYTES = 147456;
constexpr int NPHASE = 16;
typedef unsigned v4u __attribute__((ext_vector_type(4)));
typedef float f32x4 __attribute__((ext_vector_type(4)));

struct Ctx {
    Params p; MLAS unsigned char* lds; char* lds_g; int wave, G, vcu, bid;
};
__device__ __forceinline__ int tid_now() { int t = threadIdx.x; asm volatile("" : "+v"(t)); return t; }
__device__ __forceinline__ unsigned pk2(float lo, float hi) { return (unsigned)f2bf(lo) | ((unsigned)f2bf(hi) << 16); }

enum { W_IN0 = 0, W_OUT0, W_GU0, W_D0, W_IN1, W_UQ, W_UKV, W_OUT1, W_GU1, W_D1, NWMAT };
struct SrcBlk { const float* W; int ld; int col; const float* kscale; };
__device__ __forceinline__ SrcBlk src_of(const Params& p, int mat, int nb) {
    SrcBlk s; s.kscale = nullptr; const int pn = nb >> 3, q = nb & 7, bj = q >> 2, wc = q & 3;
    switch (mat) {
    case W_IN0: s.W = p.in[I0_WIN]; s.ld = L0_IN; s.col = 256 * pn + 64 * wc + 32 * bj; break;
    case W_OUT0: s.W = p.in[I0_WOUT]; s.ld = D; s.col = 32 * nb; break;
    case W_GU0: s.W = bj ? p.in[I0_WU] : p.in[I0_WG]; s.ld = FF; s.col = 128 * pn + 32 * wc; break;
    case W_D0: s.W = p.in[I0_WD]; s.ld = D; s.col = 32 * nb; break;
    case W_IN1: s.W = p.in[I1_WIN]; s.ld = L1_IN;
        if (pn == 0) s.col = 128 * bj + 32 * wc;
        else if (pn == 1) { if (bj == 0) s.col = 256 + 32 * wc; else s.col = 640; }
        else if (pn == 2) s.col = 384 + 128 * bj + 32 * wc;
        else if (pn < 5) s.col = 672 + (pn - 3) * 256 + 64 * wc + 32 * bj;
        else if (pn < 7) s.col = 1184 + (pn - 5) * 256 + 64 * wc + 32 * bj;
        else s.col = 1696 + (pn - 7) * 256 + 64 * wc + 32 * bj;
        break;
    case W_UQ: s.W = p.in[I1_WUQ]; s.ld = 768; s.col = 32 * nb; s.kscale = p.in[I1_QAG]; break;
    case W_UKV: s.W = p.in[I1_WUKV]; s.ld = 1024; s.col = (2 * pn + (wc >> 1)) * 128 + (wc & 1) * 64 + 32 * bj; s.kscale = p.in[I1_KVAG]; break;
    case W_OUT1: s.W = p.in[I1_WOUT]; s.ld = D; s.col = 32 * nb; break;
    case W_GU1: s.W = bj ? p.in[I1_WU] : p.in[I1_WG]; s.ld = FF; s.col = 128 * pn + 32 * wc; break;
    default: s.W = p.in[I1_WD]; s.ld = D; s.col = 32 * nb; break;
    }
    return s;
}
struct WMat { size_t ws_off; int K, N; };
__host__ __device__ constexpr WMat wmat(int mat) {
    switch (mat) {
    case W_IN0: return {WS_W_IN0, D, 1536}; case W_OUT0: return {WS_W_OUT0, D, D}; case W_GU0: return {WS_W_GU0, D, 2 * FF}; case W_D0: return {WS_W_D0, FF, D};
    case W_IN1: return {WS_W_IN1, D, L1_INP}; case W_UQ: return {WS_W_UQ, 384, 768}; case W_UKV: return {WS_W_UKV, 256, 1024}; case W_OUT1: return {WS_W_OUT1, D, D};
    case W_GU1: return {WS_W_GU1, D, 2 * FF}; default: return {WS_W_D1, FF, D};
    }
}
template <int mat> __device__ __forceinline__ void transpose_item(const Params& p, int item, MLAS float* scr, int lane) {
    const WMat wm = wmat(mat); const int nblk = wm.N / 32, kb = item / nblk, nb = item % nblk, k0 = 64 * kb;
    const SrcBlk s = src_of(p, mat, nb);
    bf16_t* WT = (bf16_t*)(p.ws + wm.ws_off);
    const int c = lane & 7;
    if (s.W == nullptr) {
#pragma unroll
        for (int j = 0; j < 4; ++j) { const int n = (lane >> 3) + 8 * j; *(v4u*)(WT + (size_t)(32 * nb + n) * wm.K + k0 + 8 * c) = (v4u){0u, 0u, 0u, 0u}; }
        return;
    }
    MLAS float* t0 = scr; MLAS float* t1 = scr + 64 * 33;
    if (mat == W_OUT0 && kb < 4) return;
    constexpr bool fused_pool = false;
    { const int c4 = (lane & 7) * 4, kr = lane >> 3;
        const float* wsrc = s.W + (size_t)(k0 + kr) * s.ld + s.col + c4;
        f32x4 v[8];
#pragma unroll
        for (int i = 0; i < 8; ++i) v[i] = *(const f32x4*)(wsrc + (size_t)(8 * i) * s.ld);
#pragma unroll
        for (int i = 0; i < 8; ++i) { const int kk = kr + 8 * i; float sc = 1.f;
            if (s.kscale) sc = s.kscale[k0 + kk];
            if (fused_pool) sc *= p.in[I0_POOLS][k0 + kk];
            MLAS float* d = t0 + kk * 33 + c4; d[0] = v[i][0] * sc; d[1] = v[i][1] * sc; d[2] = v[i][2] * sc; d[3] = v[i][3] * sc; } }
    asm volatile("s_waitcnt lgkmcnt(0)" ::: "memory");
    MLAS float* src = t0;
    if (fused_pool) {
        const float* pw = p.in[I0_POOLW] + kb * 4096; const int nn = lane & 31, ch = lane >> 5;
        for (int cc = ch; cc < 64; cc += 2) { float a = 0.f;
#pragma unroll 8
            for (int d = 0; d < 64; ++d) a += pw[cc * 64 + d] * t0[d * 33 + nn];
            t1[cc * 33 + nn] = a; }
        asm volatile("s_waitcnt lgkmcnt(0)" ::: "memory");
        src = t1;
    }
#pragma unroll
    for (int j = 0; j < 4; ++j) { const int n = (lane >> 3) + 8 * j; const MLAS float* sp = src + (8 * c) * 33 + n;
        v4u o; o.x = pk2(sp[0 * 33], sp[1 * 33]); o.y = pk2(sp[2 * 33], sp[3 * 33]); o.z = pk2(sp[4 * 33], sp[5 * 33]); o.w = pk2(sp[6 * 33], sp[7 * 33]);
        *(v4u*)(WT + (size_t)(32 * nb + n) * wm.K + k0 + 8 * c) = o; }
    asm volatile("s_waitcnt lgkmcnt(0)" ::: "memory");
}

#ifndef P0MASK
#define P0MASK 15
#endif
template <int PART> __device__ __forceinline__ void phase_prologue(Ctx& C, int vcu, int G) {
    const Params& p = C.p; const int tid = tid_now(), lane = tid & 63;
    MLAS float* sil = (MLAS float*)C.lds;
    MLAS float* red = (MLAS float*)(C.lds + 9 * 1024 * 4);
    __syncthreads();
#ifdef ADA_SPLIT
    if (PART <= 2)
#else
    if (PART < 2)
#endif
    for (int i = tid; i < 9 * D; i += NTHR) { const int j = i / D, k = i % D; const float c = (j < 8) ? p.in[I_C][j * D + k] : p.in[I_CCTX][k]; sil[i] = c / (1.f + expf(-c)); }
    __syncthreads();
    float* MOD = (float*)(p.ws + WS_MOD);
#ifdef ADA_SPLIT
    constexpr int ADA_N = (PART == 0) ? 32 : (PART == 2) ? 64 : 96, ADA_BASE = (PART == 0) ? 0 : (PART == 2) ? 32 : 96;
    if ((P0MASK & 1) && PART <= 2)
    for (int it0 = vcu; it0 < ADA_N; it0 += G) { const int it = it0 + ADA_BASE;
#else
    if ((P0MASK & 1) && PART < 2)
    for (int it0 = vcu; it0 < 96; it0 += G) { const int it = it0 + 96 * PART;
#endif
        const int l = it / 96, r_ = it % 96, cg_ = r_ >> 2, kq = r_ & 3, n0 = cg_ * 256;
        const float* w = (l ? p.in[I1_ADAW] : p.in[I0_ADAW]) + (size_t)(kq * 256 + C.wave * 32) * 6144 + n0 + 4 * lane;
        f32x4 acc[9];
#pragma unroll
        for (int j = 0; j < 9; ++j) acc[j] = (f32x4){0.f, 0.f, 0.f, 0.f};
#pragma unroll 8
        for (int k = 0; k < 32; ++k) { const f32x4 wv = *(const f32x4*)(w + (size_t)k * 6144); const int kk = kq * 256 + C.wave * 32 + k;
#pragma unroll
            for (int j = 0; j < 9; ++j) acc[j] += wv * sil[j * D + kk]; }
#pragma unroll
        for (int j = 0; j < 9; ++j) *(MLAS f32x4*)(red + (C.wave * 9 + j) * 256 + 4 * lane) = acc[j];
        __syncthreads();
        for (int i = tid; i < 9 * 256; i += NTHR) { const int j = i >> 8, c = i & 255; float sm_ = 0.f;
#pragma unroll
            for (int wv = 0; wv < 8; ++wv) sm_ += red[(wv * 9 + j) * 256 + c];
            if (kq == 0) sm_ += (l ? p.in[I1_ADAB] : p.in[I0_ADAB])[n0 + c];
            atomicAdd(MOD + (size_t)(l * 9 + j) * 6144 + n0 + c, sm_); }
        __syncthreads();
    }
    __syncthreads();
    {
        MLAS float* PA = (MLAS float*)C.lds;
        MLAS float* PB = (MLAS float*)(C.lds + 64 * 65 * 4);
        bf16_t* WT = (bf16_t*)(p.ws + WS_W_OUT0);
#ifdef L0_SPLIT
        constexpr int POOL_PART = 2;
#else
        constexpr int POOL_PART = 0;
#endif
        if (PART == POOL_PART) for (int tile = vcu; tile < 128; tile += G) {
            const int g = tile >> 5, nb = tile & 31;
            for (int i = tid; i < 4096; i += NTHR) PA[(i >> 6) * 65 + (i & 63)] = p.in[I0_POOLW][g * 4096 + i];
            for (int i = tid; i < 2048; i += NTHR) { const int d = i >> 5, nn = i & 31; PB[d * 33 + nn] = p.in[I0_WOUT][(size_t)(g * 64 + d) * D + 32 * nb + nn] * p.in[I0_POOLS][g * 64 + d]; }
            __syncthreads();
            { const int c = tid >> 3, n4 = (tid & 7) * 4; float a0 = 0.f, a1 = 0.f, a2 = 0.f, a3 = 0.f;
#pragma unroll 8
                for (int d = 0; d < 64; ++d) { const float pa = PA[c * 65 + d]; const MLAS float* b = PB + d * 33 + n4; a0 += pa * b[0]; a1 += pa * b[1]; a2 += pa * b[2]; a3 += pa * b[3]; }
                bf16_t* o = WT + (size_t)(32 * nb + n4) * D + g * 64 + c;
                o[0] = f2bf(a0); o[D] = f2bf(a1); o[2 * D] = f2bf(a2); o[3 * D] = f2bf(a3); }
            __syncthreads();
        }
    }
    const int gw = vcu * NWAVES + C.wave, NGW = G * NWAVES;
    MLAS float* scr = (MLAS float*)(C.lds + C.wave * 16896);
    if (P0MASK & 2) {
        int rot = 0;
#define TR_MAT(M) { constexpr int ni = (wmat(M).K / 64) * (wmat(M).N / 32); int first = gw - rot; if (first < 0) first += NGW; \
            for (int it = first; it < ni; it += NGW) transpose_item<M>(p, it, scr, lane); rot = (rot + ni) % NGW; }
        if (PART == 0) { TR_MAT(W_IN0)
#ifndef L0_SPLIT
            TR_MAT(W_OUT0) TR_MAT(W_GU0) TR_MAT(W_D0)
#endif
        }
        else if (PART == 2) { TR_MAT(W_OUT0) TR_MAT(W_GU0)
#if !defined(D0_IN_P6) && !defined(CTXD_IN_P6)
            TR_MAT(W_D0)
#endif
        }
        else if (PART == 3) { TR_MAT(W_D0) }
        else if (PART == 1) { TR_MAT(W_IN1) TR_MAT(W_UQ) TR_MAT(W_UKV)
#ifndef CTXD_IN_P6
            TR_MAT(W_OUT1) TR_MAT(W_GU1) TR_MAT(W_D1)
#endif
        }
        else if (PART == 4) { TR_MAT(W_OUT1) TR_MAT(W_GU1) TR_MAT(W_D1) }
#undef TR_MAT
    }
    if (PART == 0 && (P0MASK & 4) && C.bid == C.G - 1) {
        float* T32 = (float*)(p.ws + WS_ROPE32); float* T16 = (float*)(p.ws + WS_ROPE16);
        for (int i = tid; i < 1024; i += NTHR) { const int pos = i >> 4, f = i & 15; const float ang = (float)pos * powf(10000.0f, -((float)f * 2.0f) / 32.0f); T32[i] = cosf(ang); T32[1024 + i] = sinf(ang); }
        for (int i = tid; i < 512; i += NTHR) { const int pos = i >> 3, f = i & 7; const float ang = (float)pos * powf(10000.0f, -((float)f * 2.0f) / 16.0f); T16[i] = cosf(ang); T16[512 + i] = sinf(ang); }
    }
    if (PART == 0 && (P0MASK & 8)) { float* SSQ = (float*)(p.ws + WS_SSQ); float* SSKV = (float*)(p.ws + WS_SSKV);
        for (int i = C.bid * NTHR + tid; i < MT; i += C.G * NTHR) { SSQ[i] = 0.f; SSKV[i] = 0.f; } }
}

__device__ __forceinline__ void phase_norm(Ctx& C, const float* xl, const float* xc, const float* gain, int layer, int sh_chunk, int sc_chunk, int nrows, const float* slab = nullptr, int nslab = 0, float* xc_wb = nullptr) {
    const int lane = tid_now() & 63;
    const int gw = C.vcu * NWAVES + C.wave, NGW = C.G * NWAVES;
    bf16_t* XN = (bf16_t*)(C.p.ws + WS_XN); const float* MODb = (const float*)(C.p.ws + WS_MOD) + (size_t)layer * 9 * 6144;
    for (int m = gw; m < nrows; m += NGW) {
        const float* xr = m < ML ? xl + (size_t)m * D : xc + (size_t)(m - ML) * D;
        const float* mod = MODb + (size_t)modidx_of(m) * 6144;
        f32x4 v[4]; float ss = 0.f;
#pragma unroll
        for (int j = 0; j < 4; ++j) { v[j] = *(const f32x4*)(xr + 4 * lane + 256 * j);
            if (m >= ML && nslab > 0) { for (int s_ = 0; s_ < nslab; ++s_) v[j] += *(const f32x4*)(slab + (size_t)s_ * MC * D + (size_t)(m - ML) * D + 4 * lane + 256 * j);
                if (xc_wb) *(f32x4*)(xc_wb + (size_t)(m - ML) * D + 4 * lane + 256 * j) = v[j]; }
            ss += (v[j][0] * v[j][0] + v[j][1] * v[j][1]) + (v[j][2] * v[j][2] + v[j][3] * v[j][3]); }
        ss = wave_sum(ss);
        const float r = rsqrtf(ss * (1.f / D) + EPS);
#pragma unroll
        for (int j = 0; j < 4; ++j) { const int c = 4 * lane + 256 * j;
            const f32x4 g = *(const f32x4*)(gain + c), sc = *(const f32x4*)(mod + sc_chunk * D + c), sh = *(const f32x4*)(mod + sh_chunk * D + c);
            const f32x4 y = ((v[j] * r) * g) * (sc + 1.f) + sh;
            uint2 o; o.x = pk2(y[0], y[1]); o.y = pk2(y[2], y[3]);
            *(uint2*)(XN + (size_t)m * D + c) = o; }
    }
}

__device__ __forceinline__ void phase_pool(Ctx& C) {
    const bf16_t* A0 = (const bf16_t*)(C.p.ws + WS_A0); bf16_t* MIX = (bf16_t*)(C.p.ws + WS_MIX);
    const int skip = (C.G > 128) ? 96 : 0;
    if (C.vcu < skip) return;
    const int gt = (C.vcu - skip) * NTHR + tid_now(), NGT = (C.G - skip) * NTHR;
    for (int it = gt; it < MT * 32; it += NGT) {
        const int m = it >> 5, c8 = (it & 31) * 8, g = c8 >> 6, w = 2 << g;
        int t, T; if (m < ML) { t = m % S; T = S; } else { t = (m - ML) % CTX; T = CTX; }
        const int base = m - t; int lo = t - w / 2; if (lo < 0) lo = 0; int hi = t - w / 2 + w; if (hi > T) hi = T;
        float s[8];
#pragma unroll
        for (int e = 0; e < 8; ++e) s[e] = 0.f;
        for (int j = lo; j < hi; ++j) { const v4u q = *(const v4u*)(A0 + (size_t)(base + j) * 256 + c8);
#pragma unroll
            for (int e = 0; e < 4; ++e) { s[2 * e] += __uint_as_float(q[e] << 16); s[2 * e + 1] += __uint_as_float(q[e] & 0xffff0000u); } }
        const v4u q = *(const v4u*)(A0 + (size_t)m * 256 + c8); const float inv = 1.f / (float)(hi - lo);
        v4u o;
#pragma unroll
        for (int e = 0; e < 4; ++e) o[e] = pk2(s[2 * e] * inv - __uint_as_float(q[e] << 16), s[2 * e + 1] * inv - __uint_as_float(q[e] & 0xffff0000u));
        *(v4u*)(MIX + (size_t)m * D + c8) = o;
    }
}


__device__ __forceinline__ void phase_natable(Ctx& C, int vcu, int Gn) {
    bf16_t* G = (bf16_t*)(C.p.ws + WS_NAG); const float* rpb = C.p.in[I1_RPB];
    const int gt = vcu * NTHR + tid_now(), NGT = Gn * NTHR;
    for (int it = gt; it < 8 * 16 * 2 * 64 * 32; it += NGT) {
        const int j = it & 31, kc = (it >> 5) & 63, half = (it >> 11) & 1, dr = (it >> 12) & 15, h = it >> 16;
        const int qc = 32 * half + j, cs = min(max(qc - 8, 0), 48);
        float v = -30000.f;
        if (dr < 15 && (unsigned)(kc - cs) < 16u) v = rpb[(h * 15 + dr) * 31 + (kc - qc + 15)] * LOG2E;
        G[it] = f2bf(v);
    }
}

__device__ __forceinline__ void phase_attn0(Ctx& C) {
    const Params& p = C.p;
    MLAS char* shm = (MLAS char*)C.lds;
    att::UnitDesc U; U.Q = (const bf16_t*)(p.ws + WS_Q0); U.qpitch = 768; U.K = (const bf16_t*)(p.ws + WS_K0); U.kpitch = 256; U.V = (const bf16_t*)(p.ws + WS_V0); U.vpitch = 256;
    U.O = (bf16_t*)(p.ws + WS_MIX); U.opitch = D; U.rg = 0; U.rmin = 0; U.head = 0; U.G = nullptr;
    for (int u = C.vcu; u < 768 + 96; u += C.G) {
        if (u < 768) { const int qb = u & 7, bh = u >> 3, h = bh % 12, b = bh / 12;
            U.q0 = (long)b * S + 256 * qb; U.qcol = h * 64; U.kcol = (h / 3) * 64; U.vcol = (h / 3) * 64; U.ocol = 256 + h * 64; U.kv0 = b * SK; U.nt = SK / 64; }
        else { const int bh = u - 768, h = bh % 12, b = bh / 12;
            U.q0 = (long)ML + 256 * b; U.qcol = h * 64; U.kcol = (h / 3) * 64; U.vcol = (h / 3) * 64; U.ocol = 256 + h * 64; U.kv0 = b * SK; U.nt = CTX / 64; }
#ifdef USE_ATT64
        att64::attn_unit<8>(U.q0, (const att64::bf16*)U.Q, U.qpitch, U.qcol, (const att64::bf16*)U.K, U.kpitch, U.kcol, (const att64::bf16*)U.V, U.vpitch, U.vcol, (long)U.kv0, U.nt, (att64::bf16*)U.O, U.opitch, U.ocol, C.lds_g);
#else
        att::attn_unit<64, false, false>(U, shm, nullptr, nullptr, nullptr);
#endif
    }
    phase_pool(C);
}
__device__ __forceinline__ void phase_attn1(Ctx& C) {
    const Params& p = C.p;
    MLAS char* shm = (MLAS char*)C.lds;
    const float* T16 = (const float*)(p.ws + WS_ROPE16);
    att::UnitDesc U; U.O = (bf16_t*)(p.ws + WS_MIX); U.opitch = D; U.G = (const bf16_t*)(p.ws + WS_NAG);
    for (int u = C.vcu; u < 1024; u += C.G) {
        const int uu = u & 511, qb = uu & 7, h = (uu >> 3) & 7, b = uu >> 6;
        U.q0 = (long)b * S + 256 * qb; U.kv0 = b * SK; U.head = h;
        if (u < 512) {
            U.Q = (const bf16_t*)(p.ws + WS_MQ); U.qpitch = 768; U.qcol = h * 96; U.K = (const bf16_t*)(p.ws + WS_MK); U.kpitch = 768; U.kcol = h * 96;
            U.V = (const bf16_t*)(p.ws + WS_MV); U.vpitch = 512; U.vcol = h * 64; U.ocol = h * 64; U.nt = SK / 64; U.rg = 0; U.rmin = 0;
#ifdef USE_ATT96
            att96::attn_unit<8>(U.q0, (const att96::bf16*)U.Q, U.qpitch, U.qcol, (const att96::bf16*)U.K, U.kpitch, U.kcol, (const att96::bf16*)U.V, U.vpitch, U.vcol, (long)U.kv0, U.nt, (att96::bf16*)U.O, U.opitch, U.ocol, C.lds_g, p.in[I1_MQG], T16);
#ifdef DUP_MLA
            att96::attn_unit<8>(U.q0, (const att96::bf16*)U.Q, U.qpitch, U.qcol, (const att96::bf16*)U.K, U.kpitch, U.kcol, (const att96::bf16*)U.V, U.vpitch, U.vcol, (long)U.kv0, U.nt, (att96::bf16*)U.O, U.opitch, U.ocol, C.lds_g, p.in[I1_MQG], T16);
#endif
#else
            att::attn_unit<96, false, true>(U, shm, p.in[I1_MQG], T16, nullptr);
#ifdef DUP_MLA
            att::attn_unit<96, false, true>(U, shm, p.in[I1_MQG], T16, nullptr);
#endif
#endif
        } else {
            U.Q = (const bf16_t*)(p.ws + WS_NQ); U.qpitch = 512; U.qcol = h * 64; U.K = (const bf16_t*)(p.ws + WS_NK); U.kpitch = 512; U.kcol = h * 64;
            U.V = (const bf16_t*)(p.ws + WS_NV); U.vpitch = 512; U.vcol = h * 64; U.ocol = 512 + h * 64; U.rg = qb;
            const int rmin = min(max(4 * qb - 4, 0), 24), rmax = min(max(4 * qb + 3 - 4, 0), 24) + 7;
            U.rmin = rmin; U.nt = 4 + (rmax - rmin + 1);
#ifdef USE_ATTNA
            attna::attn_unit<8>(U.q0, (const attna::bf16*)U.Q, U.qpitch, U.qcol, (const attna::bf16*)U.K, U.kpitch, U.kcol, (const attna::bf16*)U.V, U.vpitch, U.vcol, (long)U.kv0, (U.nt + 1) & ~1, (attna::bf16*)U.O, U.opitch, U.ocol, C.lds_g, U.rmin, U.rg, p.in[I1_RPB] + h * 465);
#ifdef DUP_NA
            attna::attn_unit<8>(U.q0, (const attna::bf16*)U.Q, U.qpitch, U.qcol, (const attna::bf16*)U.K, U.kpitch, U.kcol, (const attna::bf16*)U.V, U.vpitch, U.vcol, (long)U.kv0, (U.nt + 1) & ~1, (attna::bf16*)U.O, U.opitch, U.ocol, C.lds_g, U.rmin, U.rg, p.in[I1_RPB] + h * 465);
#endif
#else
            att::attn_unit<64, true, false>(U, shm, nullptr, nullptr, p.in[I1_RPB]);
#ifdef DUP_NA
            att::attn_unit<64, true, false>(U, shm, nullptr, nullptr, p.in[I1_RPB]);
#endif
#endif
        }
    }
}

__global__ void __launch_bounds__(NTHR, 2) mega(Params p, int ph_lo, int ph_hi) {
    extern __shared__ __attribute__((aligned(16))) unsigned char lds_raw[];
    cg::grid_group grid = cg::this_grid();
    Ctx C; C.p = p; C.lds = (MLAS unsigned char*)lds_raw; C.lds_g = (char*)lds_raw; C.wave = __builtin_amdgcn_readfirstlane((int)threadIdx.x >> 6);
    C.G = gridDim.x; C.bid = blockIdx.x; C.vcu = (C.G % 8 == 0) ? (C.bid % 8) * (C.G / 8) + C.bid / 8 : C.bid;
    volatile LAS unsigned* bst = (volatile LAS unsigned*)(C.lds + LDS_BYTES - 64);
    if (threadIdx.x < 2) bst[threadIdx.x] = 0u;
    __syncthreads();
    unsigned* barw = (unsigned*)(p.ws + WS_BARRIER);
    XcdBarrier bar; bar.bar = barw; bar.x = 0; bar.st = nullptr;
    if (ph_hi - ph_lo > 1) bar = xcd_barrier_post(barw, bst);
    float* out = p.out; float* xrc = (float*)(p.ws + WS_XRC);
    const float* MOD = (const float*)(p.ws + WS_MOD);
    bf16_t* XN = (bf16_t*)(p.ws + WS_XN); bf16_t* MIX = (bf16_t*)(p.ws + WS_MIX); bf16_t* H = (bf16_t*)(p.ws + WS_H);
    const float* T32 = (const float*)(p.ws + WS_ROPE32); const float* T16 = (const float*)(p.ws + WS_ROPE16);
#define WSB(off) ((bf16_t*)(p.ws + (off)))
#ifndef PHMASK
#define PHMASK 0xFFFF
#endif
#ifndef REPMASK
#define REPMASK 0
#endif
#ifndef NSYNC
#define NSYNC 1
#endif
#define PH(k) if (((PHMASK >> (k)) & 1) && ph_lo <= (k) && (k) < ph_hi) for (int rep_ = 0; rep_ < (((REPMASK >> (k)) & 1) ? 2 : 1); ++rep_, (((REPMASK >> (k)) & 1) && rep_ == 1 ? xcd_barrier(bar) : (void)0))
#ifndef USE_CG_SYNC
#define USE_CG_SYNC 0
#endif
#define SEAM(k) if (ph_lo <= (k) && (k) + 1 < ph_hi) { for (int s_ = 0; s_ < NSYNC; ++s_) { if (USE_CG_SYNC || ph_hi > 1000) grid.sync(); else xcd_barrier(bar); } }
    PH(0) { phase_prologue<0>(C, C.vcu, C.G);
#if !defined(L1_LATE) && !defined(L1_IN_P7)
        phase_prologue<1>(C, C.vcu, C.G);
#endif
    } SEAM(0);
    PH(1) { phase_norm(C, p.in[I_X], p.in[I_CTX], p.in[I0_NMIX], 0, 0, 1, MT); } SEAM(1);
    PH(2) { pg8::Gemm g{XN, WSB(WS_W_IN0), MT, 1536, D, D}; pg8::StaticOrder So; So.init(MT, 1536, C.G, C.bid);
        epi::EpiIn0 E{WSB(WS_A0), WSB(WS_Q0), WSB(WS_K0), WSB(WS_V0), p.in[I0_QG], p.in[I0_KG], T32};
        pg8::gemm_phase<epi::EpiIn0, pg8::StaticOrder, ALIGN2, true>(C.lds, g, So, E);
#ifdef L0_SPLIT
        { const int n2 = (MT / 256) * 6 - C.G;
          if (n2 >= 0 && n2 < C.G) { if (C.bid >= n2) phase_prologue<2>(C, C.bid - n2, C.G - n2); } else phase_prologue<2>(C, C.vcu, C.G); }
#endif
#ifdef L1_LATE
        { const int n2 = (MT / 256) * 6 - C.G;
          if (n2 >= 0 && n2 < C.G && C.bid >= n2) phase_prologue<1>(C, C.bid - n2, C.G - n2);
          else if (n2 < 0 || n2 >= C.G) phase_prologue<1>(C, C.vcu, C.G); }
#endif
    } SEAM(2);
    PH(3) { phase_attn0(C); } SEAM(3);
    PH(4) { { pg8::Gemm g{MIX, WSB(WS_W_OUT0), ML, D, D, D}; pg8::StaticOrder So; So.init(ML, D, C.G, C.bid);
          epi::EpiResid E{p.in[I_X], p.in[I_CTX], out, xrc, MOD + 2 * D};
          pg8::gemm_phase<epi::EpiResid, pg8::StaticOrder, ALIGN1, true>(C.lds, g, So, E); }
        { pg8::Gemm g{MIX, WSB(WS_W_OUT0), MT, D, D / 4, D}; pg8::CtxSplitOrder So; So.init(4, C.G, C.bid);
          epi::EpiResidSplit E{p.in[I_CTX], xrc, (float*)(p.ws + WS_SLAB4), MOD + 2 * D};
          pg8::gemm_phase<epi::EpiResidSplit, pg8::CtxSplitOrder, true, true>(C.lds, g, So, E); }
#ifdef CTXD_IN_P6
        if (C.G > 128) { if (C.bid >= 128) phase_prologue<3>(C, C.bid - 128, C.G - 128); } else phase_prologue<3>(C, C.vcu, C.G);
#endif
    } SEAM(4);
    PH(5) { phase_norm(C, out, xrc, p.in[I0_NFFN], 0, 3, 4, MT, (const float*)(p.ws + WS_SLAB4), 3, xrc); } SEAM(5);
#ifdef CTXD_IN_P6
    const bool ctxd = (C.G == 256);
#else
    const bool ctxd = false;
#endif
    PH(6) { pg8::Gemm g{XN, WSB(WS_W_GU0), MT, 2 * FF, D, D}; epi::EpiSwiGLU E{H};
        if (!ctxd) { pg8::StaticOrder So; So.init(MT, 2 * FF, C.G, C.bid);
            pg8::gemm_phase<epi::EpiSwiGLU, pg8::StaticOrder, true, true>(C.lds, g, So, E);
#ifdef D0_IN_P6
            { const int total = (MT / 256) * (2 * FF / 256), full = total / C.G, n7 = total - full * C.G;
              if (n7 > 0 && n7 < C.G) { if (C.bid >= n7) phase_prologue<3>(C, C.bid - n7, C.G - n7); } else phase_prologue<3>(C, C.vcu, C.G); }
#endif
        }
#ifdef CTXD_IN_P6
        else {
            unsigned* flag = barw + XB_CTXH;
            { pg8::CtxFirstOrder So; So.init(0, C.bid); pg8::gemm_phase<epi::EpiSwiGLU, pg8::CtxFirstOrder, true, true>(C.lds, g, So, E); }
            if (C.bid >= 80 && threadIdx.x == 0) { __builtin_amdgcn_fence(__ATOMIC_RELEASE, "agent"); asm volatile("s_waitcnt vmcnt(0)" ::: "memory"); xb_add(flag, 1u); }
            { pg8::CtxFirstOrder So; So.init(1, C.bid); pg8::gemm_phase<epi::EpiSwiGLU, pg8::CtxFirstOrder, true, true>(C.lds, g, So, E); }
            if (C.bid >= 48 && C.bid < 176) {
                if (threadIdx.x == 0) { XB_SPIN(xb_ld(flag) < 176u, barw); __builtin_amdgcn_fence(__ATOMIC_ACQUIRE, "agent"); asm volatile("s_waitcnt vmcnt(0)" ::: "memory"); }
                __syncthreads();
                if (C.bid < 112) { pg8::Gemm g2{H, WSB(WS_W_D0), MT, D, 768, FF}; pg8::CtxSplitOrder S2; S2.init(2, C.G, C.bid - 48);
                    epi::EpiResidSplit E2{xrc, xrc, (float*)(p.ws + WS_SLAB7), MOD + 5 * D, 0};
                    pg8::gemm_phase<epi::EpiResidSplit, pg8::CtxSplitOrder, true, true>(C.lds, g2, S2, E2); }
                else { pg8::Gemm g2{H + 1536, WSB(WS_W_D0) + 1536, MT, D, 640, FF}; pg8::CtxSplitOrder S2; S2.init(2, C.G, C.bid - 112);
                    epi::EpiResidSplit E2{xrc, xrc, (float*)(p.ws + WS_SLAB7), MOD + 5 * D, 2};
                    pg8::gemm_phase<epi::EpiResidSplit, pg8::CtxSplitOrder, true, true>(C.lds, g2, S2, E2); }
            } else if (C.bid >= 176) { phase_prologue<1>(C, C.bid - 176, C.G - 176); phase_natable(C, C.bid - 176, C.G - 176); }
        }
#endif
    } SEAM(6);
    PH(7) { { pg8::Gemm g{H, WSB(WS_W_D0), ML, D, FF, FF}; pg8::StaticOrder So; So.init(ML, D, C.G, C.bid);
          epi::EpiResid E{out, xrc, out, xrc, MOD + 5 * D};
          pg8::gemm_phase<epi::EpiResid, pg8::StaticOrder, ALIGN1, true>(C.lds, g, So, E); }
        if (!ctxd) {
        { pg8::Gemm g{H, WSB(WS_W_D0), MT, D, FF / 2, FF}; pg8::CtxSplitOrder So; So.init(2, C.G, C.bid);
          epi::EpiResidSplit E{xrc, xrc, (float*)(p.ws + WS_SLAB7), MOD + 5 * D};
          pg8::gemm_phase<epi::EpiResidSplit, pg8::CtxSplitOrder, true, true>(C.lds, g, So, E); }
#ifdef L1_IN_P7
        if (C.G > 64) { if (C.bid >= 64) { phase_prologue<1>(C, C.bid - 64, C.G - 64);
#ifdef CTXD_IN_P6
            phase_prologue<4>(C, C.bid - 64, C.G - 64);
#endif
            phase_natable(C, C.bid - 64, C.G - 64); } }
        else { phase_prologue<1>(C, C.vcu, C.G);
#ifdef CTXD_IN_P6
            phase_prologue<4>(C, C.vcu, C.G);
#endif
            phase_natable(C, C.vcu, C.G); }
#endif
        }
    } SEAM(7);
    PH(8) {
#ifndef L1_IN_P7
        phase_natable(C, C.vcu, C.G);
#endif
        phase_norm(C, out, xrc, p.in[I1_NMIX], 1, 0, 1, MT, (const float*)(p.ws + WS_SLAB7), ctxd ? 3 : 1, nullptr); } SEAM(8);
    PH(9) { pg8::Gemm g{XN, WSB(WS_W_IN1), MT, L1_INP, D, D}; pg8::StaticOrder So; So.init(MT, L1_INP, C.G, C.bid);
        epi::EpiIn1 E{WSB(WS_CQ), WSB(WS_CKV), WSB(WS_NQ), WSB(WS_NK), WSB(WS_NV), (float*)(p.ws + WS_KR), (float*)(p.ws + WS_SSQ), (float*)(p.ws + WS_SSKV), p.in[I1_NQG], p.in[I1_NKG]};
        pg8::gemm_phase<epi::EpiIn1, pg8::StaticOrder, ALIGN2, true>(C.lds, g, So, E);
#ifdef CTXD_IN_P6
        if (ctxd) { const int n3 = (MT / 256) * (L1_INP / 256) - 2 * C.G;
            if (n3 >= 0 && n3 < C.G) { if (C.bid >= n3) phase_prologue<4>(C, C.bid - n3, C.G - n3); } else phase_prologue<4>(C, C.vcu, C.G); }
#endif
    } SEAM(9);
    PH(10) {
#ifndef NO_QUP
        { pg8::Gemm g{WSB(WS_CQ), WSB(WS_W_UQ), ML, 768, 384, 384}; pg8::StaticOrder So; So.init(ML, 768, C.G, C.bid);
          epi::EpiQUp E{WSB(WS_MQ), (const float*)(p.ws + WS_SSQ)};
          pg8::gemm_phase<epi::EpiQUp, pg8::StaticOrder, ALIGN2, true>(C.lds, g, So, E); }
#endif
#ifndef NO_KVUP
        { pg8::Gemm g{WSB(WS_CKV), WSB(WS_W_UKV), MT, 1024, 256, 256}; pg8::StaticOrder So; So.init(MT, 1024, C.G, (C.bid + KVROT) % C.G);
          epi::EpiKvUp E{WSB(WS_MK), WSB(WS_MV), (const float*)(p.ws + WS_SSKV), (const float*)(p.ws + WS_KR), p.in[I1_MKG], T16};
          pg8::gemm_phase<epi::EpiKvUp, pg8::StaticOrder, ALIGN2, true>(C.lds, g, So, E); }
#endif
    } SEAM(10);
    PH(11) { phase_attn1(C); } SEAM(11);
    PH(12) { pg8::Gemm g{MIX, WSB(WS_W_OUT1), ML, D, D, D}; pg8::StaticOrder So; So.init(ML, D, C.G, C.bid);
        epi::EpiResid E{out, xrc, out, xrc, MOD + 9 * 6144 + 2 * D};
        pg8::gemm_phase<epi::EpiResid, pg8::StaticOrder, ALIGN1, true>(C.lds, g, So, E); } SEAM(12);
    PH(13) { phase_norm(C, out, xrc, p.in[I1_NFFN], 1, 3, 4, ML); } SEAM(13);
    PH(14) { pg8::Gemm g{XN, WSB(WS_W_GU1), ML, 2 * FF, D, D}; pg8::StaticOrder So; So.init(ML, 2 * FF, C.G, C.bid);
        epi::EpiSwiGLU E{H};
        pg8::gemm_phase<epi::EpiSwiGLU, pg8::StaticOrder, true, true>(C.lds, g, So, E); } SEAM(14);
    PH(15) { pg8::Gemm g{H, WSB(WS_W_D1), ML, D, FF, FF}; pg8::StaticOrder So; So.init(ML, D, C.G, C.bid);
        epi::EpiResid E{out, xrc, out, xrc, MOD + 9 * 6144 + 5 * D};
        pg8::gemm_phase<epi::EpiResid, pg8::StaticOrder, ALIGN1, true>(C.lds, g, So, E); }
    if (ph_hi - ph_lo > 1 && C.bid == 0 && threadIdx.x == 0) { if (xb_ld(&barw[XB_TMO]) != 0u) out[0] = __builtin_nanf(""); }
#undef PH
#undef SEAM
#undef WSB
}
}
#ifndef MK_DEBUG
#define MK_DEBUG 0
#endif
static int g_grid = 0;
static bool mega_setup() {
    if (g_grid) return g_grid > 0;
    int dev = 0, cus = 0, per_cu = 0;
    if (hipGetDevice(&dev) != hipSuccess || hipDeviceGetAttribute(&cus, hipDeviceAttributeMultiprocessorCount, dev) != hipSuccess) { g_grid = -1; return false; }
    if (hipFuncSetAttribute((const void*)mk::mega, hipFuncAttributeMaxDynamicSharedMemorySize, mk::LDS_BYTES) != hipSuccess) { fprintf(stderr, "kernel_launch: hipFuncSetAttribute failed\n"); g_grid = -1; return false; }
    if (hipOccupancyMaxActiveBlocksPerMultiprocessor(&per_cu, (const void*)mk::mega, mk::NTHR, mk::LDS_BYTES) != hipSuccess || per_cu < 1) { fprintf(stderr, "kernel_launch: occupancy query says %d\n", per_cu); g_grid = -1; return false; }
    g_grid = cus;
    fprintf(stderr, "kernel_launch: %d CUs, occupancy %d blocks/CU, grid %d\n", cus, per_cu, g_grid);
    return true;
}
static void launch_phases(const Params& p, int lo, int hi, hipStream_t st) {
    Params pp = p; int l = lo, h = hi;
    void* args[] = {&pp, &l, &h};
    hipError_t e;
    if (hi - lo > 1) e = hipLaunchCooperativeKernel((const void*)mk::mega, dim3(g_grid), dim3(mk::NTHR), args, mk::LDS_BYTES, st);
    else e = hipLaunchKernel((const void*)mk::mega, dim3(g_grid), dim3(mk::NTHR), args, mk::LDS_BYTES, st);
    if (e != hipSuccess) fprintf(stderr, "kernel_launch: launch [%d,%d) failed: %s\n", lo, hi, hipGetErrorString(e));
}
#if MK_DEBUG
static void launch_debug(const Params& p, hipStream_t st) {
    using namespace nv;
    unsigned* err = (unsigned*)(p.ws + WS_CTL) + 64;
    float* out = p.out; float* xrc = (float*)(p.ws + WS_XRC);
    const float* x = p.in[I_X]; const float* cx = p.in[I_CTX];
    const size_t att_sm = 4 * (SK + 128) * sizeof(float);
    const int SR = 4096;
    float* snapL = (float*)(p.ws + WS_SNAP); float* snapC = snapL + (size_t)SR * D;
    float* snapB = (float*)(p.ws + WS_BIG);
    hipMemsetAsync(p.ws + WS_CTL, 0, WS_SSQ, st);
    launch_phases(p, 0, 1, st);  k_adaln<true><<<dim3(6144 / 256, 9, 2), 256, 0, st>>>(p, err + 0);
    launch_phases(p, 1, 2, st);  k_norm<true><<<MT / 4, 256, 0, st>>>(p, x, cx, I0_NMIX, 0, 0, 1, MT, err + 1);
    launch_phases(p, 2, 3, st);  k_in0<true><<<MT / R, 256, (R * D + R * L0_IN) * 4, st>>>(p, err + 2);
    launch_phases(p, 3, 4, st);  k_attn<true, 0><<<dim3(ML / 4, 12), 256, att_sm, st>>>(p, err + 3);
                                 k_attn<true, 1><<<dim3(MC / 4, 12), 256, att_sm, st>>>(p, err + 16);
                                 k_pool0<true><<<MT, 256, 0, st>>>(p, err + 17);
    launch_phases(p, 4, 5, st);  k_out<true, 0><<<MT / R, 256, (R * D + R * 256) * 4, st>>>(p, x, cx, out, xrc, 0, err + 4);
    launch_phases(p, 5, 6, st);  k_norm<true><<<MT / 4, 256, 0, st>>>(p, out, xrc, I0_NFFN, 0, 3, 4, MT, err + 5);
    launch_phases(p, 6, 7, st);  k_ffn_gu<true, 0><<<MT / R, 256, R * D * 4, st>>>(p, err + 6);
    hipMemcpyAsync(snapL, out, (size_t)SR * D * 4, hipMemcpyDeviceToDevice, st); hipMemcpyAsync(snapC, xrc, (size_t)MC * D * 4, hipMemcpyDeviceToDevice, st);
    launch_phases(p, 7, 8, st);  k_ffn_d<true, 0><<<SR / R, 256, R * FF * 4, st>>>(p, snapL, snapC, out, xrc, 0, err + 7);
                                 k_ffn_d<true, 0><<<MC / R, 256, R * FF * 4, st>>>(p, snapL, snapC, out, xrc, ML, err + 7);
    launch_phases(p, 8, 9, st);  k_norm<true><<<MT / 4, 256, 0, st>>>(p, out, xrc, I1_NMIX, 1, 0, 1, MT, err + 8);
    launch_phases(p, 9, 10, st); k_in1<true><<<MT / R, 256, (R * D + R * L1_IN) * 4, st>>>(p, err + 9);
    launch_phases(p, 10, 11, st); k_mlaq<true><<<ML / R, 256, R * 384 * 4, st>>>(p, err + 10);
                                 k_mlakv<true><<<MT / R, 256, (R * 256 + R * 1024) * 4, st>>>(p, err + 19);
    launch_phases(p, 11, 12, st); k_attn<true, 2><<<dim3(ML / 4, 8), 256, att_sm, st>>>(p, err + 11);
                                 k_attn<true, 3><<<dim3(ML / 4, 8), 256, att_sm, st>>>(p, err + 18);
    hipMemcpyAsync(snapB, out, (size_t)SR * D * 4, hipMemcpyDeviceToDevice, st);
    launch_phases(p, 12, 13, st); k_out<true, 1><<<SR / R, 256, (R * D + R * 256) * 4, st>>>(p, snapB, snapC, out, xrc, 0, err + 12);
    launch_phases(p, 13, 14, st); k_norm<true><<<ML / 4, 256, 0, st>>>(p, out, xrc, I1_NFFN, 1, 3, 4, ML, err + 13);
    launch_phases(p, 14, 15, st); k_ffn_gu<true, 1><<<ML / R, 256, R * D * 4, st>>>(p, err + 14);
    hipMemcpyAsync(snapL, out, (size_t)SR * D * 4, hipMemcpyDeviceToDevice, st);
    launch_phases(p, 15, 16, st); k_ffn_d<true, 1><<<SR / R, 256, R * FF * 4, st>>>(p, snapL, snapC, out, xrc, 0, err + 15);
    k_report<<<1, 1, 0, st>>>(p, 20, 0.15f);
}
#endif
extern "C" void kernel_launch(void* const* d_in, const int* in_sizes, int n_in, void* d_out, int out_size, void* d_ws, size_t ws_size, hipStream_t stream) {
    if (n_in != N_IN || out_size != ML * D || ws_size < WS_END) { fprintf(stderr, "kernel_launch: unexpected shapes n_in=%d out=%d ws=%zu\n", n_in, out_size, ws_size); return; }
    if (!mega_setup()) return;
    Params p{};
    for (int i = 0; i < N_IN; ++i) p.in[i] = (const float*)d_in[i];
    p.out = (float*)d_out; p.ws = (unsigned char*)d_ws;
#if MK_DEBUG
    launch_debug(p, stream);
#else
    if (hipMemsetAsync((char*)d_ws + WS_BARRIER, 0, WS_SSQ - WS_BARRIER, stream) != hipSuccess) { fprintf(stderr, "kernel_launch: memset failed\n"); return; }
#ifdef EXTRA_MEMSET
    (void)hipMemsetAsync((char*)d_ws + WS_CTL, 0, 4096, stream);
#endif
    launch_phases(p, 0, mk::NPHASE, stream);
#endif
}
```

```cpp
#define USE_ATT64 1
#define USE_ATT96 1
#define ATT_STATIC_PRIO 1
#define L1_IN_P7 1
#define L0_SPLIT 1
#define CTXD_IN_P6 1
#include <hip/hip_runtime.h>
#include <hip/hip_cooperative_groups.h>
#include <cstdio>
#include <cstdint>
namespace cg = cooperative_groups;

typedef unsigned short bf16_t;
constexpr int D = 1024, NB = 8, S = 2048, CTX = 256, SK = S + CTX, ML = NB * S, MC = NB * CTX, MT = ML + MC, FF = 2816;
constexpr int GW = 64;
constexpr int L0_IN = 1536, L1_IN = 2208, L1_INP = 2304;
constexpr float EPS = 1e-6f;
constexpr float LOG2E = 1.4426950408889634f;
constexpr float C2_64 = 0.125f * LOG2E;
constexpr float C2_96 = 0.10206207261596577f * LOG2E;

enum { I_X = 0, I_C, I_CTX, I_CCTX,
       I0_ADAW, I0_ADAB, I0_NMIX, I0_NFFN, I0_WIN, I0_POOLW, I0_POOLS, I0_QG, I0_KG, I0_WOUT, I0_WG, I0_WU, I0_WD,
       I1_ADAW, I1_ADAB, I1_NMIX, I1_NFFN, I1_WIN, I1_QAG, I1_KVAG, I1_WUQ, I1_WUKV, I1_MQG, I1_MKG, I1_NQG, I1_NKG, I1_RPB, I1_WOUT, I1_WG, I1_WU, I1_WD, N_IN };

constexpr size_t MiB = 1u << 20;
constexpr size_t WS_CTL = 0;
constexpr size_t WS_BARRIER = 16 * 1024;
constexpr size_t WS_MOD = 64 * 1024;
constexpr size_t WS_SSQ = 512 * 1024;
constexpr size_t WS_SSKV = 600 * 1024;
constexpr size_t WS_ROPE32 = 700 * 1024;
constexpr size_t WS_ROPE16 = 712 * 1024;
constexpr size_t WS_W_IN0 = 1 * MiB;
constexpr size_t WS_W_OUT0 = 4 * MiB;
constexpr size_t WS_W_GU0 = 6 * MiB;
constexpr size_t WS_W_D0 = 17 * MiB;
constexpr size_t WS_W_IN1 = 23 * MiB;
constexpr size_t WS_W_UQ = 28 * MiB;
constexpr size_t WS_W_UKV = 29 * MiB;
constexpr size_t WS_W_OUT1 = 30 * MiB;
constexpr size_t WS_W_GU1 = 32 * MiB;
constexpr size_t WS_W_D1 = 43 * MiB;
constexpr size_t WS_XRC = 49 * MiB;
constexpr size_t WS_XN = 57 * MiB;
constexpr size_t WS_MIX = WS_XN;
constexpr size_t WS_BIG = 96 * MiB;
constexpr size_t WS_H = WS_BIG;
constexpr size_t WS_A0 = WS_BIG;
constexpr size_t WS_Q0 = WS_BIG + 9 * MiB;
constexpr size_t WS_K0 = WS_BIG + 36 * MiB;
constexpr size_t WS_V0 = WS_BIG + 45 * MiB;
constexpr size_t WS_CQ = WS_BIG;
constexpr size_t WS_CKV = WS_BIG + 14 * MiB;
constexpr size_t WS_NQ = WS_BIG + 23 * MiB;
constexpr size_t WS_NK = WS_BIG + 41 * MiB;
constexpr size_t WS_NV = WS_BIG + 59 * MiB;
constexpr size_t WS_MQ = WS_BIG + 77 * MiB;
constexpr size_t WS_MK = WS_BIG + 101 * MiB;
constexpr size_t WS_MV = WS_BIG + 128 * MiB;
constexpr size_t WS_KR = WS_BIG + 146 * MiB;
constexpr size_t WS_SLAB4 = WS_BIG;
constexpr size_t WS_SLAB7 = WS_BIG + 100 * MiB;
constexpr size_t WS_NAG = WS_BIG + 150 * MiB;
constexpr size_t WS_SNAP = WS_BIG + 100 * MiB;
constexpr size_t WS_END = 256 * MiB;
static_assert(WS_KR + (size_t)MT * 32 * 4 <= WS_END, "ws map");
static_assert(WS_W_D1 + (size_t)D * FF * 2 <= WS_XRC, "ws map");
static_assert(WS_XN + (size_t)MT * D * 2 <= WS_BIG, "ws map");

__device__ __forceinline__ float bf2f(bf16_t u) { return __uint_as_float((unsigned)u << 16); }
__device__ __forceinline__ bf16_t f2bf(float f) { unsigned u = __float_as_uint(f); return (bf16_t)((u + 0x7fffu + ((u >> 16) & 1u)) >> 16); }
__device__ __forceinline__ int kvrow_of(int m) { return m < ML ? (m / S) * SK + CTX + (m % S) : ((m - ML) / CTX) * SK + ((m - ML) % CTX); }
__device__ __forceinline__ int modidx_of(int m) { return m < ML ? m / S : 8; }
__device__ __forceinline__ float wave_sum(float v) {
#pragma unroll
    for (int o = 1; o < 64; o <<= 1) v += __shfl_xor(v, o);
    return v;
}
__device__ __forceinline__ float wave_max(float v) {
#pragma unroll
    for (int o = 1; o < 64; o <<= 1) v = fmaxf(v, __shfl_xor(v, o));
    return v;
}

struct Params {
    const float* in[N_IN];
    float* out;
    unsigned char* ws;
};
namespace pg8 {
#define PG8_LAS __attribute__((address_space(3)))
typedef unsigned short bf16_t;
typedef short bf16x8 __attribute__((ext_vector_type(8)));
typedef float f32x4 __attribute__((ext_vector_type(4)));
typedef unsigned u32x4 __attribute__((ext_vector_type(4)));
constexpr int BM = 256, BK = 64, HALF = 128, HTB = HALF * BK * 2  , STAGE_BYTES = 8 * HTB, NXCD = 8, WGM = 8;

__host__ __device__ __forceinline__ int lds_byte(int r, int c) { const int st = (r >> 4) * 2 + (c >> 5), rr = r & 15, cc = c & 31, ob = rr * 64 + cc * 2; return st * 1024 + (ob ^ (((ob >> 9) & 1) << 5)); }
__host__ __device__ __forceinline__ void stage_rc(int b, int& R, int& C) { const int st = b / 1024, sb = b % 1024, swz = sb ^ (((sb >> 9) & 1) << 5); R = (st >> 1) * 16 + swz / 64; C = (st & 1) * 32 + (swz % 64) / 2; }
__host__ __device__ __forceinline__ int perm32(int rho) { const int n = rho >> 4, i = rho & 15; return 8 * (i >> 2) + 4 * n + (i & 3); }

struct Unit { int pm, pn, ks; };
struct Gemm { const bf16_t* A; const bf16_t* Bt; int M, N, K, ld; };

struct StaticOrder {
    int nM, nN, nwg, G, c;
    __host__ __device__ void init(int M, int N, int G_, int c_) { nM = M / BM; nN = N / BM; nwg = nM * nN; G = G_; c = c_; }
    __host__ __device__ bool next(int i, Unit& u) const {
        const long L = (long)i * G + c; if (L >= nwg) return false;
        int wgid = (int)L; { const int q = nwg / NXCD, r = nwg % NXCD, xcd = wgid % NXCD, off = wgid / NXCD; wgid = (xcd < r ? xcd * (q + 1) : r * (q + 1) + (xcd - r) * q) + off; }
        const int nig = WGM * nN, gid = wgid / nig, fm = gid * WGM, gsz = (nM - fm) < WGM ? (nM - fm) : WGM;
        u.pm = fm + ((wgid % nig) % gsz); u.pn = (wgid % nig) / gsz; u.ks = 0; return true;
    }
    __device__ __forceinline__ void a_ready(const Unit&) const {}
    __device__ __forceinline__ void done(const Unit&) const {}
};

__device__ __forceinline__ unsigned cvt_pk_bf16(float lo, float hi) { unsigned r; asm volatile("v_cvt_pk_bf16_f32 %0, %1, %2" : "=v"(r) : "v"(lo), "v"(hi)); return r; }
typedef float f32x2 __attribute__((ext_vector_type(2)));
struct CtxSplitOrder {
    int G, c, split;
    __host__ __device__ void init(int split_, int G_, int c_) { split = split_; G = G_; c = c_; }
    __host__ __device__ bool next(int i, Unit& u) const {
        const int L = i * G + c; if (L >= 32 * split) return false;
        u.ks = L % split; const int t = L / split; u.pn = t & 3; u.pm = 64 + (t >> 2); return true;
    }
    __device__ __forceinline__ void a_ready(const Unit&) const {}
    __device__ __forceinline__ void done(const Unit&) const {}
};
struct CtxFirstOrder {
    int c, mode; StaticOrder lat;
    __host__ __device__ void init(int mode_, int c_) { mode = mode_; c = c_; lat.init(64 * BM, 22 * BM, 1 << 28, 0); }
    __host__ __device__ bool next(int i, Unit& u) const {
        if (mode == 0) { if (i != 0 || c < 80) return false; const int j = c - 80; u.pm = 64 + (j & 7); u.pn = j >> 3; u.ks = 0; return true; }
        const int Lp = c < 80 ? (i == 0 ? c : 80 + (i - 1) * 256 + c) : 80 + i * 256 + c;
        if (Lp >= 1408) return false;
        StaticOrder t = lat; t.c = Lp; return t.next(0, u);
    }
    __device__ __forceinline__ void a_ready(const Unit&) const {}
    __device__ __forceinline__ void done(const Unit&) const {}
};
template <class Epi, class Sched, bool ALIGN_EPI = false, bool SP2 = false>
__device__ __forceinline__ void gemm_phase(PG8_LAS unsigned char* lds, const Gemm g, const Sched& S, const Epi& E) {
    int tid_ = threadIdx.x; asm volatile("" : "+v"(tid_));
    const int tid = tid_, wid = __builtin_amdgcn_readfirstlane(tid >> 6), lane = tid & 63, wr = wid >> 2, wc = wid & 3, fr = lane & 15, fq = lane >> 4;
    int K_ = g.K; asm volatile("" : "+s"(K_));
    const int K = K_, nt = K / BK; int LD_ = g.ld; asm volatile("" : "+s"(LD_)); const int LD = LD_;
    unsigned voffA[2], voffB[2];
#pragma unroll
    for (int i = 0; i < 2; ++i) { int R, C; stage_rc(tid * 16 + i * 8192, R, C); const int Rb = Epi::PERM ? ((R & ~31) + perm32(R & 31)) : R;
        voffA[i] = (unsigned)(R * LD + C) * 2u; voffB[i] = (unsigned)(Rb * LD + C) * 2u; }
    const size_t kstep = (size_t)(BK * 2);
    const size_t hstep = (size_t)HALF * LD * 2;
    const size_t tstep = 2 * hstep;
    const unsigned ldsw = (unsigned)wid * 1024u;
    const int aoff = lds_byte(wr * 64 + fr, fq * 8), boff = lds_byte(wc * 32 + fr, fq * 8);
#define PG8_SA(b, h) (((b) * 2 + (h)) * HTB)
#define PG8_SB(b, h) ((4 + (b) * 2 + (h)) * HTB)
#define PG8_STAGE(bufoff, gbase, voff) do { _Pragma("unroll") for (int _i = 0; _i < 2; ++_i) \
        __builtin_amdgcn_global_load_lds((const unsigned*)((const char*)(gbase) + (voff)[_i]), (PG8_LAS unsigned*)(lds + (bufoff) + ldsw + _i * 8192), 16, 0, 0); } while (0)
#define PG8_LDA(dst, b, h) do { _Pragma("unroll") for (int m = 0; m < 4; ++m) _Pragma("unroll") for (int k = 0; k < 2; ++k) dst[m][k] = *(const PG8_LAS bf16x8*)(lds + PG8_SA(b, h) + aoff + m * 2048 + k * 1024); } while (0)
#define PG8_LDB(dst, b, h) do { _Pragma("unroll") for (int n = 0; n < 2; ++n) _Pragma("unroll") for (int k = 0; k < 2; ++k) dst[n][k] = *(const PG8_LAS bf16x8*)(lds + PG8_SB(b, h) + boff + n * 2048 + k * 1024); } while (0)
#define PG8_MMA(ai, bj, At, Bt) do { __builtin_amdgcn_s_setprio(1); _Pragma("unroll") for (int m = 0; m < 4; ++m) _Pragma("unroll") for (int n = 0; n < 2; ++n) _Pragma("unroll") for (int k = 0; k < 2; ++k) \
        acc[ai][bj][m][n] = __builtin_amdgcn_mfma_f32_16x16x32_bf16(Bt[n][k], At[m][k], acc[ai][bj][m][n], 0, 0, 0); __builtin_amdgcn_s_setprio(0); } while (0)
#define PG8_WAIT_V(n) asm volatile("s_waitcnt vmcnt(" #n ")" ::: "memory")
#define PG8_WAIT_L(n) asm volatile("s_waitcnt lgkmcnt(" #n ")" ::: "memory")
#define PG8_BAR __builtin_amdgcn_s_barrier()
#define PG8_SCHED __builtin_amdgcn_sched_barrier(0)
    Unit cur, nxt; int ui = 0;
    if (!S.next(0, cur)) return;
    f32x4 acc[2][2][4][2];
#pragma unroll
    for (int a = 0; a < 2; ++a)
#pragma unroll
        for (int b = 0; b < 2; ++b)
#pragma unroll
            for (int m = 0; m < 4; ++m)
#pragma unroll
                for (int n = 0; n < 2; ++n) acc[a][b][m][n] = (f32x4){0.f, 0.f, 0.f, 0.f};
    bf16x8 At[4][2], B0[2][2], B1[2][2];
    const char* cA = (const char*)g.A + (size_t)cur.pm * tstep + (size_t)cur.ks * K * 2; const char* cB = (const char*)g.Bt + (size_t)cur.pn * tstep + (size_t)cur.ks * K * 2;
    S.a_ready(cur);
    if constexpr (SP2) {
        PG8_STAGE(PG8_SB(0, 0), cB, voffB); PG8_STAGE(PG8_SB(0, 1), cB + hstep, voffB); PG8_STAGE(PG8_SA(0, 0), cA, voffA); PG8_STAGE(PG8_SA(0, 1), cA + hstep, voffA);
        if (wr == 1) PG8_BAR;
        PG8_WAIT_V(2); PG8_BAR;
        PG8_STAGE(PG8_SB(1, 0), cB + kstep, voffB); PG8_STAGE(PG8_SA(1, 0), cA + kstep, voffA); PG8_STAGE(PG8_SB(1, 1), cB + hstep + kstep, voffB);
        PG8_WAIT_V(6); PG8_BAR;
    } else {
        PG8_STAGE(PG8_SB(0, 0), cB, voffB); PG8_STAGE(PG8_SA(0, 0), cA, voffA); PG8_STAGE(PG8_SB(0, 1), cB + hstep, voffB); PG8_STAGE(PG8_SA(0, 1), cA + hstep, voffA);
        if (wr == 1) PG8_BAR;
        PG8_WAIT_V(4); PG8_BAR;
        PG8_STAGE(PG8_SB(1, 0), cB + kstep, voffB); PG8_STAGE(PG8_SA(1, 0), cA + kstep, voffA); PG8_STAGE(PG8_SB(1, 1), cB + hstep + kstep, voffB);
        PG8_WAIT_V(6); PG8_BAR;
    }
    for (;;) {
        const bool has_next = S.next(ui + 1, nxt);
        const char* nA = has_next ? (const char*)g.A + (size_t)nxt.pm * tstep + (size_t)nxt.ks * K * 2 : cA; const char* nB = has_next ? (const char*)g.Bt + (size_t)nxt.pn * tstep + (size_t)nxt.ks * K * 2 : cB;
        for (int t = 0; t < nt; t += 2) {
            const bool last = (t == nt - 2);
            const char* a1 = cA + (size_t)(t + 1) * kstep;
            const char* a2 = last ? nA : cA + (size_t)(t + 2) * kstep; const char* b2 = last ? nB : cB + (size_t)(t + 2) * kstep;
            const char* a3 = a2 + kstep; const char* b3 = b2 + kstep;
            if (last && has_next) S.a_ready(nxt);
            if constexpr (SP2) {
            PG8_LDB(B0, 0, 0); PG8_LDB(B1, 0, 1); PG8_SCHED; PG8_LDA(At, 0, 0); PG8_STAGE(PG8_SA(1, 1), a1 + hstep, voffA);
            PG8_WAIT_V(8); PG8_WAIT_L(0); PG8_BAR; PG8_MMA(0, 0, At, B0); PG8_MMA(0, 1, At, B1); PG8_BAR; PG8_SCHED;
            PG8_LDA(At, 0, 1); PG8_STAGE(PG8_SB(0, 0), b2, voffB); PG8_STAGE(PG8_SB(0, 1), b2 + hstep, voffB); PG8_STAGE(PG8_SA(0, 0), a2, voffA);
            PG8_WAIT_V(8); PG8_WAIT_L(0); PG8_BAR; PG8_MMA(1, 0, At, B0); PG8_MMA(1, 1, At, B1); PG8_BAR; PG8_SCHED;
            PG8_LDB(B0, 1, 0); PG8_LDB(B1, 1, 1); PG8_SCHED; PG8_LDA(At, 1, 0); PG8_STAGE(PG8_SA(0, 1), a2 + hstep, voffA);
            PG8_WAIT_V(8); PG8_WAIT_L(0); PG8_BAR; PG8_MMA(0, 0, At, B0); PG8_MMA(0, 1, At, B1); PG8_BAR; PG8_SCHED;
            PG8_LDA(At, 1, 1); PG8_STAGE(PG8_SB(1, 0), b3, voffB); PG8_STAGE(PG8_SB(1, 1), b3 + hstep, voffB); PG8_STAGE(PG8_SA(1, 0), a3, voffA);
            PG8_WAIT_V(8); PG8_WAIT_L(0); PG8_BAR; PG8_MMA(1, 0, At, B0); PG8_MMA(1, 1, At, B1); PG8_BAR; PG8_SCHED;
            } else {
            PG8_LDB(B0, 0, 0); PG8_SCHED; PG8_LDA(At, 0, 0); PG8_STAGE(PG8_SA(1, 1), a1 + hstep, voffA);
            PG8_WAIT_L(8); PG8_BAR; PG8_WAIT_L(0); PG8_MMA(0, 0, At, B0); PG8_BAR; PG8_SCHED;
            PG8_LDB(B1, 0, 1); PG8_STAGE(PG8_SB(0, 0), b2, voffB);
            PG8_BAR; PG8_WAIT_L(0); PG8_MMA(0, 1, At, B1); PG8_BAR;
            PG8_LDA(At, 0, 1); PG8_STAGE(PG8_SA(0, 0), a2, voffA);
            PG8_BAR; PG8_WAIT_L(0); PG8_MMA(1, 0, At, B0); PG8_BAR; PG8_SCHED;
            PG8_STAGE(PG8_SB(0, 1), b2 + hstep, voffB);
            PG8_WAIT_V(6); PG8_BAR; PG8_MMA(1, 1, At, B1); PG8_BAR;
            PG8_LDB(B0, 1, 0); PG8_SCHED; PG8_LDA(At, 1, 0); PG8_STAGE(PG8_SA(0, 1), a2 + hstep, voffA);
            PG8_WAIT_L(8); PG8_BAR; PG8_WAIT_L(0); PG8_MMA(0, 0, At, B0); PG8_BAR; PG8_SCHED;
            PG8_LDB(B1, 1, 1); PG8_STAGE(PG8_SB(1, 0), b3, voffB);
            PG8_BAR; PG8_WAIT_L(0); PG8_MMA(0, 1, At, B1); PG8_BAR;
            PG8_LDA(At, 1, 1); PG8_STAGE(PG8_SA(1, 0), a3, voffA);
            PG8_BAR; PG8_WAIT_L(0); PG8_MMA(1, 0, At, B0); PG8_BAR; PG8_SCHED;
            PG8_STAGE(PG8_SB(1, 1), b3 + hstep, voffB);
            PG8_WAIT_V(6); PG8_BAR; PG8_MMA(1, 1, At, B1); PG8_BAR;
            }
        }
        if constexpr (ALIGN_EPI) { if (wr == 0) PG8_BAR; }
        if constexpr (!Epi::AFTER_DRAIN) { E(acc, cur, wr, wc, fr, fq); S.done(cur); }
        if (!has_next) break;
#pragma unroll
        for (int a = 0; a < 2; ++a)
#pragma unroll
            for (int b = 0; b < 2; ++b)
#pragma unroll
                for (int m = 0; m < 4; ++m)
#pragma unroll
                    for (int n = 0; n < 2; ++n) acc[a][b][m][n] = (f32x4){0.f, 0.f, 0.f, 0.f};
        cur = nxt; cA = nA; cB = nB; ++ui;
        if constexpr (ALIGN_EPI) { if (wr == 1) PG8_BAR; }
    }
    PG8_WAIT_V(0);
    if constexpr (!ALIGN_EPI) { if (wr == 0) PG8_BAR; }
    PG8_BAR;
    if constexpr (Epi::AFTER_DRAIN) { E.fused(acc, cur, wr, wc, fr, fq, lds, wid, lane); S.done(cur); }
#undef PG8_SA
#undef PG8_SB
#undef PG8_STAGE
#undef PG8_LDA
#undef PG8_LDB
#undef PG8_MMA
#undef PG8_WAIT_V
#undef PG8_WAIT_L
#undef PG8_BAR
#undef PG8_SCHED
}
}
namespace epi {
using pg8::f32x4; using pg8::Unit;
typedef unsigned u32x2 __attribute__((ext_vector_type(2)));
typedef unsigned u32x4 __attribute__((ext_vector_type(4)));
typedef float f32x2 __attribute__((ext_vector_type(2)));
typedef __bf16 bf16x2_t __attribute__((ext_vector_type(2)));
__device__ __forceinline__ unsigned pk(float lo, float hi) { f32x2 v = {lo, hi}; bf16x2_t b = __builtin_convertvector(v, bf16x2_t); return __builtin_bit_cast(unsigned, b); }
__device__ __forceinline__ u32x2 pk4(f32x4 v) { u32x2 w; w.x = pk(v[0], v[1]); w.y = pk(v[2], v[3]); return w; }
__device__ __forceinline__ float sum4sq(f32x4 v) { return (v[0] * v[0] + v[1] * v[1]) + (v[2] * v[2] + v[3] * v[3]); }
__device__ __forceinline__ float quad_sum(float s) { s += __shfl_xor(s, 16); s += __shfl_xor(s, 32); return s; }

__device__ __forceinline__ void st32(bf16_t* base32, f32x4 v0, f32x4 v1, int fq) {
    u32x2 a = pk4(v0), b = pk4(v1);
    { auto r = __builtin_amdgcn_permlane16_swap(a.x, b.x, false, false); a.x = r[0]; b.x = r[1]; }
    { auto r = __builtin_amdgcn_permlane16_swap(a.y, b.y, false, false); a.y = r[0]; b.y = r[1]; }
    u32x4 w; w.x = a.x; w.y = a.y; w.z = b.x; w.w = b.y;
    *(u32x4*)(base32 + 16 * (fq & 1) + 8 * (fq >> 1)) = w;
}

__device__ __forceinline__ int kvbase_of(int pm) { return pm < 64 ? (pm >> 3) * SK + CTX + (pm & 7) * 256 : (pm - 64) * SK; }
__device__ __forceinline__ int modidx_pm(int pm) { return pm < 64 ? (pm >> 3) : 8; }

__device__ __forceinline__ void head_finish(f32x4 (&v)[2][2], const float* gain, bool rope, const float* T32, int grow, int gcol, float scale, int fq) {
    float ss = (sum4sq(v[0][0]) + sum4sq(v[0][1])) + (sum4sq(v[1][0]) + sum4sq(v[1][1]));
    ss = quad_sum(ss);
    const float rn = rsqrtf(ss * (1.f / 64.f) + EPS);
#pragma unroll
    for (int bj = 0; bj < 2; ++bj)
#pragma unroll
        for (int n = 0; n < 2; ++n) { const f32x4 g = *(const f32x4*)(gain + 32 * bj + 16 * n + 4 * fq); v[bj][n] = (v[bj][n] * rn) * g; }
    if (rope) {
#pragma unroll
        for (int bj = 0; bj < 2; ++bj) { const int pos = bj ? gcol : grow;
            const f32x4 cs = *(const f32x4*)(T32 + pos * 16 + 4 * fq), sn = *(const f32x4*)(T32 + 1024 + pos * 16 + 4 * fq);
            const f32x4 x1 = v[bj][0], x2 = v[bj][1];
            v[bj][0] = x1 * cs - x2 * sn; v[bj][1] = x1 * sn + x2 * cs; }
    }
#pragma unroll
    for (int bj = 0; bj < 2; ++bj)
#pragma unroll
        for (int n = 0; n < 2; ++n) v[bj][n] = v[bj][n] * scale;
}

struct EpiIn0 {
    static constexpr bool PERM = false, AFTER_DRAIN = false;
    bf16_t *A0, *Q0, *K0, *V0; const float *qg, *kg, *T32;
    __device__ __forceinline__ void operator()(const f32x4 (&acc)[2][2][4][2], const Unit& u, int wr, int wc, int fr_in, int fq_in) const {
        int fr = fr_in, fq = fq_in; asm volatile("" : "+v"(fr), "+v"(fq));
        const int pn = u.pn, pm = u.pm; const bool lat = pm < 64; const int kvb = kvbase_of(pm);
#pragma unroll
        for (int ai = 0; ai < 2; ++ai)
#pragma unroll
            for (int m = 0; m < 4; ++m) {
                const int rl = 128 * ai + 64 * wr + 16 * m + fr; const size_t r = (size_t)pm * 256 + rl;
                if (pn == 0 || pn == 5) {
                    bf16_t* dst = pn == 0 ? A0 + r * 256 : V0 + (size_t)(kvb + rl) * 256;
#pragma unroll
                    for (int bj = 0; bj < 2; ++bj)
                        st32(dst + 64 * wc + 32 * bj, acc[ai][bj][m][0], acc[ai][bj][m][1], fq);
                } else {
                    f32x4 v[2][2] = {{acc[ai][0][m][0], acc[ai][0][m][1]}, {acc[ai][1][m][0], acc[ai][1][m][1]}};
                    const int grow = (pm & 7) * 4 + 2 * ai + wr, gcol = 16 * m + fr;
                    bf16_t* dst;
                    if (pn < 4) { head_finish(v, qg, lat, T32, grow, gcol, C2_64, fq); dst = Q0 + r * 768 + ((pn - 1) * 4 + wc) * 64; }
                    else { head_finish(v, kg, lat, T32, grow, gcol, 1.0f, fq); dst = K0 + (size_t)(kvb + rl) * 256 + wc * 64; }
#pragma unroll
                    for (int bj = 0; bj < 2; ++bj)
                        st32(dst + 32 * bj, v[bj][0], v[bj][1], fq);
                }
            }
    }
};

struct EpiResid {
    static constexpr bool PERM = false, AFTER_DRAIN = false;
    const float *base_l, *base_c; float *out_l, *out_c; const float* mod;
    __device__ __forceinline__ void operator()(const f32x4 (&acc)[2][2][4][2], const Unit& u, int wr, int wc, int fr_in, int fq_in) const {
        int fr = fr_in, fq = fq_in; asm volatile("" : "+v"(fr), "+v"(fq));
        const int pm = u.pm; const bool lat = pm < 64;
        const float* bp = lat ? base_l + (size_t)pm * 256 * D : base_c + (size_t)(pm - 64) * 256 * D;
        float* op = lat ? out_l + (size_t)pm * 256 * D : out_c + (size_t)(pm - 64) * 256 * D;
        const float* gp = mod + (size_t)modidx_pm(pm) * 6144 + u.pn * 256 + 32 * wc + 4 * fq;
        f32x4 g[2][2];
#pragma unroll
        for (int bj = 0; bj < 2; ++bj)
#pragma unroll
            for (int n = 0; n < 2; ++n) g[bj][n] = *(const f32x4*)(gp + 128 * bj + 16 * n);
#pragma unroll
        for (int ai = 0; ai < 2; ++ai)
#pragma unroll
            for (int m = 0; m < 4; ++m) { const size_t off = (size_t)(128 * ai + 64 * wr + 16 * m + fr) * D + u.pn * 256 + 32 * wc + 4 * fq;
#pragma unroll
                for (int bj = 0; bj < 2; ++bj)
#pragma unroll
                    for (int n = 0; n < 2; ++n) { const f32x4 b = *(const f32x4*)(bp + off + 128 * bj + 16 * n); *(f32x4*)(op + off + 128 * bj + 16 * n) = b + g[bj][n] * acc[ai][bj][m][n]; } }
    }
};

struct EpiResidSplit {
    static constexpr bool PERM = false, AFTER_DRAIN = false;
    const float* base_c; float* out_c; float* slab; const float* mod; int ks_base = 0;
    __device__ __forceinline__ void operator()(const f32x4 (&acc)[2][2][4][2], const Unit& u_in, int wr, int wc, int fr_in, int fq_in) const {
        int fr = fr_in, fq = fq_in; asm volatile("" : "+v"(fr), "+v"(fq));
        Unit u = u_in; u.ks += ks_base;
        const int pm = u.pm - 64;
        const float* bp = base_c + (size_t)pm * 256 * D;
        float* op = u.ks == 0 ? out_c + (size_t)pm * 256 * D : slab + (size_t)(u.ks - 1) * MC * D + (size_t)pm * 256 * D;
        const float* gp = mod + (size_t)8 * 6144 + u.pn * 256 + 32 * wc + 4 * fq;
        f32x4 g[2][2];
#pragma unroll
        for (int bj = 0; bj < 2; ++bj)
#pragma unroll
            for (int n = 0; n < 2; ++n) g[bj][n] = *(const f32x4*)(gp + 128 * bj + 16 * n);
#pragma unroll
        for (int ai = 0; ai < 2; ++ai)
#pragma unroll
            for (int m = 0; m < 4; ++m) { const size_t off = (size_t)(128 * ai + 64 * wr + 16 * m + fr) * D + u.pn * 256 + 32 * wc + 4 * fq;
#pragma unroll
                for (int bj = 0; bj < 2; ++bj)
#pragma unroll
                    for (int n = 0; n < 2; ++n) { f32x4 v = g[bj][n] * acc[ai][bj][m][n]; if (u.ks == 0) v += *(const f32x4*)(bp + off + 128 * bj + 16 * n); *(f32x4*)(op + off + 128 * bj + 16 * n) = v; } }
    }
};

struct EpiSwiGLU {
    static constexpr bool PERM = true, AFTER_DRAIN = false;
    bf16_t* H;
    __device__ __forceinline__ void operator()(const f32x4 (&acc)[2][2][4][2], const Unit& u, int wr, int wc, int fr_in, int fq_in) const {
        int fr = fr_in, fq = fq_in; asm volatile("" : "+v"(fr), "+v"(fq));
#pragma unroll
        for (int ai = 0; ai < 2; ++ai)
#pragma unroll
            for (int m = 0; m < 4; ++m) { const size_t r = (size_t)u.pm * 256 + 128 * ai + 64 * wr + 16 * m + fr;
                f32x4 h[2];
#pragma unroll
                for (int n = 0; n < 2; ++n) { const f32x4 g = acc[ai][0][m][n], up = acc[ai][1][m][n];
#pragma unroll
                    for (int e = 0; e < 4; ++e) h[n][e] = g[e] * __builtin_amdgcn_rcpf(1.f + __builtin_amdgcn_exp2f(-g[e] * LOG2E)) * up[e]; }
                u32x4 w; w.x = pk(h[0][0], h[0][1]); w.y = pk(h[0][2], h[0][3]); w.z = pk(h[1][0], h[1][1]); w.w = pk(h[1][2], h[1][3]);
                *(u32x4*)(H + r * FF + u.pn * 128 + 32 * wc + 8 * fq) = w; }
    }
};

typedef unsigned int v4u_t __attribute__((vector_size(16)));
struct EpiSwiGLUW {
    static constexpr bool PERM = true, AFTER_DRAIN = false;
    bf16_t* H;
    __device__ __forceinline__ void operator()(const f32x4 (&acc)[2][2][4][2], const Unit& u, int wr, int wc, int fr_in, int fq_in) const {
        int fr = fr_in, fq = fq_in; asm volatile("" : "+v"(fr), "+v"(fq));
        const __amdgpu_buffer_rsrc_t rs = __builtin_amdgcn_make_buffer_rsrc((void*)(H + (size_t)ML * FF), (short)0, (int)(MC * FF * 2), 0x00020000);
#pragma unroll
        for (int ai = 0; ai < 2; ++ai)
#pragma unroll
            for (int m = 0; m < 4; ++m) { const unsigned r = (unsigned)(u.pm - 64) * 256 + 128 * ai + 64 * wr + 16 * m + fr;
                f32x4 h[2];
#pragma unroll
                for (int n = 0; n < 2; ++n) { const f32x4 g = acc[ai][0][m][n], up = acc[ai][1][m][n];
#pragma unroll
                    for (int e = 0; e < 4; ++e) h[n][e] = g[e] * __builtin_amdgcn_rcpf(1.f + __builtin_amdgcn_exp2f(-g[e] * LOG2E)) * up[e]; }
                u32x4 w; w.x = pk(h[0][0], h[0][1]); w.y = pk(h[0][2], h[0][3]); w.z = pk(h[1][0], h[1][1]); w.w = pk(h[1][2], h[1][3]);
                __builtin_amdgcn_raw_buffer_store_b128(__builtin_bit_cast(v4u_t, w), rs, (r * FF + u.pn * 128 + 32 * wc + 8 * fq) * 2u, 0,   16); }
    }
};

struct EpiIn1 {
    static constexpr bool PERM = false, AFTER_DRAIN = false;
    bf16_t *CQ, *CKV, *NQ, *NK, *NV; float *KR, *SSQ, *SSKV; const float *nqg, *nkg;
    __device__ __forceinline__ void operator()(const f32x4 (&acc)[2][2][4][2], const Unit& u, int wr, int wc, int fr_in, int fq_in) const {
        int fr = fr_in, fq = fq_in; asm volatile("" : "+v"(fr), "+v"(fq));
        const int pn = u.pn, pm = u.pm; const int kvb = kvbase_of(pm);
#pragma unroll
        for (int ai = 0; ai < 2; ++ai)
#pragma unroll
            for (int m = 0; m < 4; ++m) {
                const int rl = 128 * ai + 64 * wr + 16 * m + fr; const size_t r = (size_t)pm * 256 + rl;
                if (pn == 0 || pn == 2) {
                    bf16_t* dst = pn == 0 ? CQ + r * 384 : CKV + r * 256; float ss = 0.f;
#pragma unroll
                    for (int bj = 0; bj < 2; ++bj)
                        { ss += sum4sq(acc[ai][bj][m][0]) + sum4sq(acc[ai][bj][m][1]); st32(dst + 128 * bj + 32 * wc, acc[ai][bj][m][0], acc[ai][bj][m][1], fq); }
                    ss = quad_sum(ss);
                    if (fq == 0) atomicAdd((pn == 0 ? SSQ : SSKV) + r, ss);
                } else if (pn == 1) {
                    float ss = 0.f;
                    { ss += sum4sq(acc[ai][0][m][0]) + sum4sq(acc[ai][0][m][1]); st32(CQ + r * 384 + 256 + 32 * wc, acc[ai][0][m][0], acc[ai][0][m][1], fq); }
                    ss = quad_sum(ss);
                    if (fq == 0) atomicAdd(SSQ + r, ss);
                    if (wc == 0) {
#pragma unroll
                        for (int n = 0; n < 2; ++n) *(f32x4*)(KR + r * 32 + 16 * n + 4 * fq) = acc[ai][1][m][n]; }
                } else if (pn >= 7) {
                    bf16_t* dst = NV + (size_t)(kvb + rl) * 512 + (pn - 7) * 256 + 64 * wc;
#pragma unroll
                    for (int bj = 0; bj < 2; ++bj)
                        st32(dst + 32 * bj, acc[ai][bj][m][0], acc[ai][bj][m][1], fq);
                } else {
                    f32x4 v[2][2] = {{acc[ai][0][m][0], acc[ai][0][m][1]}, {acc[ai][1][m][0], acc[ai][1][m][1]}};
                    bf16_t* dst;
                    if (pn < 5) { head_finish(v, nqg, false, nullptr, 0, 0, C2_64, fq); dst = NQ + r * 512 + ((pn - 3) * 4 + wc) * 64; }
                    else { head_finish(v, nkg, false, nullptr, 0, 0, 1.0f, fq); dst = NK + (size_t)(kvb + rl) * 512 + ((pn - 5) * 4 + wc) * 64; }
#pragma unroll
                    for (int bj = 0; bj < 2; ++bj)
                        st32(dst + 32 * bj, v[bj][0], v[bj][1], fq);
                }
            }
    }
};

struct EpiQUp {
    static constexpr bool PERM = true, AFTER_DRAIN = false;
    bf16_t* MQ; const float* SSQ;
    __device__ __forceinline__ void operator()(const f32x4 (&acc)[2][2][4][2], const Unit& u, int wr, int wc, int fr_in, int fq_in) const {
        int fr = fr_in, fq = fq_in; asm volatile("" : "+v"(fr), "+v"(fq));
#pragma unroll
        for (int ai = 0; ai < 2; ++ai)
#pragma unroll
            for (int m = 0; m < 4; ++m) { const size_t r = (size_t)u.pm * 256 + 128 * ai + 64 * wr + 16 * m + fr;
                const float rs = rsqrtf(SSQ[r] * (1.f / 384.f) + EPS);
#pragma unroll
                for (int bj = 0; bj < 2; ++bj) { const f32x4 a = acc[ai][bj][m][0] * rs, b = acc[ai][bj][m][1] * rs;
                    u32x4 w; w.x = pk(a[0], a[1]); w.y = pk(a[2], a[3]); w.z = pk(b[0], b[1]); w.w = pk(b[2], b[3]);
                    *(u32x4*)(MQ + r * 768 + u.pn * 256 + 128 * bj + 32 * wc + 8 * fq) = w; } }
    }
};

struct EpiKvUp {
    static constexpr bool PERM = false, AFTER_DRAIN = false;
    bf16_t *MK, *MV; const float *SSKV, *KR, *kg, *T16;
    __device__ __forceinline__ void operator()(const f32x4 (&acc)[2][2][4][2], const Unit& u, int wr, int wc, int fr_in, int fq_in) const {
        int fr = fr_in, fq = fq_in; asm volatile("" : "+v"(fr), "+v"(fq));
        const int pm = u.pm; const bool lat = pm < 64; const int kvb = kvbase_of(pm); const int head = 2 * u.pn + (wc >> 1); const bool isv = wc & 1;
        float rs[2][4];
#pragma unroll
        for (int ai = 0; ai < 2; ++ai)
#pragma unroll
            for (int m = 0; m < 4; ++m) rs[ai][m] = SSKV[(size_t)pm * 256 + 128 * ai + 64 * wr + 16 * m + fr];
#pragma unroll
        for (int ai = 0; ai < 2; ++ai)
#pragma unroll
            for (int m = 0; m < 4; ++m) rs[ai][m] = rsqrtf(rs[ai][m] * (1.f / 256.f) + EPS);
        if (isv) {
#pragma unroll
            for (int ai = 0; ai < 2; ++ai)
#pragma unroll
                for (int m = 0; m < 4; ++m) { const size_t kvr = (size_t)(kvb + 128 * ai + 64 * wr + 16 * m + fr);
#pragma unroll
                    for (int bj = 0; bj < 2; ++bj)
                        st32(MV + kvr * 512 + head * 64 + 32 * bj, acc[ai][bj][m][0] * rs[ai][m], acc[ai][bj][m][1] * rs[ai][m], fq); }
            return;
        }
        f32x4 gn[2][2]; f32x2 gr[4];
#pragma unroll
        for (int bj = 0; bj < 2; ++bj)
#pragma unroll
            for (int n = 0; n < 2; ++n) gn[bj][n] = *(const f32x4*)(kg + 32 * bj + 16 * n + 4 * fq);
#pragma unroll
        for (int j = 0; j < 4; ++j) gr[j] = *(const f32x2*)(kg + 64 + 8 * j + 2 * fq);
#pragma unroll
        for (int ai = 0; ai < 2; ++ai) {
            const int grow = (pm & 7) * 4 + 2 * ai + wr;
            f32x2 csr = {1.f, 1.f}, snr = {0.f, 0.f};
            if (lat) { csr = *(const f32x2*)(T16 + grow * 8 + 2 * fq); snr = *(const f32x2*)(T16 + 512 + grow * 8 + 2 * fq); }
#pragma unroll
            for (int m = 0; m < 4; ++m) {
                const int rl = 128 * ai + 64 * wr + 16 * m + fr; const size_t r = (size_t)pm * 256 + rl; const size_t kvr = (size_t)(kvb + rl);
                f32x2 k[4];
#pragma unroll
                for (int j = 0; j < 4; ++j) k[j] = *(const f32x2*)(KR + r * 32 + 8 * j + 2 * fq);
                f32x2 csc = {1.f, 1.f}, snc = {0.f, 0.f};
                if (lat) { const int gcol = 16 * m + fr; csc = *(const f32x2*)(T16 + gcol * 8 + 2 * fq); snc = *(const f32x2*)(T16 + 512 + gcol * 8 + 2 * fq); }
                f32x4 v[2][2];
#pragma unroll
                for (int bj = 0; bj < 2; ++bj)
#pragma unroll
                    for (int n = 0; n < 2; ++n) v[bj][n] = acc[ai][bj][m][n] * rs[ai][m];
                float ss = (sum4sq(v[0][0]) + sum4sq(v[0][1])) + (sum4sq(v[1][0]) + sum4sq(v[1][1]));
#pragma unroll
                for (int j = 0; j < 4; ++j) ss += k[j][0] * k[j][0] + k[j][1] * k[j][1];
                ss = quad_sum(ss);
                const float rr = rsqrtf(ss * (1.f / 96.f) + EPS);
#pragma unroll
                for (int bj = 0; bj < 2; ++bj)
                    st32(MK + kvr * 768 + head * 96 + 32 * bj, (v[bj][0] * rr) * gn[bj][0], (v[bj][1] * rr) * gn[bj][1], fq);
#pragma unroll
                for (int j = 0; j < 4; ++j) k[j] = (k[j] * rr) * gr[j];
                { const f32x2 x1 = k[0], x2 = k[1]; k[0] = x1 * csr - x2 * snr; k[1] = x1 * snr + x2 * csr; }
                { const f32x2 x1 = k[2], x2 = k[3]; k[2] = x1 * csc - x2 * snc; k[3] = x1 * snc + x2 * csc; }
#pragma unroll
                for (int j = 0; j < 4; ++j) *(unsigned*)(MK + kvr * 768 + head * 96 + 64 + 8 * j + 2 * fq) = pk(k[j][0], k[j][1]);
                if (m & 1) asm volatile("" ::: "memory");
            }
        }
    }
};
}
namespace att {
using bf16x8 = __attribute__((ext_vector_type(8))) short;
using s16x4 = __attribute__((ext_vector_type(4))) short;
using f32x16 = __attribute__((ext_vector_type(16))) float;
using u32x4 = __attribute__((ext_vector_type(4))) unsigned;
typedef float f32x2_t __attribute__((ext_vector_type(2))); typedef __bf16 bf16x2_t __attribute__((ext_vector_type(2)));
#define ALAS __attribute__((address_space(3)))
constexpr int KSLOT = 12288, VSLOT = 8192, SLOT = KSLOT + VSLOT, NSLOT = 4, PD = NSLOT - 2;
constexpr int LDS_WS = NSLOT * SLOT;
constexpr int LDS_OST = LDS_WS + 8 * 256;
constexpr int LDS_RPB = LDS_OST + 8 * 4096;
constexpr int LDS_BYTES = LDS_RPB + 4096;
constexpr float THR = 8.0f;

__device__ __forceinline__ int crow(int r, int hi) { return (r & 3) + 8 * (r >> 2) + 4 * hi; }
__device__ __forceinline__ void glds16(const void* gsrc, unsigned lds_dst) { unsigned keep;
    asm volatile("s_mov_b32 %0, m0\n\ts_mov_b32 m0, %2\n\ts_nop 0\n\tglobal_load_lds_dwordx4 %1, off\n\ts_mov_b32 m0, %0" : "=&s"(keep) : "v"(gsrc), "s"(lds_dst) : "memory"); }
__device__ __forceinline__ unsigned cvtpk(float lo, float hi) { f32x2_t v = {lo, hi}; bf16x2_t b = __builtin_convertvector(v, bf16x2_t); return __builtin_bit_cast(unsigned, b); }
__device__ __forceinline__ void glds16s(unsigned voff, const void* sbase, unsigned lds_dst) { unsigned keep;
    asm volatile("s_mov_b32 %0, m0\n\ts_mov_b32 m0, %3\n\ts_nop 0\n\tglobal_load_lds_dwordx4 %1, %2\n\ts_mov_b32 m0, %0" : "=&s"(keep) : "v"(voff), "s"(sbase), "s"(lds_dst) : "memory"); }
__device__ __forceinline__ float max3f(float a, float b, float c) { float r; asm("v_max3_f32 %0, %1, %2, %3" : "=v"(r) : "v"(a), "v"(b), "v"(c)); return r; }
__device__ __forceinline__ float max2f(float a, float b) { float r; asm("v_max_f32_e32 %0, %1, %2" : "=v"(r) : "v"(a), "v"(b)); return r; }
#define AWAIT_BAR(N) asm volatile("s_waitcnt vmcnt(" #N ") lgkmcnt(0)\n\ts_barrier" ::: "memory")

template <int ND0> __device__ __forceinline__ void qkt(f32x16& p0, f32x16& p1, const ALAS char* Kslot, const bf16x8* qr, const f32x16& negm, int r32, int hi) {
    const ALAS char* kb = Kslot + hi * 1024 + r32 * 16;
#pragma unroll
    for (int d0 = 0; d0 < ND0; ++d0) {
        const bf16x8 b0 = *(const ALAS bf16x8*)(kb + d0 * 2048);
        const bf16x8 b1 = *(const ALAS bf16x8*)(kb + d0 * 2048 + 512);
        if (d0 == 0) { p0 = __builtin_amdgcn_mfma_f32_32x32x16_bf16(b0, qr[0], negm, 0, 0, 0); p1 = __builtin_amdgcn_mfma_f32_32x32x16_bf16(b1, qr[0], negm, 0, 0, 0); }
        else { p0 = __builtin_amdgcn_mfma_f32_32x32x16_bf16(b0, qr[d0], p0, 0, 0, 0); p1 = __builtin_amdgcn_mfma_f32_32x32x16_bf16(b1, qr[d0], p1, 0, 0, 0); }
    }
}
__device__ __forceinline__ float rowmax32(const f32x16& p0, const f32x16& p1) {
    float a[4];
#pragma unroll
    for (int k = 0; k < 4; ++k) { a[k] = max3f(p0[4 * k], p0[4 * k + 1], p0[4 * k + 2]); }
#pragma unroll
    for (int k = 0; k < 4; ++k) { a[k] = max3f(a[k], p0[4 * k + 3], p1[4 * k]); }
#pragma unroll
    for (int k = 0; k < 4; ++k) { a[k] = max3f(a[k], p1[4 * k + 1], p1[4 * k + 2]); }
    const float m = max3f(max3f(a[0], p1[3], p1[7]), max3f(a[1], p1[11], p1[15]), max2f(a[2], a[3]));
    auto rr = __builtin_amdgcn_permlane32_swap(__float_as_uint(m), __float_as_uint(m), false, false);
    return max2f(__uint_as_float(rr[0]), __uint_as_float(rr[1]));
}
typedef short v4i16_t __attribute__((ext_vector_type(4)));
__device__ __forceinline__ s16x4 vtr(const ALAS char* p) { return __builtin_bit_cast(s16x4, __builtin_amdgcn_ds_read_tr16_b64_v4i16((ALAS v4i16_t*)p)); }
__device__ __forceinline__ void pv(f32x16* o, const ALAS char* vp, bf16x8 pa0, bf16x8 pa1, bf16x8 pa2, bf16x8 pa3) {
#pragma unroll
    for (int d0 = 0; d0 < 2; ++d0) { s16x4 lo[4], hi[4];
#pragma unroll
        for (int ks = 0; ks < 4; ++ks) { lo[ks] = vtr(vp + d0 * 4096 + ks * 1024); hi[ks] = vtr(vp + d0 * 4096 + ks * 1024 + 512); }
#define APK(k) (bf16x8){lo[k][0], lo[k][1], lo[k][2], lo[k][3], hi[k][0], hi[k][1], hi[k][2], hi[k][3]}
        o[d0] = __builtin_amdgcn_mfma_f32_32x32x16_bf16(pa0, APK(0), o[d0], 0, 0, 0);
        o[d0] = __builtin_amdgcn_mfma_f32_32x32x16_bf16(pa1, APK(1), o[d0], 0, 0, 0);
        o[d0] = __builtin_amdgcn_mfma_f32_32x32x16_bf16(pa2, APK(2), o[d0], 0, 0, 0);
        o[d0] = __builtin_amdgcn_mfma_f32_32x32x16_bf16(pa3, APK(3), o[d0], 0, 0, 0);
#undef APK
    }
}

struct UnitDesc {
    const bf16_t* Q; int qpitch;
    long q0; int qcol;
    const bf16_t* K; int kpitch, kcol;
    const bf16_t* V; int vpitch, vcol;
    bf16_t* O; int opitch, ocol;
    int kv0;
    int nt;
    int rg;
    int rmin;
    int head;
    const bf16_t* G;
};

template <int DQK, bool NA, bool MLAQ>
__device__ __forceinline__ void attn_unit(const UnitDesc& U, ALAS char* shm, const float* qgain, const float* T16, const float* rpb_g) {
    constexpr int ND0 = DQK / 16, NCH = DQK / 8, NP = NCH + 8;
    int tid_ = threadIdx.x; asm volatile("" : "+v"(tid_));
    const int tid = tid_, lane = tid & 63, r32 = lane & 31, hi = lane >> 5; const int wid = __builtin_amdgcn_readfirstlane(tid >> 6);
#ifdef ATT_STATIC_PRIO_NA
    if (wid >= 4) __builtin_amdgcn_s_setprio(1);
#endif
    const unsigned lds0 = (unsigned)(uintptr_t)shm;
    ALAS float* wsf = (ALAS float*)(shm + LDS_WS) + wid * 64;
    unsigned doff[3];
#pragma unroll
    for (int i = 0; i < 3; ++i) { const int pc = wid + 8 * i;
        if (pc < NCH) doff[i] = (unsigned)((lane * U.kpitch + U.kcol + pc * 8) * 2);
        else { const int v = pc - NCH; doff[i] = (unsigned)(((16 * (v & 3) + (lane >> 2)) * U.vpitch + U.vcol + (v >> 2) * 32 + (lane & 3) * 8) * 2); } }
    auto dma_tile = [&](int t, int slot) {
        int key0;
        if (NA && t >= 4) key0 = U.kv0 + CTX + (U.rmin + (t - 4)) * GW; else key0 = U.kv0 + 64 * t;
        const unsigned sbase = lds0 + slot * SLOT;
        const bf16_t* kb_ = U.K + (size_t)key0 * U.kpitch; const bf16_t* vb_ = U.V + (size_t)key0 * U.vpitch;
#pragma unroll
        for (int i = 0; i < 3; ++i) { const int pc = wid + 8 * i;
            if (pc < NP) {
                if (pc < NCH) glds16s(doff[i], kb_, (unsigned)__builtin_amdgcn_readfirstlane(sbase + pc * 1024));
                else glds16s(doff[i], vb_, (unsigned)__builtin_amdgcn_readfirstlane(sbase + KSLOT + (pc - NCH) * 1024));
#ifdef ATT_DUP_DMA
                if (pc < NCH) glds16s(doff[i], kb_, (unsigned)__builtin_amdgcn_readfirstlane(sbase + pc * 1024));
                else glds16s(doff[i], vb_, (unsigned)__builtin_amdgcn_readfirstlane(sbase + KSLOT + (pc - NCH) * 1024));
#endif
            } }
    };
    asm volatile("s_waitcnt vmcnt(0)" ::: "memory");
#pragma unroll
    for (int t0_ = 0; t0_ < PD; ++t0_) if (t0_ < U.nt) dma_tile(t0_, t0_);
    bf16x8 qr[ND0];
    const bf16_t* Qw = U.Q + (size_t)(U.q0 + wid * 32 + r32) * U.qpitch + U.qcol;
#pragma unroll
    for (int d0 = 0; d0 < ND0; ++d0) qr[d0] = *(const bf16x8*)(Qw + d0 * 16 + hi * 8);
    if (MLAQ) {
        float f[ND0][8]; float ss = 0.f;
#pragma unroll
        for (int d0 = 0; d0 < ND0; ++d0)
#pragma unroll
            for (int j = 0; j < 8; ++j) { f[d0][j] = bf2f((bf16_t)qr[d0][j]); ss += f[d0][j] * f[d0][j]; }
        ss += __shfl_xor(ss, 32);
        const float rn = rsqrtf(ss * (1.f / 96.f) + EPS) * C2_96;
#pragma unroll
        for (int d0 = 0; d0 < ND0; ++d0)
#pragma unroll
            for (int j = 0; j < 8; ++j) f[d0][j] = f[d0][j] * rn * qgain[d0 * 16 + hi * 8 + j];
        const int t = (int)((U.q0 + wid * 32 + r32) % S); const int grow = t / GW, gcol = t % GW;
#pragma unroll
        for (int part = 0; part < 2; ++part) { const int pos = part ? gcol : grow;
#pragma unroll
            for (int j = 0; j < 8; ++j) { const float cs = T16[pos * 8 + j], sn = T16[512 + pos * 8 + j];
                const float mine = f[4 + part][j], other = __shfl_xor(mine, 32);
                f[4 + part][j] = hi == 0 ? (mine * cs - other * sn) : (other * sn + mine * cs); } }
#pragma unroll
        for (int d0 = 0; d0 < ND0; ++d0)
#pragma unroll
            for (int j = 0; j < 4; ++j) { const unsigned w = cvtpk(f[d0][2 * j], f[d0][2 * j + 1]); qr[d0][2 * j] = (short)(w & 0xffff); qr[d0][2 * j + 1] = (short)(w >> 16); }
    }
    const int grow_w = NA ? 4 * U.rg + (wid >> 1) : 0, c0w = 32 * (wid & 1);
    const int r0w = NA ? min(max(grow_w - 4, 0), 24) : 0;
    const int qc = c0w + r32;
    const int cs_q = min(max(qc - 8, 0), 48);
    float mhat = 0.f, l_reg = 0.f; f32x16 o[2]; o[0] = f32x16{}; o[1] = f32x16{};
    const ALAS char* vp0 = shm + KSLOT + ((lane >> 4) & 1) * 32 + (lane & 3) * 8 + (4 * hi + ((lane & 15) >> 2)) * 64;
    const int NT = U.nt;
    f32x16 a0, a1, b0, b1;
    u32x4 pw0, pw1, pw2, pw3;
    auto wait_tile = [&](int t) {
        const int ahead = min(PD - 1, NT - 1 - t);
        const bool big = (NP == 20 && wid < 4);
#ifdef ATT_DUP_DMA
        if (ahead >= 1) { if (big) AWAIT_BAR(6); else AWAIT_BAR(4); }
        else AWAIT_BAR(0);
#else
        if (ahead >= 2) { if (big) AWAIT_BAR(6); else AWAIT_BAR(4); }
        else if (ahead == 1) { if (big) AWAIT_BAR(3); else AWAIT_BAR(2); }
        else AWAIT_BAR(0);
#endif
        if (t + PD < NT) dma_tile(t + PD, (t + PD) % NSLOT);
    };
    bf16x8 eq[2];
    if (NA) {
#pragma unroll
        for (int s_ = 0; s_ < 2; ++s_)
#pragma unroll
            for (int jj = 0; jj < 8; ++jj) eq[s_][jj] = (16 * s_ + 8 * hi + jj == r32) ? (short)0x3f80 : (short)0;
    }
    const bf16_t* gq = NA ? U.G + (size_t)U.head * (16 * 2 * 64 * 32) + (size_t)(wid & 1) * (64 * 32) + r32 * 32 + hi * 8 : nullptr;
    auto gbias_load = [&](bf16x8 (&f)[4], int t) {
        const int krow = U.rmin + (t - 4); int dr = krow - grow_w + 7; if (krow < r0w || krow >= r0w + 8) dr = 15;
        const bf16_t* g = gq + (size_t)dr * (2 * 64 * 32);
#pragma unroll
        for (int half = 0; half < 2; ++half)
#pragma unroll
            for (int s_ = 0; s_ < 2; ++s_) f[2 * s_ + half] = *(const bf16x8*)(g + half * 1024 + s_ * 16);
    };
    auto gbias_mma = [&](f32x16& c0, f32x16& c1, const bf16x8 (&f)[4]) {
        c0 = __builtin_amdgcn_mfma_f32_32x32x16_bf16(f[0], eq[0], c0, 0, 0, 0); c1 = __builtin_amdgcn_mfma_f32_32x32x16_bf16(f[1], eq[0], c1, 0, 0, 0);
        c0 = __builtin_amdgcn_mfma_f32_32x32x16_bf16(f[2], eq[1], c0, 0, 0, 0); c1 = __builtin_amdgcn_mfma_f32_32x32x16_bf16(f[3], eq[1], c1, 0, 0, 0);
    };
    constexpr bool NEGM = true;
    f32x16 negm = f32x16{};
    auto decide = [&](f32x16& c0, f32x16& c1, bool first) -> bool {
        const float rm = rowmax32(c0, c1);
        if (first || __any(rm > THR)) {
            const float dl = first ? rm : fmaxf(rm, 0.f);
            mhat += dl;
#pragma unroll
            for (int r = 0; r < 16; ++r) { c0[r] -= dl; c1[r] -= dl; }
#pragma unroll
            for (int r = 0; r < 16; ++r) negm[r] = -mhat;
            if (!first) { const float f = __builtin_amdgcn_exp2f(-dl); l_reg *= f; if (hi == 0) wsf[r32] = f; return true; }
        }
        return false;
    };
    auto rescale_o = [&]() {
        asm volatile("s_waitcnt lgkmcnt(0)" ::: "memory");
#pragma unroll
        for (int r = 0; r < 16; ++r) { const float fr_ = wsf[crow(r, hi)]; o[0][r] *= fr_; o[1][r] *= fr_; }
    };
    auto expo = [&](f32x16& c0, f32x16& c1) {
#pragma unroll
        for (int r = 0; r < 16; ++r) { c0[r] = __builtin_amdgcn_exp2f(c0[r]); c1[r] = __builtin_amdgcn_exp2f(c1[r]); }
    };
    auto sumpack = [&](const f32x16& c0, const f32x16& c1) {
        float s4[4];
#pragma unroll
        for (int k = 0; k < 4; ++k) s4[k] = c0[k] + c1[k];
#pragma unroll
        for (int r = 4; r < 16; ++r) s4[r & 3] += c0[r] + c1[r];
        l_reg += (s4[0] + s4[1]) + (s4[2] + s4[3]);
#pragma unroll
        for (int j = 0; j < 4; ++j) { pw0[j] = cvtpk(c0[2 * j], c0[2 * j + 1]); pw1[j] = cvtpk(c0[8 + 2 * j], c0[9 + 2 * j]); pw2[j] = cvtpk(c1[2 * j], c1[2 * j + 1]); pw3[j] = cvtpk(c1[8 + 2 * j], c1[9 + 2 * j]); }
    };
    auto step = [&](f32x16& c0, f32x16& c1, f32x16& q0, f32x16& q1, int j) {
        wait_tile(j);
        bf16x8 gf[4];
        if (NA && j >= 4) gbias_load(gf, j);
        qkt<ND0>(c0, c1, shm + (j % NSLOT) * SLOT, qr, negm, r32, hi);
        if (NA && j >= 4) gbias_mma(c0, c1, gf);
        sumpack(q0, q1);
        const bool resc = decide(c0, c1, false);
        pv(o, vp0 + ((j - 1) % NSLOT) * SLOT, __builtin_bit_cast(bf16x8, pw0), __builtin_bit_cast(bf16x8, pw1), __builtin_bit_cast(bf16x8, pw2), __builtin_bit_cast(bf16x8, pw3));
        expo(c0, c1);
        if (resc) rescale_o();
    };
    wait_tile(0);
    qkt<ND0>(a0, a1, shm, qr, negm, r32, hi);
    (void)decide(a0, a1, true);
    expo(a0, a1);
    int j = 1;
#pragma unroll 1
    for (; j + 1 < NT; j += 2) { step(b0, b1, a0, a1, j); step(a0, a1, b0, b1, j + 1); }
    if (j < NT) { step(b0, b1, a0, a1, j); sumpack(b0, b1); } else sumpack(a0, a1);
    pv(o, vp0 + ((NT - 1) % NSLOT) * SLOT, __builtin_bit_cast(bf16x8, pw0), __builtin_bit_cast(bf16x8, pw1), __builtin_bit_cast(bf16x8, pw2), __builtin_bit_cast(bf16x8, pw3));
    { auto rr = __builtin_amdgcn_permlane32_swap(__float_as_uint(l_reg), __float_as_uint(l_reg), false, false); l_reg = __uint_as_float(rr[0]) + __uint_as_float(rr[1]); }
    if (hi == 0) wsf[32 + r32] = l_reg;
    asm volatile("s_waitcnt lgkmcnt(0)" ::: "memory");
    float rli[16];
#pragma unroll
    for (int r = 0; r < 16; ++r) rli[r] = __builtin_amdgcn_rcpf(wsf[32 + crow(r, hi)]);
    bf16_t* Ow = U.O + (size_t)(U.q0 + wid * 32) * U.opitch + U.ocol;
    { ALAS bf16_t* stg = (ALAS bf16_t*)(shm + LDS_OST) + wid * 2048;
#pragma unroll
        for (int r = 0; r < 16; ++r) { const int orow = crow(r, hi);
#pragma unroll
            for (int d0 = 0; d0 < 2; ++d0) stg[orow * 64 + d0 * 32 + r32] = f2bf(o[d0][r] * rli[r]); }
        asm volatile("s_waitcnt lgkmcnt(0)" ::: "memory");
#pragma unroll
        for (int i = 0; i < 4; ++i) { const int row = i * 8 + (lane >> 3), ch = lane & 7; const u32x4 v = *(const ALAS u32x4*)(stg + row * 64 + ch * 8); *(u32x4*)(Ow + (size_t)row * U.opitch + ch * 8) = v; } }
#ifdef ATT_STATIC_PRIO_NA
    __builtin_amdgcn_s_setprio(0);
#endif
    asm volatile("s_waitcnt vmcnt(0) lgkmcnt(0)\n\ts_barrier" ::: "memory");
}
}
#include <hip/hip_bf16.h>
namespace att64 {
using bf16=__hip_bfloat16;
using bf16x8=__attribute__((ext_vector_type(8)))short;
using s16x4=__attribute__((ext_vector_type(4)))short;
using f32x16=__attribute__((ext_vector_type(16)))float;
using u32x4=__attribute__((ext_vector_type(4)))unsigned;
constexpr int D=64;
constexpr int NW=8,QBLK=32,QB=QBLK*NW,KVBLK=64;

__device__ __forceinline__ int crow(int r,int hi){return (r&3)+8*(r>>2)+4*hi;}
#define SBAR() __builtin_amdgcn_sched_barrier(0)
__device__ __forceinline__ void cmask(f32x16&p0,f32x16&p1,int jb,int qrel,int hi){
  const float NEG=-INFINITY; int kb=64*jb+4*hi;
  #pragma unroll
  for(int r=0;r<16;++r){int kv=kb+(r&3)+8*(r>>2); if(kv>qrel)p0[r]=NEG; if(kv+32>qrel)p1[r]=NEG;}
}

constexpr int NSLOT=3, SLOTB=8192;
constexpr int LDS_K=0, LDS_V=NSLOT*SLOTB, LDS_WS=2*NSLOT*SLOTB, LDS_OST=LDS_WS+NW*64*4, LDS_BYTES=LDS_OST+NW*4096;
constexpr float C2=0.125f*1.4426950408889634f;
__device__ __forceinline__ void glds16(const void*gsrc,unsigned lds_dst){unsigned keep;
  asm volatile("s_mov_b32 %0, m0\n\ts_mov_b32 m0, %2\n\ts_nop 0\n\tglobal_load_lds_dwordx4 %1, off\n\ts_mov_b32 m0, %0":"=&s"(keep):"v"(gsrc),"s"(lds_dst):"memory");}
__device__ __forceinline__ float max3f(float a,float b,float c){float r;asm("v_max3_f32 %0, %1, %2, %3":"=v"(r):"v"(a),"v"(b),"v"(c));return r;}
__device__ __forceinline__ float max2f(float a,float b){float r;asm("v_max_f32_e32 %0, %1, %2":"=v"(r):"v"(a),"v"(b));return r;}
__device__ __forceinline__ float fadd_s(float a,float b){float r;asm("v_add_f32_e32 %0, %1, %2":"=v"(r):"v"(a),"v"(b));return r;}
__device__ __forceinline__ float fsub_s(float a,float b){float r;asm("v_sub_f32_e32 %0, %1, %2":"=v"(r):"v"(a),"v"(b));return r;}
typedef float f32x2_t __attribute__((ext_vector_type(2))); typedef __bf16 bf16x2_t __attribute__((ext_vector_type(2)));
__device__ __forceinline__ unsigned cvtpk_s(float lo,float hi){f32x2_t v={lo,hi};bf16x2_t b=__builtin_convertvector(v,bf16x2_t);return __builtin_bit_cast(unsigned,b);}
#define WAIT_BAR(N) asm volatile("s_waitcnt vmcnt(" #N ") lgkmcnt(0)\n\ts_barrier":::"memory")

__device__ __forceinline__ void qkt(f32x16&p0,f32x16&p1,const char*Kslot,const bf16x8*qr,const f32x16&negm,int r32,int hi){
  const char*kb=Kslot+hi*1024+r32*16;
  #pragma unroll
  for(int d0=0;d0<4;++d0){
    const bf16x8 b0=*reinterpret_cast<const bf16x8*>(kb+d0*2048);
    const bf16x8 b1=*reinterpret_cast<const bf16x8*>(kb+d0*2048+512);
    if(d0==0){p0=__builtin_amdgcn_mfma_f32_32x32x16_bf16(b0,qr[0],negm,0,0,0);p1=__builtin_amdgcn_mfma_f32_32x32x16_bf16(b1,qr[0],negm,0,0,0);}
    else{p0=__builtin_amdgcn_mfma_f32_32x32x16_bf16(b0,qr[d0],p0,0,0,0);p1=__builtin_amdgcn_mfma_f32_32x32x16_bf16(b1,qr[d0],p1,0,0,0);}}
}
typedef __attribute__((address_space(3))) const char* lds_cptr;
typedef short v4i16_t __attribute__((ext_vector_type(4)));
__device__ __forceinline__ void kload8(bf16x8*kf,lds_cptr kp){
  kf[0]=*(const __attribute__((address_space(3))) bf16x8*)(kp);      kf[1]=*(const __attribute__((address_space(3))) bf16x8*)(kp+512);
  kf[2]=*(const __attribute__((address_space(3))) bf16x8*)(kp+2048); kf[3]=*(const __attribute__((address_space(3))) bf16x8*)(kp+2560);
  kf[4]=*(const __attribute__((address_space(3))) bf16x8*)(kp+4096); kf[5]=*(const __attribute__((address_space(3))) bf16x8*)(kp+4608);
  kf[6]=*(const __attribute__((address_space(3))) bf16x8*)(kp+6144); kf[7]=*(const __attribute__((address_space(3))) bf16x8*)(kp+6656);
}
__device__ __forceinline__ void kload2(bf16x8*kf,lds_cptr kp,int j){ kf[2*j]=*(const __attribute__((address_space(3))) bf16x8*)(kp+j*2048); kf[2*j+1]=*(const __attribute__((address_space(3))) bf16x8*)(kp+j*2048+512); }
__device__ __forceinline__ s16x4 vtr(lds_cptr p){ return __builtin_bit_cast(s16x4,__builtin_amdgcn_ds_read_tr16_b64_v4i16((__attribute__((address_space(3))) v4i16_t*)p)); }
__device__ __forceinline__ float rowmax(const f32x16&p0,const f32x16&p1){
  float a=max3f(p0[0],p0[1],p1[0]),b=max3f(p0[2],p0[3],p1[1]);a=max3f(a,p1[2],p1[3]);
  #pragma unroll
  for(int r=4;r<16;r+=4){a=max3f(a,p0[r],p0[r+1]);b=max3f(b,p0[r+2],p0[r+3]);a=max3f(a,p1[r],p1[r+1]);b=max3f(b,p1[r+2],p1[r+3]);}
  const float m=max2f(a,b);
  auto rr=__builtin_amdgcn_permlane32_swap(__float_as_uint(m),__float_as_uint(m),false,false);
  return max2f(__uint_as_float(rr[0]),__uint_as_float(rr[1]));
}
__device__ __forceinline__ void pv(f32x16*o,int vb,bf16x8 pa0,bf16x8 pa1,bf16x8 pa2,bf16x8 pa3){
  #pragma unroll
  for(int d0=0;d0<2;++d0){s16x4 lo[4],hi[4];
    #pragma unroll
    for(int ks=0;ks<4;++ks){
      asm volatile("ds_read_b64_tr_b16 %0,%1 offset:%c2":"=&v"(lo[ks]):"v"(vb),"i"(d0*4096+ks*1024):"memory");
      asm volatile("ds_read_b64_tr_b16 %0,%1 offset:%c2":"=&v"(hi[ks]):"v"(vb),"i"(d0*4096+ks*1024+512):"memory");}
    asm volatile("s_waitcnt lgkmcnt(0)":::"memory");SBAR();
    #define PK(k) (bf16x8){lo[k][0],lo[k][1],lo[k][2],lo[k][3],hi[k][0],hi[k][1],hi[k][2],hi[k][3]}
    o[d0]=__builtin_amdgcn_mfma_f32_32x32x16_bf16(pa0,PK(0),o[d0],0,0,0);
    o[d0]=__builtin_amdgcn_mfma_f32_32x32x16_bf16(pa1,PK(1),o[d0],0,0,0);
    o[d0]=__builtin_amdgcn_mfma_f32_32x32x16_bf16(pa2,PK(2),o[d0],0,0,0);
    o[d0]=__builtin_amdgcn_mfma_f32_32x32x16_bf16(pa3,PK(3),o[d0],0,0,0);
    #undef PK
  }
}

#ifndef ATTN_STORE16
#define ATTN_STORE16(p,v) (*(u32x4*)(p)=(v))
#endif
template<int THRL> __device__ __forceinline__ void attn_unit(long q0,const bf16*Q,int qp,int qcol,const bf16*__restrict__ K,int kp,int kcol,const bf16*__restrict__ V,int vp,int vcol,long kv0,int NT,bf16*O,int op,int ocol,char*shm){
  int tid_=threadIdx.x; asm volatile("":"+v"(tid_));
  const int tid=tid_,lane=tid&63,r32=lane&31,hi=lane>>5; const int wid=__builtin_amdgcn_readfirstlane(tid>>6);
#ifdef ATT_STATIC_PRIO
  if(wid>=4)__builtin_amdgcn_s_setprio(1);
#endif
  const bf16*Qw=Q+(q0+wid*QBLK)*qp+qcol;
  const bf16*Kh=K+kv0*kp+kcol,*Vh=V+kv0*vp+vcol;
  const unsigned lds0=(unsigned)(uintptr_t)shm;
  float*wsf=(float*)(shm+LDS_WS)+wid*64;
  const bf16*ksrc=Kh+(long)lane*kp+wid*8;
  const bf16*vsrc=Vh+(long)(16*(wid&3)+(lane>>2))*vp+(wid>>2)*32+(lane&3)*8;
  const unsigned kdst=lds0+LDS_K+wid*1024, vdst=lds0+LDS_V+wid*1024;
  #define DMA_K(t,slot) glds16(ksrc+(long)(t)*KVBLK*kp,(unsigned)__builtin_amdgcn_readfirstlane(kdst+(slot)))
  #define DMA_V(t,slot) glds16(vsrc+(long)(t)*KVBLK*vp,(unsigned)__builtin_amdgcn_readfirstlane(vdst+(slot)))
  const int vb0=(int)(lds0+LDS_V)+((lane>>4)&1)*32+(lane&3)*8+(4*hi+((lane&15)>>2))*64;
  const char*Kbase=shm+LDS_K; bf16x8 kf[8];
  const lds_cptr shm3=(lds_cptr)shm; const lds_cptr kp0=shm3+LDS_K+hi*1024+r32*16; const lds_cptr vp0=shm3+LDS_V+((lane>>4)&1)*32+(lane&3)*8+(4*hi+((lane&15)>>2))*64;
  DMA_K(0,0);DMA_V(0,0);DMA_K(1,SLOTB);
  bf16x8 qr[4];
  #pragma unroll
  for(int d0=0;d0<4;++d0)qr[d0]=*reinterpret_cast<const bf16x8*>(&Qw[(long)r32*qp+d0*16+hi*8]);
  float mhat=0.f,l_reg=0.f;f32x16 o[2];o[0]=f32x16{};o[1]=f32x16{};f32x16 negm=f32x16{};asm volatile("":"+v"(negm));
  #define CMASK(P0,P1,t) do{}while(0)
  bool resc=false;
  #define START(P0,P1) do{ const float rm=rowmax(P0,P1); resc=false; \
    { const float dl=rm; mhat=fadd_s(mhat,dl); \
      _Pragma("unroll") for(int r=0;r<16;++r){P0[r]=fsub_s(P0[r],dl);P1[r]=fsub_s(P1[r],dl);} \
      _Pragma("unroll") for(int r=0;r<16;++r)negm[r]=-mhat; asm volatile("":"+v"(negm)); } \
    _Pragma("unroll") for(int r=0;r<16;++r)P0[r]=__builtin_amdgcn_exp2f(P0[r]); }while(0)
  #define RESC() do{ if(resc){ asm volatile("s_waitcnt lgkmcnt(0)":::"memory"); \
      _Pragma("unroll") for(int d_=0;d_<2;++d_) _Pragma("unroll") for(int r=0;r<16;++r)o[d_][r]*=wsf[crow(r,hi)]; } }while(0)
  f32x16 pA0,pA1,pB0,pB1;
  int sl_prev=0,sl_cur=0,sl_next=SLOTB;
  #define ROT() do{sl_prev=sl_cur;sl_cur=sl_next;sl_next=(sl_next==(NSLOT-1)*SLOTB)?0:sl_next+SLOTB;}while(0)
  DMA_K(2,2*SLOTB);
  WAIT_BAR(3);
  qkt(pA0,pA1,Kbase,qr,negm,r32,hi);asm volatile("s_nop 15\n\ts_nop 7":"+v"(pA0),"+v"(pA1));CMASK(pA0,pA1,0);
  START(pA0,pA1);
  _Pragma("unroll") for(int r=0;r<16;++r)pA1[r]=__builtin_amdgcn_exp2f(pA1[r]);
  WAIT_BAR(0);
  DMA_K(3,0);DMA_V(1,SLOTB);
  ROT();
  kload8(kf,kp0+sl_cur);
  WAIT_BAR(2);
  s16x4 vlo[8],vhi[8]; u32x4 pw0,pw1,pw2,pw3;
  #define PKW(P,B) cvtpk_s(P[B],P[B+1])
  #define PAF(k) __builtin_bit_cast(bf16x8,pw##k)
  #define VFR(i) (bf16x8){vlo[i][0],vlo[i][1],vlo[i][2],vlo[i][3],vhi[i][0],vhi[i][1],vhi[i][2],vhi[i][3]}
  #define PIN(x) asm volatile("":"+v"(x))
  #define MX3(a,b,c) __builtin_fmaxf(__builtin_fmaxf((a),(b)),(c))
  #define GAPA(MF,A0,A1,A2,A3,W0,W1,PW) do{ MF; sacc+=A0; sacc+=A1; sacc+=A2; sacc+=A3; PIN(sacc); W0; W1; PIN(PW); SBAR(); }while(0)
  #define EX(v) __builtin_amdgcn_exp2f(v)
  #define GAPB(MF,X,B) do{ MF; X[B]=EX(X[B]); X[B+1]=EX(X[B+1]); X[B+2]=EX(X[B+2]); X[B+3]=EX(X[B+3]); PIN(X); SBAR(); }while(0)
  #define VRD(i) do{ vlo[i]=vtr(vp_+(((i)>>2)*4096+((i)&3)*1024)); vhi[i]=vtr(vp_+(((i)>>2)*4096+((i)&3)*1024+512)); }while(0)
  #define KRD(G,j) do{ if(G){ kload2(kf,kp0+sl_next,j); SBAR(); } }while(0)
  #define STEP(C0,C1,P0,P1,t,GK,GV,GL) do{ SBAR(); \
    const lds_cptr vp_=vp0+sl_prev; \
    VRD(0); SBAR(); float sacc=(P0[0]+P0[1]); \
    GAPA(C0=__builtin_amdgcn_mfma_f32_32x32x16_bf16(kf[0],qr[0],negm,0,0,0), P0[2],P0[3],P0[4],P0[5],     pw0[0]=PKW(P0,0), pw0[1]=PKW(P0,2), pw0); \
    VRD(4); SBAR(); GAPA(C1=__builtin_amdgcn_mfma_f32_32x32x16_bf16(kf[1],qr[0],negm,0,0,0), P0[6],P0[7],P0[8],P0[9],     pw0[2]=PKW(P0,4), pw0[3]=PKW(P0,6), pw0); \
    VRD(1); SBAR(); GAPA(C0=__builtin_amdgcn_mfma_f32_32x32x16_bf16(kf[2],qr[1],C0,0,0,0),   P0[10],P0[11],P0[12],P0[13], pw1[0]=PKW(P0,8), pw1[1]=PKW(P0,10), pw1); \
    VRD(5); SBAR(); GAPA(C1=__builtin_amdgcn_mfma_f32_32x32x16_bf16(kf[3],qr[1],C1,0,0,0),   P0[14],P0[15],P1[0],P1[1],   pw1[2]=PKW(P0,12),pw1[3]=PKW(P0,14), pw1); \
    VRD(2); SBAR(); GAPA(C0=__builtin_amdgcn_mfma_f32_32x32x16_bf16(kf[4],qr[2],C0,0,0,0),   P1[2],P1[3],P1[4],P1[5],     pw2[0]=PKW(P1,0), pw2[1]=PKW(P1,2), pw2); \
    VRD(6); SBAR(); GAPA(C1=__builtin_amdgcn_mfma_f32_32x32x16_bf16(kf[5],qr[2],C1,0,0,0),   P1[6],P1[7],P1[8],P1[9],     pw2[2]=PKW(P1,4), pw2[3]=PKW(P1,6), pw2); \
    VRD(3); SBAR(); GAPA(C0=__builtin_amdgcn_mfma_f32_32x32x16_bf16(kf[6],qr[3],C0,0,0,0),   P1[10],P1[11],P1[12],P1[13], pw3[0]=PKW(P1,8), pw3[1]=PKW(P1,10), pw3); \
    VRD(7); SBAR(); GAPA(C1=__builtin_amdgcn_mfma_f32_32x32x16_bf16(kf[7],qr[3],C1,0,0,0),   P1[14],P1[15],0.f,0.f,       pw3[2]=PKW(P1,12),pw3[3]=PKW(P1,14), pw3); \
    l_reg+=sacc; \
    if(GK){DMA_K((t)+3,sl_cur);} if(GV){DMA_V((t)+1,sl_next);} \
    CMASK(C0,C1,t); \
    { float a=MX3(C0[0],C0[1],C1[0]),b=MX3(C0[2],C0[3],C1[1]); a=MX3(a,C1[2],C1[3]); \
      _Pragma("unroll") for(int r=4;r<16;r+=4){a=MX3(a,C0[r],C0[r+1]);b=MX3(b,C0[r+2],C0[r+3]);a=MX3(a,C1[r],C1[r+1]);b=MX3(b,C1[r+2],C1[r+3]);} \
      float rm=__builtin_fmaxf(a,b); { auto rr=__builtin_amdgcn_permlane32_swap(__float_as_uint(rm),__float_as_uint(rm),false,false); rm=__builtin_fmaxf(__uint_as_float(rr[0]),__uint_as_float(rr[1])); } \
      resc=false; \
      if(__builtin_expect(__any(rm>(float)THRL),0)){ const float dl=__builtin_fmaxf(rm,0.f); mhat+=dl; \
        _Pragma("unroll") for(int r=0;r<16;++r){C0[r]-=dl;C1[r]-=dl;} \
        _Pragma("unroll") for(int r=0;r<16;++r)negm[r]=-mhat; asm volatile("":"+v"(negm)); \
        const float f=__builtin_amdgcn_exp2f(-dl); l_reg*=f; if(hi==0)wsf[r32]=f; resc=true; } } \
    SBAR(); \
    GAPB(o[0]=__builtin_amdgcn_mfma_f32_32x32x16_bf16(PAF(0),VFR(0),o[0],0,0,0), C0,0); \
    GAPB(o[1]=__builtin_amdgcn_mfma_f32_32x32x16_bf16(PAF(0),VFR(4),o[1],0,0,0), C0,4); \
    KRD(GL,0); GAPB(o[0]=__builtin_amdgcn_mfma_f32_32x32x16_bf16(PAF(1),VFR(1),o[0],0,0,0), C0,8); \
    KRD(GL,1); GAPB(o[1]=__builtin_amdgcn_mfma_f32_32x32x16_bf16(PAF(1),VFR(5),o[1],0,0,0), C0,12); \
    KRD(GL,2); GAPB(o[0]=__builtin_amdgcn_mfma_f32_32x32x16_bf16(PAF(2),VFR(2),o[0],0,0,0), C1,0); \
    KRD(GL,3); GAPB(o[1]=__builtin_amdgcn_mfma_f32_32x32x16_bf16(PAF(2),VFR(6),o[1],0,0,0), C1,4); \
    GAPB(o[0]=__builtin_amdgcn_mfma_f32_32x32x16_bf16(PAF(3),VFR(3),o[0],0,0,0), C1,8); \
    GAPB(o[1]=__builtin_amdgcn_mfma_f32_32x32x16_bf16(PAF(3),VFR(7),o[1],0,0,0), C1,12); \
    }while(0)
  int t=1;
  #undef CMASK
  #define CMASK(P0,P1,t) do{}while(0)
  for(;t+5<NT;t+=2){
    STEP(pB0,pB1,pA0,pA1,t,true,true,true);     WAIT_BAR(2); RESC(); ROT();
    STEP(pA0,pA1,pB0,pB1,t+1,true,true,true);   WAIT_BAR(2); RESC(); ROT();
  }
  #undef CMASK
  #define CMASK(P0,P1,t) do{}while(0)
  #define ENDW(tt) do{ if((tt)+3<NT){WAIT_BAR(2);} else if((tt)+2<NT){WAIT_BAR(1);} else {WAIT_BAR(0);} }while(0)
  for(;t+1<NT;t+=2){
    STEP(pB0,pB1,pA0,pA1,t,(t+3<NT),(t+1<NT),(t+1<NT));       ENDW(t);   RESC(); ROT();
    STEP(pA0,pA1,pB0,pB1,t+1,(t+4<NT),(t+2<NT),(t+2<NT));     ENDW(t+1); RESC(); ROT();
  }
  STEP(pB0,pB1,pA0,pA1,NT-1,false,false,false); RESC();
  { float sacc=pB0[0]+pB0[1]; _Pragma("unroll") for(int r=2;r<16;++r)sacc+=pB0[r]; _Pragma("unroll") for(int r=0;r<16;++r)sacc+=pB1[r]; l_reg+=sacc;
    pw0=(u32x4){PKW(pB0,0),PKW(pB0,2),PKW(pB0,4),PKW(pB0,6)};pw1=(u32x4){PKW(pB0,8),PKW(pB0,10),PKW(pB0,12),PKW(pB0,14)};pw2=(u32x4){PKW(pB1,0),PKW(pB1,2),PKW(pB1,4),PKW(pB1,6)};pw3=(u32x4){PKW(pB1,8),PKW(pB1,10),PKW(pB1,12),PKW(pB1,14)};
    SBAR(); pv(o,vb0+sl_cur,PAF(0),PAF(1),PAF(2),PAF(3)); }
  #undef PKW
  #undef PAF
  #undef VFR
  #undef PIN
  #undef MX3
  #undef GAPA
  #undef GAPB
  #undef EX
  #undef VRD
  #undef KRD
  #undef STEP
  #undef ENDW
  {auto rr=__builtin_amdgcn_permlane32_swap(__float_as_uint(l_reg),__float_as_uint(l_reg),false,false);l_reg=__uint_as_float(rr[0])+__uint_as_float(rr[1]);}
  if(hi==0)wsf[32+r32]=l_reg;asm volatile("s_waitcnt lgkmcnt(0)":::"memory");
  float rli[16];
  #pragma unroll
  for(int r=0;r<16;++r)rli[r]=__builtin_amdgcn_rcpf(wsf[32+crow(r,hi)]);
  bf16*Ow=O+(q0+wid*QBLK)*op+ocol;
  { bf16*stg=(bf16*)(shm+LDS_OST)+wid*2048;
    #pragma unroll
    for(int r=0;r<16;++r){const int orow=crow(r,hi);
      #pragma unroll
      for(int d0=0;d0<2;++d0)stg[orow*64+d0*32+r32]=__float2bfloat16(o[d0][r]*rli[r]);}
    asm volatile("s_waitcnt lgkmcnt(0)":::"memory");
    #pragma unroll
    for(int i=0;i<4;++i){const int row=i*8+(lane>>3),ch=lane&7; const u32x4 v=*(const u32x4*)(stg+row*64+ch*8); ATTN_STORE16(Ow+(long)row*op+ch*8,v);} }
#ifdef ATT_STATIC_PRIO
  __builtin_amdgcn_s_setprio(0);
#endif
  asm volatile("s_waitcnt lgkmcnt(0)\n\ts_barrier":::"memory");
  #undef DMA_K
  #undef DMA_V
  #undef CMASK
  #undef START
  #undef RESC
  #undef ROT
}
constexpr int ATTN_LDS_BYTES=LDS_BYTES;

#undef SBAR
#undef WAIT_BAR
}
namespace att96 {
using bf16=__hip_bfloat16;
using bf16x8=__attribute__((ext_vector_type(8)))short;
using s16x4=__attribute__((ext_vector_type(4)))short;
using f32x16=__attribute__((ext_vector_type(16)))float;
using u32x4=__attribute__((ext_vector_type(4)))unsigned;
constexpr int D=64;
constexpr int NW=8,QBLK=32,QB=QBLK*NW,KVBLK=64;

__device__ __forceinline__ int crow(int r,int hi){return (r&3)+8*(r>>2)+4*hi;}
#define SBAR() __builtin_amdgcn_sched_barrier(0)
__device__ __forceinline__ void cmask(f32x16&p0,f32x16&p1,int jb,int qrel,int hi){
  const float NEG=-INFINITY; int kb=64*jb+4*hi;
  #pragma unroll
  for(int r=0;r<16;++r){int kv=kb+(r&3)+8*(r>>2); if(kv>qrel)p0[r]=NEG; if(kv+32>qrel)p1[r]=NEG;}
}

constexpr int NSLOT=3, SLOTB=8192;
constexpr int KSLOTB=12288;
constexpr int LDS_K=0, LDS_V=NSLOT*KSLOTB, LDS_WS=LDS_V+NSLOT*SLOTB, LDS_OST=LDS_WS+NW*64*4, LDS_BYTES=LDS_OST+NW*4096;
constexpr float C2=0.125f*1.4426950408889634f;
__device__ __forceinline__ void glds16(const void*gsrc,unsigned lds_dst){unsigned keep;
  asm volatile("s_mov_b32 %0, m0\n\ts_mov_b32 m0, %2\n\ts_nop 0\n\tglobal_load_lds_dwordx4 %1, off\n\ts_mov_b32 m0, %0":"=&s"(keep):"v"(gsrc),"s"(lds_dst):"memory");}
__device__ __forceinline__ float max3f(float a,float b,float c){float r;asm("v_max3_f32 %0, %1, %2, %3":"=v"(r):"v"(a),"v"(b),"v"(c));return r;}
__device__ __forceinline__ float max2f(float a,float b){float r;asm("v_max_f32_e32 %0, %1, %2":"=v"(r):"v"(a),"v"(b));return r;}
__device__ __forceinline__ float fadd_s(float a,float b){float r;asm("v_add_f32_e32 %0, %1, %2":"=v"(r):"v"(a),"v"(b));return r;}
__device__ __forceinline__ float fsub_s(float a,float b){float r;asm("v_sub_f32_e32 %0, %1, %2":"=v"(r):"v"(a),"v"(b));return r;}
typedef float f32x2_t __attribute__((ext_vector_type(2))); typedef __bf16 bf16x2_t __attribute__((ext_vector_type(2)));
__device__ __forceinline__ unsigned cvtpk_s(float lo,float hi){f32x2_t v={lo,hi};bf16x2_t b=__builtin_convertvector(v,bf16x2_t);return __builtin_bit_cast(unsigned,b);}
#define KOFF(sl) ((sl)+((sl)>>1))
#define WAIT_BAR(N) asm volatile("s_waitcnt vmcnt(" #N ") lgkmcnt(0)\n\ts_barrier":::"memory")

__device__ __forceinline__ void qkt(f32x16&p0,f32x16&p1,const char*Kslot,const bf16x8*qr,const f32x16&negm,int r32,int hi){
  const char*kb=Kslot+hi*1024+r32*16;
  #pragma unroll
  for(int d0=0;d0<6;++d0){
    const bf16x8 b0=*reinterpret_cast<const bf16x8*>(kb+d0*2048);
    const bf16x8 b1=*reinterpret_cast<const bf16x8*>(kb+d0*2048+512);
    if(d0==0){p0=__builtin_amdgcn_mfma_f32_32x32x16_bf16(b0,qr[0],negm,0,0,0);p1=__builtin_amdgcn_mfma_f32_32x32x16_bf16(b1,qr[0],negm,0,0,0);}
    else{p0=__builtin_amdgcn_mfma_f32_32x32x16_bf16(b0,qr[d0],p0,0,0,0);p1=__builtin_amdgcn_mfma_f32_32x32x16_bf16(b1,qr[d0],p1,0,0,0);}}
}
typedef __attribute__((address_space(3))) const char* lds_cptr;
typedef short v4i16_t __attribute__((ext_vector_type(4)));
__device__ __forceinline__ void kload12(bf16x8*kf,lds_cptr kp){
  kf[0]=*(const __attribute__((address_space(3))) bf16x8*)(kp);      kf[1]=*(const __attribute__((address_space(3))) bf16x8*)(kp+512);
  kf[2]=*(const __attribute__((address_space(3))) bf16x8*)(kp+2048); kf[3]=*(const __attribute__((address_space(3))) bf16x8*)(kp+2560);
  kf[4]=*(const __attribute__((address_space(3))) bf16x8*)(kp+4096); kf[5]=*(const __attribute__((address_space(3))) bf16x8*)(kp+4608);
  kf[6]=*(const __attribute__((address_space(3))) bf16x8*)(kp+6144); kf[7]=*(const __attribute__((address_space(3))) bf16x8*)(kp+6656);
  kf[8]=*(const __attribute__((address_space(3))) bf16x8*)(kp+8192); kf[9]=*(const __attribute__((address_space(3))) bf16x8*)(kp+8704);
  kf[10]=*(const __attribute__((address_space(3))) bf16x8*)(kp+10240); kf[11]=*(const __attribute__((address_space(3))) bf16x8*)(kp+10752);
}
__device__ __forceinline__ void kload2(bf16x8*kf,lds_cptr kp,int j){ kf[2*j]=*(const __attribute__((address_space(3))) bf16x8*)(kp+j*2048); kf[2*j+1]=*(const __attribute__((address_space(3))) bf16x8*)(kp+j*2048+512); }
__device__ __forceinline__ s16x4 vtr(lds_cptr p){ return __builtin_bit_cast(s16x4,__builtin_amdgcn_ds_read_tr16_b64_v4i16((__attribute__((address_space(3))) v4i16_t*)p)); }
__device__ __forceinline__ float rowmax(const f32x16&p0,const f32x16&p1){
  float a=max3f(p0[0],p0[1],p1[0]),b=max3f(p0[2],p0[3],p1[1]);a=max3f(a,p1[2],p1[3]);
  #pragma unroll
  for(int r=4;r<16;r+=4){a=max3f(a,p0[r],p0[r+1]);b=max3f(b,p0[r+2],p0[r+3]);a=max3f(a,p1[r],p1[r+1]);b=max3f(b,p1[r+2],p1[r+3]);}
  const float m=max2f(a,b);
  auto rr=__builtin_amdgcn_permlane32_swap(__float_as_uint(m),__float_as_uint(m),false,false);
  return max2f(__uint_as_float(rr[0]),__uint_as_float(rr[1]));
}
__device__ __forceinline__ void pv(f32x16*o,int vb,bf16x8 pa0,bf16x8 pa1,bf16x8 pa2,bf16x8 pa3){
  #pragma unroll
  for(int d0=0;d0<2;++d0){s16x4 lo[4],hi[4];
    #pragma unroll
    for(int ks=0;ks<4;++ks){
      asm volatile("ds_read_b64_tr_b16 %0,%1 offset:%c2":"=&v"(lo[ks]):"v"(vb),"i"(d0*4096+ks*1024):"memory");
      asm volatile("ds_read_b64_tr_b16 %0,%1 offset:%c2":"=&v"(hi[ks]):"v"(vb),"i"(d0*4096+ks*1024+512):"memory");}
    asm volatile("s_waitcnt lgkmcnt(0)":::"memory");SBAR();
    #define PK(k) (bf16x8){lo[k][0],lo[k][1],lo[k][2],lo[k][3],hi[k][0],hi[k][1],hi[k][2],hi[k][3]}
    o[d0]=__builtin_amdgcn_mfma_f32_32x32x16_bf16(pa0,PK(0),o[d0],0,0,0);
    o[d0]=__builtin_amdgcn_mfma_f32_32x32x16_bf16(pa1,PK(1),o[d0],0,0,0);
    o[d0]=__builtin_amdgcn_mfma_f32_32x32x16_bf16(pa2,PK(2),o[d0],0,0,0);
    o[d0]=__builtin_amdgcn_mfma_f32_32x32x16_bf16(pa3,PK(3),o[d0],0,0,0);
    #undef PK
  }
}

#ifndef ATTN_STORE16
#define ATTN_STORE16(p,v) (*(u32x4*)(p)=(v))
#endif
template<int THRL> __device__ __forceinline__ void attn_unit(long q0,const bf16*Q,int qp,int qcol,const bf16*__restrict__ K,int kp,int kcol,const bf16*__restrict__ V,int vp,int vcol,long kv0,int NT,bf16*O,int op,int ocol,char*shm,const float*qgain,const float*T16){
  int tid_=threadIdx.x; asm volatile("":"+v"(tid_));
  const int tid=tid_,lane=tid&63,r32=lane&31,hi=lane>>5; const int wid=__builtin_amdgcn_readfirstlane(tid>>6);
#ifdef ATT_STATIC_PRIO
  if(wid>=4)__builtin_amdgcn_s_setprio(1);
#endif
  const bf16*Qw=Q+(q0+wid*QBLK)*qp+qcol;
  const bf16*Kh=K+kv0*kp+kcol,*Vh=V+kv0*vp+vcol;
  const unsigned lds0=(unsigned)(uintptr_t)shm;
  float*wsf=(float*)(shm+LDS_WS)+wid*64;
  const bf16*ksrc=Kh+(long)lane*kp+wid*8;
  const bf16*vsrc=Vh+(long)(16*(wid&3)+(lane>>2))*vp+(wid>>2)*32+(lane&3)*8;
  const unsigned kdst=lds0+LDS_K+wid*1024, vdst=lds0+LDS_V+wid*1024, kdst2=lds0+LDS_K+(8+wid)*1024;
  const bf16*ksrc2=Kh+(long)lane*kp+64+wid*8;
  const bool big=wid<4;
  #define DMA_K(t,slot) do{ glds16(ksrc+(long)(t)*KVBLK*kp,(unsigned)__builtin_amdgcn_readfirstlane(kdst+KOFF(slot))); if(big) glds16(ksrc2+(long)(t)*KVBLK*kp,(unsigned)__builtin_amdgcn_readfirstlane(kdst2+KOFF(slot))); }while(0)
  #define WAITKV() do{ if(big){WAIT_BAR(3);} else {WAIT_BAR(2);} }while(0)
  #define DMA_V(t,slot) glds16(vsrc+(long)(t)*KVBLK*vp,(unsigned)__builtin_amdgcn_readfirstlane(vdst+(slot)))
  const int vb0=(int)(lds0+LDS_V)+((lane>>4)&1)*32+(lane&3)*8+(4*hi+((lane&15)>>2))*64;
  const char*Kbase=shm+LDS_K; bf16x8 kf[12];
  const lds_cptr shm3=(lds_cptr)shm; const lds_cptr kp0=shm3+LDS_K+hi*1024+r32*16; const lds_cptr vp0=shm3+LDS_V+((lane>>4)&1)*32+(lane&3)*8+(4*hi+((lane&15)>>2))*64;
  DMA_K(0,0);DMA_V(0,0);DMA_K(1,SLOTB);
  bf16x8 qr[6];
  #pragma unroll
  for(int d0=0;d0<6;++d0)qr[d0]=*reinterpret_cast<const bf16x8*>(&Qw[(long)r32*qp+d0*16+hi*8]);
  {
    float f[6][8]; float ss=0.f;
    #pragma unroll
    for(int d0=0;d0<6;++d0)
      #pragma unroll
      for(int j=0;j<8;++j){ f[d0][j]=__uint_as_float(((unsigned)(unsigned short)qr[d0][j])<<16); ss+=f[d0][j]*f[d0][j]; }
    ss+=__shfl_xor(ss,32);
    const float rn=rsqrtf(ss*(1.f/96.f)+EPS)*C2_96;
    #pragma unroll
    for(int d0=0;d0<6;++d0)
      #pragma unroll
      for(int j=0;j<8;++j) f[d0][j]=f[d0][j]*rn*qgain[d0*16+hi*8+j];
    const int tq=(int)((q0+wid*QBLK+r32)%S); const int grow=tq/GW,gcol=tq%GW;
    #pragma unroll
    for(int part=0;part<2;++part){ const int pos=part?gcol:grow;
      #pragma unroll
      for(int j=0;j<8;++j){ const float cs=T16[pos*8+j],sn=T16[512+pos*8+j];
        const float mine=f[4+part][j],other=__shfl_xor(mine,32);
        f[4+part][j]=hi==0?(mine*cs-other*sn):(other*sn+mine*cs); } }
    #pragma unroll
    for(int d0=0;d0<6;++d0)
      #pragma unroll
      for(int j=0;j<4;++j){ const unsigned w=cvtpk_s(f[d0][2*j],f[d0][2*j+1]); qr[d0][2*j]=(short)(w&0xffff); qr[d0][2*j+1]=(short)(w>>16); }
  }
  float mhat=0.f,l_reg=0.f;f32x16 o[2];o[0]=f32x16{};o[1]=f32x16{};f32x16 negm=f32x16{};asm volatile("":"+v"(negm));
  #define CMASK(P0,P1,t) do{}while(0)
  bool resc=false;
  #define START(P0,P1) do{ const float rm=rowmax(P0,P1); resc=false; \
    { const float dl=rm; mhat=fadd_s(mhat,dl); \
      _Pragma("unroll") for(int r=0;r<16;++r){P0[r]=fsub_s(P0[r],dl);P1[r]=fsub_s(P1[r],dl);} \
      _Pragma("unroll") for(int r=0;r<16;++r)negm[r]=-mhat; asm volatile("":"+v"(negm)); } \
    _Pragma("unroll") for(int r=0;r<16;++r)P0[r]=__builtin_amdgcn_exp2f(P0[r]); }while(0)
  #define RESC() do{ if(resc){ asm volatile("s_waitcnt lgkmcnt(0)":::"memory"); \
      _Pragma("unroll") for(int d_=0;d_<2;++d_) _Pragma("unroll") for(int r=0;r<16;++r)o[d_][r]*=wsf[crow(r,hi)]; } }while(0)
  f32x16 pA0,pA1,pB0,pB1;
  int sl_prev=0,sl_cur=0,sl_next=SLOTB;
  #define ROT() do{sl_prev=sl_cur;sl_cur=sl_next;sl_next=(sl_next==(NSLOT-1)*SLOTB)?0:sl_next+SLOTB;}while(0)
  DMA_K(2,2*SLOTB);
  if(big){WAIT_BAR(5);}else{WAIT_BAR(3);}
  qkt(pA0,pA1,Kbase,qr,negm,r32,hi);asm volatile("s_nop 15\n\ts_nop 7":"+v"(pA0),"+v"(pA1));CMASK(pA0,pA1,0);
  START(pA0,pA1);
  _Pragma("unroll") for(int r=0;r<16;++r)pA1[r]=__builtin_amdgcn_exp2f(pA1[r]);
  WAIT_BAR(0);
  DMA_K(3,0);DMA_V(1,SLOTB);
  ROT();
  kload12(kf,kp0+KOFF(sl_cur));
  WAITKV();
  s16x4 vlo[8],vhi[8]; u32x4 pw0,pw1,pw2,pw3;
  #define PKW(P,B) cvtpk_s(P[B],P[B+1])
  #define PAF(k) __builtin_bit_cast(bf16x8,pw##k)
  #define VFR(i) (bf16x8){vlo[i][0],vlo[i][1],vlo[i][2],vlo[i][3],vhi[i][0],vhi[i][1],vhi[i][2],vhi[i][3]}
  #define PIN(x) asm volatile("":"+v"(x))
  #define MX3(a,b,c) __builtin_fmaxf(__builtin_fmaxf((a),(b)),(c))
  #define GAPA(MF,A0,A1,A2,A3,W0,W1,PW) do{ MF; sacc+=A0; sacc+=A1; sacc+=A2; sacc+=A3; PIN(sacc); W0; W1; PIN(PW); SBAR(); }while(0)
  #define EX(v) __builtin_amdgcn_exp2f(v)
  #define GAPB(MF,X,B) do{ MF; X[B]=EX(X[B]); X[B+1]=EX(X[B+1]); X[B+2]=EX(X[B+2]); X[B+3]=EX(X[B+3]); PIN(X); SBAR(); }while(0)
  #define VRD(i) do{ vlo[i]=vtr(vp_+(((i)>>2)*4096+((i)&3)*1024)); vhi[i]=vtr(vp_+(((i)>>2)*4096+((i)&3)*1024+512)); }while(0)
  #define KRD(G,j) do{ if(G){ kload2(kf,kp0+KOFF(sl_next),j); SBAR(); } }while(0)
  #define STEP(C0,C1,P0,P1,t,GK,GV,GL) do{ SBAR(); \
    const lds_cptr vp_=vp0+sl_prev; \
    VRD(0); SBAR(); float sacc=(P0[0]+P0[1]); \
    GAPA(C0=__builtin_amdgcn_mfma_f32_32x32x16_bf16(kf[0],qr[0],negm,0,0,0), P0[2],P0[3],P0[4],P0[5],     pw0[0]=PKW(P0,0), pw0[1]=PKW(P0,2), pw0); \
    VRD(4); SBAR(); GAPA(C1=__builtin_amdgcn_mfma_f32_32x32x16_bf16(kf[1],qr[0],negm,0,0,0), P0[6],P0[7],P0[8],P0[9],     pw0[2]=PKW(P0,4), pw0[3]=PKW(P0,6), pw0); \
    VRD(1); SBAR(); GAPA(C0=__builtin_amdgcn_mfma_f32_32x32x16_bf16(kf[2],qr[1],C0,0,0,0),   P0[10],P0[11],P0[12],P0[13], pw1[0]=PKW(P0,8), pw1[1]=PKW(P0,10), pw1); \
    VRD(5); SBAR(); GAPA(C1=__builtin_amdgcn_mfma_f32_32x32x16_bf16(kf[3],qr[1],C1,0,0,0),   P0[14],P0[15],P1[0],P1[1],   pw1[2]=PKW(P0,12),pw1[3]=PKW(P0,14), pw1); \
    VRD(2); SBAR(); GAPA(C0=__builtin_amdgcn_mfma_f32_32x32x16_bf16(kf[4],qr[2],C0,0,0,0),   P1[2],P1[3],P1[4],P1[5],     pw2[0]=PKW(P1,0), pw2[1]=PKW(P1,2), pw2); \
    VRD(6); SBAR(); GAPA(C1=__builtin_amdgcn_mfma_f32_32x32x16_bf16(kf[5],qr[2],C1,0,0,0),   P1[6],P1[7],P1[8],P1[9],     pw2[2]=PKW(P1,4), pw2[3]=PKW(P1,6), pw2); \
    VRD(3); SBAR(); GAPA(C0=__builtin_amdgcn_mfma_f32_32x32x16_bf16(kf[6],qr[3],C0,0,0,0),   P1[10],P1[11],P1[12],P1[13], pw3[0]=PKW(P1,8), pw3[1]=PKW(P1,10), pw3); \
    VRD(7); SBAR(); GAPA(C1=__builtin_amdgcn_mfma_f32_32x32x16_bf16(kf[7],qr[3],C1,0,0,0),   P1[14],P1[15],0.f,0.f,       pw3[2]=PKW(P1,12),pw3[3]=PKW(P1,14), pw3); \
    C0=__builtin_amdgcn_mfma_f32_32x32x16_bf16(kf[8],qr[4],C0,0,0,0); SBAR(); C1=__builtin_amdgcn_mfma_f32_32x32x16_bf16(kf[9],qr[4],C1,0,0,0); SBAR(); \
    C0=__builtin_amdgcn_mfma_f32_32x32x16_bf16(kf[10],qr[5],C0,0,0,0); SBAR(); C1=__builtin_amdgcn_mfma_f32_32x32x16_bf16(kf[11],qr[5],C1,0,0,0); SBAR(); \
    l_reg+=sacc; \
    if(GK){DMA_K((t)+3,sl_cur);} if(GV){DMA_V((t)+1,sl_next);} \
    CMASK(C0,C1,t); \
    { float a=MX3(C0[0],C0[1],C1[0]),b=MX3(C0[2],C0[3],C1[1]); a=MX3(a,C1[2],C1[3]); \
      _Pragma("unroll") for(int r=4;r<16;r+=4){a=MX3(a,C0[r],C0[r+1]);b=MX3(b,C0[r+2],C0[r+3]);a=MX3(a,C1[r],C1[r+1]);b=MX3(b,C1[r+2],C1[r+3]);} \
      float rm=__builtin_fmaxf(a,b); { auto rr=__builtin_amdgcn_permlane32_swap(__float_as_uint(rm),__float_as_uint(rm),false,false); rm=__builtin_fmaxf(__uint_as_float(rr[0]),__uint_as_float(rr[1])); } \
      resc=false; \
      if(__builtin_expect(__any(rm>(float)THRL),0)){ const float dl=__builtin_fmaxf(rm,0.f); mhat+=dl; \
        _Pragma("unroll") for(int r=0;r<16;++r){C0[r]-=dl;C1[r]-=dl;} \
        _Pragma("unroll") for(int r=0;r<16;++r)negm[r]=-mhat; asm volatile("":"+v"(negm)); \
        const float f=__builtin_amdgcn_exp2f(-dl); l_reg*=f; if(hi==0)wsf[r32]=f; resc=true; } } \
    SBAR(); \
    GAPB(o[0]=__builtin_amdgcn_mfma_f32_32x32x16_bf16(PAF(0),VFR(0),o[0],0,0,0), C0,0); \
    KRD(GL,0); GAPB(o[1]=__builtin_amdgcn_mfma_f32_32x32x16_bf16(PAF(0),VFR(4),o[1],0,0,0), C0,4); \
    KRD(GL,1); GAPB(o[0]=__builtin_amdgcn_mfma_f32_32x32x16_bf16(PAF(1),VFR(1),o[0],0,0,0), C0,8); \
    KRD(GL,2); GAPB(o[1]=__builtin_amdgcn_mfma_f32_32x32x16_bf16(PAF(1),VFR(5),o[1],0,0,0), C0,12); \
    KRD(GL,3); GAPB(o[0]=__builtin_amdgcn_mfma_f32_32x32x16_bf16(PAF(2),VFR(2),o[0],0,0,0), C1,0); \
    KRD(GL,4); GAPB(o[1]=__builtin_amdgcn_mfma_f32_32x32x16_bf16(PAF(2),VFR(6),o[1],0,0,0), C1,4); \
    KRD(GL,5); GAPB(o[0]=__builtin_amdgcn_mfma_f32_32x32x16_bf16(PAF(3),VFR(3),o[0],0,0,0), C1,8); \
    GAPB(o[1]=__builtin_amdgcn_mfma_f32_32x32x16_bf16(PAF(3),VFR(7),o[1],0,0,0), C1,12); \
    }while(0)
  int t=1;
  #undef CMASK
  #define CMASK(P0,P1,t) do{}while(0)
  for(;t+5<NT;t+=2){
    STEP(pB0,pB1,pA0,pA1,t,true,true,true);     WAITKV(); RESC(); ROT();
    STEP(pA0,pA1,pB0,pB1,t+1,true,true,true);   WAITKV(); RESC(); ROT();
  }
  #undef CMASK
  #define CMASK(P0,P1,t) do{}while(0)
  #define ENDW(tt) do{ if((tt)+3<NT){WAITKV();} else if((tt)+2<NT){WAIT_BAR(1);} else {WAIT_BAR(0);} }while(0)
  for(;t+1<NT;t+=2){
    STEP(pB0,pB1,pA0,pA1,t,(t+3<NT),(t+1<NT),(t+1<NT));       ENDW(t);   RESC(); ROT();
    STEP(pA0,pA1,pB0,pB1,t+1,(t+4<NT),(t+2<NT),(t+2<NT));     ENDW(t+1); RESC(); ROT();
  }
  STEP(pB0,pB1,pA0,pA1,NT-1,false,false,false); RESC();
  { float sacc=pB0[0]+pB0[1]; _Pragma("unroll") for(int r=2;r<16;++r)sacc+=pB0[r]; _Pragma("unroll") for(int r=0;r<16;++r)sacc+=pB1[r]; l_reg+=sacc;
    pw0=(u32x4){PKW(pB0,0),PKW(pB0,2),PKW(pB0,4),PKW(pB0,6)};pw1=(u32x4){PKW(pB0,8),PKW(pB0,10),PKW(pB0,12),PKW(pB0,14)};pw2=(u32x4){PKW(pB1,0),PKW(pB1,2),PKW(pB1,4),PKW(pB1,6)};pw3=(u32x4){PKW(pB1,8),PKW(pB1,10),PKW(pB1,12),PKW(pB1,14)};
    SBAR(); pv(o,vb0+sl_cur,PAF(0),PAF(1),PAF(2),PAF(3)); }
  #undef PKW
  #undef PAF
  #undef VFR
  #undef PIN
  #undef MX3
  #undef GAPA
  #undef GAPB
  #undef EX
  #undef VRD
  #undef KRD
  #undef STEP
  #undef ENDW
  {auto rr=__builtin_amdgcn_permlane32_swap(__float_as_uint(l_reg),__float_as_uint(l_reg),false,false);l_reg=__uint_as_float(rr[0])+__uint_as_float(rr[1]);}
  if(hi==0)wsf[32+r32]=l_reg;asm volatile("s_waitcnt lgkmcnt(0)":::"memory");
  float rli[16];
  #pragma unroll
  for(int r=0;r<16;++r)rli[r]=__builtin_amdgcn_rcpf(wsf[32+crow(r,hi)]);
  bf16*Ow=O+(q0+wid*QBLK)*op+ocol;
  { bf16*stg=(bf16*)(shm+LDS_OST)+wid*2048;
    #pragma unroll
    for(int r=0;r<16;++r){const int orow=crow(r,hi);
      #pragma unroll
      for(int d0=0;d0<2;++d0)stg[orow*64+d0*32+r32]=__float2bfloat16(o[d0][r]*rli[r]);}
    asm volatile("s_waitcnt lgkmcnt(0)":::"memory");
    #pragma unroll
    for(int i=0;i<4;++i){const int row=i*8+(lane>>3),ch=lane&7; const u32x4 v=*(const u32x4*)(stg+row*64+ch*8); ATTN_STORE16(Ow+(long)row*op+ch*8,v);} }
#ifdef ATT_STATIC_PRIO
  __builtin_amdgcn_s_setprio(0);
#endif
  asm volatile("s_waitcnt lgkmcnt(0)\n\ts_barrier":::"memory");
  #undef DMA_K
  #undef WAITKV
  #undef DMA_V
  #undef CMASK
  #undef START
  #undef RESC
  #undef ROT
}
constexpr int ATTN_LDS_BYTES=LDS_BYTES;

#undef SBAR
#undef WAIT_BAR
#undef KOFF
}
#define LAS __attribute__((address_space(3)))
#define XB_TMO      128
#define XB_XCNT(j)  (256  + 64 * (j))
#define XB_XSUB(j)  (1280 + 64 * (j))
#define XB_XGEN(j)  (2304 + 64 * (j))
#define XB_TOP      3328
#define XB_TOPGEN   3392
#define XCD_BAR_WORDS 3456
#define XB_CTXH     3520
#define XB_SPIN_CAP (1u << 18)

__device__ __forceinline__ unsigned xb_ld(unsigned* p)              { return __hip_atomic_load(p, __ATOMIC_RELAXED, __HIP_MEMORY_SCOPE_AGENT); }
__device__ __forceinline__ unsigned xb_add(unsigned* p, unsigned v) { return __hip_atomic_fetch_add(p, v, __ATOMIC_RELAXED, __HIP_MEMORY_SCOPE_AGENT); }
__device__ __forceinline__ unsigned xb_xcc_id() { return (unsigned)__builtin_amdgcn_s_getreg((3 << 11) | 20) & 0xFu; }
#define XB_SPIN(cond, bar) do { unsigned _sp = 0; while (cond) { __builtin_amdgcn_s_sleep(1); \
    if ((++_sp & 255u) == 0u) { if (xb_ld(&(bar)[XB_TMO])) break; if (_sp > XB_SPIN_CAP) { atomicAdd(&(bar)[XB_TMO], 1u); break; } } } } while (0)

struct XcdBarrier {
    unsigned* bar; unsigned x;
    volatile LAS unsigned* st;
};

__device__ __forceinline__ XcdBarrier xcd_barrier_post(unsigned* bar, volatile LAS unsigned* st) {
    XcdBarrier b; b.bar = bar; b.x = xb_xcc_id(); b.st = st;
    if (threadIdx.x == 0) (void)xb_add(&bar[XB_XCNT(b.x)], 1u);
    return b;
}
__device__ __forceinline__ void xcd_barrier_complete(unsigned* bar, unsigned x, unsigned& nloc, unsigned& nx) {
    const unsigned G = gridDim.x * gridDim.y * gridDim.z;
    unsigned sum, cnt, mine, sp = 0u;
    for (;;) {
        sum = 0u; cnt = 0u; mine = 0u;
#pragma unroll
        for (unsigned j = 0; j < 16; ++j) { const unsigned c = xb_ld(&bar[XB_XCNT(j)]); sum += c; cnt += (c > 0u) ? 1u : 0u; mine = (j == x) ? c : mine; }
        if (sum == G) break;
        __builtin_amdgcn_s_sleep(1);
        if ((++sp & 255u) == 0u) { if (xb_ld(&bar[XB_TMO])) break; if (sp > XB_SPIN_CAP) { atomicAdd(&bar[XB_TMO], 1u); break; } }
    }
    nloc = mine > 0u ? mine : 1u; nx = cnt > 0u ? cnt : 1u;
}

__device__ __forceinline__ void xcd_barrier(const XcdBarrier& b) {
    asm volatile("s_waitcnt vmcnt(0)" ::: "memory");
    __syncthreads();
    if (threadIdx.x == 0) {
        unsigned* bar = b.bar;
        __builtin_amdgcn_s_waitcnt(0);
        unsigned nloc = b.st[0], nx = b.st[1];
        if (nloc == 0u) { xcd_barrier_complete(bar, b.x, nloc, nx); b.st[0] = nloc; b.st[1] = nx; }
        const unsigned old = xb_add(&bar[XB_XSUB(b.x)], 1u);
        const unsigned gen = old / nloc;
        if (old + 1u == (gen + 1u) * nloc) {
            __builtin_amdgcn_fence(__ATOMIC_RELEASE, "agent");
            asm volatile("s_waitcnt vmcnt(0)" ::: "memory");
            const unsigned og = xb_add(&bar[XB_TOP], 1u);
            const unsigned tg = og / nx;
            if (og + 1u == (tg + 1u) * nx) xb_add(&bar[XB_TOPGEN], 1u);
            else XB_SPIN(xb_ld(&bar[XB_TOPGEN]) == tg, bar);
            __builtin_amdgcn_fence(__ATOMIC_ACQUIRE, "agent");
            xb_add(&bar[XB_XGEN(b.x)], 1u);
            asm volatile("s_waitcnt vmcnt(0)" ::: "memory");
        } else {
            XB_SPIN(xb_ld(&bar[XB_XGEN(b.x)]) == gen, bar);
            __builtin_amdgcn_fence(__ATOMIC_ACQUIRE, "agent");
            asm volatile("s_waitcnt vmcnt(0)" ::: "memory");
        }
    }
    __syncthreads();
}
namespace mk {
#ifndef KVROT
#define KVROT 0
#endif
#ifndef ALIGN2
#define ALIGN2 true
#endif
#ifndef ALIGN1
#define ALIGN1 true
#endif
#define MLAS __attribute__((address_space(3)))
constexpr int NWAVES = 8, NTHR = 512;
constexpr int RING_BYTES = 131072;
constexpr int LDS_BYTES = 147456;
constexpr int NPHASE = 16;
typedef unsigned v4u __attribute__((ext_vector_type(4)));
typedef float f32x4 __attribute__((ext_vector_type(4)));

struct Ctx {
    Params p; MLAS unsigned char* lds; char* lds_g; int wave, G, vcu, bid;
};
__device__ __forceinline__ int tid_now() { int t = threadIdx.x; asm volatile("" : "+v"(t)); return t; }
__device__ __forceinline__ unsigned pk2(float lo, float hi) { return (unsigned)f2bf(lo) | ((unsigned)f2bf(hi) << 16); }

enum { W_IN0 = 0, W_OUT0, W_GU0, W_D0, W_IN1, W_UQ, W_UKV, W_OUT1, W_GU1, W_D1, NWMAT };
struct SrcBlk { const float* W; int ld; int col; const float* kscale; };
__device__ __forceinline__ SrcBlk src_of(const Params& p, int mat, int nb) {
    SrcBlk s; s.kscale = nullptr; const int pn = nb >> 3, q = nb & 7, bj = q >> 2, wc = q & 3;
    switch (mat) {
    case W_IN0: s.W = p.in[I0_WIN]; s.ld = L0_IN; s.col = 256 * pn + 64 * wc + 32 * bj; break;
    case W_OUT0: s.W = p.in[I0_WOUT]; s.ld = D; s.col = 32 * nb; break;
    case W_GU0: s.W = bj ? p.in[I0_WU] : p.in[I0_WG]; s.ld = FF; s.col = 128 * pn + 32 * wc; break;
    case W_D0: s.W = p.in[I0_WD]; s.ld = D; s.col = 32 * nb; break;
    case W_IN1: s.W = p.in[I1_WIN]; s.ld = L1_IN;
        if (pn == 0) s.col = 128 * bj + 32 * wc;
        else if (pn == 1) { if (bj == 0) s.col = 256 + 32 * wc; else s.col = 640; }
        else if (pn == 2) s.col = 384 + 128 * bj + 32 * wc;
        else if (pn < 5) s.col = 672 + (pn - 3) * 256 + 64 * wc + 32 * bj;
        else if (pn < 7) s.col = 1184 + (pn - 5) * 256 + 64 * wc + 32 * bj;
        else s.col = 1696 + (pn - 7) * 256 + 64 * wc + 32 * bj;
        break;
    case W_UQ: s.W = p.in[I1_WUQ]; s.ld = 768; s.col = 32 * nb; s.kscale = p.in[I1_QAG]; break;
    case W_UKV: s.W = p.in[I1_WUKV]; s.ld = 1024; s.col = (2 * pn + (wc >> 1)) * 128 + (wc & 1) * 64 + 32 * bj; s.kscale = p.in[I1_KVAG]; break;
    case W_OUT1: s.W = p.in[I1_WOUT]; s.ld = D; s.col = 32 * nb; break;
    case W_GU1: s.W = bj ? p.in[I1_WU] : p.in[I1_WG]; s.ld = FF; s.col = 128 * pn + 32 * wc; break;
    default: s.W = p.in[I1_WD]; s.ld = D; s.col = 32 * nb; break;
    }
    return s;
}
struct WMat { size_t ws_off; int K, N; };
__host__ __device__ constexpr WMat wmat(int mat) {
    switch (mat) {
    case W_IN0: return {WS_W_IN0, D, 1536}; case W_OUT0: return {WS_W_OUT0, D, D}; case W_GU0: return {WS_W_GU0, D, 2 * FF}; case W_D0: return {WS_W_D0, FF, D};
    case W_IN1: return {WS_W_IN1, D, L1_INP}; case W_UQ: return {WS_W_UQ, 384, 768}; case W_UKV: return {WS_W_UKV, 256, 1024}; case W_OUT1: return {WS_W_OUT1, D, D};
    case W_GU1: return {WS_W_GU1, D, 2 * FF}; default: return {WS_W_D1, FF, D};
    }
}
template <int mat> __device__ __forceinline__ void transpose_item(const Params& p, int item, MLAS float* scr, int lane) {
    const WMat wm = wmat(mat); const int nblk = wm.N / 32, kb = item / nblk, nb = item % nblk, k0 = 64 * kb;
    const SrcBlk s = src_of(p, mat, nb);
    bf16_t* WT = (bf16_t*)(p.ws + wm.ws_off);
    const int c = lane & 7;
    if (s.W == nullptr) {
#pragma unroll
        for (int j = 0; j < 4; ++j) { const int n = (lane >> 3) + 8 * j; *(v4u*)(WT + (size_t)(32 * nb + n) * wm.K + k0 + 8 * c) = (v4u){0u, 0u, 0u, 0u}; }
        return;
    }
    MLAS float* t0 = scr; MLAS float* t1 = scr + 64 * 33;
    if (mat == W_OUT0 && kb < 4) return;
    constexpr bool fused_pool = false;
    { const int c4 = (lane & 7) * 4, kr = lane >> 3;
        const float* wsrc = s.W + (size_t)(k0 + kr) * s.ld + s.col + c4;
        f32x4 v[8];
#pragma unroll
        for (int i = 0; i < 8; ++i) v[i] = *(const f32x4*)(wsrc + (size_t)(8 * i) * s.ld);
#pragma unroll
        for (int i = 0; i < 8; ++i) { const int kk = kr + 8 * i; float sc = 1.f;
            if (s.kscale) sc = s.kscale[k0 + kk];
            if (fused_pool) sc *= p.in[I0_POOLS][k0 + kk];
            MLAS float* d = t0 + kk * 33 + c4; d[0] = v[i][0] * sc; d[1] = v[i][1] * sc; d[2] = v[i][2] * sc; d[3] = v[i][3] * sc; } }
    asm volatile("s_waitcnt lgkmcnt(0)" ::: "memory");
    MLAS float* src = t0;
    if (fused_pool) {
        const float* pw = p.in[I0_POOLW] + kb * 4096; const int nn = lane & 31, ch = lane >> 5;
        for (int cc = ch; cc < 64; cc += 2) { float a = 0.f;
#pragma unroll 8
            for (int d = 0; d < 64; ++d) a += pw[cc * 64 + d] * t0[d * 33 + nn];
            t1[cc * 33 + nn] = a; }
        asm volatile("s_waitcnt lgkmcnt(0)" ::: "memory");
        src = t1;
    }
#pragma unroll
    for (int j = 0; j < 4; ++j) { const int n = (lane >> 3) + 8 * j; const MLAS float* sp = src + (8 * c) * 33 + n;
        v4u o; o.x = pk2(sp[0 * 33], sp[1 * 33]); o.y = pk2(sp[2 * 33], sp[3 * 33]); o.z = pk2(sp[4 * 33], sp[5 * 33]); o.w = pk2(sp[6 * 33], sp[7 * 33]);
        *(v4u*)(WT + (size_t)(32 * nb + n) * wm.K + k0 + 8 * c) = o; }
    asm volatile("s_waitcnt lgkmcnt(0)" ::: "memory");
}

#ifndef P0MASK
#define P0MASK 15
#endif
template <int PART> __device__ __forceinline__ void phase_prologue(Ctx& C, int vcu, int G) {
    const Params& p = C.p; const int tid = tid_now(), lane = tid & 63;
    MLAS float* sil = (MLAS float*)C.lds;
    MLAS float* red = (MLAS float*)(C.lds + 9 * 1024 * 4);
    __syncthreads();
#ifdef ADA_SPLIT
    if (PART <= 2)
#else
    if (PART < 2)
#endif
    for (int i = tid; i < 9 * D; i += NTHR) { const int j = i / D, k = i % D; const float c = (j < 8) ? p.in[I_C][j * D + k] : p.in[I_CCTX][k]; sil[i] = c / (1.f + expf(-c)); }
    __syncthreads();
    float* MOD = (float*)(p.ws + WS_MOD);
#ifdef ADA_SPLIT
    constexpr int ADA_N = (PART == 0) ? 32 : (PART == 2) ? 64 : 96, ADA_BASE = (PART == 0) ? 0 : (PART == 2) ? 32 : 96;
    if ((P0MASK & 1) && PART <= 2)
    for (int it0 = vcu; it0 < ADA_N; it0 += G) { const int it = it0 + ADA_BASE;
#else
    if ((P0MASK & 1) && PART < 2)
    for (int it0 = vcu; it0 < 96; it0 += G) { const int it = it0 + 96 * PART;
#endif
        const int l = it / 96, r_ = it % 96, cg_ = r_ >> 2, kq = r_ & 3, n0 = cg_ * 256;
        const float* w = (l ? p.in[I1_ADAW] : p.in[I0_ADAW]) + (size_t)(kq * 256 + C.wave * 32) * 6144 + n0 + 4 * lane;
        f32x4 acc[9];
#pragma unroll
        for (int j = 0; j < 9; ++j) acc[j] = (f32x4){0.f, 0.f, 0.f, 0.f};
#pragma unroll 8
        for (int k = 0; k < 32; ++k) { const f32x4 wv = *(const f32x4*)(w + (size_t)k * 6144); const int kk = kq * 256 + C.wave * 32 + k;
#pragma unroll
            for (int j = 0; j < 9; ++j) acc[j] += wv * sil[j * D + kk]; }
#pragma unroll
        for (int j = 0; j < 9; ++j) *(MLAS f32x4*)(red + (C.wave * 9 + j) * 256 + 4 * lane) = acc[j];
        __syncthreads();
        for (int i = tid; i < 9 * 256; i += NTHR) { const int j = i >> 8, c = i & 255; float sm_ = 0.f;
#pragma unroll
            for (int wv = 0; wv < 8; ++wv) sm_ += red[(wv * 9 + j) * 256 + c];
            if (kq == 0) sm_ += (l ? p.in[I1_ADAB] : p.in[I0_ADAB])[n0 + c];
            atomicAdd(MOD + (size_t)(l * 9 + j) * 6144 + n0 + c, sm_); }
        __syncthreads();
    }
    __syncthreads();
    {
        MLAS float* PA = (MLAS float*)C.lds;
        MLAS float* PB = (MLAS float*)(C.lds + 64 * 65 * 4);
        bf16_t* WT = (bf16_t*)(p.ws + WS_W_OUT0);
#ifdef L0_SPLIT
        constexpr int POOL_PART = 2;
#else
        constexpr int POOL_PART = 0;
#endif
        if (PART == POOL_PART) for (int tile = vcu; tile < 128; tile += G) {
            const int g = tile >> 5, nb = tile & 31;
            for (int i = tid; i < 4096; i += NTHR) PA[(i >> 6) * 65 + (i & 63)] = p.in[I0_POOLW][g * 4096 + i];
            for (int i = tid; i < 2048; i += NTHR) { const int d = i >> 5, nn = i & 31; PB[d * 33 + nn] = p.in[I0_WOUT][(size_t)(g * 64 + d) * D + 32 * nb + nn] * p.in[I0_POOLS][g * 64 + d]; }
            __syncthreads();
            { const int c = tid >> 3, n4 = (tid & 7) * 4; float a0 = 0.f, a1 = 0.f, a2 = 0.f, a3 = 0.f;
#pragma unroll 8
                for (int d = 0; d < 64; ++d) { const float pa = PA[c * 65 + d]; const MLAS float* b = PB + d * 33 + n4; a0 += pa * b[0]; a1 += pa * b[1]; a2 += pa * b[2]; a3 += pa * b[3]; }
                bf16_t* o = WT + (size_t)(32 * nb + n4) * D + g * 64 + c;
                o[0] = f2bf(a0); o[D] = f2bf(a1); o[2 * D] = f2bf(a2); o[3 * D] = f2bf(a3); }
            __syncthreads();
        }
    }
    const int gw = vcu * NWAVES + C.wave, NGW = G * NWAVES;
    MLAS float* scr = (MLAS float*)(C.lds + C.wave * 16896);
    if (P0MASK & 2) {
        int rot = 0;
#define TR_MAT(M) { constexpr int ni = (wmat(M).K / 64) * (wmat(M).N / 32); int first = gw - rot; if (first < 0) first += NGW; \
            for (int it = first; it < ni; it += NGW) transpose_item<M>(p, it, scr, lane); rot = (rot + ni) % NGW; }
        if (PART == 0) { TR_MAT(W_IN0)
#ifndef L0_SPLIT
            TR_MAT(W_OUT0) TR_MAT(W_GU0) TR_MAT(W_D0)
#endif
        }
        else if (PART == 2) { TR_MAT(W_OUT0) TR_MAT(W_GU0)
#if !defined(D0_IN_P6) && !defined(CTXD_IN_P6)
            TR_MAT(W_D0)
#endif
        }
        else if (PART == 3) { TR_MAT(W_D0) }
        else if (PART == 1) { TR_MAT(W_IN1) TR_MAT(W_UQ) TR_MAT(W_UKV)
#ifndef CTXD_IN_P6
            TR_MAT(W_OUT1) TR_MAT(W_GU1) TR_MAT(W_D1)
#endif
        }
        else if (PART == 4) { TR_MAT(W_OUT1) TR_MAT(W_GU1) TR_MAT(W_D1) }
#undef TR_MAT
    }
    if (PART == 0 && (P0MASK & 4) && C.bid == C.G - 1) {
        float* T32 = (float*)(p.ws + WS_ROPE32); float* T16 = (float*)(p.ws + WS_ROPE16);
        for (int i = tid; i < 1024; i += NTHR) { const int pos = i >> 4, f = i & 15; const float ang = (float)pos * powf(10000.0f, -((float)f * 2.0f) / 32.0f); T32[i] = cosf(ang); T32[1024 + i] = sinf(ang); }
        for (int i = tid; i < 512; i += NTHR) { const int pos = i >> 3, f = i & 7; const float ang = (float)pos * powf(10000.0f, -((float)f * 2.0f) / 16.0f); T16[i] = cosf(ang); T16[512 + i] = sinf(ang); }
    }
    if (PART == 0 && (P0MASK & 8)) { float* SSQ = (float*)(p.ws + WS_SSQ); float* SSKV = (float*)(p.ws + WS_SSKV);
        for (int i = C.bid * NTHR + tid; i < MT; i += C.G * NTHR) { SSQ[i] = 0.f; SSKV[i] = 0.f; } }
}

__device__ __forceinline__ void phase_norm(Ctx& C, const float* xl, const float* xc, const float* gain, int layer, int sh_chunk, int sc_chunk, int nrows, const float* slab = nullptr, int nslab = 0, float* xc_wb = nullptr) {
    const int lane = tid_now() & 63;
    const int gw = C.vcu * NWAVES + C.wave, NGW = C.G * NWAVES;
    bf16_t* XN = (bf16_t*)(C.p.ws + WS_XN); const float* MODb = (const float*)(C.p.ws + WS_MOD) + (size_t)layer * 9 * 6144;
    for (int m = gw; m < nrows; m += NGW) {
        const float* xr = m < ML ? xl + (size_t)m * D : xc + (size_t)(m - ML) * D;
        const float* mod = MODb + (size_t)modidx_of(m) * 6144;
        f32x4 v[4]; float ss = 0.f;
#pragma unroll
        for (int j = 0; j < 4; ++j) { v[j] = *(const f32x4*)(xr + 4 * lane + 256 * j);
            if (m >= ML && nslab > 0) { for (int s_ = 0; s_ < nslab; ++s_) v[j] += *(const f32x4*)(slab + (size_t)s_ * MC * D + (size_t)(m - ML) * D + 4 * lane + 256 * j);
                if (xc_wb) *(f32x4*)(xc_wb + (size_t)(m - ML) * D + 4 * lane + 256 * j) = v[j]; }
            ss += (v[j][0] * v[j][0] + v[j][1] * v[j][1]) + (v[j][2] * v[j][2] + v[j][3] * v[j][3]); }
        ss = wave_sum(ss);
        const float r = rsqrtf(ss * (1.f / D) + EPS);
#pragma unroll
        for (int j = 0; j < 4; ++j) { const int c = 4 * lane + 256 * j;
            const f32x4 g = *(const f32x4*)(gain + c), sc = *(const f32x4*)(mod + sc_chunk * D + c), sh = *(const f32x4*)(mod + sh_chunk * D + c);
            const f32x4 y = ((v[j] * r) * g) * (sc + 1.f) + sh;
            uint2 o; o.x = pk2(y[0], y[1]); o.y = pk2(y[2], y[3]);
            *(uint2*)(XN + (size_t)m * D + c) = o; }
    }
}

__device__ __forceinline__ void phase_pool(Ctx& C) {
    const bf16_t* A0 = (const bf16_t*)(C.p.ws + WS_A0); bf16_t* MIX = (bf16_t*)(C.p.ws + WS_MIX);
    const int skip = (C.G > 128) ? 96 : 0;
    if (C.vcu < skip) return;
    const int gt = (C.vcu - skip) * NTHR + tid_now(), NGT = (C.G - skip) * NTHR;
    for (int it = gt; it < MT * 32; it += NGT) {
        const int m = it >> 5, c8 = (it & 31) * 8, g = c8 >> 6, w = 2 << g;
        int t, T; if (m < ML) { t = m % S; T = S; } else { t = (m - ML) % CTX; T = CTX; }
        const int base = m - t; int lo = t - w / 2; if (lo < 0) lo = 0; int hi = t - w / 2 + w; if (hi > T) hi = T;
        float s[8];
#pragma unroll
        for (int e = 0; e < 8; ++e) s[e] = 0.f;
        for (int j = lo; j < hi; ++j) { const v4u q = *(const v4u*)(A0 + (size_t)(base + j) * 256 + c8);
#pragma unroll
            for (int e = 0; e < 4; ++e) { s[2 * e] += __uint_as_float(q[e] << 16); s[2 * e + 1] += __uint_as_float(q[e] & 0xffff0000u); } }
        const v4u q = *(const v4u*)(A0 + (size_t)m * 256 + c8); const float inv = 1.f / (float)(hi - lo);
        v4u o;
#pragma unroll
        for (int e = 0; e < 4; ++e) o[e] = pk2(s[2 * e] * inv - __uint_as_float(q[e] << 16), s[2 * e + 1] * inv - __uint_as_float(q[e] & 0xffff0000u));
        *(v4u*)(MIX + (size_t)m * D + c8) = o;
    }
}


__device__ __forceinline__ void phase_natable(Ctx& C, int vcu, int Gn) {
    bf16_t* G = (bf16_t*)(C.p.ws + WS_NAG); const float* rpb = C.p.in[I1_RPB];
    const int gt = vcu * NTHR + tid_now(), NGT = Gn * NTHR;
    for (int it = gt; it < 8 * 16 * 2 * 64 * 32; it += NGT) {
        const int j = it & 31, kc = (it >> 5) & 63, half = (it >> 11) & 1, dr = (it >> 12) & 15, h = it >> 16;
        const int qc = 32 * half + j, cs = min(max(qc - 8, 0), 48);
        float v = -30000.f;
        if (dr < 15 && (unsigned)(kc - cs) < 16u) v = rpb[(h * 15 + dr) * 31 + (kc - qc + 15)] * LOG2E;
        G[it] = f2bf(v);
    }
}

__device__ __forceinline__ void phase_attn0(Ctx& C) {
    const Params& p = C.p;
    MLAS char* shm = (MLAS char*)C.lds;
    att::UnitDesc U; U.Q = (const bf16_t*)(p.ws + WS_Q0); U.qpitch = 768; U.K = (const bf16_t*)(p.ws + WS_K0); U.kpitch = 256; U.V = (const bf16_t*)(p.ws + WS_V0); U.vpitch = 256;
    U.O = (bf16_t*)(p.ws + WS_MIX); U.opitch = D; U.rg = 0; U.rmin = 0; U.head = 0; U.G = nullptr;
    for (int u = C.vcu; u < 768 + 96; u += C.G) {
        if (u < 768) { const int qb = u & 7, bh = u >> 3, h = bh % 12, b = bh / 12;
            U.q0 = (long)b * S + 256 * qb; U.qcol = h * 64; U.kcol = (h / 3) * 64; U.vcol = (h / 3) * 64; U.ocol = 256 + h * 64; U.kv0 = b * SK; U.nt = SK / 64; }
        else { const int bh = u - 768, h = bh % 12, b = bh / 12;
            U.q0 = (long)ML + 256 * b; U.qcol = h * 64; U.kcol = (h / 3) * 64; U.vcol = (h / 3) * 64; U.ocol = 256 + h * 64; U.kv0 = b * SK; U.nt = CTX / 64; }
#ifdef USE_ATT64
        att64::attn_unit<8>(U.q0, (const att64::bf16*)U.Q, U.qpitch, U.qcol, (const att64::bf16*)U.K, U.kpitch, U.kcol, (const att64::bf16*)U.V, U.vpitch, U.vcol, (long)U.kv0, U.nt, (att64::bf16*)U.O, U.opitch, U.ocol, C.lds_g);
#else
        att::attn_unit<64, false, false>(U, shm, nullptr, nullptr, nullptr);
#endif
    }
    phase_pool(C);
}
__device__ __forceinline__ void phase_attn1(Ctx& C) {
    const Params& p = C.p;
    MLAS char* shm = (MLAS char*)C.lds;
    const float* T16 = (const float*)(p.ws + WS_ROPE16);
    att::UnitDesc U; U.O = (bf16_t*)(p.ws + WS_MIX); U.opitch = D; U.G = (const bf16_t*)(p.ws + WS_NAG);
    for (int u = C.vcu; u < 1024; u += C.G) {
        const int uu = u & 511, qb = uu & 7, h = (uu >> 3) & 7, b = uu >> 6;
        U.q0 = (long)b * S + 256 * qb; U.kv0 = b * SK; U.head = h;
        if (u < 512) {
            U.Q = (const bf16_t*)(p.ws + WS_MQ); U.qpitch = 768; U.qcol = h * 96; U.K = (const bf16_t*)(p.ws + WS_MK); U.kpitch = 768; U.kcol = h * 96;
            U.V = (const bf16_t*)(p.ws + WS_MV); U.vpitch = 512; U.vcol = h * 64; U.ocol = h * 64; U.nt = SK / 64; U.rg = 0; U.rmin = 0;
#ifdef USE_ATT96
            att96::attn_unit<8>(U.q0, (const att96::bf16*)U.Q, U.qpitch, U.qcol, (const att96::bf16*)U.K, U.kpitch, U.kcol, (const att96::bf16*)U.V, U.vpitch, U.vcol, (long)U.kv0, U.nt, (att96::bf16*)U.O, U.opitch, U.ocol, C.lds_g, p.in[I1_MQG], T16);
#ifdef DUP_MLA
            att96::attn_unit<8>(U.q0, (const att96::bf16*)U.Q, U.qpitch, U.qcol, (const att96::bf16*)U.K, U.kpitch, U.kcol, (const att96::bf16*)U.V, U.vpitch, U.vcol, (long)U.kv0, U.nt, (att96::bf16*)U.O, U.opitch, U.ocol, C.lds_g, p.in[I1_MQG], T16);
#endif
#else
            att::attn_unit<96, false, true>(U, shm, p.in[I1_MQG], T16, nullptr);
#ifdef DUP_MLA
            att::attn_unit<96, false, true>(U, shm, p.in[I1_MQG], T16, nullptr);
#endif
#endif
        } else {
            U.Q = (const bf16_t*)(p.ws + WS_NQ); U.qpitch = 512; U.qcol = h * 64; U.K = (const bf16_t*)(p.ws + WS_NK); U.kpitch = 512; U.kcol = h * 64;
            U.V = (const bf16_t*)(p.ws + WS_NV); U.vpitch = 512; U.vcol = h * 64; U.ocol = 512 + h * 64; U.rg = qb;
            const int rmin = min(max(4 * qb - 4, 0), 24), rmax = min(max(4 * qb + 3 - 4, 0), 24) + 7;
            U.rmin = rmin; U.nt = 4 + (rmax - rmin + 1);
#ifdef USE_ATTNA
            attna::attn_unit<8>(U.q0, (const attna::bf16*)U.Q, U.qpitch, U.qcol, (const attna::bf16*)U.K, U.kpitch, U.kcol, (const attna::bf16*)U.V, U.vpitch, U.vcol, (long)U.kv0, (U.nt + 1) & ~1, (attna::bf16*)U.O, U.opitch, U.ocol, C.lds_g, U.rmin, U.rg, p.in[I1_RPB] + h * 465);
#ifdef DUP_NA
            attna::attn_unit<8>(U.q0, (const attna::bf16*)U.Q, U.qpitch, U.qcol, (const attna::bf16*)U.K, U.kpitch, U.kcol, (const attna::bf16*)U.V, U.vpitch, U.vcol, (long)U.kv0, (U.nt + 1) & ~1, (attna::bf16*)U.O, U.opitch, U.ocol, C.lds_g, U.rmin, U.rg, p.in[I1_RPB] + h * 465);
#endif
#else
            att::attn_unit<64, true, false>(U, shm, nullptr, nullptr, p.in[I1_RPB]);
#ifdef DUP_NA
            att::attn_unit<64, true, false>(U, shm, nullptr, nullptr, p.in[I1_RPB]);
#endif
#endif
        }
    }
}

__global__ void __launch_bounds__(NTHR, 2) mega(Params p, int ph_lo, int ph_hi) {
    extern __shared__ __attribute__((aligned(16))) unsigned char lds_raw[];
    cg::grid_group grid = cg::this_grid();
    Ctx C; C.p = p; C.lds = (MLAS unsigned char*)lds_raw; C.lds_g = (char*)lds_raw; C.wave = __builtin_amdgcn_readfirstlane((int)threadIdx.x >> 6);
    C.G = gridDim.x; C.bid = blockIdx.x; C.vcu = (C.G % 8 == 0) ? (C.bid % 8) * (C.G / 8) + C.bid / 8 : C.bid;
    volatile LAS unsigned* bst = (volatile LAS unsigned*)(C.lds + LDS_BYTES - 64);
    if (threadIdx.x < 2) bst[threadIdx.x] = 0u;
    __syncthreads();
    unsigned* barw = (unsigned*)(p.ws + WS_BARRIER);
    XcdBarrier bar; bar.bar = barw; bar.x = 0; bar.st = nullptr;
    if (ph_hi - ph_lo > 1) bar = xcd_barrier_post(barw, bst);
    float* out = p.out; float* xrc = (float*)(p.ws + WS_XRC);
    const float* MOD = (const float*)(p.ws + WS_MOD);
    bf16_t* XN = (bf16_t*)(p.ws + WS_XN); bf16_t* MIX = (bf16_t*)(p.ws + WS_MIX); bf16_t* H = (bf16_t*)(p.ws + WS_H);
    const float* T32 = (const float*)(p.ws + WS_ROPE32); const float* T16 = (const float*)(p.ws + WS_ROPE16);
#define WSB(off) ((bf16_t*)(p.ws + (off)))
#ifndef PHMASK
#define PHMASK 0xFFFF
#endif
#ifndef REPMASK
#define REPMASK 0
#endif
#ifndef NSYNC
#define NSYNC 1
#endif
#define PH(k) if (((PHMASK >> (k)) & 1) && ph_lo <= (k) && (k) < ph_hi) for (int rep_ = 0; rep_ < (((REPMASK >> (k)) & 1) ? 2 : 1); ++rep_, (((REPMASK >> (k)) & 1) && rep_ == 1 ? xcd_barrier(bar) : (void)0))
#ifndef USE_CG_SYNC
#define USE_CG_SYNC 0
#endif
#define SEAM(k) if (ph_lo <= (k) && (k) + 1 < ph_hi) { for (int s_ = 0; s_ < NSYNC; ++s_) { if (USE_CG_SYNC || ph_hi > 1000) grid.sync(); else xcd_barrier(bar); } }
    PH(0) { phase_prologue<0>(C, C.vcu, C.G);
#if !defined(L1_LATE) && !defined(L1_IN_P7)
        phase_prologue<1>(C, C.vcu, C.G);
#endif
    } SEAM(0);
    PH(1) { phase_norm(C, p.in[I_X], p.in[I_CTX], p.in[I0_NMIX], 0, 0, 1, MT); } SEAM(1);
    PH(2) { pg8::Gemm g{XN, WSB(WS_W_IN0), MT, 1536, D, D}; pg8::StaticOrder So; So.init(MT, 1536, C.G, C.bid);
        epi::EpiIn0 E{WSB(WS_A0), WSB(WS_Q0), WSB(WS_K0), WSB(WS_V0), p.in[I0_QG], p.in[I0_KG], T32};
        pg8::gemm_phase<epi::EpiIn0, pg8::StaticOrder, ALIGN2, true>(C.lds, g, So, E);
#ifdef L0_SPLIT
        { const int n2 = (MT / 256) * 6 - C.G;
          if (n2 >= 0 && n2 < C.G) { if (C.bid >= n2) phase_prologue<2>(C, C.bid - n2, C.G - n2); } else phase_prologue<2>(C, C.vcu, C.G); }
#endif
#ifdef L1_LATE
        { const int n2 = (MT / 256) * 6 - C.G;
          if (n2 >= 0 && n2 < C.G && C.bid >= n2) phase_prologue<1>(C, C.bid - n2, C.G - n2);
          else if (n2 < 0 || n2 >= C.G) phase_prologue<1>(C, C.vcu, C.G); }
#endif
    } SEAM(2);
    PH(3) { phase_attn0(C); } SEAM(3);
    PH(4) { { pg8::Gemm g{MIX, WSB(WS_W_OUT0), ML, D, D, D}; pg8::StaticOrder So; So.init(ML, D, C.G, C.bid);
          epi::EpiResid E{p.in[I_X], p.in[I_CTX], out, xrc, MOD + 2 * D};
          pg8::gemm_phase<epi::EpiResid, pg8::StaticOrder, ALIGN1, true>(C.lds, g, So, E); }
        { pg8::Gemm g{MIX, WSB(WS_W_OUT0), MT, D, D / 4, D}; pg8::CtxSplitOrder So; So.init(4, C.G, C.bid);
          epi::EpiResidSplit E{p.in[I_CTX], xrc, (float*)(p.ws + WS_SLAB4), MOD + 2 * D};
          pg8::gemm_phase<epi::EpiResidSplit, pg8::CtxSplitOrder, true, true>(C.lds, g, So, E); }
#ifdef CTXD_IN_P6
        if (C.G > 128) { if (C.bid >= 128) phase_prologue<3>(C, C.bid - 128, C.G - 128); } else phase_prologue<3>(C, C.vcu, C.G);
#endif
    } SEAM(4);
    PH(5) { phase_norm(C, out, xrc, p.in[I0_NFFN], 0, 3, 4, MT, (const float*)(p.ws + WS_SLAB4), 3, xrc); } SEAM(5);
#ifdef CTXD_IN_P6
    const bool ctxd = (C.G == 256);
#else
    const bool ctxd = false;
#endif
    PH(6) { pg8::Gemm g{XN, WSB(WS_W_GU0), MT, 2 * FF, D, D}; epi::EpiSwiGLU E{H};
        if (!ctxd) { pg8::StaticOrder So; So.init(MT, 2 * FF, C.G, C.bid);
            pg8::gemm_phase<epi::EpiSwiGLU, pg8::StaticOrder, true, true>(C.lds, g, So, E);
#ifdef D0_IN_P6
            { const int total = (MT / 256) * (2 * FF / 256), full = total / C.G, n7 = total - full * C.G;
              if (n7 > 0 && n7 < C.G) { if (C.bid >= n7) phase_prologue<3>(C, C.bid - n7, C.G - n7); } else phase_prologue<3>(C, C.vcu, C.G); }
#endif
        }
#ifdef CTXD_IN_P6
        else {
            unsigned* flag = barw + XB_CTXH;
            { pg8::CtxFirstOrder So; So.init(0, C.bid); epi::EpiSwiGLUW EW{H}; pg8::gemm_phase<epi::EpiSwiGLUW, pg8::CtxFirstOrder, true, true>(C.lds, g, So, EW); }
            if (C.bid >= 80 && threadIdx.x == 0) xb_add(flag, 1u);
            { pg8::CtxFirstOrder So; So.init(1, C.bid); pg8::gemm_phase<epi::EpiSwiGLU, pg8::CtxFirstOrder, true, true>(C.lds, g, So, E); }
            if (C.bid >= 48 && C.bid < 176) {
                if (threadIdx.x == 0) { XB_SPIN(xb_ld(flag) < 176u, barw); __builtin_amdgcn_fence(__ATOMIC_ACQUIRE, "agent"); asm volatile("s_waitcnt vmcnt(0)" ::: "memory"); }
                __syncthreads();
                if (C.bid < 112) { pg8::Gemm g2{H, WSB(WS_W_D0), MT, D, 768, FF}; pg8::CtxSplitOrder S2; S2.init(2, C.G, C.bid - 48);
                    epi::EpiResidSplit E2{xrc, xrc, (float*)(p.ws + WS_SLAB7), MOD + 5 * D, 0};
                    pg8::gemm_phase<epi::EpiResidSplit, pg8::CtxSplitOrder, true, true>(C.lds, g2, S2, E2); }
                else { pg8::Gemm g2{H + 1536, WSB(WS_W_D0) + 1536, MT, D, 640, FF}; pg8::CtxSplitOrder S2; S2.init(2, C.G, C.bid - 112);
                    epi::EpiResidSplit E2{xrc, xrc, (float*)(p.ws + WS_SLAB7), MOD + 5 * D, 2};
                    pg8::gemm_phase<epi::EpiResidSplit, pg8::CtxSplitOrder, true, true>(C.lds, g2, S2, E2); }
            } else if (C.bid >= 176) { phase_prologue<1>(C, C.bid - 176, C.G - 176); phase_natable(C, C.bid - 176, C.G - 176); }
        }
#endif
    } SEAM(6);
    PH(7) { { pg8::Gemm g{H, WSB(WS_W_D0), ML, D, FF, FF}; pg8::StaticOrder So; So.init(ML, D, C.G, C.bid);
          epi::EpiResid E{out, xrc, out, xrc, MOD + 5 * D};
          pg8::gemm_phase<epi::EpiResid, pg8::StaticOrder, ALIGN1, true>(C.lds, g, So, E); }
        if (!ctxd) {
        { pg8::Gemm g{H, WSB(WS_W_D0), MT, D, FF / 2, FF}; pg8::CtxSplitOrder So; So.init(2, C.G, C.bid);
          epi::EpiResidSplit E{xrc, xrc, (float*)(p.ws + WS_SLAB7), MOD + 5 * D};
          pg8::gemm_phase<epi::EpiResidSplit, pg8::CtxSplitOrder, true, true>(C.lds, g, So, E); }
#ifdef L1_IN_P7
        if (C.G > 64) { if (C.bid >= 64) { phase_prologue<1>(C, C.bid - 64, C.G - 64);
#ifdef CTXD_IN_P6
            phase_prologue<4>(C, C.bid - 64, C.G - 64);
#endif
            phase_natable(C, C.bid - 64, C.G - 64); } }
        else { phase_prologue<1>(C, C.vcu, C.G);
#ifdef CTXD_IN_P6
            phase_prologue<4>(C, C.vcu, C.G);
#endif
            phase_natable(C, C.vcu, C.G); }
#endif
        }
    } SEAM(7);
    PH(8) {
#ifndef L1_IN_P7
        phase_natable(C, C.vcu, C.G);
#endif
        phase_norm(C, out, xrc, p.in[I1_NMIX], 1, 0, 1, MT, (const float*)(p.ws + WS_SLAB7), ctxd ? 3 : 1, nullptr); } SEAM(8);
    PH(9) { pg8::Gemm g{XN, WSB(WS_W_IN1), MT, L1_INP, D, D}; pg8::StaticOrder So; So.init(MT, L1_INP, C.G, C.bid);
        epi::EpiIn1 E{WSB(WS_CQ), WSB(WS_CKV), WSB(WS_NQ), WSB(WS_NK), WSB(WS_NV), (float*)(p.ws + WS_KR), (float*)(p.ws + WS_SSQ), (float*)(p.ws + WS_SSKV), p.in[I1_NQG], p.in[I1_NKG]};
        pg8::gemm_phase<epi::EpiIn1, pg8::StaticOrder, ALIGN2, true>(C.lds, g, So, E);
#ifdef CTXD_IN_P6
        if (ctxd) { const int n3 = (MT / 256) * (L1_INP / 256) - 2 * C.G;
            if (n3 >= 0 && n3 < C.G) { if (C.bid >= n3) phase_prologue<4>(C, C.bid - n3, C.G - n3); } else phase_prologue<4>(C, C.vcu, C.G); }
#endif
    } SEAM(9);
    PH(10) {
#ifndef NO_QUP
        { pg8::Gemm g{WSB(WS_CQ), WSB(WS_W_UQ), ML, 768, 384, 384}; pg8::StaticOrder So; So.init(ML, 768, C.G, C.bid);
          epi::EpiQUp E{WSB(WS_MQ), (const float*)(p.ws + WS_SSQ)};
          pg8::gemm_phase<epi::EpiQUp, pg8::StaticOrder, ALIGN2, true>(C.lds, g, So, E); }
#endif
#ifndef NO_KVUP
        { pg8::Gemm g{WSB(WS_CKV), WSB(WS_W_UKV), MT, 1024, 256, 256}; pg8::StaticOrder So; So.init(MT, 1024, C.G, (C.bid + KVROT) % C.G);
          epi::EpiKvUp E{WSB(WS_MK), WSB(WS_MV), (const float*)(p.ws + WS_SSKV), (const float*)(p.ws + WS_KR), p.in[I1_MKG], T16};
          pg8::gemm_phase<epi::EpiKvUp, pg8::StaticOrder, ALIGN2, true>(C.lds, g, So, E); }
#endif
    } SEAM(10);
    PH(11) { phase_attn1(C); } SEAM(11);
    PH(12) { pg8::Gemm g{MIX, WSB(WS_W_OUT1), ML, D, D, D}; pg8::StaticOrder So; So.init(ML, D, C.G, C.bid);
        epi::EpiResid E{out, xrc, out, xrc, MOD + 9 * 6144 + 2 * D};
        pg8::gemm_phase<epi::EpiResid, pg8::StaticOrder, ALIGN1, true>(C.lds, g, So, E); } SEAM(12);
    PH(13) { phase_norm(C, out, xrc, p.in[I1_NFFN], 1, 3, 4, ML); } SEAM(13);
    PH(14) { pg8::Gemm g{XN, WSB(WS_W_GU1), ML, 2 * FF, D, D}; pg8::StaticOrder So; So.init(ML, 2 * FF, C.G, C.bid);
        epi::EpiSwiGLU E{H};
        pg8::gemm_phase<epi::EpiSwiGLU, pg8::StaticOrder, true, true>(C.lds, g, So, E); } SEAM(14);
    PH(15) { pg8::Gemm g{H, WSB(WS_W_D1), ML, D, FF, FF}; pg8::StaticOrder So; So.init(ML, D, C.G, C.bid);
        epi::EpiResid E{out, xrc, out, xrc, MOD + 9 * 6144 + 5 * D};
        pg8::gemm_phase<epi::EpiResid, pg8::StaticOrder, ALIGN1, true>(C.lds, g, So, E); }
    if (ph_hi - ph_lo > 1 && C.bid == 0 && threadIdx.x == 0) { if (xb_ld(&barw[XB_TMO]) != 0u) out[0] = __builtin_nanf(""); }
#undef PH
#undef SEAM
#undef WSB
}
}
#ifndef MK_DEBUG
#define MK_DEBUG 0
#endif
static int g_grid = 0;
static bool mega_setup() {
    if (g_grid) return g_grid > 0;
    int dev = 0, cus = 0, per_cu = 0;
    if (hipGetDevice(&dev) != hipSuccess || hipDeviceGetAttribute(&cus, hipDeviceAttributeMultiprocessorCount, dev) != hipSuccess) { g_grid = -1; return false; }
    if (hipFuncSetAttribute((const void*)mk::mega, hipFuncAttributeMaxDynamicSharedMemorySize, mk::LDS_BYTES) != hipSuccess) { fprintf(stderr, "kernel_launch: hipFuncSetAttribute failed\n"); g_grid = -1; return false; }
    if (hipOccupancyMaxActiveBlocksPerMultiprocessor(&per_cu, (const void*)mk::mega, mk::NTHR, mk::LDS_BYTES) != hipSuccess || per_cu < 1) { fprintf(stderr, "kernel_launch: occupancy query says %d\n", per_cu); g_grid = -1; return false; }
    g_grid = cus;
    fprintf(stderr, "kernel_launch: %d CUs, occupancy %d blocks/CU, grid %d\n", cus, per_cu, g_grid);
    return true;
}
static void launch_phases(const Params& p, int lo, int hi, hipStream_t st) {
    Params pp = p; int l = lo, h = hi;
    void* args[] = {&pp, &l, &h};
    hipError_t e;
    if (hi - lo > 1) e = hipLaunchCooperativeKernel((const void*)mk::mega, dim3(g_grid), dim3(mk::NTHR), args, mk::LDS_BYTES, st);
    else e = hipLaunchKernel((const void*)mk::mega, dim3(g_grid), dim3(mk::NTHR), args, mk::LDS_BYTES, st);
    if (e != hipSuccess) fprintf(stderr, "kernel_launch: launch [%d,%d) failed: %s\n", lo, hi, hipGetErrorString(e));
}
#if MK_DEBUG
static void launch_debug(const Params& p, hipStream_t st) {
    using namespace nv;
    unsigned* err = (unsigned*)(p.ws + WS_CTL) + 64;
    float* out = p.out; float* xrc = (float*)(p.ws + WS_XRC);
    const float* x = p.in[I_X]; const float* cx = p.in[I_CTX];
    const size_t att_sm = 4 * (SK + 128) * sizeof(float);
    const int SR = 4096;
    float* snapL = (float*)(p.ws + WS_SNAP); float* snapC = snapL + (size_t)SR * D;
    float* snapB = (float*)(p.ws + WS_BIG);
    hipMemsetAsync(p.ws + WS_CTL, 0, WS_SSQ, st);
    launch_phases(p, 0, 1, st);  k_adaln<true><<<dim3(6144 / 256, 9, 2), 256, 0, st>>>(p, err + 0);
    launch_phases(p, 1, 2, st);  k_norm<true><<<MT / 4, 256, 0, st>>>(p, x, cx, I0_NMIX, 0, 0, 1, MT, err + 1);
    launch_phases(p, 2, 3, st);  k_in0<true><<<MT / R, 256, (R * D + R * L0_IN) * 4, st>>>(p, err + 2);
    launch_phases(p, 3, 4, st);  k_attn<true, 0><<<dim3(ML / 4, 12), 256, att_sm, st>>>(p, err + 3);
                                 k_attn<true, 1><<<dim3(MC / 4, 12), 256, att_sm, st>>>(p, err + 16);
                                 k_pool0<true><<<MT, 256, 0, st>>>(p, err + 17);
    launch_phases(p, 4, 5, st);  k_out<true, 0><<<MT / R, 256, (R * D + R * 256) * 4, st>>>(p, x, cx, out, xrc, 0, err + 4);
    launch_phases(p, 5, 6, st);  k_norm<true><<<MT / 4, 256, 0, st>>>(p, out, xrc, I0_NFFN, 0, 3, 4, MT, err + 5);
    launch_phases(p, 6, 7, st);  k_ffn_gu<true, 0><<<MT / R, 256, R * D * 4, st>>>(p, err + 6);
    hipMemcpyAsync(snapL, out, (size_t)SR * D * 4, hipMemcpyDeviceToDevice, st); hipMemcpyAsync(snapC, xrc, (size_t)MC * D * 4, hipMemcpyDeviceToDevice, st);
    launch_phases(p, 7, 8, st);  k_ffn_d<true, 0><<<SR / R, 256, R * FF * 4, st>>>(p, snapL, snapC, out, xrc, 0, err + 7);
                                 k_ffn_d<true, 0><<<MC / R, 256, R * FF * 4, st>>>(p, snapL, snapC, out, xrc, ML, err + 7);
    launch_phases(p, 8, 9, st);  k_norm<true><<<MT / 4, 256, 0, st>>>(p, out, xrc, I1_NMIX, 1, 0, 1, MT, err + 8);
    launch_phases(p, 9, 10, st); k_in1<true><<<MT / R, 256, (R * D + R * L1_IN) * 4, st>>>(p, err + 9);
    launch_phases(p, 10, 11, st); k_mlaq<true><<<ML / R, 256, R * 384 * 4, st>>>(p, err + 10);
                                 k_mlakv<true><<<MT / R, 256, (R * 256 + R * 1024) * 4, st>>>(p, err + 19);
    launch_phases(p, 11, 12, st); k_attn<true, 2><<<dim3(ML / 4, 8), 256, att_sm, st>>>(p, err + 11);
                                 k_attn<true, 3><<<dim3(ML / 4, 8), 256, att_sm, st>>>(p, err + 18);
    hipMemcpyAsync(snapB, out, (size_t)SR * D * 4, hipMemcpyDeviceToDevice, st);
    launch_phases(p, 12, 13, st); k_out<true, 1><<<SR / R, 256, (R * D + R * 256) * 4, st>>>(p, snapB, snapC, out, xrc, 0, err + 12);
    launch_phases(p, 13, 14, st); k_norm<true><<<ML / 4, 256, 0, st>>>(p, out, xrc, I1_NFFN, 1, 3, 4, ML, err + 13);
    launch_phases(p, 14, 15, st); k_ffn_gu<true, 1><<<ML / R, 256, R * D * 4, st>>>(p, err + 14);
    hipMemcpyAsync(snapL, out, (size_t)SR * D * 4, hipMemcpyDeviceToDevice, st);
    launch_phases(p, 15, 16, st); k_ffn_d<true, 1><<<SR / R, 256, R * FF * 4, st>>>(p, snapL, snapC, out, xrc, 0, err + 15);
    k_report<<<1, 1, 0, st>>>(p, 20, 0.15f);
}
#endif
extern "C" void kernel_launch(void* const* d_in, const int* in_sizes, int n_in, void* d_out, int out_size, void* d_ws, size_t ws_size, hipStream_t stream) {
    if (n_in != N_IN || out_size != ML * D || ws_size < WS_END) { fprintf(stderr, "kernel_launch: unexpected shapes n_in=%d out=%d ws=%zu\n", n_in, out_size, ws_size); return; }
    if (!mega_setup()) return;
    Params p{};
    for (int i = 0; i < N_IN; ++i) p.in[i] = (const float*)d_in[i];
    p.out = (float*)d_out; p.ws = (unsigned char*)d_ws;
#if MK_DEBUG
    launch_debug(p, stream);
#else
    if (hipMemsetAsync((char*)d_ws + WS_BARRIER, 0, WS_SSQ - WS_BARRIER, stream) != hipSuccess) { fprintf(stderr, "kernel_launch: memset failed\n"); return; }
#ifdef EXTRA_MEMSET
    (void)hipMemsetAsync((char*)d_ws + WS_CTL, 0, 4096, stream);
#endif
    launch_phases(p, 0, mk::NPHASE, stream);
#endif
}
```

```cpp
#define USE_ATT64 1
#define USE_ATT96 1
#define ATT_STATIC_PRIO 1
#define L1_IN_P7 1
#define L0_SPLIT 1
#define D0_IN_P6 1
#define FOLD_N13 1
#include <hip/hip_runtime.h>
#include <hip/hip_cooperative_groups.h>
#include <cstdio>
#include <cstdint>
namespace cg = cooperative_groups;

typedef unsigned short bf16_t;
constexpr int D = 1024, NB = 8, S = 2048, CTX = 256, SK = S + CTX, ML = NB * S, MC = NB * CTX, MT = ML + MC, FF = 2816;
constexpr int GW = 64;
constexpr int L0_IN = 1536, L1_IN = 2208, L1_INP = 2304;
constexpr float EPS = 1e-6f;
constexpr float LOG2E = 1.4426950408889634f;
constexpr float C2_64 = 0.125f * LOG2E;
constexpr float C2_96 = 0.10206207261596577f * LOG2E;

enum { I_X = 0, I_C, I_CTX, I_CCTX,
       I0_ADAW, I0_ADAB, I0_NMIX, I0_NFFN, I0_WIN, I0_POOLW, I0_POOLS, I0_QG, I0_KG, I0_WOUT, I0_WG, I0_WU, I0_WD,
       I1_ADAW, I1_ADAB, I1_NMIX, I1_NFFN, I1_WIN, I1_QAG, I1_KVAG, I1_WUQ, I1_WUKV, I1_MQG, I1_MKG, I1_NQG, I1_NKG, I1_RPB, I1_WOUT, I1_WG, I1_WU, I1_WD, N_IN };

constexpr size_t MiB = 1u << 20;
constexpr size_t WS_CTL = 0;
constexpr size_t WS_BARRIER = 16 * 1024;
constexpr size_t WS_MOD = 64 * 1024;
constexpr size_t WS_SSQ = 512 * 1024;
constexpr size_t WS_SSKV = 600 * 1024;
constexpr size_t WS_ROPE32 = 700 * 1024;
constexpr size_t WS_ROPE16 = 712 * 1024;
constexpr size_t WS_W_IN0 = 1 * MiB;
constexpr size_t WS_W_OUT0 = 4 * MiB;
constexpr size_t WS_W_GU0 = 6 * MiB;
constexpr size_t WS_W_D0 = 17 * MiB;
constexpr size_t WS_W_IN1 = 23 * MiB;
constexpr size_t WS_W_UQ = 28 * MiB;
constexpr size_t WS_W_UKV = 29 * MiB;
constexpr size_t WS_W_OUT1 = 30 * MiB;
constexpr size_t WS_W_GU1 = 32 * MiB;
constexpr size_t WS_W_D1 = 43 * MiB;
constexpr size_t WS_XRC = 49 * MiB;
constexpr size_t WS_XN = 57 * MiB;
constexpr size_t WS_MIX = WS_XN;
constexpr size_t WS_BIG = 96 * MiB;
constexpr size_t WS_H = WS_BIG;
constexpr size_t WS_A0 = WS_BIG;
constexpr size_t WS_Q0 = WS_BIG + 9 * MiB;
constexpr size_t WS_K0 = WS_BIG + 36 * MiB;
constexpr size_t WS_V0 = WS_BIG + 45 * MiB;
constexpr size_t WS_CQ = WS_BIG;
constexpr size_t WS_CKV = WS_BIG + 14 * MiB;
constexpr size_t WS_NQ = WS_BIG + 23 * MiB;
constexpr size_t WS_NK = WS_BIG + 41 * MiB;
constexpr size_t WS_NV = WS_BIG + 59 * MiB;
constexpr size_t WS_MQ = WS_BIG + 77 * MiB;
constexpr size_t WS_MK = WS_BIG + 101 * MiB;
constexpr size_t WS_MV = WS_BIG + 128 * MiB;
constexpr size_t WS_KR = WS_BIG + 146 * MiB;
constexpr size_t WS_SLAB4 = WS_BIG;
constexpr size_t WS_SLAB7 = WS_BIG + 100 * MiB;
constexpr size_t WS_NAG = WS_BIG + 150 * MiB;
constexpr size_t WS_SSN1 = 768 * 1024;
constexpr size_t WS_BIAS1 = 832 * 1024;
constexpr size_t WS_XN2 = WS_BIG + 100 * MiB;
constexpr size_t WS_SNAP = WS_BIG + 100 * MiB;
constexpr size_t WS_END = 256 * MiB;
static_assert(WS_KR + (size_t)MT * 32 * 4 <= WS_END, "ws map");
static_assert(WS_W_D1 + (size_t)D * FF * 2 <= WS_XRC, "ws map");
static_assert(WS_XN + (size_t)MT * D * 2 <= WS_BIG, "ws map");

__device__ __forceinline__ float bf2f(bf16_t u) { return __uint_as_float((unsigned)u << 16); }
__device__ __forceinline__ bf16_t f2bf(float f) { unsigned u = __float_as_uint(f); return (bf16_t)((u + 0x7fffu + ((u >> 16) & 1u)) >> 16); }
__device__ __forceinline__ int kvrow_of(int m) { return m < ML ? (m / S) * SK + CTX + (m % S) : ((m - ML) / CTX) * SK + ((m - ML) % CTX); }
__device__ __forceinline__ int modidx_of(int m) { return m < ML ? m / S : 8; }
__device__ __forceinline__ float wave_sum(float v) {
#pragma unroll
    for (int o = 1; o < 64; o <<= 1) v += __shfl_xor(v, o);
    return v;
}
__device__ __forceinline__ float wave_max(float v) {
#pragma unroll
    for (int o = 1; o < 64; o <<= 1) v = fmaxf(v, __shfl_xor(v, o));
    return v;
}

struct Params {
    const float* in[N_IN];
    float* out;
    unsigned char* ws;
};
namespace pg8 {
#define PG8_LAS __attribute__((address_space(3)))
typedef unsigned short bf16_t;
typedef short bf16x8 __attribute__((ext_vector_type(8)));
typedef float f32x4 __attribute__((ext_vector_type(4)));
typedef unsigned u32x4 __attribute__((ext_vector_type(4)));
constexpr int BM = 256, BK = 64, HALF = 128, HTB = HALF * BK * 2  , STAGE_BYTES = 8 * HTB, NXCD = 8, WGM = 8;

__host__ __device__ __forceinline__ int lds_byte(int r, int c) { const int st = (r >> 4) * 2 + (c >> 5), rr = r & 15, cc = c & 31, ob = rr * 64 + cc * 2; return st * 1024 + (ob ^ (((ob >> 9) & 1) << 5)); }
__host__ __device__ __forceinline__ void stage_rc(int b, int& R, int& C) { const int st = b / 1024, sb = b % 1024, swz = sb ^ (((sb >> 9) & 1) << 5); R = (st >> 1) * 16 + swz / 64; C = (st & 1) * 32 + (swz % 64) / 2; }
__host__ __device__ __forceinline__ int perm32(int rho) { const int n = rho >> 4, i = rho & 15; return 8 * (i >> 2) + 4 * n + (i & 3); }

struct Unit { int pm, pn, ks; };
struct Gemm { const bf16_t* A; const bf16_t* Bt; int M, N, K, ld; };

struct StaticOrder {
    int nM, nN, nwg, G, c;
    __host__ __device__ void init(int M, int N, int G_, int c_) { nM = M / BM; nN = N / BM; nwg = nM * nN; G = G_; c = c_; }
    __host__ __device__ bool next(int i, Unit& u) const {
        const long L = (long)i * G + c; if (L >= nwg) return false;
        int wgid = (int)L; { const int q = nwg / NXCD, r = nwg % NXCD, xcd = wgid % NXCD, off = wgid / NXCD; wgid = (xcd < r ? xcd * (q + 1) : r * (q + 1) + (xcd - r) * q) + off; }
        const int nig = WGM * nN, gid = wgid / nig, fm = gid * WGM, gsz = (nM - fm) < WGM ? (nM - fm) : WGM;
        u.pm = fm + ((wgid % nig) % gsz); u.pn = (wgid % nig) / gsz; u.ks = 0; return true;
    }
    __device__ __forceinline__ void a_ready(const Unit&) const {}
    __device__ __forceinline__ void done(const Unit&) const {}
};

__device__ __forceinline__ unsigned cvt_pk_bf16(float lo, float hi) { unsigned r; asm volatile("v_cvt_pk_bf16_f32 %0, %1, %2" : "=v"(r) : "v"(lo), "v"(hi)); return r; }
typedef float f32x2 __attribute__((ext_vector_type(2)));
struct CtxSplitOrder {
    int G, c, split;
    __host__ __device__ void init(int split_, int G_, int c_) { split = split_; G = G_; c = c_; }
    __host__ __device__ bool next(int i, Unit& u) const {
        const int L = i * G + c; if (L >= 32 * split) return false;
        u.ks = L % split; const int t = L / split; u.pn = t & 3; u.pm = 64 + (t >> 2); return true;
    }
    __device__ __forceinline__ void a_ready(const Unit&) const {}
    __device__ __forceinline__ void done(const Unit&) const {}
};
struct CtxFirstOrder {
    int c, mode; StaticOrder lat;
    __host__ __device__ void init(int mode_, int c_) { mode = mode_; c = c_; lat.init(64 * BM, 22 * BM, 1 << 28, 0); }
    __host__ __device__ bool next(int i, Unit& u) const {
        if (mode == 0) { if (i != 0 || c < 80) return false; const int j = c - 80; u.pm = 64 + (j & 7); u.pn = j >> 3; u.ks = 0; return true; }
        const int Lp = c < 80 ? (i == 0 ? c : 80 + (i - 1) * 256 + c) : 80 + i * 256 + c;
        if (Lp >= 1408) return false;
        StaticOrder t = lat; t.c = Lp; return t.next(0, u);
    }
    __device__ __forceinline__ void a_ready(const Unit&) const {}
    __device__ __forceinline__ void done(const Unit&) const {}
};
template <class Epi, class Sched, bool ALIGN_EPI = false, bool SP2 = false>
__device__ __forceinline__ void gemm_phase(PG8_LAS unsigned char* lds, const Gemm g, const Sched& S, const Epi& E) {
    int tid_ = threadIdx.x; asm volatile("" : "+v"(tid_));
    const int tid = tid_, wid = __builtin_amdgcn_readfirstlane(tid >> 6), lane = tid & 63, wr = wid >> 2, wc = wid & 3, fr = lane & 15, fq = lane >> 4;
    int K_ = g.K; asm volatile("" : "+s"(K_));
    const int K = K_, nt = K / BK; int LD_ = g.ld; asm volatile("" : "+s"(LD_)); const int LD = LD_;
    unsigned voffA[2], voffB[2];
#pragma unroll
    for (int i = 0; i < 2; ++i) { int R, C; stage_rc(tid * 16 + i * 8192, R, C); const int Rb = Epi::PERM ? ((R & ~31) + perm32(R & 31)) : R;
        voffA[i] = (unsigned)(R * LD + C) * 2u; voffB[i] = (unsigned)(Rb * LD + C) * 2u; }
    const size_t kstep = (size_t)(BK * 2);
    const size_t hstep = (size_t)HALF * LD * 2;
    const size_t tstep = 2 * hstep;
    const unsigned ldsw = (unsigned)wid * 1024u;
    const int aoff = lds_byte(wr * 64 + fr, fq * 8), boff = lds_byte(wc * 32 + fr, fq * 8);
#define PG8_SA(b, h) (((b) * 2 + (h)) * HTB)
#define PG8_SB(b, h) ((4 + (b) * 2 + (h)) * HTB)
#define PG8_STAGE(bufoff, gbase, voff) do { _Pragma("unroll") for (int _i = 0; _i < 2; ++_i) \
        __builtin_amdgcn_global_load_lds((const unsigned*)((const char*)(gbase) + (voff)[_i]), (PG8_LAS unsigned*)(lds + (bufoff) + ldsw + _i * 8192), 16, 0, 0); } while (0)
#define PG8_LDA(dst, b, h) do { _Pragma("unroll") for (int m = 0; m < 4; ++m) _Pragma("unroll") for (int k = 0; k < 2; ++k) dst[m][k] = *(const PG8_LAS bf16x8*)(lds + PG8_SA(b, h) + aoff + m * 2048 + k * 1024); } while (0)
#define PG8_LDB(dst, b, h) do { _Pragma("unroll") for (int n = 0; n < 2; ++n) _Pragma("unroll") for (int k = 0; k < 2; ++k) dst[n][k] = *(const PG8_LAS bf16x8*)(lds + PG8_SB(b, h) + boff + n * 2048 + k * 1024); } while (0)
#define PG8_MMA(ai, bj, At, Bt) do { __builtin_amdgcn_s_setprio(1); _Pragma("unroll") for (int m = 0; m < 4; ++m) _Pragma("unroll") for (int n = 0; n < 2; ++n) _Pragma("unroll") for (int k = 0; k < 2; ++k) \
        acc[ai][bj][m][n] = __builtin_amdgcn_mfma_f32_16x16x32_bf16(Bt[n][k], At[m][k], acc[ai][bj][m][n], 0, 0, 0); __builtin_amdgcn_s_setprio(0); } while (0)
#define PG8_WAIT_V(n) asm volatile("s_waitcnt vmcnt(" #n ")" ::: "memory")
#define PG8_WAIT_L(n) asm volatile("s_waitcnt lgkmcnt(" #n ")" ::: "memory")
#define PG8_BAR __builtin_amdgcn_s_barrier()
#define PG8_SCHED __builtin_amdgcn_sched_barrier(0)
    Unit cur, nxt; int ui = 0;
    if (!S.next(0, cur)) return;
    f32x4 acc[2][2][4][2];
#pragma unroll
    for (int a = 0; a < 2; ++a)
#pragma unroll
        for (int b = 0; b < 2; ++b)
#pragma unroll
            for (int m = 0; m < 4; ++m)
#pragma unroll
                for (int n = 0; n < 2; ++n) acc[a][b][m][n] = (f32x4){0.f, 0.f, 0.f, 0.f};
    bf16x8 At[4][2], B0[2][2], B1[2][2];
    const char* cA = (const char*)g.A + (size_t)cur.pm * tstep + (size_t)cur.ks * K * 2; const char* cB = (const char*)g.Bt + (size_t)cur.pn * tstep + (size_t)cur.ks * K * 2;
    S.a_ready(cur);
    if constexpr (SP2) {
        PG8_STAGE(PG8_SB(0, 0), cB, voffB); PG8_STAGE(PG8_SB(0, 1), cB + hstep, voffB); PG8_STAGE(PG8_SA(0, 0), cA, voffA); PG8_STAGE(PG8_SA(0, 1), cA + hstep, voffA);
        if (wr == 1) PG8_BAR;
        PG8_WAIT_V(2); PG8_BAR;
        PG8_STAGE(PG8_SB(1, 0), cB + kstep, voffB); PG8_STAGE(PG8_SA(1, 0), cA + kstep, voffA); PG8_STAGE(PG8_SB(1, 1), cB + hstep + kstep, voffB);
        PG8_WAIT_V(6); PG8_BAR;
    } else {
        PG8_STAGE(PG8_SB(0, 0), cB, voffB); PG8_STAGE(PG8_SA(0, 0), cA, voffA); PG8_STAGE(PG8_SB(0, 1), cB + hstep, voffB); PG8_STAGE(PG8_SA(0, 1), cA + hstep, voffA);
        if (wr == 1) PG8_BAR;
        PG8_WAIT_V(4); PG8_BAR;
        PG8_STAGE(PG8_SB(1, 0), cB + kstep, voffB); PG8_STAGE(PG8_SA(1, 0), cA + kstep, voffA); PG8_STAGE(PG8_SB(1, 1), cB + hstep + kstep, voffB);
        PG8_WAIT_V(6); PG8_BAR;
    }
    for (;;) {
        const bool has_next = S.next(ui + 1, nxt);
        const char* nA = has_next ? (const char*)g.A + (size_t)nxt.pm * tstep + (size_t)nxt.ks * K * 2 : cA; const char* nB = has_next ? (const char*)g.Bt + (size_t)nxt.pn * tstep + (size_t)nxt.ks * K * 2 : cB;
        for (int t = 0; t < nt; t += 2) {
            const bool last = (t == nt - 2);
            const char* a1 = cA + (size_t)(t + 1) * kstep;
            const char* a2 = last ? nA : cA + (size_t)(t + 2) * kstep; const char* b2 = last ? nB : cB + (size_t)(t + 2) * kstep;
            const char* a3 = a2 + kstep; const char* b3 = b2 + kstep;
            if (last && has_next) S.a_ready(nxt);
            if constexpr (SP2) {
            PG8_LDB(B0, 0, 0); PG8_LDB(B1, 0, 1); PG8_SCHED; PG8_LDA(At, 0, 0); PG8_STAGE(PG8_SA(1, 1), a1 + hstep, voffA);
            PG8_WAIT_V(8); PG8_WAIT_L(0); PG8_BAR; PG8_MMA(0, 0, At, B0); PG8_MMA(0, 1, At, B1); PG8_BAR; PG8_SCHED;
            PG8_LDA(At, 0, 1); PG8_STAGE(PG8_SB(0, 0), b2, voffB); PG8_STAGE(PG8_SB(0, 1), b2 + hstep, voffB); PG8_STAGE(PG8_SA(0, 0), a2, voffA);
            PG8_WAIT_V(8); PG8_WAIT_L(0); PG8_BAR; PG8_MMA(1, 0, At, B0); PG8_MMA(1, 1, At, B1); PG8_BAR; PG8_SCHED;
            PG8_LDB(B0, 1, 0); PG8_LDB(B1, 1, 1); PG8_SCHED; PG8_LDA(At, 1, 0); PG8_STAGE(PG8_SA(0, 1), a2 + hstep, voffA);
            PG8_WAIT_V(8); PG8_WAIT_L(0); PG8_BAR; PG8_MMA(0, 0, At, B0); PG8_MMA(0, 1, At, B1); PG8_BAR; PG8_SCHED;
            PG8_LDA(At, 1, 1); PG8_STAGE(PG8_SB(1, 0), b3, voffB); PG8_STAGE(PG8_SB(1, 1), b3 + hstep, voffB); PG8_STAGE(PG8_SA(1, 0), a3, voffA);
            PG8_WAIT_V(8); PG8_WAIT_L(0); PG8_BAR; PG8_MMA(1, 0, At, B0); PG8_MMA(1, 1, At, B1); PG8_BAR; PG8_SCHED;
            } else {
            PG8_LDB(B0, 0, 0); PG8_SCHED; PG8_LDA(At, 0, 0); PG8_STAGE(PG8_SA(1, 1), a1 + hstep, voffA);
            PG8_WAIT_L(8); PG8_BAR; PG8_WAIT_L(0); PG8_MMA(0, 0, At, B0); PG8_BAR; PG8_SCHED;
            PG8_LDB(B1, 0, 1); PG8_STAGE(PG8_SB(0, 0), b2, voffB);
            PG8_BAR; PG8_WAIT_L(0); PG8_MMA(0, 1, At, B1); PG8_BAR;
            PG8_LDA(At, 0, 1); PG8_STAGE(PG8_SA(0, 0), a2, voffA);
            PG8_BAR; PG8_WAIT_L(0); PG8_MMA(1, 0, At, B0); PG8_BAR; PG8_SCHED;
            PG8_STAGE(PG8_SB(0, 1), b2 + hstep, voffB);
            PG8_WAIT_V(6); PG8_BAR; PG8_MMA(1, 1, At, B1); PG8_BAR;
            PG8_LDB(B0, 1, 0); PG8_SCHED; PG8_LDA(At, 1, 0); PG8_STAGE(PG8_SA(0, 1), a2 + hstep, voffA);
            PG8_WAIT_L(8); PG8_BAR; PG8_WAIT_L(0); PG8_MMA(0, 0, At, B0); PG8_BAR; PG8_SCHED;
            PG8_LDB(B1, 1, 1); PG8_STAGE(PG8_SB(1, 0), b3, voffB);
            PG8_BAR; PG8_WAIT_L(0); PG8_MMA(0, 1, At, B1); PG8_BAR;
            PG8_LDA(At, 1, 1); PG8_STAGE(PG8_SA(1, 0), a3, voffA);
            PG8_BAR; PG8_WAIT_L(0); PG8_MMA(1, 0, At, B0); PG8_BAR; PG8_SCHED;
            PG8_STAGE(PG8_SB(1, 1), b3 + hstep, voffB);
            PG8_WAIT_V(6); PG8_BAR; PG8_MMA(1, 1, At, B1); PG8_BAR;
            }
        }
        if constexpr (ALIGN_EPI) { if (wr == 0) PG8_BAR; }
        if constexpr (!Epi::AFTER_DRAIN) { E(acc, cur, wr, wc, fr, fq); S.done(cur); }
        if (!has_next) break;
#pragma unroll
        for (int a = 0; a < 2; ++a)
#pragma unroll
            for (int b = 0; b < 2; ++b)
#pragma unroll
                for (int m = 0; m < 4; ++m)
#pragma unroll
                    for (int n = 0; n < 2; ++n) acc[a][b][m][n] = (f32x4){0.f, 0.f, 0.f, 0.f};
        cur = nxt; cA = nA; cB = nB; ++ui;
        if constexpr (ALIGN_EPI) { if (wr == 1) PG8_BAR; }
    }
    PG8_WAIT_V(0);
    if constexpr (!ALIGN_EPI) { if (wr == 0) PG8_BAR; }
    PG8_BAR;
    if constexpr (Epi::AFTER_DRAIN) { E.fused(acc, cur, wr, wc, fr, fq, lds, wid, lane); S.done(cur); }
#undef PG8_SA
#undef PG8_SB
#undef PG8_STAGE
#undef PG8_LDA
#undef PG8_LDB
#undef PG8_MMA
#undef PG8_WAIT_V
#undef PG8_WAIT_L
#undef PG8_BAR
#undef PG8_SCHED
}
}
namespace epi {
using pg8::f32x4; using pg8::Unit;
typedef unsigned u32x2 __attribute__((ext_vector_type(2)));
typedef unsigned u32x4 __attribute__((ext_vector_type(4)));
typedef float f32x2 __attribute__((ext_vector_type(2)));
typedef __bf16 bf16x2_t __attribute__((ext_vector_type(2)));
__device__ __forceinline__ unsigned pk(float lo, float hi) { f32x2 v = {lo, hi}; bf16x2_t b = __builtin_convertvector(v, bf16x2_t); return __builtin_bit_cast(unsigned, b); }
__device__ __forceinline__ u32x2 pk4(f32x4 v) { u32x2 w; w.x = pk(v[0], v[1]); w.y = pk(v[2], v[3]); return w; }
__device__ __forceinline__ float sum4sq(f32x4 v) { return (v[0] * v[0] + v[1] * v[1]) + (v[2] * v[2] + v[3] * v[3]); }
__device__ __forceinline__ float quad_sum(float s) { s += __shfl_xor(s, 16); s += __shfl_xor(s, 32); return s; }

__device__ __forceinline__ void st32(bf16_t* base32, f32x4 v0, f32x4 v1, int fq) {
    u32x2 a = pk4(v0), b = pk4(v1);
    { auto r = __builtin_amdgcn_permlane16_swap(a.x, b.x, false, false); a.x = r[0]; b.x = r[1]; }
    { auto r = __builtin_amdgcn_permlane16_swap(a.y, b.y, false, false); a.y = r[0]; b.y = r[1]; }
    u32x4 w; w.x = a.x; w.y = a.y; w.z = b.x; w.w = b.y;
    *(u32x4*)(base32 + 16 * (fq & 1) + 8 * (fq >> 1)) = w;
}

__device__ __forceinline__ int kvbase_of(int pm) { return pm < 64 ? (pm >> 3) * SK + CTX + (pm & 7) * 256 : (pm - 64) * SK; }
__device__ __forceinline__ int modidx_pm(int pm) { return pm < 64 ? (pm >> 3) : 8; }

__device__ __forceinline__ void head_finish(f32x4 (&v)[2][2], const float* gain, bool rope, const float* T32, int grow, int gcol, float scale, int fq) {
    float ss = (sum4sq(v[0][0]) + sum4sq(v[0][1])) + (sum4sq(v[1][0]) + sum4sq(v[1][1]));
    ss = quad_sum(ss);
    const float rn = rsqrtf(ss * (1.f / 64.f) + EPS);
#pragma unroll
    for (int bj = 0; bj < 2; ++bj)
#pragma unroll
        for (int n = 0; n < 2; ++n) { const f32x4 g = *(const f32x4*)(gain + 32 * bj + 16 * n + 4 * fq); v[bj][n] = (v[bj][n] * rn) * g; }
    if (rope) {
#pragma unroll
        for (int bj = 0; bj < 2; ++bj) { const int pos = bj ? gcol : grow;
            const f32x4 cs = *(const f32x4*)(T32 + pos * 16 + 4 * fq), sn = *(const f32x4*)(T32 + 1024 + pos * 16 + 4 * fq);
            const f32x4 x1 = v[bj][0], x2 = v[bj][1];
            v[bj][0] = x1 * cs - x2 * sn; v[bj][1] = x1 * sn + x2 * cs; }
    }
#pragma unroll
    for (int bj = 0; bj < 2; ++bj)
#pragma unroll
        for (int n = 0; n < 2; ++n) v[bj][n] = v[bj][n] * scale;
}

struct EpiIn0 {
    static constexpr bool PERM = false, AFTER_DRAIN = false;
    bf16_t *A0, *Q0, *K0, *V0; const float *qg, *kg, *T32;
    __device__ __forceinline__ void operator()(const f32x4 (&acc)[2][2][4][2], const Unit& u, int wr, int wc, int fr_in, int fq_in) const {
        int fr = fr_in, fq = fq_in; asm volatile("" : "+v"(fr), "+v"(fq));
        const int pn = u.pn, pm = u.pm; const bool lat = pm < 64; const int kvb = kvbase_of(pm);
#pragma unroll
        for (int ai = 0; ai < 2; ++ai)
#pragma unroll
            for (int m = 0; m < 4; ++m) {
                const int rl = 128 * ai + 64 * wr + 16 * m + fr; const size_t r = (size_t)pm * 256 + rl;
                if (pn == 0 || pn == 5) {
                    bf16_t* dst = pn == 0 ? A0 + r * 256 : V0 + (size_t)(kvb + rl) * 256;
#pragma unroll
                    for (int bj = 0; bj < 2; ++bj)
                        st32(dst + 64 * wc + 32 * bj, acc[ai][bj][m][0], acc[ai][bj][m][1], fq);
                } else {
                    f32x4 v[2][2] = {{acc[ai][0][m][0], acc[ai][0][m][1]}, {acc[ai][1][m][0], acc[ai][1][m][1]}};
                    const int grow = (pm & 7) * 4 + 2 * ai + wr, gcol = 16 * m + fr;
                    bf16_t* dst;
                    if (pn < 4) { head_finish(v, qg, lat, T32, grow, gcol, C2_64, fq); dst = Q0 + r * 768 + ((pn - 1) * 4 + wc) * 64; }
                    else { head_finish(v, kg, lat, T32, grow, gcol, 1.0f, fq); dst = K0 + (size_t)(kvb + rl) * 256 + wc * 64; }
#pragma unroll
                    for (int bj = 0; bj < 2; ++bj)
                        st32(dst + 32 * bj, v[bj][0], v[bj][1], fq);
                }
            }
    }
};

struct EpiResid {
    static constexpr bool PERM = false, AFTER_DRAIN = false;
    const float *base_l, *base_c; float *out_l, *out_c; const float* mod;
    __device__ __forceinline__ void operator()(const f32x4 (&acc)[2][2][4][2], const Unit& u, int wr, int wc, int fr_in, int fq_in) const {
        int fr = fr_in, fq = fq_in; asm volatile("" : "+v"(fr), "+v"(fq));
        const int pm = u.pm; const bool lat = pm < 64;
        const float* bp = lat ? base_l + (size_t)pm * 256 * D : base_c + (size_t)(pm - 64) * 256 * D;
        float* op = lat ? out_l + (size_t)pm * 256 * D : out_c + (size_t)(pm - 64) * 256 * D;
        const float* gp = mod + (size_t)modidx_pm(pm) * 6144 + u.pn * 256 + 32 * wc + 4 * fq;
        f32x4 g[2][2];
#pragma unroll
        for (int bj = 0; bj < 2; ++bj)
#pragma unroll
            for (int n = 0; n < 2; ++n) g[bj][n] = *(const f32x4*)(gp + 128 * bj + 16 * n);
#pragma unroll
        for (int ai = 0; ai < 2; ++ai)
#pragma unroll
            for (int m = 0; m < 4; ++m) { const size_t off = (size_t)(128 * ai + 64 * wr + 16 * m + fr) * D + u.pn * 256 + 32 * wc + 4 * fq;
#pragma unroll
                for (int bj = 0; bj < 2; ++bj)
#pragma unroll
                    for (int n = 0; n < 2; ++n) { const f32x4 b = *(const f32x4*)(bp + off + 128 * bj + 16 * n); *(f32x4*)(op + off + 128 * bj + 16 * n) = b + g[bj][n] * acc[ai][bj][m][n]; } }
    }
};

struct EpiResidN {
    static constexpr bool PERM = false, AFTER_DRAIN = false;
    const float* base_l; float* out_l; const float* mod;
    bf16_t* xn2; float* ssn; const float* gain; const float* modsc;
    __device__ __forceinline__ void operator()(const f32x4 (&acc)[2][2][4][2], const Unit& u, int wr, int wc, int fr_in, int fq_in) const {
        int fr = fr_in, fq = fq_in; asm volatile("" : "+v"(fr), "+v"(fq));
        const int pm = u.pm;
        const float* bp = base_l + (size_t)pm * 256 * D;
        float* op = out_l + (size_t)pm * 256 * D;
        bf16_t* xp = xn2 + (size_t)pm * 256 * D;
        const int c0 = u.pn * 256 + 32 * wc + 4 * fq;
        const float* gp = mod + (size_t)(pm >> 3) * 6144 + c0;
        const float* sp = modsc + (size_t)(pm >> 3) * 6144 + c0;
        f32x4 g[2][2], f[2][2];
#pragma unroll
        for (int bj = 0; bj < 2; ++bj)
#pragma unroll
            for (int n = 0; n < 2; ++n) { g[bj][n] = *(const f32x4*)(gp + 128 * bj + 16 * n);
                f[bj][n] = *(const f32x4*)(gain + c0 + 128 * bj + 16 * n) * (*(const f32x4*)(sp + 128 * bj + 16 * n) + 1.f); }
#pragma unroll
        for (int ai = 0; ai < 2; ++ai)
#pragma unroll
            for (int m = 0; m < 4; ++m) { const int row = 128 * ai + 64 * wr + 16 * m + fr; const size_t off = (size_t)row * D + c0;
                float ss = 0.f;
#pragma unroll
                for (int bj = 0; bj < 2; ++bj)
#pragma unroll
                    for (int n = 0; n < 2; ++n) { const f32x4 b = *(const f32x4*)(bp + off + 128 * bj + 16 * n); const f32x4 v = b + g[bj][n] * acc[ai][bj][m][n];
                        *(f32x4*)(op + off + 128 * bj + 16 * n) = v;
                        ss += (v[0] * v[0] + v[1] * v[1]) + (v[2] * v[2] + v[3] * v[3]);
                        *(u32x2*)(xp + off + 128 * bj + 16 * n) = pk4(v * f[bj][n]); }
                ss += __shfl_xor(ss, 16); ss += __shfl_xor(ss, 32);
                if (fq == 0) atomicAdd(ssn + pm * 256 + row, ss); }
    }
};

struct EpiResidSplit {
    static constexpr bool PERM = false, AFTER_DRAIN = false;
    const float* base_c; float* out_c; float* slab; const float* mod; int ks_base = 0;
    __device__ __forceinline__ void operator()(const f32x4 (&acc)[2][2][4][2], const Unit& u_in, int wr, int wc, int fr_in, int fq_in) const {
        int fr = fr_in, fq = fq_in; asm volatile("" : "+v"(fr), "+v"(fq));
        Unit u = u_in; u.ks += ks_base;
        const int pm = u.pm - 64;
        const float* bp = base_c + (size_t)pm * 256 * D;
        float* op = u.ks == 0 ? out_c + (size_t)pm * 256 * D : slab + (size_t)(u.ks - 1) * MC * D + (size_t)pm * 256 * D;
        const float* gp = mod + (size_t)8 * 6144 + u.pn * 256 + 32 * wc + 4 * fq;
        f32x4 g[2][2];
#pragma unroll
        for (int bj = 0; bj < 2; ++bj)
#pragma unroll
            for (int n = 0; n < 2; ++n) g[bj][n] = *(const f32x4*)(gp + 128 * bj + 16 * n);
#pragma unroll
        for (int ai = 0; ai < 2; ++ai)
#pragma unroll
            for (int m = 0; m < 4; ++m) { const size_t off = (size_t)(128 * ai + 64 * wr + 16 * m + fr) * D + u.pn * 256 + 32 * wc + 4 * fq;
#pragma unroll
                for (int bj = 0; bj < 2; ++bj)
#pragma unroll
                    for (int n = 0; n < 2; ++n) { f32x4 v = g[bj][n] * acc[ai][bj][m][n]; if (u.ks == 0) v += *(const f32x4*)(bp + off + 128 * bj + 16 * n); *(f32x4*)(op + off + 128 * bj + 16 * n) = v; } }
    }
};

struct EpiSwiGLU {
    static constexpr bool PERM = true, AFTER_DRAIN = false;
    bf16_t* H;
    __device__ __forceinline__ void operator()(const f32x4 (&acc)[2][2][4][2], const Unit& u, int wr, int wc, int fr_in, int fq_in) const {
        int fr = fr_in, fq = fq_in; asm volatile("" : "+v"(fr), "+v"(fq));
#pragma unroll
        for (int ai = 0; ai < 2; ++ai)
#pragma unroll
            for (int m = 0; m < 4; ++m) { const size_t r = (size_t)u.pm * 256 + 128 * ai + 64 * wr + 16 * m + fr;
                f32x4 h[2];
#pragma unroll
                for (int n = 0; n < 2; ++n) { const f32x4 g = acc[ai][0][m][n], up = acc[ai][1][m][n];
#pragma unroll
                    for (int e = 0; e < 4; ++e) h[n][e] = g[e] * __builtin_amdgcn_rcpf(1.f + __builtin_amdgcn_exp2f(-g[e] * LOG2E)) * up[e]; }
                u32x4 w; w.x = pk(h[0][0], h[0][1]); w.y = pk(h[0][2], h[0][3]); w.z = pk(h[1][0], h[1][1]); w.w = pk(h[1][2], h[1][3]);
                *(u32x4*)(H + r * FF + u.pn * 128 + 32 * wc + 8 * fq) = w; }
    }
};

struct EpiSwiGLUN {
    static constexpr bool PERM = true, AFTER_DRAIN = false;
    bf16_t* H; const float* ssn; const float* bias;
    __device__ __forceinline__ void operator()(const f32x4 (&acc)[2][2][4][2], const Unit& u, int wr, int wc, int fr_in, int fq_in) const {
        int fr = fr_in, fq = fq_in; asm volatile("" : "+v"(fr), "+v"(fq));
        const float* bp = bias + (size_t)(u.pm >> 3) * (2 * FF) + u.pn * 256 + 32 * wc + 8 * fq;
        f32x4 bg[2], bu[2];
#pragma unroll
        for (int n = 0; n < 2; ++n) { bg[n] = *(const f32x4*)(bp + 4 * n); bu[n] = *(const f32x4*)(bp + 128 + 4 * n); }
        float rr[2][4];
#pragma unroll
        for (int ai = 0; ai < 2; ++ai)
#pragma unroll
            for (int m = 0; m < 4; ++m) rr[ai][m] = ssn[u.pm * 256 + 128 * ai + 64 * wr + 16 * m + fr];
#pragma unroll
        for (int ai = 0; ai < 2; ++ai)
#pragma unroll
            for (int m = 0; m < 4; ++m) { const size_t r = (size_t)u.pm * 256 + 128 * ai + 64 * wr + 16 * m + fr;
                const float rs = rsqrtf(rr[ai][m] * (1.f / D) + EPS);
                f32x4 h[2];
#pragma unroll
                for (int n = 0; n < 2; ++n) { const f32x4 g = acc[ai][0][m][n] * rs + bg[n], up = acc[ai][1][m][n] * rs + bu[n];
#pragma unroll
                    for (int e = 0; e < 4; ++e) h[n][e] = g[e] * __builtin_amdgcn_rcpf(1.f + __builtin_amdgcn_exp2f(-g[e] * LOG2E)) * up[e]; }
                u32x4 w; w.x = pk(h[0][0], h[0][1]); w.y = pk(h[0][2], h[0][3]); w.z = pk(h[1][0], h[1][1]); w.w = pk(h[1][2], h[1][3]);
                *(u32x4*)(H + r * FF + u.pn * 128 + 32 * wc + 8 * fq) = w; }
    }
};

typedef unsigned int v4u_t __attribute__((vector_size(16)));
struct EpiSwiGLUW {
    static constexpr bool PERM = true, AFTER_DRAIN = false;
    bf16_t* H;
    __device__ __forceinline__ void operator()(const f32x4 (&acc)[2][2][4][2], const Unit& u, int wr, int wc, int fr_in, int fq_in) const {
        int fr = fr_in, fq = fq_in; asm volatile("" : "+v"(fr), "+v"(fq));
        const __amdgpu_buffer_rsrc_t rs = __builtin_amdgcn_make_buffer_rsrc((void*)(H + (size_t)ML * FF), (short)0, (int)(MC * FF * 2), 0x00020000);
#pragma unroll
        for (int ai = 0; ai < 2; ++ai)
#pragma unroll
            for (int m = 0; m < 4; ++m) { const unsigned r = (unsigned)(u.pm - 64) * 256 + 128 * ai + 64 * wr + 16 * m + fr;
                f32x4 h[2];
#pragma unroll
                for (int n = 0; n < 2; ++n) { const f32x4 g = acc[ai][0][m][n], up = acc[ai][1][m][n];
#pragma unroll
                    for (int e = 0; e < 4; ++e) h[n][e] = g[e] * __builtin_amdgcn_rcpf(1.f + __builtin_amdgcn_exp2f(-g[e] * LOG2E)) * up[e]; }
                u32x4 w; w.x = pk(h[0][0], h[0][1]); w.y = pk(h[0][2], h[0][3]); w.z = pk(h[1][0], h[1][1]); w.w = pk(h[1][2], h[1][3]);
                __builtin_amdgcn_raw_buffer_store_b128(__builtin_bit_cast(v4u_t, w), rs, (r * FF + u.pn * 128 + 32 * wc + 8 * fq) * 2u, 0,   16); }
    }
};

struct EpiIn1 {
    static constexpr bool PERM = false, AFTER_DRAIN = false;
    bf16_t *CQ, *CKV, *NQ, *NK, *NV; float *KR, *SSQ, *SSKV; const float *nqg, *nkg;
    __device__ __forceinline__ void operator()(const f32x4 (&acc)[2][2][4][2], const Unit& u, int wr, int wc, int fr_in, int fq_in) const {
        int fr = fr_in, fq = fq_in; asm volatile("" : "+v"(fr), "+v"(fq));
        const int pn = u.pn, pm = u.pm; const int kvb = kvbase_of(pm);
#pragma unroll
        for (int ai = 0; ai < 2; ++ai)
#pragma unroll
            for (int m = 0; m < 4; ++m) {
                const int rl = 128 * ai + 64 * wr + 16 * m + fr; const size_t r = (size_t)pm * 256 + rl;
                if (pn == 0 || pn == 2) {
                    bf16_t* dst = pn == 0 ? CQ + r * 384 : CKV + r * 256; float ss = 0.f;
#pragma unroll
                    for (int bj = 0; bj < 2; ++bj)
                        { ss += sum4sq(acc[ai][bj][m][0]) + sum4sq(acc[ai][bj][m][1]); st32(dst + 128 * bj + 32 * wc, acc[ai][bj][m][0], acc[ai][bj][m][1], fq); }
                    ss = quad_sum(ss);
                    if (fq == 0) atomicAdd((pn == 0 ? SSQ : SSKV) + r, ss);
                } else if (pn == 1) {
                    float ss = 0.f;
                    { ss += sum4sq(acc[ai][0][m][0]) + sum4sq(acc[ai][0][m][1]); st32(CQ + r * 384 + 256 + 32 * wc, acc[ai][0][m][0], acc[ai][0][m][1], fq); }
                    ss = quad_sum(ss);
                    if (fq == 0) atomicAdd(SSQ + r, ss);
                    if (wc == 0) {
#pragma unroll
                        for (int n = 0; n < 2; ++n) *(f32x4*)(KR + r * 32 + 16 * n + 4 * fq) = acc[ai][1][m][n]; }
                } else if (pn >= 7) {
                    bf16_t* dst = NV + (size_t)(kvb + rl) * 512 + (pn - 7) * 256 + 64 * wc;
#pragma unroll
                    for (int bj = 0; bj < 2; ++bj)
                        st32(dst + 32 * bj, acc[ai][bj][m][0], acc[ai][bj][m][1], fq);
                } else {
                    f32x4 v[2][2] = {{acc[ai][0][m][0], acc[ai][0][m][1]}, {acc[ai][1][m][0], acc[ai][1][m][1]}};
                    bf16_t* dst;
                    if (pn < 5) { head_finish(v, nqg, false, nullptr, 0, 0, C2_64, fq); dst = NQ + r * 512 + ((pn - 3) * 4 + wc) * 64; }
                    else { head_finish(v, nkg, false, nullptr, 0, 0, 1.0f, fq); dst = NK + (size_t)(kvb + rl) * 512 + ((pn - 5) * 4 + wc) * 64; }
#pragma unroll
                    for (int bj = 0; bj < 2; ++bj)
                        st32(dst + 32 * bj, v[bj][0], v[bj][1], fq);
                }
            }
    }
};

struct EpiQUp {
    static constexpr bool PERM = true, AFTER_DRAIN = false;
    bf16_t* MQ; const float* SSQ;
    __device__ __forceinline__ void operator()(const f32x4 (&acc)[2][2][4][2], const Unit& u, int wr, int wc, int fr_in, int fq_in) const {
        int fr = fr_in, fq = fq_in; asm volatile("" : "+v"(fr), "+v"(fq));
#pragma unroll
        for (int ai = 0; ai < 2; ++ai)
#pragma unroll
            for (int m = 0; m < 4; ++m) { const size_t r = (size_t)u.pm * 256 + 128 * ai + 64 * wr + 16 * m + fr;
                const float rs = rsqrtf(SSQ[r] * (1.f / 384.f) + EPS);
#pragma unroll
                for (int bj = 0; bj < 2; ++bj) { const f32x4 a = acc[ai][bj][m][0] * rs, b = acc[ai][bj][m][1] * rs;
                    u32x4 w; w.x = pk(a[0], a[1]); w.y = pk(a[2], a[3]); w.z = pk(b[0], b[1]); w.w = pk(b[2], b[3]);
                    *(u32x4*)(MQ + r * 768 + u.pn * 256 + 128 * bj + 32 * wc + 8 * fq) = w; } }
    }
};

struct EpiKvUp {
    static constexpr bool PERM = false, AFTER_DRAIN = false;
    bf16_t *MK, *MV; const float *SSKV, *KR, *kg, *T16;
    __device__ __forceinline__ void operator()(const f32x4 (&acc)[2][2][4][2], const Unit& u, int wr, int wc, int fr_in, int fq_in) const {
        int fr = fr_in, fq = fq_in; asm volatile("" : "+v"(fr), "+v"(fq));
        const int pm = u.pm; const bool lat = pm < 64; const int kvb = kvbase_of(pm); const int head = 2 * u.pn + (wc >> 1); const bool isv = wc & 1;
        float rs[2][4];
#pragma unroll
        for (int ai = 0; ai < 2; ++ai)
#pragma unroll
            for (int m = 0; m < 4; ++m) rs[ai][m] = SSKV[(size_t)pm * 256 + 128 * ai + 64 * wr + 16 * m + fr];
#pragma unroll
        for (int ai = 0; ai < 2; ++ai)
#pragma unroll
            for (int m = 0; m < 4; ++m) rs[ai][m] = rsqrtf(rs[ai][m] * (1.f / 256.f) + EPS);
        if (isv) {
#pragma unroll
            for (int ai = 0; ai < 2; ++ai)
#pragma unroll
                for (int m = 0; m < 4; ++m) { const size_t kvr = (size_t)(kvb + 128 * ai + 64 * wr + 16 * m + fr);
#pragma unroll
                    for (int bj = 0; bj < 2; ++bj)
                        st32(MV + kvr * 512 + head * 64 + 32 * bj, acc[ai][bj][m][0] * rs[ai][m], acc[ai][bj][m][1] * rs[ai][m], fq); }
            return;
        }
        f32x4 gn[2][2]; f32x2 gr[4];
#pragma unroll
        for (int bj = 0; bj < 2; ++bj)
#pragma unroll
            for (int n = 0; n < 2; ++n) gn[bj][n] = *(const f32x4*)(kg + 32 * bj + 16 * n + 4 * fq);
#pragma unroll
        for (int j = 0; j < 4; ++j) gr[j] = *(const f32x2*)(kg + 64 + 8 * j + 2 * fq);
#pragma unroll
        for (int ai = 0; ai < 2; ++ai) {
            const int grow = (pm & 7) * 4 + 2 * ai + wr;
            f32x2 csr = {1.f, 1.f}, snr = {0.f, 0.f};
            if (lat) { csr = *(const f32x2*)(T16 + grow * 8 + 2 * fq); snr = *(const f32x2*)(T16 + 512 + grow * 8 + 2 * fq); }
#pragma unroll
            for (int m = 0; m < 4; ++m) {
                const int rl = 128 * ai + 64 * wr + 16 * m + fr; const size_t r = (size_t)pm * 256 + rl; const size_t kvr = (size_t)(kvb + rl);
                f32x2 k[4];
#pragma unroll
                for (int j = 0; j < 4; ++j) k[j] = *(const f32x2*)(KR + r * 32 + 8 * j + 2 * fq);
                f32x2 csc = {1.f, 1.f}, snc = {0.f, 0.f};
                if (lat) { const int gcol = 16 * m + fr; csc = *(const f32x2*)(T16 + gcol * 8 + 2 * fq); snc = *(const f32x2*)(T16 + 512 + gcol * 8 + 2 * fq); }
                f32x4 v[2][2];
#pragma unroll
                for (int bj = 0; bj < 2; ++bj)
#pragma unroll
                    for (int n = 0; n < 2; ++n) v[bj][n] = acc[ai][bj][m][n] * rs[ai][m];
                float ss = (sum4sq(v[0][0]) + sum4sq(v[0][1])) + (sum4sq(v[1][0]) + sum4sq(v[1][1]));
#pragma unroll
                for (int j = 0; j < 4; ++j) ss += k[j][0] * k[j][0] + k[j][1] * k[j][1];
                ss = quad_sum(ss);
                const float rr = rsqrtf(ss * (1.f / 96.f) + EPS);
#pragma unroll
                for (int bj = 0; bj < 2; ++bj)
                    st32(MK + kvr * 768 + head * 96 + 32 * bj, (v[bj][0] * rr) * gn[bj][0], (v[bj][1] * rr) * gn[bj][1], fq);
#pragma unroll
                for (int j = 0; j < 4; ++j) k[j] = (k[j] * rr) * gr[j];
                { const f32x2 x1 = k[0], x2 = k[1]; k[0] = x1 * csr - x2 * snr; k[1] = x1 * snr + x2 * csr; }
                { const f32x2 x1 = k[2], x2 = k[3]; k[2] = x1 * csc - x2 * snc; k[3] = x1 * snc + x2 * csc; }
#pragma unroll
                for (int j = 0; j < 4; ++j) *(unsigned*)(MK + kvr * 768 + head * 96 + 64 + 8 * j + 2 * fq) = pk(k[j][0], k[j][1]);
                if (m & 1) asm volatile("" ::: "memory");
            }
        }
    }
};
}
namespace att {
using bf16x8 = __attribute__((ext_vector_type(8))) short;
using s16x4 = __attribute__((ext_vector_type(4))) short;
using f32x16 = __attribute__((ext_vector_type(16))) float;
using u32x4 = __attribute__((ext_vector_type(4))) unsigned;
typedef float f32x2_t __attribute__((ext_vector_type(2))); typedef __bf16 bf16x2_t __attribute__((ext_vector_type(2)));
#define ALAS __attribute__((address_space(3)))
constexpr int KSLOT = 12288, VSLOT = 8192, SLOT = KSLOT + VSLOT, NSLOT = 4, PD = NSLOT - 2;
constexpr int LDS_WS = NSLOT * SLOT;
constexpr int LDS_OST = LDS_WS + 8 * 256;
constexpr int LDS_RPB = LDS_OST + 8 * 4096;
constexpr int LDS_BYTES = LDS_RPB + 4096;
constexpr float THR = 8.0f;

__device__ __forceinline__ int crow(int r, int hi) { return (r & 3) + 8 * (r >> 2) + 4 * hi; }
__device__ __forceinline__ void glds16(const void* gsrc, unsigned lds_dst) { unsigned keep;
    asm volatile("s_mov_b32 %0, m0\n\ts_mov_b32 m0, %2\n\ts_nop 0\n\tglobal_load_lds_dwordx4 %1, off\n\ts_mov_b32 m0, %0" : "=&s"(keep) : "v"(gsrc), "s"(lds_dst) : "memory"); }
__device__ __forceinline__ unsigned cvtpk(float lo, float hi) { f32x2_t v = {lo, hi}; bf16x2_t b = __builtin_convertvector(v, bf16x2_t); return __builtin_bit_cast(unsigned, b); }
__device__ __forceinline__ void glds16s(unsigned voff, const void* sbase, unsigned lds_dst) { unsigned keep;
    asm volatile("s_mov_b32 %0, m0\n\ts_mov_b32 m0, %3\n\ts_nop 0\n\tglobal_load_lds_dwordx4 %1, %2\n\ts_mov_b32 m0, %0" : "=&s"(keep) : "v"(voff), "s"(sbase), "s"(lds_dst) : "memory"); }
__device__ __forceinline__ float max3f(float a, float b, float c) { float r; asm("v_max3_f32 %0, %1, %2, %3" : "=v"(r) : "v"(a), "v"(b), "v"(c)); return r; }
__device__ __forceinline__ float max2f(float a, float b) { float r; asm("v_max_f32_e32 %0, %1, %2" : "=v"(r) : "v"(a), "v"(b)); return r; }
#define AWAIT_BAR(N) asm volatile("s_waitcnt vmcnt(" #N ") lgkmcnt(0)\n\ts_barrier" ::: "memory")

template <int ND0> __device__ __forceinline__ void qkt(f32x16& p0, f32x16& p1, const ALAS char* Kslot, const bf16x8* qr, const f32x16& negm, int r32, int hi) {
    const ALAS char* kb = Kslot + hi * 1024 + r32 * 16;
#pragma unroll
    for (int d0 = 0; d0 < ND0; ++d0) {
        const bf16x8 b0 = *(const ALAS bf16x8*)(kb + d0 * 2048);
        const bf16x8 b1 = *(const ALAS bf16x8*)(kb + d0 * 2048 + 512);
        if (d0 == 0) { p0 = __builtin_amdgcn_mfma_f32_32x32x16_bf16(b0, qr[0], negm, 0, 0, 0); p1 = __builtin_amdgcn_mfma_f32_32x32x16_bf16(b1, qr[0], negm, 0, 0, 0); }
        else { p0 = __builtin_amdgcn_mfma_f32_32x32x16_bf16(b0, qr[d0], p0, 0, 0, 0); p1 = __builtin_amdgcn_mfma_f32_32x32x16_bf16(b1, qr[d0], p1, 0, 0, 0); }
    }
}
__device__ __forceinline__ float rowmax32(const f32x16& p0, const f32x16& p1) {
    float a[4];
#pragma unroll
    for (int k = 0; k < 4; ++k) { a[k] = max3f(p0[4 * k], p0[4 * k + 1], p0[4 * k + 2]); }
#pragma unroll
    for (int k = 0; k < 4; ++k) { a[k] = max3f(a[k], p0[4 * k + 3], p1[4 * k]); }
#pragma unroll
    for (int k = 0; k < 4; ++k) { a[k] = max3f(a[k], p1[4 * k + 1], p1[4 * k + 2]); }
    const float m = max3f(max3f(a[0], p1[3], p1[7]), max3f(a[1], p1[11], p1[15]), max2f(a[2], a[3]));
    auto rr = __builtin_amdgcn_permlane32_swap(__float_as_uint(m), __float_as_uint(m), false, false);
    return max2f(__uint_as_float(rr[0]), __uint_as_float(rr[1]));
}
typedef short v4i16_t __attribute__((ext_vector_type(4)));
__device__ __forceinline__ s16x4 vtr(const ALAS char* p) { return __builtin_bit_cast(s16x4, __builtin_amdgcn_ds_read_tr16_b64_v4i16((ALAS v4i16_t*)p)); }
__device__ __forceinline__ void pv(f32x16* o, const ALAS char* vp, bf16x8 pa0, bf16x8 pa1, bf16x8 pa2, bf16x8 pa3) {
#pragma unroll
    for (int d0 = 0; d0 < 2; ++d0) { s16x4 lo[4], hi[4];
#pragma unroll
        for (int ks = 0; ks < 4; ++ks) { lo[ks] = vtr(vp + d0 * 4096 + ks * 1024); hi[ks] = vtr(vp + d0 * 4096 + ks * 1024 + 512); }
#define APK(k) (bf16x8){lo[k][0], lo[k][1], lo[k][2], lo[k][3], hi[k][0], hi[k][1], hi[k][2], hi[k][3]}
        o[d0] = __builtin_amdgcn_mfma_f32_32x32x16_bf16(pa0, APK(0), o[d0], 0, 0, 0);
        o[d0] = __builtin_amdgcn_mfma_f32_32x32x16_bf16(pa1, APK(1), o[d0], 0, 0, 0);
        o[d0] = __builtin_amdgcn_mfma_f32_32x32x16_bf16(pa2, APK(2), o[d0], 0, 0, 0);
        o[d0] = __builtin_amdgcn_mfma_f32_32x32x16_bf16(pa3, APK(3), o[d0], 0, 0, 0);
#undef APK
    }
}

struct UnitDesc {
    const bf16_t* Q; int qpitch;
    long q0; int qcol;
    const bf16_t* K; int kpitch, kcol;
    const bf16_t* V; int vpitch, vcol;
    bf16_t* O; int opitch, ocol;
    int kv0;
    int nt;
    int rg;
    int rmin;
    int head;
    const bf16_t* G;
};

template <int DQK, bool NA, bool MLAQ>
__device__ __forceinline__ void attn_unit(const UnitDesc& U, ALAS char* shm, const float* qgain, const float* T16, const float* rpb_g) {
    constexpr int ND0 = DQK / 16, NCH = DQK / 8, NP = NCH + 8;
    int tid_ = threadIdx.x; asm volatile("" : "+v"(tid_));
    const int tid = tid_, lane = tid & 63, r32 = lane & 31, hi = lane >> 5; const int wid = __builtin_amdgcn_readfirstlane(tid >> 6);
#ifdef ATT_STATIC_PRIO_NA
    if (wid >= 4) __builtin_amdgcn_s_setprio(1);
#endif
    const unsigned lds0 = (unsigned)(uintptr_t)shm;
    ALAS float* wsf = (ALAS float*)(shm + LDS_WS) + wid * 64;
    unsigned doff[3];
#pragma unroll
    for (int i = 0; i < 3; ++i) { const int pc = wid + 8 * i;
        if (pc < NCH) doff[i] = (unsigned)((lane * U.kpitch + U.kcol + pc * 8) * 2);
        else { const int v = pc - NCH; doff[i] = (unsigned)(((16 * (v & 3) + (lane >> 2)) * U.vpitch + U.vcol + (v >> 2) * 32 + (lane & 3) * 8) * 2); } }
    auto dma_tile = [&](int t, int slot) {
        int key0;
        if (NA && t >= 4) key0 = U.kv0 + CTX + (U.rmin + (t - 4)) * GW; else key0 = U.kv0 + 64 * t;
        const unsigned sbase = lds0 + slot * SLOT;
        const bf16_t* kb_ = U.K + (size_t)key0 * U.kpitch; const bf16_t* vb_ = U.V + (size_t)key0 * U.vpitch;
#pragma unroll
        for (int i = 0; i < 3; ++i) { const int pc = wid + 8 * i;
            if (pc < NP) {
                if (pc < NCH) glds16s(doff[i], kb_, (unsigned)__builtin_amdgcn_readfirstlane(sbase + pc * 1024));
                else glds16s(doff[i], vb_, (unsigned)__builtin_amdgcn_readfirstlane(sbase + KSLOT + (pc - NCH) * 1024));
#ifdef ATT_DUP_DMA
                if (pc < NCH) glds16s(doff[i], kb_, (unsigned)__builtin_amdgcn_readfirstlane(sbase + pc * 1024));
                else glds16s(doff[i], vb_, (unsigned)__builtin_amdgcn_readfirstlane(sbase + KSLOT + (pc - NCH) * 1024));
#endif
            } }
    };
    asm volatile("s_waitcnt vmcnt(0)" ::: "memory");
#pragma unroll
    for (int t0_ = 0; t0_ < PD; ++t0_) if (t0_ < U.nt) dma_tile(t0_, t0_);
    bf16x8 qr[ND0];
    const bf16_t* Qw = U.Q + (size_t)(U.q0 + wid * 32 + r32) * U.qpitch + U.qcol;
#pragma unroll
    for (int d0 = 0; d0 < ND0; ++d0) qr[d0] = *(const bf16x8*)(Qw + d0 * 16 + hi * 8);
    if (MLAQ) {
        float f[ND0][8]; float ss = 0.f;
#pragma unroll
        for (int d0 = 0; d0 < ND0; ++d0)
#pragma unroll
            for (int j = 0; j < 8; ++j) { f[d0][j] = bf2f((bf16_t)qr[d0][j]); ss += f[d0][j] * f[d0][j]; }
        ss += __shfl_xor(ss, 32);
        const float rn = rsqrtf(ss * (1.f / 96.f) + EPS) * C2_96;
#pragma unroll
        for (int d0 = 0; d0 < ND0; ++d0)
#pragma unroll
            for (int j = 0; j < 8; ++j) f[d0][j] = f[d0][j] * rn * qgain[d0 * 16 + hi * 8 + j];
        const int t = (int)((U.q0 + wid * 32 + r32) % S); const int grow = t / GW, gcol = t % GW;
#pragma unroll
        for (int part = 0; part < 2; ++part) { const int pos = part ? gcol : grow;
#pragma unroll
            for (int j = 0; j < 8; ++j) { const float cs = T16[pos * 8 + j], sn = T16[512 + pos * 8 + j];
                const float mine = f[4 + part][j], other = __shfl_xor(mine, 32);
                f[4 + part][j] = hi == 0 ? (mine * cs - other * sn) : (other * sn + mine * cs); } }
#pragma unroll
        for (int d0 = 0; d0 < ND0; ++d0)
#pragma unroll
            for (int j = 0; j < 4; ++j) { const unsigned w = cvtpk(f[d0][2 * j], f[d0][2 * j + 1]); qr[d0][2 * j] = (short)(w & 0xffff); qr[d0][2 * j + 1] = (short)(w >> 16); }
    }
    const int grow_w = NA ? 4 * U.rg + (wid >> 1) : 0, c0w = 32 * (wid & 1);
    const int r0w = NA ? min(max(grow_w - 4, 0), 24) : 0;
    const int qc = c0w + r32;
    const int cs_q = min(max(qc - 8, 0), 48);
    float mhat = 0.f, l_reg = 0.f; f32x16 o[2]; o[0] = f32x16{}; o[1] = f32x16{};
    const ALAS char* vp0 = shm + KSLOT + ((lane >> 4) & 1) * 32 + (lane & 3) * 8 + (4 * hi + ((lane & 15) >> 2)) * 64;
    const int NT = U.nt;
    f32x16 a0, a1, b0, b1;
    u32x4 pw0, pw1, pw2, pw3;
    auto wait_tile = [&](int t) {
        const int ahead = min(PD - 1, NT - 1 - t);
        const bool big = (NP == 20 && wid < 4);
#ifdef ATT_DUP_DMA
        if (ahead >= 1) { if (big) AWAIT_BAR(6); else AWAIT_BAR(4); }
        else AWAIT_BAR(0);
#else
        if (ahead >= 2) { if (big) AWAIT_BAR(6); else AWAIT_BAR(4); }
        else if (ahead == 1) { if (big) AWAIT_BAR(3); else AWAIT_BAR(2); }
        else AWAIT_BAR(0);
#endif
        if (t + PD < NT) dma_tile(t + PD, (t + PD) % NSLOT);
    };
    bf16x8 eq[2];
    if (NA) {
#pragma unroll
        for (int s_ = 0; s_ < 2; ++s_)
#pragma unroll
            for (int jj = 0; jj < 8; ++jj) eq[s_][jj] = (16 * s_ + 8 * hi + jj == r32) ? (short)0x3f80 : (short)0;
    }
    const bf16_t* gq = NA ? U.G + (size_t)U.head * (16 * 2 * 64 * 32) + (size_t)(wid & 1) * (64 * 32) + r32 * 32 + hi * 8 : nullptr;
    auto gbias_load = [&](bf16x8 (&f)[4], int t) {
        const int krow = U.rmin + (t - 4); int dr = krow - grow_w + 7; if (krow < r0w || krow >= r0w + 8) dr = 15;
        const bf16_t* g = gq + (size_t)dr * (2 * 64 * 32);
#pragma unroll
        for (int half = 0; half < 2; ++half)
#pragma unroll
            for (int s_ = 0; s_ < 2; ++s_) f[2 * s_ + half] = *(const bf16x8*)(g + half * 1024 + s_ * 16);
    };
    auto gbias_mma = [&](f32x16& c0, f32x16& c1, const bf16x8 (&f)[4]) {
        c0 = __builtin_amdgcn_mfma_f32_32x32x16_bf16(f[0], eq[0], c0, 0, 0, 0); c1 = __builtin_amdgcn_mfma_f32_32x32x16_bf16(f[1], eq[0], c1, 0, 0, 0);
        c0 = __builtin_amdgcn_mfma_f32_32x32x16_bf16(f[2], eq[1], c0, 0, 0, 0); c1 = __builtin_amdgcn_mfma_f32_32x32x16_bf16(f[3], eq[1], c1, 0, 0, 0);
    };
    constexpr bool NEGM = true;
    f32x16 negm = f32x16{};
    auto decide = [&](f32x16& c0, f32x16& c1, bool first) -> bool {
        const float rm = rowmax32(c0, c1);
        if (first || __any(rm > THR)) {
            const float dl = first ? rm : fmaxf(rm, 0.f);
            mhat += dl;
#pragma unroll
            for (int r = 0; r < 16; ++r) { c0[r] -= dl; c1[r] -= dl; }
#pragma unroll
            for (int r = 0; r < 16; ++r) negm[r] = -mhat;
            if (!first) { const float f = __builtin_amdgcn_exp2f(-dl); l_reg *= f; if (hi == 0) wsf[r32] = f; return true; }
        }
        return false;
    };
    auto rescale_o = [&]() {
        asm volatile("s_waitcnt lgkmcnt(0)" ::: "memory");
#pragma unroll
        for (int r = 0; r < 16; ++r) { const float fr_ = wsf[crow(r, hi)]; o[0][r] *= fr_; o[1][r] *= fr_; }
    };
    auto expo = [&](f32x16& c0, f32x16& c1) {
#pragma unroll
        for (int r = 0; r < 16; ++r) { c0[r] = __builtin_amdgcn_exp2f(c0[r]); c1[r] = __builtin_amdgcn_exp2f(c1[r]); }
    };
    auto sumpack = [&](const f32x16& c0, const f32x16& c1) {
        float s4[4];
#pragma unroll
        for (int k = 0; k < 4; ++k) s4[k] = c0[k] + c1[k];
#pragma unroll
        for (int r = 4; r < 16; ++r) s4[r & 3] += c0[r] + c1[r];
        l_reg += (s4[0] + s4[1]) + (s4[2] + s4[3]);
#pragma unroll
        for (int j = 0; j < 4; ++j) { pw0[j] = cvtpk(c0[2 * j], c0[2 * j + 1]); pw1[j] = cvtpk(c0[8 + 2 * j], c0[9 + 2 * j]); pw2[j] = cvtpk(c1[2 * j], c1[2 * j + 1]); pw3[j] = cvtpk(c1[8 + 2 * j], c1[9 + 2 * j]); }
    };
    auto step = [&](f32x16& c0, f32x16& c1, f32x16& q0, f32x16& q1, int j) {
        wait_tile(j);
        bf16x8 gf[4];
        if (NA && j >= 4) gbias_load(gf, j);
        qkt<ND0>(c0, c1, shm + (j % NSLOT) * SLOT, qr, negm, r32, hi);
        if (NA && j >= 4) gbias_mma(c0, c1, gf);
        sumpack(q0, q1);
        const bool resc = decide(c0, c1, false);
        pv(o, vp0 + ((j - 1) % NSLOT) * SLOT, __builtin_bit_cast(bf16x8, pw0), __builtin_bit_cast(bf16x8, pw1), __builtin_bit_cast(bf16x8, pw2), __builtin_bit_cast(bf16x8, pw3));
        expo(c0, c1);
        if (resc) rescale_o();
    };
    wait_tile(0);
    qkt<ND0>(a0, a1, shm, qr, negm, r32, hi);
    (void)decide(a0, a1, true);
    expo(a0, a1);
    int j = 1;
#pragma unroll 1
    for (; j + 1 < NT; j += 2) { step(b0, b1, a0, a1, j); step(a0, a1, b0, b1, j + 1); }
    if (j < NT) { step(b0, b1, a0, a1, j); sumpack(b0, b1); } else sumpack(a0, a1);
    pv(o, vp0 + ((NT - 1) % NSLOT) * SLOT, __builtin_bit_cast(bf16x8, pw0), __builtin_bit_cast(bf16x8, pw1), __builtin_bit_cast(bf16x8, pw2), __builtin_bit_cast(bf16x8, pw3));
    { auto rr = __builtin_amdgcn_permlane32_swap(__float_as_uint(l_reg), __float_as_uint(l_reg), false, false); l_reg = __uint_as_float(rr[0]) + __uint_as_float(rr[1]); }
    if (hi == 0) wsf[32 + r32] = l_reg;
    asm volatile("s_waitcnt lgkmcnt(0)" ::: "memory");
    float rli[16];
#pragma unroll
    for (int r = 0; r < 16; ++r) rli[r] = __builtin_amdgcn_rcpf(wsf[32 + crow(r, hi)]);
    bf16_t* Ow = U.O + (size_t)(U.q0 + wid * 32) * U.opitch + U.ocol;
    { ALAS bf16_t* stg = (ALAS bf16_t*)(shm + LDS_OST) + wid * 2048;
#pragma unroll
        for (int r = 0; r < 16; ++r) { const int orow = crow(r, hi);
#pragma unroll
            for (int d0 = 0; d0 < 2; ++d0) stg[orow * 64 + d0 * 32 + r32] = f2bf(o[d0][r] * rli[r]); }
        asm volatile("s_waitcnt lgkmcnt(0)" ::: "memory");
#pragma unroll
        for (int i = 0; i < 4; ++i) { const int row = i * 8 + (lane >> 3), ch = lane & 7; const u32x4 v = *(const ALAS u32x4*)(stg + row * 64 + ch * 8); *(u32x4*)(Ow + (size_t)row * U.opitch + ch * 8) = v; } }
#ifdef ATT_STATIC_PRIO_NA
    __builtin_amdgcn_s_setprio(0);
#endif
    asm volatile("s_waitcnt vmcnt(0) lgkmcnt(0)\n\ts_barrier" ::: "memory");
}
}
#include <hip/hip_bf16.h>
namespace att64 {
using bf16=__hip_bfloat16;
using bf16x8=__attribute__((ext_vector_type(8)))short;
using s16x4=__attribute__((ext_vector_type(4)))short;
using f32x16=__attribute__((ext_vector_type(16)))float;
using u32x4=__attribute__((ext_vector_type(4)))unsigned;
constexpr int D=64;
constexpr int NW=8,QBLK=32,QB=QBLK*NW,KVBLK=64;

__device__ __forceinline__ int crow(int r,int hi){return (r&3)+8*(r>>2)+4*hi;}
#define SBAR() __builtin_amdgcn_sched_barrier(0)
__device__ __forceinline__ void cmask(f32x16&p0,f32x16&p1,int jb,int qrel,int hi){
  const float NEG=-INFINITY; int kb=64*jb+4*hi;
  #pragma unroll
  for(int r=0;r<16;++r){int kv=kb+(r&3)+8*(r>>2); if(kv>qrel)p0[r]=NEG; if(kv+32>qrel)p1[r]=NEG;}
}

constexpr int NSLOT=3, SLOTB=8192;
constexpr int LDS_K=0, LDS_V=NSLOT*SLOTB, LDS_WS=2*NSLOT*SLOTB, LDS_OST=LDS_WS+NW*64*4, LDS_BYTES=LDS_OST+NW*4096;
constexpr float C2=0.125f*1.4426950408889634f;
__device__ __forceinline__ void glds16(const void*gsrc,unsigned lds_dst){unsigned keep;
  asm volatile("s_mov_b32 %0, m0\n\ts_mov_b32 m0, %2\n\ts_nop 0\n\tglobal_load_lds_dwordx4 %1, off\n\ts_mov_b32 m0, %0":"=&s"(keep):"v"(gsrc),"s"(lds_dst):"memory");}
__device__ __forceinline__ float max3f(float a,float b,float c){float r;asm("v_max3_f32 %0, %1, %2, %3":"=v"(r):"v"(a),"v"(b),"v"(c));return r;}
__device__ __forceinline__ float max2f(float a,float b){float r;asm("v_max_f32_e32 %0, %1, %2":"=v"(r):"v"(a),"v"(b));return r;}
__device__ __forceinline__ float fadd_s(float a,float b){float r;asm("v_add_f32_e32 %0, %1, %2":"=v"(r):"v"(a),"v"(b));return r;}
__device__ __forceinline__ float fsub_s(float a,float b){float r;asm("v_sub_f32_e32 %0, %1, %2":"=v"(r):"v"(a),"v"(b));return r;}
typedef float f32x2_t __attribute__((ext_vector_type(2))); typedef __bf16 bf16x2_t __attribute__((ext_vector_type(2)));
__device__ __forceinline__ unsigned cvtpk_s(float lo,float hi){f32x2_t v={lo,hi};bf16x2_t b=__builtin_convertvector(v,bf16x2_t);return __builtin_bit_cast(unsigned,b);}
#define WAIT_BAR(N) asm volatile("s_waitcnt vmcnt(" #N ") lgkmcnt(0)\n\ts_barrier":::"memory")

__device__ __forceinline__ void qkt(f32x16&p0,f32x16&p1,const char*Kslot,const bf16x8*qr,const f32x16&negm,int r32,int hi){
  const char*kb=Kslot+hi*1024+r32*16;
  #pragma unroll
  for(int d0=0;d0<4;++d0){
    const bf16x8 b0=*reinterpret_cast<const bf16x8*>(kb+d0*2048);
    const bf16x8 b1=*reinterpret_cast<const bf16x8*>(kb+d0*2048+512);
    if(d0==0){p0=__builtin_amdgcn_mfma_f32_32x32x16_bf16(b0,qr[0],negm,0,0,0);p1=__builtin_amdgcn_mfma_f32_32x32x16_bf16(b1,qr[0],negm,0,0,0);}
    else{p0=__builtin_amdgcn_mfma_f32_32x32x16_bf16(b0,qr[d0],p0,0,0,0);p1=__builtin_amdgcn_mfma_f32_32x32x16_bf16(b1,qr[d0],p1,0,0,0);}}
}
typedef __attribute__((address_space(3))) const char* lds_cptr;
typedef short v4i16_t __attribute__((ext_vector_type(4)));
__device__ __forceinline__ void kload8(bf16x8*kf,lds_cptr kp){
  kf[0]=*(const __attribute__((address_space(3))) bf16x8*)(kp);      kf[1]=*(const __attribute__((address_space(3))) bf16x8*)(kp+512);
  kf[2]=*(const __attribute__((address_space(3))) bf16x8*)(kp+2048); kf[3]=*(const __attribute__((address_space(3))) bf16x8*)(kp+2560);
  kf[4]=*(const __attribute__((address_space(3))) bf16x8*)(kp+4096); kf[5]=*(const __attribute__((address_space(3))) bf16x8*)(kp+4608);
  kf[6]=*(const __attribute__((address_space(3))) bf16x8*)(kp+6144); kf[7]=*(const __attribute__((address_space(3))) bf16x8*)(kp+6656);
}
__device__ __forceinline__ void kload2(bf16x8*kf,lds_cptr kp,int j){ kf[2*j]=*(const __attribute__((address_space(3))) bf16x8*)(kp+j*2048); kf[2*j+1]=*(const __attribute__((address_space(3))) bf16x8*)(kp+j*2048+512); }
__device__ __forceinline__ s16x4 vtr(lds_cptr p){ return __builtin_bit_cast(s16x4,__builtin_amdgcn_ds_read_tr16_b64_v4i16((__attribute__((address_space(3))) v4i16_t*)p)); }
__device__ __forceinline__ float rowmax(const f32x16&p0,const f32x16&p1){
  float a=max3f(p0[0],p0[1],p1[0]),b=max3f(p0[2],p0[3],p1[1]);a=max3f(a,p1[2],p1[3]);
  #pragma unroll
  for(int r=4;r<16;r+=4){a=max3f(a,p0[r],p0[r+1]);b=max3f(b,p0[r+2],p0[r+3]);a=max3f(a,p1[r],p1[r+1]);b=max3f(b,p1[r+2],p1[r+3]);}
  const float m=max2f(a,b);
  auto rr=__builtin_amdgcn_permlane32_swap(__float_as_uint(m),__float_as_uint(m),false,false);
  return max2f(__uint_as_float(rr[0]),__uint_as_float(rr[1]));
}
__device__ __forceinline__ void pv(f32x16*o,int vb,bf16x8 pa0,bf16x8 pa1,bf16x8 pa2,bf16x8 pa3){
  #pragma unroll
  for(int d0=0;d0<2;++d0){s16x4 lo[4],hi[4];
    #pragma unroll
    for(int ks=0;ks<4;++ks){
      asm volatile("ds_read_b64_tr_b16 %0,%1 offset:%c2":"=&v"(lo[ks]):"v"(vb),"i"(d0*4096+ks*1024):"memory");
      asm volatile("ds_read_b64_tr_b16 %0,%1 offset:%c2":"=&v"(hi[ks]):"v"(vb),"i"(d0*4096+ks*1024+512):"memory");}
    asm volatile("s_waitcnt lgkmcnt(0)":::"memory");SBAR();
    #define PK(k) (bf16x8){lo[k][0],lo[k][1],lo[k][2],lo[k][3],hi[k][0],hi[k][1],hi[k][2],hi[k][3]}
    o[d0]=__builtin_amdgcn_mfma_f32_32x32x16_bf16(pa0,PK(0),o[d0],0,0,0);
    o[d0]=__builtin_amdgcn_mfma_f32_32x32x16_bf16(pa1,PK(1),o[d0],0,0,0);
    o[d0]=__builtin_amdgcn_mfma_f32_32x32x16_bf16(pa2,PK(2),o[d0],0,0,0);
    o[d0]=__builtin_amdgcn_mfma_f32_32x32x16_bf16(pa3,PK(3),o[d0],0,0,0);
    #undef PK
  }
}

#ifndef ATTN_STORE16
#define ATTN_STORE16(p,v) (*(u32x4*)(p)=(v))
#endif
template<int THRL> __device__ __forceinline__ void attn_unit(long q0,const bf16*Q,int qp,int qcol,const bf16*__restrict__ K,int kp,int kcol,const bf16*__restrict__ V,int vp,int vcol,long kv0,int NT,bf16*O,int op,int ocol,char*shm){
  int tid_=threadIdx.x; asm volatile("":"+v"(tid_));
  const int tid=tid_,lane=tid&63,r32=lane&31,hi=lane>>5; const int wid=__builtin_amdgcn_readfirstlane(tid>>6);
#ifdef ATT_STATIC_PRIO
  if(wid>=4)__builtin_amdgcn_s_setprio(1);
#endif
  const bf16*Qw=Q+(q0+wid*QBLK)*qp+qcol;
  const bf16*Kh=K+kv0*kp+kcol,*Vh=V+kv0*vp+vcol;
  const unsigned lds0=(unsigned)(uintptr_t)shm;
  float*wsf=(float*)(shm+LDS_WS)+wid*64;
  const bf16*ksrc=Kh+(long)lane*kp+wid*8;
  const bf16*vsrc=Vh+(long)(16*(wid&3)+(lane>>2))*vp+(wid>>2)*32+(lane&3)*8;
  const unsigned kdst=lds0+LDS_K+wid*1024, vdst=lds0+LDS_V+wid*1024;
  #define DMA_K(t,slot) glds16(ksrc+(long)(t)*KVBLK*kp,(unsigned)__builtin_amdgcn_readfirstlane(kdst+(slot)))
  #define DMA_V(t,slot) glds16(vsrc+(long)(t)*KVBLK*vp,(unsigned)__builtin_amdgcn_readfirstlane(vdst+(slot)))
  const int vb0=(int)(lds0+LDS_V)+((lane>>4)&1)*32+(lane&3)*8+(4*hi+((lane&15)>>2))*64;
  const char*Kbase=shm+LDS_K; bf16x8 kf[8];
  const lds_cptr shm3=(lds_cptr)shm; const lds_cptr kp0=shm3+LDS_K+hi*1024+r32*16; const lds_cptr vp0=shm3+LDS_V+((lane>>4)&1)*32+(lane&3)*8+(4*hi+((lane&15)>>2))*64;
  DMA_K(0,0);DMA_V(0,0);DMA_K(1,SLOTB);
  bf16x8 qr[4];
  #pragma unroll
  for(int d0=0;d0<4;++d0)qr[d0]=*reinterpret_cast<const bf16x8*>(&Qw[(long)r32*qp+d0*16+hi*8]);
  float mhat=0.f,l_reg=0.f;f32x16 o[2];o[0]=f32x16{};o[1]=f32x16{};f32x16 negm=f32x16{};asm volatile("":"+v"(negm));
  #define CMASK(P0,P1,t) do{}while(0)
  bool resc=false;
  #define START(P0,P1) do{ const float rm=rowmax(P0,P1); resc=false; \
    { const float dl=rm; mhat=fadd_s(mhat,dl); \
      _Pragma("unroll") for(int r=0;r<16;++r){P0[r]=fsub_s(P0[r],dl);P1[r]=fsub_s(P1[r],dl);} \
      _Pragma("unroll") for(int r=0;r<16;++r)negm[r]=-mhat; asm volatile("":"+v"(negm)); } \
    _Pragma("unroll") for(int r=0;r<16;++r)P0[r]=__builtin_amdgcn_exp2f(P0[r]); }while(0)
  #define RESC() do{ if(resc){ asm volatile("s_waitcnt lgkmcnt(0)":::"memory"); \
      _Pragma("unroll") for(int d_=0;d_<2;++d_) _Pragma("unroll") for(int r=0;r<16;++r)o[d_][r]*=wsf[crow(r,hi)]; } }while(0)
  f32x16 pA0,pA1,pB0,pB1;
  int sl_prev=0,sl_cur=0,sl_next=SLOTB;
  #define ROT() do{sl_prev=sl_cur;sl_cur=sl_next;sl_next=(sl_next==(NSLOT-1)*SLOTB)?0:sl_next+SLOTB;}while(0)
  DMA_K(2,2*SLOTB);
  WAIT_BAR(3);
  qkt(pA0,pA1,Kbase,qr,negm,r32,hi);asm volatile("s_nop 15\n\ts_nop 7":"+v"(pA0),"+v"(pA1));CMASK(pA0,pA1,0);
  START(pA0,pA1);
  _Pragma("unroll") for(int r=0;r<16;++r)pA1[r]=__builtin_amdgcn_exp2f(pA1[r]);
  WAIT_BAR(0);
  DMA_K(3,0);DMA_V(1,SLOTB);
  ROT();
  kload8(kf,kp0+sl_cur);
  WAIT_BAR(2);
  s16x4 vlo[8],vhi[8]; u32x4 pw0,pw1,pw2,pw3;
  #define PKW(P,B) cvtpk_s(P[B],P[B+1])
  #define PAF(k) __builtin_bit_cast(bf16x8,pw##k)
  #define VFR(i) (bf16x8){vlo[i][0],vlo[i][1],vlo[i][2],vlo[i][3],vhi[i][0],vhi[i][1],vhi[i][2],vhi[i][3]}
  #define PIN(x) asm volatile("":"+v"(x))
  #define MX3(a,b,c) __builtin_fmaxf(__builtin_fmaxf((a),(b)),(c))
  #define GAPA(MF,A0,A1,A2,A3,W0,W1,PW) do{ MF; sacc+=A0; sacc+=A1; sacc+=A2; sacc+=A3; PIN(sacc); W0; W1; PIN(PW); SBAR(); }while(0)
  #define EX(v) __builtin_amdgcn_exp2f(v)
  #define GAPB(MF,X,B) do{ MF; X[B]=EX(X[B]); X[B+1]=EX(X[B+1]); X[B+2]=EX(X[B+2]); X[B+3]=EX(X[B+3]); PIN(X); SBAR(); }while(0)
  #define VRD(i) do{ vlo[i]=vtr(vp_+(((i)>>2)*4096+((i)&3)*1024)); vhi[i]=vtr(vp_+(((i)>>2)*4096+((i)&3)*1024+512)); }while(0)
  #define KRD(G,j) do{ if(G){ kload2(kf,kp0+sl_next,j); SBAR(); } }while(0)
  #define STEP(C0,C1,P0,P1,t,GK,GV,GL) do{ SBAR(); \
    const lds_cptr vp_=vp0+sl_prev; \
    VRD(0); SBAR(); float sacc=(P0[0]+P0[1]); \
    GAPA(C0=__builtin_amdgcn_mfma_f32_32x32x16_bf16(kf[0],qr[0],negm,0,0,0), P0[2],P0[3],P0[4],P0[5],     pw0[0]=PKW(P0,0), pw0[1]=PKW(P0,2), pw0); \
    VRD(4); SBAR(); GAPA(C1=__builtin_amdgcn_mfma_f32_32x32x16_bf16(kf[1],qr[0],negm,0,0,0), P0[6],P0[7],P0[8],P0[9],     pw0[2]=PKW(P0,4), pw0[3]=PKW(P0,6), pw0); \
    VRD(1); SBAR(); GAPA(C0=__builtin_amdgcn_mfma_f32_32x32x16_bf16(kf[2],qr[1],C0,0,0,0),   P0[10],P0[11],P0[12],P0[13], pw1[0]=PKW(P0,8), pw1[1]=PKW(P0,10), pw1); \
    VRD(5); SBAR(); GAPA(C1=__builtin_amdgcn_mfma_f32_32x32x16_bf16(kf[3],qr[1],C1,0,0,0),   P0[14],P0[15],P1[0],P1[1],   pw1[2]=PKW(P0,12),pw1[3]=PKW(P0,14), pw1); \
    VRD(2); SBAR(); GAPA(C0=__builtin_amdgcn_mfma_f32_32x32x16_bf16(kf[4],qr[2],C0,0,0,0),   P1[2],P1[3],P1[4],P1[5],     pw2[0]=PKW(P1,0), pw2[1]=PKW(P1,2), pw2); \
    VRD(6); SBAR(); GAPA(C1=__builtin_amdgcn_mfma_f32_32x32x16_bf16(kf[5],qr[2],C1,0,0,0),   P1[6],P1[7],P1[8],P1[9],     pw2[2]=PKW(P1,4), pw2[3]=PKW(P1,6), pw2); \
    VRD(3); SBAR(); GAPA(C0=__builtin_amdgcn_mfma_f32_32x32x16_bf16(kf[6],qr[3],C0,0,0,0),   P1[10],P1[11],P1[12],P1[13], pw3[0]=PKW(P1,8), pw3[1]=PKW(P1,10), pw3); \
    VRD(7); SBAR(); GAPA(C1=__builtin_amdgcn_mfma_f32_32x32x16_bf16(kf[7],qr[3],C1,0,0,0),   P1[14],P1[15],0.f,0.f,       pw3[2]=PKW(P1,12),pw3[3]=PKW(P1,14), pw3); \
    l_reg+=sacc; \
    if(GK){DMA_K((t)+3,sl_cur);} if(GV){DMA_V((t)+1,sl_next);} \
    CMASK(C0,C1,t); \
    { float a=MX3(C0[0],C0[1],C1[0]),b=MX3(C0[2],C0[3],C1[1]); a=MX3(a,C1[2],C1[3]); \
      _Pragma("unroll") for(int r=4;r<16;r+=4){a=MX3(a,C0[r],C0[r+1]);b=MX3(b,C0[r+2],C0[r+3]);a=MX3(a,C1[r],C1[r+1]);b=MX3(b,C1[r+2],C1[r+3]);} \
      float rm=__builtin_fmaxf(a,b); { auto rr=__builtin_amdgcn_permlane32_swap(__float_as_uint(rm),__float_as_uint(rm),false,false); rm=__builtin_fmaxf(__uint_as_float(rr[0]),__uint_as_float(rr[1])); } \
      resc=false; \
      if(__builtin_expect(__any(rm>(float)THRL),0)){ const float dl=__builtin_fmaxf(rm,0.f); mhat+=dl; \
        _Pragma("unroll") for(int r=0;r<16;++r){C0[r]-=dl;C1[r]-=dl;} \
        _Pragma("unroll") for(int r=0;r<16;++r)negm[r]=-mhat; asm volatile("":"+v"(negm)); \
        const float f=__builtin_amdgcn_exp2f(-dl); l_reg*=f; if(hi==0)wsf[r32]=f; resc=true; } } \
    SBAR(); \
    GAPB(o[0]=__builtin_amdgcn_mfma_f32_32x32x16_bf16(PAF(0),VFR(0),o[0],0,0,0), C0,0); \
    GAPB(o[1]=__builtin_amdgcn_mfma_f32_32x32x16_bf16(PAF(0),VFR(4),o[1],0,0,0), C0,4); \
    KRD(GL,0); GAPB(o[0]=__builtin_amdgcn_mfma_f32_32x32x16_bf16(PAF(1),VFR(1),o[0],0,0,0), C0,8); \
    KRD(GL,1); GAPB(o[1]=__builtin_amdgcn_mfma_f32_32x32x16_bf16(PAF(1),VFR(5),o[1],0,0,0), C0,12); \
    KRD(GL,2); GAPB(o[0]=__builtin_amdgcn_mfma_f32_32x32x16_bf16(PAF(2),VFR(2),o[0],0,0,0), C1,0); \
    KRD(GL,3); GAPB(o[1]=__builtin_amdgcn_mfma_f32_32x32x16_bf16(PAF(2),VFR(6),o[1],0,0,0), C1,4); \
    GAPB(o[0]=__builtin_amdgcn_mfma_f32_32x32x16_bf16(PAF(3),VFR(3),o[0],0,0,0), C1,8); \
    GAPB(o[1]=__builtin_amdgcn_mfma_f32_32x32x16_bf16(PAF(3),VFR(7),o[1],0,0,0), C1,12); \
    }while(0)
  int t=1;
  #undef CMASK
  #define CMASK(P0,P1,t) do{}while(0)
  for(;t+5<NT;t+=2){
    STEP(pB0,pB1,pA0,pA1,t,true,true,true);     WAIT_BAR(2); RESC(); ROT();
    STEP(pA0,pA1,pB0,pB1,t+1,true,true,true);   WAIT_BAR(2); RESC(); ROT();
  }
  #undef CMASK
  #define CMASK(P0,P1,t) do{}while(0)
  #define ENDW(tt) do{ if((tt)+3<NT){WAIT_BAR(2);} else if((tt)+2<NT){WAIT_BAR(1);} else {WAIT_BAR(0);} }while(0)
  for(;t+1<NT;t+=2){
    STEP(pB0,pB1,pA0,pA1,t,(t+3<NT),(t+1<NT),(t+1<NT));       ENDW(t);   RESC(); ROT();
    STEP(pA0,pA1,pB0,pB1,t+1,(t+4<NT),(t+2<NT),(t+2<NT));     ENDW(t+1); RESC(); ROT();
  }
  STEP(pB0,pB1,pA0,pA1,NT-1,false,false,false); RESC();
  { float sacc=pB0[0]+pB0[1]; _Pragma("unroll") for(int r=2;r<16;++r)sacc+=pB0[r]; _Pragma("unroll") for(int r=0;r<16;++r)sacc+=pB1[r]; l_reg+=sacc;
    pw0=(u32x4){PKW(pB0,0),PKW(pB0,2),PKW(pB0,4),PKW(pB0,6)};pw1=(u32x4){PKW(pB0,8),PKW(pB0,10),PKW(pB0,12),PKW(pB0,14)};pw2=(u32x4){PKW(pB1,0),PKW(pB1,2),PKW(pB1,4),PKW(pB1,6)};pw3=(u32x4){PKW(pB1,8),PKW(pB1,10),PKW(pB1,12),PKW(pB1,14)};
    SBAR(); pv(o,vb0+sl_cur,PAF(0),PAF(1),PAF(2),PAF(3)); }
  #undef PKW
  #undef PAF
  #undef VFR
  #undef PIN
  #undef MX3
  #undef GAPA
  #undef GAPB
  #undef EX
  #undef VRD
  #undef KRD
  #undef STEP
  #undef ENDW
  {auto rr=__builtin_amdgcn_permlane32_swap(__float_as_uint(l_reg),__float_as_uint(l_reg),false,false);l_reg=__uint_as_float(rr[0])+__uint_as_float(rr[1]);}
  if(hi==0)wsf[32+r32]=l_reg;asm volatile("s_waitcnt lgkmcnt(0)":::"memory");
  float rli[16];
  #pragma unroll
  for(int r=0;r<16;++r)rli[r]=__builtin_amdgcn_rcpf(wsf[32+crow(r,hi)]);
  bf16*Ow=O+(q0+wid*QBLK)*op+ocol;
  { bf16*stg=(bf16*)(shm+LDS_OST)+wid*2048;
    #pragma unroll
    for(int r=0;r<16;++r){const int orow=crow(r,hi);
      #pragma unroll
      for(int d0=0;d0<2;++d0)stg[orow*64+d0*32+r32]=__float2bfloat16(o[d0][r]*rli[r]);}
    asm volatile("s_waitcnt lgkmcnt(0)":::"memory");
    #pragma unroll
    for(int i=0;i<4;++i){const int row=i*8+(lane>>3),ch=lane&7; const u32x4 v=*(const u32x4*)(stg+row*64+ch*8); ATTN_STORE16(Ow+(long)row*op+ch*8,v);} }
#ifdef ATT_STATIC_PRIO
  __builtin_amdgcn_s_setprio(0);
#endif
  asm volatile("s_waitcnt lgkmcnt(0)\n\ts_barrier":::"memory");
  #undef DMA_K
  #undef DMA_V
  #undef CMASK
  #undef START
  #undef RESC
  #undef ROT
}
constexpr int ATTN_LDS_BYTES=LDS_BYTES;

#undef SBAR
#undef WAIT_BAR
}
namespace att96 {
using bf16=__hip_bfloat16;
using bf16x8=__attribute__((ext_vector_type(8)))short;
using s16x4=__attribute__((ext_vector_type(4)))short;
using f32x16=__attribute__((ext_vector_type(16)))float;
using u32x4=__attribute__((ext_vector_type(4)))unsigned;
constexpr int D=64;
constexpr int NW=8,QBLK=32,QB=QBLK*NW,KVBLK=64;

__device__ __forceinline__ int crow(int r,int hi){return (r&3)+8*(r>>2)+4*hi;}
#define SBAR() __builtin_amdgcn_sched_barrier(0)
__device__ __forceinline__ void cmask(f32x16&p0,f32x16&p1,int jb,int qrel,int hi){
  const float NEG=-INFINITY; int kb=64*jb+4*hi;
  #pragma unroll
  for(int r=0;r<16;++r){int kv=kb+(r&3)+8*(r>>2); if(kv>qrel)p0[r]=NEG; if(kv+32>qrel)p1[r]=NEG;}
}

constexpr int NSLOT=3, SLOTB=8192;
constexpr int KSLOTB=12288;
constexpr int LDS_K=0, LDS_V=NSLOT*KSLOTB, LDS_WS=LDS_V+NSLOT*SLOTB, LDS_OST=LDS_WS+NW*64*4, LDS_BYTES=LDS_OST+NW*4096;
constexpr float C2=0.125f*1.4426950408889634f;
__device__ __forceinline__ void glds16(const void*gsrc,unsigned lds_dst){unsigned keep;
  asm volatile("s_mov_b32 %0, m0\n\ts_mov_b32 m0, %2\n\ts_nop 0\n\tglobal_load_lds_dwordx4 %1, off\n\ts_mov_b32 m0, %0":"=&s"(keep):"v"(gsrc),"s"(lds_dst):"memory");}
__device__ __forceinline__ float max3f(float a,float b,float c){float r;asm("v_max3_f32 %0, %1, %2, %3":"=v"(r):"v"(a),"v"(b),"v"(c));return r;}
__device__ __forceinline__ float max2f(float a,float b){float r;asm("v_max_f32_e32 %0, %1, %2":"=v"(r):"v"(a),"v"(b));return r;}
__device__ __forceinline__ float fadd_s(float a,float b){float r;asm("v_add_f32_e32 %0, %1, %2":"=v"(r):"v"(a),"v"(b));return r;}
__device__ __forceinline__ float fsub_s(float a,float b){float r;asm("v_sub_f32_e32 %0, %1, %2":"=v"(r):"v"(a),"v"(b));return r;}
typedef float f32x2_t __attribute__((ext_vector_type(2))); typedef __bf16 bf16x2_t __attribute__((ext_vector_type(2)));
__device__ __forceinline__ unsigned cvtpk_s(float lo,float hi){f32x2_t v={lo,hi};bf16x2_t b=__builtin_convertvector(v,bf16x2_t);return __builtin_bit_cast(unsigned,b);}
#define KOFF(sl) ((sl)+((sl)>>1))
#define WAIT_BAR(N) asm volatile("s_waitcnt vmcnt(" #N ") lgkmcnt(0)\n\ts_barrier":::"memory")

__device__ __forceinline__ void qkt(f32x16&p0,f32x16&p1,const char*Kslot,const bf16x8*qr,const f32x16&negm,int r32,int hi){
  const char*kb=Kslot+hi*1024+r32*16;
  #pragma unroll
  for(int d0=0;d0<6;++d0){
    const bf16x8 b0=*reinterpret_cast<const bf16x8*>(kb+d0*2048);
    const bf16x8 b1=*reinterpret_cast<const bf16x8*>(kb+d0*2048+512);
    if(d0==0){p0=__builtin_amdgcn_mfma_f32_32x32x16_bf16(b0,qr[0],negm,0,0,0);p1=__builtin_amdgcn_mfma_f32_32x32x16_bf16(b1,qr[0],negm,0,0,0);}
    else{p0=__builtin_amdgcn_mfma_f32_32x32x16_bf16(b0,qr[d0],p0,0,0,0);p1=__builtin_amdgcn_mfma_f32_32x32x16_bf16(b1,qr[d0],p1,0,0,0);}}
}
typedef __attribute__((address_space(3))) const char* lds_cptr;
typedef short v4i16_t __attribute__((ext_vector_type(4)));
__device__ __forceinline__ void kload12(bf16x8*kf,lds_cptr kp){
  kf[0]=*(const __attribute__((address_space(3))) bf16x8*)(kp);      kf[1]=*(const __attribute__((address_space(3))) bf16x8*)(kp+512);
  kf[2]=*(const __attribute__((address_space(3))) bf16x8*)(kp+2048); kf[3]=*(const __attribute__((address_space(3))) bf16x8*)(kp+2560);
  kf[4]=*(const __attribute__((address_space(3))) bf16x8*)(kp+4096); kf[5]=*(const __attribute__((address_space(3))) bf16x8*)(kp+4608);
  kf[6]=*(const __attribute__((address_space(3))) bf16x8*)(kp+6144); kf[7]=*(const __attribute__((address_space(3))) bf16x8*)(kp+6656);
  kf[8]=*(const __attribute__((address_space(3))) bf16x8*)(kp+8192); kf[9]=*(const __attribute__((address_space(3))) bf16x8*)(kp+8704);
  kf[10]=*(const __attribute__((address_space(3))) bf16x8*)(kp+10240); kf[11]=*(const __attribute__((address_space(3))) bf16x8*)(kp+10752);
}
__device__ __forceinline__ void kload2(bf16x8*kf,lds_cptr kp,int j){ kf[2*j]=*(const __attribute__((address_space(3))) bf16x8*)(kp+j*2048); kf[2*j+1]=*(const __attribute__((address_space(3))) bf16x8*)(kp+j*2048+512); }
__device__ __forceinline__ s16x4 vtr(lds_cptr p){ return __builtin_bit_cast(s16x4,__builtin_amdgcn_ds_read_tr16_b64_v4i16((__attribute__((address_space(3))) v4i16_t*)p)); }
__device__ __forceinline__ float rowmax(const f32x16&p0,const f32x16&p1){
  float a=max3f(p0[0],p0[1],p1[0]),b=max3f(p0[2],p0[3],p1[1]);a=max3f(a,p1[2],p1[3]);
  #pragma unroll
  for(int r=4;r<16;r+=4){a=max3f(a,p0[r],p0[r+1]);b=max3f(b,p0[r+2],p0[r+3]);a=max3f(a,p1[r],p1[r+1]);b=max3f(b,p1[r+2],p1[r+3]);}
  const float m=max2f(a,b);
  auto rr=__builtin_amdgcn_permlane32_swap(__float_as_uint(m),__float_as_uint(m),false,false);
  return max2f(__uint_as_float(rr[0]),__uint_as_float(rr[1]));
}
__device__ __forceinline__ void pv(f32x16*o,int vb,bf16x8 pa0,bf16x8 pa1,bf16x8 pa2,bf16x8 pa3){
  #pragma unroll
  for(int d0=0;d0<2;++d0){s16x4 lo[4],hi[4];
    #pragma unroll
    for(int ks=0;ks<4;++ks){
      asm volatile("ds_read_b64_tr_b16 %0,%1 offset:%c2":"=&v"(lo[ks]):"v"(vb),"i"(d0*4096+ks*1024):"memory");
      asm volatile("ds_read_b64_tr_b16 %0,%1 offset:%c2":"=&v"(hi[ks]):"v"(vb),"i"(d0*4096+ks*1024+512):"memory");}
    asm volatile("s_waitcnt lgkmcnt(0)":::"memory");SBAR();
    #define PK(k) (bf16x8){lo[k][0],lo[k][1],lo[k][2],lo[k][3],hi[k][0],hi[k][1],hi[k][2],hi[k][3]}
    o[d0]=__builtin_amdgcn_mfma_f32_32x32x16_bf16(pa0,PK(0),o[d0],0,0,0);
    o[d0]=__builtin_amdgcn_mfma_f32_32x32x16_bf16(pa1,PK(1),o[d0],0,0,0);
    o[d0]=__builtin_amdgcn_mfma_f32_32x32x16_bf16(pa2,PK(2),o[d0],0,0,0);
    o[d0]=__builtin_amdgcn_mfma_f32_32x32x16_bf16(pa3,PK(3),o[d0],0,0,0);
    #undef PK
  }
}

#ifndef ATTN_STORE16
#define ATTN_STORE16(p,v) (*(u32x4*)(p)=(v))
#endif
template<int THRL> __device__ __forceinline__ void attn_unit(long q0,const bf16*Q,int qp,int qcol,const bf16*__restrict__ K,int kp,int kcol,const bf16*__restrict__ V,int vp,int vcol,long kv0,int NT,bf16*O,int op,int ocol,char*shm,const float*qgain,const float*T16){
  int tid_=threadIdx.x; asm volatile("":"+v"(tid_));
  const int tid=tid_,lane=tid&63,r32=lane&31,hi=lane>>5; const int wid=__builtin_amdgcn_readfirstlane(tid>>6);
#ifdef ATT_STATIC_PRIO
  if(wid>=4)__builtin_amdgcn_s_setprio(1);
#endif
  const bf16*Qw=Q+(q0+wid*QBLK)*qp+qcol;
  const bf16*Kh=K+kv0*kp+kcol,*Vh=V+kv0*vp+vcol;
  const unsigned lds0=(unsigned)(uintptr_t)shm;
  float*wsf=(float*)(shm+LDS_WS)+wid*64;
  const bf16*ksrc=Kh+(long)lane*kp+wid*8;
  const bf16*vsrc=Vh+(long)(16*(wid&3)+(lane>>2))*vp+(wid>>2)*32+(lane&3)*8;
  const unsigned kdst=lds0+LDS_K+wid*1024, vdst=lds0+LDS_V+wid*1024, kdst2=lds0+LDS_K+(8+wid)*1024;
  const bf16*ksrc2=Kh+(long)lane*kp+64+wid*8;
  const bool big=wid<4;
  #define DMA_K(t,slot) do{ glds16(ksrc+(long)(t)*KVBLK*kp,(unsigned)__builtin_amdgcn_readfirstlane(kdst+KOFF(slot))); if(big) glds16(ksrc2+(long)(t)*KVBLK*kp,(unsigned)__builtin_amdgcn_readfirstlane(kdst2+KOFF(slot))); }while(0)
  #define WAITKV() do{ if(big){WAIT_BAR(3);} else {WAIT_BAR(2);} }while(0)
  #define DMA_V(t,slot) glds16(vsrc+(long)(t)*KVBLK*vp,(unsigned)__builtin_amdgcn_readfirstlane(vdst+(slot)))
  const int vb0=(int)(lds0+LDS_V)+((lane>>4)&1)*32+(lane&3)*8+(4*hi+((lane&15)>>2))*64;
  const char*Kbase=shm+LDS_K; bf16x8 kf[12];
  const lds_cptr shm3=(lds_cptr)shm; const lds_cptr kp0=shm3+LDS_K+hi*1024+r32*16; const lds_cptr vp0=shm3+LDS_V+((lane>>4)&1)*32+(lane&3)*8+(4*hi+((lane&15)>>2))*64;
  DMA_K(0,0);DMA_V(0,0);DMA_K(1,SLOTB);
  bf16x8 qr[6];
  #pragma unroll
  for(int d0=0;d0<6;++d0)qr[d0]=*reinterpret_cast<const bf16x8*>(&Qw[(long)r32*qp+d0*16+hi*8]);
  {
    float f[6][8]; float ss=0.f;
    #pragma unroll
    for(int d0=0;d0<6;++d0)
      #pragma unroll
      for(int j=0;j<8;++j){ f[d0][j]=__uint_as_float(((unsigned)(unsigned short)qr[d0][j])<<16); ss+=f[d0][j]*f[d0][j]; }
    ss+=__shfl_xor(ss,32);
    const float rn=rsqrtf(ss*(1.f/96.f)+EPS)*C2_96;
    #pragma unroll
    for(int d0=0;d0<6;++d0)
      #pragma unroll
      for(int j=0;j<8;++j) f[d0][j]=f[d0][j]*rn*qgain[d0*16+hi*8+j];
    const int tq=(int)((q0+wid*QBLK+r32)%S); const int grow=tq/GW,gcol=tq%GW;
    #pragma unroll
    for(int part=0;part<2;++part){ const int pos=part?gcol:grow;
      #pragma unroll
      for(int j=0;j<8;++j){ const float cs=T16[pos*8+j],sn=T16[512+pos*8+j];
        const float mine=f[4+part][j],other=__shfl_xor(mine,32);
        f[4+part][j]=hi==0?(mine*cs-other*sn):(other*sn+mine*cs); } }
    #pragma unroll
    for(int d0=0;d0<6;++d0)
      #pragma unroll
      for(int j=0;j<4;++j){ const unsigned w=cvtpk_s(f[d0][2*j],f[d0][2*j+1]); qr[d0][2*j]=(short)(w&0xffff); qr[d0][2*j+1]=(short)(w>>16); }
  }
  float mhat=0.f,l_reg=0.f;f32x16 o[2];o[0]=f32x16{};o[1]=f32x16{};f32x16 negm=f32x16{};asm volatile("":"+v"(negm));
  #define CMASK(P0,P1,t) do{}while(0)
  bool resc=false;
  #define START(P0,P1) do{ const float rm=rowmax(P0,P1); resc=false; \
    { const float dl=rm; mhat=fadd_s(mhat,dl); \
      _Pragma("unroll") for(int r=0;r<16;++r){P0[r]=fsub_s(P0[r],dl);P1[r]=fsub_s(P1[r],dl);} \
      _Pragma("unroll") for(int r=0;r<16;++r)negm[r]=-mhat; asm volatile("":"+v"(negm)); } \
    _Pragma("unroll") for(int r=0;r<16;++r)P0[r]=__builtin_amdgcn_exp2f(P0[r]); }while(0)
  #define RESC() do{ if(resc){ asm volatile("s_waitcnt lgkmcnt(0)":::"memory"); \
      _Pragma("unroll") for(int d_=0;d_<2;++d_) _Pragma("unroll") for(int r=0;r<16;++r)o[d_][r]*=wsf[crow(r,hi)]; } }while(0)
  f32x16 pA0,pA1,pB0,pB1;
  int sl_prev=0,sl_cur=0,sl_next=SLOTB;
  #define ROT() do{sl_prev=sl_cur;sl_cur=sl_next;sl_next=(sl_next==(NSLOT-1)*SLOTB)?0:sl_next+SLOTB;}while(0)
  DMA_K(2,2*SLOTB);
  if(big){WAIT_BAR(5);}else{WAIT_BAR(3);}
  qkt(pA0,pA1,Kbase,qr,negm,r32,hi);asm volatile("s_nop 15\n\ts_nop 7":"+v"(pA0),"+v"(pA1));CMASK(pA0,pA1,0);
  START(pA0,pA1);
  _Pragma("unroll") for(int r=0;r<16;++r)pA1[r]=__builtin_amdgcn_exp2f(pA1[r]);
  WAIT_BAR(0);
  DMA_K(3,0);DMA_V(1,SLOTB);
  ROT();
  kload12(kf,kp0+KOFF(sl_cur));
  WAITKV();
  s16x4 vlo[8],vhi[8]; u32x4 pw0,pw1,pw2,pw3;
  #define PKW(P,B) cvtpk_s(P[B],P[B+1])
  #define PAF(k) __builtin_bit_cast(bf16x8,pw##k)
  #define VFR(i) (bf16x8){vlo[i][0],vlo[i][1],vlo[i][2],vlo[i][3],vhi[i][0],vhi[i][1],vhi[i][2],vhi[i][3]}
  #define PIN(x) asm volatile("":"+v"(x))
  #define MX3(a,b,c) __builtin_fmaxf(__builtin_fmaxf((a),(b)),(c))
  #define GAPA(MF,A0,A1,A2,A3,W0,W1,PW) do{ MF; sacc+=A0; sacc+=A1; sacc+=A2; sacc+=A3; PIN(sacc); W0; W1; PIN(PW); SBAR(); }while(0)
  #define EX(v) __builtin_amdgcn_exp2f(v)
  #define GAPB(MF,X,B) do{ MF; X[B]=EX(X[B]); X[B+1]=EX(X[B+1]); X[B+2]=EX(X[B+2]); X[B+3]=EX(X[B+3]); PIN(X); SBAR(); }while(0)
  #define VRD(i) do{ vlo[i]=vtr(vp_+(((i)>>2)*4096+((i)&3)*1024)); vhi[i]=vtr(vp_+(((i)>>2)*4096+((i)&3)*1024+512)); }while(0)
  #define KRD(G,j) do{ if(G){ kload2(kf,kp0+KOFF(sl_next),j); SBAR(); } }while(0)
  #define STEP(C0,C1,P0,P1,t,GK,GV,GL) do{ SBAR(); \
    const lds_cptr vp_=vp0+sl_prev; \
    VRD(0); SBAR(); float sacc=(P0[0]+P0[1]); \
    GAPA(C0=__builtin_amdgcn_mfma_f32_32x32x16_bf16(kf[0],qr[0],negm,0,0,0), P0[2],P0[3],P0[4],P0[5],     pw0[0]=PKW(P0,0), pw0[1]=PKW(P0,2), pw0); \
    VRD(4); SBAR(); GAPA(C1=__builtin_amdgcn_mfma_f32_32x32x16_bf16(kf[1],qr[0],negm,0,0,0), P0[6],P0[7],P0[8],P0[9],     pw0[2]=PKW(P0,4), pw0[3]=PKW(P0,6), pw0); \
    VRD(1); SBAR(); GAPA(C0=__builtin_amdgcn_mfma_f32_32x32x16_bf16(kf[2],qr[1],C0,0,0,0),   P0[10],P0[11],P0[12],P0[13], pw1[0]=PKW(P0,8), pw1[1]=PKW(P0,10), pw1); \
    VRD(5); SBAR(); GAPA(C1=__builtin_amdgcn_mfma_f32_32x32x16_bf16(kf[3],qr[1],C1,0,0,0),   P0[14],P0[15],P1[0],P1[1],   pw1[2]=PKW(P0,12),pw1[3]=PKW(P0,14), pw1); \
    VRD(2); SBAR(); GAPA(C0=__builtin_amdgcn_mfma_f32_32x32x16_bf16(kf[4],qr[2],C0,0,0,0),   P1[2],P1[3],P1[4],P1[5],     pw2[0]=PKW(P1,0), pw2[1]=PKW(P1,2), pw2); \
    VRD(6); SBAR(); GAPA(C1=__builtin_amdgcn_mfma_f32_32x32x16_bf16(kf[5],qr[2],C1,0,0,0),   P1[6],P1[7],P1[8],P1[9],     pw2[2]=PKW(P1,4), pw2[3]=PKW(P1,6), pw2); \
    VRD(3); SBAR(); GAPA(C0=__builtin_amdgcn_mfma_f32_32x32x16_bf16(kf[6],qr[3],C0,0,0,0),   P1[10],P1[11],P1[12],P1[13], pw3[0]=PKW(P1,8), pw3[1]=PKW(P1,10), pw3); \
    VRD(7); SBAR(); GAPA(C1=__builtin_amdgcn_mfma_f32_32x32x16_bf16(kf[7],qr[3],C1,0,0,0),   P1[14],P1[15],0.f,0.f,       pw3[2]=PKW(P1,12),pw3[3]=PKW(P1,14), pw3); \
    C0=__builtin_amdgcn_mfma_f32_32x32x16_bf16(kf[8],qr[4],C0,0,0,0); SBAR(); C1=__builtin_amdgcn_mfma_f32_32x32x16_bf16(kf[9],qr[4],C1,0,0,0); SBAR(); \
    C0=__builtin_amdgcn_mfma_f32_32x32x16_bf16(kf[10],qr[5],C0,0,0,0); SBAR(); C1=__builtin_amdgcn_mfma_f32_32x32x16_bf16(kf[11],qr[5],C1,0,0,0); SBAR(); \
    l_reg+=sacc; \
    if(GK){DMA_K((t)+3,sl_cur);} if(GV){DMA_V((t)+1,sl_next);} \
    CMASK(C0,C1,t); \
    { float a=MX3(C0[0],C0[1],C1[0]),b=MX3(C0[2],C0[3],C1[1]); a=MX3(a,C1[2],C1[3]); \
      _Pragma("unroll") for(int r=4;r<16;r+=4){a=MX3(a,C0[r],C0[r+1]);b=MX3(b,C0[r+2],C0[r+3]);a=MX3(a,C1[r],C1[r+1]);b=MX3(b,C1[r+2],C1[r+3]);} \
      float rm=__builtin_fmaxf(a,b); { auto rr=__builtin_amdgcn_permlane32_swap(__float_as_uint(rm),__float_as_uint(rm),false,false); rm=__builtin_fmaxf(__uint_as_float(rr[0]),__uint_as_float(rr[1])); } \
      resc=false; \
      if(__builtin_expect(__any(rm>(float)THRL),0)){ const float dl=__builtin_fmaxf(rm,0.f); mhat+=dl; \
        _Pragma("unroll") for(int r=0;r<16;++r){C0[r]-=dl;C1[r]-=dl;} \
        _Pragma("unroll") for(int r=0;r<16;++r)negm[r]=-mhat; asm volatile("":"+v"(negm)); \
        const float f=__builtin_amdgcn_exp2f(-dl); l_reg*=f; if(hi==0)wsf[r32]=f; resc=true; } } \
    SBAR(); \
    GAPB(o[0]=__builtin_amdgcn_mfma_f32_32x32x16_bf16(PAF(0),VFR(0),o[0],0,0,0), C0,0); \
    KRD(GL,0); GAPB(o[1]=__builtin_amdgcn_mfma_f32_32x32x16_bf16(PAF(0),VFR(4),o[1],0,0,0), C0,4); \
    KRD(GL,1); GAPB(o[0]=__builtin_amdgcn_mfma_f32_32x32x16_bf16(PAF(1),VFR(1),o[0],0,0,0), C0,8); \
    KRD(GL,2); GAPB(o[1]=__builtin_amdgcn_mfma_f32_32x32x16_bf16(PAF(1),VFR(5),o[1],0,0,0), C0,12); \
    KRD(GL,3); GAPB(o[0]=__builtin_amdgcn_mfma_f32_32x32x16_bf16(PAF(2),VFR(2),o[0],0,0,0), C1,0); \
    KRD(GL,4); GAPB(o[1]=__builtin_amdgcn_mfma_f32_32x32x16_bf16(PAF(2),VFR(6),o[1],0,0,0), C1,4); \
    KRD(GL,5); GAPB(o[0]=__builtin_amdgcn_mfma_f32_32x32x16_bf16(PAF(3),VFR(3),o[0],0,0,0), C1,8); \
    GAPB(o[1]=__builtin_amdgcn_mfma_f32_32x32x16_bf16(PAF(3),VFR(7),o[1],0,0,0), C1,12); \
    }while(0)
  int t=1;
  #undef CMASK
  #define CMASK(P0,P1,t) do{}while(0)
  for(;t+5<NT;t+=2){
    STEP(pB0,pB1,pA0,pA1,t,true,true,true);     WAITKV(); RESC(); ROT();
    STEP(pA0,pA1,pB0,pB1,t+1,true,true,true);   WAITKV(); RESC(); ROT();
  }
  #undef CMASK
  #define CMASK(P0,P1,t) do{}while(0)
  #define ENDW(tt) do{ if((tt)+3<NT){WAITKV();} else if((tt)+2<NT){WAIT_BAR(1);} else {WAIT_BAR(0);} }while(0)
  for(;t+1<NT;t+=2){
    STEP(pB0,pB1,pA0,pA1,t,(t+3<NT),(t+1<NT),(t+1<NT));       ENDW(t);   RESC(); ROT();
    STEP(pA0,pA1,pB0,pB1,t+1,(t+4<NT),(t+2<NT),(t+2<NT));     ENDW(t+1); RESC(); ROT();
  }
  STEP(pB0,pB1,pA0,pA1,NT-1,false,false,false); RESC();
  { float sacc=pB0[0]+pB0[1]; _Pragma("unroll") for(int r=2;r<16;++r)sacc+=pB0[r]; _Pragma("unroll") for(int r=0;r<16;++r)sacc+=pB1[r]; l_reg+=sacc;
    pw0=(u32x4){PKW(pB0,0),PKW(pB0,2),PKW(pB0,4),PKW(pB0,6)};pw1=(u32x4){PKW(pB0,8),PKW(pB0,10),PKW(pB0,12),PKW(pB0,14)};pw2=(u32x4){PKW(pB1,0),PKW(pB1,2),PKW(pB1,4),PKW(pB1,6)};pw3=(u32x4){PKW(pB1,8),PKW(pB1,10),PKW(pB1,12),PKW(pB1,14)};
    SBAR(); pv(o,vb0+sl_cur,PAF(0),PAF(1),PAF(2),PAF(3)); }
  #undef PKW
  #undef PAF
  #undef VFR
  #undef PIN
  #undef MX3
  #undef GAPA
  #undef GAPB
  #undef EX
  #undef VRD
  #undef KRD
  #undef STEP
  #undef ENDW
  {auto rr=__builtin_amdgcn_permlane32_swap(__float_as_uint(l_reg),__float_as_uint(l_reg),false,false);l_reg=__uint_as_float(rr[0])+__uint_as_float(rr[1]);}
  if(hi==0)wsf[32+r32]=l_reg;asm volatile("s_waitcnt lgkmcnt(0)":::"memory");
  float rli[16];
  #pragma unroll
  for(int r=0;r<16;++r)rli[r]=__builtin_amdgcn_rcpf(wsf[32+crow(r,hi)]);
  bf16*Ow=O+(q0+wid*QBLK)*op+ocol;
  { bf16*stg=(bf16*)(shm+LDS_OST)+wid*2048;
    #pragma unroll
    for(int r=0;r<16;++r){const int orow=crow(r,hi);
      #pragma unroll
      for(int d0=0;d0<2;++d0)stg[orow*64+d0*32+r32]=__float2bfloat16(o[d0][r]*rli[r]);}
    asm volatile("s_waitcnt lgkmcnt(0)":::"memory");
    #pragma unroll
    for(int i=0;i<4;++i){const int row=i*8+(lane>>3),ch=lane&7; const u32x4 v=*(const u32x4*)(stg+row*64+ch*8); ATTN_STORE16(Ow+(long)row*op+ch*8,v);} }
#ifdef ATT_STATIC_PRIO
  __builtin_amdgcn_s_setprio(0);
#endif
  asm volatile("s_waitcnt lgkmcnt(0)\n\ts_barrier":::"memory");
  #undef DMA_K
  #undef WAITKV
  #undef DMA_V
  #undef CMASK
  #undef START
  #undef RESC
  #undef ROT
}
constexpr int ATTN_LDS_BYTES=LDS_BYTES;

#undef SBAR
#undef WAIT_BAR
#undef KOFF
}
#define LAS __attribute__((address_space(3)))
#define XB_TMO      128
#define XB_XCNT(j)  (256  + 64 * (j))
#define XB_XSUB(j)  (1280 + 64 * (j))
#define XB_XGEN(j)  (2304 + 64 * (j))
#define XB_TOP      3328
#define XB_TOPGEN   3392
#define XCD_BAR_WORDS 3456
#define XB_CTXH     3520
#define XB_SPIN_CAP (1u << 18)

__device__ __forceinline__ unsigned xb_ld(unsigned* p)              { return __hip_atomic_load(p, __ATOMIC_RELAXED, __HIP_MEMORY_SCOPE_AGENT); }
__device__ __forceinline__ unsigned xb_add(unsigned* p, unsigned v) { return __hip_atomic_fetch_add(p, v, __ATOMIC_RELAXED, __HIP_MEMORY_SCOPE_AGENT); }
__device__ __forceinline__ unsigned xb_xcc_id() { return (unsigned)__builtin_amdgcn_s_getreg((3 << 11) | 20) & 0xFu; }
#define XB_SPIN(cond, bar) do { unsigned _sp = 0; while (cond) { __builtin_amdgcn_s_sleep(1); \
    if ((++_sp & 255u) == 0u) { if (xb_ld(&(bar)[XB_TMO])) break; if (_sp > XB_SPIN_CAP) { atomicAdd(&(bar)[XB_TMO], 1u); break; } } } } while (0)

struct XcdBarrier {
    unsigned* bar; unsigned x;
    volatile LAS unsigned* st;
};

__device__ __forceinline__ XcdBarrier xcd_barrier_post(unsigned* bar, volatile LAS unsigned* st) {
    XcdBarrier b; b.bar = bar; b.x = xb_xcc_id(); b.st = st;
    if (threadIdx.x == 0) (void)xb_add(&bar[XB_XCNT(b.x)], 1u);
    return b;
}
__device__ __forceinline__ void xcd_barrier_complete(unsigned* bar, unsigned x, unsigned& nloc, unsigned& nx) {
    const unsigned G = gridDim.x * gridDim.y * gridDim.z;
    unsigned sum, cnt, mine, sp = 0u;
    for (;;) {
        sum = 0u; cnt = 0u; mine = 0u;
#pragma unroll
        for (unsigned j = 0; j < 16; ++j) { const unsigned c = xb_ld(&bar[XB_XCNT(j)]); sum += c; cnt += (c > 0u) ? 1u : 0u; mine = (j == x) ? c : mine; }
        if (sum == G) break;
        __builtin_amdgcn_s_sleep(1);
        if ((++sp & 255u) == 0u) { if (xb_ld(&bar[XB_TMO])) break; if (sp > XB_SPIN_CAP) { atomicAdd(&bar[XB_TMO], 1u); break; } }
    }
    nloc = mine > 0u ? mine : 1u; nx = cnt > 0u ? cnt : 1u;
}

__device__ __forceinline__ void xcd_barrier(const XcdBarrier& b) {
    asm volatile("s_waitcnt vmcnt(0)" ::: "memory");
    __syncthreads();
    if (threadIdx.x == 0) {
        unsigned* bar = b.bar;
        __builtin_amdgcn_s_waitcnt(0);
        unsigned nloc = b.st[0], nx = b.st[1];
        if (nloc == 0u) { xcd_barrier_complete(bar, b.x, nloc, nx); b.st[0] = nloc; b.st[1] = nx; }
        const unsigned old = xb_add(&bar[XB_XSUB(b.x)], 1u);
        const unsigned gen = old / nloc;
        if (old + 1u == (gen + 1u) * nloc) {
            __builtin_amdgcn_fence(__ATOMIC_RELEASE, "agent");
            asm volatile("s_waitcnt vmcnt(0)" ::: "memory");
            const unsigned og = xb_add(&bar[XB_TOP], 1u);
            const unsigned tg = og / nx;
            if (og + 1u == (tg + 1u) * nx) xb_add(&bar[XB_TOPGEN], 1u);
            else XB_SPIN(xb_ld(&bar[XB_TOPGEN]) == tg, bar);
            __builtin_amdgcn_fence(__ATOMIC_ACQUIRE, "agent");
            xb_add(&bar[XB_XGEN(b.x)], 1u);
            asm volatile("s_waitcnt vmcnt(0)" ::: "memory");
        } else {
            XB_SPIN(xb_ld(&bar[XB_XGEN(b.x)]) == gen, bar);
            __builtin_amdgcn_fence(__ATOMIC_ACQUIRE, "agent");
            asm volatile("s_waitcnt vmcnt(0)" ::: "memory");
        }
    }
    __syncthreads();
}
namespace mk {
#ifndef KVROT
#define KVROT 0
#endif
#ifndef ALIGN2
#define ALIGN2 true
#endif
#ifndef ALIGN1
#define ALIGN1 true
#endif
#define MLAS __attribute__((address_space(3)))
constexpr int NWAVES = 8, NTHR = 512;
constexpr int RING_BYTES = 131072;
constexpr int LDS_BYTES = 147456;
constexpr int NPHASE = 16;
typedef unsigned v4u __attribute__((ext_vector_type(4)));
typedef float f32x4 __attribute__((ext_vector_type(4)));

struct Ctx {
    Params p; MLAS unsigned char* lds; char* lds_g; int wave, G, vcu, bid;
};
__device__ __forceinline__ int tid_now() { int t = threadIdx.x; asm volatile("" : "+v"(t)); return t; }
__device__ __forceinline__ unsigned pk2(float lo, float hi) { return (unsigned)f2bf(lo) | ((unsigned)f2bf(hi) << 16); }

enum { W_IN0 = 0, W_OUT0, W_GU0, W_D0, W_IN1, W_UQ, W_UKV, W_OUT1, W_GU1, W_D1, NWMAT };
struct SrcBlk { const float* W; int ld; int col; const float* kscale; };
__device__ __forceinline__ SrcBlk src_of(const Params& p, int mat, int nb) {
    SrcBlk s; s.kscale = nullptr; const int pn = nb >> 3, q = nb & 7, bj = q >> 2, wc = q & 3;
    switch (mat) {
    case W_IN0: s.W = p.in[I0_WIN]; s.ld = L0_IN; s.col = 256 * pn + 64 * wc + 32 * bj; break;
    case W_OUT0: s.W = p.in[I0_WOUT]; s.ld = D; s.col = 32 * nb; break;
    case W_GU0: s.W = bj ? p.in[I0_WU] : p.in[I0_WG]; s.ld = FF; s.col = 128 * pn + 32 * wc; break;
    case W_D0: s.W = p.in[I0_WD]; s.ld = D; s.col = 32 * nb; break;
    case W_IN1: s.W = p.in[I1_WIN]; s.ld = L1_IN;
        if (pn == 0) s.col = 128 * bj + 32 * wc;
        else if (pn == 1) { if (bj == 0) s.col = 256 + 32 * wc; else s.col = 640; }
        else if (pn == 2) s.col = 384 + 128 * bj + 32 * wc;
        else if (pn < 5) s.col = 672 + (pn - 3) * 256 + 64 * wc + 32 * bj;
        else if (pn < 7) s.col = 1184 + (pn - 5) * 256 + 64 * wc + 32 * bj;
        else s.col = 1696 + (pn - 7) * 256 + 64 * wc + 32 * bj;
        break;
    case W_UQ: s.W = p.in[I1_WUQ]; s.ld = 768; s.col = 32 * nb; s.kscale = p.in[I1_QAG]; break;
    case W_UKV: s.W = p.in[I1_WUKV]; s.ld = 1024; s.col = (2 * pn + (wc >> 1)) * 128 + (wc & 1) * 64 + 32 * bj; s.kscale = p.in[I1_KVAG]; break;
    case W_OUT1: s.W = p.in[I1_WOUT]; s.ld = D; s.col = 32 * nb; break;
    case W_GU1: s.W = bj ? p.in[I1_WU] : p.in[I1_WG]; s.ld = FF; s.col = 128 * pn + 32 * wc; break;
    default: s.W = p.in[I1_WD]; s.ld = D; s.col = 32 * nb; break;
    }
    return s;
}
struct WMat { size_t ws_off; int K, N; };
__host__ __device__ constexpr WMat wmat(int mat) {
    switch (mat) {
    case W_IN0: return {WS_W_IN0, D, 1536}; case W_OUT0: return {WS_W_OUT0, D, D}; case W_GU0: return {WS_W_GU0, D, 2 * FF}; case W_D0: return {WS_W_D0, FF, D};
    case W_IN1: return {WS_W_IN1, D, L1_INP}; case W_UQ: return {WS_W_UQ, 384, 768}; case W_UKV: return {WS_W_UKV, 256, 1024}; case W_OUT1: return {WS_W_OUT1, D, D};
    case W_GU1: return {WS_W_GU1, D, 2 * FF}; default: return {WS_W_D1, FF, D};
    }
}
template <int mat> __device__ __forceinline__ void transpose_item(const Params& p, int item, MLAS float* scr, int lane) {
    const WMat wm = wmat(mat); const int nblk = wm.N / 32, kb = item / nblk, nb = item % nblk, k0 = 64 * kb;
    const SrcBlk s = src_of(p, mat, nb);
    bf16_t* WT = (bf16_t*)(p.ws + wm.ws_off);
    const int c = lane & 7;
    if (s.W == nullptr) {
#pragma unroll
        for (int j = 0; j < 4; ++j) { const int n = (lane >> 3) + 8 * j; *(v4u*)(WT + (size_t)(32 * nb + n) * wm.K + k0 + 8 * c) = (v4u){0u, 0u, 0u, 0u}; }
        return;
    }
    MLAS float* t0 = scr; MLAS float* t1 = scr + 64 * 33;
    if (mat == W_OUT0 && kb < 4) return;
    constexpr bool fused_pool = false;
    { const int c4 = (lane & 7) * 4, kr = lane >> 3;
        const float* wsrc = s.W + (size_t)(k0 + kr) * s.ld + s.col + c4;
        f32x4 v[8];
#pragma unroll
        for (int i = 0; i < 8; ++i) v[i] = *(const f32x4*)(wsrc + (size_t)(8 * i) * s.ld);
#pragma unroll
        for (int i = 0; i < 8; ++i) { const int kk = kr + 8 * i; float sc = 1.f;
            if (s.kscale) sc = s.kscale[k0 + kk];
            if (fused_pool) sc *= p.in[I0_POOLS][k0 + kk];
            MLAS float* d = t0 + kk * 33 + c4; d[0] = v[i][0] * sc; d[1] = v[i][1] * sc; d[2] = v[i][2] * sc; d[3] = v[i][3] * sc; } }
    asm volatile("s_waitcnt lgkmcnt(0)" ::: "memory");
    MLAS float* src = t0;
    if (fused_pool) {
        const float* pw = p.in[I0_POOLW] + kb * 4096; const int nn = lane & 31, ch = lane >> 5;
        for (int cc = ch; cc < 64; cc += 2) { float a = 0.f;
#pragma unroll 8
            for (int d = 0; d < 64; ++d) a += pw[cc * 64 + d] * t0[d * 33 + nn];
            t1[cc * 33 + nn] = a; }
        asm volatile("s_waitcnt lgkmcnt(0)" ::: "memory");
        src = t1;
    }
#pragma unroll
    for (int j = 0; j < 4; ++j) { const int n = (lane >> 3) + 8 * j; const MLAS float* sp = src + (8 * c) * 33 + n;
        v4u o; o.x = pk2(sp[0 * 33], sp[1 * 33]); o.y = pk2(sp[2 * 33], sp[3 * 33]); o.z = pk2(sp[4 * 33], sp[5 * 33]); o.w = pk2(sp[6 * 33], sp[7 * 33]);
        *(v4u*)(WT + (size_t)(32 * nb + n) * wm.K + k0 + 8 * c) = o; }
    asm volatile("s_waitcnt lgkmcnt(0)" ::: "memory");
}

#ifndef P0MASK
#define P0MASK 15
#endif
template <int PART> __device__ __forceinline__ void phase_prologue(Ctx& C, int vcu, int G) {
    const Params& p = C.p; const int tid = tid_now(), lane = tid & 63;
    MLAS float* sil = (MLAS float*)C.lds;
    MLAS float* red = (MLAS float*)(C.lds + 9 * 1024 * 4);
    __syncthreads();
#ifdef ADA_SPLIT
    if (PART <= 2)
#else
    if (PART < 2)
#endif
    for (int i = tid; i < 9 * D; i += NTHR) { const int j = i / D, k = i % D; const float c = (j < 8) ? p.in[I_C][j * D + k] : p.in[I_CCTX][k]; sil[i] = c / (1.f + expf(-c)); }
    __syncthreads();
    float* MOD = (float*)(p.ws + WS_MOD);
#ifdef ADA_SPLIT
    constexpr int ADA_N = (PART == 0) ? 32 : (PART == 2) ? 64 : 96, ADA_BASE = (PART == 0) ? 0 : (PART == 2) ? 32 : 96;
    if ((P0MASK & 1) && PART <= 2)
    for (int it0 = vcu; it0 < ADA_N; it0 += G) { const int it = it0 + ADA_BASE;
#else
    if ((P0MASK & 1) && PART < 2)
    for (int it0 = vcu; it0 < 96; it0 += G) { const int it = it0 + 96 * PART;
#endif
        const int l = it / 96, r_ = it % 96, cg_ = r_ >> 2, kq = r_ & 3, n0 = cg_ * 256;
        const float* w = (l ? p.in[I1_ADAW] : p.in[I0_ADAW]) + (size_t)(kq * 256 + C.wave * 32) * 6144 + n0 + 4 * lane;
        f32x4 acc[9];
#pragma unroll
        for (int j = 0; j < 9; ++j) acc[j] = (f32x4){0.f, 0.f, 0.f, 0.f};
#pragma unroll 8
        for (int k = 0; k < 32; ++k) { const f32x4 wv = *(const f32x4*)(w + (size_t)k * 6144); const int kk = kq * 256 + C.wave * 32 + k;
#pragma unroll
            for (int j = 0; j < 9; ++j) acc[j] += wv * sil[j * D + kk]; }
#pragma unroll
        for (int j = 0; j < 9; ++j) *(MLAS f32x4*)(red + (C.wave * 9 + j) * 256 + 4 * lane) = acc[j];
        __syncthreads();
        for (int i = tid; i < 9 * 256; i += NTHR) { const int j = i >> 8, c = i & 255; float sm_ = 0.f;
#pragma unroll
            for (int wv = 0; wv < 8; ++wv) sm_ += red[(wv * 9 + j) * 256 + c];
            if (kq == 0) sm_ += (l ? p.in[I1_ADAB] : p.in[I0_ADAB])[n0 + c];
            atomicAdd(MOD + (size_t)(l * 9 + j) * 6144 + n0 + c, sm_); }
        __syncthreads();
    }
    __syncthreads();
    {
        MLAS float* PA = (MLAS float*)C.lds;
        MLAS float* PB = (MLAS float*)(C.lds + 64 * 65 * 4);
        bf16_t* WT = (bf16_t*)(p.ws + WS_W_OUT0);
#ifdef L0_SPLIT
        constexpr int POOL_PART = 2;
#else
        constexpr int POOL_PART = 0;
#endif
        if (PART == POOL_PART) for (int tile = vcu; tile < 128; tile += G) {
            const int g = tile >> 5, nb = tile & 31;
            for (int i = tid; i < 4096; i += NTHR) PA[(i >> 6) * 65 + (i & 63)] = p.in[I0_POOLW][g * 4096 + i];
            for (int i = tid; i < 2048; i += NTHR) { const int d = i >> 5, nn = i & 31; PB[d * 33 + nn] = p.in[I0_WOUT][(size_t)(g * 64 + d) * D + 32 * nb + nn] * p.in[I0_POOLS][g * 64 + d]; }
            __syncthreads();
            { const int c = tid >> 3, n4 = (tid & 7) * 4; float a0 = 0.f, a1 = 0.f, a2 = 0.f, a3 = 0.f;
#pragma unroll 8
                for (int d = 0; d < 64; ++d) { const float pa = PA[c * 65 + d]; const MLAS float* b = PB + d * 33 + n4; a0 += pa * b[0]; a1 += pa * b[1]; a2 += pa * b[2]; a3 += pa * b[3]; }
                bf16_t* o = WT + (size_t)(32 * nb + n4) * D + g * 64 + c;
                o[0] = f2bf(a0); o[D] = f2bf(a1); o[2 * D] = f2bf(a2); o[3 * D] = f2bf(a3); }
            __syncthreads();
        }
    }
    const int gw = vcu * NWAVES + C.wave, NGW = G * NWAVES;
    MLAS float* scr = (MLAS float*)(C.lds + C.wave * 16896);
    if (P0MASK & 2) {
        int rot = 0;
#define TR_MAT(M) { constexpr int ni = (wmat(M).K / 64) * (wmat(M).N / 32); int first = gw - rot; if (first < 0) first += NGW; \
            for (int it = first; it < ni; it += NGW) transpose_item<M>(p, it, scr, lane); rot = (rot + ni) % NGW; }
        if (PART == 0) { TR_MAT(W_IN0)
#ifndef L0_SPLIT
            TR_MAT(W_OUT0) TR_MAT(W_GU0) TR_MAT(W_D0)
#endif
        }
        else if (PART == 2) { TR_MAT(W_OUT0) TR_MAT(W_GU0)
#if !defined(D0_IN_P6) && !defined(CTXD_IN_P6)
            TR_MAT(W_D0)
#endif
        }
        else if (PART == 3) { TR_MAT(W_D0) }
        else if (PART == 1) { TR_MAT(W_IN1) TR_MAT(W_UQ) TR_MAT(W_UKV)
#ifndef CTXD_IN_P6
            TR_MAT(W_OUT1) TR_MAT(W_GU1) TR_MAT(W_D1)
#endif
        }
        else if (PART == 4) { TR_MAT(W_OUT1) TR_MAT(W_GU1) TR_MAT(W_D1) }
#undef TR_MAT
    }
    if (PART == 0 && (P0MASK & 4) && C.bid == C.G - 1) {
        float* T32 = (float*)(p.ws + WS_ROPE32); float* T16 = (float*)(p.ws + WS_ROPE16);
        for (int i = tid; i < 1024; i += NTHR) { const int pos = i >> 4, f = i & 15; const float ang = (float)pos * powf(10000.0f, -((float)f * 2.0f) / 32.0f); T32[i] = cosf(ang); T32[1024 + i] = sinf(ang); }
        for (int i = tid; i < 512; i += NTHR) { const int pos = i >> 3, f = i & 7; const float ang = (float)pos * powf(10000.0f, -((float)f * 2.0f) / 16.0f); T16[i] = cosf(ang); T16[512 + i] = sinf(ang); }
    }
    if (PART == 0 && (P0MASK & 8)) { float* SSQ = (float*)(p.ws + WS_SSQ); float* SSKV = (float*)(p.ws + WS_SSKV);
        for (int i = C.bid * NTHR + tid; i < MT; i += C.G * NTHR) { SSQ[i] = 0.f; SSKV[i] = 0.f; }
#ifdef FOLD_N13
        { float* SSN1 = (float*)(p.ws + WS_SSN1); for (int i = C.bid * NTHR + tid; i < ML; i += C.G * NTHR) SSN1[i] = 0.f; }
#endif
    }
}

__device__ __forceinline__ void phase_norm(Ctx& C, const float* xl, const float* xc, const float* gain, int layer, int sh_chunk, int sc_chunk, int nrows, const float* slab = nullptr, int nslab = 0, float* xc_wb = nullptr) {
    const int lane = tid_now() & 63;
    const int gw = C.vcu * NWAVES + C.wave, NGW = C.G * NWAVES;
    bf16_t* XN = (bf16_t*)(C.p.ws + WS_XN); const float* MODb = (const float*)(C.p.ws + WS_MOD) + (size_t)layer * 9 * 6144;
    for (int m = gw; m < nrows; m += NGW) {
        const float* xr = m < ML ? xl + (size_t)m * D : xc + (size_t)(m - ML) * D;
        const float* mod = MODb + (size_t)modidx_of(m) * 6144;
        f32x4 v[4]; float ss = 0.f;
#pragma unroll
        for (int j = 0; j < 4; ++j) { v[j] = *(const f32x4*)(xr + 4 * lane + 256 * j);
            if (m >= ML && nslab > 0) { for (int s_ = 0; s_ < nslab; ++s_) v[j] += *(const f32x4*)(slab + (size_t)s_ * MC * D + (size_t)(m - ML) * D + 4 * lane + 256 * j);
                if (xc_wb) *(f32x4*)(xc_wb + (size_t)(m - ML) * D + 4 * lane + 256 * j) = v[j]; }
            ss += (v[j][0] * v[j][0] + v[j][1] * v[j][1]) + (v[j][2] * v[j][2] + v[j][3] * v[j][3]); }
        ss = wave_sum(ss);
        const float r = rsqrtf(ss * (1.f / D) + EPS);
#pragma unroll
        for (int j = 0; j < 4; ++j) { const int c = 4 * lane + 256 * j;
            const f32x4 g = *(const f32x4*)(gain + c), sc = *(const f32x4*)(mod + sc_chunk * D + c), sh = *(const f32x4*)(mod + sh_chunk * D + c);
            const f32x4 y = ((v[j] * r) * g) * (sc + 1.f) + sh;
            uint2 o; o.x = pk2(y[0], y[1]); o.y = pk2(y[2], y[3]);
            *(uint2*)(XN + (size_t)m * D + c) = o; }
    }
}

__device__ __forceinline__ void phase_bias(Ctx& C, int vcu, int Gn, const bf16_t* Wt, int npos, const float* shift  , int nb, float* bias) {
    const int tid = tid_now(), lane = tid & 63;
    MLAS float* sh = (MLAS float*)C.lds;
    __syncthreads();
    for (int i = tid; i < nb * D; i += NTHR) sh[i] = shift[(size_t)(i / D) * 6144 + (i % D)];
    __syncthreads();
    const int gw = vcu * NWAVES + C.wave, NGW = Gn * NWAVES;
    for (int pos = gw; pos < npos; pos += NGW) {
        const v4u w0 = *(const v4u*)(Wt + (size_t)pos * D + 16 * lane), w1 = *(const v4u*)(Wt + (size_t)pos * D + 16 * lane + 8);
        float wf[16];
#pragma unroll
        for (int e = 0; e < 4; ++e) { wf[2 * e] = __uint_as_float(w0[e] << 16); wf[2 * e + 1] = __uint_as_float(w0[e] & 0xffff0000u); wf[8 + 2 * e] = __uint_as_float(w1[e] << 16); wf[8 + 2 * e + 1] = __uint_as_float(w1[e] & 0xffff0000u); }
        float mine = 0.f;
        for (int b = 0; b < nb; ++b) { float s = 0.f;
#pragma unroll
            for (int q = 0; q < 4; ++q) { const f32x4 sv = *(const MLAS f32x4*)(sh + b * D + 16 * lane + 4 * q); s += (wf[4 * q] * sv[0] + wf[4 * q + 1] * sv[1]) + (wf[4 * q + 2] * sv[2] + wf[4 * q + 3] * sv[3]); }
            s = wave_sum(s); if (lane == b) mine = s; }
        if (lane < nb) bias[(size_t)lane * npos + pos] = mine;
    }
}

__device__ __forceinline__ void phase_pool(Ctx& C) {
    const bf16_t* A0 = (const bf16_t*)(C.p.ws + WS_A0); bf16_t* MIX = (bf16_t*)(C.p.ws + WS_MIX);
    const int skip = (C.G > 128) ? 96 : 0;
    if (C.vcu < skip) return;
    const int gt = (C.vcu - skip) * NTHR + tid_now(), NGT = (C.G - skip) * NTHR;
    for (int it = gt; it < MT * 32; it += NGT) {
        const int m = it >> 5, c8 = (it & 31) * 8, g = c8 >> 6, w = 2 << g;
        int t, T; if (m < ML) { t = m % S; T = S; } else { t = (m - ML) % CTX; T = CTX; }
        const int base = m - t; int lo = t - w / 2; if (lo < 0) lo = 0; int hi = t - w / 2 + w; if (hi > T) hi = T;
        float s[8];
#pragma unroll
        for (int e = 0; e < 8; ++e) s[e] = 0.f;
        for (int j = lo; j < hi; ++j) { const v4u q = *(const v4u*)(A0 + (size_t)(base + j) * 256 + c8);
#pragma unroll
            for (int e = 0; e < 4; ++e) { s[2 * e] += __uint_as_float(q[e] << 16); s[2 * e + 1] += __uint_as_float(q[e] & 0xffff0000u); } }
        const v4u q = *(const v4u*)(A0 + (size_t)m * 256 + c8); const float inv = 1.f / (float)(hi - lo);
        v4u o;
#pragma unroll
        for (int e = 0; e < 4; ++e) o[e] = pk2(s[2 * e] * inv - __uint_as_float(q[e] << 16), s[2 * e + 1] * inv - __uint_as_float(q[e] & 0xffff0000u));
        *(v4u*)(MIX + (size_t)m * D + c8) = o;
    }
}


__device__ __forceinline__ void phase_natable(Ctx& C, int vcu, int Gn) {
    bf16_t* G = (bf16_t*)(C.p.ws + WS_NAG); const float* rpb = C.p.in[I1_RPB];
    const int gt = vcu * NTHR + tid_now(), NGT = Gn * NTHR;
    for (int it = gt; it < 8 * 16 * 2 * 64 * 32; it += NGT) {
        const int j = it & 31, kc = (it >> 5) & 63, half = (it >> 11) & 1, dr = (it >> 12) & 15, h = it >> 16;
        const int qc = 32 * half + j, cs = min(max(qc - 8, 0), 48);
        float v = -30000.f;
        if (dr < 15 && (unsigned)(kc - cs) < 16u) v = rpb[(h * 15 + dr) * 31 + (kc - qc + 15)] * LOG2E;
        G[it] = f2bf(v);
    }
}

__device__ __forceinline__ void phase_attn0(Ctx& C) {
    const Params& p = C.p;
    MLAS char* shm = (MLAS char*)C.lds;
    att::UnitDesc U; U.Q = (const bf16_t*)(p.ws + WS_Q0); U.qpitch = 768; U.K = (const bf16_t*)(p.ws + WS_K0); U.kpitch = 256; U.V = (const bf16_t*)(p.ws + WS_V0); U.vpitch = 256;
    U.O = (bf16_t*)(p.ws + WS_MIX); U.opitch = D; U.rg = 0; U.rmin = 0; U.head = 0; U.G = nullptr;
    for (int u = C.vcu; u < 768 + 96; u += C.G) {
        if (u < 768) { const int qb = u & 7, bh = u >> 3, h = bh % 12, b = bh / 12;
            U.q0 = (long)b * S + 256 * qb; U.qcol = h * 64; U.kcol = (h / 3) * 64; U.vcol = (h / 3) * 64; U.ocol = 256 + h * 64; U.kv0 = b * SK; U.nt = SK / 64; }
        else { const int bh = u - 768, h = bh % 12, b = bh / 12;
            U.q0 = (long)ML + 256 * b; U.qcol = h * 64; U.kcol = (h / 3) * 64; U.vcol = (h / 3) * 64; U.ocol = 256 + h * 64; U.kv0 = b * SK; U.nt = CTX / 64; }
#ifdef USE_ATT64
        att64::attn_unit<8>(U.q0, (const att64::bf16*)U.Q, U.qpitch, U.qcol, (const att64::bf16*)U.K, U.kpitch, U.kcol, (const att64::bf16*)U.V, U.vpitch, U.vcol, (long)U.kv0, U.nt, (att64::bf16*)U.O, U.opitch, U.ocol, C.lds_g);
#else
        att::attn_unit<64, false, false>(U, shm, nullptr, nullptr, nullptr);
#endif
    }
    phase_pool(C);
}
__device__ __forceinline__ void phase_attn1(Ctx& C) {
    const Params& p = C.p;
    MLAS char* shm = (MLAS char*)C.lds;
    const float* T16 = (const float*)(p.ws + WS_ROPE16);
    att::UnitDesc U; U.O = (bf16_t*)(p.ws + WS_MIX); U.opitch = D; U.G = (const bf16_t*)(p.ws + WS_NAG);
    for (int u = C.vcu; u < 1024; u += C.G) {
        const int uu = u & 511, qb = uu & 7, h = (uu >> 3) & 7, b = uu >> 6;
        U.q0 = (long)b * S + 256 * qb; U.kv0 = b * SK; U.head = h;
        if (u < 512) {
            U.Q = (const bf16_t*)(p.ws + WS_MQ); U.qpitch = 768; U.qcol = h * 96; U.K = (const bf16_t*)(p.ws + WS_MK); U.kpitch = 768; U.kcol = h * 96;
            U.V = (const bf16_t*)(p.ws + WS_MV); U.vpitch = 512; U.vcol = h * 64; U.ocol = h * 64; U.nt = SK / 64; U.rg = 0; U.rmin = 0;
#ifdef USE_ATT96
            att96::attn_unit<8>(U.q0, (const att96::bf16*)U.Q, U.qpitch, U.qcol, (const att96::bf16*)U.K, U.kpitch, U.kcol, (const att96::bf16*)U.V, U.vpitch, U.vcol, (long)U.kv0, U.nt, (att96::bf16*)U.O, U.opitch, U.ocol, C.lds_g, p.in[I1_MQG], T16);
#ifdef DUP_MLA
            att96::attn_unit<8>(U.q0, (const att96::bf16*)U.Q, U.qpitch, U.qcol, (const att96::bf16*)U.K, U.kpitch, U.kcol, (const att96::bf16*)U.V, U.vpitch, U.vcol, (long)U.kv0, U.nt, (att96::bf16*)U.O, U.opitch, U.ocol, C.lds_g, p.in[I1_MQG], T16);
#endif
#else
            att::attn_unit<96, false, true>(U, shm, p.in[I1_MQG], T16, nullptr);
#ifdef DUP_MLA
            att::attn_unit<96, false, true>(U, shm, p.in[I1_MQG], T16, nullptr);
#endif
#endif
        } else {
            U.Q = (const bf16_t*)(p.ws + WS_NQ); U.qpitch = 512; U.qcol = h * 64; U.K = (const bf16_t*)(p.ws + WS_NK); U.kpitch = 512; U.kcol = h * 64;
            U.V = (const bf16_t*)(p.ws + WS_NV); U.vpitch = 512; U.vcol = h * 64; U.ocol = 512 + h * 64; U.rg = qb;
            const int rmin = min(max(4 * qb - 4, 0), 24), rmax = min(max(4 * qb + 3 - 4, 0), 24) + 7;
            U.rmin = rmin; U.nt = 4 + (rmax - rmin + 1);
#ifdef USE_ATTNA
            attna::attn_unit<8>(U.q0, (const attna::bf16*)U.Q, U.qpitch, U.qcol, (const attna::bf16*)U.K, U.kpitch, U.kcol, (const attna::bf16*)U.V, U.vpitch, U.vcol, (long)U.kv0, (U.nt + 1) & ~1, (attna::bf16*)U.O, U.opitch, U.ocol, C.lds_g, U.rmin, U.rg, p.in[I1_RPB] + h * 465);
#ifdef DUP_NA
            attna::attn_unit<8>(U.q0, (const attna::bf16*)U.Q, U.qpitch, U.qcol, (const attna::bf16*)U.K, U.kpitch, U.kcol, (const attna::bf16*)U.V, U.vpitch, U.vcol, (long)U.kv0, (U.nt + 1) & ~1, (attna::bf16*)U.O, U.opitch, U.ocol, C.lds_g, U.rmin, U.rg, p.in[I1_RPB] + h * 465);
#endif
#else
            att::attn_unit<64, true, false>(U, shm, nullptr, nullptr, p.in[I1_RPB]);
#ifdef DUP_NA
            att::attn_unit<64, true, false>(U, shm, nullptr, nullptr, p.in[I1_RPB]);
#endif
#endif
        }
    }
}

__global__ void __launch_bounds__(NTHR, 2) mega(Params p, int ph_lo, int ph_hi) {
    extern __shared__ __attribute__((aligned(16))) unsigned char lds_raw[];
    cg::grid_group grid = cg::this_grid();
    Ctx C; C.p = p; C.lds = (MLAS unsigned char*)lds_raw; C.lds_g = (char*)lds_raw; C.wave = __builtin_amdgcn_readfirstlane((int)threadIdx.x >> 6);
    C.G = gridDim.x; C.bid = blockIdx.x; C.vcu = (C.G % 8 == 0) ? (C.bid % 8) * (C.G / 8) + C.bid / 8 : C.bid;
    volatile LAS unsigned* bst = (volatile LAS unsigned*)(C.lds + LDS_BYTES - 64);
    if (threadIdx.x < 2) bst[threadIdx.x] = 0u;
    __syncthreads();
    unsigned* barw = (unsigned*)(p.ws + WS_BARRIER);
    XcdBarrier bar; bar.bar = barw; bar.x = 0; bar.st = nullptr;
    if (ph_hi - ph_lo > 1) bar = xcd_barrier_post(barw, bst);
    float* out = p.out; float* xrc = (float*)(p.ws + WS_XRC);
    const float* MOD = (const float*)(p.ws + WS_MOD);
    bf16_t* XN = (bf16_t*)(p.ws + WS_XN); bf16_t* MIX = (bf16_t*)(p.ws + WS_MIX); bf16_t* H = (bf16_t*)(p.ws + WS_H);
    const float* T32 = (const float*)(p.ws + WS_ROPE32); const float* T16 = (const float*)(p.ws + WS_ROPE16);
#define WSB(off) ((bf16_t*)(p.ws + (off)))
#ifndef PHMASK
#define PHMASK 0xFFFF
#endif
#ifndef REPMASK
#define REPMASK 0
#endif
#ifndef NSYNC
#define NSYNC 1
#endif
#define PH(k) if (((PHMASK >> (k)) & 1) && ph_lo <= (k) && (k) < ph_hi) for (int rep_ = 0; rep_ < (((REPMASK >> (k)) & 1) ? 2 : 1); ++rep_, (((REPMASK >> (k)) & 1) && rep_ == 1 ? xcd_barrier(bar) : (void)0))
#ifndef USE_CG_SYNC
#define USE_CG_SYNC 0
#endif
#define SEAM(k) if (ph_lo <= (k) && (k) + 1 < ph_hi) { for (int s_ = 0; s_ < NSYNC; ++s_) { if (USE_CG_SYNC || ph_hi > 1000) grid.sync(); else xcd_barrier(bar); } }
    PH(0) { phase_prologue<0>(C, C.vcu, C.G);
#if !defined(L1_LATE) && !defined(L1_IN_P7)
        phase_prologue<1>(C, C.vcu, C.G);
#endif
    } SEAM(0);
    PH(1) { phase_norm(C, p.in[I_X], p.in[I_CTX], p.in[I0_NMIX], 0, 0, 1, MT); } SEAM(1);
    PH(2) { pg8::Gemm g{XN, WSB(WS_W_IN0), MT, 1536, D, D}; pg8::StaticOrder So; So.init(MT, 1536, C.G, C.bid);
        epi::EpiIn0 E{WSB(WS_A0), WSB(WS_Q0), WSB(WS_K0), WSB(WS_V0), p.in[I0_QG], p.in[I0_KG], T32};
        pg8::gemm_phase<epi::EpiIn0, pg8::StaticOrder, ALIGN2, true>(C.lds, g, So, E);
#ifdef L0_SPLIT
        { const int n2 = (MT / 256) * 6 - C.G;
          if (n2 >= 0 && n2 < C.G) { if (C.bid >= n2) phase_prologue<2>(C, C.bid - n2, C.G - n2); } else phase_prologue<2>(C, C.vcu, C.G); }
#endif
#ifdef L1_LATE
        { const int n2 = (MT / 256) * 6 - C.G;
          if (n2 >= 0 && n2 < C.G && C.bid >= n2) phase_prologue<1>(C, C.bid - n2, C.G - n2);
          else if (n2 < 0 || n2 >= C.G) phase_prologue<1>(C, C.vcu, C.G); }
#endif
    } SEAM(2);
    PH(3) { phase_attn0(C); } SEAM(3);
    PH(4) { { pg8::Gemm g{MIX, WSB(WS_W_OUT0), ML, D, D, D}; pg8::StaticOrder So; So.init(ML, D, C.G, C.bid);
          epi::EpiResid E{p.in[I_X], p.in[I_CTX], out, xrc, MOD + 2 * D};
          pg8::gemm_phase<epi::EpiResid, pg8::StaticOrder, ALIGN1, true>(C.lds, g, So, E); }
        { pg8::Gemm g{MIX, WSB(WS_W_OUT0), MT, D, D / 4, D}; pg8::CtxSplitOrder So; So.init(4, C.G, C.bid);
          epi::EpiResidSplit E{p.in[I_CTX], xrc, (float*)(p.ws + WS_SLAB4), MOD + 2 * D};
          pg8::gemm_phase<epi::EpiResidSplit, pg8::CtxSplitOrder, true, true>(C.lds, g, So, E); }
#ifdef CTXD_IN_P6
        if (C.G > 128) { if (C.bid >= 128) phase_prologue<3>(C, C.bid - 128, C.G - 128); } else phase_prologue<3>(C, C.vcu, C.G);
#endif
    } SEAM(4);
    PH(5) { phase_norm(C, out, xrc, p.in[I0_NFFN], 0, 3, 4, MT, (const float*)(p.ws + WS_SLAB4), 3, xrc); } SEAM(5);
#ifdef CTXD_IN_P6
    const bool ctxd = (C.G == 256);
#else
    const bool ctxd = false;
#endif
    PH(6) { pg8::Gemm g{XN, WSB(WS_W_GU0), MT, 2 * FF, D, D}; epi::EpiSwiGLU E{H};
        if (!ctxd) { pg8::StaticOrder So; So.init(MT, 2 * FF, C.G, C.bid);
            pg8::gemm_phase<epi::EpiSwiGLU, pg8::StaticOrder, true, true>(C.lds, g, So, E);
#ifdef D0_IN_P6
            { const int total = (MT / 256) * (2 * FF / 256), full = total / C.G, n7 = total - full * C.G;
              if (n7 > 0 && n7 < C.G) { if (C.bid >= n7) phase_prologue<3>(C, C.bid - n7, C.G - n7); } else phase_prologue<3>(C, C.vcu, C.G); }
#endif
        }
#ifdef CTXD_IN_P6
        else {
            unsigned* flag = barw + XB_CTXH;
            { pg8::CtxFirstOrder So; So.init(0, C.bid); epi::EpiSwiGLUW EW{H}; pg8::gemm_phase<epi::EpiSwiGLUW, pg8::CtxFirstOrder, true, true>(C.lds, g, So, EW); }
            if (C.bid >= 80 && threadIdx.x == 0) xb_add(flag, 1u);
            { pg8::CtxFirstOrder So; So.init(1, C.bid); pg8::gemm_phase<epi::EpiSwiGLU, pg8::CtxFirstOrder, true, true>(C.lds, g, So, E); }
            if (C.bid >= 48 && C.bid < 176) {
                if (threadIdx.x == 0) { XB_SPIN(xb_ld(flag) < 176u, barw); __builtin_amdgcn_fence(__ATOMIC_ACQUIRE, "agent"); asm volatile("s_waitcnt vmcnt(0)" ::: "memory"); }
                __syncthreads();
                if (C.bid < 112) { pg8::Gemm g2{H, WSB(WS_W_D0), MT, D, 768, FF}; pg8::CtxSplitOrder S2; S2.init(2, C.G, C.bid - 48);
                    epi::EpiResidSplit E2{xrc, xrc, (float*)(p.ws + WS_SLAB7), MOD + 5 * D, 0};
                    pg8::gemm_phase<epi::EpiResidSplit, pg8::CtxSplitOrder, true, true>(C.lds, g2, S2, E2); }
                else { pg8::Gemm g2{H + 1536, WSB(WS_W_D0) + 1536, MT, D, 640, FF}; pg8::CtxSplitOrder S2; S2.init(2, C.G, C.bid - 112);
                    epi::EpiResidSplit E2{xrc, xrc, (float*)(p.ws + WS_SLAB7), MOD + 5 * D, 2};
                    pg8::gemm_phase<epi::EpiResidSplit, pg8::CtxSplitOrder, true, true>(C.lds, g2, S2, E2); }
            } else if (C.bid >= 176) { phase_prologue<1>(C, C.bid - 176, C.G - 176); phase_natable(C, C.bid - 176, C.G - 176); }
        }
#endif
    } SEAM(6);
    PH(7) { { pg8::Gemm g{H, WSB(WS_W_D0), ML, D, FF, FF}; pg8::StaticOrder So; So.init(ML, D, C.G, C.bid);
          epi::EpiResid E{out, xrc, out, xrc, MOD + 5 * D};
          pg8::gemm_phase<epi::EpiResid, pg8::StaticOrder, ALIGN1, true>(C.lds, g, So, E); }
        if (!ctxd) {
        { pg8::Gemm g{H, WSB(WS_W_D0), MT, D, FF / 2, FF}; pg8::CtxSplitOrder So; So.init(2, C.G, C.bid);
          epi::EpiResidSplit E{xrc, xrc, (float*)(p.ws + WS_SLAB7), MOD + 5 * D};
          pg8::gemm_phase<epi::EpiResidSplit, pg8::CtxSplitOrder, true, true>(C.lds, g, So, E); }
#ifdef L1_IN_P7
        if (C.G > 64) { if (C.bid >= 64) { phase_prologue<1>(C, C.bid - 64, C.G - 64);
#ifdef CTXD_IN_P6
            phase_prologue<4>(C, C.bid - 64, C.G - 64);
#endif
            phase_natable(C, C.bid - 64, C.G - 64); } }
        else { phase_prologue<1>(C, C.vcu, C.G);
#ifdef CTXD_IN_P6
            phase_prologue<4>(C, C.vcu, C.G);
#endif
            phase_natable(C, C.vcu, C.G); }
#endif
        }
    } SEAM(7);
    PH(8) {
#ifndef L1_IN_P7
        phase_natable(C, C.vcu, C.G);
#endif
        phase_norm(C, out, xrc, p.in[I1_NMIX], 1, 0, 1, MT, (const float*)(p.ws + WS_SLAB7), ctxd ? 3 : 1, nullptr); } SEAM(8);
    PH(9) { pg8::Gemm g{XN, WSB(WS_W_IN1), MT, L1_INP, D, D}; pg8::StaticOrder So; So.init(MT, L1_INP, C.G, C.bid);
        epi::EpiIn1 E{WSB(WS_CQ), WSB(WS_CKV), WSB(WS_NQ), WSB(WS_NK), WSB(WS_NV), (float*)(p.ws + WS_KR), (float*)(p.ws + WS_SSQ), (float*)(p.ws + WS_SSKV), p.in[I1_NQG], p.in[I1_NKG]};
        pg8::gemm_phase<epi::EpiIn1, pg8::StaticOrder, ALIGN2, true>(C.lds, g, So, E);
#ifdef FOLD_N13
        { const int n3 = (MT / 256) * (L1_INP / 256) - 2 * C.G;
          if (n3 >= 0 && n3 < C.G) { if (C.bid >= n3) phase_bias(C, C.bid - n3, C.G - n3, WSB(WS_W_GU1), 2 * FF, MOD + 9 * 6144 + 3 * D, 8, (float*)(p.ws + WS_BIAS1)); }
          else phase_bias(C, C.vcu, C.G, WSB(WS_W_GU1), 2 * FF, MOD + 9 * 6144 + 3 * D, 8, (float*)(p.ws + WS_BIAS1)); }
#endif
#ifdef CTXD_IN_P6
        if (ctxd) { const int n3 = (MT / 256) * (L1_INP / 256) - 2 * C.G;
            if (n3 >= 0 && n3 < C.G) { if (C.bid >= n3) phase_prologue<4>(C, C.bid - n3, C.G - n3); } else phase_prologue<4>(C, C.vcu, C.G); }
#endif
    } SEAM(9);
    PH(10) {
#ifndef NO_QUP
        { pg8::Gemm g{WSB(WS_CQ), WSB(WS_W_UQ), ML, 768, 384, 384}; pg8::StaticOrder So; So.init(ML, 768, C.G, C.bid);
          epi::EpiQUp E{WSB(WS_MQ), (const float*)(p.ws + WS_SSQ)};
          pg8::gemm_phase<epi::EpiQUp, pg8::StaticOrder, ALIGN2, true>(C.lds, g, So, E); }
#endif
#ifndef NO_KVUP
        { pg8::Gemm g{WSB(WS_CKV), WSB(WS_W_UKV), MT, 1024, 256, 256}; pg8::StaticOrder So; So.init(MT, 1024, C.G, (C.bid + KVROT) % C.G);
          epi::EpiKvUp E{WSB(WS_MK), WSB(WS_MV), (const float*)(p.ws + WS_SSKV), (const float*)(p.ws + WS_KR), p.in[I1_MKG], T16};
          pg8::gemm_phase<epi::EpiKvUp, pg8::StaticOrder, ALIGN2, true>(C.lds, g, So, E); }
#endif
    } SEAM(10);
    PH(11) { phase_attn1(C); } SEAM(11);
#ifdef FOLD_N13
    PH(12) { pg8::Gemm g{MIX, WSB(WS_W_OUT1), ML, D, D, D}; pg8::StaticOrder So; So.init(ML, D, C.G, C.bid);
        epi::EpiResidN E{out, out, MOD + 9 * 6144 + 2 * D, WSB(WS_XN2), (float*)(p.ws + WS_SSN1), p.in[I1_NFFN], MOD + 9 * 6144 + 4 * D};
        pg8::gemm_phase<epi::EpiResidN, pg8::StaticOrder, ALIGN1, true>(C.lds, g, So, E); } SEAM(12);
    PH(14) { pg8::Gemm g{WSB(WS_XN2), WSB(WS_W_GU1), ML, 2 * FF, D, D}; pg8::StaticOrder So; So.init(ML, 2 * FF, C.G, C.bid);
        epi::EpiSwiGLUN E{H, (const float*)(p.ws + WS_SSN1), (const float*)(p.ws + WS_BIAS1)};
        pg8::gemm_phase<epi::EpiSwiGLUN, pg8::StaticOrder, true, true>(C.lds, g, So, E); } SEAM(14);
#else
    PH(12) { pg8::Gemm g{MIX, WSB(WS_W_OUT1), ML, D, D, D}; pg8::StaticOrder So; So.init(ML, D, C.G, C.bid);
        epi::EpiResid E{out, xrc, out, xrc, MOD + 9 * 6144 + 2 * D};
        pg8::gemm_phase<epi::EpiResid, pg8::StaticOrder, ALIGN1, true>(C.lds, g, So, E); } SEAM(12);
    PH(13) { phase_norm(C, out, xrc, p.in[I1_NFFN], 1, 3, 4, ML); } SEAM(13);
    PH(14) { pg8::Gemm g{XN, WSB(WS_W_GU1), ML, 2 * FF, D, D}; pg8::StaticOrder So; So.init(ML, 2 * FF, C.G, C.bid);
        epi::EpiSwiGLU E{H};
        pg8::gemm_phase<epi::EpiSwiGLU, pg8::StaticOrder, true, true>(C.lds, g, So, E); } SEAM(14);
#endif
    PH(15) { pg8::Gemm g{H, WSB(WS_W_D1), ML, D, FF, FF}; pg8::StaticOrder So; So.init(ML, D, C.G, C.bid);
        epi::EpiResid E{out, xrc, out, xrc, MOD + 9 * 6144 + 5 * D};
        pg8::gemm_phase<epi::EpiResid, pg8::StaticOrder, ALIGN1, true>(C.lds, g, So, E); }
    if (ph_hi - ph_lo > 1 && C.bid == 0 && threadIdx.x == 0) { if (xb_ld(&barw[XB_TMO]) != 0u) out[0] = __builtin_nanf(""); }
#undef PH
#undef SEAM
#undef WSB
}
}
#ifndef MK_DEBUG
#define MK_DEBUG 0
#endif
static int g_grid = 0;
static bool mega_setup() {
    if (g_grid) return g_grid > 0;
    int dev = 0, cus = 0, per_cu = 0;
    if (hipGetDevice(&dev) != hipSuccess || hipDeviceGetAttribute(&cus, hipDeviceAttributeMultiprocessorCount, dev) != hipSuccess) { g_grid = -1; return false; }
    if (hipFuncSetAttribute((const void*)mk::mega, hipFuncAttributeMaxDynamicSharedMemorySize, mk::LDS_BYTES) != hipSuccess) { fprintf(stderr, "kernel_launch: hipFuncSetAttribute failed\n"); g_grid = -1; return false; }
    if (hipOccupancyMaxActiveBlocksPerMultiprocessor(&per_cu, (const void*)mk::mega, mk::NTHR, mk::LDS_BYTES) != hipSuccess || per_cu < 1) { fprintf(stderr, "kernel_launch: occupancy query says %d\n", per_cu); g_grid = -1; return false; }
    g_grid = cus;
    fprintf(stderr, "kernel_launch: %d CUs, occupancy %d blocks/CU, grid %d\n", cus, per_cu, g_grid);
    return true;
}
static void launch_phases(const Params& p, int lo, int hi, hipStream_t st) {
    Params pp = p; int l = lo, h = hi;
    void* args[] = {&pp, &l, &h};
    hipError_t e;
    if (hi - lo > 1) e = hipLaunchCooperativeKernel((const void*)mk::mega, dim3(g_grid), dim3(mk::NTHR), args, mk::LDS_BYTES, st);
    else e = hipLaunchKernel((const void*)mk::mega, dim3(g_grid), dim3(mk::NTHR), args, mk::LDS_BYTES, st);
    if (e != hipSuccess) fprintf(stderr, "kernel_launch: launch [%d,%d) failed: %s\n", lo, hi, hipGetErrorString(e));
}
#if MK_DEBUG
static void launch_debug(const Params& p, hipStream_t st) {
    using namespace nv;
    unsigned* err = (unsigned*)(p.ws + WS_CTL) + 64;
    float* out = p.out; float* xrc = (float*)(p.ws + WS_XRC);
    const float* x = p.in[I_X]; const float* cx = p.in[I_CTX];
    const size_t att_sm = 4 * (SK + 128) * sizeof(float);
    const int SR = 4096;
    float* snapL = (float*)(p.ws + WS_SNAP); float* snapC = snapL + (size_t)SR * D;
    float* snapB = (float*)(p.ws + WS_BIG);
    hipMemsetAsync(p.ws + WS_CTL, 0, WS_SSQ, st);
    launch_phases(p, 0, 1, st);  k_adaln<true><<<dim3(6144 / 256, 9, 2), 256, 0, st>>>(p, err + 0);
    launch_phases(p, 1, 2, st);  k_norm<true><<<MT / 4, 256, 0, st>>>(p, x, cx, I0_NMIX, 0, 0, 1, MT, err + 1);
    launch_phases(p, 2, 3, st);  k_in0<true><<<MT / R, 256, (R * D + R * L0_IN) * 4, st>>>(p, err + 2);
    launch_phases(p, 3, 4, st);  k_attn<true, 0><<<dim3(ML / 4, 12), 256, att_sm, st>>>(p, err + 3);
                                 k_attn<true, 1><<<dim3(MC / 4, 12), 256, att_sm, st>>>(p, err + 16);
                                 k_pool0<true><<<MT, 256, 0, st>>>(p, err + 17);
    launch_phases(p, 4, 5, st);  k_out<true, 0><<<MT / R, 256, (R * D + R * 256) * 4, st>>>(p, x, cx, out, xrc, 0, err + 4);
    launch_phases(p, 5, 6, st);  k_norm<true><<<MT / 4, 256, 0, st>>>(p, out, xrc, I0_NFFN, 0, 3, 4, MT, err + 5);
    launch_phases(p, 6, 7, st);  k_ffn_gu<true, 0><<<MT / R, 256, R * D * 4, st>>>(p, err + 6);
    hipMemcpyAsync(snapL, out, (size_t)SR * D * 4, hipMemcpyDeviceToDevice, st); hipMemcpyAsync(snapC, xrc, (size_t)MC * D * 4, hipMemcpyDeviceToDevice, st);
    launch_phases(p, 7, 8, st);  k_ffn_d<true, 0><<<SR / R, 256, R * FF * 4, st>>>(p, snapL, snapC, out, xrc, 0, err + 7);
                                 k_ffn_d<true, 0><<<MC / R, 256, R * FF * 4, st>>>(p, snapL, snapC, out, xrc, ML, err + 7);
    launch_phases(p, 8, 9, st);  k_norm<true><<<MT / 4, 256, 0, st>>>(p, out, xrc, I1_NMIX, 1, 0, 1, MT, err + 8);
    launch_phases(p, 9, 10, st); k_in1<true><<<MT / R, 256, (R * D + R * L1_IN) * 4, st>>>(p, err + 9);
    launch_phases(p, 10, 11, st); k_mlaq<true><<<ML / R, 256, R * 384 * 4, st>>>(p, err + 10);
                                 k_mlakv<true><<<MT / R, 256, (R * 256 + R * 1024) * 4, st>>>(p, err + 19);
    launch_phases(p, 11, 12, st); k_attn<true, 2><<<dim3(ML / 4, 8), 256, att_sm, st>>>(p, err + 11);
                                 k_attn<true, 3><<<dim3(ML / 4, 8), 256, att_sm, st>>>(p, err + 18);
    hipMemcpyAsync(snapB, out, (size_t)SR * D * 4, hipMemcpyDeviceToDevice, st);
    launch_phases(p, 12, 13, st); k_out<true, 1><<<SR / R, 256, (R * D + R * 256) * 4, st>>>(p, snapB, snapC, out, xrc, 0, err + 12);
    launch_phases(p, 13, 14, st); k_norm<true><<<ML / 4, 256, 0, st>>>(p, out, xrc, I1_NFFN, 1, 3, 4, ML, err + 13);
    launch_phases(p, 14, 15, st); k_ffn_gu<true, 1><<<ML / R, 256, R * D * 4, st>>>(p, err + 14);
    hipMemcpyAsync(snapL, out, (size_t)SR * D * 4, hipMemcpyDeviceToDevice, st);
    launch_phases(p, 15, 16, st); k_ffn_d<true, 1><<<SR / R, 256, R * FF * 4, st>>>(p, snapL, snapC, out, xrc, 0, err + 15);
    k_report<<<1, 1, 0, st>>>(p, 20, 0.15f);
}
#endif
extern "C" void kernel_launch(void* const* d_in, const int* in_sizes, int n_in, void* d_out, int out_size, void* d_ws, size_t ws_size, hipStream_t stream) {
    if (n_in != N_IN || out_size != ML * D || ws_size < WS_END) { fprintf(stderr, "kernel_launch: unexpected shapes n_in=%d out=%d ws=%zu\n", n_in, out_size, ws_size); return; }
    if (!mega_setup()) return;
    Params p{};
    for (int i = 0; i < N_IN; ++i) p.in[i] = (const float*)d_in[i];
    p.out = (float*)d_out; p.ws = (unsigned char*)d_ws;
#if MK_DEBUG
    launch_debug(p, stream);
#else
    if (hipMemsetAsync((char*)d_ws + WS_BARRIER, 0, WS_SSQ - WS_BARRIER, stream) != hipSuccess) { fprintf(stderr, "kernel_launch: memset failed\n"); return; }
#ifdef EXTRA_MEMSET
    (void)hipMemsetAsync((char*)d_ws + WS_CTL, 0, 4096, stream);
#endif
    launch_phases(p, 0, mk::NPHASE, stream);
#endif
}
```

```cpp
#define USE_ATT64 1
#define USE_ATT96 1
#define ATT_STATIC_PRIO 1
#define L1_IN_P7 1
#define L0_SPLIT 1
#define D0_IN_P6 1
#define FOLD_N13 1
#define BF16RES 1
#include <hip/hip_runtime.h>
#include <hip/hip_cooperative_groups.h>
#include <cstdio>
#include <cstdint>
namespace cg = cooperative_groups;

typedef unsigned short bf16_t;
constexpr int D = 1024, NB = 8, S = 2048, CTX = 256, SK = S + CTX, ML = NB * S, MC = NB * CTX, MT = ML + MC, FF = 2816;
constexpr int GW = 64;
constexpr int L0_IN = 1536, L1_IN = 2208, L1_INP = 2304;
constexpr float EPS = 1e-6f;
constexpr float LOG2E = 1.4426950408889634f;
constexpr float C2_64 = 0.125f * LOG2E;
constexpr float C2_96 = 0.10206207261596577f * LOG2E;

enum { I_X = 0, I_C, I_CTX, I_CCTX,
       I0_ADAW, I0_ADAB, I0_NMIX, I0_NFFN, I0_WIN, I0_POOLW, I0_POOLS, I0_QG, I0_KG, I0_WOUT, I0_WG, I0_WU, I0_WD,
       I1_ADAW, I1_ADAB, I1_NMIX, I1_NFFN, I1_WIN, I1_QAG, I1_KVAG, I1_WUQ, I1_WUKV, I1_MQG, I1_MKG, I1_NQG, I1_NKG, I1_RPB, I1_WOUT, I1_WG, I1_WU, I1_WD, N_IN };

constexpr size_t MiB = 1u << 20;
constexpr size_t WS_CTL = 0;
constexpr size_t WS_BARRIER = 16 * 1024;
constexpr size_t WS_MOD = 64 * 1024;
constexpr size_t WS_SSQ = 512 * 1024;
constexpr size_t WS_SSKV = 600 * 1024;
constexpr size_t WS_ROPE32 = 700 * 1024;
constexpr size_t WS_ROPE16 = 712 * 1024;
constexpr size_t WS_W_IN0 = 1 * MiB;
constexpr size_t WS_W_OUT0 = 4 * MiB;
constexpr size_t WS_W_GU0 = 6 * MiB;
constexpr size_t WS_W_D0 = 17 * MiB;
constexpr size_t WS_W_IN1 = 23 * MiB;
constexpr size_t WS_W_UQ = 28 * MiB;
constexpr size_t WS_W_UKV = 29 * MiB;
constexpr size_t WS_W_OUT1 = 30 * MiB;
constexpr size_t WS_W_GU1 = 32 * MiB;
constexpr size_t WS_W_D1 = 43 * MiB;
constexpr size_t WS_XRC = 49 * MiB;
constexpr size_t WS_XN = 57 * MiB;
constexpr size_t WS_MIX = WS_XN;
constexpr size_t WS_BIG = 96 * MiB;
constexpr size_t WS_H = WS_BIG;
constexpr size_t WS_A0 = WS_BIG;
constexpr size_t WS_Q0 = WS_BIG + 9 * MiB;
constexpr size_t WS_K0 = WS_BIG + 36 * MiB;
constexpr size_t WS_V0 = WS_BIG + 45 * MiB;
constexpr size_t WS_CQ = WS_BIG;
constexpr size_t WS_CKV = WS_BIG + 14 * MiB;
constexpr size_t WS_NQ = WS_BIG + 23 * MiB;
constexpr size_t WS_NK = WS_BIG + 41 * MiB;
constexpr size_t WS_NV = WS_BIG + 59 * MiB;
constexpr size_t WS_MQ = WS_BIG + 77 * MiB;
constexpr size_t WS_MK = WS_BIG + 101 * MiB;
constexpr size_t WS_MV = WS_BIG + 128 * MiB;
constexpr size_t WS_KR = WS_BIG + 146 * MiB;
constexpr size_t WS_SLAB4 = WS_BIG;
constexpr size_t WS_SLAB7 = WS_BIG + 100 * MiB;
constexpr size_t WS_NAG = WS_BIG + 150 * MiB;
constexpr size_t WS_SSN1 = 768 * 1024;
constexpr size_t WS_BIAS1 = 832 * 1024;
constexpr size_t WS_XN2 = WS_BIG + 88 * MiB;
constexpr size_t WS_X3 = WS_BIG + 120 * MiB;
constexpr size_t WS_SNAP = WS_BIG + 100 * MiB;
constexpr size_t WS_END = 256 * MiB;
static_assert(WS_KR + (size_t)MT * 32 * 4 <= WS_END, "ws map");
static_assert(WS_X3 + (size_t)ML * D * 2 <= WS_END, "ws map");
static_assert(WS_W_D1 + (size_t)D * FF * 2 <= WS_XRC, "ws map");
static_assert(WS_XN + (size_t)MT * D * 2 <= WS_BIG, "ws map");

__device__ __forceinline__ float bf2f(bf16_t u) { return __uint_as_float((unsigned)u << 16); }
__device__ __forceinline__ bf16_t f2bf(float f) { unsigned u = __float_as_uint(f); return (bf16_t)((u + 0x7fffu + ((u >> 16) & 1u)) >> 16); }
__device__ __forceinline__ int kvrow_of(int m) { return m < ML ? (m / S) * SK + CTX + (m % S) : ((m - ML) / CTX) * SK + ((m - ML) % CTX); }
__device__ __forceinline__ int modidx_of(int m) { return m < ML ? m / S : 8; }
__device__ __forceinline__ float wave_sum(float v) {
#pragma unroll
    for (int o = 1; o < 64; o <<= 1) v += __shfl_xor(v, o);
    return v;
}
__device__ __forceinline__ float wave_max(float v) {
#pragma unroll
    for (int o = 1; o < 64; o <<= 1) v = fmaxf(v, __shfl_xor(v, o));
    return v;
}

struct Params {
    const float* in[N_IN];
    float* out;
    unsigned char* ws;
};
namespace pg8 {
#define PG8_LAS __attribute__((address_space(3)))
typedef unsigned short bf16_t;
typedef short bf16x8 __attribute__((ext_vector_type(8)));
typedef float f32x4 __attribute__((ext_vector_type(4)));
typedef unsigned u32x4 __attribute__((ext_vector_type(4)));
constexpr int BM = 256, BK = 64, HALF = 128, HTB = HALF * BK * 2  , STAGE_BYTES = 8 * HTB, NXCD = 8, WGM = 8;

__host__ __device__ __forceinline__ int lds_byte(int r, int c) { const int st = (r >> 4) * 2 + (c >> 5), rr = r & 15, cc = c & 31, ob = rr * 64 + cc * 2; return st * 1024 + (ob ^ (((ob >> 9) & 1) << 5)); }
__host__ __device__ __forceinline__ void stage_rc(int b, int& R, int& C) { const int st = b / 1024, sb = b % 1024, swz = sb ^ (((sb >> 9) & 1) << 5); R = (st >> 1) * 16 + swz / 64; C = (st & 1) * 32 + (swz % 64) / 2; }
__host__ __device__ __forceinline__ int perm32(int rho) { const int n = rho >> 4, i = rho & 15; return 8 * (i >> 2) + 4 * n + (i & 3); }

struct Unit { int pm, pn, ks; };
struct Gemm { const bf16_t* A; const bf16_t* Bt; int M, N, K, ld; };

struct StaticOrder {
    int nM, nN, nwg, G, c;
    __host__ __device__ void init(int M, int N, int G_, int c_) { nM = M / BM; nN = N / BM; nwg = nM * nN; G = G_; c = c_; }
    __host__ __device__ bool next(int i, Unit& u) const {
        const long L = (long)i * G + c; if (L >= nwg) return false;
        int wgid = (int)L; { const int q = nwg / NXCD, r = nwg % NXCD, xcd = wgid % NXCD, off = wgid / NXCD; wgid = (xcd < r ? xcd * (q + 1) : r * (q + 1) + (xcd - r) * q) + off; }
        const int nig = WGM * nN, gid = wgid / nig, fm = gid * WGM, gsz = (nM - fm) < WGM ? (nM - fm) : WGM;
        u.pm = fm + ((wgid % nig) % gsz); u.pn = (wgid % nig) / gsz; u.ks = 0; return true;
    }
    __device__ __forceinline__ void a_ready(const Unit&) const {}
    __device__ __forceinline__ void done(const Unit&) const {}
};

__device__ __forceinline__ unsigned cvt_pk_bf16(float lo, float hi) { unsigned r; asm volatile("v_cvt_pk_bf16_f32 %0, %1, %2" : "=v"(r) : "v"(lo), "v"(hi)); return r; }
typedef float f32x2 __attribute__((ext_vector_type(2)));
struct CtxSplitOrder {
    int G, c, split;
    __host__ __device__ void init(int split_, int G_, int c_) { split = split_; G = G_; c = c_; }
    __host__ __device__ bool next(int i, Unit& u) const {
        const int L = i * G + c; if (L >= 32 * split) return false;
        u.ks = L % split; const int t = L / split; u.pn = t & 3; u.pm = 64 + (t >> 2); return true;
    }
    __device__ __forceinline__ void a_ready(const Unit&) const {}
    __device__ __forceinline__ void done(const Unit&) const {}
};
struct CtxFirstOrder {
    int c, mode; StaticOrder lat;
    __host__ __device__ void init(int mode_, int c_) { mode = mode_; c = c_; lat.init(64 * BM, 22 * BM, 1 << 28, 0); }
    __host__ __device__ bool next(int i, Unit& u) const {
        if (mode == 0) { if (i != 0 || c < 80) return false; const int j = c - 80; u.pm = 64 + (j & 7); u.pn = j >> 3; u.ks = 0; return true; }
        const int Lp = c < 80 ? (i == 0 ? c : 80 + (i - 1) * 256 + c) : 80 + i * 256 + c;
        if (Lp >= 1408) return false;
        StaticOrder t = lat; t.c = Lp; return t.next(0, u);
    }
    __device__ __forceinline__ void a_ready(const Unit&) const {}
    __device__ __forceinline__ void done(const Unit&) const {}
};
template <class Epi, class Sched, bool ALIGN_EPI = false, bool SP2 = false>
__device__ __forceinline__ void gemm_phase(PG8_LAS unsigned char* lds, const Gemm g, const Sched& S, const Epi& E) {
    int tid_ = threadIdx.x; asm volatile("" : "+v"(tid_));
    const int tid = tid_, wid = __builtin_amdgcn_readfirstlane(tid >> 6), lane = tid & 63, wr = wid >> 2, wc = wid & 3, fr = lane & 15, fq = lane >> 4;
    int K_ = g.K; asm volatile("" : "+s"(K_));
    const int K = K_, nt = K / BK; int LD_ = g.ld; asm volatile("" : "+s"(LD_)); const int LD = LD_;
    unsigned voffA[2], voffB[2];
#pragma unroll
    for (int i = 0; i < 2; ++i) { int R, C; stage_rc(tid * 16 + i * 8192, R, C); const int Rb = Epi::PERM ? ((R & ~31) + perm32(R & 31)) : R;
        voffA[i] = (unsigned)(R * LD + C) * 2u; voffB[i] = (unsigned)(Rb * LD + C) * 2u; }
    const size_t kstep = (size_t)(BK * 2);
    const size_t hstep = (size_t)HALF * LD * 2;
    const size_t tstep = 2 * hstep;
    const unsigned ldsw = (unsigned)wid * 1024u;
    const int aoff = lds_byte(wr * 64 + fr, fq * 8), boff = lds_byte(wc * 32 + fr, fq * 8);
#define PG8_SA(b, h) (((b) * 2 + (h)) * HTB)
#define PG8_SB(b, h) ((4 + (b) * 2 + (h)) * HTB)
#define PG8_STAGE(bufoff, gbase, voff) do { _Pragma("unroll") for (int _i = 0; _i < 2; ++_i) \
        __builtin_amdgcn_global_load_lds((const unsigned*)((const char*)(gbase) + (voff)[_i]), (PG8_LAS unsigned*)(lds + (bufoff) + ldsw + _i * 8192), 16, 0, 0); } while (0)
#define PG8_LDA(dst, b, h) do { _Pragma("unroll") for (int m = 0; m < 4; ++m) _Pragma("unroll") for (int k = 0; k < 2; ++k) dst[m][k] = *(const PG8_LAS bf16x8*)(lds + PG8_SA(b, h) + aoff + m * 2048 + k * 1024); } while (0)
#define PG8_LDB(dst, b, h) do { _Pragma("unroll") for (int n = 0; n < 2; ++n) _Pragma("unroll") for (int k = 0; k < 2; ++k) dst[n][k] = *(const PG8_LAS bf16x8*)(lds + PG8_SB(b, h) + boff + n * 2048 + k * 1024); } while (0)
#define PG8_MMA(ai, bj, At, Bt) do { __builtin_amdgcn_s_setprio(1); _Pragma("unroll") for (int m = 0; m < 4; ++m) _Pragma("unroll") for (int n = 0; n < 2; ++n) _Pragma("unroll") for (int k = 0; k < 2; ++k) \
        acc[ai][bj][m][n] = __builtin_amdgcn_mfma_f32_16x16x32_bf16(Bt[n][k], At[m][k], acc[ai][bj][m][n], 0, 0, 0); __builtin_amdgcn_s_setprio(0); } while (0)
#define PG8_WAIT_V(n) asm volatile("s_waitcnt vmcnt(" #n ")" ::: "memory")
#define PG8_WAIT_L(n) asm volatile("s_waitcnt lgkmcnt(" #n ")" ::: "memory")
#define PG8_BAR __builtin_amdgcn_s_barrier()
#define PG8_SCHED __builtin_amdgcn_sched_barrier(0)
    Unit cur, nxt; int ui = 0;
    if (!S.next(0, cur)) return;
    f32x4 acc[2][2][4][2];
#pragma unroll
    for (int a = 0; a < 2; ++a)
#pragma unroll
        for (int b = 0; b < 2; ++b)
#pragma unroll
            for (int m = 0; m < 4; ++m)
#pragma unroll
                for (int n = 0; n < 2; ++n) acc[a][b][m][n] = (f32x4){0.f, 0.f, 0.f, 0.f};
    bf16x8 At[4][2], B0[2][2], B1[2][2];
    const char* cA = (const char*)g.A + (size_t)cur.pm * tstep + (size_t)cur.ks * K * 2; const char* cB = (const char*)g.Bt + (size_t)cur.pn * tstep + (size_t)cur.ks * K * 2;
    S.a_ready(cur);
    if constexpr (SP2) {
        PG8_STAGE(PG8_SB(0, 0), cB, voffB); PG8_STAGE(PG8_SB(0, 1), cB + hstep, voffB); PG8_STAGE(PG8_SA(0, 0), cA, voffA); PG8_STAGE(PG8_SA(0, 1), cA + hstep, voffA);
        if (wr == 1) PG8_BAR;
        PG8_WAIT_V(2); PG8_BAR;
        PG8_STAGE(PG8_SB(1, 0), cB + kstep, voffB); PG8_STAGE(PG8_SA(1, 0), cA + kstep, voffA); PG8_STAGE(PG8_SB(1, 1), cB + hstep + kstep, voffB);
        PG8_WAIT_V(6); PG8_BAR;
    } else {
        PG8_STAGE(PG8_SB(0, 0), cB, voffB); PG8_STAGE(PG8_SA(0, 0), cA, voffA); PG8_STAGE(PG8_SB(0, 1), cB + hstep, voffB); PG8_STAGE(PG8_SA(0, 1), cA + hstep, voffA);
        if (wr == 1) PG8_BAR;
        PG8_WAIT_V(4); PG8_BAR;
        PG8_STAGE(PG8_SB(1, 0), cB + kstep, voffB); PG8_STAGE(PG8_SA(1, 0), cA + kstep, voffA); PG8_STAGE(PG8_SB(1, 1), cB + hstep + kstep, voffB);
        PG8_WAIT_V(6); PG8_BAR;
    }
    for (;;) {
        const bool has_next = S.next(ui + 1, nxt);
        const char* nA = has_next ? (const char*)g.A + (size_t)nxt.pm * tstep + (size_t)nxt.ks * K * 2 : cA; const char* nB = has_next ? (const char*)g.Bt + (size_t)nxt.pn * tstep + (size_t)nxt.ks * K * 2 : cB;
        for (int t = 0; t < nt; t += 2) {
            const bool last = (t == nt - 2);
            const char* a1 = cA + (size_t)(t + 1) * kstep;
            const char* a2 = last ? nA : cA + (size_t)(t + 2) * kstep; const char* b2 = last ? nB : cB + (size_t)(t + 2) * kstep;
            const char* a3 = a2 + kstep; const char* b3 = b2 + kstep;
            if (last && has_next) S.a_ready(nxt);
            if constexpr (SP2) {
            PG8_LDB(B0, 0, 0); PG8_LDB(B1, 0, 1); PG8_SCHED; PG8_LDA(At, 0, 0); PG8_STAGE(PG8_SA(1, 1), a1 + hstep, voffA);
            PG8_WAIT_V(8); PG8_WAIT_L(0); PG8_BAR; PG8_MMA(0, 0, At, B0); PG8_MMA(0, 1, At, B1); PG8_BAR; PG8_SCHED;
            PG8_LDA(At, 0, 1); PG8_STAGE(PG8_SB(0, 0), b2, voffB); PG8_STAGE(PG8_SB(0, 1), b2 + hstep, voffB); PG8_STAGE(PG8_SA(0, 0), a2, voffA);
            PG8_WAIT_V(8); PG8_WAIT_L(0); PG8_BAR; PG8_MMA(1, 0, At, B0); PG8_MMA(1, 1, At, B1); PG8_BAR; PG8_SCHED;
            PG8_LDB(B0, 1, 0); PG8_LDB(B1, 1, 1); PG8_SCHED; PG8_LDA(At, 1, 0); PG8_STAGE(PG8_SA(0, 1), a2 + hstep, voffA);
            PG8_WAIT_V(8); PG8_WAIT_L(0); PG8_BAR; PG8_MMA(0, 0, At, B0); PG8_MMA(0, 1, At, B1); PG8_BAR; PG8_SCHED;
            PG8_LDA(At, 1, 1); PG8_STAGE(PG8_SB(1, 0), b3, voffB); PG8_STAGE(PG8_SB(1, 1), b3 + hstep, voffB); PG8_STAGE(PG8_SA(1, 0), a3, voffA);
            PG8_WAIT_V(8); PG8_WAIT_L(0); PG8_BAR; PG8_MMA(1, 0, At, B0); PG8_MMA(1, 1, At, B1); PG8_BAR; PG8_SCHED;
            } else {
            PG8_LDB(B0, 0, 0); PG8_SCHED; PG8_LDA(At, 0, 0); PG8_STAGE(PG8_SA(1, 1), a1 + hstep, voffA);
            PG8_WAIT_L(8); PG8_BAR; PG8_WAIT_L(0); PG8_MMA(0, 0, At, B0); PG8_BAR; PG8_SCHED;
            PG8_LDB(B1, 0, 1); PG8_STAGE(PG8_SB(0, 0), b2, voffB);
            PG8_BAR; PG8_WAIT_L(0); PG8_MMA(0, 1, At, B1); PG8_BAR;
            PG8_LDA(At, 0, 1); PG8_STAGE(PG8_SA(0, 0), a2, voffA);
            PG8_BAR; PG8_WAIT_L(0); PG8_MMA(1, 0, At, B0); PG8_BAR; PG8_SCHED;
            PG8_STAGE(PG8_SB(0, 1), b2 + hstep, voffB);
            PG8_WAIT_V(6); PG8_BAR; PG8_MMA(1, 1, At, B1); PG8_BAR;
            PG8_LDB(B0, 1, 0); PG8_SCHED; PG8_LDA(At, 1, 0); PG8_STAGE(PG8_SA(0, 1), a2 + hstep, voffA);
            PG8_WAIT_L(8); PG8_BAR; PG8_WAIT_L(0); PG8_MMA(0, 0, At, B0); PG8_BAR; PG8_SCHED;
            PG8_LDB(B1, 1, 1); PG8_STAGE(PG8_SB(1, 0), b3, voffB);
            PG8_BAR; PG8_WAIT_L(0); PG8_MMA(0, 1, At, B1); PG8_BAR;
            PG8_LDA(At, 1, 1); PG8_STAGE(PG8_SA(1, 0), a3, voffA);
            PG8_BAR; PG8_WAIT_L(0); PG8_MMA(1, 0, At, B0); PG8_BAR; PG8_SCHED;
            PG8_STAGE(PG8_SB(1, 1), b3 + hstep, voffB);
            PG8_WAIT_V(6); PG8_BAR; PG8_MMA(1, 1, At, B1); PG8_BAR;
            }
        }
        if constexpr (ALIGN_EPI) { if (wr == 0) PG8_BAR; }
        if constexpr (!Epi::AFTER_DRAIN) { E(acc, cur, wr, wc, fr, fq); S.done(cur); }
        if (!has_next) break;
#pragma unroll
        for (int a = 0; a < 2; ++a)
#pragma unroll
            for (int b = 0; b < 2; ++b)
#pragma unroll
                for (int m = 0; m < 4; ++m)
#pragma unroll
                    for (int n = 0; n < 2; ++n) acc[a][b][m][n] = (f32x4){0.f, 0.f, 0.f, 0.f};
        cur = nxt; cA = nA; cB = nB; ++ui;
        if constexpr (ALIGN_EPI) { if (wr == 1) PG8_BAR; }
    }
    PG8_WAIT_V(0);
    if constexpr (!ALIGN_EPI) { if (wr == 0) PG8_BAR; }
    PG8_BAR;
    if constexpr (Epi::AFTER_DRAIN) { E.fused(acc, cur, wr, wc, fr, fq, lds, wid, lane); S.done(cur); }
#undef PG8_SA
#undef PG8_SB
#undef PG8_STAGE
#undef PG8_LDA
#undef PG8_LDB
#undef PG8_MMA
#undef PG8_WAIT_V
#undef PG8_WAIT_L
#undef PG8_BAR
#undef PG8_SCHED
}
}
namespace epi {
using pg8::f32x4; using pg8::Unit;
typedef unsigned u32x2 __attribute__((ext_vector_type(2)));
typedef unsigned u32x4 __attribute__((ext_vector_type(4)));
typedef float f32x2 __attribute__((ext_vector_type(2)));
typedef __bf16 bf16x2_t __attribute__((ext_vector_type(2)));
__device__ __forceinline__ unsigned pk(float lo, float hi) { f32x2 v = {lo, hi}; bf16x2_t b = __builtin_convertvector(v, bf16x2_t); return __builtin_bit_cast(unsigned, b); }
__device__ __forceinline__ u32x2 pk4(f32x4 v) { u32x2 w; w.x = pk(v[0], v[1]); w.y = pk(v[2], v[3]); return w; }
__device__ __forceinline__ float sum4sq(f32x4 v) { return (v[0] * v[0] + v[1] * v[1]) + (v[2] * v[2] + v[3] * v[3]); }
__device__ __forceinline__ float quad_sum(float s) { s += __shfl_xor(s, 16); s += __shfl_xor(s, 32); return s; }

__device__ __forceinline__ void st32(bf16_t* base32, f32x4 v0, f32x4 v1, int fq) {
    u32x2 a = pk4(v0), b = pk4(v1);
    { auto r = __builtin_amdgcn_permlane16_swap(a.x, b.x, false, false); a.x = r[0]; b.x = r[1]; }
    { auto r = __builtin_amdgcn_permlane16_swap(a.y, b.y, false, false); a.y = r[0]; b.y = r[1]; }
    u32x4 w; w.x = a.x; w.y = a.y; w.z = b.x; w.w = b.y;
    *(u32x4*)(base32 + 16 * (fq & 1) + 8 * (fq >> 1)) = w;
}

__device__ __forceinline__ int kvbase_of(int pm) { return pm < 64 ? (pm >> 3) * SK + CTX + (pm & 7) * 256 : (pm - 64) * SK; }
__device__ __forceinline__ int modidx_pm(int pm) { return pm < 64 ? (pm >> 3) : 8; }

__device__ __forceinline__ void head_finish(f32x4 (&v)[2][2], const float* gain, bool rope, const float* T32, int grow, int gcol, float scale, int fq) {
    float ss = (sum4sq(v[0][0]) + sum4sq(v[0][1])) + (sum4sq(v[1][0]) + sum4sq(v[1][1]));
    ss = quad_sum(ss);
    const float rn = rsqrtf(ss * (1.f / 64.f) + EPS);
#pragma unroll
    for (int bj = 0; bj < 2; ++bj)
#pragma unroll
        for (int n = 0; n < 2; ++n) { const f32x4 g = *(const f32x4*)(gain + 32 * bj + 16 * n + 4 * fq); v[bj][n] = (v[bj][n] * rn) * g; }
    if (rope) {
#pragma unroll
        for (int bj = 0; bj < 2; ++bj) { const int pos = bj ? gcol : grow;
            const f32x4 cs = *(const f32x4*)(T32 + pos * 16 + 4 * fq), sn = *(const f32x4*)(T32 + 1024 + pos * 16 + 4 * fq);
            const f32x4 x1 = v[bj][0], x2 = v[bj][1];
            v[bj][0] = x1 * cs - x2 * sn; v[bj][1] = x1 * sn + x2 * cs; }
    }
#pragma unroll
    for (int bj = 0; bj < 2; ++bj)
#pragma unroll
        for (int n = 0; n < 2; ++n) v[bj][n] = v[bj][n] * scale;
}

struct EpiIn0 {
    static constexpr bool PERM = false, AFTER_DRAIN = false;
    bf16_t *A0, *Q0, *K0, *V0; const float *qg, *kg, *T32;
    __device__ __forceinline__ void operator()(const f32x4 (&acc)[2][2][4][2], const Unit& u, int wr, int wc, int fr_in, int fq_in) const {
        int fr = fr_in, fq = fq_in; asm volatile("" : "+v"(fr), "+v"(fq));
        const int pn = u.pn, pm = u.pm; const bool lat = pm < 64; const int kvb = kvbase_of(pm);
#pragma unroll
        for (int ai = 0; ai < 2; ++ai)
#pragma unroll
            for (int m = 0; m < 4; ++m) {
                const int rl = 128 * ai + 64 * wr + 16 * m + fr; const size_t r = (size_t)pm * 256 + rl;
                if (pn == 0 || pn == 5) {
                    bf16_t* dst = pn == 0 ? A0 + r * 256 : V0 + (size_t)(kvb + rl) * 256;
#pragma unroll
                    for (int bj = 0; bj < 2; ++bj)
                        st32(dst + 64 * wc + 32 * bj, acc[ai][bj][m][0], acc[ai][bj][m][1], fq);
                } else {
                    f32x4 v[2][2] = {{acc[ai][0][m][0], acc[ai][0][m][1]}, {acc[ai][1][m][0], acc[ai][1][m][1]}};
                    const int grow = (pm & 7) * 4 + 2 * ai + wr, gcol = 16 * m + fr;
                    bf16_t* dst;
                    if (pn < 4) { head_finish(v, qg, lat, T32, grow, gcol, C2_64, fq); dst = Q0 + r * 768 + ((pn - 1) * 4 + wc) * 64; }
                    else { head_finish(v, kg, lat, T32, grow, gcol, 1.0f, fq); dst = K0 + (size_t)(kvb + rl) * 256 + wc * 64; }
#pragma unroll
                    for (int bj = 0; bj < 2; ++bj)
                        st32(dst + 32 * bj, v[bj][0], v[bj][1], fq);
                }
            }
    }
};

__device__ __forceinline__ f32x4 ld4(const float* p) { return *(const f32x4*)p; }
__device__ __forceinline__ f32x4 ld4(const bf16_t* p) { const u32x2 w = *(const u32x2*)p; return (f32x4){__uint_as_float(w.x << 16), __uint_as_float(w.x & 0xffff0000u), __uint_as_float(w.y << 16), __uint_as_float(w.y & 0xffff0000u)}; }
__device__ __forceinline__ void st4(float* p, f32x4 v) { *(f32x4*)p = v; }
__device__ __forceinline__ void st4(bf16_t* p, f32x4 v) { *(u32x2*)p = pk4(v); }
template <class TB, class TO> struct EpiResidT {
    static constexpr bool PERM = false, AFTER_DRAIN = false;
    const TB* base_l; const float* base_c; TO* out_l; float* out_c; const float* mod;
    __device__ __forceinline__ void operator()(const f32x4 (&acc)[2][2][4][2], const Unit& u, int wr, int wc, int fr_in, int fq_in) const {
        int fr = fr_in, fq = fq_in; asm volatile("" : "+v"(fr), "+v"(fq));
        const int pm = u.pm; const bool lat = pm < 64;
        const float* gp = mod + (size_t)modidx_pm(pm) * 6144 + u.pn * 256 + 32 * wc + 4 * fq;
        f32x4 g[2][2];
#pragma unroll
        for (int bj = 0; bj < 2; ++bj)
#pragma unroll
            for (int n = 0; n < 2; ++n) g[bj][n] = *(const f32x4*)(gp + 128 * bj + 16 * n);
        if (lat) {
            const TB* bp = base_l + (size_t)pm * 256 * D; TO* op = out_l + (size_t)pm * 256 * D;
#pragma unroll
            for (int ai = 0; ai < 2; ++ai)
#pragma unroll
                for (int m = 0; m < 4; ++m) { const size_t off = (size_t)(128 * ai + 64 * wr + 16 * m + fr) * D + u.pn * 256 + 32 * wc + 4 * fq;
#pragma unroll
                    for (int bj = 0; bj < 2; ++bj)
#pragma unroll
                        for (int n = 0; n < 2; ++n) { const f32x4 b = ld4(bp + off + 128 * bj + 16 * n); st4(op + off + 128 * bj + 16 * n, b + g[bj][n] * acc[ai][bj][m][n]); } }
        } else {
            const float* bp = base_c + (size_t)(pm - 64) * 256 * D; float* op = out_c + (size_t)(pm - 64) * 256 * D;
#pragma unroll
            for (int ai = 0; ai < 2; ++ai)
#pragma unroll
                for (int m = 0; m < 4; ++m) { const size_t off = (size_t)(128 * ai + 64 * wr + 16 * m + fr) * D + u.pn * 256 + 32 * wc + 4 * fq;
#pragma unroll
                    for (int bj = 0; bj < 2; ++bj)
#pragma unroll
                        for (int n = 0; n < 2; ++n) { const f32x4 b = *(const f32x4*)(bp + off + 128 * bj + 16 * n); *(f32x4*)(op + off + 128 * bj + 16 * n) = b + g[bj][n] * acc[ai][bj][m][n]; } }
        }
    }
};
typedef EpiResidT<float, float> EpiResid;

template <class TB, class TO> struct EpiResidNT {
    static constexpr bool PERM = false, AFTER_DRAIN = false;
    const TB* base_l; TO* out_l; const float* mod;
    bf16_t* xn2; float* ssn; const float* gain; const float* modsc;
    __device__ __forceinline__ void operator()(const f32x4 (&acc)[2][2][4][2], const Unit& u, int wr, int wc, int fr_in, int fq_in) const {
        int fr = fr_in, fq = fq_in; asm volatile("" : "+v"(fr), "+v"(fq));
        const int pm = u.pm;
        const TB* bp = base_l + (size_t)pm * 256 * D;
        TO* op = out_l + (size_t)pm * 256 * D;
        bf16_t* xp = xn2 + (size_t)pm * 256 * D;
        const int c0 = u.pn * 256 + 32 * wc + 4 * fq;
        const float* gp = mod + (size_t)(pm >> 3) * 6144 + c0;
        const float* sp = modsc + (size_t)(pm >> 3) * 6144 + c0;
        f32x4 g[2][2], f[2][2];
#pragma unroll
        for (int bj = 0; bj < 2; ++bj)
#pragma unroll
            for (int n = 0; n < 2; ++n) { g[bj][n] = *(const f32x4*)(gp + 128 * bj + 16 * n);
                f[bj][n] = *(const f32x4*)(gain + c0 + 128 * bj + 16 * n) * (*(const f32x4*)(sp + 128 * bj + 16 * n) + 1.f); }
#pragma unroll
        for (int ai = 0; ai < 2; ++ai)
#pragma unroll
            for (int m = 0; m < 4; ++m) { const int row = 128 * ai + 64 * wr + 16 * m + fr; const size_t off = (size_t)row * D + c0;
                float ss = 0.f;
#pragma unroll
                for (int bj = 0; bj < 2; ++bj)
#pragma unroll
                    for (int n = 0; n < 2; ++n) { const f32x4 b = ld4(bp + off + 128 * bj + 16 * n); const f32x4 v = b + g[bj][n] * acc[ai][bj][m][n];
                        st4(op + off + 128 * bj + 16 * n, v);
                        ss += (v[0] * v[0] + v[1] * v[1]) + (v[2] * v[2] + v[3] * v[3]);
                        *(u32x2*)(xp + off + 128 * bj + 16 * n) = pk4(v * f[bj][n]); }
                ss += __shfl_xor(ss, 16); ss += __shfl_xor(ss, 32);
                if (fq == 0) atomicAdd(ssn + pm * 256 + row, ss); }
    }
};

struct EpiResidSplit {
    static constexpr bool PERM = false, AFTER_DRAIN = false;
    const float* base_c; float* out_c; float* slab; const float* mod; int ks_base = 0;
    __device__ __forceinline__ void operator()(const f32x4 (&acc)[2][2][4][2], const Unit& u_in, int wr, int wc, int fr_in, int fq_in) const {
        int fr = fr_in, fq = fq_in; asm volatile("" : "+v"(fr), "+v"(fq));
        Unit u = u_in; u.ks += ks_base;
        const int pm = u.pm - 64;
        const float* bp = base_c + (size_t)pm * 256 * D;
        float* op = u.ks == 0 ? out_c + (size_t)pm * 256 * D : slab + (size_t)(u.ks - 1) * MC * D + (size_t)pm * 256 * D;
        const float* gp = mod + (size_t)8 * 6144 + u.pn * 256 + 32 * wc + 4 * fq;
        f32x4 g[2][2];
#pragma unroll
        for (int bj = 0; bj < 2; ++bj)
#pragma unroll
            for (int n = 0; n < 2; ++n) g[bj][n] = *(const f32x4*)(gp + 128 * bj + 16 * n);
#pragma unroll
        for (int ai = 0; ai < 2; ++ai)
#pragma unroll
            for (int m = 0; m < 4; ++m) { const size_t off = (size_t)(128 * ai + 64 * wr + 16 * m + fr) * D + u.pn * 256 + 32 * wc + 4 * fq;
#pragma unroll
                for (int bj = 0; bj < 2; ++bj)
#pragma unroll
                    for (int n = 0; n < 2; ++n) { f32x4 v = g[bj][n] * acc[ai][bj][m][n]; if (u.ks == 0) v += *(const f32x4*)(bp + off + 128 * bj + 16 * n); *(f32x4*)(op + off + 128 * bj + 16 * n) = v; } }
    }
};

struct EpiSwiGLU {
    static constexpr bool PERM = true, AFTER_DRAIN = false;
    bf16_t* H;
    __device__ __forceinline__ void operator()(const f32x4 (&acc)[2][2][4][2], const Unit& u, int wr, int wc, int fr_in, int fq_in) const {
        int fr = fr_in, fq = fq_in; asm volatile("" : "+v"(fr), "+v"(fq));
#pragma unroll
        for (int ai = 0; ai < 2; ++ai)
#pragma unroll
            for (int m = 0; m < 4; ++m) { const size_t r = (size_t)u.pm * 256 + 128 * ai + 64 * wr + 16 * m + fr;
                f32x4 h[2];
#pragma unroll
                for (int n = 0; n < 2; ++n) { const f32x4 g = acc[ai][0][m][n], up = acc[ai][1][m][n];
#pragma unroll
                    for (int e = 0; e < 4; ++e) h[n][e] = g[e] * __builtin_amdgcn_rcpf(1.f + __builtin_amdgcn_exp2f(-g[e] * LOG2E)) * up[e]; }
                u32x4 w; w.x = pk(h[0][0], h[0][1]); w.y = pk(h[0][2], h[0][3]); w.z = pk(h[1][0], h[1][1]); w.w = pk(h[1][2], h[1][3]);
                *(u32x4*)(H + r * FF + u.pn * 128 + 32 * wc + 8 * fq) = w; }
    }
};

struct EpiSwiGLUN {
    static constexpr bool PERM = true, AFTER_DRAIN = false;
    bf16_t* H; const float* ssn; const float* bias;
    __device__ __forceinline__ void operator()(const f32x4 (&acc)[2][2][4][2], const Unit& u, int wr, int wc, int fr_in, int fq_in) const {
        int fr = fr_in, fq = fq_in; asm volatile("" : "+v"(fr), "+v"(fq));
        const float* bp = bias + (size_t)(u.pm >> 3) * (2 * FF) + u.pn * 256 + 32 * wc + 8 * fq;
        f32x4 bg[2], bu[2];
#pragma unroll
        for (int n = 0; n < 2; ++n) { bg[n] = *(const f32x4*)(bp + 4 * n); bu[n] = *(const f32x4*)(bp + 128 + 4 * n); }
        float rr[2][4];
#pragma unroll
        for (int ai = 0; ai < 2; ++ai)
#pragma unroll
            for (int m = 0; m < 4; ++m) rr[ai][m] = ssn[u.pm * 256 + 128 * ai + 64 * wr + 16 * m + fr];
#pragma unroll
        for (int ai = 0; ai < 2; ++ai)
#pragma unroll
            for (int m = 0; m < 4; ++m) { const size_t r = (size_t)u.pm * 256 + 128 * ai + 64 * wr + 16 * m + fr;
                const float rs = rsqrtf(rr[ai][m] * (1.f / D) + EPS);
                f32x4 h[2];
#pragma unroll
                for (int n = 0; n < 2; ++n) { const f32x4 g = acc[ai][0][m][n] * rs + bg[n], up = acc[ai][1][m][n] * rs + bu[n];
#pragma unroll
                    for (int e = 0; e < 4; ++e) h[n][e] = g[e] * __builtin_amdgcn_rcpf(1.f + __builtin_amdgcn_exp2f(-g[e] * LOG2E)) * up[e]; }
                u32x4 w; w.x = pk(h[0][0], h[0][1]); w.y = pk(h[0][2], h[0][3]); w.z = pk(h[1][0], h[1][1]); w.w = pk(h[1][2], h[1][3]);
                *(u32x4*)(H + r * FF + u.pn * 128 + 32 * wc + 8 * fq) = w; }
    }
};

typedef unsigned int v4u_t __attribute__((vector_size(16)));
struct EpiSwiGLUW {
    static constexpr bool PERM = true, AFTER_DRAIN = false;
    bf16_t* H;
    __device__ __forceinline__ void operator()(const f32x4 (&acc)[2][2][4][2], const Unit& u, int wr, int wc, int fr_in, int fq_in) const {
        int fr = fr_in, fq = fq_in; asm volatile("" : "+v"(fr), "+v"(fq));
        const __amdgpu_buffer_rsrc_t rs = __builtin_amdgcn_make_buffer_rsrc((void*)(H + (size_t)ML * FF), (short)0, (int)(MC * FF * 2), 0x00020000);
#pragma unroll
        for (int ai = 0; ai < 2; ++ai)
#pragma unroll
            for (int m = 0; m < 4; ++m) { const unsigned r = (unsigned)(u.pm - 64) * 256 + 128 * ai + 64 * wr + 16 * m + fr;
                f32x4 h[2];
#pragma unroll
                for (int n = 0; n < 2; ++n) { const f32x4 g = acc[ai][0][m][n], up = acc[ai][1][m][n];
#pragma unroll
                    for (int e = 0; e < 4; ++e) h[n][e] = g[e] * __builtin_amdgcn_rcpf(1.f + __builtin_amdgcn_exp2f(-g[e] * LOG2E)) * up[e]; }
                u32x4 w; w.x = pk(h[0][0], h[0][1]); w.y = pk(h[0][2], h[0][3]); w.z = pk(h[1][0], h[1][1]); w.w = pk(h[1][2], h[1][3]);
                __builtin_amdgcn_raw_buffer_store_b128(__builtin_bit_cast(v4u_t, w), rs, (r * FF + u.pn * 128 + 32 * wc + 8 * fq) * 2u, 0,   16); }
    }
};

struct EpiIn1 {
    static constexpr bool PERM = false, AFTER_DRAIN = false;
    bf16_t *CQ, *CKV, *NQ, *NK, *NV; float *KR, *SSQ, *SSKV; const float *nqg, *nkg;
    __device__ __forceinline__ void operator()(const f32x4 (&acc)[2][2][4][2], const Unit& u, int wr, int wc, int fr_in, int fq_in) const {
        int fr = fr_in, fq = fq_in; asm volatile("" : "+v"(fr), "+v"(fq));
        const int pn = u.pn, pm = u.pm; const int kvb = kvbase_of(pm);
#pragma unroll
        for (int ai = 0; ai < 2; ++ai)
#pragma unroll
            for (int m = 0; m < 4; ++m) {
                const int rl = 128 * ai + 64 * wr + 16 * m + fr; const size_t r = (size_t)pm * 256 + rl;
                if (pn == 0 || pn == 2) {
                    bf16_t* dst = pn == 0 ? CQ + r * 384 : CKV + r * 256; float ss = 0.f;
#pragma unroll
                    for (int bj = 0; bj < 2; ++bj)
                        { ss += sum4sq(acc[ai][bj][m][0]) + sum4sq(acc[ai][bj][m][1]); st32(dst + 128 * bj + 32 * wc, acc[ai][bj][m][0], acc[ai][bj][m][1], fq); }
                    ss = quad_sum(ss);
                    if (fq == 0) atomicAdd((pn == 0 ? SSQ : SSKV) + r, ss);
                } else if (pn == 1) {
                    float ss = 0.f;
                    { ss += sum4sq(acc[ai][0][m][0]) + sum4sq(acc[ai][0][m][1]); st32(CQ + r * 384 + 256 + 32 * wc, acc[ai][0][m][0], acc[ai][0][m][1], fq); }
                    ss = quad_sum(ss);
                    if (fq == 0) atomicAdd(SSQ + r, ss);
                    if (wc == 0) {
#pragma unroll
                        for (int n = 0; n < 2; ++n) *(f32x4*)(KR + r * 32 + 16 * n + 4 * fq) = acc[ai][1][m][n]; }
                } else if (pn >= 7) {
                    bf16_t* dst = NV + (size_t)(kvb + rl) * 512 + (pn - 7) * 256 + 64 * wc;
#pragma unroll
                    for (int bj = 0; bj < 2; ++bj)
                        st32(dst + 32 * bj, acc[ai][bj][m][0], acc[ai][bj][m][1], fq);
                } else {
                    f32x4 v[2][2] = {{acc[ai][0][m][0], acc[ai][0][m][1]}, {acc[ai][1][m][0], acc[ai][1][m][1]}};
                    bf16_t* dst;
                    if (pn < 5) { head_finish(v, nqg, false, nullptr, 0, 0, C2_64, fq); dst = NQ + r * 512 + ((pn - 3) * 4 + wc) * 64; }
                    else { head_finish(v, nkg, false, nullptr, 0, 0, 1.0f, fq); dst = NK + (size_t)(kvb + rl) * 512 + ((pn - 5) * 4 + wc) * 64; }
#pragma unroll
                    for (int bj = 0; bj < 2; ++bj)
                        st32(dst + 32 * bj, v[bj][0], v[bj][1], fq);
                }
            }
    }
};

struct EpiQUp {
    static constexpr bool PERM = true, AFTER_DRAIN = false;
    bf16_t* MQ; const float* SSQ;
    __device__ __forceinline__ void operator()(const f32x4 (&acc)[2][2][4][2], const Unit& u, int wr, int wc, int fr_in, int fq_in) const {
        int fr = fr_in, fq = fq_in; asm volatile("" : "+v"(fr), "+v"(fq));
#pragma unroll
        for (int ai = 0; ai < 2; ++ai)
#pragma unroll
            for (int m = 0; m < 4; ++m) { const size_t r = (size_t)u.pm * 256 + 128 * ai + 64 * wr + 16 * m + fr;
                const float rs = rsqrtf(SSQ[r] * (1.f / 384.f) + EPS);
#pragma unroll
                for (int bj = 0; bj < 2; ++bj) { const f32x4 a = acc[ai][bj][m][0] * rs, b = acc[ai][bj][m][1] * rs;
                    u32x4 w; w.x = pk(a[0], a[1]); w.y = pk(a[2], a[3]); w.z = pk(b[0], b[1]); w.w = pk(b[2], b[3]);
                    *(u32x4*)(MQ + r * 768 + u.pn * 256 + 128 * bj + 32 * wc + 8 * fq) = w; } }
    }
};

struct EpiKvUp {
    static constexpr bool PERM = false, AFTER_DRAIN = false;
    bf16_t *MK, *MV; const float *SSKV, *KR, *kg, *T16;
    __device__ __forceinline__ void operator()(const f32x4 (&acc)[2][2][4][2], const Unit& u, int wr, int wc, int fr_in, int fq_in) const {
        int fr = fr_in, fq = fq_in; asm volatile("" : "+v"(fr), "+v"(fq));
        const int pm = u.pm; const bool lat = pm < 64; const int kvb = kvbase_of(pm); const int head = 2 * u.pn + (wc >> 1); const bool isv = wc & 1;
        float rs[2][4];
#pragma unroll
        for (int ai = 0; ai < 2; ++ai)
#pragma unroll
            for (int m = 0; m < 4; ++m) rs[ai][m] = SSKV[(size_t)pm * 256 + 128 * ai + 64 * wr + 16 * m + fr];
#pragma unroll
        for (int ai = 0; ai < 2; ++ai)
#pragma unroll
            for (int m = 0; m < 4; ++m) rs[ai][m] = rsqrtf(rs[ai][m] * (1.f / 256.f) + EPS);
        if (isv) {
#pragma unroll
            for (int ai = 0; ai < 2; ++ai)
#pragma unroll
                for (int m = 0; m < 4; ++m) { const size_t kvr = (size_t)(kvb + 128 * ai + 64 * wr + 16 * m + fr);
#pragma unroll
                    for (int bj = 0; bj < 2; ++bj)
                        st32(MV + kvr * 512 + head * 64 + 32 * bj, acc[ai][bj][m][0] * rs[ai][m], acc[ai][bj][m][1] * rs[ai][m], fq); }
            return;
        }
        f32x4 gn[2][2]; f32x2 gr[4];
#pragma unroll
        for (int bj = 0; bj < 2; ++bj)
#pragma unroll
            for (int n = 0; n < 2; ++n) gn[bj][n] = *(const f32x4*)(kg + 32 * bj + 16 * n + 4 * fq);
#pragma unroll
        for (int j = 0; j < 4; ++j) gr[j] = *(const f32x2*)(kg + 64 + 8 * j + 2 * fq);
#pragma unroll
        for (int ai = 0; ai < 2; ++ai) {
            const int grow = (pm & 7) * 4 + 2 * ai + wr;
            f32x2 csr = {1.f, 1.f}, snr = {0.f, 0.f};
            if (lat) { csr = *(const f32x2*)(T16 + grow * 8 + 2 * fq); snr = *(const f32x2*)(T16 + 512 + grow * 8 + 2 * fq); }
#pragma unroll
            for (int m = 0; m < 4; ++m) {
                const int rl = 128 * ai + 64 * wr + 16 * m + fr; const size_t r = (size_t)pm * 256 + rl; const size_t kvr = (size_t)(kvb + rl);
                f32x2 k[4];
#pragma unroll
                for (int j = 0; j < 4; ++j) k[j] = *(const f32x2*)(KR + r * 32 + 8 * j + 2 * fq);
                f32x2 csc = {1.f, 1.f}, snc = {0.f, 0.f};
                if (lat) { const int gcol = 16 * m + fr; csc = *(const f32x2*)(T16 + gcol * 8 + 2 * fq); snc = *(const f32x2*)(T16 + 512 + gcol * 8 + 2 * fq); }
                f32x4 v[2][2];
#pragma unroll
                for (int bj = 0; bj < 2; ++bj)
#pragma unroll
                    for (int n = 0; n < 2; ++n) v[bj][n] = acc[ai][bj][m][n] * rs[ai][m];
                float ss = (sum4sq(v[0][0]) + sum4sq(v[0][1])) + (sum4sq(v[1][0]) + sum4sq(v[1][1]));
#pragma unroll
                for (int j = 0; j < 4; ++j) ss += k[j][0] * k[j][0] + k[j][1] * k[j][1];
                ss = quad_sum(ss);
                const float rr = rsqrtf(ss * (1.f / 96.f) + EPS);
#pragma unroll
                for (int bj = 0; bj < 2; ++bj)
                    st32(MK + kvr * 768 + head * 96 + 32 * bj, (v[bj][0] * rr) * gn[bj][0], (v[bj][1] * rr) * gn[bj][1], fq);
#pragma unroll
                for (int j = 0; j < 4; ++j) k[j] = (k[j] * rr) * gr[j];
                { const f32x2 x1 = k[0], x2 = k[1]; k[0] = x1 * csr - x2 * snr; k[1] = x1 * snr + x2 * csr; }
                { const f32x2 x1 = k[2], x2 = k[3]; k[2] = x1 * csc - x2 * snc; k[3] = x1 * snc + x2 * csc; }
#pragma unroll
                for (int j = 0; j < 4; ++j) *(unsigned*)(MK + kvr * 768 + head * 96 + 64 + 8 * j + 2 * fq) = pk(k[j][0], k[j][1]);
                if (m & 1) asm volatile("" ::: "memory");
            }
        }
    }
};
}
namespace att {
using bf16x8 = __attribute__((ext_vector_type(8))) short;
using s16x4 = __attribute__((ext_vector_type(4))) short;
using f32x16 = __attribute__((ext_vector_type(16))) float;
using u32x4 = __attribute__((ext_vector_type(4))) unsigned;
typedef float f32x2_t __attribute__((ext_vector_type(2))); typedef __bf16 bf16x2_t __attribute__((ext_vector_type(2)));
#define ALAS __attribute__((address_space(3)))
constexpr int KSLOT = 12288, VSLOT = 8192, SLOT = KSLOT + VSLOT, NSLOT = 4, PD = NSLOT - 2;
constexpr int LDS_WS = NSLOT * SLOT;
constexpr int LDS_OST = LDS_WS + 8 * 256;
constexpr int LDS_RPB = LDS_OST + 8 * 4096;
constexpr int LDS_BYTES = LDS_RPB + 4096;
constexpr float THR = 8.0f;

__device__ __forceinline__ int crow(int r, int hi) { return (r & 3) + 8 * (r >> 2) + 4 * hi; }
__device__ __forceinline__ void glds16(const void* gsrc, unsigned lds_dst) { unsigned keep;
    asm volatile("s_mov_b32 %0, m0\n\ts_mov_b32 m0, %2\n\ts_nop 0\n\tglobal_load_lds_dwordx4 %1, off\n\ts_mov_b32 m0, %0" : "=&s"(keep) : "v"(gsrc), "s"(lds_dst) : "memory"); }
__device__ __forceinline__ unsigned cvtpk(float lo, float hi) { f32x2_t v = {lo, hi}; bf16x2_t b = __builtin_convertvector(v, bf16x2_t); return __builtin_bit_cast(unsigned, b); }
__device__ __forceinline__ void glds16s(unsigned voff, const void* sbase, unsigned lds_dst) { unsigned keep;
    asm volatile("s_mov_b32 %0, m0\n\ts_mov_b32 m0, %3\n\ts_nop 0\n\tglobal_load_lds_dwordx4 %1, %2\n\ts_mov_b32 m0, %0" : "=&s"(keep) : "v"(voff), "s"(sbase), "s"(lds_dst) : "memory"); }
__device__ __forceinline__ float max3f(float a, float b, float c) { float r; asm("v_max3_f32 %0, %1, %2, %3" : "=v"(r) : "v"(a), "v"(b), "v"(c)); return r; }
__device__ __forceinline__ float max2f(float a, float b) { float r; asm("v_max_f32_e32 %0, %1, %2" : "=v"(r) : "v"(a), "v"(b)); return r; }
#define AWAIT_BAR(N) asm volatile("s_waitcnt vmcnt(" #N ") lgkmcnt(0)\n\ts_barrier" ::: "memory")

template <int ND0> __device__ __forceinline__ void qkt(f32x16& p0, f32x16& p1, const ALAS char* Kslot, const bf16x8* qr, const f32x16& negm, int r32, int hi) {
    const ALAS char* kb = Kslot + hi * 1024 + r32 * 16;
#pragma unroll
    for (int d0 = 0; d0 < ND0; ++d0) {
        const bf16x8 b0 = *(const ALAS bf16x8*)(kb + d0 * 2048);
        const bf16x8 b1 = *(const ALAS bf16x8*)(kb + d0 * 2048 + 512);
        if (d0 == 0) { p0 = __builtin_amdgcn_mfma_f32_32x32x16_bf16(b0, qr[0], negm, 0, 0, 0); p1 = __builtin_amdgcn_mfma_f32_32x32x16_bf16(b1, qr[0], negm, 0, 0, 0); }
        else { p0 = __builtin_amdgcn_mfma_f32_32x32x16_bf16(b0, qr[d0], p0, 0, 0, 0); p1 = __builtin_amdgcn_mfma_f32_32x32x16_bf16(b1, qr[d0], p1, 0, 0, 0); }
    }
}
__device__ __forceinline__ float rowmax32(const f32x16& p0, const f32x16& p1) {
    float a[4];
#pragma unroll
    for (int k = 0; k < 4; ++k) { a[k] = max3f(p0[4 * k], p0[4 * k + 1], p0[4 * k + 2]); }
#pragma unroll
    for (int k = 0; k < 4; ++k) { a[k] = max3f(a[k], p0[4 * k + 3], p1[4 * k]); }
#pragma unroll
    for (int k = 0; k < 4; ++k) { a[k] = max3f(a[k], p1[4 * k + 1], p1[4 * k + 2]); }
    const float m = max3f(max3f(a[0], p1[3], p1[7]), max3f(a[1], p1[11], p1[15]), max2f(a[2], a[3]));
    auto rr = __builtin_amdgcn_permlane32_swap(__float_as_uint(m), __float_as_uint(m), false, false);
    return max2f(__uint_as_float(rr[0]), __uint_as_float(rr[1]));
}
typedef short v4i16_t __attribute__((ext_vector_type(4)));
__device__ __forceinline__ s16x4 vtr(const ALAS char* p) { return __builtin_bit_cast(s16x4, __builtin_amdgcn_ds_read_tr16_b64_v4i16((ALAS v4i16_t*)p)); }
__device__ __forceinline__ void pv(f32x16* o, const ALAS char* vp, bf16x8 pa0, bf16x8 pa1, bf16x8 pa2, bf16x8 pa3) {
#pragma unroll
    for (int d0 = 0; d0 < 2; ++d0) { s16x4 lo[4], hi[4];
#pragma unroll
        for (int ks = 0; ks < 4; ++ks) { lo[ks] = vtr(vp + d0 * 4096 + ks * 1024); hi[ks] = vtr(vp + d0 * 4096 + ks * 1024 + 512); }
#define APK(k) (bf16x8){lo[k][0], lo[k][1], lo[k][2], lo[k][3], hi[k][0], hi[k][1], hi[k][2], hi[k][3]}
        o[d0] = __builtin_amdgcn_mfma_f32_32x32x16_bf16(pa0, APK(0), o[d0], 0, 0, 0);
        o[d0] = __builtin_amdgcn_mfma_f32_32x32x16_bf16(pa1, APK(1), o[d0], 0, 0, 0);
        o[d0] = __builtin_amdgcn_mfma_f32_32x32x16_bf16(pa2, APK(2), o[d0], 0, 0, 0);
        o[d0] = __builtin_amdgcn_mfma_f32_32x32x16_bf16(pa3, APK(3), o[d0], 0, 0, 0);
#undef APK
    }
}

struct UnitDesc {
    const bf16_t* Q; int qpitch;
    long q0; int qcol;
    const bf16_t* K; int kpitch, kcol;
    const bf16_t* V; int vpitch, vcol;
    bf16_t* O; int opitch, ocol;
    int kv0;
    int nt;
    int rg;
    int rmin;
    int head;
    const bf16_t* G;
};

template <int DQK, bool NA, bool MLAQ>
__device__ __forceinline__ void attn_unit(const UnitDesc& U, ALAS char* shm, const float* qgain, const float* T16, const float* rpb_g) {
    constexpr int ND0 = DQK / 16, NCH = DQK / 8, NP = NCH + 8;
    int tid_ = threadIdx.x; asm volatile("" : "+v"(tid_));
    const int tid = tid_, lane = tid & 63, r32 = lane & 31, hi = lane >> 5; const int wid = __builtin_amdgcn_readfirstlane(tid >> 6);
#ifdef ATT_STATIC_PRIO_NA
    if (wid >= 4) __builtin_amdgcn_s_setprio(1);
#endif
    const unsigned lds0 = (unsigned)(uintptr_t)shm;
    ALAS float* wsf = (ALAS float*)(shm + LDS_WS) + wid * 64;
    unsigned doff[3];
#pragma unroll
    for (int i = 0; i < 3; ++i) { const int pc = wid + 8 * i;
        if (pc < NCH) doff[i] = (unsigned)((lane * U.kpitch + U.kcol + pc * 8) * 2);
        else { const int v = pc - NCH; doff[i] = (unsigned)(((16 * (v & 3) + (lane >> 2)) * U.vpitch + U.vcol + (v >> 2) * 32 + (lane & 3) * 8) * 2); } }
    auto dma_tile = [&](int t, int slot) {
        int key0;
        if (NA && t >= 4) key0 = U.kv0 + CTX + (U.rmin + (t - 4)) * GW; else key0 = U.kv0 + 64 * t;
        const unsigned sbase = lds0 + slot * SLOT;
        const bf16_t* kb_ = U.K + (size_t)key0 * U.kpitch; const bf16_t* vb_ = U.V + (size_t)key0 * U.vpitch;
#pragma unroll
        for (int i = 0; i < 3; ++i) { const int pc = wid + 8 * i;
            if (pc < NP) {
                if (pc < NCH) glds16s(doff[i], kb_, (unsigned)__builtin_amdgcn_readfirstlane(sbase + pc * 1024));
                else glds16s(doff[i], vb_, (unsigned)__builtin_amdgcn_readfirstlane(sbase + KSLOT + (pc - NCH) * 1024));
#ifdef ATT_DUP_DMA
                if (pc < NCH) glds16s(doff[i], kb_, (unsigned)__builtin_amdgcn_readfirstlane(sbase + pc * 1024));
                else glds16s(doff[i], vb_, (unsigned)__builtin_amdgcn_readfirstlane(sbase + KSLOT + (pc - NCH) * 1024));
#endif
            } }
    };
    asm volatile("s_waitcnt vmcnt(0)" ::: "memory");
#pragma unroll
    for (int t0_ = 0; t0_ < PD; ++t0_) if (t0_ < U.nt) dma_tile(t0_, t0_);
    bf16x8 qr[ND0];
    const bf16_t* Qw = U.Q + (size_t)(U.q0 + wid * 32 + r32) * U.qpitch + U.qcol;
#pragma unroll
    for (int d0 = 0; d0 < ND0; ++d0) qr[d0] = *(const bf16x8*)(Qw + d0 * 16 + hi * 8);
    if (MLAQ) {
        float f[ND0][8]; float ss = 0.f;
#pragma unroll
        for (int d0 = 0; d0 < ND0; ++d0)
#pragma unroll
            for (int j = 0; j < 8; ++j) { f[d0][j] = bf2f((bf16_t)qr[d0][j]); ss += f[d0][j] * f[d0][j]; }
        ss += __shfl_xor(ss, 32);
        const float rn = rsqrtf(ss * (1.f / 96.f) + EPS) * C2_96;
#pragma unroll
        for (int d0 = 0; d0 < ND0; ++d0)
#pragma unroll
            for (int j = 0; j < 8; ++j) f[d0][j] = f[d0][j] * rn * qgain[d0 * 16 + hi * 8 + j];
        const int t = (int)((U.q0 + wid * 32 + r32) % S); const int grow = t / GW, gcol = t % GW;
#pragma unroll
        for (int part = 0; part < 2; ++part) { const int pos = part ? gcol : grow;
#pragma unroll
            for (int j = 0; j < 8; ++j) { const float cs = T16[pos * 8 + j], sn = T16[512 + pos * 8 + j];
                const float mine = f[4 + part][j], other = __shfl_xor(mine, 32);
                f[4 + part][j] = hi == 0 ? (mine * cs - other * sn) : (other * sn + mine * cs); } }
#pragma unroll
        for (int d0 = 0; d0 < ND0; ++d0)
#pragma unroll
            for (int j = 0; j < 4; ++j) { const unsigned w = cvtpk(f[d0][2 * j], f[d0][2 * j + 1]); qr[d0][2 * j] = (short)(w & 0xffff); qr[d0][2 * j + 1] = (short)(w >> 16); }
    }
    const int grow_w = NA ? 4 * U.rg + (wid >> 1) : 0, c0w = 32 * (wid & 1);
    const int r0w = NA ? min(max(grow_w - 4, 0), 24) : 0;
    const int qc = c0w + r32;
    const int cs_q = min(max(qc - 8, 0), 48);
    float mhat = 0.f, l_reg = 0.f; f32x16 o[2]; o[0] = f32x16{}; o[1] = f32x16{};
    const ALAS char* vp0 = shm + KSLOT + ((lane >> 4) & 1) * 32 + (lane & 3) * 8 + (4 * hi + ((lane & 15) >> 2)) * 64;
    const int NT = U.nt;
    f32x16 a0, a1, b0, b1;
    u32x4 pw0, pw1, pw2, pw3;
    auto wait_tile = [&](int t) {
        const int ahead = min(PD - 1, NT - 1 - t);
        const bool big = (NP == 20 && wid < 4);
#ifdef ATT_DUP_DMA
        if (ahead >= 1) { if (big) AWAIT_BAR(6); else AWAIT_BAR(4); }
        else AWAIT_BAR(0);
#else
        if (ahead >= 2) { if (big) AWAIT_BAR(6); else AWAIT_BAR(4); }
        else if (ahead == 1) { if (big) AWAIT_BAR(3); else AWAIT_BAR(2); }
        else AWAIT_BAR(0);
#endif
        if (t + PD < NT) dma_tile(t + PD, (t + PD) % NSLOT);
    };
    bf16x8 eq[2];
    if (NA) {
#pragma unroll
        for (int s_ = 0; s_ < 2; ++s_)
#pragma unroll
            for (int jj = 0; jj < 8; ++jj) eq[s_][jj] = (16 * s_ + 8 * hi + jj == r32) ? (short)0x3f80 : (short)0;
    }
    const bf16_t* gq = NA ? U.G + (size_t)U.head * (16 * 2 * 64 * 32) + (size_t)(wid & 1) * (64 * 32) + r32 * 32 + hi * 8 : nullptr;
    auto gbias_load = [&](bf16x8 (&f)[4], int t) {
        const int krow = U.rmin + (t - 4); int dr = krow - grow_w + 7; if (krow < r0w || krow >= r0w + 8) dr = 15;
        const bf16_t* g = gq + (size_t)dr * (2 * 64 * 32);
#pragma unroll
        for (int half = 0; half < 2; ++half)
#pragma unroll
            for (int s_ = 0; s_ < 2; ++s_) f[2 * s_ + half] = *(const bf16x8*)(g + half * 1024 + s_ * 16);
    };
    auto gbias_mma = [&](f32x16& c0, f32x16& c1, const bf16x8 (&f)[4]) {
        c0 = __builtin_amdgcn_mfma_f32_32x32x16_bf16(f[0], eq[0], c0, 0, 0, 0); c1 = __builtin_amdgcn_mfma_f32_32x32x16_bf16(f[1], eq[0], c1, 0, 0, 0);
        c0 = __builtin_amdgcn_mfma_f32_32x32x16_bf16(f[2], eq[1], c0, 0, 0, 0); c1 = __builtin_amdgcn_mfma_f32_32x32x16_bf16(f[3], eq[1], c1, 0, 0, 0);
    };
    constexpr bool NEGM = true;
    f32x16 negm = f32x16{};
    auto decide = [&](f32x16& c0, f32x16& c1, bool first) -> bool {
        const float rm = rowmax32(c0, c1);
        if (first || __any(rm > THR)) {
            const float dl = first ? rm : fmaxf(rm, 0.f);
            mhat += dl;
#pragma unroll
            for (int r = 0; r < 16; ++r) { c0[r] -= dl; c1[r] -= dl; }
#pragma unroll
            for (int r = 0; r < 16; ++r) negm[r] = -mhat;
            if (!first) { const float f = __builtin_amdgcn_exp2f(-dl); l_reg *= f; if (hi == 0) wsf[r32] = f; return true; }
        }
        return false;
    };
    auto rescale_o = [&]() {
        asm volatile("s_waitcnt lgkmcnt(0)" ::: "memory");
#pragma unroll
        for (int r = 0; r < 16; ++r) { const float fr_ = wsf[crow(r, hi)]; o[0][r] *= fr_; o[1][r] *= fr_; }
    };
    auto expo = [&](f32x16& c0, f32x16& c1) {
#pragma unroll
        for (int r = 0; r < 16; ++r) { c0[r] = __builtin_amdgcn_exp2f(c0[r]); c1[r] = __builtin_amdgcn_exp2f(c1[r]); }
    };
    auto sumpack = [&](const f32x16& c0, const f32x16& c1) {
        float s4[4];
#pragma unroll
        for (int k = 0; k < 4; ++k) s4[k] = c0[k] + c1[k];
#pragma unroll
        for (int r = 4; r < 16; ++r) s4[r & 3] += c0[r] + c1[r];
        l_reg += (s4[0] + s4[1]) + (s4[2] + s4[3]);
#pragma unroll
        for (int j = 0; j < 4; ++j) { pw0[j] = cvtpk(c0[2 * j], c0[2 * j + 1]); pw1[j] = cvtpk(c0[8 + 2 * j], c0[9 + 2 * j]); pw2[j] = cvtpk(c1[2 * j], c1[2 * j + 1]); pw3[j] = cvtpk(c1[8 + 2 * j], c1[9 + 2 * j]); }
    };
    auto step = [&](f32x16& c0, f32x16& c1, f32x16& q0, f32x16& q1, int j) {
        wait_tile(j);
        bf16x8 gf[4];
        if (NA && j >= 4) gbias_load(gf, j);
        qkt<ND0>(c0, c1, shm + (j % NSLOT) * SLOT, qr, negm, r32, hi);
        if (NA && j >= 4) gbias_mma(c0, c1, gf);
        sumpack(q0, q1);
        const bool resc = decide(c0, c1, false);
        pv(o, vp0 + ((j - 1) % NSLOT) * SLOT, __builtin_bit_cast(bf16x8, pw0), __builtin_bit_cast(bf16x8, pw1), __builtin_bit_cast(bf16x8, pw2), __builtin_bit_cast(bf16x8, pw3));
        expo(c0, c1);
        if (resc) rescale_o();
    };
    wait_tile(0);
    qkt<ND0>(a0, a1, shm, qr, negm, r32, hi);
    (void)decide(a0, a1, true);
    expo(a0, a1);
    int j = 1;
#pragma unroll 1
    for (; j + 1 < NT; j += 2) { step(b0, b1, a0, a1, j); step(a0, a1, b0, b1, j + 1); }
    if (j < NT) { step(b0, b1, a0, a1, j); sumpack(b0, b1); } else sumpack(a0, a1);
    pv(o, vp0 + ((NT - 1) % NSLOT) * SLOT, __builtin_bit_cast(bf16x8, pw0), __builtin_bit_cast(bf16x8, pw1), __builtin_bit_cast(bf16x8, pw2), __builtin_bit_cast(bf16x8, pw3));
    { auto rr = __builtin_amdgcn_permlane32_swap(__float_as_uint(l_reg), __float_as_uint(l_reg), false, false); l_reg = __uint_as_float(rr[0]) + __uint_as_float(rr[1]); }
    if (hi == 0) wsf[32 + r32] = l_reg;
    asm volatile("s_waitcnt lgkmcnt(0)" ::: "memory");
    float rli[16];
#pragma unroll
    for (int r = 0; r < 16; ++r) rli[r] = __builtin_amdgcn_rcpf(wsf[32 + crow(r, hi)]);
    bf16_t* Ow = U.O + (size_t)(U.q0 + wid * 32) * U.opitch + U.ocol;
    { ALAS bf16_t* stg = (ALAS bf16_t*)(shm + LDS_OST) + wid * 2048;
#pragma unroll
        for (int r = 0; r < 16; ++r) { const int orow = crow(r, hi);
#pragma unroll
            for (int d0 = 0; d0 < 2; ++d0) stg[orow * 64 + d0 * 32 + r32] = f2bf(o[d0][r] * rli[r]); }
        asm volatile("s_waitcnt lgkmcnt(0)" ::: "memory");
#pragma unroll
        for (int i = 0; i < 4; ++i) { const int row = i * 8 + (lane >> 3), ch = lane & 7; const u32x4 v = *(const ALAS u32x4*)(stg + row * 64 + ch * 8); *(u32x4*)(Ow + (size_t)row * U.opitch + ch * 8) = v; } }
#ifdef ATT_STATIC_PRIO_NA
    __builtin_amdgcn_s_setprio(0);
#endif
    asm volatile("s_waitcnt vmcnt(0) lgkmcnt(0)\n\ts_barrier" ::: "memory");
}
}
#include <hip/hip_bf16.h>
namespace att64 {
using bf16=__hip_bfloat16;
using bf16x8=__attribute__((ext_vector_type(8)))short;
using s16x4=__attribute__((ext_vector_type(4)))short;
using f32x16=__attribute__((ext_vector_type(16)))float;
using u32x4=__attribute__((ext_vector_type(4)))unsigned;
constexpr int D=64;
constexpr int NW=8,QBLK=32,QB=QBLK*NW,KVBLK=64;

__device__ __forceinline__ int crow(int r,int hi){return (r&3)+8*(r>>2)+4*hi;}
#define SBAR() __builtin_amdgcn_sched_barrier(0)
__device__ __forceinline__ void cmask(f32x16&p0,f32x16&p1,int jb,int qrel,int hi){
  const float NEG=-INFINITY; int kb=64*jb+4*hi;
  #pragma unroll
  for(int r=0;r<16;++r){int kv=kb+(r&3)+8*(r>>2); if(kv>qrel)p0[r]=NEG; if(kv+32>qrel)p1[r]=NEG;}
}

constexpr int NSLOT=3, SLOTB=8192;
constexpr int LDS_K=0, LDS_V=NSLOT*SLOTB, LDS_WS=2*NSLOT*SLOTB, LDS_OST=LDS_WS+NW*64*4, LDS_BYTES=LDS_OST+NW*4096;
constexpr float C2=0.125f*1.4426950408889634f;
__device__ __forceinline__ void glds16(const void*gsrc,unsigned lds_dst){unsigned keep;
  asm volatile("s_mov_b32 %0, m0\n\ts_mov_b32 m0, %2\n\ts_nop 0\n\tglobal_load_lds_dwordx4 %1, off\n\ts_mov_b32 m0, %0":"=&s"(keep):"v"(gsrc),"s"(lds_dst):"memory");}
__device__ __forceinline__ float max3f(float a,float b,float c){float r;asm("v_max3_f32 %0, %1, %2, %3":"=v"(r):"v"(a),"v"(b),"v"(c));return r;}
__device__ __forceinline__ float max2f(float a,float b){float r;asm("v_max_f32_e32 %0, %1, %2":"=v"(r):"v"(a),"v"(b));return r;}
__device__ __forceinline__ float fadd_s(float a,float b){float r;asm("v_add_f32_e32 %0, %1, %2":"=v"(r):"v"(a),"v"(b));return r;}
__device__ __forceinline__ float fsub_s(float a,float b){float r;asm("v_sub_f32_e32 %0, %1, %2":"=v"(r):"v"(a),"v"(b));return r;}
typedef float f32x2_t __attribute__((ext_vector_type(2))); typedef __bf16 bf16x2_t __attribute__((ext_vector_type(2)));
__device__ __forceinline__ unsigned cvtpk_s(float lo,float hi){f32x2_t v={lo,hi};bf16x2_t b=__builtin_convertvector(v,bf16x2_t);return __builtin_bit_cast(unsigned,b);}
#define WAIT_BAR(N) asm volatile("s_waitcnt vmcnt(" #N ") lgkmcnt(0)\n\ts_barrier":::"memory")

__device__ __forceinline__ void qkt(f32x16&p0,f32x16&p1,const char*Kslot,const bf16x8*qr,const f32x16&negm,int r32,int hi){
  const char*kb=Kslot+hi*1024+r32*16;
  #pragma unroll
  for(int d0=0;d0<4;++d0){
    const bf16x8 b0=*reinterpret_cast<const bf16x8*>(kb+d0*2048);
    const bf16x8 b1=*reinterpret_cast<const bf16x8*>(kb+d0*2048+512);
    if(d0==0){p0=__builtin_amdgcn_mfma_f32_32x32x16_bf16(b0,qr[0],negm,0,0,0);p1=__builtin_amdgcn_mfma_f32_32x32x16_bf16(b1,qr[0],negm,0,0,0);}
    else{p0=__builtin_amdgcn_mfma_f32_32x32x16_bf16(b0,qr[d0],p0,0,0,0);p1=__builtin_amdgcn_mfma_f32_32x32x16_bf16(b1,qr[d0],p1,0,0,0);}}
}
typedef __attribute__((address_space(3))) const char* lds_cptr;
typedef short v4i16_t __attribute__((ext_vector_type(4)));
__device__ __forceinline__ void kload8(bf16x8*kf,lds_cptr kp){
  kf[0]=*(const __attribute__((address_space(3))) bf16x8*)(kp);      kf[1]=*(const __attribute__((address_space(3))) bf16x8*)(kp+512);
  kf[2]=*(const __attribute__((address_space(3))) bf16x8*)(kp+2048); kf[3]=*(const __attribute__((address_space(3))) bf16x8*)(kp+2560);
  kf[4]=*(const __attribute__((address_space(3))) bf16x8*)(kp+4096); kf[5]=*(const __attribute__((address_space(3))) bf16x8*)(kp+4608);
  kf[6]=*(const __attribute__((address_space(3))) bf16x8*)(kp+6144); kf[7]=*(const __attribute__((address_space(3))) bf16x8*)(kp+6656);
}
__device__ __forceinline__ void kload2(bf16x8*kf,lds_cptr kp,int j){ kf[2*j]=*(const __attribute__((address_space(3))) bf16x8*)(kp+j*2048); kf[2*j+1]=*(const __attribute__((address_space(3))) bf16x8*)(kp+j*2048+512); }
__device__ __forceinline__ s16x4 vtr(lds_cptr p){ return __builtin_bit_cast(s16x4,__builtin_amdgcn_ds_read_tr16_b64_v4i16((__attribute__((address_space(3))) v4i16_t*)p)); }
__device__ __forceinline__ float rowmax(const f32x16&p0,const f32x16&p1){
  float a=max3f(p0[0],p0[1],p1[0]),b=max3f(p0[2],p0[3],p1[1]);a=max3f(a,p1[2],p1[3]);
  #pragma unroll
  for(int r=4;r<16;r+=4){a=max3f(a,p0[r],p0[r+1]);b=max3f(b,p0[r+2],p0[r+3]);a=max3f(a,p1[r],p1[r+1]);b=max3f(b,p1[r+2],p1[r+3]);}
  const float m=max2f(a,b);
  auto rr=__builtin_amdgcn_permlane32_swap(__float_as_uint(m),__float_as_uint(m),false,false);
  return max2f(__uint_as_float(rr[0]),__uint_as_float(rr[1]));
}
__device__ __forceinline__ void pv(f32x16*o,int vb,bf16x8 pa0,bf16x8 pa1,bf16x8 pa2,bf16x8 pa3){
  #pragma unroll
  for(int d0=0;d0<2;++d0){s16x4 lo[4],hi[4];
    #pragma unroll
    for(int ks=0;ks<4;++ks){
      asm volatile("ds_read_b64_tr_b16 %0,%1 offset:%c2":"=&v"(lo[ks]):"v"(vb),"i"(d0*4096+ks*1024):"memory");
      asm volatile("ds_read_b64_tr_b16 %0,%1 offset:%c2":"=&v"(hi[ks]):"v"(vb),"i"(d0*4096+ks*1024+512):"memory");}
    asm volatile("s_waitcnt lgkmcnt(0)":::"memory");SBAR();
    #define PK(k) (bf16x8){lo[k][0],lo[k][1],lo[k][2],lo[k][3],hi[k][0],hi[k][1],hi[k][2],hi[k][3]}
    o[d0]=__builtin_amdgcn_mfma_f32_32x32x16_bf16(pa0,PK(0),o[d0],0,0,0);
    o[d0]=__builtin_amdgcn_mfma_f32_32x32x16_bf16(pa1,PK(1),o[d0],0,0,0);
    o[d0]=__builtin_amdgcn_mfma_f32_32x32x16_bf16(pa2,PK(2),o[d0],0,0,0);
    o[d0]=__builtin_amdgcn_mfma_f32_32x32x16_bf16(pa3,PK(3),o[d0],0,0,0);
    #undef PK
  }
}

#ifndef ATTN_STORE16
#define ATTN_STORE16(p,v) (*(u32x4*)(p)=(v))
#endif
template<int THRL> __device__ __forceinline__ void attn_unit(long q0,const bf16*Q,int qp,int qcol,const bf16*__restrict__ K,int kp,int kcol,const bf16*__restrict__ V,int vp,int vcol,long kv0,int NT,bf16*O,int op,int ocol,char*shm){
  int tid_=threadIdx.x; asm volatile("":"+v"(tid_));
  const int tid=tid_,lane=tid&63,r32=lane&31,hi=lane>>5; const int wid=__builtin_amdgcn_readfirstlane(tid>>6);
#ifdef ATT_STATIC_PRIO
  if(wid>=4)__builtin_amdgcn_s_setprio(1);
#endif
  const bf16*Qw=Q+(q0+wid*QBLK)*qp+qcol;
  const bf16*Kh=K+kv0*kp+kcol,*Vh=V+kv0*vp+vcol;
  const unsigned lds0=(unsigned)(uintptr_t)shm;
  float*wsf=(float*)(shm+LDS_WS)+wid*64;
  const bf16*ksrc=Kh+(long)lane*kp+wid*8;
  const bf16*vsrc=Vh+(long)(16*(wid&3)+(lane>>2))*vp+(wid>>2)*32+(lane&3)*8;
  const unsigned kdst=lds0+LDS_K+wid*1024, vdst=lds0+LDS_V+wid*1024;
  #define DMA_K(t,slot) glds16(ksrc+(long)(t)*KVBLK*kp,(unsigned)__builtin_amdgcn_readfirstlane(kdst+(slot)))
  #define DMA_V(t,slot) glds16(vsrc+(long)(t)*KVBLK*vp,(unsigned)__builtin_amdgcn_readfirstlane(vdst+(slot)))
  const int vb0=(int)(lds0+LDS_V)+((lane>>4)&1)*32+(lane&3)*8+(4*hi+((lane&15)>>2))*64;
  const char*Kbase=shm+LDS_K; bf16x8 kf[8];
  const lds_cptr shm3=(lds_cptr)shm; const lds_cptr kp0=shm3+LDS_K+hi*1024+r32*16; const lds_cptr vp0=shm3+LDS_V+((lane>>4)&1)*32+(lane&3)*8+(4*hi+((lane&15)>>2))*64;
  DMA_K(0,0);DMA_V(0,0);DMA_K(1,SLOTB);
  bf16x8 qr[4];
  #pragma unroll
  for(int d0=0;d0<4;++d0)qr[d0]=*reinterpret_cast<const bf16x8*>(&Qw[(long)r32*qp+d0*16+hi*8]);
  float mhat=0.f,l_reg=0.f;f32x16 o[2];o[0]=f32x16{};o[1]=f32x16{};f32x16 negm=f32x16{};asm volatile("":"+v"(negm));
  #define CMASK(P0,P1,t) do{}while(0)
  bool resc=false;
  #define START(P0,P1) do{ const float rm=rowmax(P0,P1); resc=false; \
    { const float dl=rm; mhat=fadd_s(mhat,dl); \
      _Pragma("unroll") for(int r=0;r<16;++r){P0[r]=fsub_s(P0[r],dl);P1[r]=fsub_s(P1[r],dl);} \
      _Pragma("unroll") for(int r=0;r<16;++r)negm[r]=-mhat; asm volatile("":"+v"(negm)); } \
    _Pragma("unroll") for(int r=0;r<16;++r)P0[r]=__builtin_amdgcn_exp2f(P0[r]); }while(0)
  #define RESC() do{ if(resc){ asm volatile("s_waitcnt lgkmcnt(0)":::"memory"); \
      _Pragma("unroll") for(int d_=0;d_<2;++d_) _Pragma("unroll") for(int r=0;r<16;++r)o[d_][r]*=wsf[crow(r,hi)]; } }while(0)
  f32x16 pA0,pA1,pB0,pB1;
  int sl_prev=0,sl_cur=0,sl_next=SLOTB;
  #define ROT() do{sl_prev=sl_cur;sl_cur=sl_next;sl_next=(sl_next==(NSLOT-1)*SLOTB)?0:sl_next+SLOTB;}while(0)
  DMA_K(2,2*SLOTB);
  WAIT_BAR(3);
  qkt(pA0,pA1,Kbase,qr,negm,r32,hi);asm volatile("s_nop 15\n\ts_nop 7":"+v"(pA0),"+v"(pA1));CMASK(pA0,pA1,0);
  START(pA0,pA1);
  _Pragma("unroll") for(int r=0;r<16;++r)pA1[r]=__builtin_amdgcn_exp2f(pA1[r]);
  WAIT_BAR(0);
  DMA_K(3,0);DMA_V(1,SLOTB);
  ROT();
  kload8(kf,kp0+sl_cur);
  WAIT_BAR(2);
  s16x4 vlo[8],vhi[8]; u32x4 pw0,pw1,pw2,pw3;
  #define PKW(P,B) cvtpk_s(P[B],P[B+1])
  #define PAF(k) __builtin_bit_cast(bf16x8,pw##k)
  #define VFR(i) (bf16x8){vlo[i][0],vlo[i][1],vlo[i][2],vlo[i][3],vhi[i][0],vhi[i][1],vhi[i][2],vhi[i][3]}
  #define PIN(x) asm volatile("":"+v"(x))
  #define MX3(a,b,c) __builtin_fmaxf(__builtin_fmaxf((a),(b)),(c))
  #define GAPA(MF,A0,A1,A2,A3,W0,W1,PW) do{ MF; sacc+=A0; sacc+=A1; sacc+=A2; sacc+=A3; PIN(sacc); W0; W1; PIN(PW); SBAR(); }while(0)
  #define EX(v) __builtin_amdgcn_exp2f(v)
  #define GAPB(MF,X,B) do{ MF; X[B]=EX(X[B]); X[B+1]=EX(X[B+1]); X[B+2]=EX(X[B+2]); X[B+3]=EX(X[B+3]); PIN(X); SBAR(); }while(0)
  #define VRD(i) do{ vlo[i]=vtr(vp_+(((i)>>2)*4096+((i)&3)*1024)); vhi[i]=vtr(vp_+(((i)>>2)*4096+((i)&3)*1024+512)); }while(0)
  #define KRD(G,j) do{ if(G){ kload2(kf,kp0+sl_next,j); SBAR(); } }while(0)
  #define STEP(C0,C1,P0,P1,t,GK,GV,GL) do{ SBAR(); \
    const lds_cptr vp_=vp0+sl_prev; \
    VRD(0); SBAR(); float sacc=(P0[0]+P0[1]); \
    GAPA(C0=__builtin_amdgcn_mfma_f32_32x32x16_bf16(kf[0],qr[0],negm,0,0,0), P0[2],P0[3],P0[4],P0[5],     pw0[0]=PKW(P0,0), pw0[1]=PKW(P0,2), pw0); \
    VRD(4); SBAR(); GAPA(C1=__builtin_amdgcn_mfma_f32_32x32x16_bf16(kf[1],qr[0],negm,0,0,0), P0[6],P0[7],P0[8],P0[9],     pw0[2]=PKW(P0,4), pw0[3]=PKW(P0,6), pw0); \
    VRD(1); SBAR(); GAPA(C0=__builtin_amdgcn_mfma_f32_32x32x16_bf16(kf[2],qr[1],C0,0,0,0),   P0[10],P0[11],P0[12],P0[13], pw1[0]=PKW(P0,8), pw1[1]=PKW(P0,10), pw1); \
    VRD(5); SBAR(); GAPA(C1=__builtin_amdgcn_mfma_f32_32x32x16_bf16(kf[3],qr[1],C1,0,0,0),   P0[14],P0[15],P1[0],P1[1],   pw1[2]=PKW(P0,12),pw1[3]=PKW(P0,14), pw1); \
    VRD(2); SBAR(); GAPA(C0=__builtin_amdgcn_mfma_f32_32x32x16_bf16(kf[4],qr[2],C0,0,0,0),   P1[2],P1[3],P1[4],P1[5],     pw2[0]=PKW(P1,0), pw2[1]=PKW(P1,2), pw2); \
    VRD(6); SBAR(); GAPA(C1=__builtin_amdgcn_mfma_f32_32x32x16_bf16(kf[5],qr[2],C1,0,0,0),   P1[6],P1[7],P1[8],P1[9],     pw2[2]=PKW(P1,4), pw2[3]=PKW(P1,6), pw2); \
    VRD(3); SBAR(); GAPA(C0=__builtin_amdgcn_mfma_f32_32x32x16_bf16(kf[6],qr[3],C0,0,0,0),   P1[10],P1[11],P1[12],P1[13], pw3[0]=PKW(P1,8), pw3[1]=PKW(P1,10), pw3); \
    VRD(7); SBAR(); GAPA(C1=__builtin_amdgcn_mfma_f32_32x32x16_bf16(kf[7],qr[3],C1,0,0,0),   P1[14],P1[15],0.f,0.f,       pw3[2]=PKW(P1,12),pw3[3]=PKW(P1,14), pw3); \
    l_reg+=sacc; \
    if(GK){DMA_K((t)+3,sl_cur);} if(GV){DMA_V((t)+1,sl_next);} \
    CMASK(C0,C1,t); \
    { float a=MX3(C0[0],C0[1],C1[0]),b=MX3(C0[2],C0[3],C1[1]); a=MX3(a,C1[2],C1[3]); \
      _Pragma("unroll") for(int r=4;r<16;r+=4){a=MX3(a,C0[r],C0[r+1]);b=MX3(b,C0[r+2],C0[r+3]);a=MX3(a,C1[r],C1[r+1]);b=MX3(b,C1[r+2],C1[r+3]);} \
      float rm=__builtin_fmaxf(a,b); { auto rr=__builtin_amdgcn_permlane32_swap(__float_as_uint(rm),__float_as_uint(rm),false,false); rm=__builtin_fmaxf(__uint_as_float(rr[0]),__uint_as_float(rr[1])); } \
      resc=false; \
      if(__builtin_expect(__any(rm>(float)THRL),0)){ const float dl=__builtin_fmaxf(rm,0.f); mhat+=dl; \
        _Pragma("unroll") for(int r=0;r<16;++r){C0[r]-=dl;C1[r]-=dl;} \
        _Pragma("unroll") for(int r=0;r<16;++r)negm[r]=-mhat; asm volatile("":"+v"(negm)); \
        const float f=__builtin_amdgcn_exp2f(-dl); l_reg*=f; if(hi==0)wsf[r32]=f; resc=true; } } \
    SBAR(); \
    GAPB(o[0]=__builtin_amdgcn_mfma_f32_32x32x16_bf16(PAF(0),VFR(0),o[0],0,0,0), C0,0); \
    GAPB(o[1]=__builtin_amdgcn_mfma_f32_32x32x16_bf16(PAF(0),VFR(4),o[1],0,0,0), C0,4); \
    KRD(GL,0); GAPB(o[0]=__builtin_amdgcn_mfma_f32_32x32x16_bf16(PAF(1),VFR(1),o[0],0,0,0), C0,8); \
    KRD(GL,1); GAPB(o[1]=__builtin_amdgcn_mfma_f32_32x32x16_bf16(PAF(1),VFR(5),o[1],0,0,0), C0,12); \
    KRD(GL,2); GAPB(o[0]=__builtin_amdgcn_mfma_f32_32x32x16_bf16(PAF(2),VFR(2),o[0],0,0,0), C1,0); \
    KRD(GL,3); GAPB(o[1]=__builtin_amdgcn_mfma_f32_32x32x16_bf16(PAF(2),VFR(6),o[1],0,0,0), C1,4); \
    GAPB(o[0]=__builtin_amdgcn_mfma_f32_32x32x16_bf16(PAF(3),VFR(3),o[0],0,0,0), C1,8); \
    GAPB(o[1]=__builtin_amdgcn_mfma_f32_32x32x16_bf16(PAF(3),VFR(7),o[1],0,0,0), C1,12); \
    }while(0)
  int t=1;
  #undef CMASK
  #define CMASK(P0,P1,t) do{}while(0)
  for(;t+5<NT;t+=2){
    STEP(pB0,pB1,pA0,pA1,t,true,true,true);     WAIT_BAR(2); RESC(); ROT();
    STEP(pA0,pA1,pB0,pB1,t+1,true,true,true);   WAIT_BAR(2); RESC(); ROT();
  }
  #undef CMASK
  #define CMASK(P0,P1,t) do{}while(0)
  #define ENDW(tt) do{ if((tt)+3<NT){WAIT_BAR(2);} else if((tt)+2<NT){WAIT_BAR(1);} else {WAIT_BAR(0);} }while(0)
  for(;t+1<NT;t+=2){
    STEP(pB0,pB1,pA0,pA1,t,(t+3<NT),(t+1<NT),(t+1<NT));       ENDW(t);   RESC(); ROT();
    STEP(pA0,pA1,pB0,pB1,t+1,(t+4<NT),(t+2<NT),(t+2<NT));     ENDW(t+1); RESC(); ROT();
  }
  STEP(pB0,pB1,pA0,pA1,NT-1,false,false,false); RESC();
  { float sacc=pB0[0]+pB0[1]; _Pragma("unroll") for(int r=2;r<16;++r)sacc+=pB0[r]; _Pragma("unroll") for(int r=0;r<16;++r)sacc+=pB1[r]; l_reg+=sacc;
    pw0=(u32x4){PKW(pB0,0),PKW(pB0,2),PKW(pB0,4),PKW(pB0,6)};pw1=(u32x4){PKW(pB0,8),PKW(pB0,10),PKW(pB0,12),PKW(pB0,14)};pw2=(u32x4){PKW(pB1,0),PKW(pB1,2),PKW(pB1,4),PKW(pB1,6)};pw3=(u32x4){PKW(pB1,8),PKW(pB1,10),PKW(pB1,12),PKW(pB1,14)};
    SBAR(); pv(o,vb0+sl_cur,PAF(0),PAF(1),PAF(2),PAF(3)); }
  #undef PKW
  #undef PAF
  #undef VFR
  #undef PIN
  #undef MX3
  #undef GAPA
  #undef GAPB
  #undef EX
  #undef VRD
  #undef KRD
  #undef STEP
  #undef ENDW
  {auto rr=__builtin_amdgcn_permlane32_swap(__float_as_uint(l_reg),__float_as_uint(l_reg),false,false);l_reg=__uint_as_float(rr[0])+__uint_as_float(rr[1]);}
  if(hi==0)wsf[32+r32]=l_reg;asm volatile("s_waitcnt lgkmcnt(0)":::"memory");
  float rli[16];
  #pragma unroll
  for(int r=0;r<16;++r)rli[r]=__builtin_amdgcn_rcpf(wsf[32+crow(r,hi)]);
  bf16*Ow=O+(q0+wid*QBLK)*op+ocol;
  { bf16*stg=(bf16*)(shm+LDS_OST)+wid*2048;
    #pragma unroll
    for(int r=0;r<16;++r){const int orow=crow(r,hi);
      #pragma unroll
      for(int d0=0;d0<2;++d0)stg[orow*64+d0*32+r32]=__float2bfloat16(o[d0][r]*rli[r]);}
    asm volatile("s_waitcnt lgkmcnt(0)":::"memory");
    #pragma unroll
    for(int i=0;i<4;++i){const int row=i*8+(lane>>3),ch=lane&7; const u32x4 v=*(const u32x4*)(stg+row*64+ch*8); ATTN_STORE16(Ow+(long)row*op+ch*8,v);} }
#ifdef ATT_STATIC_PRIO
  __builtin_amdgcn_s_setprio(0);
#endif
  asm volatile("s_waitcnt lgkmcnt(0)\n\ts_barrier":::"memory");
  #undef DMA_K
  #undef DMA_V
  #undef CMASK
  #undef START
  #undef RESC
  #undef ROT
}
constexpr int ATTN_LDS_BYTES=LDS_BYTES;

#undef SBAR
#undef WAIT_BAR
}
namespace att96 {
using bf16=__hip_bfloat16;
using bf16x8=__attribute__((ext_vector_type(8)))short;
using s16x4=__attribute__((ext_vector_type(4)))short;
using f32x16=__attribute__((ext_vector_type(16)))float;
using u32x4=__attribute__((ext_vector_type(4)))unsigned;
constexpr int D=64;
constexpr int NW=8,QBLK=32,QB=QBLK*NW,KVBLK=64;

__device__ __forceinline__ int crow(int r,int hi){return (r&3)+8*(r>>2)+4*hi;}
#define SBAR() __builtin_amdgcn_sched_barrier(0)
__device__ __forceinline__ void cmask(f32x16&p0,f32x16&p1,int jb,int qrel,int hi){
  const float NEG=-INFINITY; int kb=64*jb+4*hi;
  #pragma unroll
  for(int r=0;r<16;++r){int kv=kb+(r&3)+8*(r>>2); if(kv>qrel)p0[r]=NEG; if(kv+32>qrel)p1[r]=NEG;}
}

constexpr int NSLOT=3, SLOTB=8192;
constexpr int KSLOTB=12288;
constexpr int LDS_K=0, LDS_V=NSLOT*KSLOTB, LDS_WS=LDS_V+NSLOT*SLOTB, LDS_OST=LDS_WS+NW*64*4, LDS_BYTES=LDS_OST+NW*4096;
constexpr float C2=0.125f*1.4426950408889634f;
__device__ __forceinline__ void glds16(const void*gsrc,unsigned lds_dst){unsigned keep;
  asm volatile("s_mov_b32 %0, m0\n\ts_mov_b32 m0, %2\n\ts_nop 0\n\tglobal_load_lds_dwordx4 %1, off\n\ts_mov_b32 m0, %0":"=&s"(keep):"v"(gsrc),"s"(lds_dst):"memory");}
__device__ __forceinline__ float max3f(float a,float b,float c){float r;asm("v_max3_f32 %0, %1, %2, %3":"=v"(r):"v"(a),"v"(b),"v"(c));return r;}
__device__ __forceinline__ float max2f(float a,float b){float r;asm("v_max_f32_e32 %0, %1, %2":"=v"(r):"v"(a),"v"(b));return r;}
__device__ __forceinline__ float fadd_s(float a,float b){float r;asm("v_add_f32_e32 %0, %1, %2":"=v"(r):"v"(a),"v"(b));return r;}
__device__ __forceinline__ float fsub_s(float a,float b){float r;asm("v_sub_f32_e32 %0, %1, %2":"=v"(r):"v"(a),"v"(b));return r;}
typedef float f32x2_t __attribute__((ext_vector_type(2))); typedef __bf16 bf16x2_t __attribute__((ext_vector_type(2)));
__device__ __forceinline__ unsigned cvtpk_s(float lo,float hi){f32x2_t v={lo,hi};bf16x2_t b=__builtin_convertvector(v,bf16x2_t);return __builtin_bit_cast(unsigned,b);}
#define KOFF(sl) ((sl)+((sl)>>1))
#define WAIT_BAR(N) asm volatile("s_waitcnt vmcnt(" #N ") lgkmcnt(0)\n\ts_barrier":::"memory")

__device__ __forceinline__ void qkt(f32x16&p0,f32x16&p1,const char*Kslot,const bf16x8*qr,const f32x16&negm,int r32,int hi){
  const char*kb=Kslot+hi*1024+r32*16;
  #pragma unroll
  for(int d0=0;d0<6;++d0){
    const bf16x8 b0=*reinterpret_cast<const bf16x8*>(kb+d0*2048);
    const bf16x8 b1=*reinterpret_cast<const bf16x8*>(kb+d0*2048+512);
    if(d0==0){p0=__builtin_amdgcn_mfma_f32_32x32x16_bf16(b0,qr[0],negm,0,0,0);p1=__builtin_amdgcn_mfma_f32_32x32x16_bf16(b1,qr[0],negm,0,0,0);}
    else{p0=__builtin_amdgcn_mfma_f32_32x32x16_bf16(b0,qr[d0],p0,0,0,0);p1=__builtin_amdgcn_mfma_f32_32x32x16_bf16(b1,qr[d0],p1,0,0,0);}}
}
typedef __attribute__((address_space(3))) const char* lds_cptr;
typedef short v4i16_t __attribute__((ext_vector_type(4)));
__device__ __forceinline__ void kload12(bf16x8*kf,lds_cptr kp){
  kf[0]=*(const __attribute__((address_space(3))) bf16x8*)(kp);      kf[1]=*(const __attribute__((address_space(3))) bf16x8*)(kp+512);
  kf[2]=*(const __attribute__((address_space(3))) bf16x8*)(kp+2048); kf[3]=*(const __attribute__((address_space(3))) bf16x8*)(kp+2560);
  kf[4]=*(const __attribute__((address_space(3))) bf16x8*)(kp+4096); kf[5]=*(const __attribute__((address_space(3))) bf16x8*)(kp+4608);
  kf[6]=*(const __attribute__((address_space(3))) bf16x8*)(kp+6144); kf[7]=*(const __attribute__((address_space(3))) bf16x8*)(kp+6656);
  kf[8]=*(const __attribute__((address_space(3))) bf16x8*)(kp+8192); kf[9]=*(const __attribute__((address_space(3))) bf16x8*)(kp+8704);
  kf[10]=*(const __attribute__((address_space(3))) bf16x8*)(kp+10240); kf[11]=*(const __attribute__((address_space(3))) bf16x8*)(kp+10752);
}
__device__ __forceinline__ void kload2(bf16x8*kf,lds_cptr kp,int j){ kf[2*j]=*(const __attribute__((address_space(3))) bf16x8*)(kp+j*2048); kf[2*j+1]=*(const __attribute__((address_space(3))) bf16x8*)(kp+j*2048+512); }
__device__ __forceinline__ s16x4 vtr(lds_cptr p){ return __builtin_bit_cast(s16x4,__builtin_amdgcn_ds_read_tr16_b64_v4i16((__attribute__((address_space(3))) v4i16_t*)p)); }
__device__ __forceinline__ float rowmax(const f32x16&p0,const f32x16&p1){
  float a=max3f(p0[0],p0[1],p1[0]),b=max3f(p0[2],p0[3],p1[1]);a=max3f(a,p1[2],p1[3]);
  #pragma unroll
  for(int r=4;r<16;r+=4){a=max3f(a,p0[r],p0[r+1]);b=max3f(b,p0[r+2],p0[r+3]);a=max3f(a,p1[r],p1[r+1]);b=max3f(b,p1[r+2],p1[r+3]);}
  const float m=max2f(a,b);
  auto rr=__builtin_amdgcn_permlane32_swap(__float_as_uint(m),__float_as_uint(m),false,false);
  return max2f(__uint_as_float(rr[0]),__uint_as_float(rr[1]));
}
__device__ __forceinline__ void pv(f32x16*o,int vb,bf16x8 pa0,bf16x8 pa1,bf16x8 pa2,bf16x8 pa3){
  #pragma unroll
  for(int d0=0;d0<2;++d0){s16x4 lo[4],hi[4];
    #pragma unroll
    for(int ks=0;ks<4;++ks){
      asm volatile("ds_read_b64_tr_b16 %0,%1 offset:%c2":"=&v"(lo[ks]):"v"(vb),"i"(d0*4096+ks*1024):"memory");
      asm volatile("ds_read_b64_tr_b16 %0,%1 offset:%c2":"=&v"(hi[ks]):"v"(vb),"i"(d0*4096+ks*1024+512):"memory");}
    asm volatile("s_waitcnt lgkmcnt(0)":::"memory");SBAR();
    #define PK(k) (bf16x8){lo[k][0],lo[k][1],lo[k][2],lo[k][3],hi[k][0],hi[k][1],hi[k][2],hi[k][3]}
    o[d0]=__builtin_amdgcn_mfma_f32_32x32x16_bf16(pa0,PK(0),o[d0],0,0,0);
    o[d0]=__builtin_amdgcn_mfma_f32_32x32x16_bf16(pa1,PK(1),o[d0],0,0,0);
    o[d0]=__builtin_amdgcn_mfma_f32_32x32x16_bf16(pa2,PK(2),o[d0],0,0,0);
    o[d0]=__builtin_amdgcn_mfma_f32_32x32x16_bf16(pa3,PK(3),o[d0],0,0,0);
    #undef PK
  }
}

#ifndef ATTN_STORE16
#define ATTN_STORE16(p,v) (*(u32x4*)(p)=(v))
#endif
template<int THRL> __device__ __forceinline__ void attn_unit(long q0,const bf16*Q,int qp,int qcol,const bf16*__restrict__ K,int kp,int kcol,const bf16*__restrict__ V,int vp,int vcol,long kv0,int NT,bf16*O,int op,int ocol,char*shm,const float*qgain,const float*T16){
  int tid_=threadIdx.x; asm volatile("":"+v"(tid_));
  const int tid=tid_,lane=tid&63,r32=lane&31,hi=lane>>5; const int wid=__builtin_amdgcn_readfirstlane(tid>>6);
#ifdef ATT_STATIC_PRIO
  if(wid>=4)__builtin_amdgcn_s_setprio(1);
#endif
  const bf16*Qw=Q+(q0+wid*QBLK)*qp+qcol;
  const bf16*Kh=K+kv0*kp+kcol,*Vh=V+kv0*vp+vcol;
  const unsigned lds0=(unsigned)(uintptr_t)shm;
  float*wsf=(float*)(shm+LDS_WS)+wid*64;
  const bf16*ksrc=Kh+(long)lane*kp+wid*8;
  const bf16*vsrc=Vh+(long)(16*(wid&3)+(lane>>2))*vp+(wid>>2)*32+(lane&3)*8;
  const unsigned kdst=lds0+LDS_K+wid*1024, vdst=lds0+LDS_V+wid*1024, kdst2=lds0+LDS_K+(8+wid)*1024;
  const bf16*ksrc2=Kh+(long)lane*kp+64+wid*8;
  const bool big=wid<4;
  #define DMA_K(t,slot) do{ glds16(ksrc+(long)(t)*KVBLK*kp,(unsigned)__builtin_amdgcn_readfirstlane(kdst+KOFF(slot))); if(big) glds16(ksrc2+(long)(t)*KVBLK*kp,(unsigned)__builtin_amdgcn_readfirstlane(kdst2+KOFF(slot))); }while(0)
  #define WAITKV() do{ if(big){WAIT_BAR(3);} else {WAIT_BAR(2);} }while(0)
  #define DMA_V(t,slot) glds16(vsrc+(long)(t)*KVBLK*vp,(unsigned)__builtin_amdgcn_readfirstlane(vdst+(slot)))
  const int vb0=(int)(lds0+LDS_V)+((lane>>4)&1)*32+(lane&3)*8+(4*hi+((lane&15)>>2))*64;
  const char*Kbase=shm+LDS_K; bf16x8 kf[12];
  const lds_cptr shm3=(lds_cptr)shm; const lds_cptr kp0=shm3+LDS_K+hi*1024+r32*16; const lds_cptr vp0=shm3+LDS_V+((lane>>4)&1)*32+(lane&3)*8+(4*hi+((lane&15)>>2))*64;
  DMA_K(0,0);DMA_V(0,0);DMA_K(1,SLOTB);
  bf16x8 qr[6];
  #pragma unroll
  for(int d0=0;d0<6;++d0)qr[d0]=*reinterpret_cast<const bf16x8*>(&Qw[(long)r32*qp+d0*16+hi*8]);
  {
    float f[6][8]; float ss=0.f;
    #pragma unroll
    for(int d0=0;d0<6;++d0)
      #pragma unroll
      for(int j=0;j<8;++j){ f[d0][j]=__uint_as_float(((unsigned)(unsigned short)qr[d0][j])<<16); ss+=f[d0][j]*f[d0][j]; }
    ss+=__shfl_xor(ss,32);
    const float rn=rsqrtf(ss*(1.f/96.f)+EPS)*C2_96;
    #pragma unroll
    for(int d0=0;d0<6;++d0)
      #pragma unroll
      for(int j=0;j<8;++j) f[d0][j]=f[d0][j]*rn*qgain[d0*16+hi*8+j];
    const int tq=(int)((q0+wid*QBLK+r32)%S); const int grow=tq/GW,gcol=tq%GW;
    #pragma unroll
    for(int part=0;part<2;++part){ const int pos=part?gcol:grow;
      #pragma unroll
      for(int j=0;j<8;++j){ const float cs=T16[pos*8+j],sn=T16[512+pos*8+j];
        const float mine=f[4+part][j],other=__shfl_xor(mine,32);
        f[4+part][j]=hi==0?(mine*cs-other*sn):(other*sn+mine*cs); } }
    #pragma unroll
    for(int d0=0;d0<6;++d0)
      #pragma unroll
      for(int j=0;j<4;++j){ const unsigned w=cvtpk_s(f[d0][2*j],f[d0][2*j+1]); qr[d0][2*j]=(short)(w&0xffff); qr[d0][2*j+1]=(short)(w>>16); }
  }
  float mhat=0.f,l_reg=0.f;f32x16 o[2];o[0]=f32x16{};o[1]=f32x16{};f32x16 negm=f32x16{};asm volatile("":"+v"(negm));
  #define CMASK(P0,P1,t) do{}while(0)
  bool resc=false;
  #define START(P0,P1) do{ const float rm=rowmax(P0,P1); resc=false; \
    { const float dl=rm; mhat=fadd_s(mhat,dl); \
      _Pragma("unroll") for(int r=0;r<16;++r){P0[r]=fsub_s(P0[r],dl);P1[r]=fsub_s(P1[r],dl);} \
      _Pragma("unroll") for(int r=0;r<16;++r)negm[r]=-mhat; asm volatile("":"+v"(negm)); } \
    _Pragma("unroll") for(int r=0;r<16;++r)P0[r]=__builtin_amdgcn_exp2f(P0[r]); }while(0)
  #define RESC() do{ if(resc){ asm volatile("s_waitcnt lgkmcnt(0)":::"memory"); \
      _Pragma("unroll") for(int d_=0;d_<2;++d_) _Pragma("unroll") for(int r=0;r<16;++r)o[d_][r]*=wsf[crow(r,hi)]; } }while(0)
  f32x16 pA0,pA1,pB0,pB1;
  int sl_prev=0,sl_cur=0,sl_next=SLOTB;
  #define ROT() do{sl_prev=sl_cur;sl_cur=sl_next;sl_next=(sl_next==(NSLOT-1)*SLOTB)?0:sl_next+SLOTB;}while(0)
  DMA_K(2,2*SLOTB);
  if(big){WAIT_BAR(5);}else{WAIT_BAR(3);}
  qkt(pA0,pA1,Kbase,qr,negm,r32,hi);asm volatile("s_nop 15\n\ts_nop 7":"+v"(pA0),"+v"(pA1));CMASK(pA0,pA1,0);
  START(pA0,pA1);
  _Pragma("unroll") for(int r=0;r<16;++r)pA1[r]=__builtin_amdgcn_exp2f(pA1[r]);
  WAIT_BAR(0);
  DMA_K(3,0);DMA_V(1,SLOTB);
  ROT();
  kload12(kf,kp0+KOFF(sl_cur));
  WAITKV();
  s16x4 vlo[8],vhi[8]; u32x4 pw0,pw1,pw2,pw3;
  #define PKW(P,B) cvtpk_s(P[B],P[B+1])
  #define PAF(k) __builtin_bit_cast(bf16x8,pw##k)
  #define VFR(i) (bf16x8){vlo[i][0],vlo[i][1],vlo[i][2],vlo[i][3],vhi[i][0],vhi[i][1],vhi[i][2],vhi[i][3]}
  #define PIN(x) asm volatile("":"+v"(x))
  #define MX3(a,b,c) __builtin_fmaxf(__builtin_fmaxf((a),(b)),(c))
  #define GAPA(MF,A0,A1,A2,A3,W0,W1,PW) do{ MF; sacc+=A0; sacc+=A1; sacc+=A2; sacc+=A3; PIN(sacc); W0; W1; PIN(PW); SBAR(); }while(0)
  #define EX(v) __builtin_amdgcn_exp2f(v)
  #define GAPB(MF,X,B) do{ MF; X[B]=EX(X[B]); X[B+1]=EX(X[B+1]); X[B+2]=EX(X[B+2]); X[B+3]=EX(X[B+3]); PIN(X); SBAR(); }while(0)
  #define VRD(i) do{ vlo[i]=vtr(vp_+(((i)>>2)*4096+((i)&3)*1024)); vhi[i]=vtr(vp_+(((i)>>2)*4096+((i)&3)*1024+512)); }while(0)
  #define KRD(G,j) do{ if(G){ kload2(kf,kp0+KOFF(sl_next),j); SBAR(); } }while(0)
  #define STEP(C0,C1,P0,P1,t,GK,GV,GL) do{ SBAR(); \
    const lds_cptr vp_=vp0+sl_prev; \
    VRD(0); SBAR(); float sacc=(P0[0]+P0[1]); \
    GAPA(C0=__builtin_amdgcn_mfma_f32_32x32x16_bf16(kf[0],qr[0],negm,0,0,0), P0[2],P0[3],P0[4],P0[5],     pw0[0]=PKW(P0,0), pw0[1]=PKW(P0,2), pw0); \
    VRD(4); SBAR(); GAPA(C1=__builtin_amdgcn_mfma_f32_32x32x16_bf16(kf[1],qr[0],negm,0,0,0), P0[6],P0[7],P0[8],P0[9],     pw0[2]=PKW(P0,4), pw0[3]=PKW(P0,6), pw0); \
    VRD(1); SBAR(); GAPA(C0=__builtin_amdgcn_mfma_f32_32x32x16_bf16(kf[2],qr[1],C0,0,0,0),   P0[10],P0[11],P0[12],P0[13], pw1[0]=PKW(P0,8), pw1[1]=PKW(P0,10), pw1); \
    VRD(5); SBAR(); GAPA(C1=__builtin_amdgcn_mfma_f32_32x32x16_bf16(kf[3],qr[1],C1,0,0,0),   P0[14],P0[15],P1[0],P1[1],   pw1[2]=PKW(P0,12),pw1[3]=PKW(P0,14), pw1); \
    VRD(2); SBAR(); GAPA(C0=__builtin_amdgcn_mfma_f32_32x32x16_bf16(kf[4],qr[2],C0,0,0,0),   P1[2],P1[3],P1[4],P1[5],     pw2[0]=PKW(P1,0), pw2[1]=PKW(P1,2), pw2); \
    VRD(6); SBAR(); GAPA(C1=__builtin_amdgcn_mfma_f32_32x32x16_bf16(kf[5],qr[2],C1,0,0,0),   P1[6],P1[7],P1[8],P1[9],     pw2[2]=PKW(P1,4), pw2[3]=PKW(P1,6), pw2); \
    VRD(3); SBAR(); GAPA(C0=__builtin_amdgcn_mfma_f32_32x32x16_bf16(kf[6],qr[3],C0,0,0,0),   P1[10],P1[11],P1[12],P1[13], pw3[0]=PKW(P1,8), pw3[1]=PKW(P1,10), pw3); \
    VRD(7); SBAR(); GAPA(C1=__builtin_amdgcn_mfma_f32_32x32x16_bf16(kf[7],qr[3],C1,0,0,0),   P1[14],P1[15],0.f,0.f,       pw3[2]=PKW(P1,12),pw3[3]=PKW(P1,14), pw3); \
    C0=__builtin_amdgcn_mfma_f32_32x32x16_bf16(kf[8],qr[4],C0,0,0,0); SBAR(); C1=__builtin_amdgcn_mfma_f32_32x32x16_bf16(kf[9],qr[4],C1,0,0,0); SBAR(); \
    C0=__builtin_amdgcn_mfma_f32_32x32x16_bf16(kf[10],qr[5],C0,0,0,0); SBAR(); C1=__builtin_amdgcn_mfma_f32_32x32x16_bf16(kf[11],qr[5],C1,0,0,0); SBAR(); \
    l_reg+=sacc; \
    if(GK){DMA_K((t)+3,sl_cur);} if(GV){DMA_V((t)+1,sl_next);} \
    CMASK(C0,C1,t); \
    { float a=MX3(C0[0],C0[1],C1[0]),b=MX3(C0[2],C0[3],C1[1]); a=MX3(a,C1[2],C1[3]); \
      _Pragma("unroll") for(int r=4;r<16;r+=4){a=MX3(a,C0[r],C0[r+1]);b=MX3(b,C0[r+2],C0[r+3]);a=MX3(a,C1[r],C1[r+1]);b=MX3(b,C1[r+2],C1[r+3]);} \
      float rm=__builtin_fmaxf(a,b); { auto rr=__builtin_amdgcn_permlane32_swap(__float_as_uint(rm),__float_as_uint(rm),false,false); rm=__builtin_fmaxf(__uint_as_float(rr[0]),__uint_as_float(rr[1])); } \
      resc=false; \
      if(__builtin_expect(__any(rm>(float)THRL),0)){ const float dl=__builtin_fmaxf(rm,0.f); mhat+=dl; \
        _Pragma("unroll") for(int r=0;r<16;++r){C0[r]-=dl;C1[r]-=dl;} \
        _Pragma("unroll") for(int r=0;r<16;++r)negm[r]=-mhat; asm volatile("":"+v"(negm)); \
        const float f=__builtin_amdgcn_exp2f(-dl); l_reg*=f; if(hi==0)wsf[r32]=f; resc=true; } } \
    SBAR(); \
    GAPB(o[0]=__builtin_amdgcn_mfma_f32_32x32x16_bf16(PAF(0),VFR(0),o[0],0,0,0), C0,0); \
    KRD(GL,0); GAPB(o[1]=__builtin_amdgcn_mfma_f32_32x32x16_bf16(PAF(0),VFR(4),o[1],0,0,0), C0,4); \
    KRD(GL,1); GAPB(o[0]=__builtin_amdgcn_mfma_f32_32x32x16_bf16(PAF(1),VFR(1),o[0],0,0,0), C0,8); \
    KRD(GL,2); GAPB(o[1]=__builtin_amdgcn_mfma_f32_32x32x16_bf16(PAF(1),VFR(5),o[1],0,0,0), C0,12); \
    KRD(GL,3); GAPB(o[0]=__builtin_amdgcn_mfma_f32_32x32x16_bf16(PAF(2),VFR(2),o[0],0,0,0), C1,0); \
    KRD(GL,4); GAPB(o[1]=__builtin_amdgcn_mfma_f32_32x32x16_bf16(PAF(2),VFR(6),o[1],0,0,0), C1,4); \
    KRD(GL,5); GAPB(o[0]=__builtin_amdgcn_mfma_f32_32x32x16_bf16(PAF(3),VFR(3),o[0],0,0,0), C1,8); \
    GAPB(o[1]=__builtin_amdgcn_mfma_f32_32x32x16_bf16(PAF(3),VFR(7),o[1],0,0,0), C1,12); \
    }while(0)
  int t=1;
  #undef CMASK
  #define CMASK(P0,P1,t) do{}while(0)
  for(;t+5<NT;t+=2){
    STEP(pB0,pB1,pA0,pA1,t,true,true,true);     WAITKV(); RESC(); ROT();
    STEP(pA0,pA1,pB0,pB1,t+1,true,true,true);   WAITKV(); RESC(); ROT();
  }
  #undef CMASK
  #define CMASK(P0,P1,t) do{}while(0)
  #define ENDW(tt) do{ if((tt)+3<NT){WAITKV();} else if((tt)+2<NT){WAIT_BAR(1);} else {WAIT_BAR(0);} }while(0)
  for(;t+1<NT;t+=2){
    STEP(pB0,pB1,pA0,pA1,t,(t+3<NT),(t+1<NT),(t+1<NT));       ENDW(t);   RESC(); ROT();
    STEP(pA0,pA1,pB0,pB1,t+1,(t+4<NT),(t+2<NT),(t+2<NT));     ENDW(t+1); RESC(); ROT();
  }
  STEP(pB0,pB1,pA0,pA1,NT-1,false,false,false); RESC();
  { float sacc=pB0[0]+pB0[1]; _Pragma("unroll") for(int r=2;r<16;++r)sacc+=pB0[r]; _Pragma("unroll") for(int r=0;r<16;++r)sacc+=pB1[r]; l_reg+=sacc;
    pw0=(u32x4){PKW(pB0,0),PKW(pB0,2),PKW(pB0,4),PKW(pB0,6)};pw1=(u32x4){PKW(pB0,8),PKW(pB0,10),PKW(pB0,12),PKW(pB0,14)};pw2=(u32x4){PKW(pB1,0),PKW(pB1,2),PKW(pB1,4),PKW(pB1,6)};pw3=(u32x4){PKW(pB1,8),PKW(pB1,10),PKW(pB1,12),PKW(pB1,14)};
    SBAR(); pv(o,vb0+sl_cur,PAF(0),PAF(1),PAF(2),PAF(3)); }
  #undef PKW
  #undef PAF
  #undef VFR
  #undef PIN
  #undef MX3
  #undef GAPA
  #undef GAPB
  #undef EX
  #undef VRD
  #undef KRD
  #undef STEP
  #undef ENDW
  {auto rr=__builtin_amdgcn_permlane32_swap(__float_as_uint(l_reg),__float_as_uint(l_reg),false,false);l_reg=__uint_as_float(rr[0])+__uint_as_float(rr[1]);}
  if(hi==0)wsf[32+r32]=l_reg;asm volatile("s_waitcnt lgkmcnt(0)":::"memory");
  float rli[16];
  #pragma unroll
  for(int r=0;r<16;++r)rli[r]=__builtin_amdgcn_rcpf(wsf[32+crow(r,hi)]);
  bf16*Ow=O+(q0+wid*QBLK)*op+ocol;
  { bf16*stg=(bf16*)(shm+LDS_OST)+wid*2048;
    #pragma unroll
    for(int r=0;r<16;++r){const int orow=crow(r,hi);
      #pragma unroll
      for(int d0=0;d0<2;++d0)stg[orow*64+d0*32+r32]=__float2bfloat16(o[d0][r]*rli[r]);}
    asm volatile("s_waitcnt lgkmcnt(0)":::"memory");
    #pragma unroll
    for(int i=0;i<4;++i){const int row=i*8+(lane>>3),ch=lane&7; const u32x4 v=*(const u32x4*)(stg+row*64+ch*8); ATTN_STORE16(Ow+(long)row*op+ch*8,v);} }
#ifdef ATT_STATIC_PRIO
  __builtin_amdgcn_s_setprio(0);
#endif
  asm volatile("s_waitcnt lgkmcnt(0)\n\ts_barrier":::"memory");
  #undef DMA_K
  #undef WAITKV
  #undef DMA_V
  #undef CMASK
  #undef START
  #undef RESC
  #undef ROT
}
constexpr int ATTN_LDS_BYTES=LDS_BYTES;

#undef SBAR
#undef WAIT_BAR
#undef KOFF
}
#define LAS __attribute__((address_space(3)))
#define XB_TMO      128
#define XB_XCNT(j)  (256  + 64 * (j))
#define XB_XSUB(j)  (1280 + 64 * (j))
#define XB_XGEN(j)  (2304 + 64 * (j))
#define XB_TOP      3328
#define XB_TOPGEN   3392
#define XCD_BAR_WORDS 3456
#define XB_CTXH     3520
#define XB_SPIN_CAP (1u << 18)

__device__ __forceinline__ unsigned xb_ld(unsigned* p)              { return __hip_atomic_load(p, __ATOMIC_RELAXED, __HIP_MEMORY_SCOPE_AGENT); }
__device__ __forceinline__ unsigned xb_add(unsigned* p, unsigned v) { return __hip_atomic_fetch_add(p, v, __ATOMIC_RELAXED, __HIP_MEMORY_SCOPE_AGENT); }
__device__ __forceinline__ unsigned xb_xcc_id() { return (unsigned)__builtin_amdgcn_s_getreg((3 << 11) | 20) & 0xFu; }
#define XB_SPIN(cond, bar) do { unsigned _sp = 0; while (cond) { __builtin_amdgcn_s_sleep(1); \
    if ((++_sp & 255u) == 0u) { if (xb_ld(&(bar)[XB_TMO])) break; if (_sp > XB_SPIN_CAP) { atomicAdd(&(bar)[XB_TMO], 1u); break; } } } } while (0)

struct XcdBarrier {
    unsigned* bar; unsigned x;
    volatile LAS unsigned* st;
};

__device__ __forceinline__ XcdBarrier xcd_barrier_post(unsigned* bar, volatile LAS unsigned* st) {
    XcdBarrier b; b.bar = bar; b.x = xb_xcc_id(); b.st = st;
    if (threadIdx.x == 0) (void)xb_add(&bar[XB_XCNT(b.x)], 1u);
    return b;
}
__device__ __forceinline__ void xcd_barrier_complete(unsigned* bar, unsigned x, unsigned& nloc, unsigned& nx) {
    const unsigned G = gridDim.x * gridDim.y * gridDim.z;
    unsigned sum, cnt, mine, sp = 0u;
    for (;;) {
        sum = 0u; cnt = 0u; mine = 0u;
#pragma unroll
        for (unsigned j = 0; j < 16; ++j) { const unsigned c = xb_ld(&bar[XB_XCNT(j)]); sum += c; cnt += (c > 0u) ? 1u : 0u; mine = (j == x) ? c : mine; }
        if (sum == G) break;
        __builtin_amdgcn_s_sleep(1);
        if ((++sp & 255u) == 0u) { if (xb_ld(&bar[XB_TMO])) break; if (sp > XB_SPIN_CAP) { atomicAdd(&bar[XB_TMO], 1u); break; } }
    }
    nloc = mine > 0u ? mine : 1u; nx = cnt > 0u ? cnt : 1u;
}

__device__ __forceinline__ void xcd_barrier(const XcdBarrier& b) {
    asm volatile("s_waitcnt vmcnt(0)" ::: "memory");
    __syncthreads();
    if (threadIdx.x == 0) {
        unsigned* bar = b.bar;
        __builtin_amdgcn_s_waitcnt(0);
        unsigned nloc = b.st[0], nx = b.st[1];
        if (nloc == 0u) { xcd_barrier_complete(bar, b.x, nloc, nx); b.st[0] = nloc; b.st[1] = nx; }
        const unsigned old = xb_add(&bar[XB_XSUB(b.x)], 1u);
        const unsigned gen = old / nloc;
        if (old + 1u == (gen + 1u) * nloc) {
            __builtin_amdgcn_fence(__ATOMIC_RELEASE, "agent");
            asm volatile("s_waitcnt vmcnt(0)" ::: "memory");
            const unsigned og = xb_add(&bar[XB_TOP], 1u);
            const unsigned tg = og / nx;
            if (og + 1u == (tg + 1u) * nx) xb_add(&bar[XB_TOPGEN], 1u);
            else XB_SPIN(xb_ld(&bar[XB_TOPGEN]) == tg, bar);
            __builtin_amdgcn_fence(__ATOMIC_ACQUIRE, "agent");
            xb_add(&bar[XB_XGEN(b.x)], 1u);
            asm volatile("s_waitcnt vmcnt(0)" ::: "memory");
        } else {
            XB_SPIN(xb_ld(&bar[XB_XGEN(b.x)]) == gen, bar);
            __builtin_amdgcn_fence(__ATOMIC_ACQUIRE, "agent");
            asm volatile("s_waitcnt vmcnt(0)" ::: "memory");
        }
    }
    __syncthreads();
}
namespace mk {
#ifndef KVROT
#define KVROT 0
#endif
#ifndef ALIGN2
#define ALIGN2 true
#endif
#ifndef ALIGN1
#define ALIGN1 true
#endif
#define MLAS __attribute__((address_space(3)))
constexpr int NWAVES = 8, NTHR = 512;
constexpr int RING_BYTES = 131072;
constexpr int LDS_BYTES = 147456;
constexpr int NPHASE = 16;
typedef unsigned v4u __attribute__((ext_vector_type(4)));
typedef float f32x4 __attribute__((ext_vector_type(4)));

struct Ctx {
    Params p; MLAS unsigned char* lds; char* lds_g; int wave, G, vcu, bid;
};
__device__ __forceinline__ int tid_now() { int t = threadIdx.x; asm volatile("" : "+v"(t)); return t; }
__device__ __forceinline__ unsigned pk2(float lo, float hi) { return (unsigned)f2bf(lo) | ((unsigned)f2bf(hi) << 16); }

enum { W_IN0 = 0, W_OUT0, W_GU0, W_D0, W_IN1, W_UQ, W_UKV, W_OUT1, W_GU1, W_D1, NWMAT };
struct SrcBlk { const float* W; int ld; int col; const float* kscale; };
__device__ __forceinline__ SrcBlk src_of(const Params& p, int mat, int nb) {
    SrcBlk s; s.kscale = nullptr; const int pn = nb >> 3, q = nb & 7, bj = q >> 2, wc = q & 3;
    switch (mat) {
    case W_IN0: s.W = p.in[I0_WIN]; s.ld = L0_IN; s.col = 256 * pn + 64 * wc + 32 * bj; break;
    case W_OUT0: s.W = p.in[I0_WOUT]; s.ld = D; s.col = 32 * nb; break;
    case W_GU0: s.W = bj ? p.in[I0_WU] : p.in[I0_WG]; s.ld = FF; s.col = 128 * pn + 32 * wc; break;
    case W_D0: s.W = p.in[I0_WD]; s.ld = D; s.col = 32 * nb; break;
    case W_IN1: s.W = p.in[I1_WIN]; s.ld = L1_IN;
        if (pn == 0) s.col = 128 * bj + 32 * wc;
        else if (pn == 1) { if (bj == 0) s.col = 256 + 32 * wc; else s.col = 640; }
        else if (pn == 2) s.col = 384 + 128 * bj + 32 * wc;
        else if (pn < 5) s.col = 672 + (pn - 3) * 256 + 64 * wc + 32 * bj;
        else if (pn < 7) s.col = 1184 + (pn - 5) * 256 + 64 * wc + 32 * bj;
        else s.col = 1696 + (pn - 7) * 256 + 64 * wc + 32 * bj;
        break;
    case W_UQ: s.W = p.in[I1_WUQ]; s.ld = 768; s.col = 32 * nb; s.kscale = p.in[I1_QAG]; break;
    case W_UKV: s.W = p.in[I1_WUKV]; s.ld = 1024; s.col = (2 * pn + (wc >> 1)) * 128 + (wc & 1) * 64 + 32 * bj; s.kscale = p.in[I1_KVAG]; break;
    case W_OUT1: s.W = p.in[I1_WOUT]; s.ld = D; s.col = 32 * nb; break;
    case W_GU1: s.W = bj ? p.in[I1_WU] : p.in[I1_WG]; s.ld = FF; s.col = 128 * pn + 32 * wc; break;
    default: s.W = p.in[I1_WD]; s.ld = D; s.col = 32 * nb; break;
    }
    return s;
}
struct WMat { size_t ws_off; int K, N; };
__host__ __device__ constexpr WMat wmat(int mat) {
    switch (mat) {
    case W_IN0: return {WS_W_IN0, D, 1536}; case W_OUT0: return {WS_W_OUT0, D, D}; case W_GU0: return {WS_W_GU0, D, 2 * FF}; case W_D0: return {WS_W_D0, FF, D};
    case W_IN1: return {WS_W_IN1, D, L1_INP}; case W_UQ: return {WS_W_UQ, 384, 768}; case W_UKV: return {WS_W_UKV, 256, 1024}; case W_OUT1: return {WS_W_OUT1, D, D};
    case W_GU1: return {WS_W_GU1, D, 2 * FF}; default: return {WS_W_D1, FF, D};
    }
}
template <int mat> __device__ __forceinline__ void transpose_item(const Params& p, int item, MLAS float* scr, int lane) {
    const WMat wm = wmat(mat); const int nblk = wm.N / 32, kb = item / nblk, nb = item % nblk, k0 = 64 * kb;
    const SrcBlk s = src_of(p, mat, nb);
    bf16_t* WT = (bf16_t*)(p.ws + wm.ws_off);
    const int c = lane & 7;
    if (s.W == nullptr) {
#pragma unroll
        for (int j = 0; j < 4; ++j) { const int n = (lane >> 3) + 8 * j; *(v4u*)(WT + (size_t)(32 * nb + n) * wm.K + k0 + 8 * c) = (v4u){0u, 0u, 0u, 0u}; }
        return;
    }
    MLAS float* t0 = scr; MLAS float* t1 = scr + 64 * 33;
    if (mat == W_OUT0 && kb < 4) return;
    constexpr bool fused_pool = false;
    { const int c4 = (lane & 7) * 4, kr = lane >> 3;
        const float* wsrc = s.W + (size_t)(k0 + kr) * s.ld + s.col + c4;
        f32x4 v[8];
#pragma unroll
        for (int i = 0; i < 8; ++i) v[i] = *(const f32x4*)(wsrc + (size_t)(8 * i) * s.ld);
#pragma unroll
        for (int i = 0; i < 8; ++i) { const int kk = kr + 8 * i; float sc = 1.f;
            if (s.kscale) sc = s.kscale[k0 + kk];
            if (fused_pool) sc *= p.in[I0_POOLS][k0 + kk];
            MLAS float* d = t0 + kk * 33 + c4; d[0] = v[i][0] * sc; d[1] = v[i][1] * sc; d[2] = v[i][2] * sc; d[3] = v[i][3] * sc; } }
    asm volatile("s_waitcnt lgkmcnt(0)" ::: "memory");
    MLAS float* src = t0;
    if (fused_pool) {
        const float* pw = p.in[I0_POOLW] + kb * 4096; const int nn = lane & 31, ch = lane >> 5;
        for (int cc = ch; cc < 64; cc += 2) { float a = 0.f;
#pragma unroll 8
            for (int d = 0; d < 64; ++d) a += pw[cc * 64 + d] * t0[d * 33 + nn];
            t1[cc * 33 + nn] = a; }
        asm volatile("s_waitcnt lgkmcnt(0)" ::: "memory");
        src = t1;
    }
#pragma unroll
    for (int j = 0; j < 4; ++j) { const int n = (lane >> 3) + 8 * j; const MLAS float* sp = src + (8 * c) * 33 + n;
        v4u o; o.x = pk2(sp[0 * 33], sp[1 * 33]); o.y = pk2(sp[2 * 33], sp[3 * 33]); o.z = pk2(sp[4 * 33], sp[5 * 33]); o.w = pk2(sp[6 * 33], sp[7 * 33]);
        *(v4u*)(WT + (size_t)(32 * nb + n) * wm.K + k0 + 8 * c) = o; }
    asm volatile("s_waitcnt lgkmcnt(0)" ::: "memory");
}

#ifndef P0MASK
#define P0MASK 15
#endif
template <int PART> __device__ __forceinline__ void phase_prologue(Ctx& C, int vcu, int G) {
    const Params& p = C.p; const int tid = tid_now(), lane = tid & 63;
    MLAS float* sil = (MLAS float*)C.lds;
    MLAS float* red = (MLAS float*)(C.lds + 9 * 1024 * 4);
    __syncthreads();
#ifdef ADA_SPLIT
    if (PART <= 2)
#else
    if (PART < 2)
#endif
    for (int i = tid; i < 9 * D; i += NTHR) { const int j = i / D, k = i % D; const float c = (j < 8) ? p.in[I_C][j * D + k] : p.in[I_CCTX][k]; sil[i] = c / (1.f + expf(-c)); }
    __syncthreads();
    float* MOD = (float*)(p.ws + WS_MOD);
#ifdef ADA_SPLIT
    constexpr int ADA_N = (PART == 0) ? 32 : (PART == 2) ? 64 : 96, ADA_BASE = (PART == 0) ? 0 : (PART == 2) ? 32 : 96;
    if ((P0MASK & 1) && PART <= 2)
    for (int it0 = vcu; it0 < ADA_N; it0 += G) { const int it = it0 + ADA_BASE;
#else
    if ((P0MASK & 1) && PART < 2)
    for (int it0 = vcu; it0 < 96; it0 += G) { const int it = it0 + 96 * PART;
#endif
        const int l = it / 96, r_ = it % 96, cg_ = r_ >> 2, kq = r_ & 3, n0 = cg_ * 256;
        const float* w = (l ? p.in[I1_ADAW] : p.in[I0_ADAW]) + (size_t)(kq * 256 + C.wave * 32) * 6144 + n0 + 4 * lane;
        f32x4 acc[9];
#pragma unroll
        for (int j = 0; j < 9; ++j) acc[j] = (f32x4){0.f, 0.f, 0.f, 0.f};
#pragma unroll 8
        for (int k = 0; k < 32; ++k) { const f32x4 wv = *(const f32x4*)(w + (size_t)k * 6144); const int kk = kq * 256 + C.wave * 32 + k;
#pragma unroll
            for (int j = 0; j < 9; ++j) acc[j] += wv * sil[j * D + kk]; }
#pragma unroll
        for (int j = 0; j < 9; ++j) *(MLAS f32x4*)(red + (C.wave * 9 + j) * 256 + 4 * lane) = acc[j];
        __syncthreads();
        for (int i = tid; i < 9 * 256; i += NTHR) { const int j = i >> 8, c = i & 255; float sm_ = 0.f;
#pragma unroll
            for (int wv = 0; wv < 8; ++wv) sm_ += red[(wv * 9 + j) * 256 + c];
            if (kq == 0) sm_ += (l ? p.in[I1_ADAB] : p.in[I0_ADAB])[n0 + c];
            atomicAdd(MOD + (size_t)(l * 9 + j) * 6144 + n0 + c, sm_); }
        __syncthreads();
    }
    __syncthreads();
    {
        MLAS float* PA = (MLAS float*)C.lds;
        MLAS float* PB = (MLAS float*)(C.lds + 64 * 65 * 4);
        bf16_t* WT = (bf16_t*)(p.ws + WS_W_OUT0);
#ifdef L0_SPLIT
        constexpr int POOL_PART = 2;
#else
        constexpr int POOL_PART = 0;
#endif
        if (PART == POOL_PART) for (int tile = vcu; tile < 128; tile += G) {
            const int g = tile >> 5, nb = tile & 31;
            for (int i = tid; i < 4096; i += NTHR) PA[(i >> 6) * 65 + (i & 63)] = p.in[I0_POOLW][g * 4096 + i];
            for (int i = tid; i < 2048; i += NTHR) { const int d = i >> 5, nn = i & 31; PB[d * 33 + nn] = p.in[I0_WOUT][(size_t)(g * 64 + d) * D + 32 * nb + nn] * p.in[I0_POOLS][g * 64 + d]; }
            __syncthreads();
            { const int c = tid >> 3, n4 = (tid & 7) * 4; float a0 = 0.f, a1 = 0.f, a2 = 0.f, a3 = 0.f;
#pragma unroll 8
                for (int d = 0; d < 64; ++d) { const float pa = PA[c * 65 + d]; const MLAS float* b = PB + d * 33 + n4; a0 += pa * b[0]; a1 += pa * b[1]; a2 += pa * b[2]; a3 += pa * b[3]; }
                bf16_t* o = WT + (size_t)(32 * nb + n4) * D + g * 64 + c;
                o[0] = f2bf(a0); o[D] = f2bf(a1); o[2 * D] = f2bf(a2); o[3 * D] = f2bf(a3); }
            __syncthreads();
        }
    }
    const int gw = vcu * NWAVES + C.wave, NGW = G * NWAVES;
    MLAS float* scr = (MLAS float*)(C.lds + C.wave * 16896);
    if (P0MASK & 2) {
        int rot = 0;
#define TR_MAT(M) { constexpr int ni = (wmat(M).K / 64) * (wmat(M).N / 32); int first = gw - rot; if (first < 0) first += NGW; \
            for (int it = first; it < ni; it += NGW) transpose_item<M>(p, it, scr, lane); rot = (rot + ni) % NGW; }
        if (PART == 0) { TR_MAT(W_IN0)
#ifndef L0_SPLIT
            TR_MAT(W_OUT0) TR_MAT(W_GU0) TR_MAT(W_D0)
#endif
        }
        else if (PART == 2) { TR_MAT(W_OUT0) TR_MAT(W_GU0)
#if !defined(D0_IN_P6) && !defined(CTXD_IN_P6)
            TR_MAT(W_D0)
#endif
        }
        else if (PART == 3) { TR_MAT(W_D0) }
        else if (PART == 1) { TR_MAT(W_IN1) TR_MAT(W_UQ) TR_MAT(W_UKV)
#ifndef CTXD_IN_P6
            TR_MAT(W_OUT1) TR_MAT(W_GU1) TR_MAT(W_D1)
#endif
        }
        else if (PART == 4) { TR_MAT(W_OUT1) TR_MAT(W_GU1) TR_MAT(W_D1) }
#undef TR_MAT
    }
    if (PART == 0 && (P0MASK & 4) && C.bid == C.G - 1) {
        float* T32 = (float*)(p.ws + WS_ROPE32); float* T16 = (float*)(p.ws + WS_ROPE16);
        for (int i = tid; i < 1024; i += NTHR) { const int pos = i >> 4, f = i & 15; const float ang = (float)pos * powf(10000.0f, -((float)f * 2.0f) / 32.0f); T32[i] = cosf(ang); T32[1024 + i] = sinf(ang); }
        for (int i = tid; i < 512; i += NTHR) { const int pos = i >> 3, f = i & 7; const float ang = (float)pos * powf(10000.0f, -((float)f * 2.0f) / 16.0f); T16[i] = cosf(ang); T16[512 + i] = sinf(ang); }
    }
    if (PART == 0 && (P0MASK & 8)) { float* SSQ = (float*)(p.ws + WS_SSQ); float* SSKV = (float*)(p.ws + WS_SSKV);
        for (int i = C.bid * NTHR + tid; i < MT; i += C.G * NTHR) { SSQ[i] = 0.f; SSKV[i] = 0.f; }
#ifdef FOLD_N13
        { float* SSN1 = (float*)(p.ws + WS_SSN1); for (int i = C.bid * NTHR + tid; i < ML; i += C.G * NTHR) SSN1[i] = 0.f; }
#endif
    }
}

template <class TL> __device__ __forceinline__ void phase_norm(Ctx& C, const TL* xl, const float* xc, const float* gain, int layer, int sh_chunk, int sc_chunk, int nrows, const float* slab = nullptr, int nslab = 0, float* xc_wb = nullptr) {
    const int lane = tid_now() & 63;
    const int gw = C.vcu * NWAVES + C.wave, NGW = C.G * NWAVES;
    bf16_t* XN = (bf16_t*)(C.p.ws + WS_XN); const float* MODb = (const float*)(C.p.ws + WS_MOD) + (size_t)layer * 9 * 6144;
    for (int m = gw; m < nrows; m += NGW) {
        const float* mod = MODb + (size_t)modidx_of(m) * 6144;
        f32x4 v[4]; float ss = 0.f;
#pragma unroll
        for (int j = 0; j < 4; ++j) { v[j] = m < ML ? epi::ld4(xl + (size_t)m * D + 4 * lane + 256 * j) : *(const f32x4*)(xc + (size_t)(m - ML) * D + 4 * lane + 256 * j);
            if (m >= ML && nslab > 0) { for (int s_ = 0; s_ < nslab; ++s_) v[j] += *(const f32x4*)(slab + (size_t)s_ * MC * D + (size_t)(m - ML) * D + 4 * lane + 256 * j);
                if (xc_wb) *(f32x4*)(xc_wb + (size_t)(m - ML) * D + 4 * lane + 256 * j) = v[j]; }
            ss += (v[j][0] * v[j][0] + v[j][1] * v[j][1]) + (v[j][2] * v[j][2] + v[j][3] * v[j][3]); }
        ss = wave_sum(ss);
        const float r = rsqrtf(ss * (1.f / D) + EPS);
#pragma unroll
        for (int j = 0; j < 4; ++j) { const int c = 4 * lane + 256 * j;
            const f32x4 g = *(const f32x4*)(gain + c), sc = *(const f32x4*)(mod + sc_chunk * D + c), sh = *(const f32x4*)(mod + sh_chunk * D + c);
            const f32x4 y = ((v[j] * r) * g) * (sc + 1.f) + sh;
            uint2 o; o.x = pk2(y[0], y[1]); o.y = pk2(y[2], y[3]);
            *(uint2*)(XN + (size_t)m * D + c) = o; }
    }
}

__device__ __forceinline__ void phase_bias(Ctx& C, int vcu, int Gn, const bf16_t* Wt, int npos, const float* shift  , int nb, float* bias) {
    const int tid = tid_now(), lane = tid & 63;
    MLAS float* sh = (MLAS float*)C.lds;
    __syncthreads();
    for (int i = tid; i < nb * D; i += NTHR) sh[i] = shift[(size_t)(i / D) * 6144 + (i % D)];
    __syncthreads();
    const int gw = vcu * NWAVES + C.wave, NGW = Gn * NWAVES;
    for (int pos = gw; pos < npos; pos += NGW) {
        const v4u w0 = *(const v4u*)(Wt + (size_t)pos * D + 16 * lane), w1 = *(const v4u*)(Wt + (size_t)pos * D + 16 * lane + 8);
        float wf[16];
#pragma unroll
        for (int e = 0; e < 4; ++e) { wf[2 * e] = __uint_as_float(w0[e] << 16); wf[2 * e + 1] = __uint_as_float(w0[e] & 0xffff0000u); wf[8 + 2 * e] = __uint_as_float(w1[e] << 16); wf[8 + 2 * e + 1] = __uint_as_float(w1[e] & 0xffff0000u); }
        float mine = 0.f;
        for (int b = 0; b < nb; ++b) { float s = 0.f;
#pragma unroll
            for (int q = 0; q < 4; ++q) { const f32x4 sv = *(const MLAS f32x4*)(sh + b * D + 16 * lane + 4 * q); s += (wf[4 * q] * sv[0] + wf[4 * q + 1] * sv[1]) + (wf[4 * q + 2] * sv[2] + wf[4 * q + 3] * sv[3]); }
            s = wave_sum(s); if (lane == b) mine = s; }
        if (lane < nb) bias[(size_t)lane * npos + pos] = mine;
    }
}

__device__ __forceinline__ void phase_pool(Ctx& C) {
    const bf16_t* A0 = (const bf16_t*)(C.p.ws + WS_A0); bf16_t* MIX = (bf16_t*)(C.p.ws + WS_MIX);
    const int skip = (C.G > 128) ? 96 : 0;
    if (C.vcu < skip) return;
    const int gt = (C.vcu - skip) * NTHR + tid_now(), NGT = (C.G - skip) * NTHR;
    for (int it = gt; it < MT * 32; it += NGT) {
        const int m = it >> 5, c8 = (it & 31) * 8, g = c8 >> 6, w = 2 << g;
        int t, T; if (m < ML) { t = m % S; T = S; } else { t = (m - ML) % CTX; T = CTX; }
        const int base = m - t; int lo = t - w / 2; if (lo < 0) lo = 0; int hi = t - w / 2 + w; if (hi > T) hi = T;
        float s[8];
#pragma unroll
        for (int e = 0; e < 8; ++e) s[e] = 0.f;
        for (int j = lo; j < hi; ++j) { const v4u q = *(const v4u*)(A0 + (size_t)(base + j) * 256 + c8);
#pragma unroll
            for (int e = 0; e < 4; ++e) { s[2 * e] += __uint_as_float(q[e] << 16); s[2 * e + 1] += __uint_as_float(q[e] & 0xffff0000u); } }
        const v4u q = *(const v4u*)(A0 + (size_t)m * 256 + c8); const float inv = 1.f / (float)(hi - lo);
        v4u o;
#pragma unroll
        for (int e = 0; e < 4; ++e) o[e] = pk2(s[2 * e] * inv - __uint_as_float(q[e] << 16), s[2 * e + 1] * inv - __uint_as_float(q[e] & 0xffff0000u));
        *(v4u*)(MIX + (size_t)m * D + c8) = o;
    }
}


__device__ __forceinline__ void phase_natable(Ctx& C, int vcu, int Gn) {
    bf16_t* G = (bf16_t*)(C.p.ws + WS_NAG); const float* rpb = C.p.in[I1_RPB];
    const int gt = vcu * NTHR + tid_now(), NGT = Gn * NTHR;
    for (int it = gt; it < 8 * 16 * 2 * 64 * 32; it += NGT) {
        const int j = it & 31, kc = (it >> 5) & 63, half = (it >> 11) & 1, dr = (it >> 12) & 15, h = it >> 16;
        const int qc = 32 * half + j, cs = min(max(qc - 8, 0), 48);
        float v = -30000.f;
        if (dr < 15 && (unsigned)(kc - cs) < 16u) v = rpb[(h * 15 + dr) * 31 + (kc - qc + 15)] * LOG2E;
        G[it] = f2bf(v);
    }
}

__device__ __forceinline__ void phase_attn0(Ctx& C) {
    const Params& p = C.p;
    MLAS char* shm = (MLAS char*)C.lds;
    att::UnitDesc U; U.Q = (const bf16_t*)(p.ws + WS_Q0); U.qpitch = 768; U.K = (const bf16_t*)(p.ws + WS_K0); U.kpitch = 256; U.V = (const bf16_t*)(p.ws + WS_V0); U.vpitch = 256;
    U.O = (bf16_t*)(p.ws + WS_MIX); U.opitch = D; U.rg = 0; U.rmin = 0; U.head = 0; U.G = nullptr;
    for (int u = C.vcu; u < 768 + 96; u += C.G) {
        if (u < 768) { const int qb = u & 7, bh = u >> 3, h = bh % 12, b = bh / 12;
            U.q0 = (long)b * S + 256 * qb; U.qcol = h * 64; U.kcol = (h / 3) * 64; U.vcol = (h / 3) * 64; U.ocol = 256 + h * 64; U.kv0 = b * SK; U.nt = SK / 64; }
        else { const int bh = u - 768, h = bh % 12, b = bh / 12;
            U.q0 = (long)ML + 256 * b; U.qcol = h * 64; U.kcol = (h / 3) * 64; U.vcol = (h / 3) * 64; U.ocol = 256 + h * 64; U.kv0 = b * SK; U.nt = CTX / 64; }
#ifdef USE_ATT64
        att64::attn_unit<8>(U.q0, (const att64::bf16*)U.Q, U.qpitch, U.qcol, (const att64::bf16*)U.K, U.kpitch, U.kcol, (const att64::bf16*)U.V, U.vpitch, U.vcol, (long)U.kv0, U.nt, (att64::bf16*)U.O, U.opitch, U.ocol, C.lds_g);
#else
        att::attn_unit<64, false, false>(U, shm, nullptr, nullptr, nullptr);
#endif
    }
    phase_pool(C);
}
__device__ __forceinline__ void phase_attn1(Ctx& C) {
    const Params& p = C.p;
    MLAS char* shm = (MLAS char*)C.lds;
    const float* T16 = (const float*)(p.ws + WS_ROPE16);
    att::UnitDesc U; U.O = (bf16_t*)(p.ws + WS_MIX); U.opitch = D; U.G = (const bf16_t*)(p.ws + WS_NAG);
    for (int u = C.vcu; u < 1024; u += C.G) {
        const int uu = u & 511, qb = uu & 7, h = (uu >> 3) & 7, b = uu >> 6;
        U.q0 = (long)b * S + 256 * qb; U.kv0 = b * SK; U.head = h;
        if (u < 512) {
            U.Q = (const bf16_t*)(p.ws + WS_MQ); U.qpitch = 768; U.qcol = h * 96; U.K = (const bf16_t*)(p.ws + WS_MK); U.kpitch = 768; U.kcol = h * 96;
            U.V = (const bf16_t*)(p.ws + WS_MV); U.vpitch = 512; U.vcol = h * 64; U.ocol = h * 64; U.nt = SK / 64; U.rg = 0; U.rmin = 0;
#ifdef USE_ATT96
            att96::attn_unit<8>(U.q0, (const att96::bf16*)U.Q, U.qpitch, U.qcol, (const att96::bf16*)U.K, U.kpitch, U.kcol, (const att96::bf16*)U.V, U.vpitch, U.vcol, (long)U.kv0, U.nt, (att96::bf16*)U.O, U.opitch, U.ocol, C.lds_g, p.in[I1_MQG], T16);
#ifdef DUP_MLA
            att96::attn_unit<8>(U.q0, (const att96::bf16*)U.Q, U.qpitch, U.qcol, (const att96::bf16*)U.K, U.kpitch, U.kcol, (const att96::bf16*)U.V, U.vpitch, U.vcol, (long)U.kv0, U.nt, (att96::bf16*)U.O, U.opitch, U.ocol, C.lds_g, p.in[I1_MQG], T16);
#endif
#else
            att::attn_unit<96, false, true>(U, shm, p.in[I1_MQG], T16, nullptr);
#ifdef DUP_MLA
            att::attn_unit<96, false, true>(U, shm, p.in[I1_MQG], T16, nullptr);
#endif
#endif
        } else {
            U.Q = (const bf16_t*)(p.ws + WS_NQ); U.qpitch = 512; U.qcol = h * 64; U.K = (const bf16_t*)(p.ws + WS_NK); U.kpitch = 512; U.kcol = h * 64;
            U.V = (const bf16_t*)(p.ws + WS_NV); U.vpitch = 512; U.vcol = h * 64; U.ocol = 512 + h * 64; U.rg = qb;
            const int rmin = min(max(4 * qb - 4, 0), 24), rmax = min(max(4 * qb + 3 - 4, 0), 24) + 7;
            U.rmin = rmin; U.nt = 4 + (rmax - rmin + 1);
#ifdef USE_ATTNA
            attna::attn_unit<8>(U.q0, (const attna::bf16*)U.Q, U.qpitch, U.qcol, (const attna::bf16*)U.K, U.kpitch, U.kcol, (const attna::bf16*)U.V, U.vpitch, U.vcol, (long)U.kv0, (U.nt + 1) & ~1, (attna::bf16*)U.O, U.opitch, U.ocol, C.lds_g, U.rmin, U.rg, p.in[I1_RPB] + h * 465);
#ifdef DUP_NA
            attna::attn_unit<8>(U.q0, (const attna::bf16*)U.Q, U.qpitch, U.qcol, (const attna::bf16*)U.K, U.kpitch, U.kcol, (const attna::bf16*)U.V, U.vpitch, U.vcol, (long)U.kv0, (U.nt + 1) & ~1, (attna::bf16*)U.O, U.opitch, U.ocol, C.lds_g, U.rmin, U.rg, p.in[I1_RPB] + h * 465);
#endif
#else
            att::attn_unit<64, true, false>(U, shm, nullptr, nullptr, p.in[I1_RPB]);
#ifdef DUP_NA
            att::attn_unit<64, true, false>(U, shm, nullptr, nullptr, p.in[I1_RPB]);
#endif
#endif
        }
    }
}

__global__ void __launch_bounds__(NTHR, 2) mega(Params p, int ph_lo, int ph_hi) {
    extern __shared__ __attribute__((aligned(16))) unsigned char lds_raw[];
    cg::grid_group grid = cg::this_grid();
    Ctx C; C.p = p; C.lds = (MLAS unsigned char*)lds_raw; C.lds_g = (char*)lds_raw; C.wave = __builtin_amdgcn_readfirstlane((int)threadIdx.x >> 6);
    C.G = gridDim.x; C.bid = blockIdx.x; C.vcu = (C.G % 8 == 0) ? (C.bid % 8) * (C.G / 8) + C.bid / 8 : C.bid;
    volatile LAS unsigned* bst = (volatile LAS unsigned*)(C.lds + LDS_BYTES - 64);
    if (threadIdx.x < 2) bst[threadIdx.x] = 0u;
    __syncthreads();
    unsigned* barw = (unsigned*)(p.ws + WS_BARRIER);
    XcdBarrier bar; bar.bar = barw; bar.x = 0; bar.st = nullptr;
    if (ph_hi - ph_lo > 1) bar = xcd_barrier_post(barw, bst);
    float* out = p.out; float* xrc = (float*)(p.ws + WS_XRC);
#ifdef BF16RES
    typedef bf16_t res_t;
    res_t* xa = (res_t*)p.out; res_t* xb3 = (res_t*)(p.ws + WS_X3);
#else
    typedef float res_t;
    res_t* xa = p.out; res_t* xb3 = p.out;
#endif
    const float* MOD = (const float*)(p.ws + WS_MOD);
    bf16_t* XN = (bf16_t*)(p.ws + WS_XN); bf16_t* MIX = (bf16_t*)(p.ws + WS_MIX); bf16_t* H = (bf16_t*)(p.ws + WS_H);
    const float* T32 = (const float*)(p.ws + WS_ROPE32); const float* T16 = (const float*)(p.ws + WS_ROPE16);
#define WSB(off) ((bf16_t*)(p.ws + (off)))
#ifndef PHMASK
#define PHMASK 0xFFFF
#endif
#ifndef REPMASK
#define REPMASK 0
#endif
#ifndef NSYNC
#define NSYNC 1
#endif
#define PH(k) if (((PHMASK >> (k)) & 1) && ph_lo <= (k) && (k) < ph_hi) for (int rep_ = 0; rep_ < (((REPMASK >> (k)) & 1) ? 2 : 1); ++rep_, (((REPMASK >> (k)) & 1) && rep_ == 1 ? xcd_barrier(bar) : (void)0))
#ifndef USE_CG_SYNC
#define USE_CG_SYNC 0
#endif
#define SEAM(k) if (ph_lo <= (k) && (k) + 1 < ph_hi) { for (int s_ = 0; s_ < NSYNC; ++s_) { if (USE_CG_SYNC || ph_hi > 1000) grid.sync(); else xcd_barrier(bar); } }
    PH(0) { phase_prologue<0>(C, C.vcu, C.G);
#if !defined(L1_LATE) && !defined(L1_IN_P7)
        phase_prologue<1>(C, C.vcu, C.G);
#endif
    } SEAM(0);
    PH(1) { phase_norm(C, p.in[I_X], p.in[I_CTX], p.in[I0_NMIX], 0, 0, 1, MT); } SEAM(1);
    PH(2) { pg8::Gemm g{XN, WSB(WS_W_IN0), MT, 1536, D, D}; pg8::StaticOrder So; So.init(MT, 1536, C.G, C.bid);
        epi::EpiIn0 E{WSB(WS_A0), WSB(WS_Q0), WSB(WS_K0), WSB(WS_V0), p.in[I0_QG], p.in[I0_KG], T32};
        pg8::gemm_phase<epi::EpiIn0, pg8::StaticOrder, ALIGN2, true>(C.lds, g, So, E);
#ifdef L0_SPLIT
        { const int n2 = (MT / 256) * 6 - C.G;
          if (n2 >= 0 && n2 < C.G) { if (C.bid >= n2) phase_prologue<2>(C, C.bid - n2, C.G - n2); } else phase_prologue<2>(C, C.vcu, C.G); }
#endif
#ifdef L1_LATE
        { const int n2 = (MT / 256) * 6 - C.G;
          if (n2 >= 0 && n2 < C.G && C.bid >= n2) phase_prologue<1>(C, C.bid - n2, C.G - n2);
          else if (n2 < 0 || n2 >= C.G) phase_prologue<1>(C, C.vcu, C.G); }
#endif
    } SEAM(2);
    PH(3) { phase_attn0(C); } SEAM(3);
    PH(4) { { pg8::Gemm g{MIX, WSB(WS_W_OUT0), ML, D, D, D}; pg8::StaticOrder So; So.init(ML, D, C.G, C.bid);
          epi::EpiResidT<float, res_t> E{p.in[I_X], p.in[I_CTX], xa, xrc, MOD + 2 * D};
          pg8::gemm_phase<epi::EpiResidT<float, res_t>, pg8::StaticOrder, ALIGN1, true>(C.lds, g, So, E); }
        { pg8::Gemm g{MIX, WSB(WS_W_OUT0), MT, D, D / 4, D}; pg8::CtxSplitOrder So; So.init(4, C.G, C.bid);
          epi::EpiResidSplit E{p.in[I_CTX], xrc, (float*)(p.ws + WS_SLAB4), MOD + 2 * D};
          pg8::gemm_phase<epi::EpiResidSplit, pg8::CtxSplitOrder, true, true>(C.lds, g, So, E); }
#ifdef CTXD_IN_P6
        if (C.G > 128) { if (C.bid >= 128) phase_prologue<3>(C, C.bid - 128, C.G - 128); } else phase_prologue<3>(C, C.vcu, C.G);
#endif
    } SEAM(4);
    PH(5) { phase_norm(C, xa, xrc, p.in[I0_NFFN], 0, 3, 4, MT, (const float*)(p.ws + WS_SLAB4), 3, xrc); } SEAM(5);
#ifdef CTXD_IN_P6
    const bool ctxd = (C.G == 256);
#else
    const bool ctxd = false;
#endif
    PH(6) { pg8::Gemm g{XN, WSB(WS_W_GU0), MT, 2 * FF, D, D}; epi::EpiSwiGLU E{H};
        if (!ctxd) { pg8::StaticOrder So; So.init(MT, 2 * FF, C.G, C.bid);
            pg8::gemm_phase<epi::EpiSwiGLU, pg8::StaticOrder, true, true>(C.lds, g, So, E);
#ifdef D0_IN_P6
            { const int total = (MT / 256) * (2 * FF / 256), full = total / C.G, n7 = total - full * C.G;
              if (n7 > 0 && n7 < C.G) { if (C.bid >= n7) phase_prologue<3>(C, C.bid - n7, C.G - n7); } else phase_prologue<3>(C, C.vcu, C.G); }
#endif
        }
#ifdef CTXD_IN_P6
        else {
            unsigned* flag = barw + XB_CTXH;
            { pg8::CtxFirstOrder So; So.init(0, C.bid); epi::EpiSwiGLUW EW{H}; pg8::gemm_phase<epi::EpiSwiGLUW, pg8::CtxFirstOrder, true, true>(C.lds, g, So, EW); }
            if (C.bid >= 80 && threadIdx.x == 0) xb_add(flag, 1u);
            { pg8::CtxFirstOrder So; So.init(1, C.bid); pg8::gemm_phase<epi::EpiSwiGLU, pg8::CtxFirstOrder, true, true>(C.lds, g, So, E); }
            if (C.bid >= 48 && C.bid < 176) {
                if (threadIdx.x == 0) { XB_SPIN(xb_ld(flag) < 176u, barw); __builtin_amdgcn_fence(__ATOMIC_ACQUIRE, "agent"); asm volatile("s_waitcnt vmcnt(0)" ::: "memory"); }
                __syncthreads();
                if (C.bid < 112) { pg8::Gemm g2{H, WSB(WS_W_D0), MT, D, 768, FF}; pg8::CtxSplitOrder S2; S2.init(2, C.G, C.bid - 48);
                    epi::EpiResidSplit E2{xrc, xrc, (float*)(p.ws + WS_SLAB7), MOD + 5 * D, 0};
                    pg8::gemm_phase<epi::EpiResidSplit, pg8::CtxSplitOrder, true, true>(C.lds, g2, S2, E2); }
                else { pg8::Gemm g2{H + 1536, WSB(WS_W_D0) + 1536, MT, D, 640, FF}; pg8::CtxSplitOrder S2; S2.init(2, C.G, C.bid - 112);
                    epi::EpiResidSplit E2{xrc, xrc, (float*)(p.ws + WS_SLAB7), MOD + 5 * D, 2};
                    pg8::gemm_phase<epi::EpiResidSplit, pg8::CtxSplitOrder, true, true>(C.lds, g2, S2, E2); }
            } else if (C.bid >= 176) { phase_prologue<1>(C, C.bid - 176, C.G - 176); phase_natable(C, C.bid - 176, C.G - 176); }
        }
#endif
    } SEAM(6);
    PH(7) { { pg8::Gemm g{H, WSB(WS_W_D0), ML, D, FF, FF}; pg8::StaticOrder So; So.init(ML, D, C.G, C.bid);
          epi::EpiResidT<res_t, res_t> E{xa, xrc, xa, xrc, MOD + 5 * D};
          pg8::gemm_phase<epi::EpiResidT<res_t, res_t>, pg8::StaticOrder, ALIGN1, true>(C.lds, g, So, E); }
        if (!ctxd) {
        { pg8::Gemm g{H, WSB(WS_W_D0), MT, D, FF / 2, FF}; pg8::CtxSplitOrder So; So.init(2, C.G, C.bid);
          epi::EpiResidSplit E{xrc, xrc, (float*)(p.ws + WS_SLAB7), MOD + 5 * D};
          pg8::gemm_phase<epi::EpiResidSplit, pg8::CtxSplitOrder, true, true>(C.lds, g, So, E); }
#ifdef L1_IN_P7
        if (C.G > 64) { if (C.bid >= 64) { phase_prologue<1>(C, C.bid - 64, C.G - 64);
#ifdef CTXD_IN_P6
            phase_prologue<4>(C, C.bid - 64, C.G - 64);
#endif
            phase_natable(C, C.bid - 64, C.G - 64); } }
        else { phase_prologue<1>(C, C.vcu, C.G);
#ifdef CTXD_IN_P6
            phase_prologue<4>(C, C.vcu, C.G);
#endif
            phase_natable(C, C.vcu, C.G); }
#endif
        }
    } SEAM(7);
    PH(8) {
#ifndef L1_IN_P7
        phase_natable(C, C.vcu, C.G);
#endif
        phase_norm(C, xa, xrc, p.in[I1_NMIX], 1, 0, 1, MT, (const float*)(p.ws + WS_SLAB7), ctxd ? 3 : 1, nullptr); } SEAM(8);
    PH(9) { pg8::Gemm g{XN, WSB(WS_W_IN1), MT, L1_INP, D, D}; pg8::StaticOrder So; So.init(MT, L1_INP, C.G, C.bid);
        epi::EpiIn1 E{WSB(WS_CQ), WSB(WS_CKV), WSB(WS_NQ), WSB(WS_NK), WSB(WS_NV), (float*)(p.ws + WS_KR), (float*)(p.ws + WS_SSQ), (float*)(p.ws + WS_SSKV), p.in[I1_NQG], p.in[I1_NKG]};
        pg8::gemm_phase<epi::EpiIn1, pg8::StaticOrder, ALIGN2, true>(C.lds, g, So, E);
#ifdef FOLD_N13
        { const int n3 = (MT / 256) * (L1_INP / 256) - 2 * C.G;
          if (n3 >= 0 && n3 < C.G) { if (C.bid >= n3) phase_bias(C, C.bid - n3, C.G - n3, WSB(WS_W_GU1), 2 * FF, MOD + 9 * 6144 + 3 * D, 8, (float*)(p.ws + WS_BIAS1)); }
          else phase_bias(C, C.vcu, C.G, WSB(WS_W_GU1), 2 * FF, MOD + 9 * 6144 + 3 * D, 8, (float*)(p.ws + WS_BIAS1)); }
#endif
#ifdef CTXD_IN_P6
        if (ctxd) { const int n3 = (MT / 256) * (L1_INP / 256) - 2 * C.G;
            if (n3 >= 0 && n3 < C.G) { if (C.bid >= n3) phase_prologue<4>(C, C.bid - n3, C.G - n3); } else phase_prologue<4>(C, C.vcu, C.G); }
#endif
    } SEAM(9);
    PH(10) {
#ifndef NO_QUP
        { pg8::Gemm g{WSB(WS_CQ), WSB(WS_W_UQ), ML, 768, 384, 384}; pg8::StaticOrder So; So.init(ML, 768, C.G, C.bid);
          epi::EpiQUp E{WSB(WS_MQ), (const float*)(p.ws + WS_SSQ)};
          pg8::gemm_phase<epi::EpiQUp, pg8::StaticOrder, ALIGN2, true>(C.lds, g, So, E); }
#endif
#ifndef NO_KVUP
        { pg8::Gemm g{WSB(WS_CKV), WSB(WS_W_UKV), MT, 1024, 256, 256}; pg8::StaticOrder So; So.init(MT, 1024, C.G, (C.bid + KVROT) % C.G);
          epi::EpiKvUp E{WSB(WS_MK), WSB(WS_MV), (const float*)(p.ws + WS_SSKV), (const float*)(p.ws + WS_KR), p.in[I1_MKG], T16};
          pg8::gemm_phase<epi::EpiKvUp, pg8::StaticOrder, ALIGN2, true>(C.lds, g, So, E); }
#endif
    } SEAM(10);
    PH(11) { phase_attn1(C); } SEAM(11);
#ifdef FOLD_N13
    PH(12) { pg8::Gemm g{MIX, WSB(WS_W_OUT1), ML, D, D, D}; pg8::StaticOrder So; So.init(ML, D, C.G, C.bid);
        epi::EpiResidNT<res_t, res_t> E{xa, xb3, MOD + 9 * 6144 + 2 * D, WSB(WS_XN2), (float*)(p.ws + WS_SSN1), p.in[I1_NFFN], MOD + 9 * 6144 + 4 * D};
        pg8::gemm_phase<epi::EpiResidNT<res_t, res_t>, pg8::StaticOrder, ALIGN1, true>(C.lds, g, So, E); } SEAM(12);
    PH(14) { pg8::Gemm g{WSB(WS_XN2), WSB(WS_W_GU1), ML, 2 * FF, D, D}; pg8::StaticOrder So; So.init(ML, 2 * FF, C.G, C.bid);
        epi::EpiSwiGLUN E{H, (const float*)(p.ws + WS_SSN1), (const float*)(p.ws + WS_BIAS1)};
        pg8::gemm_phase<epi::EpiSwiGLUN, pg8::StaticOrder, true, true>(C.lds, g, So, E); } SEAM(14);
#else
    PH(12) { pg8::Gemm g{MIX, WSB(WS_W_OUT1), ML, D, D, D}; pg8::StaticOrder So; So.init(ML, D, C.G, C.bid);
        epi::EpiResidT<res_t, res_t> E{xa, xrc, xb3, xrc, MOD + 9 * 6144 + 2 * D};
        pg8::gemm_phase<epi::EpiResidT<res_t, res_t>, pg8::StaticOrder, ALIGN1, true>(C.lds, g, So, E); } SEAM(12);
    PH(13) { phase_norm(C, xb3, xrc, p.in[I1_NFFN], 1, 3, 4, ML); } SEAM(13);
    PH(14) { pg8::Gemm g{XN, WSB(WS_W_GU1), ML, 2 * FF, D, D}; pg8::StaticOrder So; So.init(ML, 2 * FF, C.G, C.bid);
        epi::EpiSwiGLU E{H};
        pg8::gemm_phase<epi::EpiSwiGLU, pg8::StaticOrder, true, true>(C.lds, g, So, E); } SEAM(14);
#endif
    PH(15) { pg8::Gemm g{H, WSB(WS_W_D1), ML, D, FF, FF}; pg8::StaticOrder So; So.init(ML, D, C.G, C.bid);
        epi::EpiResidT<res_t, float> E{xb3, xrc, out, xrc, MOD + 9 * 6144 + 5 * D};
        pg8::gemm_phase<epi::EpiResidT<res_t, float>, pg8::StaticOrder, ALIGN1, true>(C.lds, g, So, E); }
    if (ph_hi - ph_lo > 1 && C.bid == 0 && threadIdx.x == 0) { if (xb_ld(&barw[XB_TMO]) != 0u) out[0] = __builtin_nanf(""); }
#undef PH
#undef SEAM
#undef WSB
}
}
#ifndef MK_DEBUG
#define MK_DEBUG 0
#endif
static int g_grid = 0;
static bool mega_setup() {
    if (g_grid) return g_grid > 0;
    int dev = 0, cus = 0, per_cu = 0;
    if (hipGetDevice(&dev) != hipSuccess || hipDeviceGetAttribute(&cus, hipDeviceAttributeMultiprocessorCount, dev) != hipSuccess) { g_grid = -1; return false; }
    if (hipFuncSetAttribute((const void*)mk::mega, hipFuncAttributeMaxDynamicSharedMemorySize, mk::LDS_BYTES) != hipSuccess) { fprintf(stderr, "kernel_launch: hipFuncSetAttribute failed\n"); g_grid = -1; return false; }
    if (hipOccupancyMaxActiveBlocksPerMultiprocessor(&per_cu, (const void*)mk::mega, mk::NTHR, mk::LDS_BYTES) != hipSuccess || per_cu < 1) { fprintf(stderr, "kernel_launch: occupancy query says %d\n", per_cu); g_grid = -1; return false; }
    g_grid = cus;
    fprintf(stderr, "kernel_launch: %d CUs, occupancy %d blocks/CU, grid %d\n", cus, per_cu, g_grid);
    return true;
}
static void launch_phases(const Params& p, int lo, int hi, hipStream_t st) {
    Params pp = p; int l = lo, h = hi;
    void* args[] = {&pp, &l, &h};
    hipError_t e;
    if (hi - lo > 1) e = hipLaunchCooperativeKernel((const void*)mk::mega, dim3(g_grid), dim3(mk::NTHR), args, mk::LDS_BYTES, st);
    else e = hipLaunchKernel((const void*)mk::mega, dim3(g_grid), dim3(mk::NTHR), args, mk::LDS_BYTES, st);
    if (e != hipSuccess) fprintf(stderr, "kernel_launch: launch [%d,%d) failed: %s\n", lo, hi, hipGetErrorString(e));
}
#if MK_DEBUG
static void launch_debug(const Params& p, hipStream_t st) {
    using namespace nv;
    unsigned* err = (unsigned*)(p.ws + WS_CTL) + 64;
    float* out = p.out; float* xrc = (float*)(p.ws + WS_XRC);
    const float* x = p.in[I_X]; const float* cx = p.in[I_CTX];
    const size_t att_sm = 4 * (SK + 128) * sizeof(float);
    const int SR = 4096;
    float* snapL = (float*)(p.ws + WS_SNAP); float* snapC = snapL + (size_t)SR * D;
    float* snapB = (float*)(p.ws + WS_BIG);
    hipMemsetAsync(p.ws + WS_CTL, 0, WS_SSQ, st);
    launch_phases(p, 0, 1, st);  k_adaln<true><<<dim3(6144 / 256, 9, 2), 256, 0, st>>>(p, err + 0);
    launch_phases(p, 1, 2, st);  k_norm<true><<<MT / 4, 256, 0, st>>>(p, x, cx, I0_NMIX, 0, 0, 1, MT, err + 1);
    launch_phases(p, 2, 3, st);  k_in0<true><<<MT / R, 256, (R * D + R * L0_IN) * 4, st>>>(p, err + 2);
    launch_phases(p, 3, 4, st);  k_attn<true, 0><<<dim3(ML / 4, 12), 256, att_sm, st>>>(p, err + 3);
                                 k_attn<true, 1><<<dim3(MC / 4, 12), 256, att_sm, st>>>(p, err + 16);
                                 k_pool0<true><<<MT, 256, 0, st>>>(p, err + 17);
    launch_phases(p, 4, 5, st);  k_out<true, 0><<<MT / R, 256, (R * D + R * 256) * 4, st>>>(p, x, cx, out, xrc, 0, err + 4);
    launch_phases(p, 5, 6, st);  k_norm<true><<<MT / 4, 256, 0, st>>>(p, out, xrc, I0_NFFN, 0, 3, 4, MT, err + 5);
    launch_phases(p, 6, 7, st);  k_ffn_gu<true, 0><<<MT / R, 256, R * D * 4, st>>>(p, err + 6);
    hipMemcpyAsync(snapL, out, (size_t)SR * D * 4, hipMemcpyDeviceToDevice, st); hipMemcpyAsync(snapC, xrc, (size_t)MC * D * 4, hipMemcpyDeviceToDevice, st);
    launch_phases(p, 7, 8, st);  k_ffn_d<true, 0><<<SR / R, 256, R * FF * 4, st>>>(p, snapL, snapC, out, xrc, 0, err + 7);
                                 k_ffn_d<true, 0><<<MC / R, 256, R * FF * 4, st>>>(p, snapL, snapC, out, xrc, ML, err + 7);
    launch_phases(p, 8, 9, st);  k_norm<true><<<MT / 4, 256, 0, st>>>(p, out, xrc, I1_NMIX, 1, 0, 1, MT, err + 8);
    launch_phases(p, 9, 10, st); k_in1<true><<<MT / R, 256, (R * D + R * L1_IN) * 4, st>>>(p, err + 9);
    launch_phases(p, 10, 11, st); k_mlaq<true><<<ML / R, 256, R * 384 * 4, st>>>(p, err + 10);
                                 k_mlakv<true><<<MT / R, 256, (R * 256 + R * 1024) * 4, st>>>(p, err + 19);
    launch_phases(p, 11, 12, st); k_attn<true, 2><<<dim3(ML / 4, 8), 256, att_sm, st>>>(p, err + 11);
                                 k_attn<true, 3><<<dim3(ML / 4, 8), 256, att_sm, st>>>(p, err + 18);
    hipMemcpyAsync(snapB, out, (size_t)SR * D * 4, hipMemcpyDeviceToDevice, st);
    launch_phases(p, 12, 13, st); k_out<true, 1><<<SR / R, 256, (R * D + R * 256) * 4, st>>>(p, snapB, snapC, out, xrc, 0, err + 12);
    launch_phases(p, 13, 14, st); k_norm<true><<<ML / 4, 256, 0, st>>>(p, out, xrc, I1_NFFN, 1, 3, 4, ML, err + 13);
    launch_phases(p, 14, 15, st); k_ffn_gu<true, 1><<<ML / R, 256, R * D * 4, st>>>(p, err + 14);
    hipMemcpyAsync(snapL, out, (size_t)SR * D * 4, hipMemcpyDeviceToDevice, st);
    launch_phases(p, 15, 16, st); k_ffn_d<true, 1><<<SR / R, 256, R * FF * 4, st>>>(p, snapL, snapC, out, xrc, 0, err + 15);
    k_report<<<1, 1, 0, st>>>(p, 20, 0.15f);
}
#endif
extern "C" void kernel_launch(void* const* d_in, const int* in_sizes, int n_in, void* d_out, int out_size, void* d_ws, size_t ws_size, hipStream_t stream) {
    if (n_in != N_IN || out_size != ML * D || ws_size < WS_END) { fprintf(stderr, "kernel_launch: unexpected shapes n_in=%d out=%d ws=%zu\n", n_in, out_size, ws_size); return; }
    if (!mega_setup()) return;
    Params p{};
    for (int i = 0; i < N_IN; ++i) p.in[i] = (const float*)d_in[i];
    p.out = (float*)d_out; p.ws = (unsigned char*)d_ws;
#if MK_DEBUG
    launch_debug(p, stream);
#else
    if (hipMemsetAsync((char*)d_ws + WS_BARRIER, 0, WS_SSQ - WS_BARRIER, stream) != hipSuccess) { fprintf(stderr, "kernel_launch: memset failed\n"); return; }
#ifdef EXTRA_MEMSET
    (void)hipMemsetAsync((char*)d_ws + WS_CTL, 0, 4096, stream);
#endif
    launch_phases(p, 0, mk::NPHASE, stream);
#endif
}
```

```cpp
#define USE_ATT64 1
#define USE_ATT96 1
#define ATT_STATIC_PRIO 1
#define L1_IN_P7 1
#define L0_SPLIT 1
#define D0_IN_P6 1
#define FOLD_N13 1
#define BF16RES 1
#define MERGE01 1
#include <hip/hip_runtime.h>
#include <hip/hip_cooperative_groups.h>
#include <cstdio>
#include <cstdint>
namespace cg = cooperative_groups;

typedef unsigned short bf16_t;
constexpr int D = 1024, NB = 8, S = 2048, CTX = 256, SK = S + CTX, ML = NB * S, MC = NB * CTX, MT = ML + MC, FF = 2816;
constexpr int GW = 64;
constexpr int L0_IN = 1536, L1_IN = 2208, L1_INP = 2304;
constexpr float EPS = 1e-6f;
constexpr float LOG2E = 1.4426950408889634f;
constexpr float C2_64 = 0.125f * LOG2E;
constexpr float C2_96 = 0.10206207261596577f * LOG2E;

enum { I_X = 0, I_C, I_CTX, I_CCTX,
       I0_ADAW, I0_ADAB, I0_NMIX, I0_NFFN, I0_WIN, I0_POOLW, I0_POOLS, I0_QG, I0_KG, I0_WOUT, I0_WG, I0_WU, I0_WD,
       I1_ADAW, I1_ADAB, I1_NMIX, I1_NFFN, I1_WIN, I1_QAG, I1_KVAG, I1_WUQ, I1_WUKV, I1_MQG, I1_MKG, I1_NQG, I1_NKG, I1_RPB, I1_WOUT, I1_WG, I1_WU, I1_WD, N_IN };

constexpr size_t MiB = 1u << 20;
constexpr size_t WS_CTL = 0;
constexpr size_t WS_BARRIER = 16 * 1024;
constexpr size_t WS_MOD = 64 * 1024;
constexpr size_t WS_SSQ = 512 * 1024;
constexpr size_t WS_SSKV = 600 * 1024;
constexpr size_t WS_ROPE32 = 700 * 1024;
constexpr size_t WS_ROPE16 = 712 * 1024;
constexpr size_t WS_W_IN0 = 1 * MiB;
constexpr size_t WS_W_OUT0 = 4 * MiB;
constexpr size_t WS_W_GU0 = 6 * MiB;
constexpr size_t WS_W_D0 = 17 * MiB;
constexpr size_t WS_W_IN1 = 23 * MiB;
constexpr size_t WS_W_UQ = 28 * MiB;
constexpr size_t WS_W_UKV = 29 * MiB;
constexpr size_t WS_W_OUT1 = 30 * MiB;
constexpr size_t WS_W_GU1 = 32 * MiB;
constexpr size_t WS_W_D1 = 43 * MiB;
constexpr size_t WS_XRC = 49 * MiB;
constexpr size_t WS_XN = 57 * MiB;
constexpr size_t WS_MIX = WS_XN;
constexpr size_t WS_BIG = 96 * MiB;
constexpr size_t WS_H = WS_BIG;
constexpr size_t WS_A0 = WS_BIG;
constexpr size_t WS_Q0 = WS_BIG + 9 * MiB;
constexpr size_t WS_K0 = WS_BIG + 36 * MiB;
constexpr size_t WS_V0 = WS_BIG + 45 * MiB;
constexpr size_t WS_CQ = WS_BIG;
constexpr size_t WS_CKV = WS_BIG + 14 * MiB;
constexpr size_t WS_NQ = WS_BIG + 23 * MiB;
constexpr size_t WS_NK = WS_BIG + 41 * MiB;
constexpr size_t WS_NV = WS_BIG + 59 * MiB;
constexpr size_t WS_MQ = WS_BIG + 77 * MiB;
constexpr size_t WS_MK = WS_BIG + 101 * MiB;
constexpr size_t WS_MV = WS_BIG + 128 * MiB;
constexpr size_t WS_KR = WS_BIG + 146 * MiB;
constexpr size_t WS_SLAB4 = WS_BIG;
constexpr size_t WS_SLAB7 = WS_BIG + 100 * MiB;
constexpr size_t WS_NAG = WS_BIG + 150 * MiB;
constexpr size_t WS_SSN1 = 768 * 1024;
constexpr size_t WS_BIAS1 = 832 * 1024;
constexpr size_t WS_XN2 = WS_BIG + 88 * MiB;
constexpr size_t WS_X3 = WS_BIG + 120 * MiB;
constexpr size_t WS_SNAP = WS_BIG + 100 * MiB;
constexpr size_t WS_END = 256 * MiB;
static_assert(WS_KR + (size_t)MT * 32 * 4 <= WS_END, "ws map");
static_assert(WS_X3 + (size_t)ML * D * 2 <= WS_END, "ws map");
static_assert(WS_W_D1 + (size_t)D * FF * 2 <= WS_XRC, "ws map");
static_assert(WS_XN + (size_t)MT * D * 2 <= WS_BIG, "ws map");

__device__ __forceinline__ float bf2f(bf16_t u) { return __uint_as_float((unsigned)u << 16); }
__device__ __forceinline__ bf16_t f2bf(float f) { unsigned u = __float_as_uint(f); return (bf16_t)((u + 0x7fffu + ((u >> 16) & 1u)) >> 16); }
__device__ __forceinline__ int kvrow_of(int m) { return m < ML ? (m / S) * SK + CTX + (m % S) : ((m - ML) / CTX) * SK + ((m - ML) % CTX); }
__device__ __forceinline__ int modidx_of(int m) { return m < ML ? m / S : 8; }
__device__ __forceinline__ float wave_sum(float v) {
#pragma unroll
    for (int o = 1; o < 64; o <<= 1) v += __shfl_xor(v, o);
    return v;
}
__device__ __forceinline__ float wave_max(float v) {
#pragma unroll
    for (int o = 1; o < 64; o <<= 1) v = fmaxf(v, __shfl_xor(v, o));
    return v;
}

struct Params {
    const float* in[N_IN];
    float* out;
    unsigned char* ws;
};
namespace pg8 {
#define PG8_LAS __attribute__((address_space(3)))
typedef unsigned short bf16_t;
typedef short bf16x8 __attribute__((ext_vector_type(8)));
typedef float f32x4 __attribute__((ext_vector_type(4)));
typedef unsigned u32x4 __attribute__((ext_vector_type(4)));
constexpr int BM = 256, BK = 64, HALF = 128, HTB = HALF * BK * 2  , STAGE_BYTES = 8 * HTB, NXCD = 8, WGM = 8;

__host__ __device__ __forceinline__ int lds_byte(int r, int c) { const int st = (r >> 4) * 2 + (c >> 5), rr = r & 15, cc = c & 31, ob = rr * 64 + cc * 2; return st * 1024 + (ob ^ (((ob >> 9) & 1) << 5)); }
__host__ __device__ __forceinline__ void stage_rc(int b, int& R, int& C) { const int st = b / 1024, sb = b % 1024, swz = sb ^ (((sb >> 9) & 1) << 5); R = (st >> 1) * 16 + swz / 64; C = (st & 1) * 32 + (swz % 64) / 2; }
__host__ __device__ __forceinline__ int perm32(int rho) { const int n = rho >> 4, i = rho & 15; return 8 * (i >> 2) + 4 * n + (i & 3); }

struct Unit { int pm, pn, ks; };
struct Gemm { const bf16_t* A; const bf16_t* Bt; int M, N, K, ld; };

struct StaticOrder {
    int nM, nN, nwg, G, c;
    __host__ __device__ void init(int M, int N, int G_, int c_) { nM = M / BM; nN = N / BM; nwg = nM * nN; G = G_; c = c_; }
    __host__ __device__ bool next(int i, Unit& u) const {
        const long L = (long)i * G + c; if (L >= nwg) return false;
        int wgid = (int)L; { const int q = nwg / NXCD, r = nwg % NXCD, xcd = wgid % NXCD, off = wgid / NXCD; wgid = (xcd < r ? xcd * (q + 1) : r * (q + 1) + (xcd - r) * q) + off; }
        const int nig = WGM * nN, gid = wgid / nig, fm = gid * WGM, gsz = (nM - fm) < WGM ? (nM - fm) : WGM;
        u.pm = fm + ((wgid % nig) % gsz); u.pn = (wgid % nig) / gsz; u.ks = 0; return true;
    }
    __device__ __forceinline__ void a_ready(const Unit&) const {}
    __device__ __forceinline__ void done(const Unit&) const {}
};

__device__ __forceinline__ unsigned cvt_pk_bf16(float lo, float hi) { unsigned r; asm volatile("v_cvt_pk_bf16_f32 %0, %1, %2" : "=v"(r) : "v"(lo), "v"(hi)); return r; }
typedef float f32x2 __attribute__((ext_vector_type(2)));
struct CtxSplitOrder {
    int G, c, split;
    __host__ __device__ void init(int split_, int G_, int c_) { split = split_; G = G_; c = c_; }
    __host__ __device__ bool next(int i, Unit& u) const {
        const int L = i * G + c; if (L >= 32 * split) return false;
        u.ks = L % split; const int t = L / split; u.pn = t & 3; u.pm = 64 + (t >> 2); return true;
    }
    __device__ __forceinline__ void a_ready(const Unit&) const {}
    __device__ __forceinline__ void done(const Unit&) const {}
};
struct CtxFirstOrder {
    int c, mode; StaticOrder lat;
    __host__ __device__ void init(int mode_, int c_) { mode = mode_; c = c_; lat.init(64 * BM, 22 * BM, 1 << 28, 0); }
    __host__ __device__ bool next(int i, Unit& u) const {
        if (mode == 0) { if (i != 0 || c < 80) return false; const int j = c - 80; u.pm = 64 + (j & 7); u.pn = j >> 3; u.ks = 0; return true; }
        const int Lp = c < 80 ? (i == 0 ? c : 80 + (i - 1) * 256 + c) : 80 + i * 256 + c;
        if (Lp >= 1408) return false;
        StaticOrder t = lat; t.c = Lp; return t.next(0, u);
    }
    __device__ __forceinline__ void a_ready(const Unit&) const {}
    __device__ __forceinline__ void done(const Unit&) const {}
};
template <class Epi, class Sched, bool ALIGN_EPI = false, bool SP2 = false>
__device__ __forceinline__ void gemm_phase(PG8_LAS unsigned char* lds, const Gemm g, const Sched& S, const Epi& E) {
    int tid_ = threadIdx.x; asm volatile("" : "+v"(tid_));
    const int tid = tid_, wid = __builtin_amdgcn_readfirstlane(tid >> 6), lane = tid & 63, wr = wid >> 2, wc = wid & 3, fr = lane & 15, fq = lane >> 4;
    int K_ = g.K; asm volatile("" : "+s"(K_));
    const int K = K_, nt = K / BK; int LD_ = g.ld; asm volatile("" : "+s"(LD_)); const int LD = LD_;
    unsigned voffA[2], voffB[2];
#pragma unroll
    for (int i = 0; i < 2; ++i) { int R, C; stage_rc(tid * 16 + i * 8192, R, C); const int Rb = Epi::PERM ? ((R & ~31) + perm32(R & 31)) : R;
        voffA[i] = (unsigned)(R * LD + C) * 2u; voffB[i] = (unsigned)(Rb * LD + C) * 2u; }
    const size_t kstep = (size_t)(BK * 2);
    const size_t hstep = (size_t)HALF * LD * 2;
    const size_t tstep = 2 * hstep;
    const unsigned ldsw = (unsigned)wid * 1024u;
    const int aoff = lds_byte(wr * 64 + fr, fq * 8), boff = lds_byte(wc * 32 + fr, fq * 8);
#define PG8_SA(b, h) (((b) * 2 + (h)) * HTB)
#define PG8_SB(b, h) ((4 + (b) * 2 + (h)) * HTB)
#define PG8_STAGE(bufoff, gbase, voff) do { _Pragma("unroll") for (int _i = 0; _i < 2; ++_i) \
        __builtin_amdgcn_global_load_lds((const unsigned*)((const char*)(gbase) + (voff)[_i]), (PG8_LAS unsigned*)(lds + (bufoff) + ldsw + _i * 8192), 16, 0, 0); } while (0)
#define PG8_LDA(dst, b, h) do { _Pragma("unroll") for (int m = 0; m < 4; ++m) _Pragma("unroll") for (int k = 0; k < 2; ++k) dst[m][k] = *(const PG8_LAS bf16x8*)(lds + PG8_SA(b, h) + aoff + m * 2048 + k * 1024); } while (0)
#define PG8_LDB(dst, b, h) do { _Pragma("unroll") for (int n = 0; n < 2; ++n) _Pragma("unroll") for (int k = 0; k < 2; ++k) dst[n][k] = *(const PG8_LAS bf16x8*)(lds + PG8_SB(b, h) + boff + n * 2048 + k * 1024); } while (0)
#define PG8_MMA(ai, bj, At, Bt) do { __builtin_amdgcn_s_setprio(1); _Pragma("unroll") for (int m = 0; m < 4; ++m) _Pragma("unroll") for (int n = 0; n < 2; ++n) _Pragma("unroll") for (int k = 0; k < 2; ++k) \
        acc[ai][bj][m][n] = __builtin_amdgcn_mfma_f32_16x16x32_bf16(Bt[n][k], At[m][k], acc[ai][bj][m][n], 0, 0, 0); __builtin_amdgcn_s_setprio(0); } while (0)
#define PG8_WAIT_V(n) asm volatile("s_waitcnt vmcnt(" #n ")" ::: "memory")
#define PG8_WAIT_L(n) asm volatile("s_waitcnt lgkmcnt(" #n ")" ::: "memory")
#define PG8_BAR __builtin_amdgcn_s_barrier()
#define PG8_SCHED __builtin_amdgcn_sched_barrier(0)
    Unit cur, nxt; int ui = 0;
    if (!S.next(0, cur)) return;
    f32x4 acc[2][2][4][2];
#pragma unroll
    for (int a = 0; a < 2; ++a)
#pragma unroll
        for (int b = 0; b < 2; ++b)
#pragma unroll
            for (int m = 0; m < 4; ++m)
#pragma unroll
                for (int n = 0; n < 2; ++n) acc[a][b][m][n] = (f32x4){0.f, 0.f, 0.f, 0.f};
    bf16x8 At[4][2], B0[2][2], B1[2][2];
    const char* cA = (const char*)g.A + (size_t)cur.pm * tstep + (size_t)cur.ks * K * 2; const char* cB = (const char*)g.Bt + (size_t)cur.pn * tstep + (size_t)cur.ks * K * 2;
    S.a_ready(cur);
    if constexpr (SP2) {
        PG8_STAGE(PG8_SB(0, 0), cB, voffB); PG8_STAGE(PG8_SB(0, 1), cB + hstep, voffB); PG8_STAGE(PG8_SA(0, 0), cA, voffA); PG8_STAGE(PG8_SA(0, 1), cA + hstep, voffA);
        if (wr == 1) PG8_BAR;
        PG8_WAIT_V(2); PG8_BAR;
        PG8_STAGE(PG8_SB(1, 0), cB + kstep, voffB); PG8_STAGE(PG8_SA(1, 0), cA + kstep, voffA); PG8_STAGE(PG8_SB(1, 1), cB + hstep + kstep, voffB);
        PG8_WAIT_V(6); PG8_BAR;
    } else {
        PG8_STAGE(PG8_SB(0, 0), cB, voffB); PG8_STAGE(PG8_SA(0, 0), cA, voffA); PG8_STAGE(PG8_SB(0, 1), cB + hstep, voffB); PG8_STAGE(PG8_SA(0, 1), cA + hstep, voffA);
        if (wr == 1) PG8_BAR;
        PG8_WAIT_V(4); PG8_BAR;
        PG8_STAGE(PG8_SB(1, 0), cB + kstep, voffB); PG8_STAGE(PG8_SA(1, 0), cA + kstep, voffA); PG8_STAGE(PG8_SB(1, 1), cB + hstep + kstep, voffB);
        PG8_WAIT_V(6); PG8_BAR;
    }
    for (;;) {
        const bool has_next = S.next(ui + 1, nxt);
        const char* nA = has_next ? (const char*)g.A + (size_t)nxt.pm * tstep + (size_t)nxt.ks * K * 2 : cA; const char* nB = has_next ? (const char*)g.Bt + (size_t)nxt.pn * tstep + (size_t)nxt.ks * K * 2 : cB;
        for (int t = 0; t < nt; t += 2) {
            const bool last = (t == nt - 2);
            const char* a1 = cA + (size_t)(t + 1) * kstep;
            const char* a2 = last ? nA : cA + (size_t)(t + 2) * kstep; const char* b2 = last ? nB : cB + (size_t)(t + 2) * kstep;
            const char* a3 = a2 + kstep; const char* b3 = b2 + kstep;
            if (last && has_next) S.a_ready(nxt);
            if constexpr (SP2) {
            PG8_LDB(B0, 0, 0); PG8_LDB(B1, 0, 1); PG8_SCHED; PG8_LDA(At, 0, 0); PG8_STAGE(PG8_SA(1, 1), a1 + hstep, voffA);
            PG8_WAIT_V(8); PG8_WAIT_L(0); PG8_BAR; PG8_MMA(0, 0, At, B0); PG8_MMA(0, 1, At, B1); PG8_BAR; PG8_SCHED;
            PG8_LDA(At, 0, 1); PG8_STAGE(PG8_SB(0, 0), b2, voffB); PG8_STAGE(PG8_SB(0, 1), b2 + hstep, voffB); PG8_STAGE(PG8_SA(0, 0), a2, voffA);
            PG8_WAIT_V(8); PG8_WAIT_L(0); PG8_BAR; PG8_MMA(1, 0, At, B0); PG8_MMA(1, 1, At, B1); PG8_BAR; PG8_SCHED;
            PG8_LDB(B0, 1, 0); PG8_LDB(B1, 1, 1); PG8_SCHED; PG8_LDA(At, 1, 0); PG8_STAGE(PG8_SA(0, 1), a2 + hstep, voffA);
            PG8_WAIT_V(8); PG8_WAIT_L(0); PG8_BAR; PG8_MMA(0, 0, At, B0); PG8_MMA(0, 1, At, B1); PG8_BAR; PG8_SCHED;
            PG8_LDA(At, 1, 1); PG8_STAGE(PG8_SB(1, 0), b3, voffB); PG8_STAGE(PG8_SB(1, 1), b3 + hstep, voffB); PG8_STAGE(PG8_SA(1, 0), a3, voffA);
            PG8_WAIT_V(8); PG8_WAIT_L(0); PG8_BAR; PG8_MMA(1, 0, At, B0); PG8_MMA(1, 1, At, B1); PG8_BAR; PG8_SCHED;
            } else {
            PG8_LDB(B0, 0, 0); PG8_SCHED; PG8_LDA(At, 0, 0); PG8_STAGE(PG8_SA(1, 1), a1 + hstep, voffA);
            PG8_WAIT_L(8); PG8_BAR; PG8_WAIT_L(0); PG8_MMA(0, 0, At, B0); PG8_BAR; PG8_SCHED;
            PG8_LDB(B1, 0, 1); PG8_STAGE(PG8_SB(0, 0), b2, voffB);
            PG8_BAR; PG8_WAIT_L(0); PG8_MMA(0, 1, At, B1); PG8_BAR;
            PG8_LDA(At, 0, 1); PG8_STAGE(PG8_SA(0, 0), a2, voffA);
            PG8_BAR; PG8_WAIT_L(0); PG8_MMA(1, 0, At, B0); PG8_BAR; PG8_SCHED;
            PG8_STAGE(PG8_SB(0, 1), b2 + hstep, voffB);
            PG8_WAIT_V(6); PG8_BAR; PG8_MMA(1, 1, At, B1); PG8_BAR;
            PG8_LDB(B0, 1, 0); PG8_SCHED; PG8_LDA(At, 1, 0); PG8_STAGE(PG8_SA(0, 1), a2 + hstep, voffA);
            PG8_WAIT_L(8); PG8_BAR; PG8_WAIT_L(0); PG8_MMA(0, 0, At, B0); PG8_BAR; PG8_SCHED;
            PG8_LDB(B1, 1, 1); PG8_STAGE(PG8_SB(1, 0), b3, voffB);
            PG8_BAR; PG8_WAIT_L(0); PG8_MMA(0, 1, At, B1); PG8_BAR;
            PG8_LDA(At, 1, 1); PG8_STAGE(PG8_SA(1, 0), a3, voffA);
            PG8_BAR; PG8_WAIT_L(0); PG8_MMA(1, 0, At, B0); PG8_BAR; PG8_SCHED;
            PG8_STAGE(PG8_SB(1, 1), b3 + hstep, voffB);
            PG8_WAIT_V(6); PG8_BAR; PG8_MMA(1, 1, At, B1); PG8_BAR;
            }
        }
        if constexpr (ALIGN_EPI) { if (wr == 0) PG8_BAR; }
        if constexpr (!Epi::AFTER_DRAIN) { E(acc, cur, wr, wc, fr, fq); S.done(cur); }
        if (!has_next) break;
#pragma unroll
        for (int a = 0; a < 2; ++a)
#pragma unroll
            for (int b = 0; b < 2; ++b)
#pragma unroll
                for (int m = 0; m < 4; ++m)
#pragma unroll
                    for (int n = 0; n < 2; ++n) acc[a][b][m][n] = (f32x4){0.f, 0.f, 0.f, 0.f};
        cur = nxt; cA = nA; cB = nB; ++ui;
        if constexpr (ALIGN_EPI) { if (wr == 1) PG8_BAR; }
    }
    PG8_WAIT_V(0);
    if constexpr (!ALIGN_EPI) { if (wr == 0) PG8_BAR; }
    PG8_BAR;
    if constexpr (Epi::AFTER_DRAIN) { E.fused(acc, cur, wr, wc, fr, fq, lds, wid, lane); S.done(cur); }
#undef PG8_SA
#undef PG8_SB
#undef PG8_STAGE
#undef PG8_LDA
#undef PG8_LDB
#undef PG8_MMA
#undef PG8_WAIT_V
#undef PG8_WAIT_L
#undef PG8_BAR
#undef PG8_SCHED
}
}
namespace epi {
using pg8::f32x4; using pg8::Unit;
typedef unsigned u32x2 __attribute__((ext_vector_type(2)));
typedef unsigned u32x4 __attribute__((ext_vector_type(4)));
typedef float f32x2 __attribute__((ext_vector_type(2)));
typedef __bf16 bf16x2_t __attribute__((ext_vector_type(2)));
__device__ __forceinline__ unsigned pk(float lo, float hi) { f32x2 v = {lo, hi}; bf16x2_t b = __builtin_convertvector(v, bf16x2_t); return __builtin_bit_cast(unsigned, b); }
__device__ __forceinline__ u32x2 pk4(f32x4 v) { u32x2 w; w.x = pk(v[0], v[1]); w.y = pk(v[2], v[3]); return w; }
__device__ __forceinline__ float sum4sq(f32x4 v) { return (v[0] * v[0] + v[1] * v[1]) + (v[2] * v[2] + v[3] * v[3]); }
__device__ __forceinline__ float quad_sum(float s) { s += __shfl_xor(s, 16); s += __shfl_xor(s, 32); return s; }

__device__ __forceinline__ void st32(bf16_t* base32, f32x4 v0, f32x4 v1, int fq) {
    u32x2 a = pk4(v0), b = pk4(v1);
    { auto r = __builtin_amdgcn_permlane16_swap(a.x, b.x, false, false); a.x = r[0]; b.x = r[1]; }
    { auto r = __builtin_amdgcn_permlane16_swap(a.y, b.y, false, false); a.y = r[0]; b.y = r[1]; }
    u32x4 w; w.x = a.x; w.y = a.y; w.z = b.x; w.w = b.y;
    *(u32x4*)(base32 + 16 * (fq & 1) + 8 * (fq >> 1)) = w;
}

__device__ __forceinline__ int kvbase_of(int pm) { return pm < 64 ? (pm >> 3) * SK + CTX + (pm & 7) * 256 : (pm - 64) * SK; }
__device__ __forceinline__ int modidx_pm(int pm) { return pm < 64 ? (pm >> 3) : 8; }

__device__ __forceinline__ void head_finish(f32x4 (&v)[2][2], const float* gain, bool rope, const float* T32, int grow, int gcol, float scale, int fq) {
    float ss = (sum4sq(v[0][0]) + sum4sq(v[0][1])) + (sum4sq(v[1][0]) + sum4sq(v[1][1]));
    ss = quad_sum(ss);
    const float rn = rsqrtf(ss * (1.f / 64.f) + EPS);
#pragma unroll
    for (int bj = 0; bj < 2; ++bj)
#pragma unroll
        for (int n = 0; n < 2; ++n) { const f32x4 g = *(const f32x4*)(gain + 32 * bj + 16 * n + 4 * fq); v[bj][n] = (v[bj][n] * rn) * g; }
    if (rope) {
#pragma unroll
        for (int bj = 0; bj < 2; ++bj) { const int pos = bj ? gcol : grow;
            const f32x4 cs = *(const f32x4*)(T32 + pos * 16 + 4 * fq), sn = *(const f32x4*)(T32 + 1024 + pos * 16 + 4 * fq);
            const f32x4 x1 = v[bj][0], x2 = v[bj][1];
            v[bj][0] = x1 * cs - x2 * sn; v[bj][1] = x1 * sn + x2 * cs; }
    }
#pragma unroll
    for (int bj = 0; bj < 2; ++bj)
#pragma unroll
        for (int n = 0; n < 2; ++n) v[bj][n] = v[bj][n] * scale;
}

struct EpiIn0 {
    static constexpr bool PERM = false, AFTER_DRAIN = false;
    bf16_t *A0, *Q0, *K0, *V0; const float *qg, *kg, *T32;
    __device__ __forceinline__ void operator()(const f32x4 (&acc)[2][2][4][2], const Unit& u, int wr, int wc, int fr_in, int fq_in) const {
        int fr = fr_in, fq = fq_in; asm volatile("" : "+v"(fr), "+v"(fq));
        const int pn = u.pn, pm = u.pm; const bool lat = pm < 64; const int kvb = kvbase_of(pm);
#pragma unroll
        for (int ai = 0; ai < 2; ++ai)
#pragma unroll
            for (int m = 0; m < 4; ++m) {
                const int rl = 128 * ai + 64 * wr + 16 * m + fr; const size_t r = (size_t)pm * 256 + rl;
                if (pn == 0 || pn == 5) {
                    bf16_t* dst = pn == 0 ? A0 + r * 256 : V0 + (size_t)(kvb + rl) * 256;
#pragma unroll
                    for (int bj = 0; bj < 2; ++bj)
                        st32(dst + 64 * wc + 32 * bj, acc[ai][bj][m][0], acc[ai][bj][m][1], fq);
                } else {
                    f32x4 v[2][2] = {{acc[ai][0][m][0], acc[ai][0][m][1]}, {acc[ai][1][m][0], acc[ai][1][m][1]}};
                    const int grow = (pm & 7) * 4 + 2 * ai + wr, gcol = 16 * m + fr;
                    bf16_t* dst;
                    if (pn < 4) { head_finish(v, qg, lat, T32, grow, gcol, C2_64, fq); dst = Q0 + r * 768 + ((pn - 1) * 4 + wc) * 64; }
                    else { head_finish(v, kg, lat, T32, grow, gcol, 1.0f, fq); dst = K0 + (size_t)(kvb + rl) * 256 + wc * 64; }
#pragma unroll
                    for (int bj = 0; bj < 2; ++bj)
                        st32(dst + 32 * bj, v[bj][0], v[bj][1], fq);
                }
            }
    }
};

__device__ __forceinline__ f32x4 ld4(const float* p) { return *(const f32x4*)p; }
__device__ __forceinline__ f32x4 ld4(const bf16_t* p) { const u32x2 w = *(const u32x2*)p; return (f32x4){__uint_as_float(w.x << 16), __uint_as_float(w.x & 0xffff0000u), __uint_as_float(w.y << 16), __uint_as_float(w.y & 0xffff0000u)}; }
__device__ __forceinline__ void st4(float* p, f32x4 v) { *(f32x4*)p = v; }
__device__ __forceinline__ void st4(bf16_t* p, f32x4 v) { *(u32x2*)p = pk4(v); }
template <class TB, class TO> struct EpiResidT {
    static constexpr bool PERM = false, AFTER_DRAIN = false;
    const TB* base_l; const float* base_c; TO* out_l; float* out_c; const float* mod;
    __device__ __forceinline__ void operator()(const f32x4 (&acc)[2][2][4][2], const Unit& u, int wr, int wc, int fr_in, int fq_in) const {
        int fr = fr_in, fq = fq_in; asm volatile("" : "+v"(fr), "+v"(fq));
        const int pm = u.pm; const bool lat = pm < 64;
        const float* gp = mod + (size_t)modidx_pm(pm) * 6144 + u.pn * 256 + 32 * wc + 4 * fq;
        f32x4 g[2][2];
#pragma unroll
        for (int bj = 0; bj < 2; ++bj)
#pragma unroll
            for (int n = 0; n < 2; ++n) g[bj][n] = *(const f32x4*)(gp + 128 * bj + 16 * n);
        if (lat) {
            const TB* bp = base_l + (size_t)pm * 256 * D; TO* op = out_l + (size_t)pm * 256 * D;
#pragma unroll
            for (int ai = 0; ai < 2; ++ai)
#pragma unroll
                for (int m = 0; m < 4; ++m) { const size_t off = (size_t)(128 * ai + 64 * wr + 16 * m + fr) * D + u.pn * 256 + 32 * wc + 4 * fq;
#pragma unroll
                    for (int bj = 0; bj < 2; ++bj)
#pragma unroll
                        for (int n = 0; n < 2; ++n) { const f32x4 b = ld4(bp + off + 128 * bj + 16 * n); st4(op + off + 128 * bj + 16 * n, b + g[bj][n] * acc[ai][bj][m][n]); } }
        } else {
            const float* bp = base_c + (size_t)(pm - 64) * 256 * D; float* op = out_c + (size_t)(pm - 64) * 256 * D;
#pragma unroll
            for (int ai = 0; ai < 2; ++ai)
#pragma unroll
                for (int m = 0; m < 4; ++m) { const size_t off = (size_t)(128 * ai + 64 * wr + 16 * m + fr) * D + u.pn * 256 + 32 * wc + 4 * fq;
#pragma unroll
                    for (int bj = 0; bj < 2; ++bj)
#pragma unroll
                        for (int n = 0; n < 2; ++n) { const f32x4 b = *(const f32x4*)(bp + off + 128 * bj + 16 * n); *(f32x4*)(op + off + 128 * bj + 16 * n) = b + g[bj][n] * acc[ai][bj][m][n]; } }
        }
    }
};
typedef EpiResidT<float, float> EpiResid;

template <class TB, class TO> struct EpiResidNT {
    static constexpr bool PERM = false, AFTER_DRAIN = false;
    const TB* base_l; TO* out_l; const float* mod;
    bf16_t* xn2; float* ssn; const float* gain; const float* modsc;
    __device__ __forceinline__ void operator()(const f32x4 (&acc)[2][2][4][2], const Unit& u, int wr, int wc, int fr_in, int fq_in) const {
        int fr = fr_in, fq = fq_in; asm volatile("" : "+v"(fr), "+v"(fq));
        const int pm = u.pm;
        const TB* bp = base_l + (size_t)pm * 256 * D;
        TO* op = out_l + (size_t)pm * 256 * D;
        bf16_t* xp = xn2 + (size_t)pm * 256 * D;
        const int c0 = u.pn * 256 + 32 * wc + 4 * fq;
        const float* gp = mod + (size_t)(pm >> 3) * 6144 + c0;
        const float* sp = modsc + (size_t)(pm >> 3) * 6144 + c0;
        f32x4 g[2][2], f[2][2];
#pragma unroll
        for (int bj = 0; bj < 2; ++bj)
#pragma unroll
            for (int n = 0; n < 2; ++n) { g[bj][n] = *(const f32x4*)(gp + 128 * bj + 16 * n);
                f[bj][n] = *(const f32x4*)(gain + c0 + 128 * bj + 16 * n) * (*(const f32x4*)(sp + 128 * bj + 16 * n) + 1.f); }
#pragma unroll
        for (int ai = 0; ai < 2; ++ai)
#pragma unroll
            for (int m = 0; m < 4; ++m) { const int row = 128 * ai + 64 * wr + 16 * m + fr; const size_t off = (size_t)row * D + c0;
                float ss = 0.f;
#pragma unroll
                for (int bj = 0; bj < 2; ++bj)
#pragma unroll
                    for (int n = 0; n < 2; ++n) { const f32x4 b = ld4(bp + off + 128 * bj + 16 * n); const f32x4 v = b + g[bj][n] * acc[ai][bj][m][n];
                        st4(op + off + 128 * bj + 16 * n, v);
                        ss += (v[0] * v[0] + v[1] * v[1]) + (v[2] * v[2] + v[3] * v[3]);
                        *(u32x2*)(xp + off + 128 * bj + 16 * n) = pk4(v * f[bj][n]); }
                ss += __shfl_xor(ss, 16); ss += __shfl_xor(ss, 32);
                if (fq == 0) atomicAdd(ssn + pm * 256 + row, ss); }
    }
};

struct EpiResidSplit {
    static constexpr bool PERM = false, AFTER_DRAIN = false;
    const float* base_c; float* out_c; float* slab; const float* mod; int ks_base = 0;
    __device__ __forceinline__ void operator()(const f32x4 (&acc)[2][2][4][2], const Unit& u_in, int wr, int wc, int fr_in, int fq_in) const {
        int fr = fr_in, fq = fq_in; asm volatile("" : "+v"(fr), "+v"(fq));
        Unit u = u_in; u.ks += ks_base;
        const int pm = u.pm - 64;
        const float* bp = base_c + (size_t)pm * 256 * D;
        float* op = u.ks == 0 ? out_c + (size_t)pm * 256 * D : slab + (size_t)(u.ks - 1) * MC * D + (size_t)pm * 256 * D;
        const float* gp = mod + (size_t)8 * 6144 + u.pn * 256 + 32 * wc + 4 * fq;
        f32x4 g[2][2];
#pragma unroll
        for (int bj = 0; bj < 2; ++bj)
#pragma unroll
            for (int n = 0; n < 2; ++n) g[bj][n] = *(const f32x4*)(gp + 128 * bj + 16 * n);
#pragma unroll
        for (int ai = 0; ai < 2; ++ai)
#pragma unroll
            for (int m = 0; m < 4; ++m) { const size_t off = (size_t)(128 * ai + 64 * wr + 16 * m + fr) * D + u.pn * 256 + 32 * wc + 4 * fq;
#pragma unroll
                for (int bj = 0; bj < 2; ++bj)
#pragma unroll
                    for (int n = 0; n < 2; ++n) { f32x4 v = g[bj][n] * acc[ai][bj][m][n]; if (u.ks == 0) v += *(const f32x4*)(bp + off + 128 * bj + 16 * n); *(f32x4*)(op + off + 128 * bj + 16 * n) = v; } }
    }
};

struct EpiSwiGLU {
    static constexpr bool PERM = true, AFTER_DRAIN = false;
    bf16_t* H;
    __device__ __forceinline__ void operator()(const f32x4 (&acc)[2][2][4][2], const Unit& u, int wr, int wc, int fr_in, int fq_in) const {
        int fr = fr_in, fq = fq_in; asm volatile("" : "+v"(fr), "+v"(fq));
#pragma unroll
        for (int ai = 0; ai < 2; ++ai)
#pragma unroll
            for (int m = 0; m < 4; ++m) { const size_t r = (size_t)u.pm * 256 + 128 * ai + 64 * wr + 16 * m + fr;
                f32x4 h[2];
#pragma unroll
                for (int n = 0; n < 2; ++n) { const f32x4 g = acc[ai][0][m][n], up = acc[ai][1][m][n];
#pragma unroll
                    for (int e = 0; e < 4; ++e) h[n][e] = g[e] * __builtin_amdgcn_rcpf(1.f + __builtin_amdgcn_exp2f(-g[e] * LOG2E)) * up[e]; }
                u32x4 w; w.x = pk(h[0][0], h[0][1]); w.y = pk(h[0][2], h[0][3]); w.z = pk(h[1][0], h[1][1]); w.w = pk(h[1][2], h[1][3]);
                *(u32x4*)(H + r * FF + u.pn * 128 + 32 * wc + 8 * fq) = w; }
    }
};

struct EpiSwiGLUN {
    static constexpr bool PERM = true, AFTER_DRAIN = false;
    bf16_t* H; const float* ssn; const float* bias;
    __device__ __forceinline__ void operator()(const f32x4 (&acc)[2][2][4][2], const Unit& u, int wr, int wc, int fr_in, int fq_in) const {
        int fr = fr_in, fq = fq_in; asm volatile("" : "+v"(fr), "+v"(fq));
        const float* bp = bias + (size_t)(u.pm >> 3) * (2 * FF) + u.pn * 256 + 32 * wc + 8 * fq;
        f32x4 bg[2], bu[2];
#pragma unroll
        for (int n = 0; n < 2; ++n) { bg[n] = *(const f32x4*)(bp + 4 * n); bu[n] = *(const f32x4*)(bp + 128 + 4 * n); }
        float rr[2][4];
#pragma unroll
        for (int ai = 0; ai < 2; ++ai)
#pragma unroll
            for (int m = 0; m < 4; ++m) rr[ai][m] = ssn[u.pm * 256 + 128 * ai + 64 * wr + 16 * m + fr];
#pragma unroll
        for (int ai = 0; ai < 2; ++ai)
#pragma unroll
            for (int m = 0; m < 4; ++m) { const size_t r = (size_t)u.pm * 256 + 128 * ai + 64 * wr + 16 * m + fr;
                const float rs = rsqrtf(rr[ai][m] * (1.f / D) + EPS);
                f32x4 h[2];
#pragma unroll
                for (int n = 0; n < 2; ++n) { const f32x4 g = acc[ai][0][m][n] * rs + bg[n], up = acc[ai][1][m][n] * rs + bu[n];
#pragma unroll
                    for (int e = 0; e < 4; ++e) h[n][e] = g[e] * __builtin_amdgcn_rcpf(1.f + __builtin_amdgcn_exp2f(-g[e] * LOG2E)) * up[e]; }
                u32x4 w; w.x = pk(h[0][0], h[0][1]); w.y = pk(h[0][2], h[0][3]); w.z = pk(h[1][0], h[1][1]); w.w = pk(h[1][2], h[1][3]);
                *(u32x4*)(H + r * FF + u.pn * 128 + 32 * wc + 8 * fq) = w; }
    }
};

typedef unsigned int v4u_t __attribute__((vector_size(16)));
struct EpiSwiGLUW {
    static constexpr bool PERM = true, AFTER_DRAIN = false;
    bf16_t* H;
    __device__ __forceinline__ void operator()(const f32x4 (&acc)[2][2][4][2], const Unit& u, int wr, int wc, int fr_in, int fq_in) const {
        int fr = fr_in, fq = fq_in; asm volatile("" : "+v"(fr), "+v"(fq));
        const __amdgpu_buffer_rsrc_t rs = __builtin_amdgcn_make_buffer_rsrc((void*)(H + (size_t)ML * FF), (short)0, (int)(MC * FF * 2), 0x00020000);
#pragma unroll
        for (int ai = 0; ai < 2; ++ai)
#pragma unroll
            for (int m = 0; m < 4; ++m) { const unsigned r = (unsigned)(u.pm - 64) * 256 + 128 * ai + 64 * wr + 16 * m + fr;
                f32x4 h[2];
#pragma unroll
                for (int n = 0; n < 2; ++n) { const f32x4 g = acc[ai][0][m][n], up = acc[ai][1][m][n];
#pragma unroll
                    for (int e = 0; e < 4; ++e) h[n][e] = g[e] * __builtin_amdgcn_rcpf(1.f + __builtin_amdgcn_exp2f(-g[e] * LOG2E)) * up[e]; }
                u32x4 w; w.x = pk(h[0][0], h[0][1]); w.y = pk(h[0][2], h[0][3]); w.z = pk(h[1][0], h[1][1]); w.w = pk(h[1][2], h[1][3]);
                __builtin_amdgcn_raw_buffer_store_b128(__builtin_bit_cast(v4u_t, w), rs, (r * FF + u.pn * 128 + 32 * wc + 8 * fq) * 2u, 0,   16); }
    }
};

struct EpiIn1 {
    static constexpr bool PERM = false, AFTER_DRAIN = false;
    bf16_t *CQ, *CKV, *NQ, *NK, *NV; float *KR, *SSQ, *SSKV; const float *nqg, *nkg;
    __device__ __forceinline__ void operator()(const f32x4 (&acc)[2][2][4][2], const Unit& u, int wr, int wc, int fr_in, int fq_in) const {
        int fr = fr_in, fq = fq_in; asm volatile("" : "+v"(fr), "+v"(fq));
        const int pn = u.pn, pm = u.pm; const int kvb = kvbase_of(pm);
#pragma unroll
        for (int ai = 0; ai < 2; ++ai)
#pragma unroll
            for (int m = 0; m < 4; ++m) {
                const int rl = 128 * ai + 64 * wr + 16 * m + fr; const size_t r = (size_t)pm * 256 + rl;
                if (pn == 0 || pn == 2) {
                    bf16_t* dst = pn == 0 ? CQ + r * 384 : CKV + r * 256; float ss = 0.f;
#pragma unroll
                    for (int bj = 0; bj < 2; ++bj)
                        { ss += sum4sq(acc[ai][bj][m][0]) + sum4sq(acc[ai][bj][m][1]); st32(dst + 128 * bj + 32 * wc, acc[ai][bj][m][0], acc[ai][bj][m][1], fq); }
                    ss = quad_sum(ss);
                    if (fq == 0) atomicAdd((pn == 0 ? SSQ : SSKV) + r, ss);
                } else if (pn == 1) {
                    float ss = 0.f;
                    { ss += sum4sq(acc[ai][0][m][0]) + sum4sq(acc[ai][0][m][1]); st32(CQ + r * 384 + 256 + 32 * wc, acc[ai][0][m][0], acc[ai][0][m][1], fq); }
                    ss = quad_sum(ss);
                    if (fq == 0) atomicAdd(SSQ + r, ss);
                    if (wc == 0) {
#pragma unroll
                        for (int n = 0; n < 2; ++n) *(f32x4*)(KR + r * 32 + 16 * n + 4 * fq) = acc[ai][1][m][n]; }
                } else if (pn >= 7) {
                    bf16_t* dst = NV + (size_t)(kvb + rl) * 512 + (pn - 7) * 256 + 64 * wc;
#pragma unroll
                    for (int bj = 0; bj < 2; ++bj)
                        st32(dst + 32 * bj, acc[ai][bj][m][0], acc[ai][bj][m][1], fq);
                } else {
                    f32x4 v[2][2] = {{acc[ai][0][m][0], acc[ai][0][m][1]}, {acc[ai][1][m][0], acc[ai][1][m][1]}};
                    bf16_t* dst;
                    if (pn < 5) { head_finish(v, nqg, false, nullptr, 0, 0, C2_64, fq); dst = NQ + r * 512 + ((pn - 3) * 4 + wc) * 64; }
                    else { head_finish(v, nkg, false, nullptr, 0, 0, 1.0f, fq); dst = NK + (size_t)(kvb + rl) * 512 + ((pn - 5) * 4 + wc) * 64; }
#pragma unroll
                    for (int bj = 0; bj < 2; ++bj)
                        st32(dst + 32 * bj, v[bj][0], v[bj][1], fq);
                }
            }
    }
};

struct EpiQUp {
    static constexpr bool PERM = true, AFTER_DRAIN = false;
    bf16_t* MQ; const float* SSQ;
    __device__ __forceinline__ void operator()(const f32x4 (&acc)[2][2][4][2], const Unit& u, int wr, int wc, int fr_in, int fq_in) const {
        int fr = fr_in, fq = fq_in; asm volatile("" : "+v"(fr), "+v"(fq));
#pragma unroll
        for (int ai = 0; ai < 2; ++ai)
#pragma unroll
            for (int m = 0; m < 4; ++m) { const size_t r = (size_t)u.pm * 256 + 128 * ai + 64 * wr + 16 * m + fr;
                const float rs = rsqrtf(SSQ[r] * (1.f / 384.f) + EPS);
#pragma unroll
                for (int bj = 0; bj < 2; ++bj) { const f32x4 a = acc[ai][bj][m][0] * rs, b = acc[ai][bj][m][1] * rs;
                    u32x4 w; w.x = pk(a[0], a[1]); w.y = pk(a[2], a[3]); w.z = pk(b[0], b[1]); w.w = pk(b[2], b[3]);
                    *(u32x4*)(MQ + r * 768 + u.pn * 256 + 128 * bj + 32 * wc + 8 * fq) = w; } }
    }
};

struct EpiKvUp {
    static constexpr bool PERM = false, AFTER_DRAIN = false;
    bf16_t *MK, *MV; const float *SSKV, *KR, *kg, *T16;
    __device__ __forceinline__ void operator()(const f32x4 (&acc)[2][2][4][2], const Unit& u, int wr, int wc, int fr_in, int fq_in) const {
        int fr = fr_in, fq = fq_in; asm volatile("" : "+v"(fr), "+v"(fq));
        const int pm = u.pm; const bool lat = pm < 64; const int kvb = kvbase_of(pm); const int head = 2 * u.pn + (wc >> 1); const bool isv = wc & 1;
        float rs[2][4];
#pragma unroll
        for (int ai = 0; ai < 2; ++ai)
#pragma unroll
            for (int m = 0; m < 4; ++m) rs[ai][m] = SSKV[(size_t)pm * 256 + 128 * ai + 64 * wr + 16 * m + fr];
#pragma unroll
        for (int ai = 0; ai < 2; ++ai)
#pragma unroll
            for (int m = 0; m < 4; ++m) rs[ai][m] = rsqrtf(rs[ai][m] * (1.f / 256.f) + EPS);
        if (isv) {
#pragma unroll
            for (int ai = 0; ai < 2; ++ai)
#pragma unroll
                for (int m = 0; m < 4; ++m) { const size_t kvr = (size_t)(kvb + 128 * ai + 64 * wr + 16 * m + fr);
#pragma unroll
                    for (int bj = 0; bj < 2; ++bj)
                        st32(MV + kvr * 512 + head * 64 + 32 * bj, acc[ai][bj][m][0] * rs[ai][m], acc[ai][bj][m][1] * rs[ai][m], fq); }
            return;
        }
        f32x4 gn[2][2]; f32x2 gr[4];
#pragma unroll
        for (int bj = 0; bj < 2; ++bj)
#pragma unroll
            for (int n = 0; n < 2; ++n) gn[bj][n] = *(const f32x4*)(kg + 32 * bj + 16 * n + 4 * fq);
#pragma unroll
        for (int j = 0; j < 4; ++j) gr[j] = *(const f32x2*)(kg + 64 + 8 * j + 2 * fq);
#pragma unroll
        for (int ai = 0; ai < 2; ++ai) {
            const int grow = (pm & 7) * 4 + 2 * ai + wr;
            f32x2 csr = {1.f, 1.f}, snr = {0.f, 0.f};
            if (lat) { csr = *(const f32x2*)(T16 + grow * 8 + 2 * fq); snr = *(const f32x2*)(T16 + 512 + grow * 8 + 2 * fq); }
#pragma unroll
            for (int m = 0; m < 4; ++m) {
                const int rl = 128 * ai + 64 * wr + 16 * m + fr; const size_t r = (size_t)pm * 256 + rl; const size_t kvr = (size_t)(kvb + rl);
                f32x2 k[4];
#pragma unroll
                for (int j = 0; j < 4; ++j) k[j] = *(const f32x2*)(KR + r * 32 + 8 * j + 2 * fq);
                f32x2 csc = {1.f, 1.f}, snc = {0.f, 0.f};
                if (lat) { const int gcol = 16 * m + fr; csc = *(const f32x2*)(T16 + gcol * 8 + 2 * fq); snc = *(const f32x2*)(T16 + 512 + gcol * 8 + 2 * fq); }
                f32x4 v[2][2];
#pragma unroll
                for (int bj = 0; bj < 2; ++bj)
#pragma unroll
                    for (int n = 0; n < 2; ++n) v[bj][n] = acc[ai][bj][m][n] * rs[ai][m];
                float ss = (sum4sq(v[0][0]) + sum4sq(v[0][1])) + (sum4sq(v[1][0]) + sum4sq(v[1][1]));
#pragma unroll
                for (int j = 0; j < 4; ++j) ss += k[j][0] * k[j][0] + k[j][1] * k[j][1];
                ss = quad_sum(ss);
                const float rr = rsqrtf(ss * (1.f / 96.f) + EPS);
#pragma unroll
                for (int bj = 0; bj < 2; ++bj)
                    st32(MK + kvr * 768 + head * 96 + 32 * bj, (v[bj][0] * rr) * gn[bj][0], (v[bj][1] * rr) * gn[bj][1], fq);
#pragma unroll
                for (int j = 0; j < 4; ++j) k[j] = (k[j] * rr) * gr[j];
                { const f32x2 x1 = k[0], x2 = k[1]; k[0] = x1 * csr - x2 * snr; k[1] = x1 * snr + x2 * csr; }
                { const f32x2 x1 = k[2], x2 = k[3]; k[2] = x1 * csc - x2 * snc; k[3] = x1 * snc + x2 * csc; }
#pragma unroll
                for (int j = 0; j < 4; ++j) *(unsigned*)(MK + kvr * 768 + head * 96 + 64 + 8 * j + 2 * fq) = pk(k[j][0], k[j][1]);
                if (m & 1) asm volatile("" ::: "memory");
            }
        }
    }
};
}
namespace att {
using bf16x8 = __attribute__((ext_vector_type(8))) short;
using s16x4 = __attribute__((ext_vector_type(4))) short;
using f32x16 = __attribute__((ext_vector_type(16))) float;
using u32x4 = __attribute__((ext_vector_type(4))) unsigned;
typedef float f32x2_t __attribute__((ext_vector_type(2))); typedef __bf16 bf16x2_t __attribute__((ext_vector_type(2)));
#define ALAS __attribute__((address_space(3)))
constexpr int KSLOT = 12288, VSLOT = 8192, SLOT = KSLOT + VSLOT, NSLOT = 4, PD = NSLOT - 2;
constexpr int LDS_WS = NSLOT * SLOT;
constexpr int LDS_OST = LDS_WS + 8 * 256;
constexpr int LDS_RPB = LDS_OST + 8 * 4096;
constexpr int LDS_BYTES = LDS_RPB + 4096;
constexpr float THR = 8.0f;

__device__ __forceinline__ int crow(int r, int hi) { return (r & 3) + 8 * (r >> 2) + 4 * hi; }
__device__ __forceinline__ void glds16(const void* gsrc, unsigned lds_dst) { unsigned keep;
    asm volatile("s_mov_b32 %0, m0\n\ts_mov_b32 m0, %2\n\ts_nop 0\n\tglobal_load_lds_dwordx4 %1, off\n\ts_mov_b32 m0, %0" : "=&s"(keep) : "v"(gsrc), "s"(lds_dst) : "memory"); }
__device__ __forceinline__ unsigned cvtpk(float lo, float hi) { f32x2_t v = {lo, hi}; bf16x2_t b = __builtin_convertvector(v, bf16x2_t); return __builtin_bit_cast(unsigned, b); }
__device__ __forceinline__ void glds16s(unsigned voff, const void* sbase, unsigned lds_dst) { unsigned keep;
    asm volatile("s_mov_b32 %0, m0\n\ts_mov_b32 m0, %3\n\ts_nop 0\n\tglobal_load_lds_dwordx4 %1, %2\n\ts_mov_b32 m0, %0" : "=&s"(keep) : "v"(voff), "s"(sbase), "s"(lds_dst) : "memory"); }
__device__ __forceinline__ float max3f(float a, float b, float c) { float r; asm("v_max3_f32 %0, %1, %2, %3" : "=v"(r) : "v"(a), "v"(b), "v"(c)); return r; }
__device__ __forceinline__ float max2f(float a, float b) { float r; asm("v_max_f32_e32 %0, %1, %2" : "=v"(r) : "v"(a), "v"(b)); return r; }
#define AWAIT_BAR(N) asm volatile("s_waitcnt vmcnt(" #N ") lgkmcnt(0)\n\ts_barrier" ::: "memory")

template <int ND0> __device__ __forceinline__ void qkt(f32x16& p0, f32x16& p1, const ALAS char* Kslot, const bf16x8* qr, const f32x16& negm, int r32, int hi) {
    const ALAS char* kb = Kslot + hi * 1024 + r32 * 16;
#pragma unroll
    for (int d0 = 0; d0 < ND0; ++d0) {
        const bf16x8 b0 = *(const ALAS bf16x8*)(kb + d0 * 2048);
        const bf16x8 b1 = *(const ALAS bf16x8*)(kb + d0 * 2048 + 512);
        if (d0 == 0) { p0 = __builtin_amdgcn_mfma_f32_32x32x16_bf16(b0, qr[0], negm, 0, 0, 0); p1 = __builtin_amdgcn_mfma_f32_32x32x16_bf16(b1, qr[0], negm, 0, 0, 0); }
        else { p0 = __builtin_amdgcn_mfma_f32_32x32x16_bf16(b0, qr[d0], p0, 0, 0, 0); p1 = __builtin_amdgcn_mfma_f32_32x32x16_bf16(b1, qr[d0], p1, 0, 0, 0); }
    }
}
__device__ __forceinline__ float rowmax32(const f32x16& p0, const f32x16& p1) {
    float a[4];
#pragma unroll
    for (int k = 0; k < 4; ++k) { a[k] = max3f(p0[4 * k], p0[4 * k + 1], p0[4 * k + 2]); }
#pragma unroll
    for (int k = 0; k < 4; ++k) { a[k] = max3f(a[k], p0[4 * k + 3], p1[4 * k]); }
#pragma unroll
    for (int k = 0; k < 4; ++k) { a[k] = max3f(a[k], p1[4 * k + 1], p1[4 * k + 2]); }
    const float m = max3f(max3f(a[0], p1[3], p1[7]), max3f(a[1], p1[11], p1[15]), max2f(a[2], a[3]));
    auto rr = __builtin_amdgcn_permlane32_swap(__float_as_uint(m), __float_as_uint(m), false, false);
    return max2f(__uint_as_float(rr[0]), __uint_as_float(rr[1]));
}
typedef short v4i16_t __attribute__((ext_vector_type(4)));
__device__ __forceinline__ s16x4 vtr(const ALAS char* p) { return __builtin_bit_cast(s16x4, __builtin_amdgcn_ds_read_tr16_b64_v4i16((ALAS v4i16_t*)p)); }
__device__ __forceinline__ void pv(f32x16* o, const ALAS char* vp, bf16x8 pa0, bf16x8 pa1, bf16x8 pa2, bf16x8 pa3) {
#pragma unroll
    for (int d0 = 0; d0 < 2; ++d0) { s16x4 lo[4], hi[4];
#pragma unroll
        for (int ks = 0; ks < 4; ++ks) { lo[ks] = vtr(vp + d0 * 4096 + ks * 1024); hi[ks] = vtr(vp + d0 * 4096 + ks * 1024 + 512); }
#define APK(k) (bf16x8){lo[k][0], lo[k][1], lo[k][2], lo[k][3], hi[k][0], hi[k][1], hi[k][2], hi[k][3]}
        o[d0] = __builtin_amdgcn_mfma_f32_32x32x16_bf16(pa0, APK(0), o[d0], 0, 0, 0);
        o[d0] = __builtin_amdgcn_mfma_f32_32x32x16_bf16(pa1, APK(1), o[d0], 0, 0, 0);
        o[d0] = __builtin_amdgcn_mfma_f32_32x32x16_bf16(pa2, APK(2), o[d0], 0, 0, 0);
        o[d0] = __builtin_amdgcn_mfma_f32_32x32x16_bf16(pa3, APK(3), o[d0], 0, 0, 0);
#undef APK
    }
}

struct UnitDesc {
    const bf16_t* Q; int qpitch;
    long q0; int qcol;
    const bf16_t* K; int kpitch, kcol;
    const bf16_t* V; int vpitch, vcol;
    bf16_t* O; int opitch, ocol;
    int kv0;
    int nt;
    int rg;
    int rmin;
    int head;
    const bf16_t* G;
};

template <int DQK, bool NA, bool MLAQ>
__device__ __forceinline__ void attn_unit(const UnitDesc& U, ALAS char* shm, const float* qgain, const float* T16, const float* rpb_g) {
    constexpr int ND0 = DQK / 16, NCH = DQK / 8, NP = NCH + 8;
    int tid_ = threadIdx.x; asm volatile("" : "+v"(tid_));
    const int tid = tid_, lane = tid & 63, r32 = lane & 31, hi = lane >> 5; const int wid = __builtin_amdgcn_readfirstlane(tid >> 6);
#ifdef ATT_STATIC_PRIO_NA
    if (wid >= 4) __builtin_amdgcn_s_setprio(1);
#endif
    const unsigned lds0 = (unsigned)(uintptr_t)shm;
    ALAS float* wsf = (ALAS float*)(shm + LDS_WS) + wid * 64;
    unsigned doff[3];
#pragma unroll
    for (int i = 0; i < 3; ++i) { const int pc = wid + 8 * i;
        if (pc < NCH) doff[i] = (unsigned)((lane * U.kpitch + U.kcol + pc * 8) * 2);
        else { const int v = pc - NCH; doff[i] = (unsigned)(((16 * (v & 3) + (lane >> 2)) * U.vpitch + U.vcol + (v >> 2) * 32 + (lane & 3) * 8) * 2); } }
    auto dma_tile = [&](int t, int slot) {
        int key0;
        if (NA && t >= 4) key0 = U.kv0 + CTX + (U.rmin + (t - 4)) * GW; else key0 = U.kv0 + 64 * t;
        const unsigned sbase = lds0 + slot * SLOT;
        const bf16_t* kb_ = U.K + (size_t)key0 * U.kpitch; const bf16_t* vb_ = U.V + (size_t)key0 * U.vpitch;
#pragma unroll
        for (int i = 0; i < 3; ++i) { const int pc = wid + 8 * i;
            if (pc < NP) {
                if (pc < NCH) glds16s(doff[i], kb_, (unsigned)__builtin_amdgcn_readfirstlane(sbase + pc * 1024));
                else glds16s(doff[i], vb_, (unsigned)__builtin_amdgcn_readfirstlane(sbase + KSLOT + (pc - NCH) * 1024));
#ifdef ATT_DUP_DMA
                if (pc < NCH) glds16s(doff[i], kb_, (unsigned)__builtin_amdgcn_readfirstlane(sbase + pc * 1024));
                else glds16s(doff[i], vb_, (unsigned)__builtin_amdgcn_readfirstlane(sbase + KSLOT + (pc - NCH) * 1024));
#endif
            } }
    };
    asm volatile("s_waitcnt vmcnt(0)" ::: "memory");
#pragma unroll
    for (int t0_ = 0; t0_ < PD; ++t0_) if (t0_ < U.nt) dma_tile(t0_, t0_);
    bf16x8 qr[ND0];
    const bf16_t* Qw = U.Q + (size_t)(U.q0 + wid * 32 + r32) * U.qpitch + U.qcol;
#pragma unroll
    for (int d0 = 0; d0 < ND0; ++d0) qr[d0] = *(const bf16x8*)(Qw + d0 * 16 + hi * 8);
    if (MLAQ) {
        float f[ND0][8]; float ss = 0.f;
#pragma unroll
        for (int d0 = 0; d0 < ND0; ++d0)
#pragma unroll
            for (int j = 0; j < 8; ++j) { f[d0][j] = bf2f((bf16_t)qr[d0][j]); ss += f[d0][j] * f[d0][j]; }
        ss += __shfl_xor(ss, 32);
        const float rn = rsqrtf(ss * (1.f / 96.f) + EPS) * C2_96;
#pragma unroll
        for (int d0 = 0; d0 < ND0; ++d0)
#pragma unroll
            for (int j = 0; j < 8; ++j) f[d0][j] = f[d0][j] * rn * qgain[d0 * 16 + hi * 8 + j];
        const int t = (int)((U.q0 + wid * 32 + r32) % S); const int grow = t / GW, gcol = t % GW;
#pragma unroll
        for (int part = 0; part < 2; ++part) { const int pos = part ? gcol : grow;
#pragma unroll
            for (int j = 0; j < 8; ++j) { const float cs = T16[pos * 8 + j], sn = T16[512 + pos * 8 + j];
                const float mine = f[4 + part][j], other = __shfl_xor(mine, 32);
                f[4 + part][j] = hi == 0 ? (mine * cs - other * sn) : (other * sn + mine * cs); } }
#pragma unroll
        for (int d0 = 0; d0 < ND0; ++d0)
#pragma unroll
            for (int j = 0; j < 4; ++j) { const unsigned w = cvtpk(f[d0][2 * j], f[d0][2 * j + 1]); qr[d0][2 * j] = (short)(w & 0xffff); qr[d0][2 * j + 1] = (short)(w >> 16); }
    }
    const int grow_w = NA ? 4 * U.rg + (wid >> 1) : 0, c0w = 32 * (wid & 1);
    const int r0w = NA ? min(max(grow_w - 4, 0), 24) : 0;
    const int qc = c0w + r32;
    const int cs_q = min(max(qc - 8, 0), 48);
    float mhat = 0.f, l_reg = 0.f; f32x16 o[2]; o[0] = f32x16{}; o[1] = f32x16{};
    const ALAS char* vp0 = shm + KSLOT + ((lane >> 4) & 1) * 32 + (lane & 3) * 8 + (4 * hi + ((lane & 15) >> 2)) * 64;
    const int NT = U.nt;
    f32x16 a0, a1, b0, b1;
    u32x4 pw0, pw1, pw2, pw3;
    auto wait_tile = [&](int t) {
        const int ahead = min(PD - 1, NT - 1 - t);
        const bool big = (NP == 20 && wid < 4);
#ifdef ATT_DUP_DMA
        if (ahead >= 1) { if (big) AWAIT_BAR(6); else AWAIT_BAR(4); }
        else AWAIT_BAR(0);
#else
        if (ahead >= 2) { if (big) AWAIT_BAR(6); else AWAIT_BAR(4); }
        else if (ahead == 1) { if (big) AWAIT_BAR(3); else AWAIT_BAR(2); }
        else AWAIT_BAR(0);
#endif
        if (t + PD < NT) dma_tile(t + PD, (t + PD) % NSLOT);
    };
    bf16x8 eq[2];
    if (NA) {
#pragma unroll
        for (int s_ = 0; s_ < 2; ++s_)
#pragma unroll
            for (int jj = 0; jj < 8; ++jj) eq[s_][jj] = (16 * s_ + 8 * hi + jj == r32) ? (short)0x3f80 : (short)0;
    }
    const bf16_t* gq = NA ? U.G + (size_t)U.head * (16 * 2 * 64 * 32) + (size_t)(wid & 1) * (64 * 32) + r32 * 32 + hi * 8 : nullptr;
    auto gbias_load = [&](bf16x8 (&f)[4], int t) {
        const int krow = U.rmin + (t - 4); int dr = krow - grow_w + 7; if (krow < r0w || krow >= r0w + 8) dr = 15;
        const bf16_t* g = gq + (size_t)dr * (2 * 64 * 32);
#pragma unroll
        for (int half = 0; half < 2; ++half)
#pragma unroll
            for (int s_ = 0; s_ < 2; ++s_) f[2 * s_ + half] = *(const bf16x8*)(g + half * 1024 + s_ * 16);
    };
    auto gbias_mma = [&](f32x16& c0, f32x16& c1, const bf16x8 (&f)[4]) {
        c0 = __builtin_amdgcn_mfma_f32_32x32x16_bf16(f[0], eq[0], c0, 0, 0, 0); c1 = __builtin_amdgcn_mfma_f32_32x32x16_bf16(f[1], eq[0], c1, 0, 0, 0);
        c0 = __builtin_amdgcn_mfma_f32_32x32x16_bf16(f[2], eq[1], c0, 0, 0, 0); c1 = __builtin_amdgcn_mfma_f32_32x32x16_bf16(f[3], eq[1], c1, 0, 0, 0);
    };
    constexpr bool NEGM = true;
    f32x16 negm = f32x16{};
    auto decide = [&](f32x16& c0, f32x16& c1, bool first) -> bool {
        const float rm = rowmax32(c0, c1);
        if (first || __any(rm > THR)) {
            const float dl = first ? rm : fmaxf(rm, 0.f);
            mhat += dl;
#pragma unroll
            for (int r = 0; r < 16; ++r) { c0[r] -= dl; c1[r] -= dl; }
#pragma unroll
            for (int r = 0; r < 16; ++r) negm[r] = -mhat;
            if (!first) { const float f = __builtin_amdgcn_exp2f(-dl); l_reg *= f; if (hi == 0) wsf[r32] = f; return true; }
        }
        return false;
    };
    auto rescale_o = [&]() {
        asm volatile("s_waitcnt lgkmcnt(0)" ::: "memory");
#pragma unroll
        for (int r = 0; r < 16; ++r) { const float fr_ = wsf[crow(r, hi)]; o[0][r] *= fr_; o[1][r] *= fr_; }
    };
    auto expo = [&](f32x16& c0, f32x16& c1) {
#pragma unroll
        for (int r = 0; r < 16; ++r) { c0[r] = __builtin_amdgcn_exp2f(c0[r]); c1[r] = __builtin_amdgcn_exp2f(c1[r]); }
    };
    auto sumpack = [&](const f32x16& c0, const f32x16& c1) {
        float s4[4];
#pragma unroll
        for (int k = 0; k < 4; ++k) s4[k] = c0[k] + c1[k];
#pragma unroll
        for (int r = 4; r < 16; ++r) s4[r & 3] += c0[r] + c1[r];
        l_reg += (s4[0] + s4[1]) + (s4[2] + s4[3]);
#pragma unroll
        for (int j = 0; j < 4; ++j) { pw0[j] = cvtpk(c0[2 * j], c0[2 * j + 1]); pw1[j] = cvtpk(c0[8 + 2 * j], c0[9 + 2 * j]); pw2[j] = cvtpk(c1[2 * j], c1[2 * j + 1]); pw3[j] = cvtpk(c1[8 + 2 * j], c1[9 + 2 * j]); }
    };
    auto step = [&](f32x16& c0, f32x16& c1, f32x16& q0, f32x16& q1, int j) {
        wait_tile(j);
        bf16x8 gf[4];
        if (NA && j >= 4) gbias_load(gf, j);
        qkt<ND0>(c0, c1, shm + (j % NSLOT) * SLOT, qr, negm, r32, hi);
        if (NA && j >= 4) gbias_mma(c0, c1, gf);
        sumpack(q0, q1);
        const bool resc = decide(c0, c1, false);
        pv(o, vp0 + ((j - 1) % NSLOT) * SLOT, __builtin_bit_cast(bf16x8, pw0), __builtin_bit_cast(bf16x8, pw1), __builtin_bit_cast(bf16x8, pw2), __builtin_bit_cast(bf16x8, pw3));
        expo(c0, c1);
        if (resc) rescale_o();
    };
    wait_tile(0);
    qkt<ND0>(a0, a1, shm, qr, negm, r32, hi);
    (void)decide(a0, a1, true);
    expo(a0, a1);
    int j = 1;
#pragma unroll 1
    for (; j + 1 < NT; j += 2) { step(b0, b1, a0, a1, j); step(a0, a1, b0, b1, j + 1); }
    if (j < NT) { step(b0, b1, a0, a1, j); sumpack(b0, b1); } else sumpack(a0, a1);
    pv(o, vp0 + ((NT - 1) % NSLOT) * SLOT, __builtin_bit_cast(bf16x8, pw0), __builtin_bit_cast(bf16x8, pw1), __builtin_bit_cast(bf16x8, pw2), __builtin_bit_cast(bf16x8, pw3));
    { auto rr = __builtin_amdgcn_permlane32_swap(__float_as_uint(l_reg), __float_as_uint(l_reg), false, false); l_reg = __uint_as_float(rr[0]) + __uint_as_float(rr[1]); }
    if (hi == 0) wsf[32 + r32] = l_reg;
    asm volatile("s_waitcnt lgkmcnt(0)" ::: "memory");
    float rli[16];
#pragma unroll
    for (int r = 0; r < 16; ++r) rli[r] = __builtin_amdgcn_rcpf(wsf[32 + crow(r, hi)]);
    bf16_t* Ow = U.O + (size_t)(U.q0 + wid * 32) * U.opitch + U.ocol;
    { ALAS bf16_t* stg = (ALAS bf16_t*)(shm + LDS_OST) + wid * 2048;
#pragma unroll
        for (int r = 0; r < 16; ++r) { const int orow = crow(r, hi);
#pragma unroll
            for (int d0 = 0; d0 < 2; ++d0) stg[orow * 64 + d0 * 32 + r32] = f2bf(o[d0][r] * rli[r]); }
        asm volatile("s_waitcnt lgkmcnt(0)" ::: "memory");
#pragma unroll
        for (int i = 0; i < 4; ++i) { const int row = i * 8 + (lane >> 3), ch = lane & 7; const u32x4 v = *(const ALAS u32x4*)(stg + row * 64 + ch * 8); *(u32x4*)(Ow + (size_t)row * U.opitch + ch * 8) = v; } }
#ifdef ATT_STATIC_PRIO_NA
    __builtin_amdgcn_s_setprio(0);
#endif
    asm volatile("s_waitcnt vmcnt(0) lgkmcnt(0)\n\ts_barrier" ::: "memory");
}
}
#include <hip/hip_bf16.h>
namespace att64 {
using bf16=__hip_bfloat16;
using bf16x8=__attribute__((ext_vector_type(8)))short;
using s16x4=__attribute__((ext_vector_type(4)))short;
using f32x16=__attribute__((ext_vector_type(16)))float;
using u32x4=__attribute__((ext_vector_type(4)))unsigned;
constexpr int D=64;
constexpr int NW=8,QBLK=32,QB=QBLK*NW,KVBLK=64;

__device__ __forceinline__ int crow(int r,int hi){return (r&3)+8*(r>>2)+4*hi;}
#define SBAR() __builtin_amdgcn_sched_barrier(0)
__device__ __forceinline__ void cmask(f32x16&p0,f32x16&p1,int jb,int qrel,int hi){
  const float NEG=-INFINITY; int kb=64*jb+4*hi;
  #pragma unroll
  for(int r=0;r<16;++r){int kv=kb+(r&3)+8*(r>>2); if(kv>qrel)p0[r]=NEG; if(kv+32>qrel)p1[r]=NEG;}
}

constexpr int NSLOT=3, SLOTB=8192;
constexpr int LDS_K=0, LDS_V=NSLOT*SLOTB, LDS_WS=2*NSLOT*SLOTB, LDS_OST=LDS_WS+NW*64*4, LDS_BYTES=LDS_OST+NW*4096;
constexpr float C2=0.125f*1.4426950408889634f;
__device__ __forceinline__ void glds16(const void*gsrc,unsigned lds_dst){unsigned keep;
  asm volatile("s_mov_b32 %0, m0\n\ts_mov_b32 m0, %2\n\ts_nop 0\n\tglobal_load_lds_dwordx4 %1, off\n\ts_mov_b32 m0, %0":"=&s"(keep):"v"(gsrc),"s"(lds_dst):"memory");}
__device__ __forceinline__ float max3f(float a,float b,float c){float r;asm("v_max3_f32 %0, %1, %2, %3":"=v"(r):"v"(a),"v"(b),"v"(c));return r;}
__device__ __forceinline__ float max2f(float a,float b){float r;asm("v_max_f32_e32 %0, %1, %2":"=v"(r):"v"(a),"v"(b));return r;}
__device__ __forceinline__ float fadd_s(float a,float b){float r;asm("v_add_f32_e32 %0, %1, %2":"=v"(r):"v"(a),"v"(b));return r;}
__device__ __forceinline__ float fsub_s(float a,float b){float r;asm("v_sub_f32_e32 %0, %1, %2":"=v"(r):"v"(a),"v"(b));return r;}
typedef float f32x2_t __attribute__((ext_vector_type(2))); typedef __bf16 bf16x2_t __attribute__((ext_vector_type(2)));
__device__ __forceinline__ unsigned cvtpk_s(float lo,float hi){f32x2_t v={lo,hi};bf16x2_t b=__builtin_convertvector(v,bf16x2_t);return __builtin_bit_cast(unsigned,b);}
#define WAIT_BAR(N) asm volatile("s_waitcnt vmcnt(" #N ") lgkmcnt(0)\n\ts_barrier":::"memory")

__device__ __forceinline__ void qkt(f32x16&p0,f32x16&p1,const char*Kslot,const bf16x8*qr,const f32x16&negm,int r32,int hi){
  const char*kb=Kslot+hi*1024+r32*16;
  #pragma unroll
  for(int d0=0;d0<4;++d0){
    const bf16x8 b0=*reinterpret_cast<const bf16x8*>(kb+d0*2048);
    const bf16x8 b1=*reinterpret_cast<const bf16x8*>(kb+d0*2048+512);
    if(d0==0){p0=__builtin_amdgcn_mfma_f32_32x32x16_bf16(b0,qr[0],negm,0,0,0);p1=__builtin_amdgcn_mfma_f32_32x32x16_bf16(b1,qr[0],negm,0,0,0);}
    else{p0=__builtin_amdgcn_mfma_f32_32x32x16_bf16(b0,qr[d0],p0,0,0,0);p1=__builtin_amdgcn_mfma_f32_32x32x16_bf16(b1,qr[d0],p1,0,0,0);}}
}
typedef __attribute__((address_space(3))) const char* lds_cptr;
typedef short v4i16_t __attribute__((ext_vector_type(4)));
__device__ __forceinline__ void kload8(bf16x8*kf,lds_cptr kp){
  kf[0]=*(const __attribute__((address_space(3))) bf16x8*)(kp);      kf[1]=*(const __attribute__((address_space(3))) bf16x8*)(kp+512);
  kf[2]=*(const __attribute__((address_space(3))) bf16x8*)(kp+2048); kf[3]=*(const __attribute__((address_space(3))) bf16x8*)(kp+2560);
  kf[4]=*(const __attribute__((address_space(3))) bf16x8*)(kp+4096); kf[5]=*(const __attribute__((address_space(3))) bf16x8*)(kp+4608);
  kf[6]=*(const __attribute__((address_space(3))) bf16x8*)(kp+6144); kf[7]=*(const __attribute__((address_space(3))) bf16x8*)(kp+6656);
}
__device__ __forceinline__ void kload2(bf16x8*kf,lds_cptr kp,int j){ kf[2*j]=*(const __attribute__((address_space(3))) bf16x8*)(kp+j*2048); kf[2*j+1]=*(const __attribute__((address_space(3))) bf16x8*)(kp+j*2048+512); }
__device__ __forceinline__ s16x4 vtr(lds_cptr p){ return __builtin_bit_cast(s16x4,__builtin_amdgcn_ds_read_tr16_b64_v4i16((__attribute__((address_space(3))) v4i16_t*)p)); }
__device__ __forceinline__ float rowmax(const f32x16&p0,const f32x16&p1){
  float a=max3f(p0[0],p0[1],p1[0]),b=max3f(p0[2],p0[3],p1[1]);a=max3f(a,p1[2],p1[3]);
  #pragma unroll
  for(int r=4;r<16;r+=4){a=max3f(a,p0[r],p0[r+1]);b=max3f(b,p0[r+2],p0[r+3]);a=max3f(a,p1[r],p1[r+1]);b=max3f(b,p1[r+2],p1[r+3]);}
  const float m=max2f(a,b);
  auto rr=__builtin_amdgcn_permlane32_swap(__float_as_uint(m),__float_as_uint(m),false,false);
  return max2f(__uint_as_float(rr[0]),__uint_as_float(rr[1]));
}
__device__ __forceinline__ void pv(f32x16*o,int vb,bf16x8 pa0,bf16x8 pa1,bf16x8 pa2,bf16x8 pa3){
  #pragma unroll
  for(int d0=0;d0<2;++d0){s16x4 lo[4],hi[4];
    #pragma unroll
    for(int ks=0;ks<4;++ks){
      asm volatile("ds_read_b64_tr_b16 %0,%1 offset:%c2":"=&v"(lo[ks]):"v"(vb),"i"(d0*4096+ks*1024):"memory");
      asm volatile("ds_read_b64_tr_b16 %0,%1 offset:%c2":"=&v"(hi[ks]):"v"(vb),"i"(d0*4096+ks*1024+512):"memory");}
    asm volatile("s_waitcnt lgkmcnt(0)":::"memory");SBAR();
    #define PK(k) (bf16x8){lo[k][0],lo[k][1],lo[k][2],lo[k][3],hi[k][0],hi[k][1],hi[k][2],hi[k][3]}
    o[d0]=__builtin_amdgcn_mfma_f32_32x32x16_bf16(pa0,PK(0),o[d0],0,0,0);
    o[d0]=__builtin_amdgcn_mfma_f32_32x32x16_bf16(pa1,PK(1),o[d0],0,0,0);
    o[d0]=__builtin_amdgcn_mfma_f32_32x32x16_bf16(pa2,PK(2),o[d0],0,0,0);
    o[d0]=__builtin_amdgcn_mfma_f32_32x32x16_bf16(pa3,PK(3),o[d0],0,0,0);
    #undef PK
  }
}

#ifndef ATTN_STORE16
#define ATTN_STORE16(p,v) (*(u32x4*)(p)=(v))
#endif
template<int THRL> __device__ __forceinline__ void attn_unit(long q0,const bf16*Q,int qp,int qcol,const bf16*__restrict__ K,int kp,int kcol,const bf16*__restrict__ V,int vp,int vcol,long kv0,int NT,bf16*O,int op,int ocol,char*shm){
  int tid_=threadIdx.x; asm volatile("":"+v"(tid_));
  const int tid=tid_,lane=tid&63,r32=lane&31,hi=lane>>5; const int wid=__builtin_amdgcn_readfirstlane(tid>>6);
#ifdef ATT_STATIC_PRIO
  if(wid>=4)__builtin_amdgcn_s_setprio(1);
#endif
  const bf16*Qw=Q+(q0+wid*QBLK)*qp+qcol;
  const bf16*Kh=K+kv0*kp+kcol,*Vh=V+kv0*vp+vcol;
  const unsigned lds0=(unsigned)(uintptr_t)shm;
  float*wsf=(float*)(shm+LDS_WS)+wid*64;
  const bf16*ksrc=Kh+(long)lane*kp+wid*8;
  const bf16*vsrc=Vh+(long)(16*(wid&3)+(lane>>2))*vp+(wid>>2)*32+(lane&3)*8;
  const unsigned kdst=lds0+LDS_K+wid*1024, vdst=lds0+LDS_V+wid*1024;
  #define DMA_K(t,slot) glds16(ksrc+(long)(t)*KVBLK*kp,(unsigned)__builtin_amdgcn_readfirstlane(kdst+(slot)))
  #define DMA_V(t,slot) glds16(vsrc+(long)(t)*KVBLK*vp,(unsigned)__builtin_amdgcn_readfirstlane(vdst+(slot)))
  const int vb0=(int)(lds0+LDS_V)+((lane>>4)&1)*32+(lane&3)*8+(4*hi+((lane&15)>>2))*64;
  const char*Kbase=shm+LDS_K; bf16x8 kf[8];
  const lds_cptr shm3=(lds_cptr)shm; const lds_cptr kp0=shm3+LDS_K+hi*1024+r32*16; const lds_cptr vp0=shm3+LDS_V+((lane>>4)&1)*32+(lane&3)*8+(4*hi+((lane&15)>>2))*64;
  DMA_K(0,0);DMA_V(0,0);DMA_K(1,SLOTB);
  bf16x8 qr[4];
  #pragma unroll
  for(int d0=0;d0<4;++d0)qr[d0]=*reinterpret_cast<const bf16x8*>(&Qw[(long)r32*qp+d0*16+hi*8]);
  float mhat=0.f,l_reg=0.f;f32x16 o[2];o[0]=f32x16{};o[1]=f32x16{};f32x16 negm=f32x16{};asm volatile("":"+v"(negm));
  #define CMASK(P0,P1,t) do{}while(0)
  bool resc=false;
  #define START(P0,P1) do{ const float rm=rowmax(P0,P1); resc=false; \
    { const float dl=rm; mhat=fadd_s(mhat,dl); \
      _Pragma("unroll") for(int r=0;r<16;++r){P0[r]=fsub_s(P0[r],dl);P1[r]=fsub_s(P1[r],dl);} \
      _Pragma("unroll") for(int r=0;r<16;++r)negm[r]=-mhat; asm volatile("":"+v"(negm)); } \
    _Pragma("unroll") for(int r=0;r<16;++r)P0[r]=__builtin_amdgcn_exp2f(P0[r]); }while(0)
  #define RESC() do{ if(resc){ asm volatile("s_waitcnt lgkmcnt(0)":::"memory"); \
      _Pragma("unroll") for(int d_=0;d_<2;++d_) _Pragma("unroll") for(int r=0;r<16;++r)o[d_][r]*=wsf[crow(r,hi)]; } }while(0)
  f32x16 pA0,pA1,pB0,pB1;
  int sl_prev=0,sl_cur=0,sl_next=SLOTB;
  #define ROT() do{sl_prev=sl_cur;sl_cur=sl_next;sl_next=(sl_next==(NSLOT-1)*SLOTB)?0:sl_next+SLOTB;}while(0)
  DMA_K(2,2*SLOTB);
  WAIT_BAR(3);
  qkt(pA0,pA1,Kbase,qr,negm,r32,hi);asm volatile("s_nop 15\n\ts_nop 7":"+v"(pA0),"+v"(pA1));CMASK(pA0,pA1,0);
  START(pA0,pA1);
  _Pragma("unroll") for(int r=0;r<16;++r)pA1[r]=__builtin_amdgcn_exp2f(pA1[r]);
  WAIT_BAR(0);
  DMA_K(3,0);DMA_V(1,SLOTB);
  ROT();
  kload8(kf,kp0+sl_cur);
  WAIT_BAR(2);
  s16x4 vlo[8],vhi[8]; u32x4 pw0,pw1,pw2,pw3;
  #define PKW(P,B) cvtpk_s(P[B],P[B+1])
  #define PAF(k) __builtin_bit_cast(bf16x8,pw##k)
  #define VFR(i) (bf16x8){vlo[i][0],vlo[i][1],vlo[i][2],vlo[i][3],vhi[i][0],vhi[i][1],vhi[i][2],vhi[i][3]}
  #define PIN(x) asm volatile("":"+v"(x))
  #define MX3(a,b,c) __builtin_fmaxf(__builtin_fmaxf((a),(b)),(c))
  #define GAPA(MF,A0,A1,A2,A3,W0,W1,PW) do{ MF; sacc+=A0; sacc+=A1; sacc+=A2; sacc+=A3; PIN(sacc); W0; W1; PIN(PW); SBAR(); }while(0)
  #define EX(v) __builtin_amdgcn_exp2f(v)
  #define GAPB(MF,X,B) do{ MF; X[B]=EX(X[B]); X[B+1]=EX(X[B+1]); X[B+2]=EX(X[B+2]); X[B+3]=EX(X[B+3]); PIN(X); SBAR(); }while(0)
  #define VRD(i) do{ vlo[i]=vtr(vp_+(((i)>>2)*4096+((i)&3)*1024)); vhi[i]=vtr(vp_+(((i)>>2)*4096+((i)&3)*1024+512)); }while(0)
  #define KRD(G,j) do{ if(G){ kload2(kf,kp0+sl_next,j); SBAR(); } }while(0)
  #define STEP(C0,C1,P0,P1,t,GK,GV,GL) do{ SBAR(); \
    const lds_cptr vp_=vp0+sl_prev; \
    VRD(0); SBAR(); float sacc=(P0[0]+P0[1]); \
    GAPA(C0=__builtin_amdgcn_mfma_f32_32x32x16_bf16(kf[0],qr[0],negm,0,0,0), P0[2],P0[3],P0[4],P0[5],     pw0[0]=PKW(P0,0), pw0[1]=PKW(P0,2), pw0); \
    VRD(4); SBAR(); GAPA(C1=__builtin_amdgcn_mfma_f32_32x32x16_bf16(kf[1],qr[0],negm,0,0,0), P0[6],P0[7],P0[8],P0[9],     pw0[2]=PKW(P0,4), pw0[3]=PKW(P0,6), pw0); \
    VRD(1); SBAR(); GAPA(C0=__builtin_amdgcn_mfma_f32_32x32x16_bf16(kf[2],qr[1],C0,0,0,0),   P0[10],P0[11],P0[12],P0[13], pw1[0]=PKW(P0,8), pw1[1]=PKW(P0,10), pw1); \
    VRD(5); SBAR(); GAPA(C1=__builtin_amdgcn_mfma_f32_32x32x16_bf16(kf[3],qr[1],C1,0,0,0),   P0[14],P0[15],P1[0],P1[1],   pw1[2]=PKW(P0,12),pw1[3]=PKW(P0,14), pw1); \
    VRD(2); SBAR(); GAPA(C0=__builtin_amdgcn_mfma_f32_32x32x16_bf16(kf[4],qr[2],C0,0,0,0),   P1[2],P1[3],P1[4],P1[5],     pw2[0]=PKW(P1,0), pw2[1]=PKW(P1,2), pw2); \
    VRD(6); SBAR(); GAPA(C1=__builtin_amdgcn_mfma_f32_32x32x16_bf16(kf[5],qr[2],C1,0,0,0),   P1[6],P1[7],P1[8],P1[9],     pw2[2]=PKW(P1,4), pw2[3]=PKW(P1,6), pw2); \
    VRD(3); SBAR(); GAPA(C0=__builtin_amdgcn_mfma_f32_32x32x16_bf16(kf[6],qr[3],C0,0,0,0),   P1[10],P1[11],P1[12],P1[13], pw3[0]=PKW(P1,8), pw3[1]=PKW(P1,10), pw3); \
    VRD(7); SBAR(); GAPA(C1=__builtin_amdgcn_mfma_f32_32x32x16_bf16(kf[7],qr[3],C1,0,0,0),   P1[14],P1[15],0.f,0.f,       pw3[2]=PKW(P1,12),pw3[3]=PKW(P1,14), pw3); \
    l_reg+=sacc; \
    if(GK){DMA_K((t)+3,sl_cur);} if(GV){DMA_V((t)+1,sl_next);} \
    CMASK(C0,C1,t); \
    { float a=MX3(C0[0],C0[1],C1[0]),b=MX3(C0[2],C0[3],C1[1]); a=MX3(a,C1[2],C1[3]); \
      _Pragma("unroll") for(int r=4;r<16;r+=4){a=MX3(a,C0[r],C0[r+1]);b=MX3(b,C0[r+2],C0[r+3]);a=MX3(a,C1[r],C1[r+1]);b=MX3(b,C1[r+2],C1[r+3]);} \
      float rm=__builtin_fmaxf(a,b); { auto rr=__builtin_amdgcn_permlane32_swap(__float_as_uint(rm),__float_as_uint(rm),false,false); rm=__builtin_fmaxf(__uint_as_float(rr[0]),__uint_as_float(rr[1])); } \
      resc=false; \
      if(__builtin_expect(__any(rm>(float)THRL),0)){ const float dl=__builtin_fmaxf(rm,0.f); mhat+=dl; \
        _Pragma("unroll") for(int r=0;r<16;++r){C0[r]-=dl;C1[r]-=dl;} \
        _Pragma("unroll") for(int r=0;r<16;++r)negm[r]=-mhat; asm volatile("":"+v"(negm)); \
        const float f=__builtin_amdgcn_exp2f(-dl); l_reg*=f; if(hi==0)wsf[r32]=f; resc=true; } } \
    SBAR(); \
    GAPB(o[0]=__builtin_amdgcn_mfma_f32_32x32x16_bf16(PAF(0),VFR(0),o[0],0,0,0), C0,0); \
    GAPB(o[1]=__builtin_amdgcn_mfma_f32_32x32x16_bf16(PAF(0),VFR(4),o[1],0,0,0), C0,4); \
    KRD(GL,0); GAPB(o[0]=__builtin_amdgcn_mfma_f32_32x32x16_bf16(PAF(1),VFR(1),o[0],0,0,0), C0,8); \
    KRD(GL,1); GAPB(o[1]=__builtin_amdgcn_mfma_f32_32x32x16_bf16(PAF(1),VFR(5),o[1],0,0,0), C0,12); \
    KRD(GL,2); GAPB(o[0]=__builtin_amdgcn_mfma_f32_32x32x16_bf16(PAF(2),VFR(2),o[0],0,0,0), C1,0); \
    KRD(GL,3); GAPB(o[1]=__builtin_amdgcn_mfma_f32_32x32x16_bf16(PAF(2),VFR(6),o[1],0,0,0), C1,4); \
    GAPB(o[0]=__builtin_amdgcn_mfma_f32_32x32x16_bf16(PAF(3),VFR(3),o[0],0,0,0), C1,8); \
    GAPB(o[1]=__builtin_amdgcn_mfma_f32_32x32x16_bf16(PAF(3),VFR(7),o[1],0,0,0), C1,12); \
    }while(0)
  int t=1;
  #undef CMASK
  #define CMASK(P0,P1,t) do{}while(0)
  for(;t+5<NT;t+=2){
    STEP(pB0,pB1,pA0,pA1,t,true,true,true);     WAIT_BAR(2); RESC(); ROT();
    STEP(pA0,pA1,pB0,pB1,t+1,true,true,true);   WAIT_BAR(2); RESC(); ROT();
  }
  #undef CMASK
  #define CMASK(P0,P1,t) do{}while(0)
  #define ENDW(tt) do{ if((tt)+3<NT){WAIT_BAR(2);} else if((tt)+2<NT){WAIT_BAR(1);} else {WAIT_BAR(0);} }while(0)
  for(;t+1<NT;t+=2){
    STEP(pB0,pB1,pA0,pA1,t,(t+3<NT),(t+1<NT),(t+1<NT));       ENDW(t);   RESC(); ROT();
    STEP(pA0,pA1,pB0,pB1,t+1,(t+4<NT),(t+2<NT),(t+2<NT));     ENDW(t+1); RESC(); ROT();
  }
  STEP(pB0,pB1,pA0,pA1,NT-1,false,false,false); RESC();
  { float sacc=pB0[0]+pB0[1]; _Pragma("unroll") for(int r=2;r<16;++r)sacc+=pB0[r]; _Pragma("unroll") for(int r=0;r<16;++r)sacc+=pB1[r]; l_reg+=sacc;
    pw0=(u32x4){PKW(pB0,0),PKW(pB0,2),PKW(pB0,4),PKW(pB0,6)};pw1=(u32x4){PKW(pB0,8),PKW(pB0,10),PKW(pB0,12),PKW(pB0,14)};pw2=(u32x4){PKW(pB1,0),PKW(pB1,2),PKW(pB1,4),PKW(pB1,6)};pw3=(u32x4){PKW(pB1,8),PKW(pB1,10),PKW(pB1,12),PKW(pB1,14)};
    SBAR(); pv(o,vb0+sl_cur,PAF(0),PAF(1),PAF(2),PAF(3)); }
  #undef PKW
  #undef PAF
  #undef VFR
  #undef PIN
  #undef MX3
  #undef GAPA
  #undef GAPB
  #undef EX
  #undef VRD
  #undef KRD
  #undef STEP
  #undef ENDW
  {auto rr=__builtin_amdgcn_permlane32_swap(__float_as_uint(l_reg),__float_as_uint(l_reg),false,false);l_reg=__uint_as_float(rr[0])+__uint_as_float(rr[1]);}
  if(hi==0)wsf[32+r32]=l_reg;asm volatile("s_waitcnt lgkmcnt(0)":::"memory");
  float rli[16];
  #pragma unroll
  for(int r=0;r<16;++r)rli[r]=__builtin_amdgcn_rcpf(wsf[32+crow(r,hi)]);
  bf16*Ow=O+(q0+wid*QBLK)*op+ocol;
  { bf16*stg=(bf16*)(shm+LDS_OST)+wid*2048;
    #pragma unroll
    for(int r=0;r<16;++r){const int orow=crow(r,hi);
      #pragma unroll
      for(int d0=0;d0<2;++d0)stg[orow*64+d0*32+r32]=__float2bfloat16(o[d0][r]*rli[r]);}
    asm volatile("s_waitcnt lgkmcnt(0)":::"memory");
    #pragma unroll
    for(int i=0;i<4;++i){const int row=i*8+(lane>>3),ch=lane&7; const u32x4 v=*(const u32x4*)(stg+row*64+ch*8); ATTN_STORE16(Ow+(long)row*op+ch*8,v);} }
#ifdef ATT_STATIC_PRIO
  __builtin_amdgcn_s_setprio(0);
#endif
  asm volatile("s_waitcnt lgkmcnt(0)\n\ts_barrier":::"memory");
  #undef DMA_K
  #undef DMA_V
  #undef CMASK
  #undef START
  #undef RESC
  #undef ROT
}
constexpr int ATTN_LDS_BYTES=LDS_BYTES;

#undef SBAR
#undef WAIT_BAR
}
namespace att96 {
using bf16=__hip_bfloat16;
using bf16x8=__attribute__((ext_vector_type(8)))short;
using s16x4=__attribute__((ext_vector_type(4)))short;
using f32x16=__attribute__((ext_vector_type(16)))float;
using u32x4=__attribute__((ext_vector_type(4)))unsigned;
constexpr int D=64;
constexpr int NW=8,QBLK=32,QB=QBLK*NW,KVBLK=64;

__device__ __forceinline__ int crow(int r,int hi){return (r&3)+8*(r>>2)+4*hi;}
#define SBAR() __builtin_amdgcn_sched_barrier(0)
__device__ __forceinline__ void cmask(f32x16&p0,f32x16&p1,int jb,int qrel,int hi){
  const float NEG=-INFINITY; int kb=64*jb+4*hi;
  #pragma unroll
  for(int r=0;r<16;++r){int kv=kb+(r&3)+8*(r>>2); if(kv>qrel)p0[r]=NEG; if(kv+32>qrel)p1[r]=NEG;}
}

constexpr int NSLOT=3, SLOTB=8192;
constexpr int KSLOTB=12288;
constexpr int LDS_K=0, LDS_V=NSLOT*KSLOTB, LDS_WS=LDS_V+NSLOT*SLOTB, LDS_OST=LDS_WS+NW*64*4, LDS_BYTES=LDS_OST+NW*4096;
constexpr float C2=0.125f*1.4426950408889634f;
__device__ __forceinline__ void glds16(const void*gsrc,unsigned lds_dst){unsigned keep;
  asm volatile("s_mov_b32 %0, m0\n\ts_mov_b32 m0, %2\n\ts_nop 0\n\tglobal_load_lds_dwordx4 %1, off\n\ts_mov_b32 m0, %0":"=&s"(keep):"v"(gsrc),"s"(lds_dst):"memory");}
__device__ __forceinline__ float max3f(float a,float b,float c){float r;asm("v_max3_f32 %0, %1, %2, %3":"=v"(r):"v"(a),"v"(b),"v"(c));return r;}
__device__ __forceinline__ float max2f(float a,float b){float r;asm("v_max_f32_e32 %0, %1, %2":"=v"(r):"v"(a),"v"(b));return r;}
__device__ __forceinline__ float fadd_s(float a,float b){float r;asm("v_add_f32_e32 %0, %1, %2":"=v"(r):"v"(a),"v"(b));return r;}
__device__ __forceinline__ float fsub_s(float a,float b){float r;asm("v_sub_f32_e32 %0, %1, %2":"=v"(r):"v"(a),"v"(b));return r;}
typedef float f32x2_t __attribute__((ext_vector_type(2))); typedef __bf16 bf16x2_t __attribute__((ext_vector_type(2)));
__device__ __forceinline__ unsigned cvtpk_s(float lo,float hi){f32x2_t v={lo,hi};bf16x2_t b=__builtin_convertvector(v,bf16x2_t);return __builtin_bit_cast(unsigned,b);}
#define KOFF(sl) ((sl)+((sl)>>1))
#define WAIT_BAR(N) asm volatile("s_waitcnt vmcnt(" #N ") lgkmcnt(0)\n\ts_barrier":::"memory")

__device__ __forceinline__ void qkt(f32x16&p0,f32x16&p1,const char*Kslot,const bf16x8*qr,const f32x16&negm,int r32,int hi){
  const char*kb=Kslot+hi*1024+r32*16;
  #pragma unroll
  for(int d0=0;d0<6;++d0){
    const bf16x8 b0=*reinterpret_cast<const bf16x8*>(kb+d0*2048);
    const bf16x8 b1=*reinterpret_cast<const bf16x8*>(kb+d0*2048+512);
    if(d0==0){p0=__builtin_amdgcn_mfma_f32_32x32x16_bf16(b0,qr[0],negm,0,0,0);p1=__builtin_amdgcn_mfma_f32_32x32x16_bf16(b1,qr[0],negm,0,0,0);}
    else{p0=__builtin_amdgcn_mfma_f32_32x32x16_bf16(b0,qr[d0],p0,0,0,0);p1=__builtin_amdgcn_mfma_f32_32x32x16_bf16(b1,qr[d0],p1,0,0,0);}}
}
typedef __attribute__((address_space(3))) const char* lds_cptr;
typedef short v4i16_t __attribute__((ext_vector_type(4)));
__device__ __forceinline__ void kload12(bf16x8*kf,lds_cptr kp){
  kf[0]=*(const __attribute__((address_space(3))) bf16x8*)(kp);      kf[1]=*(const __attribute__((address_space(3))) bf16x8*)(kp+512);
  kf[2]=*(const __attribute__((address_space(3))) bf16x8*)(kp+2048); kf[3]=*(const __attribute__((address_space(3))) bf16x8*)(kp+2560);
  kf[4]=*(const __attribute__((address_space(3))) bf16x8*)(kp+4096); kf[5]=*(const __attribute__((address_space(3))) bf16x8*)(kp+4608);
  kf[6]=*(const __attribute__((address_space(3))) bf16x8*)(kp+6144); kf[7]=*(const __attribute__((address_space(3))) bf16x8*)(kp+6656);
  kf[8]=*(const __attribute__((address_space(3))) bf16x8*)(kp+8192); kf[9]=*(const __attribute__((address_space(3))) bf16x8*)(kp+8704);
  kf[10]=*(const __attribute__((address_space(3))) bf16x8*)(kp+10240); kf[11]=*(const __attribute__((address_space(3))) bf16x8*)(kp+10752);
}
__device__ __forceinline__ void kload2(bf16x8*kf,lds_cptr kp,int j){ kf[2*j]=*(const __attribute__((address_space(3))) bf16x8*)(kp+j*2048); kf[2*j+1]=*(const __attribute__((address_space(3))) bf16x8*)(kp+j*2048+512); }
__device__ __forceinline__ s16x4 vtr(lds_cptr p){ return __builtin_bit_cast(s16x4,__builtin_amdgcn_ds_read_tr16_b64_v4i16((__attribute__((address_space(3))) v4i16_t*)p)); }
__device__ __forceinline__ float rowmax(const f32x16&p0,const f32x16&p1){
  float a=max3f(p0[0],p0[1],p1[0]),b=max3f(p0[2],p0[3],p1[1]);a=max3f(a,p1[2],p1[3]);
  #pragma unroll
  for(int r=4;r<16;r+=4){a=max3f(a,p0[r],p0[r+1]);b=max3f(b,p0[r+2],p0[r+3]);a=max3f(a,p1[r],p1[r+1]);b=max3f(b,p1[r+2],p1[r+3]);}
  const float m=max2f(a,b);
  auto rr=__builtin_amdgcn_permlane32_swap(__float_as_uint(m),__float_as_uint(m),false,false);
  return max2f(__uint_as_float(rr[0]),__uint_as_float(rr[1]));
}
__device__ __forceinline__ void pv(f32x16*o,int vb,bf16x8 pa0,bf16x8 pa1,bf16x8 pa2,bf16x8 pa3){
  #pragma unroll
  for(int d0=0;d0<2;++d0){s16x4 lo[4],hi[4];
    #pragma unroll
    for(int ks=0;ks<4;++ks){
      asm volatile("ds_read_b64_tr_b16 %0,%1 offset:%c2":"=&v"(lo[ks]):"v"(vb),"i"(d0*4096+ks*1024):"memory");
      asm volatile("ds_read_b64_tr_b16 %0,%1 offset:%c2":"=&v"(hi[ks]):"v"(vb),"i"(d0*4096+ks*1024+512):"memory");}
    asm volatile("s_waitcnt lgkmcnt(0)":::"memory");SBAR();
    #define PK(k) (bf16x8){lo[k][0],lo[k][1],lo[k][2],lo[k][3],hi[k][0],hi[k][1],hi[k][2],hi[k][3]}
    o[d0]=__builtin_amdgcn_mfma_f32_32x32x16_bf16(pa0,PK(0),o[d0],0,0,0);
    o[d0]=__builtin_amdgcn_mfma_f32_32x32x16_bf16(pa1,PK(1),o[d0],0,0,0);
    o[d0]=__builtin_amdgcn_mfma_f32_32x32x16_bf16(pa2,PK(2),o[d0],0,0,0);
    o[d0]=__builtin_amdgcn_mfma_f32_32x32x16_bf16(pa3,PK(3),o[d0],0,0,0);
    #undef PK
  }
}

#ifndef ATTN_STORE16
#define ATTN_STORE16(p,v) (*(u32x4*)(p)=(v))
#endif
template<int THRL> __device__ __forceinline__ void attn_unit(long q0,const bf16*Q,int qp,int qcol,const bf16*__restrict__ K,int kp,int kcol,const bf16*__restrict__ V,int vp,int vcol,long kv0,int NT,bf16*O,int op,int ocol,char*shm,const float*qgain,const float*T16){
  int tid_=threadIdx.x; asm volatile("":"+v"(tid_));
  const int tid=tid_,lane=tid&63,r32=lane&31,hi=lane>>5; const int wid=__builtin_amdgcn_readfirstlane(tid>>6);
#ifdef ATT_STATIC_PRIO
  if(wid>=4)__builtin_amdgcn_s_setprio(1);
#endif
  const bf16*Qw=Q+(q0+wid*QBLK)*qp+qcol;
  const bf16*Kh=K+kv0*kp+kcol,*Vh=V+kv0*vp+vcol;
  const unsigned lds0=(unsigned)(uintptr_t)shm;
  float*wsf=(float*)(shm+LDS_WS)+wid*64;
  const bf16*ksrc=Kh+(long)lane*kp+wid*8;
  const bf16*vsrc=Vh+(long)(16*(wid&3)+(lane>>2))*vp+(wid>>2)*32+(lane&3)*8;
  const unsigned kdst=lds0+LDS_K+wid*1024, vdst=lds0+LDS_V+wid*1024, kdst2=lds0+LDS_K+(8+wid)*1024;
  const bf16*ksrc2=Kh+(long)lane*kp+64+wid*8;
  const bool big=wid<4;
  #define DMA_K(t,slot) do{ glds16(ksrc+(long)(t)*KVBLK*kp,(unsigned)__builtin_amdgcn_readfirstlane(kdst+KOFF(slot))); if(big) glds16(ksrc2+(long)(t)*KVBLK*kp,(unsigned)__builtin_amdgcn_readfirstlane(kdst2+KOFF(slot))); }while(0)
  #define WAITKV() do{ if(big){WAIT_BAR(3);} else {WAIT_BAR(2);} }while(0)
  #define DMA_V(t,slot) glds16(vsrc+(long)(t)*KVBLK*vp,(unsigned)__builtin_amdgcn_readfirstlane(vdst+(slot)))
  const int vb0=(int)(lds0+LDS_V)+((lane>>4)&1)*32+(lane&3)*8+(4*hi+((lane&15)>>2))*64;
  const char*Kbase=shm+LDS_K; bf16x8 kf[12];
  const lds_cptr shm3=(lds_cptr)shm; const lds_cptr kp0=shm3+LDS_K+hi*1024+r32*16; const lds_cptr vp0=shm3+LDS_V+((lane>>4)&1)*32+(lane&3)*8+(4*hi+((lane&15)>>2))*64;
  DMA_K(0,0);DMA_V(0,0);DMA_K(1,SLOTB);
  bf16x8 qr[6];
  #pragma unroll
  for(int d0=0;d0<6;++d0)qr[d0]=*reinterpret_cast<const bf16x8*>(&Qw[(long)r32*qp+d0*16+hi*8]);
  {
    float f[6][8]; float ss=0.f;
    #pragma unroll
    for(int d0=0;d0<6;++d0)
      #pragma unroll
      for(int j=0;j<8;++j){ f[d0][j]=__uint_as_float(((unsigned)(unsigned short)qr[d0][j])<<16); ss+=f[d0][j]*f[d0][j]; }
    ss+=__shfl_xor(ss,32);
    const float rn=rsqrtf(ss*(1.f/96.f)+EPS)*C2_96;
    #pragma unroll
    for(int d0=0;d0<6;++d0)
      #pragma unroll
      for(int j=0;j<8;++j) f[d0][j]=f[d0][j]*rn*qgain[d0*16+hi*8+j];
    const int tq=(int)((q0+wid*QBLK+r32)%S); const int grow=tq/GW,gcol=tq%GW;
    #pragma unroll
    for(int part=0;part<2;++part){ const int pos=part?gcol:grow;
      #pragma unroll
      for(int j=0;j<8;++j){ const float cs=T16[pos*8+j],sn=T16[512+pos*8+j];
        const float mine=f[4+part][j],other=__shfl_xor(mine,32);
        f[4+part][j]=hi==0?(mine*cs-other*sn):(other*sn+mine*cs); } }
    #pragma unroll
    for(int d0=0;d0<6;++d0)
      #pragma unroll
      for(int j=0;j<4;++j){ const unsigned w=cvtpk_s(f[d0][2*j],f[d0][2*j+1]); qr[d0][2*j]=(short)(w&0xffff); qr[d0][2*j+1]=(short)(w>>16); }
  }
  float mhat=0.f,l_reg=0.f;f32x16 o[2];o[0]=f32x16{};o[1]=f32x16{};f32x16 negm=f32x16{};asm volatile("":"+v"(negm));
  #define CMASK(P0,P1,t) do{}while(0)
  bool resc=false;
  #define START(P0,P1) do{ const float rm=rowmax(P0,P1); resc=false; \
    { const float dl=rm; mhat=fadd_s(mhat,dl); \
      _Pragma("unroll") for(int r=0;r<16;++r){P0[r]=fsub_s(P0[r],dl);P1[r]=fsub_s(P1[r],dl);} \
      _Pragma("unroll") for(int r=0;r<16;++r)negm[r]=-mhat; asm volatile("":"+v"(negm)); } \
    _Pragma("unroll") for(int r=0;r<16;++r)P0[r]=__builtin_amdgcn_exp2f(P0[r]); }while(0)
  #define RESC() do{ if(resc){ asm volatile("s_waitcnt lgkmcnt(0)":::"memory"); \
      _Pragma("unroll") for(int d_=0;d_<2;++d_) _Pragma("unroll") for(int r=0;r<16;++r)o[d_][r]*=wsf[crow(r,hi)]; } }while(0)
  f32x16 pA0,pA1,pB0,pB1;
  int sl_prev=0,sl_cur=0,sl_next=SLOTB;
  #define ROT() do{sl_prev=sl_cur;sl_cur=sl_next;sl_next=(sl_next==(NSLOT-1)*SLOTB)?0:sl_next+SLOTB;}while(0)
  DMA_K(2,2*SLOTB);
  if(big){WAIT_BAR(5);}else{WAIT_BAR(3);}
  qkt(pA0,pA1,Kbase,qr,negm,r32,hi);asm volatile("s_nop 15\n\ts_nop 7":"+v"(pA0),"+v"(pA1));CMASK(pA0,pA1,0);
  START(pA0,pA1);
  _Pragma("unroll") for(int r=0;r<16;++r)pA1[r]=__builtin_amdgcn_exp2f(pA1[r]);
  WAIT_BAR(0);
  DMA_K(3,0);DMA_V(1,SLOTB);
  ROT();
  kload12(kf,kp0+KOFF(sl_cur));
  WAITKV();
  s16x4 vlo[8],vhi[8]; u32x4 pw0,pw1,pw2,pw3;
  #define PKW(P,B) cvtpk_s(P[B],P[B+1])
  #define PAF(k) __builtin_bit_cast(bf16x8,pw##k)
  #define VFR(i) (bf16x8){vlo[i][0],vlo[i][1],vlo[i][2],vlo[i][3],vhi[i][0],vhi[i][1],vhi[i][2],vhi[i][3]}
  #define PIN(x) asm volatile("":"+v"(x))
  #define MX3(a,b,c) __builtin_fmaxf(__builtin_fmaxf((a),(b)),(c))
  #define GAPA(MF,A0,A1,A2,A3,W0,W1,PW) do{ MF; sacc+=A0; sacc+=A1; sacc+=A2; sacc+=A3; PIN(sacc); W0; W1; PIN(PW); SBAR(); }while(0)
  #define EX(v) __builtin_amdgcn_exp2f(v)
  #define GAPB(MF,X,B) do{ MF; X[B]=EX(X[B]); X[B+1]=EX(X[B+1]); X[B+2]=EX(X[B+2]); X[B+3]=EX(X[B+3]); PIN(X); SBAR(); }while(0)
  #define VRD(i) do{ vlo[i]=vtr(vp_+(((i)>>2)*4096+((i)&3)*1024)); vhi[i]=vtr(vp_+(((i)>>2)*4096+((i)&3)*1024+512)); }while(0)
  #define KRD(G,j) do{ if(G){ kload2(kf,kp0+KOFF(sl_next),j); SBAR(); } }while(0)
  #define STEP(C0,C1,P0,P1,t,GK,GV,GL) do{ SBAR(); \
    const lds_cptr vp_=vp0+sl_prev; \
    VRD(0); SBAR(); float sacc=(P0[0]+P0[1]); \
    GAPA(C0=__builtin_amdgcn_mfma_f32_32x32x16_bf16(kf[0],qr[0],negm,0,0,0), P0[2],P0[3],P0[4],P0[5],     pw0[0]=PKW(P0,0), pw0[1]=PKW(P0,2), pw0); \
    VRD(4); SBAR(); GAPA(C1=__builtin_amdgcn_mfma_f32_32x32x16_bf16(kf[1],qr[0],negm,0,0,0), P0[6],P0[7],P0[8],P0[9],     pw0[2]=PKW(P0,4), pw0[3]=PKW(P0,6), pw0); \
    VRD(1); SBAR(); GAPA(C0=__builtin_amdgcn_mfma_f32_32x32x16_bf16(kf[2],qr[1],C0,0,0,0),   P0[10],P0[11],P0[12],P0[13], pw1[0]=PKW(P0,8), pw1[1]=PKW(P0,10), pw1); \
    VRD(5); SBAR(); GAPA(C1=__builtin_amdgcn_mfma_f32_32x32x16_bf16(kf[3],qr[1],C1,0,0,0),   P0[14],P0[15],P1[0],P1[1],   pw1[2]=PKW(P0,12),pw1[3]=PKW(P0,14), pw1); \
    VRD(2); SBAR(); GAPA(C0=__builtin_amdgcn_mfma_f32_32x32x16_bf16(kf[4],qr[2],C0,0,0,0),   P1[2],P1[3],P1[4],P1[5],     pw2[0]=PKW(P1,0), pw2[1]=PKW(P1,2), pw2); \
    VRD(6); SBAR(); GAPA(C1=__builtin_amdgcn_mfma_f32_32x32x16_bf16(kf[5],qr[2],C1,0,0,0),   P1[6],P1[7],P1[8],P1[9],     pw2[2]=PKW(P1,4), pw2[3]=PKW(P1,6), pw2); \
    VRD(3); SBAR(); GAPA(C0=__builtin_amdgcn_mfma_f32_32x32x16_bf16(kf[6],qr[3],C0,0,0,0),   P1[10],P1[11],P1[12],P1[13], pw3[0]=PKW(P1,8), pw3[1]=PKW(P1,10), pw3); \
    VRD(7); SBAR(); GAPA(C1=__builtin_amdgcn_mfma_f32_32x32x16_bf16(kf[7],qr[3],C1,0,0,0),   P1[14],P1[15],0.f,0.f,       pw3[2]=PKW(P1,12),pw3[3]=PKW(P1,14), pw3); \
    C0=__builtin_amdgcn_mfma_f32_32x32x16_bf16(kf[8],qr[4],C0,0,0,0); SBAR(); C1=__builtin_amdgcn_mfma_f32_32x32x16_bf16(kf[9],qr[4],C1,0,0,0); SBAR(); \
    C0=__builtin_amdgcn_mfma_f32_32x32x16_bf16(kf[10],qr[5],C0,0,0,0); SBAR(); C1=__builtin_amdgcn_mfma_f32_32x32x16_bf16(kf[11],qr[5],C1,0,0,0); SBAR(); \
    l_reg+=sacc; \
    if(GK){DMA_K((t)+3,sl_cur);} if(GV){DMA_V((t)+1,sl_next);} \
    CMASK(C0,C1,t); \
    { float a=MX3(C0[0],C0[1],C1[0]),b=MX3(C0[2],C0[3],C1[1]); a=MX3(a,C1[2],C1[3]); \
      _Pragma("unroll") for(int r=4;r<16;r+=4){a=MX3(a,C0[r],C0[r+1]);b=MX3(b,C0[r+2],C0[r+3]);a=MX3(a,C1[r],C1[r+1]);b=MX3(b,C1[r+2],C1[r+3]);} \
      float rm=__builtin_fmaxf(a,b); { auto rr=__builtin_amdgcn_permlane32_swap(__float_as_uint(rm),__float_as_uint(rm),false,false); rm=__builtin_fmaxf(__uint_as_float(rr[0]),__uint_as_float(rr[1])); } \
      resc=false; \
      if(__builtin_expect(__any(rm>(float)THRL),0)){ const float dl=__builtin_fmaxf(rm,0.f); mhat+=dl; \
        _Pragma("unroll") for(int r=0;r<16;++r){C0[r]-=dl;C1[r]-=dl;} \
        _Pragma("unroll") for(int r=0;r<16;++r)negm[r]=-mhat; asm volatile("":"+v"(negm)); \
        const float f=__builtin_amdgcn_exp2f(-dl); l_reg*=f; if(hi==0)wsf[r32]=f; resc=true; } } \
    SBAR(); \
    GAPB(o[0]=__builtin_amdgcn_mfma_f32_32x32x16_bf16(PAF(0),VFR(0),o[0],0,0,0), C0,0); \
    KRD(GL,0); GAPB(o[1]=__builtin_amdgcn_mfma_f32_32x32x16_bf16(PAF(0),VFR(4),o[1],0,0,0), C0,4); \
    KRD(GL,1); GAPB(o[0]=__builtin_amdgcn_mfma_f32_32x32x16_bf16(PAF(1),VFR(1),o[0],0,0,0), C0,8); \
    KRD(GL,2); GAPB(o[1]=__builtin_amdgcn_mfma_f32_32x32x16_bf16(PAF(1),VFR(5),o[1],0,0,0), C0,12); \
    KRD(GL,3); GAPB(o[0]=__builtin_amdgcn_mfma_f32_32x32x16_bf16(PAF(2),VFR(2),o[0],0,0,0), C1,0); \
    KRD(GL,4); GAPB(o[1]=__builtin_amdgcn_mfma_f32_32x32x16_bf16(PAF(2),VFR(6),o[1],0,0,0), C1,4); \
    KRD(GL,5); GAPB(o[0]=__builtin_amdgcn_mfma_f32_32x32x16_bf16(PAF(3),VFR(3),o[0],0,0,0), C1,8); \
    GAPB(o[1]=__builtin_amdgcn_mfma_f32_32x32x16_bf16(PAF(3),VFR(7),o[1],0,0,0), C1,12); \
    }while(0)
  int t=1;
  #undef CMASK
  #define CMASK(P0,P1,t) do{}while(0)
  for(;t+5<NT;t+=2){
    STEP(pB0,pB1,pA0,pA1,t,true,true,true);     WAITKV(); RESC(); ROT();
    STEP(pA0,pA1,pB0,pB1,t+1,true,true,true);   WAITKV(); RESC(); ROT();
  }
  #undef CMASK
  #define CMASK(P0,P1,t) do{}while(0)
  #define ENDW(tt) do{ if((tt)+3<NT){WAITKV();} else if((tt)+2<NT){WAIT_BAR(1);} else {WAIT_BAR(0);} }while(0)
  for(;t+1<NT;t+=2){
    STEP(pB0,pB1,pA0,pA1,t,(t+3<NT),(t+1<NT),(t+1<NT));       ENDW(t);   RESC(); ROT();
    STEP(pA0,pA1,pB0,pB1,t+1,(t+4<NT),(t+2<NT),(t+2<NT));     ENDW(t+1); RESC(); ROT();
  }
  STEP(pB0,pB1,pA0,pA1,NT-1,false,false,false); RESC();
  { float sacc=pB0[0]+pB0[1]; _Pragma("unroll") for(int r=2;r<16;++r)sacc+=pB0[r]; _Pragma("unroll") for(int r=0;r<16;++r)sacc+=pB1[r]; l_reg+=sacc;
    pw0=(u32x4){PKW(pB0,0),PKW(pB0,2),PKW(pB0,4),PKW(pB0,6)};pw1=(u32x4){PKW(pB0,8),PKW(pB0,10),PKW(pB0,12),PKW(pB0,14)};pw2=(u32x4){PKW(pB1,0),PKW(pB1,2),PKW(pB1,4),PKW(pB1,6)};pw3=(u32x4){PKW(pB1,8),PKW(pB1,10),PKW(pB1,12),PKW(pB1,14)};
    SBAR(); pv(o,vb0+sl_cur,PAF(0),PAF(1),PAF(2),PAF(3)); }
  #undef PKW
  #undef PAF
  #undef VFR
  #undef PIN
  #undef MX3
  #undef GAPA
  #undef GAPB
  #undef EX
  #undef VRD
  #undef KRD
  #undef STEP
  #undef ENDW
  {auto rr=__builtin_amdgcn_permlane32_swap(__float_as_uint(l_reg),__float_as_uint(l_reg),false,false);l_reg=__uint_as_float(rr[0])+__uint_as_float(rr[1]);}
  if(hi==0)wsf[32+r32]=l_reg;asm volatile("s_waitcnt lgkmcnt(0)":::"memory");
  float rli[16];
  #pragma unroll
  for(int r=0;r<16;++r)rli[r]=__builtin_amdgcn_rcpf(wsf[32+crow(r,hi)]);
  bf16*Ow=O+(q0+wid*QBLK)*op+ocol;
  { bf16*stg=(bf16*)(shm+LDS_OST)+wid*2048;
    #pragma unroll
    for(int r=0;r<16;++r){const int orow=crow(r,hi);
      #pragma unroll
      for(int d0=0;d0<2;++d0)stg[orow*64+d0*32+r32]=__float2bfloat16(o[d0][r]*rli[r]);}
    asm volatile("s_waitcnt lgkmcnt(0)":::"memory");
    #pragma unroll
    for(int i=0;i<4;++i){const int row=i*8+(lane>>3),ch=lane&7; const u32x4 v=*(const u32x4*)(stg+row*64+ch*8); ATTN_STORE16(Ow+(long)row*op+ch*8,v);} }
#ifdef ATT_STATIC_PRIO
  __builtin_amdgcn_s_setprio(0);
#endif
  asm volatile("s_waitcnt lgkmcnt(0)\n\ts_barrier":::"memory");
  #undef DMA_K
  #undef WAITKV
  #undef DMA_V
  #undef CMASK
  #undef START
  #undef RESC
  #undef ROT
}
constexpr int ATTN_LDS_BYTES=LDS_BYTES;

#undef SBAR
#undef WAIT_BAR
#undef KOFF
}
#define LAS __attribute__((address_space(3)))
#define XB_TMO      128
#define XB_XCNT(j)  (256  + 64 * (j))
#define XB_XSUB(j)  (1280 + 64 * (j))
#define XB_XGEN(j)  (2304 + 64 * (j))
#define XB_TOP      3328
#define XB_TOPGEN   3392
#define XCD_BAR_WORDS 3456
#define XB_ADA0     3584
#define XB_CTXH     3520
#define XB_SPIN_CAP (1u << 18)

__device__ __forceinline__ unsigned xb_ld(unsigned* p)              { return __hip_atomic_load(p, __ATOMIC_RELAXED, __HIP_MEMORY_SCOPE_AGENT); }
__device__ __forceinline__ unsigned xb_add(unsigned* p, unsigned v) { return __hip_atomic_fetch_add(p, v, __ATOMIC_RELAXED, __HIP_MEMORY_SCOPE_AGENT); }
__device__ __forceinline__ unsigned xb_xcc_id() { return (unsigned)__builtin_amdgcn_s_getreg((3 << 11) | 20) & 0xFu; }
#define XB_SPIN(cond, bar) do { unsigned _sp = 0; while (cond) { __builtin_amdgcn_s_sleep(1); \
    if ((++_sp & 255u) == 0u) { if (xb_ld(&(bar)[XB_TMO])) break; if (_sp > XB_SPIN_CAP) { atomicAdd(&(bar)[XB_TMO], 1u); break; } } } } while (0)

struct XcdBarrier {
    unsigned* bar; unsigned x;
    volatile LAS unsigned* st;
};

__device__ __forceinline__ XcdBarrier xcd_barrier_post(unsigned* bar, volatile LAS unsigned* st) {
    XcdBarrier b; b.bar = bar; b.x = xb_xcc_id(); b.st = st;
    if (threadIdx.x == 0) (void)xb_add(&bar[XB_XCNT(b.x)], 1u);
    return b;
}
__device__ __forceinline__ void xcd_barrier_complete(unsigned* bar, unsigned x, unsigned& nloc, unsigned& nx) {
    const unsigned G = gridDim.x * gridDim.y * gridDim.z;
    unsigned sum, cnt, mine, sp = 0u;
    for (;;) {
        sum = 0u; cnt = 0u; mine = 0u;
#pragma unroll
        for (unsigned j = 0; j < 16; ++j) { const unsigned c = xb_ld(&bar[XB_XCNT(j)]); sum += c; cnt += (c > 0u) ? 1u : 0u; mine = (j == x) ? c : mine; }
        if (sum == G) break;
        __builtin_amdgcn_s_sleep(1);
        if ((++sp & 255u) == 0u) { if (xb_ld(&bar[XB_TMO])) break; if (sp > XB_SPIN_CAP) { atomicAdd(&bar[XB_TMO], 1u); break; } }
    }
    nloc = mine > 0u ? mine : 1u; nx = cnt > 0u ? cnt : 1u;
}

__device__ __forceinline__ void xcd_barrier(const XcdBarrier& b) {
    asm volatile("s_waitcnt vmcnt(0)" ::: "memory");
    __syncthreads();
    if (threadIdx.x == 0) {
        unsigned* bar = b.bar;
        __builtin_amdgcn_s_waitcnt(0);
        unsigned nloc = b.st[0], nx = b.st[1];
        if (nloc == 0u) { xcd_barrier_complete(bar, b.x, nloc, nx); b.st[0] = nloc; b.st[1] = nx; }
        const unsigned old = xb_add(&bar[XB_XSUB(b.x)], 1u);
        const unsigned gen = old / nloc;
        if (old + 1u == (gen + 1u) * nloc) {
            __builtin_amdgcn_fence(__ATOMIC_RELEASE, "agent");
            asm volatile("s_waitcnt vmcnt(0)" ::: "memory");
            const unsigned og = xb_add(&bar[XB_TOP], 1u);
            const unsigned tg = og / nx;
            if (og + 1u == (tg + 1u) * nx) xb_add(&bar[XB_TOPGEN], 1u);
            else XB_SPIN(xb_ld(&bar[XB_TOPGEN]) == tg, bar);
            __builtin_amdgcn_fence(__ATOMIC_ACQUIRE, "agent");
            xb_add(&bar[XB_XGEN(b.x)], 1u);
            asm volatile("s_waitcnt vmcnt(0)" ::: "memory");
        } else {
            XB_SPIN(xb_ld(&bar[XB_XGEN(b.x)]) == gen, bar);
            __builtin_amdgcn_fence(__ATOMIC_ACQUIRE, "agent");
            asm volatile("s_waitcnt vmcnt(0)" ::: "memory");
        }
    }
    __syncthreads();
}
namespace mk {
#ifndef KVROT
#define KVROT 0
#endif
#ifndef ALIGN2
#define ALIGN2 true
#endif
#ifndef ALIGN1
#define ALIGN1 true
#endif
#define MLAS __attribute__((address_space(3)))
constexpr int NWAVES = 8, NTHR = 512;
constexpr int RING_BYTES = 131072;
constexpr int LDS_BYTES = 147456;
constexpr int NPHASE = 16;
typedef unsigned v4u __attribute__((ext_vector_type(4)));
typedef float f32x4 __attribute__((ext_vector_type(4)));

struct Ctx {
    Params p; MLAS unsigned char* lds; char* lds_g; int wave, G, vcu, bid;
};
__device__ __forceinline__ int tid_now() { int t = threadIdx.x; asm volatile("" : "+v"(t)); return t; }
__device__ __forceinline__ unsigned pk2(float lo, float hi) { return (unsigned)f2bf(lo) | ((unsigned)f2bf(hi) << 16); }

enum { W_IN0 = 0, W_OUT0, W_GU0, W_D0, W_IN1, W_UQ, W_UKV, W_OUT1, W_GU1, W_D1, NWMAT };
struct SrcBlk { const float* W; int ld; int col; const float* kscale; };
__device__ __forceinline__ SrcBlk src_of(const Params& p, int mat, int nb) {
    SrcBlk s; s.kscale = nullptr; const int pn = nb >> 3, q = nb & 7, bj = q >> 2, wc = q & 3;
    switch (mat) {
    case W_IN0: s.W = p.in[I0_WIN]; s.ld = L0_IN; s.col = 256 * pn + 64 * wc + 32 * bj; break;
    case W_OUT0: s.W = p.in[I0_WOUT]; s.ld = D; s.col = 32 * nb; break;
    case W_GU0: s.W = bj ? p.in[I0_WU] : p.in[I0_WG]; s.ld = FF; s.col = 128 * pn + 32 * wc; break;
    case W_D0: s.W = p.in[I0_WD]; s.ld = D; s.col = 32 * nb; break;
    case W_IN1: s.W = p.in[I1_WIN]; s.ld = L1_IN;
        if (pn == 0) s.col = 128 * bj + 32 * wc;
        else if (pn == 1) { if (bj == 0) s.col = 256 + 32 * wc; else s.col = 640; }
        else if (pn == 2) s.col = 384 + 128 * bj + 32 * wc;
        else if (pn < 5) s.col = 672 + (pn - 3) * 256 + 64 * wc + 32 * bj;
        else if (pn < 7) s.col = 1184 + (pn - 5) * 256 + 64 * wc + 32 * bj;
        else s.col = 1696 + (pn - 7) * 256 + 64 * wc + 32 * bj;
        break;
    case W_UQ: s.W = p.in[I1_WUQ]; s.ld = 768; s.col = 32 * nb; s.kscale = p.in[I1_QAG]; break;
    case W_UKV: s.W = p.in[I1_WUKV]; s.ld = 1024; s.col = (2 * pn + (wc >> 1)) * 128 + (wc & 1) * 64 + 32 * bj; s.kscale = p.in[I1_KVAG]; break;
    case W_OUT1: s.W = p.in[I1_WOUT]; s.ld = D; s.col = 32 * nb; break;
    case W_GU1: s.W = bj ? p.in[I1_WU] : p.in[I1_WG]; s.ld = FF; s.col = 128 * pn + 32 * wc; break;
    default: s.W = p.in[I1_WD]; s.ld = D; s.col = 32 * nb; break;
    }
    return s;
}
struct WMat { size_t ws_off; int K, N; };
__host__ __device__ constexpr WMat wmat(int mat) {
    switch (mat) {
    case W_IN0: return {WS_W_IN0, D, 1536}; case W_OUT0: return {WS_W_OUT0, D, D}; case W_GU0: return {WS_W_GU0, D, 2 * FF}; case W_D0: return {WS_W_D0, FF, D};
    case W_IN1: return {WS_W_IN1, D, L1_INP}; case W_UQ: return {WS_W_UQ, 384, 768}; case W_UKV: return {WS_W_UKV, 256, 1024}; case W_OUT1: return {WS_W_OUT1, D, D};
    case W_GU1: return {WS_W_GU1, D, 2 * FF}; default: return {WS_W_D1, FF, D};
    }
}
template <int mat> __device__ __forceinline__ void transpose_item(const Params& p, int item, MLAS float* scr, int lane) {
    const WMat wm = wmat(mat); const int nblk = wm.N / 32, kb = item / nblk, nb = item % nblk, k0 = 64 * kb;
    const SrcBlk s = src_of(p, mat, nb);
    bf16_t* WT = (bf16_t*)(p.ws + wm.ws_off);
    const int c = lane & 7;
    if (s.W == nullptr) {
#pragma unroll
        for (int j = 0; j < 4; ++j) { const int n = (lane >> 3) + 8 * j; *(v4u*)(WT + (size_t)(32 * nb + n) * wm.K + k0 + 8 * c) = (v4u){0u, 0u, 0u, 0u}; }
        return;
    }
    MLAS float* t0 = scr; MLAS float* t1 = scr + 64 * 33;
    if (mat == W_OUT0 && kb < 4) return;
    constexpr bool fused_pool = false;
    { const int c4 = (lane & 7) * 4, kr = lane >> 3;
        const float* wsrc = s.W + (size_t)(k0 + kr) * s.ld + s.col + c4;
        f32x4 v[8];
#pragma unroll
        for (int i = 0; i < 8; ++i) v[i] = *(const f32x4*)(wsrc + (size_t)(8 * i) * s.ld);
#pragma unroll
        for (int i = 0; i < 8; ++i) { const int kk = kr + 8 * i; float sc = 1.f;
            if (s.kscale) sc = s.kscale[k0 + kk];
            if (fused_pool) sc *= p.in[I0_POOLS][k0 + kk];
            MLAS float* d = t0 + kk * 33 + c4; d[0] = v[i][0] * sc; d[1] = v[i][1] * sc; d[2] = v[i][2] * sc; d[3] = v[i][3] * sc; } }
    asm volatile("s_waitcnt lgkmcnt(0)" ::: "memory");
    MLAS float* src = t0;
    if (fused_pool) {
        const float* pw = p.in[I0_POOLW] + kb * 4096; const int nn = lane & 31, ch = lane >> 5;
        for (int cc = ch; cc < 64; cc += 2) { float a = 0.f;
#pragma unroll 8
            for (int d = 0; d < 64; ++d) a += pw[cc * 64 + d] * t0[d * 33 + nn];
            t1[cc * 33 + nn] = a; }
        asm volatile("s_waitcnt lgkmcnt(0)" ::: "memory");
        src = t1;
    }
#pragma unroll
    for (int j = 0; j < 4; ++j) { const int n = (lane >> 3) + 8 * j; const MLAS float* sp = src + (8 * c) * 33 + n;
        v4u o; o.x = pk2(sp[0 * 33], sp[1 * 33]); o.y = pk2(sp[2 * 33], sp[3 * 33]); o.z = pk2(sp[4 * 33], sp[5 * 33]); o.w = pk2(sp[6 * 33], sp[7 * 33]);
        *(v4u*)(WT + (size_t)(32 * nb + n) * wm.K + k0 + 8 * c) = o; }
    asm volatile("s_waitcnt lgkmcnt(0)" ::: "memory");
}

#ifndef P0MASK
#define P0MASK 15
#endif
template <int PART> __device__ __forceinline__ void phase_prologue(Ctx& C, int vcu, int G) {
    const Params& p = C.p; const int tid = tid_now(), lane = tid & 63;
    MLAS float* sil = (MLAS float*)C.lds;
    MLAS float* red = (MLAS float*)(C.lds + 9 * 1024 * 4);
    __syncthreads();
#ifdef ADA_SPLIT
    if (PART <= 2)
#else
    if (PART < 2)
#endif
    for (int i = tid; i < 9 * D; i += NTHR) { const int j = i / D, k = i % D; const float c = (j < 8) ? p.in[I_C][j * D + k] : p.in[I_CCTX][k]; sil[i] = c / (1.f + expf(-c)); }
    __syncthreads();
    float* MOD = (float*)(p.ws + WS_MOD);
#ifdef ADA_SPLIT
    constexpr int ADA_N = (PART == 0) ? 32 : (PART == 2) ? 64 : 96, ADA_BASE = (PART == 0) ? 0 : (PART == 2) ? 32 : 96;
    if ((P0MASK & 1) && PART <= 2)
    for (int it0 = vcu; it0 < ADA_N; it0 += G) { const int it = it0 + ADA_BASE;
#else
    if ((P0MASK & 1) && PART < 2)
    for (int it0 = vcu; it0 < 96; it0 += G) { const int it = it0 + 96 * PART;
#endif
        const int l = it / 96, r_ = it % 96, cg_ = r_ >> 2, kq = r_ & 3, n0 = cg_ * 256;
        const float* w = (l ? p.in[I1_ADAW] : p.in[I0_ADAW]) + (size_t)(kq * 256 + C.wave * 32) * 6144 + n0 + 4 * lane;
        f32x4 acc[9];
#pragma unroll
        for (int j = 0; j < 9; ++j) acc[j] = (f32x4){0.f, 0.f, 0.f, 0.f};
#pragma unroll 8
        for (int k = 0; k < 32; ++k) { const f32x4 wv = *(const f32x4*)(w + (size_t)k * 6144); const int kk = kq * 256 + C.wave * 32 + k;
#pragma unroll
            for (int j = 0; j < 9; ++j) acc[j] += wv * sil[j * D + kk]; }
#pragma unroll
        for (int j = 0; j < 9; ++j) *(MLAS f32x4*)(red + (C.wave * 9 + j) * 256 + 4 * lane) = acc[j];
        __syncthreads();
        for (int i = tid; i < 9 * 256; i += NTHR) { const int j = i >> 8, c = i & 255; float sm_ = 0.f;
#pragma unroll
            for (int wv = 0; wv < 8; ++wv) sm_ += red[(wv * 9 + j) * 256 + c];
            if (kq == 0) sm_ += (l ? p.in[I1_ADAB] : p.in[I0_ADAB])[n0 + c];
            atomicAdd(MOD + (size_t)(l * 9 + j) * 6144 + n0 + c, sm_); }
        __syncthreads();
    }
#ifdef MERGE01
    if (PART == 0) { asm volatile("s_waitcnt vmcnt(0)" ::: "memory"); __syncthreads();
        if (threadIdx.x == 0) { int n = 0; for (int it0 = vcu; it0 < 32; it0 += G) ++n; if (n) xb_add((unsigned*)(p.ws + WS_BARRIER) + XB_ADA0, (unsigned)n); } }
#endif
    __syncthreads();
    {
        MLAS float* PA = (MLAS float*)C.lds;
        MLAS float* PB = (MLAS float*)(C.lds + 64 * 65 * 4);
        bf16_t* WT = (bf16_t*)(p.ws + WS_W_OUT0);
#ifdef L0_SPLIT
        constexpr int POOL_PART = 2;
#else
        constexpr int POOL_PART = 0;
#endif
        if (PART == POOL_PART) for (int tile = vcu; tile < 128; tile += G) {
            const int g = tile >> 5, nb = tile & 31;
            for (int i = tid; i < 4096; i += NTHR) PA[(i >> 6) * 65 + (i & 63)] = p.in[I0_POOLW][g * 4096 + i];
            for (int i = tid; i < 2048; i += NTHR) { const int d = i >> 5, nn = i & 31; PB[d * 33 + nn] = p.in[I0_WOUT][(size_t)(g * 64 + d) * D + 32 * nb + nn] * p.in[I0_POOLS][g * 64 + d]; }
            __syncthreads();
            { const int c = tid >> 3, n4 = (tid & 7) * 4; float a0 = 0.f, a1 = 0.f, a2 = 0.f, a3 = 0.f;
#pragma unroll 8
                for (int d = 0; d < 64; ++d) { const float pa = PA[c * 65 + d]; const MLAS float* b = PB + d * 33 + n4; a0 += pa * b[0]; a1 += pa * b[1]; a2 += pa * b[2]; a3 += pa * b[3]; }
                bf16_t* o = WT + (size_t)(32 * nb + n4) * D + g * 64 + c;
                o[0] = f2bf(a0); o[D] = f2bf(a1); o[2 * D] = f2bf(a2); o[3 * D] = f2bf(a3); }
            __syncthreads();
        }
    }
    const int gw = vcu * NWAVES + C.wave, NGW = G * NWAVES;
    MLAS float* scr = (MLAS float*)(C.lds + C.wave * 16896);
    if (P0MASK & 2) {
#ifdef MERGE01
        int rot = (PART == 0 && NGW > 96 * NWAVES) ? 96 * NWAVES : 0;
#else
        int rot = 0;
#endif
#define TR_MAT(M) { constexpr int ni = (wmat(M).K / 64) * (wmat(M).N / 32); int first = gw - rot; if (first < 0) first += NGW; \
            for (int it = first; it < ni; it += NGW) transpose_item<M>(p, it, scr, lane); rot = (rot + ni) % NGW; }
        if (PART == 0) { TR_MAT(W_IN0)
#ifndef L0_SPLIT
            TR_MAT(W_OUT0) TR_MAT(W_GU0) TR_MAT(W_D0)
#endif
        }
        else if (PART == 2) { TR_MAT(W_OUT0) TR_MAT(W_GU0)
#if !defined(D0_IN_P6) && !defined(CTXD_IN_P6)
            TR_MAT(W_D0)
#endif
        }
        else if (PART == 3) { TR_MAT(W_D0) }
        else if (PART == 1) { TR_MAT(W_IN1) TR_MAT(W_UQ) TR_MAT(W_UKV)
#ifndef CTXD_IN_P6
            TR_MAT(W_OUT1) TR_MAT(W_GU1) TR_MAT(W_D1)
#endif
        }
        else if (PART == 4) { TR_MAT(W_OUT1) TR_MAT(W_GU1) TR_MAT(W_D1) }
#undef TR_MAT
    }
    if (PART == 0 && (P0MASK & 4) && C.bid == C.G - 1) {
        float* T32 = (float*)(p.ws + WS_ROPE32); float* T16 = (float*)(p.ws + WS_ROPE16);
        for (int i = tid; i < 1024; i += NTHR) { const int pos = i >> 4, f = i & 15; const float ang = (float)pos * powf(10000.0f, -((float)f * 2.0f) / 32.0f); T32[i] = cosf(ang); T32[1024 + i] = sinf(ang); }
        for (int i = tid; i < 512; i += NTHR) { const int pos = i >> 3, f = i & 7; const float ang = (float)pos * powf(10000.0f, -((float)f * 2.0f) / 16.0f); T16[i] = cosf(ang); T16[512 + i] = sinf(ang); }
    }
    if (PART == 0 && (P0MASK & 8)) { float* SSQ = (float*)(p.ws + WS_SSQ); float* SSKV = (float*)(p.ws + WS_SSKV);
        for (int i = C.bid * NTHR + tid; i < MT; i += C.G * NTHR) { SSQ[i] = 0.f; SSKV[i] = 0.f; }
#ifdef FOLD_N13
        { float* SSN1 = (float*)(p.ws + WS_SSN1); for (int i = C.bid * NTHR + tid; i < ML; i += C.G * NTHR) SSN1[i] = 0.f; }
#endif
    }
}

template <class TL> __device__ __forceinline__ void phase_norm(Ctx& C, const TL* xl, const float* xc, const float* gain, int layer, int sh_chunk, int sc_chunk, int nrows, const float* slab = nullptr, int nslab = 0, float* xc_wb = nullptr) {
    const int lane = tid_now() & 63;
    const int gw = C.vcu * NWAVES + C.wave, NGW = C.G * NWAVES;
    bf16_t* XN = (bf16_t*)(C.p.ws + WS_XN); const float* MODb = (const float*)(C.p.ws + WS_MOD) + (size_t)layer * 9 * 6144;
    for (int m = gw; m < nrows; m += NGW) {
        const float* mod = MODb + (size_t)modidx_of(m) * 6144;
        f32x4 v[4]; float ss = 0.f;
#pragma unroll
        for (int j = 0; j < 4; ++j) { v[j] = m < ML ? epi::ld4(xl + (size_t)m * D + 4 * lane + 256 * j) : *(const f32x4*)(xc + (size_t)(m - ML) * D + 4 * lane + 256 * j);
            if (m >= ML && nslab > 0) { for (int s_ = 0; s_ < nslab; ++s_) v[j] += *(const f32x4*)(slab + (size_t)s_ * MC * D + (size_t)(m - ML) * D + 4 * lane + 256 * j);
                if (xc_wb) *(f32x4*)(xc_wb + (size_t)(m - ML) * D + 4 * lane + 256 * j) = v[j]; }
            ss += (v[j][0] * v[j][0] + v[j][1] * v[j][1]) + (v[j][2] * v[j][2] + v[j][3] * v[j][3]); }
        ss = wave_sum(ss);
        const float r = rsqrtf(ss * (1.f / D) + EPS);
#pragma unroll
        for (int j = 0; j < 4; ++j) { const int c = 4 * lane + 256 * j;
            const f32x4 g = *(const f32x4*)(gain + c), sc = *(const f32x4*)(mod + sc_chunk * D + c), sh = *(const f32x4*)(mod + sh_chunk * D + c);
            const f32x4 y = ((v[j] * r) * g) * (sc + 1.f) + sh;
            uint2 o; o.x = pk2(y[0], y[1]); o.y = pk2(y[2], y[3]);
            *(uint2*)(XN + (size_t)m * D + c) = o; }
    }
}

__device__ __forceinline__ void phase_bias(Ctx& C, int vcu, int Gn, const bf16_t* Wt, int npos, const float* shift  , int nb, float* bias) {
    const int tid = tid_now(), lane = tid & 63;
    MLAS float* sh = (MLAS float*)C.lds;
    __syncthreads();
    for (int i = tid; i < nb * D; i += NTHR) sh[i] = shift[(size_t)(i / D) * 6144 + (i % D)];
    __syncthreads();
    const int gw = vcu * NWAVES + C.wave, NGW = Gn * NWAVES;
    for (int pos = gw; pos < npos; pos += NGW) {
        const v4u w0 = *(const v4u*)(Wt + (size_t)pos * D + 16 * lane), w1 = *(const v4u*)(Wt + (size_t)pos * D + 16 * lane + 8);
        float wf[16];
#pragma unroll
        for (int e = 0; e < 4; ++e) { wf[2 * e] = __uint_as_float(w0[e] << 16); wf[2 * e + 1] = __uint_as_float(w0[e] & 0xffff0000u); wf[8 + 2 * e] = __uint_as_float(w1[e] << 16); wf[8 + 2 * e + 1] = __uint_as_float(w1[e] & 0xffff0000u); }
        float mine = 0.f;
        for (int b = 0; b < nb; ++b) { float s = 0.f;
#pragma unroll
            for (int q = 0; q < 4; ++q) { const f32x4 sv = *(const MLAS f32x4*)(sh + b * D + 16 * lane + 4 * q); s += (wf[4 * q] * sv[0] + wf[4 * q + 1] * sv[1]) + (wf[4 * q + 2] * sv[2] + wf[4 * q + 3] * sv[3]); }
            s = wave_sum(s); if (lane == b) mine = s; }
        if (lane < nb) bias[(size_t)lane * npos + pos] = mine;
    }
}

__device__ __forceinline__ void phase_pool(Ctx& C) {
    const bf16_t* A0 = (const bf16_t*)(C.p.ws + WS_A0); bf16_t* MIX = (bf16_t*)(C.p.ws + WS_MIX);
    const int skip = (C.G > 128) ? 96 : 0;
    if (C.vcu < skip) return;
    const int gt = (C.vcu - skip) * NTHR + tid_now(), NGT = (C.G - skip) * NTHR;
    for (int it = gt; it < MT * 32; it += NGT) {
        const int m = it >> 5, c8 = (it & 31) * 8, g = c8 >> 6, w = 2 << g;
        int t, T; if (m < ML) { t = m % S; T = S; } else { t = (m - ML) % CTX; T = CTX; }
        const int base = m - t; int lo = t - w / 2; if (lo < 0) lo = 0; int hi = t - w / 2 + w; if (hi > T) hi = T;
        float s[8];
#pragma unroll
        for (int e = 0; e < 8; ++e) s[e] = 0.f;
        for (int j = lo; j < hi; ++j) { const v4u q = *(const v4u*)(A0 + (size_t)(base + j) * 256 + c8);
#pragma unroll
            for (int e = 0; e < 4; ++e) { s[2 * e] += __uint_as_float(q[e] << 16); s[2 * e + 1] += __uint_as_float(q[e] & 0xffff0000u); } }
        const v4u q = *(const v4u*)(A0 + (size_t)m * 256 + c8); const float inv = 1.f / (float)(hi - lo);
        v4u o;
#pragma unroll
        for (int e = 0; e < 4; ++e) o[e] = pk2(s[2 * e] * inv - __uint_as_float(q[e] << 16), s[2 * e + 1] * inv - __uint_as_float(q[e] & 0xffff0000u));
        *(v4u*)(MIX + (size_t)m * D + c8) = o;
    }
}


__device__ __forceinline__ void phase_natable(Ctx& C, int vcu, int Gn) {
    bf16_t* G = (bf16_t*)(C.p.ws + WS_NAG); const float* rpb = C.p.in[I1_RPB];
    const int gt = vcu * NTHR + tid_now(), NGT = Gn * NTHR;
    for (int it = gt; it < 8 * 16 * 2 * 64 * 32; it += NGT) {
        const int j = it & 31, kc = (it >> 5) & 63, half = (it >> 11) & 1, dr = (it >> 12) & 15, h = it >> 16;
        const int qc = 32 * half + j, cs = min(max(qc - 8, 0), 48);
        float v = -30000.f;
        if (dr < 15 && (unsigned)(kc - cs) < 16u) v = rpb[(h * 15 + dr) * 31 + (kc - qc + 15)] * LOG2E;
        G[it] = f2bf(v);
    }
}

__device__ __forceinline__ void phase_attn0(Ctx& C) {
    const Params& p = C.p;
    MLAS char* shm = (MLAS char*)C.lds;
    att::UnitDesc U; U.Q = (const bf16_t*)(p.ws + WS_Q0); U.qpitch = 768; U.K = (const bf16_t*)(p.ws + WS_K0); U.kpitch = 256; U.V = (const bf16_t*)(p.ws + WS_V0); U.vpitch = 256;
    U.O = (bf16_t*)(p.ws + WS_MIX); U.opitch = D; U.rg = 0; U.rmin = 0; U.head = 0; U.G = nullptr;
    for (int u = C.vcu; u < 768 + 96; u += C.G) {
        if (u < 768) { const int qb = u & 7, bh = u >> 3, h = bh % 12, b = bh / 12;
            U.q0 = (long)b * S + 256 * qb; U.qcol = h * 64; U.kcol = (h / 3) * 64; U.vcol = (h / 3) * 64; U.ocol = 256 + h * 64; U.kv0 = b * SK; U.nt = SK / 64; }
        else { const int bh = u - 768, h = bh % 12, b = bh / 12;
            U.q0 = (long)ML + 256 * b; U.qcol = h * 64; U.kcol = (h / 3) * 64; U.vcol = (h / 3) * 64; U.ocol = 256 + h * 64; U.kv0 = b * SK; U.nt = CTX / 64; }
#ifdef USE_ATT64
        att64::attn_unit<8>(U.q0, (const att64::bf16*)U.Q, U.qpitch, U.qcol, (const att64::bf16*)U.K, U.kpitch, U.kcol, (const att64::bf16*)U.V, U.vpitch, U.vcol, (long)U.kv0, U.nt, (att64::bf16*)U.O, U.opitch, U.ocol, C.lds_g);
#else
        att::attn_unit<64, false, false>(U, shm, nullptr, nullptr, nullptr);
#endif
    }
    phase_pool(C);
}
__device__ __forceinline__ void phase_attn1(Ctx& C) {
    const Params& p = C.p;
    MLAS char* shm = (MLAS char*)C.lds;
    const float* T16 = (const float*)(p.ws + WS_ROPE16);
    att::UnitDesc U; U.O = (bf16_t*)(p.ws + WS_MIX); U.opitch = D; U.G = (const bf16_t*)(p.ws + WS_NAG);
    for (int u = C.vcu; u < 1024; u += C.G) {
        const int uu = u & 511, qb = uu & 7, h = (uu >> 3) & 7, b = uu >> 6;
        U.q0 = (long)b * S + 256 * qb; U.kv0 = b * SK; U.head = h;
        if (u < 512) {
            U.Q = (const bf16_t*)(p.ws + WS_MQ); U.qpitch = 768; U.qcol = h * 96; U.K = (const bf16_t*)(p.ws + WS_MK); U.kpitch = 768; U.kcol = h * 96;
            U.V = (const bf16_t*)(p.ws + WS_MV); U.vpitch = 512; U.vcol = h * 64; U.ocol = h * 64; U.nt = SK / 64; U.rg = 0; U.rmin = 0;
#ifdef USE_ATT96
            att96::attn_unit<8>(U.q0, (const att96::bf16*)U.Q, U.qpitch, U.qcol, (const att96::bf16*)U.K, U.kpitch, U.kcol, (const att96::bf16*)U.V, U.vpitch, U.vcol, (long)U.kv0, U.nt, (att96::bf16*)U.O, U.opitch, U.ocol, C.lds_g, p.in[I1_MQG], T16);
#ifdef DUP_MLA
            att96::attn_unit<8>(U.q0, (const att96::bf16*)U.Q, U.qpitch, U.qcol, (const att96::bf16*)U.K, U.kpitch, U.kcol, (const att96::bf16*)U.V, U.vpitch, U.vcol, (long)U.kv0, U.nt, (att96::bf16*)U.O, U.opitch, U.ocol, C.lds_g, p.in[I1_MQG], T16);
#endif
#else
            att::attn_unit<96, false, true>(U, shm, p.in[I1_MQG], T16, nullptr);
#ifdef DUP_MLA
            att::attn_unit<96, false, true>(U, shm, p.in[I1_MQG], T16, nullptr);
#endif
#endif
        } else {
            U.Q = (const bf16_t*)(p.ws + WS_NQ); U.qpitch = 512; U.qcol = h * 64; U.K = (const bf16_t*)(p.ws + WS_NK); U.kpitch = 512; U.kcol = h * 64;
            U.V = (const bf16_t*)(p.ws + WS_NV); U.vpitch = 512; U.vcol = h * 64; U.ocol = 512 + h * 64; U.rg = qb;
            const int rmin = min(max(4 * qb - 4, 0), 24), rmax = min(max(4 * qb + 3 - 4, 0), 24) + 7;
            U.rmin = rmin; U.nt = 4 + (rmax - rmin + 1);
#ifdef USE_ATTNA
            attna::attn_unit<8>(U.q0, (const attna::bf16*)U.Q, U.qpitch, U.qcol, (const attna::bf16*)U.K, U.kpitch, U.kcol, (const attna::bf16*)U.V, U.vpitch, U.vcol, (long)U.kv0, (U.nt + 1) & ~1, (attna::bf16*)U.O, U.opitch, U.ocol, C.lds_g, U.rmin, U.rg, p.in[I1_RPB] + h * 465);
#ifdef DUP_NA
            attna::attn_unit<8>(U.q0, (const attna::bf16*)U.Q, U.qpitch, U.qcol, (const attna::bf16*)U.K, U.kpitch, U.kcol, (const attna::bf16*)U.V, U.vpitch, U.vcol, (long)U.kv0, (U.nt + 1) & ~1, (attna::bf16*)U.O, U.opitch, U.ocol, C.lds_g, U.rmin, U.rg, p.in[I1_RPB] + h * 465);
#endif
#else
            att::attn_unit<64, true, false>(U, shm, nullptr, nullptr, p.in[I1_RPB]);
#ifdef DUP_NA
            att::attn_unit<64, true, false>(U, shm, nullptr, nullptr, p.in[I1_RPB]);
#endif
#endif
        }
    }
}

__global__ void __launch_bounds__(NTHR, 2) mega(Params p, int ph_lo, int ph_hi) {
    extern __shared__ __attribute__((aligned(16))) unsigned char lds_raw[];
    cg::grid_group grid = cg::this_grid();
    Ctx C; C.p = p; C.lds = (MLAS unsigned char*)lds_raw; C.lds_g = (char*)lds_raw; C.wave = __builtin_amdgcn_readfirstlane((int)threadIdx.x >> 6);
    C.G = gridDim.x; C.bid = blockIdx.x; C.vcu = (C.G % 8 == 0) ? (C.bid % 8) * (C.G / 8) + C.bid / 8 : C.bid;
    volatile LAS unsigned* bst = (volatile LAS unsigned*)(C.lds + LDS_BYTES - 64);
    if (threadIdx.x < 2) bst[threadIdx.x] = 0u;
    __syncthreads();
    unsigned* barw = (unsigned*)(p.ws + WS_BARRIER);
    XcdBarrier bar; bar.bar = barw; bar.x = 0; bar.st = nullptr;
    if (ph_hi - ph_lo > 1) bar = xcd_barrier_post(barw, bst);
    float* out = p.out; float* xrc = (float*)(p.ws + WS_XRC);
#ifdef BF16RES
    typedef bf16_t res_t;
    res_t* xa = (res_t*)p.out; res_t* xb3 = (res_t*)(p.ws + WS_X3);
#else
    typedef float res_t;
    res_t* xa = p.out; res_t* xb3 = p.out;
#endif
    const float* MOD = (const float*)(p.ws + WS_MOD);
    bf16_t* XN = (bf16_t*)(p.ws + WS_XN); bf16_t* MIX = (bf16_t*)(p.ws + WS_MIX); bf16_t* H = (bf16_t*)(p.ws + WS_H);
    const float* T32 = (const float*)(p.ws + WS_ROPE32); const float* T16 = (const float*)(p.ws + WS_ROPE16);
#define WSB(off) ((bf16_t*)(p.ws + (off)))
#ifndef PHMASK
#define PHMASK 0xFFFF
#endif
#ifndef REPMASK
#define REPMASK 0
#endif
#ifndef NSYNC
#define NSYNC 1
#endif
#define PH(k) if (((PHMASK >> (k)) & 1) && ph_lo <= (k) && (k) < ph_hi) for (int rep_ = 0; rep_ < (((REPMASK >> (k)) & 1) ? 2 : 1); ++rep_, (((REPMASK >> (k)) & 1) && rep_ == 1 ? xcd_barrier(bar) : (void)0))
#ifndef USE_CG_SYNC
#define USE_CG_SYNC 0
#endif
#define SEAM(k) if (ph_lo <= (k) && (k) + 1 < ph_hi) { for (int s_ = 0; s_ < NSYNC; ++s_) { if (USE_CG_SYNC || ph_hi > 1000) grid.sync(); else xcd_barrier(bar); } }
    PH(0) { phase_prologue<0>(C, C.vcu, C.G);
#if !defined(L1_LATE) && !defined(L1_IN_P7)
        phase_prologue<1>(C, C.vcu, C.G);
#endif
    }
#ifdef MERGE01
    if (ph_lo <= 0 && ph_hi > 1) {
        if (threadIdx.x == 0) { XB_SPIN(xb_ld(barw + XB_ADA0) < 32u, barw); __builtin_amdgcn_fence(__ATOMIC_ACQUIRE, "agent"); asm volatile("s_waitcnt vmcnt(0)" ::: "memory"); }
        __syncthreads();
    }
#else
    SEAM(0);
#endif
    PH(1) { phase_norm(C, p.in[I_X], p.in[I_CTX], p.in[I0_NMIX], 0, 0, 1, MT); } SEAM(1);
    PH(2) { pg8::Gemm g{XN, WSB(WS_W_IN0), MT, 1536, D, D}; pg8::StaticOrder So; So.init(MT, 1536, C.G, C.bid);
        epi::EpiIn0 E{WSB(WS_A0), WSB(WS_Q0), WSB(WS_K0), WSB(WS_V0), p.in[I0_QG], p.in[I0_KG], T32};
        pg8::gemm_phase<epi::EpiIn0, pg8::StaticOrder, ALIGN2, true>(C.lds, g, So, E);
#ifdef L0_SPLIT
        { const int n2 = (MT / 256) * 6 - C.G;
          if (n2 >= 0 && n2 < C.G) { if (C.bid >= n2) phase_prologue<2>(C, C.bid - n2, C.G - n2); } else phase_prologue<2>(C, C.vcu, C.G); }
#endif
#ifdef L1_LATE
        { const int n2 = (MT / 256) * 6 - C.G;
          if (n2 >= 0 && n2 < C.G && C.bid >= n2) phase_prologue<1>(C, C.bid - n2, C.G - n2);
          else if (n2 < 0 || n2 >= C.G) phase_prologue<1>(C, C.vcu, C.G); }
#endif
    } SEAM(2);
    PH(3) { phase_attn0(C); } SEAM(3);
    PH(4) { { pg8::Gemm g{MIX, WSB(WS_W_OUT0), ML, D, D, D}; pg8::StaticOrder So; So.init(ML, D, C.G, C.bid);
          epi::EpiResidT<float, res_t> E{p.in[I_X], p.in[I_CTX], xa, xrc, MOD + 2 * D};
          pg8::gemm_phase<epi::EpiResidT<float, res_t>, pg8::StaticOrder, ALIGN1, true>(C.lds, g, So, E); }
        { pg8::Gemm g{MIX, WSB(WS_W_OUT0), MT, D, D / 4, D}; pg8::CtxSplitOrder So; So.init(4, C.G, C.bid);
          epi::EpiResidSplit E{p.in[I_CTX], xrc, (float*)(p.ws + WS_SLAB4), MOD + 2 * D};
          pg8::gemm_phase<epi::EpiResidSplit, pg8::CtxSplitOrder, true, true>(C.lds, g, So, E); }
#ifdef CTXD_IN_P6
        if (C.G > 128) { if (C.bid >= 128) phase_prologue<3>(C, C.bid - 128, C.G - 128); } else phase_prologue<3>(C, C.vcu, C.G);
#endif
    } SEAM(4);
    PH(5) { phase_norm(C, xa, xrc, p.in[I0_NFFN], 0, 3, 4, MT, (const float*)(p.ws + WS_SLAB4), 3, xrc); } SEAM(5);
#ifdef CTXD_IN_P6
    const bool ctxd = (C.G == 256);
#else
    const bool ctxd = false;
#endif
    PH(6) { pg8::Gemm g{XN, WSB(WS_W_GU0), MT, 2 * FF, D, D}; epi::EpiSwiGLU E{H};
        if (!ctxd) { pg8::StaticOrder So; So.init(MT, 2 * FF, C.G, C.bid);
            pg8::gemm_phase<epi::EpiSwiGLU, pg8::StaticOrder, true, true>(C.lds, g, So, E);
#ifdef D0_IN_P6
            { const int total = (MT / 256) * (2 * FF / 256), full = total / C.G, n7 = total - full * C.G;
              if (n7 > 0 && n7 < C.G) { if (C.bid >= n7) phase_prologue<3>(C, C.bid - n7, C.G - n7); } else phase_prologue<3>(C, C.vcu, C.G); }
#endif
        }
#ifdef CTXD_IN_P6
        else {
            unsigned* flag = barw + XB_CTXH;
            { pg8::CtxFirstOrder So; So.init(0, C.bid); epi::EpiSwiGLUW EW{H}; pg8::gemm_phase<epi::EpiSwiGLUW, pg8::CtxFirstOrder, true, true>(C.lds, g, So, EW); }
            if (C.bid >= 80 && threadIdx.x == 0) xb_add(flag, 1u);
            { pg8::CtxFirstOrder So; So.init(1, C.bid); pg8::gemm_phase<epi::EpiSwiGLU, pg8::CtxFirstOrder, true, true>(C.lds, g, So, E); }
            if (C.bid >= 48 && C.bid < 176) {
                if (threadIdx.x == 0) { XB_SPIN(xb_ld(flag) < 176u, barw); __builtin_amdgcn_fence(__ATOMIC_ACQUIRE, "agent"); asm volatile("s_waitcnt vmcnt(0)" ::: "memory"); }
                __syncthreads();
                if (C.bid < 112) { pg8::Gemm g2{H, WSB(WS_W_D0), MT, D, 768, FF}; pg8::CtxSplitOrder S2; S2.init(2, C.G, C.bid - 48);
                    epi::EpiResidSplit E2{xrc, xrc, (float*)(p.ws + WS_SLAB7), MOD + 5 * D, 0};
                    pg8::gemm_phase<epi::EpiResidSplit, pg8::CtxSplitOrder, true, true>(C.lds, g2, S2, E2); }
                else { pg8::Gemm g2{H + 1536, WSB(WS_W_D0) + 1536, MT, D, 640, FF}; pg8::CtxSplitOrder S2; S2.init(2, C.G, C.bid - 112);
                    epi::EpiResidSplit E2{xrc, xrc, (float*)(p.ws + WS_SLAB7), MOD + 5 * D, 2};
                    pg8::gemm_phase<epi::EpiResidSplit, pg8::CtxSplitOrder, true, true>(C.lds, g2, S2, E2); }
            } else if (C.bid >= 176) { phase_prologue<1>(C, C.bid - 176, C.G - 176); phase_natable(C, C.bid - 176, C.G - 176); }
        }
#endif
    } SEAM(6);
    PH(7) { { pg8::Gemm g{H, WSB(WS_W_D0), ML, D, FF, FF}; pg8::StaticOrder So; So.init(ML, D, C.G, C.bid);
          epi::EpiResidT<res_t, res_t> E{xa, xrc, xa, xrc, MOD + 5 * D};
          pg8::gemm_phase<epi::EpiResidT<res_t, res_t>, pg8::StaticOrder, ALIGN1, true>(C.lds, g, So, E); }
        if (!ctxd) {
        { pg8::Gemm g{H, WSB(WS_W_D0), MT, D, FF / 2, FF}; pg8::CtxSplitOrder So; So.init(2, C.G, C.bid);
          epi::EpiResidSplit E{xrc, xrc, (float*)(p.ws + WS_SLAB7), MOD + 5 * D};
          pg8::gemm_phase<epi::EpiResidSplit, pg8::CtxSplitOrder, true, true>(C.lds, g, So, E); }
#ifdef L1_IN_P7
        if (C.G > 64) { if (C.bid >= 64) { phase_prologue<1>(C, C.bid - 64, C.G - 64);
#ifdef CTXD_IN_P6
            phase_prologue<4>(C, C.bid - 64, C.G - 64);
#endif
            phase_natable(C, C.bid - 64, C.G - 64); } }
        else { phase_prologue<1>(C, C.vcu, C.G);
#ifdef CTXD_IN_P6
            phase_prologue<4>(C, C.vcu, C.G);
#endif
            phase_natable(C, C.vcu, C.G); }
#endif
        }
    } SEAM(7);
    PH(8) {
#ifndef L1_IN_P7
        phase_natable(C, C.vcu, C.G);
#endif
        phase_norm(C, xa, xrc, p.in[I1_NMIX], 1, 0, 1, MT, (const float*)(p.ws + WS_SLAB7), ctxd ? 3 : 1, nullptr); } SEAM(8);
    PH(9) { pg8::Gemm g{XN, WSB(WS_W_IN1), MT, L1_INP, D, D}; pg8::StaticOrder So; So.init(MT, L1_INP, C.G, C.bid);
        epi::EpiIn1 E{WSB(WS_CQ), WSB(WS_CKV), WSB(WS_NQ), WSB(WS_NK), WSB(WS_NV), (float*)(p.ws + WS_KR), (float*)(p.ws + WS_SSQ), (float*)(p.ws + WS_SSKV), p.in[I1_NQG], p.in[I1_NKG]};
        pg8::gemm_phase<epi::EpiIn1, pg8::StaticOrder, ALIGN2, true>(C.lds, g, So, E);
#ifdef FOLD_N13
        { const int n3 = (MT / 256) * (L1_INP / 256) - 2 * C.G;
          if (n3 >= 0 && n3 < C.G) { if (C.bid >= n3) phase_bias(C, C.bid - n3, C.G - n3, WSB(WS_W_GU1), 2 * FF, MOD + 9 * 6144 + 3 * D, 8, (float*)(p.ws + WS_BIAS1)); }
          else phase_bias(C, C.vcu, C.G, WSB(WS_W_GU1), 2 * FF, MOD + 9 * 6144 + 3 * D, 8, (float*)(p.ws + WS_BIAS1)); }
#endif
#ifdef CTXD_IN_P6
        if (ctxd) { const int n3 = (MT / 256) * (L1_INP / 256) - 2 * C.G;
            if (n3 >= 0 && n3 < C.G) { if (C.bid >= n3) phase_prologue<4>(C, C.bid - n3, C.G - n3); } else phase_prologue<4>(C, C.vcu, C.G); }
#endif
    } SEAM(9);
    PH(10) {
#ifndef NO_QUP
        { pg8::Gemm g{WSB(WS_CQ), WSB(WS_W_UQ), ML, 768, 384, 384}; pg8::StaticOrder So; So.init(ML, 768, C.G, C.bid);
          epi::EpiQUp E{WSB(WS_MQ), (const float*)(p.ws + WS_SSQ)};
          pg8::gemm_phase<epi::EpiQUp, pg8::StaticOrder, ALIGN2, true>(C.lds, g, So, E); }
#endif
#ifndef NO_KVUP
        { pg8::Gemm g{WSB(WS_CKV), WSB(WS_W_UKV), MT, 1024, 256, 256}; pg8::StaticOrder So; So.init(MT, 1024, C.G, (C.bid + KVROT) % C.G);
          epi::EpiKvUp E{WSB(WS_MK), WSB(WS_MV), (const float*)(p.ws + WS_SSKV), (const float*)(p.ws + WS_KR), p.in[I1_MKG], T16};
          pg8::gemm_phase<epi::EpiKvUp, pg8::StaticOrder, ALIGN2, true>(C.lds, g, So, E); }
#endif
    } SEAM(10);
    PH(11) { phase_attn1(C); } SEAM(11);
#ifdef FOLD_N13
    PH(12) { pg8::Gemm g{MIX, WSB(WS_W_OUT1), ML, D, D, D}; pg8::StaticOrder So; So.init(ML, D, C.G, C.bid);
        epi::EpiResidNT<res_t, res_t> E{xa, xb3, MOD + 9 * 6144 + 2 * D, WSB(WS_XN2), (float*)(p.ws + WS_SSN1), p.in[I1_NFFN], MOD + 9 * 6144 + 4 * D};
        pg8::gemm_phase<epi::EpiResidNT<res_t, res_t>, pg8::StaticOrder, ALIGN1, true>(C.lds, g, So, E); } SEAM(12);
    PH(14) { pg8::Gemm g{WSB(WS_XN2), WSB(WS_W_GU1), ML, 2 * FF, D, D}; pg8::StaticOrder So; So.init(ML, 2 * FF, C.G, C.bid);
        epi::EpiSwiGLUN E{H, (const float*)(p.ws + WS_SSN1), (const float*)(p.ws + WS_BIAS1)};
        pg8::gemm_phase<epi::EpiSwiGLUN, pg8::StaticOrder, true, true>(C.lds, g, So, E); } SEAM(14);
#else
    PH(12) { pg8::Gemm g{MIX, WSB(WS_W_OUT1), ML, D, D, D}; pg8::StaticOrder So; So.init(ML, D, C.G, C.bid);
        epi::EpiResidT<res_t, res_t> E{xa, xrc, xb3, xrc, MOD + 9 * 6144 + 2 * D};
        pg8::gemm_phase<epi::EpiResidT<res_t, res_t>, pg8::StaticOrder, ALIGN1, true>(C.lds, g, So, E); } SEAM(12);
    PH(13) { phase_norm(C, xb3, xrc, p.in[I1_NFFN], 1, 3, 4, ML); } SEAM(13);
    PH(14) { pg8::Gemm g{XN, WSB(WS_W_GU1), ML, 2 * FF, D, D}; pg8::StaticOrder So; So.init(ML, 2 * FF, C.G, C.bid);
        epi::EpiSwiGLU E{H};
        pg8::gemm_phase<epi::EpiSwiGLU, pg8::StaticOrder, true, true>(C.lds, g, So, E); } SEAM(14);
#endif
    PH(15) { pg8::Gemm g{H, WSB(WS_W_D1), ML, D, FF, FF}; pg8::StaticOrder So; So.init(ML, D, C.G, C.bid);
        epi::EpiResidT<res_t, float> E{xb3, xrc, out, xrc, MOD + 9 * 6144 + 5 * D};
        pg8::gemm_phase<epi::EpiResidT<res_t, float>, pg8::StaticOrder, ALIGN1, true>(C.lds, g, So, E); }
    if (ph_hi - ph_lo > 1 && C.bid == 0 && threadIdx.x == 0) { if (xb_ld(&barw[XB_TMO]) != 0u) out[0] = __builtin_nanf(""); }
#undef PH
#undef SEAM
#undef WSB
}
}
#ifndef MK_DEBUG
#define MK_DEBUG 0
#endif
static int g_grid = 0;
static bool mega_setup() {
    if (g_grid) return g_grid > 0;
    int dev = 0, cus = 0, per_cu = 0;
    if (hipGetDevice(&dev) != hipSuccess || hipDeviceGetAttribute(&cus, hipDeviceAttributeMultiprocessorCount, dev) != hipSuccess) { g_grid = -1; return false; }
    if (hipFuncSetAttribute((const void*)mk::mega, hipFuncAttributeMaxDynamicSharedMemorySize, mk::LDS_BYTES) != hipSuccess) { fprintf(stderr, "kernel_launch: hipFuncSetAttribute failed\n"); g_grid = -1; return false; }
    if (hipOccupancyMaxActiveBlocksPerMultiprocessor(&per_cu, (const void*)mk::mega, mk::NTHR, mk::LDS_BYTES) != hipSuccess || per_cu < 1) { fprintf(stderr, "kernel_launch: occupancy query says %d\n", per_cu); g_grid = -1; return false; }
    g_grid = cus;
    fprintf(stderr, "kernel_launch: %d CUs, occupancy %d blocks/CU, grid %d\n", cus, per_cu, g_grid);
    return true;
}
static void launch_phases(const Params& p, int lo, int hi, hipStream_t st) {
    Params pp = p; int l = lo, h = hi;
    void* args[] = {&pp, &l, &h};
    hipError_t e;
    if (hi - lo > 1) e = hipLaunchCooperativeKernel((const void*)mk::mega, dim3(g_grid), dim3(mk::NTHR), args, mk::LDS_BYTES, st);
    else e = hipLaunchKernel((const void*)mk::mega, dim3(g_grid), dim3(mk::NTHR), args, mk::LDS_BYTES, st);
    if (e != hipSuccess) fprintf(stderr, "kernel_launch: launch [%d,%d) failed: %s\n", lo, hi, hipGetErrorString(e));
}
#if MK_DEBUG
static void launch_debug(const Params& p, hipStream_t st) {
    using namespace nv;
    unsigned* err = (unsigned*)(p.ws + WS_CTL) + 64;
    float* out = p.out; float* xrc = (float*)(p.ws + WS_XRC);
    const float* x = p.in[I_X]; const float* cx = p.in[I_CTX];
    const size_t att_sm = 4 * (SK + 128) * sizeof(float);
    const int SR = 4096;
    float* snapL = (float*)(p.ws + WS_SNAP); float* snapC = snapL + (size_t)SR * D;
    float* snapB = (float*)(p.ws + WS_BIG);
    hipMemsetAsync(p.ws + WS_CTL, 0, WS_SSQ, st);
    launch_phases(p, 0, 1, st);  k_adaln<true><<<dim3(6144 / 256, 9, 2), 256, 0, st>>>(p, err + 0);
    launch_phases(p, 1, 2, st);  k_norm<true><<<MT / 4, 256, 0, st>>>(p, x, cx, I0_NMIX, 0, 0, 1, MT, err + 1);
    launch_phases(p, 2, 3, st);  k_in0<true><<<MT / R, 256, (R * D + R * L0_IN) * 4, st>>>(p, err + 2);
    launch_phases(p, 3, 4, st);  k_attn<true, 0><<<dim3(ML / 4, 12), 256, att_sm, st>>>(p, err + 3);
                                 k_attn<true, 1><<<dim3(MC / 4, 12), 256, att_sm, st>>>(p, err + 16);
                                 k_pool0<true><<<MT, 256, 0, st>>>(p, err + 17);
    launch_phases(p, 4, 5, st);  k_out<true, 0><<<MT / R, 256, (R * D + R * 256) * 4, st>>>(p, x, cx, out, xrc, 0, err + 4);
    launch_phases(p, 5, 6, st);  k_norm<true><<<MT / 4, 256, 0, st>>>(p, out, xrc, I0_NFFN, 0, 3, 4, MT, err + 5);
    launch_phases(p, 6, 7, st);  k_ffn_gu<true, 0><<<MT / R, 256, R * D * 4, st>>>(p, err + 6);
    hipMemcpyAsync(snapL, out, (size_t)SR * D * 4, hipMemcpyDeviceToDevice, st); hipMemcpyAsync(snapC, xrc, (size_t)MC * D * 4, hipMemcpyDeviceToDevice, st);
    launch_phases(p, 7, 8, st);  k_ffn_d<true, 0><<<SR / R, 256, R * FF * 4, st>>>(p, snapL, snapC, out, xrc, 0, err + 7);
                                 k_ffn_d<true, 0><<<MC / R, 256, R * FF * 4, st>>>(p, snapL, snapC, out, xrc, ML, err + 7);
    launch_phases(p, 8, 9, st);  k_norm<true><<<MT / 4, 256, 0, st>>>(p, out, xrc, I1_NMIX, 1, 0, 1, MT, err + 8);
    launch_phases(p, 9, 10, st); k_in1<true><<<MT / R, 256, (R * D + R * L1_IN) * 4, st>>>(p, err + 9);
    launch_phases(p, 10, 11, st); k_mlaq<true><<<ML / R, 256, R * 384 * 4, st>>>(p, err + 10);
                                 k_mlakv<true><<<MT / R, 256, (R * 256 + R * 1024) * 4, st>>>(p, err + 19);
    launch_phases(p, 11, 12, st); k_attn<true, 2><<<dim3(ML / 4, 8), 256, att_sm, st>>>(p, err + 11);
                                 k_attn<true, 3><<<dim3(ML / 4, 8), 256, att_sm, st>>>(p, err + 18);
    hipMemcpyAsync(snapB, out, (size_t)SR * D * 4, hipMemcpyDeviceToDevice, st);
    launch_phases(p, 12, 13, st); k_out<true, 1><<<SR / R, 256, (R * D + R * 256) * 4, st>>>(p, snapB, snapC, out, xrc, 0, err + 12);
    launch_phases(p, 13, 14, st); k_norm<true><<<ML / 4, 256, 0, st>>>(p, out, xrc, I1_NFFN, 1, 3, 4, ML, err + 13);
    launch_phases(p, 14, 15, st); k_ffn_gu<true, 1><<<ML / R, 256, R * D * 4, st>>>(p, err + 14);
    hipMemcpyAsync(snapL, out, (size_t)SR * D * 4, hipMemcpyDeviceToDevice, st);
    launch_phases(p, 15, 16, st); k_ffn_d<true, 1><<<SR / R, 256, R * FF * 4, st>>>(p, snapL, snapC, out, xrc, 0, err + 15);
    k_report<<<1, 1, 0, st>>>(p, 20, 0.15f);
}
#endif
extern "C" void kernel_launch(void* const* d_in, const int* in_sizes, int n_in, void* d_out, int out_size, void* d_ws, size_t ws_size, hipStream_t stream) {
    if (n_in != N_IN || out_size != ML * D || ws_size < WS_END) { fprintf(stderr, "kernel_launch: unexpected shapes n_in=%d out=%d ws=%zu\n", n_in, out_size, ws_size); return; }
    if (!mega_setup()) return;
    Params p{};
    for (int i = 0; i < N_IN; ++i) p.in[i] = (const float*)d_in[i];
    p.out = (float*)d_out; p.ws = (unsigned char*)d_ws;
#if MK_DEBUG
    launch_debug(p, stream);
#else
    if (hipMemsetAsync((char*)d_ws + WS_BARRIER, 0, WS_SSQ - WS_BARRIER, stream) != hipSuccess) { fprintf(stderr, "kernel_launch: memset failed\n"); return; }
#ifdef EXTRA_MEMSET
    (void)hipMemsetAsync((char*)d_ws + WS_CTL, 0, 4096, stream);
#endif
    launch_phases(p, 0, mk::NPHASE, stream);
#endif
}
```

```cpp
#define USE_ATT64 1
#define USE_ATT96 1
#define ATT_STATIC_PRIO 1
#define L1_IN_P7 1
#define L0_SPLIT 1
#define D0_IN_P6 1
#define FOLD_N13 1
#define BF16RES 1
#define MERGE01 1
#define GU0_IN_P4 1
#define KVROT 64
#define MBT_F32 4
#define ADA1_IN_P6 1
#define ADA_KS 8
#define D0CTX_X4 1
#define KVB 1
#include <hip/hip_runtime.h>
#include <hip/hip_cooperative_groups.h>
#include <cstdio>
#include <cstdint>
namespace cg = cooperative_groups;

typedef unsigned short bf16_t;
constexpr int D = 1024, NB = 8, S = 2048, CTX = 256, SK = S + CTX, ML = NB * S, MC = NB * CTX, MT = ML + MC, FF = 2816;
constexpr int GW = 64;
constexpr int L0_IN = 1536, L1_IN = 2208, L1_INP = 2304;
constexpr float EPS = 1e-6f;
constexpr float LOG2E = 1.4426950408889634f;
constexpr float C2_64 = 0.125f * LOG2E;
constexpr float C2_96 = 0.10206207261596577f * LOG2E;

enum { I_X = 0, I_C, I_CTX, I_CCTX,
       I0_ADAW, I0_ADAB, I0_NMIX, I0_NFFN, I0_WIN, I0_POOLW, I0_POOLS, I0_QG, I0_KG, I0_WOUT, I0_WG, I0_WU, I0_WD,
       I1_ADAW, I1_ADAB, I1_NMIX, I1_NFFN, I1_WIN, I1_QAG, I1_KVAG, I1_WUQ, I1_WUKV, I1_MQG, I1_MKG, I1_NQG, I1_NKG, I1_RPB, I1_WOUT, I1_WG, I1_WU, I1_WD, N_IN };

constexpr size_t MiB = 1u << 20;
constexpr size_t WS_CTL = 0;
constexpr size_t WS_BARRIER = 16 * 1024;
constexpr size_t WS_MOD = 64 * 1024;
constexpr size_t WS_SSQ = 512 * 1024;
constexpr size_t WS_SSKV = 600 * 1024;
constexpr size_t WS_ROPE32 = 700 * 1024;
constexpr size_t WS_ROPE16 = 712 * 1024;
constexpr size_t WS_W_IN0 = 1 * MiB;
constexpr size_t WS_W_OUT0 = 4 * MiB;
constexpr size_t WS_W_GU0 = 6 * MiB;
constexpr size_t WS_W_D0 = 17 * MiB;
constexpr size_t WS_W_IN1 = 23 * MiB;
constexpr size_t WS_W_UQ = 28 * MiB;
constexpr size_t WS_W_UKV = 29 * MiB;
constexpr size_t WS_W_OUT1 = 30 * MiB;
constexpr size_t WS_W_GU1 = 32 * MiB;
constexpr size_t WS_W_D1 = 43 * MiB;
constexpr size_t WS_XRC = 49 * MiB;
constexpr size_t WS_XN = 57 * MiB;
constexpr size_t WS_MIX = WS_XN;
constexpr size_t WS_BIG = 96 * MiB;
constexpr size_t WS_H = WS_BIG;
constexpr size_t WS_A0 = WS_BIG;
constexpr size_t WS_Q0 = WS_BIG + 9 * MiB;
constexpr size_t WS_K0 = WS_BIG + 36 * MiB;
constexpr size_t WS_V0 = WS_BIG + 45 * MiB;
constexpr size_t WS_CQ = WS_BIG;
constexpr size_t WS_CKV = WS_BIG + 14 * MiB;
constexpr size_t WS_NQ = WS_BIG + 23 * MiB;
constexpr size_t WS_NK = WS_BIG + 41 * MiB;
constexpr size_t WS_NV = WS_BIG + 59 * MiB;
constexpr size_t WS_MQ = WS_BIG + 77 * MiB;
constexpr size_t WS_MK = WS_BIG + 101 * MiB;
constexpr size_t WS_MV = WS_BIG + 128 * MiB;
constexpr size_t WS_KR = WS_BIG + 146 * MiB;
constexpr size_t WS_SLAB4 = WS_BIG;
constexpr size_t WS_SLAB7 = WS_BIG + 100 * MiB;
constexpr size_t WS_NAG = WS_BIG + 150 * MiB;
constexpr size_t WS_SSN1 = 768 * 1024;
constexpr size_t WS_BIAS1 = 832 * 1024;
constexpr size_t WS_XN2 = WS_BIG + 88 * MiB;
constexpr size_t WS_X3 = WS_BIG + 120 * MiB;
constexpr size_t WS_SNAP = WS_BIG + 100 * MiB;
constexpr size_t WS_END = 256 * MiB;
static_assert(WS_KR + (size_t)MT * 32 * 4 <= WS_END, "ws map");
static_assert(WS_X3 + (size_t)ML * D * 2 <= WS_END, "ws map");
static_assert(WS_W_D1 + (size_t)D * FF * 2 <= WS_XRC, "ws map");
static_assert(WS_XN + (size_t)MT * D * 2 <= WS_BIG, "ws map");

__device__ __forceinline__ float bf2f(bf16_t u) { return __uint_as_float((unsigned)u << 16); }
__device__ __forceinline__ bf16_t f2bf(float f) { unsigned u = __float_as_uint(f); return (bf16_t)((u + 0x7fffu + ((u >> 16) & 1u)) >> 16); }
__device__ __forceinline__ int kvrow_of(int m) { return m < ML ? (m / S) * SK + CTX + (m % S) : ((m - ML) / CTX) * SK + ((m - ML) % CTX); }
__device__ __forceinline__ int modidx_of(int m) { return m < ML ? m / S : 8; }
__device__ __forceinline__ float wave_sum(float v) {
#pragma unroll
    for (int o = 1; o < 64; o <<= 1) v += __shfl_xor(v, o);
    return v;
}
__device__ __forceinline__ float wave_max(float v) {
#pragma unroll
    for (int o = 1; o < 64; o <<= 1) v = fmaxf(v, __shfl_xor(v, o));
    return v;
}

struct Params {
    const float* in[N_IN];
    float* out;
    unsigned char* ws;
};
namespace pg8 {
#define PG8_LAS __attribute__((address_space(3)))
typedef unsigned short bf16_t;
typedef short bf16x8 __attribute__((ext_vector_type(8)));
typedef float f32x4 __attribute__((ext_vector_type(4)));
typedef unsigned u32x4 __attribute__((ext_vector_type(4)));
constexpr int BM = 256, BK = 64, HALF = 128, HTB = HALF * BK * 2  , STAGE_BYTES = 8 * HTB, NXCD = 8, WGM = 8;

__host__ __device__ __forceinline__ int lds_byte(int r, int c) { const int st = (r >> 4) * 2 + (c >> 5), rr = r & 15, cc = c & 31, ob = rr * 64 + cc * 2; return st * 1024 + (ob ^ (((ob >> 9) & 1) << 5)); }
__host__ __device__ __forceinline__ void stage_rc(int b, int& R, int& C) { const int st = b / 1024, sb = b % 1024, swz = sb ^ (((sb >> 9) & 1) << 5); R = (st >> 1) * 16 + swz / 64; C = (st & 1) * 32 + (swz % 64) / 2; }
__host__ __device__ __forceinline__ int perm32(int rho) { const int n = rho >> 4, i = rho & 15; return 8 * (i >> 2) + 4 * n + (i & 3); }

struct Unit { int pm, pn, ks; };
struct Gemm { const bf16_t* A; const bf16_t* Bt; int M, N, K, ld; };

struct StaticOrder {
    int nM, nN, nwg, G, c;
    __host__ __device__ void init(int M, int N, int G_, int c_) { nM = M / BM; nN = N / BM; nwg = nM * nN; G = G_; c = c_; }
    __host__ __device__ bool next(int i, Unit& u) const {
        const long L = (long)i * G + c; if (L >= nwg) return false;
        int wgid = (int)L; { const int q = nwg / NXCD, r = nwg % NXCD, xcd = wgid % NXCD, off = wgid / NXCD; wgid = (xcd < r ? xcd * (q + 1) : r * (q + 1) + (xcd - r) * q) + off; }
        const int nig = WGM * nN, gid = wgid / nig, fm = gid * WGM, gsz = (nM - fm) < WGM ? (nM - fm) : WGM;
        u.pm = fm + ((wgid % nig) % gsz); u.pn = (wgid % nig) / gsz; u.ks = 0; return true;
    }
    __device__ __forceinline__ void a_ready(const Unit&) const {}
    __device__ __forceinline__ void done(const Unit&) const {}
};

__device__ __forceinline__ unsigned cvt_pk_bf16(float lo, float hi) { unsigned r; asm volatile("v_cvt_pk_bf16_f32 %0, %1, %2" : "=v"(r) : "v"(lo), "v"(hi)); return r; }
typedef float f32x2 __attribute__((ext_vector_type(2)));
struct CtxSplitOrder {
    int G, c, split;
    __host__ __device__ void init(int split_, int G_, int c_) { split = split_; G = G_; c = c_; }
    __host__ __device__ bool next(int i, Unit& u) const {
        const int L = i * G + c; if (L >= 32 * split) return false;
        u.ks = L % split; const int t = L / split; u.pn = t & 3; u.pm = 64 + (t >> 2); return true;
    }
    __device__ __forceinline__ void a_ready(const Unit&) const {}
    __device__ __forceinline__ void done(const Unit&) const {}
};
struct CtxFirstOrder {
    int c, mode; StaticOrder lat;
    __host__ __device__ void init(int mode_, int c_) { mode = mode_; c = c_; lat.init(64 * BM, 22 * BM, 1 << 28, 0); }
    __host__ __device__ bool next(int i, Unit& u) const {
        if (mode == 0) { if (i != 0 || c < 80) return false; const int j = c - 80; u.pm = 64 + (j & 7); u.pn = j >> 3; u.ks = 0; return true; }
        const int Lp = c < 80 ? (i == 0 ? c : 80 + (i - 1) * 256 + c) : 80 + i * 256 + c;
        if (Lp >= 1408) return false;
        StaticOrder t = lat; t.c = Lp; return t.next(0, u);
    }
    __device__ __forceinline__ void a_ready(const Unit&) const {}
    __device__ __forceinline__ void done(const Unit&) const {}
};
struct ListOrder {
    int n, u0, u1, u2;
    __host__ __device__ bool next(int i, Unit& u) const {
        if (i >= n) return false; const int v = i == 0 ? u0 : (i == 1 ? u1 : u2);
        u.pm = v & 0xff; u.pn = v >> 8; u.ks = 0; return true;
    }
    __device__ __forceinline__ void a_ready(const Unit&) const {}
    __device__ __forceinline__ void done(const Unit&) const {}
};
__host__ __device__ inline int in1_pack(int x, int l) { if (l < 27) return (x + 8 * (l / 3)) | ((l % 3) << 8); const int lp = l - 27; return (x + 8 * (lp / 6)) | ((3 + lp % 6) << 8); }
__host__ __device__ inline void in1_xcd_list(ListOrder& L, int c, int ilo, int ihi) {
    const int x = c & 7, j = c >> 3, l0 = j + 32 * ilo;
    int n = ihi - ilo; const int cap = (81 - l0 + 31) / 32; if (n > cap) n = cap; if (n < 0) n = 0;
    L.n = n; L.u0 = in1_pack(x, l0); L.u1 = in1_pack(x, l0 + 32); L.u2 = in1_pack(x, l0 + 64);
}
__host__ __device__ inline int up_pack(int x, int w, int kv) { if (kv) { const int wp = w - 24; return (x + 8 * (wp >> 2)) | ((wp & 3) << 8); } return (x + 8 * (w / 3)) | ((w % 3) << 8); }
__host__ __device__ inline void up_xcd_list(ListOrder& L, int c, int kv) {
    const int x = c & 7, j = c >> 3;
    int a, b; if (j >= 17) { a = 3 * (j - 17); b = a + 3; } else if (j < 15) { a = 45 + j; b = a + 1; } else { a = 24; b = 24; }
    int w0, w1; if (kv) { w0 = a > 24 ? a : 24; w1 = b; } else { w0 = a; w1 = b < 24 ? b : 24; }
    int n = w1 - w0; if (n < 0) n = 0;
    if (n == 0) w0 = kv ? 24 : 0;
    L.n = n; L.u0 = up_pack(x, w0, kv); L.u1 = up_pack(x, w0 + 1, kv); L.u2 = up_pack(x, w0 + 2, kv);
}
template <class Epi, class Sched, bool ALIGN_EPI = false, bool SP2 = false>
__device__ __forceinline__ void gemm_phase(PG8_LAS unsigned char* lds, const Gemm g, const Sched& S, const Epi& E) {
    int tid_ = threadIdx.x; asm volatile("" : "+v"(tid_));
    const int tid = tid_, wid = __builtin_amdgcn_readfirstlane(tid >> 6), lane = tid & 63, wr = wid >> 2, wc = wid & 3, fr = lane & 15, fq = lane >> 4;
    int K_ = g.K; asm volatile("" : "+s"(K_));
    const int K = K_, nt = K / BK; int LD_ = g.ld; asm volatile("" : "+s"(LD_)); const int LD = LD_;
    unsigned voffA[2], voffB[2];
#pragma unroll
    for (int i = 0; i < 2; ++i) { int R, C; stage_rc(tid * 16 + i * 8192, R, C); const int Rb = Epi::PERM ? ((R & ~31) + perm32(R & 31)) : R;
        voffA[i] = (unsigned)(R * LD + C) * 2u; voffB[i] = (unsigned)(Rb * LD + C) * 2u; }
    const size_t kstep = (size_t)(BK * 2);
    const size_t hstep = (size_t)HALF * LD * 2;
    const size_t tstep = 2 * hstep;
    const unsigned ldsw = (unsigned)wid * 1024u;
    const int aoff = lds_byte(wr * 64 + fr, fq * 8), boff = lds_byte(wc * 32 + fr, fq * 8);
#define PG8_SA(b, h) (((b) * 2 + (h)) * HTB)
#define PG8_SB(b, h) ((4 + (b) * 2 + (h)) * HTB)
#define PG8_STAGE(bufoff, gbase, voff) do { _Pragma("unroll") for (int _i = 0; _i < 2; ++_i) \
        __builtin_amdgcn_global_load_lds((const unsigned*)((const char*)(gbase) + (voff)[_i]), (PG8_LAS unsigned*)(lds + (bufoff) + ldsw + _i * 8192), 16, 0, 0); } while (0)
#define PG8_LDA(dst, b, h) do { _Pragma("unroll") for (int m = 0; m < 4; ++m) _Pragma("unroll") for (int k = 0; k < 2; ++k) dst[m][k] = *(const PG8_LAS bf16x8*)(lds + PG8_SA(b, h) + aoff + m * 2048 + k * 1024); } while (0)
#define PG8_LDB(dst, b, h) do { _Pragma("unroll") for (int n = 0; n < 2; ++n) _Pragma("unroll") for (int k = 0; k < 2; ++k) dst[n][k] = *(const PG8_LAS bf16x8*)(lds + PG8_SB(b, h) + boff + n * 2048 + k * 1024); } while (0)
#define PG8_MMA(ai, bj, At, Bt) do { __builtin_amdgcn_s_setprio(1); _Pragma("unroll") for (int m = 0; m < 4; ++m) _Pragma("unroll") for (int n = 0; n < 2; ++n) _Pragma("unroll") for (int k = 0; k < 2; ++k) \
        acc[ai][bj][m][n] = __builtin_amdgcn_mfma_f32_16x16x32_bf16(Bt[n][k], At[m][k], acc[ai][bj][m][n], 0, 0, 0); __builtin_amdgcn_s_setprio(0); } while (0)
#define PG8_WAIT_V(n) asm volatile("s_waitcnt vmcnt(" #n ")" ::: "memory")
#define PG8_WAIT_L(n) asm volatile("s_waitcnt lgkmcnt(" #n ")" ::: "memory")
#define PG8_BAR __builtin_amdgcn_s_barrier()
#define PG8_SCHED __builtin_amdgcn_sched_barrier(0)
    Unit cur, nxt; int ui = 0;
    if (!S.next(0, cur)) return;
    f32x4 acc[2][2][4][2];
#pragma unroll
    for (int a = 0; a < 2; ++a)
#pragma unroll
        for (int b = 0; b < 2; ++b)
#pragma unroll
            for (int m = 0; m < 4; ++m)
#pragma unroll
                for (int n = 0; n < 2; ++n) acc[a][b][m][n] = (f32x4){0.f, 0.f, 0.f, 0.f};
    bf16x8 At[4][2], B0[2][2], B1[2][2];
    const char* cA = (const char*)g.A + (size_t)cur.pm * tstep + (size_t)cur.ks * K * 2; const char* cB = (const char*)g.Bt + (size_t)cur.pn * tstep + (size_t)cur.ks * K * 2;
    S.a_ready(cur);
    if constexpr (SP2) {
        PG8_STAGE(PG8_SB(0, 0), cB, voffB); PG8_STAGE(PG8_SB(0, 1), cB + hstep, voffB); PG8_STAGE(PG8_SA(0, 0), cA, voffA); PG8_STAGE(PG8_SA(0, 1), cA + hstep, voffA);
        if (wr == 1) PG8_BAR;
        PG8_WAIT_V(2); PG8_BAR;
        PG8_STAGE(PG8_SB(1, 0), cB + kstep, voffB); PG8_STAGE(PG8_SA(1, 0), cA + kstep, voffA); PG8_STAGE(PG8_SB(1, 1), cB + hstep + kstep, voffB);
        PG8_WAIT_V(6); PG8_BAR;
    } else {
        PG8_STAGE(PG8_SB(0, 0), cB, voffB); PG8_STAGE(PG8_SA(0, 0), cA, voffA); PG8_STAGE(PG8_SB(0, 1), cB + hstep, voffB); PG8_STAGE(PG8_SA(0, 1), cA + hstep, voffA);
        if (wr == 1) PG8_BAR;
        PG8_WAIT_V(4); PG8_BAR;
        PG8_STAGE(PG8_SB(1, 0), cB + kstep, voffB); PG8_STAGE(PG8_SA(1, 0), cA + kstep, voffA); PG8_STAGE(PG8_SB(1, 1), cB + hstep + kstep, voffB);
        PG8_WAIT_V(6); PG8_BAR;
    }
    for (;;) {
        const bool has_next = S.next(ui + 1, nxt);
        const char* nA = has_next ? (const char*)g.A + (size_t)nxt.pm * tstep + (size_t)nxt.ks * K * 2 : cA; const char* nB = has_next ? (const char*)g.Bt + (size_t)nxt.pn * tstep + (size_t)nxt.ks * K * 2 : cB;
        for (int t = 0; t < nt; t += 2) {
            const bool last = (t == nt - 2);
            const char* a1 = cA + (size_t)(t + 1) * kstep;
            const char* a2 = last ? nA : cA + (size_t)(t + 2) * kstep; const char* b2 = last ? nB : cB + (size_t)(t + 2) * kstep;
            const char* a3 = a2 + kstep; const char* b3 = b2 + kstep;
            if (last && has_next) S.a_ready(nxt);
            if constexpr (SP2) {
            PG8_LDB(B0, 0, 0); PG8_LDB(B1, 0, 1); PG8_SCHED; PG8_LDA(At, 0, 0); PG8_STAGE(PG8_SA(1, 1), a1 + hstep, voffA);
            PG8_WAIT_V(8); PG8_WAIT_L(0); PG8_BAR; PG8_MMA(0, 0, At, B0); PG8_MMA(0, 1, At, B1); PG8_BAR; PG8_SCHED;
            PG8_LDA(At, 0, 1); PG8_STAGE(PG8_SB(0, 0), b2, voffB); PG8_STAGE(PG8_SB(0, 1), b2 + hstep, voffB); PG8_STAGE(PG8_SA(0, 0), a2, voffA);
            PG8_WAIT_V(8); PG8_WAIT_L(0); PG8_BAR; PG8_MMA(1, 0, At, B0); PG8_MMA(1, 1, At, B1); PG8_BAR; PG8_SCHED;
            PG8_LDB(B0, 1, 0); PG8_LDB(B1, 1, 1); PG8_SCHED; PG8_LDA(At, 1, 0); PG8_STAGE(PG8_SA(0, 1), a2 + hstep, voffA);
            PG8_WAIT_V(8); PG8_WAIT_L(0); PG8_BAR; PG8_MMA(0, 0, At, B0); PG8_MMA(0, 1, At, B1); PG8_BAR; PG8_SCHED;
            PG8_LDA(At, 1, 1); PG8_STAGE(PG8_SB(1, 0), b3, voffB); PG8_STAGE(PG8_SB(1, 1), b3 + hstep, voffB); PG8_STAGE(PG8_SA(1, 0), a3, voffA);
            PG8_WAIT_V(8); PG8_WAIT_L(0); PG8_BAR; PG8_MMA(1, 0, At, B0); PG8_MMA(1, 1, At, B1); PG8_BAR; PG8_SCHED;
            } else {
            PG8_LDB(B0, 0, 0); PG8_SCHED; PG8_LDA(At, 0, 0); PG8_STAGE(PG8_SA(1, 1), a1 + hstep, voffA);
            PG8_WAIT_L(8); PG8_BAR; PG8_WAIT_L(0); PG8_MMA(0, 0, At, B0); PG8_BAR; PG8_SCHED;
            PG8_LDB(B1, 0, 1); PG8_STAGE(PG8_SB(0, 0), b2, voffB);
            PG8_BAR; PG8_WAIT_L(0); PG8_MMA(0, 1, At, B1); PG8_BAR;
            PG8_LDA(At, 0, 1); PG8_STAGE(PG8_SA(0, 0), a2, voffA);
            PG8_BAR; PG8_WAIT_L(0); PG8_MMA(1, 0, At, B0); PG8_BAR; PG8_SCHED;
            PG8_STAGE(PG8_SB(0, 1), b2 + hstep, voffB);
            PG8_WAIT_V(6); PG8_BAR; PG8_MMA(1, 1, At, B1); PG8_BAR;
            PG8_LDB(B0, 1, 0); PG8_SCHED; PG8_LDA(At, 1, 0); PG8_STAGE(PG8_SA(0, 1), a2 + hstep, voffA);
            PG8_WAIT_L(8); PG8_BAR; PG8_WAIT_L(0); PG8_MMA(0, 0, At, B0); PG8_BAR; PG8_SCHED;
            PG8_LDB(B1, 1, 1); PG8_STAGE(PG8_SB(1, 0), b3, voffB);
            PG8_BAR; PG8_WAIT_L(0); PG8_MMA(0, 1, At, B1); PG8_BAR;
            PG8_LDA(At, 1, 1); PG8_STAGE(PG8_SA(1, 0), a3, voffA);
            PG8_BAR; PG8_WAIT_L(0); PG8_MMA(1, 0, At, B0); PG8_BAR; PG8_SCHED;
            PG8_STAGE(PG8_SB(1, 1), b3 + hstep, voffB);
            PG8_WAIT_V(6); PG8_BAR; PG8_MMA(1, 1, At, B1); PG8_BAR;
            }
        }
        if constexpr (ALIGN_EPI) { if (wr == 0) PG8_BAR; }
        if constexpr (!Epi::AFTER_DRAIN) { E(acc, cur, wr, wc, fr, fq); S.done(cur); }
        if (!has_next) break;
#pragma unroll
        for (int a = 0; a < 2; ++a)
#pragma unroll
            for (int b = 0; b < 2; ++b)
#pragma unroll
                for (int m = 0; m < 4; ++m)
#pragma unroll
                    for (int n = 0; n < 2; ++n) acc[a][b][m][n] = (f32x4){0.f, 0.f, 0.f, 0.f};
        cur = nxt; cA = nA; cB = nB; ++ui;
        if constexpr (ALIGN_EPI) { if (wr == 1) PG8_BAR; }
    }
    PG8_WAIT_V(0);
    if constexpr (!ALIGN_EPI) { if (wr == 0) PG8_BAR; }
    PG8_BAR;
    if constexpr (Epi::AFTER_DRAIN) { E.fused(acc, cur, wr, wc, fr, fq, lds, wid, lane); S.done(cur); }
#undef PG8_SA
#undef PG8_SB
#undef PG8_STAGE
#undef PG8_LDA
#undef PG8_LDB
#undef PG8_MMA
#undef PG8_WAIT_V
#undef PG8_WAIT_L
#undef PG8_BAR
#undef PG8_SCHED
}
}
namespace epi {
using pg8::f32x4; using pg8::Unit;
typedef unsigned u32x2 __attribute__((ext_vector_type(2)));
typedef unsigned u32x4 __attribute__((ext_vector_type(4)));
typedef float f32x2 __attribute__((ext_vector_type(2)));
typedef __bf16 bf16x2_t __attribute__((ext_vector_type(2)));
__device__ __forceinline__ unsigned pk(float lo, float hi) { f32x2 v = {lo, hi}; bf16x2_t b = __builtin_convertvector(v, bf16x2_t); return __builtin_bit_cast(unsigned, b); }
__device__ __forceinline__ u32x2 pk4(f32x4 v) { u32x2 w; w.x = pk(v[0], v[1]); w.y = pk(v[2], v[3]); return w; }
__device__ __forceinline__ float sum4sq(f32x4 v) { return (v[0] * v[0] + v[1] * v[1]) + (v[2] * v[2] + v[3] * v[3]); }
__device__ __forceinline__ float quad_sum(float s) { s += __shfl_xor(s, 16); s += __shfl_xor(s, 32); return s; }

__device__ __forceinline__ void st32(bf16_t* base32, f32x4 v0, f32x4 v1, int fq) {
    u32x2 a = pk4(v0), b = pk4(v1);
    { auto r = __builtin_amdgcn_permlane16_swap(a.x, b.x, false, false); a.x = r[0]; b.x = r[1]; }
    { auto r = __builtin_amdgcn_permlane16_swap(a.y, b.y, false, false); a.y = r[0]; b.y = r[1]; }
    u32x4 w; w.x = a.x; w.y = a.y; w.z = b.x; w.w = b.y;
    *(u32x4*)(base32 + 16 * (fq & 1) + 8 * (fq >> 1)) = w;
}

__device__ __forceinline__ int kvbase_of(int pm) { return pm < 64 ? (pm >> 3) * SK + CTX + (pm & 7) * 256 : (pm - 64) * SK; }
__device__ __forceinline__ int modidx_pm(int pm) { return pm < 64 ? (pm >> 3) : 8; }

__device__ __forceinline__ void head_finish(f32x4 (&v)[2][2], const float* gain, bool rope, const float* T32, int grow, int gcol, float scale, int fq) {
    float ss = (sum4sq(v[0][0]) + sum4sq(v[0][1])) + (sum4sq(v[1][0]) + sum4sq(v[1][1]));
    ss = quad_sum(ss);
    const float rn = rsqrtf(ss * (1.f / 64.f) + EPS);
#pragma unroll
    for (int bj = 0; bj < 2; ++bj)
#pragma unroll
        for (int n = 0; n < 2; ++n) { const f32x4 g = *(const f32x4*)(gain + 32 * bj + 16 * n + 4 * fq); v[bj][n] = (v[bj][n] * rn) * g; }
    if (rope) {
#pragma unroll
        for (int bj = 0; bj < 2; ++bj) { const int pos = bj ? gcol : grow;
            const f32x4 cs = *(const f32x4*)(T32 + pos * 16 + 4 * fq), sn = *(const f32x4*)(T32 + 1024 + pos * 16 + 4 * fq);
            const f32x4 x1 = v[bj][0], x2 = v[bj][1];
            v[bj][0] = x1 * cs - x2 * sn; v[bj][1] = x1 * sn + x2 * cs; }
    }
#pragma unroll
    for (int bj = 0; bj < 2; ++bj)
#pragma unroll
        for (int n = 0; n < 2; ++n) v[bj][n] = v[bj][n] * scale;
}

__device__ __forceinline__ void head_finish_r(f32x4 (&v)[2][2], const f32x4 (&g)[2][2], bool rope, f32x4 cs0, f32x4 sn0, f32x4 cs1, f32x4 sn1, float scale) {
    float ss = (sum4sq(v[0][0]) + sum4sq(v[0][1])) + (sum4sq(v[1][0]) + sum4sq(v[1][1]));
    ss = quad_sum(ss);
    const float rn = rsqrtf(ss * (1.f / 64.f) + EPS);
#pragma unroll
    for (int bj = 0; bj < 2; ++bj)
#pragma unroll
        for (int n = 0; n < 2; ++n) v[bj][n] = (v[bj][n] * rn) * g[bj][n];
    if (rope) {
        { const f32x4 x1 = v[0][0], x2 = v[0][1]; v[0][0] = x1 * cs0 - x2 * sn0; v[0][1] = x1 * sn0 + x2 * cs0; }
        { const f32x4 x1 = v[1][0], x2 = v[1][1]; v[1][0] = x1 * cs1 - x2 * sn1; v[1][1] = x1 * sn1 + x2 * cs1; }
    }
#pragma unroll
    for (int bj = 0; bj < 2; ++bj)
#pragma unroll
        for (int n = 0; n < 2; ++n) v[bj][n] = v[bj][n] * scale;
}

struct EpiIn0 {
    static constexpr bool PERM = false, AFTER_DRAIN = false;
    bf16_t *A0, *Q0, *K0, *V0; const float *qg, *kg, *T32;
    __device__ __forceinline__ void operator()(const f32x4 (&acc)[2][2][4][2], const Unit& u, int wr, int wc, int fr_in, int fq_in) const {
        int fr = fr_in, fq = fq_in; asm volatile("" : "+v"(fr), "+v"(fq));
        const int pn = u.pn, pm = u.pm; const bool lat = pm < 64; const int kvb = kvbase_of(pm);
        f32x4 gq[2][2], cs0[2], sn0[2], cs1[4], sn1[4];
        if (pn != 0 && pn != 5) { const float* gain = pn < 4 ? qg : kg;
#pragma unroll
            for (int bj = 0; bj < 2; ++bj)
#pragma unroll
                for (int n = 0; n < 2; ++n) gq[bj][n] = *(const f32x4*)(gain + 32 * bj + 16 * n + 4 * fq);
#pragma unroll
            for (int ai = 0; ai < 2; ++ai) { const int grow = (pm & 7) * 4 + 2 * ai + wr; cs0[ai] = *(const f32x4*)(T32 + grow * 16 + 4 * fq); sn0[ai] = *(const f32x4*)(T32 + 1024 + grow * 16 + 4 * fq); }
#pragma unroll
            for (int m = 0; m < 4; ++m) { const int gcol = 16 * m + fr; cs1[m] = *(const f32x4*)(T32 + gcol * 16 + 4 * fq); sn1[m] = *(const f32x4*)(T32 + 1024 + gcol * 16 + 4 * fq); }
        }
#pragma unroll
        for (int ai = 0; ai < 2; ++ai)
#pragma unroll
            for (int m = 0; m < 4; ++m) {
                const int rl = 128 * ai + 64 * wr + 16 * m + fr; const size_t r = (size_t)pm * 256 + rl;
                if (pn == 0 || pn == 5) {
                    bf16_t* dst = pn == 0 ? A0 + r * 256 : V0 + (size_t)(kvb + rl) * 256;
#pragma unroll
                    for (int bj = 0; bj < 2; ++bj)
                        st32(dst + 64 * wc + 32 * bj, acc[ai][bj][m][0], acc[ai][bj][m][1], fq);
                } else {
                    f32x4 v[2][2] = {{acc[ai][0][m][0], acc[ai][0][m][1]}, {acc[ai][1][m][0], acc[ai][1][m][1]}};
                    bf16_t* dst;
                    if (pn < 4) { head_finish_r(v, gq, lat, cs0[ai], sn0[ai], cs1[m], sn1[m], C2_64); dst = Q0 + r * 768 + ((pn - 1) * 4 + wc) * 64; }
                    else { head_finish_r(v, gq, lat, cs0[ai], sn0[ai], cs1[m], sn1[m], 1.0f); dst = K0 + (size_t)(kvb + rl) * 256 + wc * 64; }
#pragma unroll
                    for (int bj = 0; bj < 2; ++bj)
                        st32(dst + 32 * bj, v[bj][0], v[bj][1], fq);
                }
            }
    }
};

__device__ __forceinline__ f32x4 ld4(const float* p) { return *(const f32x4*)p; }
__device__ __forceinline__ f32x4 ld4(const bf16_t* p) { const u32x2 w = *(const u32x2*)p; return (f32x4){__uint_as_float(w.x << 16), __uint_as_float(w.x & 0xffff0000u), __uint_as_float(w.y << 16), __uint_as_float(w.y & 0xffff0000u)}; }
template <class T> struct Raw4;
template <> struct Raw4<float> { typedef f32x4 type; };
template <> struct Raw4<bf16_t> { typedef u32x2 type; };
__device__ __forceinline__ f32x4 ldraw(const float* p) { return *(const f32x4*)p; }
__device__ __forceinline__ u32x2 ldraw(const bf16_t* p) { return *(const u32x2*)p; }
__device__ __forceinline__ f32x4 cvraw(f32x4 w) { return w; }
__device__ __forceinline__ f32x4 cvraw(u32x2 w) { return (f32x4){__uint_as_float(w.x << 16), __uint_as_float(w.x & 0xffff0000u), __uint_as_float(w.y << 16), __uint_as_float(w.y & 0xffff0000u)}; }
__device__ __forceinline__ void st4(float* p, f32x4 v) { *(f32x4*)p = v; }
__device__ __forceinline__ void st4(bf16_t* p, f32x4 v) { *(u32x2*)p = pk4(v); }
struct RawPF { f32x4 a, b; };
template <class T> struct RawP;
template <> struct RawP<float> { typedef RawPF type; };
template <> struct RawP<bf16_t> { typedef u32x4 type; };
__device__ __forceinline__ RawPF ldp(const float* g32, int fq) { RawPF r; r.a = *(const f32x4*)(g32 + 4 * fq); r.b = *(const f32x4*)(g32 + 16 + 4 * fq); return r; }
__device__ __forceinline__ u32x4 ldp(const bf16_t* g32, int fq) { return *(const u32x4*)(g32 + 16 * (fq & 1) + 8 * (fq >> 1)); }
__device__ __forceinline__ void cvp(const RawPF& r, f32x4& v0, f32x4& v1) { v0 = r.a; v1 = r.b; }
__device__ __forceinline__ void cvp(u32x4 w, f32x4& v0, f32x4& v1) {
    u32x2 a, b; a.x = w.x; a.y = w.y; b.x = w.z; b.y = w.w;
    { auto r = __builtin_amdgcn_permlane16_swap(a.x, b.x, false, false); a.x = r[0]; b.x = r[1]; }
    { auto r = __builtin_amdgcn_permlane16_swap(a.y, b.y, false, false); a.y = r[0]; b.y = r[1]; }
    v0 = cvraw(a); v1 = cvraw(b);
}
__device__ __forceinline__ void stp(float* g32, int fq, f32x4 v0, f32x4 v1) { *(f32x4*)(g32 + 4 * fq) = v0; *(f32x4*)(g32 + 16 + 4 * fq) = v1; }
__device__ __forceinline__ void stp(bf16_t* g32, int fq, f32x4 v0, f32x4 v1) { st32(g32, v0, v1, fq); }
#ifndef MBT_BF
#define MBT_BF 4
#endif
#ifndef MBT_F32
#define MBT_F32 2
#endif
template <class TB, class TO> struct EpiResidT {
    static constexpr bool PERM = false, AFTER_DRAIN = false; static constexpr int MBT = sizeof(TB) == 4 ? MBT_F32 : MBT_BF;
    const TB* base_l; const float* base_c; TO* out_l; float* out_c; const float* mod;
    __device__ __forceinline__ void operator()(const f32x4 (&acc)[2][2][4][2], const Unit& u, int wr, int wc, int fr_in, int fq_in) const {
        int fr = fr_in, fq = fq_in; asm volatile("" : "+v"(fr), "+v"(fq));
        const int pm = u.pm; const bool lat = pm < 64;
        const float* gp = mod + (size_t)modidx_pm(pm) * 6144 + u.pn * 256 + 32 * wc + 4 * fq;
        f32x4 g[2][2];
#pragma unroll
        for (int bj = 0; bj < 2; ++bj)
#pragma unroll
            for (int n = 0; n < 2; ++n) g[bj][n] = *(const f32x4*)(gp + 128 * bj + 16 * n);
        if (lat) {
            const TB* bp = base_l + (size_t)pm * 256 * D; TO* op = out_l + (size_t)pm * 256 * D;
#pragma unroll
            for (int aim = 0; aim < 8; aim += MBT) {
                typename RawP<TB>::type braw[8][2];
#pragma unroll
                for (int q = aim; q < aim + MBT; ++q) { const int ai = q >> 2, m = q & 3; const size_t off = (size_t)(128 * ai + 64 * wr + 16 * m + fr) * D + u.pn * 256 + 32 * wc;
#pragma unroll
                    for (int bj = 0; bj < 2; ++bj) braw[q][bj] = ldp(bp + off + 128 * bj, fq); }
#pragma unroll
                for (int q = aim; q < aim + MBT; ++q) { const int ai = q >> 2, m = q & 3; const size_t off = (size_t)(128 * ai + 64 * wr + 16 * m + fr) * D + u.pn * 256 + 32 * wc;
#pragma unroll
                    for (int bj = 0; bj < 2; ++bj) { f32x4 b0, b1; cvp(braw[q][bj], b0, b1);
                        stp(op + off + 128 * bj, fq, b0 + g[bj][0] * acc[ai][bj][m][0], b1 + g[bj][1] * acc[ai][bj][m][1]); } }
            }
        } else {
            const float* bp = base_c + (size_t)(pm - 64) * 256 * D; float* op = out_c + (size_t)(pm - 64) * 256 * D;
#pragma unroll
            for (int aim = 0; aim < 8; aim += 2) { const int ai = aim >> 2, m0 = aim & 3;
                f32x4 braw[4][2][2];
#pragma unroll
                for (int m = m0; m < m0 + 2; ++m) { const size_t off = (size_t)(128 * ai + 64 * wr + 16 * m + fr) * D + u.pn * 256 + 32 * wc + 4 * fq;
#pragma unroll
                    for (int bj = 0; bj < 2; ++bj)
#pragma unroll
                        for (int n = 0; n < 2; ++n) braw[m][bj][n] = *(const f32x4*)(bp + off + 128 * bj + 16 * n); }
#pragma unroll
                for (int m = m0; m < m0 + 2; ++m) { const size_t off = (size_t)(128 * ai + 64 * wr + 16 * m + fr) * D + u.pn * 256 + 32 * wc + 4 * fq;
#pragma unroll
                    for (int bj = 0; bj < 2; ++bj)
#pragma unroll
                        for (int n = 0; n < 2; ++n) *(f32x4*)(op + off + 128 * bj + 16 * n) = braw[m][bj][n] + g[bj][n] * acc[ai][bj][m][n]; }
            }
        }
    }
};
typedef EpiResidT<float, float> EpiResid;

template <class TB, class TO> struct EpiResidNT {
    static constexpr bool PERM = false, AFTER_DRAIN = false; static constexpr int MBT = sizeof(TB) == 4 ? 2 : 4;
    const TB* base_l; TO* out_l; const float* mod;
    bf16_t* xn2; float* ssn; const float* gain; const float* modsc;
    __device__ __forceinline__ void operator()(const f32x4 (&acc)[2][2][4][2], const Unit& u, int wr, int wc, int fr_in, int fq_in) const {
        int fr = fr_in, fq = fq_in; asm volatile("" : "+v"(fr), "+v"(fq));
        const int pm = u.pm;
        const TB* bp = base_l + (size_t)pm * 256 * D;
        TO* op = out_l + (size_t)pm * 256 * D;
        bf16_t* xp = xn2 + (size_t)pm * 256 * D;
        const int c0 = u.pn * 256 + 32 * wc + 4 * fq;
        const float* gp = mod + (size_t)(pm >> 3) * 6144 + c0;
        const float* sp = modsc + (size_t)(pm >> 3) * 6144 + c0;
        f32x4 g[2][2], f[2][2];
#pragma unroll
        for (int bj = 0; bj < 2; ++bj)
#pragma unroll
            for (int n = 0; n < 2; ++n) { g[bj][n] = *(const f32x4*)(gp + 128 * bj + 16 * n);
                f[bj][n] = *(const f32x4*)(gain + c0 + 128 * bj + 16 * n) * (*(const f32x4*)(sp + 128 * bj + 16 * n) + 1.f); }
#pragma unroll
        for (int aim = 0; aim < 8; aim += MBT) { const int ai = aim >> 2, m0 = aim & 3;
            typename RawP<TB>::type braw[4][2];
            const int cg0 = u.pn * 256 + 32 * wc;
#pragma unroll
            for (int m = m0; m < m0 + MBT; ++m) { const size_t off = (size_t)(128 * ai + 64 * wr + 16 * m + fr) * D + cg0;
#pragma unroll
                for (int bj = 0; bj < 2; ++bj) braw[m][bj] = ldp(bp + off + 128 * bj, fq); }
#pragma unroll
            for (int m = m0; m < m0 + MBT; ++m) { const int row = 128 * ai + 64 * wr + 16 * m + fr; const size_t off = (size_t)row * D + cg0;
                float ss = 0.f;
#pragma unroll
                for (int bj = 0; bj < 2; ++bj) { f32x4 b0, b1; cvp(braw[m][bj], b0, b1);
                    const f32x4 v0 = b0 + g[bj][0] * acc[ai][bj][m][0], v1 = b1 + g[bj][1] * acc[ai][bj][m][1];
                    stp(op + off + 128 * bj, fq, v0, v1);
                    ss += ((v0[0] * v0[0] + v0[1] * v0[1]) + (v0[2] * v0[2] + v0[3] * v0[3])) + ((v1[0] * v1[0] + v1[1] * v1[1]) + (v1[2] * v1[2] + v1[3] * v1[3]));
                    st32(xp + off + 128 * bj, v0 * f[bj][0], v1 * f[bj][1], fq); }
                ss += __shfl_xor(ss, 16); ss += __shfl_xor(ss, 32);
                if (fq == 0) atomicAdd(ssn + pm * 256 + row, ss); }
        }
    }
};

struct EpiResidSplit {
    static constexpr bool PERM = false, AFTER_DRAIN = false;
    const float* base_c; float* out_c; float* slab; const float* mod; int ks_base = 0;
    __device__ __forceinline__ void operator()(const f32x4 (&acc)[2][2][4][2], const Unit& u_in, int wr, int wc, int fr_in, int fq_in) const {
        int fr = fr_in, fq = fq_in; asm volatile("" : "+v"(fr), "+v"(fq));
        Unit u = u_in; u.ks += ks_base;
        const int pm = u.pm - 64;
        const float* bp = base_c + (size_t)pm * 256 * D;
        float* op = u.ks == 0 ? out_c + (size_t)pm * 256 * D : slab + (size_t)(u.ks - 1) * MC * D + (size_t)pm * 256 * D;
        const float* gp = mod + (size_t)8 * 6144 + u.pn * 256 + 32 * wc + 4 * fq;
        f32x4 g[2][2];
#pragma unroll
        for (int bj = 0; bj < 2; ++bj)
#pragma unroll
            for (int n = 0; n < 2; ++n) g[bj][n] = *(const f32x4*)(gp + 128 * bj + 16 * n);
#pragma unroll
        for (int aim = 0; aim < 8; aim += 2) { const int ai = aim >> 2, m0 = aim & 3;
            f32x4 braw[4][2][2];
#pragma unroll
            for (int m = m0; m < m0 + 2; ++m) { const size_t off = (size_t)(128 * ai + 64 * wr + 16 * m + fr) * D + u.pn * 256 + 32 * wc + 4 * fq;
#pragma unroll
                for (int bj = 0; bj < 2; ++bj)
#pragma unroll
                    for (int n = 0; n < 2; ++n) braw[m][bj][n] = u.ks == 0 ? *(const f32x4*)(bp + off + 128 * bj + 16 * n) : (f32x4){0.f, 0.f, 0.f, 0.f}; }
#pragma unroll
            for (int m = m0; m < m0 + 2; ++m) { const size_t off = (size_t)(128 * ai + 64 * wr + 16 * m + fr) * D + u.pn * 256 + 32 * wc + 4 * fq;
#pragma unroll
                for (int bj = 0; bj < 2; ++bj)
#pragma unroll
                    for (int n = 0; n < 2; ++n) *(f32x4*)(op + off + 128 * bj + 16 * n) = braw[m][bj][n] + g[bj][n] * acc[ai][bj][m][n]; }
        }
    }
};

typedef unsigned int v4u_t __attribute__((vector_size(16)));
__device__ __forceinline__ __amdgpu_buffer_rsrc_t wt_rsrc(void* base, unsigned bytes) { return __builtin_amdgcn_make_buffer_rsrc(base, (short)0, (int)bytes, 0x00020000); }
__device__ __forceinline__ void wt_st16(__amdgpu_buffer_rsrc_t rs, unsigned off_bytes, u32x4 w) { __builtin_amdgcn_raw_buffer_store_b128(__builtin_bit_cast(v4u_t, w), rs, off_bytes, 0,   16); }
struct EpiSwiGLU {
    static constexpr bool PERM = true, AFTER_DRAIN = false;
    bf16_t* H;
    __device__ __forceinline__ void operator()(const f32x4 (&acc)[2][2][4][2], const Unit& u, int wr, int wc, int fr_in, int fq_in) const {
        int fr = fr_in, fq = fq_in; asm volatile("" : "+v"(fr), "+v"(fq));
#ifdef WT_H
        const __amdgpu_buffer_rsrc_t hrs = wt_rsrc(H, (unsigned)((size_t)MT * FF * 2));
#endif
#pragma unroll
        for (int ai = 0; ai < 2; ++ai)
#pragma unroll
            for (int m = 0; m < 4; ++m) { const size_t r = (size_t)u.pm * 256 + 128 * ai + 64 * wr + 16 * m + fr;
                f32x4 h[2];
#pragma unroll
                for (int n = 0; n < 2; ++n) { const f32x4 g = acc[ai][0][m][n], up = acc[ai][1][m][n];
#pragma unroll
                    for (int e = 0; e < 4; ++e) h[n][e] = g[e] * __builtin_amdgcn_rcpf(1.f + __builtin_amdgcn_exp2f(-g[e] * LOG2E)) * up[e]; }
                u32x4 w; w.x = pk(h[0][0], h[0][1]); w.y = pk(h[0][2], h[0][3]); w.z = pk(h[1][0], h[1][1]); w.w = pk(h[1][2], h[1][3]);
#ifdef WT_H
                wt_st16(hrs, (unsigned)((r * FF + u.pn * 128 + 32 * wc + 8 * fq) * 2), w); }
#else
                *(u32x4*)(H + r * FF + u.pn * 128 + 32 * wc + 8 * fq) = w; }
#endif
    }
};

struct EpiSwiGLUN {
    static constexpr bool PERM = true, AFTER_DRAIN = false;
    bf16_t* H; const float* ssn; const float* bias;
    __device__ __forceinline__ void operator()(const f32x4 (&acc)[2][2][4][2], const Unit& u, int wr, int wc, int fr_in, int fq_in) const {
        int fr = fr_in, fq = fq_in; asm volatile("" : "+v"(fr), "+v"(fq));
#ifdef WT_H
        const __amdgpu_buffer_rsrc_t hrs = wt_rsrc(H, (unsigned)((size_t)MT * FF * 2));
#endif
        const float* bp = bias + (size_t)(u.pm >> 3) * (2 * FF) + u.pn * 256 + 32 * wc + 8 * fq;
        f32x4 bg[2], bu[2];
#pragma unroll
        for (int n = 0; n < 2; ++n) { bg[n] = *(const f32x4*)(bp + 4 * n); bu[n] = *(const f32x4*)(bp + 128 + 4 * n); }
        float rr[2][4];
#pragma unroll
        for (int ai = 0; ai < 2; ++ai)
#pragma unroll
            for (int m = 0; m < 4; ++m) rr[ai][m] = ssn[u.pm * 256 + 128 * ai + 64 * wr + 16 * m + fr];
#pragma unroll
        for (int ai = 0; ai < 2; ++ai)
#pragma unroll
            for (int m = 0; m < 4; ++m) { const size_t r = (size_t)u.pm * 256 + 128 * ai + 64 * wr + 16 * m + fr;
                const float rs = rsqrtf(rr[ai][m] * (1.f / D) + EPS);
                f32x4 h[2];
#pragma unroll
                for (int n = 0; n < 2; ++n) { const f32x4 g = acc[ai][0][m][n] * rs + bg[n], up = acc[ai][1][m][n] * rs + bu[n];
#pragma unroll
                    for (int e = 0; e < 4; ++e) h[n][e] = g[e] * __builtin_amdgcn_rcpf(1.f + __builtin_amdgcn_exp2f(-g[e] * LOG2E)) * up[e]; }
                u32x4 w; w.x = pk(h[0][0], h[0][1]); w.y = pk(h[0][2], h[0][3]); w.z = pk(h[1][0], h[1][1]); w.w = pk(h[1][2], h[1][3]);
#ifdef WT_H
                wt_st16(hrs, (unsigned)((r * FF + u.pn * 128 + 32 * wc + 8 * fq) * 2), w); }
#else
                *(u32x4*)(H + r * FF + u.pn * 128 + 32 * wc + 8 * fq) = w; }
#endif
    }
};

struct EpiSwiGLUW {
    static constexpr bool PERM = true, AFTER_DRAIN = false;
    bf16_t* H;
    __device__ __forceinline__ void operator()(const f32x4 (&acc)[2][2][4][2], const Unit& u, int wr, int wc, int fr_in, int fq_in) const {
        int fr = fr_in, fq = fq_in; asm volatile("" : "+v"(fr), "+v"(fq));
        const __amdgpu_buffer_rsrc_t rs = __builtin_amdgcn_make_buffer_rsrc((void*)(H + (size_t)ML * FF), (short)0, (int)(MC * FF * 2), 0x00020000);
#pragma unroll
        for (int ai = 0; ai < 2; ++ai)
#pragma unroll
            for (int m = 0; m < 4; ++m) { const unsigned r = (unsigned)(u.pm - 64) * 256 + 128 * ai + 64 * wr + 16 * m + fr;
                f32x4 h[2];
#pragma unroll
                for (int n = 0; n < 2; ++n) { const f32x4 g = acc[ai][0][m][n], up = acc[ai][1][m][n];
#pragma unroll
                    for (int e = 0; e < 4; ++e) h[n][e] = g[e] * __builtin_amdgcn_rcpf(1.f + __builtin_amdgcn_exp2f(-g[e] * LOG2E)) * up[e]; }
                u32x4 w; w.x = pk(h[0][0], h[0][1]); w.y = pk(h[0][2], h[0][3]); w.z = pk(h[1][0], h[1][1]); w.w = pk(h[1][2], h[1][3]);
                __builtin_amdgcn_raw_buffer_store_b128(__builtin_bit_cast(v4u_t, w), rs, (r * FF + u.pn * 128 + 32 * wc + 8 * fq) * 2u, 0,   16); }
    }
};

struct EpiIn1 {
    static constexpr bool PERM = false, AFTER_DRAIN = false;
    bf16_t *CQ, *CKV, *NQ, *NK, *NV; float *KR, *SSQ, *SSKV; const float *nqg, *nkg;
    __device__ __forceinline__ void operator()(const f32x4 (&acc)[2][2][4][2], const Unit& u, int wr, int wc, int fr_in, int fq_in) const {
        int fr = fr_in, fq = fq_in; asm volatile("" : "+v"(fr), "+v"(fq));
        const int pn = u.pn, pm = u.pm; const int kvb = kvbase_of(pm);
        f32x4 gna[2][2];
        if (pn >= 3 && pn < 7) { const float* gain = pn < 5 ? nqg : nkg;
#pragma unroll
            for (int bj = 0; bj < 2; ++bj)
#pragma unroll
                for (int n = 0; n < 2; ++n) gna[bj][n] = *(const f32x4*)(gain + 32 * bj + 16 * n + 4 * fq); }
#pragma unroll
        for (int ai = 0; ai < 2; ++ai)
#pragma unroll
            for (int m = 0; m < 4; ++m) {
                const int rl = 128 * ai + 64 * wr + 16 * m + fr; const size_t r = (size_t)pm * 256 + rl;
                if (pn == 0 || pn == 2) {
                    bf16_t* dst = pn == 0 ? CQ + r * 384 : CKV + r * 256; float ss = 0.f;
#pragma unroll
                    for (int bj = 0; bj < 2; ++bj)
                        { ss += sum4sq(acc[ai][bj][m][0]) + sum4sq(acc[ai][bj][m][1]); st32(dst + 128 * bj + 32 * wc, acc[ai][bj][m][0], acc[ai][bj][m][1], fq); }
                    ss = quad_sum(ss);
                    if (fq == 0) atomicAdd((pn == 0 ? SSQ : SSKV) + r, ss);
                } else if (pn == 1) {
                    float ss = 0.f;
                    { ss += sum4sq(acc[ai][0][m][0]) + sum4sq(acc[ai][0][m][1]); st32(CQ + r * 384 + 256 + 32 * wc, acc[ai][0][m][0], acc[ai][0][m][1], fq); }
                    ss = quad_sum(ss);
                    if (fq == 0) atomicAdd(SSQ + r, ss);
                    if (wc == 0) {
#pragma unroll
                        for (int n = 0; n < 2; ++n) *(f32x4*)(KR + r * 32 + 16 * n + 4 * fq) = acc[ai][1][m][n]; }
                } else if (pn >= 7) {
                    bf16_t* dst = NV + (size_t)(kvb + rl) * 512 + (pn - 7) * 256 + 64 * wc;
#pragma unroll
                    for (int bj = 0; bj < 2; ++bj)
                        st32(dst + 32 * bj, acc[ai][bj][m][0], acc[ai][bj][m][1], fq);
                } else {
                    f32x4 v[2][2] = {{acc[ai][0][m][0], acc[ai][0][m][1]}, {acc[ai][1][m][0], acc[ai][1][m][1]}};
                    bf16_t* dst;
                    const f32x4 z4 = {0.f, 0.f, 0.f, 0.f};
                    if (pn < 5) { head_finish_r(v, gna, false, z4, z4, z4, z4, C2_64); dst = NQ + r * 512 + ((pn - 3) * 4 + wc) * 64; }
                    else { head_finish_r(v, gna, false, z4, z4, z4, z4, 1.0f); dst = NK + (size_t)(kvb + rl) * 512 + ((pn - 5) * 4 + wc) * 64; }
#pragma unroll
                    for (int bj = 0; bj < 2; ++bj)
                        st32(dst + 32 * bj, v[bj][0], v[bj][1], fq);
                }
            }
    }
};

struct EpiQUp {
    static constexpr bool PERM = true, AFTER_DRAIN = false;
    bf16_t* MQ; const float* SSQ;
    __device__ __forceinline__ void operator()(const f32x4 (&acc)[2][2][4][2], const Unit& u, int wr, int wc, int fr_in, int fq_in) const {
        int fr = fr_in, fq = fq_in; asm volatile("" : "+v"(fr), "+v"(fq));
        float ssq[2][4];
#pragma unroll
        for (int ai = 0; ai < 2; ++ai)
#pragma unroll
            for (int m = 0; m < 4; ++m) ssq[ai][m] = SSQ[(size_t)u.pm * 256 + 128 * ai + 64 * wr + 16 * m + fr];
#pragma unroll
        for (int ai = 0; ai < 2; ++ai)
#pragma unroll
            for (int m = 0; m < 4; ++m) { const size_t r = (size_t)u.pm * 256 + 128 * ai + 64 * wr + 16 * m + fr;
                const float rs = rsqrtf(ssq[ai][m] * (1.f / 384.f) + EPS);
#pragma unroll
                for (int bj = 0; bj < 2; ++bj) { const f32x4 a = acc[ai][bj][m][0] * rs, b = acc[ai][bj][m][1] * rs;
                    u32x4 w; w.x = pk(a[0], a[1]); w.y = pk(a[2], a[3]); w.z = pk(b[0], b[1]); w.w = pk(b[2], b[3]);
                    *(u32x4*)(MQ + r * 768 + u.pn * 256 + 128 * bj + 32 * wc + 8 * fq) = w; } }
    }
};

#ifndef KVB
#ifdef TP_A
#define KVB 1
#else
#define KVB 2
#endif
#endif
struct EpiKvUp {
    static constexpr bool PERM = false, AFTER_DRAIN = false;
    bf16_t *MK, *MV; const float *SSKV, *KR, *kg, *T16;
    __device__ __forceinline__ void operator()(const f32x4 (&acc)[2][2][4][2], const Unit& u, int wr, int wc, int fr_in, int fq_in) const {
        int fr = fr_in, fq = fq_in; asm volatile("" : "+v"(fr), "+v"(fq));
        const int pm = u.pm; const bool lat = pm < 64; const int kvb = kvbase_of(pm); const int head = 2 * u.pn + (wc >> 1); const bool isv = wc & 1;
        float rs[2][4];
#pragma unroll
        for (int ai = 0; ai < 2; ++ai)
#pragma unroll
            for (int m = 0; m < 4; ++m) rs[ai][m] = SSKV[(size_t)pm * 256 + 128 * ai + 64 * wr + 16 * m + fr];
#pragma unroll
        for (int ai = 0; ai < 2; ++ai)
#pragma unroll
            for (int m = 0; m < 4; ++m) rs[ai][m] = rsqrtf(rs[ai][m] * (1.f / 256.f) + EPS);
        if (isv) {
#pragma unroll
            for (int ai = 0; ai < 2; ++ai)
#pragma unroll
                for (int m = 0; m < 4; ++m) { const size_t kvr = (size_t)(kvb + 128 * ai + 64 * wr + 16 * m + fr);
#pragma unroll
                    for (int bj = 0; bj < 2; ++bj)
                        st32(MV + kvr * 512 + head * 64 + 32 * bj, acc[ai][bj][m][0] * rs[ai][m], acc[ai][bj][m][1] * rs[ai][m], fq); }
            return;
        }
        f32x4 gn[2][2]; f32x2 gr[4];
#pragma unroll
        for (int bj = 0; bj < 2; ++bj)
#pragma unroll
            for (int n = 0; n < 2; ++n) gn[bj][n] = *(const f32x4*)(kg + 32 * bj + 16 * n + 4 * fq);
#pragma unroll
        for (int j = 0; j < 4; ++j) gr[j] = *(const f32x2*)(kg + 64 + 8 * j + 2 * fq);
        f32x2 cscm[4], sncm[4];
#pragma unroll
        for (int m = 0; m < 4; ++m) { cscm[m] = (f32x2){1.f, 1.f}; sncm[m] = (f32x2){0.f, 0.f};
            if (lat) { const int gcol = 16 * m + fr; cscm[m] = *(const f32x2*)(T16 + gcol * 8 + 2 * fq); sncm[m] = *(const f32x2*)(T16 + 512 + gcol * 8 + 2 * fq); } }
#pragma unroll
        for (int ai = 0; ai < 2; ++ai) {
            const int grow = (pm & 7) * 4 + 2 * ai + wr;
            f32x2 csr = {1.f, 1.f}, snr = {0.f, 0.f};
            if (lat) { csr = *(const f32x2*)(T16 + grow * 8 + 2 * fq); snr = *(const f32x2*)(T16 + 512 + grow * 8 + 2 * fq); }
#pragma unroll
            for (int mp = 0; mp < 4; mp += KVB) {
            f32x2 kk[4][4];
#pragma unroll
            for (int m = mp; m < mp + KVB; ++m) { const size_t r = (size_t)pm * 256 + 128 * ai + 64 * wr + 16 * m + fr;
#pragma unroll
                for (int j = 0; j < 4; ++j) kk[m][j] = *(const f32x2*)(KR + r * 32 + 8 * j + 2 * fq); }
#pragma unroll
            for (int m = mp; m < mp + KVB; ++m) {
                const int rl = 128 * ai + 64 * wr + 16 * m + fr; const size_t kvr = (size_t)(kvb + rl);
                f32x2 k[4];
#pragma unroll
                for (int j = 0; j < 4; ++j) k[j] = kk[m][j];
                const f32x2 csc = cscm[m], snc = sncm[m];
                f32x4 v[2][2];
#pragma unroll
                for (int bj = 0; bj < 2; ++bj)
#pragma unroll
                    for (int n = 0; n < 2; ++n) v[bj][n] = acc[ai][bj][m][n] * rs[ai][m];
                float ss = (sum4sq(v[0][0]) + sum4sq(v[0][1])) + (sum4sq(v[1][0]) + sum4sq(v[1][1]));
#pragma unroll
                for (int j = 0; j < 4; ++j) ss += k[j][0] * k[j][0] + k[j][1] * k[j][1];
                ss = quad_sum(ss);
                const float rr = rsqrtf(ss * (1.f / 96.f) + EPS);
#pragma unroll
                for (int bj = 0; bj < 2; ++bj)
                    st32(MK + kvr * 768 + head * 96 + 32 * bj, (v[bj][0] * rr) * gn[bj][0], (v[bj][1] * rr) * gn[bj][1], fq);
#pragma unroll
                for (int j = 0; j < 4; ++j) k[j] = (k[j] * rr) * gr[j];
                { const f32x2 x1 = k[0], x2 = k[1]; k[0] = x1 * csr - x2 * snr; k[1] = x1 * snr + x2 * csr; }
                { const f32x2 x1 = k[2], x2 = k[3]; k[2] = x1 * csc - x2 * snc; k[3] = x1 * snc + x2 * csc; }
#pragma unroll
                for (int j = 0; j < 4; ++j) *(unsigned*)(MK + kvr * 768 + head * 96 + 64 + 8 * j + 2 * fq) = pk(k[j][0], k[j][1]);
                if (m & 1) asm volatile("" ::: "memory");
            }
            }
        }
    }
};
}
namespace att {
using bf16x8 = __attribute__((ext_vector_type(8))) short;
using s16x4 = __attribute__((ext_vector_type(4))) short;
using f32x16 = __attribute__((ext_vector_type(16))) float;
using u32x4 = __attribute__((ext_vector_type(4))) unsigned;
typedef float f32x2_t __attribute__((ext_vector_type(2))); typedef __bf16 bf16x2_t __attribute__((ext_vector_type(2)));
#define ALAS __attribute__((address_space(3)))
constexpr int KSLOT = 12288, VSLOT = 8192, SLOT = KSLOT + VSLOT, NSLOT = 4, PD = NSLOT - 2;
constexpr int LDS_WS = NSLOT * SLOT;
constexpr int LDS_OST = LDS_WS + 8 * 256;
constexpr int LDS_RPB = LDS_OST + 8 * 4096;
constexpr int LDS_BYTES = LDS_RPB + 4096;
constexpr float THR = 8.0f;

__device__ __forceinline__ int crow(int r, int hi) { return (r & 3) + 8 * (r >> 2) + 4 * hi; }
__device__ __forceinline__ void glds16(const void* gsrc, unsigned lds_dst) { unsigned keep;
    asm volatile("s_mov_b32 %0, m0\n\ts_mov_b32 m0, %2\n\ts_nop 0\n\tglobal_load_lds_dwordx4 %1, off\n\ts_mov_b32 m0, %0" : "=&s"(keep) : "v"(gsrc), "s"(lds_dst) : "memory"); }
__device__ __forceinline__ unsigned cvtpk(float lo, float hi) { f32x2_t v = {lo, hi}; bf16x2_t b = __builtin_convertvector(v, bf16x2_t); return __builtin_bit_cast(unsigned, b); }
__device__ __forceinline__ void glds16s(unsigned voff, const void* sbase, unsigned lds_dst) { unsigned keep;
    asm volatile("s_mov_b32 %0, m0\n\ts_mov_b32 m0, %3\n\ts_nop 0\n\tglobal_load_lds_dwordx4 %1, %2\n\ts_mov_b32 m0, %0" : "=&s"(keep) : "v"(voff), "s"(sbase), "s"(lds_dst) : "memory"); }
__device__ __forceinline__ float max3f(float a, float b, float c) { float r; asm("v_max3_f32 %0, %1, %2, %3" : "=v"(r) : "v"(a), "v"(b), "v"(c)); return r; }
__device__ __forceinline__ float max2f(float a, float b) { float r; asm("v_max_f32_e32 %0, %1, %2" : "=v"(r) : "v"(a), "v"(b)); return r; }
#define AWAIT_BAR(N) asm volatile("s_waitcnt vmcnt(" #N ") lgkmcnt(0)\n\ts_barrier" ::: "memory")

template <int ND0> __device__ __forceinline__ void qkt(f32x16& p0, f32x16& p1, const ALAS char* Kslot, const bf16x8* qr, const f32x16& negm, int r32, int hi) {
    const ALAS char* kb = Kslot + hi * 1024 + r32 * 16;
#pragma unroll
    for (int d0 = 0; d0 < ND0; ++d0) {
        const bf16x8 b0 = *(const ALAS bf16x8*)(kb + d0 * 2048);
        const bf16x8 b1 = *(const ALAS bf16x8*)(kb + d0 * 2048 + 512);
        if (d0 == 0) { p0 = __builtin_amdgcn_mfma_f32_32x32x16_bf16(b0, qr[0], negm, 0, 0, 0); p1 = __builtin_amdgcn_mfma_f32_32x32x16_bf16(b1, qr[0], negm, 0, 0, 0); }
        else { p0 = __builtin_amdgcn_mfma_f32_32x32x16_bf16(b0, qr[d0], p0, 0, 0, 0); p1 = __builtin_amdgcn_mfma_f32_32x32x16_bf16(b1, qr[d0], p1, 0, 0, 0); }
    }
}
__device__ __forceinline__ float rowmax32(const f32x16& p0, const f32x16& p1) {
    float a[4];
#pragma unroll
    for (int k = 0; k < 4; ++k) { a[k] = max3f(p0[4 * k], p0[4 * k + 1], p0[4 * k + 2]); }
#pragma unroll
    for (int k = 0; k < 4; ++k) { a[k] = max3f(a[k], p0[4 * k + 3], p1[4 * k]); }
#pragma unroll
    for (int k = 0; k < 4; ++k) { a[k] = max3f(a[k], p1[4 * k + 1], p1[4 * k + 2]); }
    const float m = max3f(max3f(a[0], p1[3], p1[7]), max3f(a[1], p1[11], p1[15]), max2f(a[2], a[3]));
    auto rr = __builtin_amdgcn_permlane32_swap(__float_as_uint(m), __float_as_uint(m), false, false);
    return max2f(__uint_as_float(rr[0]), __uint_as_float(rr[1]));
}
typedef short v4i16_t __attribute__((ext_vector_type(4)));
__device__ __forceinline__ s16x4 vtr(const ALAS char* p) { return __builtin_bit_cast(s16x4, __builtin_amdgcn_ds_read_tr16_b64_v4i16((ALAS v4i16_t*)p)); }
__device__ __forceinline__ void pv(f32x16* o, const ALAS char* vp, bf16x8 pa0, bf16x8 pa1, bf16x8 pa2, bf16x8 pa3) {
#pragma unroll
    for (int d0 = 0; d0 < 2; ++d0) { s16x4 lo[4], hi[4];
#pragma unroll
        for (int ks = 0; ks < 4; ++ks) { lo[ks] = vtr(vp + d0 * 4096 + ks * 1024); hi[ks] = vtr(vp + d0 * 4096 + ks * 1024 + 512); }
#define APK(k) (bf16x8){lo[k][0], lo[k][1], lo[k][2], lo[k][3], hi[k][0], hi[k][1], hi[k][2], hi[k][3]}
        o[d0] = __builtin_amdgcn_mfma_f32_32x32x16_bf16(pa0, APK(0), o[d0], 0, 0, 0);
        o[d0] = __builtin_amdgcn_mfma_f32_32x32x16_bf16(pa1, APK(1), o[d0], 0, 0, 0);
        o[d0] = __builtin_amdgcn_mfma_f32_32x32x16_bf16(pa2, APK(2), o[d0], 0, 0, 0);
        o[d0] = __builtin_amdgcn_mfma_f32_32x32x16_bf16(pa3, APK(3), o[d0], 0, 0, 0);
#undef APK
    }
}

struct UnitDesc {
    const bf16_t* Q; int qpitch;
    long q0; int qcol;
    const bf16_t* K; int kpitch, kcol;
    const bf16_t* V; int vpitch, vcol;
    bf16_t* O; int opitch, ocol;
    int kv0;
    int nt;
    int rg;
    int rmin;
    int head;
    const bf16_t* G;
};

template <int DQK, bool NA, bool MLAQ>
__device__ __forceinline__ void attn_unit(const UnitDesc& U, ALAS char* shm, const float* qgain, const float* T16, const float* rpb_g) {
    constexpr int ND0 = DQK / 16, NCH = DQK / 8, NP = NCH + 8;
    int tid_ = threadIdx.x; asm volatile("" : "+v"(tid_));
    const int tid = tid_, lane = tid & 63, r32 = lane & 31, hi = lane >> 5; const int wid = __builtin_amdgcn_readfirstlane(tid >> 6);
#ifdef ATT_STATIC_PRIO_NA
    if (wid >= 4) __builtin_amdgcn_s_setprio(1);
#endif
    const unsigned lds0 = (unsigned)(uintptr_t)shm;
    ALAS float* wsf = (ALAS float*)(shm + LDS_WS) + wid * 64;
    unsigned doff[3];
#pragma unroll
    for (int i = 0; i < 3; ++i) { const int pc = wid + 8 * i;
        if (pc < NCH) doff[i] = (unsigned)((lane * U.kpitch + U.kcol + pc * 8) * 2);
        else { const int v = pc - NCH; doff[i] = (unsigned)(((16 * (v & 3) + (lane >> 2)) * U.vpitch + U.vcol + (v >> 2) * 32 + (lane & 3) * 8) * 2); } }
    auto dma_tile = [&](int t, int slot) {
        int key0;
        if (NA && t >= 4) key0 = U.kv0 + CTX + (U.rmin + (t - 4)) * GW; else key0 = U.kv0 + 64 * t;
        const unsigned sbase = lds0 + slot * SLOT;
        const bf16_t* kb_ = U.K + (size_t)key0 * U.kpitch; const bf16_t* vb_ = U.V + (size_t)key0 * U.vpitch;
#pragma unroll
        for (int i = 0; i < 3; ++i) { const int pc = wid + 8 * i;
            if (pc < NP) {
                if (pc < NCH) glds16s(doff[i], kb_, (unsigned)__builtin_amdgcn_readfirstlane(sbase + pc * 1024));
                else glds16s(doff[i], vb_, (unsigned)__builtin_amdgcn_readfirstlane(sbase + KSLOT + (pc - NCH) * 1024));
#ifdef ATT_DUP_DMA
                if (pc < NCH) glds16s(doff[i], kb_, (unsigned)__builtin_amdgcn_readfirstlane(sbase + pc * 1024));
                else glds16s(doff[i], vb_, (unsigned)__builtin_amdgcn_readfirstlane(sbase + KSLOT + (pc - NCH) * 1024));
#endif
            } }
    };
    asm volatile("s_waitcnt vmcnt(0)" ::: "memory");
#pragma unroll
    for (int t0_ = 0; t0_ < PD; ++t0_) if (t0_ < U.nt) dma_tile(t0_, t0_);
    bf16x8 qr[ND0];
    const bf16_t* Qw = U.Q + (size_t)(U.q0 + wid * 32 + r32) * U.qpitch + U.qcol;
#pragma unroll
    for (int d0 = 0; d0 < ND0; ++d0) qr[d0] = *(const bf16x8*)(Qw + d0 * 16 + hi * 8);
    if (MLAQ) {
        float f[ND0][8]; float ss = 0.f;
#pragma unroll
        for (int d0 = 0; d0 < ND0; ++d0)
#pragma unroll
            for (int j = 0; j < 8; ++j) { f[d0][j] = bf2f((bf16_t)qr[d0][j]); ss += f[d0][j] * f[d0][j]; }
        ss += __shfl_xor(ss, 32);
        const float rn = rsqrtf(ss * (1.f / 96.f) + EPS) * C2_96;
#pragma unroll
        for (int d0 = 0; d0 < ND0; ++d0)
#pragma unroll
            for (int j = 0; j < 8; ++j) f[d0][j] = f[d0][j] * rn * qgain[d0 * 16 + hi * 8 + j];
        const int t = (int)((U.q0 + wid * 32 + r32) % S); const int grow = t / GW, gcol = t % GW;
#pragma unroll
        for (int part = 0; part < 2; ++part) { const int pos = part ? gcol : grow;
#pragma unroll
            for (int j = 0; j < 8; ++j) { const float cs = T16[pos * 8 + j], sn = T16[512 + pos * 8 + j];
                const float mine = f[4 + part][j], other = __shfl_xor(mine, 32);
                f[4 + part][j] = hi == 0 ? (mine * cs - other * sn) : (other * sn + mine * cs); } }
#pragma unroll
        for (int d0 = 0; d0 < ND0; ++d0)
#pragma unroll
            for (int j = 0; j < 4; ++j) { const unsigned w = cvtpk(f[d0][2 * j], f[d0][2 * j + 1]); qr[d0][2 * j] = (short)(w & 0xffff); qr[d0][2 * j + 1] = (short)(w >> 16); }
    }
    const int grow_w = NA ? 4 * U.rg + (wid >> 1) : 0, c0w = 32 * (wid & 1);
    const int r0w = NA ? min(max(grow_w - 4, 0), 24) : 0;
    const int qc = c0w + r32;
    const int cs_q = min(max(qc - 8, 0), 48);
    float mhat = 0.f, l_reg = 0.f; f32x16 o[2]; o[0] = f32x16{}; o[1] = f32x16{};
    const ALAS char* vp0 = shm + KSLOT + ((lane >> 4) & 1) * 32 + (lane & 3) * 8 + (4 * hi + ((lane & 15) >> 2)) * 64;
    const int NT = U.nt;
    f32x16 a0, a1, b0, b1;
    u32x4 pw0, pw1, pw2, pw3;
    auto wait_tile = [&](int t) {
        const int ahead = min(PD - 1, NT - 1 - t);
        const bool big = (NP == 20 && wid < 4);
#ifdef ATT_DUP_DMA
        if (ahead >= 1) { if (big) AWAIT_BAR(6); else AWAIT_BAR(4); }
        else AWAIT_BAR(0);
#else
        if (ahead >= 2) { if (big) AWAIT_BAR(6); else AWAIT_BAR(4); }
        else if (ahead == 1) { if (big) AWAIT_BAR(3); else AWAIT_BAR(2); }
        else AWAIT_BAR(0);
#endif
        if (t + PD < NT) dma_tile(t + PD, (t + PD) % NSLOT);
    };
    bf16x8 eq[2];
    if (NA) {
#pragma unroll
        for (int s_ = 0; s_ < 2; ++s_)
#pragma unroll
            for (int jj = 0; jj < 8; ++jj) eq[s_][jj] = (16 * s_ + 8 * hi + jj == r32) ? (short)0x3f80 : (short)0;
    }
    const bf16_t* gq = NA ? U.G + (size_t)U.head * (16 * 2 * 64 * 32) + (size_t)(wid & 1) * (64 * 32) + r32 * 32 + hi * 8 : nullptr;
    auto gbias_load = [&](bf16x8 (&f)[4], int t) {
        const int krow = U.rmin + (t - 4); int dr = krow - grow_w + 7; if (krow < r0w || krow >= r0w + 8) dr = 15;
        const bf16_t* g = gq + (size_t)dr * (2 * 64 * 32);
#pragma unroll
        for (int half = 0; half < 2; ++half)
#pragma unroll
            for (int s_ = 0; s_ < 2; ++s_) f[2 * s_ + half] = *(const bf16x8*)(g + half * 1024 + s_ * 16);
    };
    auto gbias_mma = [&](f32x16& c0, f32x16& c1, const bf16x8 (&f)[4]) {
        c0 = __builtin_amdgcn_mfma_f32_32x32x16_bf16(f[0], eq[0], c0, 0, 0, 0); c1 = __builtin_amdgcn_mfma_f32_32x32x16_bf16(f[1], eq[0], c1, 0, 0, 0);
        c0 = __builtin_amdgcn_mfma_f32_32x32x16_bf16(f[2], eq[1], c0, 0, 0, 0); c1 = __builtin_amdgcn_mfma_f32_32x32x16_bf16(f[3], eq[1], c1, 0, 0, 0);
    };
    constexpr bool NEGM = true;
    f32x16 negm = f32x16{};
    auto decide = [&](f32x16& c0, f32x16& c1, bool first) -> bool {
        const float rm = rowmax32(c0, c1);
        if (first || __any(rm > THR)) {
            const float dl = first ? rm : fmaxf(rm, 0.f);
            mhat += dl;
#pragma unroll
            for (int r = 0; r < 16; ++r) { c0[r] -= dl; c1[r] -= dl; }
#pragma unroll
            for (int r = 0; r < 16; ++r) negm[r] = -mhat;
            if (!first) { const float f = __builtin_amdgcn_exp2f(-dl); l_reg *= f; if (hi == 0) wsf[r32] = f; return true; }
        }
        return false;
    };
    auto rescale_o = [&]() {
        asm volatile("s_waitcnt lgkmcnt(0)" ::: "memory");
#pragma unroll
        for (int r = 0; r < 16; ++r) { const float fr_ = wsf[crow(r, hi)]; o[0][r] *= fr_; o[1][r] *= fr_; }
    };
    auto expo = [&](f32x16& c0, f32x16& c1) {
#pragma unroll
        for (int r = 0; r < 16; ++r) { c0[r] = __builtin_amdgcn_exp2f(c0[r]); c1[r] = __builtin_amdgcn_exp2f(c1[r]); }
    };
    auto sumpack = [&](const f32x16& c0, const f32x16& c1) {
        float s4[4];
#pragma unroll
        for (int k = 0; k < 4; ++k) s4[k] = c0[k] + c1[k];
#pragma unroll
        for (int r = 4; r < 16; ++r) s4[r & 3] += c0[r] + c1[r];
        l_reg += (s4[0] + s4[1]) + (s4[2] + s4[3]);
#pragma unroll
        for (int j = 0; j < 4; ++j) { pw0[j] = cvtpk(c0[2 * j], c0[2 * j + 1]); pw1[j] = cvtpk(c0[8 + 2 * j], c0[9 + 2 * j]); pw2[j] = cvtpk(c1[2 * j], c1[2 * j + 1]); pw3[j] = cvtpk(c1[8 + 2 * j], c1[9 + 2 * j]); }
    };
    auto step = [&](f32x16& c0, f32x16& c1, f32x16& q0, f32x16& q1, int j) {
        wait_tile(j);
        bf16x8 gf[4];
        if (NA && j >= 4) gbias_load(gf, j);
        qkt<ND0>(c0, c1, shm + (j % NSLOT) * SLOT, qr, negm, r32, hi);
        if (NA && j >= 4) gbias_mma(c0, c1, gf);
        sumpack(q0, q1);
        const bool resc = decide(c0, c1, false);
        pv(o, vp0 + ((j - 1) % NSLOT) * SLOT, __builtin_bit_cast(bf16x8, pw0), __builtin_bit_cast(bf16x8, pw1), __builtin_bit_cast(bf16x8, pw2), __builtin_bit_cast(bf16x8, pw3));
        expo(c0, c1);
        if (resc) rescale_o();
    };
    wait_tile(0);
    qkt<ND0>(a0, a1, shm, qr, negm, r32, hi);
    (void)decide(a0, a1, true);
    expo(a0, a1);
    int j = 1;
#pragma unroll 1
    for (; j + 1 < NT; j += 2) { step(b0, b1, a0, a1, j); step(a0, a1, b0, b1, j + 1); }
    if (j < NT) { step(b0, b1, a0, a1, j); sumpack(b0, b1); } else sumpack(a0, a1);
    pv(o, vp0 + ((NT - 1) % NSLOT) * SLOT, __builtin_bit_cast(bf16x8, pw0), __builtin_bit_cast(bf16x8, pw1), __builtin_bit_cast(bf16x8, pw2), __builtin_bit_cast(bf16x8, pw3));
    { auto rr = __builtin_amdgcn_permlane32_swap(__float_as_uint(l_reg), __float_as_uint(l_reg), false, false); l_reg = __uint_as_float(rr[0]) + __uint_as_float(rr[1]); }
    if (hi == 0) wsf[32 + r32] = l_reg;
    asm volatile("s_waitcnt lgkmcnt(0)" ::: "memory");
    float rli[16];
#pragma unroll
    for (int r = 0; r < 16; ++r) rli[r] = __builtin_amdgcn_rcpf(wsf[32 + crow(r, hi)]);
    bf16_t* Ow = U.O + (size_t)(U.q0 + wid * 32) * U.opitch + U.ocol;
    { ALAS bf16_t* stg = (ALAS bf16_t*)(shm + LDS_OST) + wid * 2048;
#pragma unroll
        for (int r = 0; r < 16; ++r) { const int orow = crow(r, hi);
#pragma unroll
            for (int d0 = 0; d0 < 2; ++d0) stg[orow * 64 + d0 * 32 + r32] = f2bf(o[d0][r] * rli[r]); }
        asm volatile("s_waitcnt lgkmcnt(0)" ::: "memory");
#pragma unroll
        for (int i = 0; i < 4; ++i) { const int row = i * 8 + (lane >> 3), ch = lane & 7; const u32x4 v = *(const ALAS u32x4*)(stg + row * 64 + ch * 8); *(u32x4*)(Ow + (size_t)row * U.opitch + ch * 8) = v; } }
#ifdef ATT_STATIC_PRIO_NA
    __builtin_amdgcn_s_setprio(0);
#endif
    asm volatile("s_waitcnt vmcnt(0) lgkmcnt(0)\n\ts_barrier" ::: "memory");
}
}
#include <hip/hip_bf16.h>
namespace att64 {
using bf16=__hip_bfloat16;
using bf16x8=__attribute__((ext_vector_type(8)))short;
using s16x4=__attribute__((ext_vector_type(4)))short;
using f32x16=__attribute__((ext_vector_type(16)))float;
using u32x4=__attribute__((ext_vector_type(4)))unsigned;
constexpr int D=64;
constexpr int NW=8,QBLK=32,QB=QBLK*NW,KVBLK=64;

__device__ __forceinline__ int crow(int r,int hi){return (r&3)+8*(r>>2)+4*hi;}
#define SBAR() __builtin_amdgcn_sched_barrier(0)
__device__ __forceinline__ void cmask(f32x16&p0,f32x16&p1,int jb,int qrel,int hi){
  const float NEG=-INFINITY; int kb=64*jb+4*hi;
  #pragma unroll
  for(int r=0;r<16;++r){int kv=kb+(r&3)+8*(r>>2); if(kv>qrel)p0[r]=NEG; if(kv+32>qrel)p1[r]=NEG;}
}

constexpr int NSLOT=3, SLOTB=8192;
constexpr int LDS_K=0, LDS_V=NSLOT*SLOTB, LDS_WS=2*NSLOT*SLOTB, LDS_OST=LDS_WS+NW*64*4, LDS_BYTES=LDS_OST+NW*4096;
constexpr float C2=0.125f*1.4426950408889634f;
__device__ __forceinline__ void glds16(const void*gsrc,unsigned lds_dst){unsigned keep;
  asm volatile("s_mov_b32 %0, m0\n\ts_mov_b32 m0, %2\n\ts_nop 0\n\tglobal_load_lds_dwordx4 %1, off\n\ts_mov_b32 m0, %0":"=&s"(keep):"v"(gsrc),"s"(lds_dst):"memory");}
__device__ __forceinline__ float max3f(float a,float b,float c){float r;asm("v_max3_f32 %0, %1, %2, %3":"=v"(r):"v"(a),"v"(b),"v"(c));return r;}
__device__ __forceinline__ float max2f(float a,float b){float r;asm("v_max_f32_e32 %0, %1, %2":"=v"(r):"v"(a),"v"(b));return r;}
__device__ __forceinline__ float fadd_s(float a,float b){float r;asm("v_add_f32_e32 %0, %1, %2":"=v"(r):"v"(a),"v"(b));return r;}
__device__ __forceinline__ float fsub_s(float a,float b){float r;asm("v_sub_f32_e32 %0, %1, %2":"=v"(r):"v"(a),"v"(b));return r;}
typedef float f32x2_t __attribute__((ext_vector_type(2))); typedef __bf16 bf16x2_t __attribute__((ext_vector_type(2)));
__device__ __forceinline__ unsigned cvtpk_s(float lo,float hi){f32x2_t v={lo,hi};bf16x2_t b=__builtin_convertvector(v,bf16x2_t);return __builtin_bit_cast(unsigned,b);}
#define WAIT_BAR(N) asm volatile("s_waitcnt vmcnt(" #N ") lgkmcnt(0)\n\ts_barrier":::"memory")

__device__ __forceinline__ void qkt(f32x16&p0,f32x16&p1,const char*Kslot,const bf16x8*qr,const f32x16&negm,int r32,int hi){
  const char*kb=Kslot+hi*1024+r32*16;
  #pragma unroll
  for(int d0=0;d0<4;++d0){
    const bf16x8 b0=*reinterpret_cast<const bf16x8*>(kb+d0*2048);
    const bf16x8 b1=*reinterpret_cast<const bf16x8*>(kb+d0*2048+512);
    if(d0==0){p0=__builtin_amdgcn_mfma_f32_32x32x16_bf16(b0,qr[0],negm,0,0,0);p1=__builtin_amdgcn_mfma_f32_32x32x16_bf16(b1,qr[0],negm,0,0,0);}
    else{p0=__builtin_amdgcn_mfma_f32_32x32x16_bf16(b0,qr[d0],p0,0,0,0);p1=__builtin_amdgcn_mfma_f32_32x32x16_bf16(b1,qr[d0],p1,0,0,0);}}
}
typedef __attribute__((address_space(3))) const char* lds_cptr;
typedef short v4i16_t __attribute__((ext_vector_type(4)));
__device__ __forceinline__ void kload8(bf16x8*kf,lds_cptr kp){
  kf[0]=*(const __attribute__((address_space(3))) bf16x8*)(kp);      kf[1]=*(const __attribute__((address_space(3))) bf16x8*)(kp+512);
  kf[2]=*(const __attribute__((address_space(3))) bf16x8*)(kp+2048); kf[3]=*(const __attribute__((address_space(3))) bf16x8*)(kp+2560);
  kf[4]=*(const __attribute__((address_space(3))) bf16x8*)(kp+4096); kf[5]=*(const __attribute__((address_space(3))) bf16x8*)(kp+4608);
  kf[6]=*(const __attribute__((address_space(3))) bf16x8*)(kp+6144); kf[7]=*(const __attribute__((address_space(3))) bf16x8*)(kp+6656);
}
__device__ __forceinline__ void kload2(bf16x8*kf,lds_cptr kp,int j){ kf[2*j]=*(const __attribute__((address_space(3))) bf16x8*)(kp+j*2048); kf[2*j+1]=*(const __attribute__((address_space(3))) bf16x8*)(kp+j*2048+512); }
__device__ __forceinline__ s16x4 vtr(lds_cptr p){ return __builtin_bit_cast(s16x4,__builtin_amdgcn_ds_read_tr16_b64_v4i16((__attribute__((address_space(3))) v4i16_t*)p)); }
__device__ __forceinline__ float rowmax(const f32x16&p0,const f32x16&p1){
  float a=max3f(p0[0],p0[1],p1[0]),b=max3f(p0[2],p0[3],p1[1]);a=max3f(a,p1[2],p1[3]);
  #pragma unroll
  for(int r=4;r<16;r+=4){a=max3f(a,p0[r],p0[r+1]);b=max3f(b,p0[r+2],p0[r+3]);a=max3f(a,p1[r],p1[r+1]);b=max3f(b,p1[r+2],p1[r+3]);}
  const float m=max2f(a,b);
  auto rr=__builtin_amdgcn_permlane32_swap(__float_as_uint(m),__float_as_uint(m),false,false);
  return max2f(__uint_as_float(rr[0]),__uint_as_float(rr[1]));
}
__device__ __forceinline__ void pv(f32x16*o,int vb,bf16x8 pa0,bf16x8 pa1,bf16x8 pa2,bf16x8 pa3){
  #pragma unroll
  for(int d0=0;d0<2;++d0){s16x4 lo[4],hi[4];
    #pragma unroll
    for(int ks=0;ks<4;++ks){
      asm volatile("ds_read_b64_tr_b16 %0,%1 offset:%c2":"=&v"(lo[ks]):"v"(vb),"i"(d0*4096+ks*1024):"memory");
      asm volatile("ds_read_b64_tr_b16 %0,%1 offset:%c2":"=&v"(hi[ks]):"v"(vb),"i"(d0*4096+ks*1024+512):"memory");}
    asm volatile("s_waitcnt lgkmcnt(0)":::"memory");SBAR();
    #define PK(k) (bf16x8){lo[k][0],lo[k][1],lo[k][2],lo[k][3],hi[k][0],hi[k][1],hi[k][2],hi[k][3]}
    o[d0]=__builtin_amdgcn_mfma_f32_32x32x16_bf16(pa0,PK(0),o[d0],0,0,0);
    o[d0]=__builtin_amdgcn_mfma_f32_32x32x16_bf16(pa1,PK(1),o[d0],0,0,0);
    o[d0]=__builtin_amdgcn_mfma_f32_32x32x16_bf16(pa2,PK(2),o[d0],0,0,0);
    o[d0]=__builtin_amdgcn_mfma_f32_32x32x16_bf16(pa3,PK(3),o[d0],0,0,0);
    #undef PK
  }
}

#ifndef ATTN_STORE16
#define ATTN_STORE16(p,v) (*(u32x4*)(p)=(v))
#endif
template<int THRL> __device__ __forceinline__ void attn_unit(long q0,const bf16*Q,int qp,int qcol,const bf16*__restrict__ K,int kp,int kcol,const bf16*__restrict__ V,int vp,int vcol,long kv0,int NT,bf16*O,int op,int ocol,char*shm){
  int tid_=threadIdx.x; asm volatile("":"+v"(tid_));
  const int tid=tid_,lane=tid&63,r32=lane&31,hi=lane>>5; const int wid=__builtin_amdgcn_readfirstlane(tid>>6);
#ifdef ATT_STATIC_PRIO
  if(wid>=4)__builtin_amdgcn_s_setprio(1);
#endif
  const bf16*Qw=Q+(q0+wid*QBLK)*qp+qcol;
  const bf16*Kh=K+kv0*kp+kcol,*Vh=V+kv0*vp+vcol;
  const unsigned lds0=(unsigned)(uintptr_t)shm;
  float*wsf=(float*)(shm+LDS_WS)+wid*64;
  const bf16*ksrc=Kh+(long)lane*kp+wid*8;
  const bf16*vsrc=Vh+(long)(16*(wid&3)+(lane>>2))*vp+(wid>>2)*32+(lane&3)*8;
  const unsigned kdst=lds0+LDS_K+wid*1024, vdst=lds0+LDS_V+wid*1024;
  #define DMA_K(t,slot) glds16(ksrc+(long)(t)*KVBLK*kp,(unsigned)__builtin_amdgcn_readfirstlane(kdst+(slot)))
  #define DMA_V(t,slot) glds16(vsrc+(long)(t)*KVBLK*vp,(unsigned)__builtin_amdgcn_readfirstlane(vdst+(slot)))
  const int vb0=(int)(lds0+LDS_V)+((lane>>4)&1)*32+(lane&3)*8+(4*hi+((lane&15)>>2))*64;
  const char*Kbase=shm+LDS_K; bf16x8 kf[8];
  const lds_cptr shm3=(lds_cptr)shm; const lds_cptr kp0=shm3+LDS_K+hi*1024+r32*16; const lds_cptr vp0=shm3+LDS_V+((lane>>4)&1)*32+(lane&3)*8+(4*hi+((lane&15)>>2))*64;
  DMA_K(0,0);DMA_V(0,0);DMA_K(1,SLOTB);
  bf16x8 qr[4];
  #pragma unroll
  for(int d0=0;d0<4;++d0)qr[d0]=*reinterpret_cast<const bf16x8*>(&Qw[(long)r32*qp+d0*16+hi*8]);
  float mhat=0.f,l_reg=0.f;f32x16 o[2];o[0]=f32x16{};o[1]=f32x16{};f32x16 negm=f32x16{};asm volatile("":"+v"(negm));
  #define CMASK(P0,P1,t) do{}while(0)
  bool resc=false;
  #define START(P0,P1) do{ const float rm=rowmax(P0,P1); resc=false; \
    { const float dl=rm; mhat=fadd_s(mhat,dl); \
      _Pragma("unroll") for(int r=0;r<16;++r){P0[r]=fsub_s(P0[r],dl);P1[r]=fsub_s(P1[r],dl);} \
      _Pragma("unroll") for(int r=0;r<16;++r)negm[r]=-mhat; asm volatile("":"+v"(negm)); } \
    _Pragma("unroll") for(int r=0;r<16;++r)P0[r]=__builtin_amdgcn_exp2f(P0[r]); }while(0)
  #define RESC() do{ if(resc){ asm volatile("s_waitcnt lgkmcnt(0)":::"memory"); \
      _Pragma("unroll") for(int d_=0;d_<2;++d_) _Pragma("unroll") for(int r=0;r<16;++r)o[d_][r]*=wsf[crow(r,hi)]; } }while(0)
  f32x16 pA0,pA1,pB0,pB1;
  int sl_prev=0,sl_cur=0,sl_next=SLOTB;
  #define ROT() do{sl_prev=sl_cur;sl_cur=sl_next;sl_next=(sl_next==(NSLOT-1)*SLOTB)?0:sl_next+SLOTB;}while(0)
  DMA_K(2,2*SLOTB);
  WAIT_BAR(3);
  qkt(pA0,pA1,Kbase,qr,negm,r32,hi);asm volatile("s_nop 15\n\ts_nop 7":"+v"(pA0),"+v"(pA1));CMASK(pA0,pA1,0);
  START(pA0,pA1);
  _Pragma("unroll") for(int r=0;r<16;++r)pA1[r]=__builtin_amdgcn_exp2f(pA1[r]);
  WAIT_BAR(0);
  DMA_K(3,0);DMA_V(1,SLOTB);
  ROT();
  kload8(kf,kp0+sl_cur);
  WAIT_BAR(2);
  s16x4 vlo[8],vhi[8]; u32x4 pw0,pw1,pw2,pw3;
  #define PKW(P,B) cvtpk_s(P[B],P[B+1])
  #define PAF(k) __builtin_bit_cast(bf16x8,pw##k)
  #define VFR(i) (bf16x8){vlo[i][0],vlo[i][1],vlo[i][2],vlo[i][3],vhi[i][0],vhi[i][1],vhi[i][2],vhi[i][3]}
  #define PIN(x) asm volatile("":"+v"(x))
  #define MX3(a,b,c) __builtin_fmaxf(__builtin_fmaxf((a),(b)),(c))
  #define GAPA(MF,A0,A1,A2,A3,W0,W1,PW) do{ MF; sacc+=A0; sacc+=A1; sacc+=A2; sacc+=A3; PIN(sacc); W0; W1; PIN(PW); SBAR(); }while(0)
  #define EX(v) __builtin_amdgcn_exp2f(v)
  #define GAPB(MF,X,B) do{ MF; X[B]=EX(X[B]); X[B+1]=EX(X[B+1]); X[B+2]=EX(X[B+2]); X[B+3]=EX(X[B+3]); PIN(X); SBAR(); }while(0)
  #define VRD(i) do{ vlo[i]=vtr(vp_+(((i)>>2)*4096+((i)&3)*1024)); vhi[i]=vtr(vp_+(((i)>>2)*4096+((i)&3)*1024+512)); }while(0)
  #define KRD(G,j) do{ if(G){ kload2(kf,kp0+sl_next,j); SBAR(); } }while(0)
  #define STEP(C0,C1,P0,P1,t,GK,GV,GL) do{ SBAR(); \
    const lds_cptr vp_=vp0+sl_prev; \
    VRD(0); SBAR(); float sacc=(P0[0]+P0[1]); \
    GAPA(C0=__builtin_amdgcn_mfma_f32_32x32x16_bf16(kf[0],qr[0],negm,0,0,0), P0[2],P0[3],P0[4],P0[5],     pw0[0]=PKW(P0,0), pw0[1]=PKW(P0,2), pw0); \
    VRD(4); SBAR(); GAPA(C1=__builtin_amdgcn_mfma_f32_32x32x16_bf16(kf[1],qr[0],negm,0,0,0), P0[6],P0[7],P0[8],P0[9],     pw0[2]=PKW(P0,4), pw0[3]=PKW(P0,6), pw0); \
    VRD(1); SBAR(); GAPA(C0=__builtin_amdgcn_mfma_f32_32x32x16_bf16(kf[2],qr[1],C0,0,0,0),   P0[10],P0[11],P0[12],P0[13], pw1[0]=PKW(P0,8), pw1[1]=PKW(P0,10), pw1); \
    VRD(5); SBAR(); GAPA(C1=__builtin_amdgcn_mfma_f32_32x32x16_bf16(kf[3],qr[1],C1,0,0,0),   P0[14],P0[15],P1[0],P1[1],   pw1[2]=PKW(P0,12),pw1[3]=PKW(P0,14), pw1); \
    VRD(2); SBAR(); GAPA(C0=__builtin_amdgcn_mfma_f32_32x32x16_bf16(kf[4],qr[2],C0,0,0,0),   P1[2],P1[3],P1[4],P1[5],     pw2[0]=PKW(P1,0), pw2[1]=PKW(P1,2), pw2); \
    VRD(6); SBAR(); GAPA(C1=__builtin_amdgcn_mfma_f32_32x32x16_bf16(kf[5],qr[2],C1,0,0,0),   P1[6],P1[7],P1[8],P1[9],     pw2[2]=PKW(P1,4), pw2[3]=PKW(P1,6), pw2); \
    VRD(3); SBAR(); GAPA(C0=__builtin_amdgcn_mfma_f32_32x32x16_bf16(kf[6],qr[3],C0,0,0,0),   P1[10],P1[11],P1[12],P1[13], pw3[0]=PKW(P1,8), pw3[1]=PKW(P1,10), pw3); \
    VRD(7); SBAR(); GAPA(C1=__builtin_amdgcn_mfma_f32_32x32x16_bf16(kf[7],qr[3],C1,0,0,0),   P1[14],P1[15],0.f,0.f,       pw3[2]=PKW(P1,12),pw3[3]=PKW(P1,14), pw3); \
    l_reg+=sacc; \
    if(GK){DMA_K((t)+3,sl_cur);} if(GV){DMA_V((t)+1,sl_next);} \
    CMASK(C0,C1,t); \
    { float a=MX3(C0[0],C0[1],C1[0]),b=MX3(C0[2],C0[3],C1[1]); a=MX3(a,C1[2],C1[3]); \
      _Pragma("unroll") for(int r=4;r<16;r+=4){a=MX3(a,C0[r],C0[r+1]);b=MX3(b,C0[r+2],C0[r+3]);a=MX3(a,C1[r],C1[r+1]);b=MX3(b,C1[r+2],C1[r+3]);} \
      float rm=__builtin_fmaxf(a,b); { auto rr=__builtin_amdgcn_permlane32_swap(__float_as_uint(rm),__float_as_uint(rm),false,false); rm=__builtin_fmaxf(__uint_as_float(rr[0]),__uint_as_float(rr[1])); } \
      resc=false; \
      if(__builtin_expect(__any(rm>(float)THRL),0)){ const float dl=__builtin_fmaxf(rm,0.f); mhat+=dl; \
        _Pragma("unroll") for(int r=0;r<16;++r){C0[r]-=dl;C1[r]-=dl;} \
        _Pragma("unroll") for(int r=0;r<16;++r)negm[r]=-mhat; asm volatile("":"+v"(negm)); \
        const float f=__builtin_amdgcn_exp2f(-dl); l_reg*=f; if(hi==0)wsf[r32]=f; resc=true; } } \
    SBAR(); \
    GAPB(o[0]=__builtin_amdgcn_mfma_f32_32x32x16_bf16(PAF(0),VFR(0),o[0],0,0,0), C0,0); \
    GAPB(o[1]=__builtin_amdgcn_mfma_f32_32x32x16_bf16(PAF(0),VFR(4),o[1],0,0,0), C0,4); \
    KRD(GL,0); GAPB(o[0]=__builtin_amdgcn_mfma_f32_32x32x16_bf16(PAF(1),VFR(1),o[0],0,0,0), C0,8); \
    KRD(GL,1); GAPB(o[1]=__builtin_amdgcn_mfma_f32_32x32x16_bf16(PAF(1),VFR(5),o[1],0,0,0), C0,12); \
    KRD(GL,2); GAPB(o[0]=__builtin_amdgcn_mfma_f32_32x32x16_bf16(PAF(2),VFR(2),o[0],0,0,0), C1,0); \
    KRD(GL,3); GAPB(o[1]=__builtin_amdgcn_mfma_f32_32x32x16_bf16(PAF(2),VFR(6),o[1],0,0,0), C1,4); \
    GAPB(o[0]=__builtin_amdgcn_mfma_f32_32x32x16_bf16(PAF(3),VFR(3),o[0],0,0,0), C1,8); \
    GAPB(o[1]=__builtin_amdgcn_mfma_f32_32x32x16_bf16(PAF(3),VFR(7),o[1],0,0,0), C1,12); \
    }while(0)
  int t=1;
  #undef CMASK
  #define CMASK(P0,P1,t) do{}while(0)
  for(;t+5<NT;t+=2){
    STEP(pB0,pB1,pA0,pA1,t,true,true,true);     WAIT_BAR(2); RESC(); ROT();
    STEP(pA0,pA1,pB0,pB1,t+1,true,true,true);   WAIT_BAR(2); RESC(); ROT();
  }
  #undef CMASK
  #define CMASK(P0,P1,t) do{}while(0)
  #define ENDW(tt) do{ if((tt)+3<NT){WAIT_BAR(2);} else if((tt)+2<NT){WAIT_BAR(1);} else {WAIT_BAR(0);} }while(0)
  for(;t+1<NT;t+=2){
    STEP(pB0,pB1,pA0,pA1,t,(t+3<NT),(t+1<NT),(t+1<NT));       ENDW(t);   RESC(); ROT();
    STEP(pA0,pA1,pB0,pB1,t+1,(t+4<NT),(t+2<NT),(t+2<NT));     ENDW(t+1); RESC(); ROT();
  }
  STEP(pB0,pB1,pA0,pA1,NT-1,false,false,false); RESC();
  { float sacc=pB0[0]+pB0[1]; _Pragma("unroll") for(int r=2;r<16;++r)sacc+=pB0[r]; _Pragma("unroll") for(int r=0;r<16;++r)sacc+=pB1[r]; l_reg+=sacc;
    pw0=(u32x4){PKW(pB0,0),PKW(pB0,2),PKW(pB0,4),PKW(pB0,6)};pw1=(u32x4){PKW(pB0,8),PKW(pB0,10),PKW(pB0,12),PKW(pB0,14)};pw2=(u32x4){PKW(pB1,0),PKW(pB1,2),PKW(pB1,4),PKW(pB1,6)};pw3=(u32x4){PKW(pB1,8),PKW(pB1,10),PKW(pB1,12),PKW(pB1,14)};
    SBAR(); pv(o,vb0+sl_cur,PAF(0),PAF(1),PAF(2),PAF(3)); }
  #undef PKW
  #undef PAF
  #undef VFR
  #undef PIN
  #undef MX3
  #undef GAPA
  #undef GAPB
  #undef EX
  #undef VRD
  #undef KRD
  #undef STEP
  #undef ENDW
  {auto rr=__builtin_amdgcn_permlane32_swap(__float_as_uint(l_reg),__float_as_uint(l_reg),false,false);l_reg=__uint_as_float(rr[0])+__uint_as_float(rr[1]);}
  if(hi==0)wsf[32+r32]=l_reg;asm volatile("s_waitcnt lgkmcnt(0)":::"memory");
  float rli[16];
  #pragma unroll
  for(int r=0;r<16;++r)rli[r]=__builtin_amdgcn_rcpf(wsf[32+crow(r,hi)]);
  bf16*Ow=O+(q0+wid*QBLK)*op+ocol;
  { bf16*stg=(bf16*)(shm+LDS_OST)+wid*2048;
    #pragma unroll
    for(int r=0;r<16;++r){const int orow=crow(r,hi);
      #pragma unroll
      for(int d0=0;d0<2;++d0)stg[orow*64+d0*32+r32]=__float2bfloat16(o[d0][r]*rli[r]);}
    asm volatile("s_waitcnt lgkmcnt(0)":::"memory");
    #pragma unroll
    for(int i=0;i<4;++i){const int row=i*8+(lane>>3),ch=lane&7; const u32x4 v=*(const u32x4*)(stg+row*64+ch*8); ATTN_STORE16(Ow+(long)row*op+ch*8,v);} }
#ifdef ATT_STATIC_PRIO
  __builtin_amdgcn_s_setprio(0);
#endif
  asm volatile("s_waitcnt lgkmcnt(0)\n\ts_barrier":::"memory");
  #undef DMA_K
  #undef DMA_V
  #undef CMASK
  #undef START
  #undef RESC
  #undef ROT
}
constexpr int ATTN_LDS_BYTES=LDS_BYTES;

#undef SBAR
#undef WAIT_BAR
}
namespace att96 {
using bf16=__hip_bfloat16;
using bf16x8=__attribute__((ext_vector_type(8)))short;
using s16x4=__attribute__((ext_vector_type(4)))short;
using f32x16=__attribute__((ext_vector_type(16)))float;
using u32x4=__attribute__((ext_vector_type(4)))unsigned;
constexpr int D=64;
constexpr int NW=8,QBLK=32,QB=QBLK*NW,KVBLK=64;

__device__ __forceinline__ int crow(int r,int hi){return (r&3)+8*(r>>2)+4*hi;}
#define SBAR() __builtin_amdgcn_sched_barrier(0)
__device__ __forceinline__ void cmask(f32x16&p0,f32x16&p1,int jb,int qrel,int hi){
  const float NEG=-INFINITY; int kb=64*jb+4*hi;
  #pragma unroll
  for(int r=0;r<16;++r){int kv=kb+(r&3)+8*(r>>2); if(kv>qrel)p0[r]=NEG; if(kv+32>qrel)p1[r]=NEG;}
}

constexpr int NSLOT=3, SLOTB=8192;
constexpr int KSLOTB=12288;
constexpr int LDS_K=0, LDS_V=NSLOT*KSLOTB, LDS_WS=LDS_V+NSLOT*SLOTB, LDS_OST=LDS_WS+NW*64*4, LDS_BYTES=LDS_OST+NW*4096;
constexpr float C2=0.125f*1.4426950408889634f;
__device__ __forceinline__ void glds16(const void*gsrc,unsigned lds_dst){unsigned keep;
  asm volatile("s_mov_b32 %0, m0\n\ts_mov_b32 m0, %2\n\ts_nop 0\n\tglobal_load_lds_dwordx4 %1, off\n\ts_mov_b32 m0, %0":"=&s"(keep):"v"(gsrc),"s"(lds_dst):"memory");}
__device__ __forceinline__ float max3f(float a,float b,float c){float r;asm("v_max3_f32 %0, %1, %2, %3":"=v"(r):"v"(a),"v"(b),"v"(c));return r;}
__device__ __forceinline__ float max2f(float a,float b){float r;asm("v_max_f32_e32 %0, %1, %2":"=v"(r):"v"(a),"v"(b));return r;}
__device__ __forceinline__ float fadd_s(float a,float b){float r;asm("v_add_f32_e32 %0, %1, %2":"=v"(r):"v"(a),"v"(b));return r;}
__device__ __forceinline__ float fsub_s(float a,float b){float r;asm("v_sub_f32_e32 %0, %1, %2":"=v"(r):"v"(a),"v"(b));return r;}
typedef float f32x2_t __attribute__((ext_vector_type(2))); typedef __bf16 bf16x2_t __attribute__((ext_vector_type(2)));
__device__ __forceinline__ unsigned cvtpk_s(float lo,float hi){f32x2_t v={lo,hi};bf16x2_t b=__builtin_convertvector(v,bf16x2_t);return __builtin_bit_cast(unsigned,b);}
#define KOFF(sl) ((sl)+((sl)>>1))
#define WAIT_BAR(N) asm volatile("s_waitcnt vmcnt(" #N ") lgkmcnt(0)\n\ts_barrier":::"memory")

__device__ __forceinline__ void qkt(f32x16&p0,f32x16&p1,const char*Kslot,const bf16x8*qr,const f32x16&negm,int r32,int hi){
  const char*kb=Kslot+hi*1024+r32*16;
  #pragma unroll
  for(int d0=0;d0<6;++d0){
    const bf16x8 b0=*reinterpret_cast<const bf16x8*>(kb+d0*2048);
    const bf16x8 b1=*reinterpret_cast<const bf16x8*>(kb+d0*2048+512);
    if(d0==0){p0=__builtin_amdgcn_mfma_f32_32x32x16_bf16(b0,qr[0],negm,0,0,0);p1=__builtin_amdgcn_mfma_f32_32x32x16_bf16(b1,qr[0],negm,0,0,0);}
    else{p0=__builtin_amdgcn_mfma_f32_32x32x16_bf16(b0,qr[d0],p0,0,0,0);p1=__builtin_amdgcn_mfma_f32_32x32x16_bf16(b1,qr[d0],p1,0,0,0);}}
}
typedef __attribute__((address_space(3))) const char* lds_cptr;
typedef short v4i16_t __attribute__((ext_vector_type(4)));
__device__ __forceinline__ void kload12(bf16x8*kf,lds_cptr kp){
  kf[0]=*(const __attribute__((address_space(3))) bf16x8*)(kp);      kf[1]=*(const __attribute__((address_space(3))) bf16x8*)(kp+512);
  kf[2]=*(const __attribute__((address_space(3))) bf16x8*)(kp+2048); kf[3]=*(const __attribute__((address_space(3))) bf16x8*)(kp+2560);
  kf[4]=*(const __attribute__((address_space(3))) bf16x8*)(kp+4096); kf[5]=*(const __attribute__((address_space(3))) bf16x8*)(kp+4608);
  kf[6]=*(const __attribute__((address_space(3))) bf16x8*)(kp+6144); kf[7]=*(const __attribute__((address_space(3))) bf16x8*)(kp+6656);
  kf[8]=*(const __attribute__((address_space(3))) bf16x8*)(kp+8192); kf[9]=*(const __attribute__((address_space(3))) bf16x8*)(kp+8704);
  kf[10]=*(const __attribute__((address_space(3))) bf16x8*)(kp+10240); kf[11]=*(const __attribute__((address_space(3))) bf16x8*)(kp+10752);
}
__device__ __forceinline__ void kload2(bf16x8*kf,lds_cptr kp,int j){ kf[2*j]=*(const __attribute__((address_space(3))) bf16x8*)(kp+j*2048); kf[2*j+1]=*(const __attribute__((address_space(3))) bf16x8*)(kp+j*2048+512); }
__device__ __forceinline__ s16x4 vtr(lds_cptr p){ return __builtin_bit_cast(s16x4,__builtin_amdgcn_ds_read_tr16_b64_v4i16((__attribute__((address_space(3))) v4i16_t*)p)); }
__device__ __forceinline__ float rowmax(const f32x16&p0,const f32x16&p1){
  float a=max3f(p0[0],p0[1],p1[0]),b=max3f(p0[2],p0[3],p1[1]);a=max3f(a,p1[2],p1[3]);
  #pragma unroll
  for(int r=4;r<16;r+=4){a=max3f(a,p0[r],p0[r+1]);b=max3f(b,p0[r+2],p0[r+3]);a=max3f(a,p1[r],p1[r+1]);b=max3f(b,p1[r+2],p1[r+3]);}
  const float m=max2f(a,b);
  auto rr=__builtin_amdgcn_permlane32_swap(__float_as_uint(m),__float_as_uint(m),false,false);
  return max2f(__uint_as_float(rr[0]),__uint_as_float(rr[1]));
}
__device__ __forceinline__ void pv(f32x16*o,int vb,bf16x8 pa0,bf16x8 pa1,bf16x8 pa2,bf16x8 pa3){
  #pragma unroll
  for(int d0=0;d0<2;++d0){s16x4 lo[4],hi[4];
    #pragma unroll
    for(int ks=0;ks<4;++ks){
      asm volatile("ds_read_b64_tr_b16 %0,%1 offset:%c2":"=&v"(lo[ks]):"v"(vb),"i"(d0*4096+ks*1024):"memory");
      asm volatile("ds_read_b64_tr_b16 %0,%1 offset:%c2":"=&v"(hi[ks]):"v"(vb),"i"(d0*4096+ks*1024+512):"memory");}
    asm volatile("s_waitcnt lgkmcnt(0)":::"memory");SBAR();
    #define PK(k) (bf16x8){lo[k][0],lo[k][1],lo[k][2],lo[k][3],hi[k][0],hi[k][1],hi[k][2],hi[k][3]}
    o[d0]=__builtin_amdgcn_mfma_f32_32x32x16_bf16(pa0,PK(0),o[d0],0,0,0);
    o[d0]=__builtin_amdgcn_mfma_f32_32x32x16_bf16(pa1,PK(1),o[d0],0,0,0);
    o[d0]=__builtin_amdgcn_mfma_f32_32x32x16_bf16(pa2,PK(2),o[d0],0,0,0);
    o[d0]=__builtin_amdgcn_mfma_f32_32x32x16_bf16(pa3,PK(3),o[d0],0,0,0);
    #undef PK
  }
}

#ifndef ATTN_STORE16
#define ATTN_STORE16(p,v) (*(u32x4*)(p)=(v))
#endif
template<int THRL> __device__ __forceinline__ void attn_unit(long q0,const bf16*Q,int qp,int qcol,const bf16*__restrict__ K,int kp,int kcol,const bf16*__restrict__ V,int vp,int vcol,long kv0,int NT,bf16*O,int op,int ocol,char*shm,const float*qgain,const float*T16){
  int tid_=threadIdx.x; asm volatile("":"+v"(tid_));
  const int tid=tid_,lane=tid&63,r32=lane&31,hi=lane>>5; const int wid=__builtin_amdgcn_readfirstlane(tid>>6);
#ifdef ATT_STATIC_PRIO
  if(wid>=4)__builtin_amdgcn_s_setprio(1);
#endif
  const bf16*Qw=Q+(q0+wid*QBLK)*qp+qcol;
  const bf16*Kh=K+kv0*kp+kcol,*Vh=V+kv0*vp+vcol;
  const unsigned lds0=(unsigned)(uintptr_t)shm;
  float*wsf=(float*)(shm+LDS_WS)+wid*64;
  const bf16*ksrc=Kh+(long)lane*kp+wid*8;
  const bf16*vsrc=Vh+(long)(16*(wid&3)+(lane>>2))*vp+(wid>>2)*32+(lane&3)*8;
  const unsigned kdst=lds0+LDS_K+wid*1024, vdst=lds0+LDS_V+wid*1024, kdst2=lds0+LDS_K+(8+wid)*1024;
  const bf16*ksrc2=Kh+(long)lane*kp+64+wid*8;
  const bool big=wid<4;
  #define DMA_K(t,slot) do{ glds16(ksrc+(long)(t)*KVBLK*kp,(unsigned)__builtin_amdgcn_readfirstlane(kdst+KOFF(slot))); if(big) glds16(ksrc2+(long)(t)*KVBLK*kp,(unsigned)__builtin_amdgcn_readfirstlane(kdst2+KOFF(slot))); }while(0)
  #define WAITKV() do{ if(big){WAIT_BAR(3);} else {WAIT_BAR(2);} }while(0)
  #define DMA_V(t,slot) glds16(vsrc+(long)(t)*KVBLK*vp,(unsigned)__builtin_amdgcn_readfirstlane(vdst+(slot)))
  const int vb0=(int)(lds0+LDS_V)+((lane>>4)&1)*32+(lane&3)*8+(4*hi+((lane&15)>>2))*64;
  const char*Kbase=shm+LDS_K; bf16x8 kf[12];
  const lds_cptr shm3=(lds_cptr)shm; const lds_cptr kp0=shm3+LDS_K+hi*1024+r32*16; const lds_cptr vp0=shm3+LDS_V+((lane>>4)&1)*32+(lane&3)*8+(4*hi+((lane&15)>>2))*64;
  DMA_K(0,0);DMA_V(0,0);DMA_K(1,SLOTB);
  bf16x8 qr[6];
  #pragma unroll
  for(int d0=0;d0<6;++d0)qr[d0]=*reinterpret_cast<const bf16x8*>(&Qw[(long)r32*qp+d0*16+hi*8]);
  {
    float f[6][8]; float ss=0.f;
    #pragma unroll
    for(int d0=0;d0<6;++d0)
      #pragma unroll
      for(int j=0;j<8;++j){ f[d0][j]=__uint_as_float(((unsigned)(unsigned short)qr[d0][j])<<16); ss+=f[d0][j]*f[d0][j]; }
    ss+=__shfl_xor(ss,32);
    const float rn=rsqrtf(ss*(1.f/96.f)+EPS)*C2_96;
    #pragma unroll
    for(int d0=0;d0<6;++d0)
      #pragma unroll
      for(int j=0;j<8;++j) f[d0][j]=f[d0][j]*rn*qgain[d0*16+hi*8+j];
    const int tq=(int)((q0+wid*QBLK+r32)%S); const int grow=tq/GW,gcol=tq%GW;
    #pragma unroll
    for(int part=0;part<2;++part){ const int pos=part?gcol:grow;
      #pragma unroll
      for(int j=0;j<8;++j){ const float cs=T16[pos*8+j],sn=T16[512+pos*8+j];
        const float mine=f[4+part][j],other=__shfl_xor(mine,32);
        f[4+part][j]=hi==0?(mine*cs-other*sn):(other*sn+mine*cs); } }
    #pragma unroll
    for(int d0=0;d0<6;++d0)
      #pragma unroll
      for(int j=0;j<4;++j){ const unsigned w=cvtpk_s(f[d0][2*j],f[d0][2*j+1]); qr[d0][2*j]=(short)(w&0xffff); qr[d0][2*j+1]=(short)(w>>16); }
  }
  float mhat=0.f,l_reg=0.f;f32x16 o[2];o[0]=f32x16{};o[1]=f32x16{};f32x16 negm=f32x16{};asm volatile("":"+v"(negm));
  #define CMASK(P0,P1,t) do{}while(0)
  bool resc=false;
  #define START(P0,P1) do{ const float rm=rowmax(P0,P1); resc=false; \
    { const float dl=rm; mhat=fadd_s(mhat,dl); \
      _Pragma("unroll") for(int r=0;r<16;++r){P0[r]=fsub_s(P0[r],dl);P1[r]=fsub_s(P1[r],dl);} \
      _Pragma("unroll") for(int r=0;r<16;++r)negm[r]=-mhat; asm volatile("":"+v"(negm)); } \
    _Pragma("unroll") for(int r=0;r<16;++r)P0[r]=__builtin_amdgcn_exp2f(P0[r]); }while(0)
  #define RESC() do{ if(resc){ asm volatile("s_waitcnt lgkmcnt(0)":::"memory"); \
      _Pragma("unroll") for(int d_=0;d_<2;++d_) _Pragma("unroll") for(int r=0;r<16;++r)o[d_][r]*=wsf[crow(r,hi)]; } }while(0)
  f32x16 pA0,pA1,pB0,pB1;
  int sl_prev=0,sl_cur=0,sl_next=SLOTB;
  #define ROT() do{sl_prev=sl_cur;sl_cur=sl_next;sl_next=(sl_next==(NSLOT-1)*SLOTB)?0:sl_next+SLOTB;}while(0)
  DMA_K(2,2*SLOTB);
  if(big){WAIT_BAR(5);}else{WAIT_BAR(3);}
  qkt(pA0,pA1,Kbase,qr,negm,r32,hi);asm volatile("s_nop 15\n\ts_nop 7":"+v"(pA0),"+v"(pA1));CMASK(pA0,pA1,0);
  START(pA0,pA1);
  _Pragma("unroll") for(int r=0;r<16;++r)pA1[r]=__builtin_amdgcn_exp2f(pA1[r]);
  WAIT_BAR(0);
  DMA_K(3,0);DMA_V(1,SLOTB);
  ROT();
  kload12(kf,kp0+KOFF(sl_cur));
  WAITKV();
  s16x4 vlo[8],vhi[8]; u32x4 pw0,pw1,pw2,pw3;
  #define PKW(P,B) cvtpk_s(P[B],P[B+1])
  #define PAF(k) __builtin_bit_cast(bf16x8,pw##k)
  #define VFR(i) (bf16x8){vlo[i][0],vlo[i][1],vlo[i][2],vlo[i][3],vhi[i][0],vhi[i][1],vhi[i][2],vhi[i][3]}
  #define PIN(x) asm volatile("":"+v"(x))
  #define MX3(a,b,c) __builtin_fmaxf(__builtin_fmaxf((a),(b)),(c))
  #define GAPA(MF,A0,A1,A2,A3,W0,W1,PW) do{ MF; sacc+=A0; sacc+=A1; sacc+=A2; sacc+=A3; PIN(sacc); W0; W1; PIN(PW); SBAR(); }while(0)
  #define EX(v) __builtin_amdgcn_exp2f(v)
  #define GAPB(MF,X,B) do{ MF; X[B]=EX(X[B]); X[B+1]=EX(X[B+1]); X[B+2]=EX(X[B+2]); X[B+3]=EX(X[B+3]); PIN(X); SBAR(); }while(0)
  #define VRD(i) do{ vlo[i]=vtr(vp_+(((i)>>2)*4096+((i)&3)*1024)); vhi[i]=vtr(vp_+(((i)>>2)*4096+((i)&3)*1024+512)); }while(0)
  #define KRD(G,j) do{ if(G){ kload2(kf,kp0+KOFF(sl_next),j); SBAR(); } }while(0)
  #define STEP(C0,C1,P0,P1,t,GK,GV,GL) do{ SBAR(); \
    const lds_cptr vp_=vp0+sl_prev; \
    VRD(0); SBAR(); float sacc=(P0[0]+P0[1]); \
    GAPA(C0=__builtin_amdgcn_mfma_f32_32x32x16_bf16(kf[0],qr[0],negm,0,0,0), P0[2],P0[3],P0[4],P0[5],     pw0[0]=PKW(P0,0), pw0[1]=PKW(P0,2), pw0); \
    VRD(4); SBAR(); GAPA(C1=__builtin_amdgcn_mfma_f32_32x32x16_bf16(kf[1],qr[0],negm,0,0,0), P0[6],P0[7],P0[8],P0[9],     pw0[2]=PKW(P0,4), pw0[3]=PKW(P0,6), pw0); \
    VRD(1); SBAR(); GAPA(C0=__builtin_amdgcn_mfma_f32_32x32x16_bf16(kf[2],qr[1],C0,0,0,0),   P0[10],P0[11],P0[12],P0[13], pw1[0]=PKW(P0,8), pw1[1]=PKW(P0,10), pw1); \
    VRD(5); SBAR(); GAPA(C1=__builtin_amdgcn_mfma_f32_32x32x16_bf16(kf[3],qr[1],C1,0,0,0),   P0[14],P0[15],P1[0],P1[1],   pw1[2]=PKW(P0,12),pw1[3]=PKW(P0,14), pw1); \
    VRD(2); SBAR(); GAPA(C0=__builtin_amdgcn_mfma_f32_32x32x16_bf16(kf[4],qr[2],C0,0,0,0),   P1[2],P1[3],P1[4],P1[5],     pw2[0]=PKW(P1,0), pw2[1]=PKW(P1,2), pw2); \
    VRD(6); SBAR(); GAPA(C1=__builtin_amdgcn_mfma_f32_32x32x16_bf16(kf[5],qr[2],C1,0,0,0),   P1[6],P1[7],P1[8],P1[9],     pw2[2]=PKW(P1,4), pw2[3]=PKW(P1,6), pw2); \
    VRD(3); SBAR(); GAPA(C0=__builtin_amdgcn_mfma_f32_32x32x16_bf16(kf[6],qr[3],C0,0,0,0),   P1[10],P1[11],P1[12],P1[13], pw3[0]=PKW(P1,8), pw3[1]=PKW(P1,10), pw3); \
    VRD(7); SBAR(); GAPA(C1=__builtin_amdgcn_mfma_f32_32x32x16_bf16(kf[7],qr[3],C1,0,0,0),   P1[14],P1[15],0.f,0.f,       pw3[2]=PKW(P1,12),pw3[3]=PKW(P1,14), pw3); \
    C0=__builtin_amdgcn_mfma_f32_32x32x16_bf16(kf[8],qr[4],C0,0,0,0); SBAR(); C1=__builtin_amdgcn_mfma_f32_32x32x16_bf16(kf[9],qr[4],C1,0,0,0); SBAR(); \
    C0=__builtin_amdgcn_mfma_f32_32x32x16_bf16(kf[10],qr[5],C0,0,0,0); SBAR(); C1=__builtin_amdgcn_mfma_f32_32x32x16_bf16(kf[11],qr[5],C1,0,0,0); SBAR(); \
    l_reg+=sacc; \
    if(GK){DMA_K((t)+3,sl_cur);} if(GV){DMA_V((t)+1,sl_next);} \
    CMASK(C0,C1,t); \
    { float a=MX3(C0[0],C0[1],C1[0]),b=MX3(C0[2],C0[3],C1[1]); a=MX3(a,C1[2],C1[3]); \
      _Pragma("unroll") for(int r=4;r<16;r+=4){a=MX3(a,C0[r],C0[r+1]);b=MX3(b,C0[r+2],C0[r+3]);a=MX3(a,C1[r],C1[r+1]);b=MX3(b,C1[r+2],C1[r+3]);} \
      float rm=__builtin_fmaxf(a,b); { auto rr=__builtin_amdgcn_permlane32_swap(__float_as_uint(rm),__float_as_uint(rm),false,false); rm=__builtin_fmaxf(__uint_as_float(rr[0]),__uint_as_float(rr[1])); } \
      resc=false; \
      if(__builtin_expect(__any(rm>(float)THRL),0)){ const float dl=__builtin_fmaxf(rm,0.f); mhat+=dl; \
        _Pragma("unroll") for(int r=0;r<16;++r){C0[r]-=dl;C1[r]-=dl;} \
        _Pragma("unroll") for(int r=0;r<16;++r)negm[r]=-mhat; asm volatile("":"+v"(negm)); \
        const float f=__builtin_amdgcn_exp2f(-dl); l_reg*=f; if(hi==0)wsf[r32]=f; resc=true; } } \
    SBAR(); \
    GAPB(o[0]=__builtin_amdgcn_mfma_f32_32x32x16_bf16(PAF(0),VFR(0),o[0],0,0,0), C0,0); \
    KRD(GL,0); GAPB(o[1]=__builtin_amdgcn_mfma_f32_32x32x16_bf16(PAF(0),VFR(4),o[1],0,0,0), C0,4); \
    KRD(GL,1); GAPB(o[0]=__builtin_amdgcn_mfma_f32_32x32x16_bf16(PAF(1),VFR(1),o[0],0,0,0), C0,8); \
    KRD(GL,2); GAPB(o[1]=__builtin_amdgcn_mfma_f32_32x32x16_bf16(PAF(1),VFR(5),o[1],0,0,0), C0,12); \
    KRD(GL,3); GAPB(o[0]=__builtin_amdgcn_mfma_f32_32x32x16_bf16(PAF(2),VFR(2),o[0],0,0,0), C1,0); \
    KRD(GL,4); GAPB(o[1]=__builtin_amdgcn_mfma_f32_32x32x16_bf16(PAF(2),VFR(6),o[1],0,0,0), C1,4); \
    KRD(GL,5); GAPB(o[0]=__builtin_amdgcn_mfma_f32_32x32x16_bf16(PAF(3),VFR(3),o[0],0,0,0), C1,8); \
    GAPB(o[1]=__builtin_amdgcn_mfma_f32_32x32x16_bf16(PAF(3),VFR(7),o[1],0,0,0), C1,12); \
    }while(0)
  int t=1;
  #undef CMASK
  #define CMASK(P0,P1,t) do{}while(0)
  for(;t+5<NT;t+=2){
    STEP(pB0,pB1,pA0,pA1,t,true,true,true);     WAITKV(); RESC(); ROT();
    STEP(pA0,pA1,pB0,pB1,t+1,true,true,true);   WAITKV(); RESC(); ROT();
  }
  #undef CMASK
  #define CMASK(P0,P1,t) do{}while(0)
  #define ENDW(tt) do{ if((tt)+3<NT){WAITKV();} else if((tt)+2<NT){WAIT_BAR(1);} else {WAIT_BAR(0);} }while(0)
  for(;t+1<NT;t+=2){
    STEP(pB0,pB1,pA0,pA1,t,(t+3<NT),(t+1<NT),(t+1<NT));       ENDW(t);   RESC(); ROT();
    STEP(pA0,pA1,pB0,pB1,t+1,(t+4<NT),(t+2<NT),(t+2<NT));     ENDW(t+1); RESC(); ROT();
  }
  STEP(pB0,pB1,pA0,pA1,NT-1,false,false,false); RESC();
  { float sacc=pB0[0]+pB0[1]; _Pragma("unroll") for(int r=2;r<16;++r)sacc+=pB0[r]; _Pragma("unroll") for(int r=0;r<16;++r)sacc+=pB1[r]; l_reg+=sacc;
    pw0=(u32x4){PKW(pB0,0),PKW(pB0,2),PKW(pB0,4),PKW(pB0,6)};pw1=(u32x4){PKW(pB0,8),PKW(pB0,10),PKW(pB0,12),PKW(pB0,14)};pw2=(u32x4){PKW(pB1,0),PKW(pB1,2),PKW(pB1,4),PKW(pB1,6)};pw3=(u32x4){PKW(pB1,8),PKW(pB1,10),PKW(pB1,12),PKW(pB1,14)};
    SBAR(); pv(o,vb0+sl_cur,PAF(0),PAF(1),PAF(2),PAF(3)); }
  #undef PKW
  #undef PAF
  #undef VFR
  #undef PIN
  #undef MX3
  #undef GAPA
  #undef GAPB
  #undef EX
  #undef VRD
  #undef KRD
  #undef STEP
  #undef ENDW
  {auto rr=__builtin_amdgcn_permlane32_swap(__float_as_uint(l_reg),__float_as_uint(l_reg),false,false);l_reg=__uint_as_float(rr[0])+__uint_as_float(rr[1]);}
  if(hi==0)wsf[32+r32]=l_reg;asm volatile("s_waitcnt lgkmcnt(0)":::"memory");
  float rli[16];
  #pragma unroll
  for(int r=0;r<16;++r)rli[r]=__builtin_amdgcn_rcpf(wsf[32+crow(r,hi)]);
  bf16*Ow=O+(q0+wid*QBLK)*op+ocol;
  { bf16*stg=(bf16*)(shm+LDS_OST)+wid*2048;
    #pragma unroll
    for(int r=0;r<16;++r){const int orow=crow(r,hi);
      #pragma unroll
      for(int d0=0;d0<2;++d0)stg[orow*64+d0*32+r32]=__float2bfloat16(o[d0][r]*rli[r]);}
    asm volatile("s_waitcnt lgkmcnt(0)":::"memory");
    #pragma unroll
    for(int i=0;i<4;++i){const int row=i*8+(lane>>3),ch=lane&7; const u32x4 v=*(const u32x4*)(stg+row*64+ch*8); ATTN_STORE16(Ow+(long)row*op+ch*8,v);} }
#ifdef ATT_STATIC_PRIO
  __builtin_amdgcn_s_setprio(0);
#endif
  asm volatile("s_waitcnt lgkmcnt(0)\n\ts_barrier":::"memory");
  #undef DMA_K
  #undef WAITKV
  #undef DMA_V
  #undef CMASK
  #undef START
  #undef RESC
  #undef ROT
}
constexpr int ATTN_LDS_BYTES=LDS_BYTES;

#undef SBAR
#undef WAIT_BAR
#undef KOFF
}
#define LAS __attribute__((address_space(3)))
#define XB_TMO      128
#define XB_XCNT(j)  (256  + 64 * (j))
#define XB_XSUB(j)  (1280 + 64 * (j))
#define XB_XGEN(j)  (2304 + 64 * (j))
#define XB_TOP      3328
#define XB_TOPGEN   3392
#define XCD_BAR_WORDS 3456
#define XB_ADA0     3584
#define XB_IN1A     3648
#define XB_UP10     3712
#define XB_CTXH     3520
#define XB_SPIN_CAP (1u << 18)

__device__ __forceinline__ unsigned xb_ld(unsigned* p)              { return __hip_atomic_load(p, __ATOMIC_RELAXED, __HIP_MEMORY_SCOPE_AGENT); }
__device__ __forceinline__ unsigned xb_add(unsigned* p, unsigned v) { return __hip_atomic_fetch_add(p, v, __ATOMIC_RELAXED, __HIP_MEMORY_SCOPE_AGENT); }
__device__ __forceinline__ unsigned xb_xcc_id() { return (unsigned)__builtin_amdgcn_s_getreg((3 << 11) | 20) & 0xFu; }
#define XB_SPIN(cond, bar) do { unsigned _sp = 0; while (cond) { __builtin_amdgcn_s_sleep(1); \
    if ((++_sp & 255u) == 0u) { if (xb_ld(&(bar)[XB_TMO])) break; if (_sp > XB_SPIN_CAP) { atomicAdd(&(bar)[XB_TMO], 1u); break; } } } } while (0)

struct XcdBarrier {
    unsigned* bar; unsigned x;
    volatile LAS unsigned* st;
};

__device__ __forceinline__ XcdBarrier xcd_barrier_post(unsigned* bar, volatile LAS unsigned* st) {
    XcdBarrier b; b.bar = bar; b.x = xb_xcc_id(); b.st = st;
    if (threadIdx.x == 0) (void)xb_add(&bar[XB_XCNT(b.x)], 1u);
    return b;
}
__device__ __forceinline__ void xcd_barrier_complete(unsigned* bar, unsigned x, unsigned& nloc, unsigned& nx) {
    const unsigned G = gridDim.x * gridDim.y * gridDim.z;
    unsigned sum, cnt, mine, sp = 0u;
    for (;;) {
        sum = 0u; cnt = 0u; mine = 0u;
#pragma unroll
        for (unsigned j = 0; j < 16; ++j) { const unsigned c = xb_ld(&bar[XB_XCNT(j)]); sum += c; cnt += (c > 0u) ? 1u : 0u; mine = (j == x) ? c : mine; }
        if (sum == G) break;
        __builtin_amdgcn_s_sleep(1);
        if ((++sp & 255u) == 0u) { if (xb_ld(&bar[XB_TMO])) break; if (sp > XB_SPIN_CAP) { atomicAdd(&bar[XB_TMO], 1u); break; } }
    }
    nloc = mine > 0u ? mine : 1u; nx = cnt > 0u ? cnt : 1u;
}

__device__ __forceinline__ void xcd_barrier(const XcdBarrier& b) {
    asm volatile("s_waitcnt vmcnt(0)" ::: "memory");
    __syncthreads();
    if (threadIdx.x == 0) {
        unsigned* bar = b.bar;
        __builtin_amdgcn_s_waitcnt(0);
        unsigned nloc = b.st[0], nx = b.st[1];
        if (nloc == 0u) { xcd_barrier_complete(bar, b.x, nloc, nx); b.st[0] = nloc; b.st[1] = nx; }
        const unsigned old = xb_add(&bar[XB_XSUB(b.x)], 1u);
        const unsigned gen = old / nloc;
        if (old + 1u == (gen + 1u) * nloc) {
            __builtin_amdgcn_fence(__ATOMIC_RELEASE, "agent");
            asm volatile("s_waitcnt vmcnt(0)" ::: "memory");
            const unsigned og = xb_add(&bar[XB_TOP], 1u);
            const unsigned tg = og / nx;
            if (og + 1u == (tg + 1u) * nx) xb_add(&bar[XB_TOPGEN], 1u);
            else XB_SPIN(xb_ld(&bar[XB_TOPGEN]) == tg, bar);
            __builtin_amdgcn_fence(__ATOMIC_ACQUIRE, "agent");
            xb_add(&bar[XB_XGEN(b.x)], 1u);
            asm volatile("s_waitcnt vmcnt(0)" ::: "memory");
        } else {
            XB_SPIN(xb_ld(&bar[XB_XGEN(b.x)]) == gen, bar);
            __builtin_amdgcn_fence(__ATOMIC_ACQUIRE, "agent");
            asm volatile("s_waitcnt vmcnt(0)" ::: "memory");
        }
    }
    __syncthreads();
}
namespace mk {
#ifndef KVROT
#define KVROT 0
#endif
#ifndef ALIGN2
#define ALIGN2 true
#endif
#ifndef ALIGN1
#define ALIGN1 true
#endif
#define MLAS __attribute__((address_space(3)))
constexpr int NWAVES = 8, NTHR = 512;
constexpr int RING_BYTES = 131072;
constexpr int LDS_BYTES = 147456;
constexpr int NPHASE = 16;
typedef unsigned v4u __attribute__((ext_vector_type(4)));
typedef float f32x4 __attribute__((ext_vector_type(4)));

struct Ctx {
    Params p; MLAS unsigned char* lds; char* lds_g; int wave, G, vcu, bid;
};
__device__ __forceinline__ int tid_now() { int t = threadIdx.x; asm volatile("" : "+v"(t)); return t; }
__device__ __forceinline__ unsigned pk2(float lo, float hi) { return (unsigned)f2bf(lo) | ((unsigned)f2bf(hi) << 16); }

enum { W_IN0 = 0, W_OUT0, W_GU0, W_D0, W_IN1, W_UQ, W_UKV, W_OUT1, W_GU1, W_D1, NWMAT };
struct SrcBlk { const float* W; int ld; int col; const float* kscale; };
__device__ __forceinline__ SrcBlk src_of(const Params& p, int mat, int nb) {
    SrcBlk s; s.kscale = nullptr; const int pn = nb >> 3, q = nb & 7, bj = q >> 2, wc = q & 3;
    switch (mat) {
    case W_IN0: s.W = p.in[I0_WIN]; s.ld = L0_IN; s.col = 256 * pn + 64 * wc + 32 * bj; break;
    case W_OUT0: s.W = p.in[I0_WOUT]; s.ld = D; s.col = 32 * nb; break;
    case W_GU0: s.W = bj ? p.in[I0_WU] : p.in[I0_WG]; s.ld = FF; s.col = 128 * pn + 32 * wc; break;
    case W_D0: s.W = p.in[I0_WD]; s.ld = D; s.col = 32 * nb; break;
    case W_IN1: s.W = p.in[I1_WIN]; s.ld = L1_IN;
        if (pn == 0) s.col = 128 * bj + 32 * wc;
        else if (pn == 1) { if (bj == 0) s.col = 256 + 32 * wc; else s.col = 640; }
        else if (pn == 2) s.col = 384 + 128 * bj + 32 * wc;
        else if (pn < 5) s.col = 672 + (pn - 3) * 256 + 64 * wc + 32 * bj;
        else if (pn < 7) s.col = 1184 + (pn - 5) * 256 + 64 * wc + 32 * bj;
        else s.col = 1696 + (pn - 7) * 256 + 64 * wc + 32 * bj;
        break;
    case W_UQ: s.W = p.in[I1_WUQ]; s.ld = 768; s.col = 32 * nb; s.kscale = p.in[I1_QAG]; break;
    case W_UKV: s.W = p.in[I1_WUKV]; s.ld = 1024; s.col = (2 * pn + (wc >> 1)) * 128 + (wc & 1) * 64 + 32 * bj; s.kscale = p.in[I1_KVAG]; break;
    case W_OUT1: s.W = p.in[I1_WOUT]; s.ld = D; s.col = 32 * nb; break;
    case W_GU1: s.W = bj ? p.in[I1_WU] : p.in[I1_WG]; s.ld = FF; s.col = 128 * pn + 32 * wc; break;
    default: s.W = p.in[I1_WD]; s.ld = D; s.col = 32 * nb; break;
    }
    return s;
}
struct WMat { size_t ws_off; int K, N; };
__host__ __device__ constexpr WMat wmat(int mat) {
    switch (mat) {
    case W_IN0: return {WS_W_IN0, D, 1536}; case W_OUT0: return {WS_W_OUT0, D, D}; case W_GU0: return {WS_W_GU0, D, 2 * FF}; case W_D0: return {WS_W_D0, FF, D};
    case W_IN1: return {WS_W_IN1, D, L1_INP}; case W_UQ: return {WS_W_UQ, 384, 768}; case W_UKV: return {WS_W_UKV, 256, 1024}; case W_OUT1: return {WS_W_OUT1, D, D};
    case W_GU1: return {WS_W_GU1, D, 2 * FF}; default: return {WS_W_D1, FF, D};
    }
}
template <int mat> __device__ __forceinline__ void tr_load(const Params& p, int item, f32x4 (&v)[8], int lane) {
    const WMat wm = wmat(mat); const int nblk = wm.N / 32, kb = item / nblk, nb = item % nblk, k0 = 64 * kb;
    const SrcBlk s = src_of(p, mat, nb);
    if (s.W == nullptr || (mat == W_OUT0 && kb < 4)) return;
    const int c4 = (lane & 7) * 4, kr = lane >> 3;
    const float* wsrc = s.W + (size_t)(k0 + kr) * s.ld + s.col + c4;
#pragma unroll
    for (int i = 0; i < 8; ++i) v[i] = *(const f32x4*)(wsrc + (size_t)(8 * i) * s.ld);
}
template <int mat> __device__ __forceinline__ void tr_finish(const Params& p, int item, const f32x4 (&v)[8], MLAS float* scr, int lane) {
    const WMat wm = wmat(mat); const int nblk = wm.N / 32, kb = item / nblk, nb = item % nblk, k0 = 64 * kb;
    const SrcBlk s = src_of(p, mat, nb);
    bf16_t* WT = (bf16_t*)(p.ws + wm.ws_off);
    const int c = lane & 7;
    if (s.W == nullptr) {
#pragma unroll
        for (int j = 0; j < 4; ++j) { const int n = (lane >> 3) + 8 * j; *(v4u*)(WT + (size_t)(32 * nb + n) * wm.K + k0 + 8 * c) = (v4u){0u, 0u, 0u, 0u}; }
        return;
    }
    MLAS float* t0 = scr; MLAS float* t1 = scr + 64 * 33;
    if (mat == W_OUT0 && kb < 4) return;
    constexpr bool fused_pool = false;
    { const int c4 = (lane & 7) * 4, kr = lane >> 3;
#pragma unroll
        for (int i = 0; i < 8; ++i) { const int kk = kr + 8 * i; float sc = 1.f;
            if (s.kscale) sc = s.kscale[k0 + kk];
            if (fused_pool) sc *= p.in[I0_POOLS][k0 + kk];
            MLAS float* d = t0 + kk * 33 + c4; d[0] = v[i][0] * sc; d[1] = v[i][1] * sc; d[2] = v[i][2] * sc; d[3] = v[i][3] * sc; } }
    asm volatile("s_waitcnt lgkmcnt(0)" ::: "memory");
    MLAS float* src = t0;
    if (fused_pool) {
        const float* pw = p.in[I0_POOLW] + kb * 4096; const int nn = lane & 31, ch = lane >> 5;
        for (int cc = ch; cc < 64; cc += 2) { float a = 0.f;
#pragma unroll 8
            for (int d = 0; d < 64; ++d) a += pw[cc * 64 + d] * t0[d * 33 + nn];
            t1[cc * 33 + nn] = a; }
        asm volatile("s_waitcnt lgkmcnt(0)" ::: "memory");
        src = t1;
    }
#pragma unroll
    for (int j = 0; j < 4; ++j) { const int n = (lane >> 3) + 8 * j; const MLAS float* sp = src + (8 * c) * 33 + n;
        v4u o; o.x = pk2(sp[0 * 33], sp[1 * 33]); o.y = pk2(sp[2 * 33], sp[3 * 33]); o.z = pk2(sp[4 * 33], sp[5 * 33]); o.w = pk2(sp[6 * 33], sp[7 * 33]);
        *(v4u*)(WT + (size_t)(32 * nb + n) * wm.K + k0 + 8 * c) = o; }
    asm volatile("s_waitcnt lgkmcnt(0)" ::: "memory");
}

#ifndef ADA_KS
#define ADA_KS 4
#endif
#define ADA_NIT (24 * ADA_KS)
#define ADA_RW (D / (ADA_KS * NWAVES))
#ifdef TP_A
#define TSTAMP_B(blk, i) do { if (C.bid == (blk) && threadIdx.x == 0) ((unsigned long long*)(C.p.ws + WS_CTL))[64 + (i)] = wall_clock64(); } while (0)
#else
#define TSTAMP_B(blk, i) do { } while (0)
#endif
#ifndef P0MASK
#define P0MASK 15
#endif
template <int PART> __device__ __forceinline__ void phase_prologue(Ctx& C, int vcu, int G) {
    const Params& p = C.p; const int tid = tid_now(), lane = tid & 63;
    MLAS float* sil = (MLAS float*)C.lds;
    MLAS float* red = (MLAS float*)(C.lds + 9 * 1024 * 4);
    __syncthreads();
    if (PART == 1) { TSTAMP_B(255, 40); TSTAMP_B(74, 50); }
#ifdef ADA_SPLIT
    if (PART <= 2)
#elif defined(ADA1_IN_P6)
    if (PART == 0 || PART == 6)
#else
    if (PART < 2)
#endif
    for (int i = tid; i < 9 * D; i += NTHR) { const int j = i / D, k = i % D; const float c = (j < 8) ? p.in[I_C][j * D + k] : p.in[I_CCTX][k]; sil[i] = c / (1.f + expf(-c)); }
    __syncthreads();
    if (PART == 1) { TSTAMP_B(255, 41); TSTAMP_B(74, 51); }
    float* MOD = (float*)(p.ws + WS_MOD);
#ifdef ADA_SPLIT
    constexpr int ADA_N = (PART == 0) ? 32 : (PART == 2) ? 64 : 96, ADA_BASE = (PART == 0) ? 0 : (PART == 2) ? 32 : 96;
    if ((P0MASK & 1) && PART <= 2)
    for (int it0 = vcu; it0 < ADA_N; it0 += G) { const int it = it0 + ADA_BASE;
#else
#ifdef ADA1_IN_P6
    constexpr bool ADA_ON = (PART == 0 || PART == 6); constexpr int ADA_L = (PART == 6) ? 1 : 0;
#else
    constexpr bool ADA_ON = (PART < 2); constexpr int ADA_L = PART;
#endif
    if ((P0MASK & 1) && ADA_ON)
    for (int it0 = vcu; it0 < ADA_NIT; it0 += G) { const int it = it0 + ADA_NIT * ADA_L;
#endif
        const int l = it / ADA_NIT, r_ = it % ADA_NIT, cg_ = r_ / ADA_KS, kq = r_ % ADA_KS, n0 = cg_ * 256;
        const int krow0 = kq * (D / ADA_KS) + C.wave * ADA_RW;
        const float* w = (l ? p.in[I1_ADAW] : p.in[I0_ADAW]) + (size_t)krow0 * 6144 + n0 + 4 * lane;
        f32x4 acc[9];
#pragma unroll
        for (int j = 0; j < 9; ++j) acc[j] = (f32x4){0.f, 0.f, 0.f, 0.f};
        f32x4 wrow[ADA_RW];
#pragma unroll
        for (int k = 0; k < ADA_RW; ++k) wrow[k] = *(const f32x4*)(w + (size_t)k * 6144);
#pragma unroll
        for (int k = 0; k < ADA_RW; ++k) { const f32x4 wv = wrow[k]; const int kk = krow0 + k;
#pragma unroll
            for (int j = 0; j < 9; ++j) acc[j] += wv * sil[j * D + kk]; }
#pragma unroll
        for (int j = 0; j < 9; ++j) *(MLAS f32x4*)(red + (C.wave * 9 + j) * 256 + 4 * lane) = acc[j];
        __syncthreads();
        for (int i = tid; i < 9 * 256; i += NTHR) { const int j = i >> 8, c = i & 255; float sm_ = 0.f;
#pragma unroll
            for (int wv = 0; wv < 8; ++wv) sm_ += red[(wv * 9 + j) * 256 + c];
            if (kq == 0) sm_ += (l ? p.in[I1_ADAB] : p.in[I0_ADAB])[n0 + c];
            atomicAdd(MOD + (size_t)(l * 9 + j) * 6144 + n0 + c, sm_); }
        __syncthreads();
    }
#ifdef MERGE01
    if (PART == 0) { asm volatile("s_waitcnt vmcnt(0)" ::: "memory"); __syncthreads();
        if (threadIdx.x == 0) { int n = 0; for (int it0 = vcu; it0 < 8 * ADA_KS; it0 += G) ++n; if (n) xb_add((unsigned*)(p.ws + WS_BARRIER) + XB_ADA0, (unsigned)n); } }
#endif
    __syncthreads();
    {
        MLAS float* PA = (MLAS float*)C.lds;
        MLAS float* PB = (MLAS float*)(C.lds + 64 * 65 * 4);
        bf16_t* WT = (bf16_t*)(p.ws + WS_W_OUT0);
#ifdef L0_SPLIT
        constexpr int POOL_PART = 2;
#else
        constexpr int POOL_PART = 0;
#endif
        if (PART == POOL_PART) for (int tile = vcu; tile < 128; tile += G) {
            const int g = tile >> 5, nb = tile & 31;
            for (int i = tid; i < 4096; i += NTHR) PA[(i >> 6) * 65 + (i & 63)] = p.in[I0_POOLW][g * 4096 + i];
            for (int i = tid; i < 2048; i += NTHR) { const int d = i >> 5, nn = i & 31; PB[d * 33 + nn] = p.in[I0_WOUT][(size_t)(g * 64 + d) * D + 32 * nb + nn] * p.in[I0_POOLS][g * 64 + d]; }
            __syncthreads();
            { const int c = tid >> 3, n4 = (tid & 7) * 4; float a0 = 0.f, a1 = 0.f, a2 = 0.f, a3 = 0.f;
#pragma unroll 8
                for (int d = 0; d < 64; ++d) { const float pa = PA[c * 65 + d]; const MLAS float* b = PB + d * 33 + n4; a0 += pa * b[0]; a1 += pa * b[1]; a2 += pa * b[2]; a3 += pa * b[3]; }
                bf16_t* o = WT + (size_t)(32 * nb + n4) * D + g * 64 + c;
                o[0] = f2bf(a0); o[D] = f2bf(a1); o[2 * D] = f2bf(a2); o[3 * D] = f2bf(a3); }
            __syncthreads();
        }
    }
    if (PART == 1) { TSTAMP_B(255, 42); TSTAMP_B(74, 52); }
    const int gw = vcu * NWAVES + C.wave, NGW = G * NWAVES;
    MLAS float* scr = (MLAS float*)(C.lds + C.wave * 16896);
    if (P0MASK & 2) {
#ifdef MERGE01
        int rot = (PART == 0 && NGW > ADA_NIT * NWAVES) ? ADA_NIT * NWAVES : 0;
#else
        int rot = 0;
#endif
#define TR_MAT(M) { constexpr int ni = (wmat(M).K / 64) * (wmat(M).N / 32); int first = gw - rot; if (first < 0) first += NGW; \
            { f32x4 va[8]; for (int it = first; it < ni; it += NGW) { tr_load<M>(p, it, va, lane); tr_finish<M>(p, it, va, scr, lane); } } \
            rot = (rot + ni) % NGW; }
        if (PART == 0) { TR_MAT(W_IN0)
#ifndef L0_SPLIT
            TR_MAT(W_OUT0) TR_MAT(W_GU0) TR_MAT(W_D0)
#endif
        }
        else if (PART == 2) { TR_MAT(W_OUT0)
#ifndef GU0_IN_P4
            TR_MAT(W_GU0)
#endif
#if !defined(D0_IN_P6) && !defined(CTXD_IN_P6)
            TR_MAT(W_D0)
#endif
        }
        else if (PART == 3) { TR_MAT(W_D0) }
        else if (PART == 5) { TR_MAT(W_GU0) }
        else if (PART == 1) { TR_MAT(W_IN1) TR_MAT(W_UQ) TR_MAT(W_UKV)
#if defined(REPACK)
#elif defined(P9_OUTD1)
            TR_MAT(W_GU1)
#elif !defined(CTXD_IN_P6)
            TR_MAT(W_OUT1) TR_MAT(W_GU1) TR_MAT(W_D1)
#endif
        }
#if defined(REPACK)
        else if (PART == 4) { TR_MAT(W_GU1) }
        else if (PART == 7) { TR_MAT(W_OUT1) TR_MAT(W_D1) }
#elif defined(P9_OUTD1) && defined(OUT1_IN_P6)
        else if (PART == 4) { TR_MAT(W_D1) }
        else if (PART == 7) { TR_MAT(W_OUT1) }
#elif defined(P9_OUTD1)
        else if (PART == 4) { TR_MAT(W_OUT1) TR_MAT(W_D1) }
#else
        else if (PART == 4) { TR_MAT(W_OUT1) TR_MAT(W_GU1) TR_MAT(W_D1) }
#endif
#undef TR_MAT
    }
    if (PART == 1) { __syncthreads(); TSTAMP_B(255, 43); TSTAMP_B(74, 53); }
    if (PART == 0 && (P0MASK & 4) && C.bid == C.G - 1) {
        float* T32 = (float*)(p.ws + WS_ROPE32); float* T16 = (float*)(p.ws + WS_ROPE16);
        for (int i = tid; i < 1024; i += NTHR) { const int pos = i >> 4, f = i & 15; const float ang = (float)pos * powf(10000.0f, -((float)f * 2.0f) / 32.0f); T32[i] = cosf(ang); T32[1024 + i] = sinf(ang); }
        for (int i = tid; i < 512; i += NTHR) { const int pos = i >> 3, f = i & 7; const float ang = (float)pos * powf(10000.0f, -((float)f * 2.0f) / 16.0f); T16[i] = cosf(ang); T16[512 + i] = sinf(ang); }
    }
    if (PART == 0 && (P0MASK & 8)) { float* SSQ = (float*)(p.ws + WS_SSQ); float* SSKV = (float*)(p.ws + WS_SSKV);
        for (int i = C.bid * NTHR + tid; i < MT; i += C.G * NTHR) { SSQ[i] = 0.f; SSKV[i] = 0.f; }
#ifdef FOLD_N13
        { float* SSN1 = (float*)(p.ws + WS_SSN1); for (int i = C.bid * NTHR + tid; i < ML; i += C.G * NTHR) SSN1[i] = 0.f; }
#endif
    }
}

__device__ __forceinline__ epi::RawPF norm_ld8(const float* p) { epi::RawPF r; r.a = *(const f32x4*)p; r.b = *(const f32x4*)(p + 4); return r; }
__device__ __forceinline__ epi::u32x4 norm_ld8(const bf16_t* p) { return *(const epi::u32x4*)p; }
__device__ __forceinline__ void norm_cv8(const epi::RawPF& r, f32x4& lo, f32x4& hi) { lo = r.a; hi = r.b; }
__device__ __forceinline__ void norm_cv8(epi::u32x4 w, f32x4& lo, f32x4& hi) { epi::u32x2 a, b; a.x = w.x; a.y = w.y; b.x = w.z; b.y = w.w; lo = epi::cvraw(a); hi = epi::cvraw(b); }
template <class TL> __device__ __forceinline__ void phase_norm(Ctx& C, const TL* xl, const float* xc, const float* gain, int layer, int sh_chunk, int sc_chunk, int nrows, const float* slab = nullptr, int nslab = 0, float* xc_wb = nullptr) {
    const int lane = tid_now() & 63;
    const int gw = C.vcu * NWAVES + C.wave, NGW = C.G * NWAVES;
    bf16_t* XN = (bf16_t*)(C.p.ws + WS_XN); const float* MODb = (const float*)(C.p.ws + WS_MOD) + (size_t)layer * 9 * 6144;
    for (int ch = gw; ch < ML / 8; ch += NGW) {
        const int m0 = ch * 8; const float* mod = MODb + (size_t)(m0 / S) * 6144;
        f32x4 a[2][2], sh[2][2];
#pragma unroll
        for (int j = 0; j < 2; ++j)
#pragma unroll
            for (int h = 0; h < 2; ++h) { const int c = 8 * lane + 512 * j + 4 * h; a[j][h] = *(const f32x4*)(gain + c) * (*(const f32x4*)(mod + sc_chunk * D + c) + 1.f); sh[j][h] = *(const f32x4*)(mod + sh_chunk * D + c); }
#pragma unroll
        for (int rb = 0; rb < 8; rb += 4) {
            typename epi::RawP<TL>::type raw[4][2];
#pragma unroll
            for (int b = 0; b < 4; ++b)
#pragma unroll
                for (int j = 0; j < 2; ++j) raw[b][j] = norm_ld8(xl + (size_t)(m0 + rb + b) * D + 8 * lane + 512 * j);
#pragma unroll
            for (int b = 0; b < 4; ++b) { f32x4 v[2][2]; float ss = 0.f;
#pragma unroll
                for (int j = 0; j < 2; ++j) { norm_cv8(raw[b][j], v[j][0], v[j][1]);
#pragma unroll
                    for (int h = 0; h < 2; ++h) ss += (v[j][h][0] * v[j][h][0] + v[j][h][1] * v[j][h][1]) + (v[j][h][2] * v[j][h][2] + v[j][h][3] * v[j][h][3]); }
                ss = wave_sum(ss);
                const float r = rsqrtf(ss * (1.f / D) + EPS);
#pragma unroll
                for (int j = 0; j < 2; ++j) { const f32x4 y0 = (v[j][0] * r) * a[j][0] + sh[j][0], y1 = (v[j][1] * r) * a[j][1] + sh[j][1];
                    v4u o; o.x = pk2(y0[0], y0[1]); o.y = pk2(y0[2], y0[3]); o.z = pk2(y1[0], y1[1]); o.w = pk2(y1[2], y1[3]);
                    *(v4u*)(XN + (size_t)(m0 + rb + b) * D + 8 * lane + 512 * j) = o; } }
        }
    }
    for (int m = ML + gw; m < nrows; m += NGW) {
        const float* mod = MODb + (size_t)8 * 6144;
        f32x4 v[4]; float ss = 0.f;
#pragma unroll
        for (int j = 0; j < 4; ++j) v[j] = *(const f32x4*)(xc + (size_t)(m - ML) * D + 4 * lane + 256 * j);
        for (int s_ = 0; s_ < nslab; ++s_) {
#pragma unroll
            for (int j = 0; j < 4; ++j) v[j] += *(const f32x4*)(slab + (size_t)s_ * MC * D + (size_t)(m - ML) * D + 4 * lane + 256 * j); }
        if (nslab > 0 && xc_wb) {
#pragma unroll
            for (int j = 0; j < 4; ++j) *(f32x4*)(xc_wb + (size_t)(m - ML) * D + 4 * lane + 256 * j) = v[j]; }
#pragma unroll
        for (int j = 0; j < 4; ++j) ss += (v[j][0] * v[j][0] + v[j][1] * v[j][1]) + (v[j][2] * v[j][2] + v[j][3] * v[j][3]);
        ss = wave_sum(ss);
        const float r = rsqrtf(ss * (1.f / D) + EPS);
#pragma unroll
        for (int j = 0; j < 4; ++j) { const int c = 4 * lane + 256 * j;
            const f32x4 g = *(const f32x4*)(gain + c), sc = *(const f32x4*)(mod + sc_chunk * D + c), sh = *(const f32x4*)(mod + sh_chunk * D + c);
            const f32x4 y = ((v[j] * r) * g) * (sc + 1.f) + sh;
            uint2 o; o.x = pk2(y[0], y[1]); o.y = pk2(y[2], y[3]);
            *(uint2*)(XN + (size_t)m * D + c) = o; }
    }
}

__device__ __forceinline__ void phase_bias(Ctx& C, int vcu, int Gn, const bf16_t* Wt, int npos, const float* shift  , int nb, float* bias) {
    const int tid = tid_now(), lane = tid & 63;
    MLAS float* sh = (MLAS float*)C.lds;
    __syncthreads();
    for (int i = tid; i < nb * D; i += NTHR) sh[i] = shift[(size_t)(i / D) * 6144 + (i % D)];
    __syncthreads();
    const int gw = vcu * NWAVES + C.wave, NGW = Gn * NWAVES;
    for (int pos = gw; pos < npos; pos += NGW) {
        const v4u w0 = *(const v4u*)(Wt + (size_t)pos * D + 16 * lane), w1 = *(const v4u*)(Wt + (size_t)pos * D + 16 * lane + 8);
        float wf[16];
#pragma unroll
        for (int e = 0; e < 4; ++e) { wf[2 * e] = __uint_as_float(w0[e] << 16); wf[2 * e + 1] = __uint_as_float(w0[e] & 0xffff0000u); wf[8 + 2 * e] = __uint_as_float(w1[e] << 16); wf[8 + 2 * e + 1] = __uint_as_float(w1[e] & 0xffff0000u); }
        float mine = 0.f;
        for (int b = 0; b < nb; ++b) { float s = 0.f;
#pragma unroll
            for (int q = 0; q < 4; ++q) { const f32x4 sv = *(const MLAS f32x4*)(sh + b * D + 16 * lane + 4 * q); s += (wf[4 * q] * sv[0] + wf[4 * q + 1] * sv[1]) + (wf[4 * q + 2] * sv[2] + wf[4 * q + 3] * sv[3]); }
            s = wave_sum(s); if (lane == b) mine = s; }
        if (lane < nb) bias[(size_t)lane * npos + pos] = mine;
    }
}

#ifdef TP_A
#define TSTAMP_C(i) do { if (C.bid == 0 && threadIdx.x == 0) ((unsigned long long*)(C.p.ws + WS_CTL))[64 + (i)] = wall_clock64(); } while (0)
#else
#define TSTAMP_C(i) do { } while (0)
#endif
template <int W> __device__ __forceinline__ void pool8(const bf16_t* A0, bf16_t* MIX, int m0, int c8) {
    constexpr int HW = W / 2, NR = 7 + W;
    int t0, T; if (m0 < ML) { t0 = m0 % S; T = S; } else { t0 = (m0 - ML) % CTX; T = CTX; }
    const int base = m0 - t0;
    v4u row[NR];
#pragma unroll
    for (int j = 0; j < NR; ++j) { row[j] = (v4u){0u, 0u, 0u, 0u}; const int r = t0 - HW + j; if (r >= 0 && r < T) row[j] = *(const v4u*)(A0 + (size_t)(base + r) * 256 + c8); }
    float s[8];
#pragma unroll
    for (int e = 0; e < 8; ++e) s[e] = 0.f;
#pragma unroll
    for (int j = 0; j < W; ++j) {
#pragma unroll
        for (int e = 0; e < 4; ++e) { s[2 * e] += __uint_as_float(row[j][e] << 16); s[2 * e + 1] += __uint_as_float(row[j][e] & 0xffff0000u); } }
#pragma unroll
    for (int i = 0; i < 8; ++i) {
        int lo = t0 + i - HW; if (lo < 0) lo = 0; int hi = t0 + i - HW + W; if (hi > T) hi = T;
        const float inv = 1.f / (float)(hi - lo); const v4u q = row[i + HW];
        v4u o;
#pragma unroll
        for (int e = 0; e < 4; ++e) o[e] = pk2(s[2 * e] * inv - __uint_as_float(q[e] << 16), s[2 * e + 1] * inv - __uint_as_float(q[e] & 0xffff0000u));
        *(v4u*)(MIX + (size_t)(m0 + i) * D + c8) = o;
        if (i < 7) {
#pragma unroll
            for (int e = 0; e < 4; ++e) { s[2 * e] += __uint_as_float(row[i + W][e] << 16) - __uint_as_float(row[i][e] << 16); s[2 * e + 1] += __uint_as_float(row[i + W][e] & 0xffff0000u) - __uint_as_float(row[i][e] & 0xffff0000u); } }
    }
}
__device__ __forceinline__ void phase_pool(Ctx& C) {
    const bf16_t* A0 = (const bf16_t*)(C.p.ws + WS_A0); bf16_t* MIX = (bf16_t*)(C.p.ws + WS_MIX);
    const int skip = (C.G > 128) ? 96 : 0;
    if (C.vcu < skip) return;
    const int lane = tid_now() & 63;
    const int gwv = (C.vcu - skip) * NWAVES + C.wave, NGWV = (C.G - skip) * NWAVES;
    for (int wi = gwv; wi < (MT / 64) * 4; wi += NGWV) {
        const int g = wi & 3, m0 = ((wi >> 2) * 8 + (lane >> 3)) * 8, c8 = g * 64 + (lane & 7) * 8;
        if (g == 0) pool8<2>(A0, MIX, m0, c8); else if (g == 1) pool8<4>(A0, MIX, m0, c8); else if (g == 2) pool8<8>(A0, MIX, m0, c8); else pool8<16>(A0, MIX, m0, c8);
    }
}


__device__ __forceinline__ void phase_natable(Ctx& C, int vcu, int Gn) {
    bf16_t* G = (bf16_t*)(C.p.ws + WS_NAG); const float* rpb = C.p.in[I1_RPB];
    const int gt = vcu * NTHR + tid_now(), NGT = Gn * NTHR;
    for (int it = gt; it < 8 * 16 * 2 * 64 * 32; it += NGT) {
        const int j = it & 31, kc = (it >> 5) & 63, half = (it >> 11) & 1, dr = (it >> 12) & 15, h = it >> 16;
        const int qc = 32 * half + j, cs = min(max(qc - 8, 0), 48);
        float v = -30000.f;
        if (dr < 15 && (unsigned)(kc - cs) < 16u) v = rpb[(h * 15 + dr) * 31 + (kc - qc + 15)] * LOG2E;
        G[it] = f2bf(v);
    }
}

__device__ __forceinline__ void phase_attn0(Ctx& C) {
    const Params& p = C.p;
    MLAS char* shm = (MLAS char*)C.lds;
    att::UnitDesc U; U.Q = (const bf16_t*)(p.ws + WS_Q0); U.qpitch = 768; U.K = (const bf16_t*)(p.ws + WS_K0); U.kpitch = 256; U.V = (const bf16_t*)(p.ws + WS_V0); U.vpitch = 256;
    U.O = (bf16_t*)(p.ws + WS_MIX); U.opitch = D; U.rg = 0; U.rmin = 0; U.head = 0; U.G = nullptr;
    for (int u = C.vcu; u < 768 + 96; u += C.G) {
        if (u < 768) { const int qb = u & 7, bh = u >> 3, h = bh % 12, b = bh / 12;
            U.q0 = (long)b * S + 256 * qb; U.qcol = h * 64; U.kcol = (h / 3) * 64; U.vcol = (h / 3) * 64; U.ocol = 256 + h * 64; U.kv0 = b * SK; U.nt = SK / 64; }
        else { const int bh = u - 768, h = bh % 12, b = bh / 12;
            U.q0 = (long)ML + 256 * b; U.qcol = h * 64; U.kcol = (h / 3) * 64; U.vcol = (h / 3) * 64; U.ocol = 256 + h * 64; U.kv0 = b * SK; U.nt = CTX / 64; }
#ifdef USE_ATT64
        att64::attn_unit<8>(U.q0, (const att64::bf16*)U.Q, U.qpitch, U.qcol, (const att64::bf16*)U.K, U.kpitch, U.kcol, (const att64::bf16*)U.V, U.vpitch, U.vcol, (long)U.kv0, U.nt, (att64::bf16*)U.O, U.opitch, U.ocol, C.lds_g);
#else
        att::attn_unit<64, false, false>(U, shm, nullptr, nullptr, nullptr);
#endif
    }
    TSTAMP_C(24);
    phase_pool(C);
    TSTAMP_C(25);
}
__device__ __forceinline__ void phase_attn1(Ctx& C) {
    const Params& p = C.p;
    MLAS char* shm = (MLAS char*)C.lds;
    const float* T16 = (const float*)(p.ws + WS_ROPE16);
    att::UnitDesc U; U.O = (bf16_t*)(p.ws + WS_MIX); U.opitch = D; U.G = (const bf16_t*)(p.ws + WS_NAG);
#ifdef MERGE1011
    bool waited = false;
    for (int ul = C.vcu; ul < 1024; ul += C.G) { const int u = ul < 512 ? ul + 512 : ul - 512;
        if (u < 512 && !waited) { waited = true;
            unsigned* barw = (unsigned*)(p.ws + WS_BARRIER);
            if (threadIdx.x == 0) { XB_SPIN(xb_ld(barw + XB_UP10) < (unsigned)C.G, barw); __builtin_amdgcn_fence(__ATOMIC_ACQUIRE, "agent"); asm volatile("s_waitcnt vmcnt(0)" ::: "memory"); }
            __syncthreads(); }
#else
    for (int u = C.vcu; u < 1024; u += C.G) {
#endif
        const int uu = u & 511, qb = uu & 7, h = (uu >> 3) & 7, b = uu >> 6;
        U.q0 = (long)b * S + 256 * qb; U.kv0 = b * SK; U.head = h;
        if (u < 512) {
            U.Q = (const bf16_t*)(p.ws + WS_MQ); U.qpitch = 768; U.qcol = h * 96; U.K = (const bf16_t*)(p.ws + WS_MK); U.kpitch = 768; U.kcol = h * 96;
            U.V = (const bf16_t*)(p.ws + WS_MV); U.vpitch = 512; U.vcol = h * 64; U.ocol = h * 64; U.nt = SK / 64; U.rg = 0; U.rmin = 0;
#ifdef USE_ATT96
            att96::attn_unit<8>(U.q0, (const att96::bf16*)U.Q, U.qpitch, U.qcol, (const att96::bf16*)U.K, U.kpitch, U.kcol, (const att96::bf16*)U.V, U.vpitch, U.vcol, (long)U.kv0, U.nt, (att96::bf16*)U.O, U.opitch, U.ocol, C.lds_g, p.in[I1_MQG], T16);
            TSTAMP_C(26);
#ifdef DUP_MLA
            att96::attn_unit<8>(U.q0, (const att96::bf16*)U.Q, U.qpitch, U.qcol, (const att96::bf16*)U.K, U.kpitch, U.kcol, (const att96::bf16*)U.V, U.vpitch, U.vcol, (long)U.kv0, U.nt, (att96::bf16*)U.O, U.opitch, U.ocol, C.lds_g, p.in[I1_MQG], T16);
#endif
#else
            att::attn_unit<96, false, true>(U, shm, p.in[I1_MQG], T16, nullptr);
#ifdef DUP_MLA
            att::attn_unit<96, false, true>(U, shm, p.in[I1_MQG], T16, nullptr);
#endif
#endif
        } else {
            U.Q = (const bf16_t*)(p.ws + WS_NQ); U.qpitch = 512; U.qcol = h * 64; U.K = (const bf16_t*)(p.ws + WS_NK); U.kpitch = 512; U.kcol = h * 64;
            U.V = (const bf16_t*)(p.ws + WS_NV); U.vpitch = 512; U.vcol = h * 64; U.ocol = 512 + h * 64; U.rg = qb;
            const int rmin = min(max(4 * qb - 4, 0), 24), rmax = min(max(4 * qb + 3 - 4, 0), 24) + 7;
            U.rmin = rmin; U.nt = 4 + (rmax - rmin + 1);
#ifdef USE_ATTNA
            attna::attn_unit<8>(U.q0, (const attna::bf16*)U.Q, U.qpitch, U.qcol, (const attna::bf16*)U.K, U.kpitch, U.kcol, (const attna::bf16*)U.V, U.vpitch, U.vcol, (long)U.kv0, (U.nt + 1) & ~1, (attna::bf16*)U.O, U.opitch, U.ocol, C.lds_g, U.rmin, U.rg, p.in[I1_RPB] + h * 465);
#ifdef DUP_NA
            attna::attn_unit<8>(U.q0, (const attna::bf16*)U.Q, U.qpitch, U.qcol, (const attna::bf16*)U.K, U.kpitch, U.kcol, (const attna::bf16*)U.V, U.vpitch, U.vcol, (long)U.kv0, (U.nt + 1) & ~1, (attna::bf16*)U.O, U.opitch, U.ocol, C.lds_g, U.rmin, U.rg, p.in[I1_RPB] + h * 465);
#endif
#else
            att::attn_unit<64, true, false>(U, shm, nullptr, nullptr, p.in[I1_RPB]);
#ifdef DUP_NA
            att::attn_unit<64, true, false>(U, shm, nullptr, nullptr, p.in[I1_RPB]);
#endif
#endif
        }
    }
}

__device__ __forceinline__ void skew_wait(unsigned ticks) {
    if (threadIdx.x == 0) { const unsigned long long t0 = wall_clock64(); while (wall_clock64() - t0 < ticks) __builtin_amdgcn_s_sleep(8); }
    __syncthreads();
}

__global__ void __launch_bounds__(NTHR, 2) mega(Params p, int ph_lo, int ph_hi) {
    extern __shared__ __attribute__((aligned(16))) unsigned char lds_raw[];
    cg::grid_group grid = cg::this_grid();
    Ctx C; C.p = p; C.lds = (MLAS unsigned char*)lds_raw; C.lds_g = (char*)lds_raw; C.wave = __builtin_amdgcn_readfirstlane((int)threadIdx.x >> 6);
    C.G = gridDim.x; C.bid = blockIdx.x; C.vcu = (C.G % 8 == 0) ? (C.bid % 8) * (C.G / 8) + C.bid / 8 : C.bid;
    volatile LAS unsigned* bst = (volatile LAS unsigned*)(C.lds + LDS_BYTES - 64);
    if (threadIdx.x < 2) bst[threadIdx.x] = 0u;
    __syncthreads();
    unsigned* barw = (unsigned*)(p.ws + WS_BARRIER);
    XcdBarrier bar; bar.bar = barw; bar.x = 0; bar.st = nullptr;
    if (ph_hi - ph_lo > 1) bar = xcd_barrier_post(barw, bst);
    float* out = p.out; float* xrc = (float*)(p.ws + WS_XRC);
#ifdef BF16RES
    typedef bf16_t res_t;
    res_t* xa = (res_t*)p.out; res_t* xb3 = (res_t*)(p.ws + WS_X3);
#else
    typedef float res_t;
    res_t* xa = p.out; res_t* xb3 = p.out;
#endif
    const float* MOD = (const float*)(p.ws + WS_MOD);
    bf16_t* XN = (bf16_t*)(p.ws + WS_XN); bf16_t* MIX = (bf16_t*)(p.ws + WS_MIX); bf16_t* H = (bf16_t*)(p.ws + WS_H);
    const float* T32 = (const float*)(p.ws + WS_ROPE32); const float* T16 = (const float*)(p.ws + WS_ROPE16);
#define WSB(off) ((bf16_t*)(p.ws + (off)))
#ifndef PHMASK
#define PHMASK 0xFFFF
#endif
#ifndef REPMASK
#define REPMASK 0
#endif
#ifndef NSYNC
#define NSYNC 1
#endif
#define PH(k) if (((PHMASK >> (k)) & 1) && ph_lo <= (k) && (k) < ph_hi) for (int rep_ = 0; rep_ < (((REPMASK >> (k)) & 1) ? 2 : 1); ++rep_, (((REPMASK >> (k)) & 1) && rep_ == 1 ? xcd_barrier(bar) : (void)0))
#ifndef USE_CG_SYNC
#define USE_CG_SYNC 0
#endif
#ifdef TP_A
#ifndef TP_Q
#define TP_Q 4.f
#define TP_O 2.f
#endif
#define TSTAMP(i) do { if (C.bid == 0 && threadIdx.x == 0) ((unsigned long long*)(p.ws + WS_CTL))[64 + (i)] = wall_clock64(); } while (0)
#else
#define TSTAMP(i) do { } while (0)
#endif
#define SEAM(k) if (ph_lo <= (k) && (k) + 1 < ph_hi) { TSTAMP(32 + (k)); for (int s_ = 0; s_ < NSYNC; ++s_) { if (USE_CG_SYNC || ph_hi > 1000) grid.sync(); else xcd_barrier(bar); } TSTAMP((k) + 1); }
    TSTAMP(0);
    PH(0) { phase_prologue<0>(C, C.vcu, C.G);
#if !defined(L1_LATE) && !defined(L1_IN_P7)
        phase_prologue<1>(C, C.vcu, C.G);
#endif
    }
#ifdef MERGE01
    if (ph_lo <= 0 && ph_hi > 1) {
        if (threadIdx.x == 0) { XB_SPIN(xb_ld(barw + XB_ADA0) < (unsigned)(8 * ADA_KS), barw); __builtin_amdgcn_fence(__ATOMIC_ACQUIRE, "agent"); asm volatile("s_waitcnt vmcnt(0)" ::: "memory"); }
        __syncthreads();
    }
    TSTAMP(1);
#else
    SEAM(0);
#endif
    PH(1) { phase_norm(C, p.in[I_X], p.in[I_CTX], p.in[I0_NMIX], 0, 0, 1, MT); } SEAM(1);
    PH(2) { pg8::Gemm g{XN, WSB(WS_W_IN0), MT, 1536, D, D}; pg8::StaticOrder So; So.init(MT, 1536, C.G, C.bid);
        epi::EpiIn0 E{WSB(WS_A0), WSB(WS_Q0), WSB(WS_K0), WSB(WS_V0), p.in[I0_QG], p.in[I0_KG], T32};
        pg8::gemm_phase<epi::EpiIn0, pg8::StaticOrder, ALIGN2, true>(C.lds, g, So, E);
#ifdef L0_SPLIT
        { const int n2 = (MT / 256) * 6 - C.G;
          if (n2 >= 0 && n2 < C.G) { if (C.bid >= n2) phase_prologue<2>(C, C.bid - n2, C.G - n2); } else phase_prologue<2>(C, C.vcu, C.G); }
#endif
#ifdef L1_LATE
        { const int n2 = (MT / 256) * 6 - C.G;
          if (n2 >= 0 && n2 < C.G && C.bid >= n2) phase_prologue<1>(C, C.bid - n2, C.G - n2);
          else if (n2 < 0 || n2 >= C.G) phase_prologue<1>(C, C.vcu, C.G); }
#endif
    } SEAM(2);
    PH(3) { phase_attn0(C); } SEAM(3);
    PH(4) { { pg8::Gemm g{MIX, WSB(WS_W_OUT0), ML, D, D, D}; pg8::StaticOrder So; So.init(ML, D, C.G, C.bid);
          epi::EpiResidT<float, res_t> E{p.in[I_X], p.in[I_CTX], xa, xrc, MOD + 2 * D};
          pg8::gemm_phase<epi::EpiResidT<float, res_t>, pg8::StaticOrder, ALIGN1, true>(C.lds, g, So, E); }
        TSTAMP(20);
        { pg8::Gemm g{MIX, WSB(WS_W_OUT0), MT, D, D / 4, D}; pg8::CtxSplitOrder So; So.init(4, C.G, C.bid);
          epi::EpiResidSplit E{p.in[I_CTX], xrc, (float*)(p.ws + WS_SLAB4), MOD + 2 * D};
          pg8::gemm_phase<epi::EpiResidSplit, pg8::CtxSplitOrder, true, true>(C.lds, g, So, E); }
        TSTAMP(21);
#ifdef GU0_IN_P4
        if (C.G > 128) { if (C.bid >= 128) phase_prologue<5>(C, C.bid - 128, C.G - 128); } else phase_prologue<5>(C, C.vcu, C.G);
#endif
#ifdef CTXD_IN_P6
        if (C.G > 128) { if (C.bid >= 128) phase_prologue<3>(C, C.bid - 128, C.G - 128); } else phase_prologue<3>(C, C.vcu, C.G);
#endif
    } SEAM(4);
    PH(5) { phase_norm(C, xa, xrc, p.in[I0_NFFN], 0, 3, 4, MT, (const float*)(p.ws + WS_SLAB4), 3, xrc); } SEAM(5);
#ifdef CTXD_IN_P6
    const bool ctxd = (C.G == 256);
#else
    const bool ctxd = false;
#endif
    PH(6) { pg8::Gemm g{XN, WSB(WS_W_GU0), MT, 2 * FF, D, D}; epi::EpiSwiGLU E{H};
        if (!ctxd) { pg8::StaticOrder So; So.init(MT, 2 * FF, C.G, C.bid);
#ifdef SKEW6
            { const int total = (MT / 256) * (2 * FF / 256), rem = total % C.G; if (rem > 0 && C.bid >= rem + (C.G - rem) / 2) skew_wait(SKEW6); }
#endif
            pg8::gemm_phase<epi::EpiSwiGLU, pg8::StaticOrder, true, true>(C.lds, g, So, E);
#ifdef D0_IN_P6
            { const int total = (MT / 256) * (2 * FF / 256), full = total / C.G, n7 = total - full * C.G;
              if (n7 > 0 && n7 < C.G) { if (C.bid >= n7) { phase_prologue<3>(C, C.bid - n7, C.G - n7);
#if defined(REPACK) || defined(OUT1_IN_P6)
                      phase_prologue<7>(C, C.bid - n7, C.G - n7);
#endif
#ifdef ADA1_IN_P6
                      phase_prologue<6>(C, C.G - 1 - C.bid, C.G - n7);
#endif
                  } }
              else { phase_prologue<3>(C, C.vcu, C.G);
#if defined(REPACK) || defined(OUT1_IN_P6)
                  phase_prologue<7>(C, C.vcu, C.G);
#endif
#ifdef ADA1_IN_P6
                  phase_prologue<6>(C, C.vcu, C.G);
#endif
              } }
#endif
        }
#ifdef CTXD_IN_P6
        else {
            unsigned* flag = barw + XB_CTXH;
            { pg8::CtxFirstOrder So; So.init(0, C.bid); epi::EpiSwiGLUW EW{H}; pg8::gemm_phase<epi::EpiSwiGLUW, pg8::CtxFirstOrder, true, true>(C.lds, g, So, EW); }
            if (C.bid >= 80 && threadIdx.x == 0) xb_add(flag, 1u);
            { pg8::CtxFirstOrder So; So.init(1, C.bid); pg8::gemm_phase<epi::EpiSwiGLU, pg8::CtxFirstOrder, true, true>(C.lds, g, So, E); }
            if (C.bid >= 48 && C.bid < 176) {
                if (threadIdx.x == 0) { XB_SPIN(xb_ld(flag) < 176u, barw); __builtin_amdgcn_fence(__ATOMIC_ACQUIRE, "agent"); asm volatile("s_waitcnt vmcnt(0)" ::: "memory"); }
                __syncthreads();
                if (C.bid < 112) { pg8::Gemm g2{H, WSB(WS_W_D0), MT, D, 768, FF}; pg8::CtxSplitOrder S2; S2.init(2, C.G, C.bid - 48);
                    epi::EpiResidSplit E2{xrc, xrc, (float*)(p.ws + WS_SLAB7), MOD + 5 * D, 0};
                    pg8::gemm_phase<epi::EpiResidSplit, pg8::CtxSplitOrder, true, true>(C.lds, g2, S2, E2); }
                else { pg8::Gemm g2{H + 1536, WSB(WS_W_D0) + 1536, MT, D, 640, FF}; pg8::CtxSplitOrder S2; S2.init(2, C.G, C.bid - 112);
                    epi::EpiResidSplit E2{xrc, xrc, (float*)(p.ws + WS_SLAB7), MOD + 5 * D, 2};
                    pg8::gemm_phase<epi::EpiResidSplit, pg8::CtxSplitOrder, true, true>(C.lds, g2, S2, E2); }
            } else if (C.bid >= 176) { phase_prologue<1>(C, C.bid - 176, C.G - 176); phase_natable(C, C.bid - 176, C.G - 176); }
        }
#endif
    } SEAM(6);
    PH(7) { { pg8::Gemm g{H, WSB(WS_W_D0), ML, D, FF, FF}; pg8::StaticOrder So; So.init(ML, D, C.G, C.bid);
          epi::EpiResidT<res_t, res_t> E{xa, xrc, xa, xrc, MOD + 5 * D};
          pg8::gemm_phase<epi::EpiResidT<res_t, res_t>, pg8::StaticOrder, ALIGN1, true>(C.lds, g, So, E); }
        TSTAMP(22);
        if (!ctxd) {
#ifdef D0CTX_X4
        constexpr int NCTX7 = 128;
        {
            if (C.bid < 64) { pg8::Gemm g2{H, WSB(WS_W_D0), MT, D, 768, FF}; pg8::CtxSplitOrder S2; S2.init(2, C.G, C.bid);
                epi::EpiResidSplit E2{xrc, xrc, (float*)(p.ws + WS_SLAB7), MOD + 5 * D, 0};
                pg8::gemm_phase<epi::EpiResidSplit, pg8::CtxSplitOrder, true, true>(C.lds, g2, S2, E2); }
            else if (C.bid < 128) { pg8::Gemm g2{H + 1536, WSB(WS_W_D0) + 1536, MT, D, 640, FF}; pg8::CtxSplitOrder S2; S2.init(2, C.G, C.bid - 64);
                epi::EpiResidSplit E2{xrc, xrc, (float*)(p.ws + WS_SLAB7), MOD + 5 * D, 2};
                pg8::gemm_phase<epi::EpiResidSplit, pg8::CtxSplitOrder, true, true>(C.lds, g2, S2, E2); }
        }
#else
        constexpr int NCTX7 = 64;
        { pg8::Gemm g{H, WSB(WS_W_D0), MT, D, FF / 2, FF}; pg8::CtxSplitOrder So; So.init(2, C.G, C.bid);
          epi::EpiResidSplit E{xrc, xrc, (float*)(p.ws + WS_SLAB7), MOD + 5 * D};
          pg8::gemm_phase<epi::EpiResidSplit, pg8::CtxSplitOrder, true, true>(C.lds, g, So, E); }
#endif
        TSTAMP(23);
#ifdef L1_IN_P7
        if (C.G > NCTX7) { if (C.bid >= NCTX7) { phase_prologue<1>(C, C.bid - NCTX7, C.G - NCTX7);
#ifdef CTXD_IN_P6
            phase_prologue<4>(C, C.bid - NCTX7, C.G - NCTX7);
#endif
            phase_natable(C, C.bid - NCTX7, C.G - NCTX7); } }
        else { phase_prologue<1>(C, C.vcu, C.G);
#ifdef CTXD_IN_P6
            phase_prologue<4>(C, C.vcu, C.G);
#endif
            phase_natable(C, C.vcu, C.G); }
#endif
        }
    } SEAM(7);
    PH(8) {
#ifndef L1_IN_P7
        phase_natable(C, C.vcu, C.G);
#endif
#if defined(FUSE910) && defined(FOLD_N13)
        if (C.G == 256) phase_bias(C, C.vcu, C.G, WSB(WS_W_GU1), 2 * FF, MOD + 9 * 6144 + 3 * D, 8, (float*)(p.ws + WS_BIAS1));
#endif
        phase_norm(C, xa, xrc, p.in[I1_NMIX], 1, 0, 1, MT, (const float*)(p.ws + WS_SLAB7),
#ifdef D0CTX_X4
            3,
#else
            ctxd ? 3 : 1,
#endif
            nullptr); } SEAM(8);
#ifdef FUSE910
    const bool fuse910 = (C.G == 256);
#else
    const bool fuse910 = false;
#endif
#ifdef FUSE910
    if (fuse910) {
      PH(9) { pg8::Gemm g{XN, WSB(WS_W_IN1), MT, L1_INP, D, D};
        epi::EpiIn1 E{WSB(WS_CQ), WSB(WS_CKV), WSB(WS_NQ), WSB(WS_NK), WSB(WS_NV), (float*)(p.ws + WS_KR), (float*)(p.ws + WS_SSQ), (float*)(p.ws + WS_SSKV), p.in[I1_NQG], p.in[I1_NKG]};
        unsigned* flag = barw + XB_IN1A;
        { pg8::ListOrder So; pg8::in1_xcd_list(So, C.bid, 0, 1); pg8::gemm_phase<epi::EpiIn1, pg8::ListOrder, ALIGN2, true>(C.lds, g, So, E); }
        if ((C.bid >> 3) < 27 && threadIdx.x == 0) { __builtin_amdgcn_fence(__ATOMIC_RELEASE, "agent"); asm volatile("s_waitcnt vmcnt(0)" ::: "memory"); xb_add(flag, 1u); }
        { pg8::ListOrder So; pg8::in1_xcd_list(So, C.bid, 1, 3); pg8::gemm_phase<epi::EpiIn1, pg8::ListOrder, ALIGN2, true>(C.lds, g, So, E); }
        if (threadIdx.x == 0) { XB_SPIN(xb_ld(flag) < 216u, barw); __builtin_amdgcn_fence(__ATOMIC_ACQUIRE, "agent"); asm volatile("s_waitcnt vmcnt(0)" ::: "memory"); }
        __syncthreads();
        { pg8::Gemm g2{WSB(WS_CQ), WSB(WS_W_UQ), ML, 768, 384, 384}; pg8::ListOrder S2; pg8::up_xcd_list(S2, C.bid, 0);
          epi::EpiQUp E2{WSB(WS_MQ), (const float*)(p.ws + WS_SSQ)};
          pg8::gemm_phase<epi::EpiQUp, pg8::ListOrder, ALIGN2, true>(C.lds, g2, S2, E2); }
        { pg8::Gemm g2{WSB(WS_CKV), WSB(WS_W_UKV), MT, 1024, 256, 256}; pg8::ListOrder S2; pg8::up_xcd_list(S2, C.bid, 1);
          epi::EpiKvUp E2{WSB(WS_MK), WSB(WS_MV), (const float*)(p.ws + WS_SSKV), (const float*)(p.ws + WS_KR), p.in[I1_MKG], T16};
          pg8::gemm_phase<epi::EpiKvUp, pg8::ListOrder, ALIGN2, true>(C.lds, g2, S2, E2); }
      } SEAM(10);
    }
#ifndef FUSE910_ONLY
    else {
#endif
#endif
#if !defined(FUSE910) || !defined(FUSE910_ONLY)
    PH(9) { pg8::Gemm g{XN, WSB(WS_W_IN1), MT, L1_INP, D, D}; pg8::StaticOrder So; So.init(MT, L1_INP, C.G, C.bid);
        epi::EpiIn1 E{WSB(WS_CQ), WSB(WS_CKV), WSB(WS_NQ), WSB(WS_NK), WSB(WS_NV), (float*)(p.ws + WS_KR), (float*)(p.ws + WS_SSQ), (float*)(p.ws + WS_SSKV), p.in[I1_NQG], p.in[I1_NKG]};
        pg8::gemm_phase<epi::EpiIn1, pg8::StaticOrder, ALIGN2, true>(C.lds, g, So, E);
#if defined(FOLD_N13) && !defined(REPACK)
        { const int n3 = (MT / 256) * (L1_INP / 256) - 2 * C.G;
          if (n3 >= 0 && n3 < C.G) { if (C.bid >= n3) phase_bias(C, C.bid - n3, C.G - n3, WSB(WS_W_GU1), 2 * FF, MOD + 9 * 6144 + 3 * D, 8, (float*)(p.ws + WS_BIAS1)); }
          else phase_bias(C, C.vcu, C.G, WSB(WS_W_GU1), 2 * FF, MOD + 9 * 6144 + 3 * D, 8, (float*)(p.ws + WS_BIAS1)); }
#endif
#if defined(P9_OUTD1) || defined(REPACK)
        { const int n3 = (MT / 256) * (L1_INP / 256) - 2 * C.G;
          if (n3 >= 0 && n3 < C.G) { if (C.bid >= n3) phase_prologue<4>(C, C.bid - n3, C.G - n3); } else phase_prologue<4>(C, C.vcu, C.G); }
#endif
#ifdef CTXD_IN_P6
        if (ctxd) { const int n3 = (MT / 256) * (L1_INP / 256) - 2 * C.G;
            if (n3 >= 0 && n3 < C.G) { if (C.bid >= n3) phase_prologue<4>(C, C.bid - n3, C.G - n3); } else phase_prologue<4>(C, C.vcu, C.G); }
#endif
    } SEAM(9);
    PH(10) {
#ifndef NO_QUP
        { pg8::Gemm g{WSB(WS_CQ), WSB(WS_W_UQ), ML, 768, 384, 384}; pg8::StaticOrder So; So.init(ML, 768, C.G, C.bid);
          epi::EpiQUp E{WSB(WS_MQ), (const float*)(p.ws + WS_SSQ)};
          pg8::gemm_phase<epi::EpiQUp, pg8::StaticOrder, ALIGN2, true>(C.lds, g, So, E); }
#endif
#ifndef NO_KVUP
        { pg8::Gemm g{WSB(WS_CKV), WSB(WS_W_UKV), MT, 1024, 256, 256}; pg8::StaticOrder So; So.init(MT, 1024, C.G, (C.bid + KVROT) % C.G);
          epi::EpiKvUp E{WSB(WS_MK), WSB(WS_MV), (const float*)(p.ws + WS_SSKV), (const float*)(p.ws + WS_KR), p.in[I1_MKG], T16};
          pg8::gemm_phase<epi::EpiKvUp, pg8::StaticOrder, ALIGN2, true>(C.lds, g, So, E); }
#endif
#ifdef MERGE1011
        asm volatile("s_waitcnt vmcnt(0)" ::: "memory"); __syncthreads();
        if (threadIdx.x == 0) { __builtin_amdgcn_fence(__ATOMIC_RELEASE, "agent"); asm volatile("s_waitcnt vmcnt(0)" ::: "memory"); xb_add(barw + XB_UP10, 1u); }
    }
    if (!(ph_lo <= 10 && 11 < ph_hi)) { }
#else
    } SEAM(10);
#endif
#endif
#if defined(FUSE910) && !defined(FUSE910_ONLY)
    }
#endif
    PH(11) { phase_attn1(C); TSTAMP(27);
#if defined(FOLD_N13) && defined(REPACK)
        if (C.G == 256) { const int lo3 = C.vcu & 7; if (lo3 == 0 || lo3 == 7) phase_bias(C, 2 * (C.vcu >> 3) + (lo3 == 7), 64, WSB(WS_W_GU1), 2 * FF, MOD + 9 * 6144 + 3 * D, 8, (float*)(p.ws + WS_BIAS1)); }
        else phase_bias(C, C.vcu, C.G, WSB(WS_W_GU1), 2 * FF, MOD + 9 * 6144 + 3 * D, 8, (float*)(p.ws + WS_BIAS1));
#endif
    } SEAM(11);
#ifdef FOLD_N13
    PH(12) { pg8::Gemm g{MIX, WSB(WS_W_OUT1), ML, D, D, D}; pg8::StaticOrder So; So.init(ML, D, C.G, C.bid);
        epi::EpiResidNT<res_t, res_t> E{xa, xb3, MOD + 9 * 6144 + 2 * D, WSB(WS_XN2), (float*)(p.ws + WS_SSN1), p.in[I1_NFFN], MOD + 9 * 6144 + 4 * D};
        pg8::gemm_phase<epi::EpiResidNT<res_t, res_t>, pg8::StaticOrder, ALIGN1, true>(C.lds, g, So, E); } SEAM(12);
    PH(14) { pg8::Gemm g{WSB(WS_XN2), WSB(WS_W_GU1), ML, 2 * FF, D, D}; pg8::StaticOrder So; So.init(ML, 2 * FF, C.G, C.bid);
#ifdef SKEW14
        { const int total = (ML / 256) * (2 * FF / 256), rem = total % C.G; if (rem > 0 && C.bid >= rem) skew_wait(SKEW14); }
#endif
        epi::EpiSwiGLUN E{H, (const float*)(p.ws + WS_SSN1), (const float*)(p.ws + WS_BIAS1)};
        pg8::gemm_phase<epi::EpiSwiGLUN, pg8::StaticOrder, true, true>(C.lds, g, So, E); } SEAM(14);
#else
    PH(12) { pg8::Gemm g{MIX, WSB(WS_W_OUT1), ML, D, D, D}; pg8::StaticOrder So; So.init(ML, D, C.G, C.bid);
        epi::EpiResidT<res_t, res_t> E{xa, xrc, xb3, xrc, MOD + 9 * 6144 + 2 * D};
        pg8::gemm_phase<epi::EpiResidT<res_t, res_t>, pg8::StaticOrder, ALIGN1, true>(C.lds, g, So, E); } SEAM(12);
    PH(13) { phase_norm(C, xb3, xrc, p.in[I1_NFFN], 1, 3, 4, ML); } SEAM(13);
    PH(14) { pg8::Gemm g{XN, WSB(WS_W_GU1), ML, 2 * FF, D, D}; pg8::StaticOrder So; So.init(ML, 2 * FF, C.G, C.bid);
        epi::EpiSwiGLU E{H};
        pg8::gemm_phase<epi::EpiSwiGLU, pg8::StaticOrder, true, true>(C.lds, g, So, E); } SEAM(14);
#endif
    PH(15) { pg8::Gemm g{H, WSB(WS_W_D1), ML, D, FF, FF}; pg8::StaticOrder So; So.init(ML, D, C.G, C.bid);
        epi::EpiResidT<res_t, float> E{xb3, xrc, out, xrc, MOD + 9 * 6144 + 5 * D};
        pg8::gemm_phase<epi::EpiResidT<res_t, float>, pg8::StaticOrder, ALIGN1, true>(C.lds, g, So, E); }
#ifdef TP_A
    xcd_barrier(bar); TSTAMP(16);
    if (C.bid == 0 && threadIdx.x == 0) { const unsigned long long* ts = (const unsigned long long*)(p.ws + WS_CTL) + 64; out[0] = TP_Q * floorf(((float)(ts[TP_B] - ts[TP_A]) * 0.01f + TP_O) / TP_Q); }
#endif
    if (ph_hi - ph_lo > 1 && C.bid == 0 && threadIdx.x == 0) { if (xb_ld(&barw[XB_TMO]) != 0u) out[0] = __builtin_nanf(""); }
#undef PH
#undef SEAM
#undef WSB
}
}
#ifndef MK_DEBUG
#define MK_DEBUG 0
#endif
static int g_grid = 0;
static bool mega_setup() {
    if (g_grid) return g_grid > 0;
    int dev = 0, cus = 0, per_cu = 0;
    if (hipGetDevice(&dev) != hipSuccess || hipDeviceGetAttribute(&cus, hipDeviceAttributeMultiprocessorCount, dev) != hipSuccess) { g_grid = -1; return false; }
    if (hipFuncSetAttribute((const void*)mk::mega, hipFuncAttributeMaxDynamicSharedMemorySize, mk::LDS_BYTES) != hipSuccess) { fprintf(stderr, "kernel_launch: hipFuncSetAttribute failed\n"); g_grid = -1; return false; }
    if (hipOccupancyMaxActiveBlocksPerMultiprocessor(&per_cu, (const void*)mk::mega, mk::NTHR, mk::LDS_BYTES) != hipSuccess || per_cu < 1) { fprintf(stderr, "kernel_launch: occupancy query says %d\n", per_cu); g_grid = -1; return false; }
    g_grid = cus;
    fprintf(stderr, "kernel_launch: %d CUs, occupancy %d blocks/CU, grid %d\n", cus, per_cu, g_grid);
    return true;
}
static void launch_phases(const Params& p, int lo, int hi, hipStream_t st) {
    Params pp = p; int l = lo, h = hi;
    void* args[] = {&pp, &l, &h};
    hipError_t e;
    if (hi - lo > 1) e = hipLaunchCooperativeKernel((const void*)mk::mega, dim3(g_grid), dim3(mk::NTHR), args, mk::LDS_BYTES, st);
    else e = hipLaunchKernel((const void*)mk::mega, dim3(g_grid), dim3(mk::NTHR), args, mk::LDS_BYTES, st);
    if (e != hipSuccess) fprintf(stderr, "kernel_launch: launch [%d,%d) failed: %s\n", lo, hi, hipGetErrorString(e));
}
#if MK_DEBUG
static void launch_debug(const Params& p, hipStream_t st) {
    using namespace nv;
    unsigned* err = (unsigned*)(p.ws + WS_CTL) + 64;
    float* out = p.out; float* xrc = (float*)(p.ws + WS_XRC);
    const float* x = p.in[I_X]; const float* cx = p.in[I_CTX];
    const size_t att_sm = 4 * (SK + 128) * sizeof(float);
    const int SR = 4096;
    float* snapL = (float*)(p.ws + WS_SNAP); float* snapC = snapL + (size_t)SR * D;
    float* snapB = (float*)(p.ws + WS_BIG);
    hipMemsetAsync(p.ws + WS_CTL, 0, WS_SSQ, st);
    launch_phases(p, 0, 1, st);  k_adaln<true><<<dim3(6144 / 256, 9, 2), 256, 0, st>>>(p, err + 0);
    launch_phases(p, 1, 2, st);  k_norm<true><<<MT / 4, 256, 0, st>>>(p, x, cx, I0_NMIX, 0, 0, 1, MT, err + 1);
    launch_phases(p, 2, 3, st);  k_in0<true><<<MT / R, 256, (R * D + R * L0_IN) * 4, st>>>(p, err + 2);
    launch_phases(p, 3, 4, st);  k_attn<true, 0><<<dim3(ML / 4, 12), 256, att_sm, st>>>(p, err + 3);
                                 k_attn<true, 1><<<dim3(MC / 4, 12), 256, att_sm, st>>>(p, err + 16);
                                 k_pool0<true><<<MT, 256, 0, st>>>(p, err + 17);
    launch_phases(p, 4, 5, st);  k_out<true, 0><<<MT / R, 256, (R * D + R * 256) * 4, st>>>(p, x, cx, out, xrc, 0, err + 4);
    launch_phases(p, 5, 6, st);  k_norm<true><<<MT / 4, 256, 0, st>>>(p, out, xrc, I0_NFFN, 0, 3, 4, MT, err + 5);
    launch_phases(p, 6, 7, st);  k_ffn_gu<true, 0><<<MT / R, 256, R * D * 4, st>>>(p, err + 6);
    hipMemcpyAsync(snapL, out, (size_t)SR * D * 4, hipMemcpyDeviceToDevice, st); hipMemcpyAsync(snapC, xrc, (size_t)MC * D * 4, hipMemcpyDeviceToDevice, st);
    launch_phases(p, 7, 8, st);  k_ffn_d<true, 0><<<SR / R, 256, R * FF * 4, st>>>(p, snapL, snapC, out, xrc, 0, err + 7);
                                 k_ffn_d<true, 0><<<MC / R, 256, R * FF * 4, st>>>(p, snapL, snapC, out, xrc, ML, err + 7);
    launch_phases(p, 8, 9, st);  k_norm<true><<<MT / 4, 256, 0, st>>>(p, out, xrc, I1_NMIX, 1, 0, 1, MT, err + 8);
    launch_phases(p, 9, 10, st); k_in1<true><<<MT / R, 256, (R * D + R * L1_IN) * 4, st>>>(p, err + 9);
    launch_phases(p, 10, 11, st); k_mlaq<true><<<ML / R, 256, R * 384 * 4, st>>>(p, err + 10);
                                 k_mlakv<true><<<MT / R, 256, (R * 256 + R * 1024) * 4, st>>>(p, err + 19);
    launch_phases(p, 11, 12, st); k_attn<true, 2><<<dim3(ML / 4, 8), 256, att_sm, st>>>(p, err + 11);
                                 k_attn<true, 3><<<dim3(ML / 4, 8), 256, att_sm, st>>>(p, err + 18);
    hipMemcpyAsync(snapB, out, (size_t)SR * D * 4, hipMemcpyDeviceToDevice, st);
    launch_phases(p, 12, 13, st); k_out<true, 1><<<SR / R, 256, (R * D + R * 256) * 4, st>>>(p, snapB, snapC, out, xrc, 0, err + 12);
    launch_phases(p, 13, 14, st); k_norm<true><<<ML / 4, 256, 0, st>>>(p, out, xrc, I1_NFFN, 1, 3, 4, ML, err + 13);
    launch_phases(p, 14, 15, st); k_ffn_gu<true, 1><<<ML / R, 256, R * D * 4, st>>>(p, err + 14);
    hipMemcpyAsync(snapL, out, (size_t)SR * D * 4, hipMemcpyDeviceToDevice, st);
    launch_phases(p, 15, 16, st); k_ffn_d<true, 1><<<SR / R, 256, R * FF * 4, st>>>(p, snapL, snapC, out, xrc, 0, err + 15);
    k_report<<<1, 1, 0, st>>>(p, 20, 0.15f);
}
#endif
extern "C" void kernel_launch(void* const* d_in, const int* in_sizes, int n_in, void* d_out, int out_size, void* d_ws, size_t ws_size, hipStream_t stream) {
    if (n_in != N_IN || out_size != ML * D || ws_size < WS_END) { fprintf(stderr, "kernel_launch: unexpected shapes n_in=%d out=%d ws=%zu\n", n_in, out_size, ws_size); return; }
    if (!mega_setup()) return;
    Params p{};
    for (int i = 0; i < N_IN; ++i) p.in[i] = (const float*)d_in[i];
    p.out = (float*)d_out; p.ws = (unsigned char*)d_ws;
#if MK_DEBUG
    launch_debug(p, stream);
#else
    if (hipMemsetAsync((char*)d_ws + WS_BARRIER, 0, WS_SSQ - WS_BARRIER, stream) != hipSuccess) { fprintf(stderr, "kernel_launch: memset failed\n"); return; }
#ifdef EXTRA_MEMSET
    (void)hipMemsetAsync((char*)d_ws + WS_CTL, 0, 4096, stream);
#endif
    launch_phases(p, 0, mk::NPHASE, stream);
#endif
}
```

```cpp
#define USE_ATT64 1
#define USE_ATT96 1
#define ATT_STATIC_PRIO 1
#define L1_IN_P7 1
#define L0_SPLIT 1
#define D0_IN_P6 1
#define FOLD_N13 1
#define BF16RES 1
#define MERGE01 1
#define GU0_IN_P4 1
#define P9_OUTD1 1
#define KVROT 64
#define MBT_F32 4
#define ADA1_IN_P6 1
#define ADA_KS 8
#define D0CTX_X4 1
#define PG8_WGM 4
#include <hip/hip_runtime.h>
#include <hip/hip_cooperative_groups.h>
#include <cstdio>
#include <cstdint>
namespace cg = cooperative_groups;

typedef unsigned short bf16_t;
constexpr int D = 1024, NB = 8, S = 2048, CTX = 256, SK = S + CTX, ML = NB * S, MC = NB * CTX, MT = ML + MC, FF = 2816;
constexpr int GW = 64;
constexpr int L0_IN = 1536, L1_IN = 2208, L1_INP = 2304;
constexpr float EPS = 1e-6f;
constexpr float LOG2E = 1.4426950408889634f;
constexpr float C2_64 = 0.125f * LOG2E;
constexpr float C2_96 = 0.10206207261596577f * LOG2E;

enum { I_X = 0, I_C, I_CTX, I_CCTX,
       I0_ADAW, I0_ADAB, I0_NMIX, I0_NFFN, I0_WIN, I0_POOLW, I0_POOLS, I0_QG, I0_KG, I0_WOUT, I0_WG, I0_WU, I0_WD,
       I1_ADAW, I1_ADAB, I1_NMIX, I1_NFFN, I1_WIN, I1_QAG, I1_KVAG, I1_WUQ, I1_WUKV, I1_MQG, I1_MKG, I1_NQG, I1_NKG, I1_RPB, I1_WOUT, I1_WG, I1_WU, I1_WD, N_IN };

constexpr size_t MiB = 1u << 20;
constexpr size_t WS_CTL = 0;
constexpr size_t WS_BARRIER = 16 * 1024;
constexpr size_t WS_MOD = 64 * 1024;
constexpr size_t WS_SSQ = 512 * 1024;
constexpr size_t WS_SSKV = 600 * 1024;
constexpr size_t WS_ROPE32 = 700 * 1024;
constexpr size_t WS_ROPE16 = 712 * 1024;
constexpr size_t WS_W_IN0 = 1 * MiB;
constexpr size_t WS_W_OUT0 = 4 * MiB;
constexpr size_t WS_W_GU0 = 6 * MiB;
constexpr size_t WS_W_D0 = 17 * MiB;
constexpr size_t WS_W_IN1 = 23 * MiB;
constexpr size_t WS_W_UQ = 28 * MiB;
constexpr size_t WS_W_UKV = 29 * MiB;
constexpr size_t WS_W_OUT1 = 30 * MiB;
constexpr size_t WS_W_GU1 = 32 * MiB;
constexpr size_t WS_W_D1 = 43 * MiB;
constexpr size_t WS_XRC = 49 * MiB;
constexpr size_t WS_XN = 57 * MiB;
constexpr size_t WS_MIX = WS_XN;
constexpr size_t WS_BIG = 96 * MiB;
constexpr size_t WS_H = WS_BIG;
constexpr size_t WS_A0 = WS_BIG;
constexpr size_t WS_Q0 = WS_BIG + 9 * MiB;
constexpr size_t WS_K0 = WS_BIG + 36 * MiB;
constexpr size_t WS_V0 = WS_BIG + 45 * MiB;
constexpr size_t WS_CQ = WS_BIG;
constexpr size_t WS_CKV = WS_BIG + 14 * MiB;
constexpr size_t WS_NQ = WS_BIG + 23 * MiB;
constexpr size_t WS_NK = WS_BIG + 41 * MiB;
constexpr size_t WS_NV = WS_BIG + 59 * MiB;
constexpr size_t WS_MQ = WS_BIG + 77 * MiB;
constexpr size_t WS_MK = WS_BIG + 101 * MiB;
constexpr size_t WS_MV = WS_BIG + 128 * MiB;
constexpr size_t WS_KR = WS_BIG + 146 * MiB;
constexpr size_t WS_SLAB4 = WS_BIG;
constexpr size_t WS_SLAB7 = WS_BIG + 100 * MiB;
constexpr size_t WS_NAG = WS_BIG + 150 * MiB;
constexpr size_t WS_SSN1 = 768 * 1024;
constexpr size_t WS_BIAS1 = 832 * 1024;
constexpr size_t WS_XN2 = WS_BIG + 88 * MiB;
constexpr size_t WS_X3 = WS_BIG + 120 * MiB;
constexpr size_t WS_SNAP = WS_BIG + 100 * MiB;
constexpr size_t WS_END = 256 * MiB;
static_assert(WS_KR + (size_t)MT * 32 * 4 <= WS_END, "ws map");
static_assert(WS_X3 + (size_t)ML * D * 2 <= WS_END, "ws map");
static_assert(WS_W_D1 + (size_t)D * FF * 2 <= WS_XRC, "ws map");
static_assert(WS_XN + (size_t)MT * D * 2 <= WS_BIG, "ws map");

__device__ __forceinline__ float bf2f(bf16_t u) { return __uint_as_float((unsigned)u << 16); }
__device__ __forceinline__ bf16_t f2bf(float f) { unsigned u = __float_as_uint(f); return (bf16_t)((u + 0x7fffu + ((u >> 16) & 1u)) >> 16); }
__device__ __forceinline__ int kvrow_of(int m) { return m < ML ? (m / S) * SK + CTX + (m % S) : ((m - ML) / CTX) * SK + ((m - ML) % CTX); }
__device__ __forceinline__ int modidx_of(int m) { return m < ML ? m / S : 8; }
__device__ __forceinline__ float wave_sum(float v) {
#pragma unroll
    for (int o = 1; o < 64; o <<= 1) v += __shfl_xor(v, o);
    return v;
}
__device__ __forceinline__ float wave_max(float v) {
#pragma unroll
    for (int o = 1; o < 64; o <<= 1) v = fmaxf(v, __shfl_xor(v, o));
    return v;
}

struct Params {
    const float* in[N_IN];
    float* out;
    unsigned char* ws;
};
namespace pg8 {
#define PG8_LAS __attribute__((address_space(3)))
typedef unsigned short bf16_t;
typedef short bf16x8 __attribute__((ext_vector_type(8)));
typedef float f32x4 __attribute__((ext_vector_type(4)));
typedef unsigned u32x4 __attribute__((ext_vector_type(4)));
#ifndef PG8_WGM
#define PG8_WGM 8
#endif
constexpr int BM = 256, BK = 64, HALF = 128, HTB = HALF * BK * 2  , STAGE_BYTES = 8 * HTB, NXCD = 8, WGM = PG8_WGM;

__host__ __device__ __forceinline__ int lds_byte(int r, int c) { const int st = (r >> 4) * 2 + (c >> 5), rr = r & 15, cc = c & 31, ob = rr * 64 + cc * 2; return st * 1024 + (ob ^ (((ob >> 9) & 1) << 5)); }
__host__ __device__ __forceinline__ void stage_rc(int b, int& R, int& C) { const int st = b / 1024, sb = b % 1024, swz = sb ^ (((sb >> 9) & 1) << 5); R = (st >> 1) * 16 + swz / 64; C = (st & 1) * 32 + (swz % 64) / 2; }
__host__ __device__ __forceinline__ int perm32(int rho) { const int n = rho >> 4, i = rho & 15; return 8 * (i >> 2) + 4 * n + (i & 3); }

struct Unit { int pm, pn, ks; };
struct Gemm { const bf16_t* A; const bf16_t* Bt; int M, N, K, ld; };

struct StaticOrder {
    int nM, nN, nwg, G, c;
    __host__ __device__ void init(int M, int N, int G_, int c_) { nM = M / BM; nN = N / BM; nwg = nM * nN; G = G_; c = c_; }
    __host__ __device__ bool next(int i, Unit& u) const {
        const long L = (long)i * G + c; if (L >= nwg) return false;
        int wgid = (int)L; { const int q = nwg / NXCD, r = nwg % NXCD, xcd = wgid % NXCD, off = wgid / NXCD; wgid = (xcd < r ? xcd * (q + 1) : r * (q + 1) + (xcd - r) * q) + off; }
        const int nig = WGM * nN, gid = wgid / nig, fm = gid * WGM, gsz = (nM - fm) < WGM ? (nM - fm) : WGM;
        u.pm = fm + ((wgid % nig) % gsz); u.pn = (wgid % nig) / gsz; u.ks = 0; return true;
    }
    __device__ __forceinline__ void a_ready(const Unit&) const {}
    __device__ __forceinline__ void done(const Unit&) const {}
};

__device__ __forceinline__ unsigned cvt_pk_bf16(float lo, float hi) { unsigned r; asm volatile("v_cvt_pk_bf16_f32 %0, %1, %2" : "=v"(r) : "v"(lo), "v"(hi)); return r; }
typedef float f32x2 __attribute__((ext_vector_type(2)));
struct CtxSplitOrder {
    int G, c, split;
    __host__ __device__ void init(int split_, int G_, int c_) { split = split_; G = G_; c = c_; }
    __host__ __device__ bool next(int i, Unit& u) const {
        const int L = i * G + c; if (L >= 32 * split) return false;
        u.ks = L % split; const int t = L / split; u.pn = t & 3; u.pm = 64 + (t >> 2); return true;
    }
    __device__ __forceinline__ void a_ready(const Unit&) const {}
    __device__ __forceinline__ void done(const Unit&) const {}
};
struct CtxFirstOrder {
    int c, mode; StaticOrder lat;
    __host__ __device__ void init(int mode_, int c_) { mode = mode_; c = c_; lat.init(64 * BM, 22 * BM, 1 << 28, 0); }
    __host__ __device__ bool next(int i, Unit& u) const {
        if (mode == 0) { if (i != 0 || c < 80) return false; const int j = c - 80; u.pm = 64 + (j & 7); u.pn = j >> 3; u.ks = 0; return true; }
        const int Lp = c < 80 ? (i == 0 ? c : 80 + (i - 1) * 256 + c) : 80 + i * 256 + c;
        if (Lp >= 1408) return false;
        StaticOrder t = lat; t.c = Lp; return t.next(0, u);
    }
    __device__ __forceinline__ void a_ready(const Unit&) const {}
    __device__ __forceinline__ void done(const Unit&) const {}
};
struct ListOrder {
    int n, u0, u1, u2;
    __host__ __device__ bool next(int i, Unit& u) const {
        if (i >= n) return false; const int v = i == 0 ? u0 : (i == 1 ? u1 : u2);
        u.pm = v & 0xff; u.pn = v >> 8; u.ks = 0; return true;
    }
    __device__ __forceinline__ void a_ready(const Unit&) const {}
    __device__ __forceinline__ void done(const Unit&) const {}
};
__host__ __device__ inline int in1_pack(int x, int l) { if (l < 27) return (x + 8 * (l / 3)) | ((l % 3) << 8); const int lp = l - 27; return (x + 8 * (lp / 6)) | ((3 + lp % 6) << 8); }
__host__ __device__ inline void in1_xcd_list(ListOrder& L, int c, int ilo, int ihi) {
    const int x = c & 7, j = c >> 3, l0 = j + 32 * ilo;
    int n = ihi - ilo; const int cap = (81 - l0 + 31) / 32; if (n > cap) n = cap; if (n < 0) n = 0;
    L.n = n; L.u0 = in1_pack(x, l0); L.u1 = in1_pack(x, l0 + 32); L.u2 = in1_pack(x, l0 + 64);
}
__host__ __device__ inline int up_pack(int x, int w, int kv) { if (kv) { const int wp = w - 24; return (x + 8 * (wp >> 2)) | ((wp & 3) << 8); } return (x + 8 * (w / 3)) | ((w % 3) << 8); }
__host__ __device__ inline void up_xcd_list(ListOrder& L, int c, int kv) {
    const int x = c & 7, j = c >> 3;
    int a, b; if (j >= 17) { a = 3 * (j - 17); b = a + 3; } else if (j < 15) { a = 45 + j; b = a + 1; } else { a = 24; b = 24; }
    int w0, w1; if (kv) { w0 = a > 24 ? a : 24; w1 = b; } else { w0 = a; w1 = b < 24 ? b : 24; }
    int n = w1 - w0; if (n < 0) n = 0;
    if (n == 0) w0 = kv ? 24 : 0;
    L.n = n; L.u0 = up_pack(x, w0, kv); L.u1 = up_pack(x, w0 + 1, kv); L.u2 = up_pack(x, w0 + 2, kv);
}
template <class Epi, class Sched, bool ALIGN_EPI = false, bool SP2 = false>
__device__ __forceinline__ void gemm_phase(PG8_LAS unsigned char* lds, const Gemm g, const Sched& S, const Epi& E) {
    int tid_ = threadIdx.x; asm volatile("" : "+v"(tid_));
    const int tid = tid_, wid = __builtin_amdgcn_readfirstlane(tid >> 6), lane = tid & 63, wr = wid >> 2, wc = wid & 3, fr = lane & 15, fq = lane >> 4;
    int K_ = g.K; asm volatile("" : "+s"(K_));
    const int K = K_, nt = K / BK; int LD_ = g.ld; asm volatile("" : "+s"(LD_)); const int LD = LD_;
    unsigned voffA[2], voffB[2];
#pragma unroll
    for (int i = 0; i < 2; ++i) { int R, C; stage_rc(tid * 16 + i * 8192, R, C); const int Rb = Epi::PERM ? ((R & ~31) + perm32(R & 31)) : R;
        voffA[i] = (unsigned)(R * LD + C) * 2u; voffB[i] = (unsigned)(Rb * LD + C) * 2u; }
    const size_t kstep = (size_t)(BK * 2);
    const size_t hstep = (size_t)HALF * LD * 2;
    const size_t tstep = 2 * hstep;
    const unsigned ldsw = (unsigned)wid * 1024u;
    const int aoff = lds_byte(wr * 64 + fr, fq * 8), boff = lds_byte(wc * 32 + fr, fq * 8);
#define PG8_SA(b, h) (((b) * 2 + (h)) * HTB)
#define PG8_SB(b, h) ((4 + (b) * 2 + (h)) * HTB)
#define PG8_STAGE(bufoff, gbase, voff) do { _Pragma("unroll") for (int _i = 0; _i < 2; ++_i) \
        __builtin_amdgcn_global_load_lds((const unsigned*)((const char*)(gbase) + (voff)[_i]), (PG8_LAS unsigned*)(lds + (bufoff) + ldsw + _i * 8192), 16, 0, 0); } while (0)
#define PG8_LDA(dst, b, h) do { _Pragma("unroll") for (int m = 0; m < 4; ++m) _Pragma("unroll") for (int k = 0; k < 2; ++k) dst[m][k] = *(const PG8_LAS bf16x8*)(lds + PG8_SA(b, h) + aoff + m * 2048 + k * 1024); } while (0)
#define PG8_LDB(dst, b, h) do { _Pragma("unroll") for (int n = 0; n < 2; ++n) _Pragma("unroll") for (int k = 0; k < 2; ++k) dst[n][k] = *(const PG8_LAS bf16x8*)(lds + PG8_SB(b, h) + boff + n * 2048 + k * 1024); } while (0)
#define PG8_MMA(ai, bj, At, Bt) do { __builtin_amdgcn_s_setprio(1); _Pragma("unroll") for (int m = 0; m < 4; ++m) _Pragma("unroll") for (int n = 0; n < 2; ++n) _Pragma("unroll") for (int k = 0; k < 2; ++k) \
        acc[ai][bj][m][n] = __builtin_amdgcn_mfma_f32_16x16x32_bf16(Bt[n][k], At[m][k], acc[ai][bj][m][n], 0, 0, 0); __builtin_amdgcn_s_setprio(0); } while (0)
#define PG8_WAIT_V(n) asm volatile("s_waitcnt vmcnt(" #n ")" ::: "memory")
#define PG8_WAIT_L(n) asm volatile("s_waitcnt lgkmcnt(" #n ")" ::: "memory")
#define PG8_BAR __builtin_amdgcn_s_barrier()
#define PG8_SCHED __builtin_amdgcn_sched_barrier(0)
    Unit cur, nxt; int ui = 0;
    if (!S.next(0, cur)) return;
    f32x4 acc[2][2][4][2];
#pragma unroll
    for (int a = 0; a < 2; ++a)
#pragma unroll
        for (int b = 0; b < 2; ++b)
#pragma unroll
            for (int m = 0; m < 4; ++m)
#pragma unroll
                for (int n = 0; n < 2; ++n) acc[a][b][m][n] = (f32x4){0.f, 0.f, 0.f, 0.f};
    bf16x8 At[4][2], B0[2][2], B1[2][2];
    const char* cA = (const char*)g.A + (size_t)cur.pm * tstep + (size_t)cur.ks * K * 2; const char* cB = (const char*)g.Bt + (size_t)cur.pn * tstep + (size_t)cur.ks * K * 2;
    S.a_ready(cur);
    if constexpr (SP2) {
        PG8_STAGE(PG8_SB(0, 0), cB, voffB); PG8_STAGE(PG8_SB(0, 1), cB + hstep, voffB); PG8_STAGE(PG8_SA(0, 0), cA, voffA); PG8_STAGE(PG8_SA(0, 1), cA + hstep, voffA);
        if (wr == 1) PG8_BAR;
        PG8_WAIT_V(2); PG8_BAR;
        PG8_STAGE(PG8_SB(1, 0), cB + kstep, voffB); PG8_STAGE(PG8_SA(1, 0), cA + kstep, voffA); PG8_STAGE(PG8_SB(1, 1), cB + hstep + kstep, voffB);
        PG8_WAIT_V(6); PG8_BAR;
    } else {
        PG8_STAGE(PG8_SB(0, 0), cB, voffB); PG8_STAGE(PG8_SA(0, 0), cA, voffA); PG8_STAGE(PG8_SB(0, 1), cB + hstep, voffB); PG8_STAGE(PG8_SA(0, 1), cA + hstep, voffA);
        if (wr == 1) PG8_BAR;
        PG8_WAIT_V(4); PG8_BAR;
        PG8_STAGE(PG8_SB(1, 0), cB + kstep, voffB); PG8_STAGE(PG8_SA(1, 0), cA + kstep, voffA); PG8_STAGE(PG8_SB(1, 1), cB + hstep + kstep, voffB);
        PG8_WAIT_V(6); PG8_BAR;
    }
    for (;;) {
        const bool has_next = S.next(ui + 1, nxt);
        const char* nA = has_next ? (const char*)g.A + (size_t)nxt.pm * tstep + (size_t)nxt.ks * K * 2 : cA; const char* nB = has_next ? (const char*)g.Bt + (size_t)nxt.pn * tstep + (size_t)nxt.ks * K * 2 : cB;
        for (int t = 0; t < nt; t += 2) {
            const bool last = (t == nt - 2);
            const char* a1 = cA + (size_t)(t + 1) * kstep;
            const char* a2 = last ? nA : cA + (size_t)(t + 2) * kstep; const char* b2 = last ? nB : cB + (size_t)(t + 2) * kstep;
            const char* a3 = a2 + kstep; const char* b3 = b2 + kstep;
            if (last && has_next) S.a_ready(nxt);
            if constexpr (SP2) {
            PG8_LDB(B0, 0, 0); PG8_LDB(B1, 0, 1); PG8_SCHED; PG8_LDA(At, 0, 0); PG8_STAGE(PG8_SA(1, 1), a1 + hstep, voffA);
            PG8_WAIT_V(8); PG8_WAIT_L(0); PG8_BAR; PG8_MMA(0, 0, At, B0); PG8_MMA(0, 1, At, B1); PG8_BAR; PG8_SCHED;
            PG8_LDA(At, 0, 1); PG8_STAGE(PG8_SB(0, 0), b2, voffB); PG8_STAGE(PG8_SB(0, 1), b2 + hstep, voffB); PG8_STAGE(PG8_SA(0, 0), a2, voffA);
            PG8_WAIT_V(8); PG8_WAIT_L(0); PG8_BAR; PG8_MMA(1, 0, At, B0); PG8_MMA(1, 1, At, B1); PG8_BAR; PG8_SCHED;
            PG8_LDB(B0, 1, 0); PG8_LDB(B1, 1, 1); PG8_SCHED; PG8_LDA(At, 1, 0); PG8_STAGE(PG8_SA(0, 1), a2 + hstep, voffA);
            PG8_WAIT_V(8); PG8_WAIT_L(0); PG8_BAR; PG8_MMA(0, 0, At, B0); PG8_MMA(0, 1, At, B1); PG8_BAR; PG8_SCHED;
            PG8_LDA(At, 1, 1); PG8_STAGE(PG8_SB(1, 0), b3, voffB); PG8_STAGE(PG8_SB(1, 1), b3 + hstep, voffB); PG8_STAGE(PG8_SA(1, 0), a3, voffA);
            PG8_WAIT_V(8); PG8_WAIT_L(0); PG8_BAR; PG8_MMA(1, 0, At, B0); PG8_MMA(1, 1, At, B1); PG8_BAR; PG8_SCHED;
            } else {
            PG8_LDB(B0, 0, 0); PG8_SCHED; PG8_LDA(At, 0, 0); PG8_STAGE(PG8_SA(1, 1), a1 + hstep, voffA);
            PG8_WAIT_L(8); PG8_BAR; PG8_WAIT_L(0); PG8_MMA(0, 0, At, B0); PG8_BAR; PG8_SCHED;
            PG8_LDB(B1, 0, 1); PG8_STAGE(PG8_SB(0, 0), b2, voffB);
            PG8_BAR; PG8_WAIT_L(0); PG8_MMA(0, 1, At, B1); PG8_BAR;
            PG8_LDA(At, 0, 1); PG8_STAGE(PG8_SA(0, 0), a2, voffA);
            PG8_BAR; PG8_WAIT_L(0); PG8_MMA(1, 0, At, B0); PG8_BAR; PG8_SCHED;
            PG8_STAGE(PG8_SB(0, 1), b2 + hstep, voffB);
            PG8_WAIT_V(6); PG8_BAR; PG8_MMA(1, 1, At, B1); PG8_BAR;
            PG8_LDB(B0, 1, 0); PG8_SCHED; PG8_LDA(At, 1, 0); PG8_STAGE(PG8_SA(0, 1), a2 + hstep, voffA);
            PG8_WAIT_L(8); PG8_BAR; PG8_WAIT_L(0); PG8_MMA(0, 0, At, B0); PG8_BAR; PG8_SCHED;
            PG8_LDB(B1, 1, 1); PG8_STAGE(PG8_SB(1, 0), b3, voffB);
            PG8_BAR; PG8_WAIT_L(0); PG8_MMA(0, 1, At, B1); PG8_BAR;
            PG8_LDA(At, 1, 1); PG8_STAGE(PG8_SA(1, 0), a3, voffA);
            PG8_BAR; PG8_WAIT_L(0); PG8_MMA(1, 0, At, B0); PG8_BAR; PG8_SCHED;
            PG8_STAGE(PG8_SB(1, 1), b3 + hstep, voffB);
            PG8_WAIT_V(6); PG8_BAR; PG8_MMA(1, 1, At, B1); PG8_BAR;
            }
        }
        if constexpr (ALIGN_EPI) { if (wr == 0) PG8_BAR; }
        if constexpr (!Epi::AFTER_DRAIN) { E(acc, cur, wr, wc, fr, fq); S.done(cur); }
        if (!has_next) break;
#pragma unroll
        for (int a = 0; a < 2; ++a)
#pragma unroll
            for (int b = 0; b < 2; ++b)
#pragma unroll
                for (int m = 0; m < 4; ++m)
#pragma unroll
                    for (int n = 0; n < 2; ++n) acc[a][b][m][n] = (f32x4){0.f, 0.f, 0.f, 0.f};
        cur = nxt; cA = nA; cB = nB; ++ui;
        if constexpr (ALIGN_EPI) { if (wr == 1) PG8_BAR; }
    }
    PG8_WAIT_V(0);
    if constexpr (!ALIGN_EPI) { if (wr == 0) PG8_BAR; }
    PG8_BAR;
    if constexpr (Epi::AFTER_DRAIN) { E.fused(acc, cur, wr, wc, fr, fq, lds, wid, lane); S.done(cur); }
#undef PG8_SA
#undef PG8_SB
#undef PG8_STAGE
#undef PG8_LDA
#undef PG8_LDB
#undef PG8_MMA
#undef PG8_WAIT_V
#undef PG8_WAIT_L
#undef PG8_BAR
#undef PG8_SCHED
}
}
namespace epi {
using pg8::f32x4; using pg8::Unit;
typedef unsigned u32x2 __attribute__((ext_vector_type(2)));
typedef unsigned u32x4 __attribute__((ext_vector_type(4)));
typedef float f32x2 __attribute__((ext_vector_type(2)));
typedef __bf16 bf16x2_t __attribute__((ext_vector_type(2)));
__device__ __forceinline__ unsigned pk(float lo, float hi) { f32x2 v = {lo, hi}; bf16x2_t b = __builtin_convertvector(v, bf16x2_t); return __builtin_bit_cast(unsigned, b); }
__device__ __forceinline__ u32x2 pk4(f32x4 v) { u32x2 w; w.x = pk(v[0], v[1]); w.y = pk(v[2], v[3]); return w; }
__device__ __forceinline__ float sum4sq(f32x4 v) { return (v[0] * v[0] + v[1] * v[1]) + (v[2] * v[2] + v[3] * v[3]); }
__device__ __forceinline__ float quad_sum(float s) { s += __shfl_xor(s, 16); s += __shfl_xor(s, 32); return s; }

__device__ __forceinline__ void st32(bf16_t* base32, f32x4 v0, f32x4 v1, int fq) {
    u32x2 a = pk4(v0), b = pk4(v1);
    { auto r = __builtin_amdgcn_permlane16_swap(a.x, b.x, false, false); a.x = r[0]; b.x = r[1]; }
    { auto r = __builtin_amdgcn_permlane16_swap(a.y, b.y, false, false); a.y = r[0]; b.y = r[1]; }
    u32x4 w; w.x = a.x; w.y = a.y; w.z = b.x; w.w = b.y;
    *(u32x4*)(base32 + 16 * (fq & 1) + 8 * (fq >> 1)) = w;
}

__device__ __forceinline__ int kvbase_of(int pm) { return pm < 64 ? (pm >> 3) * SK + CTX + (pm & 7) * 256 : (pm - 64) * SK; }
__device__ __forceinline__ int modidx_pm(int pm) { return pm < 64 ? (pm >> 3) : 8; }

__device__ __forceinline__ void head_finish(f32x4 (&v)[2][2], const float* gain, bool rope, const float* T32, int grow, int gcol, float scale, int fq) {
    float ss = (sum4sq(v[0][0]) + sum4sq(v[0][1])) + (sum4sq(v[1][0]) + sum4sq(v[1][1]));
    ss = quad_sum(ss);
    const float rn = rsqrtf(ss * (1.f / 64.f) + EPS);
#pragma unroll
    for (int bj = 0; bj < 2; ++bj)
#pragma unroll
        for (int n = 0; n < 2; ++n) { const f32x4 g = *(const f32x4*)(gain + 32 * bj + 16 * n + 4 * fq); v[bj][n] = (v[bj][n] * rn) * g; }
    if (rope) {
#pragma unroll
        for (int bj = 0; bj < 2; ++bj) { const int pos = bj ? gcol : grow;
            const f32x4 cs = *(const f32x4*)(T32 + pos * 16 + 4 * fq), sn = *(const f32x4*)(T32 + 1024 + pos * 16 + 4 * fq);
            const f32x4 x1 = v[bj][0], x2 = v[bj][1];
            v[bj][0] = x1 * cs - x2 * sn; v[bj][1] = x1 * sn + x2 * cs; }
    }
#pragma unroll
    for (int bj = 0; bj < 2; ++bj)
#pragma unroll
        for (int n = 0; n < 2; ++n) v[bj][n] = v[bj][n] * scale;
}

__device__ __forceinline__ void head_finish_r(f32x4 (&v)[2][2], const f32x4 (&g)[2][2], bool rope, f32x4 cs0, f32x4 sn0, f32x4 cs1, f32x4 sn1, float scale) {
    float ss = (sum4sq(v[0][0]) + sum4sq(v[0][1])) + (sum4sq(v[1][0]) + sum4sq(v[1][1]));
    ss = quad_sum(ss);
    const float rn = rsqrtf(ss * (1.f / 64.f) + EPS);
#pragma unroll
    for (int bj = 0; bj < 2; ++bj)
#pragma unroll
        for (int n = 0; n < 2; ++n) v[bj][n] = (v[bj][n] * rn) * g[bj][n];
    if (rope) {
        { const f32x4 x1 = v[0][0], x2 = v[0][1]; v[0][0] = x1 * cs0 - x2 * sn0; v[0][1] = x1 * sn0 + x2 * cs0; }
        { const f32x4 x1 = v[1][0], x2 = v[1][1]; v[1][0] = x1 * cs1 - x2 * sn1; v[1][1] = x1 * sn1 + x2 * cs1; }
    }
#pragma unroll
    for (int bj = 0; bj < 2; ++bj)
#pragma unroll
        for (int n = 0; n < 2; ++n) v[bj][n] = v[bj][n] * scale;
}

struct EpiIn0 {
    static constexpr bool PERM = false, AFTER_DRAIN = false;
    bf16_t *A0, *Q0, *K0, *V0; const float *qg, *kg, *T32;
    __device__ __forceinline__ void operator()(const f32x4 (&acc)[2][2][4][2], const Unit& u, int wr, int wc, int fr_in, int fq_in) const {
        int fr = fr_in, fq = fq_in; asm volatile("" : "+v"(fr), "+v"(fq));
        const int pn = u.pn, pm = u.pm; const bool lat = pm < 64; const int kvb = kvbase_of(pm);
        f32x4 gq[2][2], cs0[2], sn0[2], cs1[4], sn1[4];
        if (pn != 0 && pn != 5) { const float* gain = pn < 4 ? qg : kg;
#pragma unroll
            for (int bj = 0; bj < 2; ++bj)
#pragma unroll
                for (int n = 0; n < 2; ++n) gq[bj][n] = *(const f32x4*)(gain + 32 * bj + 16 * n + 4 * fq);
#pragma unroll
            for (int ai = 0; ai < 2; ++ai) { const int grow = (pm & 7) * 4 + 2 * ai + wr; cs0[ai] = *(const f32x4*)(T32 + grow * 16 + 4 * fq); sn0[ai] = *(const f32x4*)(T32 + 1024 + grow * 16 + 4 * fq); }
#pragma unroll
            for (int m = 0; m < 4; ++m) { const int gcol = 16 * m + fr; cs1[m] = *(const f32x4*)(T32 + gcol * 16 + 4 * fq); sn1[m] = *(const f32x4*)(T32 + 1024 + gcol * 16 + 4 * fq); }
        }
#pragma unroll
        for (int ai = 0; ai < 2; ++ai)
#pragma unroll
            for (int m = 0; m < 4; ++m) {
                const int rl = 128 * ai + 64 * wr + 16 * m + fr; const size_t r = (size_t)pm * 256 + rl;
                if (pn == 0 || pn == 5) {
                    bf16_t* dst = pn == 0 ? A0 + r * 256 : V0 + (size_t)(kvb + rl) * 256;
#pragma unroll
                    for (int bj = 0; bj < 2; ++bj)
                        st32(dst + 64 * wc + 32 * bj, acc[ai][bj][m][0], acc[ai][bj][m][1], fq);
                } else {
                    f32x4 v[2][2] = {{acc[ai][0][m][0], acc[ai][0][m][1]}, {acc[ai][1][m][0], acc[ai][1][m][1]}};
                    bf16_t* dst;
                    if (pn < 4) { head_finish_r(v, gq, lat, cs0[ai], sn0[ai], cs1[m], sn1[m], C2_64); dst = Q0 + r * 768 + ((pn - 1) * 4 + wc) * 64; }
                    else { head_finish_r(v, gq, lat, cs0[ai], sn0[ai], cs1[m], sn1[m], 1.0f); dst = K0 + (size_t)(kvb + rl) * 256 + wc * 64; }
#pragma unroll
                    for (int bj = 0; bj < 2; ++bj)
                        st32(dst + 32 * bj, v[bj][0], v[bj][1], fq);
                }
            }
    }
};

__device__ __forceinline__ f32x4 ld4(const float* p) { return *(const f32x4*)p; }
__device__ __forceinline__ f32x4 ld4(const bf16_t* p) { const u32x2 w = *(const u32x2*)p; return (f32x4){__uint_as_float(w.x << 16), __uint_as_float(w.x & 0xffff0000u), __uint_as_float(w.y << 16), __uint_as_float(w.y & 0xffff0000u)}; }
template <class T> struct Raw4;
template <> struct Raw4<float> { typedef f32x4 type; };
template <> struct Raw4<bf16_t> { typedef u32x2 type; };
__device__ __forceinline__ f32x4 ldraw(const float* p) { return *(const f32x4*)p; }
__device__ __forceinline__ u32x2 ldraw(const bf16_t* p) { return *(const u32x2*)p; }
__device__ __forceinline__ f32x4 cvraw(f32x4 w) { return w; }
__device__ __forceinline__ f32x4 cvraw(u32x2 w) { return (f32x4){__uint_as_float(w.x << 16), __uint_as_float(w.x & 0xffff0000u), __uint_as_float(w.y << 16), __uint_as_float(w.y & 0xffff0000u)}; }
__device__ __forceinline__ void st4(float* p, f32x4 v) { *(f32x4*)p = v; }
__device__ __forceinline__ void st4(bf16_t* p, f32x4 v) { *(u32x2*)p = pk4(v); }
struct RawPF { f32x4 a, b; };
template <class T> struct RawP;
template <> struct RawP<float> { typedef RawPF type; };
template <> struct RawP<bf16_t> { typedef u32x4 type; };
__device__ __forceinline__ RawPF ldp(const float* g32, int fq) { RawPF r; r.a = *(const f32x4*)(g32 + 4 * fq); r.b = *(const f32x4*)(g32 + 16 + 4 * fq); return r; }
__device__ __forceinline__ u32x4 ldp(const bf16_t* g32, int fq) { return *(const u32x4*)(g32 + 16 * (fq & 1) + 8 * (fq >> 1)); }
__device__ __forceinline__ void cvp(const RawPF& r, f32x4& v0, f32x4& v1) { v0 = r.a; v1 = r.b; }
__device__ __forceinline__ void cvp(u32x4 w, f32x4& v0, f32x4& v1) {
    u32x2 a, b; a.x = w.x; a.y = w.y; b.x = w.z; b.y = w.w;
    { auto r = __builtin_amdgcn_permlane16_swap(a.x, b.x, false, false); a.x = r[0]; b.x = r[1]; }
    { auto r = __builtin_amdgcn_permlane16_swap(a.y, b.y, false, false); a.y = r[0]; b.y = r[1]; }
    v0 = cvraw(a); v1 = cvraw(b);
}
__device__ __forceinline__ void stp(float* g32, int fq, f32x4 v0, f32x4 v1) { *(f32x4*)(g32 + 4 * fq) = v0; *(f32x4*)(g32 + 16 + 4 * fq) = v1; }
__device__ __forceinline__ void stp(bf16_t* g32, int fq, f32x4 v0, f32x4 v1) { st32(g32, v0, v1, fq); }
#ifndef MBT_BF
#define MBT_BF 4
#endif
#ifndef MBT_F32
#define MBT_F32 2
#endif
template <class TB, class TO> struct EpiResidT {
    static constexpr bool PERM = false, AFTER_DRAIN = false; static constexpr int MBT = sizeof(TB) == 4 ? MBT_F32 : MBT_BF;
    const TB* base_l; const float* base_c; TO* out_l; float* out_c; const float* mod;
    __device__ __forceinline__ void operator()(const f32x4 (&acc)[2][2][4][2], const Unit& u, int wr, int wc, int fr_in, int fq_in) const {
        int fr = fr_in, fq = fq_in; asm volatile("" : "+v"(fr), "+v"(fq));
        const int pm = u.pm; const bool lat = pm < 64;
        const float* gp = mod + (size_t)modidx_pm(pm) * 6144 + u.pn * 256 + 32 * wc + 4 * fq;
        f32x4 g[2][2];
#pragma unroll
        for (int bj = 0; bj < 2; ++bj)
#pragma unroll
            for (int n = 0; n < 2; ++n) g[bj][n] = *(const f32x4*)(gp + 128 * bj + 16 * n);
        if (lat) {
            const TB* bp = base_l + (size_t)pm * 256 * D; TO* op = out_l + (size_t)pm * 256 * D;
#pragma unroll
            for (int aim = 0; aim < 8; aim += MBT) {
                typename RawP<TB>::type braw[8][2];
#pragma unroll
                for (int q = aim; q < aim + MBT; ++q) { const int ai = q >> 2, m = q & 3; const size_t off = (size_t)(128 * ai + 64 * wr + 16 * m + fr) * D + u.pn * 256 + 32 * wc;
#pragma unroll
                    for (int bj = 0; bj < 2; ++bj) braw[q][bj] = ldp(bp + off + 128 * bj, fq); }
#pragma unroll
                for (int q = aim; q < aim + MBT; ++q) { const int ai = q >> 2, m = q & 3; const size_t off = (size_t)(128 * ai + 64 * wr + 16 * m + fr) * D + u.pn * 256 + 32 * wc;
#pragma unroll
                    for (int bj = 0; bj < 2; ++bj) { f32x4 b0, b1; cvp(braw[q][bj], b0, b1);
                        stp(op + off + 128 * bj, fq, b0 + g[bj][0] * acc[ai][bj][m][0], b1 + g[bj][1] * acc[ai][bj][m][1]); } }
            }
        } else {
            const float* bp = base_c + (size_t)(pm - 64) * 256 * D; float* op = out_c + (size_t)(pm - 64) * 256 * D;
#pragma unroll
            for (int aim = 0; aim < 8; aim += 2) { const int ai = aim >> 2, m0 = aim & 3;
                f32x4 braw[4][2][2];
#pragma unroll
                for (int m = m0; m < m0 + 2; ++m) { const size_t off = (size_t)(128 * ai + 64 * wr + 16 * m + fr) * D + u.pn * 256 + 32 * wc + 4 * fq;
#pragma unroll
                    for (int bj = 0; bj < 2; ++bj)
#pragma unroll
                        for (int n = 0; n < 2; ++n) braw[m][bj][n] = *(const f32x4*)(bp + off + 128 * bj + 16 * n); }
#pragma unroll
                for (int m = m0; m < m0 + 2; ++m) { const size_t off = (size_t)(128 * ai + 64 * wr + 16 * m + fr) * D + u.pn * 256 + 32 * wc + 4 * fq;
#pragma unroll
                    for (int bj = 0; bj < 2; ++bj)
#pragma unroll
                        for (int n = 0; n < 2; ++n) *(f32x4*)(op + off + 128 * bj + 16 * n) = braw[m][bj][n] + g[bj][n] * acc[ai][bj][m][n]; }
            }
        }
    }
};
typedef EpiResidT<float, float> EpiResid;

template <class TB, class TO> struct EpiResidNT {
    static constexpr bool PERM = false, AFTER_DRAIN = false; static constexpr int MBT = sizeof(TB) == 4 ? 2 : 4;
    const TB* base_l; TO* out_l; const float* mod;
    bf16_t* xn2; float* ssn; const float* gain; const float* modsc;
    __device__ __forceinline__ void operator()(const f32x4 (&acc)[2][2][4][2], const Unit& u, int wr, int wc, int fr_in, int fq_in) const {
        int fr = fr_in, fq = fq_in; asm volatile("" : "+v"(fr), "+v"(fq));
        const int pm = u.pm;
        const TB* bp = base_l + (size_t)pm * 256 * D;
        TO* op = out_l + (size_t)pm * 256 * D;
        bf16_t* xp = xn2 + (size_t)pm * 256 * D;
        const int c0 = u.pn * 256 + 32 * wc + 4 * fq;
        const float* gp = mod + (size_t)(pm >> 3) * 6144 + c0;
        const float* sp = modsc + (size_t)(pm >> 3) * 6144 + c0;
        f32x4 g[2][2], f[2][2];
#pragma unroll
        for (int bj = 0; bj < 2; ++bj)
#pragma unroll
            for (int n = 0; n < 2; ++n) { g[bj][n] = *(const f32x4*)(gp + 128 * bj + 16 * n);
                f[bj][n] = *(const f32x4*)(gain + c0 + 128 * bj + 16 * n) * (*(const f32x4*)(sp + 128 * bj + 16 * n) + 1.f); }
#pragma unroll
        for (int aim = 0; aim < 8; aim += MBT) { const int ai = aim >> 2, m0 = aim & 3;
            typename RawP<TB>::type braw[4][2];
            const int cg0 = u.pn * 256 + 32 * wc;
#pragma unroll
            for (int m = m0; m < m0 + MBT; ++m) { const size_t off = (size_t)(128 * ai + 64 * wr + 16 * m + fr) * D + cg0;
#pragma unroll
                for (int bj = 0; bj < 2; ++bj) braw[m][bj] = ldp(bp + off + 128 * bj, fq); }
#pragma unroll
            for (int m = m0; m < m0 + MBT; ++m) { const int row = 128 * ai + 64 * wr + 16 * m + fr; const size_t off = (size_t)row * D + cg0;
                float ss = 0.f;
#pragma unroll
                for (int bj = 0; bj < 2; ++bj) { f32x4 b0, b1; cvp(braw[m][bj], b0, b1);
                    const f32x4 v0 = b0 + g[bj][0] * acc[ai][bj][m][0], v1 = b1 + g[bj][1] * acc[ai][bj][m][1];
                    stp(op + off + 128 * bj, fq, v0, v1);
                    ss += ((v0[0] * v0[0] + v0[1] * v0[1]) + (v0[2] * v0[2] + v0[3] * v0[3])) + ((v1[0] * v1[0] + v1[1] * v1[1]) + (v1[2] * v1[2] + v1[3] * v1[3]));
                    st32(xp + off + 128 * bj, v0 * f[bj][0], v1 * f[bj][1], fq); }
                ss += __shfl_xor(ss, 16); ss += __shfl_xor(ss, 32);
                if (fq == 0) atomicAdd(ssn + pm * 256 + row, ss); }
        }
    }
};

struct EpiResidSplit {
    static constexpr bool PERM = false, AFTER_DRAIN = false;
    const float* base_c; float* out_c; float* slab; const float* mod; int ks_base = 0;
    __device__ __forceinline__ void operator()(const f32x4 (&acc)[2][2][4][2], const Unit& u_in, int wr, int wc, int fr_in, int fq_in) const {
        int fr = fr_in, fq = fq_in; asm volatile("" : "+v"(fr), "+v"(fq));
        Unit u = u_in; u.ks += ks_base;
        const int pm = u.pm - 64;
        const float* bp = base_c + (size_t)pm * 256 * D;
        float* op = u.ks == 0 ? out_c + (size_t)pm * 256 * D : slab + (size_t)(u.ks - 1) * MC * D + (size_t)pm * 256 * D;
        const float* gp = mod + (size_t)8 * 6144 + u.pn * 256 + 32 * wc + 4 * fq;
        f32x4 g[2][2];
#pragma unroll
        for (int bj = 0; bj < 2; ++bj)
#pragma unroll
            for (int n = 0; n < 2; ++n) g[bj][n] = *(const f32x4*)(gp + 128 * bj + 16 * n);
#pragma unroll
        for (int aim = 0; aim < 8; aim += 2) { const int ai = aim >> 2, m0 = aim & 3;
            f32x4 braw[4][2][2];
#pragma unroll
            for (int m = m0; m < m0 + 2; ++m) { const size_t off = (size_t)(128 * ai + 64 * wr + 16 * m + fr) * D + u.pn * 256 + 32 * wc + 4 * fq;
#pragma unroll
                for (int bj = 0; bj < 2; ++bj)
#pragma unroll
                    for (int n = 0; n < 2; ++n) braw[m][bj][n] = u.ks == 0 ? *(const f32x4*)(bp + off + 128 * bj + 16 * n) : (f32x4){0.f, 0.f, 0.f, 0.f}; }
#pragma unroll
            for (int m = m0; m < m0 + 2; ++m) { const size_t off = (size_t)(128 * ai + 64 * wr + 16 * m + fr) * D + u.pn * 256 + 32 * wc + 4 * fq;
#pragma unroll
                for (int bj = 0; bj < 2; ++bj)
#pragma unroll
                    for (int n = 0; n < 2; ++n) *(f32x4*)(op + off + 128 * bj + 16 * n) = braw[m][bj][n] + g[bj][n] * acc[ai][bj][m][n]; }
        }
    }
};

typedef unsigned int v4u_t __attribute__((vector_size(16)));
__device__ __forceinline__ __amdgpu_buffer_rsrc_t wt_rsrc(void* base, unsigned bytes) { return __builtin_amdgcn_make_buffer_rsrc(base, (short)0, (int)bytes, 0x00020000); }
__device__ __forceinline__ void wt_st16(__amdgpu_buffer_rsrc_t rs, unsigned off_bytes, u32x4 w) { __builtin_amdgcn_raw_buffer_store_b128(__builtin_bit_cast(v4u_t, w), rs, off_bytes, 0,   16); }
struct EpiSwiGLU {
    static constexpr bool PERM = true, AFTER_DRAIN = false;
    bf16_t* H;
    __device__ __forceinline__ void operator()(const f32x4 (&acc)[2][2][4][2], const Unit& u, int wr, int wc, int fr_in, int fq_in) const {
        int fr = fr_in, fq = fq_in; asm volatile("" : "+v"(fr), "+v"(fq));
#ifdef WT_H
        const __amdgpu_buffer_rsrc_t hrs = wt_rsrc(H, (unsigned)((size_t)MT * FF * 2));
#endif
#pragma unroll
        for (int ai = 0; ai < 2; ++ai)
#pragma unroll
            for (int m = 0; m < 4; ++m) { const size_t r = (size_t)u.pm * 256 + 128 * ai + 64 * wr + 16 * m + fr;
                f32x4 h[2];
#pragma unroll
                for (int n = 0; n < 2; ++n) { const f32x4 g = acc[ai][0][m][n], up = acc[ai][1][m][n];
#pragma unroll
                    for (int e = 0; e < 4; ++e) h[n][e] = g[e] * __builtin_amdgcn_rcpf(1.f + __builtin_amdgcn_exp2f(-g[e] * LOG2E)) * up[e]; }
                u32x4 w; w.x = pk(h[0][0], h[0][1]); w.y = pk(h[0][2], h[0][3]); w.z = pk(h[1][0], h[1][1]); w.w = pk(h[1][2], h[1][3]);
#ifdef WT_H
                wt_st16(hrs, (unsigned)((r * FF + u.pn * 128 + 32 * wc + 8 * fq) * 2), w); }
#else
                *(u32x4*)(H + r * FF + u.pn * 128 + 32 * wc + 8 * fq) = w; }
#endif
    }
};

struct EpiSwiGLUN {
    static constexpr bool PERM = true, AFTER_DRAIN = false;
    bf16_t* H; const float* ssn; const float* bias;
    __device__ __forceinline__ void operator()(const f32x4 (&acc)[2][2][4][2], const Unit& u, int wr, int wc, int fr_in, int fq_in) const {
        int fr = fr_in, fq = fq_in; asm volatile("" : "+v"(fr), "+v"(fq));
#ifdef WT_H
        const __amdgpu_buffer_rsrc_t hrs = wt_rsrc(H, (unsigned)((size_t)MT * FF * 2));
#endif
        const float* bp = bias + (size_t)(u.pm >> 3) * (2 * FF) + u.pn * 256 + 32 * wc + 8 * fq;
        f32x4 bg[2], bu[2];
#pragma unroll
        for (int n = 0; n < 2; ++n) { bg[n] = *(const f32x4*)(bp + 4 * n); bu[n] = *(const f32x4*)(bp + 128 + 4 * n); }
        float rr[2][4];
#pragma unroll
        for (int ai = 0; ai < 2; ++ai)
#pragma unroll
            for (int m = 0; m < 4; ++m) rr[ai][m] = ssn[u.pm * 256 + 128 * ai + 64 * wr + 16 * m + fr];
#pragma unroll
        for (int ai = 0; ai < 2; ++ai)
#pragma unroll
            for (int m = 0; m < 4; ++m) { const size_t r = (size_t)u.pm * 256 + 128 * ai + 64 * wr + 16 * m + fr;
                const float rs = rsqrtf(rr[ai][m] * (1.f / D) + EPS);
                f32x4 h[2];
#pragma unroll
                for (int n = 0; n < 2; ++n) { const f32x4 g = acc[ai][0][m][n] * rs + bg[n], up = acc[ai][1][m][n] * rs + bu[n];
#pragma unroll
                    for (int e = 0; e < 4; ++e) h[n][e] = g[e] * __builtin_amdgcn_rcpf(1.f + __builtin_amdgcn_exp2f(-g[e] * LOG2E)) * up[e]; }
                u32x4 w; w.x = pk(h[0][0], h[0][1]); w.y = pk(h[0][2], h[0][3]); w.z = pk(h[1][0], h[1][1]); w.w = pk(h[1][2], h[1][3]);
#ifdef WT_H
                wt_st16(hrs, (unsigned)((r * FF + u.pn * 128 + 32 * wc + 8 * fq) * 2), w); }
#else
                *(u32x4*)(H + r * FF + u.pn * 128 + 32 * wc + 8 * fq) = w; }
#endif
    }
};

struct EpiSwiGLUW {
    static constexpr bool PERM = true, AFTER_DRAIN = false;
    bf16_t* H;
    __device__ __forceinline__ void operator()(const f32x4 (&acc)[2][2][4][2], const Unit& u, int wr, int wc, int fr_in, int fq_in) const {
        int fr = fr_in, fq = fq_in; asm volatile("" : "+v"(fr), "+v"(fq));
        const __amdgpu_buffer_rsrc_t rs = __builtin_amdgcn_make_buffer_rsrc((void*)(H + (size_t)ML * FF), (short)0, (int)(MC * FF * 2), 0x00020000);
#pragma unroll
        for (int ai = 0; ai < 2; ++ai)
#pragma unroll
            for (int m = 0; m < 4; ++m) { const unsigned r = (unsigned)(u.pm - 64) * 256 + 128 * ai + 64 * wr + 16 * m + fr;
                f32x4 h[2];
#pragma unroll
                for (int n = 0; n < 2; ++n) { const f32x4 g = acc[ai][0][m][n], up = acc[ai][1][m][n];
#pragma unroll
                    for (int e = 0; e < 4; ++e) h[n][e] = g[e] * __builtin_amdgcn_rcpf(1.f + __builtin_amdgcn_exp2f(-g[e] * LOG2E)) * up[e]; }
                u32x4 w; w.x = pk(h[0][0], h[0][1]); w.y = pk(h[0][2], h[0][3]); w.z = pk(h[1][0], h[1][1]); w.w = pk(h[1][2], h[1][3]);
                __builtin_amdgcn_raw_buffer_store_b128(__builtin_bit_cast(v4u_t, w), rs, (r * FF + u.pn * 128 + 32 * wc + 8 * fq) * 2u, 0,   16); }
    }
};

struct EpiIn1 {
    static constexpr bool PERM = false, AFTER_DRAIN = false;
    bf16_t *CQ, *CKV, *NQ, *NK, *NV; float *KR, *SSQ, *SSKV; const float *nqg, *nkg;
    __device__ __forceinline__ void operator()(const f32x4 (&acc)[2][2][4][2], const Unit& u, int wr, int wc, int fr_in, int fq_in) const {
        int fr = fr_in, fq = fq_in; asm volatile("" : "+v"(fr), "+v"(fq));
        const int pn = u.pn, pm = u.pm; const int kvb = kvbase_of(pm);
        f32x4 gna[2][2];
        if (pn >= 3 && pn < 7) { const float* gain = pn < 5 ? nqg : nkg;
#pragma unroll
            for (int bj = 0; bj < 2; ++bj)
#pragma unroll
                for (int n = 0; n < 2; ++n) gna[bj][n] = *(const f32x4*)(gain + 32 * bj + 16 * n + 4 * fq); }
#pragma unroll
        for (int ai = 0; ai < 2; ++ai)
#pragma unroll
            for (int m = 0; m < 4; ++m) {
                const int rl = 128 * ai + 64 * wr + 16 * m + fr; const size_t r = (size_t)pm * 256 + rl;
                if (pn == 0 || pn == 2) {
                    bf16_t* dst = pn == 0 ? CQ + r * 384 : CKV + r * 256; float ss = 0.f;
#pragma unroll
                    for (int bj = 0; bj < 2; ++bj)
                        { ss += sum4sq(acc[ai][bj][m][0]) + sum4sq(acc[ai][bj][m][1]); st32(dst + 128 * bj + 32 * wc, acc[ai][bj][m][0], acc[ai][bj][m][1], fq); }
                    ss = quad_sum(ss);
                    if (fq == 0) atomicAdd((pn == 0 ? SSQ : SSKV) + r, ss);
                } else if (pn == 1) {
                    float ss = 0.f;
                    { ss += sum4sq(acc[ai][0][m][0]) + sum4sq(acc[ai][0][m][1]); st32(CQ + r * 384 + 256 + 32 * wc, acc[ai][0][m][0], acc[ai][0][m][1], fq); }
                    ss = quad_sum(ss);
                    if (fq == 0) atomicAdd(SSQ + r, ss);
                    if (wc == 0) {
#pragma unroll
                        for (int n = 0; n < 2; ++n) *(f32x4*)(KR + r * 32 + 16 * n + 4 * fq) = acc[ai][1][m][n]; }
                } else if (pn >= 7) {
                    bf16_t* dst = NV + (size_t)(kvb + rl) * 512 + (pn - 7) * 256 + 64 * wc;
#pragma unroll
                    for (int bj = 0; bj < 2; ++bj)
                        st32(dst + 32 * bj, acc[ai][bj][m][0], acc[ai][bj][m][1], fq);
                } else {
                    f32x4 v[2][2] = {{acc[ai][0][m][0], acc[ai][0][m][1]}, {acc[ai][1][m][0], acc[ai][1][m][1]}};
                    bf16_t* dst;
                    const f32x4 z4 = {0.f, 0.f, 0.f, 0.f};
                    if (pn < 5) { head_finish_r(v, gna, false, z4, z4, z4, z4, C2_64); dst = NQ + r * 512 + ((pn - 3) * 4 + wc) * 64; }
                    else { head_finish_r(v, gna, false, z4, z4, z4, z4, 1.0f); dst = NK + (size_t)(kvb + rl) * 512 + ((pn - 5) * 4 + wc) * 64; }
#pragma unroll
                    for (int bj = 0; bj < 2; ++bj)
                        st32(dst + 32 * bj, v[bj][0], v[bj][1], fq);
                }
            }
    }
};

struct EpiQUp {
    static constexpr bool PERM = true, AFTER_DRAIN = false;
    bf16_t* MQ; const float* SSQ;
    __device__ __forceinline__ void operator()(const f32x4 (&acc)[2][2][4][2], const Unit& u, int wr, int wc, int fr_in, int fq_in) const {
        int fr = fr_in, fq = fq_in; asm volatile("" : "+v"(fr), "+v"(fq));
        float ssq[2][4];
#pragma unroll
        for (int ai = 0; ai < 2; ++ai)
#pragma unroll
            for (int m = 0; m < 4; ++m) ssq[ai][m] = SSQ[(size_t)u.pm * 256 + 128 * ai + 64 * wr + 16 * m + fr];
#pragma unroll
        for (int ai = 0; ai < 2; ++ai)
#pragma unroll
            for (int m = 0; m < 4; ++m) { const size_t r = (size_t)u.pm * 256 + 128 * ai + 64 * wr + 16 * m + fr;
                const float rs = rsqrtf(ssq[ai][m] * (1.f / 384.f) + EPS);
#pragma unroll
                for (int bj = 0; bj < 2; ++bj) { const f32x4 a = acc[ai][bj][m][0] * rs, b = acc[ai][bj][m][1] * rs;
                    u32x4 w; w.x = pk(a[0], a[1]); w.y = pk(a[2], a[3]); w.z = pk(b[0], b[1]); w.w = pk(b[2], b[3]);
                    *(u32x4*)(MQ + r * 768 + u.pn * 256 + 128 * bj + 32 * wc + 8 * fq) = w; } }
    }
};

#ifndef KVB
#ifdef TP_A
#define KVB 1
#else
#define KVB 2
#endif
#endif
struct EpiKvUp {
    static constexpr bool PERM = false, AFTER_DRAIN = false;
    bf16_t *MK, *MV; const float *SSKV, *KR, *kg, *T16;
    __device__ __forceinline__ void operator()(const f32x4 (&acc)[2][2][4][2], const Unit& u, int wr, int wc, int fr_in, int fq_in) const {
        int fr = fr_in, fq = fq_in; asm volatile("" : "+v"(fr), "+v"(fq));
        const int pm = u.pm; const bool lat = pm < 64; const int kvb = kvbase_of(pm); const int head = 2 * u.pn + (wc >> 1); const bool isv = wc & 1;
        float rs[2][4];
#pragma unroll
        for (int ai = 0; ai < 2; ++ai)
#pragma unroll
            for (int m = 0; m < 4; ++m) rs[ai][m] = SSKV[(size_t)pm * 256 + 128 * ai + 64 * wr + 16 * m + fr];
#pragma unroll
        for (int ai = 0; ai < 2; ++ai)
#pragma unroll
            for (int m = 0; m < 4; ++m) rs[ai][m] = rsqrtf(rs[ai][m] * (1.f / 256.f) + EPS);
        if (isv) {
#pragma unroll
            for (int ai = 0; ai < 2; ++ai)
#pragma unroll
                for (int m = 0; m < 4; ++m) { const size_t kvr = (size_t)(kvb + 128 * ai + 64 * wr + 16 * m + fr);
#pragma unroll
                    for (int bj = 0; bj < 2; ++bj)
                        st32(MV + kvr * 512 + head * 64 + 32 * bj, acc[ai][bj][m][0] * rs[ai][m], acc[ai][bj][m][1] * rs[ai][m], fq); }
            return;
        }
        f32x4 gn[2][2]; f32x2 gr[4];
#pragma unroll
        for (int bj = 0; bj < 2; ++bj)
#pragma unroll
            for (int n = 0; n < 2; ++n) gn[bj][n] = *(const f32x4*)(kg + 32 * bj + 16 * n + 4 * fq);
#pragma unroll
        for (int j = 0; j < 4; ++j) gr[j] = *(const f32x2*)(kg + 64 + 8 * j + 2 * fq);
        f32x2 cscm[4], sncm[4];
#pragma unroll
        for (int m = 0; m < 4; ++m) { cscm[m] = (f32x2){1.f, 1.f}; sncm[m] = (f32x2){0.f, 0.f};
            if (lat) { const int gcol = 16 * m + fr; cscm[m] = *(const f32x2*)(T16 + gcol * 8 + 2 * fq); sncm[m] = *(const f32x2*)(T16 + 512 + gcol * 8 + 2 * fq); } }
#pragma unroll
        for (int ai = 0; ai < 2; ++ai) {
            const int grow = (pm & 7) * 4 + 2 * ai + wr;
            f32x2 csr = {1.f, 1.f}, snr = {0.f, 0.f};
            if (lat) { csr = *(const f32x2*)(T16 + grow * 8 + 2 * fq); snr = *(const f32x2*)(T16 + 512 + grow * 8 + 2 * fq); }
#pragma unroll
            for (int mp = 0; mp < 4; mp += KVB) {
            f32x2 kk[4][4];
#pragma unroll
            for (int m = mp; m < mp + KVB; ++m) { const size_t r = (size_t)pm * 256 + 128 * ai + 64 * wr + 16 * m + fr;
#pragma unroll
                for (int j = 0; j < 4; ++j) kk[m][j] = *(const f32x2*)(KR + r * 32 + 8 * j + 2 * fq); }
#pragma unroll
            for (int m = mp; m < mp + KVB; ++m) {
                const int rl = 128 * ai + 64 * wr + 16 * m + fr; const size_t kvr = (size_t)(kvb + rl);
                f32x2 k[4];
#pragma unroll
                for (int j = 0; j < 4; ++j) k[j] = kk[m][j];
                const f32x2 csc = cscm[m], snc = sncm[m];
                f32x4 v[2][2];
#pragma unroll
                for (int bj = 0; bj < 2; ++bj)
#pragma unroll
                    for (int n = 0; n < 2; ++n) v[bj][n] = acc[ai][bj][m][n] * rs[ai][m];
                float ss = (sum4sq(v[0][0]) + sum4sq(v[0][1])) + (sum4sq(v[1][0]) + sum4sq(v[1][1]));
#pragma unroll
                for (int j = 0; j < 4; ++j) ss += k[j][0] * k[j][0] + k[j][1] * k[j][1];
                ss = quad_sum(ss);
                const float rr = rsqrtf(ss * (1.f / 96.f) + EPS);
#pragma unroll
                for (int bj = 0; bj < 2; ++bj)
                    st32(MK + kvr * 768 + head * 96 + 32 * bj, (v[bj][0] * rr) * gn[bj][0], (v[bj][1] * rr) * gn[bj][1], fq);
#pragma unroll
                for (int j = 0; j < 4; ++j) k[j] = (k[j] * rr) * gr[j];
                { const f32x2 x1 = k[0], x2 = k[1]; k[0] = x1 * csr - x2 * snr; k[1] = x1 * snr + x2 * csr; }
                { const f32x2 x1 = k[2], x2 = k[3]; k[2] = x1 * csc - x2 * snc; k[3] = x1 * snc + x2 * csc; }
#pragma unroll
                for (int j = 0; j < 4; ++j) *(unsigned*)(MK + kvr * 768 + head * 96 + 64 + 8 * j + 2 * fq) = pk(k[j][0], k[j][1]);
                if (m & 1) asm volatile("" ::: "memory");
            }
            }
        }
    }
};
}
namespace att {
using bf16x8 = __attribute__((ext_vector_type(8))) short;
using s16x4 = __attribute__((ext_vector_type(4))) short;
using f32x16 = __attribute__((ext_vector_type(16))) float;
using u32x4 = __attribute__((ext_vector_type(4))) unsigned;
typedef float f32x2_t __attribute__((ext_vector_type(2))); typedef __bf16 bf16x2_t __attribute__((ext_vector_type(2)));
#define ALAS __attribute__((address_space(3)))
constexpr int KSLOT = 12288, VSLOT = 8192, SLOT = KSLOT + VSLOT, NSLOT = 4, PD = NSLOT - 2;
constexpr int LDS_WS = NSLOT * SLOT;
constexpr int LDS_OST = LDS_WS + 8 * 256;
constexpr int LDS_RPB = LDS_OST + 8 * 4096;
constexpr int LDS_BYTES = LDS_RPB + 4096;
constexpr float THR = 8.0f;

__device__ __forceinline__ int crow(int r, int hi) { return (r & 3) + 8 * (r >> 2) + 4 * hi; }
__device__ __forceinline__ void glds16(const void* gsrc, unsigned lds_dst) { unsigned keep;
    asm volatile("s_mov_b32 %0, m0\n\ts_mov_b32 m0, %2\n\ts_nop 0\n\tglobal_load_lds_dwordx4 %1, off\n\ts_mov_b32 m0, %0" : "=&s"(keep) : "v"(gsrc), "s"(lds_dst) : "memory"); }
__device__ __forceinline__ unsigned cvtpk(float lo, float hi) { f32x2_t v = {lo, hi}; bf16x2_t b = __builtin_convertvector(v, bf16x2_t); return __builtin_bit_cast(unsigned, b); }
__device__ __forceinline__ void glds16s(unsigned voff, const void* sbase, unsigned lds_dst) { unsigned keep;
    asm volatile("s_mov_b32 %0, m0\n\ts_mov_b32 m0, %3\n\ts_nop 0\n\tglobal_load_lds_dwordx4 %1, %2\n\ts_mov_b32 m0, %0" : "=&s"(keep) : "v"(voff), "s"(sbase), "s"(lds_dst) : "memory"); }
__device__ __forceinline__ float max3f(float a, float b, float c) { float r; asm("v_max3_f32 %0, %1, %2, %3" : "=v"(r) : "v"(a), "v"(b), "v"(c)); return r; }
__device__ __forceinline__ float max2f(float a, float b) { float r; asm("v_max_f32_e32 %0, %1, %2" : "=v"(r) : "v"(a), "v"(b)); return r; }
#define AWAIT_BAR(N) asm volatile("s_waitcnt vmcnt(" #N ") lgkmcnt(0)\n\ts_barrier" ::: "memory")

template <int ND0> __device__ __forceinline__ void qkt(f32x16& p0, f32x16& p1, const ALAS char* Kslot, const bf16x8* qr, const f32x16& negm, int r32, int hi) {
    const ALAS char* kb = Kslot + hi * 1024 + r32 * 16;
#pragma unroll
    for (int d0 = 0; d0 < ND0; ++d0) {
        const bf16x8 b0 = *(const ALAS bf16x8*)(kb + d0 * 2048);
        const bf16x8 b1 = *(const ALAS bf16x8*)(kb + d0 * 2048 + 512);
        if (d0 == 0) { p0 = __builtin_amdgcn_mfma_f32_32x32x16_bf16(b0, qr[0], negm, 0, 0, 0); p1 = __builtin_amdgcn_mfma_f32_32x32x16_bf16(b1, qr[0], negm, 0, 0, 0); }
        else { p0 = __builtin_amdgcn_mfma_f32_32x32x16_bf16(b0, qr[d0], p0, 0, 0, 0); p1 = __builtin_amdgcn_mfma_f32_32x32x16_bf16(b1, qr[d0], p1, 0, 0, 0); }
    }
}
__device__ __forceinline__ float rowmax32(const f32x16& p0, const f32x16& p1) {
    float a[4];
#pragma unroll
    for (int k = 0; k < 4; ++k) { a[k] = max3f(p0[4 * k], p0[4 * k + 1], p0[4 * k + 2]); }
#pragma unroll
    for (int k = 0; k < 4; ++k) { a[k] = max3f(a[k], p0[4 * k + 3], p1[4 * k]); }
#pragma unroll
    for (int k = 0; k < 4; ++k) { a[k] = max3f(a[k], p1[4 * k + 1], p1[4 * k + 2]); }
    const float m = max3f(max3f(a[0], p1[3], p1[7]), max3f(a[1], p1[11], p1[15]), max2f(a[2], a[3]));
    auto rr = __builtin_amdgcn_permlane32_swap(__float_as_uint(m), __float_as_uint(m), false, false);
    return max2f(__uint_as_float(rr[0]), __uint_as_float(rr[1]));
}
typedef short v4i16_t __attribute__((ext_vector_type(4)));
__device__ __forceinline__ s16x4 vtr(const ALAS char* p) { return __builtin_bit_cast(s16x4, __builtin_amdgcn_ds_read_tr16_b64_v4i16((ALAS v4i16_t*)p)); }
__device__ __forceinline__ void pv(f32x16* o, const ALAS char* vp, bf16x8 pa0, bf16x8 pa1, bf16x8 pa2, bf16x8 pa3) {
#pragma unroll
    for (int d0 = 0; d0 < 2; ++d0) { s16x4 lo[4], hi[4];
#pragma unroll
        for (int ks = 0; ks < 4; ++ks) { lo[ks] = vtr(vp + d0 * 4096 + ks * 1024); hi[ks] = vtr(vp + d0 * 4096 + ks * 1024 + 512); }
#define APK(k) (bf16x8){lo[k][0], lo[k][1], lo[k][2], lo[k][3], hi[k][0], hi[k][1], hi[k][2], hi[k][3]}
        o[d0] = __builtin_amdgcn_mfma_f32_32x32x16_bf16(pa0, APK(0), o[d0], 0, 0, 0);
        o[d0] = __builtin_amdgcn_mfma_f32_32x32x16_bf16(pa1, APK(1), o[d0], 0, 0, 0);
        o[d0] = __builtin_amdgcn_mfma_f32_32x32x16_bf16(pa2, APK(2), o[d0], 0, 0, 0);
        o[d0] = __builtin_amdgcn_mfma_f32_32x32x16_bf16(pa3, APK(3), o[d0], 0, 0, 0);
#undef APK
    }
}

struct UnitDesc {
    const bf16_t* Q; int qpitch;
    long q0; int qcol;
    const bf16_t* K; int kpitch, kcol;
    const bf16_t* V; int vpitch, vcol;
    bf16_t* O; int opitch, ocol;
    int kv0;
    int nt;
    int rg;
    int rmin;
    int head;
    const bf16_t* G;
};

template <int DQK, bool NA, bool MLAQ>
__device__ __forceinline__ void attn_unit(const UnitDesc& U, ALAS char* shm, const float* qgain, const float* T16, const float* rpb_g) {
    constexpr int ND0 = DQK / 16, NCH = DQK / 8, NP = NCH + 8;
    int tid_ = threadIdx.x; asm volatile("" : "+v"(tid_));
    const int tid = tid_, lane = tid & 63, r32 = lane & 31, hi = lane >> 5; const int wid = __builtin_amdgcn_readfirstlane(tid >> 6);
#ifdef ATT_STATIC_PRIO_NA
    if (wid >= 4) __builtin_amdgcn_s_setprio(1);
#endif
    const unsigned lds0 = (unsigned)(uintptr_t)shm;
    ALAS float* wsf = (ALAS float*)(shm + LDS_WS) + wid * 64;
    unsigned doff[3];
#pragma unroll
    for (int i = 0; i < 3; ++i) { const int pc = wid + 8 * i;
        if (pc < NCH) doff[i] = (unsigned)((lane * U.kpitch + U.kcol + pc * 8) * 2);
        else { const int v = pc - NCH; doff[i] = (unsigned)(((16 * (v & 3) + (lane >> 2)) * U.vpitch + U.vcol + (v >> 2) * 32 + (lane & 3) * 8) * 2); } }
    auto dma_tile = [&](int t, int slot) {
        int key0;
        if (NA && t >= 4) key0 = U.kv0 + CTX + (U.rmin + (t - 4)) * GW; else key0 = U.kv0 + 64 * t;
        const unsigned sbase = lds0 + slot * SLOT;
        const bf16_t* kb_ = U.K + (size_t)key0 * U.kpitch; const bf16_t* vb_ = U.V + (size_t)key0 * U.vpitch;
#pragma unroll
        for (int i = 0; i < 3; ++i) { const int pc = wid + 8 * i;
            if (pc < NP) {
                if (pc < NCH) glds16s(doff[i], kb_, (unsigned)__builtin_amdgcn_readfirstlane(sbase + pc * 1024));
                else glds16s(doff[i], vb_, (unsigned)__builtin_amdgcn_readfirstlane(sbase + KSLOT + (pc - NCH) * 1024));
#ifdef ATT_DUP_DMA
                if (pc < NCH) glds16s(doff[i], kb_, (unsigned)__builtin_amdgcn_readfirstlane(sbase + pc * 1024));
                else glds16s(doff[i], vb_, (unsigned)__builtin_amdgcn_readfirstlane(sbase + KSLOT + (pc - NCH) * 1024));
#endif
            } }
    };
    asm volatile("s_waitcnt vmcnt(0)" ::: "memory");
#pragma unroll
    for (int t0_ = 0; t0_ < PD; ++t0_) if (t0_ < U.nt) dma_tile(t0_, t0_);
    bf16x8 qr[ND0];
    const bf16_t* Qw = U.Q + (size_t)(U.q0 + wid * 32 + r32) * U.qpitch + U.qcol;
#pragma unroll
    for (int d0 = 0; d0 < ND0; ++d0) qr[d0] = *(const bf16x8*)(Qw + d0 * 16 + hi * 8);
    if (MLAQ) {
        float f[ND0][8]; float ss = 0.f;
#pragma unroll
        for (int d0 = 0; d0 < ND0; ++d0)
#pragma unroll
            for (int j = 0; j < 8; ++j) { f[d0][j] = bf2f((bf16_t)qr[d0][j]); ss += f[d0][j] * f[d0][j]; }
        ss += __shfl_xor(ss, 32);
        const float rn = rsqrtf(ss * (1.f / 96.f) + EPS) * C2_96;
#pragma unroll
        for (int d0 = 0; d0 < ND0; ++d0)
#pragma unroll
            for (int j = 0; j < 8; ++j) f[d0][j] = f[d0][j] * rn * qgain[d0 * 16 + hi * 8 + j];
        const int t = (int)((U.q0 + wid * 32 + r32) % S); const int grow = t / GW, gcol = t % GW;
#pragma unroll
        for (int part = 0; part < 2; ++part) { const int pos = part ? gcol : grow;
#pragma unroll
            for (int j = 0; j < 8; ++j) { const float cs = T16[pos * 8 + j], sn = T16[512 + pos * 8 + j];
                const float mine = f[4 + part][j], other = __shfl_xor(mine, 32);
                f[4 + part][j] = hi == 0 ? (mine * cs - other * sn) : (other * sn + mine * cs); } }
#pragma unroll
        for (int d0 = 0; d0 < ND0; ++d0)
#pragma unroll
            for (int j = 0; j < 4; ++j) { const unsigned w = cvtpk(f[d0][2 * j], f[d0][2 * j + 1]); qr[d0][2 * j] = (short)(w & 0xffff); qr[d0][2 * j + 1] = (short)(w >> 16); }
    }
    const int grow_w = NA ? 4 * U.rg + (wid >> 1) : 0, c0w = 32 * (wid & 1);
    const int r0w = NA ? min(max(grow_w - 4, 0), 24) : 0;
    const int qc = c0w + r32;
    const int cs_q = min(max(qc - 8, 0), 48);
    float mhat = 0.f, l_reg = 0.f; f32x16 o[2]; o[0] = f32x16{}; o[1] = f32x16{};
    const ALAS char* vp0 = shm + KSLOT + ((lane >> 4) & 1) * 32 + (lane & 3) * 8 + (4 * hi + ((lane & 15) >> 2)) * 64;
    const int NT = U.nt;
    f32x16 a0, a1, b0, b1;
    u32x4 pw0, pw1, pw2, pw3;
    auto wait_tile = [&](int t) {
        const int ahead = min(PD - 1, NT - 1 - t);
        const bool big = (NP == 20 && wid < 4);
#ifdef ATT_DUP_DMA
        if (ahead >= 1) { if (big) AWAIT_BAR(6); else AWAIT_BAR(4); }
        else AWAIT_BAR(0);
#else
        if (ahead >= 2) { if (big) AWAIT_BAR(6); else AWAIT_BAR(4); }
        else if (ahead == 1) { if (big) AWAIT_BAR(3); else AWAIT_BAR(2); }
        else AWAIT_BAR(0);
#endif
        if (t + PD < NT) dma_tile(t + PD, (t + PD) % NSLOT);
    };
    bf16x8 eq[2];
    if (NA) {
#pragma unroll
        for (int s_ = 0; s_ < 2; ++s_)
#pragma unroll
            for (int jj = 0; jj < 8; ++jj) eq[s_][jj] = (16 * s_ + 8 * hi + jj == r32) ? (short)0x3f80 : (short)0;
    }
    const bf16_t* gq = NA ? U.G + (size_t)U.head * (16 * 2 * 64 * 32) + (size_t)(wid & 1) * (64 * 32) + r32 * 32 + hi * 8 : nullptr;
    auto gbias_load = [&](bf16x8 (&f)[4], int t) {
        const int krow = U.rmin + (t - 4); int dr = krow - grow_w + 7; if (krow < r0w || krow >= r0w + 8) dr = 15;
        const bf16_t* g = gq + (size_t)dr * (2 * 64 * 32);
#pragma unroll
        for (int half = 0; half < 2; ++half)
#pragma unroll
            for (int s_ = 0; s_ < 2; ++s_) f[2 * s_ + half] = *(const bf16x8*)(g + half * 1024 + s_ * 16);
    };
    auto gbias_mma = [&](f32x16& c0, f32x16& c1, const bf16x8 (&f)[4]) {
        c0 = __builtin_amdgcn_mfma_f32_32x32x16_bf16(f[0], eq[0], c0, 0, 0, 0); c1 = __builtin_amdgcn_mfma_f32_32x32x16_bf16(f[1], eq[0], c1, 0, 0, 0);
        c0 = __builtin_amdgcn_mfma_f32_32x32x16_bf16(f[2], eq[1], c0, 0, 0, 0); c1 = __builtin_amdgcn_mfma_f32_32x32x16_bf16(f[3], eq[1], c1, 0, 0, 0);
    };
    constexpr bool NEGM = true;
    f32x16 negm = f32x16{};
    auto decide = [&](f32x16& c0, f32x16& c1, bool first) -> bool {
        const float rm = rowmax32(c0, c1);
        if (first || __any(rm > THR)) {
            const float dl = first ? rm : fmaxf(rm, 0.f);
            mhat += dl;
#pragma unroll
            for (int r = 0; r < 16; ++r) { c0[r] -= dl; c1[r] -= dl; }
#pragma unroll
            for (int r = 0; r < 16; ++r) negm[r] = -mhat;
            if (!first) { const float f = __builtin_amdgcn_exp2f(-dl); l_reg *= f; if (hi == 0) wsf[r32] = f; return true; }
        }
        return false;
    };
    auto rescale_o = [&]() {
        asm volatile("s_waitcnt lgkmcnt(0)" ::: "memory");
#pragma unroll
        for (int r = 0; r < 16; ++r) { const float fr_ = wsf[crow(r, hi)]; o[0][r] *= fr_; o[1][r] *= fr_; }
    };
    auto expo = [&](f32x16& c0, f32x16& c1) {
#pragma unroll
        for (int r = 0; r < 16; ++r) { c0[r] = __builtin_amdgcn_exp2f(c0[r]); c1[r] = __builtin_amdgcn_exp2f(c1[r]); }
    };
    auto sumpack = [&](const f32x16& c0, const f32x16& c1) {
        float s4[4];
#pragma unroll
        for (int k = 0; k < 4; ++k) s4[k] = c0[k] + c1[k];
#pragma unroll
        for (int r = 4; r < 16; ++r) s4[r & 3] += c0[r] + c1[r];
        l_reg += (s4[0] + s4[1]) + (s4[2] + s4[3]);
#pragma unroll
        for (int j = 0; j < 4; ++j) { pw0[j] = cvtpk(c0[2 * j], c0[2 * j + 1]); pw1[j] = cvtpk(c0[8 + 2 * j], c0[9 + 2 * j]); pw2[j] = cvtpk(c1[2 * j], c1[2 * j + 1]); pw3[j] = cvtpk(c1[8 + 2 * j], c1[9 + 2 * j]); }
    };
    auto step = [&](f32x16& c0, f32x16& c1, f32x16& q0, f32x16& q1, int j) {
        wait_tile(j);
        bf16x8 gf[4];
        if (NA && j >= 4) gbias_load(gf, j);
        qkt<ND0>(c0, c1, shm + (j % NSLOT) * SLOT, qr, negm, r32, hi);
        if (NA && j >= 4) gbias_mma(c0, c1, gf);
        sumpack(q0, q1);
        const bool resc = decide(c0, c1, false);
        pv(o, vp0 + ((j - 1) % NSLOT) * SLOT, __builtin_bit_cast(bf16x8, pw0), __builtin_bit_cast(bf16x8, pw1), __builtin_bit_cast(bf16x8, pw2), __builtin_bit_cast(bf16x8, pw3));
        expo(c0, c1);
        if (resc) rescale_o();
    };
    wait_tile(0);
    qkt<ND0>(a0, a1, shm, qr, negm, r32, hi);
    (void)decide(a0, a1, true);
    expo(a0, a1);
    int j = 1;
#pragma unroll 1
    for (; j + 1 < NT; j += 2) { step(b0, b1, a0, a1, j); step(a0, a1, b0, b1, j + 1); }
    if (j < NT) { step(b0, b1, a0, a1, j); sumpack(b0, b1); } else sumpack(a0, a1);
    pv(o, vp0 + ((NT - 1) % NSLOT) * SLOT, __builtin_bit_cast(bf16x8, pw0), __builtin_bit_cast(bf16x8, pw1), __builtin_bit_cast(bf16x8, pw2), __builtin_bit_cast(bf16x8, pw3));
    { auto rr = __builtin_amdgcn_permlane32_swap(__float_as_uint(l_reg), __float_as_uint(l_reg), false, false); l_reg = __uint_as_float(rr[0]) + __uint_as_float(rr[1]); }
    if (hi == 0) wsf[32 + r32] = l_reg;
    asm volatile("s_waitcnt lgkmcnt(0)" ::: "memory");
    float rli[16];
#pragma unroll
    for (int r = 0; r < 16; ++r) rli[r] = __builtin_amdgcn_rcpf(wsf[32 + crow(r, hi)]);
    bf16_t* Ow = U.O + (size_t)(U.q0 + wid * 32) * U.opitch + U.ocol;
    { ALAS bf16_t* stg = (ALAS bf16_t*)(shm + LDS_OST) + wid * 2048;
#pragma unroll
        for (int r = 0; r < 16; ++r) { const int orow = crow(r, hi);
#pragma unroll
            for (int d0 = 0; d0 < 2; ++d0) stg[orow * 64 + d0 * 32 + r32] = f2bf(o[d0][r] * rli[r]); }
        asm volatile("s_waitcnt lgkmcnt(0)" ::: "memory");
#pragma unroll
        for (int i = 0; i < 4; ++i) { const int row = i * 8 + (lane >> 3), ch = lane & 7; const u32x4 v = *(const ALAS u32x4*)(stg + row * 64 + ch * 8); *(u32x4*)(Ow + (size_t)row * U.opitch + ch * 8) = v; } }
#ifdef ATT_STATIC_PRIO_NA
    __builtin_amdgcn_s_setprio(0);
#endif
    asm volatile("s_waitcnt vmcnt(0) lgkmcnt(0)\n\ts_barrier" ::: "memory");
}
}
#include <hip/hip_bf16.h>
namespace att64 {
using bf16=__hip_bfloat16;
using bf16x8=__attribute__((ext_vector_type(8)))short;
using s16x4=__attribute__((ext_vector_type(4)))short;
using f32x16=__attribute__((ext_vector_type(16)))float;
using u32x4=__attribute__((ext_vector_type(4)))unsigned;
constexpr int D=64;
constexpr int NW=8,QBLK=32,QB=QBLK*NW,KVBLK=64;

__device__ __forceinline__ int crow(int r,int hi){return (r&3)+8*(r>>2)+4*hi;}
#define SBAR() __builtin_amdgcn_sched_barrier(0)
__device__ __forceinline__ void cmask(f32x16&p0,f32x16&p1,int jb,int qrel,int hi){
  const float NEG=-INFINITY; int kb=64*jb+4*hi;
  #pragma unroll
  for(int r=0;r<16;++r){int kv=kb+(r&3)+8*(r>>2); if(kv>qrel)p0[r]=NEG; if(kv+32>qrel)p1[r]=NEG;}
}

constexpr int NSLOT=3, SLOTB=8192;
constexpr int LDS_K=0, LDS_V=NSLOT*SLOTB, LDS_WS=2*NSLOT*SLOTB, LDS_OST=LDS_WS+NW*64*4, LDS_BYTES=LDS_OST+NW*4096;
constexpr float C2=0.125f*1.4426950408889634f;
__device__ __forceinline__ void glds16(const void*gsrc,unsigned lds_dst){unsigned keep;
  asm volatile("s_mov_b32 %0, m0\n\ts_mov_b32 m0, %2\n\ts_nop 0\n\tglobal_load_lds_dwordx4 %1, off\n\ts_mov_b32 m0, %0":"=&s"(keep):"v"(gsrc),"s"(lds_dst):"memory");}
__device__ __forceinline__ float max3f(float a,float b,float c){float r;asm("v_max3_f32 %0, %1, %2, %3":"=v"(r):"v"(a),"v"(b),"v"(c));return r;}
__device__ __forceinline__ float max2f(float a,float b){float r;asm("v_max_f32_e32 %0, %1, %2":"=v"(r):"v"(a),"v"(b));return r;}
__device__ __forceinline__ float fadd_s(float a,float b){float r;asm("v_add_f32_e32 %0, %1, %2":"=v"(r):"v"(a),"v"(b));return r;}
__device__ __forceinline__ float fsub_s(float a,float b){float r;asm("v_sub_f32_e32 %0, %1, %2":"=v"(r):"v"(a),"v"(b));return r;}
typedef float f32x2_t __attribute__((ext_vector_type(2))); typedef __bf16 bf16x2_t __attribute__((ext_vector_type(2)));
__device__ __forceinline__ unsigned cvtpk_s(float lo,float hi){f32x2_t v={lo,hi};bf16x2_t b=__builtin_convertvector(v,bf16x2_t);return __builtin_bit_cast(unsigned,b);}
#define WAIT_BAR(N) asm volatile("s_waitcnt vmcnt(" #N ") lgkmcnt(0)\n\ts_barrier":::"memory")

__device__ __forceinline__ void qkt(f32x16&p0,f32x16&p1,const char*Kslot,const bf16x8*qr,const f32x16&negm,int r32,int hi){
  const char*kb=Kslot+hi*1024+r32*16;
  #pragma unroll
  for(int d0=0;d0<4;++d0){
    const bf16x8 b0=*reinterpret_cast<const bf16x8*>(kb+d0*2048);
    const bf16x8 b1=*reinterpret_cast<const bf16x8*>(kb+d0*2048+512);
    if(d0==0){p0=__builtin_amdgcn_mfma_f32_32x32x16_bf16(b0,qr[0],negm,0,0,0);p1=__builtin_amdgcn_mfma_f32_32x32x16_bf16(b1,qr[0],negm,0,0,0);}
    else{p0=__builtin_amdgcn_mfma_f32_32x32x16_bf16(b0,qr[d0],p0,0,0,0);p1=__builtin_amdgcn_mfma_f32_32x32x16_bf16(b1,qr[d0],p1,0,0,0);}}
}
typedef __attribute__((address_space(3))) const char* lds_cptr;
typedef short v4i16_t __attribute__((ext_vector_type(4)));
__device__ __forceinline__ void kload8(bf16x8*kf,lds_cptr kp){
  kf[0]=*(const __attribute__((address_space(3))) bf16x8*)(kp);      kf[1]=*(const __attribute__((address_space(3))) bf16x8*)(kp+512);
  kf[2]=*(const __attribute__((address_space(3))) bf16x8*)(kp+2048); kf[3]=*(const __attribute__((address_space(3))) bf16x8*)(kp+2560);
  kf[4]=*(const __attribute__((address_space(3))) bf16x8*)(kp+4096); kf[5]=*(const __attribute__((address_space(3))) bf16x8*)(kp+4608);
  kf[6]=*(const __attribute__((address_space(3))) bf16x8*)(kp+6144); kf[7]=*(const __attribute__((address_space(3))) bf16x8*)(kp+6656);
}
__device__ __forceinline__ void kload2(bf16x8*kf,lds_cptr kp,int j){ kf[2*j]=*(const __attribute__((address_space(3))) bf16x8*)(kp+j*2048); kf[2*j+1]=*(const __attribute__((address_space(3))) bf16x8*)(kp+j*2048+512); }
__device__ __forceinline__ s16x4 vtr(lds_cptr p){ return __builtin_bit_cast(s16x4,__builtin_amdgcn_ds_read_tr16_b64_v4i16((__attribute__((address_space(3))) v4i16_t*)p)); }
__device__ __forceinline__ float rowmax(const f32x16&p0,const f32x16&p1){
  float a=max3f(p0[0],p0[1],p1[0]),b=max3f(p0[2],p0[3],p1[1]);a=max3f(a,p1[2],p1[3]);
  #pragma unroll
  for(int r=4;r<16;r+=4){a=max3f(a,p0[r],p0[r+1]);b=max3f(b,p0[r+2],p0[r+3]);a=max3f(a,p1[r],p1[r+1]);b=max3f(b,p1[r+2],p1[r+3]);}
  const float m=max2f(a,b);
  auto rr=__builtin_amdgcn_permlane32_swap(__float_as_uint(m),__float_as_uint(m),false,false);
  return max2f(__uint_as_float(rr[0]),__uint_as_float(rr[1]));
}
__device__ __forceinline__ void pv(f32x16*o,int vb,bf16x8 pa0,bf16x8 pa1,bf16x8 pa2,bf16x8 pa3){
  #pragma unroll
  for(int d0=0;d0<2;++d0){s16x4 lo[4],hi[4];
    #pragma unroll
    for(int ks=0;ks<4;++ks){
      asm volatile("ds_read_b64_tr_b16 %0,%1 offset:%c2":"=&v"(lo[ks]):"v"(vb),"i"(d0*4096+ks*1024):"memory");
      asm volatile("ds_read_b64_tr_b16 %0,%1 offset:%c2":"=&v"(hi[ks]):"v"(vb),"i"(d0*4096+ks*1024+512):"memory");}
    asm volatile("s_waitcnt lgkmcnt(0)":::"memory");SBAR();
    #define PK(k) (bf16x8){lo[k][0],lo[k][1],lo[k][2],lo[k][3],hi[k][0],hi[k][1],hi[k][2],hi[k][3]}
    o[d0]=__builtin_amdgcn_mfma_f32_32x32x16_bf16(pa0,PK(0),o[d0],0,0,0);
    o[d0]=__builtin_amdgcn_mfma_f32_32x32x16_bf16(pa1,PK(1),o[d0],0,0,0);
    o[d0]=__builtin_amdgcn_mfma_f32_32x32x16_bf16(pa2,PK(2),o[d0],0,0,0);
    o[d0]=__builtin_amdgcn_mfma_f32_32x32x16_bf16(pa3,PK(3),o[d0],0,0,0);
    #undef PK
  }
}

#ifndef ATTN_STORE16
#define ATTN_STORE16(p,v) (*(u32x4*)(p)=(v))
#endif
template<int THRL> __device__ __forceinline__ void attn_unit(long q0,const bf16*Q,int qp,int qcol,const bf16*__restrict__ K,int kp,int kcol,const bf16*__restrict__ V,int vp,int vcol,long kv0,int NT,bf16*O,int op,int ocol,char*shm){
  int tid_=threadIdx.x; asm volatile("":"+v"(tid_));
  const int tid=tid_,lane=tid&63,r32=lane&31,hi=lane>>5; const int wid=__builtin_amdgcn_readfirstlane(tid>>6);
#ifdef ATT_STATIC_PRIO
  if(wid>=4)__builtin_amdgcn_s_setprio(1);
#endif
  const bf16*Qw=Q+(q0+wid*QBLK)*qp+qcol;
  const bf16*Kh=K+kv0*kp+kcol,*Vh=V+kv0*vp+vcol;
  const unsigned lds0=(unsigned)(uintptr_t)shm;
  float*wsf=(float*)(shm+LDS_WS)+wid*64;
  const bf16*ksrc=Kh+(long)lane*kp+wid*8;
  const bf16*vsrc=Vh+(long)(16*(wid&3)+(lane>>2))*vp+(wid>>2)*32+(lane&3)*8;
  const unsigned kdst=lds0+LDS_K+wid*1024, vdst=lds0+LDS_V+wid*1024;
  #define DMA_K(t,slot) glds16(ksrc+(long)(t)*KVBLK*kp,(unsigned)__builtin_amdgcn_readfirstlane(kdst+(slot)))
  #define DMA_V(t,slot) glds16(vsrc+(long)(t)*KVBLK*vp,(unsigned)__builtin_amdgcn_readfirstlane(vdst+(slot)))
  const int vb0=(int)(lds0+LDS_V)+((lane>>4)&1)*32+(lane&3)*8+(4*hi+((lane&15)>>2))*64;
  const char*Kbase=shm+LDS_K; bf16x8 kf[8];
  const lds_cptr shm3=(lds_cptr)shm; const lds_cptr kp0=shm3+LDS_K+hi*1024+r32*16; const lds_cptr vp0=shm3+LDS_V+((lane>>4)&1)*32+(lane&3)*8+(4*hi+((lane&15)>>2))*64;
  DMA_K(0,0);DMA_V(0,0);DMA_K(1,SLOTB);
  bf16x8 qr[4];
  #pragma unroll
  for(int d0=0;d0<4;++d0)qr[d0]=*reinterpret_cast<const bf16x8*>(&Qw[(long)r32*qp+d0*16+hi*8]);
  float mhat=0.f,l_reg=0.f;f32x16 o[2];o[0]=f32x16{};o[1]=f32x16{};f32x16 negm=f32x16{};asm volatile("":"+v"(negm));
  #define CMASK(P0,P1,t) do{}while(0)
  bool resc=false;
  #define START(P0,P1) do{ const float rm=rowmax(P0,P1); resc=false; \
    { const float dl=rm; mhat=fadd_s(mhat,dl); \
      _Pragma("unroll") for(int r=0;r<16;++r){P0[r]=fsub_s(P0[r],dl);P1[r]=fsub_s(P1[r],dl);} \
      _Pragma("unroll") for(int r=0;r<16;++r)negm[r]=-mhat; asm volatile("":"+v"(negm)); } \
    _Pragma("unroll") for(int r=0;r<16;++r)P0[r]=__builtin_amdgcn_exp2f(P0[r]); }while(0)
  #define RESC() do{ if(resc){ asm volatile("s_waitcnt lgkmcnt(0)":::"memory"); \
      _Pragma("unroll") for(int d_=0;d_<2;++d_) _Pragma("unroll") for(int r=0;r<16;++r)o[d_][r]*=wsf[crow(r,hi)]; } }while(0)
  f32x16 pA0,pA1,pB0,pB1;
  int sl_prev=0,sl_cur=0,sl_next=SLOTB;
  #define ROT() do{sl_prev=sl_cur;sl_cur=sl_next;sl_next=(sl_next==(NSLOT-1)*SLOTB)?0:sl_next+SLOTB;}while(0)
  DMA_K(2,2*SLOTB);
  WAIT_BAR(3);
  qkt(pA0,pA1,Kbase,qr,negm,r32,hi);asm volatile("s_nop 15\n\ts_nop 7":"+v"(pA0),"+v"(pA1));CMASK(pA0,pA1,0);
  START(pA0,pA1);
  _Pragma("unroll") for(int r=0;r<16;++r)pA1[r]=__builtin_amdgcn_exp2f(pA1[r]);
  WAIT_BAR(0);
  DMA_K(3,0);DMA_V(1,SLOTB);
  ROT();
  kload8(kf,kp0+sl_cur);
  WAIT_BAR(2);
  s16x4 vlo[8],vhi[8]; u32x4 pw0,pw1,pw2,pw3;
  #define PKW(P,B) cvtpk_s(P[B],P[B+1])
  #define PAF(k) __builtin_bit_cast(bf16x8,pw##k)
  #define VFR(i) (bf16x8){vlo[i][0],vlo[i][1],vlo[i][2],vlo[i][3],vhi[i][0],vhi[i][1],vhi[i][2],vhi[i][3]}
  #define PIN(x) asm volatile("":"+v"(x))
  #define MX3(a,b,c) __builtin_fmaxf(__builtin_fmaxf((a),(b)),(c))
  #define GAPA(MF,A0,A1,A2,A3,W0,W1,PW) do{ MF; sacc+=A0; sacc+=A1; sacc+=A2; sacc+=A3; PIN(sacc); W0; W1; PIN(PW); SBAR(); }while(0)
  #define EX(v) __builtin_amdgcn_exp2f(v)
  #define GAPB(MF,X,B) do{ MF; X[B]=EX(X[B]); X[B+1]=EX(X[B+1]); X[B+2]=EX(X[B+2]); X[B+3]=EX(X[B+3]); PIN(X); SBAR(); }while(0)
  #define VRD(i) do{ vlo[i]=vtr(vp_+(((i)>>2)*4096+((i)&3)*1024)); vhi[i]=vtr(vp_+(((i)>>2)*4096+((i)&3)*1024+512)); }while(0)
  #define KRD(G,j) do{ if(G){ kload2(kf,kp0+sl_next,j); SBAR(); } }while(0)
  #define STEP(C0,C1,P0,P1,t,GK,GV,GL) do{ SBAR(); \
    const lds_cptr vp_=vp0+sl_prev; \
    VRD(0); SBAR(); float sacc=(P0[0]+P0[1]); \
    GAPA(C0=__builtin_amdgcn_mfma_f32_32x32x16_bf16(kf[0],qr[0],negm,0,0,0), P0[2],P0[3],P0[4],P0[5],     pw0[0]=PKW(P0,0), pw0[1]=PKW(P0,2), pw0); \
    VRD(4); SBAR(); GAPA(C1=__builtin_amdgcn_mfma_f32_32x32x16_bf16(kf[1],qr[0],negm,0,0,0), P0[6],P0[7],P0[8],P0[9],     pw0[2]=PKW(P0,4), pw0[3]=PKW(P0,6), pw0); \
    VRD(1); SBAR(); GAPA(C0=__builtin_amdgcn_mfma_f32_32x32x16_bf16(kf[2],qr[1],C0,0,0,0),   P0[10],P0[11],P0[12],P0[13], pw1[0]=PKW(P0,8), pw1[1]=PKW(P0,10), pw1); \
    VRD(5); SBAR(); GAPA(C1=__builtin_amdgcn_mfma_f32_32x32x16_bf16(kf[3],qr[1],C1,0,0,0),   P0[14],P0[15],P1[0],P1[1],   pw1[2]=PKW(P0,12),pw1[3]=PKW(P0,14), pw1); \
    VRD(2); SBAR(); GAPA(C0=__builtin_amdgcn_mfma_f32_32x32x16_bf16(kf[4],qr[2],C0,0,0,0),   P1[2],P1[3],P1[4],P1[5],     pw2[0]=PKW(P1,0), pw2[1]=PKW(P1,2), pw2); \
    VRD(6); SBAR(); GAPA(C1=__builtin_amdgcn_mfma_f32_32x32x16_bf16(kf[5],qr[2],C1,0,0,0),   P1[6],P1[7],P1[8],P1[9],     pw2[2]=PKW(P1,4), pw2[3]=PKW(P1,6), pw2); \
    VRD(3); SBAR(); GAPA(C0=__builtin_amdgcn_mfma_f32_32x32x16_bf16(kf[6],qr[3],C0,0,0,0),   P1[10],P1[11],P1[12],P1[13], pw3[0]=PKW(P1,8), pw3[1]=PKW(P1,10), pw3); \
    VRD(7); SBAR(); GAPA(C1=__builtin_amdgcn_mfma_f32_32x32x16_bf16(kf[7],qr[3],C1,0,0,0),   P1[14],P1[15],0.f,0.f,       pw3[2]=PKW(P1,12),pw3[3]=PKW(P1,14), pw3); \
    l_reg+=sacc; \
    if(GK){DMA_K((t)+3,sl_cur);} if(GV){DMA_V((t)+1,sl_next);} \
    CMASK(C0,C1,t); \
    { float a=MX3(C0[0],C0[1],C1[0]),b=MX3(C0[2],C0[3],C1[1]); a=MX3(a,C1[2],C1[3]); \
      _Pragma("unroll") for(int r=4;r<16;r+=4){a=MX3(a,C0[r],C0[r+1]);b=MX3(b,C0[r+2],C0[r+3]);a=MX3(a,C1[r],C1[r+1]);b=MX3(b,C1[r+2],C1[r+3]);} \
      float rm=__builtin_fmaxf(a,b); { auto rr=__builtin_amdgcn_permlane32_swap(__float_as_uint(rm),__float_as_uint(rm),false,false); rm=__builtin_fmaxf(__uint_as_float(rr[0]),__uint_as_float(rr[1])); } \
      resc=false; \
      if(__builtin_expect(__any(rm>(float)THRL),0)){ const float dl=__builtin_fmaxf(rm,0.f); mhat+=dl; \
        _Pragma("unroll") for(int r=0;r<16;++r){C0[r]-=dl;C1[r]-=dl;} \
        _Pragma("unroll") for(int r=0;r<16;++r)negm[r]=-mhat; asm volatile("":"+v"(negm)); \
        const float f=__builtin_amdgcn_exp2f(-dl); l_reg*=f; if(hi==0)wsf[r32]=f; resc=true; } } \
    SBAR(); \
    GAPB(o[0]=__builtin_amdgcn_mfma_f32_32x32x16_bf16(PAF(0),VFR(0),o[0],0,0,0), C0,0); \
    GAPB(o[1]=__builtin_amdgcn_mfma_f32_32x32x16_bf16(PAF(0),VFR(4),o[1],0,0,0), C0,4); \
    KRD(GL,0); GAPB(o[0]=__builtin_amdgcn_mfma_f32_32x32x16_bf16(PAF(1),VFR(1),o[0],0,0,0), C0,8); \
    KRD(GL,1); GAPB(o[1]=__builtin_amdgcn_mfma_f32_32x32x16_bf16(PAF(1),VFR(5),o[1],0,0,0), C0,12); \
    KRD(GL,2); GAPB(o[0]=__builtin_amdgcn_mfma_f32_32x32x16_bf16(PAF(2),VFR(2),o[0],0,0,0), C1,0); \
    KRD(GL,3); GAPB(o[1]=__builtin_amdgcn_mfma_f32_32x32x16_bf16(PAF(2),VFR(6),o[1],0,0,0), C1,4); \
    GAPB(o[0]=__builtin_amdgcn_mfma_f32_32x32x16_bf16(PAF(3),VFR(3),o[0],0,0,0), C1,8); \
    GAPB(o[1]=__builtin_amdgcn_mfma_f32_32x32x16_bf16(PAF(3),VFR(7),o[1],0,0,0), C1,12); \
    }while(0)
  int t=1;
  #undef CMASK
  #define CMASK(P0,P1,t) do{}while(0)
  for(;t+5<NT;t+=2){
    STEP(pB0,pB1,pA0,pA1,t,true,true,true);     WAIT_BAR(2); RESC(); ROT();
    STEP(pA0,pA1,pB0,pB1,t+1,true,true,true);   WAIT_BAR(2); RESC(); ROT();
  }
  #undef CMASK
  #define CMASK(P0,P1,t) do{}while(0)
  #define ENDW(tt) do{ if((tt)+3<NT){WAIT_BAR(2);} else if((tt)+2<NT){WAIT_BAR(1);} else {WAIT_BAR(0);} }while(0)
  for(;t+1<NT;t+=2){
    STEP(pB0,pB1,pA0,pA1,t,(t+3<NT),(t+1<NT),(t+1<NT));       ENDW(t);   RESC(); ROT();
    STEP(pA0,pA1,pB0,pB1,t+1,(t+4<NT),(t+2<NT),(t+2<NT));     ENDW(t+1); RESC(); ROT();
  }
  STEP(pB0,pB1,pA0,pA1,NT-1,false,false,false); RESC();
  { float sacc=pB0[0]+pB0[1]; _Pragma("unroll") for(int r=2;r<16;++r)sacc+=pB0[r]; _Pragma("unroll") for(int r=0;r<16;++r)sacc+=pB1[r]; l_reg+=sacc;
    pw0=(u32x4){PKW(pB0,0),PKW(pB0,2),PKW(pB0,4),PKW(pB0,6)};pw1=(u32x4){PKW(pB0,8),PKW(pB0,10),PKW(pB0,12),PKW(pB0,14)};pw2=(u32x4){PKW(pB1,0),PKW(pB1,2),PKW(pB1,4),PKW(pB1,6)};pw3=(u32x4){PKW(pB1,8),PKW(pB1,10),PKW(pB1,12),PKW(pB1,14)};
    SBAR(); pv(o,vb0+sl_cur,PAF(0),PAF(1),PAF(2),PAF(3)); }
  #undef PKW
  #undef PAF
  #undef VFR
  #undef PIN
  #undef MX3
  #undef GAPA
  #undef GAPB
  #undef EX
  #undef VRD
  #undef KRD
  #undef STEP
  #undef ENDW
  {auto rr=__builtin_amdgcn_permlane32_swap(__float_as_uint(l_reg),__float_as_uint(l_reg),false,false);l_reg=__uint_as_float(rr[0])+__uint_as_float(rr[1]);}
  if(hi==0)wsf[32+r32]=l_reg;asm volatile("s_waitcnt lgkmcnt(0)":::"memory");
  float rli[16];
  #pragma unroll
  for(int r=0;r<16;++r)rli[r]=__builtin_amdgcn_rcpf(wsf[32+crow(r,hi)]);
  bf16*Ow=O+(q0+wid*QBLK)*op+ocol;
  { bf16*stg=(bf16*)(shm+LDS_OST)+wid*2048;
    #pragma unroll
    for(int r=0;r<16;++r){const int orow=crow(r,hi);
      #pragma unroll
      for(int d0=0;d0<2;++d0)stg[orow*64+d0*32+r32]=__float2bfloat16(o[d0][r]*rli[r]);}
    asm volatile("s_waitcnt lgkmcnt(0)":::"memory");
    #pragma unroll
    for(int i=0;i<4;++i){const int row=i*8+(lane>>3),ch=lane&7; const u32x4 v=*(const u32x4*)(stg+row*64+ch*8); ATTN_STORE16(Ow+(long)row*op+ch*8,v);} }
#ifdef ATT_STATIC_PRIO
  __builtin_amdgcn_s_setprio(0);
#endif
  asm volatile("s_waitcnt lgkmcnt(0)\n\ts_barrier":::"memory");
  #undef DMA_K
  #undef DMA_V
  #undef CMASK
  #undef START
  #undef RESC
  #undef ROT
}
constexpr int ATTN_LDS_BYTES=LDS_BYTES;

#undef SBAR
#undef WAIT_BAR
}
namespace att96 {
using bf16=__hip_bfloat16;
using bf16x8=__attribute__((ext_vector_type(8)))short;
using s16x4=__attribute__((ext_vector_type(4)))short;
using f32x16=__attribute__((ext_vector_type(16)))float;
using u32x4=__attribute__((ext_vector_type(4)))unsigned;
constexpr int D=64;
constexpr int NW=8,QBLK=32,QB=QBLK*NW,KVBLK=64;

__device__ __forceinline__ int crow(int r,int hi){return (r&3)+8*(r>>2)+4*hi;}
#define SBAR() __builtin_amdgcn_sched_barrier(0)
__device__ __forceinline__ void cmask(f32x16&p0,f32x16&p1,int jb,int qrel,int hi){
  const float NEG=-INFINITY; int kb=64*jb+4*hi;
  #pragma unroll
  for(int r=0;r<16;++r){int kv=kb+(r&3)+8*(r>>2); if(kv>qrel)p0[r]=NEG; if(kv+32>qrel)p1[r]=NEG;}
}

constexpr int NSLOT=3, SLOTB=8192;
constexpr int KSLOTB=12288;
constexpr int LDS_K=0, LDS_V=NSLOT*KSLOTB, LDS_WS=LDS_V+NSLOT*SLOTB, LDS_OST=LDS_WS+NW*64*4, LDS_BYTES=LDS_OST+NW*4096;
constexpr float C2=0.125f*1.4426950408889634f;
__device__ __forceinline__ void glds16(const void*gsrc,unsigned lds_dst){unsigned keep;
  asm volatile("s_mov_b32 %0, m0\n\ts_mov_b32 m0, %2\n\ts_nop 0\n\tglobal_load_lds_dwordx4 %1, off\n\ts_mov_b32 m0, %0":"=&s"(keep):"v"(gsrc),"s"(lds_dst):"memory");}
__device__ __forceinline__ float max3f(float a,float b,float c){float r;asm("v_max3_f32 %0, %1, %2, %3":"=v"(r):"v"(a),"v"(b),"v"(c));return r;}
__device__ __forceinline__ float max2f(float a,float b){float r;asm("v_max_f32_e32 %0, %1, %2":"=v"(r):"v"(a),"v"(b));return r;}
__device__ __forceinline__ float fadd_s(float a,float b){float r;asm("v_add_f32_e32 %0, %1, %2":"=v"(r):"v"(a),"v"(b));return r;}
__device__ __forceinline__ float fsub_s(float a,float b){float r;asm("v_sub_f32_e32 %0, %1, %2":"=v"(r):"v"(a),"v"(b));return r;}
typedef float f32x2_t __attribute__((ext_vector_type(2))); typedef __bf16 bf16x2_t __attribute__((ext_vector_type(2)));
__device__ __forceinline__ unsigned cvtpk_s(float lo,float hi){f32x2_t v={lo,hi};bf16x2_t b=__builtin_convertvector(v,bf16x2_t);return __builtin_bit_cast(unsigned,b);}
#define KOFF(sl) ((sl)+((sl)>>1))
#define WAIT_BAR(N) asm volatile("s_waitcnt vmcnt(" #N ") lgkmcnt(0)\n\ts_barrier":::"memory")

__device__ __forceinline__ void qkt(f32x16&p0,f32x16&p1,const char*Kslot,const bf16x8*qr,const f32x16&negm,int r32,int hi){
  const char*kb=Kslot+hi*1024+r32*16;
  #pragma unroll
  for(int d0=0;d0<6;++d0){
    const bf16x8 b0=*reinterpret_cast<const bf16x8*>(kb+d0*2048);
    const bf16x8 b1=*reinterpret_cast<const bf16x8*>(kb+d0*2048+512);
    if(d0==0){p0=__builtin_amdgcn_mfma_f32_32x32x16_bf16(b0,qr[0],negm,0,0,0);p1=__builtin_amdgcn_mfma_f32_32x32x16_bf16(b1,qr[0],negm,0,0,0);}
    else{p0=__builtin_amdgcn_mfma_f32_32x32x16_bf16(b0,qr[d0],p0,0,0,0);p1=__builtin_amdgcn_mfma_f32_32x32x16_bf16(b1,qr[d0],p1,0,0,0);}}
}
typedef __attribute__((address_space(3))) const char* lds_cptr;
typedef short v4i16_t __attribute__((ext_vector_type(4)));
__device__ __forceinline__ void kload12(bf16x8*kf,lds_cptr kp){
  kf[0]=*(const __attribute__((address_space(3))) bf16x8*)(kp);      kf[1]=*(const __attribute__((address_space(3))) bf16x8*)(kp+512);
  kf[2]=*(const __attribute__((address_space(3))) bf16x8*)(kp+2048); kf[3]=*(const __attribute__((address_space(3))) bf16x8*)(kp+2560);
  kf[4]=*(const __attribute__((address_space(3))) bf16x8*)(kp+4096); kf[5]=*(const __attribute__((address_space(3))) bf16x8*)(kp+4608);
  kf[6]=*(const __attribute__((address_space(3))) bf16x8*)(kp+6144); kf[7]=*(const __attribute__((address_space(3))) bf16x8*)(kp+6656);
  kf[8]=*(const __attribute__((address_space(3))) bf16x8*)(kp+8192); kf[9]=*(const __attribute__((address_space(3))) bf16x8*)(kp+8704);
  kf[10]=*(const __attribute__((address_space(3))) bf16x8*)(kp+10240); kf[11]=*(const __attribute__((address_space(3))) bf16x8*)(kp+10752);
}
__device__ __forceinline__ void kload2(bf16x8*kf,lds_cptr kp,int j){ kf[2*j]=*(const __attribute__((address_space(3))) bf16x8*)(kp+j*2048); kf[2*j+1]=*(const __attribute__((address_space(3))) bf16x8*)(kp+j*2048+512); }
__device__ __forceinline__ s16x4 vtr(lds_cptr p){ return __builtin_bit_cast(s16x4,__builtin_amdgcn_ds_read_tr16_b64_v4i16((__attribute__((address_space(3))) v4i16_t*)p)); }
__device__ __forceinline__ float rowmax(const f32x16&p0,const f32x16&p1){
  float a=max3f(p0[0],p0[1],p1[0]),b=max3f(p0[2],p0[3],p1[1]);a=max3f(a,p1[2],p1[3]);
  #pragma unroll
  for(int r=4;r<16;r+=4){a=max3f(a,p0[r],p0[r+1]);b=max3f(b,p0[r+2],p0[r+3]);a=max3f(a,p1[r],p1[r+1]);b=max3f(b,p1[r+2],p1[r+3]);}
  const float m=max2f(a,b);
  auto rr=__builtin_amdgcn_permlane32_swap(__float_as_uint(m),__float_as_uint(m),false,false);
  return max2f(__uint_as_float(rr[0]),__uint_as_float(rr[1]));
}
__device__ __forceinline__ void pv(f32x16*o,int vb,bf16x8 pa0,bf16x8 pa1,bf16x8 pa2,bf16x8 pa3){
  #pragma unroll
  for(int d0=0;d0<2;++d0){s16x4 lo[4],hi[4];
    #pragma unroll
    for(int ks=0;ks<4;++ks){
      asm volatile("ds_read_b64_tr_b16 %0,%1 offset:%c2":"=&v"(lo[ks]):"v"(vb),"i"(d0*4096+ks*1024):"memory");
      asm volatile("ds_read_b64_tr_b16 %0,%1 offset:%c2":"=&v"(hi[ks]):"v"(vb),"i"(d0*4096+ks*1024+512):"memory");}
    asm volatile("s_waitcnt lgkmcnt(0)":::"memory");SBAR();
    #define PK(k) (bf16x8){lo[k][0],lo[k][1],lo[k][2],lo[k][3],hi[k][0],hi[k][1],hi[k][2],hi[k][3]}
    o[d0]=__builtin_amdgcn_mfma_f32_32x32x16_bf16(pa0,PK(0),o[d0],0,0,0);
    o[d0]=__builtin_amdgcn_mfma_f32_32x32x16_bf16(pa1,PK(1),o[d0],0,0,0);
    o[d0]=__builtin_amdgcn_mfma_f32_32x32x16_bf16(pa2,PK(2),o[d0],0,0,0);
    o[d0]=__builtin_amdgcn_mfma_f32_32x32x16_bf16(pa3,PK(3),o[d0],0,0,0);
    #undef PK
  }
}

#ifndef ATTN_STORE16
#define ATTN_STORE16(p,v) (*(u32x4*)(p)=(v))
#endif
template<int THRL> __device__ __forceinline__ void attn_unit(long q0,const bf16*Q,int qp,int qcol,const bf16*__restrict__ K,int kp,int kcol,const bf16*__restrict__ V,int vp,int vcol,long kv0,int NT,bf16*O,int op,int ocol,char*shm,const float*qgain,const float*T16){
  int tid_=threadIdx.x; asm volatile("":"+v"(tid_));
  const int tid=tid_,lane=tid&63,r32=lane&31,hi=lane>>5; const int wid=__builtin_amdgcn_readfirstlane(tid>>6);
#ifdef ATT_STATIC_PRIO
  if(wid>=4)__builtin_amdgcn_s_setprio(1);
#endif
  const bf16*Qw=Q+(q0+wid*QBLK)*qp+qcol;
  const bf16*Kh=K+kv0*kp+kcol,*Vh=V+kv0*vp+vcol;
  const unsigned lds0=(unsigned)(uintptr_t)shm;
  float*wsf=(float*)(shm+LDS_WS)+wid*64;
  const bf16*ksrc=Kh+(long)lane*kp+wid*8;
  const bf16*vsrc=Vh+(long)(16*(wid&3)+(lane>>2))*vp+(wid>>2)*32+(lane&3)*8;
  const unsigned kdst=lds0+LDS_K+wid*1024, vdst=lds0+LDS_V+wid*1024, kdst2=lds0+LDS_K+(8+wid)*1024;
  const bf16*ksrc2=Kh+(long)lane*kp+64+wid*8;
  const bool big=wid<4;
  #define DMA_K(t,slot) do{ glds16(ksrc+(long)(t)*KVBLK*kp,(unsigned)__builtin_amdgcn_readfirstlane(kdst+KOFF(slot))); if(big) glds16(ksrc2+(long)(t)*KVBLK*kp,(unsigned)__builtin_amdgcn_readfirstlane(kdst2+KOFF(slot))); }while(0)
  #define WAITKV() do{ if(big){WAIT_BAR(3);} else {WAIT_BAR(2);} }while(0)
  #define DMA_V(t,slot) glds16(vsrc+(long)(t)*KVBLK*vp,(unsigned)__builtin_amdgcn_readfirstlane(vdst+(slot)))
  const int vb0=(int)(lds0+LDS_V)+((lane>>4)&1)*32+(lane&3)*8+(4*hi+((lane&15)>>2))*64;
  const char*Kbase=shm+LDS_K; bf16x8 kf[12];
  const lds_cptr shm3=(lds_cptr)shm; const lds_cptr kp0=shm3+LDS_K+hi*1024+r32*16; const lds_cptr vp0=shm3+LDS_V+((lane>>4)&1)*32+(lane&3)*8+(4*hi+((lane&15)>>2))*64;
  DMA_K(0,0);DMA_V(0,0);DMA_K(1,SLOTB);
  bf16x8 qr[6];
  #pragma unroll
  for(int d0=0;d0<6;++d0)qr[d0]=*reinterpret_cast<const bf16x8*>(&Qw[(long)r32*qp+d0*16+hi*8]);
  {
    float f[6][8]; float ss=0.f;
    #pragma unroll
    for(int d0=0;d0<6;++d0)
      #pragma unroll
      for(int j=0;j<8;++j){ f[d0][j]=__uint_as_float(((unsigned)(unsigned short)qr[d0][j])<<16); ss+=f[d0][j]*f[d0][j]; }
    ss+=__shfl_xor(ss,32);
    const float rn=rsqrtf(ss*(1.f/96.f)+EPS)*C2_96;
    #pragma unroll
    for(int d0=0;d0<6;++d0)
      #pragma unroll
      for(int j=0;j<8;++j) f[d0][j]=f[d0][j]*rn*qgain[d0*16+hi*8+j];
    const int tq=(int)((q0+wid*QBLK+r32)%S); const int grow=tq/GW,gcol=tq%GW;
    #pragma unroll
    for(int part=0;part<2;++part){ const int pos=part?gcol:grow;
      #pragma unroll
      for(int j=0;j<8;++j){ const float cs=T16[pos*8+j],sn=T16[512+pos*8+j];
        const float mine=f[4+part][j],other=__shfl_xor(mine,32);
        f[4+part][j]=hi==0?(mine*cs-other*sn):(other*sn+mine*cs); } }
    #pragma unroll
    for(int d0=0;d0<6;++d0)
      #pragma unroll
      for(int j=0;j<4;++j){ const unsigned w=cvtpk_s(f[d0][2*j],f[d0][2*j+1]); qr[d0][2*j]=(short)(w&0xffff); qr[d0][2*j+1]=(short)(w>>16); }
  }
  float mhat=0.f,l_reg=0.f;f32x16 o[2];o[0]=f32x16{};o[1]=f32x16{};f32x16 negm=f32x16{};asm volatile("":"+v"(negm));
  #define CMASK(P0,P1,t) do{}while(0)
  bool resc=false;
  #define START(P0,P1) do{ const float rm=rowmax(P0,P1); resc=false; \
    { const float dl=rm; mhat=fadd_s(mhat,dl); \
      _Pragma("unroll") for(int r=0;r<16;++r){P0[r]=fsub_s(P0[r],dl);P1[r]=fsub_s(P1[r],dl);} \
      _Pragma("unroll") for(int r=0;r<16;++r)negm[r]=-mhat; asm volatile("":"+v"(negm)); } \
    _Pragma("unroll") for(int r=0;r<16;++r)P0[r]=__builtin_amdgcn_exp2f(P0[r]); }while(0)
  #define RESC() do{ if(resc){ asm volatile("s_waitcnt lgkmcnt(0)":::"memory"); \
      _Pragma("unroll") for(int d_=0;d_<2;++d_) _Pragma("unroll") for(int r=0;r<16;++r)o[d_][r]*=wsf[crow(r,hi)]; } }while(0)
  f32x16 pA0,pA1,pB0,pB1;
  int sl_prev=0,sl_cur=0,sl_next=SLOTB;
  #define ROT() do{sl_prev=sl_cur;sl_cur=sl_next;sl_next=(sl_next==(NSLOT-1)*SLOTB)?0:sl_next+SLOTB;}while(0)
  DMA_K(2,2*SLOTB);
  if(big){WAIT_BAR(5);}else{WAIT_BAR(3);}
  qkt(pA0,pA1,Kbase,qr,negm,r32,hi);asm volatile("s_nop 15\n\ts_nop 7":"+v"(pA0),"+v"(pA1));CMASK(pA0,pA1,0);
  START(pA0,pA1);
  _Pragma("unroll") for(int r=0;r<16;++r)pA1[r]=__builtin_amdgcn_exp2f(pA1[r]);
  WAIT_BAR(0);
  DMA_K(3,0);DMA_V(1,SLOTB);
  ROT();
  kload12(kf,kp0+KOFF(sl_cur));
  WAITKV();
  s16x4 vlo[8],vhi[8]; u32x4 pw0,pw1,pw2,pw3;
  #define PKW(P,B) cvtpk_s(P[B],P[B+1])
  #define PAF(k) __builtin_bit_cast(bf16x8,pw##k)
  #define VFR(i) (bf16x8){vlo[i][0],vlo[i][1],vlo[i][2],vlo[i][3],vhi[i][0],vhi[i][1],vhi[i][2],vhi[i][3]}
  #define PIN(x) asm volatile("":"+v"(x))
  #define MX3(a,b,c) __builtin_fmaxf(__builtin_fmaxf((a),(b)),(c))
  #define GAPA(MF,A0,A1,A2,A3,W0,W1,PW) do{ MF; sacc+=A0; sacc+=A1; sacc+=A2; sacc+=A3; PIN(sacc); W0; W1; PIN(PW); SBAR(); }while(0)
  #define EX(v) __builtin_amdgcn_exp2f(v)
  #define GAPB(MF,X,B) do{ MF; X[B]=EX(X[B]); X[B+1]=EX(X[B+1]); X[B+2]=EX(X[B+2]); X[B+3]=EX(X[B+3]); PIN(X); SBAR(); }while(0)
  #define VRD(i) do{ vlo[i]=vtr(vp_+(((i)>>2)*4096+((i)&3)*1024)); vhi[i]=vtr(vp_+(((i)>>2)*4096+((i)&3)*1024+512)); }while(0)
  #define KRD(G,j) do{ if(G){ kload2(kf,kp0+KOFF(sl_next),j); SBAR(); } }while(0)
  #define STEP(C0,C1,P0,P1,t,GK,GV,GL) do{ SBAR(); \
    const lds_cptr vp_=vp0+sl_prev; \
    VRD(0); SBAR(); float sacc=(P0[0]+P0[1]); \
    GAPA(C0=__builtin_amdgcn_mfma_f32_32x32x16_bf16(kf[0],qr[0],negm,0,0,0), P0[2],P0[3],P0[4],P0[5],     pw0[0]=PKW(P0,0), pw0[1]=PKW(P0,2), pw0); \
    VRD(4); SBAR(); GAPA(C1=__builtin_amdgcn_mfma_f32_32x32x16_bf16(kf[1],qr[0],negm,0,0,0), P0[6],P0[7],P0[8],P0[9],     pw0[2]=PKW(P0,4), pw0[3]=PKW(P0,6), pw0); \
    VRD(1); SBAR(); GAPA(C0=__builtin_amdgcn_mfma_f32_32x32x16_bf16(kf[2],qr[1],C0,0,0,0),   P0[10],P0[11],P0[12],P0[13], pw1[0]=PKW(P0,8), pw1[1]=PKW(P0,10), pw1); \
    VRD(5); SBAR(); GAPA(C1=__builtin_amdgcn_mfma_f32_32x32x16_bf16(kf[3],qr[1],C1,0,0,0),   P0[14],P0[15],P1[0],P1[1],   pw1[2]=PKW(P0,12),pw1[3]=PKW(P0,14), pw1); \
    VRD(2); SBAR(); GAPA(C0=__builtin_amdgcn_mfma_f32_32x32x16_bf16(kf[4],qr[2],C0,0,0,0),   P1[2],P1[3],P1[4],P1[5],     pw2[0]=PKW(P1,0), pw2[1]=PKW(P1,2), pw2); \
    VRD(6); SBAR(); GAPA(C1=__builtin_amdgcn_mfma_f32_32x32x16_bf16(kf[5],qr[2],C1,0,0,0),   P1[6],P1[7],P1[8],P1[9],     pw2[2]=PKW(P1,4), pw2[3]=PKW(P1,6), pw2); \
    VRD(3); SBAR(); GAPA(C0=__builtin_amdgcn_mfma_f32_32x32x16_bf16(kf[6],qr[3],C0,0,0,0),   P1[10],P1[11],P1[12],P1[13], pw3[0]=PKW(P1,8), pw3[1]=PKW(P1,10), pw3); \
    VRD(7); SBAR(); GAPA(C1=__builtin_amdgcn_mfma_f32_32x32x16_bf16(kf[7],qr[3],C1,0,0,0),   P1[14],P1[15],0.f,0.f,       pw3[2]=PKW(P1,12),pw3[3]=PKW(P1,14), pw3); \
    C0=__builtin_amdgcn_mfma_f32_32x32x16_bf16(kf[8],qr[4],C0,0,0,0); SBAR(); C1=__builtin_amdgcn_mfma_f32_32x32x16_bf16(kf[9],qr[4],C1,0,0,0); SBAR(); \
    C0=__builtin_amdgcn_mfma_f32_32x32x16_bf16(kf[10],qr[5],C0,0,0,0); SBAR(); C1=__builtin_amdgcn_mfma_f32_32x32x16_bf16(kf[11],qr[5],C1,0,0,0); SBAR(); \
    l_reg+=sacc; \
    if(GK){DMA_K((t)+3,sl_cur);} if(GV){DMA_V((t)+1,sl_next);} \
    CMASK(C0,C1,t); \
    { float a=MX3(C0[0],C0[1],C1[0]),b=MX3(C0[2],C0[3],C1[1]); a=MX3(a,C1[2],C1[3]); \
      _Pragma("unroll") for(int r=4;r<16;r+=4){a=MX3(a,C0[r],C0[r+1]);b=MX3(b,C0[r+2],C0[r+3]);a=MX3(a,C1[r],C1[r+1]);b=MX3(b,C1[r+2],C1[r+3]);} \
      float rm=__builtin_fmaxf(a,b); { auto rr=__builtin_amdgcn_permlane32_swap(__float_as_uint(rm),__float_as_uint(rm),false,false); rm=__builtin_fmaxf(__uint_as_float(rr[0]),__uint_as_float(rr[1])); } \
      resc=false; \
      if(__builtin_expect(__any(rm>(float)THRL),0)){ const float dl=__builtin_fmaxf(rm,0.f); mhat+=dl; \
        _Pragma("unroll") for(int r=0;r<16;++r){C0[r]-=dl;C1[r]-=dl;} \
        _Pragma("unroll") for(int r=0;r<16;++r)negm[r]=-mhat; asm volatile("":"+v"(negm)); \
        const float f=__builtin_amdgcn_exp2f(-dl); l_reg*=f; if(hi==0)wsf[r32]=f; resc=true; } } \
    SBAR(); \
    GAPB(o[0]=__builtin_amdgcn_mfma_f32_32x32x16_bf16(PAF(0),VFR(0),o[0],0,0,0), C0,0); \
    KRD(GL,0); GAPB(o[1]=__builtin_amdgcn_mfma_f32_32x32x16_bf16(PAF(0),VFR(4),o[1],0,0,0), C0,4); \
    KRD(GL,1); GAPB(o[0]=__builtin_amdgcn_mfma_f32_32x32x16_bf16(PAF(1),VFR(1),o[0],0,0,0), C0,8); \
    KRD(GL,2); GAPB(o[1]=__builtin_amdgcn_mfma_f32_32x32x16_bf16(PAF(1),VFR(5),o[1],0,0,0), C0,12); \
    KRD(GL,3); GAPB(o[0]=__builtin_amdgcn_mfma_f32_32x32x16_bf16(PAF(2),VFR(2),o[0],0,0,0), C1,0); \
    KRD(GL,4); GAPB(o[1]=__builtin_amdgcn_mfma_f32_32x32x16_bf16(PAF(2),VFR(6),o[1],0,0,0), C1,4); \
    KRD(GL,5); GAPB(o[0]=__builtin_amdgcn_mfma_f32_32x32x16_bf16(PAF(3),VFR(3),o[0],0,0,0), C1,8); \
    GAPB(o[1]=__builtin_amdgcn_mfma_f32_32x32x16_bf16(PAF(3),VFR(7),o[1],0,0,0), C1,12); \
    }while(0)
  int t=1;
  #undef CMASK
  #define CMASK(P0,P1,t) do{}while(0)
  for(;t+5<NT;t+=2){
    STEP(pB0,pB1,pA0,pA1,t,true,true,true);     WAITKV(); RESC(); ROT();
    STEP(pA0,pA1,pB0,pB1,t+1,true,true,true);   WAITKV(); RESC(); ROT();
  }
  #undef CMASK
  #define CMASK(P0,P1,t) do{}while(0)
  #define ENDW(tt) do{ if((tt)+3<NT){WAITKV();} else if((tt)+2<NT){WAIT_BAR(1);} else {WAIT_BAR(0);} }while(0)
  for(;t+1<NT;t+=2){
    STEP(pB0,pB1,pA0,pA1,t,(t+3<NT),(t+1<NT),(t+1<NT));       ENDW(t);   RESC(); ROT();
    STEP(pA0,pA1,pB0,pB1,t+1,(t+4<NT),(t+2<NT),(t+2<NT));     ENDW(t+1); RESC(); ROT();
  }
  STEP(pB0,pB1,pA0,pA1,NT-1,false,false,false); RESC();
  { float sacc=pB0[0]+pB0[1]; _Pragma("unroll") for(int r=2;r<16;++r)sacc+=pB0[r]; _Pragma("unroll") for(int r=0;r<16;++r)sacc+=pB1[r]; l_reg+=sacc;
    pw0=(u32x4){PKW(pB0,0),PKW(pB0,2),PKW(pB0,4),PKW(pB0,6)};pw1=(u32x4){PKW(pB0,8),PKW(pB0,10),PKW(pB0,12),PKW(pB0,14)};pw2=(u32x4){PKW(pB1,0),PKW(pB1,2),PKW(pB1,4),PKW(pB1,6)};pw3=(u32x4){PKW(pB1,8),PKW(pB1,10),PKW(pB1,12),PKW(pB1,14)};
    SBAR(); pv(o,vb0+sl_cur,PAF(0),PAF(1),PAF(2),PAF(3)); }
  #undef PKW
  #undef PAF
  #undef VFR
  #undef PIN
  #undef MX3
  #undef GAPA
  #undef GAPB
  #undef EX
  #undef VRD
  #undef KRD
  #undef STEP
  #undef ENDW
  {auto rr=__builtin_amdgcn_permlane32_swap(__float_as_uint(l_reg),__float_as_uint(l_reg),false,false);l_reg=__uint_as_float(rr[0])+__uint_as_float(rr[1]);}
  if(hi==0)wsf[32+r32]=l_reg;asm volatile("s_waitcnt lgkmcnt(0)":::"memory");
  float rli[16];
  #pragma unroll
  for(int r=0;r<16;++r)rli[r]=__builtin_amdgcn_rcpf(wsf[32+crow(r,hi)]);
  bf16*Ow=O+(q0+wid*QBLK)*op+ocol;
  { bf16*stg=(bf16*)(shm+LDS_OST)+wid*2048;
    #pragma unroll
    for(int r=0;r<16;++r){const int orow=crow(r,hi);
      #pragma unroll
      for(int d0=0;d0<2;++d0)stg[orow*64+d0*32+r32]=__float2bfloat16(o[d0][r]*rli[r]);}
    asm volatile("s_waitcnt lgkmcnt(0)":::"memory");
    #pragma unroll
    for(int i=0;i<4;++i){const int row=i*8+(lane>>3),ch=lane&7; const u32x4 v=*(const u32x4*)(stg+row*64+ch*8); ATTN_STORE16(Ow+(long)row*op+ch*8,v);} }
#ifdef ATT_STATIC_PRIO
  __builtin_amdgcn_s_setprio(0);
#endif
  asm volatile("s_waitcnt lgkmcnt(0)\n\ts_barrier":::"memory");
  #undef DMA_K
  #undef WAITKV
  #undef DMA_V
  #undef CMASK
  #undef START
  #undef RESC
  #undef ROT
}
constexpr int ATTN_LDS_BYTES=LDS_BYTES;

#undef SBAR
#undef WAIT_BAR
#undef KOFF
}
#define LAS __attribute__((address_space(3)))
#define XB_TMO      128
#define XB_XCNT(j)  (256  + 64 * (j))
#define XB_XSUB(j)  (1280 + 64 * (j))
#define XB_XGEN(j)  (2304 + 64 * (j))
#define XB_TOP      3328
#define XB_TOPGEN   3392
#define XCD_BAR_WORDS 3456
#define XB_ADA0     3584
#define XB_IN1A     3648
#define XB_UP10     3712
#define XB_CTXH     3520
#define XB_SPIN_CAP (1u << 18)

__device__ __forceinline__ unsigned xb_ld(unsigned* p)              { return __hip_atomic_load(p, __ATOMIC_RELAXED, __HIP_MEMORY_SCOPE_AGENT); }
__device__ __forceinline__ unsigned xb_add(unsigned* p, unsigned v) { return __hip_atomic_fetch_add(p, v, __ATOMIC_RELAXED, __HIP_MEMORY_SCOPE_AGENT); }
__device__ __forceinline__ unsigned xb_xcc_id() { return (unsigned)__builtin_amdgcn_s_getreg((3 << 11) | 20) & 0xFu; }
#define XB_SPIN(cond, bar) do { unsigned _sp = 0; while (cond) { __builtin_amdgcn_s_sleep(1); \
    if ((++_sp & 255u) == 0u) { if (xb_ld(&(bar)[XB_TMO])) break; if (_sp > XB_SPIN_CAP) { atomicAdd(&(bar)[XB_TMO], 1u); break; } } } } while (0)

struct XcdBarrier {
    unsigned* bar; unsigned x;
    volatile LAS unsigned* st;
};

__device__ __forceinline__ XcdBarrier xcd_barrier_post(unsigned* bar, volatile LAS unsigned* st) {
    XcdBarrier b; b.bar = bar; b.x = xb_xcc_id(); b.st = st;
    if (threadIdx.x == 0) (void)xb_add(&bar[XB_XCNT(b.x)], 1u);
    return b;
}
__device__ __forceinline__ void xcd_barrier_complete(unsigned* bar, unsigned x, unsigned& nloc, unsigned& nx) {
    const unsigned G = gridDim.x * gridDim.y * gridDim.z;
    unsigned sum, cnt, mine, sp = 0u;
    for (;;) {
        sum = 0u; cnt = 0u; mine = 0u;
#pragma unroll
        for (unsigned j = 0; j < 16; ++j) { const unsigned c = xb_ld(&bar[XB_XCNT(j)]); sum += c; cnt += (c > 0u) ? 1u : 0u; mine = (j == x) ? c : mine; }
        if (sum == G) break;
        __builtin_amdgcn_s_sleep(1);
        if ((++sp & 255u) == 0u) { if (xb_ld(&bar[XB_TMO])) break; if (sp > XB_SPIN_CAP) { atomicAdd(&bar[XB_TMO], 1u); break; } }
    }
    nloc = mine > 0u ? mine : 1u; nx = cnt > 0u ? cnt : 1u;
}

__device__ __forceinline__ void xcd_barrier(const XcdBarrier& b) {
    asm volatile("s_waitcnt vmcnt(0)" ::: "memory");
    __syncthreads();
    if (threadIdx.x == 0) {
        unsigned* bar = b.bar;
        __builtin_amdgcn_s_waitcnt(0);
        unsigned nloc = b.st[0], nx = b.st[1];
        if (nloc == 0u) { xcd_barrier_complete(bar, b.x, nloc, nx); b.st[0] = nloc; b.st[1] = nx; }
        const unsigned old = xb_add(&bar[XB_XSUB(b.x)], 1u);
        const unsigned gen = old / nloc;
        if (old + 1u == (gen + 1u) * nloc) {
            __builtin_amdgcn_fence(__ATOMIC_RELEASE, "agent");
            asm volatile("s_waitcnt vmcnt(0)" ::: "memory");
            const unsigned og = xb_add(&bar[XB_TOP], 1u);
            const unsigned tg = og / nx;
            if (og + 1u == (tg + 1u) * nx) xb_add(&bar[XB_TOPGEN], 1u);
            else XB_SPIN(xb_ld(&bar[XB_TOPGEN]) == tg, bar);
            __builtin_amdgcn_fence(__ATOMIC_ACQUIRE, "agent");
            xb_add(&bar[XB_XGEN(b.x)], 1u);
            asm volatile("s_waitcnt vmcnt(0)" ::: "memory");
        } else {
            XB_SPIN(xb_ld(&bar[XB_XGEN(b.x)]) == gen, bar);
            __builtin_amdgcn_fence(__ATOMIC_ACQUIRE, "agent");
            asm volatile("s_waitcnt vmcnt(0)" ::: "memory");
        }
    }
    __syncthreads();
}
namespace mk {
#ifndef KVROT
#define KVROT 0
#endif
#ifndef ALIGN2
#define ALIGN2 true
#endif
#ifndef ALIGN1
#define ALIGN1 true
#endif
#define MLAS __attribute__((address_space(3)))
constexpr int NWAVES = 8, NTHR = 512;
constexpr int RING_BYTES = 131072;
constexpr int LDS_BYTES = 147456;
constexpr int NPHASE = 16;
typedef unsigned v4u __attribute__((ext_vector_type(4)));
typedef float f32x4 __attribute__((ext_vector_type(4)));

struct Ctx {
    Params p; MLAS unsigned char* lds; char* lds_g; int wave, G, vcu, bid;
};
__device__ __forceinline__ int tid_now() { int t = threadIdx.x; asm volatile("" : "+v"(t)); return t; }
__device__ __forceinline__ unsigned pk2(float lo, float hi) { return (unsigned)f2bf(lo) | ((unsigned)f2bf(hi) << 16); }

enum { W_IN0 = 0, W_OUT0, W_GU0, W_D0, W_IN1, W_UQ, W_UKV, W_OUT1, W_GU1, W_D1, NWMAT };
struct SrcBlk { const float* W; int ld; int col; const float* kscale; };
__device__ __forceinline__ SrcBlk src_of(const Params& p, int mat, int nb) {
    SrcBlk s; s.kscale = nullptr; const int pn = nb >> 3, q = nb & 7, bj = q >> 2, wc = q & 3;
    switch (mat) {
    case W_IN0: s.W = p.in[I0_WIN]; s.ld = L0_IN; s.col = 256 * pn + 64 * wc + 32 * bj; break;
    case W_OUT0: s.W = p.in[I0_WOUT]; s.ld = D; s.col = 32 * nb; break;
    case W_GU0: s.W = bj ? p.in[I0_WU] : p.in[I0_WG]; s.ld = FF; s.col = 128 * pn + 32 * wc; break;
    case W_D0: s.W = p.in[I0_WD]; s.ld = D; s.col = 32 * nb; break;
    case W_IN1: s.W = p.in[I1_WIN]; s.ld = L1_IN;
        if (pn == 0) s.col = 128 * bj + 32 * wc;
        else if (pn == 1) { if (bj == 0) s.col = 256 + 32 * wc; else s.col = 640; }
        else if (pn == 2) s.col = 384 + 128 * bj + 32 * wc;
        else if (pn < 5) s.col = 672 + (pn - 3) * 256 + 64 * wc + 32 * bj;
        else if (pn < 7) s.col = 1184 + (pn - 5) * 256 + 64 * wc + 32 * bj;
        else s.col = 1696 + (pn - 7) * 256 + 64 * wc + 32 * bj;
        break;
    case W_UQ: s.W = p.in[I1_WUQ]; s.ld = 768; s.col = 32 * nb; s.kscale = p.in[I1_QAG]; break;
    case W_UKV: s.W = p.in[I1_WUKV]; s.ld = 1024; s.col = (2 * pn + (wc >> 1)) * 128 + (wc & 1) * 64 + 32 * bj; s.kscale = p.in[I1_KVAG]; break;
    case W_OUT1: s.W = p.in[I1_WOUT]; s.ld = D; s.col = 32 * nb; break;
    case W_GU1: s.W = bj ? p.in[I1_WU] : p.in[I1_WG]; s.ld = FF; s.col = 128 * pn + 32 * wc; break;
    default: s.W = p.in[I1_WD]; s.ld = D; s.col = 32 * nb; break;
    }
    return s;
}
struct WMat { size_t ws_off; int K, N; };
__host__ __device__ constexpr WMat wmat(int mat) {
    switch (mat) {
    case W_IN0: return {WS_W_IN0, D, 1536}; case W_OUT0: return {WS_W_OUT0, D, D}; case W_GU0: return {WS_W_GU0, D, 2 * FF}; case W_D0: return {WS_W_D0, FF, D};
    case W_IN1: return {WS_W_IN1, D, L1_INP}; case W_UQ: return {WS_W_UQ, 384, 768}; case W_UKV: return {WS_W_UKV, 256, 1024}; case W_OUT1: return {WS_W_OUT1, D, D};
    case W_GU1: return {WS_W_GU1, D, 2 * FF}; default: return {WS_W_D1, FF, D};
    }
}
template <int mat> __device__ __forceinline__ void tr_load(const Params& p, int item, f32x4 (&v)[8], int lane) {
    const WMat wm = wmat(mat); const int nblk = wm.N / 32, kb = item / nblk, nb = item % nblk, k0 = 64 * kb;
    const SrcBlk s = src_of(p, mat, nb);
    if (s.W == nullptr || (mat == W_OUT0 && kb < 4)) return;
    const int c4 = (lane & 7) * 4, kr = lane >> 3;
    const float* wsrc = s.W + (size_t)(k0 + kr) * s.ld + s.col + c4;
#pragma unroll
    for (int i = 0; i < 8; ++i) v[i] = *(const f32x4*)(wsrc + (size_t)(8 * i) * s.ld);
}
template <int mat> __device__ __forceinline__ void tr_finish(const Params& p, int item, const f32x4 (&v)[8], MLAS float* scr, int lane) {
    const WMat wm = wmat(mat); const int nblk = wm.N / 32, kb = item / nblk, nb = item % nblk, k0 = 64 * kb;
    const SrcBlk s = src_of(p, mat, nb);
    bf16_t* WT = (bf16_t*)(p.ws + wm.ws_off);
    const int c = lane & 7;
    if (s.W == nullptr) {
#pragma unroll
        for (int j = 0; j < 4; ++j) { const int n = (lane >> 3) + 8 * j; *(v4u*)(WT + (size_t)(32 * nb + n) * wm.K + k0 + 8 * c) = (v4u){0u, 0u, 0u, 0u}; }
        return;
    }
    MLAS float* t0 = scr; MLAS float* t1 = scr + 64 * 33;
    if (mat == W_OUT0 && kb < 4) return;
    constexpr bool fused_pool = false;
    { const int c4 = (lane & 7) * 4, kr = lane >> 3;
#pragma unroll
        for (int i = 0; i < 8; ++i) { const int kk = kr + 8 * i; float sc = 1.f;
            if (s.kscale) sc = s.kscale[k0 + kk];
            if (fused_pool) sc *= p.in[I0_POOLS][k0 + kk];
            MLAS float* d = t0 + kk * 33 + c4; d[0] = v[i][0] * sc; d[1] = v[i][1] * sc; d[2] = v[i][2] * sc; d[3] = v[i][3] * sc; } }
    asm volatile("s_waitcnt lgkmcnt(0)" ::: "memory");
    MLAS float* src = t0;
    if (fused_pool) {
        const float* pw = p.in[I0_POOLW] + kb * 4096; const int nn = lane & 31, ch = lane >> 5;
        for (int cc = ch; cc < 64; cc += 2) { float a = 0.f;
#pragma unroll 8
            for (int d = 0; d < 64; ++d) a += pw[cc * 64 + d] * t0[d * 33 + nn];
            t1[cc * 33 + nn] = a; }
        asm volatile("s_waitcnt lgkmcnt(0)" ::: "memory");
        src = t1;
    }
#pragma unroll
    for (int j = 0; j < 4; ++j) { const int n = (lane >> 3) + 8 * j; const MLAS float* sp = src + (8 * c) * 33 + n;
        v4u o; o.x = pk2(sp[0 * 33], sp[1 * 33]); o.y = pk2(sp[2 * 33], sp[3 * 33]); o.z = pk2(sp[4 * 33], sp[5 * 33]); o.w = pk2(sp[6 * 33], sp[7 * 33]);
        *(v4u*)(WT + (size_t)(32 * nb + n) * wm.K + k0 + 8 * c) = o; }
    asm volatile("s_waitcnt lgkmcnt(0)" ::: "memory");
}

#ifndef ADA_KS
#define ADA_KS 4
#endif
#define ADA_NIT (24 * ADA_KS)
#define ADA_RW (D / (ADA_KS * NWAVES))
#ifdef TP_A
#define TSTAMP_B(blk, i) do { if (C.bid == (blk) && threadIdx.x == 0) ((unsigned long long*)(C.p.ws + WS_CTL))[64 + (i)] = wall_clock64(); } while (0)
#else
#define TSTAMP_B(blk, i) do { } while (0)
#endif
#ifndef P0MASK
#define P0MASK 15
#endif
template <int PART> __device__ __forceinline__ void phase_prologue(Ctx& C, int vcu, int G) {
    const Params& p = C.p; const int tid = tid_now(), lane = tid & 63;
    MLAS float* sil = (MLAS float*)C.lds;
    MLAS float* red = (MLAS float*)(C.lds + 9 * 1024 * 4);
    __syncthreads();
    if (PART == 1) { TSTAMP_B(255, 40); TSTAMP_B(74, 50); }
#ifdef ADA_SPLIT
    if (PART <= 2)
#elif defined(ADA1_IN_P6)
    if (PART == 0 || PART == 6)
#else
    if (PART < 2)
#endif
    for (int i = tid; i < 9 * D; i += NTHR) { const int j = i / D, k = i % D; const float c = (j < 8) ? p.in[I_C][j * D + k] : p.in[I_CCTX][k]; sil[i] = c / (1.f + expf(-c)); }
    __syncthreads();
    if (PART == 1) { TSTAMP_B(255, 41); TSTAMP_B(74, 51); }
    float* MOD = (float*)(p.ws + WS_MOD);
#ifdef ADA_SPLIT
    constexpr int ADA_N = (PART == 0) ? 32 : (PART == 2) ? 64 : 96, ADA_BASE = (PART == 0) ? 0 : (PART == 2) ? 32 : 96;
    if ((P0MASK & 1) && PART <= 2)
    for (int it0 = vcu; it0 < ADA_N; it0 += G) { const int it = it0 + ADA_BASE;
#else
#ifdef ADA1_IN_P6
    constexpr bool ADA_ON = (PART == 0 || PART == 6); constexpr int ADA_L = (PART == 6) ? 1 : 0;
#else
    constexpr bool ADA_ON = (PART < 2); constexpr int ADA_L = PART;
#endif
    if ((P0MASK & 1) && ADA_ON)
    for (int it0 = vcu; it0 < ADA_NIT; it0 += G) { const int it = it0 + ADA_NIT * ADA_L;
#endif
        const int l = it / ADA_NIT, r_ = it % ADA_NIT, cg_ = r_ / ADA_KS, kq = r_ % ADA_KS, n0 = cg_ * 256;
        const int krow0 = kq * (D / ADA_KS) + C.wave * ADA_RW;
        const float* w = (l ? p.in[I1_ADAW] : p.in[I0_ADAW]) + (size_t)krow0 * 6144 + n0 + 4 * lane;
        f32x4 acc[9];
#pragma unroll
        for (int j = 0; j < 9; ++j) acc[j] = (f32x4){0.f, 0.f, 0.f, 0.f};
        f32x4 wrow[ADA_RW];
#pragma unroll
        for (int k = 0; k < ADA_RW; ++k) wrow[k] = *(const f32x4*)(w + (size_t)k * 6144);
#pragma unroll
        for (int k = 0; k < ADA_RW; ++k) { const f32x4 wv = wrow[k]; const int kk = krow0 + k;
#pragma unroll
            for (int j = 0; j < 9; ++j) acc[j] += wv * sil[j * D + kk]; }
#pragma unroll
        for (int j = 0; j < 9; ++j) *(MLAS f32x4*)(red + (C.wave * 9 + j) * 256 + 4 * lane) = acc[j];
        __syncthreads();
        for (int i = tid; i < 9 * 256; i += NTHR) { const int j = i >> 8, c = i & 255; float sm_ = 0.f;
#pragma unroll
            for (int wv = 0; wv < 8; ++wv) sm_ += red[(wv * 9 + j) * 256 + c];
            if (kq == 0) sm_ += (l ? p.in[I1_ADAB] : p.in[I0_ADAB])[n0 + c];
            atomicAdd(MOD + (size_t)(l * 9 + j) * 6144 + n0 + c, sm_); }
        __syncthreads();
    }
#ifdef MERGE01
    if (PART == 0) { asm volatile("s_waitcnt vmcnt(0)" ::: "memory"); __syncthreads();
        if (threadIdx.x == 0) { int n = 0; for (int it0 = vcu; it0 < 8 * ADA_KS; it0 += G) ++n; if (n) xb_add((unsigned*)(p.ws + WS_BARRIER) + XB_ADA0, (unsigned)n); } }
#endif
    __syncthreads();
    {
        MLAS float* PA = (MLAS float*)C.lds;
        MLAS float* PB = (MLAS float*)(C.lds + 64 * 65 * 4);
        bf16_t* WT = (bf16_t*)(p.ws + WS_W_OUT0);
#ifdef L0_SPLIT
        constexpr int POOL_PART = 2;
#else
        constexpr int POOL_PART = 0;
#endif
        if (PART == POOL_PART) for (int tile = vcu; tile < 128; tile += G) {
            const int g = tile >> 5, nb = tile & 31;
            for (int i = tid; i < 4096; i += NTHR) PA[(i >> 6) * 65 + (i & 63)] = p.in[I0_POOLW][g * 4096 + i];
            for (int i = tid; i < 2048; i += NTHR) { const int d = i >> 5, nn = i & 31; PB[d * 33 + nn] = p.in[I0_WOUT][(size_t)(g * 64 + d) * D + 32 * nb + nn] * p.in[I0_POOLS][g * 64 + d]; }
            __syncthreads();
            { const int c = tid >> 3, n4 = (tid & 7) * 4; float a0 = 0.f, a1 = 0.f, a2 = 0.f, a3 = 0.f;
#pragma unroll 8
                for (int d = 0; d < 64; ++d) { const float pa = PA[c * 65 + d]; const MLAS float* b = PB + d * 33 + n4; a0 += pa * b[0]; a1 += pa * b[1]; a2 += pa * b[2]; a3 += pa * b[3]; }
                bf16_t* o = WT + (size_t)(32 * nb + n4) * D + g * 64 + c;
                o[0] = f2bf(a0); o[D] = f2bf(a1); o[2 * D] = f2bf(a2); o[3 * D] = f2bf(a3); }
            __syncthreads();
        }
    }
    if (PART == 1) { TSTAMP_B(255, 42); TSTAMP_B(74, 52); }
    const int gw = vcu * NWAVES + C.wave, NGW = G * NWAVES;
    MLAS float* scr = (MLAS float*)(C.lds + C.wave * 16896);
    if (P0MASK & 2) {
#ifdef MERGE01
        int rot = (PART == 0 && NGW > ADA_NIT * NWAVES) ? ADA_NIT * NWAVES : 0;
#else
        int rot = 0;
#endif
#define TR_MAT(M) { constexpr int ni = (wmat(M).K / 64) * (wmat(M).N / 32); int first = gw - rot; if (first < 0) first += NGW; \
            { f32x4 va[8]; for (int it = first; it < ni; it += NGW) { tr_load<M>(p, it, va, lane); tr_finish<M>(p, it, va, scr, lane); } } \
            rot = (rot + ni) % NGW; }
        if (PART == 0) { TR_MAT(W_IN0)
#ifndef L0_SPLIT
            TR_MAT(W_OUT0) TR_MAT(W_GU0) TR_MAT(W_D0)
#endif
        }
        else if (PART == 2) { TR_MAT(W_OUT0)
#ifndef GU0_IN_P4
            TR_MAT(W_GU0)
#endif
#if !defined(D0_IN_P6) && !defined(CTXD_IN_P6)
            TR_MAT(W_D0)
#endif
        }
        else if (PART == 3) { TR_MAT(W_D0) }
        else if (PART == 5) { TR_MAT(W_GU0) }
        else if (PART == 1) { TR_MAT(W_IN1) TR_MAT(W_UQ) TR_MAT(W_UKV)
#if defined(REPACK)
#elif defined(P9_OUTD1)
            TR_MAT(W_GU1)
#elif !defined(CTXD_IN_P6)
            TR_MAT(W_OUT1) TR_MAT(W_GU1) TR_MAT(W_D1)
#endif
        }
#if defined(REPACK)
        else if (PART == 4) { TR_MAT(W_GU1) }
        else if (PART == 7) { TR_MAT(W_OUT1) TR_MAT(W_D1) }
#elif defined(P9_OUTD1) && defined(OUT1_IN_P6)
        else if (PART == 4) { TR_MAT(W_D1) }
        else if (PART == 7) { TR_MAT(W_OUT1) }
#elif defined(P9_OUTD1)
        else if (PART == 4) { TR_MAT(W_OUT1) TR_MAT(W_D1) }
#else
        else if (PART == 4) { TR_MAT(W_OUT1) TR_MAT(W_GU1) TR_MAT(W_D1) }
#endif
#undef TR_MAT
    }
    if (PART == 1) { __syncthreads(); TSTAMP_B(255, 43); TSTAMP_B(74, 53); }
    if (PART == 0 && (P0MASK & 4) && C.bid == C.G - 1) {
        float* T32 = (float*)(p.ws + WS_ROPE32); float* T16 = (float*)(p.ws + WS_ROPE16);
        for (int i = tid; i < 1024; i += NTHR) { const int pos = i >> 4, f = i & 15; const float ang = (float)pos * powf(10000.0f, -((float)f * 2.0f) / 32.0f); T32[i] = cosf(ang); T32[1024 + i] = sinf(ang); }
        for (int i = tid; i < 512; i += NTHR) { const int pos = i >> 3, f = i & 7; const float ang = (float)pos * powf(10000.0f, -((float)f * 2.0f) / 16.0f); T16[i] = cosf(ang); T16[512 + i] = sinf(ang); }
    }
    if (PART == 0 && (P0MASK & 8)) { float* SSQ = (float*)(p.ws + WS_SSQ); float* SSKV = (float*)(p.ws + WS_SSKV);
        for (int i = C.bid * NTHR + tid; i < MT; i += C.G * NTHR) { SSQ[i] = 0.f; SSKV[i] = 0.f; }
#ifdef FOLD_N13
        { float* SSN1 = (float*)(p.ws + WS_SSN1); for (int i = C.bid * NTHR + tid; i < ML; i += C.G * NTHR) SSN1[i] = 0.f; }
#endif
    }
}

__device__ __forceinline__ epi::RawPF norm_ld8(const float* p) { epi::RawPF r; r.a = *(const f32x4*)p; r.b = *(const f32x4*)(p + 4); return r; }
__device__ __forceinline__ epi::u32x4 norm_ld8(const bf16_t* p) { return *(const epi::u32x4*)p; }
__device__ __forceinline__ void norm_cv8(const epi::RawPF& r, f32x4& lo, f32x4& hi) { lo = r.a; hi = r.b; }
__device__ __forceinline__ void norm_cv8(epi::u32x4 w, f32x4& lo, f32x4& hi) { epi::u32x2 a, b; a.x = w.x; a.y = w.y; b.x = w.z; b.y = w.w; lo = epi::cvraw(a); hi = epi::cvraw(b); }
template <class TL> __device__ __forceinline__ void phase_norm(Ctx& C, const TL* xl, const float* xc, const float* gain, int layer, int sh_chunk, int sc_chunk, int nrows, const float* slab = nullptr, int nslab = 0, float* xc_wb = nullptr) {
    const int lane = tid_now() & 63;
    const int gw = C.vcu * NWAVES + C.wave, NGW = C.G * NWAVES;
    bf16_t* XN = (bf16_t*)(C.p.ws + WS_XN); const float* MODb = (const float*)(C.p.ws + WS_MOD) + (size_t)layer * 9 * 6144;
    for (int ch = gw; ch < ML / 8; ch += NGW) {
        const int m0 = ch * 8; const float* mod = MODb + (size_t)(m0 / S) * 6144;
        f32x4 a[2][2], sh[2][2];
#pragma unroll
        for (int j = 0; j < 2; ++j)
#pragma unroll
            for (int h = 0; h < 2; ++h) { const int c = 8 * lane + 512 * j + 4 * h; a[j][h] = *(const f32x4*)(gain + c) * (*(const f32x4*)(mod + sc_chunk * D + c) + 1.f); sh[j][h] = *(const f32x4*)(mod + sh_chunk * D + c); }
#pragma unroll
        for (int rb = 0; rb < 8; rb += 4) {
            typename epi::RawP<TL>::type raw[4][2];
#pragma unroll
            for (int b = 0; b < 4; ++b)
#pragma unroll
                for (int j = 0; j < 2; ++j) raw[b][j] = norm_ld8(xl + (size_t)(m0 + rb + b) * D + 8 * lane + 512 * j);
#pragma unroll
            for (int b = 0; b < 4; ++b) { f32x4 v[2][2]; float ss = 0.f;
#pragma unroll
                for (int j = 0; j < 2; ++j) { norm_cv8(raw[b][j], v[j][0], v[j][1]);
#pragma unroll
                    for (int h = 0; h < 2; ++h) ss += (v[j][h][0] * v[j][h][0] + v[j][h][1] * v[j][h][1]) + (v[j][h][2] * v[j][h][2] + v[j][h][3] * v[j][h][3]); }
                ss = wave_sum(ss);
                const float r = rsqrtf(ss * (1.f / D) + EPS);
#pragma unroll
                for (int j = 0; j < 2; ++j) { const f32x4 y0 = (v[j][0] * r) * a[j][0] + sh[j][0], y1 = (v[j][1] * r) * a[j][1] + sh[j][1];
                    v4u o; o.x = pk2(y0[0], y0[1]); o.y = pk2(y0[2], y0[3]); o.z = pk2(y1[0], y1[1]); o.w = pk2(y1[2], y1[3]);
                    *(v4u*)(XN + (size_t)(m0 + rb + b) * D + 8 * lane + 512 * j) = o; } }
        }
    }
    for (int m = ML + gw; m < nrows; m += NGW) {
        const float* mod = MODb + (size_t)8 * 6144;
        f32x4 v[4]; float ss = 0.f;
#pragma unroll
        for (int j = 0; j < 4; ++j) v[j] = *(const f32x4*)(xc + (size_t)(m - ML) * D + 4 * lane + 256 * j);
        for (int s_ = 0; s_ < nslab; ++s_) {
#pragma unroll
            for (int j = 0; j < 4; ++j) v[j] += *(const f32x4*)(slab + (size_t)s_ * MC * D + (size_t)(m - ML) * D + 4 * lane + 256 * j); }
        if (nslab > 0 && xc_wb) {
#pragma unroll
            for (int j = 0; j < 4; ++j) *(f32x4*)(xc_wb + (size_t)(m - ML) * D + 4 * lane + 256 * j) = v[j]; }
#pragma unroll
        for (int j = 0; j < 4; ++j) ss += (v[j][0] * v[j][0] + v[j][1] * v[j][1]) + (v[j][2] * v[j][2] + v[j][3] * v[j][3]);
        ss = wave_sum(ss);
        const float r = rsqrtf(ss * (1.f / D) + EPS);
#pragma unroll
        for (int j = 0; j < 4; ++j) { const int c = 4 * lane + 256 * j;
            const f32x4 g = *(const f32x4*)(gain + c), sc = *(const f32x4*)(mod + sc_chunk * D + c), sh = *(const f32x4*)(mod + sh_chunk * D + c);
            const f32x4 y = ((v[j] * r) * g) * (sc + 1.f) + sh;
            uint2 o; o.x = pk2(y[0], y[1]); o.y = pk2(y[2], y[3]);
            *(uint2*)(XN + (size_t)m * D + c) = o; }
    }
}

__device__ __forceinline__ void phase_bias(Ctx& C, int vcu, int Gn, const bf16_t* Wt, int npos, const float* shift  , int nb, float* bias) {
    const int tid = tid_now(), lane = tid & 63;
    MLAS float* sh = (MLAS float*)C.lds;
    __syncthreads();
    for (int i = tid; i < nb * D; i += NTHR) sh[i] = shift[(size_t)(i / D) * 6144 + (i % D)];
    __syncthreads();
    const int gw = vcu * NWAVES + C.wave, NGW = Gn * NWAVES;
    for (int pos = gw; pos < npos; pos += NGW) {
        const v4u w0 = *(const v4u*)(Wt + (size_t)pos * D + 16 * lane), w1 = *(const v4u*)(Wt + (size_t)pos * D + 16 * lane + 8);
        float wf[16];
#pragma unroll
        for (int e = 0; e < 4; ++e) { wf[2 * e] = __uint_as_float(w0[e] << 16); wf[2 * e + 1] = __uint_as_float(w0[e] & 0xffff0000u); wf[8 + 2 * e] = __uint_as_float(w1[e] << 16); wf[8 + 2 * e + 1] = __uint_as_float(w1[e] & 0xffff0000u); }
        float mine = 0.f;
        for (int b = 0; b < nb; ++b) { float s = 0.f;
#pragma unroll
            for (int q = 0; q < 4; ++q) { const f32x4 sv = *(const MLAS f32x4*)(sh + b * D + 16 * lane + 4 * q); s += (wf[4 * q] * sv[0] + wf[4 * q + 1] * sv[1]) + (wf[4 * q + 2] * sv[2] + wf[4 * q + 3] * sv[3]); }
            s = wave_sum(s); if (lane == b) mine = s; }
        if (lane < nb) bias[(size_t)lane * npos + pos] = mine;
    }
}

#ifdef TP_A
#define TSTAMP_C(i) do { if (C.bid == 0 && threadIdx.x == 0) ((unsigned long long*)(C.p.ws + WS_CTL))[64 + (i)] = wall_clock64(); } while (0)
#else
#define TSTAMP_C(i) do { } while (0)
#endif
template <int W> __device__ __forceinline__ void pool8(const bf16_t* A0, bf16_t* MIX, int m0, int c8) {
    constexpr int HW = W / 2, NR = 7 + W;
    int t0, T; if (m0 < ML) { t0 = m0 % S; T = S; } else { t0 = (m0 - ML) % CTX; T = CTX; }
    const int base = m0 - t0;
    v4u row[NR];
#pragma unroll
    for (int j = 0; j < NR; ++j) { row[j] = (v4u){0u, 0u, 0u, 0u}; const int r = t0 - HW + j; if (r >= 0 && r < T) row[j] = *(const v4u*)(A0 + (size_t)(base + r) * 256 + c8); }
    float s[8];
#pragma unroll
    for (int e = 0; e < 8; ++e) s[e] = 0.f;
#pragma unroll
    for (int j = 0; j < W; ++j) {
#pragma unroll
        for (int e = 0; e < 4; ++e) { s[2 * e] += __uint_as_float(row[j][e] << 16); s[2 * e + 1] += __uint_as_float(row[j][e] & 0xffff0000u); } }
#pragma unroll
    for (int i = 0; i < 8; ++i) {
        int lo = t0 + i - HW; if (lo < 0) lo = 0; int hi = t0 + i - HW + W; if (hi > T) hi = T;
        const float inv = 1.f / (float)(hi - lo); const v4u q = row[i + HW];
        v4u o;
#pragma unroll
        for (int e = 0; e < 4; ++e) o[e] = pk2(s[2 * e] * inv - __uint_as_float(q[e] << 16), s[2 * e + 1] * inv - __uint_as_float(q[e] & 0xffff0000u));
        *(v4u*)(MIX + (size_t)(m0 + i) * D + c8) = o;
        if (i < 7) {
#pragma unroll
            for (int e = 0; e < 4; ++e) { s[2 * e] += __uint_as_float(row[i + W][e] << 16) - __uint_as_float(row[i][e] << 16); s[2 * e + 1] += __uint_as_float(row[i + W][e] & 0xffff0000u) - __uint_as_float(row[i][e] & 0xffff0000u); } }
    }
}
__device__ __forceinline__ void phase_pool(Ctx& C) {
    const bf16_t* A0 = (const bf16_t*)(C.p.ws + WS_A0); bf16_t* MIX = (bf16_t*)(C.p.ws + WS_MIX);
    const int skip = (C.G > 128) ? 96 : 0;
    if (C.vcu < skip) return;
    const int lane = tid_now() & 63;
    const int gwv = (C.vcu - skip) * NWAVES + C.wave, NGWV = (C.G - skip) * NWAVES;
    for (int wi = gwv; wi < (MT / 64) * 4; wi += NGWV) {
        const int g = wi & 3, m0 = ((wi >> 2) * 8 + (lane >> 3)) * 8, c8 = g * 64 + (lane & 7) * 8;
        if (g == 0) pool8<2>(A0, MIX, m0, c8); else if (g == 1) pool8<4>(A0, MIX, m0, c8); else if (g == 2) pool8<8>(A0, MIX, m0, c8); else pool8<16>(A0, MIX, m0, c8);
    }
}


__device__ __forceinline__ void phase_natable(Ctx& C, int vcu, int Gn) {
    bf16_t* G = (bf16_t*)(C.p.ws + WS_NAG); const float* rpb = C.p.in[I1_RPB];
    const int gt = vcu * NTHR + tid_now(), NGT = Gn * NTHR;
    for (int it = gt; it < 8 * 16 * 2 * 64 * 32; it += NGT) {
        const int j = it & 31, kc = (it >> 5) & 63, half = (it >> 11) & 1, dr = (it >> 12) & 15, h = it >> 16;
        const int qc = 32 * half + j, cs = min(max(qc - 8, 0), 48);
        float v = -30000.f;
        if (dr < 15 && (unsigned)(kc - cs) < 16u) v = rpb[(h * 15 + dr) * 31 + (kc - qc + 15)] * LOG2E;
        G[it] = f2bf(v);
    }
}

__device__ __forceinline__ void phase_attn0(Ctx& C) {
    const Params& p = C.p;
    MLAS char* shm = (MLAS char*)C.lds;
    att::UnitDesc U; U.Q = (const bf16_t*)(p.ws + WS_Q0); U.qpitch = 768; U.K = (const bf16_t*)(p.ws + WS_K0); U.kpitch = 256; U.V = (const bf16_t*)(p.ws + WS_V0); U.vpitch = 256;
    U.O = (bf16_t*)(p.ws + WS_MIX); U.opitch = D; U.rg = 0; U.rmin = 0; U.head = 0; U.G = nullptr;
    for (int u = C.vcu; u < 768 + 96; u += C.G) {
        if (u < 768) { const int qb = u & 7, bh = u >> 3, h = bh % 12, b = bh / 12;
            U.q0 = (long)b * S + 256 * qb; U.qcol = h * 64; U.kcol = (h / 3) * 64; U.vcol = (h / 3) * 64; U.ocol = 256 + h * 64; U.kv0 = b * SK; U.nt = SK / 64; }
        else { const int bh = u - 768, h = bh % 12, b = bh / 12;
            U.q0 = (long)ML + 256 * b; U.qcol = h * 64; U.kcol = (h / 3) * 64; U.vcol = (h / 3) * 64; U.ocol = 256 + h * 64; U.kv0 = b * SK; U.nt = CTX / 64; }
#ifdef USE_ATT64
        att64::attn_unit<8>(U.q0, (const att64::bf16*)U.Q, U.qpitch, U.qcol, (const att64::bf16*)U.K, U.kpitch, U.kcol, (const att64::bf16*)U.V, U.vpitch, U.vcol, (long)U.kv0, U.nt, (att64::bf16*)U.O, U.opitch, U.ocol, C.lds_g);
#else
        att::attn_unit<64, false, false>(U, shm, nullptr, nullptr, nullptr);
#endif
    }
    TSTAMP_C(24);
    phase_pool(C);
    TSTAMP_C(25);
}
__device__ __forceinline__ void phase_attn1(Ctx& C) {
    const Params& p = C.p;
    MLAS char* shm = (MLAS char*)C.lds;
    const float* T16 = (const float*)(p.ws + WS_ROPE16);
    att::UnitDesc U; U.O = (bf16_t*)(p.ws + WS_MIX); U.opitch = D; U.G = (const bf16_t*)(p.ws + WS_NAG);
#ifdef MERGE1011
    bool waited = false;
    for (int ul = C.vcu; ul < 1024; ul += C.G) { const int u = ul < 512 ? ul + 512 : ul - 512;
        if (u < 512 && !waited) { waited = true;
            unsigned* barw = (unsigned*)(p.ws + WS_BARRIER);
            if (threadIdx.x == 0) { XB_SPIN(xb_ld(barw + XB_UP10) < (unsigned)C.G, barw); __builtin_amdgcn_fence(__ATOMIC_ACQUIRE, "agent"); asm volatile("s_waitcnt vmcnt(0)" ::: "memory"); }
            __syncthreads(); }
#else
    for (int u = C.vcu; u < 1024; u += C.G) {
#endif
        const int uu = u & 511, qb = uu & 7, h = (uu >> 3) & 7, b = uu >> 6;
        U.q0 = (long)b * S + 256 * qb; U.kv0 = b * SK; U.head = h;
        if (u < 512) {
            U.Q = (const bf16_t*)(p.ws + WS_MQ); U.qpitch = 768; U.qcol = h * 96; U.K = (const bf16_t*)(p.ws + WS_MK); U.kpitch = 768; U.kcol = h * 96;
            U.V = (const bf16_t*)(p.ws + WS_MV); U.vpitch = 512; U.vcol = h * 64; U.ocol = h * 64; U.nt = SK / 64; U.rg = 0; U.rmin = 0;
#ifdef USE_ATT96
            att96::attn_unit<8>(U.q0, (const att96::bf16*)U.Q, U.qpitch, U.qcol, (const att96::bf16*)U.K, U.kpitch, U.kcol, (const att96::bf16*)U.V, U.vpitch, U.vcol, (long)U.kv0, U.nt, (att96::bf16*)U.O, U.opitch, U.ocol, C.lds_g, p.in[I1_MQG], T16);
            TSTAMP_C(26);
#ifdef DUP_MLA
            att96::attn_unit<8>(U.q0, (const att96::bf16*)U.Q, U.qpitch, U.qcol, (const att96::bf16*)U.K, U.kpitch, U.kcol, (const att96::bf16*)U.V, U.vpitch, U.vcol, (long)U.kv0, U.nt, (att96::bf16*)U.O, U.opitch, U.ocol, C.lds_g, p.in[I1_MQG], T16);
#endif
#else
            att::attn_unit<96, false, true>(U, shm, p.in[I1_MQG], T16, nullptr);
#ifdef DUP_MLA
            att::attn_unit<96, false, true>(U, shm, p.in[I1_MQG], T16, nullptr);
#endif
#endif
        } else {
            U.Q = (const bf16_t*)(p.ws + WS_NQ); U.qpitch = 512; U.qcol = h * 64; U.K = (const bf16_t*)(p.ws + WS_NK); U.kpitch = 512; U.kcol = h * 64;
            U.V = (const bf16_t*)(p.ws + WS_NV); U.vpitch = 512; U.vcol = h * 64; U.ocol = 512 + h * 64; U.rg = qb;
            const int rmin = min(max(4 * qb - 4, 0), 24), rmax = min(max(4 * qb + 3 - 4, 0), 24) + 7;
            U.rmin = rmin; U.nt = 4 + (rmax - rmin + 1);
#ifdef USE_ATTNA
            attna::attn_unit<8>(U.q0, (const attna::bf16*)U.Q, U.qpitch, U.qcol, (const attna::bf16*)U.K, U.kpitch, U.kcol, (const attna::bf16*)U.V, U.vpitch, U.vcol, (long)U.kv0, (U.nt + 1) & ~1, (attna::bf16*)U.O, U.opitch, U.ocol, C.lds_g, U.rmin, U.rg, p.in[I1_RPB] + h * 465);
#ifdef DUP_NA
            attna::attn_unit<8>(U.q0, (const attna::bf16*)U.Q, U.qpitch, U.qcol, (const attna::bf16*)U.K, U.kpitch, U.kcol, (const attna::bf16*)U.V, U.vpitch, U.vcol, (long)U.kv0, (U.nt + 1) & ~1, (attna::bf16*)U.O, U.opitch, U.ocol, C.lds_g, U.rmin, U.rg, p.in[I1_RPB] + h * 465);
#endif
#else
            att::attn_unit<64, true, false>(U, shm, nullptr, nullptr, p.in[I1_RPB]);
#ifdef DUP_NA
            att::attn_unit<64, true, false>(U, shm, nullptr, nullptr, p.in[I1_RPB]);
#endif
#endif
        }
    }
}

__device__ __forceinline__ void skew_wait(unsigned ticks) {
    if (threadIdx.x == 0) { const unsigned long long t0 = wall_clock64(); while (wall_clock64() - t0 < ticks) __builtin_amdgcn_s_sleep(8); }
    __syncthreads();
}

__global__ void __launch_bounds__(NTHR, 2) mega(Params p, int ph_lo, int ph_hi) {
    extern __shared__ __attribute__((aligned(16))) unsigned char lds_raw[];
    cg::grid_group grid = cg::this_grid();
    Ctx C; C.p = p; C.lds = (MLAS unsigned char*)lds_raw; C.lds_g = (char*)lds_raw; C.wave = __builtin_amdgcn_readfirstlane((int)threadIdx.x >> 6);
    C.G = gridDim.x; C.bid = blockIdx.x; C.vcu = (C.G % 8 == 0) ? (C.bid % 8) * (C.G / 8) + C.bid / 8 : C.bid;
    volatile LAS unsigned* bst = (volatile LAS unsigned*)(C.lds + LDS_BYTES - 64);
    if (threadIdx.x < 2) bst[threadIdx.x] = 0u;
    __syncthreads();
    unsigned* barw = (unsigned*)(p.ws + WS_BARRIER);
    XcdBarrier bar; bar.bar = barw; bar.x = 0; bar.st = nullptr;
    if (ph_hi - ph_lo > 1) bar = xcd_barrier_post(barw, bst);
    float* out = p.out; float* xrc = (float*)(p.ws + WS_XRC);
#ifdef BF16RES
    typedef bf16_t res_t;
    res_t* xa = (res_t*)p.out; res_t* xb3 = (res_t*)(p.ws + WS_X3);
#else
    typedef float res_t;
    res_t* xa = p.out; res_t* xb3 = p.out;
#endif
    const float* MOD = (const float*)(p.ws + WS_MOD);
    bf16_t* XN = (bf16_t*)(p.ws + WS_XN); bf16_t* MIX = (bf16_t*)(p.ws + WS_MIX); bf16_t* H = (bf16_t*)(p.ws + WS_H);
    const float* T32 = (const float*)(p.ws + WS_ROPE32); const float* T16 = (const float*)(p.ws + WS_ROPE16);
#define WSB(off) ((bf16_t*)(p.ws + (off)))
#ifndef PHMASK
#define PHMASK 0xFFFF
#endif
#ifndef REPMASK
#define REPMASK 0
#endif
#ifndef NSYNC
#define NSYNC 1
#endif
#define PH(k) if (((PHMASK >> (k)) & 1) && ph_lo <= (k) && (k) < ph_hi) for (int rep_ = 0; rep_ < (((REPMASK >> (k)) & 1) ? 2 : 1); ++rep_, (((REPMASK >> (k)) & 1) && rep_ == 1 ? xcd_barrier(bar) : (void)0))
#ifndef USE_CG_SYNC
#define USE_CG_SYNC 0
#endif
#ifdef TP_A
#ifndef TP_Q
#define TP_Q 4.f
#define TP_O 2.f
#endif
#define TSTAMP(i) do { if (C.bid == 0 && threadIdx.x == 0) ((unsigned long long*)(p.ws + WS_CTL))[64 + (i)] = wall_clock64(); } while (0)
#else
#define TSTAMP(i) do { } while (0)
#endif
#define SEAM(k) if (ph_lo <= (k) && (k) + 1 < ph_hi) { TSTAMP(32 + (k)); for (int s_ = 0; s_ < NSYNC; ++s_) { if (USE_CG_SYNC || ph_hi > 1000) grid.sync(); else xcd_barrier(bar); } TSTAMP((k) + 1); }
    TSTAMP(0);
    PH(0) { phase_prologue<0>(C, C.vcu, C.G);
#if !defined(L1_LATE) && !defined(L1_IN_P7)
        phase_prologue<1>(C, C.vcu, C.G);
#endif
    }
#ifdef MERGE01
    if (ph_lo <= 0 && ph_hi > 1) {
        if (threadIdx.x == 0) { XB_SPIN(xb_ld(barw + XB_ADA0) < (unsigned)(8 * ADA_KS), barw); __builtin_amdgcn_fence(__ATOMIC_ACQUIRE, "agent"); asm volatile("s_waitcnt vmcnt(0)" ::: "memory"); }
        __syncthreads();
    }
    TSTAMP(1);
#else
    SEAM(0);
#endif
    PH(1) { phase_norm(C, p.in[I_X], p.in[I_CTX], p.in[I0_NMIX], 0, 0, 1, MT); } SEAM(1);
    PH(2) { pg8::Gemm g{XN, WSB(WS_W_IN0), MT, 1536, D, D}; pg8::StaticOrder So; So.init(MT, 1536, C.G, C.bid);
        epi::EpiIn0 E{WSB(WS_A0), WSB(WS_Q0), WSB(WS_K0), WSB(WS_V0), p.in[I0_QG], p.in[I0_KG], T32};
        pg8::gemm_phase<epi::EpiIn0, pg8::StaticOrder, ALIGN2, true>(C.lds, g, So, E);
#ifdef L0_SPLIT
        { const int n2 = (MT / 256) * 6 - C.G;
          if (n2 >= 0 && n2 < C.G) { if (C.bid >= n2) phase_prologue<2>(C, C.bid - n2, C.G - n2); } else phase_prologue<2>(C, C.vcu, C.G); }
#endif
#ifdef L1_LATE
        { const int n2 = (MT / 256) * 6 - C.G;
          if (n2 >= 0 && n2 < C.G && C.bid >= n2) phase_prologue<1>(C, C.bid - n2, C.G - n2);
          else if (n2 < 0 || n2 >= C.G) phase_prologue<1>(C, C.vcu, C.G); }
#endif
    } SEAM(2);
    PH(3) { phase_attn0(C); } SEAM(3);
    PH(4) { { pg8::Gemm g{MIX, WSB(WS_W_OUT0), ML, D, D, D}; pg8::StaticOrder So; So.init(ML, D, C.G, C.bid);
          epi::EpiResidT<float, res_t> E{p.in[I_X], p.in[I_CTX], xa, xrc, MOD + 2 * D};
          pg8::gemm_phase<epi::EpiResidT<float, res_t>, pg8::StaticOrder, ALIGN1, true>(C.lds, g, So, E); }
        TSTAMP(20);
        { pg8::Gemm g{MIX, WSB(WS_W_OUT0), MT, D, D / 4, D}; pg8::CtxSplitOrder So; So.init(4, C.G, C.bid);
          epi::EpiResidSplit E{p.in[I_CTX], xrc, (float*)(p.ws + WS_SLAB4), MOD + 2 * D};
          pg8::gemm_phase<epi::EpiResidSplit, pg8::CtxSplitOrder, true, true>(C.lds, g, So, E); }
        TSTAMP(21);
#ifdef GU0_IN_P4
        if (C.G > 128) { if (C.bid >= 128) phase_prologue<5>(C, C.bid - 128, C.G - 128); } else phase_prologue<5>(C, C.vcu, C.G);
#endif
#ifdef CTXD_IN_P6
        if (C.G > 128) { if (C.bid >= 128) phase_prologue<3>(C, C.bid - 128, C.G - 128); } else phase_prologue<3>(C, C.vcu, C.G);
#endif
    } SEAM(4);
    PH(5) { phase_norm(C, xa, xrc, p.in[I0_NFFN], 0, 3, 4, MT, (const float*)(p.ws + WS_SLAB4), 3, xrc); } SEAM(5);
#ifdef CTXD_IN_P6
    const bool ctxd = (C.G == 256);
#else
    const bool ctxd = false;
#endif
    PH(6) { pg8::Gemm g{XN, WSB(WS_W_GU0), MT, 2 * FF, D, D}; epi::EpiSwiGLU E{H};
        if (!ctxd) { pg8::StaticOrder So; So.init(MT, 2 * FF, C.G, C.bid);
#ifdef SKEW6
            { const int total = (MT / 256) * (2 * FF / 256), rem = total % C.G; if (rem > 0 && C.bid >= rem + (C.G - rem) / 2) skew_wait(SKEW6); }
#endif
            pg8::gemm_phase<epi::EpiSwiGLU, pg8::StaticOrder, true, true>(C.lds, g, So, E);
#ifdef D0_IN_P6
            { const int total = (MT / 256) * (2 * FF / 256), full = total / C.G, n7 = total - full * C.G;
              if (n7 > 0 && n7 < C.G) { if (C.bid >= n7) { phase_prologue<3>(C, C.bid - n7, C.G - n7);
#if defined(REPACK) || defined(OUT1_IN_P6)
                      phase_prologue<7>(C, C.bid - n7, C.G - n7);
#endif
#ifdef ADA1_IN_P6
                      phase_prologue<6>(C, C.G - 1 - C.bid, C.G - n7);
#endif
                  } }
              else { phase_prologue<3>(C, C.vcu, C.G);
#if defined(REPACK) || defined(OUT1_IN_P6)
                  phase_prologue<7>(C, C.vcu, C.G);
#endif
#ifdef ADA1_IN_P6
                  phase_prologue<6>(C, C.vcu, C.G);
#endif
              } }
#endif
        }
#ifdef CTXD_IN_P6
        else {
            unsigned* flag = barw + XB_CTXH;
            { pg8::CtxFirstOrder So; So.init(0, C.bid); epi::EpiSwiGLUW EW{H}; pg8::gemm_phase<epi::EpiSwiGLUW, pg8::CtxFirstOrder, true, true>(C.lds, g, So, EW); }
            if (C.bid >= 80 && threadIdx.x == 0) xb_add(flag, 1u);
            { pg8::CtxFirstOrder So; So.init(1, C.bid); pg8::gemm_phase<epi::EpiSwiGLU, pg8::CtxFirstOrder, true, true>(C.lds, g, So, E); }
            if (C.bid >= 48 && C.bid < 176) {
                if (threadIdx.x == 0) { XB_SPIN(xb_ld(flag) < 176u, barw); __builtin_amdgcn_fence(__ATOMIC_ACQUIRE, "agent"); asm volatile("s_waitcnt vmcnt(0)" ::: "memory"); }
                __syncthreads();
                if (C.bid < 112) { pg8::Gemm g2{H, WSB(WS_W_D0), MT, D, 768, FF}; pg8::CtxSplitOrder S2; S2.init(2, C.G, C.bid - 48);
                    epi::EpiResidSplit E2{xrc, xrc, (float*)(p.ws + WS_SLAB7), MOD + 5 * D, 0};
                    pg8::gemm_phase<epi::EpiResidSplit, pg8::CtxSplitOrder, true, true>(C.lds, g2, S2, E2); }
                else { pg8::Gemm g2{H + 1536, WSB(WS_W_D0) + 1536, MT, D, 640, FF}; pg8::CtxSplitOrder S2; S2.init(2, C.G, C.bid - 112);
                    epi::EpiResidSplit E2{xrc, xrc, (float*)(p.ws + WS_SLAB7), MOD + 5 * D, 2};
                    pg8::gemm_phase<epi::EpiResidSplit, pg8::CtxSplitOrder, true, true>(C.lds, g2, S2, E2); }
            } else if (C.bid >= 176) { phase_prologue<1>(C, C.bid - 176, C.G - 176); phase_natable(C, C.bid - 176, C.G - 176); }
        }
#endif
    } SEAM(6);
    PH(7) { { pg8::Gemm g{H, WSB(WS_W_D0), ML, D, FF, FF}; pg8::StaticOrder So; So.init(ML, D, C.G, C.bid);
          epi::EpiResidT<res_t, res_t> E{xa, xrc, xa, xrc, MOD + 5 * D};
          pg8::gemm_phase<epi::EpiResidT<res_t, res_t>, pg8::StaticOrder, ALIGN1, true>(C.lds, g, So, E); }
        TSTAMP(22);
        if (!ctxd) {
#ifdef D0CTX_X4
        constexpr int NCTX7 = 128;
        {
            if (C.bid < 64) { pg8::Gemm g2{H, WSB(WS_W_D0), MT, D, 768, FF}; pg8::CtxSplitOrder S2; S2.init(2, C.G, C.bid);
                epi::EpiResidSplit E2{xrc, xrc, (float*)(p.ws + WS_SLAB7), MOD + 5 * D, 0};
                pg8::gemm_phase<epi::EpiResidSplit, pg8::CtxSplitOrder, true, true>(C.lds, g2, S2, E2); }
            else if (C.bid < 128) { pg8::Gemm g2{H + 1536, WSB(WS_W_D0) + 1536, MT, D, 640, FF}; pg8::CtxSplitOrder S2; S2.init(2, C.G, C.bid - 64);
                epi::EpiResidSplit E2{xrc, xrc, (float*)(p.ws + WS_SLAB7), MOD + 5 * D, 2};
                pg8::gemm_phase<epi::EpiResidSplit, pg8::CtxSplitOrder, true, true>(C.lds, g2, S2, E2); }
        }
#else
        constexpr int NCTX7 = 64;
        { pg8::Gemm g{H, WSB(WS_W_D0), MT, D, FF / 2, FF}; pg8::CtxSplitOrder So; So.init(2, C.G, C.bid);
          epi::EpiResidSplit E{xrc, xrc, (float*)(p.ws + WS_SLAB7), MOD + 5 * D};
          pg8::gemm_phase<epi::EpiResidSplit, pg8::CtxSplitOrder, true, true>(C.lds, g, So, E); }
#endif
        TSTAMP(23);
#ifdef L1_IN_P7
        if (C.G > NCTX7) { if (C.bid >= NCTX7) { phase_prologue<1>(C, C.bid - NCTX7, C.G - NCTX7);
#ifdef CTXD_IN_P6
            phase_prologue<4>(C, C.bid - NCTX7, C.G - NCTX7);
#endif
            phase_natable(C, C.bid - NCTX7, C.G - NCTX7); } }
        else { phase_prologue<1>(C, C.vcu, C.G);
#ifdef CTXD_IN_P6
            phase_prologue<4>(C, C.vcu, C.G);
#endif
            phase_natable(C, C.vcu, C.G); }
#endif
        }
    } SEAM(7);
    PH(8) {
#ifndef L1_IN_P7
        phase_natable(C, C.vcu, C.G);
#endif
#if defined(FUSE910) && defined(FOLD_N13)
        if (C.G == 256) phase_bias(C, C.vcu, C.G, WSB(WS_W_GU1), 2 * FF, MOD + 9 * 6144 + 3 * D, 8, (float*)(p.ws + WS_BIAS1));
#endif
        phase_norm(C, xa, xrc, p.in[I1_NMIX], 1, 0, 1, MT, (const float*)(p.ws + WS_SLAB7),
#ifdef D0CTX_X4
            3,
#else
            ctxd ? 3 : 1,
#endif
            nullptr); } SEAM(8);
#ifdef FUSE910
    const bool fuse910 = (C.G == 256);
#else
    const bool fuse910 = false;
#endif
#ifdef FUSE910
    if (fuse910) {
      PH(9) { pg8::Gemm g{XN, WSB(WS_W_IN1), MT, L1_INP, D, D};
        epi::EpiIn1 E{WSB(WS_CQ), WSB(WS_CKV), WSB(WS_NQ), WSB(WS_NK), WSB(WS_NV), (float*)(p.ws + WS_KR), (float*)(p.ws + WS_SSQ), (float*)(p.ws + WS_SSKV), p.in[I1_NQG], p.in[I1_NKG]};
        unsigned* flag = barw + XB_IN1A;
        { pg8::ListOrder So; pg8::in1_xcd_list(So, C.bid, 0, 1); pg8::gemm_phase<epi::EpiIn1, pg8::ListOrder, ALIGN2, true>(C.lds, g, So, E); }
        if ((C.bid >> 3) < 27 && threadIdx.x == 0) { __builtin_amdgcn_fence(__ATOMIC_RELEASE, "agent"); asm volatile("s_waitcnt vmcnt(0)" ::: "memory"); xb_add(flag, 1u); }
        { pg8::ListOrder So; pg8::in1_xcd_list(So, C.bid, 1, 3); pg8::gemm_phase<epi::EpiIn1, pg8::ListOrder, ALIGN2, true>(C.lds, g, So, E); }
        if (threadIdx.x == 0) { XB_SPIN(xb_ld(flag) < 216u, barw); __builtin_amdgcn_fence(__ATOMIC_ACQUIRE, "agent"); asm volatile("s_waitcnt vmcnt(0)" ::: "memory"); }
        __syncthreads();
        { pg8::Gemm g2{WSB(WS_CQ), WSB(WS_W_UQ), ML, 768, 384, 384}; pg8::ListOrder S2; pg8::up_xcd_list(S2, C.bid, 0);
          epi::EpiQUp E2{WSB(WS_MQ), (const float*)(p.ws + WS_SSQ)};
          pg8::gemm_phase<epi::EpiQUp, pg8::ListOrder, ALIGN2, true>(C.lds, g2, S2, E2); }
        { pg8::Gemm g2{WSB(WS_CKV), WSB(WS_W_UKV), MT, 1024, 256, 256}; pg8::ListOrder S2; pg8::up_xcd_list(S2, C.bid, 1);
          epi::EpiKvUp E2{WSB(WS_MK), WSB(WS_MV), (const float*)(p.ws + WS_SSKV), (const float*)(p.ws + WS_KR), p.in[I1_MKG], T16};
          pg8::gemm_phase<epi::EpiKvUp, pg8::ListOrder, ALIGN2, true>(C.lds, g2, S2, E2); }
      } SEAM(10);
    }
#ifndef FUSE910_ONLY
    else {
#endif
#endif
#if !defined(FUSE910) || !defined(FUSE910_ONLY)
    PH(9) { pg8::Gemm g{XN, WSB(WS_W_IN1), MT, L1_INP, D, D}; pg8::StaticOrder So; So.init(MT, L1_INP, C.G, C.bid);
        epi::EpiIn1 E{WSB(WS_CQ), WSB(WS_CKV), WSB(WS_NQ), WSB(WS_NK), WSB(WS_NV), (float*)(p.ws + WS_KR), (float*)(p.ws + WS_SSQ), (float*)(p.ws + WS_SSKV), p.in[I1_NQG], p.in[I1_NKG]};
        pg8::gemm_phase<epi::EpiIn1, pg8::StaticOrder, ALIGN2, true>(C.lds, g, So, E);
#if defined(FOLD_N13) && !defined(REPACK)
        { const int n3 = (MT / 256) * (L1_INP / 256) - 2 * C.G;
          if (n3 >= 0 && n3 < C.G) { if (C.bid >= n3) phase_bias(C, C.bid - n3, C.G - n3, WSB(WS_W_GU1), 2 * FF, MOD + 9 * 6144 + 3 * D, 8, (float*)(p.ws + WS_BIAS1)); }
          else phase_bias(C, C.vcu, C.G, WSB(WS_W_GU1), 2 * FF, MOD + 9 * 6144 + 3 * D, 8, (float*)(p.ws + WS_BIAS1)); }
#endif
#if defined(P9_OUTD1) || defined(REPACK)
        { const int n3 = (MT / 256) * (L1_INP / 256) - 2 * C.G;
          if (n3 >= 0 && n3 < C.G) { if (C.bid >= n3) phase_prologue<4>(C, C.bid - n3, C.G - n3); } else phase_prologue<4>(C, C.vcu, C.G); }
#endif
#ifdef CTXD_IN_P6
        if (ctxd) { const int n3 = (MT / 256) * (L1_INP / 256) - 2 * C.G;
            if (n3 >= 0 && n3 < C.G) { if (C.bid >= n3) phase_prologue<4>(C, C.bid - n3, C.G - n3); } else phase_prologue<4>(C, C.vcu, C.G); }
#endif
    } SEAM(9);
    PH(10) {
#ifndef NO_QUP
        { pg8::Gemm g{WSB(WS_CQ), WSB(WS_W_UQ), ML, 768, 384, 384}; pg8::StaticOrder So; So.init(ML, 768, C.G, C.bid);
          epi::EpiQUp E{WSB(WS_MQ), (const float*)(p.ws + WS_SSQ)};
          pg8::gemm_phase<epi::EpiQUp, pg8::StaticOrder, ALIGN2, true>(C.lds, g, So, E); }
#endif
#ifndef NO_KVUP
        { pg8::Gemm g{WSB(WS_CKV), WSB(WS_W_UKV), MT, 1024, 256, 256}; pg8::StaticOrder So; So.init(MT, 1024, C.G, (C.bid + KVROT) % C.G);
          epi::EpiKvUp E{WSB(WS_MK), WSB(WS_MV), (const float*)(p.ws + WS_SSKV), (const float*)(p.ws + WS_KR), p.in[I1_MKG], T16};
          pg8::gemm_phase<epi::EpiKvUp, pg8::StaticOrder, ALIGN2, true>(C.lds, g, So, E); }
#endif
#ifdef MERGE1011
        asm volatile("s_waitcnt vmcnt(0)" ::: "memory"); __syncthreads();
        if (threadIdx.x == 0) { __builtin_amdgcn_fence(__ATOMIC_RELEASE, "agent"); asm volatile("s_waitcnt vmcnt(0)" ::: "memory"); xb_add(barw + XB_UP10, 1u); }
    }
    if (!(ph_lo <= 10 && 11 < ph_hi)) { }
#else
    } SEAM(10);
#endif
#endif
#if defined(FUSE910) && !defined(FUSE910_ONLY)
    }
#endif
    PH(11) { phase_attn1(C); TSTAMP(27);
#if defined(FOLD_N13) && defined(REPACK)
        if (C.G == 256) { const int lo3 = C.vcu & 7; if (lo3 == 0 || lo3 == 7) phase_bias(C, 2 * (C.vcu >> 3) + (lo3 == 7), 64, WSB(WS_W_GU1), 2 * FF, MOD + 9 * 6144 + 3 * D, 8, (float*)(p.ws + WS_BIAS1)); }
        else phase_bias(C, C.vcu, C.G, WSB(WS_W_GU1), 2 * FF, MOD + 9 * 6144 + 3 * D, 8, (float*)(p.ws + WS_BIAS1));
#endif
    } SEAM(11);
#ifdef FOLD_N13
    PH(12) { pg8::Gemm g{MIX, WSB(WS_W_OUT1), ML, D, D, D}; pg8::StaticOrder So; So.init(ML, D, C.G, C.bid);
        epi::EpiResidNT<res_t, res_t> E{xa, xb3, MOD + 9 * 6144 + 2 * D, WSB(WS_XN2), (float*)(p.ws + WS_SSN1), p.in[I1_NFFN], MOD + 9 * 6144 + 4 * D};
        pg8::gemm_phase<epi::EpiResidNT<res_t, res_t>, pg8::StaticOrder, ALIGN1, true>(C.lds, g, So, E); } SEAM(12);
    PH(14) { pg8::Gemm g{WSB(WS_XN2), WSB(WS_W_GU1), ML, 2 * FF, D, D}; pg8::StaticOrder So; So.init(ML, 2 * FF, C.G, C.bid);
#ifdef SKEW14
        { const int total = (ML / 256) * (2 * FF / 256), rem = total % C.G; if (rem > 0 && C.bid >= rem) skew_wait(SKEW14); }
#endif
        epi::EpiSwiGLUN E{H, (const float*)(p.ws + WS_SSN1), (const float*)(p.ws + WS_BIAS1)};
        pg8::gemm_phase<epi::EpiSwiGLUN, pg8::StaticOrder, true, true>(C.lds, g, So, E); } SEAM(14);
#else
    PH(12) { pg8::Gemm g{MIX, WSB(WS_W_OUT1), ML, D, D, D}; pg8::StaticOrder So; So.init(ML, D, C.G, C.bid);
        epi::EpiResidT<res_t, res_t> E{xa, xrc, xb3, xrc, MOD + 9 * 6144 + 2 * D};
        pg8::gemm_phase<epi::EpiResidT<res_t, res_t>, pg8::StaticOrder, ALIGN1, true>(C.lds, g, So, E); } SEAM(12);
    PH(13) { phase_norm(C, xb3, xrc, p.in[I1_NFFN], 1, 3, 4, ML); } SEAM(13);
    PH(14) { pg8::Gemm g{XN, WSB(WS_W_GU1), ML, 2 * FF, D, D}; pg8::StaticOrder So; So.init(ML, 2 * FF, C.G, C.bid);
        epi::EpiSwiGLU E{H};
        pg8::gemm_phase<epi::EpiSwiGLU, pg8::StaticOrder, true, true>(C.lds, g, So, E); } SEAM(14);
#endif
    PH(15) { pg8::Gemm g{H, WSB(WS_W_D1), ML, D, FF, FF}; pg8::StaticOrder So; So.init(ML, D, C.G, C.bid);
        epi::EpiResidT<res_t, float> E{xb3, xrc, out, xrc, MOD + 9 * 6144 + 5 * D};
        pg8::gemm_phase<epi::EpiResidT<res_t, float>, pg8::StaticOrder, ALIGN1, true>(C.lds, g, So, E); }
#ifdef TP_A
    xcd_barrier(bar); TSTAMP(16);
    if (C.bid == 0 && threadIdx.x == 0) { const unsigned long long* ts = (const unsigned long long*)(p.ws + WS_CTL) + 64; out[0] = TP_Q * floorf(((float)(ts[TP_B] - ts[TP_A]) * 0.01f + TP_O) / TP_Q); }
#endif
    if (ph_hi - ph_lo > 1 && C.bid == 0 && threadIdx.x == 0) { if (xb_ld(&barw[XB_TMO]) != 0u) out[0] = __builtin_nanf(""); }
#undef PH
#undef SEAM
#undef WSB
}
}
#ifndef MK_DEBUG
#define MK_DEBUG 0
#endif
static int g_grid = 0;
static bool mega_setup() {
    if (g_grid) return g_grid > 0;
    int dev = 0, cus = 0, per_cu = 0;
    if (hipGetDevice(&dev) != hipSuccess || hipDeviceGetAttribute(&cus, hipDeviceAttributeMultiprocessorCount, dev) != hipSuccess) { g_grid = -1; return false; }
    if (hipFuncSetAttribute((const void*)mk::mega, hipFuncAttributeMaxDynamicSharedMemorySize, mk::LDS_BYTES) != hipSuccess) { fprintf(stderr, "kernel_launch: hipFuncSetAttribute failed\n"); g_grid = -1; return false; }
    if (hipOccupancyMaxActiveBlocksPerMultiprocessor(&per_cu, (const void*)mk::mega, mk::NTHR, mk::LDS_BYTES) != hipSuccess || per_cu < 1) { fprintf(stderr, "kernel_launch: occupancy query says %d\n", per_cu); g_grid = -1; return false; }
    g_grid = cus;
    fprintf(stderr, "kernel_launch: %d CUs, occupancy %d blocks/CU, grid %d\n", cus, per_cu, g_grid);
    return true;
}
static void launch_phases(const Params& p, int lo, int hi, hipStream_t st) {
    Params pp = p; int l = lo, h = hi;
    void* args[] = {&pp, &l, &h};
    hipError_t e;
    if (hi - lo > 1) e = hipLaunchCooperativeKernel((const void*)mk::mega, dim3(g_grid), dim3(mk::NTHR), args, mk::LDS_BYTES, st);
    else e = hipLaunchKernel((const void*)mk::mega, dim3(g_grid), dim3(mk::NTHR), args, mk::LDS_BYTES, st);
    if (e != hipSuccess) fprintf(stderr, "kernel_launch: launch [%d,%d) failed: %s\n", lo, hi, hipGetErrorString(e));
}
#if MK_DEBUG
static void launch_debug(const Params& p, hipStream_t st) {
    using namespace nv;
    unsigned* err = (unsigned*)(p.ws + WS_CTL) + 64;
    float* out = p.out; float* xrc = (float*)(p.ws + WS_XRC);
    const float* x = p.in[I_X]; const float* cx = p.in[I_CTX];
    const size_t att_sm = 4 * (SK + 128) * sizeof(float);
    const int SR = 4096;
    float* snapL = (float*)(p.ws + WS_SNAP); float* snapC = snapL + (size_t)SR * D;
    float* snapB = (float*)(p.ws + WS_BIG);
    hipMemsetAsync(p.ws + WS_CTL, 0, WS_SSQ, st);
    launch_phases(p, 0, 1, st);  k_adaln<true><<<dim3(6144 / 256, 9, 2), 256, 0, st>>>(p, err + 0);
    launch_phases(p, 1, 2, st);  k_norm<true><<<MT / 4, 256, 0, st>>>(p, x, cx, I0_NMIX, 0, 0, 1, MT, err + 1);
    launch_phases(p, 2, 3, st);  k_in0<true><<<MT / R, 256, (R * D + R * L0_IN) * 4, st>>>(p, err + 2);
    launch_phases(p, 3, 4, st);  k_attn<true, 0><<<dim3(ML / 4, 12), 256, att_sm, st>>>(p, err + 3);
                                 k_attn<true, 1><<<dim3(MC / 4, 12), 256, att_sm, st>>>(p, err + 16);
                                 k_pool0<true><<<MT, 256, 0, st>>>(p, err + 17);
    launch_phases(p, 4, 5, st);  k_out<true, 0><<<MT / R, 256, (R * D + R * 256) * 4, st>>>(p, x, cx, out, xrc, 0, err + 4);
    launch_phases(p, 5, 6, st);  k_norm<true><<<MT / 4, 256, 0, st>>>(p, out, xrc, I0_NFFN, 0, 3, 4, MT, err + 5);
    launch_phases(p, 6, 7, st);  k_ffn_gu<true, 0><<<MT / R, 256, R * D * 4, st>>>(p, err + 6);
    hipMemcpyAsync(snapL, out, (size_t)SR * D * 4, hipMemcpyDeviceToDevice, st); hipMemcpyAsync(snapC, xrc, (size_t)MC * D * 4, hipMemcpyDeviceToDevice, st);
    launch_phases(p, 7, 8, st);  k_ffn_d<true, 0><<<SR / R, 256, R * FF * 4, st>>>(p, snapL, snapC, out, xrc, 0, err + 7);
                                 k_ffn_d<true, 0><<<MC / R, 256, R * FF * 4, st>>>(p, snapL, snapC, out, xrc, ML, err + 7);
    launch_phases(p, 8, 9, st);  k_norm<true><<<MT / 4, 256, 0, st>>>(p, out, xrc, I1_NMIX, 1, 0, 1, MT, err + 8);
    launch_phases(p, 9, 10, st); k_in1<true><<<MT / R, 256, (R * D + R * L1_IN) * 4, st>>>(p, err + 9);
    launch_phases(p, 10, 11, st); k_mlaq<true><<<ML / R, 256, R * 384 * 4, st>>>(p, err + 10);
                                 k_mlakv<true><<<MT / R, 256, (R * 256 + R * 1024) * 4, st>>>(p, err + 19);
    launch_phases(p, 11, 12, st); k_attn<true, 2><<<dim3(ML / 4, 8), 256, att_sm, st>>>(p, err + 11);
                                 k_attn<true, 3><<<dim3(ML / 4, 8), 256, att_sm, st>>>(p, err + 18);
    hipMemcpyAsync(snapB, out, (size_t)SR * D * 4, hipMemcpyDeviceToDevice, st);
    launch_phases(p, 12, 13, st); k_out<true, 1><<<SR / R, 256, (R * D + R * 256) * 4, st>>>(p, snapB, snapC, out, xrc, 0, err + 12);
    launch_phases(p, 13, 14, st); k_norm<true><<<ML / 4, 256, 0, st>>>(p, out, xrc, I1_NFFN, 1, 3, 4, ML, err + 13);
    launch_phases(p, 14, 15, st); k_ffn_gu<true, 1><<<ML / R, 256, R * D * 4, st>>>(p, err + 14);
    hipMemcpyAsync(snapL, out, (size_t)SR * D * 4, hipMemcpyDeviceToDevice, st);
    launch_phases(p, 15, 16, st); k_ffn_d<true, 1><<<SR / R, 256, R * FF * 4, st>>>(p, snapL, snapC, out, xrc, 0, err + 15);
    k_report<<<1, 1, 0, st>>>(p, 20, 0.15f);
}
#endif
extern "C" void kernel_launch(void* const* d_in, const int* in_sizes, int n_in, void* d_out, int out_size, void* d_ws, size_t ws_size, hipStream_t stream) {
    if (n_in != N_IN || out_size != ML * D || ws_size < WS_END) { fprintf(stderr, "kernel_launch: unexpected shapes n_in=%d out=%d ws=%zu\n", n_in, out_size, ws_size); return; }
    if (!mega_setup()) return;
    Params p{};
    for (int i = 0; i < N_IN; ++i) p.in[i] = (const float*)d_in[i];
    p.out = (float*)d_out; p.ws = (unsigned char*)d_ws;
#if MK_DEBUG
    launch_debug(p, stream);
#else
    if (hipMemsetAsync((char*)d_ws + WS_BARRIER, 0, WS_SSQ - WS_BARRIER, stream) != hipSuccess) { fprintf(stderr, "kernel_launch: memset failed\n"); return; }
#ifdef EXTRA_MEMSET
    (void)hipMemsetAsync((char*)d_ws + WS_CTL, 0, 4096, stream);
#endif
    launch_phases(p, 0, mk::NPHASE, stream);
#endif
}
```
